# Optimizing an MI355X kernel written in HIP

```python
import jax
import jax.numpy as jnp
from jax import lax
import numpy as np

D_MODEL = 4096
BATCH = 2
SEQ = 8192
DEPTH = 4

GRID_W = 64
CTX_LEN = 256
MIX_W = D_MODEL
GROUP_W = MIX_W // 4

POOL_WINDOWS = (2, 4, 8, 16)
POOL_CH = GROUP_W // len(POOL_WINDOWS)
NA_HEAD_DIM = 64
NA_HEADS = GROUP_W // NA_HEAD_DIM
NA_KH = 8
NA_KW = 16
ROPE_BASE = 10000.0
RW_HEAD = 64
RW_HEADS = GROUP_W // RW_HEAD
RW_LORA = 64
GN_EPS = 64e-5
SGU_CHUNK = 128
SGU_GROUPS = 8
SGU_CH = GROUP_W // SGU_GROUPS
LN_EPS = 1e-5
NORM_EPS = 1e-6

COL_LAYOUT = (
    ('pool_v', GROUP_W), ('pool_z', GROUP_W),
    ('na_q', GROUP_W), ('na_k', GROUP_W), ('na_v', GROUP_W), ('na_z', GROUP_W),
    ('rw_r', GROUP_W), ('rw_k', GROUP_W), ('rw_v', GROUP_W), ('rw_z', GROUP_W),
    ('rw_wd', 2 * RW_LORA), ('rw_ad', 2 * RW_LORA),
    ('sg_u', GROUP_W), ('sg_v', GROUP_W), ('sg_z', GROUP_W),
)
N_IN = sum(size for _, size in COL_LAYOUT)

kernel_name = 'hybrid_pool_natten_rwkv7_sgu_dit'


def rms_norm(x):
    x32 = x.astype(jnp.float32)
    return (x32 * lax.rsqrt(jnp.mean(x32 * x32, axis=-1, keepdims=True) + NORM_EPS)).astype(x.dtype)


def head_rms_norm(x, gain):
    return (rms_norm(x) * gain).astype(x.dtype)


def modulate(cond, w_mod, b_mod):
    m = jax.nn.silu(cond) @ w_mod + b_mod
    return jnp.split(m, 3, axis=-1)


def split_cols(p):
    out, start = {}, 0
    for name, size in COL_LAYOUT:
        out[name] = p[..., start:start + size]
        start += size
    return out


def token_shift(s, reverse):
    if reverse:
        return jnp.concatenate([s[:, 1:], jnp.zeros_like(s[:, :1])], axis=1)
    return jnp.concatenate([jnp.zeros_like(s[:, :1]), s[:, :-1]], axis=1)


def pool_branch(v, pool_w, pool_scale):
    T = v.shape[1]
    v32 = v.astype(jnp.float32)
    csum = jnp.pad(jnp.cumsum(v32, axis=1), ((0, 0), (1, 0), (0, 0)))
    t = jnp.arange(T)
    outs = []
    for g, win in enumerate(POOL_WINDOWS):
        lo = jnp.clip(t - win // 2, 0, T)
        hi = jnp.clip(t - win // 2 + win, 0, T)
        ch = slice(g * POOL_CH, (g + 1) * POOL_CH)
        mean = (csum[:, hi, ch] - csum[:, lo, ch]) / (hi - lo).astype(jnp.float32)[None, :, None]
        outs.append((mean - v32[:, :, ch]).astype(v.dtype) @ pool_w[g])
    return jnp.concatenate(outs, axis=-1) * pool_scale


def rope_2d(x):
    T, dh = x.shape[1], x.shape[-1]
    t = jnp.arange(T)
    n_freq = dh // 4
    inv = ROPE_BASE ** (-jnp.arange(n_freq, dtype=jnp.float32) / n_freq)

    def rot(xa, pos):
        ang = pos.astype(jnp.float32)[:, None] * inv
        cos = jnp.cos(ang)[None, :, None, :]
        sin = jnp.sin(ang)[None, :, None, :]
        x1, x2 = xa[..., :n_freq], xa[..., n_freq:]
        return jnp.concatenate([x1 * cos - x2 * sin, x2 * cos + x1 * sin], axis=-1)

    half = dh // 2
    return jnp.concatenate([rot(x[..., :half], t // GRID_W), rot(x[..., half:], t % GRID_W)],
                           axis=-1).astype(x.dtype)


def na_indices(T):
    rows = T // GRID_W
    kh = min(NA_KH, rows)
    t = jnp.arange(T)
    qr, qc = t // GRID_W, t % GRID_W
    rs = jnp.clip(qr - kh // 2, 0, rows - kh)
    cs = jnp.clip(qc - NA_KW // 2, 0, GRID_W - NA_KW)
    kr = rs[:, None, None] + jnp.arange(kh)[None, :, None]
    kc = cs[:, None, None] + jnp.arange(NA_KW)[None, None, :]
    shape = (T, kh, NA_KW)
    idx = jnp.broadcast_to(kr * GRID_W + kc, shape)
    rel_r = jnp.broadcast_to(kr - qr[:, None, None] + NA_KH - 1, shape)
    rel_c = jnp.broadcast_to(kc - qc[:, None, None] + NA_KW - 1, shape)
    blk = lambda a: a.reshape(rows, GRID_W, kh * NA_KW)
    return blk(idx), blk(rel_r), blk(rel_c)


def na_branch(pl, pc, q_gain, k_gain, rpb, with_ctx):
    hs = lambda a: a.reshape(a.shape[0], a.shape[1], NA_HEADS, NA_HEAD_DIM)
    q = rope_2d(head_rms_norm(hs(pl['na_q']), q_gain))
    k = rope_2d(head_rms_norm(hs(pl['na_k']), k_gain))
    v = hs(pl['na_v'])
    k_c = head_rms_norm(hs(pc['na_k']), k_gain)
    v_c = hs(pc['na_v'])
    B, T = q.shape[0], q.shape[1]
    rows = T // GRID_W
    idx, rel_r, rel_c = na_indices(T)
    scale = NA_HEAD_DIM ** -0.5

    def row_block(args):
        q_b, i_b, rr_b, rc_b = args
        k_w = jnp.take(k, i_b, axis=1)
        v_w = jnp.take(v, i_b, axis=1)
        s_win = jnp.einsum('bqhd,bqkhd->bhqk', q_b, k_w) * scale + rpb[:, rr_b, rc_b]
        s_ctx = jnp.einsum('bqhd,bchd->bhqc', q_b, k_c) * scale
        prob = jax.nn.softmax(jnp.concatenate([s_win, s_ctx], axis=-1).astype(jnp.float32),
                              axis=-1).astype(v.dtype)
        n_win = i_b.shape[-1]
        return (jnp.einsum('bhqk,bqkhd->bqhd', prob[..., :n_win], v_w)
                + jnp.einsum('bhqc,bchd->bqhd', prob[..., n_win:], v_c))

    q_rows = jnp.swapaxes(q.reshape(B, rows, GRID_W, NA_HEADS, NA_HEAD_DIM), 0, 1)
    o = lax.map(row_block, (q_rows, idx, rel_r, rel_c))
    o_lat = jnp.swapaxes(o, 0, 1).reshape(B, T, GROUP_W)
    o_ctx = None
    if with_ctx:
        q_c = head_rms_norm(hs(pc['na_q']), q_gain)
        s = jnp.einsum('bqhd,bkhd->bhqk', q_c, k_c) * scale
        prob = jax.nn.softmax(s.astype(jnp.float32), axis=-1).astype(v_c.dtype)
        o_ctx = jnp.einsum('bhqk,bkhd->bqhd', prob, v_c).reshape(B, -1, GROUP_W)
    return o_lat, o_ctx


def rwkv_dir_inputs(p, d, reverse, mu_rkv, mu_lora, w0, w_up, a0, a_up, k_k, k_a):
    heads = lambda a: a.reshape(a.shape[0], a.shape[1], RW_HEADS, RW_HEAD).astype(jnp.float32)
    lerp = lambda s, m: s + (token_shift(s, reverse) - s) * m
    lo = slice(d * RW_LORA, (d + 1) * RW_LORA)
    r = lerp(p['rw_r'], mu_rkv[d, 0])
    k = lerp(p['rw_k'], mu_rkv[d, 1])
    v = lerp(p['rw_v'], mu_rkv[d, 2])
    wd = lerp(p['rw_wd'][..., lo], mu_lora[d, 0])
    ad = lerp(p['rw_ad'][..., lo], mu_lora[d, 1])
    w = -jax.nn.softplus(-(w0[d] + jnp.tanh(wd) @ w_up[d])) - 0.5
    a = jax.nn.sigmoid(a0[d] + ad @ a_up[d])
    kk = heads(k * k_k)
    kk = kk * lax.rsqrt(jnp.maximum(jnp.sum(kk * kk, axis=-1, keepdims=True), 1e-12))
    k = k * (1 + (a - 1) * k_a)
    decay = jnp.exp(-jnp.exp(heads(w)))
    return (heads(r), decay, heads(k), heads(v), kk, kk * heads(a))


def wkv7_scan(s0, inputs, reverse):
    xs = tuple(jnp.swapaxes(a, 0, 1) for a in inputs)

    def step(S, inp):
        r_t, w_t, k_t, v_t, kk_t, kka_t = inp
        S = (S * w_t[:, :, None, :]
             - jnp.einsum('bhvk,bhk->bhv', S, kk_t)[..., None] * kka_t[:, :, None, :]
             + v_t[..., None] * k_t[:, :, None, :])
        return S, jnp.einsum('bhvk,bhk->bhv', S, r_t)

    S, y = lax.scan(step, s0, xs, reverse=reverse)
    return S, jnp.swapaxes(y, 0, 1)


def rwkv_readout(y, inputs, r_k, ln_w, ln_b):
    r, _, k, v, _, _ = inputs
    B, T = y.shape[0], y.shape[1]
    mu = jnp.mean(y, axis=-1, keepdims=True)
    var = jnp.mean(jnp.square(y - mu), axis=-1, keepdims=True)
    yn = ((y - mu) * lax.rsqrt(var + GN_EPS)).reshape(B, T, GROUP_W) * ln_w + ln_b
    bonus = jnp.sum(r * k * r_k, axis=-1, keepdims=True) * v
    return yn + bonus.reshape(B, T, GROUP_W)


def rwkv_branch(pl, pc, rw, with_ctx):
    mu_rkv, mu_lora, w0, w_up, a0, a_up, k_k, k_a, r_k, ln_w, ln_b = rw
    B = pl['rw_r'].shape[0]
    lat_outs, ctx_outs = [], []
    for d, reverse in enumerate((False, True)):
        ci = rwkv_dir_inputs(pc, d, reverse, mu_rkv, mu_lora, w0, w_up, a0, a_up, k_k, k_a)
        li = rwkv_dir_inputs(pl, d, reverse, mu_rkv, mu_lora, w0, w_up, a0, a_up, k_k, k_a)
        s0 = jnp.zeros((B, RW_HEADS, RW_HEAD, RW_HEAD), jnp.float32)
        s_ctx, y_ctx = wkv7_scan(s0, ci, reverse)
        _, y_lat = wkv7_scan(s_ctx, li, reverse)
        lat_outs.append(rwkv_readout(y_lat, li, r_k, ln_w, ln_b))
        if with_ctx:
            ctx_outs.append(rwkv_readout(y_ctx, ci, r_k, ln_w, ln_b))
    dt = pl['rw_r'].dtype
    o_lat = (lat_outs[0] + lat_outs[1]).astype(dt)
    o_ctx = (ctx_outs[0] + ctx_outs[1]).astype(dt) if with_ctx else None
    return o_lat, o_ctx


def sgu_branch(u, v, ln_w, ln_b, w_s, b_s):
    B, T = v.shape[0], v.shape[1]
    v32 = v.astype(jnp.float32)
    mu = jnp.mean(v32, axis=-1, keepdims=True)
    var = jnp.mean(jnp.square(v32 - mu), axis=-1, keepdims=True)
    vn = (((v32 - mu) * lax.rsqrt(var + LN_EPS)) * ln_w + ln_b).astype(v.dtype)
    vn = vn.reshape(B, T // SGU_CHUNK, SGU_CHUNK, SGU_GROUPS, SGU_CH)
    mixed = jnp.einsum('gpq,bnqgc->bnpgc', w_s, vn) + b_s.T[:, :, None]
    return u * mixed.reshape(B, T, GROUP_W)


def merge(p, y_pool, y_na, y_rw, y_sg, w_out):
    silu = jax.nn.silu
    y = jnp.concatenate([y_pool * silu(p['pool_z']), y_na * silu(p['na_z']),
                         y_rw * silu(p['rw_z']), y_sg * silu(p['sg_z'])], axis=-1)
    return y @ w_out


def hybrid_layer(h_lat, h_ctx, c, c_ctx, w_mod, b_mod, w_in, w_out, pool_w, pool_scale,
                 na_q_gain, na_k_gain, na_rpb, rw, sg_ln_w, sg_ln_b, sg_w, sg_b, with_ctx):
    shift, scale, gate = modulate(c, w_mod, b_mod)
    shift_c, scale_c, gate_c = modulate(c_ctx, w_mod, b_mod)
    x_lat = rms_norm(h_lat) * (1 + scale[:, None]) + shift[:, None]
    x_ctx = rms_norm(h_ctx) * (1 + scale_c) + shift_c
    pl = split_cols(x_lat @ w_in)
    pc = split_cols(x_ctx @ w_in)
    na_lat, na_ctx = na_branch(pl, pc, na_q_gain, na_k_gain, na_rpb, with_ctx)
    rw_lat, rw_ctx = rwkv_branch(pl, pc, rw, with_ctx)
    y_lat = merge(pl, pool_branch(pl['pool_v'], pool_w, pool_scale), na_lat, rw_lat,
                  sgu_branch(pl['sg_u'], pl['sg_v'], sg_ln_w, sg_ln_b, sg_w, sg_b), w_out)
    h_lat = h_lat + gate[:, None] * y_lat
    if with_ctx:
        y_ctx = merge(pc, pool_branch(pc['pool_v'], pool_w, pool_scale), na_ctx, rw_ctx,
                      sgu_branch(pc['sg_u'], pc['sg_v'], sg_ln_w, sg_ln_b, sg_w, sg_b), w_out)
        h_ctx = h_ctx + gate_c * y_ctx
    return h_lat, h_ctx


def setup_inputs(seed: int = 0) -> dict:
    key = jax.random.key(seed)
    ks = iter(jax.random.split(key, 28))
    f32 = jnp.float32
    nrm = lambda shape, s: jax.random.normal(next(ks), shape, f32) * s
    uni = lambda shape, lo, hi: jax.random.uniform(next(ks), shape, f32, lo, hi)
    L, GW = DEPTH, GROUP_W
    return {
        'x': nrm((BATCH, SEQ, D_MODEL), 1.0),
        'c': nrm((BATCH, D_MODEL), 1.0),
        'ctx': nrm((BATCH, CTX_LEN, D_MODEL), 1.0),
        'c_ctx': nrm((D_MODEL,), 1.0),
        'w_mod': nrm((L, D_MODEL, 3 * D_MODEL), 0.5 * D_MODEL ** -0.5),
        'b_mod': nrm((L, 3 * D_MODEL), 0.02),
        'w_in': nrm((L, D_MODEL, N_IN), D_MODEL ** -0.5),
        'w_out': nrm((L, MIX_W, D_MODEL), MIX_W ** -0.5),
        'pool_w': nrm((L, len(POOL_WINDOWS), POOL_CH, POOL_CH), POOL_CH ** -0.5),
        'pool_scale': 1.0 + nrm((L, GW), 0.1),
        'na_q_gain': 1.0 + nrm((L, NA_HEAD_DIM), 0.1),
        'na_k_gain': 1.0 + nrm((L, NA_HEAD_DIM), 0.1),
        'na_rpb': nrm((L, NA_HEADS, 2 * NA_KH - 1, 2 * NA_KW - 1), 0.5),
        'rw_mu_rkv': uni((L, 2, 3, GW), 0.0, 1.0),
        'rw_mu_lora': uni((L, 2, 2, RW_LORA), 0.0, 1.0),
        'rw_w0': uni((L, 2, GW), -5.0, -1.0),
        'rw_w_up': nrm((L, 2, RW_LORA, GW), RW_LORA ** -0.5),
        'rw_a0': nrm((L, 2, GW), 0.5),
        'rw_a_up': nrm((L, 2, RW_LORA, GW), RW_LORA ** -0.5),
        'rw_k_k': 0.85 + nrm((L, GW), 0.05),
        'rw_k_a': 1.0 + nrm((L, GW), 0.05),
        'rw_r_k': nrm((L, RW_HEADS, RW_HEAD), 0.1),
        'rw_ln_w': 1.0 + nrm((L, GW), 0.1),
        'rw_ln_b': nrm((L, GW), 0.02),
        'sg_ln_w': 1.0 + nrm((L, GW), 0.1),
        'sg_ln_b': nrm((L, GW), 0.02),
        'sg_w': nrm((L, SGU_GROUPS, SGU_CHUNK, SGU_CHUNK), SGU_CHUNK ** -0.5),
        'sg_b': nrm((L, SGU_GROUPS, SGU_CHUNK), 0.02),
    }


def reference(x, c, ctx, c_ctx, w_mod, b_mod, w_in, w_out, pool_w, pool_scale,
              na_q_gain, na_k_gain, na_rpb, rw_mu_rkv, rw_mu_lora, rw_w0, rw_w_up, rw_a0,
              rw_a_up, rw_k_k, rw_k_a, rw_r_k, rw_ln_w, rw_ln_b, sg_ln_w, sg_ln_b, sg_w, sg_b):
    h_lat, h_ctx = x, ctx
    for l in range(DEPTH):
        rw = (rw_mu_rkv[l], rw_mu_lora[l], rw_w0[l], rw_w_up[l], rw_a0[l], rw_a_up[l],
              rw_k_k[l], rw_k_a[l], rw_r_k[l], rw_ln_w[l], rw_ln_b[l])
        h_lat, h_ctx = hybrid_layer(
            h_lat, h_ctx, c, c_ctx, w_mod[l], b_mod[l], w_in[l], w_out[l], pool_w[l],
            pool_scale[l], na_q_gain[l], na_k_gain[l], na_rpb[l], rw,
            sg_ln_w[l], sg_ln_b[l], sg_w[l], sg_b[l], with_ctx=(l < DEPTH - 1))
    return h_lat
```

```cpp
#include <hip/hip_runtime.h>
#include <cstdio>
#include <cstdint>
#define MK_SPLIT 1
namespace pg8 {
#define PG8_LAS __attribute__((address_space(3)))
typedef unsigned short bf16_t;
typedef short bf16x8 __attribute__((ext_vector_type(8)));
typedef float f32x4 __attribute__((ext_vector_type(4)));
typedef unsigned u32x4 __attribute__((ext_vector_type(4)));
constexpr int BM = 256, BK = 64, HALF = 128, HTB = HALF * BK * 2  , STAGE_BYTES = 8 * HTB, NXCD = 8, WGM = 8;

__host__ __device__ __forceinline__ int lds_byte(int r, int c) { const int st = (r >> 4) * 2 + (c >> 5), rr = r & 15, cc = c & 31, ob = rr * 64 + cc * 2; return st * 1024 + (ob ^ (((ob >> 9) & 1) << 5)); }
__host__ __device__ __forceinline__ void stage_rc(int b, int& R, int& C) { const int st = b / 1024, sb = b % 1024, swz = sb ^ (((sb >> 9) & 1) << 5); R = (st >> 1) * 16 + swz / 64; C = (st & 1) * 32 + (swz % 64) / 2; }
__host__ __device__ __forceinline__ int perm32(int rho) { const int n = rho >> 4, i = rho & 15; return 8 * (i >> 2) + 4 * n + (i & 3); }

struct Unit { int pm, pn; };
struct Gemm { const bf16_t* A; const bf16_t* Bt; int M, N, K; };

struct StaticOrder {
    int nM, nN, nwg, G, c;
    __host__ __device__ void init(int M, int N, int G_, int c_) { nM = M / BM; nN = N / BM; nwg = nM * nN; G = G_; c = c_; }
    __host__ __device__ bool next(int i, Unit& u) const {
        const long L = (long)i * G + c; if (L >= nwg) return false;
        int wgid = (int)L; { const int q = nwg / NXCD, r = nwg % NXCD, xcd = wgid % NXCD, off = wgid / NXCD; wgid = (xcd < r ? xcd * (q + 1) : r * (q + 1) + (xcd - r) * q) + off; }
        const int nig = WGM * nN, gid = wgid / nig, fm = gid * WGM, gsz = (nM - fm) < WGM ? (nM - fm) : WGM;
        u.pm = fm + ((wgid % nig) % gsz); u.pn = (wgid % nig) / gsz; return true;
    }
    __device__ __forceinline__ void a_ready(const Unit&) const {}
    __device__ __forceinline__ void done(const Unit&) const {}
};

__device__ __forceinline__ unsigned cvt_pk_bf16(float lo, float hi) { unsigned r; asm volatile("v_cvt_pk_bf16_f32 %0, %1, %2" : "=v"(r) : "v"(lo), "v"(hi)); return r; }
template <class Epi, class Sched, bool ALIGN_EPI = false, bool SP2 = false>
__device__ __forceinline__ void gemm_phase(PG8_LAS unsigned char* lds, const Gemm g, const Sched& S, const Epi& E) {
    int tid_ = threadIdx.x; asm volatile("" : "+v"(tid_));
    const int tid = tid_, wid = __builtin_amdgcn_readfirstlane(tid >> 6), lane = tid & 63, wr = wid >> 2, wc = wid & 3, fr = lane & 15, fq = lane >> 4;
    const int K = g.K, nt = K / BK;
    unsigned voffA[2], voffB[2];
#pragma unroll
    for (int i = 0; i < 2; ++i) { int R, C; stage_rc(tid * 16 + i * 8192, R, C); const int Rb = Epi::PERM ? ((R & ~31) + perm32(R & 31)) : R;
        voffA[i] = (unsigned)(R * K + C) * 2u; voffB[i] = (unsigned)(Rb * K + C) * 2u; }
    const size_t kstep = (size_t)(BK * 2);
    const size_t hstep = (size_t)HALF * K * 2;
    const size_t tstep = 2 * hstep;
    const unsigned ldsw = (unsigned)wid * 1024u;
    const int aoff = lds_byte(wr * 64 + fr, fq * 8), boff = lds_byte(wc * 32 + fr, fq * 8);
#define PG8_SA(b, h) (((b) * 2 + (h)) * HTB)
#define PG8_SB(b, h) ((4 + (b) * 2 + (h)) * HTB)
#define PG8_STAGE(bufoff, gbase, voff) do { _Pragma("unroll") for (int _i = 0; _i < 2; ++_i) \
        __builtin_amdgcn_global_load_lds((const unsigned*)((const char*)(gbase) + (voff)[_i]), (PG8_LAS unsigned*)(lds + (bufoff) + ldsw + _i * 8192), 16, 0, 0); } while (0)
#define PG8_LDA(dst, b, h) do { _Pragma("unroll") for (int m = 0; m < 4; ++m) _Pragma("unroll") for (int k = 0; k < 2; ++k) dst[m][k] = *(const PG8_LAS bf16x8*)(lds + PG8_SA(b, h) + aoff + m * 2048 + k * 1024); } while (0)
#define PG8_LDB(dst, b, h) do { _Pragma("unroll") for (int n = 0; n < 2; ++n) _Pragma("unroll") for (int k = 0; k < 2; ++k) dst[n][k] = *(const PG8_LAS bf16x8*)(lds + PG8_SB(b, h) + boff + n * 2048 + k * 1024); } while (0)
#define PG8_MMA(ai, bj, At, Bt) do { __builtin_amdgcn_s_setprio(1); _Pragma("unroll") for (int m = 0; m < 4; ++m) _Pragma("unroll") for (int n = 0; n < 2; ++n) _Pragma("unroll") for (int k = 0; k < 2; ++k) \
        acc[ai][bj][m][n] = __builtin_amdgcn_mfma_f32_16x16x32_bf16(Bt[n][k], At[m][k], acc[ai][bj][m][n], 0, 0, 0); __builtin_amdgcn_s_setprio(0); } while (0)
#define PG8_WAIT_V(n) asm volatile("s_waitcnt vmcnt(" #n ")" ::: "memory")
#define PG8_WAIT_L(n) asm volatile("s_waitcnt lgkmcnt(" #n ")" ::: "memory")
#define PG8_BAR __builtin_amdgcn_s_barrier()
#define PG8_SCHED __builtin_amdgcn_sched_barrier(0)
    Unit cur, nxt; int ui = 0;
    if (!S.next(0, cur)) return;
    f32x4 acc[2][2][4][2];
#pragma unroll
    for (int a = 0; a < 2; ++a)
#pragma unroll
        for (int b = 0; b < 2; ++b)
#pragma unroll
            for (int m = 0; m < 4; ++m)
#pragma unroll
                for (int n = 0; n < 2; ++n) acc[a][b][m][n] = (f32x4){0.f, 0.f, 0.f, 0.f};
    bf16x8 At[4][2], B0[2][2], B1[2][2];
    const char* cA = (const char*)g.A + (size_t)cur.pm * tstep; const char* cB = (const char*)g.Bt + (size_t)cur.pn * tstep;
    S.a_ready(cur);
    if constexpr (SP2) {
        PG8_STAGE(PG8_SB(0, 0), cB, voffB); PG8_STAGE(PG8_SB(0, 1), cB + hstep, voffB); PG8_STAGE(PG8_SA(0, 0), cA, voffA); PG8_STAGE(PG8_SA(0, 1), cA + hstep, voffA);
        if (wr == 1) PG8_BAR;
        PG8_WAIT_V(2); PG8_BAR;
        PG8_STAGE(PG8_SB(1, 0), cB + kstep, voffB); PG8_STAGE(PG8_SA(1, 0), cA + kstep, voffA); PG8_STAGE(PG8_SB(1, 1), cB + hstep + kstep, voffB);
        PG8_WAIT_V(6); PG8_BAR;
    } else {
        PG8_STAGE(PG8_SB(0, 0), cB, voffB); PG8_STAGE(PG8_SA(0, 0), cA, voffA); PG8_STAGE(PG8_SB(0, 1), cB + hstep, voffB); PG8_STAGE(PG8_SA(0, 1), cA + hstep, voffA);
        if (wr == 1) PG8_BAR;
        PG8_WAIT_V(4); PG8_BAR;
        PG8_STAGE(PG8_SB(1, 0), cB + kstep, voffB); PG8_STAGE(PG8_SA(1, 0), cA + kstep, voffA); PG8_STAGE(PG8_SB(1, 1), cB + hstep + kstep, voffB);
        PG8_WAIT_V(6); PG8_BAR;
    }
    for (;;) {
        const bool has_next = S.next(ui + 1, nxt);
        const char* nA = has_next ? (const char*)g.A + (size_t)nxt.pm * tstep : cA; const char* nB = has_next ? (const char*)g.Bt + (size_t)nxt.pn * tstep : cB;
        for (int t = 0; t < nt; t += 2) {
            const bool last = (t == nt - 2);
            const char* a1 = cA + (size_t)(t + 1) * kstep;
            const char* a2 = last ? nA : cA + (size_t)(t + 2) * kstep; const char* b2 = last ? nB : cB + (size_t)(t + 2) * kstep;
            const char* a3 = a2 + kstep; const char* b3 = b2 + kstep;
            if (last && has_next) S.a_ready(nxt);
            if constexpr (SP2) {
            PG8_LDB(B0, 0, 0); PG8_LDB(B1, 0, 1); PG8_SCHED; PG8_LDA(At, 0, 0); PG8_STAGE(PG8_SA(1, 1), a1 + hstep, voffA);
            PG8_WAIT_V(8); PG8_WAIT_L(0); PG8_BAR; PG8_MMA(0, 0, At, B0); PG8_MMA(0, 1, At, B1); PG8_BAR; PG8_SCHED;
            PG8_LDA(At, 0, 1); PG8_STAGE(PG8_SB(0, 0), b2, voffB); PG8_STAGE(PG8_SB(0, 1), b2 + hstep, voffB); PG8_STAGE(PG8_SA(0, 0), a2, voffA);
            PG8_WAIT_V(8); PG8_WAIT_L(0); PG8_BAR; PG8_MMA(1, 0, At, B0); PG8_MMA(1, 1, At, B1); PG8_BAR; PG8_SCHED;
            PG8_LDB(B0, 1, 0); PG8_LDB(B1, 1, 1); PG8_SCHED; PG8_LDA(At, 1, 0); PG8_STAGE(PG8_SA(0, 1), a2 + hstep, voffA);
            PG8_WAIT_V(8); PG8_WAIT_L(0); PG8_BAR; PG8_MMA(0, 0, At, B0); PG8_MMA(0, 1, At, B1); PG8_BAR; PG8_SCHED;
            PG8_LDA(At, 1, 1); PG8_STAGE(PG8_SB(1, 0), b3, voffB); PG8_STAGE(PG8_SB(1, 1), b3 + hstep, voffB); PG8_STAGE(PG8_SA(1, 0), a3, voffA);
            PG8_WAIT_V(8); PG8_WAIT_L(0); PG8_BAR; PG8_MMA(1, 0, At, B0); PG8_MMA(1, 1, At, B1); PG8_BAR; PG8_SCHED;
            } else {
            PG8_LDB(B0, 0, 0); PG8_SCHED; PG8_LDA(At, 0, 0); PG8_STAGE(PG8_SA(1, 1), a1 + hstep, voffA);
            PG8_WAIT_L(8); PG8_BAR; PG8_WAIT_L(0); PG8_MMA(0, 0, At, B0); PG8_BAR; PG8_SCHED;
            PG8_LDB(B1, 0, 1); PG8_STAGE(PG8_SB(0, 0), b2, voffB);
            PG8_BAR; PG8_WAIT_L(0); PG8_MMA(0, 1, At, B1); PG8_BAR;
            PG8_LDA(At, 0, 1); PG8_STAGE(PG8_SA(0, 0), a2, voffA);
            PG8_BAR; PG8_WAIT_L(0); PG8_MMA(1, 0, At, B0); PG8_BAR; PG8_SCHED;
            PG8_STAGE(PG8_SB(0, 1), b2 + hstep, voffB);
            PG8_WAIT_V(6); PG8_BAR; PG8_MMA(1, 1, At, B1); PG8_BAR;
            PG8_LDB(B0, 1, 0); PG8_SCHED; PG8_LDA(At, 1, 0); PG8_STAGE(PG8_SA(0, 1), a2 + hstep, voffA);
            PG8_WAIT_L(8); PG8_BAR; PG8_WAIT_L(0); PG8_MMA(0, 0, At, B0); PG8_BAR; PG8_SCHED;
            PG8_LDB(B1, 1, 1); PG8_STAGE(PG8_SB(1, 0), b3, voffB);
            PG8_BAR; PG8_WAIT_L(0); PG8_MMA(0, 1, At, B1); PG8_BAR;
            PG8_LDA(At, 1, 1); PG8_STAGE(PG8_SA(1, 0), a3, voffA);
            PG8_BAR; PG8_WAIT_L(0); PG8_MMA(1, 0, At, B0); PG8_BAR; PG8_SCHED;
            PG8_STAGE(PG8_SB(1, 1), b3 + hstep, voffB);
            PG8_WAIT_V(6); PG8_BAR; PG8_MMA(1, 1, At, B1); PG8_BAR;
            }
        }
        if constexpr (ALIGN_EPI) { if (wr == 0) PG8_BAR; }
        if constexpr (!Epi::AFTER_DRAIN) { E(acc, cur, wr, wc, fr, fq); S.done(cur); }
        if (!has_next) break;
#pragma unroll
        for (int a = 0; a < 2; ++a)
#pragma unroll
            for (int b = 0; b < 2; ++b)
#pragma unroll
                for (int m = 0; m < 4; ++m)
#pragma unroll
                    for (int n = 0; n < 2; ++n) acc[a][b][m][n] = (f32x4){0.f, 0.f, 0.f, 0.f};
        cur = nxt; cA = nA; cB = nB; ++ui;
        if constexpr (ALIGN_EPI) { if (wr == 1) PG8_BAR; }
    }
    PG8_WAIT_V(0);
    if constexpr (!ALIGN_EPI) { if (wr == 0) PG8_BAR; }
    PG8_BAR;
    if constexpr (Epi::AFTER_DRAIN) { E.fused(acc, cur, wr, wc, fr, fq, lds, wid, lane); S.done(cur); }
#undef PG8_SA
#undef PG8_SB
#undef PG8_STAGE
#undef PG8_LDA
#undef PG8_LDB
#undef PG8_MMA
#undef PG8_WAIT_V
#undef PG8_WAIT_L
#undef PG8_BAR
#undef PG8_SCHED
}
}

constexpr int DM = 4096, NBATCH = 2, SEQ = 8192, DEPTH = 4, CTXL = 256;
constexpr int NLAT = NBATCH * SEQ, NCTX = NBATCH * CTXL, MROWS = NLAT + NCTX;
constexpr int NIN = 13568, GWD = 1024;
constexpr int C_POOLV = 0, C_POOLZ = 1024, C_NAQ = 2048, C_NAK = 3072, C_NAV = 4096, C_NAZ = 5120, C_RWR = 6144, C_RWK = 7168, C_RWV = 8192, C_RWZ = 9216,
              C_RWWD = 10240, C_RWAD = 10368, C_SGU = 10496, C_SGV = 11520, C_SGZ = 12544;
constexpr int SCANLEN = CTXL + SEQ;
constexpr int NCHAIN = 64;
constexpr int RECF = 384;
constexpr int NWAVES = 8;

constexpr size_t MiB = 1u << 20;
constexpr size_t WS_CTL = 0, CTL_ZERO_BYTES = 1 * MiB;
constexpr size_t WS_MOD   = 2 * MiB;
constexpr size_t WS_TAB   = 3 * MiB;
constexpr size_t WS_SGST  = 4 * MiB;
constexpr size_t WS_BON   = 5 * MiB;
constexpr size_t WS_POOLWT= 8 * MiB;
constexpr size_t WS_WUPT  = 10 * MiB;
constexpr size_t WS_AUPT  = 11 * MiB;
constexpr size_t WS_SGW   = 12 * MiB;
constexpr size_t WS_VTC   = 13 * MiB;
constexpr size_t WS_HCTX  = 14 * MiB;
constexpr size_t WS_MODP  = 22 * MiB;
constexpr size_t WS_VTL   = 58 * MiB;
constexpr size_t WS_QN    = 90 * MiB;
constexpr size_t WS_KN    = 123 * MiB;
constexpr size_t WS_WOUTT = 156 * MiB;
constexpr size_t WS_WINT  = 284 * MiB;
constexpr size_t WS_XN    = 708 * MiB;
constexpr size_t WS_Y     = 840 * MiB;
constexpr size_t WS_P     = 972 * MiB;
constexpr size_t WS_YR    = 1410 * MiB;
constexpr size_t WS_REC   = 1542 * MiB;
constexpr size_t WS_END   = 2334 * MiB;
static_assert(WS_P + (size_t)MROWS * NIN * 2 <= WS_YR && WS_REC + (size_t)NCHAIN * SCANLEN * RECF * 4 <= WS_END && WS_WINT + (size_t)4 * NIN * DM * 2 <= WS_XN, "ws map");
constexpr int CW_TMO = 0, CW_BAR = 4096;

constexpr int RING_BYTES = 131072, LDSCTL_OFF = RING_BYTES, MISC_OFF = LDSCTL_OFF + 320, LDS_BYTES = 147456;

#define GAS __attribute__((address_space(1)))
#define LAS __attribute__((address_space(3)))
typedef unsigned short bf16;
typedef unsigned v4u __attribute__((ext_vector_type(4)));
typedef unsigned v2u __attribute__((ext_vector_type(2)));
typedef float f32x4 __attribute__((ext_vector_type(4)));
typedef float f32x2 __attribute__((ext_vector_type(2)));
typedef short bf16x8 __attribute__((ext_vector_type(8)));
#define RLX_AGENT __ATOMIC_RELAXED, __HIP_MEMORY_SCOPE_AGENT
#define LDS_WAIT() asm volatile("s_waitcnt lgkmcnt(0)" ::: "memory")

__device__ __forceinline__ float bf2f(unsigned short h) { return __uint_as_float(((unsigned)h) << 16); }
__device__ __forceinline__ float bflo(unsigned w) { return __uint_as_float(w << 16); }
__device__ __forceinline__ float bfhi(unsigned w) { return __uint_as_float(w & 0xffff0000u); }
__device__ __forceinline__ unsigned f2bf(float f) { unsigned u = __float_as_uint(f); return (u + 0x7fffu + ((u >> 16) & 1u)) >> 16; }
__device__ __forceinline__ unsigned pk2(float lo, float hi) { return f2bf(lo) | (f2bf(hi) << 16); }
__device__ __forceinline__ void unpack8(const v4u w, float* x) { x[0] = bflo(w.x); x[1] = bfhi(w.x); x[2] = bflo(w.y); x[3] = bfhi(w.y); x[4] = bflo(w.z); x[5] = bfhi(w.z); x[6] = bflo(w.w); x[7] = bfhi(w.w); }
__device__ __forceinline__ v4u pack8(const float* x) { v4u w; w.x = pk2(x[0], x[1]); w.y = pk2(x[2], x[3]); w.z = pk2(x[4], x[5]); w.w = pk2(x[6], x[7]); return w; }
__device__ __forceinline__ float silu_f(float x) { return x / (1.f + __expf(-x)); }
__device__ __forceinline__ float wave_sum(float v) {
#pragma unroll
    for (int o = 1; o < 64; o <<= 1) v += __shfl_xor(v, o);
    return v;
}
template <int CTRL> __device__ __forceinline__ float dppf(float v) { return __builtin_bit_cast(float, __builtin_amdgcn_update_dpp(0, __builtin_bit_cast(int, v), CTRL, 0xF, 0xF, true)); }
__device__ __forceinline__ float red16(float v) { v += dppf<0xB1>(v); v += dppf<0x4E>(v); v += dppf<0x141>(v); v += dppf<0x140>(v); return v; }
__device__ __forceinline__ float max16x4(float v) { v = fmaxf(v, __shfl_xor(v, 16)); v = fmaxf(v, __shfl_xor(v, 32)); return v; }
__device__ __forceinline__ float sum16x4(float v) { v += __shfl_xor(v, 16); v += __shfl_xor(v, 32); return v; }
__device__ __forceinline__ int scan_pos(int d, bool isctx, int t) { return d == 0 ? (isctx ? t : CTXL + t) : (isctx ? (CTXL - 1 - t) : (CTXL + SEQ - 1 - t)); }
__device__ __forceinline__ f32x4 mfma16(bf16x8 a, bf16x8 b, f32x4 c) { return __builtin_amdgcn_mfma_f32_16x16x32_bf16(a, b, c, 0, 0, 0); }
__device__ __forceinline__ bf16x8 ld_frag(const bf16* p) { return __builtin_bit_cast(bf16x8, *(const v4u*)p); }

namespace pg8 {
struct EpiStoreBf16 {
    static constexpr bool PERM = true, AFTER_DRAIN = false;
    bf16_t* O; int ldc;
    __device__ __forceinline__ void operator()(const f32x4 (&acc)[2][2][4][2], const Unit& u, int wr, int wc, int fr, int fq) const {
        const int row0 = u.pm * BM + wr * 64 + fr, col0 = u.pn * BM + wc * 32 + 8 * fq;
#pragma unroll
        for (int ai = 0; ai < 2; ++ai)
#pragma unroll
            for (int m = 0; m < 4; ++m) { bf16_t* rowp = O + (size_t)(row0 + ai * HALF + m * 16) * ldc + col0;
#pragma unroll
                for (int bj = 0; bj < 2; ++bj) { const f32x4 v0 = acc[ai][bj][m][0], v1 = acc[ai][bj][m][1];
                    u32x4 w; w.x = cvt_pk_bf16(v0[0], v0[1]); w.y = cvt_pk_bf16(v0[2], v0[3]); w.z = cvt_pk_bf16(v1[0], v1[1]); w.w = cvt_pk_bf16(v1[2], v1[3]);
                    *(u32x4*)(rowp + bj * HALF) = w; } }
    }
};
struct EpiResGate {
    static constexpr bool PERM = false, AFTER_DRAIN = false;
    const float* hin_lat; const float* hin_ctx; float* hout_lat; float* hout_ctx; const float* gate;
    __device__ __forceinline__ void operator()(const f32x4 (&acc)[2][2][4][2], const Unit& u, int wr, int wc, int fr, int fq) const {
        const int cond = u.pm < 32 ? 0 : (u.pm < 64 ? 1 : 2);
        const int rloc = (u.pm < 64 ? u.pm * BM : (u.pm - 64) * BM) + wr * 64 + fr, col0 = u.pn * BM + wc * 32 + 4 * fq;
        const float* hin = u.pm < 64 ? hin_lat : hin_ctx; float* hout = u.pm < 64 ? hout_lat : hout_ctx;
        f32x4 gv[2][2];
#pragma unroll
        for (int bj = 0; bj < 2; ++bj)
#pragma unroll
            for (int n = 0; n < 2; ++n) gv[bj][n] = *(const f32x4*)(gate + cond * 12288 + 8192 + col0 + bj * HALF + n * 16);
#pragma unroll
        for (int ai = 0; ai < 2; ++ai)
#pragma unroll
            for (int m = 0; m < 4; ++m) { const size_t off = (size_t)(rloc + ai * HALF + m * 16) * 4096 + col0;
#pragma unroll
                for (int bj = 0; bj < 2; ++bj)
#pragma unroll
                    for (int n = 0; n < 2; ++n) { const f32x4 b = *(const f32x4*)(hin + off + bj * HALF + n * 16);
                        *(f32x4*)(hout + off + bj * HALF + n * 16) = b + gv[bj][n] * acc[ai][bj][m][n]; } }
    }
};
}

__device__ __forceinline__ void p0_transpose_item(const float* W, int K, int N, bf16* WT, LAS float* scr, int item, int lane) {
    const int nblk = N / 32, kb = item / nblk, nb = item % nblk, k0 = 64 * kb, n0 = 32 * nb;
#pragma unroll 8
    for (int i = 0; i < 32; ++i) { const int kk = 2 * i + (lane >> 5); scr[kk * 33 + (lane & 31)] = W[(size_t)(k0 + kk) * N + n0 + (lane & 31)]; }
    LDS_WAIT(); asm volatile("" ::: "memory");
    const int c = lane & 7;
#pragma unroll
    for (int j = 0; j < 4; ++j) { const int n = (lane >> 3) + 8 * j; const LAS float* s = scr + (8 * c) * 33 + n;
        v4u o; o.x = pk2(s[0 * 33], s[1 * 33]); o.y = pk2(s[2 * 33], s[3 * 33]); o.z = pk2(s[4 * 33], s[5 * 33]); o.w = pk2(s[6 * 33], s[7 * 33]);
        *(v4u*)(WT + (size_t)(n0 + n) * K + k0 + 8 * c) = o; }
    LDS_WAIT(); asm volatile("" ::: "memory");
}
__device__ __forceinline__ void p0_mod_item(const float* wmod, const float* cvec, const float* cctx, float* MODP, LAS float* scr, int item, int lane) {
    const int l = item / (64 * 48), r = item % (64 * 48), kc = r / 48, nc = r % 48, k0 = kc * 64, n0 = nc * 256 + lane * 4;
    scr[lane] = silu_f(cvec[k0 + lane]); scr[64 + lane] = silu_f(cvec[4096 + k0 + lane]); scr[128 + lane] = silu_f(cctx[k0 + lane]);
    LDS_WAIT(); asm volatile("" ::: "memory");
    f32x4 a0 = {0.f, 0.f, 0.f, 0.f}, a1 = a0, a2 = a0;
    const float* wp = wmod + ((size_t)l * 4096 + k0) * 12288 + n0;
#pragma unroll 16
    for (int k = 0; k < 64; ++k) { const f32x4 w = *(const f32x4*)(wp + (size_t)k * 12288); a0 += scr[k] * w; a1 += scr[64 + k] * w; a2 += scr[128 + k] * w; }
    float* o = MODP + ((size_t)(l * 64 + kc) * 3) * 12288 + n0;
    *(f32x4*)(o) = a0; *(f32x4*)(o + 12288) = a1; *(f32x4*)(o + 2 * 12288) = a2;
    LDS_WAIT(); asm volatile("" ::: "memory");
}
__device__ __forceinline__ void sincos_acc(float ang, float& c, float& s) {
    const double x = (double)ang; const double n = __builtin_rint(x * 0.63661977236758134308); const double r = x - n * 1.57079632679489661923;
    const double r2 = r * r;
    const double sp = r * (1.0 + r2 * (-1.0 / 6 + r2 * (1.0 / 120 + r2 * (-1.0 / 5040 + r2 * (1.0 / 362880 + r2 * (-1.0 / 39916800 + r2 * (1.0 / 6227020800.0)))))));
    const double cp = 1.0 + r2 * (-0.5 + r2 * (1.0 / 24 + r2 * (-1.0 / 720 + r2 * (1.0 / 40320 + r2 * (-1.0 / 3628800 + r2 * (1.0 / 479001600 + r2 * (-1.0 / 87178291200.0)))))));
    const int q = ((int)n) & 3;
    const double cc = (q == 0) ? cp : (q == 1) ? -sp : (q == 2) ? -cp : sp;
    const double ss = (q == 0) ? sp : (q == 1) ? cp : (q == 2) ? -sp : -cp;
    c = (float)cc; s = (float)ss;
}

__device__ __forceinline__ void phase_xn(const float* hlat, const float* hctx, const float* mod, bf16* XN, int gw, int NGW, int lane) {
    for (int m = gw; m < MROWS; m += NGW) {
        const float* src = m < NLAT ? hlat + (size_t)m * DM : hctx + (size_t)(m - NLAT) * DM;
        const int cond = m < NLAT ? (m >> 13) : 2;
        const f32x4* s4 = (const f32x4*)src + lane;
        f32x4 v[16]; float ss = 0.f;
#pragma unroll
        for (int j = 0; j < 16; ++j) { v[j] = s4[64 * j]; ss += (v[j].x * v[j].x + v[j].y * v[j].y) + (v[j].z * v[j].z + v[j].w * v[j].w); }
        ss = wave_sum(ss);
        const float rstd = 1.0f / sqrtf(ss * (1.f / 4096.f) + 1e-6f);
        const f32x4* sh4 = (const f32x4*)(mod + cond * 12288) + lane; const f32x4* sc4 = (const f32x4*)(mod + cond * 12288 + 4096) + lane;
        v2u* o = (v2u*)(XN + (size_t)m * DM) + lane;
#pragma unroll
        for (int j = 0; j < 16; ++j) { const f32x4 sh = sh4[64 * j], sc = sc4[64 * j]; const f32x4 x = v[j] * rstd * (sc + 1.f) + sh; v2u w; w.x = pk2(x.x, x.y); w.y = pk2(x.z, x.w); o[64 * j] = w; }
    }
}

__device__ __forceinline__ void phase_rowprep(const bf16* P, const float* qgain, const float* kgain, const f32x2* tab, bf16* QN, bf16* KN, f32x2* SGST, int gw, int NGW, int lane) {
    const int sub = lane & 3;
    for (int m = gw; m < MROWS; m += NGW) {
        const bf16* pr = P + (size_t)m * NIN;
        const bool isctx = m >= NLAT; const int t = isctx ? ((m - NLAT) & 255) : (m & 8191);
        {   float x[16]; unpack8(*(const v4u*)(pr + C_SGV + 16 * lane), x); unpack8(*(const v4u*)(pr + C_SGV + 16 * lane + 8), x + 8);
            float s = 0.f;
#pragma unroll
            for (int i = 0; i < 16; ++i) s += x[i];
            const float mean = wave_sum(s) * (1.f / 1024.f); float q = 0.f;
#pragma unroll
            for (int i = 0; i < 16; ++i) { const float dlt = x[i] - mean; q += dlt * dlt; }
            const float var = wave_sum(q) * (1.f / 1024.f);
            if (lane == 0) SGST[m] = (f32x2){mean, 1.0f / sqrtf(var + 1e-5f)}; }
        float q[16], k[16];
        unpack8(*(const v4u*)(pr + C_NAQ + 16 * lane), q); unpack8(*(const v4u*)(pr + C_NAQ + 16 * lane + 8), q + 8);
        unpack8(*(const v4u*)(pr + C_NAK + 16 * lane), k); unpack8(*(const v4u*)(pr + C_NAK + 16 * lane + 8), k + 8);
        float sq = 0.f, sk = 0.f;
#pragma unroll
        for (int i = 0; i < 16; ++i) { sq += q[i] * q[i]; sk += k[i] * k[i]; }
        sq += __shfl_xor(sq, 1); sq += __shfl_xor(sq, 2); sk += __shfl_xor(sk, 1); sk += __shfl_xor(sk, 2);
        const float rq = 1.0f / sqrtf(sq * (1.f / 64.f) + 1e-6f), rk = 1.0f / sqrtf(sk * (1.f / 64.f) + 1e-6f);
#pragma unroll
        for (int i = 0; i < 16; ++i) { q[i] *= rq * qgain[16 * sub + i]; k[i] *= rk * kgain[16 * sub + i]; }
        if (!isctx) {
            const int pos = sub < 2 ? (t >> 6) : (t & 63);
#pragma unroll
            for (int i = 0; i < 16; ++i) { const f32x2 cs = tab[pos * 16 + i]; const float pq = __shfl_xor(q[i], 1), pkk = __shfl_xor(k[i], 1);
                q[i] = (sub & 1) ? (q[i] * cs.x + pq * cs.y) : (q[i] * cs.x - pq * cs.y);
                k[i] = (sub & 1) ? (k[i] * cs.x + pkk * cs.y) : (k[i] * cs.x - pkk * cs.y); }
        }
#pragma unroll
        for (int i = 0; i < 16; ++i) q[i] *= 0.125f;
        *(v4u*)(QN + (size_t)m * GWD + 16 * lane) = pack8(q); *(v4u*)(QN + (size_t)m * GWD + 16 * lane + 8) = pack8(q + 8);
        *(v4u*)(KN + (size_t)m * GWD + 16 * lane) = pack8(k); *(v4u*)(KN + (size_t)m * GWD + 16 * lane + 8) = pack8(k + 8);
    }
}
__device__ __forceinline__ void phase_vt(const bf16* P, bf16* VTL, bf16* VTC, int gw, int NGW, int lane) {
    for (int u = gw; u < (MROWS / 64) * 16; u += NGW) {
        const int tt = u >> 4, h = u & 15, m0 = tt * 64;
        const bf16* src = P + (size_t)m0 * NIN + C_NAV + h * 64 + lane;
        unsigned w[32];
#pragma unroll
        for (int i = 0; i < 32; ++i) { const unsigned lo = src[(size_t)(2 * i) * NIN], hi = src[(size_t)(2 * i + 1) * NIN]; w[i] = lo | (hi << 16); }
        bf16* dst = tt < 256 ? VTL + (((size_t)((tt >> 7) * 16 + h) * 64 + lane) * 8192 + (tt & 127) * 64)
                             : VTC + (((size_t)(((tt - 256) >> 2) * 16 + h) * 64 + lane) * 256 + ((tt - 256) & 3) * 64);
#pragma unroll
        for (int j = 0; j < 8; ++j) { v4u o; o.x = w[4 * j]; o.y = w[4 * j + 1]; o.z = w[4 * j + 2]; o.w = w[4 * j + 3]; ((v4u*)dst)[j] = o; }
    }
}
__device__ __forceinline__ void phase_pool(const bf16* P, const bf16* PWT  , const float* pscale, bf16* Y, int nrows, int gw, int NGW, int lane) {
    const int r = lane & 15, q4 = lane >> 4;
    for (int u = gw; u < (nrows / 16) * 4; u += NGW) {
        const int tt = u >> 2, g = u & 3, m0 = tt * 16, m = m0 + r;
        const bool isctx = m0 >= NLAT; const int T = isctx ? CTXL : SEQ; const int t = isctx ? ((m - NLAT) & 255) : (m & 8191);
        const int win = 2 << g, tlo = t - (win >> 1);
        const int lo = tlo < 0 ? 0 : tlo, hi = (tlo + win) > T ? T : (tlo + win);
        const float inv = 1.0f / (float)(hi - lo);
        const bf16* wbase = PWT + (size_t)g * 65536;
        f32x4 acc[16];
#pragma unroll
        for (int nt = 0; nt < 16; ++nt) acc[nt] = (f32x4){0.f, 0.f, 0.f, 0.f};
        for (int ks = 0; ks < 8; ++ks) {
            const int ch0 = C_POOLV + g * 256 + 32 * ks + 8 * q4;
            float sum[8];
#pragma unroll
            for (int j = 0; j < 8; ++j) sum[j] = 0.f;
            for (int k = 0; k < win; ++k) { const int tk = tlo + k;
                if (tk >= 0 && tk < T) { float x[8]; unpack8(*(const v4u*)(P + (size_t)(m - t + tk) * NIN + ch0), x);
#pragma unroll
                    for (int j = 0; j < 8; ++j) sum[j] += x[j]; } }
            float self[8]; unpack8(*(const v4u*)(P + (size_t)m * NIN + ch0), self);
            float dv[8];
#pragma unroll
            for (int j = 0; j < 8; ++j) dv[j] = sum[j] * inv - self[j];
            const bf16x8 af = __builtin_bit_cast(bf16x8, pack8(dv));
#pragma unroll
            for (int nt = 0; nt < 16; ++nt) { const bf16x8 bfg = ld_frag(wbase + (size_t)(16 * nt + r) * 256 + 32 * ks + 8 * q4); acc[nt] = mfma16(af, bfg, acc[nt]); }
        }
#pragma unroll
        for (int nt = 0; nt < 16; ++nt) { const int oc = g * 256 + 16 * nt + r; const float ps = pscale[oc];
#pragma unroll
            for (int i = 0; i < 4; ++i) { const int row = m0 + 4 * q4 + i; const float z = bf2f(P[(size_t)row * NIN + C_POOLZ + oc]);
                Y[(size_t)row * DM + oc] = (bf16)f2bf(acc[nt][i] * ps * silu_f(z)); } }
    }
}
__device__ __forceinline__ void phase_rwprep(const bf16* P, const float* mu_rkv  , const float* mu_lora  , const float* w0  , const bf16* WUPT  ,
                                             const float* a0, const bf16* AUPT, const float* k_k, const float* k_a, const float* r_k, float* REC, float* BON, int gw, int NGW, int lane) {
    const int r = lane & 15, q4 = lane >> 4;
    for (int u = gw; u < (MROWS / 16) * 16; u += NGW) {
        const int tt = u >> 4, d = (u >> 3) & 1, hp = u & 7, m0 = tt * 16;
        const bool isctx = m0 >= NLAT; const int T = isctx ? CTXL : SEQ; const int t0 = isctx ? ((m0 - NLAT) & 255) : (m0 & 8191); const int b = isctx ? ((m0 - NLAT) >> 8) : (m0 >> 13);
        bf16x8 Aw[2], Aa[2];
        {   const int mA = m0 + r, tA = t0 + r; const bool hasnb = d == 0 ? (tA > 0) : (tA < T - 1); const int nbA = d == 0 ? mA - 1 : mA + 1;
#pragma unroll
            for (int ks = 0; ks < 2; ++ks) { const int j0 = 32 * ks + 8 * q4;
                float cur[8], nb[8], o[8];
                unpack8(*(const v4u*)(P + (size_t)mA * NIN + C_RWWD + d * 64 + j0), cur);
                if (hasnb) unpack8(*(const v4u*)(P + (size_t)nbA * NIN + C_RWWD + d * 64 + j0), nb); else {
#pragma unroll
                    for (int j = 0; j < 8; ++j) nb[j] = 0.f; }
#pragma unroll
                for (int j = 0; j < 8; ++j) o[j] = tanhf(cur[j] + (nb[j] - cur[j]) * mu_lora[(d * 2 + 0) * 64 + j0 + j]);
                Aw[ks] = __builtin_bit_cast(bf16x8, pack8(o));
                unpack8(*(const v4u*)(P + (size_t)mA * NIN + C_RWAD + d * 64 + j0), cur);
                if (hasnb) unpack8(*(const v4u*)(P + (size_t)nbA * NIN + C_RWAD + d * 64 + j0), nb); else {
#pragma unroll
                    for (int j = 0; j < 8; ++j) nb[j] = 0.f; }
#pragma unroll
                for (int j = 0; j < 8; ++j) o[j] = cur[j] + (nb[j] - cur[j]) * mu_lora[(d * 2 + 1) * 64 + j0 + j];
                Aa[ks] = __builtin_bit_cast(bf16x8, pack8(o)); }
        }
#pragma unroll 1
        for (int hh = 0; hh < 2; ++hh) {
            const int head = hp * 2 + hh;
            float KK[4][4], Av[4][4];
            float ss[4] = {0.f, 0.f, 0.f, 0.f}, bon[4] = {0.f, 0.f, 0.f, 0.f};
            const int chain = (b * 2 + d) * 16 + head;
            const int pos0 = scan_pos(d, isctx, t0 + 4 * q4), dpos = d == 0 ? 1 : -1;
            float* const rec0 = REC + ((size_t)chain * SCANLEN + pos0) * RECF + r;
#pragma unroll
            for (int n4 = 0; n4 < 4; ++n4) {
                const int ch = head * 64 + 16 * n4 + r;
                f32x4 accW = {0.f, 0.f, 0.f, 0.f}, accA = accW;
#pragma unroll
                for (int ks = 0; ks < 2; ++ks) { accW = mfma16(Aw[ks], ld_frag(WUPT + (size_t)(d * 1024 + ch) * 64 + 32 * ks + 8 * q4), accW);
                                                 accA = mfma16(Aa[ks], ld_frag(AUPT + (size_t)(d * 1024 + ch) * 64 + 32 * ks + 8 * q4), accA); }
                const float w0v = w0[d * 1024 + ch], a0v = a0[d * 1024 + ch], mur = mu_rkv[(d * 3 + 0) * 1024 + ch], muk = mu_rkv[(d * 3 + 1) * 1024 + ch], muv = mu_rkv[(d * 3 + 2) * 1024 + ch];
                const float kkv = k_k[ch], kav = k_a[ch], rkv = r_k[ch];
#pragma unroll
                for (int i = 0; i < 4; ++i) { const int m = m0 + 4 * q4 + i, t = t0 + 4 * q4 + i; const bool hasnb = d == 0 ? (t > 0) : (t < T - 1); const int nb = d == 0 ? m - 1 : m + 1;
                    const bf16* pc = P + (size_t)m * NIN + ch; const bf16* pn = P + (size_t)nb * NIN + ch;
                    const float rc = bf2f(pc[C_RWR]), kc = bf2f(pc[C_RWK]), vc = bf2f(pc[C_RWV]);
                    const float rn = hasnb ? bf2f(pn[C_RWR]) : 0.f, kn = hasnb ? bf2f(pn[C_RWK]) : 0.f, vn = hasnb ? bf2f(pn[C_RWV]) : 0.f;
                    const float rr = rc + (rn - rc) * mur, kk0 = kc + (kn - kc) * muk, vv = vc + (vn - vc) * muv;
                    const float xw = -(w0v + accW[i]);
                    const float sp = fmaxf(xw, 0.f) + log1pf(__expf(-fabsf(xw)));
                    const float dec = __expf(-__expf(-sp - 0.5f));
                    const float av = 1.0f / (1.0f + __expf(-(a0v + accA[i])));
                    const float kx = kk0 * kkv; ss[i] += kx * kx;
                    const float kp = kk0 * (1.f + (av - 1.f) * kav); bon[i] += rr * kp * rkv;
                    KK[n4][i] = kx; Av[n4][i] = av;
                    float* o = rec0 + (ptrdiff_t)(i * dpos) * RECF + 16 * n4;
                    o[0] = dec; o[192] = kp; o[256] = rr; o[320] = vv; }
            }
#pragma unroll
            for (int i = 0; i < 4; ++i) { const float s = red16(ss[i]), bo = red16(bon[i]); const float inv = 1.0f / sqrtf(fmaxf(s, 1e-12f));
                float* rec = rec0 + (ptrdiff_t)(i * dpos) * RECF;
#pragma unroll
                for (int n4 = 0; n4 < 4; ++n4) { const float kkn = KK[n4][i] * inv; rec[16 * n4 + 64] = kkn; rec[16 * n4 + 128] = kkn * Av[n4][i]; }
                if (r == 0) BON[(size_t)chain * SCANLEN + pos0 + i * dpos] = bo; }
        }
    }
}
template <bool CTXQ>
__device__ __forceinline__ void na_unit(const bf16* QN, const bf16* KN, const bf16* VTL, const bf16* VTC, const bf16* P, const float* rpb  , bf16* Y, int u, int lane) {
    const int n = lane & 15, q4 = lane >> 4;
    int b, h, qrow0, qr = 0, jt = 0;
    if (CTXQ) { b = u >> 8; h = (u >> 4) & 15; qrow0 = NLAT + b * CTXL + 16 * (u & 15); }
    else { jt = u & 3; h = (u >> 2) & 15; qr = (u >> 6) & 127; b = u >> 13; qrow0 = b * SEQ + qr * 64 + 16 * jt; }
    bf16x8 qf[2];
#pragma unroll
    for (int ks = 0; ks < 2; ++ks) qf[ks] = ld_frag(QN + (size_t)(qrow0 + n) * GWD + h * 64 + 32 * ks + 8 * q4);
    constexpr int NT = CTXQ ? 16 : 32, WT = CTXQ ? 0 : 16;
    f32x4 s[NT];
    const int rs = qr - 4 < 0 ? 0 : (qr - 4 > 120 ? 120 : qr - 4);
    const int span0 = jt == 0 ? 0 : (jt == 1 ? 8 : (jt == 2 ? 24 : 32));
    if (!CTXQ) {
        const int qc = 16 * jt + n; const int cs = qc - 8 < 0 ? 0 : (qc - 8 > 48 ? 48 : qc - 8);
        const float* rp = rpb + (size_t)h * 15 * 31;
#pragma unroll
        for (int wt = 0; wt < 16; ++wt) { const int kri = wt >> 1, half = wt & 1;
            const bf16* kp = KN + (size_t)(b * SEQ + (rs + kri) * 64 + span0 + 16 * half + n) * GWD + h * 64 + 8 * q4;
            f32x4 a = {0.f, 0.f, 0.f, 0.f};
            a = mfma16(ld_frag(kp), qf[0], a); a = mfma16(ld_frag(kp + 32), qf[1], a);
            const int relr = rs + kri - qr + 7;
#pragma unroll
            for (int i = 0; i < 4; ++i) { const int kc = span0 + 16 * half + 4 * q4 + i; const bool ok = kc >= cs && kc < cs + 16;
                const int relc = kc - qc + 15; const int relcc = relc < 0 ? 0 : (relc > 30 ? 30 : relc);
                const float bias = rp[relr * 31 + relcc];
                a[i] = ok ? a[i] + bias : -INFINITY; }
            s[wt] = a; }
    }
#pragma unroll
    for (int ct = 0; ct < 16; ++ct) { const bf16* kp = KN + (size_t)(NLAT + b * CTXL + 16 * ct + n) * GWD + h * 64 + 8 * q4;
        f32x4 a = {0.f, 0.f, 0.f, 0.f};
        a = mfma16(ld_frag(kp), qf[0], a); a = mfma16(ld_frag(kp + 32), qf[1], a);
        s[WT + ct] = a; }
    float mx = -INFINITY;
#pragma unroll
    for (int t = 0; t < NT; ++t) mx = fmaxf(fmaxf(fmaxf(s[t][0], s[t][1]), fmaxf(s[t][2], s[t][3])), mx);
    mx = max16x4(mx);
    float sum = 0.f;
#pragma unroll
    for (int t = 0; t < NT; ++t) {
#pragma unroll
        for (int i = 0; i < 4; ++i) { const float e = __expf(s[t][i] - mx); s[t][i] = e; sum += e; } }
    sum = sum16x4(sum);
    const float inv = 1.0f / sum;
    f32x4 o[4];
#pragma unroll
    for (int nt = 0; nt < 4; ++nt) o[nt] = (f32x4){0.f, 0.f, 0.f, 0.f};
#pragma unroll
    for (int tp = 0; tp < NT / 2; ++tp) {
        const f32x4 p0 = s[2 * tp] * inv, p1 = s[2 * tp + 1] * inv;
        v4u aw; aw.x = pk2(p0[0], p0[1]); aw.y = pk2(p0[2], p0[3]); aw.z = pk2(p1[0], p1[1]); aw.w = pk2(p1[2], p1[3]);
        const bf16x8 af = __builtin_bit_cast(bf16x8, aw);
        const bf16* vb; size_t dstride;
        if (!CTXQ && tp < 8) { vb = VTL + ((size_t)(b * 16 + h) * 64 + n) * 8192 + (rs + tp) * 64 + span0 + 4 * q4; dstride = (size_t)16 * 8192; }
        else { const int ct = 2 * (tp - (CTXQ ? 0 : 8)); vb = VTC + ((size_t)(b * 16 + h) * 64 + n) * 256 + 16 * ct + 4 * q4; dstride = (size_t)16 * 256; }
#pragma unroll
        for (int nt = 0; nt < 4; ++nt) { const v2u x0 = *(const v2u*)(vb + nt * dstride), x1 = *(const v2u*)(vb + nt * dstride + 16);
            v4u bw; bw.x = x0.x; bw.y = x0.y; bw.z = x1.x; bw.w = x1.y;
            o[nt] = mfma16(af, __builtin_bit_cast(bf16x8, bw), o[nt]); }
    }
#pragma unroll
    for (int nt = 0; nt < 4; ++nt)
#pragma unroll
        for (int i = 0; i < 4; ++i) { const int row = qrow0 + 4 * q4 + i, col = h * 64 + 16 * nt + n; const float z = bf2f(P[(size_t)row * NIN + C_NAZ + col]);
            Y[(size_t)row * DM + 1024 + col] = (bf16)f2bf(o[nt][i] * silu_f(z)); }
}
__device__ __forceinline__ void phase_sgu(const bf16* P, const f32x2* SGST, const float* lnw, const float* lnb, const bf16* SGW  , const float* sgb  , bf16* Y,
                                          LAS unsigned char* lds, int nchunks, int tid, int wave, int lane) {
    const int n = lane & 15, q4 = lane >> 4;
    LAS bf16* T = (LAS bf16*)lds;
    for (int u = blockIdx.x; u < nchunks * 8; u += 256) {
        const int ck = u >> 3, g = u & 7, m0 = ck * 128;
#pragma unroll
        for (int it = 0; it < 4; ++it) { const int idx = tid + 512 * it, q = idx >> 4, c8 = idx & 15;
            float x[8]; unpack8(*(const v4u*)(P + (size_t)(m0 + q) * NIN + C_SGV + g * 128 + 8 * c8), x);
            const f32x2 st = SGST[m0 + q];
#pragma unroll
            for (int j = 0; j < 8; ++j) { const int c = 8 * c8 + j; const float v = (x[j] - st.x) * st.y * lnw[g * 128 + c] + lnb[g * 128 + c]; T[c * 136 + q] = (bf16)f2bf(v); } }
        __syncthreads();
        bf16x8 af[4];
#pragma unroll
        for (int ks = 0; ks < 4; ++ks) af[ks] = ld_frag(SGW + ((size_t)g * 128 + 16 * wave + n) * 128 + 32 * ks + 8 * q4);
#pragma unroll
        for (int nt = 0; nt < 8; ++nt) {
            f32x4 acc = {0.f, 0.f, 0.f, 0.f};
#pragma unroll
            for (int ks = 0; ks < 4; ++ks) { const bf16x8 bfg = *(const LAS bf16x8*)(T + (16 * nt + n) * 136 + 32 * ks + 8 * q4); acc = mfma16(af[ks], bfg, acc); }
#pragma unroll
            for (int i = 0; i < 4; ++i) { const int p = 16 * wave + 4 * q4 + i, row = m0 + p, col = g * 128 + 16 * nt + n;
                const float mixed = acc[i] + sgb[g * 128 + p]; const bf16* pr = P + (size_t)row * NIN;
                const float uu = bf2f(pr[C_SGU + col]), z = bf2f(pr[C_SGZ + col]);
                Y[(size_t)row * DM + 3072 + col] = (bf16)f2bf(uu * mixed * silu_f(z)); }
        }
        __syncthreads();
    }
}
__device__ __forceinline__ void phase_scan(const float* REC, float* YR, LAS unsigned char* lds, int wave, int lane) {
    constexpr int NCH = SCANLEN / 16, SLOT = 16 * RECF * 4;
    for (int su = blockIdx.x; su < NCHAIN * 4; su += 256) {
        const int chain = (su & 7) * 8 + ((su >> 3) >> 2), part = (su >> 3) & 3;
        const char* recb = (const char*)(REC + (size_t)chain * SCANLEN * RECF);
        if (wave >= 4) {
            const int wl = wave - 4;
#define SCAN_ISSUE(cc, sl) do { _Pragma("unroll") for (int p_ = 0; p_ < 6; ++p_) \
            __builtin_amdgcn_global_load_lds((const unsigned*)(recb + (size_t)(cc) * SLOT + (wl * 6 + p_) * 1024 + lane * 16), (LAS unsigned*)(lds + (sl) * SLOT + (wl * 6 + p_) * 1024), 16, 0, 0); } while (0)
            SCAN_ISSUE(0, 0); SCAN_ISSUE(1, 1); SCAN_ISSUE(2, 2);
            for (int c = 0; c < NCH; ++c) {
                asm volatile("s_waitcnt vmcnt(12)" ::: "memory");
                __builtin_amdgcn_s_barrier();
                const int cc = c + 3 < NCH ? c + 3 : NCH - 1;
                SCAN_ISSUE(cc, (c + 3) & 3);
            }
            asm volatile("s_waitcnt vmcnt(0)" ::: "memory");
#undef SCAN_ISSUE
        } else {
            const int c16 = lane & 15, rg = lane >> 4, row = 16 * part + 4 * wave + rg;
            f32x4 S = {0.f, 0.f, 0.f, 0.f};
            float* yout = YR + (size_t)chain * SCANLEN * 64 + row;
            for (int c = 0; c < NCH; ++c) {
                __builtin_amdgcn_s_barrier();
                asm volatile("" ::: "memory");
                const LAS unsigned char* slot = lds + (c & 3) * SLOT;
                float ysave = 0.f;
#pragma unroll
                for (int s = 0; s < 16; ++s) {
                    const LAS unsigned char* rec = slot + s * (RECF * 4);
                    const f32x4 w4 = *(const LAS f32x4*)(rec + c16 * 16), kk4 = *(const LAS f32x4*)(rec + 256 + c16 * 16), ka4 = *(const LAS f32x4*)(rec + 512 + c16 * 16),
                                k4 = *(const LAS f32x4*)(rec + 768 + c16 * 16), r4 = *(const LAS f32x4*)(rec + 1024 + c16 * 16);
                    const float vv = *(const LAS float*)(rec + 1280 + row * 4);
                    float dt = (S.x * kk4.x + S.y * kk4.y) + (S.z * kk4.z + S.w * kk4.w);
                    dt = red16(dt);
                    const f32x4 uu = S * w4 + vv * k4;
                    S = uu - dt * ka4;
                    float y = (S.x * r4.x + S.y * r4.y) + (S.z * r4.z + S.w * r4.w);
                    y = red16(y);
                    ysave = (c16 == s) ? y : ysave;
                }
                asm volatile("" ::: "memory");
                yout[(size_t)(c * 16 + c16) * 64] = ysave;
            }
        }
        __syncthreads();
    }
}
__device__ __forceinline__ void phase_rwfin(const bf16* P, const float* YR, const float* REC, const float* BON, const float* lnw, const float* lnb, bf16* Y, int nrows, int gw, int NGW, int lane) {
    const int head = lane >> 2, sub = lane & 3;
    for (int m = gw; m < nrows; m += NGW) {
        const bool isctx = m >= NLAT; const int t = isctx ? ((m - NLAT) & 255) : (m & 8191); const int b = isctx ? ((m - NLAT) >> 8) : (m >> 13);
        float out[16];
#pragma unroll
        for (int i = 0; i < 16; ++i) out[i] = 0.f;
#pragma unroll
        for (int d = 0; d < 2; ++d) {
            const int chain = (b * 2 + d) * 16 + head; const size_t pp = (size_t)chain * SCANLEN + scan_pos(d, isctx, t);
            float y[16], v[16];
#pragma unroll
            for (int j = 0; j < 4; ++j) { const f32x4 a = *(const f32x4*)(YR + pp * 64 + 16 * sub + 4 * j), c = *(const f32x4*)(REC + pp * RECF + 320 + 16 * sub + 4 * j);
                y[4 * j] = a.x; y[4 * j + 1] = a.y; y[4 * j + 2] = a.z; y[4 * j + 3] = a.w; v[4 * j] = c.x; v[4 * j + 1] = c.y; v[4 * j + 2] = c.z; v[4 * j + 3] = c.w; }
            const float bo = BON[pp];
            float s = 0.f;
#pragma unroll
            for (int i = 0; i < 16; ++i) s += y[i];
            s += __shfl_xor(s, 1); s += __shfl_xor(s, 2);
            const float mean = s * (1.f / 64.f); float q = 0.f;
#pragma unroll
            for (int i = 0; i < 16; ++i) { const float dl = y[i] - mean; q += dl * dl; }
            q += __shfl_xor(q, 1); q += __shfl_xor(q, 2);
            const float rstd = 1.0f / sqrtf(q * (1.f / 64.f) + 64e-5f);
#pragma unroll
            for (int i = 0; i < 16; ++i) { const int ch = head * 64 + 16 * sub + i; out[i] += (y[i] - mean) * rstd * lnw[ch] + lnb[ch] + bo * v[i]; }
        }
        float z[16]; unpack8(*(const v4u*)(P + (size_t)m * NIN + C_RWZ + 16 * lane), z); unpack8(*(const v4u*)(P + (size_t)m * NIN + C_RWZ + 16 * lane + 8), z + 8);
#pragma unroll
        for (int i = 0; i < 16; ++i) out[i] *= silu_f(z[i]);
        *(v4u*)(Y + (size_t)m * DM + 2048 + 16 * lane) = pack8(out); *(v4u*)(Y + (size_t)m * DM + 2048 + 16 * lane + 8) = pack8(out + 8);
    }
}
#define XB_TMO      128
#define XB_XCNT(j)  (256  + 64 * (j))
#define XB_XSUB(j)  (1280 + 64 * (j))
#define XB_XGEN(j)  (2304 + 64 * (j))
#define XB_TOP      3328
#define XB_TOPGEN   3392
#define XCD_BAR_WORDS 3456
#define XB_SPIN_CAP (1u << 18)

__device__ __forceinline__ unsigned xb_ld(unsigned* p)              { return __hip_atomic_load(p, __ATOMIC_RELAXED, __HIP_MEMORY_SCOPE_AGENT); }
__device__ __forceinline__ unsigned xb_add(unsigned* p, unsigned v) { return __hip_atomic_fetch_add(p, v, __ATOMIC_RELAXED, __HIP_MEMORY_SCOPE_AGENT); }
__device__ __forceinline__ unsigned xb_xcc_id() { return (unsigned)__builtin_amdgcn_s_getreg((3 << 11) | 20) & 0xFu; }
#define XB_SPIN(cond, bar) do { unsigned _sp = 0; while (cond) { __builtin_amdgcn_s_sleep(1); \
    if ((++_sp & 255u) == 0u) { if (xb_ld(&(bar)[XB_TMO])) break; if (_sp > XB_SPIN_CAP) { atomicAdd(&(bar)[XB_TMO], 1u); break; } } } } while (0)

struct XcdBarrier {
    unsigned* bar; unsigned x;
    volatile LAS unsigned* st;
};

__device__ __forceinline__ XcdBarrier xcd_barrier_post(unsigned* bar, volatile LAS unsigned* st) {
    XcdBarrier b; b.bar = bar; b.x = xb_xcc_id(); b.st = st;
    if (threadIdx.x == 0) (void)xb_add(&bar[XB_XCNT(b.x)], 1u);
    return b;
}
__device__ __forceinline__ void xcd_barrier_complete(unsigned* bar, unsigned x, unsigned& nloc, unsigned& nx) {
    const unsigned G = gridDim.x * gridDim.y * gridDim.z;
    unsigned sum, cnt, mine, sp = 0u;
    for (;;) {
        sum = 0u; cnt = 0u; mine = 0u;
#pragma unroll
        for (unsigned j = 0; j < 16; ++j) { const unsigned c = xb_ld(&bar[XB_XCNT(j)]); sum += c; cnt += (c > 0u) ? 1u : 0u; mine = (j == x) ? c : mine; }
        if (sum == G) break;
        __builtin_amdgcn_s_sleep(1);
        if ((++sp & 255u) == 0u) { if (xb_ld(&bar[XB_TMO])) break; if (sp > XB_SPIN_CAP) { atomicAdd(&bar[XB_TMO], 1u); break; } }
    }
    nloc = mine > 0u ? mine : 1u; nx = cnt > 0u ? cnt : 1u;
}

__device__ __forceinline__ void xcd_barrier(const XcdBarrier& b) {
    asm volatile("s_waitcnt vmcnt(0)" ::: "memory");
    __syncthreads();
    if (threadIdx.x == 0) {
        unsigned* bar = b.bar;
        __builtin_amdgcn_s_waitcnt(0);
        unsigned nloc = b.st[0], nx = b.st[1];
        if (nloc == 0u) { xcd_barrier_complete(bar, b.x, nloc, nx); b.st[0] = nloc; b.st[1] = nx; }
        const unsigned old = xb_add(&bar[XB_XSUB(b.x)], 1u);
        const unsigned gen = old / nloc;
        if (old + 1u == (gen + 1u) * nloc) {
            __builtin_amdgcn_fence(__ATOMIC_RELEASE, "agent");
            asm volatile("s_waitcnt vmcnt(0)" ::: "memory");
            const unsigned og = xb_add(&bar[XB_TOP], 1u);
            const unsigned tg = og / nx;
            if (og + 1u == (tg + 1u) * nx) xb_add(&bar[XB_TOPGEN], 1u);
            else XB_SPIN(xb_ld(&bar[XB_TOPGEN]) == tg, bar);
            __builtin_amdgcn_fence(__ATOMIC_ACQUIRE, "agent");
            xb_add(&bar[XB_XGEN(b.x)], 1u);
            asm volatile("s_waitcnt vmcnt(0)" ::: "memory");
        } else {
            XB_SPIN(xb_ld(&bar[XB_XGEN(b.x)]) == gen, bar);
            __builtin_amdgcn_fence(__ATOMIC_ACQUIRE, "agent");
            asm volatile("s_waitcnt vmcnt(0)" ::: "memory");
        }
    }
    __syncthreads();
}

#ifndef MK_SPLIT
#define MK_SPLIT 0
#endif
constexpr int NPHASE = 2 + 6 * DEPTH;
constexpr int NGRID = 256;
struct Args { const float* in[28]; float* out; unsigned char* ws; int ph_lo, ph_hi, li, pad; };

__global__ void __launch_bounds__(NWAVES * 64, 2) fwd(Args args) {
    extern __shared__ __attribute__((aligned(16))) unsigned char lds_raw[];
    LAS unsigned char* lds = (LAS unsigned char*)lds_raw;
    volatile LAS unsigned* MISC = (volatile LAS unsigned*)(lds + MISC_OFF);
    const int tid = threadIdx.x, lane = tid & 63, wave = __builtin_amdgcn_readfirstlane(tid >> 6);
    constexpr int G = NGRID; const int bx = blockIdx.x;
    const int vcu = (bx % 8) * (G / 8) + bx / 8;
    const int gw = vcu * NWAVES + wave; constexpr int NGW = G * NWAVES;
    unsigned char* ws = args.ws;
    const int lo = args.ph_lo, hi = args.ph_hi;

    for (int u = tid; u < (LDS_BYTES - LDSCTL_OFF) / 4; u += NWAVES * 64) ((LAS unsigned*)(lds + LDSCTL_OFF))[u] = 0u;
    __syncthreads();
    XcdBarrier bar; bar.bar = (unsigned*)(ws + WS_CTL) + CW_BAR; bar.x = 0; bar.st = MISC + 8;
    if (hi - lo > 1) bar = xcd_barrier_post((unsigned*)(ws + WS_CTL) + CW_BAR, MISC + 8);
#define IN(k) (lo <= (k) && (k) < hi)
#define SEAM(k) do { if (lo <= (k) && (k) + 1 < hi) { XcdBarrier b2_; b2_.bar = WSP(unsigned, WS_CTL) + CW_BAR; b2_.x = bar.x; b2_.st = bar.st; xcd_barrier(b2_); } } while (0)

#define OPQ_S(x) ({ int _t = (x); asm volatile("" : "+s"(_t)); _t; })
#define OPQ_V(x) ({ int _t = (x); asm volatile("" : "+v"(_t)); _t; })
#define INP(i) (args.in[OPQ_S(i)])
#define WSP(T, off) ((T*)(args.ws + ({ size_t _o = (off); asm volatile("" : "+s"(_o)); _o; })))
#define x_in INP(0)
#define c_in INP(1)
#define ctx_in INP(2)
#define cctx_in INP(3)
#define w_mod INP(4)
#define b_mod INP(5)
#define w_in INP(6)
#define w_out INP(7)
#define pool_w INP(8)
#define pool_scale INP(9)
#define na_qg INP(10)
#define na_kg INP(11)
#define na_rpb INP(12)
#define rw_mu_rkv INP(13)
#define rw_mu_lora INP(14)
#define rw_w0 INP(15)
#define rw_w_up INP(16)
#define rw_a0 INP(17)
#define rw_a_up INP(18)
#define rw_k_k INP(19)
#define rw_k_a INP(20)
#define rw_r_k INP(21)
#define rw_ln_w INP(22)
#define rw_ln_b INP(23)
#define sg_ln_w INP(24)
#define sg_ln_b INP(25)
#define sg_w INP(26)
#define sg_b INP(27)
#define MOD WSP(float, WS_MOD)
#define MODP WSP(float, WS_MODP)
#define TAB WSP(f32x2, WS_TAB)
#define SGST WSP(f32x2, WS_SGST)
#define BON WSP(float, WS_BON)
#define POOLWT WSP(bf16, WS_POOLWT)
#define WUPT WSP(bf16, WS_WUPT)
#define AUPT WSP(bf16, WS_AUPT)
#define SGW WSP(bf16, WS_SGW)
#define VTC WSP(bf16, WS_VTC)
#define VTL WSP(bf16, WS_VTL)
#define HCTX WSP(float, WS_HCTX)
#define QN WSP(bf16, WS_QN)
#define KN WSP(bf16, WS_KN)
#define WOUTT WSP(bf16, WS_WOUTT)
#define WINT WSP(bf16, WS_WINT)
#define XN WSP(bf16, WS_XN)
#define Y WSP(bf16, WS_Y)
#define P WSP(bf16, WS_P)
#define YR WSP(float, WS_YR)
#define REC WSP(float, WS_REC)
    float* const out = args.out;

    if (IN(0)) {
        LAS float* scr = (LAS float*)(lds + wave * 16384);
        constexpr int I_MOD = 4 * 64 * 48, I_WIN1 = 64 * (NIN / 32), I_WIN = 4 * I_WIN1, I_WOUT1 = 64 * 128, I_WOUT = 4 * I_WOUT1, I_POOL = 16 * 32, I_WUP = 8 * 32, I_AUP = 8 * 32, I_SGW = 1024;
        constexpr int NITEMS = I_MOD + I_WIN + I_WOUT + I_POOL + I_WUP + I_AUP + I_SGW;
        for (int it = gw; it < NITEMS; it += NGW) {
            int r = it;
            if (r < I_MOD) { p0_mod_item(w_mod, c_in, cctx_in, MODP, scr, r, lane); continue; } r -= I_MOD;
            if (r < I_WIN) { const int l = r / I_WIN1; p0_transpose_item(w_in + (size_t)l * DM * NIN, DM, NIN, WINT + (size_t)l * NIN * DM, scr, r % I_WIN1, lane); continue; } r -= I_WIN;
            if (r < I_WOUT) { const int l = r / I_WOUT1; p0_transpose_item(w_out + (size_t)l * DM * DM, DM, DM, WOUTT + (size_t)l * DM * DM, scr, r % I_WOUT1, lane); continue; } r -= I_WOUT;
            if (r < I_POOL) { const int lg = r / 32; p0_transpose_item(pool_w + (size_t)lg * 65536, 256, 256, POOLWT + (size_t)lg * 65536, scr, r % 32, lane); continue; } r -= I_POOL;
            if (r < I_WUP) { const int ld = r / 32; p0_transpose_item(rw_w_up + (size_t)ld * 65536, 64, 1024, WUPT + (size_t)ld * 65536, scr, r % 32, lane); continue; } r -= I_WUP;
            if (r < I_AUP) { const int ld = r / 32; p0_transpose_item(rw_a_up + (size_t)ld * 65536, 64, 1024, AUPT + (size_t)ld * 65536, scr, r % 32, lane); continue; } r -= I_AUP;
            {   const size_t e0 = (size_t)r * 512 + lane * 8; const f32x4 a = *(const f32x4*)(sg_w + e0), b = *(const f32x4*)(sg_w + e0 + 4);
                v4u o; o.x = pk2(a.x, a.y); o.y = pk2(a.z, a.w); o.z = pk2(b.x, b.y); o.w = pk2(b.z, b.w); *(v4u*)(SGW + e0) = o; }
        }
        SEAM(0);
    }
    if (IN(1)) {
        for (int idx = gw * 64 + lane; idx < 4 * 3 * 12288; idx += NGW * 64) {
            const int l = idx / 36864, c = (idx / 12288) % 3, n = idx % 12288;
            float s = b_mod[l * 12288 + n];
            const float* pp = MODP + ((size_t)(l * 64) * 3 + c) * 12288 + n;
#pragma unroll 8
            for (int kc = 0; kc < 64; ++kc) s += pp[(size_t)kc * 3 * 12288];
            MOD[idx] = s;
        }
        for (int idx = gw * 64 + lane; idx < 2048; idx += NGW * 64) {
            const int pos = idx >> 4, i = idx & 15;
            float inv = (i & 3) == 0 ? 1.0f : ((i & 3) == 1 ? 0.5623413251903491f : ((i & 3) == 2 ? 0.31622776601683794f : 0.17782794100389228f));
            inv *= (i >> 2) == 0 ? 1.0f : ((i >> 2) == 1 ? 0.1f : ((i >> 2) == 2 ? 0.01f : 0.001f));
            float cc, sn; sincos_acc((float)pos * inv, cc, sn);
            TAB[idx] = (f32x2){cc, sn};
        }
        SEAM(1);
    }
    for (int l = 0; l < DEPTH; ++l) {
        const int pb = 2 + 6 * l;
        const bool with_ctx = l < DEPTH - 1;
#define hin_lat (l == 0 ? x_in : (const float*)out)
#define hin_ctx (l == 0 ? ctx_in : (const float*)HCTX)
#define mod (MOD + (size_t)l * 3 * 12288)
        const int nrows = with_ctx ? MROWS : NLAT;
        if (IN(pb + 0)) {
            phase_xn(hin_lat, hin_ctx, mod, XN, OPQ_S(gw), NGW, OPQ_V(lane));
            SEAM(pb + 0);
        }
        if (IN(pb + 1)) {
            pg8::Gemm g{XN, WINT + (size_t)l * NIN * DM, MROWS, NIN, DM}; pg8::StaticOrder S; S.init(MROWS, NIN, G, bx);
            pg8::EpiStoreBf16 E{P, NIN};
            pg8::gemm_phase<pg8::EpiStoreBf16, pg8::StaticOrder, true, true>(lds, g, S, E);
            SEAM(pb + 1);
        }
        if (IN(pb + 2)) {
            phase_rowprep(P, na_qg + l * 64, na_kg + l * 64, TAB, QN, KN, SGST, OPQ_S(gw), NGW, OPQ_V(lane));
            phase_vt(P, VTL, VTC, OPQ_S(gw), NGW, OPQ_V(lane));
            phase_rwprep(P, rw_mu_rkv + (size_t)l * 6144, rw_mu_lora + (size_t)l * 256, rw_w0 + (size_t)l * 2048, WUPT + (size_t)l * 131072, rw_a0 + (size_t)l * 2048, AUPT + (size_t)l * 131072,
                         rw_k_k + (size_t)l * 1024, rw_k_a + (size_t)l * 1024, rw_r_k + (size_t)l * 1024, REC, BON, OPQ_S(gw), NGW, OPQ_V(lane));
            phase_pool(P, POOLWT + (size_t)l * 262144, pool_scale + (size_t)l * 1024, Y, nrows, OPQ_S(gw), NGW, OPQ_V(lane));
            SEAM(pb + 2);
        }
        if (IN(pb + 3)) {
            for (int u = OPQ_S(gw); u < NBATCH * 128 * 16 * 4; u += NGW) na_unit<false>(QN, KN, VTL, VTC, P, na_rpb + (size_t)l * 16 * 15 * 31, Y, u, OPQ_V(lane));
            if (with_ctx) for (int u = OPQ_S(gw); u < NBATCH * 16 * 16; u += NGW) na_unit<true>(QN, KN, VTL, VTC, P, na_rpb, Y, u, OPQ_V(lane));
            phase_sgu(P, SGST, sg_ln_w + (size_t)l * 1024, sg_ln_b + (size_t)l * 1024, SGW + (size_t)l * 131072, sg_b + (size_t)l * 1024, Y, lds, nrows / 128, OPQ_V(tid), wave, OPQ_V(lane));
            phase_scan(REC, YR, lds, wave, OPQ_V(lane));
            SEAM(pb + 3);
        }
        if (IN(pb + 4)) {
            phase_rwfin(P, YR, REC, BON, rw_ln_w + (size_t)l * 1024, rw_ln_b + (size_t)l * 1024, Y, nrows, OPQ_S(gw), NGW, OPQ_V(lane));
            SEAM(pb + 4);
        }
        if (IN(pb + 5)) {
            pg8::Gemm g{Y, WOUTT + (size_t)l * DM * DM, nrows, DM, DM}; pg8::StaticOrder S; S.init(nrows, DM, G, bx);
            pg8::EpiResGate E{hin_lat, hin_ctx, out, HCTX, mod};
            pg8::gemm_phase<pg8::EpiResGate, pg8::StaticOrder, true, true>(lds, g, S, E);
            SEAM(pb + 5);
        }
    }
#undef IN
#undef SEAM
}
#undef hin_lat
#undef hin_ctx
#undef mod
#undef P
#undef Y
#undef XN
#undef out

extern "C" void kernel_launch(void* const* d_in, const int* in_sizes, int n_in, void* d_out, int out_size, void* d_ws, size_t ws_size, hipStream_t stream) {
    static int grid = 0;
    if (grid == 0) {
        if (n_in != 28 || out_size != NLAT * DM || ws_size < WS_END) { fprintf(stderr, "kernel_launch: unexpected shapes (n_in %d, out %d, ws %zu < %zu); nothing launched\n", n_in, out_size, ws_size, (size_t)WS_END); grid = -1; return; }
        int dev = 0, cus = 0, per_cu = 0;
        if (hipGetDevice(&dev) != hipSuccess || hipDeviceGetAttribute(&cus, hipDeviceAttributeMultiprocessorCount, dev) != hipSuccess) { grid = -1; return; }
        if (hipFuncSetAttribute((const void*)fwd, hipFuncAttributeMaxDynamicSharedMemorySize, LDS_BYTES) != hipSuccess) { fprintf(stderr, "kernel_launch: hipFuncSetAttribute failed\n"); grid = -1; return; }
        if (hipOccupancyMaxActiveBlocksPerMultiprocessor(&per_cu, (const void*)fwd, NWAVES * 64, LDS_BYTES) != hipSuccess || per_cu < 1)
            fprintf(stderr, "kernel_launch: note: occupancy query reports %d workgroups per CU\n", per_cu);
        (void)hipGetLastError();
        grid = cus >= NGRID ? NGRID : -2;
    }
    if (grid == -1) return;
    if (hipMemsetAsync((char*)d_ws + WS_CTL, 0, CTL_ZERO_BYTES, stream) != hipSuccess) { fprintf(stderr, "kernel_launch: memset failed\n"); return; }
    Args a{};
    for (int i = 0; i < 28; ++i) a.in[i] = (const float*)d_in[i];
    a.out = (float*)d_out; a.ws = (unsigned char*)d_ws; a.li = 0; a.pad = 0;
    const bool split = MK_SPLIT || grid == -2;
    if (split) { for (int k = 0; k < NPHASE; ++k) { a.ph_lo = k; a.ph_hi = k + 1; hipLaunchKernelGGL(fwd, dim3(NGRID), dim3(NWAVES * 64), LDS_BYTES, stream, a); } }
    else { a.ph_lo = 0; a.ph_hi = NPHASE; hipLaunchKernelGGL(fwd, dim3(NGRID), dim3(NWAVES * 64), LDS_BYTES, stream, a); }
    const hipError_t le = hipPeekAtLastError();
    if (le != hipSuccess) fprintf(stderr, "kernel_launch: launch failed: %s\n", hipGetErrorName(le));
}
```

```cpp
#include <hip/hip_runtime.h>
#include <cstdio>
#include <cstdint>
#define MK_SPLIT 0
namespace pg8 {
#define PG8_LAS __attribute__((address_space(3)))
typedef unsigned short bf16_t;
typedef short bf16x8 __attribute__((ext_vector_type(8)));
typedef float f32x4 __attribute__((ext_vector_type(4)));
typedef unsigned u32x4 __attribute__((ext_vector_type(4)));
constexpr int BM = 256, BK = 64, HALF = 128, HTB = HALF * BK * 2  , STAGE_BYTES = 8 * HTB, NXCD = 8, WGM = 8;

__host__ __device__ __forceinline__ int lds_byte(int r, int c) { const int st = (r >> 4) * 2 + (c >> 5), rr = r & 15, cc = c & 31, ob = rr * 64 + cc * 2; return st * 1024 + (ob ^ (((ob >> 9) & 1) << 5)); }
__host__ __device__ __forceinline__ void stage_rc(int b, int& R, int& C) { const int st = b / 1024, sb = b % 1024, swz = sb ^ (((sb >> 9) & 1) << 5); R = (st >> 1) * 16 + swz / 64; C = (st & 1) * 32 + (swz % 64) / 2; }
__host__ __device__ __forceinline__ int perm32(int rho) { const int n = rho >> 4, i = rho & 15; return 8 * (i >> 2) + 4 * n + (i & 3); }

struct Unit { int pm, pn; };
struct Gemm { const bf16_t* A; const bf16_t* Bt; int M, N, K; };

struct StaticOrder {
    int nM, nN, nwg, G, c;
    __host__ __device__ void init(int M, int N, int G_, int c_) { nM = M / BM; nN = N / BM; nwg = nM * nN; G = G_; c = c_; }
    __host__ __device__ bool next(int i, Unit& u) const {
        const long L = (long)i * G + c; if (L >= nwg) return false;
        int wgid = (int)L; { const int q = nwg / NXCD, r = nwg % NXCD, xcd = wgid % NXCD, off = wgid / NXCD; wgid = (xcd < r ? xcd * (q + 1) : r * (q + 1) + (xcd - r) * q) + off; }
        const int nig = WGM * nN, gid = wgid / nig, fm = gid * WGM, gsz = (nM - fm) < WGM ? (nM - fm) : WGM;
        u.pm = fm + ((wgid % nig) % gsz); u.pn = (wgid % nig) / gsz; return true;
    }
    __device__ __forceinline__ void a_ready(const Unit&) const {}
    __device__ __forceinline__ void done(const Unit&) const {}
};

__device__ __forceinline__ unsigned cvt_pk_bf16(float lo, float hi) { unsigned r; asm volatile("v_cvt_pk_bf16_f32 %0, %1, %2" : "=v"(r) : "v"(lo), "v"(hi)); return r; }
template <class Epi, class Sched, bool ALIGN_EPI = false, bool SP2 = false>
__device__ __forceinline__ void gemm_phase(PG8_LAS unsigned char* lds, const Gemm g, const Sched& S, const Epi& E) {
    int tid_ = threadIdx.x; asm volatile("" : "+v"(tid_));
    const int tid = tid_, wid = __builtin_amdgcn_readfirstlane(tid >> 6), lane = tid & 63, wr = wid >> 2, wc = wid & 3, fr = lane & 15, fq = lane >> 4;
    const int K = g.K, nt = K / BK;
    unsigned voffA[2], voffB[2];
#pragma unroll
    for (int i = 0; i < 2; ++i) { int R, C; stage_rc(tid * 16 + i * 8192, R, C); const int Rb = Epi::PERM ? ((R & ~31) + perm32(R & 31)) : R;
        voffA[i] = (unsigned)(R * K + C) * 2u; voffB[i] = (unsigned)(Rb * K + C) * 2u; }
    const size_t kstep = (size_t)(BK * 2);
    const size_t hstep = (size_t)HALF * K * 2;
    const size_t tstep = 2 * hstep;
    const unsigned ldsw = (unsigned)wid * 1024u;
    const int aoff = lds_byte(wr * 64 + fr, fq * 8), boff = lds_byte(wc * 32 + fr, fq * 8);
#define PG8_SA(b, h) (((b) * 2 + (h)) * HTB)
#define PG8_SB(b, h) ((4 + (b) * 2 + (h)) * HTB)
#define PG8_STAGE(bufoff, gbase, voff) do { _Pragma("unroll") for (int _i = 0; _i < 2; ++_i) \
        __builtin_amdgcn_global_load_lds((const unsigned*)((const char*)(gbase) + (voff)[_i]), (PG8_LAS unsigned*)(lds + (bufoff) + ldsw + _i * 8192), 16, 0, 0); } while (0)
#define PG8_LDA(dst, b, h) do { _Pragma("unroll") for (int m = 0; m < 4; ++m) _Pragma("unroll") for (int k = 0; k < 2; ++k) dst[m][k] = *(const PG8_LAS bf16x8*)(lds + PG8_SA(b, h) + aoff + m * 2048 + k * 1024); } while (0)
#define PG8_LDB(dst, b, h) do { _Pragma("unroll") for (int n = 0; n < 2; ++n) _Pragma("unroll") for (int k = 0; k < 2; ++k) dst[n][k] = *(const PG8_LAS bf16x8*)(lds + PG8_SB(b, h) + boff + n * 2048 + k * 1024); } while (0)
#define PG8_MMA(ai, bj, At, Bt) do { __builtin_amdgcn_s_setprio(1); _Pragma("unroll") for (int m = 0; m < 4; ++m) _Pragma("unroll") for (int n = 0; n < 2; ++n) _Pragma("unroll") for (int k = 0; k < 2; ++k) \
        acc[ai][bj][m][n] = __builtin_amdgcn_mfma_f32_16x16x32_bf16(Bt[n][k], At[m][k], acc[ai][bj][m][n], 0, 0, 0); __builtin_amdgcn_s_setprio(0); } while (0)
#define PG8_WAIT_V(n) asm volatile("s_waitcnt vmcnt(" #n ")" ::: "memory")
#define PG8_WAIT_L(n) asm volatile("s_waitcnt lgkmcnt(" #n ")" ::: "memory")
#define PG8_BAR __builtin_amdgcn_s_barrier()
#define PG8_SCHED __builtin_amdgcn_sched_barrier(0)
    Unit cur, nxt; int ui = 0;
    if (!S.next(0, cur)) return;
    f32x4 acc[2][2][4][2];
#pragma unroll
    for (int a = 0; a < 2; ++a)
#pragma unroll
        for (int b = 0; b < 2; ++b)
#pragma unroll
            for (int m = 0; m < 4; ++m)
#pragma unroll
                for (int n = 0; n < 2; ++n) acc[a][b][m][n] = (f32x4){0.f, 0.f, 0.f, 0.f};
    bf16x8 At[4][2], B0[2][2], B1[2][2];
    const char* cA = (const char*)g.A + (size_t)cur.pm * tstep; const char* cB = (const char*)g.Bt + (size_t)cur.pn * tstep;
    S.a_ready(cur);
    if constexpr (SP2) {
        PG8_STAGE(PG8_SB(0, 0), cB, voffB); PG8_STAGE(PG8_SB(0, 1), cB + hstep, voffB); PG8_STAGE(PG8_SA(0, 0), cA, voffA); PG8_STAGE(PG8_SA(0, 1), cA + hstep, voffA);
        if (wr == 1) PG8_BAR;
        PG8_WAIT_V(2); PG8_BAR;
        PG8_STAGE(PG8_SB(1, 0), cB + kstep, voffB); PG8_STAGE(PG8_SA(1, 0), cA + kstep, voffA); PG8_STAGE(PG8_SB(1, 1), cB + hstep + kstep, voffB);
        PG8_WAIT_V(6); PG8_BAR;
    } else {
        PG8_STAGE(PG8_SB(0, 0), cB, voffB); PG8_STAGE(PG8_SA(0, 0), cA, voffA); PG8_STAGE(PG8_SB(0, 1), cB + hstep, voffB); PG8_STAGE(PG8_SA(0, 1), cA + hstep, voffA);
        if (wr == 1) PG8_BAR;
        PG8_WAIT_V(4); PG8_BAR;
        PG8_STAGE(PG8_SB(1, 0), cB + kstep, voffB); PG8_STAGE(PG8_SA(1, 0), cA + kstep, voffA); PG8_STAGE(PG8_SB(1, 1), cB + hstep + kstep, voffB);
        PG8_WAIT_V(6); PG8_BAR;
    }
    for (;;) {
        const bool has_next = S.next(ui + 1, nxt);
        const char* nA = has_next ? (const char*)g.A + (size_t)nxt.pm * tstep : cA; const char* nB = has_next ? (const char*)g.Bt + (size_t)nxt.pn * tstep : cB;
        for (int t = 0; t < nt; t += 2) {
            const bool last = (t == nt - 2);
            const char* a1 = cA + (size_t)(t + 1) * kstep;
            const char* a2 = last ? nA : cA + (size_t)(t + 2) * kstep; const char* b2 = last ? nB : cB + (size_t)(t + 2) * kstep;
            const char* a3 = a2 + kstep; const char* b3 = b2 + kstep;
            if (last && has_next) S.a_ready(nxt);
            if constexpr (SP2) {
            PG8_LDB(B0, 0, 0); PG8_LDB(B1, 0, 1); PG8_SCHED; PG8_LDA(At, 0, 0); PG8_STAGE(PG8_SA(1, 1), a1 + hstep, voffA);
            PG8_WAIT_V(8); PG8_WAIT_L(0); PG8_BAR; PG8_MMA(0, 0, At, B0); PG8_MMA(0, 1, At, B1); PG8_BAR; PG8_SCHED;
            PG8_LDA(At, 0, 1); PG8_STAGE(PG8_SB(0, 0), b2, voffB); PG8_STAGE(PG8_SB(0, 1), b2 + hstep, voffB); PG8_STAGE(PG8_SA(0, 0), a2, voffA);
            PG8_WAIT_V(8); PG8_WAIT_L(0); PG8_BAR; PG8_MMA(1, 0, At, B0); PG8_MMA(1, 1, At, B1); PG8_BAR; PG8_SCHED;
            PG8_LDB(B0, 1, 0); PG8_LDB(B1, 1, 1); PG8_SCHED; PG8_LDA(At, 1, 0); PG8_STAGE(PG8_SA(0, 1), a2 + hstep, voffA);
            PG8_WAIT_V(8); PG8_WAIT_L(0); PG8_BAR; PG8_MMA(0, 0, At, B0); PG8_MMA(0, 1, At, B1); PG8_BAR; PG8_SCHED;
            PG8_LDA(At, 1, 1); PG8_STAGE(PG8_SB(1, 0), b3, voffB); PG8_STAGE(PG8_SB(1, 1), b3 + hstep, voffB); PG8_STAGE(PG8_SA(1, 0), a3, voffA);
            PG8_WAIT_V(8); PG8_WAIT_L(0); PG8_BAR; PG8_MMA(1, 0, At, B0); PG8_MMA(1, 1, At, B1); PG8_BAR; PG8_SCHED;
            } else {
            PG8_LDB(B0, 0, 0); PG8_SCHED; PG8_LDA(At, 0, 0); PG8_STAGE(PG8_SA(1, 1), a1 + hstep, voffA);
            PG8_WAIT_L(8); PG8_BAR; PG8_WAIT_L(0); PG8_MMA(0, 0, At, B0); PG8_BAR; PG8_SCHED;
            PG8_LDB(B1, 0, 1); PG8_STAGE(PG8_SB(0, 0), b2, voffB);
            PG8_BAR; PG8_WAIT_L(0); PG8_MMA(0, 1, At, B1); PG8_BAR;
            PG8_LDA(At, 0, 1); PG8_STAGE(PG8_SA(0, 0), a2, voffA);
            PG8_BAR; PG8_WAIT_L(0); PG8_MMA(1, 0, At, B0); PG8_BAR; PG8_SCHED;
            PG8_STAGE(PG8_SB(0, 1), b2 + hstep, voffB);
            PG8_WAIT_V(6); PG8_BAR; PG8_MMA(1, 1, At, B1); PG8_BAR;
            PG8_LDB(B0, 1, 0); PG8_SCHED; PG8_LDA(At, 1, 0); PG8_STAGE(PG8_SA(0, 1), a2 + hstep, voffA);
            PG8_WAIT_L(8); PG8_BAR; PG8_WAIT_L(0); PG8_MMA(0, 0, At, B0); PG8_BAR; PG8_SCHED;
            PG8_LDB(B1, 1, 1); PG8_STAGE(PG8_SB(1, 0), b3, voffB);
            PG8_BAR; PG8_WAIT_L(0); PG8_MMA(0, 1, At, B1); PG8_BAR;
            PG8_LDA(At, 1, 1); PG8_STAGE(PG8_SA(1, 0), a3, voffA);
            PG8_BAR; PG8_WAIT_L(0); PG8_MMA(1, 0, At, B0); PG8_BAR; PG8_SCHED;
            PG8_STAGE(PG8_SB(1, 1), b3 + hstep, voffB);
            PG8_WAIT_V(6); PG8_BAR; PG8_MMA(1, 1, At, B1); PG8_BAR;
            }
        }
        if constexpr (ALIGN_EPI) { if (wr == 0) PG8_BAR; }
        if constexpr (!Epi::AFTER_DRAIN) { E(acc, cur, wr, wc, fr, fq); S.done(cur); }
        if (!has_next) break;
#pragma unroll
        for (int a = 0; a < 2; ++a)
#pragma unroll
            for (int b = 0; b < 2; ++b)
#pragma unroll
                for (int m = 0; m < 4; ++m)
#pragma unroll
                    for (int n = 0; n < 2; ++n) acc[a][b][m][n] = (f32x4){0.f, 0.f, 0.f, 0.f};
        cur = nxt; cA = nA; cB = nB; ++ui;
        if constexpr (ALIGN_EPI) { if (wr == 1) PG8_BAR; }
    }
    PG8_WAIT_V(0);
    if constexpr (!ALIGN_EPI) { if (wr == 0) PG8_BAR; }
    PG8_BAR;
    if constexpr (Epi::AFTER_DRAIN) { E.fused(acc, cur, wr, wc, fr, fq, lds, wid, lane); S.done(cur); }
#undef PG8_SA
#undef PG8_SB
#undef PG8_STAGE
#undef PG8_LDA
#undef PG8_LDB
#undef PG8_MMA
#undef PG8_WAIT_V
#undef PG8_WAIT_L
#undef PG8_BAR
#undef PG8_SCHED
}
}

constexpr int DM = 4096, NBATCH = 2, SEQ = 8192, DEPTH = 4, CTXL = 256;
constexpr int NLAT = NBATCH * SEQ, NCTX = NBATCH * CTXL, MROWS = NLAT + NCTX;
constexpr int NIN = 13568, GWD = 1024;
constexpr int C_POOLV = 0, C_POOLZ = 1024, C_NAQ = 2048, C_NAK = 3072, C_NAV = 4096, C_NAZ = 5120, C_RWR = 6144, C_RWK = 7168, C_RWV = 8192, C_RWZ = 9216,
              C_RWWD = 10240, C_RWAD = 10368, C_SGU = 10496, C_SGV = 11520, C_SGZ = 12544;
constexpr int SCANLEN = CTXL + SEQ;
constexpr int NCHAIN = 64;
constexpr int RECF = 384;
constexpr int NWAVES = 8;

constexpr size_t MiB = 1u << 20;
constexpr size_t WS_CTL = 0, CTL_ZERO_BYTES = 1 * MiB;
constexpr size_t WS_MOD   = 2 * MiB;
constexpr size_t WS_TAB   = 3 * MiB;
constexpr size_t WS_SGST  = 4 * MiB;
constexpr size_t WS_BON   = 5 * MiB;
constexpr size_t WS_POOLWT= 8 * MiB;
constexpr size_t WS_WUPT  = 10 * MiB;
constexpr size_t WS_AUPT  = 11 * MiB;
constexpr size_t WS_SGW   = 12 * MiB;
constexpr size_t WS_VTC   = 13 * MiB;
constexpr size_t WS_HCTX  = 14 * MiB;
constexpr size_t WS_MODP  = 22 * MiB;
constexpr size_t WS_VTL   = 58 * MiB;
constexpr size_t WS_QN    = 90 * MiB;
constexpr size_t WS_KN    = 123 * MiB;
constexpr size_t WS_WOUTT = 156 * MiB;
constexpr size_t WS_WINT  = 284 * MiB;
constexpr size_t WS_XN    = 708 * MiB;
constexpr size_t WS_Y     = 840 * MiB;
constexpr size_t WS_P     = 972 * MiB;
constexpr size_t WS_YR    = 1410 * MiB;
constexpr size_t WS_REC   = 1542 * MiB;
constexpr size_t WS_END   = 2334 * MiB;
static_assert(WS_P + (size_t)MROWS * NIN * 2 <= WS_YR && WS_REC + (size_t)NCHAIN * SCANLEN * RECF * 4 <= WS_END && WS_WINT + (size_t)4 * NIN * DM * 2 <= WS_XN, "ws map");
constexpr int CW_TMO = 0, CW_BAR = 4096;

constexpr int RING_BYTES = 131072, LDSCTL_OFF = RING_BYTES, MISC_OFF = LDSCTL_OFF + 320, LDS_BYTES = 147456;

#define GAS __attribute__((address_space(1)))
#define LAS __attribute__((address_space(3)))
typedef unsigned short bf16;
typedef unsigned v4u __attribute__((ext_vector_type(4)));
typedef unsigned v2u __attribute__((ext_vector_type(2)));
typedef float f32x4 __attribute__((ext_vector_type(4)));
typedef float f32x2 __attribute__((ext_vector_type(2)));
typedef short bf16x8 __attribute__((ext_vector_type(8)));
#define RLX_AGENT __ATOMIC_RELAXED, __HIP_MEMORY_SCOPE_AGENT
#define LDS_WAIT() asm volatile("s_waitcnt lgkmcnt(0)" ::: "memory")

__device__ __forceinline__ float bf2f(unsigned short h) { return __uint_as_float(((unsigned)h) << 16); }
__device__ __forceinline__ float bflo(unsigned w) { return __uint_as_float(w << 16); }
__device__ __forceinline__ float bfhi(unsigned w) { return __uint_as_float(w & 0xffff0000u); }
__device__ __forceinline__ unsigned f2bf(float f) { unsigned u = __float_as_uint(f); return (u + 0x7fffu + ((u >> 16) & 1u)) >> 16; }
__device__ __forceinline__ unsigned pk2(float lo, float hi) { return f2bf(lo) | (f2bf(hi) << 16); }
__device__ __forceinline__ void unpack8(const v4u w, float* x) { x[0] = bflo(w.x); x[1] = bfhi(w.x); x[2] = bflo(w.y); x[3] = bfhi(w.y); x[4] = bflo(w.z); x[5] = bfhi(w.z); x[6] = bflo(w.w); x[7] = bfhi(w.w); }
__device__ __forceinline__ v4u pack8(const float* x) { v4u w; w.x = pk2(x[0], x[1]); w.y = pk2(x[2], x[3]); w.z = pk2(x[4], x[5]); w.w = pk2(x[6], x[7]); return w; }
__device__ __forceinline__ float silu_f(float x) { return x / (1.f + __expf(-x)); }
__device__ __forceinline__ float wave_sum(float v) {
#pragma unroll
    for (int o = 1; o < 64; o <<= 1) v += __shfl_xor(v, o);
    return v;
}
template <int CTRL> __device__ __forceinline__ float dppf(float v) { return __builtin_bit_cast(float, __builtin_amdgcn_update_dpp(0, __builtin_bit_cast(int, v), CTRL, 0xF, 0xF, true)); }
__device__ __forceinline__ float red16(float v) { v += dppf<0xB1>(v); v += dppf<0x4E>(v); v += dppf<0x141>(v); v += dppf<0x140>(v); return v; }
__device__ __forceinline__ float max16x4(float v) { v = fmaxf(v, __shfl_xor(v, 16)); v = fmaxf(v, __shfl_xor(v, 32)); return v; }
__device__ __forceinline__ float sum16x4(float v) { v += __shfl_xor(v, 16); v += __shfl_xor(v, 32); return v; }
__device__ __forceinline__ int scan_pos(int d, bool isctx, int t) { return d == 0 ? (isctx ? t : CTXL + t) : (isctx ? (CTXL - 1 - t) : (CTXL + SEQ - 1 - t)); }
__device__ __forceinline__ f32x4 mfma16(bf16x8 a, bf16x8 b, f32x4 c) { return __builtin_amdgcn_mfma_f32_16x16x32_bf16(a, b, c, 0, 0, 0); }
__device__ __forceinline__ bf16x8 ld_frag(const bf16* p) { return __builtin_bit_cast(bf16x8, *(const v4u*)p); }

namespace pg8 {
struct EpiStoreBf16 {
    static constexpr bool PERM = true, AFTER_DRAIN = false;
    bf16_t* O; int ldc;
    __device__ __forceinline__ void operator()(const f32x4 (&acc)[2][2][4][2], const Unit& u, int wr, int wc, int fr, int fq) const {
        const int row0 = u.pm * BM + wr * 64 + fr, col0 = u.pn * BM + wc * 32 + 8 * fq;
#pragma unroll
        for (int ai = 0; ai < 2; ++ai)
#pragma unroll
            for (int m = 0; m < 4; ++m) { bf16_t* rowp = O + (size_t)(row0 + ai * HALF + m * 16) * ldc + col0;
#pragma unroll
                for (int bj = 0; bj < 2; ++bj) { const f32x4 v0 = acc[ai][bj][m][0], v1 = acc[ai][bj][m][1];
                    u32x4 w; w.x = cvt_pk_bf16(v0[0], v0[1]); w.y = cvt_pk_bf16(v0[2], v0[3]); w.z = cvt_pk_bf16(v1[0], v1[1]); w.w = cvt_pk_bf16(v1[2], v1[3]);
                    *(u32x4*)(rowp + bj * HALF) = w; } }
    }
};
struct EpiResGate {
    static constexpr bool PERM = false, AFTER_DRAIN = false;
    const float* hin_lat; const float* hin_ctx; float* hout_lat; float* hout_ctx; const float* gate;
    __device__ __forceinline__ void operator()(const f32x4 (&acc)[2][2][4][2], const Unit& u, int wr, int wc, int fr, int fq) const {
        const int cond = u.pm < 32 ? 0 : (u.pm < 64 ? 1 : 2);
        const int rloc = (u.pm < 64 ? u.pm * BM : (u.pm - 64) * BM) + wr * 64 + fr, col0 = u.pn * BM + wc * 32 + 4 * fq;
        const float* hin = u.pm < 64 ? hin_lat : hin_ctx; float* hout = u.pm < 64 ? hout_lat : hout_ctx;
        f32x4 gv[2][2];
#pragma unroll
        for (int bj = 0; bj < 2; ++bj)
#pragma unroll
            for (int n = 0; n < 2; ++n) gv[bj][n] = *(const f32x4*)(gate + cond * 12288 + 8192 + col0 + bj * HALF + n * 16);
#pragma unroll
        for (int ai = 0; ai < 2; ++ai)
#pragma unroll
            for (int m = 0; m < 4; ++m) { const size_t off = (size_t)(rloc + ai * HALF + m * 16) * 4096 + col0;
#pragma unroll
                for (int bj = 0; bj < 2; ++bj)
#pragma unroll
                    for (int n = 0; n < 2; ++n) { const f32x4 b = *(const f32x4*)(hin + off + bj * HALF + n * 16);
                        *(f32x4*)(hout + off + bj * HALF + n * 16) = b + gv[bj][n] * acc[ai][bj][m][n]; } }
    }
};
}

__device__ __forceinline__ void p0_transpose_item(const float* W, int K, int N, bf16* WT, LAS float* scr, int item, int lane) {
    const int nblk = N / 32, kb = item / nblk, nb = item % nblk, k0 = 64 * kb, n0 = 32 * nb;
#pragma unroll 8
    for (int i = 0; i < 32; ++i) { const int kk = 2 * i + (lane >> 5); scr[kk * 33 + (lane & 31)] = W[(size_t)(k0 + kk) * N + n0 + (lane & 31)]; }
    LDS_WAIT(); asm volatile("" ::: "memory");
    const int c = lane & 7;
#pragma unroll
    for (int j = 0; j < 4; ++j) { const int n = (lane >> 3) + 8 * j; const LAS float* s = scr + (8 * c) * 33 + n;
        v4u o; o.x = pk2(s[0 * 33], s[1 * 33]); o.y = pk2(s[2 * 33], s[3 * 33]); o.z = pk2(s[4 * 33], s[5 * 33]); o.w = pk2(s[6 * 33], s[7 * 33]);
        *(v4u*)(WT + (size_t)(n0 + n) * K + k0 + 8 * c) = o; }
    LDS_WAIT(); asm volatile("" ::: "memory");
}
__device__ __forceinline__ void p0_mod_item(const float* wmod, const float* cvec, const float* cctx, float* MODP, LAS float* scr, int item, int lane) {
    const int l = item / (64 * 48), r = item % (64 * 48), kc = r / 48, nc = r % 48, k0 = kc * 64, n0 = nc * 256 + lane * 4;
    scr[lane] = silu_f(cvec[k0 + lane]); scr[64 + lane] = silu_f(cvec[4096 + k0 + lane]); scr[128 + lane] = silu_f(cctx[k0 + lane]);
    LDS_WAIT(); asm volatile("" ::: "memory");
    f32x4 a0 = {0.f, 0.f, 0.f, 0.f}, a1 = a0, a2 = a0;
    const float* wp = wmod + ((size_t)l * 4096 + k0) * 12288 + n0;
#pragma unroll 16
    for (int k = 0; k < 64; ++k) { const f32x4 w = *(const f32x4*)(wp + (size_t)k * 12288); a0 += scr[k] * w; a1 += scr[64 + k] * w; a2 += scr[128 + k] * w; }
    float* o = MODP + ((size_t)(l * 64 + kc) * 3) * 12288 + n0;
    *(f32x4*)(o) = a0; *(f32x4*)(o + 12288) = a1; *(f32x4*)(o + 2 * 12288) = a2;
    LDS_WAIT(); asm volatile("" ::: "memory");
}
__device__ __forceinline__ void sincos_acc(float ang, float& c, float& s) {
    const double x = (double)ang; const double n = __builtin_rint(x * 0.63661977236758134308); const double r = x - n * 1.57079632679489661923;
    const double r2 = r * r;
    const double sp = r * (1.0 + r2 * (-1.0 / 6 + r2 * (1.0 / 120 + r2 * (-1.0 / 5040 + r2 * (1.0 / 362880 + r2 * (-1.0 / 39916800 + r2 * (1.0 / 6227020800.0)))))));
    const double cp = 1.0 + r2 * (-0.5 + r2 * (1.0 / 24 + r2 * (-1.0 / 720 + r2 * (1.0 / 40320 + r2 * (-1.0 / 3628800 + r2 * (1.0 / 479001600 + r2 * (-1.0 / 87178291200.0)))))));
    const int q = ((int)n) & 3;
    const double cc = (q == 0) ? cp : (q == 1) ? -sp : (q == 2) ? -cp : sp;
    const double ss = (q == 0) ? sp : (q == 1) ? cp : (q == 2) ? -sp : -cp;
    c = (float)cc; s = (float)ss;
}

__device__ __forceinline__ void phase_xn(const float* hlat, const float* hctx, const float* mod, bf16* XN, int gw, int NGW, int lane) {
    for (int m = gw; m < MROWS; m += NGW) {
        const float* src = m < NLAT ? hlat + (size_t)m * DM : hctx + (size_t)(m - NLAT) * DM;
        const int cond = m < NLAT ? (m >> 13) : 2;
        const f32x4* s4 = (const f32x4*)src + lane;
        f32x4 v[16]; float ss = 0.f;
#pragma unroll
        for (int j = 0; j < 16; ++j) { v[j] = s4[64 * j]; ss += (v[j].x * v[j].x + v[j].y * v[j].y) + (v[j].z * v[j].z + v[j].w * v[j].w); }
        ss = wave_sum(ss);
        const float rstd = 1.0f / sqrtf(ss * (1.f / 4096.f) + 1e-6f);
        const f32x4* sh4 = (const f32x4*)(mod + cond * 12288) + lane; const f32x4* sc4 = (const f32x4*)(mod + cond * 12288 + 4096) + lane;
        v2u* o = (v2u*)(XN + (size_t)m * DM) + lane;
#pragma unroll
        for (int j = 0; j < 16; ++j) { const f32x4 sh = sh4[64 * j], sc = sc4[64 * j]; const f32x4 x = v[j] * rstd * (sc + 1.f) + sh; v2u w; w.x = pk2(x.x, x.y); w.y = pk2(x.z, x.w); o[64 * j] = w; }
    }
}

__device__ __forceinline__ void phase_rowprep(const bf16* P, const float* qgain, const float* kgain, const f32x2* tab, bf16* QN, bf16* KN, f32x2* SGST, int gw, int NGW, int lane) {
    const int sub = lane & 3;
    for (int m = gw; m < MROWS; m += NGW) {
        const bf16* pr = P + (size_t)m * NIN;
        const bool isctx = m >= NLAT; const int t = isctx ? ((m - NLAT) & 255) : (m & 8191);
        {   float x[16]; unpack8(*(const v4u*)(pr + C_SGV + 16 * lane), x); unpack8(*(const v4u*)(pr + C_SGV + 16 * lane + 8), x + 8);
            float s = 0.f;
#pragma unroll
            for (int i = 0; i < 16; ++i) s += x[i];
            const float mean = wave_sum(s) * (1.f / 1024.f); float q = 0.f;
#pragma unroll
            for (int i = 0; i < 16; ++i) { const float dlt = x[i] - mean; q += dlt * dlt; }
            const float var = wave_sum(q) * (1.f / 1024.f);
            if (lane == 0) SGST[m] = (f32x2){mean, 1.0f / sqrtf(var + 1e-5f)}; }
        float q[16], k[16];
        unpack8(*(const v4u*)(pr + C_NAQ + 16 * lane), q); unpack8(*(const v4u*)(pr + C_NAQ + 16 * lane + 8), q + 8);
        unpack8(*(const v4u*)(pr + C_NAK + 16 * lane), k); unpack8(*(const v4u*)(pr + C_NAK + 16 * lane + 8), k + 8);
        float sq = 0.f, sk = 0.f;
#pragma unroll
        for (int i = 0; i < 16; ++i) { sq += q[i] * q[i]; sk += k[i] * k[i]; }
        sq += __shfl_xor(sq, 1); sq += __shfl_xor(sq, 2); sk += __shfl_xor(sk, 1); sk += __shfl_xor(sk, 2);
        const float rq = 1.0f / sqrtf(sq * (1.f / 64.f) + 1e-6f), rk = 1.0f / sqrtf(sk * (1.f / 64.f) + 1e-6f);
#pragma unroll
        for (int i = 0; i < 16; ++i) { q[i] *= rq * qgain[16 * sub + i]; k[i] *= rk * kgain[16 * sub + i]; }
        if (!isctx) {
            const int pos = sub < 2 ? (t >> 6) : (t & 63);
#pragma unroll
            for (int i = 0; i < 16; ++i) { const f32x2 cs = tab[pos * 16 + i]; const float pq = __shfl_xor(q[i], 1), pkk = __shfl_xor(k[i], 1);
                q[i] = (sub & 1) ? (q[i] * cs.x + pq * cs.y) : (q[i] * cs.x - pq * cs.y);
                k[i] = (sub & 1) ? (k[i] * cs.x + pkk * cs.y) : (k[i] * cs.x - pkk * cs.y); }
        }
#pragma unroll
        for (int i = 0; i < 16; ++i) q[i] *= 0.125f;
        *(v4u*)(QN + (size_t)m * GWD + 16 * lane) = pack8(q); *(v4u*)(QN + (size_t)m * GWD + 16 * lane + 8) = pack8(q + 8);
        *(v4u*)(KN + (size_t)m * GWD + 16 * lane) = pack8(k); *(v4u*)(KN + (size_t)m * GWD + 16 * lane + 8) = pack8(k + 8);
    }
}
__device__ __forceinline__ void phase_vt(const bf16* P, bf16* VTL, bf16* VTC, int gw, int NGW, int lane) {
    for (int u = gw; u < (MROWS / 64) * 16; u += NGW) {
        const int tt = u >> 4, h = u & 15, m0 = tt * 64;
        const bf16* src = P + (size_t)m0 * NIN + C_NAV + h * 64 + lane;
        unsigned w[32];
#pragma unroll
        for (int i = 0; i < 32; ++i) { const unsigned lo = src[(size_t)(2 * i) * NIN], hi = src[(size_t)(2 * i + 1) * NIN]; w[i] = lo | (hi << 16); }
        bf16* dst = tt < 256 ? VTL + (((size_t)((tt >> 7) * 16 + h) * 64 + lane) * 8192 + (tt & 127) * 64)
                             : VTC + (((size_t)(((tt - 256) >> 2) * 16 + h) * 64 + lane) * 256 + ((tt - 256) & 3) * 64);
#pragma unroll
        for (int j = 0; j < 8; ++j) { v4u o; o.x = w[4 * j]; o.y = w[4 * j + 1]; o.z = w[4 * j + 2]; o.w = w[4 * j + 3]; ((v4u*)dst)[j] = o; }
    }
}
__device__ __forceinline__ void phase_pool(const bf16* P, const bf16* PWT  , const float* pscale, bf16* Y, int nrows, int gw, int NGW, int lane) {
    const int r = lane & 15, q4 = lane >> 4;
    for (int u = gw; u < (nrows / 16) * 4; u += NGW) {
        const int tt = u >> 2, g = u & 3, m0 = tt * 16, m = m0 + r;
        const bool isctx = m0 >= NLAT; const int T = isctx ? CTXL : SEQ; const int t = isctx ? ((m - NLAT) & 255) : (m & 8191);
        const int win = 2 << g, tlo = t - (win >> 1);
        const int lo = tlo < 0 ? 0 : tlo, hi = (tlo + win) > T ? T : (tlo + win);
        const float inv = 1.0f / (float)(hi - lo);
        const bf16* wbase = PWT + (size_t)g * 65536;
        f32x4 acc[16];
#pragma unroll
        for (int nt = 0; nt < 16; ++nt) acc[nt] = (f32x4){0.f, 0.f, 0.f, 0.f};
        for (int ks = 0; ks < 8; ++ks) {
            const int ch0 = C_POOLV + g * 256 + 32 * ks + 8 * q4;
            float sum[8];
#pragma unroll
            for (int j = 0; j < 8; ++j) sum[j] = 0.f;
            for (int k = 0; k < win; ++k) { const int tk = tlo + k;
                if (tk >= 0 && tk < T) { float x[8]; unpack8(*(const v4u*)(P + (size_t)(m - t + tk) * NIN + ch0), x);
#pragma unroll
                    for (int j = 0; j < 8; ++j) sum[j] += x[j]; } }
            float self[8]; unpack8(*(const v4u*)(P + (size_t)m * NIN + ch0), self);
            float dv[8];
#pragma unroll
            for (int j = 0; j < 8; ++j) dv[j] = sum[j] * inv - self[j];
            const bf16x8 af = __builtin_bit_cast(bf16x8, pack8(dv));
#pragma unroll
            for (int nt = 0; nt < 16; ++nt) { const bf16x8 bfg = ld_frag(wbase + (size_t)(16 * nt + r) * 256 + 32 * ks + 8 * q4); acc[nt] = mfma16(af, bfg, acc[nt]); }
        }
#pragma unroll
        for (int nt = 0; nt < 16; ++nt) { const int oc = g * 256 + 16 * nt + r; const float ps = pscale[oc];
#pragma unroll
            for (int i = 0; i < 4; ++i) { const int row = m0 + 4 * q4 + i; const float z = bf2f(P[(size_t)row * NIN + C_POOLZ + oc]);
                Y[(size_t)row * DM + oc] = (bf16)f2bf(acc[nt][i] * ps * silu_f(z)); } }
    }
}
__device__ __forceinline__ void phase_rwprep(const bf16* P, const float* mu_rkv  , const float* mu_lora  , const float* w0  , const bf16* WUPT  ,
                                             const float* a0, const bf16* AUPT, const float* k_k, const float* k_a, const float* r_k, float* REC, float* BON, int gw, int NGW, int lane) {
    const int r = lane & 15, q4 = lane >> 4;
    for (int u = gw; u < (MROWS / 16) * 16; u += NGW) {
        const int tt = u >> 4, d = (u >> 3) & 1, hp = u & 7, m0 = tt * 16;
        const bool isctx = m0 >= NLAT; const int T = isctx ? CTXL : SEQ; const int t0 = isctx ? ((m0 - NLAT) & 255) : (m0 & 8191); const int b = isctx ? ((m0 - NLAT) >> 8) : (m0 >> 13);
        bf16x8 Aw[2], Aa[2];
        {   const int mA = m0 + r, tA = t0 + r; const bool hasnb = d == 0 ? (tA > 0) : (tA < T - 1); const int nbA = d == 0 ? mA - 1 : mA + 1;
#pragma unroll
            for (int ks = 0; ks < 2; ++ks) { const int j0 = 32 * ks + 8 * q4;
                float cur[8], nb[8], o[8];
                unpack8(*(const v4u*)(P + (size_t)mA * NIN + C_RWWD + d * 64 + j0), cur);
                if (hasnb) unpack8(*(const v4u*)(P + (size_t)nbA * NIN + C_RWWD + d * 64 + j0), nb); else {
#pragma unroll
                    for (int j = 0; j < 8; ++j) nb[j] = 0.f; }
#pragma unroll
                for (int j = 0; j < 8; ++j) o[j] = tanhf(cur[j] + (nb[j] - cur[j]) * mu_lora[(d * 2 + 0) * 64 + j0 + j]);
                Aw[ks] = __builtin_bit_cast(bf16x8, pack8(o));
                unpack8(*(const v4u*)(P + (size_t)mA * NIN + C_RWAD + d * 64 + j0), cur);
                if (hasnb) unpack8(*(const v4u*)(P + (size_t)nbA * NIN + C_RWAD + d * 64 + j0), nb); else {
#pragma unroll
                    for (int j = 0; j < 8; ++j) nb[j] = 0.f; }
#pragma unroll
                for (int j = 0; j < 8; ++j) o[j] = cur[j] + (nb[j] - cur[j]) * mu_lora[(d * 2 + 1) * 64 + j0 + j];
                Aa[ks] = __builtin_bit_cast(bf16x8, pack8(o)); }
        }
#pragma unroll 1
        for (int hh = 0; hh < 2; ++hh) {
            const int head = hp * 2 + hh;
            float KK[4][4], Av[4][4];
            float ss[4] = {0.f, 0.f, 0.f, 0.f}, bon[4] = {0.f, 0.f, 0.f, 0.f};
            const int chain = (b * 2 + d) * 16 + head;
            const int pos0 = scan_pos(d, isctx, t0 + 4 * q4), dpos = d == 0 ? 1 : -1;
            float* const rec0 = REC + ((size_t)chain * SCANLEN + pos0) * RECF + r;
#pragma unroll
            for (int n4 = 0; n4 < 4; ++n4) {
                const int ch = head * 64 + 16 * n4 + r;
                f32x4 accW = {0.f, 0.f, 0.f, 0.f}, accA = accW;
#pragma unroll
                for (int ks = 0; ks < 2; ++ks) { accW = mfma16(Aw[ks], ld_frag(WUPT + (size_t)(d * 1024 + ch) * 64 + 32 * ks + 8 * q4), accW);
                                                 accA = mfma16(Aa[ks], ld_frag(AUPT + (size_t)(d * 1024 + ch) * 64 + 32 * ks + 8 * q4), accA); }
                const float w0v = w0[d * 1024 + ch], a0v = a0[d * 1024 + ch], mur = mu_rkv[(d * 3 + 0) * 1024 + ch], muk = mu_rkv[(d * 3 + 1) * 1024 + ch], muv = mu_rkv[(d * 3 + 2) * 1024 + ch];
                const float kkv = k_k[ch], kav = k_a[ch], rkv = r_k[ch];
#pragma unroll
                for (int i = 0; i < 4; ++i) { const int m = m0 + 4 * q4 + i, t = t0 + 4 * q4 + i; const bool hasnb = d == 0 ? (t > 0) : (t < T - 1); const int nb = d == 0 ? m - 1 : m + 1;
                    const bf16* pc = P + (size_t)m * NIN + ch; const bf16* pn = P + (size_t)nb * NIN + ch;
                    const float rc = bf2f(pc[C_RWR]), kc = bf2f(pc[C_RWK]), vc = bf2f(pc[C_RWV]);
                    const float rn = hasnb ? bf2f(pn[C_RWR]) : 0.f, kn = hasnb ? bf2f(pn[C_RWK]) : 0.f, vn = hasnb ? bf2f(pn[C_RWV]) : 0.f;
                    const float rr = rc + (rn - rc) * mur, kk0 = kc + (kn - kc) * muk, vv = vc + (vn - vc) * muv;
                    const float xw = -(w0v + accW[i]);
                    const float sp = fmaxf(xw, 0.f) + log1pf(__expf(-fabsf(xw)));
                    const float dec = __expf(-__expf(-sp - 0.5f));
                    const float av = 1.0f / (1.0f + __expf(-(a0v + accA[i])));
                    const float kx = kk0 * kkv; ss[i] += kx * kx;
                    const float kp = kk0 * (1.f + (av - 1.f) * kav); bon[i] += rr * kp * rkv;
                    KK[n4][i] = kx; Av[n4][i] = av;
                    float* o = rec0 + (ptrdiff_t)(i * dpos) * RECF + 16 * n4;
                    o[0] = dec; o[192] = kp; o[256] = rr; o[320] = vv; }
            }
#pragma unroll
            for (int i = 0; i < 4; ++i) { const float s = red16(ss[i]), bo = red16(bon[i]); const float inv = 1.0f / sqrtf(fmaxf(s, 1e-12f));
                float* rec = rec0 + (ptrdiff_t)(i * dpos) * RECF;
#pragma unroll
                for (int n4 = 0; n4 < 4; ++n4) { const float kkn = KK[n4][i] * inv; rec[16 * n4 + 64] = kkn; rec[16 * n4 + 128] = kkn * Av[n4][i]; }
                if (r == 0) BON[(size_t)chain * SCANLEN + pos0 + i * dpos] = bo; }
        }
    }
}
template <bool CTXQ>
__device__ __forceinline__ void na_unit(const bf16* QN, const bf16* KN, const bf16* VTL, const bf16* VTC, const bf16* P, const float* rpb  , bf16* Y, int u, int lane) {
    const int n = lane & 15, q4 = lane >> 4;
    int b, h, qrow0, qr = 0, jt = 0;
    if (CTXQ) { b = u >> 8; h = (u >> 4) & 15; qrow0 = NLAT + b * CTXL + 16 * (u & 15); }
    else { jt = u & 3; h = (u >> 2) & 15; qr = (u >> 6) & 127; b = u >> 13; qrow0 = b * SEQ + qr * 64 + 16 * jt; }
    bf16x8 qf[2];
#pragma unroll
    for (int ks = 0; ks < 2; ++ks) qf[ks] = ld_frag(QN + (size_t)(qrow0 + n) * GWD + h * 64 + 32 * ks + 8 * q4);
    constexpr int NT = CTXQ ? 16 : 32, WT = CTXQ ? 0 : 16;
    f32x4 s[NT];
    const int rs = qr - 4 < 0 ? 0 : (qr - 4 > 120 ? 120 : qr - 4);
    const int span0 = jt == 0 ? 0 : (jt == 1 ? 8 : (jt == 2 ? 24 : 32));
    if (!CTXQ) {
        const int qc = 16 * jt + n; const int cs = qc - 8 < 0 ? 0 : (qc - 8 > 48 ? 48 : qc - 8);
        const float* rp = rpb + (size_t)h * 15 * 31;
#pragma unroll
        for (int wt = 0; wt < 16; ++wt) { const int kri = wt >> 1, half = wt & 1;
            const bf16* kp = KN + (size_t)(b * SEQ + (rs + kri) * 64 + span0 + 16 * half + n) * GWD + h * 64 + 8 * q4;
            f32x4 a = {0.f, 0.f, 0.f, 0.f};
            a = mfma16(ld_frag(kp), qf[0], a); a = mfma16(ld_frag(kp + 32), qf[1], a);
            const int relr = rs + kri - qr + 7;
#pragma unroll
            for (int i = 0; i < 4; ++i) { const int kc = span0 + 16 * half + 4 * q4 + i; const bool ok = kc >= cs && kc < cs + 16;
                const int relc = kc - qc + 15; const int relcc = relc < 0 ? 0 : (relc > 30 ? 30 : relc);
                const float bias = rp[relr * 31 + relcc];
                a[i] = ok ? a[i] + bias : -INFINITY; }
            s[wt] = a; }
    }
#pragma unroll
    for (int ct = 0; ct < 16; ++ct) { const bf16* kp = KN + (size_t)(NLAT + b * CTXL + 16 * ct + n) * GWD + h * 64 + 8 * q4;
        f32x4 a = {0.f, 0.f, 0.f, 0.f};
        a = mfma16(ld_frag(kp), qf[0], a); a = mfma16(ld_frag(kp + 32), qf[1], a);
        s[WT + ct] = a; }
    float mx = -INFINITY;
#pragma unroll
    for (int t = 0; t < NT; ++t) mx = fmaxf(fmaxf(fmaxf(s[t][0], s[t][1]), fmaxf(s[t][2], s[t][3])), mx);
    mx = max16x4(mx);
    float sum = 0.f;
#pragma unroll
    for (int t = 0; t < NT; ++t) {
#pragma unroll
        for (int i = 0; i < 4; ++i) { const float e = __expf(s[t][i] - mx); s[t][i] = e; sum += e; } }
    sum = sum16x4(sum);
    const float inv = 1.0f / sum;
    f32x4 o[4];
#pragma unroll
    for (int nt = 0; nt < 4; ++nt) o[nt] = (f32x4){0.f, 0.f, 0.f, 0.f};
#pragma unroll
    for (int tp = 0; tp < NT / 2; ++tp) {
        const f32x4 p0 = s[2 * tp] * inv, p1 = s[2 * tp + 1] * inv;
        v4u aw; aw.x = pk2(p0[0], p0[1]); aw.y = pk2(p0[2], p0[3]); aw.z = pk2(p1[0], p1[1]); aw.w = pk2(p1[2], p1[3]);
        const bf16x8 af = __builtin_bit_cast(bf16x8, aw);
        const bf16* vb; size_t dstride;
        if (!CTXQ && tp < 8) { vb = VTL + ((size_t)(b * 16 + h) * 64 + n) * 8192 + (rs + tp) * 64 + span0 + 4 * q4; dstride = (size_t)16 * 8192; }
        else { const int ct = 2 * (tp - (CTXQ ? 0 : 8)); vb = VTC + ((size_t)(b * 16 + h) * 64 + n) * 256 + 16 * ct + 4 * q4; dstride = (size_t)16 * 256; }
#pragma unroll
        for (int nt = 0; nt < 4; ++nt) { const v2u x0 = *(const v2u*)(vb + nt * dstride), x1 = *(const v2u*)(vb + nt * dstride + 16);
            v4u bw; bw.x = x0.x; bw.y = x0.y; bw.z = x1.x; bw.w = x1.y;
            o[nt] = mfma16(af, __builtin_bit_cast(bf16x8, bw), o[nt]); }
    }
#pragma unroll
    for (int nt = 0; nt < 4; ++nt)
#pragma unroll
        for (int i = 0; i < 4; ++i) { const int row = qrow0 + 4 * q4 + i, col = h * 64 + 16 * nt + n; const float z = bf2f(P[(size_t)row * NIN + C_NAZ + col]);
            Y[(size_t)row * DM + 1024 + col] = (bf16)f2bf(o[nt][i] * silu_f(z)); }
}
__device__ __forceinline__ void phase_sgu(const bf16* P, const f32x2* SGST, const float* lnw, const float* lnb, const bf16* SGW  , const float* sgb  , bf16* Y,
                                          LAS unsigned char* lds, int nchunks, int tid, int wave, int lane) {
    const int n = lane & 15, q4 = lane >> 4;
    LAS bf16* T = (LAS bf16*)lds;
    for (int u = blockIdx.x; u < nchunks * 8; u += 256) {
        const int ck = u >> 3, g = u & 7, m0 = ck * 128;
#pragma unroll
        for (int it = 0; it < 4; ++it) { const int idx = tid + 512 * it, q = idx >> 4, c8 = idx & 15;
            float x[8]; unpack8(*(const v4u*)(P + (size_t)(m0 + q) * NIN + C_SGV + g * 128 + 8 * c8), x);
            const f32x2 st = SGST[m0 + q];
#pragma unroll
            for (int j = 0; j < 8; ++j) { const int c = 8 * c8 + j; const float v = (x[j] - st.x) * st.y * lnw[g * 128 + c] + lnb[g * 128 + c]; T[c * 136 + q] = (bf16)f2bf(v); } }
        __syncthreads();
        bf16x8 af[4];
#pragma unroll
        for (int ks = 0; ks < 4; ++ks) af[ks] = ld_frag(SGW + ((size_t)g * 128 + 16 * wave + n) * 128 + 32 * ks + 8 * q4);
#pragma unroll
        for (int nt = 0; nt < 8; ++nt) {
            f32x4 acc = {0.f, 0.f, 0.f, 0.f};
#pragma unroll
            for (int ks = 0; ks < 4; ++ks) { const bf16x8 bfg = *(const LAS bf16x8*)(T + (16 * nt + n) * 136 + 32 * ks + 8 * q4); acc = mfma16(af[ks], bfg, acc); }
#pragma unroll
            for (int i = 0; i < 4; ++i) { const int p = 16 * wave + 4 * q4 + i, row = m0 + p, col = g * 128 + 16 * nt + n;
                const float mixed = acc[i] + sgb[g * 128 + p]; const bf16* pr = P + (size_t)row * NIN;
                const float uu = bf2f(pr[C_SGU + col]), z = bf2f(pr[C_SGZ + col]);
                Y[(size_t)row * DM + 3072 + col] = (bf16)f2bf(uu * mixed * silu_f(z)); }
        }
        __syncthreads();
    }
}
__device__ __forceinline__ void phase_scan(const float* REC, float* YR, LAS unsigned char* lds, int wave, int lane) {
    constexpr int NCH = SCANLEN / 16, SLOT = 16 * RECF * 4;
    for (int su = blockIdx.x; su < NCHAIN * 4; su += 256) {
        const int chain = (su & 7) * 8 + ((su >> 3) >> 2), part = (su >> 3) & 3;
        const char* recb = (const char*)(REC + (size_t)chain * SCANLEN * RECF);
        if (wave >= 4) {
            const int wl = wave - 4;
#define SCAN_ISSUE(cc, sl) do { _Pragma("unroll") for (int p_ = 0; p_ < 6; ++p_) \
            __builtin_amdgcn_global_load_lds((const unsigned*)(recb + (size_t)(cc) * SLOT + (wl * 6 + p_) * 1024 + lane * 16), (LAS unsigned*)(lds + (sl) * SLOT + (wl * 6 + p_) * 1024), 16, 0, 0); } while (0)
            SCAN_ISSUE(0, 0); SCAN_ISSUE(1, 1); SCAN_ISSUE(2, 2);
            for (int c = 0; c < NCH; ++c) {
                asm volatile("s_waitcnt vmcnt(12)" ::: "memory");
                __builtin_amdgcn_s_barrier();
                const int cc = c + 3 < NCH ? c + 3 : NCH - 1;
                SCAN_ISSUE(cc, (c + 3) & 3);
            }
            asm volatile("s_waitcnt vmcnt(0)" ::: "memory");
#undef SCAN_ISSUE
        } else {
            const int c16 = lane & 15, rg = lane >> 4, row = 16 * part + 4 * wave + rg;
            f32x4 S = {0.f, 0.f, 0.f, 0.f};
            float* yout = YR + (size_t)chain * SCANLEN * 64 + row;
            for (int c = 0; c < NCH; ++c) {
                __builtin_amdgcn_s_barrier();
                asm volatile("" ::: "memory");
                const LAS unsigned char* slot = lds + (c & 3) * SLOT;
                float ysave = 0.f;
#pragma unroll
                for (int s = 0; s < 16; ++s) {
                    const LAS unsigned char* rec = slot + s * (RECF * 4);
                    const f32x4 w4 = *(const LAS f32x4*)(rec + c16 * 16), kk4 = *(const LAS f32x4*)(rec + 256 + c16 * 16), ka4 = *(const LAS f32x4*)(rec + 512 + c16 * 16),
                                k4 = *(const LAS f32x4*)(rec + 768 + c16 * 16), r4 = *(const LAS f32x4*)(rec + 1024 + c16 * 16);
                    const float vv = *(const LAS float*)(rec + 1280 + row * 4);
                    float dt = (S.x * kk4.x + S.y * kk4.y) + (S.z * kk4.z + S.w * kk4.w);
                    dt = red16(dt);
                    const f32x4 uu = S * w4 + vv * k4;
                    S = uu - dt * ka4;
                    float y = (S.x * r4.x + S.y * r4.y) + (S.z * r4.z + S.w * r4.w);
                    y = red16(y);
                    ysave = (c16 == s) ? y : ysave;
                }
                asm volatile("" ::: "memory");
                yout[(size_t)(c * 16 + c16) * 64] = ysave;
            }
        }
        __syncthreads();
    }
}
__device__ __forceinline__ void phase_rwfin(const bf16* P, const float* YR, const float* REC, const float* BON, const float* lnw, const float* lnb, bf16* Y, int nrows, int gw, int NGW, int lane) {
    const int head = lane >> 2, sub = lane & 3;
    for (int m = gw; m < nrows; m += NGW) {
        const bool isctx = m >= NLAT; const int t = isctx ? ((m - NLAT) & 255) : (m & 8191); const int b = isctx ? ((m - NLAT) >> 8) : (m >> 13);
        float out[16];
#pragma unroll
        for (int i = 0; i < 16; ++i) out[i] = 0.f;
#pragma unroll
        for (int d = 0; d < 2; ++d) {
            const int chain = (b * 2 + d) * 16 + head; const size_t pp = (size_t)chain * SCANLEN + scan_pos(d, isctx, t);
            float y[16], v[16];
#pragma unroll
            for (int j = 0; j < 4; ++j) { const f32x4 a = *(const f32x4*)(YR + pp * 64 + 16 * sub + 4 * j), c = *(const f32x4*)(REC + pp * RECF + 320 + 16 * sub + 4 * j);
                y[4 * j] = a.x; y[4 * j + 1] = a.y; y[4 * j + 2] = a.z; y[4 * j + 3] = a.w; v[4 * j] = c.x; v[4 * j + 1] = c.y; v[4 * j + 2] = c.z; v[4 * j + 3] = c.w; }
            const float bo = BON[pp];
            float s = 0.f;
#pragma unroll
            for (int i = 0; i < 16; ++i) s += y[i];
            s += __shfl_xor(s, 1); s += __shfl_xor(s, 2);
            const float mean = s * (1.f / 64.f); float q = 0.f;
#pragma unroll
            for (int i = 0; i < 16; ++i) { const float dl = y[i] - mean; q += dl * dl; }
            q += __shfl_xor(q, 1); q += __shfl_xor(q, 2);
            const float rstd = 1.0f / sqrtf(q * (1.f / 64.f) + 64e-5f);
#pragma unroll
            for (int i = 0; i < 16; ++i) { const int ch = head * 64 + 16 * sub + i; out[i] += (y[i] - mean) * rstd * lnw[ch] + lnb[ch] + bo * v[i]; }
        }
        float z[16]; unpack8(*(const v4u*)(P + (size_t)m * NIN + C_RWZ + 16 * lane), z); unpack8(*(const v4u*)(P + (size_t)m * NIN + C_RWZ + 16 * lane + 8), z + 8);
#pragma unroll
        for (int i = 0; i < 16; ++i) out[i] *= silu_f(z[i]);
        *(v4u*)(Y + (size_t)m * DM + 2048 + 16 * lane) = pack8(out); *(v4u*)(Y + (size_t)m * DM + 2048 + 16 * lane + 8) = pack8(out + 8);
    }
}
#define XB_TMO      128
#define XB_XCNT(j)  (256  + 64 * (j))
#define XB_XSUB(j)  (1280 + 64 * (j))
#define XB_XGEN(j)  (2304 + 64 * (j))
#define XB_TOP      3328
#define XB_TOPGEN   3392
#define XCD_BAR_WORDS 3456
#define XB_SPIN_CAP (1u << 18)

__device__ __forceinline__ unsigned xb_ld(unsigned* p)              { return __hip_atomic_load(p, __ATOMIC_RELAXED, __HIP_MEMORY_SCOPE_AGENT); }
__device__ __forceinline__ unsigned xb_add(unsigned* p, unsigned v) { return __hip_atomic_fetch_add(p, v, __ATOMIC_RELAXED, __HIP_MEMORY_SCOPE_AGENT); }
__device__ __forceinline__ unsigned xb_xcc_id() { return (unsigned)__builtin_amdgcn_s_getreg((3 << 11) | 20) & 0xFu; }
#define XB_SPIN(cond, bar) do { unsigned _sp = 0; while (cond) { __builtin_amdgcn_s_sleep(1); \
    if ((++_sp & 255u) == 0u) { if (xb_ld(&(bar)[XB_TMO])) break; if (_sp > XB_SPIN_CAP) { atomicAdd(&(bar)[XB_TMO], 1u); break; } } } } while (0)

struct XcdBarrier {
    unsigned* bar; unsigned x;
    volatile LAS unsigned* st;
};

__device__ __forceinline__ XcdBarrier xcd_barrier_post(unsigned* bar, volatile LAS unsigned* st) {
    XcdBarrier b; b.bar = bar; b.x = xb_xcc_id(); b.st = st;
    if (threadIdx.x == 0) (void)xb_add(&bar[XB_XCNT(b.x)], 1u);
    return b;
}
__device__ __forceinline__ void xcd_barrier_complete(unsigned* bar, unsigned x, unsigned& nloc, unsigned& nx) {
    const unsigned G = gridDim.x * gridDim.y * gridDim.z;
    unsigned sum, cnt, mine, sp = 0u;
    for (;;) {
        sum = 0u; cnt = 0u; mine = 0u;
#pragma unroll
        for (unsigned j = 0; j < 16; ++j) { const unsigned c = xb_ld(&bar[XB_XCNT(j)]); sum += c; cnt += (c > 0u) ? 1u : 0u; mine = (j == x) ? c : mine; }
        if (sum == G) break;
        __builtin_amdgcn_s_sleep(1);
        if ((++sp & 255u) == 0u) { if (xb_ld(&bar[XB_TMO])) break; if (sp > XB_SPIN_CAP) { atomicAdd(&bar[XB_TMO], 1u); break; } }
    }
    nloc = mine > 0u ? mine : 1u; nx = cnt > 0u ? cnt : 1u;
}

__device__ __forceinline__ void xcd_barrier(const XcdBarrier& b) {
    asm volatile("s_waitcnt vmcnt(0)" ::: "memory");
    __syncthreads();
    if (threadIdx.x == 0) {
        unsigned* bar = b.bar;
        __builtin_amdgcn_s_waitcnt(0);
        unsigned nloc = b.st[0], nx = b.st[1];
        if (nloc == 0u) { xcd_barrier_complete(bar, b.x, nloc, nx); b.st[0] = nloc; b.st[1] = nx; }
        const unsigned old = xb_add(&bar[XB_XSUB(b.x)], 1u);
        const unsigned gen = old / nloc;
        if (old + 1u == (gen + 1u) * nloc) {
            __builtin_amdgcn_fence(__ATOMIC_RELEASE, "agent");
            asm volatile("s_waitcnt vmcnt(0)" ::: "memory");
            const unsigned og = xb_add(&bar[XB_TOP], 1u);
            const unsigned tg = og / nx;
            if (og + 1u == (tg + 1u) * nx) xb_add(&bar[XB_TOPGEN], 1u);
            else XB_SPIN(xb_ld(&bar[XB_TOPGEN]) == tg, bar);
            __builtin_amdgcn_fence(__ATOMIC_ACQUIRE, "agent");
            xb_add(&bar[XB_XGEN(b.x)], 1u);
            asm volatile("s_waitcnt vmcnt(0)" ::: "memory");
        } else {
            XB_SPIN(xb_ld(&bar[XB_XGEN(b.x)]) == gen, bar);
            __builtin_amdgcn_fence(__ATOMIC_ACQUIRE, "agent");
            asm volatile("s_waitcnt vmcnt(0)" ::: "memory");
        }
    }
    __syncthreads();
}

#ifndef MK_SPLIT
#define MK_SPLIT 0
#endif
constexpr int NPHASE = 2 + 6 * DEPTH;
constexpr int NGRID = 256;
struct Args { const float* in[28]; float* out; unsigned char* ws; int ph_lo, ph_hi, li, pad; };

__global__ void __launch_bounds__(NWAVES * 64, 2) fwd(Args args) {
    extern __shared__ __attribute__((aligned(16))) unsigned char lds_raw[];
    LAS unsigned char* lds = (LAS unsigned char*)lds_raw;
    volatile LAS unsigned* MISC = (volatile LAS unsigned*)(lds + MISC_OFF);
    const int tid = threadIdx.x, lane = tid & 63, wave = __builtin_amdgcn_readfirstlane(tid >> 6);
    constexpr int G = NGRID; const int bx = blockIdx.x;
    const int vcu = (bx % 8) * (G / 8) + bx / 8;
    const int gw = vcu * NWAVES + wave; constexpr int NGW = G * NWAVES;
    unsigned char* ws = args.ws;
    const int lo = args.ph_lo, hi = args.ph_hi;

    for (int u = tid; u < (LDS_BYTES - LDSCTL_OFF) / 4; u += NWAVES * 64) ((LAS unsigned*)(lds + LDSCTL_OFF))[u] = 0u;
    __syncthreads();
    XcdBarrier bar; bar.bar = (unsigned*)(ws + WS_CTL) + CW_BAR; bar.x = 0; bar.st = MISC + 8;
    if (hi - lo > 1) bar = xcd_barrier_post((unsigned*)(ws + WS_CTL) + CW_BAR, MISC + 8);
#define IN(k) (lo <= (k) && (k) < hi)
#define SEAM(k) do { if (lo <= (k) && (k) + 1 < hi) { XcdBarrier b2_; b2_.bar = WSP(unsigned, WS_CTL) + CW_BAR; b2_.x = bar.x; b2_.st = bar.st; xcd_barrier(b2_); } } while (0)

#define OPQ_S(x) ({ int _t = (x); asm volatile("" : "+s"(_t)); _t; })
#define OPQ_V(x) ({ int _t = (x); asm volatile("" : "+v"(_t)); _t; })
#define INP(i) (args.in[OPQ_S(i)])
#define WSP(T, off) ((T*)(args.ws + ({ size_t _o = (off); asm volatile("" : "+s"(_o)); _o; })))
#define x_in INP(0)
#define c_in INP(1)
#define ctx_in INP(2)
#define cctx_in INP(3)
#define w_mod INP(4)
#define b_mod INP(5)
#define w_in INP(6)
#define w_out INP(7)
#define pool_w INP(8)
#define pool_scale INP(9)
#define na_qg INP(10)
#define na_kg INP(11)
#define na_rpb INP(12)
#define rw_mu_rkv INP(13)
#define rw_mu_lora INP(14)
#define rw_w0 INP(15)
#define rw_w_up INP(16)
#define rw_a0 INP(17)
#define rw_a_up INP(18)
#define rw_k_k INP(19)
#define rw_k_a INP(20)
#define rw_r_k INP(21)
#define rw_ln_w INP(22)
#define rw_ln_b INP(23)
#define sg_ln_w INP(24)
#define sg_ln_b INP(25)
#define sg_w INP(26)
#define sg_b INP(27)
#define MOD WSP(float, WS_MOD)
#define MODP WSP(float, WS_MODP)
#define TAB WSP(f32x2, WS_TAB)
#define SGST WSP(f32x2, WS_SGST)
#define BON WSP(float, WS_BON)
#define POOLWT WSP(bf16, WS_POOLWT)
#define WUPT WSP(bf16, WS_WUPT)
#define AUPT WSP(bf16, WS_AUPT)
#define SGW WSP(bf16, WS_SGW)
#define VTC WSP(bf16, WS_VTC)
#define VTL WSP(bf16, WS_VTL)
#define HCTX WSP(float, WS_HCTX)
#define QN WSP(bf16, WS_QN)
#define KN WSP(bf16, WS_KN)
#define WOUTT WSP(bf16, WS_WOUTT)
#define WINT WSP(bf16, WS_WINT)
#define XN WSP(bf16, WS_XN)
#define Y WSP(bf16, WS_Y)
#define P WSP(bf16, WS_P)
#define YR WSP(float, WS_YR)
#define REC WSP(float, WS_REC)
    float* const out = args.out;

    if (IN(0)) {
        LAS float* scr = (LAS float*)(lds + wave * 16384);
        constexpr int I_MOD = 4 * 64 * 48, I_WIN1 = 64 * (NIN / 32), I_WIN = 4 * I_WIN1, I_WOUT1 = 64 * 128, I_WOUT = 4 * I_WOUT1, I_POOL = 16 * 32, I_WUP = 8 * 32, I_AUP = 8 * 32, I_SGW = 1024;
        constexpr int NITEMS = I_MOD + I_WIN + I_WOUT + I_POOL + I_WUP + I_AUP + I_SGW;
        for (int it = gw; it < NITEMS; it += NGW) {
            int r = it;
            if (r < I_MOD) { p0_mod_item(w_mod, c_in, cctx_in, MODP, scr, r, lane); continue; } r -= I_MOD;
            if (r < I_WIN) { const int l = r / I_WIN1; p0_transpose_item(w_in + (size_t)l * DM * NIN, DM, NIN, WINT + (size_t)l * NIN * DM, scr, r % I_WIN1, lane); continue; } r -= I_WIN;
            if (r < I_WOUT) { const int l = r / I_WOUT1; p0_transpose_item(w_out + (size_t)l * DM * DM, DM, DM, WOUTT + (size_t)l * DM * DM, scr, r % I_WOUT1, lane); continue; } r -= I_WOUT;
            if (r < I_POOL) { const int lg = r / 32; p0_transpose_item(pool_w + (size_t)lg * 65536, 256, 256, POOLWT + (size_t)lg * 65536, scr, r % 32, lane); continue; } r -= I_POOL;
            if (r < I_WUP) { const int ld = r / 32; p0_transpose_item(rw_w_up + (size_t)ld * 65536, 64, 1024, WUPT + (size_t)ld * 65536, scr, r % 32, lane); continue; } r -= I_WUP;
            if (r < I_AUP) { const int ld = r / 32; p0_transpose_item(rw_a_up + (size_t)ld * 65536, 64, 1024, AUPT + (size_t)ld * 65536, scr, r % 32, lane); continue; } r -= I_AUP;
            {   const size_t e0 = (size_t)r * 512 + lane * 8; const f32x4 a = *(const f32x4*)(sg_w + e0), b = *(const f32x4*)(sg_w + e0 + 4);
                v4u o; o.x = pk2(a.x, a.y); o.y = pk2(a.z, a.w); o.z = pk2(b.x, b.y); o.w = pk2(b.z, b.w); *(v4u*)(SGW + e0) = o; }
        }
        SEAM(0);
    }
    if (IN(1)) {
        for (int idx = gw * 64 + lane; idx < 4 * 3 * 12288; idx += NGW * 64) {
            const int l = idx / 36864, c = (idx / 12288) % 3, n = idx % 12288;
            float s = b_mod[l * 12288 + n];
            const float* pp = MODP + ((size_t)(l * 64) * 3 + c) * 12288 + n;
#pragma unroll 8
            for (int kc = 0; kc < 64; ++kc) s += pp[(size_t)kc * 3 * 12288];
            MOD[idx] = s;
        }
        for (int idx = gw * 64 + lane; idx < 2048; idx += NGW * 64) {
            const int pos = idx >> 4, i = idx & 15;
            float inv = (i & 3) == 0 ? 1.0f : ((i & 3) == 1 ? 0.5623413251903491f : ((i & 3) == 2 ? 0.31622776601683794f : 0.17782794100389228f));
            inv *= (i >> 2) == 0 ? 1.0f : ((i >> 2) == 1 ? 0.1f : ((i >> 2) == 2 ? 0.01f : 0.001f));
            float cc, sn; sincos_acc((float)pos * inv, cc, sn);
            TAB[idx] = (f32x2){cc, sn};
        }
        SEAM(1);
    }
    for (int l = 0; l < DEPTH; ++l) {
        const int pb = 2 + 6 * l;
        const bool with_ctx = l < DEPTH - 1;
#define hin_lat (l == 0 ? x_in : (const float*)out)
#define hin_ctx (l == 0 ? ctx_in : (const float*)HCTX)
#define mod (MOD + (size_t)l * 3 * 12288)
        const int nrows = with_ctx ? MROWS : NLAT;
        if (IN(pb + 0)) {
            phase_xn(hin_lat, hin_ctx, mod, XN, OPQ_S(gw), NGW, OPQ_V(lane));
            SEAM(pb + 0);
        }
        if (IN(pb + 1)) {
            pg8::Gemm g{XN, WINT + (size_t)l * NIN * DM, MROWS, NIN, DM}; pg8::StaticOrder S; S.init(MROWS, NIN, G, bx);
            pg8::EpiStoreBf16 E{P, NIN};
            pg8::gemm_phase<pg8::EpiStoreBf16, pg8::StaticOrder, true, true>(lds, g, S, E);
            SEAM(pb + 1);
        }
        if (IN(pb + 2)) {
            phase_rowprep(P, na_qg + l * 64, na_kg + l * 64, TAB, QN, KN, SGST, OPQ_S(gw), NGW, OPQ_V(lane));
            phase_vt(P, VTL, VTC, OPQ_S(gw), NGW, OPQ_V(lane));
            phase_rwprep(P, rw_mu_rkv + (size_t)l * 6144, rw_mu_lora + (size_t)l * 256, rw_w0 + (size_t)l * 2048, WUPT + (size_t)l * 131072, rw_a0 + (size_t)l * 2048, AUPT + (size_t)l * 131072,
                         rw_k_k + (size_t)l * 1024, rw_k_a + (size_t)l * 1024, rw_r_k + (size_t)l * 1024, REC, BON, OPQ_S(gw), NGW, OPQ_V(lane));
            phase_pool(P, POOLWT + (size_t)l * 262144, pool_scale + (size_t)l * 1024, Y, nrows, OPQ_S(gw), NGW, OPQ_V(lane));
            SEAM(pb + 2);
        }
        if (IN(pb + 3)) {
            for (int u = OPQ_S(gw); u < NBATCH * 128 * 16 * 4; u += NGW) na_unit<false>(QN, KN, VTL, VTC, P, na_rpb + (size_t)l * 16 * 15 * 31, Y, u, OPQ_V(lane));
            if (with_ctx) for (int u = OPQ_S(gw); u < NBATCH * 16 * 16; u += NGW) na_unit<true>(QN, KN, VTL, VTC, P, na_rpb, Y, u, OPQ_V(lane));
            phase_sgu(P, SGST, sg_ln_w + (size_t)l * 1024, sg_ln_b + (size_t)l * 1024, SGW + (size_t)l * 131072, sg_b + (size_t)l * 1024, Y, lds, nrows / 128, OPQ_V(tid), wave, OPQ_V(lane));
            phase_scan(REC, YR, lds, wave, OPQ_V(lane));
            SEAM(pb + 3);
        }
        if (IN(pb + 4)) {
            phase_rwfin(P, YR, REC, BON, rw_ln_w + (size_t)l * 1024, rw_ln_b + (size_t)l * 1024, Y, nrows, OPQ_S(gw), NGW, OPQ_V(lane));
            SEAM(pb + 4);
        }
        if (IN(pb + 5)) {
            pg8::Gemm g{Y, WOUTT + (size_t)l * DM * DM, nrows, DM, DM}; pg8::StaticOrder S; S.init(nrows, DM, G, bx);
            pg8::EpiResGate E{hin_lat, hin_ctx, out, HCTX, mod};
            pg8::gemm_phase<pg8::EpiResGate, pg8::StaticOrder, true, true>(lds, g, S, E);
            SEAM(pb + 5);
        }
    }
#undef IN
#undef SEAM
}
#undef hin_lat
#undef hin_ctx
#undef mod
#undef P
#undef Y
#undef XN
#undef out

extern "C" void kernel_launch(void* const* d_in, const int* in_sizes, int n_in, void* d_out, int out_size, void* d_ws, size_t ws_size, hipStream_t stream) {
    static int grid = 0;
    if (grid == 0) {
        if (n_in != 28 || out_size != NLAT * DM || ws_size < WS_END) { fprintf(stderr, "kernel_launch: unexpected shapes (n_in %d, out %d, ws %zu < %zu); nothing launched\n", n_in, out_size, ws_size, (size_t)WS_END); grid = -1; return; }
        int dev = 0, cus = 0, per_cu = 0;
        if (hipGetDevice(&dev) != hipSuccess || hipDeviceGetAttribute(&cus, hipDeviceAttributeMultiprocessorCount, dev) != hipSuccess) { grid = -1; return; }
        if (hipFuncSetAttribute((const void*)fwd, hipFuncAttributeMaxDynamicSharedMemorySize, LDS_BYTES) != hipSuccess) { fprintf(stderr, "kernel_launch: hipFuncSetAttribute failed\n"); grid = -1; return; }
        if (hipOccupancyMaxActiveBlocksPerMultiprocessor(&per_cu, (const void*)fwd, NWAVES * 64, LDS_BYTES) != hipSuccess || per_cu < 1)
            fprintf(stderr, "kernel_launch: note: occupancy query reports %d workgroups per CU\n", per_cu);
        (void)hipGetLastError();
        grid = cus >= NGRID ? NGRID : -2;
    }
    if (grid == -1) return;
    if (hipMemsetAsync((char*)d_ws + WS_CTL, 0, CTL_ZERO_BYTES, stream) != hipSuccess) { fprintf(stderr, "kernel_launch: memset failed\n"); return; }
    Args a{};
    for (int i = 0; i < 28; ++i) a.in[i] = (const float*)d_in[i];
    a.out = (float*)d_out; a.ws = (unsigned char*)d_ws; a.li = 0; a.pad = 0;
    const bool split = MK_SPLIT || grid == -2;
    if (split) { for (int k = 0; k < NPHASE; ++k) { a.ph_lo = k; a.ph_hi = k + 1; hipLaunchKernelGGL(fwd, dim3(NGRID), dim3(NWAVES * 64), LDS_BYTES, stream, a); } }
    else { a.ph_lo = 0; a.ph_hi = NPHASE; hipLaunchKernelGGL(fwd, dim3(NGRID), dim3(NWAVES * 64), LDS_BYTES, stream, a); }
    const hipError_t le = hipPeekAtLastError();
    if (le != hipSuccess) fprintf(stderr, "kernel_launch: launch failed: %s\n", hipGetErrorName(le));
}
```

```cpp
#include <hip/hip_runtime.h>
#include <cstdio>
#include <cstdint>
#define MK_SPLIT 0
namespace pg8 {
#define PG8_LAS __attribute__((address_space(3)))
typedef unsigned short bf16_t;
typedef short bf16x8 __attribute__((ext_vector_type(8)));
typedef float f32x4 __attribute__((ext_vector_type(4)));
typedef unsigned u32x4 __attribute__((ext_vector_type(4)));
constexpr int BM = 256, BK = 64, HALF = 128, HTB = HALF * BK * 2  , STAGE_BYTES = 8 * HTB, NXCD = 8, WGM = 8;

__host__ __device__ __forceinline__ int lds_byte(int r, int c) { const int st = (r >> 4) * 2 + (c >> 5), rr = r & 15, cc = c & 31, ob = rr * 64 + cc * 2; return st * 1024 + (ob ^ (((ob >> 9) & 1) << 5)); }
__host__ __device__ __forceinline__ void stage_rc(int b, int& R, int& C) { const int st = b / 1024, sb = b % 1024, swz = sb ^ (((sb >> 9) & 1) << 5); R = (st >> 1) * 16 + swz / 64; C = (st & 1) * 32 + (swz % 64) / 2; }
__host__ __device__ __forceinline__ int perm32(int rho) { const int n = rho >> 4, i = rho & 15; return 8 * (i >> 2) + 4 * n + (i & 3); }

struct Unit { int pm, pn; };
struct Gemm { const bf16_t* A; const bf16_t* Bt; int M, N, K; };

struct StaticOrder {
    int nM, nN, nwg, G, c;
    __host__ __device__ void init(int M, int N, int G_, int c_) { nM = M / BM; nN = N / BM; nwg = nM * nN; G = G_; c = c_; }
    __host__ __device__ bool next(int i, Unit& u) const {
        const long L = (long)i * G + c; if (L >= nwg) return false;
        int wgid = (int)L; { const int q = nwg / NXCD, r = nwg % NXCD, xcd = wgid % NXCD, off = wgid / NXCD; wgid = (xcd < r ? xcd * (q + 1) : r * (q + 1) + (xcd - r) * q) + off; }
        const int nig = WGM * nN, gid = wgid / nig, fm = gid * WGM, gsz = (nM - fm) < WGM ? (nM - fm) : WGM;
        u.pm = fm + ((wgid % nig) % gsz); u.pn = (wgid % nig) / gsz; return true;
    }
    __device__ __forceinline__ void a_ready(const Unit&) const {}
    __device__ __forceinline__ void done(const Unit&) const {}
};

__device__ __forceinline__ unsigned cvt_pk_bf16(float lo, float hi) { unsigned r; asm volatile("v_cvt_pk_bf16_f32 %0, %1, %2" : "=v"(r) : "v"(lo), "v"(hi)); return r; }
template <class Epi, class Sched, bool ALIGN_EPI = false, bool SP2 = false>
__device__ __forceinline__ void gemm_phase(PG8_LAS unsigned char* lds, const Gemm g, const Sched& S, const Epi& E) {
    int tid_ = threadIdx.x; asm volatile("" : "+v"(tid_));
    const int tid = tid_, wid = __builtin_amdgcn_readfirstlane(tid >> 6), lane = tid & 63, wr = wid >> 2, wc = wid & 3, fr = lane & 15, fq = lane >> 4;
    const int K = g.K, nt = K / BK;
    unsigned voffA[2], voffB[2];
#pragma unroll
    for (int i = 0; i < 2; ++i) { int R, C; stage_rc(tid * 16 + i * 8192, R, C); const int Rb = Epi::PERM ? ((R & ~31) + perm32(R & 31)) : R;
        voffA[i] = (unsigned)(R * K + C) * 2u; voffB[i] = (unsigned)(Rb * K + C) * 2u; }
    const size_t kstep = (size_t)(BK * 2);
    const size_t hstep = (size_t)HALF * K * 2;
    const size_t tstep = 2 * hstep;
    const unsigned ldsw = (unsigned)wid * 1024u;
    const int aoff = lds_byte(wr * 64 + fr, fq * 8), boff = lds_byte(wc * 32 + fr, fq * 8);
#define PG8_SA(b, h) (((b) * 2 + (h)) * HTB)
#define PG8_SB(b, h) ((4 + (b) * 2 + (h)) * HTB)
#define PG8_STAGE(bufoff, gbase, voff) do { _Pragma("unroll") for (int _i = 0; _i < 2; ++_i) \
        __builtin_amdgcn_global_load_lds((const unsigned*)((const char*)(gbase) + (voff)[_i]), (PG8_LAS unsigned*)(lds + (bufoff) + ldsw + _i * 8192), 16, 0, 0); } while (0)
#define PG8_LDA(dst, b, h) do { _Pragma("unroll") for (int m = 0; m < 4; ++m) _Pragma("unroll") for (int k = 0; k < 2; ++k) dst[m][k] = *(const PG8_LAS bf16x8*)(lds + PG8_SA(b, h) + aoff + m * 2048 + k * 1024); } while (0)
#define PG8_LDB(dst, b, h) do { _Pragma("unroll") for (int n = 0; n < 2; ++n) _Pragma("unroll") for (int k = 0; k < 2; ++k) dst[n][k] = *(const PG8_LAS bf16x8*)(lds + PG8_SB(b, h) + boff + n * 2048 + k * 1024); } while (0)
#define PG8_MMA(ai, bj, At, Bt) do { __builtin_amdgcn_s_setprio(1); _Pragma("unroll") for (int m = 0; m < 4; ++m) _Pragma("unroll") for (int n = 0; n < 2; ++n) _Pragma("unroll") for (int k = 0; k < 2; ++k) \
        acc[ai][bj][m][n] = __builtin_amdgcn_mfma_f32_16x16x32_bf16(Bt[n][k], At[m][k], acc[ai][bj][m][n], 0, 0, 0); __builtin_amdgcn_s_setprio(0); } while (0)
#define PG8_WAIT_V(n) asm volatile("s_waitcnt vmcnt(" #n ")" ::: "memory")
#define PG8_WAIT_L(n) asm volatile("s_waitcnt lgkmcnt(" #n ")" ::: "memory")
#define PG8_BAR __builtin_amdgcn_s_barrier()
#define PG8_SCHED __builtin_amdgcn_sched_barrier(0)
    Unit cur, nxt; int ui = 0;
    if (!S.next(0, cur)) return;
    f32x4 acc[2][2][4][2];
#pragma unroll
    for (int a = 0; a < 2; ++a)
#pragma unroll
        for (int b = 0; b < 2; ++b)
#pragma unroll
            for (int m = 0; m < 4; ++m)
#pragma unroll
                for (int n = 0; n < 2; ++n) acc[a][b][m][n] = (f32x4){0.f, 0.f, 0.f, 0.f};
    bf16x8 At[4][2], B0[2][2], B1[2][2];
    const char* cA = (const char*)g.A + (size_t)cur.pm * tstep; const char* cB = (const char*)g.Bt + (size_t)cur.pn * tstep;
    S.a_ready(cur);
    if constexpr (SP2) {
        PG8_STAGE(PG8_SB(0, 0), cB, voffB); PG8_STAGE(PG8_SB(0, 1), cB + hstep, voffB); PG8_STAGE(PG8_SA(0, 0), cA, voffA); PG8_STAGE(PG8_SA(0, 1), cA + hstep, voffA);
        if (wr == 1) PG8_BAR;
        PG8_WAIT_V(2); PG8_BAR;
        PG8_STAGE(PG8_SB(1, 0), cB + kstep, voffB); PG8_STAGE(PG8_SA(1, 0), cA + kstep, voffA); PG8_STAGE(PG8_SB(1, 1), cB + hstep + kstep, voffB);
        PG8_WAIT_V(6); PG8_BAR;
    } else {
        PG8_STAGE(PG8_SB(0, 0), cB, voffB); PG8_STAGE(PG8_SA(0, 0), cA, voffA); PG8_STAGE(PG8_SB(0, 1), cB + hstep, voffB); PG8_STAGE(PG8_SA(0, 1), cA + hstep, voffA);
        if (wr == 1) PG8_BAR;
        PG8_WAIT_V(4); PG8_BAR;
        PG8_STAGE(PG8_SB(1, 0), cB + kstep, voffB); PG8_STAGE(PG8_SA(1, 0), cA + kstep, voffA); PG8_STAGE(PG8_SB(1, 1), cB + hstep + kstep, voffB);
        PG8_WAIT_V(6); PG8_BAR;
    }
    for (;;) {
        const bool has_next = S.next(ui + 1, nxt);
        const char* nA = has_next ? (const char*)g.A + (size_t)nxt.pm * tstep : cA; const char* nB = has_next ? (const char*)g.Bt + (size_t)nxt.pn * tstep : cB;
        for (int t = 0; t < nt; t += 2) {
            const bool last = (t == nt - 2);
            const char* a1 = cA + (size_t)(t + 1) * kstep;
            const char* a2 = last ? nA : cA + (size_t)(t + 2) * kstep; const char* b2 = last ? nB : cB + (size_t)(t + 2) * kstep;
            const char* a3 = a2 + kstep; const char* b3 = b2 + kstep;
            if (last && has_next) S.a_ready(nxt);
            if constexpr (SP2) {
            PG8_LDB(B0, 0, 0); PG8_LDB(B1, 0, 1); PG8_SCHED; PG8_LDA(At, 0, 0); PG8_STAGE(PG8_SA(1, 1), a1 + hstep, voffA);
            PG8_WAIT_V(8); PG8_WAIT_L(0); PG8_BAR; PG8_MMA(0, 0, At, B0); PG8_MMA(0, 1, At, B1); PG8_BAR; PG8_SCHED;
            PG8_LDA(At, 0, 1); PG8_STAGE(PG8_SB(0, 0), b2, voffB); PG8_STAGE(PG8_SB(0, 1), b2 + hstep, voffB); PG8_STAGE(PG8_SA(0, 0), a2, voffA);
            PG8_WAIT_V(8); PG8_WAIT_L(0); PG8_BAR; PG8_MMA(1, 0, At, B0); PG8_MMA(1, 1, At, B1); PG8_BAR; PG8_SCHED;
            PG8_LDB(B0, 1, 0); PG8_LDB(B1, 1, 1); PG8_SCHED; PG8_LDA(At, 1, 0); PG8_STAGE(PG8_SA(0, 1), a2 + hstep, voffA);
            PG8_WAIT_V(8); PG8_WAIT_L(0); PG8_BAR; PG8_MMA(0, 0, At, B0); PG8_MMA(0, 1, At, B1); PG8_BAR; PG8_SCHED;
            PG8_LDA(At, 1, 1); PG8_STAGE(PG8_SB(1, 0), b3, voffB); PG8_STAGE(PG8_SB(1, 1), b3 + hstep, voffB); PG8_STAGE(PG8_SA(1, 0), a3, voffA);
            PG8_WAIT_V(8); PG8_WAIT_L(0); PG8_BAR; PG8_MMA(1, 0, At, B0); PG8_MMA(1, 1, At, B1); PG8_BAR; PG8_SCHED;
            } else {
            PG8_LDB(B0, 0, 0); PG8_SCHED; PG8_LDA(At, 0, 0); PG8_STAGE(PG8_SA(1, 1), a1 + hstep, voffA);
            PG8_WAIT_L(8); PG8_BAR; PG8_WAIT_L(0); PG8_MMA(0, 0, At, B0); PG8_BAR; PG8_SCHED;
            PG8_LDB(B1, 0, 1); PG8_STAGE(PG8_SB(0, 0), b2, voffB);
            PG8_BAR; PG8_WAIT_L(0); PG8_MMA(0, 1, At, B1); PG8_BAR;
            PG8_LDA(At, 0, 1); PG8_STAGE(PG8_SA(0, 0), a2, voffA);
            PG8_BAR; PG8_WAIT_L(0); PG8_MMA(1, 0, At, B0); PG8_BAR; PG8_SCHED;
            PG8_STAGE(PG8_SB(0, 1), b2 + hstep, voffB);
            PG8_WAIT_V(6); PG8_BAR; PG8_MMA(1, 1, At, B1); PG8_BAR;
            PG8_LDB(B0, 1, 0); PG8_SCHED; PG8_LDA(At, 1, 0); PG8_STAGE(PG8_SA(0, 1), a2 + hstep, voffA);
            PG8_WAIT_L(8); PG8_BAR; PG8_WAIT_L(0); PG8_MMA(0, 0, At, B0); PG8_BAR; PG8_SCHED;
            PG8_LDB(B1, 1, 1); PG8_STAGE(PG8_SB(1, 0), b3, voffB);
            PG8_BAR; PG8_WAIT_L(0); PG8_MMA(0, 1, At, B1); PG8_BAR;
            PG8_LDA(At, 1, 1); PG8_STAGE(PG8_SA(1, 0), a3, voffA);
            PG8_BAR; PG8_WAIT_L(0); PG8_MMA(1, 0, At, B0); PG8_BAR; PG8_SCHED;
            PG8_STAGE(PG8_SB(1, 1), b3 + hstep, voffB);
            PG8_WAIT_V(6); PG8_BAR; PG8_MMA(1, 1, At, B1); PG8_BAR;
            }
        }
        if constexpr (ALIGN_EPI) { if (wr == 0) PG8_BAR; }
        if constexpr (!Epi::AFTER_DRAIN) { E(acc, cur, wr, wc, fr, fq); S.done(cur); }
        if (!has_next) break;
#pragma unroll
        for (int a = 0; a < 2; ++a)
#pragma unroll
            for (int b = 0; b < 2; ++b)
#pragma unroll
                for (int m = 0; m < 4; ++m)
#pragma unroll
                    for (int n = 0; n < 2; ++n) acc[a][b][m][n] = (f32x4){0.f, 0.f, 0.f, 0.f};
        cur = nxt; cA = nA; cB = nB; ++ui;
        if constexpr (ALIGN_EPI) { if (wr == 1) PG8_BAR; }
    }
    PG8_WAIT_V(0);
    if constexpr (!ALIGN_EPI) { if (wr == 0) PG8_BAR; }
    PG8_BAR;
    if constexpr (Epi::AFTER_DRAIN) { E.fused(acc, cur, wr, wc, fr, fq, lds, wid, lane); S.done(cur); }
#undef PG8_SA
#undef PG8_SB
#undef PG8_STAGE
#undef PG8_LDA
#undef PG8_LDB
#undef PG8_MMA
#undef PG8_WAIT_V
#undef PG8_WAIT_L
#undef PG8_BAR
#undef PG8_SCHED
}
}

constexpr int DM = 4096, NBATCH = 2, SEQ = 8192, DEPTH = 4, CTXL = 256;
constexpr int NLAT = NBATCH * SEQ, NCTX = NBATCH * CTXL, MROWS = NLAT + NCTX;
constexpr int NIN = 13568, GWD = 1024;
constexpr int C_POOLV = 0, C_POOLZ = 1024, C_NAQ = 2048, C_NAK = 3072, C_NAV = 4096, C_NAZ = 5120, C_RWR = 6144, C_RWK = 7168, C_RWV = 8192, C_RWZ = 9216,
              C_RWWD = 10240, C_RWAD = 10368, C_SGU = 10496, C_SGV = 11520, C_SGZ = 12544;
constexpr int SCANLEN = CTXL + SEQ;
constexpr int NCHAIN = 64;
constexpr int RECF = 384;
constexpr int NWAVES = 8;

constexpr size_t MiB = 1u << 20;
constexpr size_t WS_CTL = 0, CTL_ZERO_BYTES = 1 * MiB;
constexpr size_t WS_MOD   = 2 * MiB;
constexpr size_t WS_TAB   = 3 * MiB;
constexpr size_t WS_SGST  = 4 * MiB;
constexpr size_t WS_BON   = 5 * MiB;
constexpr size_t WS_POOLWT= 8 * MiB;
constexpr size_t WS_WUPT  = 10 * MiB;
constexpr size_t WS_AUPT  = 11 * MiB;
constexpr size_t WS_SGW   = 12 * MiB;
constexpr size_t WS_VTC   = 13 * MiB;
constexpr size_t WS_HCTX  = 14 * MiB;
constexpr size_t WS_MODP  = 22 * MiB;
constexpr size_t WS_VTL   = 58 * MiB;
constexpr size_t WS_QN    = 90 * MiB;
constexpr size_t WS_KN    = 123 * MiB;
constexpr size_t WS_WOUTT = 156 * MiB;
constexpr size_t WS_WINT  = 284 * MiB;
constexpr size_t WS_XN    = 708 * MiB;
constexpr size_t WS_Y     = 840 * MiB;
constexpr size_t WS_P     = 972 * MiB;
constexpr size_t WS_YR    = 1410 * MiB;
constexpr size_t WS_REC   = 1542 * MiB;
constexpr size_t WS_END   = 2334 * MiB;
static_assert(WS_P + (size_t)MROWS * NIN * 2 <= WS_YR && WS_REC + (size_t)NCHAIN * SCANLEN * RECF * 4 <= WS_END && WS_WINT + (size_t)4 * NIN * DM * 2 <= WS_XN, "ws map");
constexpr int CW_TMO = 0, CW_BAR = 4096;

constexpr int RING_BYTES = 131072, LDSCTL_OFF = RING_BYTES, MISC_OFF = LDSCTL_OFF + 320, LDS_BYTES = 147456;

#define GAS __attribute__((address_space(1)))
#define LAS __attribute__((address_space(3)))
typedef unsigned short bf16;
typedef unsigned v4u __attribute__((ext_vector_type(4)));
typedef unsigned v2u __attribute__((ext_vector_type(2)));
typedef float f32x4 __attribute__((ext_vector_type(4)));
typedef float f32x2 __attribute__((ext_vector_type(2)));
typedef short bf16x8 __attribute__((ext_vector_type(8)));
#define RLX_AGENT __ATOMIC_RELAXED, __HIP_MEMORY_SCOPE_AGENT
#define LDS_WAIT() asm volatile("s_waitcnt lgkmcnt(0)" ::: "memory")

__device__ __forceinline__ float bf2f(unsigned short h) { return __uint_as_float(((unsigned)h) << 16); }
__device__ __forceinline__ float bflo(unsigned w) { return __uint_as_float(w << 16); }
__device__ __forceinline__ float bfhi(unsigned w) { return __uint_as_float(w & 0xffff0000u); }
__device__ __forceinline__ unsigned f2bf(float f) { unsigned u = __float_as_uint(f); return (u + 0x7fffu + ((u >> 16) & 1u)) >> 16; }
__device__ __forceinline__ unsigned pk2(float lo, float hi) { return f2bf(lo) | (f2bf(hi) << 16); }
__device__ __forceinline__ void unpack8(const v4u w, float* x) { x[0] = bflo(w.x); x[1] = bfhi(w.x); x[2] = bflo(w.y); x[3] = bfhi(w.y); x[4] = bflo(w.z); x[5] = bfhi(w.z); x[6] = bflo(w.w); x[7] = bfhi(w.w); }
__device__ __forceinline__ v4u pack8(const float* x) { v4u w; w.x = pk2(x[0], x[1]); w.y = pk2(x[2], x[3]); w.z = pk2(x[4], x[5]); w.w = pk2(x[6], x[7]); return w; }
__device__ __forceinline__ float silu_f(float x) { return x / (1.f + __expf(-x)); }
__device__ __forceinline__ float wave_sum(float v) {
#pragma unroll
    for (int o = 1; o < 64; o <<= 1) v += __shfl_xor(v, o);
    return v;
}
template <int CTRL> __device__ __forceinline__ float dppf(float v) { return __builtin_bit_cast(float, __builtin_amdgcn_update_dpp(0, __builtin_bit_cast(int, v), CTRL, 0xF, 0xF, true)); }
__device__ __forceinline__ float red16(float v) { v += dppf<0xB1>(v); v += dppf<0x4E>(v); v += dppf<0x141>(v); v += dppf<0x140>(v); return v; }
__device__ __forceinline__ void red16x2(float& a, float& b) {
    a += dppf<0xB1>(a); b += dppf<0xB1>(b); a += dppf<0x4E>(a); b += dppf<0x4E>(b); a += dppf<0x141>(a); b += dppf<0x141>(b); a += dppf<0x140>(a); b += dppf<0x140>(b); }
__device__ __forceinline__ float max16x4(float v) { v = fmaxf(v, __shfl_xor(v, 16)); v = fmaxf(v, __shfl_xor(v, 32)); return v; }
__device__ __forceinline__ float sum16x4(float v) { v += __shfl_xor(v, 16); v += __shfl_xor(v, 32); return v; }
__device__ __forceinline__ int scan_pos(int d, bool isctx, int t) { return d == 0 ? (isctx ? t : CTXL + t) : (isctx ? (CTXL - 1 - t) : (CTXL + SEQ - 1 - t)); }
__device__ __forceinline__ f32x4 mfma16(bf16x8 a, bf16x8 b, f32x4 c) { return __builtin_amdgcn_mfma_f32_16x16x32_bf16(a, b, c, 0, 0, 0); }
__device__ __forceinline__ bf16x8 ld_frag(const bf16* p) { return __builtin_bit_cast(bf16x8, *(const v4u*)p); }

namespace pg8 {
struct EpiStoreBf16 {
    static constexpr bool PERM = true, AFTER_DRAIN = false;
    bf16_t* O; int ldc;
    __device__ __forceinline__ void operator()(const f32x4 (&acc)[2][2][4][2], const Unit& u, int wr, int wc, int fr, int fq) const {
        const int row0 = u.pm * BM + wr * 64 + fr, col0 = u.pn * BM + wc * 32 + 8 * fq;
#pragma unroll
        for (int ai = 0; ai < 2; ++ai)
#pragma unroll
            for (int m = 0; m < 4; ++m) { bf16_t* rowp = O + (size_t)(row0 + ai * HALF + m * 16) * ldc + col0;
#pragma unroll
                for (int bj = 0; bj < 2; ++bj) { const f32x4 v0 = acc[ai][bj][m][0], v1 = acc[ai][bj][m][1];
                    u32x4 w; w.x = cvt_pk_bf16(v0[0], v0[1]); w.y = cvt_pk_bf16(v0[2], v0[3]); w.z = cvt_pk_bf16(v1[0], v1[1]); w.w = cvt_pk_bf16(v1[2], v1[3]);
                    *(u32x4*)(rowp + bj * HALF) = w; } }
    }
};
struct EpiResGate {
    static constexpr bool PERM = false, AFTER_DRAIN = false;
    const float* hin_lat; const float* hin_ctx; float* hout_lat; float* hout_ctx; const float* gate;
    __device__ __forceinline__ void operator()(const f32x4 (&acc)[2][2][4][2], const Unit& u, int wr, int wc, int fr, int fq) const {
        const int cond = u.pm < 32 ? 0 : (u.pm < 64 ? 1 : 2);
        const int rloc = (u.pm < 64 ? u.pm * BM : (u.pm - 64) * BM) + wr * 64 + fr, col0 = u.pn * BM + wc * 32 + 4 * fq;
        const float* hin = u.pm < 64 ? hin_lat : hin_ctx; float* hout = u.pm < 64 ? hout_lat : hout_ctx;
        f32x4 gv[2][2];
#pragma unroll
        for (int bj = 0; bj < 2; ++bj)
#pragma unroll
            for (int n = 0; n < 2; ++n) gv[bj][n] = *(const f32x4*)(gate + cond * 12288 + 8192 + col0 + bj * HALF + n * 16);
#pragma unroll
        for (int ai = 0; ai < 2; ++ai)
#pragma unroll
            for (int m = 0; m < 4; ++m) { const size_t off = (size_t)(rloc + ai * HALF + m * 16) * 4096 + col0;
#pragma unroll
                for (int bj = 0; bj < 2; ++bj)
#pragma unroll
                    for (int n = 0; n < 2; ++n) { const f32x4 b = *(const f32x4*)(hin + off + bj * HALF + n * 16);
                        *(f32x4*)(hout + off + bj * HALF + n * 16) = b + gv[bj][n] * acc[ai][bj][m][n]; } }
    }
};
}

__device__ __forceinline__ void p0_transpose_item(const float* W, int K, int N, bf16* WT, LAS float* scr, int item, int lane) {
    const int nblk = N / 32, kb = item / nblk, nb = item % nblk, k0 = 64 * kb, n0 = 32 * nb;
#pragma unroll 8
    for (int i = 0; i < 32; ++i) { const int kk = 2 * i + (lane >> 5); scr[kk * 33 + (lane & 31)] = W[(size_t)(k0 + kk) * N + n0 + (lane & 31)]; }
    LDS_WAIT(); asm volatile("" ::: "memory");
    const int c = lane & 7;
#pragma unroll
    for (int j = 0; j < 4; ++j) { const int n = (lane >> 3) + 8 * j; const LAS float* s = scr + (8 * c) * 33 + n;
        v4u o; o.x = pk2(s[0 * 33], s[1 * 33]); o.y = pk2(s[2 * 33], s[3 * 33]); o.z = pk2(s[4 * 33], s[5 * 33]); o.w = pk2(s[6 * 33], s[7 * 33]);
        *(v4u*)(WT + (size_t)(n0 + n) * K + k0 + 8 * c) = o; }
    LDS_WAIT(); asm volatile("" ::: "memory");
}
__device__ __forceinline__ void p0_mod_item(const float* wmod, const float* cvec, const float* cctx, float* MODP, LAS float* scr, int item, int lane) {
    const int l = item / (64 * 48), r = item % (64 * 48), kc = r / 48, nc = r % 48, k0 = kc * 64, n0 = nc * 256 + lane * 4;
    scr[lane] = silu_f(cvec[k0 + lane]); scr[64 + lane] = silu_f(cvec[4096 + k0 + lane]); scr[128 + lane] = silu_f(cctx[k0 + lane]);
    LDS_WAIT(); asm volatile("" ::: "memory");
    f32x4 a0 = {0.f, 0.f, 0.f, 0.f}, a1 = a0, a2 = a0;
    const float* wp = wmod + ((size_t)l * 4096 + k0) * 12288 + n0;
#pragma unroll 16
    for (int k = 0; k < 64; ++k) { const f32x4 w = *(const f32x4*)(wp + (size_t)k * 12288); a0 += scr[k] * w; a1 += scr[64 + k] * w; a2 += scr[128 + k] * w; }
    float* o = MODP + ((size_t)(l * 64 + kc) * 3) * 12288 + n0;
    *(f32x4*)(o) = a0; *(f32x4*)(o + 12288) = a1; *(f32x4*)(o + 2 * 12288) = a2;
    LDS_WAIT(); asm volatile("" ::: "memory");
}
__device__ __forceinline__ void sincos_acc(float ang, float& c, float& s) {
    const double x = (double)ang; const double n = __builtin_rint(x * 0.63661977236758134308); const double r = x - n * 1.57079632679489661923;
    const double r2 = r * r;
    const double sp = r * (1.0 + r2 * (-1.0 / 6 + r2 * (1.0 / 120 + r2 * (-1.0 / 5040 + r2 * (1.0 / 362880 + r2 * (-1.0 / 39916800 + r2 * (1.0 / 6227020800.0)))))));
    const double cp = 1.0 + r2 * (-0.5 + r2 * (1.0 / 24 + r2 * (-1.0 / 720 + r2 * (1.0 / 40320 + r2 * (-1.0 / 3628800 + r2 * (1.0 / 479001600 + r2 * (-1.0 / 87178291200.0)))))));
    const int q = ((int)n) & 3;
    const double cc = (q == 0) ? cp : (q == 1) ? -sp : (q == 2) ? -cp : sp;
    const double ss = (q == 0) ? sp : (q == 1) ? cp : (q == 2) ? -sp : -cp;
    c = (float)cc; s = (float)ss;
}

__device__ __forceinline__ void phase_xn(const float* hlat, const float* hctx, const float* mod, bf16* XN, int gw, int NGW, int lane) {
    for (int m = gw; m < MROWS; m += NGW) {
        const float* src = m < NLAT ? hlat + (size_t)m * DM : hctx + (size_t)(m - NLAT) * DM;
        const int cond = m < NLAT ? (m >> 13) : 2;
        const f32x4* s4 = (const f32x4*)src + lane;
        f32x4 v[16]; float ss = 0.f;
#pragma unroll
        for (int j = 0; j < 16; ++j) { v[j] = s4[64 * j]; ss += (v[j].x * v[j].x + v[j].y * v[j].y) + (v[j].z * v[j].z + v[j].w * v[j].w); }
        ss = wave_sum(ss);
        const float rstd = 1.0f / sqrtf(ss * (1.f / 4096.f) + 1e-6f);
        const f32x4* sh4 = (const f32x4*)(mod + cond * 12288) + lane; const f32x4* sc4 = (const f32x4*)(mod + cond * 12288 + 4096) + lane;
        v2u* o = (v2u*)(XN + (size_t)m * DM) + lane;
#pragma unroll
        for (int j = 0; j < 16; ++j) { const f32x4 sh = sh4[64 * j], sc = sc4[64 * j]; const f32x4 x = v[j] * rstd * (sc + 1.f) + sh; v2u w; w.x = pk2(x.x, x.y); w.y = pk2(x.z, x.w); o[64 * j] = w; }
    }
}

__device__ __forceinline__ void phase_rowprep(const bf16* P, const float* qgain, const float* kgain, const f32x2* tab, bf16* QN, bf16* KN, f32x2* SGST, int gw, int NGW, int lane) {
    const int sub = lane & 3;
    for (int m = gw; m < MROWS; m += NGW) {
        const bf16* pr = P + (size_t)m * NIN;
        const bool isctx = m >= NLAT; const int t = isctx ? ((m - NLAT) & 255) : (m & 8191);
        {   float x[16]; unpack8(*(const v4u*)(pr + C_SGV + 16 * lane), x); unpack8(*(const v4u*)(pr + C_SGV + 16 * lane + 8), x + 8);
            float s = 0.f;
#pragma unroll
            for (int i = 0; i < 16; ++i) s += x[i];
            const float mean = wave_sum(s) * (1.f / 1024.f); float q = 0.f;
#pragma unroll
            for (int i = 0; i < 16; ++i) { const float dlt = x[i] - mean; q += dlt * dlt; }
            const float var = wave_sum(q) * (1.f / 1024.f);
            if (lane == 0) SGST[m] = (f32x2){mean, 1.0f / sqrtf(var + 1e-5f)}; }
        float q[16], k[16];
        unpack8(*(const v4u*)(pr + C_NAQ + 16 * lane), q); unpack8(*(const v4u*)(pr + C_NAQ + 16 * lane + 8), q + 8);
        unpack8(*(const v4u*)(pr + C_NAK + 16 * lane), k); unpack8(*(const v4u*)(pr + C_NAK + 16 * lane + 8), k + 8);
        float sq = 0.f, sk = 0.f;
#pragma unroll
        for (int i = 0; i < 16; ++i) { sq += q[i] * q[i]; sk += k[i] * k[i]; }
        sq += __shfl_xor(sq, 1); sq += __shfl_xor(sq, 2); sk += __shfl_xor(sk, 1); sk += __shfl_xor(sk, 2);
        const float rq = 1.0f / sqrtf(sq * (1.f / 64.f) + 1e-6f), rk = 1.0f / sqrtf(sk * (1.f / 64.f) + 1e-6f);
#pragma unroll
        for (int i = 0; i < 16; ++i) { q[i] *= rq * qgain[16 * sub + i]; k[i] *= rk * kgain[16 * sub + i]; }
        if (!isctx) {
            const int pos = sub < 2 ? (t >> 6) : (t & 63);
#pragma unroll
            for (int i = 0; i < 16; ++i) { const f32x2 cs = tab[pos * 16 + i]; const float pq = __shfl_xor(q[i], 1), pkk = __shfl_xor(k[i], 1);
                q[i] = (sub & 1) ? (q[i] * cs.x + pq * cs.y) : (q[i] * cs.x - pq * cs.y);
                k[i] = (sub & 1) ? (k[i] * cs.x + pkk * cs.y) : (k[i] * cs.x - pkk * cs.y); }
        }
#pragma unroll
        for (int i = 0; i < 16; ++i) q[i] *= 0.125f;
        *(v4u*)(QN + (size_t)m * GWD + 16 * lane) = pack8(q); *(v4u*)(QN + (size_t)m * GWD + 16 * lane + 8) = pack8(q + 8);
        *(v4u*)(KN + (size_t)m * GWD + 16 * lane) = pack8(k); *(v4u*)(KN + (size_t)m * GWD + 16 * lane + 8) = pack8(k + 8);
    }
}
__device__ __forceinline__ void phase_vt(const bf16* P, bf16* VTL, bf16* VTC, int gw, int NGW, int lane) {
    for (int u = gw; u < (MROWS / 64) * 16; u += NGW) {
        const int tt = u >> 4, h = u & 15, m0 = tt * 64;
        const bf16* src = P + (size_t)m0 * NIN + C_NAV + h * 64 + lane;
        unsigned w[32];
#pragma unroll
        for (int i = 0; i < 32; ++i) { const unsigned lo = src[(size_t)(2 * i) * NIN], hi = src[(size_t)(2 * i + 1) * NIN]; w[i] = lo | (hi << 16); }
        bf16* dst = tt < 256 ? VTL + (((size_t)((tt >> 7) * 16 + h) * 64 + lane) * 8192 + (tt & 127) * 64)
                             : VTC + (((size_t)(((tt - 256) >> 2) * 16 + h) * 64 + lane) * 256 + ((tt - 256) & 3) * 64);
#pragma unroll
        for (int j = 0; j < 8; ++j) { v4u o; o.x = w[4 * j]; o.y = w[4 * j + 1]; o.z = w[4 * j + 2]; o.w = w[4 * j + 3]; ((v4u*)dst)[j] = o; }
    }
}
template <int G>
__device__ __forceinline__ void pool_unit(const bf16* P, const bf16* wbase, const float* pscale, bf16* Y, int m0, int lane) {
    constexpr int WIN = 2 << G;
    const int r = lane & 15, q4 = lane >> 4, m = m0 + r;
    const bool isctx = m0 >= NLAT; const int T = isctx ? CTXL : SEQ; const int t = isctx ? ((m - NLAT) & 255) : (m & 8191);
    const int tlo = t - (WIN >> 1);
    const int lo = tlo < 0 ? 0 : tlo, hi = (tlo + WIN) > T ? T : (tlo + WIN);
    const float inv = 1.0f / (float)(hi - lo);
    f32x4 acc[16];
#pragma unroll
    for (int nt = 0; nt < 16; ++nt) acc[nt] = (f32x4){0.f, 0.f, 0.f, 0.f};
#pragma unroll 1
    for (int ks = 0; ks < 8; ++ks) {
        const int ch0 = C_POOLV + G * 256 + 32 * ks + 8 * q4;
        constexpr int WB = WIN < 8 ? WIN : 8;
        bf16x8 bfr[8];
        float sum[8];
#pragma unroll
        for (int j = 0; j < 8; ++j) sum[j] = 0.f;
        const v4u selfw = *(const v4u*)(P + (size_t)m * NIN + ch0);
#pragma unroll
        for (int nt = 0; nt < 8; ++nt) bfr[nt] = ld_frag(wbase + (size_t)(16 * nt + r) * 256 + 32 * ks + 8 * q4);
#pragma unroll
        for (int k0 = 0; k0 < WIN; k0 += WB) {
            v4u wl[WB];
#pragma unroll
            for (int k = 0; k < WB; ++k) { const int tk = tlo + k0 + k; const bool ok = tk >= 0 && tk < T; wl[k] = *(const v4u*)(P + (size_t)(ok ? (m - t + tk) : m) * NIN + ch0); }
            __builtin_amdgcn_sched_barrier(0);
#pragma unroll
            for (int k = 0; k < WB; ++k) { const int tk = tlo + k0 + k; const bool ok = tk >= 0 && tk < T; float x[8]; unpack8(wl[k], x);
#pragma unroll
                for (int j = 0; j < 8; ++j) sum[j] += ok ? x[j] : 0.f; }
            __builtin_amdgcn_sched_barrier(0);
        }
        float self[8]; unpack8(selfw, self);
        float dv[8];
#pragma unroll
        for (int j = 0; j < 8; ++j) dv[j] = sum[j] * inv - self[j];
        const bf16x8 af = __builtin_bit_cast(bf16x8, pack8(dv));
        __builtin_amdgcn_sched_barrier(0);
        bf16x8 bfr2[8];
#pragma unroll
        for (int nt = 0; nt < 8; ++nt) bfr2[nt] = ld_frag(wbase + (size_t)(16 * (nt + 8) + r) * 256 + 32 * ks + 8 * q4);
        __builtin_amdgcn_sched_barrier(0);
#pragma unroll
        for (int nt = 0; nt < 8; ++nt) acc[nt] = mfma16(af, bfr[nt], acc[nt]);
        __builtin_amdgcn_sched_barrier(0);
#pragma unroll
        for (int nt = 0; nt < 8; ++nt) acc[nt + 8] = mfma16(af, bfr2[nt], acc[nt + 8]);
        __builtin_amdgcn_sched_barrier(0);
    }
#pragma unroll
    for (int nh = 0; nh < 4; ++nh) {
        unsigned short zz[4][4]; float ps[4];
#pragma unroll
        for (int nq = 0; nq < 4; ++nq) { const int oc = G * 256 + 16 * (4 * nh + nq) + r; ps[nq] = pscale[oc];
#pragma unroll
            for (int i = 0; i < 4; ++i) zz[nq][i] = P[(size_t)(m0 + 4 * q4 + i) * NIN + C_POOLZ + oc]; }
        __builtin_amdgcn_sched_barrier(0);
#pragma unroll
        for (int nq = 0; nq < 4; ++nq) { const int oc = G * 256 + 16 * (4 * nh + nq) + r;
#pragma unroll
            for (int i = 0; i < 4; ++i) Y[(size_t)(m0 + 4 * q4 + i) * DM + oc] = (bf16)f2bf(acc[4 * nh + nq][i] * ps[nq] * silu_f(bf2f(zz[nq][i]))); }
        __builtin_amdgcn_sched_barrier(0);
    }
}
__device__ __forceinline__ void phase_pool(const bf16* P, const bf16* PWT  , const float* pscale, bf16* Y, int nrows, int gw, int NGW, int lane) {
    for (int u = gw; u < (nrows / 16) * 4; u += NGW) {
        const int tt = u >> 2, g = u & 3, m0 = tt * 16;
        const bf16* wbase = PWT + (size_t)g * 65536;
        if (g == 0) pool_unit<0>(P, wbase, pscale, Y, m0, lane);
        else if (g == 1) pool_unit<1>(P, wbase, pscale, Y, m0, lane);
        else if (g == 2) pool_unit<2>(P, wbase, pscale, Y, m0, lane);
        else pool_unit<3>(P, wbase, pscale, Y, m0, lane);
    }
}
__device__ __forceinline__ void phase_rwprep(const bf16* P, const float* mu_rkv  , const float* mu_lora  , const float* w0  , const bf16* WUPT  ,
                                             const float* a0, const bf16* AUPT, const float* k_k, const float* k_a, const float* r_k, float* REC, float* BON, int gw, int NGW, int lane) {
    const int r = lane & 15, q4 = lane >> 4;
    for (int u = gw; u < (MROWS / 16) * 16; u += NGW) {
        const int tt = u >> 4, d = (u >> 3) & 1, hp = u & 7, m0 = tt * 16;
        const bool isctx = m0 >= NLAT; const int T = isctx ? CTXL : SEQ; const int t0 = isctx ? ((m0 - NLAT) & 255) : (m0 & 8191); const int b = isctx ? ((m0 - NLAT) >> 8) : (m0 >> 13);
        bf16x8 Aw[2], Aa[2];
        {   const int mA = m0 + r, tA = t0 + r; const bool hasnb = d == 0 ? (tA > 0) : (tA < T - 1); const int nbA = hasnb ? (d == 0 ? mA - 1 : mA + 1) : mA;
            v4u cw[2], nw[2], ca[2], na[2];
#pragma unroll
            for (int ks = 0; ks < 2; ++ks) { const int j0 = 32 * ks + 8 * q4;
                cw[ks] = *(const v4u*)(P + (size_t)mA * NIN + C_RWWD + d * 64 + j0); nw[ks] = *(const v4u*)(P + (size_t)nbA * NIN + C_RWWD + d * 64 + j0);
                ca[ks] = *(const v4u*)(P + (size_t)mA * NIN + C_RWAD + d * 64 + j0); na[ks] = *(const v4u*)(P + (size_t)nbA * NIN + C_RWAD + d * 64 + j0); }
            __builtin_amdgcn_sched_barrier(0);
#pragma unroll
            for (int ks = 0; ks < 2; ++ks) { const int j0 = 32 * ks + 8 * q4;
                float cur[8], nb[8], o[8];
                unpack8(cw[ks], cur); unpack8(nw[ks], nb);
#pragma unroll
                for (int j = 0; j < 8; ++j) o[j] = tanhf(cur[j] + ((hasnb ? nb[j] : 0.f) - cur[j]) * mu_lora[(d * 2 + 0) * 64 + j0 + j]);
                Aw[ks] = __builtin_bit_cast(bf16x8, pack8(o));
                unpack8(ca[ks], cur); unpack8(na[ks], nb);
#pragma unroll
                for (int j = 0; j < 8; ++j) o[j] = cur[j] + ((hasnb ? nb[j] : 0.f) - cur[j]) * mu_lora[(d * 2 + 1) * 64 + j0 + j];
                Aa[ks] = __builtin_bit_cast(bf16x8, pack8(o)); }
        }
#pragma unroll 1
        for (int hh = 0; hh < 2; ++hh) {
            const int head = hp * 2 + hh;
            float KK[4][4], Av[4][4];
            float ss[4] = {0.f, 0.f, 0.f, 0.f}, bon[4] = {0.f, 0.f, 0.f, 0.f};
            const int chain = (b * 2 + d) * 16 + head;
            const int pos0 = scan_pos(d, isctx, t0 + 4 * q4), dpos = d == 0 ? 1 : -1;
            float* const rec0 = REC + ((size_t)chain * SCANLEN + pos0) * RECF + r;
            const int tq = t0 + 4 * q4; const bool evalid = d == 0 ? (tq > 0) : (tq + 4 < T); const int erow = evalid ? (d == 0 ? m0 + 4 * q4 - 1 : m0 + 4 * q4 + 4) : (m0 + 4 * q4);
#pragma unroll
            for (int n4 = 0; n4 < 4; ++n4) {
                const int ch = head * 64 + 16 * n4 + r;
                const bf16x8 bw0 = ld_frag(WUPT + (size_t)(d * 1024 + ch) * 64 + 8 * q4), bw1 = ld_frag(WUPT + (size_t)(d * 1024 + ch) * 64 + 32 + 8 * q4);
                const bf16x8 ba0 = ld_frag(AUPT + (size_t)(d * 1024 + ch) * 64 + 8 * q4), ba1 = ld_frag(AUPT + (size_t)(d * 1024 + ch) * 64 + 32 + 8 * q4);
                const float w0v = w0[d * 1024 + ch], a0v = a0[d * 1024 + ch], mur = mu_rkv[(d * 3 + 0) * 1024 + ch], muk = mu_rkv[(d * 3 + 1) * 1024 + ch], muv = mu_rkv[(d * 3 + 2) * 1024 + ch];
                const float kkv = k_k[ch], kav = k_a[ch], rkv = r_k[ch];
                unsigned short rcu[5], kcu[5], vcu[5];
#pragma unroll
                for (int i = 0; i < 5; ++i) { const bf16* pc = P + (size_t)(i < 4 ? m0 + 4 * q4 + i : erow) * NIN + ch; rcu[i] = pc[C_RWR]; kcu[i] = pc[C_RWK]; vcu[i] = pc[C_RWV]; }
                __builtin_amdgcn_sched_barrier(0);
                f32x4 accW = {0.f, 0.f, 0.f, 0.f}, accA = accW;
                accW = mfma16(Aw[0], bw0, accW); accW = mfma16(Aw[1], bw1, accW); accA = mfma16(Aa[0], ba0, accA); accA = mfma16(Aa[1], ba1, accA);
                float rcf[5], kcf[5], vcf[5];
#pragma unroll
                for (int i = 0; i < 5; ++i) { rcf[i] = bf2f(rcu[i]); kcf[i] = bf2f(kcu[i]); vcf[i] = bf2f(vcu[i]); }
                if (!evalid) { rcf[4] = 0.f; kcf[4] = 0.f; vcf[4] = 0.f; }
#pragma unroll
                for (int i = 0; i < 4; ++i) {
                    constexpr int dummy_ = 0; (void)dummy_;
                    const int ip = i > 0 ? i - 1 : 4, in_ = i < 3 ? i + 1 : 4;
                    const float rc = rcf[i], kc = kcf[i], vc = vcf[i];
                    const float rn = d == 0 ? rcf[ip] : rcf[in_], kn = d == 0 ? kcf[ip] : kcf[in_], vn = d == 0 ? vcf[ip] : vcf[in_];
                    const float rr = rc + (rn - rc) * mur, kk0 = kc + (kn - kc) * muk, vv = vc + (vn - vc) * muv;
                    const float xw = -(w0v + accW[i]);
                    const float sp = fmaxf(xw, 0.f) + log1pf(__expf(-fabsf(xw)));
                    const float dec = __expf(-__expf(-sp - 0.5f));
                    const float av = 1.0f / (1.0f + __expf(-(a0v + accA[i])));
                    const float kx = kk0 * kkv; ss[i] += kx * kx;
                    const float kp = kk0 * (1.f + (av - 1.f) * kav); bon[i] += rr * kp * rkv;
                    KK[n4][i] = kx; Av[n4][i] = av;
                    float* o = rec0 + (ptrdiff_t)(i * dpos) * RECF + 16 * n4;
                    o[0] = dec; o[192] = kp; o[256] = rr; o[320] = vv; }
                __builtin_amdgcn_sched_barrier(0);
            }
#pragma unroll
            for (int i = 0; i < 4; ++i) { const float s = red16(ss[i]), bo = red16(bon[i]); const float inv = 1.0f / sqrtf(fmaxf(s, 1e-12f));
                float* rec = rec0 + (ptrdiff_t)(i * dpos) * RECF;
#pragma unroll
                for (int n4 = 0; n4 < 4; ++n4) { const float kkn = KK[n4][i] * inv; rec[16 * n4 + 64] = kkn; rec[16 * n4 + 128] = -(kkn * Av[n4][i]); }
                if (r == 0) BON[(size_t)chain * SCANLEN + pos0 + i * dpos] = bo; }
        }
    }
}
template <bool CTXQ>
__device__ __forceinline__ void na_unit(const bf16* QN, const bf16* KN, const bf16* VTL, const bf16* VTC, const bf16* P, const float* rpb  , bf16* Y, int u, int lane) {
    const int n = lane & 15, q4 = lane >> 4;
    int b, h, qrow0, qr = 0, jt = 0;
    if (CTXQ) { b = u >> 8; h = (u >> 4) & 15; qrow0 = NLAT + b * CTXL + 16 * (u & 15); }
    else { jt = u & 3; h = (u >> 2) & 15; qr = (u >> 6) & 127; b = u >> 13; qrow0 = b * SEQ + qr * 64 + 16 * jt; }
    constexpr int NT = CTXQ ? 16 : 32, WT = CTXQ ? 0 : 16;
    f32x4 s[NT];
    const int rs = qr - 4 < 0 ? 0 : (qr - 4 > 120 ? 120 : qr - 4);
    const int span0 = jt == 0 ? 0 : (jt == 1 ? 8 : (jt == 2 ? 24 : 32));
    const int qc = 16 * jt + n; const int cs = qc - 8 < 0 ? 0 : (qc - 8 > 48 ? 48 : qc - 8);
    bf16x8 qf[2];
#pragma unroll
    for (int ks = 0; ks < 2; ++ks) qf[ks] = ld_frag(QN + (size_t)(qrow0 + n) * GWD + h * 64 + 32 * ks + 8 * q4);
    if (!CTXQ) {
        const float* rp = rpb + (size_t)h * 15 * 31;
#pragma unroll
        for (int wt = 0; wt < 16; ++wt) { const int kri = wt >> 1, half = wt & 1, relr = rs + kri - qr + 7;
#pragma unroll
            for (int i = 0; i < 4; ++i) { const int relc = span0 + 16 * half + 4 * q4 + i - qc + 15; const int relcc = relc < 0 ? 0 : (relc > 30 ? 30 : relc); s[wt][i] = rp[relr * 31 + relcc]; } }
        __builtin_amdgcn_sched_barrier(0);
#pragma unroll
        for (int bt = 0; bt < 2; ++bt) {
            bf16x8 kf[16];
#pragma unroll
            for (int t = 0; t < 8; ++t) { const int wt = bt * 8 + t, kri = wt >> 1, half = wt & 1;
                const bf16* kp = KN + (size_t)(b * SEQ + (rs + kri) * 64 + span0 + 16 * half + n) * GWD + h * 64 + 8 * q4; kf[2 * t] = ld_frag(kp); kf[2 * t + 1] = ld_frag(kp + 32); }
            __builtin_amdgcn_sched_barrier(0);
#pragma unroll
            for (int t = 0; t < 8; ++t) { const int wt = bt * 8 + t, half = wt & 1;
                f32x4 a = s[wt];
#pragma unroll
                for (int i = 0; i < 4; ++i) { const int kc = span0 + 16 * half + 4 * q4 + i; const bool ok = kc >= cs && kc < cs + 16; a[i] = ok ? a[i] : -INFINITY; }
                a = mfma16(kf[2 * t], qf[0], a); a = mfma16(kf[2 * t + 1], qf[1], a); s[wt] = a; }
            __builtin_amdgcn_sched_barrier(0);
        }
    }
#pragma unroll
    for (int bt = 0; bt < 2; ++bt) {
        bf16x8 kf[16];
#pragma unroll
        for (int t = 0; t < 8; ++t) { const bf16* kp = KN + (size_t)(NLAT + b * CTXL + 16 * (bt * 8 + t) + n) * GWD + h * 64 + 8 * q4; kf[2 * t] = ld_frag(kp); kf[2 * t + 1] = ld_frag(kp + 32); }
        __builtin_amdgcn_sched_barrier(0);
#pragma unroll
        for (int t = 0; t < 8; ++t) { f32x4 a = {0.f, 0.f, 0.f, 0.f}; a = mfma16(kf[2 * t], qf[0], a); a = mfma16(kf[2 * t + 1], qf[1], a); s[WT + bt * 8 + t] = a; }
        __builtin_amdgcn_sched_barrier(0);
    }
    float mx = -INFINITY;
#pragma unroll
    for (int t = 0; t < NT; ++t) mx = fmaxf(fmaxf(fmaxf(s[t][0], s[t][1]), fmaxf(s[t][2], s[t][3])), mx);
    mx = max16x4(mx);
    float sum = 0.f;
#pragma unroll
    for (int t = 0; t < NT; ++t) {
#pragma unroll
        for (int i = 0; i < 4; ++i) { const float e = __expf(s[t][i] - mx); s[t][i] = e; sum += e; } }
    sum = sum16x4(sum);
    const float inv = 1.0f / sum;
    f32x4 o[4];
#pragma unroll
    for (int nt = 0; nt < 4; ++nt) o[nt] = (f32x4){0.f, 0.f, 0.f, 0.f};
#pragma unroll
    for (int tb = 0; tb < NT / 8; ++tb) {
        v2u vv[4][4][2];
#pragma unroll
        for (int tq = 0; tq < 4; ++tq) { const int tp = tb * 4 + tq;
            const bf16* vb; size_t dstride;
            if (!CTXQ && tp < 8) { vb = VTL + ((size_t)(b * 16 + h) * 64 + n) * 8192 + (rs + tp) * 64 + span0 + 4 * q4; dstride = (size_t)16 * 8192; }
            else { const int ct = 2 * (tp - (CTXQ ? 0 : 8)); vb = VTC + ((size_t)(b * 16 + h) * 64 + n) * 256 + 16 * ct + 4 * q4; dstride = (size_t)16 * 256; }
#pragma unroll
            for (int nt = 0; nt < 4; ++nt) { vv[tq][nt][0] = *(const v2u*)(vb + nt * dstride); vv[tq][nt][1] = *(const v2u*)(vb + nt * dstride + 16); } }
        __builtin_amdgcn_sched_barrier(0);
#pragma unroll
        for (int tq = 0; tq < 4; ++tq) { const int tp = tb * 4 + tq;
            const f32x4 p0 = s[2 * tp] * inv, p1 = s[2 * tp + 1] * inv;
            v4u aw; aw.x = pk2(p0[0], p0[1]); aw.y = pk2(p0[2], p0[3]); aw.z = pk2(p1[0], p1[1]); aw.w = pk2(p1[2], p1[3]);
            const bf16x8 af = __builtin_bit_cast(bf16x8, aw);
#pragma unroll
            for (int nt = 0; nt < 4; ++nt) { v4u bw; bw.x = vv[tq][nt][0].x; bw.y = vv[tq][nt][0].y; bw.z = vv[tq][nt][1].x; bw.w = vv[tq][nt][1].y;
                o[nt] = mfma16(af, __builtin_bit_cast(bf16x8, bw), o[nt]); } }
        __builtin_amdgcn_sched_barrier(0);
    }
    unsigned short zz[4][4];
#pragma unroll
    for (int nt = 0; nt < 4; ++nt)
#pragma unroll
        for (int i = 0; i < 4; ++i) zz[nt][i] = P[(size_t)(qrow0 + 4 * q4 + i) * NIN + C_NAZ + h * 64 + 16 * nt + n];
    __builtin_amdgcn_sched_barrier(0);
#pragma unroll
    for (int nt = 0; nt < 4; ++nt)
#pragma unroll
        for (int i = 0; i < 4; ++i) { const int row = qrow0 + 4 * q4 + i, col = h * 64 + 16 * nt + n;
            Y[(size_t)row * DM + 1024 + col] = (bf16)f2bf(o[nt][i] * silu_f(bf2f(zz[nt][i]))); }
}
__device__ __forceinline__ void phase_sgu(const bf16* P, const f32x2* SGST, const float* lnw, const float* lnb, const bf16* SGW  , const float* sgb  , bf16* Y,
                                          LAS unsigned char* lds, int nchunks, int tid, int wave, int lane) {
    const int n = lane & 15, q4 = lane >> 4;
    LAS bf16* T = (LAS bf16*)lds;
    for (int u = blockIdx.x; u < nchunks * 8; u += 256) {
        const int ck = u >> 3, g = u & 7, m0 = ck * 128;
#pragma unroll
        for (int it = 0; it < 4; ++it) { const int idx = tid + 512 * it, q = idx >> 4, c8 = idx & 15;
            float x[8]; unpack8(*(const v4u*)(P + (size_t)(m0 + q) * NIN + C_SGV + g * 128 + 8 * c8), x);
            const f32x2 st = SGST[m0 + q];
#pragma unroll
            for (int j = 0; j < 8; ++j) { const int c = 8 * c8 + j; const float v = (x[j] - st.x) * st.y * lnw[g * 128 + c] + lnb[g * 128 + c]; T[c * 136 + q] = (bf16)f2bf(v); } }
        __syncthreads();
        bf16x8 af[4];
#pragma unroll
        for (int ks = 0; ks < 4; ++ks) af[ks] = ld_frag(SGW + ((size_t)g * 128 + 16 * wave + n) * 128 + 32 * ks + 8 * q4);
#pragma unroll
        for (int nt = 0; nt < 8; ++nt) {
            f32x4 acc = {0.f, 0.f, 0.f, 0.f};
#pragma unroll
            for (int ks = 0; ks < 4; ++ks) { const bf16x8 bfg = *(const LAS bf16x8*)(T + (16 * nt + n) * 136 + 32 * ks + 8 * q4); acc = mfma16(af[ks], bfg, acc); }
#pragma unroll
            for (int i = 0; i < 4; ++i) { const int p = 16 * wave + 4 * q4 + i, row = m0 + p, col = g * 128 + 16 * nt + n;
                const float mixed = acc[i] + sgb[g * 128 + p]; const bf16* pr = P + (size_t)row * NIN;
                const float uu = bf2f(pr[C_SGU + col]), z = bf2f(pr[C_SGZ + col]);
                Y[(size_t)row * DM + 3072 + col] = (bf16)f2bf(uu * mixed * silu_f(z)); }
        }
        __syncthreads();
    }
}
__device__ __forceinline__ void phase_scan(const float* REC, float* YR, LAS unsigned char* lds, int wave, int lane) {
    constexpr int NCH = SCANLEN / 16, SLOT = 16 * RECF * 4;
    for (int su = blockIdx.x; su < NCHAIN * 4; su += 256) {
        const int chain = (su & 7) * 8 + ((su >> 3) >> 2), part = (su >> 3) & 3;
        const char* recb = (const char*)(REC + (size_t)chain * SCANLEN * RECF);
        if (wave >= 4) {
            const int wl = wave - 4;
#define SCAN_ISSUE(cc, sl) do { _Pragma("unroll") for (int p_ = 0; p_ < 6; ++p_) \
            __builtin_amdgcn_global_load_lds((const unsigned*)(recb + (size_t)(cc) * SLOT + (wl * 6 + p_) * 1024 + lane * 16), (LAS unsigned*)(lds + (sl) * SLOT + (wl * 6 + p_) * 1024), 16, 0, 0); } while (0)
            SCAN_ISSUE(0, 0); SCAN_ISSUE(1, 1); SCAN_ISSUE(2, 2);
            for (int c = 0; c < NCH; ++c) {
                asm volatile("s_waitcnt vmcnt(12)" ::: "memory");
                __builtin_amdgcn_s_barrier();
                const int cc = c + 3 < NCH ? c + 3 : NCH - 1;
                SCAN_ISSUE(cc, (c + 3) & 3);
            }
            asm volatile("s_waitcnt vmcnt(0)" ::: "memory");
#undef SCAN_ISSUE
        } else {
            const int c16 = lane & 15, rg = lane >> 4, row = 16 * part + 4 * wave + rg;
            f32x2 Sa = {0.f, 0.f}, Sb = {0.f, 0.f};
            float* yout = YR + (size_t)chain * SCANLEN * 64 + row;
            const int lo_c = c16 * 16, lo_v = 1280 + row * 4;
#define SCAN_LD(dst, sl, s_) do { const LAS unsigned char* rec_ = (sl) + (s_) * (RECF * 4); dst##w = *(const LAS f32x4*)(rec_ + lo_c); dst##kk = *(const LAS f32x4*)(rec_ + 256 + lo_c); \
            dst##na = *(const LAS f32x4*)(rec_ + 512 + lo_c); dst##k = *(const LAS f32x4*)(rec_ + 768 + lo_c); dst##r = *(const LAS f32x4*)(rec_ + 1024 + lo_c); dst##v = *(const LAS float*)(rec_ + lo_v); } while (0)
            for (int c = 0; c < NCH; ++c) {
                __builtin_amdgcn_s_barrier();
                asm volatile("" ::: "memory");
                const LAS unsigned char* slot = lds + (c & 3) * SLOT;
                float ysave = 0.f, ypend = 0.f;
                f32x4 Aw, Akk, Ana, Ak, Ar; float Av;
                SCAN_LD(A, slot, 0);
#pragma unroll
                for (int s = 0; s < 16; ++s) {
                    f32x4 Bw, Bkk, Bna, Bk, Br; float Bv;
                    if (s < 15) SCAN_LD(B, slot, s + 1);
                    __builtin_amdgcn_sched_barrier(0);
                    f32x2 p = Sa * (f32x2){Akk.x, Akk.y}; p = __builtin_elementwise_fma(Sb, (f32x2){Akk.z, Akk.w}, p);
                    float dt = p.x + p.y, yr = ypend; red16x2(dt, yr);
                    const f32x2 vv = {Av, Av};
                    const f32x2 ua = __builtin_elementwise_fma(Sa, (f32x2){Aw.x, Aw.y}, vv * (f32x2){Ak.x, Ak.y}), ub = __builtin_elementwise_fma(Sb, (f32x2){Aw.z, Aw.w}, vv * (f32x2){Ak.z, Ak.w});
                    const f32x2 d2 = {dt, dt};
                    Sa = __builtin_elementwise_fma(d2, (f32x2){Ana.x, Ana.y}, ua); Sb = __builtin_elementwise_fma(d2, (f32x2){Ana.z, Ana.w}, ub);
                    if (s > 0) ysave = (c16 == s - 1) ? yr : ysave;
                    f32x2 q = Sa * (f32x2){Ar.x, Ar.y}; q = __builtin_elementwise_fma(Sb, (f32x2){Ar.z, Ar.w}, q);
                    ypend = q.x + q.y;
                    __builtin_amdgcn_sched_barrier(0);
                    if (s < 15) { Aw = Bw; Akk = Bkk; Ana = Bna; Ak = Bk; Ar = Br; Av = Bv; }
                }
                { const float y = red16(ypend); ysave = (c16 == 15) ? y : ysave; }
                asm volatile("" ::: "memory");
                yout[(size_t)(c * 16 + c16) * 64] = ysave;
            }
#undef SCAN_LD
        }
        __syncthreads();
    }
}
__device__ __forceinline__ void phase_rwfin(const bf16* P, const float* YR, const float* REC, const float* BON, const float* lnw, const float* lnb, bf16* Y, int nrows, int gw, int NGW, int lane) {
    const int head = lane >> 2, sub = lane & 3;
    for (int m = gw; m < nrows; m += NGW) {
        const bool isctx = m >= NLAT; const int t = isctx ? ((m - NLAT) & 255) : (m & 8191); const int b = isctx ? ((m - NLAT) >> 8) : (m >> 13);
        float out[16];
#pragma unroll
        for (int i = 0; i < 16; ++i) out[i] = 0.f;
#pragma unroll
        for (int d = 0; d < 2; ++d) {
            const int chain = (b * 2 + d) * 16 + head; const size_t pp = (size_t)chain * SCANLEN + scan_pos(d, isctx, t);
            float y[16], v[16];
#pragma unroll
            for (int j = 0; j < 4; ++j) { const f32x4 a = *(const f32x4*)(YR + pp * 64 + 16 * sub + 4 * j), c = *(const f32x4*)(REC + pp * RECF + 320 + 16 * sub + 4 * j);
                y[4 * j] = a.x; y[4 * j + 1] = a.y; y[4 * j + 2] = a.z; y[4 * j + 3] = a.w; v[4 * j] = c.x; v[4 * j + 1] = c.y; v[4 * j + 2] = c.z; v[4 * j + 3] = c.w; }
            const float bo = BON[pp];
            float s = 0.f;
#pragma unroll
            for (int i = 0; i < 16; ++i) s += y[i];
            s += __shfl_xor(s, 1); s += __shfl_xor(s, 2);
            const float mean = s * (1.f / 64.f); float q = 0.f;
#pragma unroll
            for (int i = 0; i < 16; ++i) { const float dl = y[i] - mean; q += dl * dl; }
            q += __shfl_xor(q, 1); q += __shfl_xor(q, 2);
            const float rstd = 1.0f / sqrtf(q * (1.f / 64.f) + 64e-5f);
#pragma unroll
            for (int i = 0; i < 16; ++i) { const int ch = head * 64 + 16 * sub + i; out[i] += (y[i] - mean) * rstd * lnw[ch] + lnb[ch] + bo * v[i]; }
        }
        float z[16]; unpack8(*(const v4u*)(P + (size_t)m * NIN + C_RWZ + 16 * lane), z); unpack8(*(const v4u*)(P + (size_t)m * NIN + C_RWZ + 16 * lane + 8), z + 8);
#pragma unroll
        for (int i = 0; i < 16; ++i) out[i] *= silu_f(z[i]);
        *(v4u*)(Y + (size_t)m * DM + 2048 + 16 * lane) = pack8(out); *(v4u*)(Y + (size_t)m * DM + 2048 + 16 * lane + 8) = pack8(out + 8);
    }
}
#define XB_TMO      128
#define XB_XCNT(j)  (256  + 64 * (j))
#define XB_XSUB(j)  (1280 + 64 * (j))
#define XB_XGEN(j)  (2304 + 64 * (j))
#define XB_TOP      3328
#define XB_TOPGEN   3392
#define XCD_BAR_WORDS 3456
#define XB_SPIN_CAP (1u << 18)

__device__ __forceinline__ unsigned xb_ld(unsigned* p)              { return __hip_atomic_load(p, __ATOMIC_RELAXED, __HIP_MEMORY_SCOPE_AGENT); }
__device__ __forceinline__ unsigned xb_add(unsigned* p, unsigned v) { return __hip_atomic_fetch_add(p, v, __ATOMIC_RELAXED, __HIP_MEMORY_SCOPE_AGENT); }
__device__ __forceinline__ unsigned xb_xcc_id() { return (unsigned)__builtin_amdgcn_s_getreg((3 << 11) | 20) & 0xFu; }
#define XB_SPIN(cond, bar) do { unsigned _sp = 0; while (cond) { __builtin_amdgcn_s_sleep(1); \
    if ((++_sp & 255u) == 0u) { if (xb_ld(&(bar)[XB_TMO])) break; if (_sp > XB_SPIN_CAP) { atomicAdd(&(bar)[XB_TMO], 1u); break; } } } } while (0)

struct XcdBarrier {
    unsigned* bar; unsigned x;
    volatile LAS unsigned* st;
};

__device__ __forceinline__ XcdBarrier xcd_barrier_post(unsigned* bar, volatile LAS unsigned* st) {
    XcdBarrier b; b.bar = bar; b.x = xb_xcc_id(); b.st = st;
    if (threadIdx.x == 0) (void)xb_add(&bar[XB_XCNT(b.x)], 1u);
    return b;
}
__device__ __forceinline__ void xcd_barrier_complete(unsigned* bar, unsigned x, unsigned& nloc, unsigned& nx) {
    const unsigned G = gridDim.x * gridDim.y * gridDim.z;
    unsigned sum, cnt, mine, sp = 0u;
    for (;;) {
        sum = 0u; cnt = 0u; mine = 0u;
#pragma unroll
        for (unsigned j = 0; j < 16; ++j) { const unsigned c = xb_ld(&bar[XB_XCNT(j)]); sum += c; cnt += (c > 0u) ? 1u : 0u; mine = (j == x) ? c : mine; }
        if (sum == G) break;
        __builtin_amdgcn_s_sleep(1);
        if ((++sp & 255u) == 0u) { if (xb_ld(&bar[XB_TMO])) break; if (sp > XB_SPIN_CAP) { atomicAdd(&bar[XB_TMO], 1u); break; } }
    }
    nloc = mine > 0u ? mine : 1u; nx = cnt > 0u ? cnt : 1u;
}

__device__ __forceinline__ void xcd_barrier(const XcdBarrier& b) {
    asm volatile("s_waitcnt vmcnt(0)" ::: "memory");
    __syncthreads();
    if (threadIdx.x == 0) {
        unsigned* bar = b.bar;
        __builtin_amdgcn_s_waitcnt(0);
        unsigned nloc = b.st[0], nx = b.st[1];
        if (nloc == 0u) { xcd_barrier_complete(bar, b.x, nloc, nx); b.st[0] = nloc; b.st[1] = nx; }
        const unsigned old = xb_add(&bar[XB_XSUB(b.x)], 1u);
        const unsigned gen = old / nloc;
        if (old + 1u == (gen + 1u) * nloc) {
            __builtin_amdgcn_fence(__ATOMIC_RELEASE, "agent");
            asm volatile("s_waitcnt vmcnt(0)" ::: "memory");
            const unsigned og = xb_add(&bar[XB_TOP], 1u);
            const unsigned tg = og / nx;
            if (og + 1u == (tg + 1u) * nx) xb_add(&bar[XB_TOPGEN], 1u);
            else XB_SPIN(xb_ld(&bar[XB_TOPGEN]) == tg, bar);
            __builtin_amdgcn_fence(__ATOMIC_ACQUIRE, "agent");
            xb_add(&bar[XB_XGEN(b.x)], 1u);
            asm volatile("s_waitcnt vmcnt(0)" ::: "memory");
        } else {
            XB_SPIN(xb_ld(&bar[XB_XGEN(b.x)]) == gen, bar);
            __builtin_amdgcn_fence(__ATOMIC_ACQUIRE, "agent");
            asm volatile("s_waitcnt vmcnt(0)" ::: "memory");
        }
    }
    __syncthreads();
}

#ifndef MK_SPLIT
#define MK_SPLIT 0
#endif
#ifndef REP_G1
#define REP_G1 1
#endif
#ifndef REP_PREP
#define REP_PREP 1
#endif
#ifndef REP_MIXA
#define REP_MIXA 1
#endif
#ifndef REP_RWP
#define REP_RWP 1
#endif
#ifndef REP_POOL
#define REP_POOL 1
#endif
#ifndef REP_NA
#define REP_NA 1
#endif
#ifndef REP_SGU
#define REP_SGU 1
#endif
#ifndef REP_ROWP
#define REP_ROWP 1
#endif
#ifndef REP_VT
#define REP_VT 1
#endif
#ifndef REP_SCAN
#define REP_SCAN 1
#endif
constexpr int NPHASE = 2 + 6 * DEPTH;
constexpr int NGRID = 256;
struct Args { const float* in[28]; float* out; unsigned char* ws; int ph_lo, ph_hi, li, pad; };

__global__ void __launch_bounds__(NWAVES * 64, 2) fwd(Args args) {
    extern __shared__ __attribute__((aligned(16))) unsigned char lds_raw[];
    LAS unsigned char* lds = (LAS unsigned char*)lds_raw;
    volatile LAS unsigned* MISC = (volatile LAS unsigned*)(lds + MISC_OFF);
    const int tid = threadIdx.x, lane = tid & 63, wave = __builtin_amdgcn_readfirstlane(tid >> 6);
    constexpr int G = NGRID; const int bx = blockIdx.x;
    const int vcu = (bx % 8) * (G / 8) + bx / 8;
    const int gw = vcu * NWAVES + wave; constexpr int NGW = G * NWAVES;
    unsigned char* ws = args.ws;
    const int lo = args.ph_lo, hi = args.ph_hi;

    for (int u = tid; u < (LDS_BYTES - LDSCTL_OFF) / 4; u += NWAVES * 64) ((LAS unsigned*)(lds + LDSCTL_OFF))[u] = 0u;
    __syncthreads();
    XcdBarrier bar; bar.bar = (unsigned*)(ws + WS_CTL) + CW_BAR; bar.x = 0; bar.st = MISC + 8;
    if (hi - lo > 1) bar = xcd_barrier_post((unsigned*)(ws + WS_CTL) + CW_BAR, MISC + 8);
#define IN(k) (lo <= (k) && (k) < hi)
#define SEAM(k) do { if (lo <= (k) && (k) + 1 < hi) { XcdBarrier b2_; b2_.bar = WSP(unsigned, WS_CTL) + CW_BAR; b2_.x = bar.x; b2_.st = bar.st; xcd_barrier(b2_); } } while (0)

#define OPQ_S(x) ({ int _t = (x); asm volatile("" : "+s"(_t)); _t; })
#define OPQ_V(x) ({ int _t = (x); asm volatile("" : "+v"(_t)); _t; })
#define INP(i) (args.in[OPQ_S(i)])
#define WSP(T, off) ((T*)(args.ws + ({ size_t _o = (off); asm volatile("" : "+s"(_o)); _o; })))
#define x_in INP(0)
#define c_in INP(1)
#define ctx_in INP(2)
#define cctx_in INP(3)
#define w_mod INP(4)
#define b_mod INP(5)
#define w_in INP(6)
#define w_out INP(7)
#define pool_w INP(8)
#define pool_scale INP(9)
#define na_qg INP(10)
#define na_kg INP(11)
#define na_rpb INP(12)
#define rw_mu_rkv INP(13)
#define rw_mu_lora INP(14)
#define rw_w0 INP(15)
#define rw_w_up INP(16)
#define rw_a0 INP(17)
#define rw_a_up INP(18)
#define rw_k_k INP(19)
#define rw_k_a INP(20)
#define rw_r_k INP(21)
#define rw_ln_w INP(22)
#define rw_ln_b INP(23)
#define sg_ln_w INP(24)
#define sg_ln_b INP(25)
#define sg_w INP(26)
#define sg_b INP(27)
#define MOD WSP(float, WS_MOD)
#define MODP WSP(float, WS_MODP)
#define TAB WSP(f32x2, WS_TAB)
#define SGST WSP(f32x2, WS_SGST)
#define BON WSP(float, WS_BON)
#define POOLWT WSP(bf16, WS_POOLWT)
#define WUPT WSP(bf16, WS_WUPT)
#define AUPT WSP(bf16, WS_AUPT)
#define SGW WSP(bf16, WS_SGW)
#define VTC WSP(bf16, WS_VTC)
#define VTL WSP(bf16, WS_VTL)
#define HCTX WSP(float, WS_HCTX)
#define QN WSP(bf16, WS_QN)
#define KN WSP(bf16, WS_KN)
#define WOUTT WSP(bf16, WS_WOUTT)
#define WINT WSP(bf16, WS_WINT)
#define XN WSP(bf16, WS_XN)
#define Y WSP(bf16, WS_Y)
#define P WSP(bf16, WS_P)
#define YR WSP(float, WS_YR)
#define REC WSP(float, WS_REC)
    float* const out = args.out;

    if (IN(0)) {
        LAS float* scr = (LAS float*)(lds + wave * 16384);
        constexpr int I_MOD = 4 * 64 * 48, I_WIN1 = 64 * (NIN / 32), I_WIN = 4 * I_WIN1, I_WOUT1 = 64 * 128, I_WOUT = 4 * I_WOUT1, I_POOL = 16 * 32, I_WUP = 8 * 32, I_AUP = 8 * 32, I_SGW = 1024;
        constexpr int NITEMS = I_MOD + I_WIN + I_WOUT + I_POOL + I_WUP + I_AUP + I_SGW;
        for (int it = gw; it < NITEMS; it += NGW) {
            int r = it;
            if (r < I_MOD) { p0_mod_item(w_mod, c_in, cctx_in, MODP, scr, r, lane); continue; } r -= I_MOD;
            if (r < I_WIN) { const int l = r / I_WIN1; p0_transpose_item(w_in + (size_t)l * DM * NIN, DM, NIN, WINT + (size_t)l * NIN * DM, scr, r % I_WIN1, lane); continue; } r -= I_WIN;
            if (r < I_WOUT) { const int l = r / I_WOUT1; p0_transpose_item(w_out + (size_t)l * DM * DM, DM, DM, WOUTT + (size_t)l * DM * DM, scr, r % I_WOUT1, lane); continue; } r -= I_WOUT;
            if (r < I_POOL) { const int lg = r / 32; p0_transpose_item(pool_w + (size_t)lg * 65536, 256, 256, POOLWT + (size_t)lg * 65536, scr, r % 32, lane); continue; } r -= I_POOL;
            if (r < I_WUP) { const int ld = r / 32; p0_transpose_item(rw_w_up + (size_t)ld * 65536, 64, 1024, WUPT + (size_t)ld * 65536, scr, r % 32, lane); continue; } r -= I_WUP;
            if (r < I_AUP) { const int ld = r / 32; p0_transpose_item(rw_a_up + (size_t)ld * 65536, 64, 1024, AUPT + (size_t)ld * 65536, scr, r % 32, lane); continue; } r -= I_AUP;
            {   const size_t e0 = (size_t)r * 512 + lane * 8; const f32x4 a = *(const f32x4*)(sg_w + e0), b = *(const f32x4*)(sg_w + e0 + 4);
                v4u o; o.x = pk2(a.x, a.y); o.y = pk2(a.z, a.w); o.z = pk2(b.x, b.y); o.w = pk2(b.z, b.w); *(v4u*)(SGW + e0) = o; }
        }
        SEAM(0);
    }
    if (IN(1)) {
        for (int idx = gw * 64 + lane; idx < 4 * 3 * 12288; idx += NGW * 64) {
            const int l = idx / 36864, c = (idx / 12288) % 3, n = idx % 12288;
            float s = b_mod[l * 12288 + n];
            const float* pp = MODP + ((size_t)(l * 64) * 3 + c) * 12288 + n;
#pragma unroll 8
            for (int kc = 0; kc < 64; ++kc) s += pp[(size_t)kc * 3 * 12288];
            MOD[idx] = s;
        }
        for (int idx = gw * 64 + lane; idx < 2048; idx += NGW * 64) {
            const int pos = idx >> 4, i = idx & 15;
            float inv = (i & 3) == 0 ? 1.0f : ((i & 3) == 1 ? 0.5623413251903491f : ((i & 3) == 2 ? 0.31622776601683794f : 0.17782794100389228f));
            inv *= (i >> 2) == 0 ? 1.0f : ((i >> 2) == 1 ? 0.1f : ((i >> 2) == 2 ? 0.01f : 0.001f));
            float cc, sn; sincos_acc((float)pos * inv, cc, sn);
            TAB[idx] = (f32x2){cc, sn};
        }
        SEAM(1);
    }
    for (int l = 0; l < DEPTH; ++l) {
        const int pb = 2 + 6 * l;
        const bool with_ctx = l < DEPTH - 1;
#define hin_lat (l == 0 ? x_in : (const float*)out)
#define hin_ctx (l == 0 ? ctx_in : (const float*)HCTX)
#define mod (MOD + (size_t)l * 3 * 12288)
        const int nrows = with_ctx ? MROWS : NLAT;
        if (IN(pb + 0)) {
            phase_xn(hin_lat, hin_ctx, mod, XN, OPQ_S(gw), NGW, OPQ_V(lane));
            SEAM(pb + 0);
        }
        if (IN(pb + 1)) {
            pg8::Gemm g{XN, WINT + (size_t)l * NIN * DM, MROWS, NIN, DM}; pg8::StaticOrder S; S.init(MROWS, NIN, G, bx);
            pg8::EpiStoreBf16 E{P, NIN};
            for (int rep = 0; rep < REP_G1; ++rep) pg8::gemm_phase<pg8::EpiStoreBf16, pg8::StaticOrder, true, true>(lds, g, S, E);
            SEAM(pb + 1);
        }
        if (IN(pb + 2)) {
            for (int rep = 0; rep < REP_PREP; ++rep) {
            for (int rep2 = 0; rep2 < REP_ROWP; ++rep2)
            phase_rowprep(P, na_qg + l * 64, na_kg + l * 64, TAB, QN, KN, SGST, OPQ_S(gw), NGW, OPQ_V(lane));
            for (int rep2 = 0; rep2 < REP_VT; ++rep2)
            phase_vt(P, VTL, VTC, OPQ_S(gw), NGW, OPQ_V(lane));
            for (int rep2 = 0; rep2 < REP_RWP; ++rep2)
            phase_rwprep(P, rw_mu_rkv + (size_t)l * 6144, rw_mu_lora + (size_t)l * 256, rw_w0 + (size_t)l * 2048, WUPT + (size_t)l * 131072, rw_a0 + (size_t)l * 2048, AUPT + (size_t)l * 131072,
                         rw_k_k + (size_t)l * 1024, rw_k_a + (size_t)l * 1024, rw_r_k + (size_t)l * 1024, REC, BON, OPQ_S(gw), NGW, OPQ_V(lane));
            for (int rep2 = 0; rep2 < REP_POOL; ++rep2)
            phase_pool(P, POOLWT + (size_t)l * 262144, pool_scale + (size_t)l * 1024, Y, nrows, OPQ_S(gw), NGW, OPQ_V(lane));
            }
            SEAM(pb + 2);
        }
        if (IN(pb + 3)) {
            for (int rep = 0; rep < REP_MIXA; ++rep) {
            for (int rep2 = 0; rep2 < REP_NA; ++rep2)
            for (int u = OPQ_S(gw); u < NBATCH * 128 * 16 * 4; u += NGW) na_unit<false>(QN, KN, VTL, VTC, P, na_rpb + (size_t)l * 16 * 15 * 31, Y, u, OPQ_V(lane));
            if (with_ctx) for (int u = OPQ_S(gw); u < NBATCH * 16 * 16; u += NGW) na_unit<true>(QN, KN, VTL, VTC, P, na_rpb, Y, u, OPQ_V(lane));
            for (int rep2 = 0; rep2 < REP_SGU; ++rep2)
            phase_sgu(P, SGST, sg_ln_w + (size_t)l * 1024, sg_ln_b + (size_t)l * 1024, SGW + (size_t)l * 131072, sg_b + (size_t)l * 1024, Y, lds, nrows / 128, OPQ_V(tid), wave, OPQ_V(lane));
            }
            for (int rep = 0; rep < REP_SCAN; ++rep) phase_scan(REC, YR, lds, wave, OPQ_V(lane));
            SEAM(pb + 3);
        }
        if (IN(pb + 4)) {
            phase_rwfin(P, YR, REC, BON, rw_ln_w + (size_t)l * 1024, rw_ln_b + (size_t)l * 1024, Y, nrows, OPQ_S(gw), NGW, OPQ_V(lane));
            SEAM(pb + 4);
        }
        if (IN(pb + 5)) {
            pg8::Gemm g{Y, WOUTT + (size_t)l * DM * DM, nrows, DM, DM}; pg8::StaticOrder S; S.init(nrows, DM, G, bx);
            pg8::EpiResGate E{hin_lat, hin_ctx, out, HCTX, mod};
            pg8::gemm_phase<pg8::EpiResGate, pg8::StaticOrder, true, true>(lds, g, S, E);
            SEAM(pb + 5);
        }
    }
#undef IN
#undef SEAM
}
#undef hin_lat
#undef hin_ctx
#undef mod
#undef P
#undef Y
#undef XN
#undef out

extern "C" void kernel_launch(void* const* d_in, const int* in_sizes, int n_in, void* d_out, int out_size, void* d_ws, size_t ws_size, hipStream_t stream) {
    static int grid = 0;
    if (grid == 0) {
        if (n_in != 28 || out_size != NLAT * DM || ws_size < WS_END) { fprintf(stderr, "kernel_launch: unexpected shapes (n_in %d, out %d, ws %zu < %zu); nothing launched\n", n_in, out_size, ws_size, (size_t)WS_END); grid = -1; return; }
        int dev = 0, cus = 0, per_cu = 0;
        if (hipGetDevice(&dev) != hipSuccess || hipDeviceGetAttribute(&cus, hipDeviceAttributeMultiprocessorCount, dev) != hipSuccess) { grid = -1; return; }
        if (hipFuncSetAttribute((const void*)fwd, hipFuncAttributeMaxDynamicSharedMemorySize, LDS_BYTES) != hipSuccess) { fprintf(stderr, "kernel_launch: hipFuncSetAttribute failed\n"); grid = -1; return; }
        if (hipOccupancyMaxActiveBlocksPerMultiprocessor(&per_cu, (const void*)fwd, NWAVES * 64, LDS_BYTES) != hipSuccess || per_cu < 1)
            fprintf(stderr, "kernel_launch: note: occupancy query reports %d workgroups per CU\n", per_cu);
        (void)hipGetLastError();
        grid = cus >= NGRID ? NGRID : -2;
    }
    if (grid == -1) return;
    if (hipMemsetAsync((char*)d_ws + WS_CTL, 0, CTL_ZERO_BYTES, stream) != hipSuccess) { fprintf(stderr, "kernel_launch: memset failed\n"); return; }
    Args a{};
    for (int i = 0; i < 28; ++i) a.in[i] = (const float*)d_in[i];
    a.out = (float*)d_out; a.ws = (unsigned char*)d_ws; a.li = 0; a.pad = 0;
    const bool split = MK_SPLIT || grid == -2;
    if (split) { for (int k = 0; k < NPHASE; ++k) { a.ph_lo = k; a.ph_hi = k + 1; hipLaunchKernelGGL(fwd, dim3(NGRID), dim3(NWAVES * 64), LDS_BYTES, stream, a); } }
    else { a.ph_lo = 0; a.ph_hi = NPHASE; hipLaunchKernelGGL(fwd, dim3(NGRID), dim3(NWAVES * 64), LDS_BYTES, stream, a); }
    const hipError_t le = hipPeekAtLastError();
    if (le != hipSuccess) fprintf(stderr, "kernel_launch: launch failed: %s\n", hipGetErrorName(le));
}
```

```cpp
#include <hip/hip_runtime.h>
#include <cstdio>
#include <cstdint>
#define MK_SPLIT 0
namespace pg8 {
#define PG8_LAS __attribute__((address_space(3)))
typedef unsigned short bf16_t;
typedef short bf16x8 __attribute__((ext_vector_type(8)));
typedef float f32x4 __attribute__((ext_vector_type(4)));
typedef unsigned u32x4 __attribute__((ext_vector_type(4)));
constexpr int BM = 256, BK = 64, HALF = 128, HTB = HALF * BK * 2  , STAGE_BYTES = 8 * HTB, NXCD = 8, WGM = 8;

__host__ __device__ __forceinline__ int lds_byte(int r, int c) { const int st = (r >> 4) * 2 + (c >> 5), rr = r & 15, cc = c & 31, ob = rr * 64 + cc * 2; return st * 1024 + (ob ^ (((ob >> 9) & 1) << 5)); }
__host__ __device__ __forceinline__ void stage_rc(int b, int& R, int& C) { const int st = b / 1024, sb = b % 1024, swz = sb ^ (((sb >> 9) & 1) << 5); R = (st >> 1) * 16 + swz / 64; C = (st & 1) * 32 + (swz % 64) / 2; }
__host__ __device__ __forceinline__ int perm32(int rho) { const int n = rho >> 4, i = rho & 15; return 8 * (i >> 2) + 4 * n + (i & 3); }

struct Unit { int pm, pn; };
struct Gemm { const bf16_t* A; const bf16_t* Bt; int M, N, K; };

struct StaticOrder {
    int nM, nN, nwg, G, c;
    __host__ __device__ void init(int M, int N, int G_, int c_) { nM = M / BM; nN = N / BM; nwg = nM * nN; G = G_; c = c_; }
    __host__ __device__ bool next(int i, Unit& u) const {
        const long L = (long)i * G + c; if (L >= nwg) return false;
        int wgid = (int)L; { const int q = nwg / NXCD, r = nwg % NXCD, xcd = wgid % NXCD, off = wgid / NXCD; wgid = (xcd < r ? xcd * (q + 1) : r * (q + 1) + (xcd - r) * q) + off; }
        const int nig = WGM * nN, gid = wgid / nig, fm = gid * WGM, gsz = (nM - fm) < WGM ? (nM - fm) : WGM;
        u.pm = fm + ((wgid % nig) % gsz); u.pn = (wgid % nig) / gsz; return true;
    }
    __device__ __forceinline__ void a_ready(const Unit&) const {}
    __device__ __forceinline__ void done(const Unit&) const {}
};

__device__ __forceinline__ unsigned cvt_pk_bf16(float lo, float hi) { unsigned r; asm volatile("v_cvt_pk_bf16_f32 %0, %1, %2" : "=v"(r) : "v"(lo), "v"(hi)); return r; }
template <class Epi, class Sched, bool ALIGN_EPI = false, bool SP2 = false>
__device__ __forceinline__ void gemm_phase(PG8_LAS unsigned char* lds, const Gemm g, const Sched& S, const Epi& E) {
    int tid_ = threadIdx.x; asm volatile("" : "+v"(tid_));
    const int tid = tid_, wid = __builtin_amdgcn_readfirstlane(tid >> 6), lane = tid & 63, wr = wid >> 2, wc = wid & 3, fr = lane & 15, fq = lane >> 4;
    const int K = g.K, nt = K / BK;
    unsigned voffA[2], voffB[2];
#pragma unroll
    for (int i = 0; i < 2; ++i) { int R, C; stage_rc(tid * 16 + i * 8192, R, C); const int Rb = Epi::PERM ? ((R & ~31) + perm32(R & 31)) : R;
        voffA[i] = (unsigned)(R * K + C) * 2u; voffB[i] = (unsigned)(Rb * K + C) * 2u; }
    const size_t kstep = (size_t)(BK * 2);
    const size_t hstep = (size_t)HALF * K * 2;
    const size_t tstep = 2 * hstep;
    const unsigned ldsw = (unsigned)wid * 1024u;
    const int aoff = lds_byte(wr * 64 + fr, fq * 8), boff = lds_byte(wc * 32 + fr, fq * 8);
#define PG8_SA(b, h) (((b) * 2 + (h)) * HTB)
#define PG8_SB(b, h) ((4 + (b) * 2 + (h)) * HTB)
#define PG8_STAGE(bufoff, gbase, voff) do { _Pragma("unroll") for (int _i = 0; _i < 2; ++_i) \
        __builtin_amdgcn_global_load_lds((const unsigned*)((const char*)(gbase) + (voff)[_i]), (PG8_LAS unsigned*)(lds + (bufoff) + ldsw + _i * 8192), 16, 0, 0); } while (0)
#define PG8_LDA(dst, b, h) do { _Pragma("unroll") for (int m = 0; m < 4; ++m) _Pragma("unroll") for (int k = 0; k < 2; ++k) dst[m][k] = *(const PG8_LAS bf16x8*)(lds + PG8_SA(b, h) + aoff + m * 2048 + k * 1024); } while (0)
#define PG8_LDB(dst, b, h) do { _Pragma("unroll") for (int n = 0; n < 2; ++n) _Pragma("unroll") for (int k = 0; k < 2; ++k) dst[n][k] = *(const PG8_LAS bf16x8*)(lds + PG8_SB(b, h) + boff + n * 2048 + k * 1024); } while (0)
#define PG8_MMA(ai, bj, At, Bt) do { __builtin_amdgcn_s_setprio(1); _Pragma("unroll") for (int m = 0; m < 4; ++m) _Pragma("unroll") for (int n = 0; n < 2; ++n) _Pragma("unroll") for (int k = 0; k < 2; ++k) \
        acc[ai][bj][m][n] = __builtin_amdgcn_mfma_f32_16x16x32_bf16(Bt[n][k], At[m][k], acc[ai][bj][m][n], 0, 0, 0); __builtin_amdgcn_s_setprio(0); } while (0)
#define PG8_WAIT_V(n) asm volatile("s_waitcnt vmcnt(" #n ")" ::: "memory")
#define PG8_WAIT_L(n) asm volatile("s_waitcnt lgkmcnt(" #n ")" ::: "memory")
#define PG8_BAR __builtin_amdgcn_s_barrier()
#define PG8_SCHED __builtin_amdgcn_sched_barrier(0)
    Unit cur, nxt; int ui = 0;
    if (!S.next(0, cur)) return;
    f32x4 acc[2][2][4][2];
#pragma unroll
    for (int a = 0; a < 2; ++a)
#pragma unroll
        for (int b = 0; b < 2; ++b)
#pragma unroll
            for (int m = 0; m < 4; ++m)
#pragma unroll
                for (int n = 0; n < 2; ++n) acc[a][b][m][n] = (f32x4){0.f, 0.f, 0.f, 0.f};
    bf16x8 At[4][2], B0[2][2], B1[2][2];
    const char* cA = (const char*)g.A + (size_t)cur.pm * tstep; const char* cB = (const char*)g.Bt + (size_t)cur.pn * tstep;
    S.a_ready(cur);
    if constexpr (SP2) {
        PG8_STAGE(PG8_SB(0, 0), cB, voffB); PG8_STAGE(PG8_SB(0, 1), cB + hstep, voffB); PG8_STAGE(PG8_SA(0, 0), cA, voffA); PG8_STAGE(PG8_SA(0, 1), cA + hstep, voffA);
        if (wr == 1) PG8_BAR;
        PG8_WAIT_V(2); PG8_BAR;
        PG8_STAGE(PG8_SB(1, 0), cB + kstep, voffB); PG8_STAGE(PG8_SA(1, 0), cA + kstep, voffA); PG8_STAGE(PG8_SB(1, 1), cB + hstep + kstep, voffB);
        PG8_WAIT_V(6); PG8_BAR;
    } else {
        PG8_STAGE(PG8_SB(0, 0), cB, voffB); PG8_STAGE(PG8_SA(0, 0), cA, voffA); PG8_STAGE(PG8_SB(0, 1), cB + hstep, voffB); PG8_STAGE(PG8_SA(0, 1), cA + hstep, voffA);
        if (wr == 1) PG8_BAR;
        PG8_WAIT_V(4); PG8_BAR;
        PG8_STAGE(PG8_SB(1, 0), cB + kstep, voffB); PG8_STAGE(PG8_SA(1, 0), cA + kstep, voffA); PG8_STAGE(PG8_SB(1, 1), cB + hstep + kstep, voffB);
        PG8_WAIT_V(6); PG8_BAR;
    }
    for (;;) {
        const bool has_next = S.next(ui + 1, nxt);
        const char* nA = has_next ? (const char*)g.A + (size_t)nxt.pm * tstep : cA; const char* nB = has_next ? (const char*)g.Bt + (size_t)nxt.pn * tstep : cB;
        for (int t = 0; t < nt; t += 2) {
            const bool last = (t == nt - 2);
            const char* a1 = cA + (size_t)(t + 1) * kstep;
            const char* a2 = last ? nA : cA + (size_t)(t + 2) * kstep; const char* b2 = last ? nB : cB + (size_t)(t + 2) * kstep;
            const char* a3 = a2 + kstep; const char* b3 = b2 + kstep;
            if (last && has_next) S.a_ready(nxt);
            if constexpr (SP2) {
            PG8_LDB(B0, 0, 0); PG8_LDB(B1, 0, 1); PG8_SCHED; PG8_LDA(At, 0, 0); PG8_STAGE(PG8_SA(1, 1), a1 + hstep, voffA);
            PG8_WAIT_V(8); PG8_WAIT_L(0); PG8_BAR; PG8_MMA(0, 0, At, B0); PG8_MMA(0, 1, At, B1); PG8_BAR; PG8_SCHED;
            PG8_LDA(At, 0, 1); PG8_STAGE(PG8_SB(0, 0), b2, voffB); PG8_STAGE(PG8_SB(0, 1), b2 + hstep, voffB); PG8_STAGE(PG8_SA(0, 0), a2, voffA);
            PG8_WAIT_V(8); PG8_WAIT_L(0); PG8_BAR; PG8_MMA(1, 0, At, B0); PG8_MMA(1, 1, At, B1); PG8_BAR; PG8_SCHED;
            PG8_LDB(B0, 1, 0); PG8_LDB(B1, 1, 1); PG8_SCHED; PG8_LDA(At, 1, 0); PG8_STAGE(PG8_SA(0, 1), a2 + hstep, voffA);
            PG8_WAIT_V(8); PG8_WAIT_L(0); PG8_BAR; PG8_MMA(0, 0, At, B0); PG8_MMA(0, 1, At, B1); PG8_BAR; PG8_SCHED;
            PG8_LDA(At, 1, 1); PG8_STAGE(PG8_SB(1, 0), b3, voffB); PG8_STAGE(PG8_SB(1, 1), b3 + hstep, voffB); PG8_STAGE(PG8_SA(1, 0), a3, voffA);
            PG8_WAIT_V(8); PG8_WAIT_L(0); PG8_BAR; PG8_MMA(1, 0, At, B0); PG8_MMA(1, 1, At, B1); PG8_BAR; PG8_SCHED;
            } else {
            PG8_LDB(B0, 0, 0); PG8_SCHED; PG8_LDA(At, 0, 0); PG8_STAGE(PG8_SA(1, 1), a1 + hstep, voffA);
            PG8_WAIT_L(8); PG8_BAR; PG8_WAIT_L(0); PG8_MMA(0, 0, At, B0); PG8_BAR; PG8_SCHED;
            PG8_LDB(B1, 0, 1); PG8_STAGE(PG8_SB(0, 0), b2, voffB);
            PG8_BAR; PG8_WAIT_L(0); PG8_MMA(0, 1, At, B1); PG8_BAR;
            PG8_LDA(At, 0, 1); PG8_STAGE(PG8_SA(0, 0), a2, voffA);
            PG8_BAR; PG8_WAIT_L(0); PG8_MMA(1, 0, At, B0); PG8_BAR; PG8_SCHED;
            PG8_STAGE(PG8_SB(0, 1), b2 + hstep, voffB);
            PG8_WAIT_V(6); PG8_BAR; PG8_MMA(1, 1, At, B1); PG8_BAR;
            PG8_LDB(B0, 1, 0); PG8_SCHED; PG8_LDA(At, 1, 0); PG8_STAGE(PG8_SA(0, 1), a2 + hstep, voffA);
            PG8_WAIT_L(8); PG8_BAR; PG8_WAIT_L(0); PG8_MMA(0, 0, At, B0); PG8_BAR; PG8_SCHED;
            PG8_LDB(B1, 1, 1); PG8_STAGE(PG8_SB(1, 0), b3, voffB);
            PG8_BAR; PG8_WAIT_L(0); PG8_MMA(0, 1, At, B1); PG8_BAR;
            PG8_LDA(At, 1, 1); PG8_STAGE(PG8_SA(1, 0), a3, voffA);
            PG8_BAR; PG8_WAIT_L(0); PG8_MMA(1, 0, At, B0); PG8_BAR; PG8_SCHED;
            PG8_STAGE(PG8_SB(1, 1), b3 + hstep, voffB);
            PG8_WAIT_V(6); PG8_BAR; PG8_MMA(1, 1, At, B1); PG8_BAR;
            }
        }
        if constexpr (ALIGN_EPI) { if (wr == 0) PG8_BAR; }
        if constexpr (!Epi::AFTER_DRAIN) { E(acc, cur, wr, wc, fr, fq); S.done(cur); }
        if (!has_next) break;
#pragma unroll
        for (int a = 0; a < 2; ++a)
#pragma unroll
            for (int b = 0; b < 2; ++b)
#pragma unroll
                for (int m = 0; m < 4; ++m)
#pragma unroll
                    for (int n = 0; n < 2; ++n) acc[a][b][m][n] = (f32x4){0.f, 0.f, 0.f, 0.f};
        cur = nxt; cA = nA; cB = nB; ++ui;
        if constexpr (ALIGN_EPI) { if (wr == 1) PG8_BAR; }
    }
    PG8_WAIT_V(0);
    if constexpr (!ALIGN_EPI) { if (wr == 0) PG8_BAR; }
    PG8_BAR;
    if constexpr (Epi::AFTER_DRAIN) { E.fused(acc, cur, wr, wc, fr, fq, lds, wid, lane); S.done(cur); }
#undef PG8_SA
#undef PG8_SB
#undef PG8_STAGE
#undef PG8_LDA
#undef PG8_LDB
#undef PG8_MMA
#undef PG8_WAIT_V
#undef PG8_WAIT_L
#undef PG8_BAR
#undef PG8_SCHED
}
}

constexpr int DM = 4096, NBATCH = 2, SEQ = 8192, DEPTH = 4, CTXL = 256;
constexpr int NLAT = NBATCH * SEQ, NCTX = NBATCH * CTXL, MROWS = NLAT + NCTX;
constexpr int NIN = 13568, GWD = 1024;
constexpr int C_POOLV = 0, C_POOLZ = 1024, C_NAQ = 2048, C_NAK = 3072, C_NAV = 4096, C_NAZ = 5120, C_RWR = 6144, C_RWK = 7168, C_RWV = 8192, C_RWZ = 9216,
              C_RWWD = 10240, C_RWAD = 10368, C_SGU = 10496, C_SGV = 11520, C_SGZ = 12544;
constexpr int SCANLEN = CTXL + SEQ;
constexpr int NCHAIN = 64;
constexpr int RECF = 384;
constexpr int NWAVES = 8;

constexpr size_t MiB = 1u << 20;
constexpr size_t WS_CTL = 0, CTL_ZERO_BYTES = 1 * MiB;
constexpr size_t WS_MOD   = 2 * MiB;
constexpr size_t WS_TAB   = 3 * MiB;
constexpr size_t WS_SGST  = 4 * MiB;
constexpr size_t WS_BON   = 5 * MiB;
constexpr size_t WS_POOLWT= 8 * MiB;
constexpr size_t WS_WUPT  = 10 * MiB;
constexpr size_t WS_AUPT  = 11 * MiB;
constexpr size_t WS_SGW   = 12 * MiB;
constexpr size_t WS_VTC   = 13 * MiB;
constexpr size_t WS_HCTX  = 14 * MiB;
constexpr size_t WS_MODP  = 22 * MiB;
constexpr size_t WS_VTL   = 58 * MiB;
constexpr size_t WS_QN    = 90 * MiB;
constexpr size_t WS_KN    = 123 * MiB;
constexpr size_t WS_WOUTT = 156 * MiB;
constexpr size_t WS_WINT  = 284 * MiB;
constexpr size_t WS_XN    = 708 * MiB;
constexpr size_t WS_Y     = 840 * MiB;
constexpr size_t WS_P     = 972 * MiB;
constexpr size_t WS_YR    = 1410 * MiB;
constexpr size_t WS_REC   = 1542 * MiB;
constexpr size_t WS_END   = 2334 * MiB;
static_assert(WS_P + (size_t)MROWS * NIN * 2 <= WS_YR && WS_REC + (size_t)NCHAIN * SCANLEN * RECF * 4 <= WS_END && WS_WINT + (size_t)4 * NIN * DM * 2 <= WS_XN, "ws map");
constexpr int CW_TMO = 0, CW_BAR = 4096;

constexpr int RING_BYTES = 131072, LDSCTL_OFF = RING_BYTES, MISC_OFF = LDSCTL_OFF + 320, LDS_BYTES = 147456;

#define GAS __attribute__((address_space(1)))
#define LAS __attribute__((address_space(3)))
typedef unsigned short bf16;
typedef unsigned v4u __attribute__((ext_vector_type(4)));
typedef unsigned v2u __attribute__((ext_vector_type(2)));
typedef float f32x4 __attribute__((ext_vector_type(4)));
typedef float f32x2 __attribute__((ext_vector_type(2)));
typedef short bf16x8 __attribute__((ext_vector_type(8)));
#define RLX_AGENT __ATOMIC_RELAXED, __HIP_MEMORY_SCOPE_AGENT
#define LDS_WAIT() asm volatile("s_waitcnt lgkmcnt(0)" ::: "memory")

__device__ __forceinline__ float bf2f(unsigned short h) { return __uint_as_float(((unsigned)h) << 16); }
__device__ __forceinline__ float bflo(unsigned w) { return __uint_as_float(w << 16); }
__device__ __forceinline__ float bfhi(unsigned w) { return __uint_as_float(w & 0xffff0000u); }
__device__ __forceinline__ unsigned f2bf(float f) { unsigned u = __float_as_uint(f); return (u + 0x7fffu + ((u >> 16) & 1u)) >> 16; }
__device__ __forceinline__ unsigned pk2(float lo, float hi) { return f2bf(lo) | (f2bf(hi) << 16); }
__device__ __forceinline__ void unpack8(const v4u w, float* x) { x[0] = bflo(w.x); x[1] = bfhi(w.x); x[2] = bflo(w.y); x[3] = bfhi(w.y); x[4] = bflo(w.z); x[5] = bfhi(w.z); x[6] = bflo(w.w); x[7] = bfhi(w.w); }
__device__ __forceinline__ v4u pack8(const float* x) { v4u w; w.x = pk2(x[0], x[1]); w.y = pk2(x[2], x[3]); w.z = pk2(x[4], x[5]); w.w = pk2(x[6], x[7]); return w; }
__device__ __forceinline__ float silu_f(float x) { return x / (1.f + __expf(-x)); }
__device__ __forceinline__ float wave_sum(float v) {
#pragma unroll
    for (int o = 1; o < 64; o <<= 1) v += __shfl_xor(v, o);
    return v;
}
template <int CTRL> __device__ __forceinline__ float dppf(float v) { return __builtin_bit_cast(float, __builtin_amdgcn_update_dpp(0, __builtin_bit_cast(int, v), CTRL, 0xF, 0xF, true)); }
__device__ __forceinline__ float red16(float v) { v += dppf<0xB1>(v); v += dppf<0x4E>(v); v += dppf<0x141>(v); v += dppf<0x140>(v); return v; }
__device__ __forceinline__ void red16x2(float& a, float& b) {
    a += dppf<0xB1>(a); b += dppf<0xB1>(b); a += dppf<0x4E>(a); b += dppf<0x4E>(b); a += dppf<0x141>(a); b += dppf<0x141>(b); a += dppf<0x140>(a); b += dppf<0x140>(b); }
__device__ __forceinline__ float max16x4(float v) { v = fmaxf(v, __shfl_xor(v, 16)); v = fmaxf(v, __shfl_xor(v, 32)); return v; }
__device__ __forceinline__ float sum16x4(float v) { v += __shfl_xor(v, 16); v += __shfl_xor(v, 32); return v; }
__device__ __forceinline__ int scan_pos(int d, bool isctx, int t) { return d == 0 ? (isctx ? t : CTXL + t) : (isctx ? (CTXL - 1 - t) : (CTXL + SEQ - 1 - t)); }
__device__ __forceinline__ f32x4 mfma16(bf16x8 a, bf16x8 b, f32x4 c) { return __builtin_amdgcn_mfma_f32_16x16x32_bf16(a, b, c, 0, 0, 0); }
__device__ __forceinline__ bf16x8 ld_frag(const bf16* p) { return __builtin_bit_cast(bf16x8, *(const v4u*)p); }

namespace pg8 {
struct EpiStoreBf16 {
    static constexpr bool PERM = true, AFTER_DRAIN = false;
    bf16_t* O; int ldc;
    __device__ __forceinline__ void operator()(const f32x4 (&acc)[2][2][4][2], const Unit& u, int wr, int wc, int fr, int fq) const {
        const int row0 = u.pm * BM + wr * 64 + fr, col0 = u.pn * BM + wc * 32 + 8 * fq;
#pragma unroll
        for (int ai = 0; ai < 2; ++ai)
#pragma unroll
            for (int m = 0; m < 4; ++m) { bf16_t* rowp = O + (size_t)(row0 + ai * HALF + m * 16) * ldc + col0;
#pragma unroll
                for (int bj = 0; bj < 2; ++bj) { const f32x4 v0 = acc[ai][bj][m][0], v1 = acc[ai][bj][m][1];
                    u32x4 w; w.x = cvt_pk_bf16(v0[0], v0[1]); w.y = cvt_pk_bf16(v0[2], v0[3]); w.z = cvt_pk_bf16(v1[0], v1[1]); w.w = cvt_pk_bf16(v1[2], v1[3]);
                    *(u32x4*)(rowp + bj * HALF) = w; } }
    }
};
struct EpiResGate {
    static constexpr bool PERM = false, AFTER_DRAIN = false;
    const float* hin_lat; const float* hin_ctx; float* hout_lat; float* hout_ctx; const float* gate;
    __device__ __forceinline__ void operator()(const f32x4 (&acc)[2][2][4][2], const Unit& u, int wr, int wc, int fr, int fq) const {
        const int cond = u.pm < 32 ? 0 : (u.pm < 64 ? 1 : 2);
        const int rloc = (u.pm < 64 ? u.pm * BM : (u.pm - 64) * BM) + wr * 64 + fr, col0 = u.pn * BM + wc * 32 + 4 * fq;
        const float* hin = u.pm < 64 ? hin_lat : hin_ctx; float* hout = u.pm < 64 ? hout_lat : hout_ctx;
        f32x4 gv[2][2];
#pragma unroll
        for (int bj = 0; bj < 2; ++bj)
#pragma unroll
            for (int n = 0; n < 2; ++n) gv[bj][n] = *(const f32x4*)(gate + cond * 12288 + 8192 + col0 + bj * HALF + n * 16);
#pragma unroll
        for (int ai = 0; ai < 2; ++ai)
#pragma unroll
            for (int m = 0; m < 4; ++m) { const size_t off = (size_t)(rloc + ai * HALF + m * 16) * 4096 + col0;
#pragma unroll
                for (int bj = 0; bj < 2; ++bj)
#pragma unroll
                    for (int n = 0; n < 2; ++n) { const f32x4 b = *(const f32x4*)(hin + off + bj * HALF + n * 16);
                        *(f32x4*)(hout + off + bj * HALF + n * 16) = b + gv[bj][n] * acc[ai][bj][m][n]; } }
    }
};
}

__device__ __forceinline__ void p0_transpose_item(const float* W, int K, int N, bf16* WT, LAS float* scr, int item, int lane) {
    const int nblk = N / 32, kb = item / nblk, nb = item % nblk, k0 = 64 * kb, n0 = 32 * nb;
#pragma unroll 8
    for (int i = 0; i < 32; ++i) { const int kk = 2 * i + (lane >> 5); scr[kk * 33 + (lane & 31)] = W[(size_t)(k0 + kk) * N + n0 + (lane & 31)]; }
    LDS_WAIT(); asm volatile("" ::: "memory");
    const int c = lane & 7;
#pragma unroll
    for (int j = 0; j < 4; ++j) { const int n = (lane >> 3) + 8 * j; const LAS float* s = scr + (8 * c) * 33 + n;
        v4u o; o.x = pk2(s[0 * 33], s[1 * 33]); o.y = pk2(s[2 * 33], s[3 * 33]); o.z = pk2(s[4 * 33], s[5 * 33]); o.w = pk2(s[6 * 33], s[7 * 33]);
        *(v4u*)(WT + (size_t)(n0 + n) * K + k0 + 8 * c) = o; }
    LDS_WAIT(); asm volatile("" ::: "memory");
}
__device__ __forceinline__ void p0_mod_item(const float* wmod, const float* cvec, const float* cctx, float* MODP, LAS float* scr, int item, int lane) {
    const int l = item / (64 * 48), r = item % (64 * 48), kc = r / 48, nc = r % 48, k0 = kc * 64, n0 = nc * 256 + lane * 4;
    scr[lane] = silu_f(cvec[k0 + lane]); scr[64 + lane] = silu_f(cvec[4096 + k0 + lane]); scr[128 + lane] = silu_f(cctx[k0 + lane]);
    LDS_WAIT(); asm volatile("" ::: "memory");
    f32x4 a0 = {0.f, 0.f, 0.f, 0.f}, a1 = a0, a2 = a0;
    const float* wp = wmod + ((size_t)l * 4096 + k0) * 12288 + n0;
#pragma unroll 16
    for (int k = 0; k < 64; ++k) { const f32x4 w = *(const f32x4*)(wp + (size_t)k * 12288); a0 += scr[k] * w; a1 += scr[64 + k] * w; a2 += scr[128 + k] * w; }
    float* o = MODP + ((size_t)(l * 64 + kc) * 3) * 12288 + n0;
    *(f32x4*)(o) = a0; *(f32x4*)(o + 12288) = a1; *(f32x4*)(o + 2 * 12288) = a2;
    LDS_WAIT(); asm volatile("" ::: "memory");
}
__device__ __forceinline__ void sincos_acc(float ang, float& c, float& s) {
    const double x = (double)ang; const double n = __builtin_rint(x * 0.63661977236758134308); const double r = x - n * 1.57079632679489661923;
    const double r2 = r * r;
    const double sp = r * (1.0 + r2 * (-1.0 / 6 + r2 * (1.0 / 120 + r2 * (-1.0 / 5040 + r2 * (1.0 / 362880 + r2 * (-1.0 / 39916800 + r2 * (1.0 / 6227020800.0)))))));
    const double cp = 1.0 + r2 * (-0.5 + r2 * (1.0 / 24 + r2 * (-1.0 / 720 + r2 * (1.0 / 40320 + r2 * (-1.0 / 3628800 + r2 * (1.0 / 479001600 + r2 * (-1.0 / 87178291200.0)))))));
    const int q = ((int)n) & 3;
    const double cc = (q == 0) ? cp : (q == 1) ? -sp : (q == 2) ? -cp : sp;
    const double ss = (q == 0) ? sp : (q == 1) ? cp : (q == 2) ? -sp : -cp;
    c = (float)cc; s = (float)ss;
}

__device__ __forceinline__ void phase_xn(const float* hlat, const float* hctx, const float* mod, bf16* XN, int gw, int NGW, int lane) {
    for (int m = gw; m < MROWS; m += NGW) {
        const float* src = m < NLAT ? hlat + (size_t)m * DM : hctx + (size_t)(m - NLAT) * DM;
        const int cond = m < NLAT ? (m >> 13) : 2;
        const f32x4* s4 = (const f32x4*)src + lane;
        f32x4 v[16]; float ss = 0.f;
#pragma unroll
        for (int j = 0; j < 16; ++j) { v[j] = s4[64 * j]; ss += (v[j].x * v[j].x + v[j].y * v[j].y) + (v[j].z * v[j].z + v[j].w * v[j].w); }
        ss = wave_sum(ss);
        const float rstd = 1.0f / sqrtf(ss * (1.f / 4096.f) + 1e-6f);
        const f32x4* sh4 = (const f32x4*)(mod + cond * 12288) + lane; const f32x4* sc4 = (const f32x4*)(mod + cond * 12288 + 4096) + lane;
        v2u* o = (v2u*)(XN + (size_t)m * DM) + lane;
#pragma unroll
        for (int j = 0; j < 16; ++j) { const f32x4 sh = sh4[64 * j], sc = sc4[64 * j]; const f32x4 x = v[j] * rstd * (sc + 1.f) + sh; v2u w; w.x = pk2(x.x, x.y); w.y = pk2(x.z, x.w); o[64 * j] = w; }
    }
}

__device__ __forceinline__ void phase_rowprep(const bf16* P, const float* qgain, const float* kgain, const f32x2* tab, bf16* QN, bf16* KN, f32x2* SGST, int gw, int NGW, int lane) {
    const int sub = lane & 3;
    for (int m = gw; m < MROWS; m += NGW) {
        const bf16* pr = P + (size_t)m * NIN;
        const bool isctx = m >= NLAT; const int t = isctx ? ((m - NLAT) & 255) : (m & 8191);
        {   float x[16]; unpack8(*(const v4u*)(pr + C_SGV + 16 * lane), x); unpack8(*(const v4u*)(pr + C_SGV + 16 * lane + 8), x + 8);
            float s = 0.f;
#pragma unroll
            for (int i = 0; i < 16; ++i) s += x[i];
            const float mean = wave_sum(s) * (1.f / 1024.f); float q = 0.f;
#pragma unroll
            for (int i = 0; i < 16; ++i) { const float dlt = x[i] - mean; q += dlt * dlt; }
            const float var = wave_sum(q) * (1.f / 1024.f);
            if (lane == 0) SGST[m] = (f32x2){mean, 1.0f / sqrtf(var + 1e-5f)}; }
        float q[16], k[16];
        unpack8(*(const v4u*)(pr + C_NAQ + 16 * lane), q); unpack8(*(const v4u*)(pr + C_NAQ + 16 * lane + 8), q + 8);
        unpack8(*(const v4u*)(pr + C_NAK + 16 * lane), k); unpack8(*(const v4u*)(pr + C_NAK + 16 * lane + 8), k + 8);
        float sq = 0.f, sk = 0.f;
#pragma unroll
        for (int i = 0; i < 16; ++i) { sq += q[i] * q[i]; sk += k[i] * k[i]; }
        sq += __shfl_xor(sq, 1); sq += __shfl_xor(sq, 2); sk += __shfl_xor(sk, 1); sk += __shfl_xor(sk, 2);
        const float rq = 1.0f / sqrtf(sq * (1.f / 64.f) + 1e-6f), rk = 1.0f / sqrtf(sk * (1.f / 64.f) + 1e-6f);
#pragma unroll
        for (int i = 0; i < 16; ++i) { q[i] *= rq * qgain[16 * sub + i]; k[i] *= rk * kgain[16 * sub + i]; }
        if (!isctx) {
            const int pos = sub < 2 ? (t >> 6) : (t & 63);
#pragma unroll
            for (int i = 0; i < 16; ++i) { const f32x2 cs = tab[pos * 16 + i]; const float pq = __shfl_xor(q[i], 1), pkk = __shfl_xor(k[i], 1);
                q[i] = (sub & 1) ? (q[i] * cs.x + pq * cs.y) : (q[i] * cs.x - pq * cs.y);
                k[i] = (sub & 1) ? (k[i] * cs.x + pkk * cs.y) : (k[i] * cs.x - pkk * cs.y); }
        }
#pragma unroll
        for (int i = 0; i < 16; ++i) q[i] *= 0.125f;
        *(v4u*)(QN + (size_t)m * GWD + 16 * lane) = pack8(q); *(v4u*)(QN + (size_t)m * GWD + 16 * lane + 8) = pack8(q + 8);
        *(v4u*)(KN + (size_t)m * GWD + 16 * lane) = pack8(k); *(v4u*)(KN + (size_t)m * GWD + 16 * lane + 8) = pack8(k + 8);
    }
}
__device__ __forceinline__ void phase_vt(const bf16* P, bf16* VTL, bf16* VTC, int gw, int NGW, int lane) {
    for (int u = gw; u < (MROWS / 64) * 16; u += NGW) {
        const int tt = u >> 4, h = u & 15, m0 = tt * 64;
        const bf16* src = P + (size_t)m0 * NIN + C_NAV + h * 64 + lane;
        unsigned w[32];
#pragma unroll
        for (int i = 0; i < 32; ++i) { const unsigned lo = src[(size_t)(2 * i) * NIN], hi = src[(size_t)(2 * i + 1) * NIN]; w[i] = lo | (hi << 16); }
        bf16* dst = tt < 256 ? VTL + (((size_t)((tt >> 7) * 16 + h) * 64 + lane) * 8192 + (tt & 127) * 64)
                             : VTC + (((size_t)(((tt - 256) >> 2) * 16 + h) * 64 + lane) * 256 + ((tt - 256) & 3) * 64);
#pragma unroll
        for (int j = 0; j < 8; ++j) { v4u o; o.x = w[4 * j]; o.y = w[4 * j + 1]; o.z = w[4 * j + 2]; o.w = w[4 * j + 3]; ((v4u*)dst)[j] = o; }
    }
}
template <int G>
__device__ __forceinline__ void pool_unit(const bf16* P, const bf16* wbase, const float* pscale, bf16* Y, int m0, int lane) {
    constexpr int WIN = 2 << G;
    const int r = lane & 15, q4 = lane >> 4, m = m0 + r;
    const bool isctx = m0 >= NLAT; const int T = isctx ? CTXL : SEQ; const int t = isctx ? ((m - NLAT) & 255) : (m & 8191);
    const int tlo = t - (WIN >> 1);
    const int lo = tlo < 0 ? 0 : tlo, hi = (tlo + WIN) > T ? T : (tlo + WIN);
    const float inv = 1.0f / (float)(hi - lo);
    f32x4 acc[16];
#pragma unroll
    for (int nt = 0; nt < 16; ++nt) acc[nt] = (f32x4){0.f, 0.f, 0.f, 0.f};
#pragma unroll 1
    for (int ks = 0; ks < 8; ++ks) {
        const int ch0 = C_POOLV + G * 256 + 32 * ks + 8 * q4;
        constexpr int WB = WIN < 8 ? WIN : 8;
        bf16x8 bfr[8];
        float sum[8];
#pragma unroll
        for (int j = 0; j < 8; ++j) sum[j] = 0.f;
        const v4u selfw = *(const v4u*)(P + (size_t)m * NIN + ch0);
#pragma unroll
        for (int nt = 0; nt < 8; ++nt) bfr[nt] = ld_frag(wbase + (size_t)(16 * nt + r) * 256 + 32 * ks + 8 * q4);
#pragma unroll
        for (int k0 = 0; k0 < WIN; k0 += WB) {
            v4u wl[WB];
#pragma unroll
            for (int k = 0; k < WB; ++k) { const int tk = tlo + k0 + k; const bool ok = tk >= 0 && tk < T; wl[k] = *(const v4u*)(P + (size_t)(ok ? (m - t + tk) : m) * NIN + ch0); }
            __builtin_amdgcn_sched_barrier(0);
#pragma unroll
            for (int k = 0; k < WB; ++k) { const int tk = tlo + k0 + k; const bool ok = tk >= 0 && tk < T; float x[8]; unpack8(wl[k], x);
#pragma unroll
                for (int j = 0; j < 8; ++j) sum[j] += ok ? x[j] : 0.f; }
            __builtin_amdgcn_sched_barrier(0);
        }
        float self[8]; unpack8(selfw, self);
        float dv[8];
#pragma unroll
        for (int j = 0; j < 8; ++j) dv[j] = sum[j] * inv - self[j];
        const bf16x8 af = __builtin_bit_cast(bf16x8, pack8(dv));
        __builtin_amdgcn_sched_barrier(0);
        bf16x8 bfr2[8];
#pragma unroll
        for (int nt = 0; nt < 8; ++nt) bfr2[nt] = ld_frag(wbase + (size_t)(16 * (nt + 8) + r) * 256 + 32 * ks + 8 * q4);
        __builtin_amdgcn_sched_barrier(0);
#pragma unroll
        for (int nt = 0; nt < 8; ++nt) acc[nt] = mfma16(af, bfr[nt], acc[nt]);
        __builtin_amdgcn_sched_barrier(0);
#pragma unroll
        for (int nt = 0; nt < 8; ++nt) acc[nt + 8] = mfma16(af, bfr2[nt], acc[nt + 8]);
        __builtin_amdgcn_sched_barrier(0);
    }
#pragma unroll
    for (int nh = 0; nh < 4; ++nh) {
        unsigned short zz[4][4]; float ps[4];
#pragma unroll
        for (int nq = 0; nq < 4; ++nq) { const int oc = G * 256 + 16 * (4 * nh + nq) + r; ps[nq] = pscale[oc];
#pragma unroll
            for (int i = 0; i < 4; ++i) zz[nq][i] = P[(size_t)(m0 + 4 * q4 + i) * NIN + C_POOLZ + oc]; }
        __builtin_amdgcn_sched_barrier(0);
#pragma unroll
        for (int nq = 0; nq < 4; ++nq) { const int oc = G * 256 + 16 * (4 * nh + nq) + r;
#pragma unroll
            for (int i = 0; i < 4; ++i) Y[(size_t)(m0 + 4 * q4 + i) * DM + oc] = (bf16)f2bf(acc[4 * nh + nq][i] * ps[nq] * silu_f(bf2f(zz[nq][i]))); }
        __builtin_amdgcn_sched_barrier(0);
    }
}
__device__ __forceinline__ void phase_pool(const bf16* P, const bf16* PWT  , const float* pscale, bf16* Y, int nrows, int gw, int NGW, int lane) {
    for (int u = gw; u < (nrows / 16) * 4; u += NGW) {
        const int tt = u >> 2, g = u & 3, m0 = tt * 16;
        const bf16* wbase = PWT + (size_t)g * 65536;
        if (g == 0) pool_unit<0>(P, wbase, pscale, Y, m0, lane);
        else if (g == 1) pool_unit<1>(P, wbase, pscale, Y, m0, lane);
        else if (g == 2) pool_unit<2>(P, wbase, pscale, Y, m0, lane);
        else pool_unit<3>(P, wbase, pscale, Y, m0, lane);
    }
}
__device__ __forceinline__ void phase_rwprep(const bf16* P, const float* mu_rkv  , const float* mu_lora  , const float* w0  , const bf16* WUPT  ,
                                             const float* a0, const bf16* AUPT, const float* k_k, const float* k_a, const float* r_k, float* REC, float* BON, int gw, int NGW, int lane) {
    const int r = lane & 15, q4 = lane >> 4;
    for (int u = gw; u < (MROWS / 16) * 16; u += NGW) {
        const int tt = u >> 4, d = (u >> 3) & 1, hp = u & 7, m0 = tt * 16;
        const bool isctx = m0 >= NLAT; const int T = isctx ? CTXL : SEQ; const int t0 = isctx ? ((m0 - NLAT) & 255) : (m0 & 8191); const int b = isctx ? ((m0 - NLAT) >> 8) : (m0 >> 13);
        bf16x8 Aw[2], Aa[2];
        {   const int mA = m0 + r, tA = t0 + r; const bool hasnb = d == 0 ? (tA > 0) : (tA < T - 1); const int nbA = hasnb ? (d == 0 ? mA - 1 : mA + 1) : mA;
            v4u cw[2], nw[2], ca[2], na[2];
#pragma unroll
            for (int ks = 0; ks < 2; ++ks) { const int j0 = 32 * ks + 8 * q4;
                cw[ks] = *(const v4u*)(P + (size_t)mA * NIN + C_RWWD + d * 64 + j0); nw[ks] = *(const v4u*)(P + (size_t)nbA * NIN + C_RWWD + d * 64 + j0);
                ca[ks] = *(const v4u*)(P + (size_t)mA * NIN + C_RWAD + d * 64 + j0); na[ks] = *(const v4u*)(P + (size_t)nbA * NIN + C_RWAD + d * 64 + j0); }
            __builtin_amdgcn_sched_barrier(0);
#pragma unroll
            for (int ks = 0; ks < 2; ++ks) { const int j0 = 32 * ks + 8 * q4;
                float cur[8], nb[8], o[8];
                unpack8(cw[ks], cur); unpack8(nw[ks], nb);
#pragma unroll
                for (int j = 0; j < 8; ++j) o[j] = tanhf(cur[j] + ((hasnb ? nb[j] : 0.f) - cur[j]) * mu_lora[(d * 2 + 0) * 64 + j0 + j]);
                Aw[ks] = __builtin_bit_cast(bf16x8, pack8(o));
                unpack8(ca[ks], cur); unpack8(na[ks], nb);
#pragma unroll
                for (int j = 0; j < 8; ++j) o[j] = cur[j] + ((hasnb ? nb[j] : 0.f) - cur[j]) * mu_lora[(d * 2 + 1) * 64 + j0 + j];
                Aa[ks] = __builtin_bit_cast(bf16x8, pack8(o)); }
        }
#pragma unroll 1
        for (int hh = 0; hh < 2; ++hh) {
            const int head = hp * 2 + hh;
            float KK[4][4], Av[4][4];
            float ss[4] = {0.f, 0.f, 0.f, 0.f}, bon[4] = {0.f, 0.f, 0.f, 0.f};
            const int chain = (b * 2 + d) * 16 + head;
            const int pos0 = scan_pos(d, isctx, t0 + 4 * q4), dpos = d == 0 ? 1 : -1;
            float* const rec0 = REC + ((size_t)chain * SCANLEN + pos0) * RECF + r;
            const int tq = t0 + 4 * q4; const bool evalid = d == 0 ? (tq > 0) : (tq + 4 < T); const int erow = evalid ? (d == 0 ? m0 + 4 * q4 - 1 : m0 + 4 * q4 + 4) : (m0 + 4 * q4);
#pragma unroll
            for (int n4 = 0; n4 < 4; ++n4) {
                const int ch = head * 64 + 16 * n4 + r;
                const bf16x8 bw0 = ld_frag(WUPT + (size_t)(d * 1024 + ch) * 64 + 8 * q4), bw1 = ld_frag(WUPT + (size_t)(d * 1024 + ch) * 64 + 32 + 8 * q4);
                const bf16x8 ba0 = ld_frag(AUPT + (size_t)(d * 1024 + ch) * 64 + 8 * q4), ba1 = ld_frag(AUPT + (size_t)(d * 1024 + ch) * 64 + 32 + 8 * q4);
                const float w0v = w0[d * 1024 + ch], a0v = a0[d * 1024 + ch], mur = mu_rkv[(d * 3 + 0) * 1024 + ch], muk = mu_rkv[(d * 3 + 1) * 1024 + ch], muv = mu_rkv[(d * 3 + 2) * 1024 + ch];
                const float kkv = k_k[ch], kav = k_a[ch], rkv = r_k[ch];
                unsigned short rcu[5], kcu[5], vcu[5];
#pragma unroll
                for (int i = 0; i < 5; ++i) { const bf16* pc = P + (size_t)(i < 4 ? m0 + 4 * q4 + i : erow) * NIN + ch; rcu[i] = pc[C_RWR]; kcu[i] = pc[C_RWK]; vcu[i] = pc[C_RWV]; }
                __builtin_amdgcn_sched_barrier(0);
                f32x4 accW = {0.f, 0.f, 0.f, 0.f}, accA = accW;
                accW = mfma16(Aw[0], bw0, accW); accW = mfma16(Aw[1], bw1, accW); accA = mfma16(Aa[0], ba0, accA); accA = mfma16(Aa[1], ba1, accA);
                float rcf[5], kcf[5], vcf[5];
#pragma unroll
                for (int i = 0; i < 5; ++i) { rcf[i] = bf2f(rcu[i]); kcf[i] = bf2f(kcu[i]); vcf[i] = bf2f(vcu[i]); }
                if (!evalid) { rcf[4] = 0.f; kcf[4] = 0.f; vcf[4] = 0.f; }
#pragma unroll
                for (int i = 0; i < 4; ++i) {
                    constexpr int dummy_ = 0; (void)dummy_;
                    const int ip = i > 0 ? i - 1 : 4, in_ = i < 3 ? i + 1 : 4;
                    const float rc = rcf[i], kc = kcf[i], vc = vcf[i];
                    const float rn = d == 0 ? rcf[ip] : rcf[in_], kn = d == 0 ? kcf[ip] : kcf[in_], vn = d == 0 ? vcf[ip] : vcf[in_];
                    const float rr = rc + (rn - rc) * mur, kk0 = kc + (kn - kc) * muk, vv = vc + (vn - vc) * muv;
                    const float xw = -(w0v + accW[i]);
                    const float sp = fmaxf(xw, 0.f) + log1pf(__expf(-fabsf(xw)));
                    const float dec = __expf(-__expf(-sp - 0.5f));
                    const float av = 1.0f / (1.0f + __expf(-(a0v + accA[i])));
                    const float kx = kk0 * kkv; ss[i] += kx * kx;
                    const float kp = kk0 * (1.f + (av - 1.f) * kav); bon[i] += rr * kp * rkv;
                    KK[n4][i] = kx; Av[n4][i] = av;
                    float* o = rec0 + (ptrdiff_t)(i * dpos) * RECF + 16 * n4;
                    o[0] = dec; o[192] = kp; o[256] = rr; o[320] = vv; }
                __builtin_amdgcn_sched_barrier(0);
            }
#pragma unroll
            for (int i = 0; i < 4; ++i) { const float s = red16(ss[i]), bo = red16(bon[i]); const float inv = 1.0f / sqrtf(fmaxf(s, 1e-12f));
                float* rec = rec0 + (ptrdiff_t)(i * dpos) * RECF;
#pragma unroll
                for (int n4 = 0; n4 < 4; ++n4) { const float kkn = KK[n4][i] * inv; rec[16 * n4 + 64] = kkn; rec[16 * n4 + 128] = -(kkn * Av[n4][i]); }
                if (r == 0) BON[(size_t)chain * SCANLEN + pos0 + i * dpos] = bo; }
        }
    }
}
template <bool CTXQ>
__device__ __forceinline__ void na_unit(const bf16* QN, const bf16* KN, const bf16* VTL, const bf16* VTC, const bf16* P, const float* rpb  , bf16* Y, int u, int lane) {
    const int n = lane & 15, q4 = lane >> 4;
    int b, h, qrow0, qr = 0, jt = 0;
    if (CTXQ) { b = u >> 8; h = (u >> 4) & 15; qrow0 = NLAT + b * CTXL + 16 * (u & 15); }
    else { jt = u & 3; h = (u >> 2) & 15; qr = (u >> 6) & 127; b = u >> 13; qrow0 = b * SEQ + qr * 64 + 16 * jt; }
    constexpr int NT = CTXQ ? 16 : 32, WT = CTXQ ? 0 : 16;
    f32x4 s[NT];
    const int rs = qr - 4 < 0 ? 0 : (qr - 4 > 120 ? 120 : qr - 4);
    const int span0 = jt == 0 ? 0 : (jt == 1 ? 8 : (jt == 2 ? 24 : 32));
    const int qc = 16 * jt + n; const int cs = qc - 8 < 0 ? 0 : (qc - 8 > 48 ? 48 : qc - 8);
    bf16x8 qf[2];
#pragma unroll
    for (int ks = 0; ks < 2; ++ks) qf[ks] = ld_frag(QN + (size_t)(qrow0 + n) * GWD + h * 64 + 32 * ks + 8 * q4);
    if (!CTXQ) {
        const float* rp = rpb + (size_t)h * 15 * 31;
#pragma unroll
        for (int wt = 0; wt < 16; ++wt) { const int kri = wt >> 1, half = wt & 1, relr = rs + kri - qr + 7;
#pragma unroll
            for (int i = 0; i < 4; ++i) { const int relc = span0 + 16 * half + 4 * q4 + i - qc + 15; const int relcc = relc < 0 ? 0 : (relc > 30 ? 30 : relc); s[wt][i] = rp[relr * 31 + relcc]; } }
        __builtin_amdgcn_sched_barrier(0);
#pragma unroll
        for (int bt = 0; bt < 2; ++bt) {
            bf16x8 kf[16];
#pragma unroll
            for (int t = 0; t < 8; ++t) { const int wt = bt * 8 + t, kri = wt >> 1, half = wt & 1;
                const bf16* kp = KN + (size_t)(b * SEQ + (rs + kri) * 64 + span0 + 16 * half + n) * GWD + h * 64 + 8 * q4; kf[2 * t] = ld_frag(kp); kf[2 * t + 1] = ld_frag(kp + 32); }
            __builtin_amdgcn_sched_barrier(0);
#pragma unroll
            for (int t = 0; t < 8; ++t) { const int wt = bt * 8 + t, half = wt & 1;
                f32x4 a = s[wt];
#pragma unroll
                for (int i = 0; i < 4; ++i) { const int kc = span0 + 16 * half + 4 * q4 + i; const bool ok = kc >= cs && kc < cs + 16; a[i] = ok ? a[i] : -INFINITY; }
                a = mfma16(kf[2 * t], qf[0], a); a = mfma16(kf[2 * t + 1], qf[1], a); s[wt] = a; }
            __builtin_amdgcn_sched_barrier(0);
        }
    }
#pragma unroll
    for (int bt = 0; bt < 2; ++bt) {
        bf16x8 kf[16];
#pragma unroll
        for (int t = 0; t < 8; ++t) { const bf16* kp = KN + (size_t)(NLAT + b * CTXL + 16 * (bt * 8 + t) + n) * GWD + h * 64 + 8 * q4; kf[2 * t] = ld_frag(kp); kf[2 * t + 1] = ld_frag(kp + 32); }
        __builtin_amdgcn_sched_barrier(0);
#pragma unroll
        for (int t = 0; t < 8; ++t) { f32x4 a = {0.f, 0.f, 0.f, 0.f}; a = mfma16(kf[2 * t], qf[0], a); a = mfma16(kf[2 * t + 1], qf[1], a); s[WT + bt * 8 + t] = a; }
        __builtin_amdgcn_sched_barrier(0);
    }
    float mx = -INFINITY;
#pragma unroll
    for (int t = 0; t < NT; ++t) mx = fmaxf(fmaxf(fmaxf(s[t][0], s[t][1]), fmaxf(s[t][2], s[t][3])), mx);
    mx = max16x4(mx);
    float sum = 0.f;
#pragma unroll
    for (int t = 0; t < NT; ++t) {
#pragma unroll
        for (int i = 0; i < 4; ++i) { const float e = __expf(s[t][i] - mx); s[t][i] = e; sum += e; } }
    sum = sum16x4(sum);
    const float inv = 1.0f / sum;
    f32x4 o[4];
#pragma unroll
    for (int nt = 0; nt < 4; ++nt) o[nt] = (f32x4){0.f, 0.f, 0.f, 0.f};
#pragma unroll
    for (int tb = 0; tb < NT / 8; ++tb) {
        v2u vv[4][4][2];
#pragma unroll
        for (int tq = 0; tq < 4; ++tq) { const int tp = tb * 4 + tq;
            const bf16* vb; size_t dstride;
            if (!CTXQ && tp < 8) { vb = VTL + ((size_t)(b * 16 + h) * 64 + n) * 8192 + (rs + tp) * 64 + span0 + 4 * q4; dstride = (size_t)16 * 8192; }
            else { const int ct = 2 * (tp - (CTXQ ? 0 : 8)); vb = VTC + ((size_t)(b * 16 + h) * 64 + n) * 256 + 16 * ct + 4 * q4; dstride = (size_t)16 * 256; }
#pragma unroll
            for (int nt = 0; nt < 4; ++nt) { vv[tq][nt][0] = *(const v2u*)(vb + nt * dstride); vv[tq][nt][1] = *(const v2u*)(vb + nt * dstride + 16); } }
        __builtin_amdgcn_sched_barrier(0);
#pragma unroll
        for (int tq = 0; tq < 4; ++tq) { const int tp = tb * 4 + tq;
            const f32x4 p0 = s[2 * tp] * inv, p1 = s[2 * tp + 1] * inv;
            v4u aw; aw.x = pk2(p0[0], p0[1]); aw.y = pk2(p0[2], p0[3]); aw.z = pk2(p1[0], p1[1]); aw.w = pk2(p1[2], p1[3]);
            const bf16x8 af = __builtin_bit_cast(bf16x8, aw);
#pragma unroll
            for (int nt = 0; nt < 4; ++nt) { v4u bw; bw.x = vv[tq][nt][0].x; bw.y = vv[tq][nt][0].y; bw.z = vv[tq][nt][1].x; bw.w = vv[tq][nt][1].y;
                o[nt] = mfma16(af, __builtin_bit_cast(bf16x8, bw), o[nt]); } }
        __builtin_amdgcn_sched_barrier(0);
    }
    unsigned short zz[4][4];
#pragma unroll
    for (int nt = 0; nt < 4; ++nt)
#pragma unroll
        for (int i = 0; i < 4; ++i) zz[nt][i] = P[(size_t)(qrow0 + 4 * q4 + i) * NIN + C_NAZ + h * 64 + 16 * nt + n];
    __builtin_amdgcn_sched_barrier(0);
#pragma unroll
    for (int nt = 0; nt < 4; ++nt)
#pragma unroll
        for (int i = 0; i < 4; ++i) { const int row = qrow0 + 4 * q4 + i, col = h * 64 + 16 * nt + n;
            Y[(size_t)row * DM + 1024 + col] = (bf16)f2bf(o[nt][i] * silu_f(bf2f(zz[nt][i]))); }
}
__device__ __forceinline__ void phase_sgu(const bf16* P, const f32x2* SGST, const float* lnw, const float* lnb, const bf16* SGW  , const float* sgb  , bf16* Y,
                                          LAS unsigned char* lds, int nchunks, int tid, int wave, int lane) {
    const int n = lane & 15, q4 = lane >> 4;
    LAS bf16* T = (LAS bf16*)lds;
    for (int u = blockIdx.x; u < nchunks * 8; u += 256) {
        const int ck = u >> 3, g = u & 7, m0 = ck * 128;
#pragma unroll
        for (int it = 0; it < 4; ++it) { const int idx = tid + 512 * it, q = idx >> 4, c8 = idx & 15;
            float x[8]; unpack8(*(const v4u*)(P + (size_t)(m0 + q) * NIN + C_SGV + g * 128 + 8 * c8), x);
            const f32x2 st = SGST[m0 + q];
#pragma unroll
            for (int j = 0; j < 8; ++j) { const int c = 8 * c8 + j; const float v = (x[j] - st.x) * st.y * lnw[g * 128 + c] + lnb[g * 128 + c]; T[c * 136 + q] = (bf16)f2bf(v); } }
        __syncthreads();
        bf16x8 af[4];
#pragma unroll
        for (int ks = 0; ks < 4; ++ks) af[ks] = ld_frag(SGW + ((size_t)g * 128 + 16 * wave + n) * 128 + 32 * ks + 8 * q4);
#pragma unroll
        for (int nt = 0; nt < 8; ++nt) {
            f32x4 acc = {0.f, 0.f, 0.f, 0.f};
#pragma unroll
            for (int ks = 0; ks < 4; ++ks) { const bf16x8 bfg = *(const LAS bf16x8*)(T + (16 * nt + n) * 136 + 32 * ks + 8 * q4); acc = mfma16(af[ks], bfg, acc); }
#pragma unroll
            for (int i = 0; i < 4; ++i) { const int p = 16 * wave + 4 * q4 + i, row = m0 + p, col = g * 128 + 16 * nt + n;
                const float mixed = acc[i] + sgb[g * 128 + p]; const bf16* pr = P + (size_t)row * NIN;
                const float uu = bf2f(pr[C_SGU + col]), z = bf2f(pr[C_SGZ + col]);
                Y[(size_t)row * DM + 3072 + col] = (bf16)f2bf(uu * mixed * silu_f(z)); }
        }
        __syncthreads();
    }
}
__device__ __forceinline__ void phase_scan(const float* REC, float* YR, LAS unsigned char* lds, int wave, int lane) {
    constexpr int NCH = SCANLEN / 16, SLOT = 16 * RECF * 4;
    for (int su = blockIdx.x; su < NCHAIN * 4; su += 256) {
        const int chain = (su & 7) * 8 + ((su >> 3) >> 2), part = (su >> 3) & 3;
        const char* recb = (const char*)(REC + (size_t)chain * SCANLEN * RECF);
        if (wave >= 4) {
            const int wl = wave - 4;
#define SCAN_ISSUE(cc, sl) do { _Pragma("unroll") for (int p_ = 0; p_ < 6; ++p_) \
            __builtin_amdgcn_global_load_lds((const unsigned*)(recb + (size_t)(cc) * SLOT + (wl * 6 + p_) * 1024 + lane * 16), (LAS unsigned*)(lds + (sl) * SLOT + (wl * 6 + p_) * 1024), 16, 0, 0); } while (0)
            SCAN_ISSUE(0, 0); SCAN_ISSUE(1, 1); SCAN_ISSUE(2, 2);
            for (int c = 0; c < NCH; ++c) {
                asm volatile("s_waitcnt vmcnt(12)" ::: "memory");
                __builtin_amdgcn_s_barrier();
                const int cc = c + 3 < NCH ? c + 3 : NCH - 1;
                SCAN_ISSUE(cc, (c + 3) & 3);
            }
            asm volatile("s_waitcnt vmcnt(0)" ::: "memory");
#undef SCAN_ISSUE
        } else {
            const int c16 = lane & 15, rg = lane >> 4, row = 16 * part + 4 * wave + rg;
            f32x2 Sa = {0.f, 0.f}, Sb = {0.f, 0.f};
            float* yout = YR + (size_t)chain * SCANLEN * 64 + row;
            const int lo_c = c16 * 16, lo_v = 1280 + row * 4;
#define SCAN_LD(dst, sl, s_) do { const LAS unsigned char* rec_ = (sl) + (s_) * (RECF * 4); dst##w = *(const LAS f32x4*)(rec_ + lo_c); dst##kk = *(const LAS f32x4*)(rec_ + 256 + lo_c); \
            dst##na = *(const LAS f32x4*)(rec_ + 512 + lo_c); dst##k = *(const LAS f32x4*)(rec_ + 768 + lo_c); dst##r = *(const LAS f32x4*)(rec_ + 1024 + lo_c); dst##v = *(const LAS float*)(rec_ + lo_v); } while (0)
            for (int c = 0; c < NCH; ++c) {
                __builtin_amdgcn_s_barrier();
                asm volatile("" ::: "memory");
                const LAS unsigned char* slot = lds + (c & 3) * SLOT;
                float ysave = 0.f, ypend = 0.f;
                f32x4 Aw, Akk, Ana, Ak, Ar; float Av;
                SCAN_LD(A, slot, 0);
#pragma unroll
                for (int s = 0; s < 16; ++s) {
                    f32x4 Bw, Bkk, Bna, Bk, Br; float Bv;
                    if (s < 15) SCAN_LD(B, slot, s + 1);
                    __builtin_amdgcn_sched_barrier(0);
                    f32x2 p = Sa * (f32x2){Akk.x, Akk.y}; p = __builtin_elementwise_fma(Sb, (f32x2){Akk.z, Akk.w}, p);
                    float dt = p.x + p.y, yr = ypend; red16x2(dt, yr);
                    const f32x2 vv = {Av, Av};
                    const f32x2 ua = __builtin_elementwise_fma(Sa, (f32x2){Aw.x, Aw.y}, vv * (f32x2){Ak.x, Ak.y}), ub = __builtin_elementwise_fma(Sb, (f32x2){Aw.z, Aw.w}, vv * (f32x2){Ak.z, Ak.w});
                    const f32x2 d2 = {dt, dt};
                    Sa = __builtin_elementwise_fma(d2, (f32x2){Ana.x, Ana.y}, ua); Sb = __builtin_elementwise_fma(d2, (f32x2){Ana.z, Ana.w}, ub);
                    if (s > 0) ysave = (c16 == s - 1) ? yr : ysave;
                    f32x2 q = Sa * (f32x2){Ar.x, Ar.y}; q = __builtin_elementwise_fma(Sb, (f32x2){Ar.z, Ar.w}, q);
                    ypend = q.x + q.y;
                    __builtin_amdgcn_sched_barrier(0);
                    if (s < 15) { Aw = Bw; Akk = Bkk; Ana = Bna; Ak = Bk; Ar = Br; Av = Bv; }
                }
                { const float y = red16(ypend); ysave = (c16 == 15) ? y : ysave; }
                asm volatile("" ::: "memory");
                yout[(size_t)(c * 16 + c16) * 64] = ysave;
            }
#undef SCAN_LD
        }
        __syncthreads();
    }
}
__device__ __forceinline__ void scan_self(const float* REC, float* YR, LAS unsigned char* lds, LAS unsigned* bcnt, int su, int wave, int lane) {
    constexpr int NCH = SCANLEN / 16, SLOT = 16 * RECF * 4;
    const int chain = (su & 7) * 8 + ((su >> 3) >> 2), part = (su >> 3) & 3;
    const char* recb = (const char*)(REC + (size_t)chain * SCANLEN * RECF);
    const int wl = wave;
#define SCAN_ISSUE(cc, sl) do { _Pragma("unroll") for (int p_ = 0; p_ < 6; ++p_) \
    __builtin_amdgcn_global_load_lds((const unsigned*)(recb + (size_t)(cc) * SLOT + (wl * 6 + p_) * 1024 + lane * 16), (LAS unsigned*)(lds + (sl) * SLOT + (wl * 6 + p_) * 1024), 16, 0, 0); } while (0)
    SCAN_ISSUE(0, 0); SCAN_ISSUE(1, 1); SCAN_ISSUE(2, 2);
    const int c16 = lane & 15, rg = lane >> 4, row = 16 * part + 4 * wave + rg;
    f32x2 Sa = {0.f, 0.f}, Sb = {0.f, 0.f};
    float* yout = YR + (size_t)chain * SCANLEN * 64 + row;
    const int lo_c = c16 * 16, lo_v = 1280 + row * 4;
#define SCAN_LD(dst, sl, s_) do { const LAS unsigned char* rec_ = (sl) + (s_) * (RECF * 4); dst##w = *(const LAS f32x4*)(rec_ + lo_c); dst##kk = *(const LAS f32x4*)(rec_ + 256 + lo_c); \
    dst##na = *(const LAS f32x4*)(rec_ + 512 + lo_c); dst##k = *(const LAS f32x4*)(rec_ + 768 + lo_c); dst##r = *(const LAS f32x4*)(rec_ + 1024 + lo_c); dst##v = *(const LAS float*)(rec_ + lo_v); } while (0)
    for (int c = 0; c < NCH; ++c) {
        asm volatile("s_waitcnt vmcnt(12)" ::: "memory");
        {   const unsigned baddr = (unsigned)(size_t)bcnt, one = 1u;
            if (lane == 0) asm volatile("ds_add_u32 %0, %1" :: "v"(baddr), "v"(one) : "memory");
            const unsigned want = 4u * (unsigned)(c + 1); unsigned sp = 0, got;
            for (;;) { asm volatile("ds_read_b32 %0, %1\n\ts_waitcnt lgkmcnt(0)" : "=v"(got) : "v"(baddr) : "memory");
                if (__builtin_amdgcn_readfirstlane((int)got) >= (int)want) break; __builtin_amdgcn_s_sleep(1); if (++sp > (1u << 22)) break; } }
        asm volatile("" ::: "memory");
        {   const int cc = c + 3 < NCH ? c + 3 : NCH - 1; SCAN_ISSUE(cc, (c + 3) & 3); }
        const LAS unsigned char* slot = lds + (c & 3) * SLOT;
        float ysave = 0.f, ypend = 0.f;
        f32x4 Aw, Akk, Ana, Ak, Ar; float Av;
        SCAN_LD(A, slot, 0);
#pragma unroll
        for (int s = 0; s < 16; ++s) {
            f32x4 Bw, Bkk, Bna, Bk, Br; float Bv;
            if (s < 15) SCAN_LD(B, slot, s + 1);
            __builtin_amdgcn_sched_barrier(0);
            f32x2 p = Sa * (f32x2){Akk.x, Akk.y}; p = __builtin_elementwise_fma(Sb, (f32x2){Akk.z, Akk.w}, p);
            float dt = p.x + p.y, yr = ypend; red16x2(dt, yr);
            const f32x2 vv = {Av, Av};
            const f32x2 ua = __builtin_elementwise_fma(Sa, (f32x2){Aw.x, Aw.y}, vv * (f32x2){Ak.x, Ak.y}), ub = __builtin_elementwise_fma(Sb, (f32x2){Aw.z, Aw.w}, vv * (f32x2){Ak.z, Ak.w});
            const f32x2 d2 = {dt, dt};
            Sa = __builtin_elementwise_fma(d2, (f32x2){Ana.x, Ana.y}, ua); Sb = __builtin_elementwise_fma(d2, (f32x2){Ana.z, Ana.w}, ub);
            if (s > 0) ysave = (c16 == s - 1) ? yr : ysave;
            f32x2 q = Sa * (f32x2){Ar.x, Ar.y}; q = __builtin_elementwise_fma(Sb, (f32x2){Ar.z, Ar.w}, q);
            ypend = q.x + q.y;
            __builtin_amdgcn_sched_barrier(0);
            if (s < 15) { Aw = Bw; Akk = Bkk; Ana = Bna; Ak = Bk; Ar = Br; Av = Bv; }
        }
        { const float y = red16(ypend); ysave = (c16 == 15) ? y : ysave; }
        asm volatile("" ::: "memory");
        yout[(size_t)(c * 16 + c16) * 64] = ysave;
    }
    asm volatile("s_waitcnt vmcnt(0)" ::: "memory");
#undef SCAN_LD
#undef SCAN_ISSUE
}
__device__ __forceinline__ void phase_rwfin(const bf16* P, const float* YR, const float* REC, const float* BON, const float* lnw, const float* lnb, bf16* Y, int nrows, int gw, int NGW, int lane) {
    const int head = lane >> 2, sub = lane & 3;
    for (int m = gw; m < nrows; m += NGW) {
        const bool isctx = m >= NLAT; const int t = isctx ? ((m - NLAT) & 255) : (m & 8191); const int b = isctx ? ((m - NLAT) >> 8) : (m >> 13);
        float out[16];
#pragma unroll
        for (int i = 0; i < 16; ++i) out[i] = 0.f;
#pragma unroll
        for (int d = 0; d < 2; ++d) {
            const int chain = (b * 2 + d) * 16 + head; const size_t pp = (size_t)chain * SCANLEN + scan_pos(d, isctx, t);
            float y[16], v[16];
#pragma unroll
            for (int j = 0; j < 4; ++j) { const f32x4 a = *(const f32x4*)(YR + pp * 64 + 16 * sub + 4 * j), c = *(const f32x4*)(REC + pp * RECF + 320 + 16 * sub + 4 * j);
                y[4 * j] = a.x; y[4 * j + 1] = a.y; y[4 * j + 2] = a.z; y[4 * j + 3] = a.w; v[4 * j] = c.x; v[4 * j + 1] = c.y; v[4 * j + 2] = c.z; v[4 * j + 3] = c.w; }
            const float bo = BON[pp];
            float s = 0.f;
#pragma unroll
            for (int i = 0; i < 16; ++i) s += y[i];
            s += __shfl_xor(s, 1); s += __shfl_xor(s, 2);
            const float mean = s * (1.f / 64.f); float q = 0.f;
#pragma unroll
            for (int i = 0; i < 16; ++i) { const float dl = y[i] - mean; q += dl * dl; }
            q += __shfl_xor(q, 1); q += __shfl_xor(q, 2);
            const float rstd = 1.0f / sqrtf(q * (1.f / 64.f) + 64e-5f);
#pragma unroll
            for (int i = 0; i < 16; ++i) { const int ch = head * 64 + 16 * sub + i; out[i] += (y[i] - mean) * rstd * lnw[ch] + lnb[ch] + bo * v[i]; }
        }
        float z[16]; unpack8(*(const v4u*)(P + (size_t)m * NIN + C_RWZ + 16 * lane), z); unpack8(*(const v4u*)(P + (size_t)m * NIN + C_RWZ + 16 * lane + 8), z + 8);
#pragma unroll
        for (int i = 0; i < 16; ++i) out[i] *= silu_f(z[i]);
        *(v4u*)(Y + (size_t)m * DM + 2048 + 16 * lane) = pack8(out); *(v4u*)(Y + (size_t)m * DM + 2048 + 16 * lane + 8) = pack8(out + 8);
    }
}
#define XB_TMO      128
#define XB_XCNT(j)  (256  + 64 * (j))
#define XB_XSUB(j)  (1280 + 64 * (j))
#define XB_XGEN(j)  (2304 + 64 * (j))
#define XB_TOP      3328
#define XB_TOPGEN   3392
#define XCD_BAR_WORDS 3456
#define XB_SPIN_CAP (1u << 18)

__device__ __forceinline__ unsigned xb_ld(unsigned* p)              { return __hip_atomic_load(p, __ATOMIC_RELAXED, __HIP_MEMORY_SCOPE_AGENT); }
__device__ __forceinline__ unsigned xb_add(unsigned* p, unsigned v) { return __hip_atomic_fetch_add(p, v, __ATOMIC_RELAXED, __HIP_MEMORY_SCOPE_AGENT); }
__device__ __forceinline__ unsigned xb_xcc_id() { return (unsigned)__builtin_amdgcn_s_getreg((3 << 11) | 20) & 0xFu; }
#define XB_SPIN(cond, bar) do { unsigned _sp = 0; while (cond) { __builtin_amdgcn_s_sleep(1); \
    if ((++_sp & 255u) == 0u) { if (xb_ld(&(bar)[XB_TMO])) break; if (_sp > XB_SPIN_CAP) { atomicAdd(&(bar)[XB_TMO], 1u); break; } } } } while (0)

struct XcdBarrier {
    unsigned* bar; unsigned x;
    volatile LAS unsigned* st;
};

__device__ __forceinline__ XcdBarrier xcd_barrier_post(unsigned* bar, volatile LAS unsigned* st) {
    XcdBarrier b; b.bar = bar; b.x = xb_xcc_id(); b.st = st;
    if (threadIdx.x == 0) (void)xb_add(&bar[XB_XCNT(b.x)], 1u);
    return b;
}
__device__ __forceinline__ void xcd_barrier_complete(unsigned* bar, unsigned x, unsigned& nloc, unsigned& nx) {
    const unsigned G = gridDim.x * gridDim.y * gridDim.z;
    unsigned sum, cnt, mine, sp = 0u;
    for (;;) {
        sum = 0u; cnt = 0u; mine = 0u;
#pragma unroll
        for (unsigned j = 0; j < 16; ++j) { const unsigned c = xb_ld(&bar[XB_XCNT(j)]); sum += c; cnt += (c > 0u) ? 1u : 0u; mine = (j == x) ? c : mine; }
        if (sum == G) break;
        __builtin_amdgcn_s_sleep(1);
        if ((++sp & 255u) == 0u) { if (xb_ld(&bar[XB_TMO])) break; if (sp > XB_SPIN_CAP) { atomicAdd(&bar[XB_TMO], 1u); break; } }
    }
    nloc = mine > 0u ? mine : 1u; nx = cnt > 0u ? cnt : 1u;
}

__device__ __forceinline__ void xcd_barrier(const XcdBarrier& b) {
    asm volatile("s_waitcnt vmcnt(0)" ::: "memory");
    __syncthreads();
    if (threadIdx.x == 0) {
        unsigned* bar = b.bar;
        __builtin_amdgcn_s_waitcnt(0);
        unsigned nloc = b.st[0], nx = b.st[1];
        if (nloc == 0u) { xcd_barrier_complete(bar, b.x, nloc, nx); b.st[0] = nloc; b.st[1] = nx; }
        const unsigned old = xb_add(&bar[XB_XSUB(b.x)], 1u);
        const unsigned gen = old / nloc;
        if (old + 1u == (gen + 1u) * nloc) {
            __builtin_amdgcn_fence(__ATOMIC_RELEASE, "agent");
            asm volatile("s_waitcnt vmcnt(0)" ::: "memory");
            const unsigned og = xb_add(&bar[XB_TOP], 1u);
            const unsigned tg = og / nx;
            if (og + 1u == (tg + 1u) * nx) xb_add(&bar[XB_TOPGEN], 1u);
            else XB_SPIN(xb_ld(&bar[XB_TOPGEN]) == tg, bar);
            __builtin_amdgcn_fence(__ATOMIC_ACQUIRE, "agent");
            xb_add(&bar[XB_XGEN(b.x)], 1u);
            asm volatile("s_waitcnt vmcnt(0)" ::: "memory");
        } else {
            XB_SPIN(xb_ld(&bar[XB_XGEN(b.x)]) == gen, bar);
            __builtin_amdgcn_fence(__ATOMIC_ACQUIRE, "agent");
            asm volatile("s_waitcnt vmcnt(0)" ::: "memory");
        }
    }
    __syncthreads();
}

#ifndef MK_SPLIT
#define MK_SPLIT 0
#endif
#ifndef REP_G1
#define REP_G1 1
#endif
#ifndef REP_PREP
#define REP_PREP 1
#endif
#ifndef REP_MIXA
#define REP_MIXA 1
#endif
#ifndef REP_RWP
#define REP_RWP 1
#endif
#ifndef REP_POOL
#define REP_POOL 1
#endif
#ifndef REP_NA
#define REP_NA 1
#endif
#ifndef REP_SGU
#define REP_SGU 1
#endif
#ifndef REP_ROWP
#define REP_ROWP 1
#endif
#ifndef REP_VT
#define REP_VT 1
#endif
#ifndef REP_SCAN
#define REP_SCAN 1
#endif
constexpr int NPHASE = 2 + 6 * DEPTH;
constexpr int NGRID = 256;
struct Args { const float* in[28]; float* out; unsigned char* ws; int ph_lo, ph_hi, li, pad; };

__global__ void __launch_bounds__(NWAVES * 64, 2) fwd(Args args) {
    extern __shared__ __attribute__((aligned(16))) unsigned char lds_raw[];
    LAS unsigned char* lds = (LAS unsigned char*)lds_raw;
    volatile LAS unsigned* MISC = (volatile LAS unsigned*)(lds + MISC_OFF);
    const int tid = threadIdx.x, lane = tid & 63, wave = __builtin_amdgcn_readfirstlane(tid >> 6);
    constexpr int G = NGRID; const int bx = blockIdx.x;
    const int vcu = (bx % 8) * (G / 8) + bx / 8;
    const int gw = vcu * NWAVES + wave; constexpr int NGW = G * NWAVES;
    unsigned char* ws = args.ws;
    const int lo = args.ph_lo, hi = args.ph_hi;

    for (int u = tid; u < (LDS_BYTES - LDSCTL_OFF) / 4; u += NWAVES * 64) ((LAS unsigned*)(lds + LDSCTL_OFF))[u] = 0u;
    __syncthreads();
    XcdBarrier bar; bar.bar = (unsigned*)(ws + WS_CTL) + CW_BAR; bar.x = 0; bar.st = MISC + 8;
    if (hi - lo > 1) bar = xcd_barrier_post((unsigned*)(ws + WS_CTL) + CW_BAR, MISC + 8);
#define IN(k) (lo <= (k) && (k) < hi)
#define SEAM(k) do { if (lo <= (k) && (k) + 1 < hi) { XcdBarrier b2_; b2_.bar = WSP(unsigned, WS_CTL) + CW_BAR; b2_.x = bar.x; b2_.st = bar.st; xcd_barrier(b2_); } } while (0)

#define OPQ_S(x) ({ int _t = (x); asm volatile("" : "+s"(_t)); _t; })
#define OPQ_V(x) ({ int _t = (x); asm volatile("" : "+v"(_t)); _t; })
#define INP(i) (args.in[OPQ_S(i)])
#define WSP(T, off) ((T*)(args.ws + ({ size_t _o = (off); asm volatile("" : "+s"(_o)); _o; })))
#define x_in INP(0)
#define c_in INP(1)
#define ctx_in INP(2)
#define cctx_in INP(3)
#define w_mod INP(4)
#define b_mod INP(5)
#define w_in INP(6)
#define w_out INP(7)
#define pool_w INP(8)
#define pool_scale INP(9)
#define na_qg INP(10)
#define na_kg INP(11)
#define na_rpb INP(12)
#define rw_mu_rkv INP(13)
#define rw_mu_lora INP(14)
#define rw_w0 INP(15)
#define rw_w_up INP(16)
#define rw_a0 INP(17)
#define rw_a_up INP(18)
#define rw_k_k INP(19)
#define rw_k_a INP(20)
#define rw_r_k INP(21)
#define rw_ln_w INP(22)
#define rw_ln_b INP(23)
#define sg_ln_w INP(24)
#define sg_ln_b INP(25)
#define sg_w INP(26)
#define sg_b INP(27)
#define MOD WSP(float, WS_MOD)
#define MODP WSP(float, WS_MODP)
#define TAB WSP(f32x2, WS_TAB)
#define SGST WSP(f32x2, WS_SGST)
#define BON WSP(float, WS_BON)
#define POOLWT WSP(bf16, WS_POOLWT)
#define WUPT WSP(bf16, WS_WUPT)
#define AUPT WSP(bf16, WS_AUPT)
#define SGW WSP(bf16, WS_SGW)
#define VTC WSP(bf16, WS_VTC)
#define VTL WSP(bf16, WS_VTL)
#define HCTX WSP(float, WS_HCTX)
#define QN WSP(bf16, WS_QN)
#define KN WSP(bf16, WS_KN)
#define WOUTT WSP(bf16, WS_WOUTT)
#define WINT WSP(bf16, WS_WINT)
#define XN WSP(bf16, WS_XN)
#define Y WSP(bf16, WS_Y)
#define P WSP(bf16, WS_P)
#define YR WSP(float, WS_YR)
#define REC WSP(float, WS_REC)
    float* const out = args.out;

    if (IN(0)) {
        LAS float* scr = (LAS float*)(lds + wave * 16384);
        constexpr int I_MOD = 4 * 64 * 48, I_WIN1 = 64 * (NIN / 32), I_WIN = 4 * I_WIN1, I_WOUT1 = 64 * 128, I_WOUT = 4 * I_WOUT1, I_POOL = 16 * 32, I_WUP = 8 * 32, I_AUP = 8 * 32, I_SGW = 1024;
        constexpr int NITEMS = I_MOD + I_WIN + I_WOUT + I_POOL + I_WUP + I_AUP + I_SGW;
        for (int it = gw; it < NITEMS; it += NGW) {
            int r = it;
            if (r < I_MOD) { p0_mod_item(w_mod, c_in, cctx_in, MODP, scr, r, lane); continue; } r -= I_MOD;
            if (r < I_WIN) { const int l = r / I_WIN1; p0_transpose_item(w_in + (size_t)l * DM * NIN, DM, NIN, WINT + (size_t)l * NIN * DM, scr, r % I_WIN1, lane); continue; } r -= I_WIN;
            if (r < I_WOUT) { const int l = r / I_WOUT1; p0_transpose_item(w_out + (size_t)l * DM * DM, DM, DM, WOUTT + (size_t)l * DM * DM, scr, r % I_WOUT1, lane); continue; } r -= I_WOUT;
            if (r < I_POOL) { const int lg = r / 32; p0_transpose_item(pool_w + (size_t)lg * 65536, 256, 256, POOLWT + (size_t)lg * 65536, scr, r % 32, lane); continue; } r -= I_POOL;
            if (r < I_WUP) { const int ld = r / 32; p0_transpose_item(rw_w_up + (size_t)ld * 65536, 64, 1024, WUPT + (size_t)ld * 65536, scr, r % 32, lane); continue; } r -= I_WUP;
            if (r < I_AUP) { const int ld = r / 32; p0_transpose_item(rw_a_up + (size_t)ld * 65536, 64, 1024, AUPT + (size_t)ld * 65536, scr, r % 32, lane); continue; } r -= I_AUP;
            {   const size_t e0 = (size_t)r * 512 + lane * 8; const f32x4 a = *(const f32x4*)(sg_w + e0), b = *(const f32x4*)(sg_w + e0 + 4);
                v4u o; o.x = pk2(a.x, a.y); o.y = pk2(a.z, a.w); o.z = pk2(b.x, b.y); o.w = pk2(b.z, b.w); *(v4u*)(SGW + e0) = o; }
        }
        SEAM(0);
    }
    if (IN(1)) {
        for (int idx = gw * 64 + lane; idx < 4 * 3 * 12288; idx += NGW * 64) {
            const int l = idx / 36864, c = (idx / 12288) % 3, n = idx % 12288;
            float s = b_mod[l * 12288 + n];
            const float* pp = MODP + ((size_t)(l * 64) * 3 + c) * 12288 + n;
#pragma unroll 8
            for (int kc = 0; kc < 64; ++kc) s += pp[(size_t)kc * 3 * 12288];
            MOD[idx] = s;
        }
        for (int idx = gw * 64 + lane; idx < 2048; idx += NGW * 64) {
            const int pos = idx >> 4, i = idx & 15;
            float inv = (i & 3) == 0 ? 1.0f : ((i & 3) == 1 ? 0.5623413251903491f : ((i & 3) == 2 ? 0.31622776601683794f : 0.17782794100389228f));
            inv *= (i >> 2) == 0 ? 1.0f : ((i >> 2) == 1 ? 0.1f : ((i >> 2) == 2 ? 0.01f : 0.001f));
            float cc, sn; sincos_acc((float)pos * inv, cc, sn);
            TAB[idx] = (f32x2){cc, sn};
        }
        SEAM(1);
    }
    for (int l = 0; l < DEPTH; ++l) {
        const int pb = 2 + 6 * l;
        const bool with_ctx = l < DEPTH - 1;
#define hin_lat (l == 0 ? x_in : (const float*)out)
#define hin_ctx (l == 0 ? ctx_in : (const float*)HCTX)
#define mod (MOD + (size_t)l * 3 * 12288)
        const int nrows = with_ctx ? MROWS : NLAT;
        if (IN(pb + 0)) {
            phase_xn(hin_lat, hin_ctx, mod, XN, OPQ_S(gw), NGW, OPQ_V(lane));
            SEAM(pb + 0);
        }
        if (IN(pb + 1)) {
            pg8::Gemm g{XN, WINT + (size_t)l * NIN * DM, MROWS, NIN, DM}; pg8::StaticOrder S; S.init(MROWS, NIN, G, bx);
            pg8::EpiStoreBf16 E{P, NIN};
            for (int rep = 0; rep < REP_G1; ++rep) pg8::gemm_phase<pg8::EpiStoreBf16, pg8::StaticOrder, true, true>(lds, g, S, E);
            SEAM(pb + 1);
        }
        if (IN(pb + 2)) {
            for (int rep = 0; rep < REP_PREP; ++rep) {
            for (int rep2 = 0; rep2 < REP_ROWP; ++rep2)
            phase_rowprep(P, na_qg + l * 64, na_kg + l * 64, TAB, QN, KN, SGST, OPQ_S(gw), NGW, OPQ_V(lane));
            for (int rep2 = 0; rep2 < REP_VT; ++rep2)
            phase_vt(P, VTL, VTC, OPQ_S(gw), NGW, OPQ_V(lane));
            for (int rep2 = 0; rep2 < REP_RWP; ++rep2)
            phase_rwprep(P, rw_mu_rkv + (size_t)l * 6144, rw_mu_lora + (size_t)l * 256, rw_w0 + (size_t)l * 2048, WUPT + (size_t)l * 131072, rw_a0 + (size_t)l * 2048, AUPT + (size_t)l * 131072,
                         rw_k_k + (size_t)l * 1024, rw_k_a + (size_t)l * 1024, rw_r_k + (size_t)l * 1024, REC, BON, OPQ_S(gw), NGW, OPQ_V(lane));
            }
            SEAM(pb + 2);
        }
        if (IN(pb + 3)) {
            phase_sgu(P, SGST, sg_ln_w + (size_t)l * 1024, sg_ln_b + (size_t)l * 1024, SGW + (size_t)l * 131072, sg_b + (size_t)l * 1024, Y, lds, nrows / 128, OPQ_V(tid), wave, OPQ_V(lane));
            LAS unsigned* mixq = (LAS unsigned*)(lds + LDSCTL_OFF + 64); LAS unsigned* mixb = (LAS unsigned*)(lds + LDSCTL_OFF + 128);
            if (tid == 0) { *mixq = 0u; *mixb = 0u; }
            __syncthreads();
            if (wave < 4) scan_self(REC, YR, lds, mixb, bx, wave, OPQ_V(lane));
            {   const int nctxu = with_ctx ? 2 : 0, npool = (nrows / 16) * 4, nq = 64 + nctxu + (npool + NGRID - 1) / NGRID;
                for (;;) {
                    unsigned k = 0; if (lane == 0) k = __hip_atomic_fetch_add(mixq, 1u, __ATOMIC_RELAXED, __HIP_MEMORY_SCOPE_WORKGROUP);
                    k = (unsigned)__builtin_amdgcn_readfirstlane((int)k);
                    if ((int)k >= nq) break;
                    const int ln = OPQ_V(lane);
                    if (k < 64u) na_unit<false>(QN, KN, VTL, VTC, P, na_rpb + (size_t)l * 16 * 15 * 31, Y, bx * 64 + (int)k, ln);
                    else if ((int)k < 64 + nctxu) na_unit<true>(QN, KN, VTL, VTC, P, na_rpb, Y, bx * 2 + ((int)k - 64), ln);
                    else { const int u = bx + NGRID * ((int)k - 64 - nctxu);
                        if (u < npool) { const int tt = u >> 2, g = u & 3; const bf16* wbase = POOLWT + (size_t)l * 262144 + (size_t)g * 65536; const float* psc = pool_scale + (size_t)l * 1024;
                            if (g == 0) pool_unit<0>(P, wbase, psc, Y, tt * 16, ln); else if (g == 1) pool_unit<1>(P, wbase, psc, Y, tt * 16, ln);
                            else if (g == 2) pool_unit<2>(P, wbase, psc, Y, tt * 16, ln); else pool_unit<3>(P, wbase, psc, Y, tt * 16, ln); } }
                }
            }
            SEAM(pb + 3);
        }
        if (IN(pb + 4)) {
            phase_rwfin(P, YR, REC, BON, rw_ln_w + (size_t)l * 1024, rw_ln_b + (size_t)l * 1024, Y, nrows, OPQ_S(gw), NGW, OPQ_V(lane));
            SEAM(pb + 4);
        }
        if (IN(pb + 5)) {
            pg8::Gemm g{Y, WOUTT + (size_t)l * DM * DM, nrows, DM, DM}; pg8::StaticOrder S; S.init(nrows, DM, G, bx);
            pg8::EpiResGate E{hin_lat, hin_ctx, out, HCTX, mod};
            pg8::gemm_phase<pg8::EpiResGate, pg8::StaticOrder, true, true>(lds, g, S, E);
            SEAM(pb + 5);
        }
    }
#undef IN
#undef SEAM
}
#undef hin_lat
#undef hin_ctx
#undef mod
#undef P
#undef Y
#undef XN
#undef out

extern "C" void kernel_launch(void* const* d_in, const int* in_sizes, int n_in, void* d_out, int out_size, void* d_ws, size_t ws_size, hipStream_t stream) {
    static int grid = 0;
    if (grid == 0) {
        if (n_in != 28 || out_size != NLAT * DM || ws_size < WS_END) { fprintf(stderr, "kernel_launch: unexpected shapes (n_in %d, out %d, ws %zu < %zu); nothing launched\n", n_in, out_size, ws_size, (size_t)WS_END); grid = -1; return; }
        int dev = 0, cus = 0, per_cu = 0;
        if (hipGetDevice(&dev) != hipSuccess || hipDeviceGetAttribute(&cus, hipDeviceAttributeMultiprocessorCount, dev) != hipSuccess) { grid = -1; return; }
        if (hipFuncSetAttribute((const void*)fwd, hipFuncAttributeMaxDynamicSharedMemorySize, LDS_BYTES) != hipSuccess) { fprintf(stderr, "kernel_launch: hipFuncSetAttribute failed\n"); grid = -1; return; }
        if (hipOccupancyMaxActiveBlocksPerMultiprocessor(&per_cu, (const void*)fwd, NWAVES * 64, LDS_BYTES) != hipSuccess || per_cu < 1)
            fprintf(stderr, "kernel_launch: note: occupancy query reports %d workgroups per CU\n", per_cu);
        (void)hipGetLastError();
        grid = cus >= NGRID ? NGRID : -2;
    }
    if (grid == -1) return;
    if (hipMemsetAsync((char*)d_ws + WS_CTL, 0, CTL_ZERO_BYTES, stream) != hipSuccess) { fprintf(stderr, "kernel_launch: memset failed\n"); return; }
    Args a{};
    for (int i = 0; i < 28; ++i) a.in[i] = (const float*)d_in[i];
    a.out = (float*)d_out; a.ws = (unsigned char*)d_ws; a.li = 0; a.pad = 0;
    const bool split = MK_SPLIT || grid == -2;
    if (split) { for (int k = 0; k < NPHASE; ++k) { a.ph_lo = k; a.ph_hi = k + 1; hipLaunchKernelGGL(fwd, dim3(NGRID), dim3(NWAVES * 64), LDS_BYTES, stream, a); } }
    else { a.ph_lo = 0; a.ph_hi = NPHASE; hipLaunchKernelGGL(fwd, dim3(NGRID), dim3(NWAVES * 64), LDS_BYTES, stream, a); }
    const hipError_t le = hipPeekAtLastError();
    if (le != hipSuccess) fprintf(stderr, "kernel_launch: launch failed: %s\n", hipGetErrorName(le));
}
```

```cpp
#include <hip/hip_runtime.h>
#include <cstdio>
#include <cstdint>
#define MK_SPLIT 0
namespace pg8 {
#define PG8_LAS __attribute__((address_space(3)))
typedef unsigned short bf16_t;
typedef short bf16x8 __attribute__((ext_vector_type(8)));
typedef float f32x4 __attribute__((ext_vector_type(4)));
typedef unsigned u32x4 __attribute__((ext_vector_type(4)));
constexpr int BM = 256, BK = 64, HALF = 128, HTB = HALF * BK * 2  , STAGE_BYTES = 8 * HTB, NXCD = 8, WGM = 8;

__host__ __device__ __forceinline__ int lds_byte(int r, int c) { const int st = (r >> 4) * 2 + (c >> 5), rr = r & 15, cc = c & 31, ob = rr * 64 + cc * 2; return st * 1024 + (ob ^ (((ob >> 9) & 1) << 5)); }
__host__ __device__ __forceinline__ void stage_rc(int b, int& R, int& C) { const int st = b / 1024, sb = b % 1024, swz = sb ^ (((sb >> 9) & 1) << 5); R = (st >> 1) * 16 + swz / 64; C = (st & 1) * 32 + (swz % 64) / 2; }
__host__ __device__ __forceinline__ int perm32(int rho) { const int n = rho >> 4, i = rho & 15; return 8 * (i >> 2) + 4 * n + (i & 3); }

struct Unit { int pm, pn; };
struct Gemm { const bf16_t* A; const bf16_t* Bt; int M, N, K; };

struct StaticOrder {
    int nM, nN, nwg, G, c;
    __host__ __device__ void init(int M, int N, int G_, int c_) { nM = M / BM; nN = N / BM; nwg = nM * nN; G = G_; c = c_; }
    __host__ __device__ bool next(int i, Unit& u) const {
        const long L = (long)i * G + c; if (L >= nwg) return false;
        int wgid = (int)L; { const int q = nwg / NXCD, r = nwg % NXCD, xcd = wgid % NXCD, off = wgid / NXCD; wgid = (xcd < r ? xcd * (q + 1) : r * (q + 1) + (xcd - r) * q) + off; }
        const int nig = WGM * nN, gid = wgid / nig, fm = gid * WGM, gsz = (nM - fm) < WGM ? (nM - fm) : WGM;
        u.pm = fm + ((wgid % nig) % gsz); u.pn = (wgid % nig) / gsz; return true;
    }
    __device__ __forceinline__ void a_ready(const Unit&) const {}
    __device__ __forceinline__ void done(const Unit&) const {}
};

__device__ __forceinline__ unsigned cvt_pk_bf16(float lo, float hi) { unsigned r; asm volatile("v_cvt_pk_bf16_f32 %0, %1, %2" : "=v"(r) : "v"(lo), "v"(hi)); return r; }
template <class Epi, class Sched, bool ALIGN_EPI = false, bool SP2 = false>
__device__ __forceinline__ void gemm_phase(PG8_LAS unsigned char* lds, const Gemm g, const Sched& S, const Epi& E) {
    int tid_ = threadIdx.x; asm volatile("" : "+v"(tid_));
    const int tid = tid_, wid = __builtin_amdgcn_readfirstlane(tid >> 6), lane = tid & 63, wr = wid >> 2, wc = wid & 3, fr = lane & 15, fq = lane >> 4;
    const int K = g.K, nt = K / BK;
    unsigned voffA[2], voffB[2];
#pragma unroll
    for (int i = 0; i < 2; ++i) { int R, C; stage_rc(tid * 16 + i * 8192, R, C); const int Rb = Epi::PERM ? ((R & ~31) + perm32(R & 31)) : R;
        voffA[i] = (unsigned)(R * K + C) * 2u; voffB[i] = (unsigned)(Rb * K + C) * 2u; }
    const size_t kstep = (size_t)(BK * 2);
    const size_t hstep = (size_t)HALF * K * 2;
    const size_t tstep = 2 * hstep;
    const unsigned ldsw = (unsigned)wid * 1024u;
    const int aoff = lds_byte(wr * 64 + fr, fq * 8), boff = lds_byte(wc * 32 + fr, fq * 8);
#define PG8_SA(b, h) (((b) * 2 + (h)) * HTB)
#define PG8_SB(b, h) ((4 + (b) * 2 + (h)) * HTB)
#define PG8_STAGE(bufoff, gbase, voff) do { _Pragma("unroll") for (int _i = 0; _i < 2; ++_i) \
        __builtin_amdgcn_global_load_lds((const unsigned*)((const char*)(gbase) + (voff)[_i]), (PG8_LAS unsigned*)(lds + (bufoff) + ldsw + _i * 8192), 16, 0, 0); } while (0)
#define PG8_LDA(dst, b, h) do { _Pragma("unroll") for (int m = 0; m < 4; ++m) _Pragma("unroll") for (int k = 0; k < 2; ++k) dst[m][k] = *(const PG8_LAS bf16x8*)(lds + PG8_SA(b, h) + aoff + m * 2048 + k * 1024); } while (0)
#define PG8_LDB(dst, b, h) do { _Pragma("unroll") for (int n = 0; n < 2; ++n) _Pragma("unroll") for (int k = 0; k < 2; ++k) dst[n][k] = *(const PG8_LAS bf16x8*)(lds + PG8_SB(b, h) + boff + n * 2048 + k * 1024); } while (0)
#define PG8_MMA(ai, bj, At, Bt) do { __builtin_amdgcn_s_setprio(1); _Pragma("unroll") for (int m = 0; m < 4; ++m) _Pragma("unroll") for (int n = 0; n < 2; ++n) _Pragma("unroll") for (int k = 0; k < 2; ++k) \
        acc[ai][bj][m][n] = __builtin_amdgcn_mfma_f32_16x16x32_bf16(Bt[n][k], At[m][k], acc[ai][bj][m][n], 0, 0, 0); __builtin_amdgcn_s_setprio(0); } while (0)
#define PG8_WAIT_V(n) asm volatile("s_waitcnt vmcnt(" #n ")" ::: "memory")
#define PG8_WAIT_L(n) asm volatile("s_waitcnt lgkmcnt(" #n ")" ::: "memory")
#define PG8_BAR __builtin_amdgcn_s_barrier()
#define PG8_SCHED __builtin_amdgcn_sched_barrier(0)
    Unit cur, nxt; int ui = 0;
    if (!S.next(0, cur)) return;
    f32x4 acc[2][2][4][2];
#pragma unroll
    for (int a = 0; a < 2; ++a)
#pragma unroll
        for (int b = 0; b < 2; ++b)
#pragma unroll
            for (int m = 0; m < 4; ++m)
#pragma unroll
                for (int n = 0; n < 2; ++n) acc[a][b][m][n] = (f32x4){0.f, 0.f, 0.f, 0.f};
    bf16x8 At[4][2], B0[2][2], B1[2][2];
    const char* cA = (const char*)g.A + (size_t)cur.pm * tstep; const char* cB = (const char*)g.Bt + (size_t)cur.pn * tstep;
    S.a_ready(cur);
    if constexpr (SP2) {
        PG8_STAGE(PG8_SB(0, 0), cB, voffB); PG8_STAGE(PG8_SB(0, 1), cB + hstep, voffB); PG8_STAGE(PG8_SA(0, 0), cA, voffA); PG8_STAGE(PG8_SA(0, 1), cA + hstep, voffA);
        if (wr == 1) PG8_BAR;
        PG8_WAIT_V(2); PG8_BAR;
        PG8_STAGE(PG8_SB(1, 0), cB + kstep, voffB); PG8_STAGE(PG8_SA(1, 0), cA + kstep, voffA); PG8_STAGE(PG8_SB(1, 1), cB + hstep + kstep, voffB);
        PG8_WAIT_V(6); PG8_BAR;
    } else {
        PG8_STAGE(PG8_SB(0, 0), cB, voffB); PG8_STAGE(PG8_SA(0, 0), cA, voffA); PG8_STAGE(PG8_SB(0, 1), cB + hstep, voffB); PG8_STAGE(PG8_SA(0, 1), cA + hstep, voffA);
        if (wr == 1) PG8_BAR;
        PG8_WAIT_V(4); PG8_BAR;
        PG8_STAGE(PG8_SB(1, 0), cB + kstep, voffB); PG8_STAGE(PG8_SA(1, 0), cA + kstep, voffA); PG8_STAGE(PG8_SB(1, 1), cB + hstep + kstep, voffB);
        PG8_WAIT_V(6); PG8_BAR;
    }
    for (;;) {
        const bool has_next = S.next(ui + 1, nxt);
        const char* nA = has_next ? (const char*)g.A + (size_t)nxt.pm * tstep : cA; const char* nB = has_next ? (const char*)g.Bt + (size_t)nxt.pn * tstep : cB;
        for (int t = 0; t < nt; t += 2) {
            const bool last = (t == nt - 2);
            const char* a1 = cA + (size_t)(t + 1) * kstep;
            const char* a2 = last ? nA : cA + (size_t)(t + 2) * kstep; const char* b2 = last ? nB : cB + (size_t)(t + 2) * kstep;
            const char* a3 = a2 + kstep; const char* b3 = b2 + kstep;
            if (last && has_next) S.a_ready(nxt);
            if constexpr (SP2) {
            PG8_LDB(B0, 0, 0); PG8_LDB(B1, 0, 1); PG8_SCHED; PG8_LDA(At, 0, 0); PG8_STAGE(PG8_SA(1, 1), a1 + hstep, voffA);
            PG8_WAIT_V(8); PG8_WAIT_L(0); PG8_BAR; PG8_MMA(0, 0, At, B0); PG8_MMA(0, 1, At, B1); PG8_BAR; PG8_SCHED;
            PG8_LDA(At, 0, 1); PG8_STAGE(PG8_SB(0, 0), b2, voffB); PG8_STAGE(PG8_SB(0, 1), b2 + hstep, voffB); PG8_STAGE(PG8_SA(0, 0), a2, voffA);
            PG8_WAIT_V(8); PG8_WAIT_L(0); PG8_BAR; PG8_MMA(1, 0, At, B0); PG8_MMA(1, 1, At, B1); PG8_BAR; PG8_SCHED;
            PG8_LDB(B0, 1, 0); PG8_LDB(B1, 1, 1); PG8_SCHED; PG8_LDA(At, 1, 0); PG8_STAGE(PG8_SA(0, 1), a2 + hstep, voffA);
            PG8_WAIT_V(8); PG8_WAIT_L(0); PG8_BAR; PG8_MMA(0, 0, At, B0); PG8_MMA(0, 1, At, B1); PG8_BAR; PG8_SCHED;
            PG8_LDA(At, 1, 1); PG8_STAGE(PG8_SB(1, 0), b3, voffB); PG8_STAGE(PG8_SB(1, 1), b3 + hstep, voffB); PG8_STAGE(PG8_SA(1, 0), a3, voffA);
            PG8_WAIT_V(8); PG8_WAIT_L(0); PG8_BAR; PG8_MMA(1, 0, At, B0); PG8_MMA(1, 1, At, B1); PG8_BAR; PG8_SCHED;
            } else {
            PG8_LDB(B0, 0, 0); PG8_SCHED; PG8_LDA(At, 0, 0); PG8_STAGE(PG8_SA(1, 1), a1 + hstep, voffA);
            PG8_WAIT_L(8); PG8_BAR; PG8_WAIT_L(0); PG8_MMA(0, 0, At, B0); PG8_BAR; PG8_SCHED;
            PG8_LDB(B1, 0, 1); PG8_STAGE(PG8_SB(0, 0), b2, voffB);
            PG8_BAR; PG8_WAIT_L(0); PG8_MMA(0, 1, At, B1); PG8_BAR;
            PG8_LDA(At, 0, 1); PG8_STAGE(PG8_SA(0, 0), a2, voffA);
            PG8_BAR; PG8_WAIT_L(0); PG8_MMA(1, 0, At, B0); PG8_BAR; PG8_SCHED;
            PG8_STAGE(PG8_SB(0, 1), b2 + hstep, voffB);
            PG8_WAIT_V(6); PG8_BAR; PG8_MMA(1, 1, At, B1); PG8_BAR;
            PG8_LDB(B0, 1, 0); PG8_SCHED; PG8_LDA(At, 1, 0); PG8_STAGE(PG8_SA(0, 1), a2 + hstep, voffA);
            PG8_WAIT_L(8); PG8_BAR; PG8_WAIT_L(0); PG8_MMA(0, 0, At, B0); PG8_BAR; PG8_SCHED;
            PG8_LDB(B1, 1, 1); PG8_STAGE(PG8_SB(1, 0), b3, voffB);
            PG8_BAR; PG8_WAIT_L(0); PG8_MMA(0, 1, At, B1); PG8_BAR;
            PG8_LDA(At, 1, 1); PG8_STAGE(PG8_SA(1, 0), a3, voffA);
            PG8_BAR; PG8_WAIT_L(0); PG8_MMA(1, 0, At, B0); PG8_BAR; PG8_SCHED;
            PG8_STAGE(PG8_SB(1, 1), b3 + hstep, voffB);
            PG8_WAIT_V(6); PG8_BAR; PG8_MMA(1, 1, At, B1); PG8_BAR;
            }
        }
        if constexpr (ALIGN_EPI) { if (wr == 0) PG8_BAR; }
        if constexpr (!Epi::AFTER_DRAIN) { E(acc, cur, wr, wc, fr, fq); S.done(cur); }
        if (!has_next) break;
#pragma unroll
        for (int a = 0; a < 2; ++a)
#pragma unroll
            for (int b = 0; b < 2; ++b)
#pragma unroll
                for (int m = 0; m < 4; ++m)
#pragma unroll
                    for (int n = 0; n < 2; ++n) acc[a][b][m][n] = (f32x4){0.f, 0.f, 0.f, 0.f};
        cur = nxt; cA = nA; cB = nB; ++ui;
        if constexpr (ALIGN_EPI) { if (wr == 1) PG8_BAR; }
    }
    PG8_WAIT_V(0);
    if constexpr (!ALIGN_EPI) { if (wr == 0) PG8_BAR; }
    PG8_BAR;
    if constexpr (Epi::AFTER_DRAIN) { E.fused(acc, cur, wr, wc, fr, fq, lds, wid, lane); S.done(cur); }
#undef PG8_SA
#undef PG8_SB
#undef PG8_STAGE
#undef PG8_LDA
#undef PG8_LDB
#undef PG8_MMA
#undef PG8_WAIT_V
#undef PG8_WAIT_L
#undef PG8_BAR
#undef PG8_SCHED
}
}

constexpr int DM = 4096, NBATCH = 2, SEQ = 8192, DEPTH = 4, CTXL = 256;
constexpr int NLAT = NBATCH * SEQ, NCTX = NBATCH * CTXL, MROWS = NLAT + NCTX;
constexpr int NIN = 13568, GWD = 1024;
constexpr int C_POOLV = 0, C_POOLZ = 1024, C_NAQ = 2048, C_NAK = 3072, C_NAV = 4096, C_NAZ = 5120, C_RWR = 6144, C_RWK = 7168, C_RWV = 8192, C_RWZ = 9216,
              C_RWWD = 10240, C_RWAD = 10368, C_SGU = 10496, C_SGV = 11520, C_SGZ = 12544;
constexpr int SCANLEN = CTXL + SEQ;
constexpr int NCHAIN = 64;
constexpr int RECF = 384;
constexpr int NWAVES = 8;

constexpr size_t MiB = 1u << 20;
constexpr size_t WS_CTL = 0, CTL_ZERO_BYTES = 1 * MiB;
constexpr size_t WS_MOD   = 2 * MiB;
constexpr size_t WS_TAB   = 3 * MiB;
constexpr size_t WS_SGST  = 4 * MiB;
constexpr size_t WS_BON   = 5 * MiB;
constexpr size_t WS_POOLWT= 8 * MiB;
constexpr size_t WS_WUPT  = 10 * MiB;
constexpr size_t WS_AUPT  = 11 * MiB;
constexpr size_t WS_SGW   = 12 * MiB;
constexpr size_t WS_VTC   = 13 * MiB;
constexpr size_t WS_HCTX  = 14 * MiB;
constexpr size_t WS_MODP  = 22 * MiB;
constexpr size_t WS_VTL   = 58 * MiB;
constexpr size_t WS_QN    = 90 * MiB;
constexpr size_t WS_KN    = 123 * MiB;
constexpr size_t WS_WOUTT = 156 * MiB;
constexpr size_t WS_WINT  = 284 * MiB;
constexpr size_t WS_XN    = 708 * MiB;
constexpr size_t WS_Y     = 840 * MiB;
constexpr size_t WS_P     = 972 * MiB;
constexpr size_t WS_YR    = 1410 * MiB;
constexpr size_t WS_REC   = 1542 * MiB;
constexpr size_t WS_END   = 2334 * MiB;
static_assert(WS_P + (size_t)MROWS * NIN * 2 <= WS_YR && WS_REC + (size_t)NCHAIN * SCANLEN * RECF * 4 <= WS_END && WS_WINT + (size_t)4 * NIN * DM * 2 <= WS_XN, "ws map");
constexpr int CW_TMO = 0, CW_BAR = 4096;

constexpr int RING_BYTES = 131072, LDSCTL_OFF = RING_BYTES, MISC_OFF = LDSCTL_OFF + 320, LDS_BYTES = 147456;

#define GAS __attribute__((address_space(1)))
#define LAS __attribute__((address_space(3)))
typedef unsigned short bf16;
typedef unsigned v4u __attribute__((ext_vector_type(4)));
typedef unsigned v2u __attribute__((ext_vector_type(2)));
typedef float f32x4 __attribute__((ext_vector_type(4)));
typedef float f32x2 __attribute__((ext_vector_type(2)));
typedef short bf16x8 __attribute__((ext_vector_type(8)));
#define RLX_AGENT __ATOMIC_RELAXED, __HIP_MEMORY_SCOPE_AGENT
#define LDS_WAIT() asm volatile("s_waitcnt lgkmcnt(0)" ::: "memory")

__device__ __forceinline__ float bf2f(unsigned short h) { return __uint_as_float(((unsigned)h) << 16); }
__device__ __forceinline__ float bflo(unsigned w) { return __uint_as_float(w << 16); }
__device__ __forceinline__ float bfhi(unsigned w) { return __uint_as_float(w & 0xffff0000u); }
typedef __bf16 bf16x2_t __attribute__((ext_vector_type(2)));
__device__ __forceinline__ unsigned pk2(float lo, float hi) { const f32x2 v = {lo, hi}; const bf16x2_t b = __builtin_convertvector(v, bf16x2_t); return __builtin_bit_cast(unsigned, b); }
__device__ __forceinline__ unsigned f2bf(float f) { return pk2(f, 0.f) & 0xffffu; }
__device__ __forceinline__ float rcp_f(float x) { return __builtin_amdgcn_rcpf(x); }
__device__ __forceinline__ float rsq_f(float x) { return __builtin_amdgcn_rsqf(x); }
__device__ __forceinline__ void unpack8(const v4u w, float* x) { x[0] = bflo(w.x); x[1] = bfhi(w.x); x[2] = bflo(w.y); x[3] = bfhi(w.y); x[4] = bflo(w.z); x[5] = bfhi(w.z); x[6] = bflo(w.w); x[7] = bfhi(w.w); }
__device__ __forceinline__ v4u pack8(const float* x) { v4u w; w.x = pk2(x[0], x[1]); w.y = pk2(x[2], x[3]); w.z = pk2(x[4], x[5]); w.w = pk2(x[6], x[7]); return w; }
__device__ __forceinline__ float silu_f(float x) { return x * rcp_f(1.f + __expf(-x)); }
__device__ __forceinline__ float wave_sum(float v) {
#pragma unroll
    for (int o = 1; o < 64; o <<= 1) v += __shfl_xor(v, o);
    return v;
}
template <int CTRL> __device__ __forceinline__ float dppf(float v) { return __builtin_bit_cast(float, __builtin_amdgcn_update_dpp(0, __builtin_bit_cast(int, v), CTRL, 0xF, 0xF, true)); }
__device__ __forceinline__ float red16(float v) { v += dppf<0xB1>(v); v += dppf<0x4E>(v); v += dppf<0x141>(v); v += dppf<0x140>(v); return v; }
__device__ __forceinline__ void red16x2(float& a, float& b) {
    a += dppf<0xB1>(a); b += dppf<0xB1>(b); a += dppf<0x4E>(a); b += dppf<0x4E>(b); a += dppf<0x141>(a); b += dppf<0x141>(b); a += dppf<0x140>(a); b += dppf<0x140>(b); }
__device__ __forceinline__ float max16x4(float v) { v = fmaxf(v, __shfl_xor(v, 16)); v = fmaxf(v, __shfl_xor(v, 32)); return v; }
__device__ __forceinline__ float sum16x4(float v) { v += __shfl_xor(v, 16); v += __shfl_xor(v, 32); return v; }
__device__ __forceinline__ int scan_pos(int d, bool isctx, int t) { return d == 0 ? (isctx ? t : CTXL + t) : (isctx ? (CTXL - 1 - t) : (CTXL + SEQ - 1 - t)); }
__device__ __forceinline__ f32x4 mfma16(bf16x8 a, bf16x8 b, f32x4 c) { return __builtin_amdgcn_mfma_f32_16x16x32_bf16(a, b, c, 0, 0, 0); }
__device__ __forceinline__ bf16x8 ld_frag(const bf16* p) { return __builtin_bit_cast(bf16x8, *(const v4u*)p); }

namespace pg8 {
struct EpiStoreBf16 {
    static constexpr bool PERM = true, AFTER_DRAIN = false;
    bf16_t* O; int ldc;
    __device__ __forceinline__ void operator()(const f32x4 (&acc)[2][2][4][2], const Unit& u, int wr, int wc, int fr, int fq) const {
        const int row0 = u.pm * BM + wr * 64 + fr, col0 = u.pn * BM + wc * 32 + 8 * fq;
#pragma unroll
        for (int ai = 0; ai < 2; ++ai)
#pragma unroll
            for (int m = 0; m < 4; ++m) { bf16_t* rowp = O + (size_t)(row0 + ai * HALF + m * 16) * ldc + col0;
#pragma unroll
                for (int bj = 0; bj < 2; ++bj) { const f32x4 v0 = acc[ai][bj][m][0], v1 = acc[ai][bj][m][1];
                    u32x4 w; w.x = cvt_pk_bf16(v0[0], v0[1]); w.y = cvt_pk_bf16(v0[2], v0[3]); w.z = cvt_pk_bf16(v1[0], v1[1]); w.w = cvt_pk_bf16(v1[2], v1[3]);
                    *(u32x4*)(rowp + bj * HALF) = w; } }
    }
};
struct EpiResGate {
    static constexpr bool PERM = false, AFTER_DRAIN = false;
    const float* hin_lat; const float* hin_ctx; float* hout_lat; float* hout_ctx; const float* gate;
    __device__ __forceinline__ void operator()(const f32x4 (&acc)[2][2][4][2], const Unit& u, int wr, int wc, int fr, int fq) const {
        const int cond = u.pm < 32 ? 0 : (u.pm < 64 ? 1 : 2);
        const int rloc = (u.pm < 64 ? u.pm * BM : (u.pm - 64) * BM) + wr * 64 + fr, col0 = u.pn * BM + wc * 32 + 4 * fq;
        const float* hin = u.pm < 64 ? hin_lat : hin_ctx; float* hout = u.pm < 64 ? hout_lat : hout_ctx;
        f32x4 gv[2][2];
#pragma unroll
        for (int bj = 0; bj < 2; ++bj)
#pragma unroll
            for (int n = 0; n < 2; ++n) gv[bj][n] = *(const f32x4*)(gate + cond * 12288 + 8192 + col0 + bj * HALF + n * 16);
#pragma unroll
        for (int ai = 0; ai < 2; ++ai)
#pragma unroll
            for (int m = 0; m < 4; ++m) { const size_t off = (size_t)(rloc + ai * HALF + m * 16) * 4096 + col0;
#pragma unroll
                for (int bj = 0; bj < 2; ++bj)
#pragma unroll
                    for (int n = 0; n < 2; ++n) { const f32x4 b = *(const f32x4*)(hin + off + bj * HALF + n * 16);
                        *(f32x4*)(hout + off + bj * HALF + n * 16) = b + gv[bj][n] * acc[ai][bj][m][n]; } }
    }
};
}

__device__ __forceinline__ void p0_transpose_item(const float* W, int K, int N, bf16* WT, LAS float* scr, int item, int lane) {
    const int nblk = N / 32, kb = item / nblk, nb = item % nblk, k0 = 64 * kb, n0 = 32 * nb;
#pragma unroll 8
    for (int i = 0; i < 32; ++i) { const int kk = 2 * i + (lane >> 5); scr[kk * 33 + (lane & 31)] = W[(size_t)(k0 + kk) * N + n0 + (lane & 31)]; }
    LDS_WAIT(); asm volatile("" ::: "memory");
    const int c = lane & 7;
#pragma unroll
    for (int j = 0; j < 4; ++j) { const int n = (lane >> 3) + 8 * j; const LAS float* s = scr + (8 * c) * 33 + n;
        v4u o; o.x = pk2(s[0 * 33], s[1 * 33]); o.y = pk2(s[2 * 33], s[3 * 33]); o.z = pk2(s[4 * 33], s[5 * 33]); o.w = pk2(s[6 * 33], s[7 * 33]);
        *(v4u*)(WT + (size_t)(n0 + n) * K + k0 + 8 * c) = o; }
    LDS_WAIT(); asm volatile("" ::: "memory");
}
__device__ __forceinline__ void p0_mod_item(const float* wmod, const float* cvec, const float* cctx, float* MODP, LAS float* scr, int item, int lane) {
    const int l = item / (64 * 48), r = item % (64 * 48), kc = r / 48, nc = r % 48, k0 = kc * 64, n0 = nc * 256 + lane * 4;
    scr[lane] = silu_f(cvec[k0 + lane]); scr[64 + lane] = silu_f(cvec[4096 + k0 + lane]); scr[128 + lane] = silu_f(cctx[k0 + lane]);
    LDS_WAIT(); asm volatile("" ::: "memory");
    f32x4 a0 = {0.f, 0.f, 0.f, 0.f}, a1 = a0, a2 = a0;
    const float* wp = wmod + ((size_t)l * 4096 + k0) * 12288 + n0;
#pragma unroll 16
    for (int k = 0; k < 64; ++k) { const f32x4 w = *(const f32x4*)(wp + (size_t)k * 12288); a0 += scr[k] * w; a1 += scr[64 + k] * w; a2 += scr[128 + k] * w; }
    float* o = MODP + ((size_t)(l * 64 + kc) * 3) * 12288 + n0;
    *(f32x4*)(o) = a0; *(f32x4*)(o + 12288) = a1; *(f32x4*)(o + 2 * 12288) = a2;
    LDS_WAIT(); asm volatile("" ::: "memory");
}
__device__ __forceinline__ void sincos_acc(float ang, float& c, float& s) {
    const double x = (double)ang; const double n = __builtin_rint(x * 0.63661977236758134308); const double r = x - n * 1.57079632679489661923;
    const double r2 = r * r;
    const double sp = r * (1.0 + r2 * (-1.0 / 6 + r2 * (1.0 / 120 + r2 * (-1.0 / 5040 + r2 * (1.0 / 362880 + r2 * (-1.0 / 39916800 + r2 * (1.0 / 6227020800.0)))))));
    const double cp = 1.0 + r2 * (-0.5 + r2 * (1.0 / 24 + r2 * (-1.0 / 720 + r2 * (1.0 / 40320 + r2 * (-1.0 / 3628800 + r2 * (1.0 / 479001600 + r2 * (-1.0 / 87178291200.0)))))));
    const int q = ((int)n) & 3;
    const double cc = (q == 0) ? cp : (q == 1) ? -sp : (q == 2) ? -cp : sp;
    const double ss = (q == 0) ? sp : (q == 1) ? cp : (q == 2) ? -sp : -cp;
    c = (float)cc; s = (float)ss;
}

__device__ __forceinline__ void phase_xn(const float* hlat, const float* hctx, const float* mod, bf16* XN, int gw, int NGW, int lane) {
    for (int m = gw; m < MROWS; m += NGW) {
        const float* src = m < NLAT ? hlat + (size_t)m * DM : hctx + (size_t)(m - NLAT) * DM;
        const int cond = m < NLAT ? (m >> 13) : 2;
        const f32x4* s4 = (const f32x4*)src + lane;
        f32x4 v[16]; float ss = 0.f;
#pragma unroll
        for (int j = 0; j < 16; ++j) { v[j] = s4[64 * j]; ss += (v[j].x * v[j].x + v[j].y * v[j].y) + (v[j].z * v[j].z + v[j].w * v[j].w); }
        ss = wave_sum(ss);
        const float rstd = rsq_f(ss * (1.f / 4096.f) + 1e-6f);
        const f32x4* sh4 = (const f32x4*)(mod + cond * 12288) + lane; const f32x4* sc4 = (const f32x4*)(mod + cond * 12288 + 4096) + lane;
        v2u* o = (v2u*)(XN + (size_t)m * DM) + lane;
#pragma unroll
        for (int j = 0; j < 16; ++j) { const f32x4 sh = sh4[64 * j], sc = sc4[64 * j]; const f32x4 x = v[j] * rstd * (sc + 1.f) + sh; v2u w; w.x = pk2(x.x, x.y); w.y = pk2(x.z, x.w); o[64 * j] = w; }
    }
}

__device__ __forceinline__ void phase_rowprep(const bf16* P, const float* qgain, const float* kgain, const f32x2* tab, bf16* QN, bf16* KN, f32x2* SGST, int gw, int NGW, int lane) {
    const int sub = lane & 3;
    for (int m = gw; m < MROWS; m += NGW) {
        const bf16* pr = P + (size_t)m * NIN;
        const bool isctx = m >= NLAT; const int t = isctx ? ((m - NLAT) & 255) : (m & 8191);
        {   float x[16]; unpack8(*(const v4u*)(pr + C_SGV + 16 * lane), x); unpack8(*(const v4u*)(pr + C_SGV + 16 * lane + 8), x + 8);
            float s = 0.f;
#pragma unroll
            for (int i = 0; i < 16; ++i) s += x[i];
            const float mean = wave_sum(s) * (1.f / 1024.f); float q = 0.f;
#pragma unroll
            for (int i = 0; i < 16; ++i) { const float dlt = x[i] - mean; q += dlt * dlt; }
            const float var = wave_sum(q) * (1.f / 1024.f);
            if (lane == 0) SGST[m] = (f32x2){mean, rsq_f(var + 1e-5f)}; }
        float q[16], k[16];
        unpack8(*(const v4u*)(pr + C_NAQ + 16 * lane), q); unpack8(*(const v4u*)(pr + C_NAQ + 16 * lane + 8), q + 8);
        unpack8(*(const v4u*)(pr + C_NAK + 16 * lane), k); unpack8(*(const v4u*)(pr + C_NAK + 16 * lane + 8), k + 8);
        float sq = 0.f, sk = 0.f;
#pragma unroll
        for (int i = 0; i < 16; ++i) { sq += q[i] * q[i]; sk += k[i] * k[i]; }
        sq += __shfl_xor(sq, 1); sq += __shfl_xor(sq, 2); sk += __shfl_xor(sk, 1); sk += __shfl_xor(sk, 2);
        const float rq = rsq_f(sq * (1.f / 64.f) + 1e-6f), rk = rsq_f(sk * (1.f / 64.f) + 1e-6f);
#pragma unroll
        for (int i = 0; i < 16; ++i) { q[i] *= rq * qgain[16 * sub + i]; k[i] *= rk * kgain[16 * sub + i]; }
        if (!isctx) {
            const int pos = sub < 2 ? (t >> 6) : (t & 63);
#pragma unroll
            for (int i = 0; i < 16; ++i) { const f32x2 cs = tab[pos * 16 + i]; const float pq = __shfl_xor(q[i], 1), pkk = __shfl_xor(k[i], 1);
                q[i] = (sub & 1) ? (q[i] * cs.x + pq * cs.y) : (q[i] * cs.x - pq * cs.y);
                k[i] = (sub & 1) ? (k[i] * cs.x + pkk * cs.y) : (k[i] * cs.x - pkk * cs.y); }
        }
#pragma unroll
        for (int i = 0; i < 16; ++i) q[i] *= 0.125f;
        *(v4u*)(QN + (size_t)m * GWD + 16 * lane) = pack8(q); *(v4u*)(QN + (size_t)m * GWD + 16 * lane + 8) = pack8(q + 8);
        *(v4u*)(KN + (size_t)m * GWD + 16 * lane) = pack8(k); *(v4u*)(KN + (size_t)m * GWD + 16 * lane + 8) = pack8(k + 8);
    }
}
__device__ __forceinline__ void phase_vt(const bf16* P, bf16* VTL, bf16* VTC, int gw, int NGW, int lane) {
    for (int u = gw; u < (MROWS / 64) * 16; u += NGW) {
        const int tt = u >> 4, h = u & 15, m0 = tt * 64;
        const bf16* src = P + (size_t)m0 * NIN + C_NAV + h * 64 + lane;
        unsigned w[32];
#pragma unroll
        for (int i = 0; i < 32; ++i) { const unsigned lo = src[(size_t)(2 * i) * NIN], hi = src[(size_t)(2 * i + 1) * NIN]; w[i] = lo | (hi << 16); }
        bf16* dst = tt < 256 ? VTL + (((size_t)((tt >> 7) * 16 + h) * 64 + lane) * 8192 + (tt & 127) * 64)
                             : VTC + (((size_t)(((tt - 256) >> 2) * 16 + h) * 64 + lane) * 256 + ((tt - 256) & 3) * 64);
#pragma unroll
        for (int j = 0; j < 8; ++j) { v4u o; o.x = w[4 * j]; o.y = w[4 * j + 1]; o.z = w[4 * j + 2]; o.w = w[4 * j + 3]; ((v4u*)dst)[j] = o; }
    }
}
template <int G>
__device__ __forceinline__ void pool_unit(const bf16* P, const bf16* wbase, const float* pscale, bf16* Y, int m0, int lane) {
    constexpr int WIN = 2 << G;
    const int r = lane & 15, q4 = lane >> 4, m = m0 + r;
    const bool isctx = m0 >= NLAT; const int T = isctx ? CTXL : SEQ; const int t = isctx ? ((m - NLAT) & 255) : (m & 8191);
    const int tlo = t - (WIN >> 1);
    const int lo = tlo < 0 ? 0 : tlo, hi = (tlo + WIN) > T ? T : (tlo + WIN);
    const float inv = rcp_f((float)(hi - lo));
    f32x4 acc[16];
#pragma unroll
    for (int nt = 0; nt < 16; ++nt) acc[nt] = (f32x4){0.f, 0.f, 0.f, 0.f};
#pragma unroll 1
    for (int ks = 0; ks < 8; ++ks) {
        const int ch0 = C_POOLV + G * 256 + 32 * ks + 8 * q4;
        constexpr int WB = WIN < 8 ? WIN : 8;
        bf16x8 bfr[8];
        float sum[8];
#pragma unroll
        for (int j = 0; j < 8; ++j) sum[j] = 0.f;
        const v4u selfw = *(const v4u*)(P + (size_t)m * NIN + ch0);
#pragma unroll
        for (int nt = 0; nt < 8; ++nt) bfr[nt] = ld_frag(wbase + (size_t)(16 * nt + r) * 256 + 32 * ks + 8 * q4);
#pragma unroll
        for (int k0 = 0; k0 < WIN; k0 += WB) {
            v4u wl[WB];
#pragma unroll
            for (int k = 0; k < WB; ++k) { const int tk = tlo + k0 + k; const bool ok = tk >= 0 && tk < T; wl[k] = *(const v4u*)(P + (size_t)(ok ? (m - t + tk) : m) * NIN + ch0); }
            __builtin_amdgcn_sched_barrier(0);
#pragma unroll
            for (int k = 0; k < WB; ++k) { const int tk = tlo + k0 + k; const bool ok = tk >= 0 && tk < T; float x[8]; unpack8(wl[k], x);
#pragma unroll
                for (int j = 0; j < 8; ++j) sum[j] += ok ? x[j] : 0.f; }
            __builtin_amdgcn_sched_barrier(0);
        }
        float self[8]; unpack8(selfw, self);
        float dv[8];
#pragma unroll
        for (int j = 0; j < 8; ++j) dv[j] = sum[j] * inv - self[j];
        const bf16x8 af = __builtin_bit_cast(bf16x8, pack8(dv));
        __builtin_amdgcn_sched_barrier(0);
        bf16x8 bfr2[8];
#pragma unroll
        for (int nt = 0; nt < 8; ++nt) bfr2[nt] = ld_frag(wbase + (size_t)(16 * (nt + 8) + r) * 256 + 32 * ks + 8 * q4);
        __builtin_amdgcn_sched_barrier(0);
#pragma unroll
        for (int nt = 0; nt < 8; ++nt) acc[nt] = mfma16(af, bfr[nt], acc[nt]);
        __builtin_amdgcn_sched_barrier(0);
#pragma unroll
        for (int nt = 0; nt < 8; ++nt) acc[nt + 8] = mfma16(af, bfr2[nt], acc[nt + 8]);
        __builtin_amdgcn_sched_barrier(0);
    }
#pragma unroll
    for (int nh = 0; nh < 4; ++nh) {
        unsigned short zz[4][4]; float ps[4];
#pragma unroll
        for (int nq = 0; nq < 4; ++nq) { const int oc = G * 256 + 16 * (4 * nh + nq) + r; ps[nq] = pscale[oc];
#pragma unroll
            for (int i = 0; i < 4; ++i) zz[nq][i] = P[(size_t)(m0 + 4 * q4 + i) * NIN + C_POOLZ + oc]; }
        __builtin_amdgcn_sched_barrier(0);
#pragma unroll
        for (int nq = 0; nq < 4; ++nq) { const int oc = G * 256 + 16 * (4 * nh + nq) + r;
#pragma unroll
            for (int i = 0; i < 4; ++i) Y[(size_t)(m0 + 4 * q4 + i) * DM + oc] = (bf16)f2bf(acc[4 * nh + nq][i] * ps[nq] * silu_f(bf2f(zz[nq][i]))); }
        __builtin_amdgcn_sched_barrier(0);
    }
}
__device__ __forceinline__ void phase_pool(const bf16* P, const bf16* PWT  , const float* pscale, bf16* Y, int nrows, int gw, int NGW, int lane) {
    for (int u = gw; u < (nrows / 16) * 4; u += NGW) {
        const int tt = u >> 2, g = u & 3, m0 = tt * 16;
        const bf16* wbase = PWT + (size_t)g * 65536;
        if (g == 0) pool_unit<0>(P, wbase, pscale, Y, m0, lane);
        else if (g == 1) pool_unit<1>(P, wbase, pscale, Y, m0, lane);
        else if (g == 2) pool_unit<2>(P, wbase, pscale, Y, m0, lane);
        else pool_unit<3>(P, wbase, pscale, Y, m0, lane);
    }
}
__device__ __forceinline__ void phase_rwprep(const bf16* P, const float* mu_rkv  , const float* mu_lora  , const float* w0  , const bf16* WUPT  ,
                                             const float* a0, const bf16* AUPT, const float* k_k, const float* k_a, const float* r_k, float* REC, float* BON, int gw, int NGW, int lane) {
    const int r = lane & 15, q4 = lane >> 4;
    for (int u = gw; u < (MROWS / 16) * 16; u += NGW) {
        const int tt = u >> 4, d = (u >> 3) & 1, hp = u & 7, m0 = tt * 16;
        const bool isctx = m0 >= NLAT; const int T = isctx ? CTXL : SEQ; const int t0 = isctx ? ((m0 - NLAT) & 255) : (m0 & 8191); const int b = isctx ? ((m0 - NLAT) >> 8) : (m0 >> 13);
        bf16x8 Aw[2], Aa[2];
        {   const int mA = m0 + r, tA = t0 + r; const bool hasnb = d == 0 ? (tA > 0) : (tA < T - 1); const int nbA = hasnb ? (d == 0 ? mA - 1 : mA + 1) : mA;
            v4u cw[2], nw[2], ca[2], na[2];
#pragma unroll
            for (int ks = 0; ks < 2; ++ks) { const int j0 = 32 * ks + 8 * q4;
                cw[ks] = *(const v4u*)(P + (size_t)mA * NIN + C_RWWD + d * 64 + j0); nw[ks] = *(const v4u*)(P + (size_t)nbA * NIN + C_RWWD + d * 64 + j0);
                ca[ks] = *(const v4u*)(P + (size_t)mA * NIN + C_RWAD + d * 64 + j0); na[ks] = *(const v4u*)(P + (size_t)nbA * NIN + C_RWAD + d * 64 + j0); }
            __builtin_amdgcn_sched_barrier(0);
#pragma unroll
            for (int ks = 0; ks < 2; ++ks) { const int j0 = 32 * ks + 8 * q4;
                float cur[8], nb[8], o[8];
                unpack8(cw[ks], cur); unpack8(nw[ks], nb);
#pragma unroll
                for (int j = 0; j < 8; ++j) { const float xx = cur[j] + ((hasnb ? nb[j] : 0.f) - cur[j]) * mu_lora[(d * 2 + 0) * 64 + j0 + j]; o[j] = 1.0f - 2.0f * rcp_f(1.0f + __expf(2.0f * xx)); }
                Aw[ks] = __builtin_bit_cast(bf16x8, pack8(o));
                unpack8(ca[ks], cur); unpack8(na[ks], nb);
#pragma unroll
                for (int j = 0; j < 8; ++j) o[j] = cur[j] + ((hasnb ? nb[j] : 0.f) - cur[j]) * mu_lora[(d * 2 + 1) * 64 + j0 + j];
                Aa[ks] = __builtin_bit_cast(bf16x8, pack8(o)); }
        }
#pragma unroll 1
        for (int hh = 0; hh < 2; ++hh) {
            const int head = hp * 2 + hh;
            float KK[4][4], Av[4][4];
            float ss[4] = {0.f, 0.f, 0.f, 0.f}, bon[4] = {0.f, 0.f, 0.f, 0.f};
            const int chain = (b * 2 + d) * 16 + head;
            const int pos0 = scan_pos(d, isctx, t0 + 4 * q4), dpos = d == 0 ? 1 : -1;
            float* const rec0 = REC + ((size_t)chain * SCANLEN + pos0) * RECF + r;
            const int tq = t0 + 4 * q4; const bool evalid = d == 0 ? (tq > 0) : (tq + 4 < T); const int erow = evalid ? (d == 0 ? m0 + 4 * q4 - 1 : m0 + 4 * q4 + 4) : (m0 + 4 * q4);
#pragma unroll
            for (int nh = 0; nh < 2; ++nh) {
                bf16x8 bwv[2][2], bav[2][2]; float prm[2][8]; unsigned short rcu[2][5], kcu[2][5], vcu[2][5];
#pragma unroll
                for (int nq = 0; nq < 2; ++nq) { const int ch = head * 64 + 16 * (2 * nh + nq) + r;
                    bwv[nq][0] = ld_frag(WUPT + (size_t)(d * 1024 + ch) * 64 + 8 * q4); bwv[nq][1] = ld_frag(WUPT + (size_t)(d * 1024 + ch) * 64 + 32 + 8 * q4);
                    bav[nq][0] = ld_frag(AUPT + (size_t)(d * 1024 + ch) * 64 + 8 * q4); bav[nq][1] = ld_frag(AUPT + (size_t)(d * 1024 + ch) * 64 + 32 + 8 * q4);
                    prm[nq][0] = w0[d * 1024 + ch]; prm[nq][1] = a0[d * 1024 + ch]; prm[nq][2] = mu_rkv[(d * 3 + 0) * 1024 + ch]; prm[nq][3] = mu_rkv[(d * 3 + 1) * 1024 + ch]; prm[nq][4] = mu_rkv[(d * 3 + 2) * 1024 + ch];
                    prm[nq][5] = k_k[ch]; prm[nq][6] = k_a[ch]; prm[nq][7] = r_k[ch];
#pragma unroll
                    for (int i = 0; i < 5; ++i) { const bf16* pc = P + (size_t)(i < 4 ? m0 + 4 * q4 + i : erow) * NIN + ch; rcu[nq][i] = pc[C_RWR]; kcu[nq][i] = pc[C_RWK]; vcu[nq][i] = pc[C_RWV]; } }
                __builtin_amdgcn_sched_barrier(0);
#pragma unroll
                for (int nq = 0; nq < 2; ++nq) { const int n4 = 2 * nh + nq;
                    const float w0v = prm[nq][0], a0v = prm[nq][1], mur = prm[nq][2], muk = prm[nq][3], muv = prm[nq][4], kkv = prm[nq][5], kav = prm[nq][6], rkv = prm[nq][7];
                    f32x4 accW = {0.f, 0.f, 0.f, 0.f}, accA = accW;
                    accW = mfma16(Aw[0], bwv[nq][0], accW); accW = mfma16(Aw[1], bwv[nq][1], accW); accA = mfma16(Aa[0], bav[nq][0], accA); accA = mfma16(Aa[1], bav[nq][1], accA);
                    float rcf[5], kcf[5], vcf[5];
#pragma unroll
                    for (int i = 0; i < 5; ++i) { rcf[i] = bf2f(rcu[nq][i]); kcf[i] = bf2f(kcu[nq][i]); vcf[i] = bf2f(vcu[nq][i]); }
                    if (!evalid) { rcf[4] = 0.f; kcf[4] = 0.f; vcf[4] = 0.f; }
#pragma unroll
                    for (int i = 0; i < 4; ++i) {
                        const int ip = i > 0 ? i - 1 : 4, in_ = i < 3 ? i + 1 : 4;
                        const float rc = rcf[i], kc = kcf[i], vc = vcf[i];
                        const float rn = d == 0 ? rcf[ip] : rcf[in_], kn = d == 0 ? kcf[ip] : kcf[in_], vn = d == 0 ? vcf[ip] : vcf[in_];
                        const float rr = rc + (rn - rc) * mur, kk0 = kc + (kn - kc) * muk, vv = vc + (vn - vc) * muv;
                        const float xw = -(w0v + accW[i]);
                        const float sp = fmaxf(xw, 0.f) + __logf(1.0f + __expf(-fabsf(xw)));
                        const float dec = __expf(-__expf(-sp - 0.5f));
                        const float av = rcp_f(1.0f + __expf(-(a0v + accA[i])));
                        const float kx = kk0 * kkv; ss[i] += kx * kx;
                        const float kp = kk0 * (1.f + (av - 1.f) * kav); bon[i] += rr * kp * rkv;
                        KK[n4][i] = kx; Av[n4][i] = av;
                        float* o = rec0 + (ptrdiff_t)(i * dpos) * RECF + 16 * n4;
                        o[0] = dec; o[192] = kp; o[256] = rr; o[320] = vv; }
                }
                __builtin_amdgcn_sched_barrier(0);
            }
#pragma unroll
            for (int i = 0; i < 4; ++i) { const float s = red16(ss[i]), bo = red16(bon[i]); const float inv = rsq_f(fmaxf(s, 1e-12f));
                float* rec = rec0 + (ptrdiff_t)(i * dpos) * RECF;
#pragma unroll
                for (int n4 = 0; n4 < 4; ++n4) { const float kkn = KK[n4][i] * inv; rec[16 * n4 + 64] = kkn; rec[16 * n4 + 128] = -(kkn * Av[n4][i]); }
                if (r == 0) BON[(size_t)chain * SCANLEN + pos0 + i * dpos] = bo; }
        }
    }
}
template <bool CTXQ>
__device__ __forceinline__ void na_unit(const bf16* QN, const bf16* KN, const bf16* VTL, const bf16* VTC, const bf16* P, const float* rpb  , bf16* Y, int u, int lane) {
    const int n = lane & 15, q4 = lane >> 4;
    int b, h, qrow0, qr = 0, jt = 0;
    if (CTXQ) { b = u >> 8; h = (u >> 4) & 15; qrow0 = NLAT + b * CTXL + 16 * (u & 15); }
    else { jt = u & 3; h = (u >> 2) & 15; qr = (u >> 6) & 127; b = u >> 13; qrow0 = b * SEQ + qr * 64 + 16 * jt; }
    constexpr int NT = CTXQ ? 16 : 32, WT = CTXQ ? 0 : 16;
    f32x4 s[NT];
    const int rs = qr - 4 < 0 ? 0 : (qr - 4 > 120 ? 120 : qr - 4);
    const int span0 = jt == 0 ? 0 : (jt == 1 ? 8 : (jt == 2 ? 24 : 32));
    const int qc = 16 * jt + n; const int cs = qc - 8 < 0 ? 0 : (qc - 8 > 48 ? 48 : qc - 8);
    bf16x8 qf[2];
#pragma unroll
    for (int ks = 0; ks < 2; ++ks) qf[ks] = ld_frag(QN + (size_t)(qrow0 + n) * GWD + h * 64 + 32 * ks + 8 * q4);
    if (!CTXQ) {
        const float* rp = rpb + (size_t)h * 15 * 31;
#pragma unroll
        for (int wt = 0; wt < 16; ++wt) { const int kri = wt >> 1, half = wt & 1, relr = rs + kri - qr + 7;
#pragma unroll
            for (int i = 0; i < 4; ++i) { const int relc = span0 + 8 * q4 + 4 * half + i - qc + 15; const int relcc = relc < 0 ? 0 : (relc > 30 ? 30 : relc); s[wt][i] = rp[relr * 31 + relcc]; } }
        __builtin_amdgcn_sched_barrier(0);
#pragma unroll
        for (int bt = 0; bt < 2; ++bt) {
            bf16x8 kf[16];
#pragma unroll
            for (int t = 0; t < 8; ++t) { const int wt = bt * 8 + t, kri = wt >> 1, half = wt & 1;
                const bf16* kp = KN + (size_t)(b * SEQ + (rs + kri) * 64 + span0 + 8 * (n >> 2) + 4 * half + (n & 3)) * GWD + h * 64 + 8 * q4; kf[2 * t] = ld_frag(kp); kf[2 * t + 1] = ld_frag(kp + 32); }
            __builtin_amdgcn_sched_barrier(0);
#pragma unroll
            for (int t = 0; t < 8; ++t) { const int wt = bt * 8 + t, half = wt & 1;
                f32x4 a = s[wt];
#pragma unroll
                for (int i = 0; i < 4; ++i) { const int kc = span0 + 8 * q4 + 4 * half + i; const bool ok = kc >= cs && kc < cs + 16; a[i] = ok ? a[i] : -INFINITY; }
                a = mfma16(kf[2 * t], qf[0], a); a = mfma16(kf[2 * t + 1], qf[1], a); s[wt] = a; }
            __builtin_amdgcn_sched_barrier(0);
        }
    }
#pragma unroll
    for (int bt = 0; bt < 2; ++bt) {
        bf16x8 kf[16];
#pragma unroll
        for (int t = 0; t < 8; ++t) { const int ctile = bt * 8 + t; const bf16* kp = KN + (size_t)(NLAT + b * CTXL + 32 * (ctile >> 1) + 8 * (n >> 2) + 4 * (ctile & 1) + (n & 3)) * GWD + h * 64 + 8 * q4; kf[2 * t] = ld_frag(kp); kf[2 * t + 1] = ld_frag(kp + 32); }
        __builtin_amdgcn_sched_barrier(0);
#pragma unroll
        for (int t = 0; t < 8; ++t) { f32x4 a = {0.f, 0.f, 0.f, 0.f}; a = mfma16(kf[2 * t], qf[0], a); a = mfma16(kf[2 * t + 1], qf[1], a); s[WT + bt * 8 + t] = a; }
        __builtin_amdgcn_sched_barrier(0);
    }
    float mx = -INFINITY;
#pragma unroll
    for (int t = 0; t < NT; ++t) mx = fmaxf(fmaxf(fmaxf(s[t][0], s[t][1]), fmaxf(s[t][2], s[t][3])), mx);
    mx = max16x4(mx);
    float sum = 0.f;
#pragma unroll
    for (int t = 0; t < NT; ++t) {
#pragma unroll
        for (int i = 0; i < 4; ++i) { const float e = __expf(s[t][i] - mx); s[t][i] = e; sum += e; } }
    sum = sum16x4(sum);
    const float inv = rcp_f(sum);
    f32x4 o[4];
#pragma unroll
    for (int nt = 0; nt < 4; ++nt) o[nt] = (f32x4){0.f, 0.f, 0.f, 0.f};
#pragma unroll
    for (int tb = 0; tb < NT / 8; ++tb) {
        v4u vv[4][4];
#pragma unroll
        for (int tq = 0; tq < 4; ++tq) { const int tp = tb * 4 + tq;
            const bf16* vb; size_t dstride;
            if (!CTXQ && tp < 8) { vb = VTL + ((size_t)(b * 16 + h) * 64 + n) * 8192 + (rs + tp) * 64 + span0 + 8 * q4; dstride = (size_t)16 * 8192; }
            else { const int cp = tp - (CTXQ ? 0 : 8); vb = VTC + ((size_t)(b * 16 + h) * 64 + n) * 256 + 32 * cp + 8 * q4; dstride = (size_t)16 * 256; }
#pragma unroll
            for (int nt = 0; nt < 4; ++nt) vv[tq][nt] = *(const v4u*)(vb + nt * dstride); }
        __builtin_amdgcn_sched_barrier(0);
#pragma unroll
        for (int tq = 0; tq < 4; ++tq) { const int tp = tb * 4 + tq;
            const f32x4 p0 = s[2 * tp] * inv, p1 = s[2 * tp + 1] * inv;
            v4u aw; aw.x = pk2(p0[0], p0[1]); aw.y = pk2(p0[2], p0[3]); aw.z = pk2(p1[0], p1[1]); aw.w = pk2(p1[2], p1[3]);
            const bf16x8 af = __builtin_bit_cast(bf16x8, aw);
#pragma unroll
            for (int nt = 0; nt < 4; ++nt) o[nt] = mfma16(af, __builtin_bit_cast(bf16x8, vv[tq][nt]), o[nt]); }
        __builtin_amdgcn_sched_barrier(0);
    }
    unsigned short zz[4][4];
#pragma unroll
    for (int nt = 0; nt < 4; ++nt)
#pragma unroll
        for (int i = 0; i < 4; ++i) zz[nt][i] = P[(size_t)(qrow0 + 4 * q4 + i) * NIN + C_NAZ + h * 64 + 16 * nt + n];
    __builtin_amdgcn_sched_barrier(0);
#pragma unroll
    for (int nt = 0; nt < 4; ++nt)
#pragma unroll
        for (int i = 0; i < 4; ++i) { const int row = qrow0 + 4 * q4 + i, col = h * 64 + 16 * nt + n;
            Y[(size_t)row * DM + 1024 + col] = (bf16)f2bf(o[nt][i] * silu_f(bf2f(zz[nt][i]))); }
}
__device__ __forceinline__ void phase_sgu(const bf16* P, const f32x2* SGST, const float* lnw, const float* lnb, const bf16* SGW  , const float* sgb  , bf16* Y,
                                          LAS unsigned char* lds, int nchunks, int tid, int wave, int lane) {
    const int n = lane & 15, q4 = lane >> 4;
    LAS bf16* T = (LAS bf16*)lds;
    for (int u = blockIdx.x; u < nchunks * 8; u += 256) {
        const int ck = u >> 3, g = u & 7, m0 = ck * 128;
#pragma unroll
        for (int it = 0; it < 4; ++it) { const int idx = tid + 512 * it, q = idx >> 4, c8 = idx & 15;
            float x[8]; unpack8(*(const v4u*)(P + (size_t)(m0 + q) * NIN + C_SGV + g * 128 + 8 * c8), x);
            const f32x2 st = SGST[m0 + q];
#pragma unroll
            for (int j = 0; j < 8; ++j) { const int c = 8 * c8 + j; const float v = (x[j] - st.x) * st.y * lnw[g * 128 + c] + lnb[g * 128 + c]; T[c * 136 + q] = (bf16)f2bf(v); } }
        __syncthreads();
        bf16x8 af[4];
#pragma unroll
        for (int ks = 0; ks < 4; ++ks) af[ks] = ld_frag(SGW + ((size_t)g * 128 + 16 * wave + n) * 128 + 32 * ks + 8 * q4);
#pragma unroll
        for (int nt = 0; nt < 8; ++nt) {
            f32x4 acc = {0.f, 0.f, 0.f, 0.f};
#pragma unroll
            for (int ks = 0; ks < 4; ++ks) { const bf16x8 bfg = *(const LAS bf16x8*)(T + (16 * nt + n) * 136 + 32 * ks + 8 * q4); acc = mfma16(af[ks], bfg, acc); }
#pragma unroll
            for (int i = 0; i < 4; ++i) { const int p = 16 * wave + 4 * q4 + i, row = m0 + p, col = g * 128 + 16 * nt + n;
                const float mixed = acc[i] + sgb[g * 128 + p]; const bf16* pr = P + (size_t)row * NIN;
                const float uu = bf2f(pr[C_SGU + col]), z = bf2f(pr[C_SGZ + col]);
                Y[(size_t)row * DM + 3072 + col] = (bf16)f2bf(uu * mixed * silu_f(z)); }
        }
        __syncthreads();
    }
}
__device__ __forceinline__ void phase_scan(const float* REC, float* YR, LAS unsigned char* lds, int wave, int lane) {
    constexpr int NCH = SCANLEN / 16, SLOT = 16 * RECF * 4;
    for (int su = blockIdx.x; su < NCHAIN * 4; su += 256) {
        const int chain = (su & 7) * 8 + ((su >> 3) >> 2), part = (su >> 3) & 3;
        const char* recb = (const char*)(REC + (size_t)chain * SCANLEN * RECF);
        if (wave >= 4) {
            const int wl = wave - 4;
#define SCAN_ISSUE(cc, sl) do { _Pragma("unroll") for (int p_ = 0; p_ < 6; ++p_) \
            __builtin_amdgcn_global_load_lds((const unsigned*)(recb + (size_t)(cc) * SLOT + (wl * 6 + p_) * 1024 + lane * 16), (LAS unsigned*)(lds + (sl) * SLOT + (wl * 6 + p_) * 1024), 16, 0, 0); } while (0)
            SCAN_ISSUE(0, 0); SCAN_ISSUE(1, 1); SCAN_ISSUE(2, 2);
            for (int c = 0; c < NCH; ++c) {
                asm volatile("s_waitcnt vmcnt(12)" ::: "memory");
                __builtin_amdgcn_s_barrier();
                const int cc = c + 3 < NCH ? c + 3 : NCH - 1;
                SCAN_ISSUE(cc, (c + 3) & 3);
            }
            asm volatile("s_waitcnt vmcnt(0)" ::: "memory");
#undef SCAN_ISSUE
        } else {
            const int c16 = lane & 15, rg = lane >> 4, row = 16 * part + 4 * wave + rg;
            f32x2 Sa = {0.f, 0.f}, Sb = {0.f, 0.f};
            float* yout = YR + (size_t)chain * SCANLEN * 64 + row;
            const int lo_c = c16 * 16, lo_v = 1280 + row * 4;
#define SCAN_LD(dst, sl, s_) do { const LAS unsigned char* rec_ = (sl) + (s_) * (RECF * 4); dst##w = *(const LAS f32x4*)(rec_ + lo_c); dst##kk = *(const LAS f32x4*)(rec_ + 256 + lo_c); \
            dst##na = *(const LAS f32x4*)(rec_ + 512 + lo_c); dst##k = *(const LAS f32x4*)(rec_ + 768 + lo_c); dst##r = *(const LAS f32x4*)(rec_ + 1024 + lo_c); dst##v = *(const LAS float*)(rec_ + lo_v); } while (0)
            for (int c = 0; c < NCH; ++c) {
                __builtin_amdgcn_s_barrier();
                asm volatile("" ::: "memory");
                const LAS unsigned char* slot = lds + (c & 3) * SLOT;
                float ysave = 0.f, ypend = 0.f;
                f32x4 Aw, Akk, Ana, Ak, Ar; float Av;
                SCAN_LD(A, slot, 0);
#pragma unroll
                for (int s = 0; s < 16; ++s) {
                    f32x4 Bw, Bkk, Bna, Bk, Br; float Bv;
                    if (s < 15) SCAN_LD(B, slot, s + 1);
                    __builtin_amdgcn_sched_barrier(0);
                    f32x2 p = Sa * (f32x2){Akk.x, Akk.y}; p = __builtin_elementwise_fma(Sb, (f32x2){Akk.z, Akk.w}, p);
                    float dt = p.x + p.y, yr = ypend; red16x2(dt, yr);
                    const f32x2 vv = {Av, Av};
                    const f32x2 ua = __builtin_elementwise_fma(Sa, (f32x2){Aw.x, Aw.y}, vv * (f32x2){Ak.x, Ak.y}), ub = __builtin_elementwise_fma(Sb, (f32x2){Aw.z, Aw.w}, vv * (f32x2){Ak.z, Ak.w});
                    const f32x2 d2 = {dt, dt};
                    Sa = __builtin_elementwise_fma(d2, (f32x2){Ana.x, Ana.y}, ua); Sb = __builtin_elementwise_fma(d2, (f32x2){Ana.z, Ana.w}, ub);
                    if (s > 0) ysave = (c16 == s - 1) ? yr : ysave;
                    f32x2 q = Sa * (f32x2){Ar.x, Ar.y}; q = __builtin_elementwise_fma(Sb, (f32x2){Ar.z, Ar.w}, q);
                    ypend = q.x + q.y;
                    __builtin_amdgcn_sched_barrier(0);
                    if (s < 15) { Aw = Bw; Akk = Bkk; Ana = Bna; Ak = Bk; Ar = Br; Av = Bv; }
                }
                { const float y = red16(ypend); ysave = (c16 == 15) ? y : ysave; }
                asm volatile("" ::: "memory");
                yout[(size_t)(c * 16 + c16) * 64] = ysave;
            }
#undef SCAN_LD
        }
        __syncthreads();
    }
}
__device__ __forceinline__ void scan_self(const float* REC, float* YR, LAS unsigned char* lds, LAS unsigned* bcnt, int su, int wave, int lane) {
    constexpr int NCH = SCANLEN / 16, SLOT = 16 * RECF * 4;
    const int chain = (su & 7) * 8 + ((su >> 3) >> 2), part = (su >> 3) & 3;
    const char* recb = (const char*)(REC + (size_t)chain * SCANLEN * RECF);
    const int wl = wave;
#define SCAN_ISSUE(cc, sl) do { _Pragma("unroll") for (int p_ = 0; p_ < 6; ++p_) \
    __builtin_amdgcn_global_load_lds((const unsigned*)(recb + (size_t)(cc) * SLOT + (wl * 6 + p_) * 1024 + lane * 16), (LAS unsigned*)(lds + (sl) * SLOT + (wl * 6 + p_) * 1024), 16, 0, 0); } while (0)
    SCAN_ISSUE(0, 0); SCAN_ISSUE(1, 1); SCAN_ISSUE(2, 2);
    const int c16 = lane & 15, rg = lane >> 4, row = 16 * part + 4 * wave + rg;
    f32x2 Sa = {0.f, 0.f}, Sb = {0.f, 0.f};
    float* yout = YR + (size_t)chain * SCANLEN * 64 + row;
    const int lo_c = c16 * 16, lo_v = 1280 + row * 4;
#define SCAN_LD(dst, sl, s_) do { const LAS unsigned char* rec_ = (sl) + (s_) * (RECF * 4); dst##w = *(const LAS f32x4*)(rec_ + lo_c); dst##kk = *(const LAS f32x4*)(rec_ + 256 + lo_c); \
    dst##na = *(const LAS f32x4*)(rec_ + 512 + lo_c); dst##k = *(const LAS f32x4*)(rec_ + 768 + lo_c); dst##r = *(const LAS f32x4*)(rec_ + 1024 + lo_c); dst##v = *(const LAS float*)(rec_ + lo_v); } while (0)
    for (int c = 0; c < NCH; ++c) {
        asm volatile("s_waitcnt vmcnt(12)" ::: "memory");
        {   const unsigned baddr = (unsigned)(size_t)bcnt, one = 1u;
            if (lane == 0) asm volatile("ds_add_u32 %0, %1" :: "v"(baddr), "v"(one) : "memory");
            const unsigned want = 4u * (unsigned)(c + 1); unsigned sp = 0, got;
            for (;;) { asm volatile("ds_read_b32 %0, %1\n\ts_waitcnt lgkmcnt(0)" : "=v"(got) : "v"(baddr) : "memory");
                if (__builtin_amdgcn_readfirstlane((int)got) >= (int)want) break; __builtin_amdgcn_s_sleep(1); if (++sp > (1u << 22)) break; } }
        asm volatile("" ::: "memory");
        {   const int cc = c + 3 < NCH ? c + 3 : NCH - 1; SCAN_ISSUE(cc, (c + 3) & 3); }
        const LAS unsigned char* slot = lds + (c & 3) * SLOT;
        float ysave = 0.f, ypend = 0.f;
        f32x4 Aw, Akk, Ana, Ak, Ar; float Av;
        SCAN_LD(A, slot, 0);
#pragma unroll
        for (int s = 0; s < 16; ++s) {
            f32x4 Bw, Bkk, Bna, Bk, Br; float Bv;
            if (s < 15) SCAN_LD(B, slot, s + 1);
            __builtin_amdgcn_sched_barrier(0);
            f32x2 p = Sa * (f32x2){Akk.x, Akk.y}; p = __builtin_elementwise_fma(Sb, (f32x2){Akk.z, Akk.w}, p);
            float dt = p.x + p.y, yr = ypend; red16x2(dt, yr);
            const f32x2 vv = {Av, Av};
            const f32x2 ua = __builtin_elementwise_fma(Sa, (f32x2){Aw.x, Aw.y}, vv * (f32x2){Ak.x, Ak.y}), ub = __builtin_elementwise_fma(Sb, (f32x2){Aw.z, Aw.w}, vv * (f32x2){Ak.z, Ak.w});
            const f32x2 d2 = {dt, dt};
            Sa = __builtin_elementwise_fma(d2, (f32x2){Ana.x, Ana.y}, ua); Sb = __builtin_elementwise_fma(d2, (f32x2){Ana.z, Ana.w}, ub);
            if (s > 0) ysave = (c16 == s - 1) ? yr : ysave;
            f32x2 q = Sa * (f32x2){Ar.x, Ar.y}; q = __builtin_elementwise_fma(Sb, (f32x2){Ar.z, Ar.w}, q);
            ypend = q.x + q.y;
            __builtin_amdgcn_sched_barrier(0);
            if (s < 15) { Aw = Bw; Akk = Bkk; Ana = Bna; Ak = Bk; Ar = Br; Av = Bv; }
        }
        { const float y = red16(ypend); ysave = (c16 == 15) ? y : ysave; }
        asm volatile("" ::: "memory");
        yout[(size_t)(c * 16 + c16) * 64] = ysave;
    }
    asm volatile("s_waitcnt vmcnt(0)" ::: "memory");
#undef SCAN_LD
#undef SCAN_ISSUE
}
__device__ __forceinline__ void phase_rwfin(const bf16* P, const float* YR, const float* REC, const float* BON, const float* lnw, const float* lnb, bf16* Y, int nrows, int gw, int NGW, int lane) {
    const int head = lane >> 2, sub = lane & 3;
    for (int m = gw; m < nrows; m += NGW) {
        const bool isctx = m >= NLAT; const int t = isctx ? ((m - NLAT) & 255) : (m & 8191); const int b = isctx ? ((m - NLAT) >> 8) : (m >> 13);
        float out[16];
#pragma unroll
        for (int i = 0; i < 16; ++i) out[i] = 0.f;
#pragma unroll
        for (int d = 0; d < 2; ++d) {
            const int chain = (b * 2 + d) * 16 + head; const size_t pp = (size_t)chain * SCANLEN + scan_pos(d, isctx, t);
            float y[16], v[16];
#pragma unroll
            for (int j = 0; j < 4; ++j) { const f32x4 a = *(const f32x4*)(YR + pp * 64 + 16 * sub + 4 * j), c = *(const f32x4*)(REC + pp * RECF + 320 + 16 * sub + 4 * j);
                y[4 * j] = a.x; y[4 * j + 1] = a.y; y[4 * j + 2] = a.z; y[4 * j + 3] = a.w; v[4 * j] = c.x; v[4 * j + 1] = c.y; v[4 * j + 2] = c.z; v[4 * j + 3] = c.w; }
            const float bo = BON[pp];
            float s = 0.f;
#pragma unroll
            for (int i = 0; i < 16; ++i) s += y[i];
            s += __shfl_xor(s, 1); s += __shfl_xor(s, 2);
            const float mean = s * (1.f / 64.f); float q = 0.f;
#pragma unroll
            for (int i = 0; i < 16; ++i) { const float dl = y[i] - mean; q += dl * dl; }
            q += __shfl_xor(q, 1); q += __shfl_xor(q, 2);
            const float rstd = rsq_f(q * (1.f / 64.f) + 64e-5f);
#pragma unroll
            for (int i = 0; i < 16; ++i) { const int ch = head * 64 + 16 * sub + i; out[i] += (y[i] - mean) * rstd * lnw[ch] + lnb[ch] + bo * v[i]; }
        }
        float z[16]; unpack8(*(const v4u*)(P + (size_t)m * NIN + C_RWZ + 16 * lane), z); unpack8(*(const v4u*)(P + (size_t)m * NIN + C_RWZ + 16 * lane + 8), z + 8);
#pragma unroll
        for (int i = 0; i < 16; ++i) out[i] *= silu_f(z[i]);
        *(v4u*)(Y + (size_t)m * DM + 2048 + 16 * lane) = pack8(out); *(v4u*)(Y + (size_t)m * DM + 2048 + 16 * lane + 8) = pack8(out + 8);
    }
}
#define XB_TMO      128
#define XB_XCNT(j)  (256  + 64 * (j))
#define XB_XSUB(j)  (1280 + 64 * (j))
#define XB_XGEN(j)  (2304 + 64 * (j))
#define XB_TOP      3328
#define XB_TOPGEN   3392
#define XCD_BAR_WORDS 3456
#define XB_SPIN_CAP (1u << 18)

__device__ __forceinline__ unsigned xb_ld(unsigned* p)              { return __hip_atomic_load(p, __ATOMIC_RELAXED, __HIP_MEMORY_SCOPE_AGENT); }
__device__ __forceinline__ unsigned xb_add(unsigned* p, unsigned v) { return __hip_atomic_fetch_add(p, v, __ATOMIC_RELAXED, __HIP_MEMORY_SCOPE_AGENT); }
__device__ __forceinline__ unsigned xb_xcc_id() { return (unsigned)__builtin_amdgcn_s_getreg((3 << 11) | 20) & 0xFu; }
#define XB_SPIN(cond, bar) do { unsigned _sp = 0; while (cond) { __builtin_amdgcn_s_sleep(1); \
    if ((++_sp & 255u) == 0u) { if (xb_ld(&(bar)[XB_TMO])) break; if (_sp > XB_SPIN_CAP) { atomicAdd(&(bar)[XB_TMO], 1u); break; } } } } while (0)

struct XcdBarrier {
    unsigned* bar; unsigned x;
    volatile LAS unsigned* st;
};

__device__ __forceinline__ XcdBarrier xcd_barrier_post(unsigned* bar, volatile LAS unsigned* st) {
    XcdBarrier b; b.bar = bar; b.x = xb_xcc_id(); b.st = st;
    if (threadIdx.x == 0) (void)xb_add(&bar[XB_XCNT(b.x)], 1u);
    return b;
}
__device__ __forceinline__ void xcd_barrier_complete(unsigned* bar, unsigned x, unsigned& nloc, unsigned& nx) {
    const unsigned G = gridDim.x * gridDim.y * gridDim.z;
    unsigned sum, cnt, mine, sp = 0u;
    for (;;) {
        sum = 0u; cnt = 0u; mine = 0u;
#pragma unroll
        for (unsigned j = 0; j < 16; ++j) { const unsigned c = xb_ld(&bar[XB_XCNT(j)]); sum += c; cnt += (c > 0u) ? 1u : 0u; mine = (j == x) ? c : mine; }
        if (sum == G) break;
        __builtin_amdgcn_s_sleep(1);
        if ((++sp & 255u) == 0u) { if (xb_ld(&bar[XB_TMO])) break; if (sp > XB_SPIN_CAP) { atomicAdd(&bar[XB_TMO], 1u); break; } }
    }
    nloc = mine > 0u ? mine : 1u; nx = cnt > 0u ? cnt : 1u;
}

__device__ __forceinline__ void xcd_barrier(const XcdBarrier& b) {
    asm volatile("s_waitcnt vmcnt(0)" ::: "memory");
    __syncthreads();
    if (threadIdx.x == 0) {
        unsigned* bar = b.bar;
        __builtin_amdgcn_s_waitcnt(0);
        unsigned nloc = b.st[0], nx = b.st[1];
        if (nloc == 0u) { xcd_barrier_complete(bar, b.x, nloc, nx); b.st[0] = nloc; b.st[1] = nx; }
        const unsigned old = xb_add(&bar[XB_XSUB(b.x)], 1u);
        const unsigned gen = old / nloc;
        if (old + 1u == (gen + 1u) * nloc) {
            __builtin_amdgcn_fence(__ATOMIC_RELEASE, "agent");
            asm volatile("s_waitcnt vmcnt(0)" ::: "memory");
            const unsigned og = xb_add(&bar[XB_TOP], 1u);
            const unsigned tg = og / nx;
            if (og + 1u == (tg + 1u) * nx) xb_add(&bar[XB_TOPGEN], 1u);
            else XB_SPIN(xb_ld(&bar[XB_TOPGEN]) == tg, bar);
            __builtin_amdgcn_fence(__ATOMIC_ACQUIRE, "agent");
            xb_add(&bar[XB_XGEN(b.x)], 1u);
            asm volatile("s_waitcnt vmcnt(0)" ::: "memory");
        } else {
            XB_SPIN(xb_ld(&bar[XB_XGEN(b.x)]) == gen, bar);
            __builtin_amdgcn_fence(__ATOMIC_ACQUIRE, "agent");
            asm volatile("s_waitcnt vmcnt(0)" ::: "memory");
        }
    }
    __syncthreads();
}

#ifndef MK_SPLIT
#define MK_SPLIT 0
#endif
#ifndef REP_G1
#define REP_G1 1
#endif
#ifndef REP_PREP
#define REP_PREP 1
#endif
#ifndef REP_MIXA
#define REP_MIXA 1
#endif
#ifndef REP_RWP
#define REP_RWP 1
#endif
#ifndef REP_POOL
#define REP_POOL 1
#endif
#ifndef REP_NA
#define REP_NA 1
#endif
#ifndef REP_SGU
#define REP_SGU 1
#endif
#ifndef REP_ROWP
#define REP_ROWP 1
#endif
#ifndef REP_VT
#define REP_VT 1
#endif
#ifndef REP_SCAN
#define REP_SCAN 1
#endif
constexpr int NPHASE = 2 + 6 * DEPTH;
constexpr int NGRID = 256;
struct Args { const float* in[28]; float* out; unsigned char* ws; int ph_lo, ph_hi, li, pad; };

__global__ void __launch_bounds__(NWAVES * 64, 2) fwd(Args args) {
    extern __shared__ __attribute__((aligned(16))) unsigned char lds_raw[];
    LAS unsigned char* lds = (LAS unsigned char*)lds_raw;
    volatile LAS unsigned* MISC = (volatile LAS unsigned*)(lds + MISC_OFF);
    const int tid = threadIdx.x, lane = tid & 63, wave = __builtin_amdgcn_readfirstlane(tid >> 6);
    constexpr int G = NGRID; const int bx = blockIdx.x;
    const int vcu = (bx % 8) * (G / 8) + bx / 8;
    const int gw = vcu * NWAVES + wave; constexpr int NGW = G * NWAVES;
    unsigned char* ws = args.ws;
    const int lo = args.ph_lo, hi = args.ph_hi;

    for (int u = tid; u < (LDS_BYTES - LDSCTL_OFF) / 4; u += NWAVES * 64) ((LAS unsigned*)(lds + LDSCTL_OFF))[u] = 0u;
    __syncthreads();
    XcdBarrier bar; bar.bar = (unsigned*)(ws + WS_CTL) + CW_BAR; bar.x = 0; bar.st = MISC + 8;
    if (hi - lo > 1) bar = xcd_barrier_post((unsigned*)(ws + WS_CTL) + CW_BAR, MISC + 8);
#define IN(k) (lo <= (k) && (k) < hi)
#define SEAM(k) do { if (lo <= (k) && (k) + 1 < hi) { XcdBarrier b2_; b2_.bar = WSP(unsigned, WS_CTL) + CW_BAR; b2_.x = bar.x; b2_.st = bar.st; xcd_barrier(b2_); } } while (0)

#define OPQ_S(x) ({ int _t = (x); asm volatile("" : "+s"(_t)); _t; })
#define OPQ_V(x) ({ int _t = (x); asm volatile("" : "+v"(_t)); _t; })
#define INP(i) (args.in[OPQ_S(i)])
#define WSP(T, off) ((T*)(args.ws + ({ size_t _o = (off); asm volatile("" : "+s"(_o)); _o; })))
#define x_in INP(0)
#define c_in INP(1)
#define ctx_in INP(2)
#define cctx_in INP(3)
#define w_mod INP(4)
#define b_mod INP(5)
#define w_in INP(6)
#define w_out INP(7)
#define pool_w INP(8)
#define pool_scale INP(9)
#define na_qg INP(10)
#define na_kg INP(11)
#define na_rpb INP(12)
#define rw_mu_rkv INP(13)
#define rw_mu_lora INP(14)
#define rw_w0 INP(15)
#define rw_w_up INP(16)
#define rw_a0 INP(17)
#define rw_a_up INP(18)
#define rw_k_k INP(19)
#define rw_k_a INP(20)
#define rw_r_k INP(21)
#define rw_ln_w INP(22)
#define rw_ln_b INP(23)
#define sg_ln_w INP(24)
#define sg_ln_b INP(25)
#define sg_w INP(26)
#define sg_b INP(27)
#define MOD WSP(float, WS_MOD)
#define MODP WSP(float, WS_MODP)
#define TAB WSP(f32x2, WS_TAB)
#define SGST WSP(f32x2, WS_SGST)
#define BON WSP(float, WS_BON)
#define POOLWT WSP(bf16, WS_POOLWT)
#define WUPT WSP(bf16, WS_WUPT)
#define AUPT WSP(bf16, WS_AUPT)
#define SGW WSP(bf16, WS_SGW)
#define VTC WSP(bf16, WS_VTC)
#define VTL WSP(bf16, WS_VTL)
#define HCTX WSP(float, WS_HCTX)
#define QN WSP(bf16, WS_QN)
#define KN WSP(bf16, WS_KN)
#define WOUTT WSP(bf16, WS_WOUTT)
#define WINT WSP(bf16, WS_WINT)
#define XN WSP(bf16, WS_XN)
#define Y WSP(bf16, WS_Y)
#define P WSP(bf16, WS_P)
#define YR WSP(float, WS_YR)
#define REC WSP(float, WS_REC)
    float* const out = args.out;

    if (IN(0)) {
        LAS float* scr = (LAS float*)(lds + wave * 16384);
        constexpr int I_MOD = 4 * 64 * 48, I_WIN1 = 64 * (NIN / 32), I_WIN = 4 * I_WIN1, I_WOUT1 = 64 * 128, I_WOUT = 4 * I_WOUT1, I_POOL = 16 * 32, I_WUP = 8 * 32, I_AUP = 8 * 32, I_SGW = 1024;
        constexpr int NITEMS = I_MOD + I_WIN + I_WOUT + I_POOL + I_WUP + I_AUP + I_SGW;
        for (int it = gw; it < NITEMS; it += NGW) {
            int r = it;
            if (r < I_MOD) { p0_mod_item(w_mod, c_in, cctx_in, MODP, scr, r, lane); continue; } r -= I_MOD;
            if (r < I_WIN) { const int l = r / I_WIN1; p0_transpose_item(w_in + (size_t)l * DM * NIN, DM, NIN, WINT + (size_t)l * NIN * DM, scr, r % I_WIN1, lane); continue; } r -= I_WIN;
            if (r < I_WOUT) { const int l = r / I_WOUT1; p0_transpose_item(w_out + (size_t)l * DM * DM, DM, DM, WOUTT + (size_t)l * DM * DM, scr, r % I_WOUT1, lane); continue; } r -= I_WOUT;
            if (r < I_POOL) { const int lg = r / 32; p0_transpose_item(pool_w + (size_t)lg * 65536, 256, 256, POOLWT + (size_t)lg * 65536, scr, r % 32, lane); continue; } r -= I_POOL;
            if (r < I_WUP) { const int ld = r / 32; p0_transpose_item(rw_w_up + (size_t)ld * 65536, 64, 1024, WUPT + (size_t)ld * 65536, scr, r % 32, lane); continue; } r -= I_WUP;
            if (r < I_AUP) { const int ld = r / 32; p0_transpose_item(rw_a_up + (size_t)ld * 65536, 64, 1024, AUPT + (size_t)ld * 65536, scr, r % 32, lane); continue; } r -= I_AUP;
            {   const size_t e0 = (size_t)r * 512 + lane * 8; const f32x4 a = *(const f32x4*)(sg_w + e0), b = *(const f32x4*)(sg_w + e0 + 4);
                v4u o; o.x = pk2(a.x, a.y); o.y = pk2(a.z, a.w); o.z = pk2(b.x, b.y); o.w = pk2(b.z, b.w); *(v4u*)(SGW + e0) = o; }
        }
        SEAM(0);
    }
    if (IN(1)) {
        for (int idx = gw * 64 + lane; idx < 4 * 3 * 12288; idx += NGW * 64) {
            const int l = idx / 36864, c = (idx / 12288) % 3, n = idx % 12288;
            float s = b_mod[l * 12288 + n];
            const float* pp = MODP + ((size_t)(l * 64) * 3 + c) * 12288 + n;
#pragma unroll 8
            for (int kc = 0; kc < 64; ++kc) s += pp[(size_t)kc * 3 * 12288];
            MOD[idx] = s;
        }
        for (int idx = gw * 64 + lane; idx < 2048; idx += NGW * 64) {
            const int pos = idx >> 4, i = idx & 15;
            float inv = (i & 3) == 0 ? 1.0f : ((i & 3) == 1 ? 0.5623413251903491f : ((i & 3) == 2 ? 0.31622776601683794f : 0.17782794100389228f));
            inv *= (i >> 2) == 0 ? 1.0f : ((i >> 2) == 1 ? 0.1f : ((i >> 2) == 2 ? 0.01f : 0.001f));
            float cc, sn; sincos_acc((float)pos * inv, cc, sn);
            TAB[idx] = (f32x2){cc, sn};
        }
        SEAM(1);
    }
    for (int l = 0; l < DEPTH; ++l) {
        const int pb = 2 + 6 * l;
        const bool with_ctx = l < DEPTH - 1;
#define hin_lat (l == 0 ? x_in : (const float*)out)
#define hin_ctx (l == 0 ? ctx_in : (const float*)HCTX)
#define mod (MOD + (size_t)l * 3 * 12288)
        const int nrows = with_ctx ? MROWS : NLAT;
        if (IN(pb + 0)) {
            phase_xn(hin_lat, hin_ctx, mod, XN, OPQ_S(gw), NGW, OPQ_V(lane));
            SEAM(pb + 0);
        }
        if (IN(pb + 1)) {
            pg8::Gemm g{XN, WINT + (size_t)l * NIN * DM, MROWS, NIN, DM}; pg8::StaticOrder S; S.init(MROWS, NIN, G, bx);
            pg8::EpiStoreBf16 E{P, NIN};
            for (int rep = 0; rep < REP_G1; ++rep) pg8::gemm_phase<pg8::EpiStoreBf16, pg8::StaticOrder, true, true>(lds, g, S, E);
            SEAM(pb + 1);
        }
        if (IN(pb + 2)) {
            for (int rep = 0; rep < REP_PREP; ++rep) {
            for (int rep2 = 0; rep2 < REP_ROWP; ++rep2)
            phase_rowprep(P, na_qg + l * 64, na_kg + l * 64, TAB, QN, KN, SGST, OPQ_S(gw), NGW, OPQ_V(lane));
            for (int rep2 = 0; rep2 < REP_VT; ++rep2)
            phase_vt(P, VTL, VTC, OPQ_S(gw), NGW, OPQ_V(lane));
            for (int rep2 = 0; rep2 < REP_RWP; ++rep2)
            phase_rwprep(P, rw_mu_rkv + (size_t)l * 6144, rw_mu_lora + (size_t)l * 256, rw_w0 + (size_t)l * 2048, WUPT + (size_t)l * 131072, rw_a0 + (size_t)l * 2048, AUPT + (size_t)l * 131072,
                         rw_k_k + (size_t)l * 1024, rw_k_a + (size_t)l * 1024, rw_r_k + (size_t)l * 1024, REC, BON, OPQ_S(gw), NGW, OPQ_V(lane));
            }
            SEAM(pb + 2);
        }
        if (IN(pb + 3)) {
            phase_sgu(P, SGST, sg_ln_w + (size_t)l * 1024, sg_ln_b + (size_t)l * 1024, SGW + (size_t)l * 131072, sg_b + (size_t)l * 1024, Y, lds, nrows / 128, OPQ_V(tid), wave, OPQ_V(lane));
            LAS unsigned* mixq = (LAS unsigned*)(lds + LDSCTL_OFF + 64); LAS unsigned* mixb = (LAS unsigned*)(lds + LDSCTL_OFF + 128);
            if (tid == 0) { *mixq = 0u; *mixb = 0u; }
            __syncthreads();
            if (wave < 4) scan_self(REC, YR, lds, mixb, bx, wave, OPQ_V(lane));
            {   const int nctxu = with_ctx ? 2 : 0, npool = (nrows / 16) * 4, nq = 64 + nctxu + (npool + NGRID - 1) / NGRID;
                for (;;) {
                    unsigned k = 0; if (lane == 0) k = __hip_atomic_fetch_add(mixq, 1u, __ATOMIC_RELAXED, __HIP_MEMORY_SCOPE_WORKGROUP);
                    k = (unsigned)__builtin_amdgcn_readfirstlane((int)k);
                    if ((int)k >= nq) break;
                    const int ln = OPQ_V(lane);
                    if (k < 64u) na_unit<false>(QN, KN, VTL, VTC, P, na_rpb + (size_t)l * 16 * 15 * 31, Y, bx * 64 + (int)k, ln);
                    else if ((int)k < 64 + nctxu) na_unit<true>(QN, KN, VTL, VTC, P, na_rpb, Y, bx * 2 + ((int)k - 64), ln);
                    else { const int u = bx + NGRID * ((int)k - 64 - nctxu);
                        if (u < npool) { const int tt = u >> 2, g = u & 3; const bf16* wbase = POOLWT + (size_t)l * 262144 + (size_t)g * 65536; const float* psc = pool_scale + (size_t)l * 1024;
                            if (g == 0) pool_unit<0>(P, wbase, psc, Y, tt * 16, ln); else if (g == 1) pool_unit<1>(P, wbase, psc, Y, tt * 16, ln);
                            else if (g == 2) pool_unit<2>(P, wbase, psc, Y, tt * 16, ln); else pool_unit<3>(P, wbase, psc, Y, tt * 16, ln); } }
                }
            }
            SEAM(pb + 3);
        }
        if (IN(pb + 4)) {
            phase_rwfin(P, YR, REC, BON, rw_ln_w + (size_t)l * 1024, rw_ln_b + (size_t)l * 1024, Y, nrows, OPQ_S(gw), NGW, OPQ_V(lane));
            SEAM(pb + 4);
        }
        if (IN(pb + 5)) {
            pg8::Gemm g{Y, WOUTT + (size_t)l * DM * DM, nrows, DM, DM}; pg8::StaticOrder S; S.init(nrows, DM, G, bx);
            pg8::EpiResGate E{hin_lat, hin_ctx, out, HCTX, mod};
            pg8::gemm_phase<pg8::EpiResGate, pg8::StaticOrder, true, true>(lds, g, S, E);
            SEAM(pb + 5);
        }
    }
#undef IN
#undef SEAM
}
#undef hin_lat
#undef hin_ctx
#undef mod
#undef P
#undef Y
#undef XN
#undef out

extern "C" void kernel_launch(void* const* d_in, const int* in_sizes, int n_in, void* d_out, int out_size, void* d_ws, size_t ws_size, hipStream_t stream) {
    static int grid = 0;
    if (grid == 0) {
        if (n_in != 28 || out_size != NLAT * DM || ws_size < WS_END) { fprintf(stderr, "kernel_launch: unexpected shapes (n_in %d, out %d, ws %zu < %zu); nothing launched\n", n_in, out_size, ws_size, (size_t)WS_END); grid = -1; return; }
        int dev = 0, cus = 0, per_cu = 0;
        if (hipGetDevice(&dev) != hipSuccess || hipDeviceGetAttribute(&cus, hipDeviceAttributeMultiprocessorCount, dev) != hipSuccess) { grid = -1; return; }
        if (hipFuncSetAttribute((const void*)fwd, hipFuncAttributeMaxDynamicSharedMemorySize, LDS_BYTES) != hipSuccess) { fprintf(stderr, "kernel_launch: hipFuncSetAttribute failed\n"); grid = -1; return; }
        if (hipOccupancyMaxActiveBlocksPerMultiprocessor(&per_cu, (const void*)fwd, NWAVES * 64, LDS_BYTES) != hipSuccess || per_cu < 1)
            fprintf(stderr, "kernel_launch: note: occupancy query reports %d workgroups per CU\n", per_cu);
        (void)hipGetLastError();
        grid = cus >= NGRID ? NGRID : -2;
    }
    if (grid == -1) return;
    if (hipMemsetAsync((char*)d_ws + WS_CTL, 0, CTL_ZERO_BYTES, stream) != hipSuccess) { fprintf(stderr, "kernel_launch: memset failed\n"); return; }
    Args a{};
    for (int i = 0; i < 28; ++i) a.in[i] = (const float*)d_in[i];
    a.out = (float*)d_out; a.ws = (unsigned char*)d_ws; a.li = 0; a.pad = 0;
    const bool split = MK_SPLIT || grid == -2;
    if (split) { for (int k = 0; k < NPHASE; ++k) { a.ph_lo = k; a.ph_hi = k + 1; hipLaunchKernelGGL(fwd, dim3(NGRID), dim3(NWAVES * 64), LDS_BYTES, stream, a); } }
    else { a.ph_lo = 0; a.ph_hi = NPHASE; hipLaunchKernelGGL(fwd, dim3(NGRID), dim3(NWAVES * 64), LDS_BYTES, stream, a); }
    const hipError_t le = hipPeekAtLastError();
    if (le != hipSuccess) fprintf(stderr, "kernel_launch: launch failed: %s\n", hipGetErrorName(le));
}
```

```cpp
#include <hip/hip_runtime.h>
#include <cstdio>
#include <cstdint>
#define MK_SPLIT 0
#define REC_NT 1
namespace pg8 {
#define PG8_LAS __attribute__((address_space(3)))
typedef unsigned short bf16_t;
typedef short bf16x8 __attribute__((ext_vector_type(8)));
typedef float f32x4 __attribute__((ext_vector_type(4)));
typedef unsigned u32x4 __attribute__((ext_vector_type(4)));
constexpr int BM = 256, BK = 64, HALF = 128, HTB = HALF * BK * 2  , STAGE_BYTES = 8 * HTB, NXCD = 8, WGM = 8;

__host__ __device__ __forceinline__ int lds_byte(int r, int c) { const int st = (r >> 4) * 2 + (c >> 5), rr = r & 15, cc = c & 31, ob = rr * 64 + cc * 2; return st * 1024 + (ob ^ (((ob >> 9) & 1) << 5)); }
__host__ __device__ __forceinline__ void stage_rc(int b, int& R, int& C) { const int st = b / 1024, sb = b % 1024, swz = sb ^ (((sb >> 9) & 1) << 5); R = (st >> 1) * 16 + swz / 64; C = (st & 1) * 32 + (swz % 64) / 2; }
__host__ __device__ __forceinline__ int perm32(int rho) { const int n = rho >> 4, i = rho & 15; return 8 * (i >> 2) + 4 * n + (i & 3); }

struct Unit { int pm, pn; };
struct Gemm { const bf16_t* A; const bf16_t* Bt; int M, N, K; };

struct StaticOrder {
    int nM, nN, nwg, G, c;
    __host__ __device__ void init(int M, int N, int G_, int c_) { nM = M / BM; nN = N / BM; nwg = nM * nN; G = G_; c = c_; }
    __host__ __device__ bool next(int i, Unit& u) const {
        const long L = (long)i * G + c; if (L >= nwg) return false;
        int wgid = (int)L; { const int q = nwg / NXCD, r = nwg % NXCD, xcd = wgid % NXCD, off = wgid / NXCD; wgid = (xcd < r ? xcd * (q + 1) : r * (q + 1) + (xcd - r) * q) + off; }
        const int nig = WGM * nN, gid = wgid / nig, fm = gid * WGM, gsz = (nM - fm) < WGM ? (nM - fm) : WGM;
        u.pm = fm + ((wgid % nig) % gsz); u.pn = (wgid % nig) / gsz; return true;
    }
    __device__ __forceinline__ void a_ready(const Unit&) const {}
    __device__ __forceinline__ void done(const Unit&) const {}
};

__device__ __forceinline__ unsigned cvt_pk_bf16(float lo, float hi) { unsigned r; asm volatile("v_cvt_pk_bf16_f32 %0, %1, %2" : "=v"(r) : "v"(lo), "v"(hi)); return r; }
template <class Epi, class Sched, bool ALIGN_EPI = false, bool SP2 = false>
__device__ __forceinline__ void gemm_phase(PG8_LAS unsigned char* lds, const Gemm g, const Sched& S, const Epi& E) {
    int tid_ = threadIdx.x; asm volatile("" : "+v"(tid_));
    const int tid = tid_, wid = __builtin_amdgcn_readfirstlane(tid >> 6), lane = tid & 63, wr = wid >> 2, wc = wid & 3, fr = lane & 15, fq = lane >> 4;
    const int K = g.K, nt = K / BK;
    unsigned voffA[2], voffB[2];
#pragma unroll
    for (int i = 0; i < 2; ++i) { int R, C; stage_rc(tid * 16 + i * 8192, R, C); const int Rb = Epi::PERM ? ((R & ~31) + perm32(R & 31)) : R;
        voffA[i] = (unsigned)(R * K + C) * 2u; voffB[i] = (unsigned)(Rb * K + C) * 2u; }
    const size_t kstep = (size_t)(BK * 2);
    const size_t hstep = (size_t)HALF * K * 2;
    const size_t tstep = 2 * hstep;
    const unsigned ldsw = (unsigned)wid * 1024u;
    const int aoff = lds_byte(wr * 64 + fr, fq * 8), boff = lds_byte(wc * 32 + fr, fq * 8);
#define PG8_SA(b, h) (((b) * 2 + (h)) * HTB)
#define PG8_SB(b, h) ((4 + (b) * 2 + (h)) * HTB)
#define PG8_STAGE(bufoff, gbase, voff) do { _Pragma("unroll") for (int _i = 0; _i < 2; ++_i) \
        __builtin_amdgcn_global_load_lds((const unsigned*)((const char*)(gbase) + (voff)[_i]), (PG8_LAS unsigned*)(lds + (bufoff) + ldsw + _i * 8192), 16, 0, 0); } while (0)
#define PG8_LDA(dst, b, h) do { _Pragma("unroll") for (int m = 0; m < 4; ++m) _Pragma("unroll") for (int k = 0; k < 2; ++k) dst[m][k] = *(const PG8_LAS bf16x8*)(lds + PG8_SA(b, h) + aoff + m * 2048 + k * 1024); } while (0)
#define PG8_LDB(dst, b, h) do { _Pragma("unroll") for (int n = 0; n < 2; ++n) _Pragma("unroll") for (int k = 0; k < 2; ++k) dst[n][k] = *(const PG8_LAS bf16x8*)(lds + PG8_SB(b, h) + boff + n * 2048 + k * 1024); } while (0)
#define PG8_MMA(ai, bj, At, Bt) do { __builtin_amdgcn_s_setprio(1); _Pragma("unroll") for (int m = 0; m < 4; ++m) _Pragma("unroll") for (int n = 0; n < 2; ++n) _Pragma("unroll") for (int k = 0; k < 2; ++k) \
        acc[ai][bj][m][n] = __builtin_amdgcn_mfma_f32_16x16x32_bf16(Bt[n][k], At[m][k], acc[ai][bj][m][n], 0, 0, 0); __builtin_amdgcn_s_setprio(0); } while (0)
#define PG8_WAIT_V(n) asm volatile("s_waitcnt vmcnt(" #n ")" ::: "memory")
#define PG8_WAIT_L(n) asm volatile("s_waitcnt lgkmcnt(" #n ")" ::: "memory")
#define PG8_BAR __builtin_amdgcn_s_barrier()
#define PG8_SCHED __builtin_amdgcn_sched_barrier(0)
    Unit cur, nxt; int ui = 0;
    if (!S.next(0, cur)) return;
    f32x4 acc[2][2][4][2];
#pragma unroll
    for (int a = 0; a < 2; ++a)
#pragma unroll
        for (int b = 0; b < 2; ++b)
#pragma unroll
            for (int m = 0; m < 4; ++m)
#pragma unroll
                for (int n = 0; n < 2; ++n) acc[a][b][m][n] = (f32x4){0.f, 0.f, 0.f, 0.f};
    bf16x8 At[4][2], B0[2][2], B1[2][2];
    const char* cA = (const char*)g.A + (size_t)cur.pm * tstep; const char* cB = (const char*)g.Bt + (size_t)cur.pn * tstep;
    S.a_ready(cur);
    if constexpr (SP2) {
        PG8_STAGE(PG8_SB(0, 0), cB, voffB); PG8_STAGE(PG8_SB(0, 1), cB + hstep, voffB); PG8_STAGE(PG8_SA(0, 0), cA, voffA); PG8_STAGE(PG8_SA(0, 1), cA + hstep, voffA);
        if (wr == 1) PG8_BAR;
        PG8_WAIT_V(2); PG8_BAR;
        PG8_STAGE(PG8_SB(1, 0), cB + kstep, voffB); PG8_STAGE(PG8_SA(1, 0), cA + kstep, voffA); PG8_STAGE(PG8_SB(1, 1), cB + hstep + kstep, voffB);
        PG8_WAIT_V(6); PG8_BAR;
    } else {
        PG8_STAGE(PG8_SB(0, 0), cB, voffB); PG8_STAGE(PG8_SA(0, 0), cA, voffA); PG8_STAGE(PG8_SB(0, 1), cB + hstep, voffB); PG8_STAGE(PG8_SA(0, 1), cA + hstep, voffA);
        if (wr == 1) PG8_BAR;
        PG8_WAIT_V(4); PG8_BAR;
        PG8_STAGE(PG8_SB(1, 0), cB + kstep, voffB); PG8_STAGE(PG8_SA(1, 0), cA + kstep, voffA); PG8_STAGE(PG8_SB(1, 1), cB + hstep + kstep, voffB);
        PG8_WAIT_V(6); PG8_BAR;
    }
    for (;;) {
        const bool has_next = S.next(ui + 1, nxt);
        const char* nA = has_next ? (const char*)g.A + (size_t)nxt.pm * tstep : cA; const char* nB = has_next ? (const char*)g.Bt + (size_t)nxt.pn * tstep : cB;
        for (int t = 0; t < nt; t += 2) {
            const bool last = (t == nt - 2);
            const char* a1 = cA + (size_t)(t + 1) * kstep;
            const char* a2 = last ? nA : cA + (size_t)(t + 2) * kstep; const char* b2 = last ? nB : cB + (size_t)(t + 2) * kstep;
            const char* a3 = a2 + kstep; const char* b3 = b2 + kstep;
            if (last && has_next) S.a_ready(nxt);
            if constexpr (SP2) {
            PG8_LDB(B0, 0, 0); PG8_LDB(B1, 0, 1); PG8_SCHED; PG8_LDA(At, 0, 0); PG8_STAGE(PG8_SA(1, 1), a1 + hstep, voffA);
            PG8_WAIT_V(8); PG8_WAIT_L(0); PG8_BAR; PG8_MMA(0, 0, At, B0); PG8_MMA(0, 1, At, B1); PG8_BAR; PG8_SCHED;
            PG8_LDA(At, 0, 1); PG8_STAGE(PG8_SB(0, 0), b2, voffB); PG8_STAGE(PG8_SB(0, 1), b2 + hstep, voffB); PG8_STAGE(PG8_SA(0, 0), a2, voffA);
            PG8_WAIT_V(8); PG8_WAIT_L(0); PG8_BAR; PG8_MMA(1, 0, At, B0); PG8_MMA(1, 1, At, B1); PG8_BAR; PG8_SCHED;
            PG8_LDB(B0, 1, 0); PG8_LDB(B1, 1, 1); PG8_SCHED; PG8_LDA(At, 1, 0); PG8_STAGE(PG8_SA(0, 1), a2 + hstep, voffA);
            PG8_WAIT_V(8); PG8_WAIT_L(0); PG8_BAR; PG8_MMA(0, 0, At, B0); PG8_MMA(0, 1, At, B1); PG8_BAR; PG8_SCHED;
            PG8_LDA(At, 1, 1); PG8_STAGE(PG8_SB(1, 0), b3, voffB); PG8_STAGE(PG8_SB(1, 1), b3 + hstep, voffB); PG8_STAGE(PG8_SA(1, 0), a3, voffA);
            PG8_WAIT_V(8); PG8_WAIT_L(0); PG8_BAR; PG8_MMA(1, 0, At, B0); PG8_MMA(1, 1, At, B1); PG8_BAR; PG8_SCHED;
            } else {
            PG8_LDB(B0, 0, 0); PG8_SCHED; PG8_LDA(At, 0, 0); PG8_STAGE(PG8_SA(1, 1), a1 + hstep, voffA);
            PG8_WAIT_L(8); PG8_BAR; PG8_WAIT_L(0); PG8_MMA(0, 0, At, B0); PG8_BAR; PG8_SCHED;
            PG8_LDB(B1, 0, 1); PG8_STAGE(PG8_SB(0, 0), b2, voffB);
            PG8_BAR; PG8_WAIT_L(0); PG8_MMA(0, 1, At, B1); PG8_BAR;
            PG8_LDA(At, 0, 1); PG8_STAGE(PG8_SA(0, 0), a2, voffA);
            PG8_BAR; PG8_WAIT_L(0); PG8_MMA(1, 0, At, B0); PG8_BAR; PG8_SCHED;
            PG8_STAGE(PG8_SB(0, 1), b2 + hstep, voffB);
            PG8_WAIT_V(6); PG8_BAR; PG8_MMA(1, 1, At, B1); PG8_BAR;
            PG8_LDB(B0, 1, 0); PG8_SCHED; PG8_LDA(At, 1, 0); PG8_STAGE(PG8_SA(0, 1), a2 + hstep, voffA);
            PG8_WAIT_L(8); PG8_BAR; PG8_WAIT_L(0); PG8_MMA(0, 0, At, B0); PG8_BAR; PG8_SCHED;
            PG8_LDB(B1, 1, 1); PG8_STAGE(PG8_SB(1, 0), b3, voffB);
            PG8_BAR; PG8_WAIT_L(0); PG8_MMA(0, 1, At, B1); PG8_BAR;
            PG8_LDA(At, 1, 1); PG8_STAGE(PG8_SA(1, 0), a3, voffA);
            PG8_BAR; PG8_WAIT_L(0); PG8_MMA(1, 0, At, B0); PG8_BAR; PG8_SCHED;
            PG8_STAGE(PG8_SB(1, 1), b3 + hstep, voffB);
            PG8_WAIT_V(6); PG8_BAR; PG8_MMA(1, 1, At, B1); PG8_BAR;
            }
        }
        if constexpr (ALIGN_EPI) { if (wr == 0) PG8_BAR; }
        if constexpr (!Epi::AFTER_DRAIN) { E(acc, cur, wr, wc, fr, fq); S.done(cur); }
        if (!has_next) break;
#pragma unroll
        for (int a = 0; a < 2; ++a)
#pragma unroll
            for (int b = 0; b < 2; ++b)
#pragma unroll
                for (int m = 0; m < 4; ++m)
#pragma unroll
                    for (int n = 0; n < 2; ++n) acc[a][b][m][n] = (f32x4){0.f, 0.f, 0.f, 0.f};
        cur = nxt; cA = nA; cB = nB; ++ui;
        if constexpr (ALIGN_EPI) { if (wr == 1) PG8_BAR; }
    }
    PG8_WAIT_V(0);
    if constexpr (!ALIGN_EPI) { if (wr == 0) PG8_BAR; }
    PG8_BAR;
    if constexpr (Epi::AFTER_DRAIN) { E.fused(acc, cur, wr, wc, fr, fq, lds, wid, lane); S.done(cur); }
#undef PG8_SA
#undef PG8_SB
#undef PG8_STAGE
#undef PG8_LDA
#undef PG8_LDB
#undef PG8_MMA
#undef PG8_WAIT_V
#undef PG8_WAIT_L
#undef PG8_BAR
#undef PG8_SCHED
}
}

constexpr int DM = 4096, NBATCH = 2, SEQ = 8192, DEPTH = 4, CTXL = 256;
constexpr int NLAT = NBATCH * SEQ, NCTX = NBATCH * CTXL, MROWS = NLAT + NCTX;
constexpr int NIN = 13568, GWD = 1024;
constexpr int C_POOLV = 0, C_POOLZ = 1024, C_NAQ = 2048, C_NAK = 3072, C_NAV = 4096, C_NAZ = 5120, C_RWR = 6144, C_RWK = 7168, C_RWV = 8192, C_RWZ = 9216,
              C_RWWD = 10240, C_RWAD = 10368, C_SGU = 10496, C_SGV = 11520, C_SGZ = 12544;
constexpr int SCANLEN = CTXL + SEQ;
constexpr int NCHAIN = 64;
constexpr int RECB = 896;
constexpr int RECF = RECB / 4;
constexpr int NWAVES = 8;

constexpr size_t MiB = 1u << 20;
constexpr size_t WS_CTL = 0, CTL_ZERO_BYTES = 1 * MiB;
constexpr size_t WS_MOD   = 2 * MiB;
constexpr size_t WS_TAB   = 3 * MiB;
constexpr size_t WS_SGST  = 4 * MiB;
constexpr size_t WS_BON   = 5 * MiB;
constexpr size_t WS_POOLWT= 8 * MiB;
constexpr size_t WS_WUPT  = 10 * MiB;
constexpr size_t WS_AUPT  = 11 * MiB;
constexpr size_t WS_SGW   = 12 * MiB;
constexpr size_t WS_VTC   = 13 * MiB;
constexpr size_t WS_HCTX  = 14 * MiB;
constexpr size_t WS_MODP  = 22 * MiB;
constexpr size_t WS_VTL   = 58 * MiB;
constexpr size_t WS_QN    = 90 * MiB;
constexpr size_t WS_KN    = 123 * MiB;
constexpr size_t WS_WOUTT = 156 * MiB;
constexpr size_t WS_WINT  = 284 * MiB;
constexpr size_t WS_XN    = 708 * MiB;
constexpr size_t WS_Y     = 840 * MiB;
constexpr size_t WS_P     = 972 * MiB;
constexpr size_t WS_YR    = 1410 * MiB;
constexpr size_t WS_REC   = 1542 * MiB;
constexpr size_t WS_END   = 2334 * MiB;
static_assert(WS_P + (size_t)MROWS * NIN * 2 <= WS_YR && WS_REC + (size_t)NCHAIN * SCANLEN * RECB <= WS_END && WS_WINT + (size_t)4 * NIN * DM * 2 <= WS_XN, "ws map");
constexpr int CW_TMO = 0, CW_BAR = 4096;

constexpr int RING_BYTES = 131072, LDSCTL_OFF = RING_BYTES, MISC_OFF = LDSCTL_OFF + 320, LDS_BYTES = 147456;

#define GAS __attribute__((address_space(1)))
#define LAS __attribute__((address_space(3)))
typedef unsigned short bf16;
typedef unsigned v4u __attribute__((ext_vector_type(4)));
typedef unsigned v2u __attribute__((ext_vector_type(2)));
typedef float f32x4 __attribute__((ext_vector_type(4)));
typedef float f32x2 __attribute__((ext_vector_type(2)));
typedef short bf16x8 __attribute__((ext_vector_type(8)));
typedef _Float16 h4 __attribute__((ext_vector_type(4)));
typedef _Float16 h8 __attribute__((ext_vector_type(8)));
#define RLX_AGENT __ATOMIC_RELAXED, __HIP_MEMORY_SCOPE_AGENT
#define LDS_WAIT() asm volatile("s_waitcnt lgkmcnt(0)" ::: "memory")

__device__ __forceinline__ float bf2f(unsigned short h) { return __uint_as_float(((unsigned)h) << 16); }
__device__ __forceinline__ float bflo(unsigned w) { return __uint_as_float(w << 16); }
__device__ __forceinline__ float bfhi(unsigned w) { return __uint_as_float(w & 0xffff0000u); }
typedef __bf16 bf16x2_t __attribute__((ext_vector_type(2)));
__device__ __forceinline__ unsigned pk2(float lo, float hi) { const f32x2 v = {lo, hi}; const bf16x2_t b = __builtin_convertvector(v, bf16x2_t); return __builtin_bit_cast(unsigned, b); }
__device__ __forceinline__ unsigned f2bf(float f) { return pk2(f, 0.f) & 0xffffu; }
__device__ __forceinline__ float rcp_f(float x) { return __builtin_amdgcn_rcpf(x); }
__device__ __forceinline__ float rsq_f(float x) { return __builtin_amdgcn_rsqf(x); }
__device__ __forceinline__ void unpack8(const v4u w, float* x) { x[0] = bflo(w.x); x[1] = bfhi(w.x); x[2] = bflo(w.y); x[3] = bfhi(w.y); x[4] = bflo(w.z); x[5] = bfhi(w.z); x[6] = bflo(w.w); x[7] = bfhi(w.w); }
__device__ __forceinline__ v4u pack8(const float* x) { v4u w; w.x = pk2(x[0], x[1]); w.y = pk2(x[2], x[3]); w.z = pk2(x[4], x[5]); w.w = pk2(x[6], x[7]); return w; }
__device__ __forceinline__ float silu_f(float x) { return x * rcp_f(1.f + __expf(-x)); }
__device__ __forceinline__ float wave_sum(float v) {
#pragma unroll
    for (int o = 1; o < 64; o <<= 1) v += __shfl_xor(v, o);
    return v;
}
template <int CTRL> __device__ __forceinline__ float dppf(float v) { return __builtin_bit_cast(float, __builtin_amdgcn_update_dpp(0, __builtin_bit_cast(int, v), CTRL, 0xF, 0xF, true)); }
__device__ __forceinline__ float red16(float v) { v += dppf<0xB1>(v); v += dppf<0x4E>(v); v += dppf<0x141>(v); v += dppf<0x140>(v); return v; }
__device__ __forceinline__ void red16x2(float& a, float& b) {
    a += dppf<0xB1>(a); b += dppf<0xB1>(b); a += dppf<0x4E>(a); b += dppf<0x4E>(b); a += dppf<0x141>(a); b += dppf<0x141>(b); a += dppf<0x140>(a); b += dppf<0x140>(b); }
__device__ __forceinline__ float max16x4(float v) { v = fmaxf(v, __shfl_xor(v, 16)); v = fmaxf(v, __shfl_xor(v, 32)); return v; }
__device__ __forceinline__ float sum16x4(float v) { v += __shfl_xor(v, 16); v += __shfl_xor(v, 32); return v; }
__device__ __forceinline__ int scan_pos(int d, bool isctx, int t) { return d == 0 ? (isctx ? t : CTXL + t) : (isctx ? (CTXL - 1 - t) : (CTXL + SEQ - 1 - t)); }
__device__ __forceinline__ f32x4 mfma16(bf16x8 a, bf16x8 b, f32x4 c) { return __builtin_amdgcn_mfma_f32_16x16x32_bf16(a, b, c, 0, 0, 0); }
__device__ __forceinline__ bf16x8 ld_frag(const bf16* p) { return __builtin_bit_cast(bf16x8, *(const v4u*)p); }

namespace pg8 {
struct EpiStoreBf16 {
    static constexpr bool PERM = true, AFTER_DRAIN = false;
    bf16_t* O; int ldc;
    __device__ __forceinline__ void operator()(const f32x4 (&acc)[2][2][4][2], const Unit& u, int wr, int wc, int fr, int fq) const {
        const int row0 = u.pm * BM + wr * 64 + fr, col0 = u.pn * BM + wc * 32 + 8 * fq;
#pragma unroll
        for (int ai = 0; ai < 2; ++ai)
#pragma unroll
            for (int m = 0; m < 4; ++m) { bf16_t* rowp = O + (size_t)(row0 + ai * HALF + m * 16) * ldc + col0;
#pragma unroll
                for (int bj = 0; bj < 2; ++bj) { const f32x4 v0 = acc[ai][bj][m][0], v1 = acc[ai][bj][m][1];
                    u32x4 w; w.x = cvt_pk_bf16(v0[0], v0[1]); w.y = cvt_pk_bf16(v0[2], v0[3]); w.z = cvt_pk_bf16(v1[0], v1[1]); w.w = cvt_pk_bf16(v1[2], v1[3]);
                    *(u32x4*)(rowp + bj * HALF) = w; } }
    }
};
struct EpiResGate {
    static constexpr bool PERM = false, AFTER_DRAIN = false;
    const float* hin_lat; const float* hin_ctx; float* hout_lat; float* hout_ctx; const float* gate;
    __device__ __forceinline__ void operator()(const f32x4 (&acc)[2][2][4][2], const Unit& u, int wr, int wc, int fr, int fq) const {
        const int cond = u.pm < 32 ? 0 : (u.pm < 64 ? 1 : 2);
        const int rloc = (u.pm < 64 ? u.pm * BM : (u.pm - 64) * BM) + wr * 64 + fr, col0 = u.pn * BM + wc * 32 + 4 * fq;
        const float* hin = u.pm < 64 ? hin_lat : hin_ctx; float* hout = u.pm < 64 ? hout_lat : hout_ctx;
        f32x4 gv[2][2];
#pragma unroll
        for (int bj = 0; bj < 2; ++bj)
#pragma unroll
            for (int n = 0; n < 2; ++n) gv[bj][n] = *(const f32x4*)(gate + cond * 12288 + 8192 + col0 + bj * HALF + n * 16);
#pragma unroll
        for (int ai = 0; ai < 2; ++ai)
#pragma unroll
            for (int m = 0; m < 4; ++m) { const size_t off = (size_t)(rloc + ai * HALF + m * 16) * 4096 + col0;
#pragma unroll
                for (int bj = 0; bj < 2; ++bj)
#pragma unroll
                    for (int n = 0; n < 2; ++n) { const f32x4 b = *(const f32x4*)(hin + off + bj * HALF + n * 16);
                        *(f32x4*)(hout + off + bj * HALF + n * 16) = b + gv[bj][n] * acc[ai][bj][m][n]; } }
    }
};
}

__device__ __forceinline__ void p0_transpose_item(const float* W, int K, int N, bf16* WT, LAS float* scr, int item, int lane) {
    const int nblk = N / 32, kb = item / nblk, nb = item % nblk, k0 = 64 * kb, n0 = 32 * nb;
#pragma unroll 8
    for (int i = 0; i < 32; ++i) { const int kk = 2 * i + (lane >> 5); scr[kk * 33 + (lane & 31)] = W[(size_t)(k0 + kk) * N + n0 + (lane & 31)]; }
    LDS_WAIT(); asm volatile("" ::: "memory");
    const int c = lane & 7;
#pragma unroll
    for (int j = 0; j < 4; ++j) { const int n = (lane >> 3) + 8 * j; const LAS float* s = scr + (8 * c) * 33 + n;
        v4u o; o.x = pk2(s[0 * 33], s[1 * 33]); o.y = pk2(s[2 * 33], s[3 * 33]); o.z = pk2(s[4 * 33], s[5 * 33]); o.w = pk2(s[6 * 33], s[7 * 33]);
        *(v4u*)(WT + (size_t)(n0 + n) * K + k0 + 8 * c) = o; }
    LDS_WAIT(); asm volatile("" ::: "memory");
}
__device__ __forceinline__ void p0_mod_item(const float* wmod, const float* cvec, const float* cctx, float* MODP, LAS float* scr, int item, int lane) {
    const int l = item / (64 * 48), r = item % (64 * 48), kc = r / 48, nc = r % 48, k0 = kc * 64, n0 = nc * 256 + lane * 4;
    scr[lane] = silu_f(cvec[k0 + lane]); scr[64 + lane] = silu_f(cvec[4096 + k0 + lane]); scr[128 + lane] = silu_f(cctx[k0 + lane]);
    LDS_WAIT(); asm volatile("" ::: "memory");
    f32x4 a0 = {0.f, 0.f, 0.f, 0.f}, a1 = a0, a2 = a0;
    const float* wp = wmod + ((size_t)l * 4096 + k0) * 12288 + n0;
#pragma unroll 16
    for (int k = 0; k < 64; ++k) { const f32x4 w = *(const f32x4*)(wp + (size_t)k * 12288); a0 += scr[k] * w; a1 += scr[64 + k] * w; a2 += scr[128 + k] * w; }
    float* o = MODP + ((size_t)(l * 64 + kc) * 3) * 12288 + n0;
    *(f32x4*)(o) = a0; *(f32x4*)(o + 12288) = a1; *(f32x4*)(o + 2 * 12288) = a2;
    LDS_WAIT(); asm volatile("" ::: "memory");
}
__device__ __forceinline__ void sincos_acc(float ang, float& c, float& s) {
    const double x = (double)ang; const double n = __builtin_rint(x * 0.63661977236758134308); const double r = x - n * 1.57079632679489661923;
    const double r2 = r * r;
    const double sp = r * (1.0 + r2 * (-1.0 / 6 + r2 * (1.0 / 120 + r2 * (-1.0 / 5040 + r2 * (1.0 / 362880 + r2 * (-1.0 / 39916800 + r2 * (1.0 / 6227020800.0)))))));
    const double cp = 1.0 + r2 * (-0.5 + r2 * (1.0 / 24 + r2 * (-1.0 / 720 + r2 * (1.0 / 40320 + r2 * (-1.0 / 3628800 + r2 * (1.0 / 479001600 + r2 * (-1.0 / 87178291200.0)))))));
    const int q = ((int)n) & 3;
    const double cc = (q == 0) ? cp : (q == 1) ? -sp : (q == 2) ? -cp : sp;
    const double ss = (q == 0) ? sp : (q == 1) ? cp : (q == 2) ? -sp : -cp;
    c = (float)cc; s = (float)ss;
}

__device__ __forceinline__ void phase_xn(const float* hlat, const float* hctx, const float* mod, bf16* XN, int gw, int NGW, int lane) {
    for (int m = gw; m < MROWS; m += NGW) {
        const float* src = m < NLAT ? hlat + (size_t)m * DM : hctx + (size_t)(m - NLAT) * DM;
        const int cond = m < NLAT ? (m >> 13) : 2;
        const f32x4* s4 = (const f32x4*)src + lane;
        f32x4 v[16]; float ss = 0.f;
#pragma unroll
        for (int j = 0; j < 16; ++j) { v[j] = s4[64 * j]; ss += (v[j].x * v[j].x + v[j].y * v[j].y) + (v[j].z * v[j].z + v[j].w * v[j].w); }
        ss = wave_sum(ss);
        const float rstd = rsq_f(ss * (1.f / 4096.f) + 1e-6f);
        const f32x4* sh4 = (const f32x4*)(mod + cond * 12288) + lane; const f32x4* sc4 = (const f32x4*)(mod + cond * 12288 + 4096) + lane;
        v2u* o = (v2u*)(XN + (size_t)m * DM) + lane;
#pragma unroll
        for (int j = 0; j < 16; ++j) { const f32x4 sh = sh4[64 * j], sc = sc4[64 * j]; const f32x4 x = v[j] * rstd * (sc + 1.f) + sh; v2u w; w.x = pk2(x.x, x.y); w.y = pk2(x.z, x.w); o[64 * j] = w; }
    }
}

__device__ __forceinline__ void phase_rowprep(const bf16* P, const float* qgain, const float* kgain, const f32x2* tab, bf16* QN, bf16* KN, f32x2* SGST, int gw, int NGW, int lane) {
    const int sub = lane & 3;
    for (int m = gw; m < MROWS; m += NGW) {
        const bf16* pr = P + (size_t)m * NIN;
        const bool isctx = m >= NLAT; const int t = isctx ? ((m - NLAT) & 255) : (m & 8191);
        {   float x[16]; unpack8(*(const v4u*)(pr + C_SGV + 16 * lane), x); unpack8(*(const v4u*)(pr + C_SGV + 16 * lane + 8), x + 8);
            float s = 0.f;
#pragma unroll
            for (int i = 0; i < 16; ++i) s += x[i];
            const float mean = wave_sum(s) * (1.f / 1024.f); float q = 0.f;
#pragma unroll
            for (int i = 0; i < 16; ++i) { const float dlt = x[i] - mean; q += dlt * dlt; }
            const float var = wave_sum(q) * (1.f / 1024.f);
            if (lane == 0) SGST[m] = (f32x2){mean, rsq_f(var + 1e-5f)}; }
        float q[16], k[16];
        unpack8(*(const v4u*)(pr + C_NAQ + 16 * lane), q); unpack8(*(const v4u*)(pr + C_NAQ + 16 * lane + 8), q + 8);
        unpack8(*(const v4u*)(pr + C_NAK + 16 * lane), k); unpack8(*(const v4u*)(pr + C_NAK + 16 * lane + 8), k + 8);
        float sq = 0.f, sk = 0.f;
#pragma unroll
        for (int i = 0; i < 16; ++i) { sq += q[i] * q[i]; sk += k[i] * k[i]; }
        sq += __shfl_xor(sq, 1); sq += __shfl_xor(sq, 2); sk += __shfl_xor(sk, 1); sk += __shfl_xor(sk, 2);
        const float rq = rsq_f(sq * (1.f / 64.f) + 1e-6f), rk = rsq_f(sk * (1.f / 64.f) + 1e-6f);
#pragma unroll
        for (int i = 0; i < 16; ++i) { q[i] *= rq * qgain[16 * sub + i]; k[i] *= rk * kgain[16 * sub + i]; }
        if (!isctx) {
            const int pos = sub < 2 ? (t >> 6) : (t & 63);
#pragma unroll
            for (int i = 0; i < 16; ++i) { const f32x2 cs = tab[pos * 16 + i]; const float pq = __shfl_xor(q[i], 1), pkk = __shfl_xor(k[i], 1);
                q[i] = (sub & 1) ? (q[i] * cs.x + pq * cs.y) : (q[i] * cs.x - pq * cs.y);
                k[i] = (sub & 1) ? (k[i] * cs.x + pkk * cs.y) : (k[i] * cs.x - pkk * cs.y); }
        }
#pragma unroll
        for (int i = 0; i < 16; ++i) q[i] *= 0.125f;
        *(v4u*)(QN + (size_t)m * GWD + 16 * lane) = pack8(q); *(v4u*)(QN + (size_t)m * GWD + 16 * lane + 8) = pack8(q + 8);
        *(v4u*)(KN + (size_t)m * GWD + 16 * lane) = pack8(k); *(v4u*)(KN + (size_t)m * GWD + 16 * lane + 8) = pack8(k + 8);
    }
}
__device__ __forceinline__ void phase_vt(const bf16* P, bf16* VTL, bf16* VTC, int gw, int NGW, int lane) {
    for (int u = gw; u < (MROWS / 64) * 16; u += NGW) {
        const int tt = u >> 4, h = u & 15, m0 = tt * 64;
        const bf16* src = P + (size_t)m0 * NIN + C_NAV + h * 64 + lane;
        unsigned w[32];
#pragma unroll
        for (int i = 0; i < 32; ++i) { const unsigned lo = src[(size_t)(2 * i) * NIN], hi = src[(size_t)(2 * i + 1) * NIN]; w[i] = lo | (hi << 16); }
        bf16* dst = tt < 256 ? VTL + (((size_t)((tt >> 7) * 16 + h) * 64 + lane) * 8192 + (tt & 127) * 64)
                             : VTC + (((size_t)(((tt - 256) >> 2) * 16 + h) * 64 + lane) * 256 + ((tt - 256) & 3) * 64);
#pragma unroll
        for (int j = 0; j < 8; ++j) { v4u o; o.x = w[4 * j]; o.y = w[4 * j + 1]; o.z = w[4 * j + 2]; o.w = w[4 * j + 3]; ((v4u*)dst)[j] = o; }
    }
}
template <int G>
__device__ __forceinline__ void pool_unit(const bf16* P, const bf16* wbase, const float* pscale, bf16* Y, int m0, int lane) {
    constexpr int WIN = 2 << G;
    const int r = lane & 15, q4 = lane >> 4, m = m0 + r;
    const bool isctx = m0 >= NLAT; const int T = isctx ? CTXL : SEQ; const int t = isctx ? ((m - NLAT) & 255) : (m & 8191);
    const int tlo = t - (WIN >> 1);
    const int lo = tlo < 0 ? 0 : tlo, hi = (tlo + WIN) > T ? T : (tlo + WIN);
    const float inv = rcp_f((float)(hi - lo));
    f32x4 acc[16];
#pragma unroll
    for (int nt = 0; nt < 16; ++nt) acc[nt] = (f32x4){0.f, 0.f, 0.f, 0.f};
#pragma unroll 1
    for (int ks = 0; ks < 8; ++ks) {
        const int ch0 = C_POOLV + G * 256 + 32 * ks + 8 * q4;
        constexpr int WB = WIN < 8 ? WIN : 8;
        bf16x8 bfr[8];
        float sum[8];
#pragma unroll
        for (int j = 0; j < 8; ++j) sum[j] = 0.f;
        const v4u selfw = *(const v4u*)(P + (size_t)m * NIN + ch0);
#pragma unroll
        for (int nt = 0; nt < 8; ++nt) bfr[nt] = ld_frag(wbase + (size_t)(16 * nt + r) * 256 + 32 * ks + 8 * q4);
#pragma unroll
        for (int k0 = 0; k0 < WIN; k0 += WB) {
            v4u wl[WB];
#pragma unroll
            for (int k = 0; k < WB; ++k) { const int tk = tlo + k0 + k; const bool ok = tk >= 0 && tk < T; wl[k] = *(const v4u*)(P + (size_t)(ok ? (m - t + tk) : m) * NIN + ch0); }
            __builtin_amdgcn_sched_barrier(0);
#pragma unroll
            for (int k = 0; k < WB; ++k) { const int tk = tlo + k0 + k; const bool ok = tk >= 0 && tk < T; float x[8]; unpack8(wl[k], x);
#pragma unroll
                for (int j = 0; j < 8; ++j) sum[j] += ok ? x[j] : 0.f; }
            __builtin_amdgcn_sched_barrier(0);
        }
        float self[8]; unpack8(selfw, self);
        float dv[8];
#pragma unroll
        for (int j = 0; j < 8; ++j) dv[j] = sum[j] * inv - self[j];
        const bf16x8 af = __builtin_bit_cast(bf16x8, pack8(dv));
        __builtin_amdgcn_sched_barrier(0);
        bf16x8 bfr2[8];
#pragma unroll
        for (int nt = 0; nt < 8; ++nt) bfr2[nt] = ld_frag(wbase + (size_t)(16 * (nt + 8) + r) * 256 + 32 * ks + 8 * q4);
        __builtin_amdgcn_sched_barrier(0);
#pragma unroll
        for (int nt = 0; nt < 8; ++nt) acc[nt] = mfma16(af, bfr[nt], acc[nt]);
        __builtin_amdgcn_sched_barrier(0);
#pragma unroll
        for (int nt = 0; nt < 8; ++nt) acc[nt + 8] = mfma16(af, bfr2[nt], acc[nt + 8]);
        __builtin_amdgcn_sched_barrier(0);
    }
#pragma unroll
    for (int nh = 0; nh < 4; ++nh) {
        unsigned short zz[4][4]; float ps[4];
#pragma unroll
        for (int nq = 0; nq < 4; ++nq) { const int oc = G * 256 + 16 * (4 * nh + nq) + r; ps[nq] = pscale[oc];
#pragma unroll
            for (int i = 0; i < 4; ++i) zz[nq][i] = P[(size_t)(m0 + 4 * q4 + i) * NIN + C_POOLZ + oc]; }
        __builtin_amdgcn_sched_barrier(0);
#pragma unroll
        for (int nq = 0; nq < 4; ++nq) { const int oc = G * 256 + 16 * (4 * nh + nq) + r;
#pragma unroll
            for (int i = 0; i < 4; ++i) Y[(size_t)(m0 + 4 * q4 + i) * DM + oc] = (bf16)f2bf(acc[4 * nh + nq][i] * ps[nq] * silu_f(bf2f(zz[nq][i]))); }
        __builtin_amdgcn_sched_barrier(0);
    }
}
__device__ __forceinline__ void phase_pool(const bf16* P, const bf16* PWT  , const float* pscale, bf16* Y, int nrows, int gw, int NGW, int lane) {
    for (int u = gw; u < (nrows / 16) * 4; u += NGW) {
        const int tt = u >> 2, g = u & 3, m0 = tt * 16;
        const bf16* wbase = PWT + (size_t)g * 65536;
        if (g == 0) pool_unit<0>(P, wbase, pscale, Y, m0, lane);
        else if (g == 1) pool_unit<1>(P, wbase, pscale, Y, m0, lane);
        else if (g == 2) pool_unit<2>(P, wbase, pscale, Y, m0, lane);
        else pool_unit<3>(P, wbase, pscale, Y, m0, lane);
    }
}
#if defined(PROBE_REC2)
#define REC_ST(p, v) do { __builtin_nontemporal_store((v), (p)); __builtin_nontemporal_store((v), (f32x4*)((char*)(p) + (size_t)792 * 1048576)); } while (0)
#elif defined(REC_NT)
#define REC_ST(p, v) __builtin_nontemporal_store((v), (p))
#else
#define REC_ST(p, v) (*(p) = (v))
#endif
__device__ __forceinline__ void phase_rwprep(const bf16* P, const float* mu_rkv  , const float* mu_lora  , const float* w0  , const bf16* WUPT  ,
                                             const float* a0, const bf16* AUPT, const float* k_k, const float* k_a, const float* r_k, float* REC, float* BON, LAS unsigned char* lds,
                                             unsigned* queue  , int cls, int wave, int lane) {
    const int n = lane & 15, q4 = lane >> 4;
    const int d = cls >> 3, hp = cls & 7;
    unsigned* qh = queue + 64 * cls;
    LAS float* prm = (LAS float*)(lds + wave * 4096);
#pragma unroll
    for (int it = 0; it < 16; ++it) { const int hh = it >> 3, p = it & 7, ch = (hp * 2 + hh) * 64 + lane;
        const float* src = p == 0 ? w0 + d * 1024 : p == 1 ? a0 + d * 1024 : p == 2 ? mu_rkv + (d * 3 + 0) * 1024 : p == 3 ? mu_rkv + (d * 3 + 1) * 1024 : p == 4 ? mu_rkv + (d * 3 + 2) * 1024 : p == 5 ? k_k : p == 6 ? k_a : r_k;
        prm[it * 64 + lane] = src[ch]; }
    LDS_WAIT(); asm volatile("" ::: "memory");
    unsigned pend = 0u;
    if (lane == 0) pend = __hip_atomic_fetch_add(qh, 1u, __ATOMIC_RELAXED, __HIP_MEMORY_SCOPE_AGENT);
    for (;;) {
        const int tt = __builtin_amdgcn_readfirstlane((int)pend);
        if (tt >= MROWS / 16) break;
        if (lane == 0) pend = __hip_atomic_fetch_add(qh, 1u, __ATOMIC_RELAXED, __HIP_MEMORY_SCOPE_AGENT);
        const int m0 = tt * 16;
        const bool isctx = m0 >= NLAT; const int T = isctx ? CTXL : SEQ; const int t0 = isctx ? ((m0 - NLAT) & 255) : (m0 & 8191); const int b = isctx ? ((m0 - NLAT) >> 8) : (m0 >> 13);
        const int m = m0 + n, t = t0 + n; const bool hasnb = d == 0 ? (t > 0) : (t < T - 1); const int nbr = hasnb ? (d == 0 ? m - 1 : m + 1) : m;
        const bf16* prow = P + (size_t)m * NIN; const bf16* nrow = P + (size_t)nbr * NIN;
        bf16x8 Bw[2], Ba[2];
        {   v4u cw[2], nw[2], ca[2], na[2]; f32x4 mw[2][2], ma[2][2];
#pragma unroll
            for (int ks = 0; ks < 2; ++ks) { const int j0 = 32 * ks + 8 * q4;
                cw[ks] = *(const v4u*)(prow + C_RWWD + d * 64 + j0); nw[ks] = *(const v4u*)(nrow + C_RWWD + d * 64 + j0);
                ca[ks] = *(const v4u*)(prow + C_RWAD + d * 64 + j0); na[ks] = *(const v4u*)(nrow + C_RWAD + d * 64 + j0);
                mw[ks][0] = *(const f32x4*)(mu_lora + (d * 2 + 0) * 64 + j0); mw[ks][1] = *(const f32x4*)(mu_lora + (d * 2 + 0) * 64 + j0 + 4);
                ma[ks][0] = *(const f32x4*)(mu_lora + (d * 2 + 1) * 64 + j0); ma[ks][1] = *(const f32x4*)(mu_lora + (d * 2 + 1) * 64 + j0 + 4); }
            __builtin_amdgcn_sched_barrier(0);
#pragma unroll
            for (int ks = 0; ks < 2; ++ks) {
                float cur[8], nb[8], o[8];
                unpack8(cw[ks], cur); unpack8(nw[ks], nb);
#pragma unroll
                for (int j = 0; j < 8; ++j) { const float xx = cur[j] + ((hasnb ? nb[j] : 0.f) - cur[j]) * mw[ks][j >> 2][j & 3]; o[j] = 1.0f - 2.0f * rcp_f(1.0f + __expf(2.0f * xx)); }
                Bw[ks] = __builtin_bit_cast(bf16x8, pack8(o));
                unpack8(ca[ks], cur); unpack8(na[ks], nb);
#pragma unroll
                for (int j = 0; j < 8; ++j) o[j] = cur[j] + ((hasnb ? nb[j] : 0.f) - cur[j]) * ma[ks][j >> 2][j & 3];
                Ba[ks] = __builtin_bit_cast(bf16x8, pack8(o)); }
        }
        const int pos = scan_pos(d, isctx, t);
#pragma unroll 1
        for (int hh = 0; hh < 2; ++hh) {
            const int head = hp * 2 + hh, chain = (b * 2 + d) * 16 + head;
            char* recb = (char*)REC + ((size_t)chain * SCANLEN + pos) * RECB;
            const LAS float* pr = prm + hh * 512;
            float KK[16], AV[16]; float ss = 0.f, bon = 0.f;
#pragma unroll
            for (int hf = 0; hf < 2; ++hf) {
                const int cl = 32 * hf + 8 * q4, cg = head * 64 + cl;
                bf16x8 wf[2][2], af[2][2];
#pragma unroll
                for (int tq = 0; tq < 2; ++tq) { const size_t wrow = (size_t)(d * 1024 + head * 64 + 32 * hf + 8 * (n >> 2) + 4 * tq + (n & 3)) * 64 + 8 * q4;
                    wf[tq][0] = ld_frag(WUPT + wrow); wf[tq][1] = ld_frag(WUPT + wrow + 32); af[tq][0] = ld_frag(AUPT + wrow); af[tq][1] = ld_frag(AUPT + wrow + 32); }
                const v4u rcw = *(const v4u*)(prow + C_RWR + cg), kcw = *(const v4u*)(prow + C_RWK + cg), vcw = *(const v4u*)(prow + C_RWV + cg);
                const v4u rnw = *(const v4u*)(nrow + C_RWR + cg), knw = *(const v4u*)(nrow + C_RWK + cg), vnw = *(const v4u*)(nrow + C_RWV + cg);
                __builtin_amdgcn_sched_barrier(0);
                f32x4 accW[2], accA[2];
#pragma unroll
                for (int tq = 0; tq < 2; ++tq) { f32x4 z = {0.f, 0.f, 0.f, 0.f}; z = mfma16(wf[tq][0], Bw[0], z); accW[tq] = mfma16(wf[tq][1], Bw[1], z);
                                                 f32x4 y = {0.f, 0.f, 0.f, 0.f}; y = mfma16(af[tq][0], Ba[0], y); accA[tq] = mfma16(af[tq][1], Ba[1], y); }
                float rc[8], kc[8], vc[8], rn[8], kn[8], vn[8];
                unpack8(rcw, rc); unpack8(kcw, kc); unpack8(vcw, vc); unpack8(rnw, rn); unpack8(knw, kn); unpack8(vnw, vn);
                float dec[8], kp[8], rr[8], vv[8];
#pragma unroll
                for (int g = 0; g < 2; ++g) {
                    const f32x4 w0v = *(const LAS f32x4*)(pr + 0 * 64 + cl + 4 * g), a0v = *(const LAS f32x4*)(pr + 1 * 64 + cl + 4 * g), mur = *(const LAS f32x4*)(pr + 2 * 64 + cl + 4 * g),
                                muk = *(const LAS f32x4*)(pr + 3 * 64 + cl + 4 * g), muv = *(const LAS f32x4*)(pr + 4 * 64 + cl + 4 * g), kkv = *(const LAS f32x4*)(pr + 5 * 64 + cl + 4 * g),
                                kav = *(const LAS f32x4*)(pr + 6 * 64 + cl + 4 * g), rkv = *(const LAS f32x4*)(pr + 7 * 64 + cl + 4 * g);
#pragma unroll
                    for (int i = 0; i < 4; ++i) { const int j = 4 * g + i;
                        const float rnb = hasnb ? rn[j] : 0.f, knb = hasnb ? kn[j] : 0.f, vnb = hasnb ? vn[j] : 0.f;
                        const float r_ = rc[j] + (rnb - rc[j]) * mur[i], k0 = kc[j] + (knb - kc[j]) * muk[i], v_ = vc[j] + (vnb - vc[j]) * muv[i];
                        const float xw = -(w0v[i] + accW[g][i]);
                        const float sp = fmaxf(xw, 0.f) + __logf(1.0f + __expf(-fabsf(xw)));
                        dec[j] = __expf(-__expf(-sp - 0.5f));
                        const float av = rcp_f(1.0f + __expf(-(a0v[i] + accA[g][i])));
                        const float kx = k0 * kkv[i]; ss += kx * kx;
                        const float kp_ = k0 * (1.f + (av - 1.f) * kav[i]); bon += r_ * kp_ * rkv[i];
                        KK[8 * hf + j] = kx; AV[8 * hf + j] = av; kp[j] = kp_; rr[j] = r_; vv[j] = v_; }
                }
                char* ob = recb + cl * 2;
                REC_ST((f32x4*)(recb + cl * 4), ((f32x4){dec[0], dec[1], dec[2], dec[3]})); REC_ST((f32x4*)(recb + cl * 4 + 16), ((f32x4){dec[4], dec[5], dec[6], dec[7]}));
                REC_ST((h8*)(ob + 512), ((h8){(_Float16)kp[0], (_Float16)kp[1], (_Float16)kp[2], (_Float16)kp[3], (_Float16)kp[4], (_Float16)kp[5], (_Float16)kp[6], (_Float16)kp[7]}));
                REC_ST((h8*)(ob + 640), ((h8){(_Float16)rr[0], (_Float16)rr[1], (_Float16)rr[2], (_Float16)rr[3], (_Float16)rr[4], (_Float16)rr[5], (_Float16)rr[6], (_Float16)rr[7]}));
                REC_ST((h8*)(ob + 768), ((h8){(_Float16)vv[0], (_Float16)vv[1], (_Float16)vv[2], (_Float16)vv[3], (_Float16)vv[4], (_Float16)vv[5], (_Float16)vv[6], (_Float16)vv[7]}));
                __builtin_amdgcn_sched_barrier(0);
            }
            ss = sum16x4(ss); bon = sum16x4(bon);
            const float inv = rsq_f(fmaxf(ss, 1e-12f));
#pragma unroll
            for (int hf = 0; hf < 2; ++hf) { char* ob = recb + (32 * hf + 8 * q4) * 2; float kkn[8], nka[8];
#pragma unroll
                for (int j = 0; j < 8; ++j) { kkn[j] = KK[8 * hf + j] * inv; nka[j] = -(kkn[j] * AV[8 * hf + j]); }
                REC_ST((h8*)(ob + 256), ((h8){(_Float16)kkn[0], (_Float16)kkn[1], (_Float16)kkn[2], (_Float16)kkn[3], (_Float16)kkn[4], (_Float16)kkn[5], (_Float16)kkn[6], (_Float16)kkn[7]}));
                REC_ST((h8*)(ob + 384), ((h8){(_Float16)nka[0], (_Float16)nka[1], (_Float16)nka[2], (_Float16)nka[3], (_Float16)nka[4], (_Float16)nka[5], (_Float16)nka[6], (_Float16)nka[7]})); }
            if (q4 == 0) BON[(size_t)chain * SCANLEN + pos] = bon;
        }
    }
}
template <bool CTXQ>
__device__ __forceinline__ void na_unit(const bf16* QN, const bf16* KN, const bf16* VTL, const bf16* VTC, const bf16* P, const float* rpb  , bf16* Y, int u, int lane) {
    const int n = lane & 15, q4 = lane >> 4;
    int b, h, qrow0, qr = 0, jt = 0;
    if (CTXQ) { b = u >> 8; h = (u >> 4) & 15; qrow0 = NLAT + b * CTXL + 16 * (u & 15); }
    else { jt = u & 3; h = (u >> 2) & 15; qr = (u >> 6) & 127; b = u >> 13; qrow0 = b * SEQ + qr * 64 + 16 * jt; }
    constexpr int NT = CTXQ ? 16 : 32, WT = CTXQ ? 0 : 16;
    f32x4 s[NT];
    const int rs = qr - 4 < 0 ? 0 : (qr - 4 > 120 ? 120 : qr - 4);
    const int span0 = jt == 0 ? 0 : (jt == 1 ? 8 : (jt == 2 ? 24 : 32));
    const int qc = 16 * jt + n; const int cs = qc - 8 < 0 ? 0 : (qc - 8 > 48 ? 48 : qc - 8);
    bf16x8 qf[2];
#pragma unroll
    for (int ks = 0; ks < 2; ++ks) qf[ks] = ld_frag(QN + (size_t)(qrow0 + n) * GWD + h * 64 + 32 * ks + 8 * q4);
    if (!CTXQ) {
        const float* rp = rpb + (size_t)h * 15 * 31;
#pragma unroll
        for (int wt = 0; wt < 16; ++wt) { const int kri = wt >> 1, half = wt & 1, relr = rs + kri - qr + 7;
#pragma unroll
            for (int i = 0; i < 4; ++i) { const int relc = span0 + 8 * q4 + 4 * half + i - qc + 15; const int relcc = relc < 0 ? 0 : (relc > 30 ? 30 : relc); s[wt][i] = rp[relr * 31 + relcc]; } }
        __builtin_amdgcn_sched_barrier(0);
#pragma unroll
        for (int bt = 0; bt < 2; ++bt) {
            bf16x8 kf[16];
#pragma unroll
            for (int t = 0; t < 8; ++t) { const int wt = bt * 8 + t, kri = wt >> 1, half = wt & 1;
                const bf16* kp = KN + (size_t)(b * SEQ + (rs + kri) * 64 + span0 + 8 * (n >> 2) + 4 * half + (n & 3)) * GWD + h * 64 + 8 * q4; kf[2 * t] = ld_frag(kp); kf[2 * t + 1] = ld_frag(kp + 32); }
            __builtin_amdgcn_sched_barrier(0);
#pragma unroll
            for (int t = 0; t < 8; ++t) { const int wt = bt * 8 + t, half = wt & 1;
                f32x4 a = s[wt];
#pragma unroll
                for (int i = 0; i < 4; ++i) { const int kc = span0 + 8 * q4 + 4 * half + i; const bool ok = kc >= cs && kc < cs + 16; a[i] = ok ? a[i] : -INFINITY; }
                a = mfma16(kf[2 * t], qf[0], a); a = mfma16(kf[2 * t + 1], qf[1], a); s[wt] = a; }
            __builtin_amdgcn_sched_barrier(0);
        }
    }
#pragma unroll
    for (int bt = 0; bt < 2; ++bt) {
        bf16x8 kf[16];
#pragma unroll
        for (int t = 0; t < 8; ++t) { const int ctile = bt * 8 + t; const bf16* kp = KN + (size_t)(NLAT + b * CTXL + 32 * (ctile >> 1) + 8 * (n >> 2) + 4 * (ctile & 1) + (n & 3)) * GWD + h * 64 + 8 * q4; kf[2 * t] = ld_frag(kp); kf[2 * t + 1] = ld_frag(kp + 32); }
        __builtin_amdgcn_sched_barrier(0);
#pragma unroll
        for (int t = 0; t < 8; ++t) { f32x4 a = {0.f, 0.f, 0.f, 0.f}; a = mfma16(kf[2 * t], qf[0], a); a = mfma16(kf[2 * t + 1], qf[1], a); s[WT + bt * 8 + t] = a; }
        __builtin_amdgcn_sched_barrier(0);
    }
    float mx = -INFINITY;
#pragma unroll
    for (int t = 0; t < NT; ++t) mx = fmaxf(fmaxf(fmaxf(s[t][0], s[t][1]), fmaxf(s[t][2], s[t][3])), mx);
    mx = max16x4(mx);
    float sum = 0.f;
#pragma unroll
    for (int t = 0; t < NT; ++t) {
#pragma unroll
        for (int i = 0; i < 4; ++i) { const float e = __expf(s[t][i] - mx); s[t][i] = e; sum += e; } }
    sum = sum16x4(sum);
    const float inv = rcp_f(sum);
    f32x4 o[4];
#pragma unroll
    for (int nt = 0; nt < 4; ++nt) o[nt] = (f32x4){0.f, 0.f, 0.f, 0.f};
#pragma unroll
    for (int tb = 0; tb < NT / 8; ++tb) {
        v4u vv[4][4];
#pragma unroll
        for (int tq = 0; tq < 4; ++tq) { const int tp = tb * 4 + tq;
            const bf16* vb; size_t dstride;
            if (!CTXQ && tp < 8) { vb = VTL + ((size_t)(b * 16 + h) * 64 + n) * 8192 + (rs + tp) * 64 + span0 + 8 * q4; dstride = (size_t)16 * 8192; }
            else { const int cp = tp - (CTXQ ? 0 : 8); vb = VTC + ((size_t)(b * 16 + h) * 64 + n) * 256 + 32 * cp + 8 * q4; dstride = (size_t)16 * 256; }
#pragma unroll
            for (int nt = 0; nt < 4; ++nt) vv[tq][nt] = *(const v4u*)(vb + nt * dstride); }
        __builtin_amdgcn_sched_barrier(0);
#pragma unroll
        for (int tq = 0; tq < 4; ++tq) { const int tp = tb * 4 + tq;
            const f32x4 p0 = s[2 * tp] * inv, p1 = s[2 * tp + 1] * inv;
            v4u aw; aw.x = pk2(p0[0], p0[1]); aw.y = pk2(p0[2], p0[3]); aw.z = pk2(p1[0], p1[1]); aw.w = pk2(p1[2], p1[3]);
            const bf16x8 af = __builtin_bit_cast(bf16x8, aw);
#pragma unroll
            for (int nt = 0; nt < 4; ++nt) o[nt] = mfma16(af, __builtin_bit_cast(bf16x8, vv[tq][nt]), o[nt]); }
        __builtin_amdgcn_sched_barrier(0);
    }
    unsigned short zz[4][4];
#pragma unroll
    for (int nt = 0; nt < 4; ++nt)
#pragma unroll
        for (int i = 0; i < 4; ++i) zz[nt][i] = P[(size_t)(qrow0 + 4 * q4 + i) * NIN + C_NAZ + h * 64 + 16 * nt + n];
    __builtin_amdgcn_sched_barrier(0);
#pragma unroll
    for (int nt = 0; nt < 4; ++nt)
#pragma unroll
        for (int i = 0; i < 4; ++i) { const int row = qrow0 + 4 * q4 + i, col = h * 64 + 16 * nt + n;
            Y[(size_t)row * DM + 1024 + col] = (bf16)f2bf(o[nt][i] * silu_f(bf2f(zz[nt][i]))); }
}
__device__ __forceinline__ void phase_sgu(const bf16* P, const f32x2* SGST, const float* lnw, const float* lnb, const bf16* SGW  , const float* sgb  , bf16* Y,
                                          LAS unsigned char* lds, int nchunks, int tid, int wave, int lane) {
    const int n = lane & 15, q4 = lane >> 4;
    LAS bf16* T = (LAS bf16*)lds;
    for (int u = blockIdx.x; u < nchunks * 8; u += 256) {
        const int ck = u >> 3, g = u & 7, m0 = ck * 128;
#pragma unroll
        for (int it = 0; it < 4; ++it) { const int idx = tid + 512 * it, q = idx >> 4, c8 = idx & 15;
            float x[8]; unpack8(*(const v4u*)(P + (size_t)(m0 + q) * NIN + C_SGV + g * 128 + 8 * c8), x);
            const f32x2 st = SGST[m0 + q];
#pragma unroll
            for (int j = 0; j < 8; ++j) { const int c = 8 * c8 + j; const float v = (x[j] - st.x) * st.y * lnw[g * 128 + c] + lnb[g * 128 + c]; T[c * 136 + q] = (bf16)f2bf(v); } }
        __syncthreads();
        bf16x8 af[4];
#pragma unroll
        for (int ks = 0; ks < 4; ++ks) af[ks] = ld_frag(SGW + ((size_t)g * 128 + 16 * wave + n) * 128 + 32 * ks + 8 * q4);
#pragma unroll
        for (int nt = 0; nt < 8; ++nt) {
            f32x4 acc = {0.f, 0.f, 0.f, 0.f};
#pragma unroll
            for (int ks = 0; ks < 4; ++ks) { const bf16x8 bfg = *(const LAS bf16x8*)(T + (16 * nt + n) * 136 + 32 * ks + 8 * q4); acc = mfma16(af[ks], bfg, acc); }
#pragma unroll
            for (int i = 0; i < 4; ++i) { const int p = 16 * wave + 4 * q4 + i, row = m0 + p, col = g * 128 + 16 * nt + n;
                const float mixed = acc[i] + sgb[g * 128 + p]; const bf16* pr = P + (size_t)row * NIN;
                const float uu = bf2f(pr[C_SGU + col]), z = bf2f(pr[C_SGZ + col]);
                Y[(size_t)row * DM + 3072 + col] = (bf16)f2bf(uu * mixed * silu_f(z)); }
        }
        __syncthreads();
    }
}
__device__ __forceinline__ void scan_self(const float* REC, float* YR, LAS unsigned char* lds, LAS unsigned* bcnt, int su, int wave, int lane) {
    constexpr int CS = 32, NCH = SCANLEN / CS, SLOT = CS * RECB, NPW = SLOT / 1024 / 4;
    const int chain = (su & 7) * 8 + ((su >> 3) >> 2), part = (su >> 3) & 3;
    const char* recb = (const char*)REC + (size_t)chain * SCANLEN * RECB;
    const int wl = wave;
#define SCAN_ISSUE(cc, sl) do { _Pragma("unroll") for (int p_ = 0; p_ < NPW; ++p_) \
    __builtin_amdgcn_global_load_lds((const unsigned*)(recb + (size_t)(cc) * SLOT + (wl * NPW + p_) * 1024 + lane * 16), (LAS unsigned*)(lds + (sl) * SLOT + (wl * NPW + p_) * 1024), 16, 0, 0); } while (0)
    SCAN_ISSUE(0, 0); SCAN_ISSUE(1, 1); SCAN_ISSUE(2, 2);
    const int c16 = lane & 15, rg = lane >> 4, row = 16 * part + 4 * wave + rg;
    float S0 = 0.f, S1 = 0.f, S2 = 0.f, S3 = 0.f;
    float* yout = YR + (size_t)chain * SCANLEN * 64 + row;
    const int lo_w = c16 * 16, lo_h = 256 + c16 * 8, lo_v = 768 + row * 2;
#define SCAN_LD(dst, sl, s_) do { const LAS unsigned char* rec_ = (sl) + (s_) * RECB; dst##w = *(const LAS f32x4*)(rec_ + lo_w); dst##kk = *(const LAS h4*)(rec_ + lo_h); \
    dst##na = *(const LAS h4*)(rec_ + 128 + lo_h); dst##k = *(const LAS h4*)(rec_ + 256 + lo_h); dst##r = *(const LAS h4*)(rec_ + 384 + lo_h); dst##v = *(const LAS _Float16*)(rec_ + lo_v); } while (0)
#define FMX(a, b, c) __builtin_fmaf((a), (float)(b), (c))
    for (int c = 0; c < NCH; ++c) {
        asm volatile("s_waitcnt vmcnt(14)" ::: "memory");
        {   const unsigned baddr = (unsigned)(size_t)bcnt, one = 1u;
            if (lane == 0) asm volatile("ds_add_u32 %0, %1" :: "v"(baddr), "v"(one) : "memory");
            const unsigned want = 4u * (unsigned)(c + 1); unsigned sp = 0, got;
            for (;;) { asm volatile("ds_read_b32 %0, %1\n\ts_waitcnt lgkmcnt(0)" : "=v"(got) : "v"(baddr) : "memory");
                if (__builtin_amdgcn_readfirstlane((int)got) >= (int)want) break; __builtin_amdgcn_s_sleep(1); if (++sp > (1u << 22)) break; } }
        asm volatile("" ::: "memory");
        {   const int cc = c + 3 < NCH ? c + 3 : NCH - 1; SCAN_ISSUE(cc, (c + 3) & 3); }
        const LAS unsigned char* slot = lds + (c & 3) * SLOT;
        float ysv0 = 0.f, ysv1 = 0.f, ypend = 0.f;
        f32x4 Aw; h4 Akk, Ana, Ak, Ar; _Float16 Av;
        SCAN_LD(A, slot, 0);
#pragma unroll
        for (int s = 0; s < CS; ++s) {
            f32x4 Bw; h4 Bkk, Bna, Bk, Br; _Float16 Bv;
            if (s < CS - 1) SCAN_LD(B, slot, s + 1);
            __builtin_amdgcn_sched_barrier(0);
            float p0 = FMX(S0, Akk.x, 0.f), p1 = FMX(S2, Akk.z, 0.f); p0 = FMX(S1, Akk.y, p0); p1 = FMX(S3, Akk.w, p1);
            float dt = p0 + p1, yr = ypend; red16x2(dt, yr);
            const float u0 = __builtin_fmaf(S0, Aw.x, FMX((float)Av, Ak.x, 0.f)), u1 = __builtin_fmaf(S1, Aw.y, FMX((float)Av, Ak.y, 0.f)),
                        u2 = __builtin_fmaf(S2, Aw.z, FMX((float)Av, Ak.z, 0.f)), u3 = __builtin_fmaf(S3, Aw.w, FMX((float)Av, Ak.w, 0.f));
            S0 = FMX(dt, Ana.x, u0); S1 = FMX(dt, Ana.y, u1); S2 = FMX(dt, Ana.z, u2); S3 = FMX(dt, Ana.w, u3);
            if (s > 0) { if (s <= 16) ysv0 = (c16 == s - 1) ? yr : ysv0; else ysv1 = (c16 == s - 17) ? yr : ysv1; }
            float q0 = FMX(S0, Ar.x, 0.f), q1 = FMX(S2, Ar.z, 0.f); q0 = FMX(S1, Ar.y, q0); q1 = FMX(S3, Ar.w, q1);
            ypend = q0 + q1;
            __builtin_amdgcn_sched_barrier(0);
            if (s < CS - 1) { Aw = Bw; Akk = Bkk; Ana = Bna; Ak = Bk; Ar = Br; Av = Bv; }
        }
        { const float y = red16(ypend); ysv1 = (c16 == 15) ? y : ysv1; }
        asm volatile("" ::: "memory");
        yout[(size_t)(c * CS + c16) * 64] = ysv0; yout[(size_t)(c * CS + 16 + c16) * 64] = ysv1;
    }
    asm volatile("s_waitcnt vmcnt(0)" ::: "memory");
#undef FMX
#undef SCAN_LD
#undef SCAN_ISSUE
}
__device__ __forceinline__ void phase_rwfin(const bf16* P, const float* YR, const float* REC, const float* BON, const float* lnw, const float* lnb, bf16* Y, int nrows, int gw, int NGW, int lane) {
    const int head = lane >> 2, sub = lane & 3;
    for (int m = gw; m < nrows; m += NGW) {
        const bool isctx = m >= NLAT; const int t = isctx ? ((m - NLAT) & 255) : (m & 8191); const int b = isctx ? ((m - NLAT) >> 8) : (m >> 13);
        float out[16];
#pragma unroll
        for (int i = 0; i < 16; ++i) out[i] = 0.f;
#pragma unroll
        for (int d = 0; d < 2; ++d) {
            const int chain = (b * 2 + d) * 16 + head; const size_t pp = (size_t)chain * SCANLEN + scan_pos(d, isctx, t);
            float y[16], v[16];
#pragma unroll
            for (int j = 0; j < 4; ++j) { const f32x4 a = *(const f32x4*)(YR + pp * 64 + 16 * sub + 4 * j); const h4 c = *(const h4*)((const char*)REC + pp * RECB + 768 + (16 * sub + 4 * j) * 2);
                y[4 * j] = a.x; y[4 * j + 1] = a.y; y[4 * j + 2] = a.z; y[4 * j + 3] = a.w; v[4 * j] = (float)c.x; v[4 * j + 1] = (float)c.y; v[4 * j + 2] = (float)c.z; v[4 * j + 3] = (float)c.w; }
            const float bo = BON[pp];
            float s = 0.f;
#pragma unroll
            for (int i = 0; i < 16; ++i) s += y[i];
            s += __shfl_xor(s, 1); s += __shfl_xor(s, 2);
            const float mean = s * (1.f / 64.f); float q = 0.f;
#pragma unroll
            for (int i = 0; i < 16; ++i) { const float dl = y[i] - mean; q += dl * dl; }
            q += __shfl_xor(q, 1); q += __shfl_xor(q, 2);
            const float rstd = rsq_f(q * (1.f / 64.f) + 64e-5f);
#pragma unroll
            for (int i = 0; i < 16; ++i) { const int ch = head * 64 + 16 * sub + i; out[i] += (y[i] - mean) * rstd * lnw[ch] + lnb[ch] + bo * v[i]; }
        }
        float z[16]; unpack8(*(const v4u*)(P + (size_t)m * NIN + C_RWZ + 16 * lane), z); unpack8(*(const v4u*)(P + (size_t)m * NIN + C_RWZ + 16 * lane + 8), z + 8);
#pragma unroll
        for (int i = 0; i < 16; ++i) out[i] *= silu_f(z[i]);
        *(v4u*)(Y + (size_t)m * DM + 2048 + 16 * lane) = pack8(out); *(v4u*)(Y + (size_t)m * DM + 2048 + 16 * lane + 8) = pack8(out + 8);
    }
}
#define XB_TMO      128
#define XB_XCNT(j)  (256  + 64 * (j))
#define XB_XSUB(j)  (1280 + 64 * (j))
#define XB_XGEN(j)  (2304 + 64 * (j))
#define XB_TOP      3328
#define XB_TOPGEN   3392
#define XCD_BAR_WORDS 3456
#define XB_SPIN_CAP (1u << 18)

__device__ __forceinline__ unsigned xb_ld(unsigned* p)              { return __hip_atomic_load(p, __ATOMIC_RELAXED, __HIP_MEMORY_SCOPE_AGENT); }
__device__ __forceinline__ unsigned xb_add(unsigned* p, unsigned v) { return __hip_atomic_fetch_add(p, v, __ATOMIC_RELAXED, __HIP_MEMORY_SCOPE_AGENT); }
__device__ __forceinline__ unsigned xb_xcc_id() { return (unsigned)__builtin_amdgcn_s_getreg((3 << 11) | 20) & 0xFu; }
#define XB_SPIN(cond, bar) do { unsigned _sp = 0; while (cond) { __builtin_amdgcn_s_sleep(1); \
    if ((++_sp & 255u) == 0u) { if (xb_ld(&(bar)[XB_TMO])) break; if (_sp > XB_SPIN_CAP) { atomicAdd(&(bar)[XB_TMO], 1u); break; } } } } while (0)

struct XcdBarrier {
    unsigned* bar; unsigned x;
    volatile LAS unsigned* st;
};

__device__ __forceinline__ XcdBarrier xcd_barrier_post(unsigned* bar, volatile LAS unsigned* st) {
    XcdBarrier b; b.bar = bar; b.x = xb_xcc_id(); b.st = st;
    if (threadIdx.x == 0) (void)xb_add(&bar[XB_XCNT(b.x)], 1u);
    return b;
}
__device__ __forceinline__ void xcd_barrier_complete(unsigned* bar, unsigned x, unsigned& nloc, unsigned& nx) {
    const unsigned G = gridDim.x * gridDim.y * gridDim.z;
    unsigned sum, cnt, mine, sp = 0u;
    for (;;) {
        sum = 0u; cnt = 0u; mine = 0u;
#pragma unroll
        for (unsigned j = 0; j < 16; ++j) { const unsigned c = xb_ld(&bar[XB_XCNT(j)]); sum += c; cnt += (c > 0u) ? 1u : 0u; mine = (j == x) ? c : mine; }
        if (sum == G) break;
        __builtin_amdgcn_s_sleep(1);
        if ((++sp & 255u) == 0u) { if (xb_ld(&bar[XB_TMO])) break; if (sp > XB_SPIN_CAP) { atomicAdd(&bar[XB_TMO], 1u); break; } }
    }
    nloc = mine > 0u ? mine : 1u; nx = cnt > 0u ? cnt : 1u;
}

__device__ __forceinline__ void xcd_barrier(const XcdBarrier& b) {
    asm volatile("s_waitcnt vmcnt(0)" ::: "memory");
    __syncthreads();
    if (threadIdx.x == 0) {
        unsigned* bar = b.bar;
        __builtin_amdgcn_s_waitcnt(0);
        unsigned nloc = b.st[0], nx = b.st[1];
        if (nloc == 0u) { xcd_barrier_complete(bar, b.x, nloc, nx); b.st[0] = nloc; b.st[1] = nx; }
        const unsigned old = xb_add(&bar[XB_XSUB(b.x)], 1u);
        const unsigned gen = old / nloc;
        if (old + 1u == (gen + 1u) * nloc) {
            __builtin_amdgcn_fence(__ATOMIC_RELEASE, "agent");
            asm volatile("s_waitcnt vmcnt(0)" ::: "memory");
            const unsigned og = xb_add(&bar[XB_TOP], 1u);
            const unsigned tg = og / nx;
            if (og + 1u == (tg + 1u) * nx) xb_add(&bar[XB_TOPGEN], 1u);
            else XB_SPIN(xb_ld(&bar[XB_TOPGEN]) == tg, bar);
            __builtin_amdgcn_fence(__ATOMIC_ACQUIRE, "agent");
            xb_add(&bar[XB_XGEN(b.x)], 1u);
            asm volatile("s_waitcnt vmcnt(0)" ::: "memory");
        } else {
            XB_SPIN(xb_ld(&bar[XB_XGEN(b.x)]) == gen, bar);
            __builtin_amdgcn_fence(__ATOMIC_ACQUIRE, "agent");
            asm volatile("s_waitcnt vmcnt(0)" ::: "memory");
        }
    }
    __syncthreads();
}

#ifndef MK_SPLIT
#define MK_SPLIT 0
#endif
#ifndef REP_G1
#define REP_G1 1
#endif
#ifndef REP_PREP
#define REP_PREP 1
#endif
#ifndef REP_MIXA
#define REP_MIXA 1
#endif
#ifndef REP_RWP
#define REP_RWP 1
#endif
#ifndef REP_POOL
#define REP_POOL 1
#endif
#ifndef REP_NA
#define REP_NA 1
#endif
#ifndef REP_SGU
#define REP_SGU 1
#endif
#ifndef REP_ROWP
#define REP_ROWP 1
#endif
#ifndef REP_VT
#define REP_VT 1
#endif
#ifndef REP_XN
#define REP_XN 1
#endif
#ifndef REP_FIN
#define REP_FIN 1
#endif
#ifndef REP_SCAN
#define REP_SCAN 1
#endif
constexpr int PPL = 7;
constexpr int NPHASE = 2 + PPL * DEPTH;
constexpr int RWP_BLOCKS = 14;
constexpr int CW_RWQ = 16384;
constexpr int NGRID = 256;
struct Args { const float* in[28]; float* out; unsigned char* ws; int ph_lo, ph_hi, li, pad; };

__global__ void __launch_bounds__(NWAVES * 64, 2) fwd(Args args) {
    extern __shared__ __attribute__((aligned(16))) unsigned char lds_raw[];
    LAS unsigned char* lds = (LAS unsigned char*)lds_raw;
    volatile LAS unsigned* MISC = (volatile LAS unsigned*)(lds + MISC_OFF);
    const int tid = threadIdx.x, lane = tid & 63, wave = __builtin_amdgcn_readfirstlane(tid >> 6);
    constexpr int G = NGRID; const int bx = blockIdx.x;
    const int vcu = (bx % 8) * (G / 8) + bx / 8;
    const int gw = vcu * NWAVES + wave; constexpr int NGW = G * NWAVES;
    unsigned char* ws = args.ws;
    const int lo = args.ph_lo, hi = args.ph_hi;

    for (int u = tid; u < (LDS_BYTES - LDSCTL_OFF) / 4; u += NWAVES * 64) ((LAS unsigned*)(lds + LDSCTL_OFF))[u] = 0u;
    __syncthreads();
    XcdBarrier bar; bar.bar = (unsigned*)(ws + WS_CTL) + CW_BAR; bar.x = 0; bar.st = MISC + 8;
    if (hi - lo > 1) bar = xcd_barrier_post((unsigned*)(ws + WS_CTL) + CW_BAR, MISC + 8);
#define IN(k) (lo <= (k) && (k) < hi)
#define SEAM(k) do { if (lo <= (k) && (k) + 1 < hi) { XcdBarrier b2_; b2_.bar = WSP(unsigned, WS_CTL) + CW_BAR; b2_.x = bar.x; b2_.st = bar.st; xcd_barrier(b2_); } } while (0)

#define OPQ_S(x) ({ int _t = (x); asm volatile("" : "+s"(_t)); _t; })
#define OPQ_V(x) ({ int _t = (x); asm volatile("" : "+v"(_t)); _t; })
#define INP(i) (args.in[OPQ_S(i)])
#define WSP(T, off) ((T*)(args.ws + ({ size_t _o = (off); asm volatile("" : "+s"(_o)); _o; })))
#define x_in INP(0)
#define c_in INP(1)
#define ctx_in INP(2)
#define cctx_in INP(3)
#define w_mod INP(4)
#define b_mod INP(5)
#define w_in INP(6)
#define w_out INP(7)
#define pool_w INP(8)
#define pool_scale INP(9)
#define na_qg INP(10)
#define na_kg INP(11)
#define na_rpb INP(12)
#define rw_mu_rkv INP(13)
#define rw_mu_lora INP(14)
#define rw_w0 INP(15)
#define rw_w_up INP(16)
#define rw_a0 INP(17)
#define rw_a_up INP(18)
#define rw_k_k INP(19)
#define rw_k_a INP(20)
#define rw_r_k INP(21)
#define rw_ln_w INP(22)
#define rw_ln_b INP(23)
#define sg_ln_w INP(24)
#define sg_ln_b INP(25)
#define sg_w INP(26)
#define sg_b INP(27)
#define MOD WSP(float, WS_MOD)
#define MODP WSP(float, WS_MODP)
#define TAB WSP(f32x2, WS_TAB)
#define SGST WSP(f32x2, WS_SGST)
#define BON WSP(float, WS_BON)
#define POOLWT WSP(bf16, WS_POOLWT)
#define WUPT WSP(bf16, WS_WUPT)
#define AUPT WSP(bf16, WS_AUPT)
#define SGW WSP(bf16, WS_SGW)
#define VTC WSP(bf16, WS_VTC)
#define VTL WSP(bf16, WS_VTL)
#define HCTX WSP(float, WS_HCTX)
#define QN WSP(bf16, WS_QN)
#define KN WSP(bf16, WS_KN)
#define WOUTT WSP(bf16, WS_WOUTT)
#define WINT WSP(bf16, WS_WINT)
#define XN WSP(bf16, WS_XN)
#define Y WSP(bf16, WS_Y)
#define P WSP(bf16, WS_P)
#define YR WSP(float, WS_YR)
#define REC WSP(float, WS_REC)
    float* const out = args.out;

    if (IN(0)) {
        LAS float* scr = (LAS float*)(lds + wave * 16384);
        constexpr int I_MOD = 4 * 64 * 48, I_WIN1 = 64 * (NIN / 32), I_WIN = 4 * I_WIN1, I_WOUT1 = 64 * 128, I_WOUT = 4 * I_WOUT1, I_POOL = 16 * 32, I_WUP = 8 * 32, I_AUP = 8 * 32, I_SGW = 1024;
        constexpr int NITEMS = I_MOD + I_WIN + I_WOUT + I_POOL + I_WUP + I_AUP + I_SGW;
        for (int it = gw; it < NITEMS; it += NGW) {
            int r = it;
            if (r < I_MOD) { p0_mod_item(w_mod, c_in, cctx_in, MODP, scr, r, lane); continue; } r -= I_MOD;
            if (r < I_WIN) { const int l = r / I_WIN1; p0_transpose_item(w_in + (size_t)l * DM * NIN, DM, NIN, WINT + (size_t)l * NIN * DM, scr, r % I_WIN1, lane); continue; } r -= I_WIN;
            if (r < I_WOUT) { const int l = r / I_WOUT1; p0_transpose_item(w_out + (size_t)l * DM * DM, DM, DM, WOUTT + (size_t)l * DM * DM, scr, r % I_WOUT1, lane); continue; } r -= I_WOUT;
            if (r < I_POOL) { const int lg = r / 32; p0_transpose_item(pool_w + (size_t)lg * 65536, 256, 256, POOLWT + (size_t)lg * 65536, scr, r % 32, lane); continue; } r -= I_POOL;
            if (r < I_WUP) { const int ld = r / 32; p0_transpose_item(rw_w_up + (size_t)ld * 65536, 64, 1024, WUPT + (size_t)ld * 65536, scr, r % 32, lane); continue; } r -= I_WUP;
            if (r < I_AUP) { const int ld = r / 32; p0_transpose_item(rw_a_up + (size_t)ld * 65536, 64, 1024, AUPT + (size_t)ld * 65536, scr, r % 32, lane); continue; } r -= I_AUP;
            {   const size_t e0 = (size_t)r * 512 + lane * 8; const f32x4 a = *(const f32x4*)(sg_w + e0), b = *(const f32x4*)(sg_w + e0 + 4);
                v4u o; o.x = pk2(a.x, a.y); o.y = pk2(a.z, a.w); o.z = pk2(b.x, b.y); o.w = pk2(b.z, b.w); *(v4u*)(SGW + e0) = o; }
        }
        SEAM(0);
    }
    if (IN(1)) {
        for (int idx = gw * 64 + lane; idx < 4 * 3 * 12288; idx += NGW * 64) {
            const int l = idx / 36864, c = (idx / 12288) % 3, n = idx % 12288;
            float s = b_mod[l * 12288 + n];
            const float* pp = MODP + ((size_t)(l * 64) * 3 + c) * 12288 + n;
#pragma unroll 8
            for (int kc = 0; kc < 64; ++kc) s += pp[(size_t)kc * 3 * 12288];
            MOD[idx] = s;
        }
        for (int idx = gw * 64 + lane; idx < 2048; idx += NGW * 64) {
            const int pos = idx >> 4, i = idx & 15;
            float inv = (i & 3) == 0 ? 1.0f : ((i & 3) == 1 ? 0.5623413251903491f : ((i & 3) == 2 ? 0.31622776601683794f : 0.17782794100389228f));
            inv *= (i >> 2) == 0 ? 1.0f : ((i >> 2) == 1 ? 0.1f : ((i >> 2) == 2 ? 0.01f : 0.001f));
            float cc, sn; sincos_acc((float)pos * inv, cc, sn);
            TAB[idx] = (f32x2){cc, sn};
        }
        SEAM(1);
    }
    for (int l = 0; l < DEPTH; ++l) {
        const int pb = 2 + PPL * l;
        const bool with_ctx = l < DEPTH - 1;
#define hin_lat (l == 0 ? x_in : (const float*)out)
#define hin_ctx (l == 0 ? ctx_in : (const float*)HCTX)
#define mod (MOD + (size_t)l * 3 * 12288)
        const int nrows = with_ctx ? MROWS : NLAT;
        if (IN(pb + 0)) {
            for (int rep = 0; rep < REP_XN; ++rep)
            phase_xn(hin_lat, hin_ctx, mod, XN, OPQ_S(gw), NGW, OPQ_V(lane));
            SEAM(pb + 0);
        }
        if (IN(pb + 1)) {
            constexpr int C0 = 5632, NA_ = NIN - C0;
            pg8::Gemm g{XN, WINT + (size_t)l * NIN * DM + (size_t)C0 * DM, MROWS, NA_, DM}; pg8::StaticOrder S; S.init(MROWS, NA_, G, bx);
            pg8::EpiStoreBf16 E{P + C0, NIN};
            pg8::gemm_phase<pg8::EpiStoreBf16, pg8::StaticOrder, true, true>(lds, g, S, E);
            SEAM(pb + 1);
        }
        if (IN(pb + 2)) {
            if (bx >= RWP_BLOCKS) {
                constexpr int NB_ = 5632;
                pg8::Gemm g{XN, WINT + (size_t)l * NIN * DM, MROWS, NB_, DM}; pg8::StaticOrder S; S.init(MROWS, NB_, G - RWP_BLOCKS, bx - RWP_BLOCKS);
                pg8::EpiStoreBf16 E{P, NIN};
                pg8::gemm_phase<pg8::EpiStoreBf16, pg8::StaticOrder, true, true>(lds, g, S, E);
            }
            phase_rwprep(P, rw_mu_rkv + (size_t)l * 6144, rw_mu_lora + (size_t)l * 256, rw_w0 + (size_t)l * 2048, WUPT + (size_t)l * 131072, rw_a0 + (size_t)l * 2048, AUPT + (size_t)l * 131072,
                         rw_k_k + (size_t)l * 1024, rw_k_a + (size_t)l * 1024, rw_r_k + (size_t)l * 1024, REC, BON, lds, WSP(unsigned, WS_CTL) + CW_RWQ + l * 1024, (bx * NWAVES + wave) & 15, wave, OPQ_V(lane));
            SEAM(pb + 2);
        }
        if (IN(pb + 3)) {
            phase_rowprep(P, na_qg + l * 64, na_kg + l * 64, TAB, QN, KN, SGST, OPQ_S(gw), NGW, OPQ_V(lane));
            phase_vt(P, VTL, VTC, OPQ_S(gw), NGW, OPQ_V(lane));
            SEAM(pb + 3);
        }
        if (IN(pb + 4)) {
            phase_sgu(P, SGST, sg_ln_w + (size_t)l * 1024, sg_ln_b + (size_t)l * 1024, SGW + (size_t)l * 131072, sg_b + (size_t)l * 1024, Y, lds, nrows / 128, OPQ_V(tid), wave, OPQ_V(lane));
            LAS unsigned* mixq = (LAS unsigned*)(lds + LDSCTL_OFF + 64); LAS unsigned* mixb = (LAS unsigned*)(lds + LDSCTL_OFF + 128);
            if (tid == 0) { *mixq = 0u; *mixb = 0u; }
            __syncthreads();
            if (wave < 4) scan_self(REC, YR, lds, mixb, bx, wave, OPQ_V(lane));
            {   const int nctxu = with_ctx ? 2 : 0, npool = (nrows / 16) * 4, nq = 64 + nctxu + (npool + NGRID - 1) / NGRID;
                for (;;) {
                    unsigned k = 0; if (lane == 0) k = __hip_atomic_fetch_add(mixq, 1u, __ATOMIC_RELAXED, __HIP_MEMORY_SCOPE_WORKGROUP);
                    k = (unsigned)__builtin_amdgcn_readfirstlane((int)k);
                    if ((int)k >= nq) break;
                    const int ln = OPQ_V(lane);
                    if (k < 64u) na_unit<false>(QN, KN, VTL, VTC, P, na_rpb + (size_t)l * 16 * 15 * 31, Y, bx * 64 + (int)k, ln);
                    else if ((int)k < 64 + nctxu) na_unit<true>(QN, KN, VTL, VTC, P, na_rpb, Y, bx * 2 + ((int)k - 64), ln);
                    else { const int u = bx + NGRID * ((int)k - 64 - nctxu);
                        if (u < npool) { const int tt = u >> 2, g = u & 3; const bf16* wbase = POOLWT + (size_t)l * 262144 + (size_t)g * 65536; const float* psc = pool_scale + (size_t)l * 1024;
                            if (g == 0) pool_unit<0>(P, wbase, psc, Y, tt * 16, ln); else if (g == 1) pool_unit<1>(P, wbase, psc, Y, tt * 16, ln);
                            else if (g == 2) pool_unit<2>(P, wbase, psc, Y, tt * 16, ln); else pool_unit<3>(P, wbase, psc, Y, tt * 16, ln); } }
                }
            }
            SEAM(pb + 4);
        }
        if (IN(pb + 5)) {
            for (int rep = 0; rep < REP_FIN; ++rep)
            phase_rwfin(P, YR, REC, BON, rw_ln_w + (size_t)l * 1024, rw_ln_b + (size_t)l * 1024, Y, nrows, OPQ_S(gw), NGW, OPQ_V(lane));
            SEAM(pb + 5);
        }
        if (IN(pb + 6)) {
            pg8::Gemm g{Y, WOUTT + (size_t)l * DM * DM, nrows, DM, DM}; pg8::StaticOrder S; S.init(nrows, DM, G, bx);
            pg8::EpiResGate E{hin_lat, hin_ctx, out, HCTX, mod};
            pg8::gemm_phase<pg8::EpiResGate, pg8::StaticOrder, true, true>(lds, g, S, E);
            SEAM(pb + 6);
        }
    }
#undef IN
#undef SEAM
}
#undef hin_lat
#undef hin_ctx
#undef mod
#undef P
#undef Y
#undef XN
#undef out

extern "C" void kernel_launch(void* const* d_in, const int* in_sizes, int n_in, void* d_out, int out_size, void* d_ws, size_t ws_size, hipStream_t stream) {
    static int grid = 0;
    if (grid == 0) {
        if (n_in != 28 || out_size != NLAT * DM || ws_size < WS_END) { fprintf(stderr, "kernel_launch: unexpected shapes (n_in %d, out %d, ws %zu < %zu); nothing launched\n", n_in, out_size, ws_size, (size_t)WS_END); grid = -1; return; }
        int dev = 0, cus = 0, per_cu = 0;
        if (hipGetDevice(&dev) != hipSuccess || hipDeviceGetAttribute(&cus, hipDeviceAttributeMultiprocessorCount, dev) != hipSuccess) { grid = -1; return; }
        if (hipFuncSetAttribute((const void*)fwd, hipFuncAttributeMaxDynamicSharedMemorySize, LDS_BYTES) != hipSuccess) { fprintf(stderr, "kernel_launch: hipFuncSetAttribute failed\n"); grid = -1; return; }
        if (hipOccupancyMaxActiveBlocksPerMultiprocessor(&per_cu, (const void*)fwd, NWAVES * 64, LDS_BYTES) != hipSuccess || per_cu < 1)
            fprintf(stderr, "kernel_launch: note: occupancy query reports %d workgroups per CU\n", per_cu);
        (void)hipGetLastError();
        grid = cus >= NGRID ? NGRID : -2;
    }
    if (grid == -1) return;
    if (hipMemsetAsync((char*)d_ws + WS_CTL, 0, CTL_ZERO_BYTES, stream) != hipSuccess) { fprintf(stderr, "kernel_launch: memset failed\n"); return; }
    Args a{};
    for (int i = 0; i < 28; ++i) a.in[i] = (const float*)d_in[i];
    a.out = (float*)d_out; a.ws = (unsigned char*)d_ws; a.li = 0; a.pad = 0;
    const bool split = MK_SPLIT || grid == -2;
    if (split) { for (int k = 0; k < NPHASE; ++k) { a.ph_lo = k; a.ph_hi = k + 1; hipLaunchKernelGGL(fwd, dim3(NGRID), dim3(NWAVES * 64), LDS_BYTES, stream, a); } }
    else { a.ph_lo = 0; a.ph_hi = NPHASE; hipLaunchKernelGGL(fwd, dim3(NGRID), dim3(NWAVES * 64), LDS_BYTES, stream, a); }
    const hipError_t le = hipPeekAtLastError();
    if (le != hipSuccess) fprintf(stderr, "kernel_launch: launch failed: %s\n", hipGetErrorName(le));
}
```

```cpp
#include <hip/hip_runtime.h>
#include <cstdio>
#include <cstdint>
#define MK_SPLIT 0
#define REC_NT 1
namespace pg8 {
#define PG8_LAS __attribute__((address_space(3)))
typedef unsigned short bf16_t;
typedef short bf16x8 __attribute__((ext_vector_type(8)));
typedef float f32x4 __attribute__((ext_vector_type(4)));
typedef unsigned u32x4 __attribute__((ext_vector_type(4)));
constexpr int BM = 256, BK = 64, HALF = 128, HTB = HALF * BK * 2  , STAGE_BYTES = 8 * HTB, NXCD = 8, WGM = 8;

__host__ __device__ __forceinline__ int lds_byte(int r, int c) { const int st = (r >> 4) * 2 + (c >> 5), rr = r & 15, cc = c & 31, ob = rr * 64 + cc * 2; return st * 1024 + (ob ^ (((ob >> 9) & 1) << 5)); }
__host__ __device__ __forceinline__ void stage_rc(int b, int& R, int& C) { const int st = b / 1024, sb = b % 1024, swz = sb ^ (((sb >> 9) & 1) << 5); R = (st >> 1) * 16 + swz / 64; C = (st & 1) * 32 + (swz % 64) / 2; }
__host__ __device__ __forceinline__ int perm32(int rho) { const int n = rho >> 4, i = rho & 15; return 8 * (i >> 2) + 4 * n + (i & 3); }

struct Unit { int pm, pn; };
struct Gemm { const bf16_t* A; const bf16_t* Bt; int M, N, K; };

struct StaticOrder {
    int nM, nN, nwg, G, c;
    __host__ __device__ void init(int M, int N, int G_, int c_) { nM = M / BM; nN = N / BM; nwg = nM * nN; G = G_; c = c_; }
    __host__ __device__ bool next(int i, Unit& u) const {
        const long L = (long)i * G + c; if (L >= nwg) return false;
        int wgid = (int)L; { const int q = nwg / NXCD, r = nwg % NXCD, xcd = wgid % NXCD, off = wgid / NXCD; wgid = (xcd < r ? xcd * (q + 1) : r * (q + 1) + (xcd - r) * q) + off; }
        const int nig = WGM * nN, gid = wgid / nig, fm = gid * WGM, gsz = (nM - fm) < WGM ? (nM - fm) : WGM;
        u.pm = fm + ((wgid % nig) % gsz); u.pn = (wgid % nig) / gsz; return true;
    }
    __device__ __forceinline__ void a_ready(const Unit&) const {}
    __device__ __forceinline__ void done(const Unit&) const {}
};

__device__ __forceinline__ unsigned cvt_pk_bf16(float lo, float hi) { unsigned r; asm volatile("v_cvt_pk_bf16_f32 %0, %1, %2" : "=v"(r) : "v"(lo), "v"(hi)); return r; }
template <class Epi, class Sched, bool ALIGN_EPI = false, bool SP2 = false>
__device__ __forceinline__ void gemm_phase(PG8_LAS unsigned char* lds, const Gemm g, const Sched& S, const Epi& E) {
    int tid_ = threadIdx.x; asm volatile("" : "+v"(tid_));
    const int tid = tid_, wid = __builtin_amdgcn_readfirstlane(tid >> 6), lane = tid & 63, wr = wid >> 2, wc = wid & 3, fr = lane & 15, fq = lane >> 4;
    const int K = g.K, nt = K / BK;
    unsigned voffA[2], voffB[2];
#pragma unroll
    for (int i = 0; i < 2; ++i) { int R, C; stage_rc(tid * 16 + i * 8192, R, C); const int Rb = Epi::PERM ? ((R & ~31) + perm32(R & 31)) : R;
        voffA[i] = (unsigned)(R * K + C) * 2u; voffB[i] = (unsigned)(Rb * K + C) * 2u; }
    const size_t kstep = (size_t)(BK * 2);
    const size_t hstep = (size_t)HALF * K * 2;
    const size_t tstep = 2 * hstep;
    const unsigned ldsw = (unsigned)wid * 1024u;
    const int aoff = lds_byte(wr * 64 + fr, fq * 8), boff = lds_byte(wc * 32 + fr, fq * 8);
#define PG8_SA(b, h) (((b) * 2 + (h)) * HTB)
#define PG8_SB(b, h) ((4 + (b) * 2 + (h)) * HTB)
#define PG8_STAGE(bufoff, gbase, voff) do { _Pragma("unroll") for (int _i = 0; _i < 2; ++_i) \
        __builtin_amdgcn_global_load_lds((const unsigned*)((const char*)(gbase) + (voff)[_i]), (PG8_LAS unsigned*)(lds + (bufoff) + ldsw + _i * 8192), 16, 0, 0); } while (0)
#define PG8_LDA(dst, b, h) do { _Pragma("unroll") for (int m = 0; m < 4; ++m) _Pragma("unroll") for (int k = 0; k < 2; ++k) dst[m][k] = *(const PG8_LAS bf16x8*)(lds + PG8_SA(b, h) + aoff + m * 2048 + k * 1024); } while (0)
#define PG8_LDB(dst, b, h) do { _Pragma("unroll") for (int n = 0; n < 2; ++n) _Pragma("unroll") for (int k = 0; k < 2; ++k) dst[n][k] = *(const PG8_LAS bf16x8*)(lds + PG8_SB(b, h) + boff + n * 2048 + k * 1024); } while (0)
#define PG8_MMA(ai, bj, At, Bt) do { __builtin_amdgcn_s_setprio(1); _Pragma("unroll") for (int m = 0; m < 4; ++m) _Pragma("unroll") for (int n = 0; n < 2; ++n) _Pragma("unroll") for (int k = 0; k < 2; ++k) \
        acc[ai][bj][m][n] = __builtin_amdgcn_mfma_f32_16x16x32_bf16(Bt[n][k], At[m][k], acc[ai][bj][m][n], 0, 0, 0); __builtin_amdgcn_s_setprio(0); } while (0)
#define PG8_WAIT_V(n) asm volatile("s_waitcnt vmcnt(" #n ")" ::: "memory")
#define PG8_WAIT_L(n) asm volatile("s_waitcnt lgkmcnt(" #n ")" ::: "memory")
#define PG8_BAR __builtin_amdgcn_s_barrier()
#define PG8_SCHED __builtin_amdgcn_sched_barrier(0)
    Unit cur, nxt; int ui = 0;
    if (!S.next(0, cur)) return;
    f32x4 acc[2][2][4][2];
#pragma unroll
    for (int a = 0; a < 2; ++a)
#pragma unroll
        for (int b = 0; b < 2; ++b)
#pragma unroll
            for (int m = 0; m < 4; ++m)
#pragma unroll
                for (int n = 0; n < 2; ++n) acc[a][b][m][n] = (f32x4){0.f, 0.f, 0.f, 0.f};
    bf16x8 At[4][2], B0[2][2], B1[2][2];
    const char* cA = (const char*)g.A + (size_t)cur.pm * tstep; const char* cB = (const char*)g.Bt + (size_t)cur.pn * tstep;
    S.a_ready(cur);
    if constexpr (SP2) {
        PG8_STAGE(PG8_SB(0, 0), cB, voffB); PG8_STAGE(PG8_SB(0, 1), cB + hstep, voffB); PG8_STAGE(PG8_SA(0, 0), cA, voffA); PG8_STAGE(PG8_SA(0, 1), cA + hstep, voffA);
        if (wr == 1) PG8_BAR;
        PG8_WAIT_V(2); PG8_BAR;
        PG8_STAGE(PG8_SB(1, 0), cB + kstep, voffB); PG8_STAGE(PG8_SA(1, 0), cA + kstep, voffA); PG8_STAGE(PG8_SB(1, 1), cB + hstep + kstep, voffB);
        PG8_WAIT_V(6); PG8_BAR;
    } else {
        PG8_STAGE(PG8_SB(0, 0), cB, voffB); PG8_STAGE(PG8_SA(0, 0), cA, voffA); PG8_STAGE(PG8_SB(0, 1), cB + hstep, voffB); PG8_STAGE(PG8_SA(0, 1), cA + hstep, voffA);
        if (wr == 1) PG8_BAR;
        PG8_WAIT_V(4); PG8_BAR;
        PG8_STAGE(PG8_SB(1, 0), cB + kstep, voffB); PG8_STAGE(PG8_SA(1, 0), cA + kstep, voffA); PG8_STAGE(PG8_SB(1, 1), cB + hstep + kstep, voffB);
        PG8_WAIT_V(6); PG8_BAR;
    }
    for (;;) {
        const bool has_next = S.next(ui + 1, nxt);
        const char* nA = has_next ? (const char*)g.A + (size_t)nxt.pm * tstep : cA; const char* nB = has_next ? (const char*)g.Bt + (size_t)nxt.pn * tstep : cB;
        for (int t = 0; t < nt; t += 2) {
            const bool last = (t == nt - 2);
            const char* a1 = cA + (size_t)(t + 1) * kstep;
            const char* a2 = last ? nA : cA + (size_t)(t + 2) * kstep; const char* b2 = last ? nB : cB + (size_t)(t + 2) * kstep;
            const char* a3 = a2 + kstep; const char* b3 = b2 + kstep;
            if (last && has_next) S.a_ready(nxt);
            if constexpr (SP2) {
            PG8_LDB(B0, 0, 0); PG8_LDB(B1, 0, 1); PG8_SCHED; PG8_LDA(At, 0, 0); PG8_STAGE(PG8_SA(1, 1), a1 + hstep, voffA);
            PG8_WAIT_V(8); PG8_WAIT_L(0); PG8_BAR; PG8_MMA(0, 0, At, B0); PG8_MMA(0, 1, At, B1); PG8_BAR; PG8_SCHED;
            PG8_LDA(At, 0, 1); PG8_STAGE(PG8_SB(0, 0), b2, voffB); PG8_STAGE(PG8_SB(0, 1), b2 + hstep, voffB); PG8_STAGE(PG8_SA(0, 0), a2, voffA);
            PG8_WAIT_V(8); PG8_WAIT_L(0); PG8_BAR; PG8_MMA(1, 0, At, B0); PG8_MMA(1, 1, At, B1); PG8_BAR; PG8_SCHED;
            PG8_LDB(B0, 1, 0); PG8_LDB(B1, 1, 1); PG8_SCHED; PG8_LDA(At, 1, 0); PG8_STAGE(PG8_SA(0, 1), a2 + hstep, voffA);
            PG8_WAIT_V(8); PG8_WAIT_L(0); PG8_BAR; PG8_MMA(0, 0, At, B0); PG8_MMA(0, 1, At, B1); PG8_BAR; PG8_SCHED;
            PG8_LDA(At, 1, 1); PG8_STAGE(PG8_SB(1, 0), b3, voffB); PG8_STAGE(PG8_SB(1, 1), b3 + hstep, voffB); PG8_STAGE(PG8_SA(1, 0), a3, voffA);
            PG8_WAIT_V(8); PG8_WAIT_L(0); PG8_BAR; PG8_MMA(1, 0, At, B0); PG8_MMA(1, 1, At, B1); PG8_BAR; PG8_SCHED;
            } else {
            PG8_LDB(B0, 0, 0); PG8_SCHED; PG8_LDA(At, 0, 0); PG8_STAGE(PG8_SA(1, 1), a1 + hstep, voffA);
            PG8_WAIT_L(8); PG8_BAR; PG8_WAIT_L(0); PG8_MMA(0, 0, At, B0); PG8_BAR; PG8_SCHED;
            PG8_LDB(B1, 0, 1); PG8_STAGE(PG8_SB(0, 0), b2, voffB);
            PG8_BAR; PG8_WAIT_L(0); PG8_MMA(0, 1, At, B1); PG8_BAR;
            PG8_LDA(At, 0, 1); PG8_STAGE(PG8_SA(0, 0), a2, voffA);
            PG8_BAR; PG8_WAIT_L(0); PG8_MMA(1, 0, At, B0); PG8_BAR; PG8_SCHED;
            PG8_STAGE(PG8_SB(0, 1), b2 + hstep, voffB);
            PG8_WAIT_V(6); PG8_BAR; PG8_MMA(1, 1, At, B1); PG8_BAR;
            PG8_LDB(B0, 1, 0); PG8_SCHED; PG8_LDA(At, 1, 0); PG8_STAGE(PG8_SA(0, 1), a2 + hstep, voffA);
            PG8_WAIT_L(8); PG8_BAR; PG8_WAIT_L(0); PG8_MMA(0, 0, At, B0); PG8_BAR; PG8_SCHED;
            PG8_LDB(B1, 1, 1); PG8_STAGE(PG8_SB(1, 0), b3, voffB);
            PG8_BAR; PG8_WAIT_L(0); PG8_MMA(0, 1, At, B1); PG8_BAR;
            PG8_LDA(At, 1, 1); PG8_STAGE(PG8_SA(1, 0), a3, voffA);
            PG8_BAR; PG8_WAIT_L(0); PG8_MMA(1, 0, At, B0); PG8_BAR; PG8_SCHED;
            PG8_STAGE(PG8_SB(1, 1), b3 + hstep, voffB);
            PG8_WAIT_V(6); PG8_BAR; PG8_MMA(1, 1, At, B1); PG8_BAR;
            }
        }
        if constexpr (ALIGN_EPI) { if (wr == 0) PG8_BAR; }
        if constexpr (!Epi::AFTER_DRAIN) { E(acc, cur, wr, wc, fr, fq); S.done(cur); }
        if (!has_next) break;
#pragma unroll
        for (int a = 0; a < 2; ++a)
#pragma unroll
            for (int b = 0; b < 2; ++b)
#pragma unroll
                for (int m = 0; m < 4; ++m)
#pragma unroll
                    for (int n = 0; n < 2; ++n) acc[a][b][m][n] = (f32x4){0.f, 0.f, 0.f, 0.f};
        cur = nxt; cA = nA; cB = nB; ++ui;
        if constexpr (ALIGN_EPI) { if (wr == 1) PG8_BAR; }
    }
    PG8_WAIT_V(0);
    if constexpr (!ALIGN_EPI) { if (wr == 0) PG8_BAR; }
    PG8_BAR;
    if constexpr (Epi::AFTER_DRAIN) { E.fused(acc, cur, wr, wc, fr, fq, lds, wid, lane); S.done(cur); }
#undef PG8_SA
#undef PG8_SB
#undef PG8_STAGE
#undef PG8_LDA
#undef PG8_LDB
#undef PG8_MMA
#undef PG8_WAIT_V
#undef PG8_WAIT_L
#undef PG8_BAR
#undef PG8_SCHED
}
}

constexpr int DM = 4096, NBATCH = 2, SEQ = 8192, DEPTH = 4, CTXL = 256;
constexpr int NLAT = NBATCH * SEQ, NCTX = NBATCH * CTXL, MROWS = NLAT + NCTX;
constexpr int NIN = 13568, GWD = 1024;
constexpr int C_POOLV = 0, C_POOLZ = 1024, C_NAQ = 2048, C_NAK = 3072, C_NAV = 4096, C_NAZ = 5120, C_RWR = 6144, C_RWK = 7168, C_RWV = 8192, C_RWZ = 9216,
              C_RWWD = 10240, C_RWAD = 10368, C_SGU = 10496, C_SGV = 11520, C_SGZ = 12544;
constexpr int SCANLEN = CTXL + SEQ;
constexpr int NCHAIN = 64;
constexpr int RECB = 896;
constexpr int RECF = RECB / 4;
constexpr int NWAVES = 8;

constexpr size_t MiB = 1u << 20;
constexpr size_t WS_CTL = 0, CTL_ZERO_BYTES = 1 * MiB;
constexpr size_t WS_MOD   = 2 * MiB;
constexpr size_t WS_TAB   = 3 * MiB;
constexpr size_t WS_SGST  = 4 * MiB;
constexpr size_t WS_BON   = 5 * MiB;
constexpr size_t WS_POOLWT= 8 * MiB;
constexpr size_t WS_WUPT  = 10 * MiB;
constexpr size_t WS_AUPT  = 11 * MiB;
constexpr size_t WS_SGW   = 12 * MiB;
constexpr size_t WS_VTC   = 13 * MiB;
constexpr size_t WS_HCTX  = 14 * MiB;
constexpr size_t WS_MODP  = 22 * MiB;
constexpr size_t WS_VTL   = 58 * MiB;
constexpr size_t WS_QN    = 90 * MiB;
constexpr size_t WS_KN    = 123 * MiB;
constexpr size_t WS_WOUTT = 156 * MiB;
constexpr size_t WS_WINT  = 284 * MiB;
constexpr size_t WS_XN    = 708 * MiB;
constexpr size_t WS_Y     = 840 * MiB;
constexpr size_t WS_P     = 972 * MiB;
constexpr size_t WS_YR    = 1410 * MiB;
constexpr size_t WS_REC   = 1542 * MiB;
constexpr size_t WS_END   = 2334 * MiB;
static_assert(WS_P + (size_t)MROWS * NIN * 2 <= WS_YR && WS_REC + (size_t)NCHAIN * SCANLEN * RECB <= WS_END && WS_WINT + (size_t)4 * NIN * DM * 2 <= WS_XN, "ws map");
constexpr int CW_TMO = 0, CW_BAR = 4096;

constexpr int RING_BYTES = 131072, LDSCTL_OFF = RING_BYTES, MISC_OFF = LDSCTL_OFF + 320, LDS_BYTES = 147456;

#define GAS __attribute__((address_space(1)))
#define LAS __attribute__((address_space(3)))
typedef unsigned short bf16;
typedef unsigned v4u __attribute__((ext_vector_type(4)));
typedef unsigned v2u __attribute__((ext_vector_type(2)));
typedef float f32x4 __attribute__((ext_vector_type(4)));
typedef float f32x2 __attribute__((ext_vector_type(2)));
typedef short bf16x8 __attribute__((ext_vector_type(8)));
typedef _Float16 h4 __attribute__((ext_vector_type(4)));
typedef _Float16 h8 __attribute__((ext_vector_type(8)));
#define RLX_AGENT __ATOMIC_RELAXED, __HIP_MEMORY_SCOPE_AGENT
#define LDS_WAIT() asm volatile("s_waitcnt lgkmcnt(0)" ::: "memory")

__device__ __forceinline__ float bf2f(unsigned short h) { return __uint_as_float(((unsigned)h) << 16); }
__device__ __forceinline__ float bflo(unsigned w) { return __uint_as_float(w << 16); }
__device__ __forceinline__ float bfhi(unsigned w) { return __uint_as_float(w & 0xffff0000u); }
typedef __bf16 bf16x2_t __attribute__((ext_vector_type(2)));
__device__ __forceinline__ unsigned pk2(float lo, float hi) { const f32x2 v = {lo, hi}; const bf16x2_t b = __builtin_convertvector(v, bf16x2_t); return __builtin_bit_cast(unsigned, b); }
__device__ __forceinline__ unsigned f2bf(float f) { return pk2(f, 0.f) & 0xffffu; }
__device__ __forceinline__ float rcp_f(float x) { return __builtin_amdgcn_rcpf(x); }
__device__ __forceinline__ float rsq_f(float x) { return __builtin_amdgcn_rsqf(x); }
__device__ __forceinline__ void unpack8(const v4u w, float* x) { x[0] = bflo(w.x); x[1] = bfhi(w.x); x[2] = bflo(w.y); x[3] = bfhi(w.y); x[4] = bflo(w.z); x[5] = bfhi(w.z); x[6] = bflo(w.w); x[7] = bfhi(w.w); }
__device__ __forceinline__ v4u pack8(const float* x) { v4u w; w.x = pk2(x[0], x[1]); w.y = pk2(x[2], x[3]); w.z = pk2(x[4], x[5]); w.w = pk2(x[6], x[7]); return w; }
__device__ __forceinline__ float silu_f(float x) { return x * rcp_f(1.f + __expf(-x)); }
__device__ __forceinline__ float wave_sum(float v) {
#pragma unroll
    for (int o = 1; o < 64; o <<= 1) v += __shfl_xor(v, o);
    return v;
}
template <int CTRL> __device__ __forceinline__ float dppf(float v) { return __builtin_bit_cast(float, __builtin_amdgcn_update_dpp(0, __builtin_bit_cast(int, v), CTRL, 0xF, 0xF, true)); }
__device__ __forceinline__ float red16(float v) { v += dppf<0xB1>(v); v += dppf<0x4E>(v); v += dppf<0x141>(v); v += dppf<0x140>(v); return v; }
__device__ __forceinline__ void red16x2(float& a, float& b) {
    a += dppf<0xB1>(a); b += dppf<0xB1>(b); a += dppf<0x4E>(a); b += dppf<0x4E>(b); a += dppf<0x141>(a); b += dppf<0x141>(b); a += dppf<0x140>(a); b += dppf<0x140>(b); }
__device__ __forceinline__ float max16x4(float v) { v = fmaxf(v, __shfl_xor(v, 16)); v = fmaxf(v, __shfl_xor(v, 32)); return v; }
__device__ __forceinline__ float sum16x4(float v) { v += __shfl_xor(v, 16); v += __shfl_xor(v, 32); return v; }
__device__ __forceinline__ int scan_pos(int d, bool isctx, int t) { return d == 0 ? (isctx ? t : CTXL + t) : (isctx ? (CTXL - 1 - t) : (CTXL + SEQ - 1 - t)); }
__device__ __forceinline__ f32x4 mfma16(bf16x8 a, bf16x8 b, f32x4 c) { return __builtin_amdgcn_mfma_f32_16x16x32_bf16(a, b, c, 0, 0, 0); }
__device__ __forceinline__ bf16x8 ld_frag(const bf16* p) { return __builtin_bit_cast(bf16x8, *(const v4u*)p); }

namespace pg8 {
struct EpiStoreBf16 {
    static constexpr bool PERM = true, AFTER_DRAIN = false;
    bf16_t* O; int ldc;
    __device__ __forceinline__ void operator()(const f32x4 (&acc)[2][2][4][2], const Unit& u, int wr, int wc, int fr, int fq) const {
        const int row0 = u.pm * BM + wr * 64 + fr, col0 = u.pn * BM + wc * 32 + 8 * fq;
#pragma unroll
        for (int ai = 0; ai < 2; ++ai)
#pragma unroll
            for (int m = 0; m < 4; ++m) { bf16_t* rowp = O + (size_t)(row0 + ai * HALF + m * 16) * ldc + col0;
#pragma unroll
                for (int bj = 0; bj < 2; ++bj) { const f32x4 v0 = acc[ai][bj][m][0], v1 = acc[ai][bj][m][1];
                    u32x4 w; w.x = cvt_pk_bf16(v0[0], v0[1]); w.y = cvt_pk_bf16(v0[2], v0[3]); w.z = cvt_pk_bf16(v1[0], v1[1]); w.w = cvt_pk_bf16(v1[2], v1[3]);
                    *(u32x4*)(rowp + bj * HALF) = w; } }
    }
};
struct EpiResGate {
    static constexpr bool PERM = false, AFTER_DRAIN = false;
    const float* hin_lat; const float* hin_ctx; float* hout_lat; float* hout_ctx; const float* gate;
    __device__ __forceinline__ void operator()(const f32x4 (&acc)[2][2][4][2], const Unit& u, int wr, int wc, int fr, int fq) const {
        const int cond = u.pm < 32 ? 0 : (u.pm < 64 ? 1 : 2);
        const int rloc = (u.pm < 64 ? u.pm * BM : (u.pm - 64) * BM) + wr * 64 + fr, col0 = u.pn * BM + wc * 32 + 4 * fq;
        const float* hin = u.pm < 64 ? hin_lat : hin_ctx; float* hout = u.pm < 64 ? hout_lat : hout_ctx;
        f32x4 gv[2][2];
#pragma unroll
        for (int bj = 0; bj < 2; ++bj)
#pragma unroll
            for (int n = 0; n < 2; ++n) gv[bj][n] = *(const f32x4*)(gate + cond * 12288 + 8192 + col0 + bj * HALF + n * 16);
#pragma unroll
        for (int ai = 0; ai < 2; ++ai)
#pragma unroll
            for (int m = 0; m < 4; ++m) { const size_t off = (size_t)(rloc + ai * HALF + m * 16) * 4096 + col0;
#pragma unroll
                for (int bj = 0; bj < 2; ++bj)
#pragma unroll
                    for (int n = 0; n < 2; ++n) { const f32x4 b = *(const f32x4*)(hin + off + bj * HALF + n * 16);
                        *(f32x4*)(hout + off + bj * HALF + n * 16) = b + gv[bj][n] * acc[ai][bj][m][n]; } }
    }
};
}

__device__ __forceinline__ void p0_transpose_item(const float* W, int K, int N, bf16* WT, LAS float* scr, int item, int lane) {
    const int nblk = N / 32, kb = item / nblk, nb = item % nblk, k0 = 64 * kb, n0 = 32 * nb;
#pragma unroll 8
    for (int i = 0; i < 32; ++i) { const int kk = 2 * i + (lane >> 5); scr[kk * 33 + (lane & 31)] = W[(size_t)(k0 + kk) * N + n0 + (lane & 31)]; }
    LDS_WAIT(); asm volatile("" ::: "memory");
    const int c = lane & 7;
#pragma unroll
    for (int j = 0; j < 4; ++j) { const int n = (lane >> 3) + 8 * j; const LAS float* s = scr + (8 * c) * 33 + n;
        v4u o; o.x = pk2(s[0 * 33], s[1 * 33]); o.y = pk2(s[2 * 33], s[3 * 33]); o.z = pk2(s[4 * 33], s[5 * 33]); o.w = pk2(s[6 * 33], s[7 * 33]);
        *(v4u*)(WT + (size_t)(n0 + n) * K + k0 + 8 * c) = o; }
    LDS_WAIT(); asm volatile("" ::: "memory");
}
__device__ __forceinline__ void transpose_item_nolds(const float* W, int K, int N, bf16* WT, int item, int lane) {
    const int nblk = N / 64, kb = item / nblk, nb = item % nblk, k0 = 64 * kb, n0 = 64 * nb;
    const float* src = W + (size_t)k0 * N + n0 + lane;
    bf16* dst = WT + (size_t)(n0 + lane) * K + k0;
#pragma unroll
    for (int hb = 0; hb < 2; ++hb) {
        float v[32];
#pragma unroll
        for (int i = 0; i < 32; ++i) v[i] = src[(size_t)(32 * hb + i) * N];
        __builtin_amdgcn_sched_barrier(0);
#pragma unroll
        for (int j = 0; j < 4; ++j) { v4u o; o.x = pk2(v[8 * j], v[8 * j + 1]); o.y = pk2(v[8 * j + 2], v[8 * j + 3]); o.z = pk2(v[8 * j + 4], v[8 * j + 5]); o.w = pk2(v[8 * j + 6], v[8 * j + 7]);
            *(v4u*)(dst + 32 * hb + 8 * j) = o; }
        __builtin_amdgcn_sched_barrier(0);
    }
}
constexpr int WC_WIN = (DM / 64) * (NIN / 64), WC_WOUT = (DM / 64) * (DM / 64), WC_POOL = 4 * 16, WC_WUP = 2 * 16, WC_AUP = 2 * 16, WC_SGW = 256, WC_ITEMS = WC_WIN + WC_WOUT + WC_POOL + WC_WUP + WC_AUP + WC_SGW;
__device__ __forceinline__ void weight_copy_item(int L, int r, const float* w_in, const float* w_out, const float* pool_w, const float* rw_w_up, const float* rw_a_up, const float* sg_w,
                                                 bf16* WINT, bf16* WOUTT, bf16* POOLWT, bf16* WUPT, bf16* AUPT, bf16* SGW, int lane) {
    if (r < WC_WIN) { transpose_item_nolds(w_in + (size_t)L * DM * NIN, DM, NIN, WINT + (size_t)L * NIN * DM, r, lane); return; } r -= WC_WIN;
    if (r < WC_WOUT) { transpose_item_nolds(w_out + (size_t)L * DM * DM, DM, DM, WOUTT + (size_t)L * DM * DM, r, lane); return; } r -= WC_WOUT;
    if (r < WC_POOL) { const int g = r >> 4; transpose_item_nolds(pool_w + (size_t)(L * 4 + g) * 65536, 256, 256, POOLWT + (size_t)(L * 4 + g) * 65536, r & 15, lane); return; } r -= WC_POOL;
    if (r < WC_WUP) { const int dd = r >> 4; transpose_item_nolds(rw_w_up + (size_t)(L * 2 + dd) * 65536, 64, 1024, WUPT + (size_t)(L * 2 + dd) * 65536, r & 15, lane); return; } r -= WC_WUP;
    if (r < WC_AUP) { const int dd = r >> 4; transpose_item_nolds(rw_a_up + (size_t)(L * 2 + dd) * 65536, 64, 1024, AUPT + (size_t)(L * 2 + dd) * 65536, r & 15, lane); return; } r -= WC_AUP;
    {   const size_t e0 = (size_t)L * 131072 + (size_t)r * 512 + lane * 8; const f32x4 a = *(const f32x4*)(sg_w + e0), b = *(const f32x4*)(sg_w + e0 + 4);
        v4u o; o.x = pk2(a.x, a.y); o.y = pk2(a.z, a.w); o.z = pk2(b.x, b.y); o.w = pk2(b.z, b.w); *(v4u*)(SGW + e0) = o; }
}
__device__ __forceinline__ void p0_mod_item(const float* wmod, const float* cvec, const float* cctx, float* MODP, LAS float* scr, int item, int lane) {
    const int l = item / (64 * 48), r = item % (64 * 48), kc = r / 48, nc = r % 48, k0 = kc * 64, n0 = nc * 256 + lane * 4;
    scr[lane] = silu_f(cvec[k0 + lane]); scr[64 + lane] = silu_f(cvec[4096 + k0 + lane]); scr[128 + lane] = silu_f(cctx[k0 + lane]);
    LDS_WAIT(); asm volatile("" ::: "memory");
    f32x4 a0 = {0.f, 0.f, 0.f, 0.f}, a1 = a0, a2 = a0;
    const float* wp = wmod + ((size_t)l * 4096 + k0) * 12288 + n0;
#pragma unroll 16
    for (int k = 0; k < 64; ++k) { const f32x4 w = *(const f32x4*)(wp + (size_t)k * 12288); a0 += scr[k] * w; a1 += scr[64 + k] * w; a2 += scr[128 + k] * w; }
    float* o = MODP + ((size_t)(l * 64 + kc) * 3) * 12288 + n0;
    *(f32x4*)(o) = a0; *(f32x4*)(o + 12288) = a1; *(f32x4*)(o + 2 * 12288) = a2;
    LDS_WAIT(); asm volatile("" ::: "memory");
}
__device__ __forceinline__ void sincos_acc(float ang, float& c, float& s) {
    const double x = (double)ang; const double n = __builtin_rint(x * 0.63661977236758134308); const double r = x - n * 1.57079632679489661923;
    const double r2 = r * r;
    const double sp = r * (1.0 + r2 * (-1.0 / 6 + r2 * (1.0 / 120 + r2 * (-1.0 / 5040 + r2 * (1.0 / 362880 + r2 * (-1.0 / 39916800 + r2 * (1.0 / 6227020800.0)))))));
    const double cp = 1.0 + r2 * (-0.5 + r2 * (1.0 / 24 + r2 * (-1.0 / 720 + r2 * (1.0 / 40320 + r2 * (-1.0 / 3628800 + r2 * (1.0 / 479001600 + r2 * (-1.0 / 87178291200.0)))))));
    const int q = ((int)n) & 3;
    const double cc = (q == 0) ? cp : (q == 1) ? -sp : (q == 2) ? -cp : sp;
    const double ss = (q == 0) ? sp : (q == 1) ? cp : (q == 2) ? -sp : -cp;
    c = (float)cc; s = (float)ss;
}

__device__ __forceinline__ void phase_xn(const float* hlat, const float* hctx, const float* mod, bf16* XN, int gw, int NGW, int lane) {
    for (int m = gw; m < MROWS; m += NGW) {
        const float* src = m < NLAT ? hlat + (size_t)m * DM : hctx + (size_t)(m - NLAT) * DM;
        const int cond = m < NLAT ? (m >> 13) : 2;
        const f32x4* s4 = (const f32x4*)src + lane;
        f32x4 v[16]; float ss = 0.f;
#pragma unroll
        for (int j = 0; j < 16; ++j) { v[j] = s4[64 * j]; ss += (v[j].x * v[j].x + v[j].y * v[j].y) + (v[j].z * v[j].z + v[j].w * v[j].w); }
        ss = wave_sum(ss);
        const float rstd = rsq_f(ss * (1.f / 4096.f) + 1e-6f);
        const f32x4* sh4 = (const f32x4*)(mod + cond * 12288) + lane; const f32x4* sc4 = (const f32x4*)(mod + cond * 12288 + 4096) + lane;
        v2u* o = (v2u*)(XN + (size_t)m * DM) + lane;
#pragma unroll
        for (int j = 0; j < 16; ++j) { const f32x4 sh = sh4[64 * j], sc = sc4[64 * j]; const f32x4 x = v[j] * rstd * (sc + 1.f) + sh; v2u w; w.x = pk2(x.x, x.y); w.y = pk2(x.z, x.w); o[64 * j] = w; }
    }
}

__device__ __forceinline__ void phase_rowprep(const bf16* P, const float* qgain, const float* kgain, const f32x2* tab, bf16* QN, bf16* KN, f32x2* SGST, int gw, int NGW, int lane) {
    const int sub = lane & 3;
    for (int m = gw; m < MROWS; m += NGW) {
        const bf16* pr = P + (size_t)m * NIN;
        const bool isctx = m >= NLAT; const int t = isctx ? ((m - NLAT) & 255) : (m & 8191);
        {   float x[16]; unpack8(*(const v4u*)(pr + C_SGV + 16 * lane), x); unpack8(*(const v4u*)(pr + C_SGV + 16 * lane + 8), x + 8);
            float s = 0.f;
#pragma unroll
            for (int i = 0; i < 16; ++i) s += x[i];
            const float mean = wave_sum(s) * (1.f / 1024.f); float q = 0.f;
#pragma unroll
            for (int i = 0; i < 16; ++i) { const float dlt = x[i] - mean; q += dlt * dlt; }
            const float var = wave_sum(q) * (1.f / 1024.f);
            if (lane == 0) SGST[m] = (f32x2){mean, rsq_f(var + 1e-5f)}; }
        float q[16], k[16];
        unpack8(*(const v4u*)(pr + C_NAQ + 16 * lane), q); unpack8(*(const v4u*)(pr + C_NAQ + 16 * lane + 8), q + 8);
        unpack8(*(const v4u*)(pr + C_NAK + 16 * lane), k); unpack8(*(const v4u*)(pr + C_NAK + 16 * lane + 8), k + 8);
        float sq = 0.f, sk = 0.f;
#pragma unroll
        for (int i = 0; i < 16; ++i) { sq += q[i] * q[i]; sk += k[i] * k[i]; }
        sq += __shfl_xor(sq, 1); sq += __shfl_xor(sq, 2); sk += __shfl_xor(sk, 1); sk += __shfl_xor(sk, 2);
        const float rq = rsq_f(sq * (1.f / 64.f) + 1e-6f), rk = rsq_f(sk * (1.f / 64.f) + 1e-6f);
#pragma unroll
        for (int i = 0; i < 16; ++i) { q[i] *= rq * qgain[16 * sub + i]; k[i] *= rk * kgain[16 * sub + i]; }
        if (!isctx) {
            const int pos = sub < 2 ? (t >> 6) : (t & 63);
#pragma unroll
            for (int i = 0; i < 16; ++i) { const f32x2 cs = tab[pos * 16 + i]; const float pq = __shfl_xor(q[i], 1), pkk = __shfl_xor(k[i], 1);
                q[i] = (sub & 1) ? (q[i] * cs.x + pq * cs.y) : (q[i] * cs.x - pq * cs.y);
                k[i] = (sub & 1) ? (k[i] * cs.x + pkk * cs.y) : (k[i] * cs.x - pkk * cs.y); }
        }
#pragma unroll
        for (int i = 0; i < 16; ++i) q[i] *= 0.125f;
        *(v4u*)(QN + (size_t)m * GWD + 16 * lane) = pack8(q); *(v4u*)(QN + (size_t)m * GWD + 16 * lane + 8) = pack8(q + 8);
        *(v4u*)(KN + (size_t)m * GWD + 16 * lane) = pack8(k); *(v4u*)(KN + (size_t)m * GWD + 16 * lane + 8) = pack8(k + 8);
    }
}
__device__ __forceinline__ void phase_vt(const bf16* P, bf16* VTL, bf16* VTC, int gw, int NGW, int lane) {
    for (int u = gw; u < (MROWS / 64) * 16; u += NGW) {
        const int tt = u >> 4, h = u & 15, m0 = tt * 64;
        const bf16* src = P + (size_t)m0 * NIN + C_NAV + h * 64 + lane;
        unsigned w[32];
#pragma unroll
        for (int i = 0; i < 32; ++i) { const unsigned lo = src[(size_t)(2 * i) * NIN], hi = src[(size_t)(2 * i + 1) * NIN]; w[i] = lo | (hi << 16); }
        bf16* dst = tt < 256 ? VTL + (((size_t)((tt >> 7) * 16 + h) * 64 + lane) * 8192 + (tt & 127) * 64)
                             : VTC + (((size_t)(((tt - 256) >> 2) * 16 + h) * 64 + lane) * 256 + ((tt - 256) & 3) * 64);
#pragma unroll
        for (int j = 0; j < 8; ++j) { v4u o; o.x = w[4 * j]; o.y = w[4 * j + 1]; o.z = w[4 * j + 2]; o.w = w[4 * j + 3]; ((v4u*)dst)[j] = o; }
    }
}
template <int G>
__device__ __forceinline__ void pool_unit(const bf16* P, const bf16* wbase, const float* pscale, bf16* Y, int m0, int lane) {
    constexpr int WIN = 2 << G;
    const int r = lane & 15, q4 = lane >> 4, m = m0 + r;
    const bool isctx = m0 >= NLAT; const int T = isctx ? CTXL : SEQ; const int t = isctx ? ((m - NLAT) & 255) : (m & 8191);
    const int tlo = t - (WIN >> 1);
    const int lo = tlo < 0 ? 0 : tlo, hi = (tlo + WIN) > T ? T : (tlo + WIN);
    const float inv = rcp_f((float)(hi - lo));
    f32x4 acc[16];
#pragma unroll
    for (int nt = 0; nt < 16; ++nt) acc[nt] = (f32x4){0.f, 0.f, 0.f, 0.f};
#pragma unroll 1
    for (int ks = 0; ks < 8; ++ks) {
        const int ch0 = C_POOLV + G * 256 + 32 * ks + 8 * q4;
        constexpr int WB = WIN < 8 ? WIN : 8;
        bf16x8 bfr[8];
        float sum[8];
#pragma unroll
        for (int j = 0; j < 8; ++j) sum[j] = 0.f;
        const v4u selfw = *(const v4u*)(P + (size_t)m * NIN + ch0);
#pragma unroll
        for (int nt = 0; nt < 8; ++nt) bfr[nt] = ld_frag(wbase + (size_t)(16 * nt + r) * 256 + 32 * ks + 8 * q4);
#pragma unroll
        for (int k0 = 0; k0 < WIN; k0 += WB) {
            v4u wl[WB];
#pragma unroll
            for (int k = 0; k < WB; ++k) { const int tk = tlo + k0 + k; const bool ok = tk >= 0 && tk < T; wl[k] = *(const v4u*)(P + (size_t)(ok ? (m - t + tk) : m) * NIN + ch0); }
            __builtin_amdgcn_sched_barrier(0);
#pragma unroll
            for (int k = 0; k < WB; ++k) { const int tk = tlo + k0 + k; const bool ok = tk >= 0 && tk < T; float x[8]; unpack8(wl[k], x);
#pragma unroll
                for (int j = 0; j < 8; ++j) sum[j] += ok ? x[j] : 0.f; }
            __builtin_amdgcn_sched_barrier(0);
        }
        float self[8]; unpack8(selfw, self);
        float dv[8];
#pragma unroll
        for (int j = 0; j < 8; ++j) dv[j] = sum[j] * inv - self[j];
        const bf16x8 af = __builtin_bit_cast(bf16x8, pack8(dv));
        __builtin_amdgcn_sched_barrier(0);
        bf16x8 bfr2[8];
#pragma unroll
        for (int nt = 0; nt < 8; ++nt) bfr2[nt] = ld_frag(wbase + (size_t)(16 * (nt + 8) + r) * 256 + 32 * ks + 8 * q4);
        __builtin_amdgcn_sched_barrier(0);
#pragma unroll
        for (int nt = 0; nt < 8; ++nt) acc[nt] = mfma16(af, bfr[nt], acc[nt]);
        __builtin_amdgcn_sched_barrier(0);
#pragma unroll
        for (int nt = 0; nt < 8; ++nt) acc[nt + 8] = mfma16(af, bfr2[nt], acc[nt + 8]);
        __builtin_amdgcn_sched_barrier(0);
    }
#pragma unroll
    for (int nh = 0; nh < 4; ++nh) {
        unsigned short zz[4][4]; float ps[4];
#pragma unroll
        for (int nq = 0; nq < 4; ++nq) { const int oc = G * 256 + 16 * (4 * nh + nq) + r; ps[nq] = pscale[oc];
#pragma unroll
            for (int i = 0; i < 4; ++i) zz[nq][i] = P[(size_t)(m0 + 4 * q4 + i) * NIN + C_POOLZ + oc]; }
        __builtin_amdgcn_sched_barrier(0);
#pragma unroll
        for (int nq = 0; nq < 4; ++nq) { const int oc = G * 256 + 16 * (4 * nh + nq) + r;
#pragma unroll
            for (int i = 0; i < 4; ++i) Y[(size_t)(m0 + 4 * q4 + i) * DM + oc] = (bf16)f2bf(acc[4 * nh + nq][i] * ps[nq] * silu_f(bf2f(zz[nq][i]))); }
        __builtin_amdgcn_sched_barrier(0);
    }
}
__device__ __forceinline__ void phase_pool(const bf16* P, const bf16* PWT  , const float* pscale, bf16* Y, int nrows, int gw, int NGW, int lane) {
    for (int u = gw; u < (nrows / 16) * 4; u += NGW) {
        const int tt = u >> 2, g = u & 3, m0 = tt * 16;
        const bf16* wbase = PWT + (size_t)g * 65536;
        if (g == 0) pool_unit<0>(P, wbase, pscale, Y, m0, lane);
        else if (g == 1) pool_unit<1>(P, wbase, pscale, Y, m0, lane);
        else if (g == 2) pool_unit<2>(P, wbase, pscale, Y, m0, lane);
        else pool_unit<3>(P, wbase, pscale, Y, m0, lane);
    }
}
#if defined(PROBE_REC2)
#define REC_ST(p, v) do { __builtin_nontemporal_store((v), (p)); __builtin_nontemporal_store((v), (f32x4*)((char*)(p) + (size_t)792 * 1048576)); } while (0)
#elif defined(REC_NT)
#define REC_ST(p, v) __builtin_nontemporal_store((v), (p))
#else
#define REC_ST(p, v) (*(p) = (v))
#endif
__device__ __forceinline__ void phase_rwprep(const bf16* P, const float* mu_rkv  , const float* mu_lora  , const float* w0  , const bf16* WUPT  ,
                                             const float* a0, const bf16* AUPT, const float* k_k, const float* k_a, const float* r_k, float* REC, float* BON, LAS unsigned char* lds,
                                             unsigned* queue  , int cls, int wave, int lane) {
    const int n = lane & 15, q4 = lane >> 4;
    const int d = cls >> 3, hp = cls & 7;
    unsigned* qh = queue + 64 * cls;
    LAS float* prm = (LAS float*)(lds + wave * 4096);
#pragma unroll
    for (int it = 0; it < 16; ++it) { const int hh = it >> 3, p = it & 7, ch = (hp * 2 + hh) * 64 + lane;
        const float* src = p == 0 ? w0 + d * 1024 : p == 1 ? a0 + d * 1024 : p == 2 ? mu_rkv + (d * 3 + 0) * 1024 : p == 3 ? mu_rkv + (d * 3 + 1) * 1024 : p == 4 ? mu_rkv + (d * 3 + 2) * 1024 : p == 5 ? k_k : p == 6 ? k_a : r_k;
        prm[it * 64 + lane] = src[ch]; }
    LDS_WAIT(); asm volatile("" ::: "memory");
    unsigned pend = 0u;
    if (lane == 0) pend = __hip_atomic_fetch_add(qh, 1u, __ATOMIC_RELAXED, __HIP_MEMORY_SCOPE_AGENT);
    for (;;) {
        const int tt = __builtin_amdgcn_readfirstlane((int)pend);
        if (tt >= MROWS / 16) break;
        if (lane == 0) pend = __hip_atomic_fetch_add(qh, 1u, __ATOMIC_RELAXED, __HIP_MEMORY_SCOPE_AGENT);
        const int m0 = tt * 16;
        const bool isctx = m0 >= NLAT; const int T = isctx ? CTXL : SEQ; const int t0 = isctx ? ((m0 - NLAT) & 255) : (m0 & 8191); const int b = isctx ? ((m0 - NLAT) >> 8) : (m0 >> 13);
        const int m = m0 + n, t = t0 + n; const bool hasnb = d == 0 ? (t > 0) : (t < T - 1); const int nbr = hasnb ? (d == 0 ? m - 1 : m + 1) : m;
        const bf16* prow = P + (size_t)m * NIN; const bf16* nrow = P + (size_t)nbr * NIN;
        bf16x8 Bw[2], Ba[2];
        {   v4u cw[2], nw[2], ca[2], na[2]; f32x4 mw[2][2], ma[2][2];
#pragma unroll
            for (int ks = 0; ks < 2; ++ks) { const int j0 = 32 * ks + 8 * q4;
                cw[ks] = *(const v4u*)(prow + C_RWWD + d * 64 + j0); nw[ks] = *(const v4u*)(nrow + C_RWWD + d * 64 + j0);
                ca[ks] = *(const v4u*)(prow + C_RWAD + d * 64 + j0); na[ks] = *(const v4u*)(nrow + C_RWAD + d * 64 + j0);
                mw[ks][0] = *(const f32x4*)(mu_lora + (d * 2 + 0) * 64 + j0); mw[ks][1] = *(const f32x4*)(mu_lora + (d * 2 + 0) * 64 + j0 + 4);
                ma[ks][0] = *(const f32x4*)(mu_lora + (d * 2 + 1) * 64 + j0); ma[ks][1] = *(const f32x4*)(mu_lora + (d * 2 + 1) * 64 + j0 + 4); }
            __builtin_amdgcn_sched_barrier(0);
#pragma unroll
            for (int ks = 0; ks < 2; ++ks) {
                float cur[8], nb[8], o[8];
                unpack8(cw[ks], cur); unpack8(nw[ks], nb);
#pragma unroll
                for (int j = 0; j < 8; ++j) { const float xx = cur[j] + ((hasnb ? nb[j] : 0.f) - cur[j]) * mw[ks][j >> 2][j & 3]; o[j] = 1.0f - 2.0f * rcp_f(1.0f + __expf(2.0f * xx)); }
                Bw[ks] = __builtin_bit_cast(bf16x8, pack8(o));
                unpack8(ca[ks], cur); unpack8(na[ks], nb);
#pragma unroll
                for (int j = 0; j < 8; ++j) o[j] = cur[j] + ((hasnb ? nb[j] : 0.f) - cur[j]) * ma[ks][j >> 2][j & 3];
                Ba[ks] = __builtin_bit_cast(bf16x8, pack8(o)); }
        }
        const int pos = scan_pos(d, isctx, t);
#pragma unroll 1
        for (int hh = 0; hh < 2; ++hh) {
            const int head = hp * 2 + hh, chain = (b * 2 + d) * 16 + head;
            char* recb = (char*)REC + ((size_t)chain * SCANLEN + pos) * RECB;
            const LAS float* pr = prm + hh * 512;
            float KK[16], AV[16]; float ss = 0.f, bon = 0.f;
#pragma unroll
            for (int hf = 0; hf < 2; ++hf) {
                const int cl = 32 * hf + 8 * q4, cg = head * 64 + cl;
                bf16x8 wf[2][2], af[2][2];
#pragma unroll
                for (int tq = 0; tq < 2; ++tq) { const size_t wrow = (size_t)(d * 1024 + head * 64 + 32 * hf + 8 * (n >> 2) + 4 * tq + (n & 3)) * 64 + 8 * q4;
                    wf[tq][0] = ld_frag(WUPT + wrow); wf[tq][1] = ld_frag(WUPT + wrow + 32); af[tq][0] = ld_frag(AUPT + wrow); af[tq][1] = ld_frag(AUPT + wrow + 32); }
                const v4u rcw = *(const v4u*)(prow + C_RWR + cg), kcw = *(const v4u*)(prow + C_RWK + cg), vcw = *(const v4u*)(prow + C_RWV + cg);
                const v4u rnw = *(const v4u*)(nrow + C_RWR + cg), knw = *(const v4u*)(nrow + C_RWK + cg), vnw = *(const v4u*)(nrow + C_RWV + cg);
                __builtin_amdgcn_sched_barrier(0);
                f32x4 accW[2], accA[2];
#pragma unroll
                for (int tq = 0; tq < 2; ++tq) { f32x4 z = {0.f, 0.f, 0.f, 0.f}; z = mfma16(wf[tq][0], Bw[0], z); accW[tq] = mfma16(wf[tq][1], Bw[1], z);
                                                 f32x4 y = {0.f, 0.f, 0.f, 0.f}; y = mfma16(af[tq][0], Ba[0], y); accA[tq] = mfma16(af[tq][1], Ba[1], y); }
                float rc[8], kc[8], vc[8], rn[8], kn[8], vn[8];
                unpack8(rcw, rc); unpack8(kcw, kc); unpack8(vcw, vc); unpack8(rnw, rn); unpack8(knw, kn); unpack8(vnw, vn);
                float dec[8], kp[8], rr[8], vv[8];
#pragma unroll
                for (int g = 0; g < 2; ++g) {
                    const f32x4 w0v = *(const LAS f32x4*)(pr + 0 * 64 + cl + 4 * g), a0v = *(const LAS f32x4*)(pr + 1 * 64 + cl + 4 * g), mur = *(const LAS f32x4*)(pr + 2 * 64 + cl + 4 * g),
                                muk = *(const LAS f32x4*)(pr + 3 * 64 + cl + 4 * g), muv = *(const LAS f32x4*)(pr + 4 * 64 + cl + 4 * g), kkv = *(const LAS f32x4*)(pr + 5 * 64 + cl + 4 * g),
                                kav = *(const LAS f32x4*)(pr + 6 * 64 + cl + 4 * g), rkv = *(const LAS f32x4*)(pr + 7 * 64 + cl + 4 * g);
#pragma unroll
                    for (int i = 0; i < 4; ++i) { const int j = 4 * g + i;
                        const float rnb = hasnb ? rn[j] : 0.f, knb = hasnb ? kn[j] : 0.f, vnb = hasnb ? vn[j] : 0.f;
                        const float r_ = rc[j] + (rnb - rc[j]) * mur[i], k0 = kc[j] + (knb - kc[j]) * muk[i], v_ = vc[j] + (vnb - vc[j]) * muv[i];
                        const float xw = -(w0v[i] + accW[g][i]);
                        const float sp = fmaxf(xw, 0.f) + __logf(1.0f + __expf(-fabsf(xw)));
                        dec[j] = __expf(-__expf(-sp - 0.5f));
                        const float av = rcp_f(1.0f + __expf(-(a0v[i] + accA[g][i])));
                        const float kx = k0 * kkv[i]; ss += kx * kx;
                        const float kp_ = k0 * (1.f + (av - 1.f) * kav[i]); bon += r_ * kp_ * rkv[i];
                        KK[8 * hf + j] = kx; AV[8 * hf + j] = av; kp[j] = kp_; rr[j] = r_; vv[j] = v_; }
                }
                char* ob = recb + cl * 2;
                REC_ST((f32x4*)(recb + cl * 4), ((f32x4){dec[0], dec[1], dec[2], dec[3]})); REC_ST((f32x4*)(recb + cl * 4 + 16), ((f32x4){dec[4], dec[5], dec[6], dec[7]}));
                REC_ST((h8*)(ob + 512), ((h8){(_Float16)kp[0], (_Float16)kp[1], (_Float16)kp[2], (_Float16)kp[3], (_Float16)kp[4], (_Float16)kp[5], (_Float16)kp[6], (_Float16)kp[7]}));
                REC_ST((h8*)(ob + 640), ((h8){(_Float16)rr[0], (_Float16)rr[1], (_Float16)rr[2], (_Float16)rr[3], (_Float16)rr[4], (_Float16)rr[5], (_Float16)rr[6], (_Float16)rr[7]}));
                REC_ST((h8*)(ob + 768), ((h8){(_Float16)vv[0], (_Float16)vv[1], (_Float16)vv[2], (_Float16)vv[3], (_Float16)vv[4], (_Float16)vv[5], (_Float16)vv[6], (_Float16)vv[7]}));
                __builtin_amdgcn_sched_barrier(0);
            }
            ss = sum16x4(ss); bon = sum16x4(bon);
            const float inv = rsq_f(fmaxf(ss, 1e-12f));
#pragma unroll
            for (int hf = 0; hf < 2; ++hf) { char* ob = recb + (32 * hf + 8 * q4) * 2; float kkn[8], nka[8];
#pragma unroll
                for (int j = 0; j < 8; ++j) { kkn[j] = KK[8 * hf + j] * inv; nka[j] = -(kkn[j] * AV[8 * hf + j]); }
                REC_ST((h8*)(ob + 256), ((h8){(_Float16)kkn[0], (_Float16)kkn[1], (_Float16)kkn[2], (_Float16)kkn[3], (_Float16)kkn[4], (_Float16)kkn[5], (_Float16)kkn[6], (_Float16)kkn[7]}));
                REC_ST((h8*)(ob + 384), ((h8){(_Float16)nka[0], (_Float16)nka[1], (_Float16)nka[2], (_Float16)nka[3], (_Float16)nka[4], (_Float16)nka[5], (_Float16)nka[6], (_Float16)nka[7]})); }
            if (q4 == 0) BON[(size_t)chain * SCANLEN + pos] = bon;
        }
    }
}
template <bool CTXQ>
__device__ __forceinline__ void na_unit(const bf16* QN, const bf16* KN, const bf16* VTL, const bf16* VTC, const bf16* P, const float* rpb  , bf16* Y, int u, int lane) {
    const int n = lane & 15, q4 = lane >> 4;
    int b, h, qrow0, qr = 0, jt = 0;
    if (CTXQ) { b = u >> 8; h = (u >> 4) & 15; qrow0 = NLAT + b * CTXL + 16 * (u & 15); }
    else { jt = u & 3; h = (u >> 2) & 15; qr = (u >> 6) & 127; b = u >> 13; qrow0 = b * SEQ + qr * 64 + 16 * jt; }
    constexpr int NT = CTXQ ? 16 : 32, WT = CTXQ ? 0 : 16;
    f32x4 s[NT];
    const int rs = qr - 4 < 0 ? 0 : (qr - 4 > 120 ? 120 : qr - 4);
    const int span0 = jt == 0 ? 0 : (jt == 1 ? 8 : (jt == 2 ? 24 : 32));
    const int qc = 16 * jt + n; const int cs = qc - 8 < 0 ? 0 : (qc - 8 > 48 ? 48 : qc - 8);
    bf16x8 qf[2];
#pragma unroll
    for (int ks = 0; ks < 2; ++ks) qf[ks] = ld_frag(QN + (size_t)(qrow0 + n) * GWD + h * 64 + 32 * ks + 8 * q4);
    if (!CTXQ) {
        const float* rp = rpb + (size_t)h * 15 * 31;
#pragma unroll
        for (int wt = 0; wt < 16; ++wt) { const int kri = wt >> 1, half = wt & 1, relr = rs + kri - qr + 7;
#pragma unroll
            for (int i = 0; i < 4; ++i) { const int relc = span0 + 8 * q4 + 4 * half + i - qc + 15; const int relcc = relc < 0 ? 0 : (relc > 30 ? 30 : relc); s[wt][i] = rp[relr * 31 + relcc]; } }
        __builtin_amdgcn_sched_barrier(0);
#pragma unroll
        for (int bt = 0; bt < 2; ++bt) {
            bf16x8 kf[16];
#pragma unroll
            for (int t = 0; t < 8; ++t) { const int wt = bt * 8 + t, kri = wt >> 1, half = wt & 1;
                const bf16* kp = KN + (size_t)(b * SEQ + (rs + kri) * 64 + span0 + 8 * (n >> 2) + 4 * half + (n & 3)) * GWD + h * 64 + 8 * q4; kf[2 * t] = ld_frag(kp); kf[2 * t + 1] = ld_frag(kp + 32); }
            __builtin_amdgcn_sched_barrier(0);
#pragma unroll
            for (int t = 0; t < 8; ++t) { const int wt = bt * 8 + t, half = wt & 1;
                f32x4 a = s[wt];
#pragma unroll
                for (int i = 0; i < 4; ++i) { const int kc = span0 + 8 * q4 + 4 * half + i; const bool ok = kc >= cs && kc < cs + 16; a[i] = ok ? a[i] : -INFINITY; }
                a = mfma16(kf[2 * t], qf[0], a); a = mfma16(kf[2 * t + 1], qf[1], a); s[wt] = a; }
            __builtin_amdgcn_sched_barrier(0);
        }
    }
#pragma unroll
    for (int bt = 0; bt < 2; ++bt) {
        bf16x8 kf[16];
#pragma unroll
        for (int t = 0; t < 8; ++t) { const int ctile = bt * 8 + t; const bf16* kp = KN + (size_t)(NLAT + b * CTXL + 32 * (ctile >> 1) + 8 * (n >> 2) + 4 * (ctile & 1) + (n & 3)) * GWD + h * 64 + 8 * q4; kf[2 * t] = ld_frag(kp); kf[2 * t + 1] = ld_frag(kp + 32); }
        __builtin_amdgcn_sched_barrier(0);
#pragma unroll
        for (int t = 0; t < 8; ++t) { f32x4 a = {0.f, 0.f, 0.f, 0.f}; a = mfma16(kf[2 * t], qf[0], a); a = mfma16(kf[2 * t + 1], qf[1], a); s[WT + bt * 8 + t] = a; }
        __builtin_amdgcn_sched_barrier(0);
    }
    float mx = -INFINITY;
#pragma unroll
    for (int t = 0; t < NT; ++t) mx = fmaxf(fmaxf(fmaxf(s[t][0], s[t][1]), fmaxf(s[t][2], s[t][3])), mx);
    mx = max16x4(mx);
    float sum = 0.f;
#pragma unroll
    for (int t = 0; t < NT; ++t) {
#pragma unroll
        for (int i = 0; i < 4; ++i) { const float e = __expf(s[t][i] - mx); s[t][i] = e; sum += e; } }
    sum = sum16x4(sum);
    const float inv = rcp_f(sum);
    f32x4 o[4];
#pragma unroll
    for (int nt = 0; nt < 4; ++nt) o[nt] = (f32x4){0.f, 0.f, 0.f, 0.f};
#pragma unroll
    for (int tb = 0; tb < NT / 8; ++tb) {
        v4u vv[4][4];
#pragma unroll
        for (int tq = 0; tq < 4; ++tq) { const int tp = tb * 4 + tq;
            const bf16* vb; size_t dstride;
            if (!CTXQ && tp < 8) { vb = VTL + ((size_t)(b * 16 + h) * 64 + n) * 8192 + (rs + tp) * 64 + span0 + 8 * q4; dstride = (size_t)16 * 8192; }
            else { const int cp = tp - (CTXQ ? 0 : 8); vb = VTC + ((size_t)(b * 16 + h) * 64 + n) * 256 + 32 * cp + 8 * q4; dstride = (size_t)16 * 256; }
#pragma unroll
            for (int nt = 0; nt < 4; ++nt) vv[tq][nt] = *(const v4u*)(vb + nt * dstride); }
        __builtin_amdgcn_sched_barrier(0);
#pragma unroll
        for (int tq = 0; tq < 4; ++tq) { const int tp = tb * 4 + tq;
            const f32x4 p0 = s[2 * tp] * inv, p1 = s[2 * tp + 1] * inv;
            v4u aw; aw.x = pk2(p0[0], p0[1]); aw.y = pk2(p0[2], p0[3]); aw.z = pk2(p1[0], p1[1]); aw.w = pk2(p1[2], p1[3]);
            const bf16x8 af = __builtin_bit_cast(bf16x8, aw);
#pragma unroll
            for (int nt = 0; nt < 4; ++nt) o[nt] = mfma16(af, __builtin_bit_cast(bf16x8, vv[tq][nt]), o[nt]); }
        __builtin_amdgcn_sched_barrier(0);
    }
    unsigned short zz[4][4];
#pragma unroll
    for (int nt = 0; nt < 4; ++nt)
#pragma unroll
        for (int i = 0; i < 4; ++i) zz[nt][i] = P[(size_t)(qrow0 + 4 * q4 + i) * NIN + C_NAZ + h * 64 + 16 * nt + n];
    __builtin_amdgcn_sched_barrier(0);
#pragma unroll
    for (int nt = 0; nt < 4; ++nt)
#pragma unroll
        for (int i = 0; i < 4; ++i) { const int row = qrow0 + 4 * q4 + i, col = h * 64 + 16 * nt + n;
            Y[(size_t)row * DM + 1024 + col] = (bf16)f2bf(o[nt][i] * silu_f(bf2f(zz[nt][i]))); }
}
__device__ __forceinline__ void phase_sgu(const bf16* P, const f32x2* SGST, const float* lnw, const float* lnb, const bf16* SGW  , const float* sgb  , bf16* Y,
                                          LAS unsigned char* lds, int nchunks, int tid, int wave, int lane) {
    const int n = lane & 15, q4 = lane >> 4;
    LAS bf16* T = (LAS bf16*)lds;
    for (int u = blockIdx.x; u < nchunks * 8; u += 256) {
        const int ck = u >> 3, g = u & 7, m0 = ck * 128;
#pragma unroll
        for (int it = 0; it < 4; ++it) { const int idx = tid + 512 * it, q = idx >> 4, c8 = idx & 15;
            float x[8]; unpack8(*(const v4u*)(P + (size_t)(m0 + q) * NIN + C_SGV + g * 128 + 8 * c8), x);
            const f32x2 st = SGST[m0 + q];
#pragma unroll
            for (int j = 0; j < 8; ++j) { const int c = 8 * c8 + j; const float v = (x[j] - st.x) * st.y * lnw[g * 128 + c] + lnb[g * 128 + c]; T[c * 136 + q] = (bf16)f2bf(v); } }
        __syncthreads();
        bf16x8 af[4];
#pragma unroll
        for (int ks = 0; ks < 4; ++ks) af[ks] = ld_frag(SGW + ((size_t)g * 128 + 16 * wave + n) * 128 + 32 * ks + 8 * q4);
#pragma unroll
        for (int nt = 0; nt < 8; ++nt) {
            f32x4 acc = {0.f, 0.f, 0.f, 0.f};
#pragma unroll
            for (int ks = 0; ks < 4; ++ks) { const bf16x8 bfg = *(const LAS bf16x8*)(T + (16 * nt + n) * 136 + 32 * ks + 8 * q4); acc = mfma16(af[ks], bfg, acc); }
#pragma unroll
            for (int i = 0; i < 4; ++i) { const int p = 16 * wave + 4 * q4 + i, row = m0 + p, col = g * 128 + 16 * nt + n;
                const float mixed = acc[i] + sgb[g * 128 + p]; const bf16* pr = P + (size_t)row * NIN;
                const float uu = bf2f(pr[C_SGU + col]), z = bf2f(pr[C_SGZ + col]);
                Y[(size_t)row * DM + 3072 + col] = (bf16)f2bf(uu * mixed * silu_f(z)); }
        }
        __syncthreads();
    }
}
__device__ __forceinline__ void scan_self(const float* REC, float* YR, LAS unsigned char* lds, LAS unsigned* bcnt, int su, int wave, int lane) {
    constexpr int CS = 32, NCH = SCANLEN / CS, SLOT = CS * RECB, NPW = SLOT / 1024 / 4;
    const int chain = (su & 7) * 8 + ((su >> 3) >> 2), part = (su >> 3) & 3;
    const char* recb = (const char*)REC + (size_t)chain * SCANLEN * RECB;
    const int wl = wave;
#define SCAN_ISSUE(cc, sl) do { _Pragma("unroll") for (int p_ = 0; p_ < NPW; ++p_) \
    __builtin_amdgcn_global_load_lds((const unsigned*)(recb + (size_t)(cc) * SLOT + (wl * NPW + p_) * 1024 + lane * 16), (LAS unsigned*)(lds + (sl) * SLOT + (wl * NPW + p_) * 1024), 16, 0, 0); } while (0)
    SCAN_ISSUE(0, 0); SCAN_ISSUE(1, 1); SCAN_ISSUE(2, 2);
    const int c16 = lane & 15, rg = lane >> 4, row = 16 * part + 4 * wave + rg;
    float S0 = 0.f, S1 = 0.f, S2 = 0.f, S3 = 0.f;
    float* yout = YR + (size_t)chain * SCANLEN * 64 + row;
    const int lo_w = c16 * 16, lo_h = 256 + c16 * 8, lo_v = 768 + row * 2;
#define SCAN_LD(dst, sl, s_) do { const LAS unsigned char* rec_ = (sl) + (s_) * RECB; dst##w = *(const LAS f32x4*)(rec_ + lo_w); dst##kk = *(const LAS h4*)(rec_ + lo_h); \
    dst##na = *(const LAS h4*)(rec_ + 128 + lo_h); dst##k = *(const LAS h4*)(rec_ + 256 + lo_h); dst##r = *(const LAS h4*)(rec_ + 384 + lo_h); dst##v = *(const LAS _Float16*)(rec_ + lo_v); } while (0)
#define FMX(a, b, c) __builtin_fmaf((a), (float)(b), (c))
    for (int c = 0; c < NCH; ++c) {
        asm volatile("s_waitcnt vmcnt(14)" ::: "memory");
        {   const unsigned baddr = (unsigned)(size_t)bcnt, one = 1u;
            if (lane == 0) asm volatile("ds_add_u32 %0, %1" :: "v"(baddr), "v"(one) : "memory");
            const unsigned want = 4u * (unsigned)(c + 1); unsigned sp = 0, got;
            for (;;) { asm volatile("ds_read_b32 %0, %1\n\ts_waitcnt lgkmcnt(0)" : "=v"(got) : "v"(baddr) : "memory");
                if (__builtin_amdgcn_readfirstlane((int)got) >= (int)want) break; __builtin_amdgcn_s_sleep(1); if (++sp > (1u << 22)) break; } }
        asm volatile("" ::: "memory");
        {   const int cc = c + 3 < NCH ? c + 3 : NCH - 1; SCAN_ISSUE(cc, (c + 3) & 3); }
        const LAS unsigned char* slot = lds + (c & 3) * SLOT;
        float ysv0 = 0.f, ysv1 = 0.f, ypend = 0.f;
        f32x4 Aw; h4 Akk, Ana, Ak, Ar; _Float16 Av;
        SCAN_LD(A, slot, 0);
#pragma unroll
        for (int s = 0; s < CS; ++s) {
            f32x4 Bw; h4 Bkk, Bna, Bk, Br; _Float16 Bv;
            if (s < CS - 1) SCAN_LD(B, slot, s + 1);
            __builtin_amdgcn_sched_barrier(0);
            float p0 = FMX(S0, Akk.x, 0.f), p1 = FMX(S2, Akk.z, 0.f); p0 = FMX(S1, Akk.y, p0); p1 = FMX(S3, Akk.w, p1);
            float dt = p0 + p1, yr = ypend; red16x2(dt, yr);
            const float u0 = __builtin_fmaf(S0, Aw.x, FMX((float)Av, Ak.x, 0.f)), u1 = __builtin_fmaf(S1, Aw.y, FMX((float)Av, Ak.y, 0.f)),
                        u2 = __builtin_fmaf(S2, Aw.z, FMX((float)Av, Ak.z, 0.f)), u3 = __builtin_fmaf(S3, Aw.w, FMX((float)Av, Ak.w, 0.f));
            S0 = FMX(dt, Ana.x, u0); S1 = FMX(dt, Ana.y, u1); S2 = FMX(dt, Ana.z, u2); S3 = FMX(dt, Ana.w, u3);
            if (s > 0) { if (s <= 16) ysv0 = (c16 == s - 1) ? yr : ysv0; else ysv1 = (c16 == s - 17) ? yr : ysv1; }
            float q0 = FMX(S0, Ar.x, 0.f), q1 = FMX(S2, Ar.z, 0.f); q0 = FMX(S1, Ar.y, q0); q1 = FMX(S3, Ar.w, q1);
            ypend = q0 + q1;
            __builtin_amdgcn_sched_barrier(0);
            if (s < CS - 1) { Aw = Bw; Akk = Bkk; Ana = Bna; Ak = Bk; Ar = Br; Av = Bv; }
        }
        { const float y = red16(ypend); ysv1 = (c16 == 15) ? y : ysv1; }
        asm volatile("" ::: "memory");
        yout[(size_t)(c * CS + c16) * 64] = ysv0; yout[(size_t)(c * CS + 16 + c16) * 64] = ysv1;
    }
    asm volatile("s_waitcnt vmcnt(0)" ::: "memory");
#undef FMX
#undef SCAN_LD
#undef SCAN_ISSUE
}
__device__ __forceinline__ void phase_rwfin(const bf16* P, const float* YR, const float* REC, const float* BON, const float* lnw, const float* lnb, bf16* Y, int nrows, int gw, int NGW, int lane) {
    const int head = lane >> 2, sub = lane & 3;
    for (int m = gw; m < nrows; m += NGW) {
        const bool isctx = m >= NLAT; const int t = isctx ? ((m - NLAT) & 255) : (m & 8191); const int b = isctx ? ((m - NLAT) >> 8) : (m >> 13);
        float out[16];
#pragma unroll
        for (int i = 0; i < 16; ++i) out[i] = 0.f;
#pragma unroll
        for (int d = 0; d < 2; ++d) {
            const int chain = (b * 2 + d) * 16 + head; const size_t pp = (size_t)chain * SCANLEN + scan_pos(d, isctx, t);
            float y[16], v[16];
#pragma unroll
            for (int j = 0; j < 4; ++j) { const f32x4 a = *(const f32x4*)(YR + pp * 64 + 16 * sub + 4 * j); const h4 c = *(const h4*)((const char*)REC + pp * RECB + 768 + (16 * sub + 4 * j) * 2);
                y[4 * j] = a.x; y[4 * j + 1] = a.y; y[4 * j + 2] = a.z; y[4 * j + 3] = a.w; v[4 * j] = (float)c.x; v[4 * j + 1] = (float)c.y; v[4 * j + 2] = (float)c.z; v[4 * j + 3] = (float)c.w; }
            const float bo = BON[pp];
            float s = 0.f;
#pragma unroll
            for (int i = 0; i < 16; ++i) s += y[i];
            s += __shfl_xor(s, 1); s += __shfl_xor(s, 2);
            const float mean = s * (1.f / 64.f); float q = 0.f;
#pragma unroll
            for (int i = 0; i < 16; ++i) { const float dl = y[i] - mean; q += dl * dl; }
            q += __shfl_xor(q, 1); q += __shfl_xor(q, 2);
            const float rstd = rsq_f(q * (1.f / 64.f) + 64e-5f);
#pragma unroll
            for (int i = 0; i < 16; ++i) { const int ch = head * 64 + 16 * sub + i; out[i] += (y[i] - mean) * rstd * lnw[ch] + lnb[ch] + bo * v[i]; }
        }
        float z[16]; unpack8(*(const v4u*)(P + (size_t)m * NIN + C_RWZ + 16 * lane), z); unpack8(*(const v4u*)(P + (size_t)m * NIN + C_RWZ + 16 * lane + 8), z + 8);
#pragma unroll
        for (int i = 0; i < 16; ++i) out[i] *= silu_f(z[i]);
        *(v4u*)(Y + (size_t)m * DM + 2048 + 16 * lane) = pack8(out); *(v4u*)(Y + (size_t)m * DM + 2048 + 16 * lane + 8) = pack8(out + 8);
    }
}
#define XB_TMO      128
#define XB_XCNT(j)  (256  + 64 * (j))
#define XB_XSUB(j)  (1280 + 64 * (j))
#define XB_XGEN(j)  (2304 + 64 * (j))
#define XB_TOP      3328
#define XB_TOPGEN   3392
#define XCD_BAR_WORDS 3456
#define XB_SPIN_CAP (1u << 18)

__device__ __forceinline__ unsigned xb_ld(unsigned* p)              { return __hip_atomic_load(p, __ATOMIC_RELAXED, __HIP_MEMORY_SCOPE_AGENT); }
__device__ __forceinline__ unsigned xb_add(unsigned* p, unsigned v) { return __hip_atomic_fetch_add(p, v, __ATOMIC_RELAXED, __HIP_MEMORY_SCOPE_AGENT); }
__device__ __forceinline__ unsigned xb_xcc_id() { return (unsigned)__builtin_amdgcn_s_getreg((3 << 11) | 20) & 0xFu; }
#define XB_SPIN(cond, bar) do { unsigned _sp = 0; while (cond) { __builtin_amdgcn_s_sleep(1); \
    if ((++_sp & 255u) == 0u) { if (xb_ld(&(bar)[XB_TMO])) break; if (_sp > XB_SPIN_CAP) { atomicAdd(&(bar)[XB_TMO], 1u); break; } } } } while (0)

struct XcdBarrier {
    unsigned* bar; unsigned x;
    volatile LAS unsigned* st;
};

__device__ __forceinline__ XcdBarrier xcd_barrier_post(unsigned* bar, volatile LAS unsigned* st) {
    XcdBarrier b; b.bar = bar; b.x = xb_xcc_id(); b.st = st;
    if (threadIdx.x == 0) (void)xb_add(&bar[XB_XCNT(b.x)], 1u);
    return b;
}
__device__ __forceinline__ void xcd_barrier_complete(unsigned* bar, unsigned x, unsigned& nloc, unsigned& nx) {
    const unsigned G = gridDim.x * gridDim.y * gridDim.z;
    unsigned sum, cnt, mine, sp = 0u;
    for (;;) {
        sum = 0u; cnt = 0u; mine = 0u;
#pragma unroll
        for (unsigned j = 0; j < 16; ++j) { const unsigned c = xb_ld(&bar[XB_XCNT(j)]); sum += c; cnt += (c > 0u) ? 1u : 0u; mine = (j == x) ? c : mine; }
        if (sum == G) break;
        __builtin_amdgcn_s_sleep(1);
        if ((++sp & 255u) == 0u) { if (xb_ld(&bar[XB_TMO])) break; if (sp > XB_SPIN_CAP) { atomicAdd(&bar[XB_TMO], 1u); break; } }
    }
    nloc = mine > 0u ? mine : 1u; nx = cnt > 0u ? cnt : 1u;
}

__device__ __forceinline__ void xcd_barrier(const XcdBarrier& b) {
    asm volatile("s_waitcnt vmcnt(0)" ::: "memory");
    __syncthreads();
    if (threadIdx.x == 0) {
        unsigned* bar = b.bar;
        __builtin_amdgcn_s_waitcnt(0);
        unsigned nloc = b.st[0], nx = b.st[1];
        if (nloc == 0u) { xcd_barrier_complete(bar, b.x, nloc, nx); b.st[0] = nloc; b.st[1] = nx; }
        const unsigned old = xb_add(&bar[XB_XSUB(b.x)], 1u);
        const unsigned gen = old / nloc;
        if (old + 1u == (gen + 1u) * nloc) {
            __builtin_amdgcn_fence(__ATOMIC_RELEASE, "agent");
            asm volatile("s_waitcnt vmcnt(0)" ::: "memory");
            const unsigned og = xb_add(&bar[XB_TOP], 1u);
            const unsigned tg = og / nx;
            if (og + 1u == (tg + 1u) * nx) xb_add(&bar[XB_TOPGEN], 1u);
            else XB_SPIN(xb_ld(&bar[XB_TOPGEN]) == tg, bar);
            __builtin_amdgcn_fence(__ATOMIC_ACQUIRE, "agent");
            xb_add(&bar[XB_XGEN(b.x)], 1u);
            asm volatile("s_waitcnt vmcnt(0)" ::: "memory");
        } else {
            XB_SPIN(xb_ld(&bar[XB_XGEN(b.x)]) == gen, bar);
            __builtin_amdgcn_fence(__ATOMIC_ACQUIRE, "agent");
            asm volatile("s_waitcnt vmcnt(0)" ::: "memory");
        }
    }
    __syncthreads();
}

#ifndef MK_SPLIT
#define MK_SPLIT 0
#endif
#ifndef REP_G1
#define REP_G1 1
#endif
#ifndef REP_PREP
#define REP_PREP 1
#endif
#ifndef REP_MIXA
#define REP_MIXA 1
#endif
#ifndef REP_RWP
#define REP_RWP 1
#endif
#ifndef REP_POOL
#define REP_POOL 1
#endif
#ifndef REP_NA
#define REP_NA 1
#endif
#ifndef REP_SGU
#define REP_SGU 1
#endif
#ifndef REP_ROWP
#define REP_ROWP 1
#endif
#ifndef REP_VT
#define REP_VT 1
#endif
#ifndef REP_XN
#define REP_XN 1
#endif
#ifndef REP_FIN
#define REP_FIN 1
#endif
#ifndef REP_SCAN
#define REP_SCAN 1
#endif
constexpr int PPL = 7;
constexpr int NPHASE = 2 + PPL * DEPTH;
constexpr int RWP_BLOCKS = 14;
constexpr int CW_RWQ = 16384;
constexpr int NGRID = 256;
struct Args { const float* in[28]; float* out; unsigned char* ws; int ph_lo, ph_hi, li, pad; };

__global__ void __launch_bounds__(NWAVES * 64, 2) fwd(Args args) {
    extern __shared__ __attribute__((aligned(16))) unsigned char lds_raw[];
    LAS unsigned char* lds = (LAS unsigned char*)lds_raw;
    volatile LAS unsigned* MISC = (volatile LAS unsigned*)(lds + MISC_OFF);
    const int tid = threadIdx.x, lane = tid & 63, wave = __builtin_amdgcn_readfirstlane(tid >> 6);
    constexpr int G = NGRID; const int bx = blockIdx.x;
    const int vcu = (bx % 8) * (G / 8) + bx / 8;
    const int gw = vcu * NWAVES + wave; constexpr int NGW = G * NWAVES;
    unsigned char* ws = args.ws;
    const int lo = args.ph_lo, hi = args.ph_hi;

    for (int u = tid; u < (LDS_BYTES - LDSCTL_OFF) / 4; u += NWAVES * 64) ((LAS unsigned*)(lds + LDSCTL_OFF))[u] = 0u;
    __syncthreads();
    XcdBarrier bar; bar.bar = (unsigned*)(ws + WS_CTL) + CW_BAR; bar.x = 0; bar.st = MISC + 8;
    if (hi - lo > 1) bar = xcd_barrier_post((unsigned*)(ws + WS_CTL) + CW_BAR, MISC + 8);
#define IN(k) (lo <= (k) && (k) < hi)
#define SEAM(k) do { if (lo <= (k) && (k) + 1 < hi) { XcdBarrier b2_; b2_.bar = WSP(unsigned, WS_CTL) + CW_BAR; b2_.x = bar.x; b2_.st = bar.st; xcd_barrier(b2_); } } while (0)

#define OPQ_S(x) ({ int _t = (x); asm volatile("" : "+s"(_t)); _t; })
#define OPQ_V(x) ({ int _t = (x); asm volatile("" : "+v"(_t)); _t; })
#define INP(i) (args.in[OPQ_S(i)])
#define WSP(T, off) ((T*)(args.ws + ({ size_t _o = (off); asm volatile("" : "+s"(_o)); _o; })))
#define x_in INP(0)
#define c_in INP(1)
#define ctx_in INP(2)
#define cctx_in INP(3)
#define w_mod INP(4)
#define b_mod INP(5)
#define w_in INP(6)
#define w_out INP(7)
#define pool_w INP(8)
#define pool_scale INP(9)
#define na_qg INP(10)
#define na_kg INP(11)
#define na_rpb INP(12)
#define rw_mu_rkv INP(13)
#define rw_mu_lora INP(14)
#define rw_w0 INP(15)
#define rw_w_up INP(16)
#define rw_a0 INP(17)
#define rw_a_up INP(18)
#define rw_k_k INP(19)
#define rw_k_a INP(20)
#define rw_r_k INP(21)
#define rw_ln_w INP(22)
#define rw_ln_b INP(23)
#define sg_ln_w INP(24)
#define sg_ln_b INP(25)
#define sg_w INP(26)
#define sg_b INP(27)
#define MOD WSP(float, WS_MOD)
#define MODP WSP(float, WS_MODP)
#define TAB WSP(f32x2, WS_TAB)
#define SGST WSP(f32x2, WS_SGST)
#define BON WSP(float, WS_BON)
#define POOLWT WSP(bf16, WS_POOLWT)
#define WUPT WSP(bf16, WS_WUPT)
#define AUPT WSP(bf16, WS_AUPT)
#define SGW WSP(bf16, WS_SGW)
#define VTC WSP(bf16, WS_VTC)
#define VTL WSP(bf16, WS_VTL)
#define HCTX WSP(float, WS_HCTX)
#define QN WSP(bf16, WS_QN)
#define KN WSP(bf16, WS_KN)
#define WOUTT WSP(bf16, WS_WOUTT)
#define WINT WSP(bf16, WS_WINT)
#define XN WSP(bf16, WS_XN)
#define Y WSP(bf16, WS_Y)
#define P WSP(bf16, WS_P)
#define YR WSP(float, WS_YR)
#define REC WSP(float, WS_REC)
    float* const out = args.out;

    if (IN(0)) {
        LAS float* scr = (LAS float*)(lds + wave * 16384);
        constexpr int I_MOD = 4 * 64 * 48, I_WIN = 64 * (NIN / 32), I_WOUT = 64 * 128, I_POOL = 4 * 32, I_WUP = 2 * 32, I_AUP = 2 * 32, I_SGW = 256;
        constexpr int NITEMS = I_MOD + I_WIN + I_WOUT + I_POOL + I_WUP + I_AUP + I_SGW;
        for (int it = gw; it < NITEMS; it += NGW) {
            int r = it;
            if (r < I_MOD) { p0_mod_item(w_mod, c_in, cctx_in, MODP, scr, r, lane); continue; } r -= I_MOD;
            if (r < I_WIN) { p0_transpose_item(w_in, DM, NIN, WINT, scr, r, lane); continue; } r -= I_WIN;
            if (r < I_WOUT) { p0_transpose_item(w_out, DM, DM, WOUTT, scr, r, lane); continue; } r -= I_WOUT;
            if (r < I_POOL) { const int g = r / 32; p0_transpose_item(pool_w + (size_t)g * 65536, 256, 256, POOLWT + (size_t)g * 65536, scr, r % 32, lane); continue; } r -= I_POOL;
            if (r < I_WUP) { const int dd = r / 32; p0_transpose_item(rw_w_up + (size_t)dd * 65536, 64, 1024, WUPT + (size_t)dd * 65536, scr, r % 32, lane); continue; } r -= I_WUP;
            if (r < I_AUP) { const int dd = r / 32; p0_transpose_item(rw_a_up + (size_t)dd * 65536, 64, 1024, AUPT + (size_t)dd * 65536, scr, r % 32, lane); continue; } r -= I_AUP;
            {   const size_t e0 = (size_t)r * 512 + lane * 8; const f32x4 a = *(const f32x4*)(sg_w + e0), b = *(const f32x4*)(sg_w + e0 + 4);
                v4u o; o.x = pk2(a.x, a.y); o.y = pk2(a.z, a.w); o.z = pk2(b.x, b.y); o.w = pk2(b.z, b.w); *(v4u*)(SGW + e0) = o; }
        }
        SEAM(0);
    }
    if (IN(1)) {
        for (int idx = gw * 64 + lane; idx < 4 * 3 * 12288; idx += NGW * 64) {
            const int l = idx / 36864, c = (idx / 12288) % 3, n = idx % 12288;
            float s = b_mod[l * 12288 + n];
            const float* pp = MODP + ((size_t)(l * 64) * 3 + c) * 12288 + n;
#pragma unroll 8
            for (int kc = 0; kc < 64; ++kc) s += pp[(size_t)kc * 3 * 12288];
            MOD[idx] = s;
        }
        for (int idx = gw * 64 + lane; idx < 2048; idx += NGW * 64) {
            const int pos = idx >> 4, i = idx & 15;
            float inv = (i & 3) == 0 ? 1.0f : ((i & 3) == 1 ? 0.5623413251903491f : ((i & 3) == 2 ? 0.31622776601683794f : 0.17782794100389228f));
            inv *= (i >> 2) == 0 ? 1.0f : ((i >> 2) == 1 ? 0.1f : ((i >> 2) == 2 ? 0.01f : 0.001f));
            float cc, sn; sincos_acc((float)pos * inv, cc, sn);
            TAB[idx] = (f32x2){cc, sn};
        }
        SEAM(1);
    }
    for (int l = 0; l < DEPTH; ++l) {
        const int pb = 2 + PPL * l;
        const bool with_ctx = l < DEPTH - 1;
#define hin_lat (l == 0 ? x_in : (const float*)out)
#define hin_ctx (l == 0 ? ctx_in : (const float*)HCTX)
#define mod (MOD + (size_t)l * 3 * 12288)
        const int nrows = with_ctx ? MROWS : NLAT;
        if (IN(pb + 0)) {
            for (int rep = 0; rep < REP_XN; ++rep)
            phase_xn(hin_lat, hin_ctx, mod, XN, OPQ_S(gw), NGW, OPQ_V(lane));
            SEAM(pb + 0);
        }
        if (IN(pb + 1)) {
            constexpr int C0 = 5632, NA_ = NIN - C0;
            pg8::Gemm g{XN, WINT + (size_t)l * NIN * DM + (size_t)C0 * DM, MROWS, NA_, DM}; pg8::StaticOrder S; S.init(MROWS, NA_, G, bx);
            pg8::EpiStoreBf16 E{P + C0, NIN};
            pg8::gemm_phase<pg8::EpiStoreBf16, pg8::StaticOrder, true, true>(lds, g, S, E);
            SEAM(pb + 1);
        }
        if (IN(pb + 2)) {
            if (bx >= RWP_BLOCKS) {
                constexpr int NB_ = 5632;
                pg8::Gemm g{XN, WINT + (size_t)l * NIN * DM, MROWS, NB_, DM}; pg8::StaticOrder S; S.init(MROWS, NB_, G - RWP_BLOCKS, bx - RWP_BLOCKS);
                pg8::EpiStoreBf16 E{P, NIN};
                pg8::gemm_phase<pg8::EpiStoreBf16, pg8::StaticOrder, true, true>(lds, g, S, E);
            }
            phase_rwprep(P, rw_mu_rkv + (size_t)l * 6144, rw_mu_lora + (size_t)l * 256, rw_w0 + (size_t)l * 2048, WUPT + (size_t)l * 131072, rw_a0 + (size_t)l * 2048, AUPT + (size_t)l * 131072,
                         rw_k_k + (size_t)l * 1024, rw_k_a + (size_t)l * 1024, rw_r_k + (size_t)l * 1024, REC, BON, lds, WSP(unsigned, WS_CTL) + CW_RWQ + l * 1024, (bx * NWAVES + wave) & 15, wave, OPQ_V(lane));
            SEAM(pb + 2);
        }
        if (IN(pb + 3)) {
            phase_rowprep(P, na_qg + l * 64, na_kg + l * 64, TAB, QN, KN, SGST, OPQ_S(gw), NGW, OPQ_V(lane));
            phase_vt(P, VTL, VTC, OPQ_S(gw), NGW, OPQ_V(lane));
            SEAM(pb + 3);
        }
        if (IN(pb + 4)) {
            phase_sgu(P, SGST, sg_ln_w + (size_t)l * 1024, sg_ln_b + (size_t)l * 1024, SGW + (size_t)l * 131072, sg_b + (size_t)l * 1024, Y, lds, nrows / 128, OPQ_V(tid), wave, OPQ_V(lane));
            LAS unsigned* mixq = (LAS unsigned*)(lds + LDSCTL_OFF + 64); LAS unsigned* mixb = (LAS unsigned*)(lds + LDSCTL_OFF + 128);
            if (tid == 0) { *mixq = 0u; *mixb = 0u; }
            __syncthreads();
            if (wave < 4) scan_self(REC, YR, lds, mixb, bx, wave, OPQ_V(lane));
            {   const int nctxu = with_ctx ? 2 : 0, npool = (nrows / 16) * 4, npq = (npool + NGRID - 1) / NGRID, nwc = l + 1 < DEPTH ? (WC_ITEMS + NGRID - 1) / NGRID : 0, nq = 64 + nctxu + npq + nwc;
                for (;;) {
                    unsigned k = 0; if (lane == 0) k = __hip_atomic_fetch_add(mixq, 1u, __ATOMIC_RELAXED, __HIP_MEMORY_SCOPE_WORKGROUP);
                    k = (unsigned)__builtin_amdgcn_readfirstlane((int)k);
                    if ((int)k >= nq) break;
                    const int ln = OPQ_V(lane);
                    if (k < 64u) { na_unit<false>(QN, KN, VTL, VTC, P, na_rpb + (size_t)l * 16 * 15 * 31, Y, bx * 64 + (int)k, ln);
#ifdef PROBE_NA2
                        na_unit<false>(QN, KN, VTL, VTC, P, na_rpb + (size_t)l * 16 * 15 * 31, Y, bx * 64 + (int)k, OPQ_V(ln));
#endif
                    }
                    else if ((int)k < 64 + nctxu) na_unit<true>(QN, KN, VTL, VTC, P, na_rpb, Y, bx * 2 + ((int)k - 64), ln);
                    else if ((int)k >= 64 + nctxu + npq) { const int r = bx + NGRID * ((int)k - 64 - nctxu - npq);
                        if (r < WC_ITEMS) weight_copy_item(l + 1, r, w_in, w_out, pool_w, rw_w_up, rw_a_up, sg_w, WINT, WOUTT, POOLWT, WUPT, AUPT, SGW, ln); }
                    else { const int u = bx + NGRID * ((int)k - 64 - nctxu);
                        if (u < npool) { const int tt = u >> 2, g = u & 3; const bf16* wbase = POOLWT + (size_t)l * 262144 + (size_t)g * 65536; const float* psc = pool_scale + (size_t)l * 1024;
                            if (g == 0) pool_unit<0>(P, wbase, psc, Y, tt * 16, ln); else if (g == 1) pool_unit<1>(P, wbase, psc, Y, tt * 16, ln);
                            else if (g == 2) pool_unit<2>(P, wbase, psc, Y, tt * 16, ln); else pool_unit<3>(P, wbase, psc, Y, tt * 16, ln); } }
                }
            }
            SEAM(pb + 4);
        }
        if (IN(pb + 5)) {
            for (int rep = 0; rep < REP_FIN; ++rep)
            phase_rwfin(P, YR, REC, BON, rw_ln_w + (size_t)l * 1024, rw_ln_b + (size_t)l * 1024, Y, nrows, OPQ_S(gw), NGW, OPQ_V(lane));
            SEAM(pb + 5);
        }
        if (IN(pb + 6)) {
            pg8::Gemm g{Y, WOUTT + (size_t)l * DM * DM, nrows, DM, DM}; pg8::StaticOrder S; S.init(nrows, DM, G, bx);
            pg8::EpiResGate E{hin_lat, hin_ctx, out, HCTX, mod};
            pg8::gemm_phase<pg8::EpiResGate, pg8::StaticOrder, true, true>(lds, g, S, E);
            SEAM(pb + 6);
        }
    }
#undef IN
#undef SEAM
}
#undef hin_lat
#undef hin_ctx
#undef mod
#undef P
#undef Y
#undef XN
#undef out

extern "C" void kernel_launch(void* const* d_in, const int* in_sizes, int n_in, void* d_out, int out_size, void* d_ws, size_t ws_size, hipStream_t stream) {
    static int grid = 0;
    if (grid == 0) {
        if (n_in != 28 || out_size != NLAT * DM || ws_size < WS_END) { fprintf(stderr, "kernel_launch: unexpected shapes (n_in %d, out %d, ws %zu < %zu); nothing launched\n", n_in, out_size, ws_size, (size_t)WS_END); grid = -1; return; }
        int dev = 0, cus = 0, per_cu = 0;
        if (hipGetDevice(&dev) != hipSuccess || hipDeviceGetAttribute(&cus, hipDeviceAttributeMultiprocessorCount, dev) != hipSuccess) { grid = -1; return; }
        if (hipFuncSetAttribute((const void*)fwd, hipFuncAttributeMaxDynamicSharedMemorySize, LDS_BYTES) != hipSuccess) { fprintf(stderr, "kernel_launch: hipFuncSetAttribute failed\n"); grid = -1; return; }
        if (hipOccupancyMaxActiveBlocksPerMultiprocessor(&per_cu, (const void*)fwd, NWAVES * 64, LDS_BYTES) != hipSuccess || per_cu < 1)
            fprintf(stderr, "kernel_launch: note: occupancy query reports %d workgroups per CU\n", per_cu);
        (void)hipGetLastError();
        grid = cus >= NGRID ? NGRID : -2;
    }
    if (grid == -1) return;
    if (hipMemsetAsync((char*)d_ws + WS_CTL, 0, CTL_ZERO_BYTES, stream) != hipSuccess) { fprintf(stderr, "kernel_launch: memset failed\n"); return; }
    Args a{};
    for (int i = 0; i < 28; ++i) a.in[i] = (const float*)d_in[i];
    a.out = (float*)d_out; a.ws = (unsigned char*)d_ws; a.li = 0; a.pad = 0;
    const bool split = MK_SPLIT || grid == -2;
    if (split) { for (int k = 0; k < NPHASE; ++k) { a.ph_lo = k; a.ph_hi = k + 1; hipLaunchKernelGGL(fwd, dim3(NGRID), dim3(NWAVES * 64), LDS_BYTES, stream, a); } }
    else { a.ph_lo = 0; a.ph_hi = NPHASE; hipLaunchKernelGGL(fwd, dim3(NGRID), dim3(NWAVES * 64), LDS_BYTES, stream, a); }
    const hipError_t le = hipPeekAtLastError();
    if (le != hipSuccess) fprintf(stderr, "kernel_launch: launch failed: %s\n", hipGetErrorName(le));
}
```

```cpp
#include <hip/hip_runtime.h>
#include <cstdio>
#include <cstdint>
#define MK_SPLIT 0
#define REC_NT 1
namespace pg8 {
#define PG8_LAS __attribute__((address_space(3)))
typedef unsigned short bf16_t;
typedef short bf16x8 __attribute__((ext_vector_type(8)));
typedef float f32x4 __attribute__((ext_vector_type(4)));
typedef unsigned u32x4 __attribute__((ext_vector_type(4)));
constexpr int BM = 256, BK = 64, HALF = 128, HTB = HALF * BK * 2  , STAGE_BYTES = 8 * HTB, NXCD = 8, WGM = 8;

__host__ __device__ __forceinline__ int lds_byte(int r, int c) { const int st = (r >> 4) * 2 + (c >> 5), rr = r & 15, cc = c & 31, ob = rr * 64 + cc * 2; return st * 1024 + (ob ^ (((ob >> 9) & 1) << 5)); }
__host__ __device__ __forceinline__ void stage_rc(int b, int& R, int& C) { const int st = b / 1024, sb = b % 1024, swz = sb ^ (((sb >> 9) & 1) << 5); R = (st >> 1) * 16 + swz / 64; C = (st & 1) * 32 + (swz % 64) / 2; }
__host__ __device__ __forceinline__ int perm32(int rho) { const int n = rho >> 4, i = rho & 15; return 8 * (i >> 2) + 4 * n + (i & 3); }

struct Unit { int pm, pn; };
struct Gemm { const bf16_t* A; const bf16_t* Bt; int M, N, K; };

struct StaticOrder {
    int nM, nN, nwg, G, c;
    __host__ __device__ void init(int M, int N, int G_, int c_) { nM = M / BM; nN = N / BM; nwg = nM * nN; G = G_; c = c_; }
    __host__ __device__ bool next(int i, Unit& u) const {
        const long L = (long)i * G + c; if (L >= nwg) return false;
        int wgid = (int)L; { const int q = nwg / NXCD, r = nwg % NXCD, xcd = wgid % NXCD, off = wgid / NXCD; wgid = (xcd < r ? xcd * (q + 1) : r * (q + 1) + (xcd - r) * q) + off; }
        const int nig = WGM * nN, gid = wgid / nig, fm = gid * WGM, gsz = (nM - fm) < WGM ? (nM - fm) : WGM;
        u.pm = fm + ((wgid % nig) % gsz); u.pn = (wgid % nig) / gsz; return true;
    }
    __device__ __forceinline__ void a_ready(const Unit&) const {}
    __device__ __forceinline__ void done(const Unit&) const {}
};

__device__ __forceinline__ unsigned cvt_pk_bf16(float lo, float hi) { unsigned r; asm volatile("v_cvt_pk_bf16_f32 %0, %1, %2" : "=v"(r) : "v"(lo), "v"(hi)); return r; }
template <class Epi, class Sched, bool ALIGN_EPI = false, bool SP2 = false>
__device__ __forceinline__ void gemm_phase(PG8_LAS unsigned char* lds, const Gemm g, const Sched& S, const Epi& E) {
    int tid_ = threadIdx.x; asm volatile("" : "+v"(tid_));
    const int tid = tid_, wid = __builtin_amdgcn_readfirstlane(tid >> 6), lane = tid & 63, wr = wid >> 2, wc = wid & 3, fr = lane & 15, fq = lane >> 4;
    const int K = g.K, nt = K / BK;
    unsigned voffA[2], voffB[2];
#pragma unroll
    for (int i = 0; i < 2; ++i) { int R, C; stage_rc(tid * 16 + i * 8192, R, C); const int Rb = Epi::PERM ? ((R & ~31) + perm32(R & 31)) : R;
        voffA[i] = (unsigned)(R * K + C) * 2u; voffB[i] = (unsigned)(Rb * K + C) * 2u; }
    const size_t kstep = (size_t)(BK * 2);
    const size_t hstep = (size_t)HALF * K * 2;
    const size_t tstep = 2 * hstep;
    const unsigned ldsw = (unsigned)wid * 1024u;
    const int aoff = lds_byte(wr * 64 + fr, fq * 8), boff = lds_byte(wc * 32 + fr, fq * 8);
#define PG8_SA(b, h) (((b) * 2 + (h)) * HTB)
#define PG8_SB(b, h) ((4 + (b) * 2 + (h)) * HTB)
#define PG8_STAGE(bufoff, gbase, voff) do { _Pragma("unroll") for (int _i = 0; _i < 2; ++_i) \
        __builtin_amdgcn_global_load_lds((const unsigned*)((const char*)(gbase) + (voff)[_i]), (PG8_LAS unsigned*)(lds + (bufoff) + ldsw + _i * 8192), 16, 0, 0); } while (0)
#define PG8_LDA(dst, b, h) do { _Pragma("unroll") for (int m = 0; m < 4; ++m) _Pragma("unroll") for (int k = 0; k < 2; ++k) dst[m][k] = *(const PG8_LAS bf16x8*)(lds + PG8_SA(b, h) + aoff + m * 2048 + k * 1024); } while (0)
#define PG8_LDB(dst, b, h) do { _Pragma("unroll") for (int n = 0; n < 2; ++n) _Pragma("unroll") for (int k = 0; k < 2; ++k) dst[n][k] = *(const PG8_LAS bf16x8*)(lds + PG8_SB(b, h) + boff + n * 2048 + k * 1024); } while (0)
#define PG8_MMA(ai, bj, At, Bt) do { __builtin_amdgcn_s_setprio(1); _Pragma("unroll") for (int m = 0; m < 4; ++m) _Pragma("unroll") for (int n = 0; n < 2; ++n) _Pragma("unroll") for (int k = 0; k < 2; ++k) \
        acc[ai][bj][m][n] = __builtin_amdgcn_mfma_f32_16x16x32_bf16(Bt[n][k], At[m][k], acc[ai][bj][m][n], 0, 0, 0); __builtin_amdgcn_s_setprio(0); } while (0)
#define PG8_WAIT_V(n) asm volatile("s_waitcnt vmcnt(" #n ")" ::: "memory")
#define PG8_WAIT_L(n) asm volatile("s_waitcnt lgkmcnt(" #n ")" ::: "memory")
#define PG8_BAR __builtin_amdgcn_s_barrier()
#define PG8_SCHED __builtin_amdgcn_sched_barrier(0)
    Unit cur, nxt; int ui = 0;
    if (!S.next(0, cur)) return;
    f32x4 acc[2][2][4][2];
#pragma unroll
    for (int a = 0; a < 2; ++a)
#pragma unroll
        for (int b = 0; b < 2; ++b)
#pragma unroll
            for (int m = 0; m < 4; ++m)
#pragma unroll
                for (int n = 0; n < 2; ++n) acc[a][b][m][n] = (f32x4){0.f, 0.f, 0.f, 0.f};
    bf16x8 At[4][2], B0[2][2], B1[2][2];
    const char* cA = (const char*)g.A + (size_t)cur.pm * tstep; const char* cB = (const char*)g.Bt + (size_t)cur.pn * tstep;
    S.a_ready(cur);
    if constexpr (SP2) {
        PG8_STAGE(PG8_SB(0, 0), cB, voffB); PG8_STAGE(PG8_SB(0, 1), cB + hstep, voffB); PG8_STAGE(PG8_SA(0, 0), cA, voffA); PG8_STAGE(PG8_SA(0, 1), cA + hstep, voffA);
        if (wr == 1) PG8_BAR;
        PG8_WAIT_V(2); PG8_BAR;
        PG8_STAGE(PG8_SB(1, 0), cB + kstep, voffB); PG8_STAGE(PG8_SA(1, 0), cA + kstep, voffA); PG8_STAGE(PG8_SB(1, 1), cB + hstep + kstep, voffB);
        PG8_WAIT_V(6); PG8_BAR;
    } else {
        PG8_STAGE(PG8_SB(0, 0), cB, voffB); PG8_STAGE(PG8_SA(0, 0), cA, voffA); PG8_STAGE(PG8_SB(0, 1), cB + hstep, voffB); PG8_STAGE(PG8_SA(0, 1), cA + hstep, voffA);
        if (wr == 1) PG8_BAR;
        PG8_WAIT_V(4); PG8_BAR;
        PG8_STAGE(PG8_SB(1, 0), cB + kstep, voffB); PG8_STAGE(PG8_SA(1, 0), cA + kstep, voffA); PG8_STAGE(PG8_SB(1, 1), cB + hstep + kstep, voffB);
        PG8_WAIT_V(6); PG8_BAR;
    }
    for (;;) {
        const bool has_next = S.next(ui + 1, nxt);
        const char* nA = has_next ? (const char*)g.A + (size_t)nxt.pm * tstep : cA; const char* nB = has_next ? (const char*)g.Bt + (size_t)nxt.pn * tstep : cB;
        for (int t = 0; t < nt; t += 2) {
            const bool last = (t == nt - 2);
            const char* a1 = cA + (size_t)(t + 1) * kstep;
            const char* a2 = last ? nA : cA + (size_t)(t + 2) * kstep; const char* b2 = last ? nB : cB + (size_t)(t + 2) * kstep;
            const char* a3 = a2 + kstep; const char* b3 = b2 + kstep;
            if (last && has_next) S.a_ready(nxt);
            if constexpr (SP2) {
            PG8_LDB(B0, 0, 0); PG8_LDB(B1, 0, 1); PG8_SCHED; PG8_LDA(At, 0, 0); PG8_STAGE(PG8_SA(1, 1), a1 + hstep, voffA);
            PG8_WAIT_V(8); PG8_WAIT_L(0); PG8_BAR; PG8_MMA(0, 0, At, B0); PG8_MMA(0, 1, At, B1); PG8_BAR; PG8_SCHED;
            PG8_LDA(At, 0, 1); PG8_STAGE(PG8_SB(0, 0), b2, voffB); PG8_STAGE(PG8_SB(0, 1), b2 + hstep, voffB); PG8_STAGE(PG8_SA(0, 0), a2, voffA);
            PG8_WAIT_V(8); PG8_WAIT_L(0); PG8_BAR; PG8_MMA(1, 0, At, B0); PG8_MMA(1, 1, At, B1); PG8_BAR; PG8_SCHED;
            PG8_LDB(B0, 1, 0); PG8_LDB(B1, 1, 1); PG8_SCHED; PG8_LDA(At, 1, 0); PG8_STAGE(PG8_SA(0, 1), a2 + hstep, voffA);
            PG8_WAIT_V(8); PG8_WAIT_L(0); PG8_BAR; PG8_MMA(0, 0, At, B0); PG8_MMA(0, 1, At, B1); PG8_BAR; PG8_SCHED;
            PG8_LDA(At, 1, 1); PG8_STAGE(PG8_SB(1, 0), b3, voffB); PG8_STAGE(PG8_SB(1, 1), b3 + hstep, voffB); PG8_STAGE(PG8_SA(1, 0), a3, voffA);
            PG8_WAIT_V(8); PG8_WAIT_L(0); PG8_BAR; PG8_MMA(1, 0, At, B0); PG8_MMA(1, 1, At, B1); PG8_BAR; PG8_SCHED;
            } else {
            PG8_LDB(B0, 0, 0); PG8_SCHED; PG8_LDA(At, 0, 0); PG8_STAGE(PG8_SA(1, 1), a1 + hstep, voffA);
            PG8_WAIT_L(8); PG8_BAR; PG8_WAIT_L(0); PG8_MMA(0, 0, At, B0); PG8_BAR; PG8_SCHED;
            PG8_LDB(B1, 0, 1); PG8_STAGE(PG8_SB(0, 0), b2, voffB);
            PG8_BAR; PG8_WAIT_L(0); PG8_MMA(0, 1, At, B1); PG8_BAR;
            PG8_LDA(At, 0, 1); PG8_STAGE(PG8_SA(0, 0), a2, voffA);
            PG8_BAR; PG8_WAIT_L(0); PG8_MMA(1, 0, At, B0); PG8_BAR; PG8_SCHED;
            PG8_STAGE(PG8_SB(0, 1), b2 + hstep, voffB);
            PG8_WAIT_V(6); PG8_BAR; PG8_MMA(1, 1, At, B1); PG8_BAR;
            PG8_LDB(B0, 1, 0); PG8_SCHED; PG8_LDA(At, 1, 0); PG8_STAGE(PG8_SA(0, 1), a2 + hstep, voffA);
            PG8_WAIT_L(8); PG8_BAR; PG8_WAIT_L(0); PG8_MMA(0, 0, At, B0); PG8_BAR; PG8_SCHED;
            PG8_LDB(B1, 1, 1); PG8_STAGE(PG8_SB(1, 0), b3, voffB);
            PG8_BAR; PG8_WAIT_L(0); PG8_MMA(0, 1, At, B1); PG8_BAR;
            PG8_LDA(At, 1, 1); PG8_STAGE(PG8_SA(1, 0), a3, voffA);
            PG8_BAR; PG8_WAIT_L(0); PG8_MMA(1, 0, At, B0); PG8_BAR; PG8_SCHED;
            PG8_STAGE(PG8_SB(1, 1), b3 + hstep, voffB);
            PG8_WAIT_V(6); PG8_BAR; PG8_MMA(1, 1, At, B1); PG8_BAR;
            }
        }
        if constexpr (ALIGN_EPI) { if (wr == 0) PG8_BAR; }
        if constexpr (!Epi::AFTER_DRAIN) { E(acc, cur, wr, wc, fr, fq); S.done(cur); }
        if (!has_next) break;
#pragma unroll
        for (int a = 0; a < 2; ++a)
#pragma unroll
            for (int b = 0; b < 2; ++b)
#pragma unroll
                for (int m = 0; m < 4; ++m)
#pragma unroll
                    for (int n = 0; n < 2; ++n) acc[a][b][m][n] = (f32x4){0.f, 0.f, 0.f, 0.f};
        cur = nxt; cA = nA; cB = nB; ++ui;
        if constexpr (ALIGN_EPI) { if (wr == 1) PG8_BAR; }
    }
    PG8_WAIT_V(0);
    if constexpr (!ALIGN_EPI) { if (wr == 0) PG8_BAR; }
    PG8_BAR;
    if constexpr (Epi::AFTER_DRAIN) { E.fused(acc, cur, wr, wc, fr, fq, lds, wid, lane); S.done(cur); }
#undef PG8_SA
#undef PG8_SB
#undef PG8_STAGE
#undef PG8_LDA
#undef PG8_LDB
#undef PG8_MMA
#undef PG8_WAIT_V
#undef PG8_WAIT_L
#undef PG8_BAR
#undef PG8_SCHED
}
}

constexpr int DM = 4096, NBATCH = 2, SEQ = 8192, DEPTH = 4, CTXL = 256;
constexpr int NLAT = NBATCH * SEQ, NCTX = NBATCH * CTXL, MROWS = NLAT + NCTX;
constexpr int NIN = 13568, GWD = 1024;
constexpr int C_POOLV = 0, C_POOLZ = 1024, C_NAQ = 2048, C_NAK = 3072, C_NAV = 4096, C_NAZ = 5120, C_RWR = 6144, C_RWK = 7168, C_RWV = 8192, C_RWZ = 9216,
              C_RWWD = 10240, C_RWAD = 10368, C_SGU = 10496, C_SGV = 11520, C_SGZ = 12544;
constexpr int SCANLEN = CTXL + SEQ;
constexpr int NCHAIN = 64;
constexpr int RECB = 896;
constexpr int RECF = RECB / 4;
constexpr int NWAVES = 8;

constexpr size_t MiB = 1u << 20;
constexpr size_t WS_CTL = 0, CTL_ZERO_BYTES = 1 * MiB;
constexpr size_t WS_MOD   = 2 * MiB;
constexpr size_t WS_TAB   = 3 * MiB;
constexpr size_t WS_SGST  = 4 * MiB;
constexpr size_t WS_BON   = 5 * MiB;
constexpr size_t WS_POOLWT= 8 * MiB;
constexpr size_t WS_WUPT  = 10 * MiB;
constexpr size_t WS_AUPT  = 11 * MiB;
constexpr size_t WS_SGW   = 12 * MiB;
constexpr size_t WS_VTC   = 13 * MiB;
constexpr size_t WS_HCTX  = 14 * MiB;
constexpr size_t WS_MODP  = 22 * MiB;
constexpr size_t WS_VTL   = 58 * MiB;
constexpr size_t WS_QN    = 90 * MiB;
constexpr size_t WS_KN    = 123 * MiB;
constexpr size_t WS_WOUTT = 156 * MiB;
constexpr size_t WS_WINT  = 284 * MiB;
constexpr size_t WS_XN    = 708 * MiB;
constexpr size_t WS_Y     = 840 * MiB;
constexpr size_t WS_P     = 972 * MiB;
constexpr size_t WS_YR    = 1410 * MiB;
constexpr size_t WS_REC   = 1542 * MiB;
constexpr size_t WS_END   = 2334 * MiB;
static_assert(WS_P + (size_t)MROWS * NIN * 2 <= WS_YR && WS_REC + (size_t)NCHAIN * SCANLEN * RECB <= WS_END && WS_WINT + (size_t)4 * NIN * DM * 2 <= WS_XN, "ws map");
constexpr int CW_TMO = 0, CW_BAR = 4096;

constexpr int RING_BYTES = 131072, LDSCTL_OFF = RING_BYTES, MISC_OFF = LDSCTL_OFF + 320, LDS_BYTES = 147456;

#define GAS __attribute__((address_space(1)))
#define LAS __attribute__((address_space(3)))
typedef unsigned short bf16;
typedef unsigned v4u __attribute__((ext_vector_type(4)));
typedef unsigned v2u __attribute__((ext_vector_type(2)));
typedef float f32x4 __attribute__((ext_vector_type(4)));
typedef float f32x2 __attribute__((ext_vector_type(2)));
typedef short bf16x8 __attribute__((ext_vector_type(8)));
typedef _Float16 h4 __attribute__((ext_vector_type(4)));
typedef _Float16 h8 __attribute__((ext_vector_type(8)));
#define RLX_AGENT __ATOMIC_RELAXED, __HIP_MEMORY_SCOPE_AGENT
#define LDS_WAIT() asm volatile("s_waitcnt lgkmcnt(0)" ::: "memory")

__device__ __forceinline__ float bf2f(unsigned short h) { return __uint_as_float(((unsigned)h) << 16); }
__device__ __forceinline__ float bflo(unsigned w) { return __uint_as_float(w << 16); }
__device__ __forceinline__ float bfhi(unsigned w) { return __uint_as_float(w & 0xffff0000u); }
typedef __bf16 bf16x2_t __attribute__((ext_vector_type(2)));
__device__ __forceinline__ unsigned pk2(float lo, float hi) { const f32x2 v = {lo, hi}; const bf16x2_t b = __builtin_convertvector(v, bf16x2_t); return __builtin_bit_cast(unsigned, b); }
__device__ __forceinline__ unsigned f2bf(float f) { return pk2(f, 0.f) & 0xffffu; }
__device__ __forceinline__ float rcp_f(float x) { return __builtin_amdgcn_rcpf(x); }
__device__ __forceinline__ float rsq_f(float x) { return __builtin_amdgcn_rsqf(x); }
__device__ __forceinline__ void unpack8(const v4u w, float* x) { x[0] = bflo(w.x); x[1] = bfhi(w.x); x[2] = bflo(w.y); x[3] = bfhi(w.y); x[4] = bflo(w.z); x[5] = bfhi(w.z); x[6] = bflo(w.w); x[7] = bfhi(w.w); }
__device__ __forceinline__ v4u pack8(const float* x) { v4u w; w.x = pk2(x[0], x[1]); w.y = pk2(x[2], x[3]); w.z = pk2(x[4], x[5]); w.w = pk2(x[6], x[7]); return w; }
__device__ __forceinline__ float silu_f(float x) { return x * rcp_f(1.f + __expf(-x)); }
__device__ __forceinline__ float wave_sum(float v) {
#pragma unroll
    for (int o = 1; o < 64; o <<= 1) v += __shfl_xor(v, o);
    return v;
}
template <int CTRL> __device__ __forceinline__ float dppf(float v) { return __builtin_bit_cast(float, __builtin_amdgcn_update_dpp(0, __builtin_bit_cast(int, v), CTRL, 0xF, 0xF, true)); }
__device__ __forceinline__ float red16(float v) { v += dppf<0xB1>(v); v += dppf<0x4E>(v); v += dppf<0x141>(v); v += dppf<0x140>(v); return v; }
__device__ __forceinline__ void red16x2(float& a, float& b) {
    a += dppf<0xB1>(a); b += dppf<0xB1>(b); a += dppf<0x4E>(a); b += dppf<0x4E>(b); a += dppf<0x141>(a); b += dppf<0x141>(b); a += dppf<0x140>(a); b += dppf<0x140>(b); }
__device__ __forceinline__ float red16_transpose(const float (&y)[16], int c16) {
    float a[8], b[4], c[2];
    const bool h8 = (c16 & 8) != 0, h4 = (c16 & 4) != 0, h2 = (c16 & 2) != 0, h1 = (c16 & 1) != 0;
#pragma unroll
    for (int j = 0; j < 8; ++j) { const float keep = h8 ? y[j + 8] : y[j], send = h8 ? y[j] : y[j + 8]; a[j] = keep + dppf<0x140>(send); }
#pragma unroll
    for (int j = 0; j < 4; ++j) { const float keep = h4 ? a[j + 4] : a[j], send = h4 ? a[j] : a[j + 4]; b[j] = keep + dppf<0x141>(send); }
#pragma unroll
    for (int j = 0; j < 2; ++j) { const float keep = h2 ? b[j + 2] : b[j], send = h2 ? b[j] : b[j + 2]; c[j] = keep + dppf<0x1B>(send); }
    const float keep = h1 ? c[1] : c[0], send = h1 ? c[0] : c[1];
    return keep + dppf<0xB1>(send);
}
__device__ __forceinline__ float max16x4(float v) { v = fmaxf(v, __shfl_xor(v, 16)); v = fmaxf(v, __shfl_xor(v, 32)); return v; }
__device__ __forceinline__ float sum16x4(float v) { v += __shfl_xor(v, 16); v += __shfl_xor(v, 32); return v; }
__device__ __forceinline__ int scan_pos(int d, bool isctx, int t) { return d == 0 ? (isctx ? t : CTXL + t) : (isctx ? (CTXL - 1 - t) : (CTXL + SEQ - 1 - t)); }
__device__ __forceinline__ f32x4 mfma16(bf16x8 a, bf16x8 b, f32x4 c) { return __builtin_amdgcn_mfma_f32_16x16x32_bf16(a, b, c, 0, 0, 0); }
__device__ __forceinline__ bf16x8 ld_frag(const bf16* p) { return __builtin_bit_cast(bf16x8, *(const v4u*)p); }

namespace pg8 {
struct EpiStoreBf16 {
    static constexpr bool PERM = true, AFTER_DRAIN = false;
    bf16_t* O; int ldc;
    __device__ __forceinline__ void operator()(const f32x4 (&acc)[2][2][4][2], const Unit& u, int wr, int wc, int fr, int fq) const {
        const int row0 = u.pm * BM + wr * 64 + fr, col0 = u.pn * BM + wc * 32 + 8 * fq;
#pragma unroll
        for (int ai = 0; ai < 2; ++ai)
#pragma unroll
            for (int m = 0; m < 4; ++m) { bf16_t* rowp = O + (size_t)(row0 + ai * HALF + m * 16) * ldc + col0;
#pragma unroll
                for (int bj = 0; bj < 2; ++bj) { const f32x4 v0 = acc[ai][bj][m][0], v1 = acc[ai][bj][m][1];
                    u32x4 w; w.x = cvt_pk_bf16(v0[0], v0[1]); w.y = cvt_pk_bf16(v0[2], v0[3]); w.z = cvt_pk_bf16(v1[0], v1[1]); w.w = cvt_pk_bf16(v1[2], v1[3]);
                    *(u32x4*)(rowp + bj * HALF) = w; } }
    }
};
struct EpiResGate {
    static constexpr bool PERM = false, AFTER_DRAIN = false;
    const float* hin_lat; const float* hin_ctx; float* hout_lat; float* hout_ctx; const float* gate;
    __device__ __forceinline__ void operator()(const f32x4 (&acc)[2][2][4][2], const Unit& u, int wr, int wc, int fr, int fq) const {
        const int cond = u.pm < 32 ? 0 : (u.pm < 64 ? 1 : 2);
        const int rloc = (u.pm < 64 ? u.pm * BM : (u.pm - 64) * BM) + wr * 64 + fr, col0 = u.pn * BM + wc * 32 + 4 * fq;
        const float* hin = u.pm < 64 ? hin_lat : hin_ctx; float* hout = u.pm < 64 ? hout_lat : hout_ctx;
        f32x4 gv[2][2];
#pragma unroll
        for (int bj = 0; bj < 2; ++bj)
#pragma unroll
            for (int n = 0; n < 2; ++n) gv[bj][n] = *(const f32x4*)(gate + cond * 12288 + 8192 + col0 + bj * HALF + n * 16);
#pragma unroll
        for (int ai = 0; ai < 2; ++ai)
#pragma unroll
            for (int m = 0; m < 4; ++m) { const size_t off = (size_t)(rloc + ai * HALF + m * 16) * 4096 + col0;
#pragma unroll
                for (int bj = 0; bj < 2; ++bj)
#pragma unroll
                    for (int n = 0; n < 2; ++n) { const f32x4 b = *(const f32x4*)(hin + off + bj * HALF + n * 16);
                        *(f32x4*)(hout + off + bj * HALF + n * 16) = b + gv[bj][n] * acc[ai][bj][m][n]; } }
    }
};
}

__device__ __forceinline__ void p0_transpose_item(const float* W, int K, int N, bf16* WT, LAS float* scr, int item, int lane) {
    const int nblk = N / 32, kb = item / nblk, nb = item % nblk, k0 = 64 * kb, n0 = 32 * nb;
#pragma unroll 8
    for (int i = 0; i < 32; ++i) { const int kk = 2 * i + (lane >> 5); scr[kk * 33 + (lane & 31)] = W[(size_t)(k0 + kk) * N + n0 + (lane & 31)]; }
    LDS_WAIT(); asm volatile("" ::: "memory");
    const int c = lane & 7;
#pragma unroll
    for (int j = 0; j < 4; ++j) { const int n = (lane >> 3) + 8 * j; const LAS float* s = scr + (8 * c) * 33 + n;
        v4u o; o.x = pk2(s[0 * 33], s[1 * 33]); o.y = pk2(s[2 * 33], s[3 * 33]); o.z = pk2(s[4 * 33], s[5 * 33]); o.w = pk2(s[6 * 33], s[7 * 33]);
        *(v4u*)(WT + (size_t)(n0 + n) * K + k0 + 8 * c) = o; }
    LDS_WAIT(); asm volatile("" ::: "memory");
}
__device__ __forceinline__ void transpose_item_nolds(const float* W, int K, int N, bf16* WT, int item, int lane) {
    const int nblk = N / 64, kb = item / nblk, nb = item % nblk, k0 = 64 * kb, n0 = 64 * nb;
    const float* src = W + (size_t)k0 * N + n0 + lane;
    bf16* dst = WT + (size_t)(n0 + lane) * K + k0;
#pragma unroll
    for (int hb = 0; hb < 2; ++hb) {
        float v[32];
#pragma unroll
        for (int i = 0; i < 32; ++i) v[i] = src[(size_t)(32 * hb + i) * N];
        __builtin_amdgcn_sched_barrier(0);
#pragma unroll
        for (int j = 0; j < 4; ++j) { v4u o; o.x = pk2(v[8 * j], v[8 * j + 1]); o.y = pk2(v[8 * j + 2], v[8 * j + 3]); o.z = pk2(v[8 * j + 4], v[8 * j + 5]); o.w = pk2(v[8 * j + 6], v[8 * j + 7]);
            *(v4u*)(dst + 32 * hb + 8 * j) = o; }
        __builtin_amdgcn_sched_barrier(0);
    }
}
constexpr int WC_WIN = (DM / 64) * (NIN / 64), WC_WOUT = (DM / 64) * (DM / 64), WC_POOL = 4 * 16, WC_WUP = 2 * 16, WC_AUP = 2 * 16, WC_SGW = 256, WC_ITEMS = WC_WIN + WC_WOUT + WC_POOL + WC_WUP + WC_AUP + WC_SGW;
__device__ __forceinline__ void weight_copy_item(int L, int r, const float* w_in, const float* w_out, const float* pool_w, const float* rw_w_up, const float* rw_a_up, const float* sg_w,
                                                 bf16* WINT, bf16* WOUTT, bf16* POOLWT, bf16* WUPT, bf16* AUPT, bf16* SGW, int lane) {
    if (r < WC_WIN) { transpose_item_nolds(w_in + (size_t)L * DM * NIN, DM, NIN, WINT + (size_t)L * NIN * DM, r, lane); return; } r -= WC_WIN;
    if (r < WC_WOUT) { transpose_item_nolds(w_out + (size_t)L * DM * DM, DM, DM, WOUTT + (size_t)L * DM * DM, r, lane); return; } r -= WC_WOUT;
    if (r < WC_POOL) { const int g = r >> 4; transpose_item_nolds(pool_w + (size_t)(L * 4 + g) * 65536, 256, 256, POOLWT + (size_t)(L * 4 + g) * 65536, r & 15, lane); return; } r -= WC_POOL;
    if (r < WC_WUP) { const int dd = r >> 4; transpose_item_nolds(rw_w_up + (size_t)(L * 2 + dd) * 65536, 64, 1024, WUPT + (size_t)(L * 2 + dd) * 65536, r & 15, lane); return; } r -= WC_WUP;
    if (r < WC_AUP) { const int dd = r >> 4; transpose_item_nolds(rw_a_up + (size_t)(L * 2 + dd) * 65536, 64, 1024, AUPT + (size_t)(L * 2 + dd) * 65536, r & 15, lane); return; } r -= WC_AUP;
    {   const size_t e0 = (size_t)L * 131072 + (size_t)r * 512 + lane * 8; const f32x4 a = *(const f32x4*)(sg_w + e0), b = *(const f32x4*)(sg_w + e0 + 4);
        v4u o; o.x = pk2(a.x, a.y); o.y = pk2(a.z, a.w); o.z = pk2(b.x, b.y); o.w = pk2(b.z, b.w); *(v4u*)(SGW + e0) = o; }
}
__device__ __forceinline__ void p0_mod_item(const float* wmod, const float* cvec, const float* cctx, float* MODP, LAS float* scr, int item, int lane) {
    const int l = item / (64 * 48), r = item % (64 * 48), kc = r / 48, nc = r % 48, k0 = kc * 64, n0 = nc * 256 + lane * 4;
    scr[lane] = silu_f(cvec[k0 + lane]); scr[64 + lane] = silu_f(cvec[4096 + k0 + lane]); scr[128 + lane] = silu_f(cctx[k0 + lane]);
    LDS_WAIT(); asm volatile("" ::: "memory");
    f32x4 a0 = {0.f, 0.f, 0.f, 0.f}, a1 = a0, a2 = a0;
    const float* wp = wmod + ((size_t)l * 4096 + k0) * 12288 + n0;
#pragma unroll 16
    for (int k = 0; k < 64; ++k) { const f32x4 w = *(const f32x4*)(wp + (size_t)k * 12288); a0 += scr[k] * w; a1 += scr[64 + k] * w; a2 += scr[128 + k] * w; }
    float* o = MODP + ((size_t)(l * 64 + kc) * 3) * 12288 + n0;
    *(f32x4*)(o) = a0; *(f32x4*)(o + 12288) = a1; *(f32x4*)(o + 2 * 12288) = a2;
    LDS_WAIT(); asm volatile("" ::: "memory");
}
__device__ __forceinline__ void sincos_acc(float ang, float& c, float& s) {
    const double x = (double)ang; const double n = __builtin_rint(x * 0.63661977236758134308); const double r = x - n * 1.57079632679489661923;
    const double r2 = r * r;
    const double sp = r * (1.0 + r2 * (-1.0 / 6 + r2 * (1.0 / 120 + r2 * (-1.0 / 5040 + r2 * (1.0 / 362880 + r2 * (-1.0 / 39916800 + r2 * (1.0 / 6227020800.0)))))));
    const double cp = 1.0 + r2 * (-0.5 + r2 * (1.0 / 24 + r2 * (-1.0 / 720 + r2 * (1.0 / 40320 + r2 * (-1.0 / 3628800 + r2 * (1.0 / 479001600 + r2 * (-1.0 / 87178291200.0)))))));
    const int q = ((int)n) & 3;
    const double cc = (q == 0) ? cp : (q == 1) ? -sp : (q == 2) ? -cp : sp;
    const double ss = (q == 0) ? sp : (q == 1) ? cp : (q == 2) ? -sp : -cp;
    c = (float)cc; s = (float)ss;
}

__device__ __forceinline__ void phase_xn(const float* hlat, const float* hctx, const float* mod, bf16* XN, int gw, int NGW, int lane) {
    for (int m = gw; m < MROWS; m += NGW) {
        const float* src = m < NLAT ? hlat + (size_t)m * DM : hctx + (size_t)(m - NLAT) * DM;
        const int cond = m < NLAT ? (m >> 13) : 2;
        const f32x4* s4 = (const f32x4*)src + lane;
        f32x4 v[16]; float ss = 0.f;
#pragma unroll
        for (int j = 0; j < 16; ++j) { v[j] = s4[64 * j]; ss += (v[j].x * v[j].x + v[j].y * v[j].y) + (v[j].z * v[j].z + v[j].w * v[j].w); }
        ss = wave_sum(ss);
        const float rstd = rsq_f(ss * (1.f / 4096.f) + 1e-6f);
        const f32x4* sh4 = (const f32x4*)(mod + cond * 12288) + lane; const f32x4* sc4 = (const f32x4*)(mod + cond * 12288 + 4096) + lane;
        v2u* o = (v2u*)(XN + (size_t)m * DM) + lane;
#pragma unroll
        for (int j = 0; j < 16; ++j) { const f32x4 sh = sh4[64 * j], sc = sc4[64 * j]; const f32x4 x = v[j] * rstd * (sc + 1.f) + sh; v2u w; w.x = pk2(x.x, x.y); w.y = pk2(x.z, x.w); o[64 * j] = w; }
    }
}

__device__ __forceinline__ void phase_rowprep(const bf16* P, const float* qgain, const float* kgain, const f32x2* tab, bf16* QN, bf16* KN, f32x2* SGST, int gw, int NGW, int lane) {
    const int sub = lane & 3;
    for (int m = gw; m < MROWS; m += NGW) {
        const bf16* pr = P + (size_t)m * NIN;
        const bool isctx = m >= NLAT; const int t = isctx ? ((m - NLAT) & 255) : (m & 8191);
        {   float x[16]; unpack8(*(const v4u*)(pr + C_SGV + 16 * lane), x); unpack8(*(const v4u*)(pr + C_SGV + 16 * lane + 8), x + 8);
            float s = 0.f;
#pragma unroll
            for (int i = 0; i < 16; ++i) s += x[i];
            const float mean = wave_sum(s) * (1.f / 1024.f); float q = 0.f;
#pragma unroll
            for (int i = 0; i < 16; ++i) { const float dlt = x[i] - mean; q += dlt * dlt; }
            const float var = wave_sum(q) * (1.f / 1024.f);
            if (lane == 0) SGST[m] = (f32x2){mean, rsq_f(var + 1e-5f)}; }
        float q[16], k[16];
        unpack8(*(const v4u*)(pr + C_NAQ + 16 * lane), q); unpack8(*(const v4u*)(pr + C_NAQ + 16 * lane + 8), q + 8);
        unpack8(*(const v4u*)(pr + C_NAK + 16 * lane), k); unpack8(*(const v4u*)(pr + C_NAK + 16 * lane + 8), k + 8);
        float sq = 0.f, sk = 0.f;
#pragma unroll
        for (int i = 0; i < 16; ++i) { sq += q[i] * q[i]; sk += k[i] * k[i]; }
        sq += __shfl_xor(sq, 1); sq += __shfl_xor(sq, 2); sk += __shfl_xor(sk, 1); sk += __shfl_xor(sk, 2);
        const float rq = rsq_f(sq * (1.f / 64.f) + 1e-6f), rk = rsq_f(sk * (1.f / 64.f) + 1e-6f);
#pragma unroll
        for (int i = 0; i < 16; ++i) { q[i] *= rq * qgain[16 * sub + i]; k[i] *= rk * kgain[16 * sub + i]; }
        if (!isctx) {
            const int pos = sub < 2 ? (t >> 6) : (t & 63);
#pragma unroll
            for (int i = 0; i < 16; ++i) { const f32x2 cs = tab[pos * 16 + i]; const float pq = __shfl_xor(q[i], 1), pkk = __shfl_xor(k[i], 1);
                q[i] = (sub & 1) ? (q[i] * cs.x + pq * cs.y) : (q[i] * cs.x - pq * cs.y);
                k[i] = (sub & 1) ? (k[i] * cs.x + pkk * cs.y) : (k[i] * cs.x - pkk * cs.y); }
        }
#pragma unroll
        for (int i = 0; i < 16; ++i) q[i] *= 0.125f;
        *(v4u*)(QN + (size_t)m * GWD + 16 * lane) = pack8(q); *(v4u*)(QN + (size_t)m * GWD + 16 * lane + 8) = pack8(q + 8);
        *(v4u*)(KN + (size_t)m * GWD + 16 * lane) = pack8(k); *(v4u*)(KN + (size_t)m * GWD + 16 * lane + 8) = pack8(k + 8);
    }
}
__device__ __forceinline__ void phase_vt(const bf16* P, bf16* VTL, bf16* VTC, int gw, int NGW, int lane) {
    for (int u = gw; u < (MROWS / 64) * 16; u += NGW) {
        const int tt = u >> 4, h = u & 15, m0 = tt * 64;
        const bf16* src = P + (size_t)m0 * NIN + C_NAV + h * 64 + lane;
        unsigned w[32];
#pragma unroll
        for (int i = 0; i < 32; ++i) { const unsigned lo = src[(size_t)(2 * i) * NIN], hi = src[(size_t)(2 * i + 1) * NIN]; w[i] = lo | (hi << 16); }
        bf16* dst = tt < 256 ? VTL + (((size_t)((tt >> 7) * 16 + h) * 64 + lane) * 8192 + (tt & 127) * 64)
                             : VTC + (((size_t)(((tt - 256) >> 2) * 16 + h) * 64 + lane) * 256 + ((tt - 256) & 3) * 64);
#pragma unroll
        for (int j = 0; j < 8; ++j) { v4u o; o.x = w[4 * j]; o.y = w[4 * j + 1]; o.z = w[4 * j + 2]; o.w = w[4 * j + 3]; ((v4u*)dst)[j] = o; }
    }
}
template <int G>
__device__ __forceinline__ void pool_unit(const bf16* P, const bf16* wbase, const float* pscale, bf16* Y, int m0, int lane) {
    constexpr int WIN = 2 << G;
    const int r = lane & 15, q4 = lane >> 4, m = m0 + r;
    const bool isctx = m0 >= NLAT; const int T = isctx ? CTXL : SEQ; const int t = isctx ? ((m - NLAT) & 255) : (m & 8191);
    const int tlo = t - (WIN >> 1);
    const int lo = tlo < 0 ? 0 : tlo, hi = (tlo + WIN) > T ? T : (tlo + WIN);
    const float inv = rcp_f((float)(hi - lo));
    f32x4 acc[16];
#pragma unroll
    for (int nt = 0; nt < 16; ++nt) acc[nt] = (f32x4){0.f, 0.f, 0.f, 0.f};
#pragma unroll 1
    for (int ks = 0; ks < 8; ++ks) {
        const int ch0 = C_POOLV + G * 256 + 32 * ks + 8 * q4;
        constexpr int WB = WIN < 8 ? WIN : 8;
        bf16x8 bfr[8];
        float sum[8];
#pragma unroll
        for (int j = 0; j < 8; ++j) sum[j] = 0.f;
        const v4u selfw = *(const v4u*)(P + (size_t)m * NIN + ch0);
#pragma unroll
        for (int nt = 0; nt < 8; ++nt) bfr[nt] = ld_frag(wbase + (size_t)(16 * nt + r) * 256 + 32 * ks + 8 * q4);
#pragma unroll
        for (int k0 = 0; k0 < WIN; k0 += WB) {
            v4u wl[WB];
#pragma unroll
            for (int k = 0; k < WB; ++k) { const int tk = tlo + k0 + k; const bool ok = tk >= 0 && tk < T; wl[k] = *(const v4u*)(P + (size_t)(ok ? (m - t + tk) : m) * NIN + ch0); }
            __builtin_amdgcn_sched_barrier(0);
#pragma unroll
            for (int k = 0; k < WB; ++k) { const int tk = tlo + k0 + k; const bool ok = tk >= 0 && tk < T; float x[8]; unpack8(wl[k], x);
#pragma unroll
                for (int j = 0; j < 8; ++j) sum[j] += ok ? x[j] : 0.f; }
            __builtin_amdgcn_sched_barrier(0);
        }
        float self[8]; unpack8(selfw, self);
        float dv[8];
#pragma unroll
        for (int j = 0; j < 8; ++j) dv[j] = sum[j] * inv - self[j];
        const bf16x8 af = __builtin_bit_cast(bf16x8, pack8(dv));
        __builtin_amdgcn_sched_barrier(0);
        bf16x8 bfr2[8];
#pragma unroll
        for (int nt = 0; nt < 8; ++nt) bfr2[nt] = ld_frag(wbase + (size_t)(16 * (nt + 8) + r) * 256 + 32 * ks + 8 * q4);
        __builtin_amdgcn_sched_barrier(0);
#pragma unroll
        for (int nt = 0; nt < 8; ++nt) acc[nt] = mfma16(af, bfr[nt], acc[nt]);
        __builtin_amdgcn_sched_barrier(0);
#pragma unroll
        for (int nt = 0; nt < 8; ++nt) acc[nt + 8] = mfma16(af, bfr2[nt], acc[nt + 8]);
        __builtin_amdgcn_sched_barrier(0);
    }
#pragma unroll
    for (int nh = 0; nh < 4; ++nh) {
        unsigned short zz[4][4]; float ps[4];
#pragma unroll
        for (int nq = 0; nq < 4; ++nq) { const int oc = G * 256 + 16 * (4 * nh + nq) + r; ps[nq] = pscale[oc];
#pragma unroll
            for (int i = 0; i < 4; ++i) zz[nq][i] = P[(size_t)(m0 + 4 * q4 + i) * NIN + C_POOLZ + oc]; }
        __builtin_amdgcn_sched_barrier(0);
#pragma unroll
        for (int nq = 0; nq < 4; ++nq) { const int oc = G * 256 + 16 * (4 * nh + nq) + r;
#pragma unroll
            for (int i = 0; i < 4; ++i) Y[(size_t)(m0 + 4 * q4 + i) * DM + oc] = (bf16)f2bf(acc[4 * nh + nq][i] * ps[nq] * silu_f(bf2f(zz[nq][i]))); }
        __builtin_amdgcn_sched_barrier(0);
    }
}
__device__ __forceinline__ void phase_pool(const bf16* P, const bf16* PWT  , const float* pscale, bf16* Y, int nrows, int gw, int NGW, int lane) {
    for (int u = gw; u < (nrows / 16) * 4; u += NGW) {
        const int tt = u >> 2, g = u & 3, m0 = tt * 16;
        const bf16* wbase = PWT + (size_t)g * 65536;
        if (g == 0) pool_unit<0>(P, wbase, pscale, Y, m0, lane);
        else if (g == 1) pool_unit<1>(P, wbase, pscale, Y, m0, lane);
        else if (g == 2) pool_unit<2>(P, wbase, pscale, Y, m0, lane);
        else pool_unit<3>(P, wbase, pscale, Y, m0, lane);
    }
}
#if defined(PROBE_REC2)
#define REC_ST(p, v) do { __builtin_nontemporal_store((v), (p)); __builtin_nontemporal_store((v), (f32x4*)((char*)(p) + (size_t)792 * 1048576)); } while (0)
#elif defined(REC_NT)
#define REC_ST(p, v) __builtin_nontemporal_store((v), (p))
#else
#define REC_ST(p, v) (*(p) = (v))
#endif
__device__ __forceinline__ void phase_rwprep(const bf16* P, const float* mu_rkv  , const float* mu_lora  , const float* w0  , const bf16* WUPT  ,
                                             const float* a0, const bf16* AUPT, const float* k_k, const float* k_a, const float* r_k, float* REC, float* BON, LAS unsigned char* lds,
                                             unsigned* queue  , int cls, int wave, int lane) {
    const int n = lane & 15, q4 = lane >> 4;
    const int d = cls >> 3, hp = cls & 7;
    unsigned* qh = queue + 64 * cls;
    LAS float* prm = (LAS float*)(lds + wave * 4096);
#pragma unroll
    for (int it = 0; it < 16; ++it) { const int hh = it >> 3, p = it & 7, ch = (hp * 2 + hh) * 64 + lane;
        const float* src = p == 0 ? w0 + d * 1024 : p == 1 ? a0 + d * 1024 : p == 2 ? mu_rkv + (d * 3 + 0) * 1024 : p == 3 ? mu_rkv + (d * 3 + 1) * 1024 : p == 4 ? mu_rkv + (d * 3 + 2) * 1024 : p == 5 ? k_k : p == 6 ? k_a : r_k;
        prm[it * 64 + lane] = src[ch]; }
    LDS_WAIT(); asm volatile("" ::: "memory");
    unsigned pend = 0u;
    if (lane == 0) pend = __hip_atomic_fetch_add(qh, 1u, __ATOMIC_RELAXED, __HIP_MEMORY_SCOPE_AGENT);
    for (;;) {
        const int tt = __builtin_amdgcn_readfirstlane((int)pend);
        if (tt >= MROWS / 16) break;
        if (lane == 0) pend = __hip_atomic_fetch_add(qh, 1u, __ATOMIC_RELAXED, __HIP_MEMORY_SCOPE_AGENT);
        const int m0 = tt * 16;
        const bool isctx = m0 >= NLAT; const int T = isctx ? CTXL : SEQ; const int t0 = isctx ? ((m0 - NLAT) & 255) : (m0 & 8191); const int b = isctx ? ((m0 - NLAT) >> 8) : (m0 >> 13);
        const int m = m0 + n, t = t0 + n; const bool hasnb = d == 0 ? (t > 0) : (t < T - 1); const int nbr = hasnb ? (d == 0 ? m - 1 : m + 1) : m;
        const bf16* prow = P + (size_t)m * NIN; const bf16* nrow = P + (size_t)nbr * NIN;
        bf16x8 Bw[2], Ba[2];
        {   v4u cw[2], nw[2], ca[2], na[2]; f32x4 mw[2][2], ma[2][2];
#pragma unroll
            for (int ks = 0; ks < 2; ++ks) { const int j0 = 32 * ks + 8 * q4;
                cw[ks] = *(const v4u*)(prow + C_RWWD + d * 64 + j0); nw[ks] = *(const v4u*)(nrow + C_RWWD + d * 64 + j0);
                ca[ks] = *(const v4u*)(prow + C_RWAD + d * 64 + j0); na[ks] = *(const v4u*)(nrow + C_RWAD + d * 64 + j0);
                mw[ks][0] = *(const f32x4*)(mu_lora + (d * 2 + 0) * 64 + j0); mw[ks][1] = *(const f32x4*)(mu_lora + (d * 2 + 0) * 64 + j0 + 4);
                ma[ks][0] = *(const f32x4*)(mu_lora + (d * 2 + 1) * 64 + j0); ma[ks][1] = *(const f32x4*)(mu_lora + (d * 2 + 1) * 64 + j0 + 4); }
            __builtin_amdgcn_sched_barrier(0);
#pragma unroll
            for (int ks = 0; ks < 2; ++ks) {
                float cur[8], nb[8], o[8];
                unpack8(cw[ks], cur); unpack8(nw[ks], nb);
#pragma unroll
                for (int j = 0; j < 8; ++j) { const float xx = cur[j] + ((hasnb ? nb[j] : 0.f) - cur[j]) * mw[ks][j >> 2][j & 3]; o[j] = 1.0f - 2.0f * rcp_f(1.0f + __expf(2.0f * xx)); }
                Bw[ks] = __builtin_bit_cast(bf16x8, pack8(o));
                unpack8(ca[ks], cur); unpack8(na[ks], nb);
#pragma unroll
                for (int j = 0; j < 8; ++j) o[j] = cur[j] + ((hasnb ? nb[j] : 0.f) - cur[j]) * ma[ks][j >> 2][j & 3];
                Ba[ks] = __builtin_bit_cast(bf16x8, pack8(o)); }
        }
        const int pos = scan_pos(d, isctx, t);
#pragma unroll 1
        for (int hh = 0; hh < 2; ++hh) {
            const int head = hp * 2 + hh, chain = (b * 2 + d) * 16 + head;
            char* recb = (char*)REC + ((size_t)chain * SCANLEN + pos) * RECB;
            const LAS float* pr = prm + hh * 512;
            float KK[16], AV[16]; float ss = 0.f, bon = 0.f;
#pragma unroll
            for (int hf = 0; hf < 2; ++hf) {
                const int cl = 32 * hf + 8 * q4, cg = head * 64 + cl;
                bf16x8 wf[2][2], af[2][2];
#pragma unroll
                for (int tq = 0; tq < 2; ++tq) { const size_t wrow = (size_t)(d * 1024 + head * 64 + 32 * hf + 8 * (n >> 2) + 4 * tq + (n & 3)) * 64 + 8 * q4;
                    wf[tq][0] = ld_frag(WUPT + wrow); wf[tq][1] = ld_frag(WUPT + wrow + 32); af[tq][0] = ld_frag(AUPT + wrow); af[tq][1] = ld_frag(AUPT + wrow + 32); }
                const v4u rcw = *(const v4u*)(prow + C_RWR + cg), kcw = *(const v4u*)(prow + C_RWK + cg), vcw = *(const v4u*)(prow + C_RWV + cg);
                const v4u rnw = *(const v4u*)(nrow + C_RWR + cg), knw = *(const v4u*)(nrow + C_RWK + cg), vnw = *(const v4u*)(nrow + C_RWV + cg);
                __builtin_amdgcn_sched_barrier(0);
                f32x4 accW[2], accA[2];
#pragma unroll
                for (int tq = 0; tq < 2; ++tq) { f32x4 z = {0.f, 0.f, 0.f, 0.f}; z = mfma16(wf[tq][0], Bw[0], z); accW[tq] = mfma16(wf[tq][1], Bw[1], z);
                                                 f32x4 y = {0.f, 0.f, 0.f, 0.f}; y = mfma16(af[tq][0], Ba[0], y); accA[tq] = mfma16(af[tq][1], Ba[1], y); }
                float rc[8], kc[8], vc[8], rn[8], kn[8], vn[8];
                unpack8(rcw, rc); unpack8(kcw, kc); unpack8(vcw, vc); unpack8(rnw, rn); unpack8(knw, kn); unpack8(vnw, vn);
                float dec[8], kp[8], rr[8], vv[8];
#pragma unroll
                for (int g = 0; g < 2; ++g) {
                    const f32x4 w0v = *(const LAS f32x4*)(pr + 0 * 64 + cl + 4 * g), a0v = *(const LAS f32x4*)(pr + 1 * 64 + cl + 4 * g), mur = *(const LAS f32x4*)(pr + 2 * 64 + cl + 4 * g),
                                muk = *(const LAS f32x4*)(pr + 3 * 64 + cl + 4 * g), muv = *(const LAS f32x4*)(pr + 4 * 64 + cl + 4 * g), kkv = *(const LAS f32x4*)(pr + 5 * 64 + cl + 4 * g),
                                kav = *(const LAS f32x4*)(pr + 6 * 64 + cl + 4 * g), rkv = *(const LAS f32x4*)(pr + 7 * 64 + cl + 4 * g);
#pragma unroll
                    for (int i = 0; i < 4; ++i) { const int j = 4 * g + i;
                        const float rnb = hasnb ? rn[j] : 0.f, knb = hasnb ? kn[j] : 0.f, vnb = hasnb ? vn[j] : 0.f;
                        const float r_ = rc[j] + (rnb - rc[j]) * mur[i], k0 = kc[j] + (knb - kc[j]) * muk[i], v_ = vc[j] + (vnb - vc[j]) * muv[i];
                        const float xw = -(w0v[i] + accW[g][i]);
                        const float sp = fmaxf(xw, 0.f) + __logf(1.0f + __expf(-fabsf(xw)));
                        dec[j] = __expf(-__expf(-sp - 0.5f));
                        const float av = rcp_f(1.0f + __expf(-(a0v[i] + accA[g][i])));
                        const float kx = k0 * kkv[i]; ss += kx * kx;
                        const float kp_ = k0 * (1.f + (av - 1.f) * kav[i]); bon += r_ * kp_ * rkv[i];
                        KK[8 * hf + j] = kx; AV[8 * hf + j] = av; kp[j] = kp_; rr[j] = r_; vv[j] = v_; }
                }
                char* ob = recb + cl * 2;
                REC_ST((f32x4*)(recb + cl * 4), ((f32x4){dec[0], dec[1], dec[2], dec[3]})); REC_ST((f32x4*)(recb + cl * 4 + 16), ((f32x4){dec[4], dec[5], dec[6], dec[7]}));
                REC_ST((h8*)(ob + 512), ((h8){(_Float16)kp[0], (_Float16)kp[1], (_Float16)kp[2], (_Float16)kp[3], (_Float16)kp[4], (_Float16)kp[5], (_Float16)kp[6], (_Float16)kp[7]}));
                REC_ST((h8*)(ob + 640), ((h8){(_Float16)rr[0], (_Float16)rr[1], (_Float16)rr[2], (_Float16)rr[3], (_Float16)rr[4], (_Float16)rr[5], (_Float16)rr[6], (_Float16)rr[7]}));
                REC_ST((h8*)(ob + 768), ((h8){(_Float16)vv[0], (_Float16)vv[1], (_Float16)vv[2], (_Float16)vv[3], (_Float16)vv[4], (_Float16)vv[5], (_Float16)vv[6], (_Float16)vv[7]}));
                __builtin_amdgcn_sched_barrier(0);
            }
            ss = sum16x4(ss); bon = sum16x4(bon);
            const float inv = rsq_f(fmaxf(ss, 1e-12f));
#pragma unroll
            for (int hf = 0; hf < 2; ++hf) { char* ob = recb + (32 * hf + 8 * q4) * 2; float kkn[8], nka[8];
#pragma unroll
                for (int j = 0; j < 8; ++j) { kkn[j] = KK[8 * hf + j] * inv; nka[j] = -(kkn[j] * AV[8 * hf + j]); }
                REC_ST((h8*)(ob + 256), ((h8){(_Float16)kkn[0], (_Float16)kkn[1], (_Float16)kkn[2], (_Float16)kkn[3], (_Float16)kkn[4], (_Float16)kkn[5], (_Float16)kkn[6], (_Float16)kkn[7]}));
                REC_ST((h8*)(ob + 384), ((h8){(_Float16)nka[0], (_Float16)nka[1], (_Float16)nka[2], (_Float16)nka[3], (_Float16)nka[4], (_Float16)nka[5], (_Float16)nka[6], (_Float16)nka[7]})); }
            if (q4 == 0) BON[(size_t)chain * SCANLEN + pos] = bon;
        }
    }
}
template <bool CTXQ>
__device__ __forceinline__ void na_unit(const bf16* QN, const bf16* KN, const bf16* VTL, const bf16* VTC, const bf16* P, const float* rpb  , bf16* Y, int u, int lane) {
    const int n = lane & 15, q4 = lane >> 4;
    int b, h, qrow0, qr = 0, jt = 0;
    if (CTXQ) { b = u >> 8; h = (u >> 4) & 15; qrow0 = NLAT + b * CTXL + 16 * (u & 15); }
    else { jt = u & 3; h = (u >> 2) & 15; qr = (u >> 6) & 127; b = u >> 13; qrow0 = b * SEQ + qr * 64 + 16 * jt; }
    constexpr int NT = CTXQ ? 16 : 32, WT = CTXQ ? 0 : 16;
    f32x4 s[NT];
    const int rs = qr - 4 < 0 ? 0 : (qr - 4 > 120 ? 120 : qr - 4);
    const int span0 = jt == 0 ? 0 : (jt == 1 ? 8 : (jt == 2 ? 24 : 32));
    const int qc = 16 * jt + n; const int cs = qc - 8 < 0 ? 0 : (qc - 8 > 48 ? 48 : qc - 8);
    bf16x8 qf[2];
#pragma unroll
    for (int ks = 0; ks < 2; ++ks) qf[ks] = ld_frag(QN + (size_t)(qrow0 + n) * GWD + h * 64 + 32 * ks + 8 * q4);
    if (!CTXQ) {
        const float* rp = rpb + (size_t)h * 15 * 31;
#pragma unroll
        for (int wt = 0; wt < 16; ++wt) { const int kri = wt >> 1, half = wt & 1, relr = rs + kri - qr + 7;
#pragma unroll
            for (int i = 0; i < 4; ++i) { const int relc = span0 + 8 * q4 + 4 * half + i - qc + 15; const int relcc = relc < 0 ? 0 : (relc > 30 ? 30 : relc); s[wt][i] = rp[relr * 31 + relcc]; } }
        __builtin_amdgcn_sched_barrier(0);
#pragma unroll
        for (int bt = 0; bt < 2; ++bt) {
            bf16x8 kf[16];
#pragma unroll
            for (int t = 0; t < 8; ++t) { const int wt = bt * 8 + t, kri = wt >> 1, half = wt & 1;
                const bf16* kp = KN + (size_t)(b * SEQ + (rs + kri) * 64 + span0 + 8 * (n >> 2) + 4 * half + (n & 3)) * GWD + h * 64 + 8 * q4; kf[2 * t] = ld_frag(kp); kf[2 * t + 1] = ld_frag(kp + 32); }
            __builtin_amdgcn_sched_barrier(0);
#pragma unroll
            for (int t = 0; t < 8; ++t) { const int wt = bt * 8 + t, half = wt & 1;
                f32x4 a = s[wt];
#pragma unroll
                for (int i = 0; i < 4; ++i) { const int kc = span0 + 8 * q4 + 4 * half + i; const bool ok = kc >= cs && kc < cs + 16; a[i] = ok ? a[i] : -INFINITY; }
                a = mfma16(kf[2 * t], qf[0], a); a = mfma16(kf[2 * t + 1], qf[1], a); s[wt] = a; }
            __builtin_amdgcn_sched_barrier(0);
        }
    }
#pragma unroll
    for (int bt = 0; bt < 2; ++bt) {
        bf16x8 kf[16];
#pragma unroll
        for (int t = 0; t < 8; ++t) { const int ctile = bt * 8 + t; const bf16* kp = KN + (size_t)(NLAT + b * CTXL + 32 * (ctile >> 1) + 8 * (n >> 2) + 4 * (ctile & 1) + (n & 3)) * GWD + h * 64 + 8 * q4; kf[2 * t] = ld_frag(kp); kf[2 * t + 1] = ld_frag(kp + 32); }
        __builtin_amdgcn_sched_barrier(0);
#pragma unroll
        for (int t = 0; t < 8; ++t) { f32x4 a = {0.f, 0.f, 0.f, 0.f}; a = mfma16(kf[2 * t], qf[0], a); a = mfma16(kf[2 * t + 1], qf[1], a); s[WT + bt * 8 + t] = a; }
        __builtin_amdgcn_sched_barrier(0);
    }
    float mx = -INFINITY;
#pragma unroll
    for (int t = 0; t < NT; ++t) mx = fmaxf(fmaxf(fmaxf(s[t][0], s[t][1]), fmaxf(s[t][2], s[t][3])), mx);
    mx = max16x4(mx);
    float sum = 0.f;
#pragma unroll
    for (int t = 0; t < NT; ++t) {
#pragma unroll
        for (int i = 0; i < 4; ++i) { const float e = __expf(s[t][i] - mx); s[t][i] = e; sum += e; } }
    sum = sum16x4(sum);
    const float inv = rcp_f(sum);
    f32x4 o[4];
#pragma unroll
    for (int nt = 0; nt < 4; ++nt) o[nt] = (f32x4){0.f, 0.f, 0.f, 0.f};
#pragma unroll
    for (int tb = 0; tb < NT / 8; ++tb) {
        v4u vv[4][4];
#pragma unroll
        for (int tq = 0; tq < 4; ++tq) { const int tp = tb * 4 + tq;
            const bf16* vb; size_t dstride;
            if (!CTXQ && tp < 8) { vb = VTL + ((size_t)(b * 16 + h) * 64 + n) * 8192 + (rs + tp) * 64 + span0 + 8 * q4; dstride = (size_t)16 * 8192; }
            else { const int cp = tp - (CTXQ ? 0 : 8); vb = VTC + ((size_t)(b * 16 + h) * 64 + n) * 256 + 32 * cp + 8 * q4; dstride = (size_t)16 * 256; }
#pragma unroll
            for (int nt = 0; nt < 4; ++nt) vv[tq][nt] = *(const v4u*)(vb + nt * dstride); }
        __builtin_amdgcn_sched_barrier(0);
#pragma unroll
        for (int tq = 0; tq < 4; ++tq) { const int tp = tb * 4 + tq;
            const f32x4 p0 = s[2 * tp] * inv, p1 = s[2 * tp + 1] * inv;
            v4u aw; aw.x = pk2(p0[0], p0[1]); aw.y = pk2(p0[2], p0[3]); aw.z = pk2(p1[0], p1[1]); aw.w = pk2(p1[2], p1[3]);
            const bf16x8 af = __builtin_bit_cast(bf16x8, aw);
#pragma unroll
            for (int nt = 0; nt < 4; ++nt) o[nt] = mfma16(af, __builtin_bit_cast(bf16x8, vv[tq][nt]), o[nt]); }
        __builtin_amdgcn_sched_barrier(0);
    }
    unsigned short zz[4][4];
#pragma unroll
    for (int nt = 0; nt < 4; ++nt)
#pragma unroll
        for (int i = 0; i < 4; ++i) zz[nt][i] = P[(size_t)(qrow0 + 4 * q4 + i) * NIN + C_NAZ + h * 64 + 16 * nt + n];
    __builtin_amdgcn_sched_barrier(0);
#pragma unroll
    for (int nt = 0; nt < 4; ++nt)
#pragma unroll
        for (int i = 0; i < 4; ++i) { const int row = qrow0 + 4 * q4 + i, col = h * 64 + 16 * nt + n;
            Y[(size_t)row * DM + 1024 + col] = (bf16)f2bf(o[nt][i] * silu_f(bf2f(zz[nt][i]))); }
}
__device__ __forceinline__ void phase_sgu(const bf16* P, const f32x2* SGST, const float* lnw, const float* lnb, const bf16* SGW  , const float* sgb  , bf16* Y,
                                          LAS unsigned char* lds, int nchunks, int tid, int wave, int lane) {
    const int n = lane & 15, q4 = lane >> 4;
    LAS bf16* T = (LAS bf16*)lds;
    for (int u = blockIdx.x; u < nchunks * 8; u += 256) {
        const int ck = u >> 3, g = u & 7, m0 = ck * 128;
#pragma unroll
        for (int it = 0; it < 4; ++it) { const int idx = tid + 512 * it, q = idx >> 4, c8 = idx & 15;
            float x[8]; unpack8(*(const v4u*)(P + (size_t)(m0 + q) * NIN + C_SGV + g * 128 + 8 * c8), x);
            const f32x2 st = SGST[m0 + q];
#pragma unroll
            for (int j = 0; j < 8; ++j) { const int c = 8 * c8 + j; const float v = (x[j] - st.x) * st.y * lnw[g * 128 + c] + lnb[g * 128 + c]; T[c * 136 + q] = (bf16)f2bf(v); } }
        __syncthreads();
        bf16x8 af[4];
#pragma unroll
        for (int ks = 0; ks < 4; ++ks) af[ks] = ld_frag(SGW + ((size_t)g * 128 + 16 * wave + n) * 128 + 32 * ks + 8 * q4);
#pragma unroll
        for (int nt = 0; nt < 8; ++nt) {
            f32x4 acc = {0.f, 0.f, 0.f, 0.f};
#pragma unroll
            for (int ks = 0; ks < 4; ++ks) { const bf16x8 bfg = *(const LAS bf16x8*)(T + (16 * nt + n) * 136 + 32 * ks + 8 * q4); acc = mfma16(af[ks], bfg, acc); }
#pragma unroll
            for (int i = 0; i < 4; ++i) { const int p = 16 * wave + 4 * q4 + i, row = m0 + p, col = g * 128 + 16 * nt + n;
                const float mixed = acc[i] + sgb[g * 128 + p]; const bf16* pr = P + (size_t)row * NIN;
                const float uu = bf2f(pr[C_SGU + col]), z = bf2f(pr[C_SGZ + col]);
                Y[(size_t)row * DM + 3072 + col] = (bf16)f2bf(uu * mixed * silu_f(z)); }
        }
        __syncthreads();
    }
}
__device__ __forceinline__ void scan_self(const float* REC, float* YR, LAS unsigned char* lds, LAS unsigned* bcnt, int su, int wave, int lane) {
    constexpr int CS = 32, NCH = SCANLEN / CS, SLOT = CS * RECB, NPW = SLOT / 1024 / 4;
    const int chain = (su & 7) * 8 + ((su >> 3) >> 2), part = (su >> 3) & 3;
    const char* recb = (const char*)REC + (size_t)chain * SCANLEN * RECB;
    const int wl = wave;
#define SCAN_ISSUE(cc, sl) do { _Pragma("unroll") for (int p_ = 0; p_ < NPW; ++p_) \
    __builtin_amdgcn_global_load_lds((const unsigned*)(recb + (size_t)(cc) * SLOT + (wl * NPW + p_) * 1024 + lane * 16), (LAS unsigned*)(lds + (sl) * SLOT + (wl * NPW + p_) * 1024), 16, 0, 0); } while (0)
    __builtin_amdgcn_s_setprio(3);
    SCAN_ISSUE(0, 0); SCAN_ISSUE(1, 1); SCAN_ISSUE(2, 2);
    const int c16 = lane & 15, rg = lane >> 4, row = 16 * part + 4 * wave + rg;
    float S0 = 0.f, S1 = 0.f, S2 = 0.f, S3 = 0.f;
    float* yout = YR + (size_t)chain * SCANLEN * 64 + row;
    const int lo_w = c16 * 16, lo_h = 256 + c16 * 8, lo_v = 768 + row * 2;
#define SCAN_LD(dst, sl, s_) do { const LAS unsigned char* rec_ = (sl) + (s_) * RECB; dst##w = *(const LAS f32x4*)(rec_ + lo_w); dst##kk = *(const LAS h4*)(rec_ + lo_h); \
    dst##na = *(const LAS h4*)(rec_ + 128 + lo_h); dst##k = *(const LAS h4*)(rec_ + 256 + lo_h); dst##r = *(const LAS h4*)(rec_ + 384 + lo_h); dst##v = *(const LAS _Float16*)(rec_ + lo_v); } while (0)
#define FMX(a, b, c) __builtin_fmaf((a), (float)(b), (c))
    for (int c = 0; c < NCH; ++c) {
        asm volatile("s_waitcnt vmcnt(14)" ::: "memory");
        {   const unsigned baddr = (unsigned)(size_t)bcnt, one = 1u;
            if (lane == 0) asm volatile("ds_add_u32 %0, %1" :: "v"(baddr), "v"(one) : "memory");
            const unsigned want = 4u * (unsigned)(c + 1); unsigned sp = 0, got;
            for (;;) { asm volatile("ds_read_b32 %0, %1\n\ts_waitcnt lgkmcnt(0)" : "=v"(got) : "v"(baddr) : "memory");
                if (__builtin_amdgcn_readfirstlane((int)got) >= (int)want) break; __builtin_amdgcn_s_sleep(1); if (++sp > (1u << 22)) break; } }
        asm volatile("" ::: "memory");
        {   const int cc = c + 3 < NCH ? c + 3 : NCH - 1; SCAN_ISSUE(cc, (c + 3) & 3); }
        const LAS unsigned char* slot = lds + (c & 3) * SLOT;
        float ysv0 = 0.f, ysv1 = 0.f; float yp[16];
        f32x4 Aw; h4 Akk, Ana, Ak, Ar, Pr; _Float16 Av;
        SCAN_LD(A, slot, 0);
#pragma unroll
        for (int s = 0; s < CS; ++s) {
            f32x4 Bw; h4 Bkk, Bna, Bk, Br; _Float16 Bv;
            if (s < CS - 1) SCAN_LD(B, slot, s + 1);
            __builtin_amdgcn_sched_barrier(0);
            if (s > 0) { float q0 = FMX(S0, Pr.x, 0.f), q1 = FMX(S2, Pr.z, 0.f); q0 = FMX(S1, Pr.y, q0); q1 = FMX(S3, Pr.w, q1); yp[(s - 1) & 15] = q0 + q1; }
            float p0 = FMX(S0, Akk.x, 0.f), p1 = FMX(S2, Akk.z, 0.f); p0 = FMX(S1, Akk.y, p0); p1 = FMX(S3, Akk.w, p1);
            const float dt = red16(p0 + p1);
            const float u0 = __builtin_fmaf(S0, Aw.x, FMX((float)Av, Ak.x, 0.f)), u1 = __builtin_fmaf(S1, Aw.y, FMX((float)Av, Ak.y, 0.f)),
                        u2 = __builtin_fmaf(S2, Aw.z, FMX((float)Av, Ak.z, 0.f)), u3 = __builtin_fmaf(S3, Aw.w, FMX((float)Av, Ak.w, 0.f));
            S0 = FMX(dt, Ana.x, u0); S1 = FMX(dt, Ana.y, u1); S2 = FMX(dt, Ana.z, u2); S3 = FMX(dt, Ana.w, u3);
            if (s == 16) ysv0 = red16_transpose(yp, c16);
            Pr = Ar;
            if (s < CS - 1) { Aw = Bw; Akk = Bkk; Ana = Bna; Ak = Bk; Ar = Br; Av = Bv; }
        }
        { float q0 = FMX(S0, Pr.x, 0.f), q1 = FMX(S2, Pr.z, 0.f); q0 = FMX(S1, Pr.y, q0); q1 = FMX(S3, Pr.w, q1); yp[15] = q0 + q1; }
        ysv1 = red16_transpose(yp, c16);
        asm volatile("" ::: "memory");
        yout[(size_t)(c * CS + c16) * 64] = ysv0; yout[(size_t)(c * CS + 16 + c16) * 64] = ysv1;
    }
    asm volatile("s_waitcnt vmcnt(0)" ::: "memory");
    __builtin_amdgcn_s_setprio(0);
#undef FMX
#undef SCAN_LD
#undef SCAN_ISSUE
}
__device__ __forceinline__ void phase_rwfin(const bf16* P, const float* YR, const float* REC, const float* BON, const float* lnw, const float* lnb, bf16* Y, int nrows, int gw, int NGW, int lane) {
    const int head = lane >> 2, sub = lane & 3;
    for (int m = gw; m < nrows; m += NGW) {
        const bool isctx = m >= NLAT; const int t = isctx ? ((m - NLAT) & 255) : (m & 8191); const int b = isctx ? ((m - NLAT) >> 8) : (m >> 13);
        float out[16];
#pragma unroll
        for (int i = 0; i < 16; ++i) out[i] = 0.f;
#pragma unroll
        for (int d = 0; d < 2; ++d) {
            const int chain = (b * 2 + d) * 16 + head; const size_t pp = (size_t)chain * SCANLEN + scan_pos(d, isctx, t);
            float y[16], v[16];
#pragma unroll
            for (int j = 0; j < 4; ++j) { const f32x4 a = *(const f32x4*)(YR + pp * 64 + 16 * sub + 4 * j); const h4 c = *(const h4*)((const char*)REC + pp * RECB + 768 + (16 * sub + 4 * j) * 2);
                y[4 * j] = a.x; y[4 * j + 1] = a.y; y[4 * j + 2] = a.z; y[4 * j + 3] = a.w; v[4 * j] = (float)c.x; v[4 * j + 1] = (float)c.y; v[4 * j + 2] = (float)c.z; v[4 * j + 3] = (float)c.w; }
            const float bo = BON[pp];
            float s = 0.f;
#pragma unroll
            for (int i = 0; i < 16; ++i) s += y[i];
            s += __shfl_xor(s, 1); s += __shfl_xor(s, 2);
            const float mean = s * (1.f / 64.f); float q = 0.f;
#pragma unroll
            for (int i = 0; i < 16; ++i) { const float dl = y[i] - mean; q += dl * dl; }
            q += __shfl_xor(q, 1); q += __shfl_xor(q, 2);
            const float rstd = rsq_f(q * (1.f / 64.f) + 64e-5f);
#pragma unroll
            for (int i = 0; i < 16; ++i) { const int ch = head * 64 + 16 * sub + i; out[i] += (y[i] - mean) * rstd * lnw[ch] + lnb[ch] + bo * v[i]; }
        }
        float z[16]; unpack8(*(const v4u*)(P + (size_t)m * NIN + C_RWZ + 16 * lane), z); unpack8(*(const v4u*)(P + (size_t)m * NIN + C_RWZ + 16 * lane + 8), z + 8);
#pragma unroll
        for (int i = 0; i < 16; ++i) out[i] *= silu_f(z[i]);
        *(v4u*)(Y + (size_t)m * DM + 2048 + 16 * lane) = pack8(out); *(v4u*)(Y + (size_t)m * DM + 2048 + 16 * lane + 8) = pack8(out + 8);
    }
}
#define XB_TMO      128
#define XB_XCNT(j)  (256  + 64 * (j))
#define XB_XSUB(j)  (1280 + 64 * (j))
#define XB_XGEN(j)  (2304 + 64 * (j))
#define XB_TOP      3328
#define XB_TOPGEN   3392
#define XCD_BAR_WORDS 3456
#define XB_SPIN_CAP (1u << 18)

__device__ __forceinline__ unsigned xb_ld(unsigned* p)              { return __hip_atomic_load(p, __ATOMIC_RELAXED, __HIP_MEMORY_SCOPE_AGENT); }
__device__ __forceinline__ unsigned xb_add(unsigned* p, unsigned v) { return __hip_atomic_fetch_add(p, v, __ATOMIC_RELAXED, __HIP_MEMORY_SCOPE_AGENT); }
__device__ __forceinline__ unsigned xb_xcc_id() { return (unsigned)__builtin_amdgcn_s_getreg((3 << 11) | 20) & 0xFu; }
#define XB_SPIN(cond, bar) do { unsigned _sp = 0; while (cond) { __builtin_amdgcn_s_sleep(1); \
    if ((++_sp & 255u) == 0u) { if (xb_ld(&(bar)[XB_TMO])) break; if (_sp > XB_SPIN_CAP) { atomicAdd(&(bar)[XB_TMO], 1u); break; } } } } while (0)

struct XcdBarrier {
    unsigned* bar; unsigned x;
    volatile LAS unsigned* st;
};

__device__ __forceinline__ XcdBarrier xcd_barrier_post(unsigned* bar, volatile LAS unsigned* st) {
    XcdBarrier b; b.bar = bar; b.x = xb_xcc_id(); b.st = st;
    if (threadIdx.x == 0) (void)xb_add(&bar[XB_XCNT(b.x)], 1u);
    return b;
}
__device__ __forceinline__ void xcd_barrier_complete(unsigned* bar, unsigned x, unsigned& nloc, unsigned& nx) {
    const unsigned G = gridDim.x * gridDim.y * gridDim.z;
    unsigned sum, cnt, mine, sp = 0u;
    for (;;) {
        sum = 0u; cnt = 0u; mine = 0u;
#pragma unroll
        for (unsigned j = 0; j < 16; ++j) { const unsigned c = xb_ld(&bar[XB_XCNT(j)]); sum += c; cnt += (c > 0u) ? 1u : 0u; mine = (j == x) ? c : mine; }
        if (sum == G) break;
        __builtin_amdgcn_s_sleep(1);
        if ((++sp & 255u) == 0u) { if (xb_ld(&bar[XB_TMO])) break; if (sp > XB_SPIN_CAP) { atomicAdd(&bar[XB_TMO], 1u); break; } }
    }
    nloc = mine > 0u ? mine : 1u; nx = cnt > 0u ? cnt : 1u;
}

__device__ __forceinline__ void xcd_barrier(const XcdBarrier& b) {
    asm volatile("s_waitcnt vmcnt(0)" ::: "memory");
    __syncthreads();
    if (threadIdx.x == 0) {
        unsigned* bar = b.bar;
        __builtin_amdgcn_s_waitcnt(0);
        unsigned nloc = b.st[0], nx = b.st[1];
        if (nloc == 0u) { xcd_barrier_complete(bar, b.x, nloc, nx); b.st[0] = nloc; b.st[1] = nx; }
        const unsigned old = xb_add(&bar[XB_XSUB(b.x)], 1u);
        const unsigned gen = old / nloc;
        if (old + 1u == (gen + 1u) * nloc) {
            __builtin_amdgcn_fence(__ATOMIC_RELEASE, "agent");
            asm volatile("s_waitcnt vmcnt(0)" ::: "memory");
            const unsigned og = xb_add(&bar[XB_TOP], 1u);
            const unsigned tg = og / nx;
            if (og + 1u == (tg + 1u) * nx) xb_add(&bar[XB_TOPGEN], 1u);
            else XB_SPIN(xb_ld(&bar[XB_TOPGEN]) == tg, bar);
            __builtin_amdgcn_fence(__ATOMIC_ACQUIRE, "agent");
            xb_add(&bar[XB_XGEN(b.x)], 1u);
            asm volatile("s_waitcnt vmcnt(0)" ::: "memory");
        } else {
            XB_SPIN(xb_ld(&bar[XB_XGEN(b.x)]) == gen, bar);
            __builtin_amdgcn_fence(__ATOMIC_ACQUIRE, "agent");
            asm volatile("s_waitcnt vmcnt(0)" ::: "memory");
        }
    }
    __syncthreads();
}

#ifndef MK_SPLIT
#define MK_SPLIT 0
#endif
#ifndef REP_G1
#define REP_G1 1
#endif
#ifndef REP_PREP
#define REP_PREP 1
#endif
#ifndef REP_MIXA
#define REP_MIXA 1
#endif
#ifndef REP_RWP
#define REP_RWP 1
#endif
#ifndef REP_POOL
#define REP_POOL 1
#endif
#ifndef REP_NA
#define REP_NA 1
#endif
#ifndef REP_SGU
#define REP_SGU 1
#endif
#ifndef REP_ROWP
#define REP_ROWP 1
#endif
#ifndef REP_VT
#define REP_VT 1
#endif
#ifndef REP_XN
#define REP_XN 1
#endif
#ifndef REP_FIN
#define REP_FIN 1
#endif
#ifndef REP_SCAN
#define REP_SCAN 1
#endif
constexpr int PPL = 7;
constexpr int NPHASE = 2 + PPL * DEPTH;
constexpr int RWP_BLOCKS = 14;
constexpr int CW_RWQ = 16384;
constexpr int NGRID = 256;
struct Args { const float* in[28]; float* out; unsigned char* ws; int ph_lo, ph_hi, li, pad; };

__global__ void __launch_bounds__(NWAVES * 64, 2) fwd(Args args) {
    extern __shared__ __attribute__((aligned(16))) unsigned char lds_raw[];
    LAS unsigned char* lds = (LAS unsigned char*)lds_raw;
    volatile LAS unsigned* MISC = (volatile LAS unsigned*)(lds + MISC_OFF);
    const int tid = threadIdx.x, lane = tid & 63, wave = __builtin_amdgcn_readfirstlane(tid >> 6);
    constexpr int G = NGRID; const int bx = blockIdx.x;
    const int vcu = (bx % 8) * (G / 8) + bx / 8;
    const int gw = vcu * NWAVES + wave; constexpr int NGW = G * NWAVES;
    unsigned char* ws = args.ws;
    const int lo = args.ph_lo, hi = args.ph_hi;

    for (int u = tid; u < (LDS_BYTES - LDSCTL_OFF) / 4; u += NWAVES * 64) ((LAS unsigned*)(lds + LDSCTL_OFF))[u] = 0u;
    __syncthreads();
    XcdBarrier bar; bar.bar = (unsigned*)(ws + WS_CTL) + CW_BAR; bar.x = 0; bar.st = MISC + 8;
    if (hi - lo > 1) bar = xcd_barrier_post((unsigned*)(ws + WS_CTL) + CW_BAR, MISC + 8);
#define IN(k) (lo <= (k) && (k) < hi)
#define SEAM(k) do { if (lo <= (k) && (k) + 1 < hi) { XcdBarrier b2_; b2_.bar = WSP(unsigned, WS_CTL) + CW_BAR; b2_.x = bar.x; b2_.st = bar.st; xcd_barrier(b2_); } } while (0)

#define OPQ_S(x) ({ int _t = (x); asm volatile("" : "+s"(_t)); _t; })
#define OPQ_V(x) ({ int _t = (x); asm volatile("" : "+v"(_t)); _t; })
#define INP(i) (args.in[OPQ_S(i)])
#define WSP(T, off) ((T*)(args.ws + ({ size_t _o = (off); asm volatile("" : "+s"(_o)); _o; })))
#define x_in INP(0)
#define c_in INP(1)
#define ctx_in INP(2)
#define cctx_in INP(3)
#define w_mod INP(4)
#define b_mod INP(5)
#define w_in INP(6)
#define w_out INP(7)
#define pool_w INP(8)
#define pool_scale INP(9)
#define na_qg INP(10)
#define na_kg INP(11)
#define na_rpb INP(12)
#define rw_mu_rkv INP(13)
#define rw_mu_lora INP(14)
#define rw_w0 INP(15)
#define rw_w_up INP(16)
#define rw_a0 INP(17)
#define rw_a_up INP(18)
#define rw_k_k INP(19)
#define rw_k_a INP(20)
#define rw_r_k INP(21)
#define rw_ln_w INP(22)
#define rw_ln_b INP(23)
#define sg_ln_w INP(24)
#define sg_ln_b INP(25)
#define sg_w INP(26)
#define sg_b INP(27)
#define MOD WSP(float, WS_MOD)
#define MODP WSP(float, WS_MODP)
#define TAB WSP(f32x2, WS_TAB)
#define SGST WSP(f32x2, WS_SGST)
#define BON WSP(float, WS_BON)
#define POOLWT WSP(bf16, WS_POOLWT)
#define WUPT WSP(bf16, WS_WUPT)
#define AUPT WSP(bf16, WS_AUPT)
#define SGW WSP(bf16, WS_SGW)
#define VTC WSP(bf16, WS_VTC)
#define VTL WSP(bf16, WS_VTL)
#define HCTX WSP(float, WS_HCTX)
#define QN WSP(bf16, WS_QN)
#define KN WSP(bf16, WS_KN)
#define WOUTT WSP(bf16, WS_WOUTT)
#define WINT WSP(bf16, WS_WINT)
#define XN WSP(bf16, WS_XN)
#define Y WSP(bf16, WS_Y)
#define P WSP(bf16, WS_P)
#define YR WSP(float, WS_YR)
#define REC WSP(float, WS_REC)
    float* const out = args.out;

    if (IN(0)) {
        LAS float* scr = (LAS float*)(lds + wave * 16384);
        constexpr int I_MOD = 4 * 64 * 48, I_WIN = 64 * (NIN / 32), I_WOUT = 64 * 128, I_POOL = 4 * 32, I_WUP = 2 * 32, I_AUP = 2 * 32, I_SGW = 256;
        constexpr int NITEMS = I_MOD + I_WIN + I_WOUT + I_POOL + I_WUP + I_AUP + I_SGW;
        for (int it = gw; it < NITEMS; it += NGW) {
            int r = it;
            if (r < I_MOD) { p0_mod_item(w_mod, c_in, cctx_in, MODP, scr, r, lane); continue; } r -= I_MOD;
            if (r < I_WIN) { p0_transpose_item(w_in, DM, NIN, WINT, scr, r, lane); continue; } r -= I_WIN;
            if (r < I_WOUT) { p0_transpose_item(w_out, DM, DM, WOUTT, scr, r, lane); continue; } r -= I_WOUT;
            if (r < I_POOL) { const int g = r / 32; p0_transpose_item(pool_w + (size_t)g * 65536, 256, 256, POOLWT + (size_t)g * 65536, scr, r % 32, lane); continue; } r -= I_POOL;
            if (r < I_WUP) { const int dd = r / 32; p0_transpose_item(rw_w_up + (size_t)dd * 65536, 64, 1024, WUPT + (size_t)dd * 65536, scr, r % 32, lane); continue; } r -= I_WUP;
            if (r < I_AUP) { const int dd = r / 32; p0_transpose_item(rw_a_up + (size_t)dd * 65536, 64, 1024, AUPT + (size_t)dd * 65536, scr, r % 32, lane); continue; } r -= I_AUP;
            {   const size_t e0 = (size_t)r * 512 + lane * 8; const f32x4 a = *(const f32x4*)(sg_w + e0), b = *(const f32x4*)(sg_w + e0 + 4);
                v4u o; o.x = pk2(a.x, a.y); o.y = pk2(a.z, a.w); o.z = pk2(b.x, b.y); o.w = pk2(b.z, b.w); *(v4u*)(SGW + e0) = o; }
        }
        SEAM(0);
    }
    if (IN(1)) {
#ifdef PROBE_ISSUE
        if (wave < 4) {
            float a0 = 1.f, a1 = 2.f, a2 = 3.f, a3 = 4.f, a4 = 5.f, a5 = 6.f, a6 = 7.f, a7 = 8.f; const float b = 0.999f, cc = 1e-6f;
            for (int it = 0; it < 100000; ++it) {
#if PROBE_ISSUE == 1
                asm volatile("v_fma_f32 %0, %0, %8, %9\n v_fma_f32 %1, %1, %8, %9\n v_fma_f32 %2, %2, %8, %9\n v_fma_f32 %3, %3, %8, %9\n v_fma_f32 %4, %4, %8, %9\n v_fma_f32 %5, %5, %8, %9\n v_fma_f32 %6, %6, %8, %9\n v_fma_f32 %7, %7, %8, %9"
                    : "+v"(a0), "+v"(a1), "+v"(a2), "+v"(a3), "+v"(a4), "+v"(a5), "+v"(a6), "+v"(a7) : "v"(b), "v"(cc));
#elif PROBE_ISSUE == 2
                asm volatile("v_fma_mix_f32 %0, %0, %8, %9\n v_fma_mix_f32 %1, %1, %8, %9\n v_fma_mix_f32 %2, %2, %8, %9\n v_fma_mix_f32 %3, %3, %8, %9\n v_fma_mix_f32 %4, %4, %8, %9\n v_fma_mix_f32 %5, %5, %8, %9\n v_fma_mix_f32 %6, %6, %8, %9\n v_fma_mix_f32 %7, %7, %8, %9"
                    : "+v"(a0), "+v"(a1), "+v"(a2), "+v"(a3), "+v"(a4), "+v"(a5), "+v"(a6), "+v"(a7) : "v"(b), "v"(cc));
#else
                asm volatile("v_add_f32_dpp %0, %0, %0 quad_perm:[1,0,3,2] row_mask:0xf bank_mask:0xf bound_ctrl:1\n v_add_f32_dpp %1, %1, %1 quad_perm:[1,0,3,2] row_mask:0xf bank_mask:0xf bound_ctrl:1\n v_add_f32_dpp %2, %2, %2 quad_perm:[1,0,3,2] row_mask:0xf bank_mask:0xf bound_ctrl:1\n v_add_f32_dpp %3, %3, %3 quad_perm:[1,0,3,2] row_mask:0xf bank_mask:0xf bound_ctrl:1\n v_add_f32_dpp %4, %4, %4 quad_perm:[1,0,3,2] row_mask:0xf bank_mask:0xf bound_ctrl:1\n v_add_f32_dpp %5, %5, %5 quad_perm:[1,0,3,2] row_mask:0xf bank_mask:0xf bound_ctrl:1\n v_add_f32_dpp %6, %6, %6 quad_perm:[1,0,3,2] row_mask:0xf bank_mask:0xf bound_ctrl:1\n v_add_f32_dpp %7, %7, %7 quad_perm:[1,0,3,2] row_mask:0xf bank_mask:0xf bound_ctrl:1"
                    : "+v"(a0), "+v"(a1), "+v"(a2), "+v"(a3), "+v"(a4), "+v"(a5), "+v"(a6), "+v"(a7) : "v"(b), "v"(cc));
#endif
            }
            asm volatile("" :: "v"(a0), "v"(a1), "v"(a2), "v"(a3), "v"(a4), "v"(a5), "v"(a6), "v"(a7));
        }
#endif

        for (int idx = gw * 64 + lane; idx < 4 * 3 * 12288; idx += NGW * 64) {
            const int l = idx / 36864, c = (idx / 12288) % 3, n = idx % 12288;
            float s = b_mod[l * 12288 + n];
            const float* pp = MODP + ((size_t)(l * 64) * 3 + c) * 12288 + n;
#pragma unroll 8
            for (int kc = 0; kc < 64; ++kc) s += pp[(size_t)kc * 3 * 12288];
            MOD[idx] = s;
        }
        for (int idx = gw * 64 + lane; idx < 2048; idx += NGW * 64) {
            const int pos = idx >> 4, i = idx & 15;
            float inv = (i & 3) == 0 ? 1.0f : ((i & 3) == 1 ? 0.5623413251903491f : ((i & 3) == 2 ? 0.31622776601683794f : 0.17782794100389228f));
            inv *= (i >> 2) == 0 ? 1.0f : ((i >> 2) == 1 ? 0.1f : ((i >> 2) == 2 ? 0.01f : 0.001f));
            float cc, sn; sincos_acc((float)pos * inv, cc, sn);
            TAB[idx] = (f32x2){cc, sn};
        }
        SEAM(1);
    }
    for (int l = 0; l < DEPTH; ++l) {
        const int pb = 2 + PPL * l;
        const bool with_ctx = l < DEPTH - 1;
#define hin_lat (l == 0 ? x_in : (const float*)out)
#define hin_ctx (l == 0 ? ctx_in : (const float*)HCTX)
#define mod (MOD + (size_t)l * 3 * 12288)
        const int nrows = with_ctx ? MROWS : NLAT;
        if (IN(pb + 0)) {
            for (int rep = 0; rep < REP_XN; ++rep)
            phase_xn(hin_lat, hin_ctx, mod, XN, OPQ_S(gw), NGW, OPQ_V(lane));
            SEAM(pb + 0);
#ifdef PROBE_BAR
            SEAM(pb + 0); SEAM(pb + 0); SEAM(pb + 0); SEAM(pb + 0);
#endif
        }
        if (IN(pb + 1)) {
            constexpr int C0 = 5632, NA_ = NIN - C0;
            pg8::Gemm g{XN, WINT + (size_t)l * NIN * DM + (size_t)C0 * DM, MROWS, NA_, DM}; pg8::StaticOrder S; S.init(MROWS, NA_, G, bx);
            pg8::EpiStoreBf16 E{P + C0, NIN};
            pg8::gemm_phase<pg8::EpiStoreBf16, pg8::StaticOrder, true, true>(lds, g, S, E);
            SEAM(pb + 1);
        }
        if (IN(pb + 2)) {
            if (bx >= RWP_BLOCKS) {
                constexpr int NB_ = 5632;
                pg8::Gemm g{XN, WINT + (size_t)l * NIN * DM, MROWS, NB_, DM}; pg8::StaticOrder S; S.init(MROWS, NB_, G - RWP_BLOCKS, bx - RWP_BLOCKS);
                pg8::EpiStoreBf16 E{P, NIN};
                pg8::gemm_phase<pg8::EpiStoreBf16, pg8::StaticOrder, true, true>(lds, g, S, E);
            }
            phase_rwprep(P, rw_mu_rkv + (size_t)l * 6144, rw_mu_lora + (size_t)l * 256, rw_w0 + (size_t)l * 2048, WUPT + (size_t)l * 131072, rw_a0 + (size_t)l * 2048, AUPT + (size_t)l * 131072,
                         rw_k_k + (size_t)l * 1024, rw_k_a + (size_t)l * 1024, rw_r_k + (size_t)l * 1024, REC, BON, lds, WSP(unsigned, WS_CTL) + CW_RWQ + l * 1024, (bx * NWAVES + wave) & 15, wave, OPQ_V(lane));
            SEAM(pb + 2);
        }
        if (IN(pb + 3)) {
            phase_rowprep(P, na_qg + l * 64, na_kg + l * 64, TAB, QN, KN, SGST, OPQ_S(gw), NGW, OPQ_V(lane));
            phase_vt(P, VTL, VTC, OPQ_S(gw), NGW, OPQ_V(lane));
            SEAM(pb + 3);
        }
        if (IN(pb + 4)) {
#ifdef PROBE_MIX
            for (int rep = 0; rep < 2; ++rep) {
#else
            {
#endif
            phase_sgu(P, SGST, sg_ln_w + (size_t)l * 1024, sg_ln_b + (size_t)l * 1024, SGW + (size_t)l * 131072, sg_b + (size_t)l * 1024, Y, lds, nrows / 128, OPQ_V(tid), wave, OPQ_V(lane));
            LAS unsigned* mixq = (LAS unsigned*)(lds + LDSCTL_OFF + 64); LAS unsigned* mixb = (LAS unsigned*)(lds + LDSCTL_OFF + 128);
            if (tid == 0) { *mixq = 0u; *mixb = 0u; }
            __syncthreads();
            if (wave < 4) scan_self(REC, YR, lds, mixb, bx, wave, OPQ_V(lane));
#ifdef PROBE_SEQ
            if (wave >= 4) { unsigned sp = 0; while (__hip_atomic_load(mixb, __ATOMIC_RELAXED, __HIP_MEMORY_SCOPE_WORKGROUP) < 4u * (SCANLEN / 32)) { __builtin_amdgcn_s_sleep(8); if (++sp > (1u << 24)) break; } }
#endif
            {   const int nctxu = with_ctx ? 2 : 0, npool = (nrows / 16) * 4, npq = (npool + NGRID - 1) / NGRID, nwc = l + 1 < DEPTH ? (WC_ITEMS + NGRID - 1) / NGRID : 0, nq = 64 + nctxu + npq + nwc;
                for (;;) {
                    unsigned k = 0; if (lane == 0) k = __hip_atomic_fetch_add(mixq, 1u, __ATOMIC_RELAXED, __HIP_MEMORY_SCOPE_WORKGROUP);
                    k = (unsigned)__builtin_amdgcn_readfirstlane((int)k);
                    if ((int)k >= nq) break;
                    const int ln = OPQ_V(lane);
                    if (k < 64u) { na_unit<false>(QN, KN, VTL, VTC, P, na_rpb + (size_t)l * 16 * 15 * 31, Y, bx * 64 + (int)k, ln);
#ifdef PROBE_NA2
                        na_unit<false>(QN, KN, VTL, VTC, P, na_rpb + (size_t)l * 16 * 15 * 31, Y, bx * 64 + (int)k, OPQ_V(ln));
#endif
                    }
                    else if ((int)k < 64 + nctxu) na_unit<true>(QN, KN, VTL, VTC, P, na_rpb, Y, bx * 2 + ((int)k - 64), ln);
                    else if ((int)k >= 64 + nctxu + npq) { const int r = bx + NGRID * ((int)k - 64 - nctxu - npq);
                        if (r < WC_ITEMS) weight_copy_item(l + 1, r, w_in, w_out, pool_w, rw_w_up, rw_a_up, sg_w, WINT, WOUTT, POOLWT, WUPT, AUPT, SGW, ln); }
                    else { const int u = bx + NGRID * ((int)k - 64 - nctxu);
                        if (u < npool) { const int tt = u >> 2, g = u & 3; const bf16* wbase = POOLWT + (size_t)l * 262144 + (size_t)g * 65536; const float* psc = pool_scale + (size_t)l * 1024;
                            if (g == 0) pool_unit<0>(P, wbase, psc, Y, tt * 16, ln); else if (g == 1) pool_unit<1>(P, wbase, psc, Y, tt * 16, ln);
                            else if (g == 2) pool_unit<2>(P, wbase, psc, Y, tt * 16, ln); else pool_unit<3>(P, wbase, psc, Y, tt * 16, ln); } }
                }
            }
#ifdef PROBE_MIX
            __syncthreads();
#endif
            }
            SEAM(pb + 4);
        }
        if (IN(pb + 5)) {
            for (int rep = 0; rep < REP_FIN; ++rep)
            phase_rwfin(P, YR, REC, BON, rw_ln_w + (size_t)l * 1024, rw_ln_b + (size_t)l * 1024, Y, nrows, OPQ_S(gw), NGW, OPQ_V(lane));
            SEAM(pb + 5);
        }
        if (IN(pb + 6)) {
            pg8::Gemm g{Y, WOUTT + (size_t)l * DM * DM, nrows, DM, DM}; pg8::StaticOrder S; S.init(nrows, DM, G, bx);
#ifdef PROBE_G2
            { pg8::EpiResGate E0{hin_lat, hin_ctx, (float*)REC, (float*)REC + (size_t)NLAT * DM, mod}; pg8::gemm_phase<pg8::EpiResGate, pg8::StaticOrder, true, true>(lds, g, S, E0); }
#endif
            pg8::EpiResGate E{hin_lat, hin_ctx, out, HCTX, mod};
            pg8::gemm_phase<pg8::EpiResGate, pg8::StaticOrder, true, true>(lds, g, S, E);
            SEAM(pb + 6);
        }
    }
#undef IN
#undef SEAM
}
#undef hin_lat
#undef hin_ctx
#undef mod
#undef P
#undef Y
#undef XN
#undef out

extern "C" void kernel_launch(void* const* d_in, const int* in_sizes, int n_in, void* d_out, int out_size, void* d_ws, size_t ws_size, hipStream_t stream) {
    static int grid = 0;
    if (grid == 0) {
        if (n_in != 28 || out_size != NLAT * DM || ws_size < WS_END) { fprintf(stderr, "kernel_launch: unexpected shapes (n_in %d, out %d, ws %zu < %zu); nothing launched\n", n_in, out_size, ws_size, (size_t)WS_END); grid = -1; return; }
        int dev = 0, cus = 0, per_cu = 0;
        if (hipGetDevice(&dev) != hipSuccess || hipDeviceGetAttribute(&cus, hipDeviceAttributeMultiprocessorCount, dev) != hipSuccess) { grid = -1; return; }
        if (hipFuncSetAttribute((const void*)fwd, hipFuncAttributeMaxDynamicSharedMemorySize, LDS_BYTES) != hipSuccess) { fprintf(stderr, "kernel_launch: hipFuncSetAttribute failed\n"); grid = -1; return; }
        if (hipOccupancyMaxActiveBlocksPerMultiprocessor(&per_cu, (const void*)fwd, NWAVES * 64, LDS_BYTES) != hipSuccess || per_cu < 1)
            fprintf(stderr, "kernel_launch: note: occupancy query reports %d workgroups per CU\n", per_cu);
        (void)hipGetLastError();
        grid = cus >= NGRID ? NGRID : -2;
    }
    if (grid == -1) return;
    if (hipMemsetAsync((char*)d_ws + WS_CTL, 0, CTL_ZERO_BYTES, stream) != hipSuccess) { fprintf(stderr, "kernel_launch: memset failed\n"); return; }
    Args a{};
    for (int i = 0; i < 28; ++i) a.in[i] = (const float*)d_in[i];
    a.out = (float*)d_out; a.ws = (unsigned char*)d_ws; a.li = 0; a.pad = 0;
    const bool split = MK_SPLIT || grid == -2;
    if (split) { for (int k = 0; k < NPHASE; ++k) { a.ph_lo = k; a.ph_hi = k + 1; hipLaunchKernelGGL(fwd, dim3(NGRID), dim3(NWAVES * 64), LDS_BYTES, stream, a); } }
    else { a.ph_lo = 0; a.ph_hi = NPHASE; hipLaunchKernelGGL(fwd, dim3(NGRID), dim3(NWAVES * 64), LDS_BYTES, stream, a); }
    const hipError_t le = hipPeekAtLastError();
    if (le != hipSuccess) fprintf(stderr, "kernel_launch: launch failed: %s\n", hipGetErrorName(le));
}
```

```cpp
#include <hip/hip_runtime.h>
#include <cstdio>
#include <cstdint>
#define MK_SPLIT 0
#define REC_NT 1
namespace pg8 {
#define PG8_LAS __attribute__((address_space(3)))
typedef unsigned short bf16_t;
typedef short bf16x8 __attribute__((ext_vector_type(8)));
typedef float f32x4 __attribute__((ext_vector_type(4)));
typedef unsigned u32x4 __attribute__((ext_vector_type(4)));
constexpr int BM = 256, BK = 64, HALF = 128, HTB = HALF * BK * 2  , STAGE_BYTES = 8 * HTB, NXCD = 8, WGM = 8;

__host__ __device__ __forceinline__ int lds_byte(int r, int c) { const int st = (r >> 4) * 2 + (c >> 5), rr = r & 15, cc = c & 31, ob = rr * 64 + cc * 2; return st * 1024 + (ob ^ (((ob >> 9) & 1) << 5)); }
__host__ __device__ __forceinline__ void stage_rc(int b, int& R, int& C) { const int st = b / 1024, sb = b % 1024, swz = sb ^ (((sb >> 9) & 1) << 5); R = (st >> 1) * 16 + swz / 64; C = (st & 1) * 32 + (swz % 64) / 2; }
__host__ __device__ __forceinline__ int perm32(int rho) { const int n = rho >> 4, i = rho & 15; return 8 * (i >> 2) + 4 * n + (i & 3); }

struct Unit { int pm, pn; };
struct Gemm { const bf16_t* A; const bf16_t* Bt; int M, N, K; };

struct StaticOrder {
    int nM, nN, nwg, G, c;
    __host__ __device__ void init(int M, int N, int G_, int c_) { nM = M / BM; nN = N / BM; nwg = nM * nN; G = G_; c = c_; }
    __host__ __device__ bool next(int i, Unit& u) const {
        const long L = (long)i * G + c; if (L >= nwg) return false;
        int wgid = (int)L; { const int q = nwg / NXCD, r = nwg % NXCD, xcd = wgid % NXCD, off = wgid / NXCD; wgid = (xcd < r ? xcd * (q + 1) : r * (q + 1) + (xcd - r) * q) + off; }
        const int nig = WGM * nN, gid = wgid / nig, fm = gid * WGM, gsz = (nM - fm) < WGM ? (nM - fm) : WGM;
        u.pm = fm + ((wgid % nig) % gsz); u.pn = (wgid % nig) / gsz; return true;
    }
    __device__ __forceinline__ void a_ready(const Unit&) const {}
    __device__ __forceinline__ void done(const Unit&) const {}
};

__device__ __forceinline__ unsigned cvt_pk_bf16(float lo, float hi) { unsigned r; asm volatile("v_cvt_pk_bf16_f32 %0, %1, %2" : "=v"(r) : "v"(lo), "v"(hi)); return r; }
template <class Epi, class Sched, bool ALIGN_EPI = false, bool SP2 = false>
__device__ __forceinline__ void gemm_phase(PG8_LAS unsigned char* lds, const Gemm g, const Sched& S, const Epi& E) {
    int tid_ = threadIdx.x; asm volatile("" : "+v"(tid_));
    const int tid = tid_, wid = __builtin_amdgcn_readfirstlane(tid >> 6), lane = tid & 63, wr = wid >> 2, wc = wid & 3, fr = lane & 15, fq = lane >> 4;
    const int K = g.K, nt = K / BK;
    unsigned voffA[2], voffB[2];
#pragma unroll
    for (int i = 0; i < 2; ++i) { int R, C; stage_rc(tid * 16 + i * 8192, R, C); const int Rb = Epi::PERM ? ((R & ~31) + perm32(R & 31)) : R;
        voffA[i] = (unsigned)(R * K + C) * 2u; voffB[i] = (unsigned)(Rb * K + C) * 2u; }
    const size_t kstep = (size_t)(BK * 2);
    const size_t hstep = (size_t)HALF * K * 2;
    const size_t tstep = 2 * hstep;
    const unsigned ldsw = (unsigned)wid * 1024u;
    const int aoff = lds_byte(wr * 64 + fr, fq * 8), boff = lds_byte(wc * 32 + fr, fq * 8);
#define PG8_SA(b, h) (((b) * 2 + (h)) * HTB)
#define PG8_SB(b, h) ((4 + (b) * 2 + (h)) * HTB)
#define PG8_STAGE(bufoff, gbase, voff) do { _Pragma("unroll") for (int _i = 0; _i < 2; ++_i) \
        __builtin_amdgcn_global_load_lds((const unsigned*)((const char*)(gbase) + (voff)[_i]), (PG8_LAS unsigned*)(lds + (bufoff) + ldsw + _i * 8192), 16, 0, 0); } while (0)
#define PG8_LDA(dst, b, h) do { _Pragma("unroll") for (int m = 0; m < 4; ++m) _Pragma("unroll") for (int k = 0; k < 2; ++k) dst[m][k] = *(const PG8_LAS bf16x8*)(lds + PG8_SA(b, h) + aoff + m * 2048 + k * 1024); } while (0)
#define PG8_LDB(dst, b, h) do { _Pragma("unroll") for (int n = 0; n < 2; ++n) _Pragma("unroll") for (int k = 0; k < 2; ++k) dst[n][k] = *(const PG8_LAS bf16x8*)(lds + PG8_SB(b, h) + boff + n * 2048 + k * 1024); } while (0)
#define PG8_MMA(ai, bj, At, Bt) do { __builtin_amdgcn_s_setprio(1); _Pragma("unroll") for (int m = 0; m < 4; ++m) _Pragma("unroll") for (int n = 0; n < 2; ++n) _Pragma("unroll") for (int k = 0; k < 2; ++k) \
        acc[ai][bj][m][n] = __builtin_amdgcn_mfma_f32_16x16x32_bf16(Bt[n][k], At[m][k], acc[ai][bj][m][n], 0, 0, 0); __builtin_amdgcn_s_setprio(0); } while (0)
#define PG8_WAIT_V(n) asm volatile("s_waitcnt vmcnt(" #n ")" ::: "memory")
#define PG8_WAIT_L(n) asm volatile("s_waitcnt lgkmcnt(" #n ")" ::: "memory")
#define PG8_BAR __builtin_amdgcn_s_barrier()
#define PG8_SCHED __builtin_amdgcn_sched_barrier(0)
    Unit cur, nxt; int ui = 0;
    if (!S.next(0, cur)) return;
    f32x4 acc[2][2][4][2];
#pragma unroll
    for (int a = 0; a < 2; ++a)
#pragma unroll
        for (int b = 0; b < 2; ++b)
#pragma unroll
            for (int m = 0; m < 4; ++m)
#pragma unroll
                for (int n = 0; n < 2; ++n) acc[a][b][m][n] = (f32x4){0.f, 0.f, 0.f, 0.f};
    bf16x8 At[4][2], B0[2][2], B1[2][2];
    const char* cA = (const char*)g.A + (size_t)cur.pm * tstep; const char* cB = (const char*)g.Bt + (size_t)cur.pn * tstep;
    S.a_ready(cur);
    if constexpr (SP2) {
        PG8_STAGE(PG8_SB(0, 0), cB, voffB); PG8_STAGE(PG8_SB(0, 1), cB + hstep, voffB); PG8_STAGE(PG8_SA(0, 0), cA, voffA); PG8_STAGE(PG8_SA(0, 1), cA + hstep, voffA);
        if (wr == 1) PG8_BAR;
        PG8_WAIT_V(2); PG8_BAR;
        PG8_STAGE(PG8_SB(1, 0), cB + kstep, voffB); PG8_STAGE(PG8_SA(1, 0), cA + kstep, voffA); PG8_STAGE(PG8_SB(1, 1), cB + hstep + kstep, voffB);
        PG8_WAIT_V(6); PG8_BAR;
    } else {
        PG8_STAGE(PG8_SB(0, 0), cB, voffB); PG8_STAGE(PG8_SA(0, 0), cA, voffA); PG8_STAGE(PG8_SB(0, 1), cB + hstep, voffB); PG8_STAGE(PG8_SA(0, 1), cA + hstep, voffA);
        if (wr == 1) PG8_BAR;
        PG8_WAIT_V(4); PG8_BAR;
        PG8_STAGE(PG8_SB(1, 0), cB + kstep, voffB); PG8_STAGE(PG8_SA(1, 0), cA + kstep, voffA); PG8_STAGE(PG8_SB(1, 1), cB + hstep + kstep, voffB);
        PG8_WAIT_V(6); PG8_BAR;
    }
    for (;;) {
        const bool has_next = S.next(ui + 1, nxt);
        const char* nA = has_next ? (const char*)g.A + (size_t)nxt.pm * tstep : cA; const char* nB = has_next ? (const char*)g.Bt + (size_t)nxt.pn * tstep : cB;
        for (int t = 0; t < nt; t += 2) {
            const bool last = (t == nt - 2);
            const char* a1 = cA + (size_t)(t + 1) * kstep;
            const char* a2 = last ? nA : cA + (size_t)(t + 2) * kstep; const char* b2 = last ? nB : cB + (size_t)(t + 2) * kstep;
            const char* a3 = a2 + kstep; const char* b3 = b2 + kstep;
            if (last && has_next) S.a_ready(nxt);
            if constexpr (SP2) {
            PG8_LDB(B0, 0, 0); PG8_LDB(B1, 0, 1); PG8_SCHED; PG8_LDA(At, 0, 0); PG8_STAGE(PG8_SA(1, 1), a1 + hstep, voffA);
            PG8_WAIT_V(8); PG8_WAIT_L(0); PG8_BAR; PG8_MMA(0, 0, At, B0); PG8_MMA(0, 1, At, B1); PG8_BAR; PG8_SCHED;
            PG8_LDA(At, 0, 1); PG8_STAGE(PG8_SB(0, 0), b2, voffB); PG8_STAGE(PG8_SB(0, 1), b2 + hstep, voffB); PG8_STAGE(PG8_SA(0, 0), a2, voffA);
            PG8_WAIT_V(8); PG8_WAIT_L(0); PG8_BAR; PG8_MMA(1, 0, At, B0); PG8_MMA(1, 1, At, B1); PG8_BAR; PG8_SCHED;
            PG8_LDB(B0, 1, 0); PG8_LDB(B1, 1, 1); PG8_SCHED; PG8_LDA(At, 1, 0); PG8_STAGE(PG8_SA(0, 1), a2 + hstep, voffA);
            PG8_WAIT_V(8); PG8_WAIT_L(0); PG8_BAR; PG8_MMA(0, 0, At, B0); PG8_MMA(0, 1, At, B1); PG8_BAR; PG8_SCHED;
            PG8_LDA(At, 1, 1); PG8_STAGE(PG8_SB(1, 0), b3, voffB); PG8_STAGE(PG8_SB(1, 1), b3 + hstep, voffB); PG8_STAGE(PG8_SA(1, 0), a3, voffA);
            PG8_WAIT_V(8); PG8_WAIT_L(0); PG8_BAR; PG8_MMA(1, 0, At, B0); PG8_MMA(1, 1, At, B1); PG8_BAR; PG8_SCHED;
            } else {
            PG8_LDB(B0, 0, 0); PG8_SCHED; PG8_LDA(At, 0, 0); PG8_STAGE(PG8_SA(1, 1), a1 + hstep, voffA);
            PG8_WAIT_L(8); PG8_BAR; PG8_WAIT_L(0); PG8_MMA(0, 0, At, B0); PG8_BAR; PG8_SCHED;
            PG8_LDB(B1, 0, 1); PG8_STAGE(PG8_SB(0, 0), b2, voffB);
            PG8_BAR; PG8_WAIT_L(0); PG8_MMA(0, 1, At, B1); PG8_BAR;
            PG8_LDA(At, 0, 1); PG8_STAGE(PG8_SA(0, 0), a2, voffA);
            PG8_BAR; PG8_WAIT_L(0); PG8_MMA(1, 0, At, B0); PG8_BAR; PG8_SCHED;
            PG8_STAGE(PG8_SB(0, 1), b2 + hstep, voffB);
            PG8_WAIT_V(6); PG8_BAR; PG8_MMA(1, 1, At, B1); PG8_BAR;
            PG8_LDB(B0, 1, 0); PG8_SCHED; PG8_LDA(At, 1, 0); PG8_STAGE(PG8_SA(0, 1), a2 + hstep, voffA);
            PG8_WAIT_L(8); PG8_BAR; PG8_WAIT_L(0); PG8_MMA(0, 0, At, B0); PG8_BAR; PG8_SCHED;
            PG8_LDB(B1, 1, 1); PG8_STAGE(PG8_SB(1, 0), b3, voffB);
            PG8_BAR; PG8_WAIT_L(0); PG8_MMA(0, 1, At, B1); PG8_BAR;
            PG8_LDA(At, 1, 1); PG8_STAGE(PG8_SA(1, 0), a3, voffA);
            PG8_BAR; PG8_WAIT_L(0); PG8_MMA(1, 0, At, B0); PG8_BAR; PG8_SCHED;
            PG8_STAGE(PG8_SB(1, 1), b3 + hstep, voffB);
            PG8_WAIT_V(6); PG8_BAR; PG8_MMA(1, 1, At, B1); PG8_BAR;
            }
        }
        if constexpr (ALIGN_EPI) { if (wr == 0) PG8_BAR; }
        if constexpr (!Epi::AFTER_DRAIN) { E(acc, cur, wr, wc, fr, fq); S.done(cur); }
        if (!has_next) break;
#pragma unroll
        for (int a = 0; a < 2; ++a)
#pragma unroll
            for (int b = 0; b < 2; ++b)
#pragma unroll
                for (int m = 0; m < 4; ++m)
#pragma unroll
                    for (int n = 0; n < 2; ++n) acc[a][b][m][n] = (f32x4){0.f, 0.f, 0.f, 0.f};
        cur = nxt; cA = nA; cB = nB; ++ui;
        if constexpr (ALIGN_EPI) { if (wr == 1) PG8_BAR; }
    }
    PG8_WAIT_V(0);
    if constexpr (!ALIGN_EPI) { if (wr == 0) PG8_BAR; }
    PG8_BAR;
    if constexpr (Epi::AFTER_DRAIN) { E.fused(acc, cur, wr, wc, fr, fq, lds, wid, lane); S.done(cur); }
#undef PG8_SA
#undef PG8_SB
#undef PG8_STAGE
#undef PG8_LDA
#undef PG8_LDB
#undef PG8_MMA
#undef PG8_WAIT_V
#undef PG8_WAIT_L
#undef PG8_BAR
#undef PG8_SCHED
}
}

constexpr int DM = 4096, NBATCH = 2, SEQ = 8192, DEPTH = 4, CTXL = 256;
constexpr int NLAT = NBATCH * SEQ, NCTX = NBATCH * CTXL, MROWS = NLAT + NCTX;
constexpr int NIN = 13568, GWD = 1024;
constexpr int C_POOLV = 0, C_POOLZ = 1024, C_NAZ = 2048, C_RWZ = 3072, C_SGU = 4096, C_SGZ = 5120, C_NAQ = 6144, C_NAK = 7168, C_NAV = 8192, C_RWR = 9216, C_RWK = 10240, C_RWV = 11264,
              C_RWWD = 12288, C_RWAD = 12416, C_SGV = 12544;
constexpr int C_SPLIT = 5632;
__host__ __device__ __forceinline__ int phys_tile(int lt) {
    return lt < 8 ? lt : lt < 20 ? lt + 16 : lt < 24 ? lt - 12 : lt < 36 ? lt + 12 : lt < 40 ? lt - 24 : lt == 40 ? 48 : lt < 45 ? lt - 25 : lt < 49 ? lt + 4 : lt - 29;
}
constexpr int SCANLEN = CTXL + SEQ;
constexpr int NCHAIN = 64;
constexpr int RECB = 896;
constexpr int RECF = RECB / 4;
constexpr int NWAVES = 8;

constexpr size_t MiB = 1u << 20;
constexpr size_t WS_CTL = 0, CTL_ZERO_BYTES = 1 * MiB;
constexpr size_t WS_MOD   = 2 * MiB;
constexpr size_t WS_TAB   = 3 * MiB;
constexpr size_t WS_SGST  = 4 * MiB;
constexpr size_t WS_BON   = 5 * MiB;
constexpr size_t WS_POOLWT= 8 * MiB;
constexpr size_t WS_WUPT  = 10 * MiB;
constexpr size_t WS_AUPT  = 11 * MiB;
constexpr size_t WS_SGW   = 12 * MiB;
constexpr size_t WS_VTC   = 13 * MiB;
constexpr size_t WS_HCTX  = 14 * MiB;
constexpr size_t WS_MODP  = 22 * MiB;
constexpr size_t WS_VTL   = 58 * MiB;
constexpr size_t WS_QN    = 90 * MiB;
constexpr size_t WS_KN    = 123 * MiB;
constexpr size_t WS_WOUTT = 156 * MiB;
constexpr size_t WS_WINT  = 284 * MiB;
constexpr size_t WS_XN    = 708 * MiB;
constexpr size_t WS_Y     = 840 * MiB;
constexpr size_t WS_P     = 972 * MiB;
constexpr size_t WS_YR    = 1410 * MiB;
constexpr size_t WS_REC   = 1542 * MiB;
constexpr size_t WS_END   = 2334 * MiB;
static_assert(WS_P + (size_t)MROWS * NIN * 2 <= WS_YR && WS_REC + (size_t)NCHAIN * SCANLEN * RECB <= WS_END && WS_WINT + (size_t)4 * NIN * DM * 2 <= WS_XN, "ws map");
constexpr int CW_TMO = 0, CW_BAR = 4096;

constexpr int RING_BYTES = 131072, LDSCTL_OFF = RING_BYTES, MISC_OFF = LDSCTL_OFF + 320, LDS_BYTES = 147456;

#define GAS __attribute__((address_space(1)))
#define LAS __attribute__((address_space(3)))
typedef unsigned short bf16;
typedef unsigned v4u __attribute__((ext_vector_type(4)));
typedef unsigned v2u __attribute__((ext_vector_type(2)));
typedef float f32x4 __attribute__((ext_vector_type(4)));
typedef float f32x2 __attribute__((ext_vector_type(2)));
typedef short bf16x8 __attribute__((ext_vector_type(8)));
typedef _Float16 h4 __attribute__((ext_vector_type(4)));
typedef _Float16 h8 __attribute__((ext_vector_type(8)));
#define RLX_AGENT __ATOMIC_RELAXED, __HIP_MEMORY_SCOPE_AGENT
#define LDS_WAIT() asm volatile("s_waitcnt lgkmcnt(0)" ::: "memory")

__device__ __forceinline__ float bf2f(unsigned short h) { return __uint_as_float(((unsigned)h) << 16); }
__device__ __forceinline__ float bflo(unsigned w) { return __uint_as_float(w << 16); }
__device__ __forceinline__ float bfhi(unsigned w) { return __uint_as_float(w & 0xffff0000u); }
typedef __bf16 bf16x2_t __attribute__((ext_vector_type(2)));
__device__ __forceinline__ unsigned pk2(float lo, float hi) { const f32x2 v = {lo, hi}; const bf16x2_t b = __builtin_convertvector(v, bf16x2_t); return __builtin_bit_cast(unsigned, b); }
__device__ __forceinline__ unsigned f2bf(float f) { return pk2(f, 0.f) & 0xffffu; }
__device__ __forceinline__ float rcp_f(float x) { return __builtin_amdgcn_rcpf(x); }
__device__ __forceinline__ float rsq_f(float x) { return __builtin_amdgcn_rsqf(x); }
__device__ __forceinline__ void unpack8(const v4u w, float* x) { x[0] = bflo(w.x); x[1] = bfhi(w.x); x[2] = bflo(w.y); x[3] = bfhi(w.y); x[4] = bflo(w.z); x[5] = bfhi(w.z); x[6] = bflo(w.w); x[7] = bfhi(w.w); }
__device__ __forceinline__ v4u pack8(const float* x) { v4u w; w.x = pk2(x[0], x[1]); w.y = pk2(x[2], x[3]); w.z = pk2(x[4], x[5]); w.w = pk2(x[6], x[7]); return w; }
__device__ __forceinline__ float silu_f(float x) { return x * rcp_f(1.f + __expf(-x)); }
__device__ __forceinline__ float wave_sum(float v) {
#pragma unroll
    for (int o = 1; o < 64; o <<= 1) v += __shfl_xor(v, o);
    return v;
}
template <int CTRL> __device__ __forceinline__ float dppf(float v) { return __builtin_bit_cast(float, __builtin_amdgcn_update_dpp(0, __builtin_bit_cast(int, v), CTRL, 0xF, 0xF, true)); }
__device__ __forceinline__ float red16(float v) { v += dppf<0xB1>(v); v += dppf<0x4E>(v); v += dppf<0x141>(v); v += dppf<0x140>(v); return v; }
__device__ __forceinline__ void red16x2(float& a, float& b) {
    a += dppf<0xB1>(a); b += dppf<0xB1>(b); a += dppf<0x4E>(a); b += dppf<0x4E>(b); a += dppf<0x141>(a); b += dppf<0x141>(b); a += dppf<0x140>(a); b += dppf<0x140>(b); }
__device__ __forceinline__ float red16_transpose(const float (&y)[16], int c16) {
    float a[8], b[4], c[2];
    const bool h8 = (c16 & 8) != 0, h4 = (c16 & 4) != 0, h2 = (c16 & 2) != 0, h1 = (c16 & 1) != 0;
#pragma unroll
    for (int j = 0; j < 8; ++j) { const float keep = h8 ? y[j + 8] : y[j], send = h8 ? y[j] : y[j + 8]; a[j] = keep + dppf<0x140>(send); }
#pragma unroll
    for (int j = 0; j < 4; ++j) { const float keep = h4 ? a[j + 4] : a[j], send = h4 ? a[j] : a[j + 4]; b[j] = keep + dppf<0x141>(send); }
#pragma unroll
    for (int j = 0; j < 2; ++j) { const float keep = h2 ? b[j + 2] : b[j], send = h2 ? b[j] : b[j + 2]; c[j] = keep + dppf<0x1B>(send); }
    const float keep = h1 ? c[1] : c[0], send = h1 ? c[0] : c[1];
    return keep + dppf<0xB1>(send);
}
__device__ __forceinline__ float max16x4(float v) { v = fmaxf(v, __shfl_xor(v, 16)); v = fmaxf(v, __shfl_xor(v, 32)); return v; }
__device__ __forceinline__ float sum16x4(float v) { v += __shfl_xor(v, 16); v += __shfl_xor(v, 32); return v; }
__device__ __forceinline__ int scan_pos(int d, bool isctx, int t) { return d == 0 ? (isctx ? t : CTXL + t) : (isctx ? (CTXL - 1 - t) : (CTXL + SEQ - 1 - t)); }
__device__ __forceinline__ f32x4 mfma16(bf16x8 a, bf16x8 b, f32x4 c) { return __builtin_amdgcn_mfma_f32_16x16x32_bf16(a, b, c, 0, 0, 0); }
__device__ __forceinline__ bf16x8 ld_frag(const bf16* p) { return __builtin_bit_cast(bf16x8, *(const v4u*)p); }

namespace pg8 {
struct EpiStoreBf16 {
    static constexpr bool PERM = true, AFTER_DRAIN = false;
    bf16_t* O; int ldc;
    __device__ __forceinline__ void operator()(const f32x4 (&acc)[2][2][4][2], const Unit& u, int wr, int wc, int fr, int fq) const {
        const int row0 = u.pm * BM + wr * 64 + fr, col0 = u.pn * BM + wc * 32 + 8 * fq;
#pragma unroll
        for (int ai = 0; ai < 2; ++ai)
#pragma unroll
            for (int m = 0; m < 4; ++m) { bf16_t* rowp = O + (size_t)(row0 + ai * HALF + m * 16) * ldc + col0;
#pragma unroll
                for (int bj = 0; bj < 2; ++bj) { const f32x4 v0 = acc[ai][bj][m][0], v1 = acc[ai][bj][m][1];
                    u32x4 w; w.x = cvt_pk_bf16(v0[0], v0[1]); w.y = cvt_pk_bf16(v0[2], v0[3]); w.z = cvt_pk_bf16(v1[0], v1[1]); w.w = cvt_pk_bf16(v1[2], v1[3]);
                    *(u32x4*)(rowp + bj * HALF) = w; } }
    }
};
struct EpiResGate {
    static constexpr bool PERM = false, AFTER_DRAIN = false;
    const float* hin_lat; const float* hin_ctx; float* hout_lat; float* hout_ctx; const float* gate;
    __device__ __forceinline__ void operator()(const f32x4 (&acc)[2][2][4][2], const Unit& u, int wr, int wc, int fr, int fq) const {
        const int cond = u.pm < 32 ? 0 : (u.pm < 64 ? 1 : 2);
        const int rloc = (u.pm < 64 ? u.pm * BM : (u.pm - 64) * BM) + wr * 64 + fr, col0 = u.pn * BM + wc * 32 + 4 * fq;
        const float* hin = u.pm < 64 ? hin_lat : hin_ctx; float* hout = u.pm < 64 ? hout_lat : hout_ctx;
        f32x4 gv[2][2];
#pragma unroll
        for (int bj = 0; bj < 2; ++bj)
#pragma unroll
            for (int n = 0; n < 2; ++n) gv[bj][n] = *(const f32x4*)(gate + cond * 12288 + 8192 + col0 + bj * HALF + n * 16);
#pragma unroll
        for (int ai = 0; ai < 2; ++ai)
#pragma unroll
            for (int m = 0; m < 4; ++m) { const size_t off = (size_t)(rloc + ai * HALF + m * 16) * 4096 + col0;
#pragma unroll
                for (int bj = 0; bj < 2; ++bj)
#pragma unroll
                    for (int n = 0; n < 2; ++n) { const f32x4 b = *(const f32x4*)(hin + off + bj * HALF + n * 16);
                        *(f32x4*)(hout + off + bj * HALF + n * 16) = b + gv[bj][n] * acc[ai][bj][m][n]; } }
    }
};
}

template <bool PERMC = false>
__device__ __forceinline__ void p0_transpose_item(const float* W, int K, int N, bf16* WT, LAS float* scr, int item, int lane) {
    const int nblk = N / 32, kb = item / nblk, nb = item % nblk, k0 = 64 * kb, n0 = 32 * nb;
    const int pn0 = PERMC ? phys_tile(n0 >> 8) * 256 + (n0 & 255) : n0;
#pragma unroll 8
    for (int i = 0; i < 32; ++i) { const int kk = 2 * i + (lane >> 5); scr[kk * 33 + (lane & 31)] = W[(size_t)(k0 + kk) * N + n0 + (lane & 31)]; }
    LDS_WAIT(); asm volatile("" ::: "memory");
    const int c = lane & 7;
#pragma unroll
    for (int j = 0; j < 4; ++j) { const int n = (lane >> 3) + 8 * j; const LAS float* s = scr + (8 * c) * 33 + n;
        v4u o; o.x = pk2(s[0 * 33], s[1 * 33]); o.y = pk2(s[2 * 33], s[3 * 33]); o.z = pk2(s[4 * 33], s[5 * 33]); o.w = pk2(s[6 * 33], s[7 * 33]);
        *(v4u*)(WT + (size_t)(pn0 + n) * K + k0 + 8 * c) = o; }
    LDS_WAIT(); asm volatile("" ::: "memory");
}
template <bool PERMC = false>
__device__ __forceinline__ void transpose_item_nolds(const float* W, int K, int N, bf16* WT, int item, int lane) {
    const int nblk = N / 64, kb = item / nblk, nb = item % nblk, k0 = 64 * kb, n0 = 64 * nb;
    const int pn0 = PERMC ? phys_tile(n0 >> 8) * 256 + (n0 & 255) : n0;
    const float* src = W + (size_t)k0 * N + n0 + lane;
    bf16* dst = WT + (size_t)(pn0 + lane) * K + k0;
#pragma unroll
    for (int hb = 0; hb < 2; ++hb) {
        float v[32];
#pragma unroll
        for (int i = 0; i < 32; ++i) v[i] = src[(size_t)(32 * hb + i) * N];
        __builtin_amdgcn_sched_barrier(0);
#pragma unroll
        for (int j = 0; j < 4; ++j) { v4u o; o.x = pk2(v[8 * j], v[8 * j + 1]); o.y = pk2(v[8 * j + 2], v[8 * j + 3]); o.z = pk2(v[8 * j + 4], v[8 * j + 5]); o.w = pk2(v[8 * j + 6], v[8 * j + 7]);
            *(v4u*)(dst + 32 * hb + 8 * j) = o; }
        __builtin_amdgcn_sched_barrier(0);
    }
}
constexpr int WC_WIN = (DM / 64) * (NIN / 64), WC_WOUT = (DM / 64) * (DM / 64), WC_POOL = 4 * 16, WC_WUP = 2 * 16, WC_AUP = 2 * 16, WC_SGW = 256, WC_ITEMS = WC_WIN + WC_WOUT + WC_POOL + WC_WUP + WC_AUP + WC_SGW;
__device__ __forceinline__ void weight_copy_item(int L, int r, const float* w_in, const float* w_out, const float* pool_w, const float* rw_w_up, const float* rw_a_up, const float* sg_w,
                                                 bf16* WINT, bf16* WOUTT, bf16* POOLWT, bf16* WUPT, bf16* AUPT, bf16* SGW, int lane) {
    if (r < WC_WIN) { transpose_item_nolds<true>(w_in + (size_t)L * DM * NIN, DM, NIN, WINT + (size_t)L * NIN * DM, r, lane); return; } r -= WC_WIN;
    if (r < WC_WOUT) { transpose_item_nolds(w_out + (size_t)L * DM * DM, DM, DM, WOUTT + (size_t)L * DM * DM, r, lane); return; } r -= WC_WOUT;
    if (r < WC_POOL) { const int g = r >> 4; transpose_item_nolds(pool_w + (size_t)(L * 4 + g) * 65536, 256, 256, POOLWT + (size_t)(L * 4 + g) * 65536, r & 15, lane); return; } r -= WC_POOL;
    if (r < WC_WUP) { const int dd = r >> 4; transpose_item_nolds(rw_w_up + (size_t)(L * 2 + dd) * 65536, 64, 1024, WUPT + (size_t)(L * 2 + dd) * 65536, r & 15, lane); return; } r -= WC_WUP;
    if (r < WC_AUP) { const int dd = r >> 4; transpose_item_nolds(rw_a_up + (size_t)(L * 2 + dd) * 65536, 64, 1024, AUPT + (size_t)(L * 2 + dd) * 65536, r & 15, lane); return; } r -= WC_AUP;
    {   const size_t e0 = (size_t)L * 131072 + (size_t)r * 512 + lane * 8; const f32x4 a = *(const f32x4*)(sg_w + e0), b = *(const f32x4*)(sg_w + e0 + 4);
        v4u o; o.x = pk2(a.x, a.y); o.y = pk2(a.z, a.w); o.z = pk2(b.x, b.y); o.w = pk2(b.z, b.w); *(v4u*)(SGW + e0) = o; }
}
__device__ __forceinline__ void p0_mod_item(const float* wmod, const float* cvec, const float* cctx, float* MODP, LAS float* scr, int item, int lane) {
    const int l = item / (64 * 48), r = item % (64 * 48), kc = r / 48, nc = r % 48, k0 = kc * 64, n0 = nc * 256 + lane * 4;
    scr[lane] = silu_f(cvec[k0 + lane]); scr[64 + lane] = silu_f(cvec[4096 + k0 + lane]); scr[128 + lane] = silu_f(cctx[k0 + lane]);
    LDS_WAIT(); asm volatile("" ::: "memory");
    f32x4 a0 = {0.f, 0.f, 0.f, 0.f}, a1 = a0, a2 = a0;
    const float* wp = wmod + ((size_t)l * 4096 + k0) * 12288 + n0;
#pragma unroll 16
    for (int k = 0; k < 64; ++k) { const f32x4 w = *(const f32x4*)(wp + (size_t)k * 12288); a0 += scr[k] * w; a1 += scr[64 + k] * w; a2 += scr[128 + k] * w; }
    float* o = MODP + ((size_t)(l * 64 + kc) * 3) * 12288 + n0;
    *(f32x4*)(o) = a0; *(f32x4*)(o + 12288) = a1; *(f32x4*)(o + 2 * 12288) = a2;
    LDS_WAIT(); asm volatile("" ::: "memory");
}
__device__ __forceinline__ void sincos_acc(float ang, float& c, float& s) {
    const double x = (double)ang; const double n = __builtin_rint(x * 0.63661977236758134308); const double r = x - n * 1.57079632679489661923;
    const double r2 = r * r;
    const double sp = r * (1.0 + r2 * (-1.0 / 6 + r2 * (1.0 / 120 + r2 * (-1.0 / 5040 + r2 * (1.0 / 362880 + r2 * (-1.0 / 39916800 + r2 * (1.0 / 6227020800.0)))))));
    const double cp = 1.0 + r2 * (-0.5 + r2 * (1.0 / 24 + r2 * (-1.0 / 720 + r2 * (1.0 / 40320 + r2 * (-1.0 / 3628800 + r2 * (1.0 / 479001600 + r2 * (-1.0 / 87178291200.0)))))));
    const int q = ((int)n) & 3;
    const double cc = (q == 0) ? cp : (q == 1) ? -sp : (q == 2) ? -cp : sp;
    const double ss = (q == 0) ? sp : (q == 1) ? cp : (q == 2) ? -sp : -cp;
    c = (float)cc; s = (float)ss;
}

__device__ __forceinline__ void phase_xn(const float* hlat, const float* hctx, const float* mod, bf16* XN, int gw, int NGW, int lane) {
    for (int m = gw; m < MROWS; m += NGW) {
        const float* src = m < NLAT ? hlat + (size_t)m * DM : hctx + (size_t)(m - NLAT) * DM;
        const int cond = m < NLAT ? (m >> 13) : 2;
        const f32x4* s4 = (const f32x4*)src + lane;
        f32x4 v[16]; float ss = 0.f;
#pragma unroll
        for (int j = 0; j < 16; ++j) { v[j] = s4[64 * j]; ss += (v[j].x * v[j].x + v[j].y * v[j].y) + (v[j].z * v[j].z + v[j].w * v[j].w); }
        ss = wave_sum(ss);
        const float rstd = rsq_f(ss * (1.f / 4096.f) + 1e-6f);
        const f32x4* sh4 = (const f32x4*)(mod + cond * 12288) + lane; const f32x4* sc4 = (const f32x4*)(mod + cond * 12288 + 4096) + lane;
        v2u* o = (v2u*)(XN + (size_t)m * DM) + lane;
#pragma unroll
        for (int j = 0; j < 16; ++j) { const f32x4 sh = sh4[64 * j], sc = sc4[64 * j]; const f32x4 x = v[j] * rstd * (sc + 1.f) + sh; v2u w; w.x = pk2(x.x, x.y); w.y = pk2(x.z, x.w); o[64 * j] = w; }
    }
}

__device__ __forceinline__ void phase_rowprep(const bf16* P, const float* qgain, const float* kgain, const f32x2* tab, bf16* QN, bf16* KN, f32x2* SGST, int gw, int NGW, int lane) {
    const int sub = lane & 3;
    for (int m = gw; m < MROWS; m += NGW) {
        const bf16* pr = P + (size_t)m * NIN;
        const bool isctx = m >= NLAT; const int t = isctx ? ((m - NLAT) & 255) : (m & 8191);
        {   float x[16]; unpack8(*(const v4u*)(pr + C_SGV + 16 * lane), x); unpack8(*(const v4u*)(pr + C_SGV + 16 * lane + 8), x + 8);
            float s = 0.f;
#pragma unroll
            for (int i = 0; i < 16; ++i) s += x[i];
            const float mean = wave_sum(s) * (1.f / 1024.f); float q = 0.f;
#pragma unroll
            for (int i = 0; i < 16; ++i) { const float dlt = x[i] - mean; q += dlt * dlt; }
            const float var = wave_sum(q) * (1.f / 1024.f);
            if (lane == 0) SGST[m] = (f32x2){mean, rsq_f(var + 1e-5f)}; }
        float q[16], k[16];
        unpack8(*(const v4u*)(pr + C_NAQ + 16 * lane), q); unpack8(*(const v4u*)(pr + C_NAQ + 16 * lane + 8), q + 8);
        unpack8(*(const v4u*)(pr + C_NAK + 16 * lane), k); unpack8(*(const v4u*)(pr + C_NAK + 16 * lane + 8), k + 8);
        float sq = 0.f, sk = 0.f;
#pragma unroll
        for (int i = 0; i < 16; ++i) { sq += q[i] * q[i]; sk += k[i] * k[i]; }
        sq += __shfl_xor(sq, 1); sq += __shfl_xor(sq, 2); sk += __shfl_xor(sk, 1); sk += __shfl_xor(sk, 2);
        const float rq = rsq_f(sq * (1.f / 64.f) + 1e-6f), rk = rsq_f(sk * (1.f / 64.f) + 1e-6f);
#pragma unroll
        for (int i = 0; i < 16; ++i) { q[i] *= rq * qgain[16 * sub + i]; k[i] *= rk * kgain[16 * sub + i]; }
        if (!isctx) {
            const int pos = sub < 2 ? (t >> 6) : (t & 63);
#pragma unroll
            for (int i = 0; i < 16; ++i) { const f32x2 cs = tab[pos * 16 + i]; const float pq = __shfl_xor(q[i], 1), pkk = __shfl_xor(k[i], 1);
                q[i] = (sub & 1) ? (q[i] * cs.x + pq * cs.y) : (q[i] * cs.x - pq * cs.y);
                k[i] = (sub & 1) ? (k[i] * cs.x + pkk * cs.y) : (k[i] * cs.x - pkk * cs.y); }
        }
#pragma unroll
        for (int i = 0; i < 16; ++i) q[i] *= 0.125f;
        *(v4u*)(QN + (size_t)m * GWD + 16 * lane) = pack8(q); *(v4u*)(QN + (size_t)m * GWD + 16 * lane + 8) = pack8(q + 8);
        *(v4u*)(KN + (size_t)m * GWD + 16 * lane) = pack8(k); *(v4u*)(KN + (size_t)m * GWD + 16 * lane + 8) = pack8(k + 8);
    }
}
__device__ __forceinline__ void phase_vt(const bf16* P, bf16* VTL, bf16* VTC, int gw, int NGW, int lane) {
    for (int u = gw; u < (MROWS / 64) * 16; u += NGW) {
        const int tt = u >> 4, h = u & 15, m0 = tt * 64;
        const bf16* src = P + (size_t)m0 * NIN + C_NAV + h * 64 + lane;
        unsigned w[32];
#pragma unroll
        for (int i = 0; i < 32; ++i) { const unsigned lo = src[(size_t)(2 * i) * NIN], hi = src[(size_t)(2 * i + 1) * NIN]; w[i] = lo | (hi << 16); }
        bf16* dst = tt < 256 ? VTL + (((size_t)((tt >> 7) * 16 + h) * 64 + lane) * 8192 + (tt & 127) * 64)
                             : VTC + (((size_t)(((tt - 256) >> 2) * 16 + h) * 64 + lane) * 256 + ((tt - 256) & 3) * 64);
#pragma unroll
        for (int j = 0; j < 8; ++j) { v4u o; o.x = w[4 * j]; o.y = w[4 * j + 1]; o.z = w[4 * j + 2]; o.w = w[4 * j + 3]; ((v4u*)dst)[j] = o; }
    }
}
template <int G>
__device__ __forceinline__ void pool_unit(const bf16* P, const bf16* wbase, const float* pscale, bf16* Y, int m0, int lane) {
    constexpr int WIN = 2 << G;
    const int r = lane & 15, q4 = lane >> 4, m = m0 + r;
    const bool isctx = m0 >= NLAT; const int T = isctx ? CTXL : SEQ; const int t = isctx ? ((m - NLAT) & 255) : (m & 8191);
    const int tlo = t - (WIN >> 1);
    const int lo = tlo < 0 ? 0 : tlo, hi = (tlo + WIN) > T ? T : (tlo + WIN);
    const float inv = rcp_f((float)(hi - lo));
    f32x4 acc[16];
#pragma unroll
    for (int nt = 0; nt < 16; ++nt) acc[nt] = (f32x4){0.f, 0.f, 0.f, 0.f};
#pragma unroll 1
    for (int ks = 0; ks < 8; ++ks) {
        const int ch0 = C_POOLV + G * 256 + 32 * ks + 8 * q4;
        constexpr int WB = WIN < 8 ? WIN : 8;
        bf16x8 bfr[8];
        float sum[8];
#pragma unroll
        for (int j = 0; j < 8; ++j) sum[j] = 0.f;
        const v4u selfw = *(const v4u*)(P + (size_t)m * NIN + ch0);
#pragma unroll
        for (int nt = 0; nt < 8; ++nt) bfr[nt] = ld_frag(wbase + (size_t)(16 * nt + r) * 256 + 32 * ks + 8 * q4);
#pragma unroll
        for (int k0 = 0; k0 < WIN; k0 += WB) {
            v4u wl[WB];
#pragma unroll
            for (int k = 0; k < WB; ++k) { const int tk = tlo + k0 + k; const bool ok = tk >= 0 && tk < T; wl[k] = *(const v4u*)(P + (size_t)(ok ? (m - t + tk) : m) * NIN + ch0); }
            __builtin_amdgcn_sched_barrier(0);
#pragma unroll
            for (int k = 0; k < WB; ++k) { const int tk = tlo + k0 + k; const bool ok = tk >= 0 && tk < T; float x[8]; unpack8(wl[k], x);
#pragma unroll
                for (int j = 0; j < 8; ++j) sum[j] += ok ? x[j] : 0.f; }
            __builtin_amdgcn_sched_barrier(0);
        }
        float self[8]; unpack8(selfw, self);
        float dv[8];
#pragma unroll
        for (int j = 0; j < 8; ++j) dv[j] = sum[j] * inv - self[j];
        const bf16x8 af = __builtin_bit_cast(bf16x8, pack8(dv));
        __builtin_amdgcn_sched_barrier(0);
        bf16x8 bfr2[8];
#pragma unroll
        for (int nt = 0; nt < 8; ++nt) bfr2[nt] = ld_frag(wbase + (size_t)(16 * (nt + 8) + r) * 256 + 32 * ks + 8 * q4);
        __builtin_amdgcn_sched_barrier(0);
#pragma unroll
        for (int nt = 0; nt < 8; ++nt) acc[nt] = mfma16(af, bfr[nt], acc[nt]);
        __builtin_amdgcn_sched_barrier(0);
#pragma unroll
        for (int nt = 0; nt < 8; ++nt) acc[nt + 8] = mfma16(af, bfr2[nt], acc[nt + 8]);
        __builtin_amdgcn_sched_barrier(0);
    }
#pragma unroll
    for (int nh = 0; nh < 4; ++nh) {
        unsigned short zz[4][4]; float ps[4];
#pragma unroll
        for (int nq = 0; nq < 4; ++nq) { const int oc = G * 256 + 16 * (4 * nh + nq) + r; ps[nq] = pscale[oc];
#pragma unroll
            for (int i = 0; i < 4; ++i) zz[nq][i] = P[(size_t)(m0 + 4 * q4 + i) * NIN + C_POOLZ + oc]; }
        __builtin_amdgcn_sched_barrier(0);
#pragma unroll
        for (int nq = 0; nq < 4; ++nq) { const int oc = G * 256 + 16 * (4 * nh + nq) + r;
#pragma unroll
            for (int i = 0; i < 4; ++i) Y[(size_t)(m0 + 4 * q4 + i) * DM + oc] = (bf16)f2bf(acc[4 * nh + nq][i] * ps[nq] * silu_f(bf2f(zz[nq][i]))); }
        __builtin_amdgcn_sched_barrier(0);
    }
}
__device__ __forceinline__ void phase_pool(const bf16* P, const bf16* PWT  , const float* pscale, bf16* Y, int nrows, int gw, int NGW, int lane) {
    for (int u = gw; u < (nrows / 16) * 4; u += NGW) {
        const int tt = u >> 2, g = u & 3, m0 = tt * 16;
        const bf16* wbase = PWT + (size_t)g * 65536;
        if (g == 0) pool_unit<0>(P, wbase, pscale, Y, m0, lane);
        else if (g == 1) pool_unit<1>(P, wbase, pscale, Y, m0, lane);
        else if (g == 2) pool_unit<2>(P, wbase, pscale, Y, m0, lane);
        else pool_unit<3>(P, wbase, pscale, Y, m0, lane);
    }
}
#if defined(PROBE_REC2)
#define REC_ST(p, v) do { __builtin_nontemporal_store((v), (p)); __builtin_nontemporal_store((v), (f32x4*)((char*)(p) + (size_t)792 * 1048576)); } while (0)
#elif defined(REC_NT)
#define REC_ST(p, v) __builtin_nontemporal_store((v), (p))
#else
#define REC_ST(p, v) (*(p) = (v))
#endif
__device__ __forceinline__ void phase_rwprep(const bf16* P, const float* mu_rkv  , const float* mu_lora  , const float* w0  , const bf16* WUPT  ,
                                             const float* a0, const bf16* AUPT, const float* k_k, const float* k_a, const float* r_k, float* REC, float* BON, LAS unsigned char* lds,
                                             unsigned* queue  , int cls, int wave, int lane) {
    const int n = lane & 15, q4 = lane >> 4;
    const int d = cls >> 3, hp = cls & 7;
    unsigned* qh = queue + 64 * cls;
    LAS float* prm = (LAS float*)(lds + wave * 4096);
#pragma unroll
    for (int it = 0; it < 16; ++it) { const int hh = it >> 3, p = it & 7, ch = (hp * 2 + hh) * 64 + lane;
        const float* src = p == 0 ? w0 + d * 1024 : p == 1 ? a0 + d * 1024 : p == 2 ? mu_rkv + (d * 3 + 0) * 1024 : p == 3 ? mu_rkv + (d * 3 + 1) * 1024 : p == 4 ? mu_rkv + (d * 3 + 2) * 1024 : p == 5 ? k_k : p == 6 ? k_a : r_k;
        prm[it * 64 + lane] = src[ch]; }
    LDS_WAIT(); asm volatile("" ::: "memory");
    unsigned pend = 0u;
    if (lane == 0) pend = __hip_atomic_fetch_add(qh, 1u, __ATOMIC_RELAXED, __HIP_MEMORY_SCOPE_AGENT);
    for (;;) {
        const int tt = __builtin_amdgcn_readfirstlane((int)pend);
        if (tt >= MROWS / 16) break;
        if (lane == 0) pend = __hip_atomic_fetch_add(qh, 1u, __ATOMIC_RELAXED, __HIP_MEMORY_SCOPE_AGENT);
        const int m0 = tt * 16;
        const bool isctx = m0 >= NLAT; const int T = isctx ? CTXL : SEQ; const int t0 = isctx ? ((m0 - NLAT) & 255) : (m0 & 8191); const int b = isctx ? ((m0 - NLAT) >> 8) : (m0 >> 13);
        const int m = m0 + n, t = t0 + n; const bool hasnb = d == 0 ? (t > 0) : (t < T - 1); const int nbr = hasnb ? (d == 0 ? m - 1 : m + 1) : m;
        const bf16* prow = P + (size_t)m * NIN; const bf16* nrow = P + (size_t)nbr * NIN;
        bf16x8 Bw[2], Ba[2];
        {   v4u cw[2], nw[2], ca[2], na[2]; f32x4 mw[2][2], ma[2][2];
#pragma unroll
            for (int ks = 0; ks < 2; ++ks) { const int j0 = 32 * ks + 8 * q4;
                cw[ks] = *(const v4u*)(prow + C_RWWD + d * 64 + j0); nw[ks] = *(const v4u*)(nrow + C_RWWD + d * 64 + j0);
                ca[ks] = *(const v4u*)(prow + C_RWAD + d * 64 + j0); na[ks] = *(const v4u*)(nrow + C_RWAD + d * 64 + j0);
                mw[ks][0] = *(const f32x4*)(mu_lora + (d * 2 + 0) * 64 + j0); mw[ks][1] = *(const f32x4*)(mu_lora + (d * 2 + 0) * 64 + j0 + 4);
                ma[ks][0] = *(const f32x4*)(mu_lora + (d * 2 + 1) * 64 + j0); ma[ks][1] = *(const f32x4*)(mu_lora + (d * 2 + 1) * 64 + j0 + 4); }
            __builtin_amdgcn_sched_barrier(0);
#pragma unroll
            for (int ks = 0; ks < 2; ++ks) {
                float cur[8], nb[8], o[8];
                unpack8(cw[ks], cur); unpack8(nw[ks], nb);
#pragma unroll
                for (int j = 0; j < 8; ++j) { const float xx = cur[j] + ((hasnb ? nb[j] : 0.f) - cur[j]) * mw[ks][j >> 2][j & 3]; o[j] = 1.0f - 2.0f * rcp_f(1.0f + __expf(2.0f * xx)); }
                Bw[ks] = __builtin_bit_cast(bf16x8, pack8(o));
                unpack8(ca[ks], cur); unpack8(na[ks], nb);
#pragma unroll
                for (int j = 0; j < 8; ++j) o[j] = cur[j] + ((hasnb ? nb[j] : 0.f) - cur[j]) * ma[ks][j >> 2][j & 3];
                Ba[ks] = __builtin_bit_cast(bf16x8, pack8(o)); }
        }
        const int pos = scan_pos(d, isctx, t);
#pragma unroll 1
        for (int hh = 0; hh < 2; ++hh) {
            const int head = hp * 2 + hh, chain = (b * 2 + d) * 16 + head;
            char* recb = (char*)REC + ((size_t)chain * SCANLEN + pos) * RECB;
            const LAS float* pr = prm + hh * 512;
            float KK[16], AV[16]; float ss = 0.f, bon = 0.f;
#pragma unroll
            for (int hf = 0; hf < 2; ++hf) {
                const int cl = 32 * hf + 8 * q4, cg = head * 64 + cl;
                bf16x8 wf[2][2], af[2][2];
#pragma unroll
                for (int tq = 0; tq < 2; ++tq) { const size_t wrow = (size_t)(d * 1024 + head * 64 + 32 * hf + 8 * (n >> 2) + 4 * tq + (n & 3)) * 64 + 8 * q4;
                    wf[tq][0] = ld_frag(WUPT + wrow); wf[tq][1] = ld_frag(WUPT + wrow + 32); af[tq][0] = ld_frag(AUPT + wrow); af[tq][1] = ld_frag(AUPT + wrow + 32); }
                const v4u rcw = *(const v4u*)(prow + C_RWR + cg), kcw = *(const v4u*)(prow + C_RWK + cg), vcw = *(const v4u*)(prow + C_RWV + cg);
                const v4u rnw = *(const v4u*)(nrow + C_RWR + cg), knw = *(const v4u*)(nrow + C_RWK + cg), vnw = *(const v4u*)(nrow + C_RWV + cg);
                __builtin_amdgcn_sched_barrier(0);
                f32x4 accW[2], accA[2];
#pragma unroll
                for (int tq = 0; tq < 2; ++tq) { f32x4 z = {0.f, 0.f, 0.f, 0.f}; z = mfma16(wf[tq][0], Bw[0], z); accW[tq] = mfma16(wf[tq][1], Bw[1], z);
                                                 f32x4 y = {0.f, 0.f, 0.f, 0.f}; y = mfma16(af[tq][0], Ba[0], y); accA[tq] = mfma16(af[tq][1], Ba[1], y); }
                float rc[8], kc[8], vc[8], rn[8], kn[8], vn[8];
                unpack8(rcw, rc); unpack8(kcw, kc); unpack8(vcw, vc); unpack8(rnw, rn); unpack8(knw, kn); unpack8(vnw, vn);
                float dec[8], kp[8], rr[8], vv[8];
#pragma unroll
                for (int g = 0; g < 2; ++g) {
                    const f32x4 w0v = *(const LAS f32x4*)(pr + 0 * 64 + cl + 4 * g), a0v = *(const LAS f32x4*)(pr + 1 * 64 + cl + 4 * g), mur = *(const LAS f32x4*)(pr + 2 * 64 + cl + 4 * g),
                                muk = *(const LAS f32x4*)(pr + 3 * 64 + cl + 4 * g), muv = *(const LAS f32x4*)(pr + 4 * 64 + cl + 4 * g), kkv = *(const LAS f32x4*)(pr + 5 * 64 + cl + 4 * g),
                                kav = *(const LAS f32x4*)(pr + 6 * 64 + cl + 4 * g), rkv = *(const LAS f32x4*)(pr + 7 * 64 + cl + 4 * g);
#pragma unroll
                    for (int i = 0; i < 4; ++i) { const int j = 4 * g + i;
                        const float rnb = hasnb ? rn[j] : 0.f, knb = hasnb ? kn[j] : 0.f, vnb = hasnb ? vn[j] : 0.f;
                        const float r_ = rc[j] + (rnb - rc[j]) * mur[i], k0 = kc[j] + (knb - kc[j]) * muk[i], v_ = vc[j] + (vnb - vc[j]) * muv[i];
                        const float xw = -(w0v[i] + accW[g][i]);
                        const float sp = fmaxf(xw, 0.f) + __logf(1.0f + __expf(-fabsf(xw)));
                        dec[j] = __expf(-__expf(-sp - 0.5f));
                        const float av = rcp_f(1.0f + __expf(-(a0v[i] + accA[g][i])));
                        const float kx = k0 * kkv[i]; ss += kx * kx;
                        const float kp_ = k0 * (1.f + (av - 1.f) * kav[i]); bon += r_ * kp_ * rkv[i];
                        KK[8 * hf + j] = kx; AV[8 * hf + j] = av; kp[j] = kp_; rr[j] = r_; vv[j] = v_; }
                }
                char* ob = recb + cl * 2;
                REC_ST((f32x4*)(recb + cl * 4), ((f32x4){dec[0], dec[1], dec[2], dec[3]})); REC_ST((f32x4*)(recb + cl * 4 + 16), ((f32x4){dec[4], dec[5], dec[6], dec[7]}));
                REC_ST((h8*)(ob + 512), ((h8){(_Float16)kp[0], (_Float16)kp[1], (_Float16)kp[2], (_Float16)kp[3], (_Float16)kp[4], (_Float16)kp[5], (_Float16)kp[6], (_Float16)kp[7]}));
                REC_ST((h8*)(ob + 640), ((h8){(_Float16)rr[0], (_Float16)rr[1], (_Float16)rr[2], (_Float16)rr[3], (_Float16)rr[4], (_Float16)rr[5], (_Float16)rr[6], (_Float16)rr[7]}));
                REC_ST((h8*)(ob + 768), ((h8){(_Float16)vv[0], (_Float16)vv[1], (_Float16)vv[2], (_Float16)vv[3], (_Float16)vv[4], (_Float16)vv[5], (_Float16)vv[6], (_Float16)vv[7]}));
                __builtin_amdgcn_sched_barrier(0);
            }
            ss = sum16x4(ss); bon = sum16x4(bon);
            const float inv = rsq_f(fmaxf(ss, 1e-12f));
#pragma unroll
            for (int hf = 0; hf < 2; ++hf) { char* ob = recb + (32 * hf + 8 * q4) * 2; float kkn[8], nka[8];
#pragma unroll
                for (int j = 0; j < 8; ++j) { kkn[j] = KK[8 * hf + j] * inv; nka[j] = -(kkn[j] * AV[8 * hf + j]); }
                REC_ST((h8*)(ob + 256), ((h8){(_Float16)kkn[0], (_Float16)kkn[1], (_Float16)kkn[2], (_Float16)kkn[3], (_Float16)kkn[4], (_Float16)kkn[5], (_Float16)kkn[6], (_Float16)kkn[7]}));
                REC_ST((h8*)(ob + 384), ((h8){(_Float16)nka[0], (_Float16)nka[1], (_Float16)nka[2], (_Float16)nka[3], (_Float16)nka[4], (_Float16)nka[5], (_Float16)nka[6], (_Float16)nka[7]})); }
            if (q4 == 0) BON[(size_t)chain * SCANLEN + pos] = bon;
        }
    }
}
template <bool CTXQ>
__device__ __forceinline__ void na_unit(const bf16* QN, const bf16* KN, const bf16* VTL, const bf16* VTC, const bf16* P, const float* rpb  , bf16* Y, int u, int lane) {
    const int n = lane & 15, q4 = lane >> 4;
    int b, h, qrow0, qr = 0, jt = 0;
    if (CTXQ) { b = u >> 8; h = (u >> 4) & 15; qrow0 = NLAT + b * CTXL + 16 * (u & 15); }
    else { jt = u & 3; h = (u >> 2) & 15; qr = (u >> 6) & 127; b = u >> 13; qrow0 = b * SEQ + qr * 64 + 16 * jt; }
    constexpr int NT = CTXQ ? 16 : 32, WT = CTXQ ? 0 : 16;
    f32x4 s[NT];
    const int rs = qr - 4 < 0 ? 0 : (qr - 4 > 120 ? 120 : qr - 4);
    const int span0 = jt == 0 ? 0 : (jt == 1 ? 8 : (jt == 2 ? 24 : 32));
    const int qc = 16 * jt + n; const int cs = qc - 8 < 0 ? 0 : (qc - 8 > 48 ? 48 : qc - 8);
    bf16x8 qf[2];
#pragma unroll
    for (int ks = 0; ks < 2; ++ks) qf[ks] = ld_frag(QN + (size_t)(qrow0 + n) * GWD + h * 64 + 32 * ks + 8 * q4);
    if (!CTXQ) {
        const float* rp = rpb + (size_t)h * 15 * 31;
#pragma unroll
        for (int wt = 0; wt < 16; ++wt) { const int kri = wt >> 1, half = wt & 1, relr = rs + kri - qr + 7;
#pragma unroll
            for (int i = 0; i < 4; ++i) { const int relc = span0 + 8 * q4 + 4 * half + i - qc + 15; const int relcc = relc < 0 ? 0 : (relc > 30 ? 30 : relc); s[wt][i] = rp[relr * 31 + relcc]; } }
        __builtin_amdgcn_sched_barrier(0);
#pragma unroll
        for (int bt = 0; bt < 2; ++bt) {
            bf16x8 kf[16];
#pragma unroll
            for (int t = 0; t < 8; ++t) { const int wt = bt * 8 + t, kri = wt >> 1, half = wt & 1;
                const bf16* kp = KN + (size_t)(b * SEQ + (rs + kri) * 64 + span0 + 8 * (n >> 2) + 4 * half + (n & 3)) * GWD + h * 64 + 8 * q4; kf[2 * t] = ld_frag(kp); kf[2 * t + 1] = ld_frag(kp + 32); }
            __builtin_amdgcn_sched_barrier(0);
#pragma unroll
            for (int t = 0; t < 8; ++t) { const int wt = bt * 8 + t, half = wt & 1;
                f32x4 a = s[wt];
#pragma unroll
                for (int i = 0; i < 4; ++i) { const int kc = span0 + 8 * q4 + 4 * half + i; const bool ok = kc >= cs && kc < cs + 16; a[i] = ok ? a[i] : -INFINITY; }
                a = mfma16(kf[2 * t], qf[0], a); a = mfma16(kf[2 * t + 1], qf[1], a); s[wt] = a; }
            __builtin_amdgcn_sched_barrier(0);
        }
    }
#pragma unroll
    for (int bt = 0; bt < 2; ++bt) {
        bf16x8 kf[16];
#pragma unroll
        for (int t = 0; t < 8; ++t) { const int ctile = bt * 8 + t; const bf16* kp = KN + (size_t)(NLAT + b * CTXL + 32 * (ctile >> 1) + 8 * (n >> 2) + 4 * (ctile & 1) + (n & 3)) * GWD + h * 64 + 8 * q4; kf[2 * t] = ld_frag(kp); kf[2 * t + 1] = ld_frag(kp + 32); }
        __builtin_amdgcn_sched_barrier(0);
#pragma unroll
        for (int t = 0; t < 8; ++t) { f32x4 a = {0.f, 0.f, 0.f, 0.f}; a = mfma16(kf[2 * t], qf[0], a); a = mfma16(kf[2 * t + 1], qf[1], a); s[WT + bt * 8 + t] = a; }
        __builtin_amdgcn_sched_barrier(0);
    }
    float mx = -INFINITY;
#pragma unroll
    for (int t = 0; t < NT; ++t) mx = fmaxf(fmaxf(fmaxf(s[t][0], s[t][1]), fmaxf(s[t][2], s[t][3])), mx);
    mx = max16x4(mx);
    float sum = 0.f;
#pragma unroll
    for (int t = 0; t < NT; ++t) {
#pragma unroll
        for (int i = 0; i < 4; ++i) { const float e = __expf(s[t][i] - mx); s[t][i] = e; sum += e; } }
    sum = sum16x4(sum);
    const float inv = rcp_f(sum);
    f32x4 o[4];
#pragma unroll
    for (int nt = 0; nt < 4; ++nt) o[nt] = (f32x4){0.f, 0.f, 0.f, 0.f};
#pragma unroll
    for (int tb = 0; tb < NT / 8; ++tb) {
        v4u vv[4][4];
#pragma unroll
        for (int tq = 0; tq < 4; ++tq) { const int tp = tb * 4 + tq;
            const bf16* vb; size_t dstride;
            if (!CTXQ && tp < 8) { vb = VTL + ((size_t)(b * 16 + h) * 64 + n) * 8192 + (rs + tp) * 64 + span0 + 8 * q4; dstride = (size_t)16 * 8192; }
            else { const int cp = tp - (CTXQ ? 0 : 8); vb = VTC + ((size_t)(b * 16 + h) * 64 + n) * 256 + 32 * cp + 8 * q4; dstride = (size_t)16 * 256; }
#pragma unroll
            for (int nt = 0; nt < 4; ++nt) vv[tq][nt] = *(const v4u*)(vb + nt * dstride); }
        __builtin_amdgcn_sched_barrier(0);
#pragma unroll
        for (int tq = 0; tq < 4; ++tq) { const int tp = tb * 4 + tq;
            const f32x4 p0 = s[2 * tp] * inv, p1 = s[2 * tp + 1] * inv;
            v4u aw; aw.x = pk2(p0[0], p0[1]); aw.y = pk2(p0[2], p0[3]); aw.z = pk2(p1[0], p1[1]); aw.w = pk2(p1[2], p1[3]);
            const bf16x8 af = __builtin_bit_cast(bf16x8, aw);
#pragma unroll
            for (int nt = 0; nt < 4; ++nt) o[nt] = mfma16(af, __builtin_bit_cast(bf16x8, vv[tq][nt]), o[nt]); }
        __builtin_amdgcn_sched_barrier(0);
    }
    unsigned short zz[4][4];
#pragma unroll
    for (int nt = 0; nt < 4; ++nt)
#pragma unroll
        for (int i = 0; i < 4; ++i) zz[nt][i] = P[(size_t)(qrow0 + 4 * q4 + i) * NIN + C_NAZ + h * 64 + 16 * nt + n];
    __builtin_amdgcn_sched_barrier(0);
#pragma unroll
    for (int nt = 0; nt < 4; ++nt)
#pragma unroll
        for (int i = 0; i < 4; ++i) { const int row = qrow0 + 4 * q4 + i, col = h * 64 + 16 * nt + n;
            Y[(size_t)row * DM + 1024 + col] = (bf16)f2bf(o[nt][i] * silu_f(bf2f(zz[nt][i]))); }
}
__device__ __forceinline__ void phase_sgu(const bf16* P, const f32x2* SGST, const float* lnw, const float* lnb, const bf16* SGW  , const float* sgb  , bf16* Y,
                                          LAS unsigned char* lds, int nchunks, int tid, int wave, int lane) {
    const int n = lane & 15, q4 = lane >> 4;
    LAS bf16* T = (LAS bf16*)lds;
    for (int u = blockIdx.x; u < nchunks * 8; u += 256) {
        const int ck = u >> 3, g = u & 7, m0 = ck * 128;
#pragma unroll
        for (int it = 0; it < 4; ++it) { const int idx = tid + 512 * it, q = idx >> 4, c8 = idx & 15;
            float x[8]; unpack8(*(const v4u*)(P + (size_t)(m0 + q) * NIN + C_SGV + g * 128 + 8 * c8), x);
            const f32x2 st = SGST[m0 + q];
#pragma unroll
            for (int j = 0; j < 8; ++j) { const int c = 8 * c8 + j; const float v = (x[j] - st.x) * st.y * lnw[g * 128 + c] + lnb[g * 128 + c]; T[c * 136 + q] = (bf16)f2bf(v); } }
        __syncthreads();
        bf16x8 af[4];
#pragma unroll
        for (int ks = 0; ks < 4; ++ks) af[ks] = ld_frag(SGW + ((size_t)g * 128 + 16 * wave + n) * 128 + 32 * ks + 8 * q4);
#pragma unroll
        for (int nt = 0; nt < 8; ++nt) {
            f32x4 acc = {0.f, 0.f, 0.f, 0.f};
#pragma unroll
            for (int ks = 0; ks < 4; ++ks) { const bf16x8 bfg = *(const LAS bf16x8*)(T + (16 * nt + n) * 136 + 32 * ks + 8 * q4); acc = mfma16(af[ks], bfg, acc); }
#pragma unroll
            for (int i = 0; i < 4; ++i) { const int p = 16 * wave + 4 * q4 + i, row = m0 + p, col = g * 128 + 16 * nt + n;
                const float mixed = acc[i] + sgb[g * 128 + p]; const bf16* pr = P + (size_t)row * NIN;
                const float uu = bf2f(pr[C_SGU + col]), z = bf2f(pr[C_SGZ + col]);
                Y[(size_t)row * DM + 3072 + col] = (bf16)f2bf(uu * mixed * silu_f(z)); }
        }
        __syncthreads();
    }
}
__device__ __forceinline__ void scan_self(const float* REC, float* YR, LAS unsigned char* lds, LAS unsigned* bcnt, int su, int wave, int lane) {
    constexpr int CS = 32, NCH = SCANLEN / CS, SLOT = CS * RECB, NPW = SLOT / 1024 / 4;
    const int chain = (su & 7) * 8 + ((su >> 3) >> 2), part = (su >> 3) & 3;
    const char* recb = (const char*)REC + (size_t)chain * SCANLEN * RECB;
    const int wl = wave;
#define SCAN_ISSUE(cc, sl) do { _Pragma("unroll") for (int p_ = 0; p_ < NPW; ++p_) \
    __builtin_amdgcn_global_load_lds((const unsigned*)(recb + (size_t)(cc) * SLOT + (wl * NPW + p_) * 1024 + lane * 16), (LAS unsigned*)(lds + (sl) * SLOT + (wl * NPW + p_) * 1024), 16, 0, 0); } while (0)
    __builtin_amdgcn_s_setprio(3);
    SCAN_ISSUE(0, 0); SCAN_ISSUE(1, 1); SCAN_ISSUE(2, 2);
    const int c16 = lane & 15, rg = lane >> 4, row = 16 * part + 4 * wave + rg;
    float S0 = 0.f, S1 = 0.f, S2 = 0.f, S3 = 0.f;
    float* yout = YR + (size_t)chain * SCANLEN * 64 + row;
    const int lo_w = c16 * 16, lo_h = 256 + c16 * 8, lo_v = 768 + row * 2;
#define SCAN_LD(dst, sl, s_) do { const LAS unsigned char* rec_ = (sl) + (s_) * RECB; dst##w = *(const LAS f32x4*)(rec_ + lo_w); dst##kk = *(const LAS h4*)(rec_ + lo_h); \
    dst##na = *(const LAS h4*)(rec_ + 128 + lo_h); dst##k = *(const LAS h4*)(rec_ + 256 + lo_h); dst##r = *(const LAS h4*)(rec_ + 384 + lo_h); dst##v = *(const LAS _Float16*)(rec_ + lo_v); } while (0)
#define FMX(a, b, c) __builtin_fmaf((a), (float)(b), (c))
    for (int c = 0; c < NCH; ++c) {
        asm volatile("s_waitcnt vmcnt(14)" ::: "memory");
        {   const unsigned baddr = (unsigned)(size_t)bcnt, one = 1u;
            if (lane == 0) asm volatile("ds_add_u32 %0, %1" :: "v"(baddr), "v"(one) : "memory");
            const unsigned want = 4u * (unsigned)(c + 1); unsigned sp = 0, got;
            for (;;) { asm volatile("ds_read_b32 %0, %1\n\ts_waitcnt lgkmcnt(0)" : "=v"(got) : "v"(baddr) : "memory");
                if (__builtin_amdgcn_readfirstlane((int)got) >= (int)want) break; __builtin_amdgcn_s_sleep(1); if (++sp > (1u << 22)) break; } }
        asm volatile("" ::: "memory");
        {   const int cc = c + 3 < NCH ? c + 3 : NCH - 1; SCAN_ISSUE(cc, (c + 3) & 3); }
        const LAS unsigned char* slot = lds + (c & 3) * SLOT;
        float ysv0 = 0.f, ysv1 = 0.f; float yp[16];
        f32x4 Aw; h4 Akk, Ana, Ak, Ar, Pr; _Float16 Av;
        SCAN_LD(A, slot, 0);
#pragma unroll
        for (int s = 0; s < CS; ++s) {
            f32x4 Bw; h4 Bkk, Bna, Bk, Br; _Float16 Bv;
            if (s < CS - 1) SCAN_LD(B, slot, s + 1);
            __builtin_amdgcn_sched_barrier(0);
            if (s > 0) { float q0 = FMX(S0, Pr.x, 0.f), q1 = FMX(S2, Pr.z, 0.f); q0 = FMX(S1, Pr.y, q0); q1 = FMX(S3, Pr.w, q1); yp[(s - 1) & 15] = q0 + q1; }
            float p0 = FMX(S0, Akk.x, 0.f), p1 = FMX(S2, Akk.z, 0.f); p0 = FMX(S1, Akk.y, p0); p1 = FMX(S3, Akk.w, p1);
            const float dt = red16(p0 + p1);
            const float u0 = __builtin_fmaf(S0, Aw.x, FMX((float)Av, Ak.x, 0.f)), u1 = __builtin_fmaf(S1, Aw.y, FMX((float)Av, Ak.y, 0.f)),
                        u2 = __builtin_fmaf(S2, Aw.z, FMX((float)Av, Ak.z, 0.f)), u3 = __builtin_fmaf(S3, Aw.w, FMX((float)Av, Ak.w, 0.f));
            S0 = FMX(dt, Ana.x, u0); S1 = FMX(dt, Ana.y, u1); S2 = FMX(dt, Ana.z, u2); S3 = FMX(dt, Ana.w, u3);
            if (s == 16) ysv0 = red16_transpose(yp, c16);
            Pr = Ar;
            if (s < CS - 1) { Aw = Bw; Akk = Bkk; Ana = Bna; Ak = Bk; Ar = Br; Av = Bv; }
        }
        { float q0 = FMX(S0, Pr.x, 0.f), q1 = FMX(S2, Pr.z, 0.f); q0 = FMX(S1, Pr.y, q0); q1 = FMX(S3, Pr.w, q1); yp[15] = q0 + q1; }
        ysv1 = red16_transpose(yp, c16);
        asm volatile("" ::: "memory");
        yout[(size_t)(c * CS + c16) * 64] = ysv0; yout[(size_t)(c * CS + 16 + c16) * 64] = ysv1;
    }
    asm volatile("s_waitcnt vmcnt(0)" ::: "memory");
    __builtin_amdgcn_s_setprio(0);
#undef FMX
#undef SCAN_LD
#undef SCAN_ISSUE
}
__device__ __forceinline__ void phase_rwfin(const bf16* P, const float* YR, const float* REC, const float* BON, const float* lnw, const float* lnb, bf16* Y, int nrows, int gw, int NGW, int lane) {
    const int head = lane >> 2, sub = lane & 3;
    for (int m = gw; m < nrows; m += NGW) {
        const bool isctx = m >= NLAT; const int t = isctx ? ((m - NLAT) & 255) : (m & 8191); const int b = isctx ? ((m - NLAT) >> 8) : (m >> 13);
        float out[16];
#pragma unroll
        for (int i = 0; i < 16; ++i) out[i] = 0.f;
#pragma unroll
        for (int d = 0; d < 2; ++d) {
            const int chain = (b * 2 + d) * 16 + head; const size_t pp = (size_t)chain * SCANLEN + scan_pos(d, isctx, t);
            float y[16], v[16];
#pragma unroll
            for (int j = 0; j < 4; ++j) { const f32x4 a = *(const f32x4*)(YR + pp * 64 + 16 * sub + 4 * j); const h4 c = *(const h4*)((const char*)REC + pp * RECB + 768 + (16 * sub + 4 * j) * 2);
                y[4 * j] = a.x; y[4 * j + 1] = a.y; y[4 * j + 2] = a.z; y[4 * j + 3] = a.w; v[4 * j] = (float)c.x; v[4 * j + 1] = (float)c.y; v[4 * j + 2] = (float)c.z; v[4 * j + 3] = (float)c.w; }
            const float bo = BON[pp];
            float s = 0.f;
#pragma unroll
            for (int i = 0; i < 16; ++i) s += y[i];
            s += __shfl_xor(s, 1); s += __shfl_xor(s, 2);
            const float mean = s * (1.f / 64.f); float q = 0.f;
#pragma unroll
            for (int i = 0; i < 16; ++i) { const float dl = y[i] - mean; q += dl * dl; }
            q += __shfl_xor(q, 1); q += __shfl_xor(q, 2);
            const float rstd = rsq_f(q * (1.f / 64.f) + 64e-5f);
#pragma unroll
            for (int i = 0; i < 16; ++i) { const int ch = head * 64 + 16 * sub + i; out[i] += (y[i] - mean) * rstd * lnw[ch] + lnb[ch] + bo * v[i]; }
        }
        float z[16]; unpack8(*(const v4u*)(P + (size_t)m * NIN + C_RWZ + 16 * lane), z); unpack8(*(const v4u*)(P + (size_t)m * NIN + C_RWZ + 16 * lane + 8), z + 8);
#pragma unroll
        for (int i = 0; i < 16; ++i) out[i] *= silu_f(z[i]);
        *(v4u*)(Y + (size_t)m * DM + 2048 + 16 * lane) = pack8(out); *(v4u*)(Y + (size_t)m * DM + 2048 + 16 * lane + 8) = pack8(out + 8);
    }
}
#define XB_TMO      128
#define XB_XCNT(j)  (256  + 64 * (j))
#define XB_XSUB(j)  (1280 + 64 * (j))
#define XB_XGEN(j)  (2304 + 64 * (j))
#define XB_TOP      3328
#define XB_TOPGEN   3392
#define XCD_BAR_WORDS 3456
#define XB_SPIN_CAP (1u << 18)

__device__ __forceinline__ unsigned xb_ld(unsigned* p)              { return __hip_atomic_load(p, __ATOMIC_RELAXED, __HIP_MEMORY_SCOPE_AGENT); }
__device__ __forceinline__ unsigned xb_add(unsigned* p, unsigned v) { return __hip_atomic_fetch_add(p, v, __ATOMIC_RELAXED, __HIP_MEMORY_SCOPE_AGENT); }
__device__ __forceinline__ unsigned xb_xcc_id() { return (unsigned)__builtin_amdgcn_s_getreg((3 << 11) | 20) & 0xFu; }
#define XB_SPIN(cond, bar) do { unsigned _sp = 0; while (cond) { __builtin_amdgcn_s_sleep(1); \
    if ((++_sp & 255u) == 0u) { if (xb_ld(&(bar)[XB_TMO])) break; if (_sp > XB_SPIN_CAP) { atomicAdd(&(bar)[XB_TMO], 1u); break; } } } } while (0)

struct XcdBarrier {
    unsigned* bar; unsigned x;
    volatile LAS unsigned* st;
};

__device__ __forceinline__ XcdBarrier xcd_barrier_post(unsigned* bar, volatile LAS unsigned* st) {
    XcdBarrier b; b.bar = bar; b.x = xb_xcc_id(); b.st = st;
    if (threadIdx.x == 0) (void)xb_add(&bar[XB_XCNT(b.x)], 1u);
    return b;
}
__device__ __forceinline__ void xcd_barrier_complete(unsigned* bar, unsigned x, unsigned& nloc, unsigned& nx) {
    const unsigned G = gridDim.x * gridDim.y * gridDim.z;
    unsigned sum, cnt, mine, sp = 0u;
    for (;;) {
        sum = 0u; cnt = 0u; mine = 0u;
#pragma unroll
        for (unsigned j = 0; j < 16; ++j) { const unsigned c = xb_ld(&bar[XB_XCNT(j)]); sum += c; cnt += (c > 0u) ? 1u : 0u; mine = (j == x) ? c : mine; }
        if (sum == G) break;
        __builtin_amdgcn_s_sleep(1);
        if ((++sp & 255u) == 0u) { if (xb_ld(&bar[XB_TMO])) break; if (sp > XB_SPIN_CAP) { atomicAdd(&bar[XB_TMO], 1u); break; } }
    }
    nloc = mine > 0u ? mine : 1u; nx = cnt > 0u ? cnt : 1u;
}

__device__ __forceinline__ void xcd_barrier(const XcdBarrier& b) {
    asm volatile("s_waitcnt vmcnt(0)" ::: "memory");
    __syncthreads();
    if (threadIdx.x == 0) {
        unsigned* bar = b.bar;
        __builtin_amdgcn_s_waitcnt(0);
        unsigned nloc = b.st[0], nx = b.st[1];
        if (nloc == 0u) { xcd_barrier_complete(bar, b.x, nloc, nx); b.st[0] = nloc; b.st[1] = nx; }
        const unsigned old = xb_add(&bar[XB_XSUB(b.x)], 1u);
        const unsigned gen = old / nloc;
        if (old + 1u == (gen + 1u) * nloc) {
            __builtin_amdgcn_fence(__ATOMIC_RELEASE, "agent");
            asm volatile("s_waitcnt vmcnt(0)" ::: "memory");
            const unsigned og = xb_add(&bar[XB_TOP], 1u);
            const unsigned tg = og / nx;
            if (og + 1u == (tg + 1u) * nx) xb_add(&bar[XB_TOPGEN], 1u);
            else XB_SPIN(xb_ld(&bar[XB_TOPGEN]) == tg, bar);
            __builtin_amdgcn_fence(__ATOMIC_ACQUIRE, "agent");
            xb_add(&bar[XB_XGEN(b.x)], 1u);
            asm volatile("s_waitcnt vmcnt(0)" ::: "memory");
        } else {
            XB_SPIN(xb_ld(&bar[XB_XGEN(b.x)]) == gen, bar);
            __builtin_amdgcn_fence(__ATOMIC_ACQUIRE, "agent");
            asm volatile("s_waitcnt vmcnt(0)" ::: "memory");
        }
    }
    __syncthreads();
}

#ifndef MK_SPLIT
#define MK_SPLIT 0
#endif
#ifndef REP_G1
#define REP_G1 1
#endif
#ifndef REP_PREP
#define REP_PREP 1
#endif
#ifndef REP_MIXA
#define REP_MIXA 1
#endif
#ifndef REP_RWP
#define REP_RWP 1
#endif
#ifndef REP_POOL
#define REP_POOL 1
#endif
#ifndef REP_NA
#define REP_NA 1
#endif
#ifndef REP_SGU
#define REP_SGU 1
#endif
#ifndef REP_ROWP
#define REP_ROWP 1
#endif
#ifndef REP_VT
#define REP_VT 1
#endif
#ifndef REP_XN
#define REP_XN 1
#endif
#ifndef REP_FIN
#define REP_FIN 1
#endif
#ifndef REP_SCAN
#define REP_SCAN 1
#endif
constexpr int PPL = 6;
constexpr int NPHASE = 2 + PPL * DEPTH;
constexpr int RWP_BLOCKS = 14;
constexpr int CW_RWQ = 16384;
constexpr int NGRID = 256;
struct Args { const float* in[28]; float* out; unsigned char* ws; int ph_lo, ph_hi, li, pad; };

__global__ void __launch_bounds__(NWAVES * 64, 2) fwd(Args args) {
    extern __shared__ __attribute__((aligned(16))) unsigned char lds_raw[];
    LAS unsigned char* lds = (LAS unsigned char*)lds_raw;
    volatile LAS unsigned* MISC = (volatile LAS unsigned*)(lds + MISC_OFF);
    const int tid = threadIdx.x, lane = tid & 63, wave = __builtin_amdgcn_readfirstlane(tid >> 6);
    constexpr int G = NGRID; const int bx = blockIdx.x;
    const int vcu = (bx % 8) * (G / 8) + bx / 8;
    const int gw = vcu * NWAVES + wave; constexpr int NGW = G * NWAVES;
    unsigned char* ws = args.ws;
    const int lo = args.ph_lo, hi = args.ph_hi;

    for (int u = tid; u < (LDS_BYTES - LDSCTL_OFF) / 4; u += NWAVES * 64) ((LAS unsigned*)(lds + LDSCTL_OFF))[u] = 0u;
    __syncthreads();
    XcdBarrier bar; bar.bar = (unsigned*)(ws + WS_CTL) + CW_BAR; bar.x = 0; bar.st = MISC + 8;
    if (hi - lo > 1) bar = xcd_barrier_post((unsigned*)(ws + WS_CTL) + CW_BAR, MISC + 8);
#define IN(k) (lo <= (k) && (k) < hi)
#define SEAM(k) do { if (lo <= (k) && (k) + 1 < hi) { XcdBarrier b2_; b2_.bar = WSP(unsigned, WS_CTL) + CW_BAR; b2_.x = bar.x; b2_.st = bar.st; xcd_barrier(b2_); } } while (0)

#define OPQ_S(x) ({ int _t = (x); asm volatile("" : "+s"(_t)); _t; })
#define OPQ_V(x) ({ int _t = (x); asm volatile("" : "+v"(_t)); _t; })
#define INP(i) (args.in[OPQ_S(i)])
#define WSP(T, off) ((T*)(args.ws + ({ size_t _o = (off); asm volatile("" : "+s"(_o)); _o; })))
#define x_in INP(0)
#define c_in INP(1)
#define ctx_in INP(2)
#define cctx_in INP(3)
#define w_mod INP(4)
#define b_mod INP(5)
#define w_in INP(6)
#define w_out INP(7)
#define pool_w INP(8)
#define pool_scale INP(9)
#define na_qg INP(10)
#define na_kg INP(11)
#define na_rpb INP(12)
#define rw_mu_rkv INP(13)
#define rw_mu_lora INP(14)
#define rw_w0 INP(15)
#define rw_w_up INP(16)
#define rw_a0 INP(17)
#define rw_a_up INP(18)
#define rw_k_k INP(19)
#define rw_k_a INP(20)
#define rw_r_k INP(21)
#define rw_ln_w INP(22)
#define rw_ln_b INP(23)
#define sg_ln_w INP(24)
#define sg_ln_b INP(25)
#define sg_w INP(26)
#define sg_b INP(27)
#define MOD WSP(float, WS_MOD)
#define MODP WSP(float, WS_MODP)
#define TAB WSP(f32x2, WS_TAB)
#define SGST WSP(f32x2, WS_SGST)
#define BON WSP(float, WS_BON)
#define POOLWT WSP(bf16, WS_POOLWT)
#define WUPT WSP(bf16, WS_WUPT)
#define AUPT WSP(bf16, WS_AUPT)
#define SGW WSP(bf16, WS_SGW)
#define VTC WSP(bf16, WS_VTC)
#define VTL WSP(bf16, WS_VTL)
#define HCTX WSP(float, WS_HCTX)
#define QN WSP(bf16, WS_QN)
#define KN WSP(bf16, WS_KN)
#define WOUTT WSP(bf16, WS_WOUTT)
#define WINT WSP(bf16, WS_WINT)
#define XN WSP(bf16, WS_XN)
#define Y WSP(bf16, WS_Y)
#define P WSP(bf16, WS_P)
#define YR WSP(float, WS_YR)
#define REC WSP(float, WS_REC)
    float* const out = args.out;

    if (IN(0)) {
        LAS float* scr = (LAS float*)(lds + wave * 16384);
        constexpr int I_MOD = 4 * 64 * 48, I_WIN = 64 * (NIN / 32), I_WOUT = 64 * 128, I_POOL = 4 * 32, I_WUP = 2 * 32, I_AUP = 2 * 32, I_SGW = 256;
        constexpr int NITEMS = I_MOD + I_WIN + I_WOUT + I_POOL + I_WUP + I_AUP + I_SGW;
        for (int it = gw; it < NITEMS; it += NGW) {
            int r = it;
            if (r < I_MOD) { p0_mod_item(w_mod, c_in, cctx_in, MODP, scr, r, lane); continue; } r -= I_MOD;
            if (r < I_WIN) { p0_transpose_item<true>(w_in, DM, NIN, WINT, scr, r, lane); continue; } r -= I_WIN;
            if (r < I_WOUT) { p0_transpose_item(w_out, DM, DM, WOUTT, scr, r, lane); continue; } r -= I_WOUT;
            if (r < I_POOL) { const int g = r / 32; p0_transpose_item(pool_w + (size_t)g * 65536, 256, 256, POOLWT + (size_t)g * 65536, scr, r % 32, lane); continue; } r -= I_POOL;
            if (r < I_WUP) { const int dd = r / 32; p0_transpose_item(rw_w_up + (size_t)dd * 65536, 64, 1024, WUPT + (size_t)dd * 65536, scr, r % 32, lane); continue; } r -= I_WUP;
            if (r < I_AUP) { const int dd = r / 32; p0_transpose_item(rw_a_up + (size_t)dd * 65536, 64, 1024, AUPT + (size_t)dd * 65536, scr, r % 32, lane); continue; } r -= I_AUP;
            {   const size_t e0 = (size_t)r * 512 + lane * 8; const f32x4 a = *(const f32x4*)(sg_w + e0), b = *(const f32x4*)(sg_w + e0 + 4);
                v4u o; o.x = pk2(a.x, a.y); o.y = pk2(a.z, a.w); o.z = pk2(b.x, b.y); o.w = pk2(b.z, b.w); *(v4u*)(SGW + e0) = o; }
        }
        SEAM(0);
    }
    if (IN(1)) {
#ifdef PROBE_ISSUE
        if (wave < 4) {
            float a0 = 1.f, a1 = 2.f, a2 = 3.f, a3 = 4.f, a4 = 5.f, a5 = 6.f, a6 = 7.f, a7 = 8.f; const float b = 0.999f, cc = 1e-6f;
            for (int it = 0; it < 100000; ++it) {
#if PROBE_ISSUE == 1
                asm volatile("v_fma_f32 %0, %0, %8, %9\n v_fma_f32 %1, %1, %8, %9\n v_fma_f32 %2, %2, %8, %9\n v_fma_f32 %3, %3, %8, %9\n v_fma_f32 %4, %4, %8, %9\n v_fma_f32 %5, %5, %8, %9\n v_fma_f32 %6, %6, %8, %9\n v_fma_f32 %7, %7, %8, %9"
                    : "+v"(a0), "+v"(a1), "+v"(a2), "+v"(a3), "+v"(a4), "+v"(a5), "+v"(a6), "+v"(a7) : "v"(b), "v"(cc));
#elif PROBE_ISSUE == 2
                asm volatile("v_fma_mix_f32 %0, %0, %8, %9\n v_fma_mix_f32 %1, %1, %8, %9\n v_fma_mix_f32 %2, %2, %8, %9\n v_fma_mix_f32 %3, %3, %8, %9\n v_fma_mix_f32 %4, %4, %8, %9\n v_fma_mix_f32 %5, %5, %8, %9\n v_fma_mix_f32 %6, %6, %8, %9\n v_fma_mix_f32 %7, %7, %8, %9"
                    : "+v"(a0), "+v"(a1), "+v"(a2), "+v"(a3), "+v"(a4), "+v"(a5), "+v"(a6), "+v"(a7) : "v"(b), "v"(cc));
#else
                asm volatile("v_add_f32_dpp %0, %0, %0 quad_perm:[1,0,3,2] row_mask:0xf bank_mask:0xf bound_ctrl:1\n v_add_f32_dpp %1, %1, %1 quad_perm:[1,0,3,2] row_mask:0xf bank_mask:0xf bound_ctrl:1\n v_add_f32_dpp %2, %2, %2 quad_perm:[1,0,3,2] row_mask:0xf bank_mask:0xf bound_ctrl:1\n v_add_f32_dpp %3, %3, %3 quad_perm:[1,0,3,2] row_mask:0xf bank_mask:0xf bound_ctrl:1\n v_add_f32_dpp %4, %4, %4 quad_perm:[1,0,3,2] row_mask:0xf bank_mask:0xf bound_ctrl:1\n v_add_f32_dpp %5, %5, %5 quad_perm:[1,0,3,2] row_mask:0xf bank_mask:0xf bound_ctrl:1\n v_add_f32_dpp %6, %6, %6 quad_perm:[1,0,3,2] row_mask:0xf bank_mask:0xf bound_ctrl:1\n v_add_f32_dpp %7, %7, %7 quad_perm:[1,0,3,2] row_mask:0xf bank_mask:0xf bound_ctrl:1"
                    : "+v"(a0), "+v"(a1), "+v"(a2), "+v"(a3), "+v"(a4), "+v"(a5), "+v"(a6), "+v"(a7) : "v"(b), "v"(cc));
#endif
            }
            asm volatile("" :: "v"(a0), "v"(a1), "v"(a2), "v"(a3), "v"(a4), "v"(a5), "v"(a6), "v"(a7));
        }
#endif

        for (int idx = gw * 64 + lane; idx < 4 * 3 * 12288; idx += NGW * 64) {
            const int l = idx / 36864, c = (idx / 12288) % 3, n = idx % 12288;
            float s = b_mod[l * 12288 + n];
            const float* pp = MODP + ((size_t)(l * 64) * 3 + c) * 12288 + n;
#pragma unroll 8
            for (int kc = 0; kc < 64; ++kc) s += pp[(size_t)kc * 3 * 12288];
            MOD[idx] = s;
        }
        for (int idx = gw * 64 + lane; idx < 2048; idx += NGW * 64) {
            const int pos = idx >> 4, i = idx & 15;
            float inv = (i & 3) == 0 ? 1.0f : ((i & 3) == 1 ? 0.5623413251903491f : ((i & 3) == 2 ? 0.31622776601683794f : 0.17782794100389228f));
            inv *= (i >> 2) == 0 ? 1.0f : ((i >> 2) == 1 ? 0.1f : ((i >> 2) == 2 ? 0.01f : 0.001f));
            float cc, sn; sincos_acc((float)pos * inv, cc, sn);
            TAB[idx] = (f32x2){cc, sn};
        }
        SEAM(1);
    }
    for (int l = 0; l < DEPTH; ++l) {
        const int pb = 2 + PPL * l;
        const bool with_ctx = l < DEPTH - 1;
#define hin_lat (l == 0 ? x_in : (const float*)out)
#define hin_ctx (l == 0 ? ctx_in : (const float*)HCTX)
#define mod (MOD + (size_t)l * 3 * 12288)
        const int nrows = with_ctx ? MROWS : NLAT;
        if (IN(pb + 0)) {
            for (int rep = 0; rep < REP_XN; ++rep)
            phase_xn(hin_lat, hin_ctx, mod, XN, OPQ_S(gw), NGW, OPQ_V(lane));
            SEAM(pb + 0);
#ifdef PROBE_BAR
            SEAM(pb + 0); SEAM(pb + 0); SEAM(pb + 0); SEAM(pb + 0);
#endif
        }
        if (IN(pb + 1)) {
            constexpr int C0 = C_SPLIT, NA_ = NIN - C0;
            pg8::Gemm g{XN, WINT + (size_t)l * NIN * DM + (size_t)C0 * DM, MROWS, NA_, DM}; pg8::StaticOrder S; S.init(MROWS, NA_, G, bx);
            pg8::EpiStoreBf16 E{P + C0, NIN};
            pg8::gemm_phase<pg8::EpiStoreBf16, pg8::StaticOrder, true, true>(lds, g, S, E);
            SEAM(pb + 1);
        }
        if (IN(pb + 2)) {
            if (bx >= RWP_BLOCKS) {
                constexpr int NB_ = C_SPLIT;
                pg8::Gemm g{XN, WINT + (size_t)l * NIN * DM, MROWS, NB_, DM}; pg8::StaticOrder S; S.init(MROWS, NB_, G - RWP_BLOCKS, bx - RWP_BLOCKS);
                pg8::EpiStoreBf16 E{P, NIN};
                pg8::gemm_phase<pg8::EpiStoreBf16, pg8::StaticOrder, true, true>(lds, g, S, E);
            }
            phase_rwprep(P, rw_mu_rkv + (size_t)l * 6144, rw_mu_lora + (size_t)l * 256, rw_w0 + (size_t)l * 2048, WUPT + (size_t)l * 131072, rw_a0 + (size_t)l * 2048, AUPT + (size_t)l * 131072,
                         rw_k_k + (size_t)l * 1024, rw_k_a + (size_t)l * 1024, rw_r_k + (size_t)l * 1024, REC, BON, lds, WSP(unsigned, WS_CTL) + CW_RWQ + l * 1024, (bx * NWAVES + wave) & 15, wave, OPQ_V(lane));
            phase_rowprep(P, na_qg + l * 64, na_kg + l * 64, TAB, QN, KN, SGST, OPQ_S(gw), NGW, OPQ_V(lane));
            phase_vt(P, VTL, VTC, OPQ_S(gw), NGW, OPQ_V(lane));
            SEAM(pb + 2);
        }
        if (IN(pb + 3)) {
#ifdef PROBE_MIX
            for (int rep = 0; rep < 2; ++rep) {
#else
            {
#endif
            phase_sgu(P, SGST, sg_ln_w + (size_t)l * 1024, sg_ln_b + (size_t)l * 1024, SGW + (size_t)l * 131072, sg_b + (size_t)l * 1024, Y, lds, nrows / 128, OPQ_V(tid), wave, OPQ_V(lane));
            LAS unsigned* mixq = (LAS unsigned*)(lds + LDSCTL_OFF + 64); LAS unsigned* mixb = (LAS unsigned*)(lds + LDSCTL_OFF + 128);
            if (tid == 0) { *mixq = 0u; *mixb = 0u; }
            __syncthreads();
            if (wave < 4) scan_self(REC, YR, lds, mixb, bx, wave, OPQ_V(lane));
#ifdef PROBE_SEQ
            if (wave >= 4) { unsigned sp = 0; while (__hip_atomic_load(mixb, __ATOMIC_RELAXED, __HIP_MEMORY_SCOPE_WORKGROUP) < 4u * (SCANLEN / 32)) { __builtin_amdgcn_s_sleep(8); if (++sp > (1u << 24)) break; } }
#endif
            {   const int nctxu = with_ctx ? 2 : 0, npool = (nrows / 16) * 4, npq = (npool + NGRID - 1) / NGRID, nwc = l + 1 < DEPTH ? (WC_ITEMS + NGRID - 1) / NGRID : 0, nq = 64 + nctxu + npq + nwc;
                for (;;) {
                    unsigned k = 0; if (lane == 0) k = __hip_atomic_fetch_add(mixq, 1u, __ATOMIC_RELAXED, __HIP_MEMORY_SCOPE_WORKGROUP);
                    k = (unsigned)__builtin_amdgcn_readfirstlane((int)k);
                    if ((int)k >= nq) break;
                    const int ln = OPQ_V(lane);
                    if (k < 64u) { na_unit<false>(QN, KN, VTL, VTC, P, na_rpb + (size_t)l * 16 * 15 * 31, Y, bx * 64 + (int)k, ln);
#ifdef PROBE_NA2
                        na_unit<false>(QN, KN, VTL, VTC, P, na_rpb + (size_t)l * 16 * 15 * 31, Y, bx * 64 + (int)k, OPQ_V(ln));
#endif
                    }
                    else if ((int)k < 64 + nctxu) na_unit<true>(QN, KN, VTL, VTC, P, na_rpb, Y, bx * 2 + ((int)k - 64), ln);
                    else if ((int)k >= 64 + nctxu + npq) { const int r = bx + NGRID * ((int)k - 64 - nctxu - npq);
                        if (r < WC_ITEMS) weight_copy_item(l + 1, r, w_in, w_out, pool_w, rw_w_up, rw_a_up, sg_w, WINT, WOUTT, POOLWT, WUPT, AUPT, SGW, ln); }
                    else { const int u = bx + NGRID * ((int)k - 64 - nctxu);
                        if (u < npool) { const int tt = u >> 2, g = u & 3; const bf16* wbase = POOLWT + (size_t)l * 262144 + (size_t)g * 65536; const float* psc = pool_scale + (size_t)l * 1024;
                            if (g == 0) pool_unit<0>(P, wbase, psc, Y, tt * 16, ln); else if (g == 1) pool_unit<1>(P, wbase, psc, Y, tt * 16, ln);
                            else if (g == 2) pool_unit<2>(P, wbase, psc, Y, tt * 16, ln); else pool_unit<3>(P, wbase, psc, Y, tt * 16, ln); } }
                }
            }
#ifdef PROBE_MIX
            __syncthreads();
#endif
            }
            SEAM(pb + 3);
        }
        if (IN(pb + 4)) {
            for (int rep = 0; rep < REP_FIN; ++rep)
            phase_rwfin(P, YR, REC, BON, rw_ln_w + (size_t)l * 1024, rw_ln_b + (size_t)l * 1024, Y, nrows, OPQ_S(gw), NGW, OPQ_V(lane));
            SEAM(pb + 4);
        }
        if (IN(pb + 5)) {
            pg8::Gemm g{Y, WOUTT + (size_t)l * DM * DM, nrows, DM, DM}; pg8::StaticOrder S; S.init(nrows, DM, G, bx);
#ifdef PROBE_G2
            { pg8::EpiResGate E0{hin_lat, hin_ctx, (float*)REC, (float*)REC + (size_t)NLAT * DM, mod}; pg8::gemm_phase<pg8::EpiResGate, pg8::StaticOrder, true, true>(lds, g, S, E0); }
#endif
            pg8::EpiResGate E{hin_lat, hin_ctx, out, HCTX, mod};
            pg8::gemm_phase<pg8::EpiResGate, pg8::StaticOrder, true, true>(lds, g, S, E);
            SEAM(pb + 5);
        }
    }
#undef IN
#undef SEAM
}
#undef hin_lat
#undef hin_ctx
#undef mod
#undef P
#undef Y
#undef XN
#undef out

extern "C" void kernel_launch(void* const* d_in, const int* in_sizes, int n_in, void* d_out, int out_size, void* d_ws, size_t ws_size, hipStream_t stream) {
    static int grid = 0;
    if (grid == 0) {
        if (n_in != 28 || out_size != NLAT * DM || ws_size < WS_END) { fprintf(stderr, "kernel_launch: unexpected shapes (n_in %d, out %d, ws %zu < %zu); nothing launched\n", n_in, out_size, ws_size, (size_t)WS_END); grid = -1; return; }
        int dev = 0, cus = 0, per_cu = 0;
        if (hipGetDevice(&dev) != hipSuccess || hipDeviceGetAttribute(&cus, hipDeviceAttributeMultiprocessorCount, dev) != hipSuccess) { grid = -1; return; }
        if (hipFuncSetAttribute((const void*)fwd, hipFuncAttributeMaxDynamicSharedMemorySize, LDS_BYTES) != hipSuccess) { fprintf(stderr, "kernel_launch: hipFuncSetAttribute failed\n"); grid = -1; return; }
        if (hipOccupancyMaxActiveBlocksPerMultiprocessor(&per_cu, (const void*)fwd, NWAVES * 64, LDS_BYTES) != hipSuccess || per_cu < 1)
            fprintf(stderr, "kernel_launch: note: occupancy query reports %d workgroups per CU\n", per_cu);
        (void)hipGetLastError();
        grid = cus >= NGRID ? NGRID : -2;
    }
    if (grid == -1) return;
    if (hipMemsetAsync((char*)d_ws + WS_CTL, 0, CTL_ZERO_BYTES, stream) != hipSuccess) { fprintf(stderr, "kernel_launch: memset failed\n"); return; }
    Args a{};
    for (int i = 0; i < 28; ++i) a.in[i] = (const float*)d_in[i];
    a.out = (float*)d_out; a.ws = (unsigned char*)d_ws; a.li = 0; a.pad = 0;
    const bool split = MK_SPLIT || grid == -2;
    if (split) { for (int k = 0; k < NPHASE; ++k) { a.ph_lo = k; a.ph_hi = k + 1; hipLaunchKernelGGL(fwd, dim3(NGRID), dim3(NWAVES * 64), LDS_BYTES, stream, a); } }
    else { a.ph_lo = 0; a.ph_hi = NPHASE; hipLaunchKernelGGL(fwd, dim3(NGRID), dim3(NWAVES * 64), LDS_BYTES, stream, a); }
    const hipError_t le = hipPeekAtLastError();
    if (le != hipSuccess) fprintf(stderr, "kernel_launch: launch failed: %s\n", hipGetErrorName(le));
}
```

```cpp
#include <hip/hip_runtime.h>
#include <cstdio>
#include <cstdint>
#define MK_SPLIT 0
#define REC_NT 1
namespace pg8 {
#define PG8_LAS __attribute__((address_space(3)))
typedef unsigned short bf16_t;
typedef short bf16x8 __attribute__((ext_vector_type(8)));
typedef float f32x4 __attribute__((ext_vector_type(4)));
typedef unsigned u32x4 __attribute__((ext_vector_type(4)));
constexpr int BM = 256, BK = 64, HALF = 128, HTB = HALF * BK * 2  , STAGE_BYTES = 8 * HTB, NXCD = 8, WGM = 8;

__host__ __device__ __forceinline__ int lds_byte(int r, int c) { const int st = (r >> 4) * 2 + (c >> 5), rr = r & 15, cc = c & 31, ob = rr * 64 + cc * 2; return st * 1024 + (ob ^ (((ob >> 9) & 1) << 5)); }
__host__ __device__ __forceinline__ void stage_rc(int b, int& R, int& C) { const int st = b / 1024, sb = b % 1024, swz = sb ^ (((sb >> 9) & 1) << 5); R = (st >> 1) * 16 + swz / 64; C = (st & 1) * 32 + (swz % 64) / 2; }
__host__ __device__ __forceinline__ int perm32(int rho) { const int n = rho >> 4, i = rho & 15; return 8 * (i >> 2) + 4 * n + (i & 3); }

struct Unit { int pm, pn; };
struct Gemm { const bf16_t* A; const bf16_t* Bt; int M, N, K; };

struct StaticOrder {
    int nM, nN, nwg, G, c;
    __host__ __device__ void init(int M, int N, int G_, int c_) { nM = M / BM; nN = N / BM; nwg = nM * nN; G = G_; c = c_; }
    __host__ __device__ bool next(int i, Unit& u) const {
        const long L = (long)i * G + c; if (L >= nwg) return false;
        int wgid = (int)L; { const int q = nwg / NXCD, r = nwg % NXCD, xcd = wgid % NXCD, off = wgid / NXCD; wgid = (xcd < r ? xcd * (q + 1) : r * (q + 1) + (xcd - r) * q) + off; }
        const int nig = WGM * nN, gid = wgid / nig, fm = gid * WGM, gsz = (nM - fm) < WGM ? (nM - fm) : WGM;
        u.pm = fm + ((wgid % nig) % gsz); u.pn = (wgid % nig) / gsz; return true;
    }
    __device__ __forceinline__ void a_ready(const Unit&) const {}
    __device__ __forceinline__ void done(const Unit&) const {}
};

__device__ __forceinline__ unsigned cvt_pk_bf16(float lo, float hi) { unsigned r; asm volatile("v_cvt_pk_bf16_f32 %0, %1, %2" : "=v"(r) : "v"(lo), "v"(hi)); return r; }
template <class Epi, class Sched, bool ALIGN_EPI = false, bool SP2 = false>
__device__ __forceinline__ void gemm_phase(PG8_LAS unsigned char* lds, const Gemm g, const Sched& S, const Epi& E) {
    int tid_ = threadIdx.x; asm volatile("" : "+v"(tid_));
    const int tid = tid_, wid = __builtin_amdgcn_readfirstlane(tid >> 6), lane = tid & 63, wr = wid >> 2, wc = wid & 3, fr = lane & 15, fq = lane >> 4;
    const int K = g.K, nt = K / BK;
    unsigned voffA[2], voffB[2];
#pragma unroll
    for (int i = 0; i < 2; ++i) { int R, C; stage_rc(tid * 16 + i * 8192, R, C); const int Rb = Epi::PERM ? ((R & ~31) + perm32(R & 31)) : R;
        voffA[i] = (unsigned)(R * K + C) * 2u; voffB[i] = (unsigned)(Rb * K + C) * 2u; }
    const size_t kstep = (size_t)(BK * 2);
    const size_t hstep = (size_t)HALF * K * 2;
    const size_t tstep = 2 * hstep;
    const unsigned ldsw = (unsigned)wid * 1024u;
    const int aoff = lds_byte(wr * 64 + fr, fq * 8), boff = lds_byte(wc * 32 + fr, fq * 8);
#define PG8_SA(b, h) (((b) * 2 + (h)) * HTB)
#define PG8_SB(b, h) ((4 + (b) * 2 + (h)) * HTB)
#define PG8_STAGE(bufoff, gbase, voff) do { _Pragma("unroll") for (int _i = 0; _i < 2; ++_i) \
        __builtin_amdgcn_global_load_lds((const unsigned*)((const char*)(gbase) + (voff)[_i]), (PG8_LAS unsigned*)(lds + (bufoff) + ldsw + _i * 8192), 16, 0, 0); } while (0)
#define PG8_LDA(dst, b, h) do { _Pragma("unroll") for (int m = 0; m < 4; ++m) _Pragma("unroll") for (int k = 0; k < 2; ++k) dst[m][k] = *(const PG8_LAS bf16x8*)(lds + PG8_SA(b, h) + aoff + m * 2048 + k * 1024); } while (0)
#define PG8_LDB(dst, b, h) do { _Pragma("unroll") for (int n = 0; n < 2; ++n) _Pragma("unroll") for (int k = 0; k < 2; ++k) dst[n][k] = *(const PG8_LAS bf16x8*)(lds + PG8_SB(b, h) + boff + n * 2048 + k * 1024); } while (0)
#define PG8_MMA(ai, bj, At, Bt) do { __builtin_amdgcn_s_setprio(1); _Pragma("unroll") for (int m = 0; m < 4; ++m) _Pragma("unroll") for (int n = 0; n < 2; ++n) _Pragma("unroll") for (int k = 0; k < 2; ++k) \
        acc[ai][bj][m][n] = __builtin_amdgcn_mfma_f32_16x16x32_bf16(Bt[n][k], At[m][k], acc[ai][bj][m][n], 0, 0, 0); __builtin_amdgcn_s_setprio(0); } while (0)
#define PG8_WAIT_V(n) asm volatile("s_waitcnt vmcnt(" #n ")" ::: "memory")
#define PG8_WAIT_L(n) asm volatile("s_waitcnt lgkmcnt(" #n ")" ::: "memory")
#define PG8_BAR __builtin_amdgcn_s_barrier()
#define PG8_SCHED __builtin_amdgcn_sched_barrier(0)
    Unit cur, nxt; int ui = 0;
    if (!S.next(0, cur)) return;
    f32x4 acc[2][2][4][2];
#pragma unroll
    for (int a = 0; a < 2; ++a)
#pragma unroll
        for (int b = 0; b < 2; ++b)
#pragma unroll
            for (int m = 0; m < 4; ++m)
#pragma unroll
                for (int n = 0; n < 2; ++n) acc[a][b][m][n] = (f32x4){0.f, 0.f, 0.f, 0.f};
    bf16x8 At[4][2], B0[2][2], B1[2][2];
    const char* cA = (const char*)g.A + (size_t)cur.pm * tstep; const char* cB = (const char*)g.Bt + (size_t)cur.pn * tstep;
    S.a_ready(cur);
    if constexpr (SP2) {
        PG8_STAGE(PG8_SB(0, 0), cB, voffB); PG8_STAGE(PG8_SB(0, 1), cB + hstep, voffB); PG8_STAGE(PG8_SA(0, 0), cA, voffA); PG8_STAGE(PG8_SA(0, 1), cA + hstep, voffA);
        if (wr == 1) PG8_BAR;
        PG8_WAIT_V(2); PG8_BAR;
        PG8_STAGE(PG8_SB(1, 0), cB + kstep, voffB); PG8_STAGE(PG8_SA(1, 0), cA + kstep, voffA); PG8_STAGE(PG8_SB(1, 1), cB + hstep + kstep, voffB);
        PG8_WAIT_V(6); PG8_BAR;
    } else {
        PG8_STAGE(PG8_SB(0, 0), cB, voffB); PG8_STAGE(PG8_SA(0, 0), cA, voffA); PG8_STAGE(PG8_SB(0, 1), cB + hstep, voffB); PG8_STAGE(PG8_SA(0, 1), cA + hstep, voffA);
        if (wr == 1) PG8_BAR;
        PG8_WAIT_V(4); PG8_BAR;
        PG8_STAGE(PG8_SB(1, 0), cB + kstep, voffB); PG8_STAGE(PG8_SA(1, 0), cA + kstep, voffA); PG8_STAGE(PG8_SB(1, 1), cB + hstep + kstep, voffB);
        PG8_WAIT_V(6); PG8_BAR;
    }
    for (;;) {
        const bool has_next = S.next(ui + 1, nxt);
        const char* nA = has_next ? (const char*)g.A + (size_t)nxt.pm * tstep : cA; const char* nB = has_next ? (const char*)g.Bt + (size_t)nxt.pn * tstep : cB;
        for (int t = 0; t < nt; t += 2) {
            const bool last = (t == nt - 2);
            const char* a1 = cA + (size_t)(t + 1) * kstep;
            const char* a2 = last ? nA : cA + (size_t)(t + 2) * kstep; const char* b2 = last ? nB : cB + (size_t)(t + 2) * kstep;
            const char* a3 = a2 + kstep; const char* b3 = b2 + kstep;
            if (last && has_next) S.a_ready(nxt);
            if constexpr (SP2) {
            PG8_LDB(B0, 0, 0); PG8_LDB(B1, 0, 1); PG8_SCHED; PG8_LDA(At, 0, 0); PG8_STAGE(PG8_SA(1, 1), a1 + hstep, voffA);
            PG8_WAIT_V(8); PG8_WAIT_L(0); PG8_BAR; PG8_MMA(0, 0, At, B0); PG8_MMA(0, 1, At, B1); PG8_BAR; PG8_SCHED;
            PG8_LDA(At, 0, 1); PG8_STAGE(PG8_SB(0, 0), b2, voffB); PG8_STAGE(PG8_SB(0, 1), b2 + hstep, voffB); PG8_STAGE(PG8_SA(0, 0), a2, voffA);
            PG8_WAIT_V(8); PG8_WAIT_L(0); PG8_BAR; PG8_MMA(1, 0, At, B0); PG8_MMA(1, 1, At, B1); PG8_BAR; PG8_SCHED;
            PG8_LDB(B0, 1, 0); PG8_LDB(B1, 1, 1); PG8_SCHED; PG8_LDA(At, 1, 0); PG8_STAGE(PG8_SA(0, 1), a2 + hstep, voffA);
            PG8_WAIT_V(8); PG8_WAIT_L(0); PG8_BAR; PG8_MMA(0, 0, At, B0); PG8_MMA(0, 1, At, B1); PG8_BAR; PG8_SCHED;
            PG8_LDA(At, 1, 1); PG8_STAGE(PG8_SB(1, 0), b3, voffB); PG8_STAGE(PG8_SB(1, 1), b3 + hstep, voffB); PG8_STAGE(PG8_SA(1, 0), a3, voffA);
            PG8_WAIT_V(8); PG8_WAIT_L(0); PG8_BAR; PG8_MMA(1, 0, At, B0); PG8_MMA(1, 1, At, B1); PG8_BAR; PG8_SCHED;
            } else {
            PG8_LDB(B0, 0, 0); PG8_SCHED; PG8_LDA(At, 0, 0); PG8_STAGE(PG8_SA(1, 1), a1 + hstep, voffA);
            PG8_WAIT_L(8); PG8_BAR; PG8_WAIT_L(0); PG8_MMA(0, 0, At, B0); PG8_BAR; PG8_SCHED;
            PG8_LDB(B1, 0, 1); PG8_STAGE(PG8_SB(0, 0), b2, voffB);
            PG8_BAR; PG8_WAIT_L(0); PG8_MMA(0, 1, At, B1); PG8_BAR;
            PG8_LDA(At, 0, 1); PG8_STAGE(PG8_SA(0, 0), a2, voffA);
            PG8_BAR; PG8_WAIT_L(0); PG8_MMA(1, 0, At, B0); PG8_BAR; PG8_SCHED;
            PG8_STAGE(PG8_SB(0, 1), b2 + hstep, voffB);
            PG8_WAIT_V(6); PG8_BAR; PG8_MMA(1, 1, At, B1); PG8_BAR;
            PG8_LDB(B0, 1, 0); PG8_SCHED; PG8_LDA(At, 1, 0); PG8_STAGE(PG8_SA(0, 1), a2 + hstep, voffA);
            PG8_WAIT_L(8); PG8_BAR; PG8_WAIT_L(0); PG8_MMA(0, 0, At, B0); PG8_BAR; PG8_SCHED;
            PG8_LDB(B1, 1, 1); PG8_STAGE(PG8_SB(1, 0), b3, voffB);
            PG8_BAR; PG8_WAIT_L(0); PG8_MMA(0, 1, At, B1); PG8_BAR;
            PG8_LDA(At, 1, 1); PG8_STAGE(PG8_SA(1, 0), a3, voffA);
            PG8_BAR; PG8_WAIT_L(0); PG8_MMA(1, 0, At, B0); PG8_BAR; PG8_SCHED;
            PG8_STAGE(PG8_SB(1, 1), b3 + hstep, voffB);
            PG8_WAIT_V(6); PG8_BAR; PG8_MMA(1, 1, At, B1); PG8_BAR;
            }
        }
        if constexpr (ALIGN_EPI) { if (wr == 0) PG8_BAR; }
        if constexpr (!Epi::AFTER_DRAIN) { E(acc, cur, wr, wc, fr, fq); S.done(cur); }
        if (!has_next) break;
#pragma unroll
        for (int a = 0; a < 2; ++a)
#pragma unroll
            for (int b = 0; b < 2; ++b)
#pragma unroll
                for (int m = 0; m < 4; ++m)
#pragma unroll
                    for (int n = 0; n < 2; ++n) acc[a][b][m][n] = (f32x4){0.f, 0.f, 0.f, 0.f};
        cur = nxt; cA = nA; cB = nB; ++ui;
        if constexpr (ALIGN_EPI) { if (wr == 1) PG8_BAR; }
    }
    PG8_WAIT_V(0);
    if constexpr (!ALIGN_EPI) { if (wr == 0) PG8_BAR; }
    PG8_BAR;
    if constexpr (Epi::AFTER_DRAIN) { E.fused(acc, cur, wr, wc, fr, fq, lds, wid, lane); S.done(cur); }
#undef PG8_SA
#undef PG8_SB
#undef PG8_STAGE
#undef PG8_LDA
#undef PG8_LDB
#undef PG8_MMA
#undef PG8_WAIT_V
#undef PG8_WAIT_L
#undef PG8_BAR
#undef PG8_SCHED
}
}

constexpr int DM = 4096, NBATCH = 2, SEQ = 8192, DEPTH = 4, CTXL = 256;
constexpr int NLAT = NBATCH * SEQ, NCTX = NBATCH * CTXL, MROWS = NLAT + NCTX;
constexpr int NIN = 13568, GWD = 1024;
constexpr int C_POOLV = 0, C_POOLZ = 1024, C_NAZ = 2048, C_RWZ = 3072, C_SGU = 4096, C_SGZ = 5120, C_NAQ = 6144, C_NAK = 7168, C_NAV = 8192, C_RWR = 9216, C_RWK = 10240, C_RWV = 11264,
              C_RWWD = 12288, C_RWAD = 12416, C_SGV = 12544;
constexpr int C_SPLIT = 5632;
__host__ __device__ __forceinline__ int phys_tile(int lt) {
    return lt < 8 ? lt : lt < 20 ? lt + 16 : lt < 24 ? lt - 12 : lt < 36 ? lt + 12 : lt < 40 ? lt - 24 : lt == 40 ? 48 : lt < 45 ? lt - 25 : lt < 49 ? lt + 4 : lt - 29;
}
constexpr int SCANLEN = CTXL + SEQ;
constexpr int NCHAIN = 64;
constexpr int RECB = 896;
constexpr int RECF = RECB / 4;
constexpr int NWAVES = 8;

constexpr size_t MiB = 1u << 20;
constexpr size_t WS_CTL = 0, CTL_ZERO_BYTES = 1 * MiB;
constexpr size_t WS_MOD   = 2 * MiB;
constexpr size_t WS_TAB   = 3 * MiB;
constexpr size_t WS_SGST  = 4 * MiB;
constexpr size_t WS_BON   = 5 * MiB;
constexpr size_t WS_POOLWT= 8 * MiB;
constexpr size_t WS_WUPT  = 10 * MiB;
constexpr size_t WS_AUPT  = 11 * MiB;
constexpr size_t WS_SGW   = 12 * MiB;
constexpr size_t WS_VTC   = 13 * MiB;
constexpr size_t WS_HCTX  = 14 * MiB;
constexpr size_t WS_MODP  = 22 * MiB;
constexpr size_t WS_VTL   = 58 * MiB;
constexpr size_t WS_QN    = 90 * MiB;
constexpr size_t WS_KN    = 123 * MiB;
constexpr size_t WS_WOUTT = 156 * MiB;
constexpr size_t WS_WINT  = 284 * MiB;
constexpr size_t WS_XN    = 708 * MiB;
constexpr size_t WS_Y     = 840 * MiB;
constexpr size_t WS_P     = 972 * MiB;
constexpr size_t WS_YR    = 1410 * MiB;
constexpr size_t WS_REC   = 1542 * MiB;
constexpr size_t WS_END   = 2334 * MiB;
static_assert(WS_P + (size_t)MROWS * NIN * 2 <= WS_YR && WS_REC + (size_t)NCHAIN * SCANLEN * RECB <= WS_END && WS_WINT + (size_t)4 * NIN * DM * 2 <= WS_XN, "ws map");
constexpr int CW_TMO = 0, CW_BAR = 4096;

constexpr int RING_BYTES = 131072, LDSCTL_OFF = RING_BYTES, MISC_OFF = LDSCTL_OFF + 320, LDS_BYTES = 147456;

#define GAS __attribute__((address_space(1)))
#define LAS __attribute__((address_space(3)))
typedef unsigned short bf16;
typedef unsigned v4u __attribute__((ext_vector_type(4)));
typedef unsigned v2u __attribute__((ext_vector_type(2)));
typedef float f32x4 __attribute__((ext_vector_type(4)));
typedef float f32x2 __attribute__((ext_vector_type(2)));
typedef short bf16x8 __attribute__((ext_vector_type(8)));
typedef _Float16 h4 __attribute__((ext_vector_type(4)));
typedef _Float16 h8 __attribute__((ext_vector_type(8)));
#define RLX_AGENT __ATOMIC_RELAXED, __HIP_MEMORY_SCOPE_AGENT
#define LDS_WAIT() asm volatile("s_waitcnt lgkmcnt(0)" ::: "memory")

__device__ __forceinline__ float bf2f(unsigned short h) { return __uint_as_float(((unsigned)h) << 16); }
__device__ __forceinline__ float bflo(unsigned w) { return __uint_as_float(w << 16); }
__device__ __forceinline__ float bfhi(unsigned w) { return __uint_as_float(w & 0xffff0000u); }
typedef __bf16 bf16x2_t __attribute__((ext_vector_type(2)));
__device__ __forceinline__ unsigned pk2(float lo, float hi) { const f32x2 v = {lo, hi}; const bf16x2_t b = __builtin_convertvector(v, bf16x2_t); return __builtin_bit_cast(unsigned, b); }
__device__ __forceinline__ unsigned f2bf(float f) { return pk2(f, 0.f) & 0xffffu; }
__device__ __forceinline__ float rcp_f(float x) { return __builtin_amdgcn_rcpf(x); }
__device__ __forceinline__ float rsq_f(float x) { return __builtin_amdgcn_rsqf(x); }
__device__ __forceinline__ void unpack8(const v4u w, float* x) { x[0] = bflo(w.x); x[1] = bfhi(w.x); x[2] = bflo(w.y); x[3] = bfhi(w.y); x[4] = bflo(w.z); x[5] = bfhi(w.z); x[6] = bflo(w.w); x[7] = bfhi(w.w); }
__device__ __forceinline__ v4u pack8(const float* x) { v4u w; w.x = pk2(x[0], x[1]); w.y = pk2(x[2], x[3]); w.z = pk2(x[4], x[5]); w.w = pk2(x[6], x[7]); return w; }
__device__ __forceinline__ float silu_f(float x) { return x * rcp_f(1.f + __expf(-x)); }
__device__ __forceinline__ float wave_sum(float v) {
#pragma unroll
    for (int o = 1; o < 64; o <<= 1) v += __shfl_xor(v, o);
    return v;
}
template <int CTRL> __device__ __forceinline__ float dppf(float v) { return __builtin_bit_cast(float, __builtin_amdgcn_update_dpp(0, __builtin_bit_cast(int, v), CTRL, 0xF, 0xF, true)); }
__device__ __forceinline__ float red16(float v) { v += dppf<0xB1>(v); v += dppf<0x4E>(v); v += dppf<0x141>(v); v += dppf<0x140>(v); return v; }
__device__ __forceinline__ void red16x2(float& a, float& b) {
    a += dppf<0xB1>(a); b += dppf<0xB1>(b); a += dppf<0x4E>(a); b += dppf<0x4E>(b); a += dppf<0x141>(a); b += dppf<0x141>(b); a += dppf<0x140>(a); b += dppf<0x140>(b); }
__device__ __forceinline__ float red16_transpose(const float (&y)[16], int c16) {
    float a[8], b[4], c[2];
    const bool h8 = (c16 & 8) != 0, h4 = (c16 & 4) != 0, h2 = (c16 & 2) != 0, h1 = (c16 & 1) != 0;
#pragma unroll
    for (int j = 0; j < 8; ++j) { const float keep = h8 ? y[j + 8] : y[j], send = h8 ? y[j] : y[j + 8]; a[j] = keep + dppf<0x140>(send); }
#pragma unroll
    for (int j = 0; j < 4; ++j) { const float keep = h4 ? a[j + 4] : a[j], send = h4 ? a[j] : a[j + 4]; b[j] = keep + dppf<0x141>(send); }
#pragma unroll
    for (int j = 0; j < 2; ++j) { const float keep = h2 ? b[j + 2] : b[j], send = h2 ? b[j] : b[j + 2]; c[j] = keep + dppf<0x1B>(send); }
    const float keep = h1 ? c[1] : c[0], send = h1 ? c[0] : c[1];
    return keep + dppf<0xB1>(send);
}
__device__ __forceinline__ float max16x4(float v) { v = fmaxf(v, __shfl_xor(v, 16)); v = fmaxf(v, __shfl_xor(v, 32)); return v; }
__device__ __forceinline__ float sum16x4(float v) { v += __shfl_xor(v, 16); v += __shfl_xor(v, 32); return v; }
__device__ __forceinline__ int scan_pos(int d, bool isctx, int t) { return d == 0 ? (isctx ? t : CTXL + t) : (isctx ? (CTXL - 1 - t) : (CTXL + SEQ - 1 - t)); }
__device__ __forceinline__ f32x4 mfma16(bf16x8 a, bf16x8 b, f32x4 c) { return __builtin_amdgcn_mfma_f32_16x16x32_bf16(a, b, c, 0, 0, 0); }
__device__ __forceinline__ bf16x8 ld_frag(const bf16* p) { return __builtin_bit_cast(bf16x8, *(const v4u*)p); }

namespace pg8 {
struct EpiStoreBf16 {
    static constexpr bool PERM = true, AFTER_DRAIN = false;
    bf16_t* O; int ldc;
    __device__ __forceinline__ void operator()(const f32x4 (&acc)[2][2][4][2], const Unit& u, int wr, int wc, int fr, int fq) const {
        const int row0 = u.pm * BM + wr * 64 + fr, col0 = u.pn * BM + wc * 32 + 8 * fq;
#pragma unroll
        for (int ai = 0; ai < 2; ++ai)
#pragma unroll
            for (int m = 0; m < 4; ++m) { bf16_t* rowp = O + (size_t)(row0 + ai * HALF + m * 16) * ldc + col0;
#pragma unroll
                for (int bj = 0; bj < 2; ++bj) { const f32x4 v0 = acc[ai][bj][m][0], v1 = acc[ai][bj][m][1];
                    u32x4 w; w.x = cvt_pk_bf16(v0[0], v0[1]); w.y = cvt_pk_bf16(v0[2], v0[3]); w.z = cvt_pk_bf16(v1[0], v1[1]); w.w = cvt_pk_bf16(v1[2], v1[3]);
                    *(u32x4*)(rowp + bj * HALF) = w; } }
    }
};
struct EpiResGate {
    static constexpr bool PERM = false, AFTER_DRAIN = false;
    const float* hin_lat; const float* hin_ctx; float* hout_lat; float* hout_ctx; const float* gate;
    __device__ __forceinline__ void operator()(const f32x4 (&acc)[2][2][4][2], const Unit& u, int wr, int wc, int fr, int fq) const {
        const int cond = u.pm < 32 ? 0 : (u.pm < 64 ? 1 : 2);
        const int rloc = (u.pm < 64 ? u.pm * BM : (u.pm - 64) * BM) + wr * 64 + fr, col0 = u.pn * BM + wc * 32 + 4 * fq;
        const float* hin = u.pm < 64 ? hin_lat : hin_ctx; float* hout = u.pm < 64 ? hout_lat : hout_ctx;
        f32x4 gv[2][2];
#pragma unroll
        for (int bj = 0; bj < 2; ++bj)
#pragma unroll
            for (int n = 0; n < 2; ++n) gv[bj][n] = *(const f32x4*)(gate + cond * 12288 + 8192 + col0 + bj * HALF + n * 16);
#pragma unroll
        for (int ai = 0; ai < 2; ++ai)
#pragma unroll
            for (int m = 0; m < 4; ++m) { const size_t off = (size_t)(rloc + ai * HALF + m * 16) * 4096 + col0;
#pragma unroll
                for (int bj = 0; bj < 2; ++bj)
#pragma unroll
                    for (int n = 0; n < 2; ++n) { const f32x4 b = *(const f32x4*)(hin + off + bj * HALF + n * 16);
                        *(f32x4*)(hout + off + bj * HALF + n * 16) = b + gv[bj][n] * acc[ai][bj][m][n]; } }
    }
};
}

template <bool PERMC = false>
__device__ __forceinline__ void p0_transpose_item(const float* W, int K, int N, bf16* WT, LAS float* scr, int item, int lane) {
    const int nblk = N / 32, kb = item / nblk, nb = item % nblk, k0 = 64 * kb, n0 = 32 * nb;
    const int pn0 = PERMC ? phys_tile(n0 >> 8) * 256 + (n0 & 255) : n0;
#pragma unroll 8
    for (int i = 0; i < 32; ++i) { const int kk = 2 * i + (lane >> 5); scr[kk * 33 + (lane & 31)] = W[(size_t)(k0 + kk) * N + n0 + (lane & 31)]; }
    LDS_WAIT(); asm volatile("" ::: "memory");
    const int c = lane & 7;
#pragma unroll
    for (int j = 0; j < 4; ++j) { const int n = (lane >> 3) + 8 * j; const LAS float* s = scr + (8 * c) * 33 + n;
        v4u o; o.x = pk2(s[0 * 33], s[1 * 33]); o.y = pk2(s[2 * 33], s[3 * 33]); o.z = pk2(s[4 * 33], s[5 * 33]); o.w = pk2(s[6 * 33], s[7 * 33]);
        *(v4u*)(WT + (size_t)(pn0 + n) * K + k0 + 8 * c) = o; }
    LDS_WAIT(); asm volatile("" ::: "memory");
}
template <bool PERMC = false>
__device__ __forceinline__ void transpose_item_nolds(const float* W, int K, int N, bf16* WT, int item, int lane) {
    const int nblk = N / 64, kb = item / nblk, nb = item % nblk, k0 = 64 * kb, n0 = 64 * nb;
    const int pn0 = PERMC ? phys_tile(n0 >> 8) * 256 + (n0 & 255) : n0;
    const float* src = W + (size_t)k0 * N + n0 + lane;
    bf16* dst = WT + (size_t)(pn0 + lane) * K + k0;
#pragma unroll
    for (int hb = 0; hb < 2; ++hb) {
        float v[32];
#pragma unroll
        for (int i = 0; i < 32; ++i) v[i] = src[(size_t)(32 * hb + i) * N];
        __builtin_amdgcn_sched_barrier(0);
#pragma unroll
        for (int j = 0; j < 4; ++j) { v4u o; o.x = pk2(v[8 * j], v[8 * j + 1]); o.y = pk2(v[8 * j + 2], v[8 * j + 3]); o.z = pk2(v[8 * j + 4], v[8 * j + 5]); o.w = pk2(v[8 * j + 6], v[8 * j + 7]);
            *(v4u*)(dst + 32 * hb + 8 * j) = o; }
        __builtin_amdgcn_sched_barrier(0);
    }
}
constexpr int WC_WIN = (DM / 64) * (NIN / 64), WC_WOUT = (DM / 64) * (DM / 64), WC_POOL = 4 * 16, WC_WUP = 2 * 16, WC_AUP = 2 * 16, WC_SGW = 256, WC_ITEMS = WC_WIN + WC_WOUT + WC_POOL + WC_WUP + WC_AUP + WC_SGW;
__device__ __forceinline__ void weight_copy_item(int L, int r, const float* w_in, const float* w_out, const float* pool_w, const float* rw_w_up, const float* rw_a_up, const float* sg_w,
                                                 bf16* WINT, bf16* WOUTT, bf16* POOLWT, bf16* WUPT, bf16* AUPT, bf16* SGW, int lane) {
    if (r < WC_WIN) { transpose_item_nolds<true>(w_in + (size_t)L * DM * NIN, DM, NIN, WINT + (size_t)L * NIN * DM, r, lane); return; } r -= WC_WIN;
    if (r < WC_WOUT) { transpose_item_nolds(w_out + (size_t)L * DM * DM, DM, DM, WOUTT + (size_t)L * DM * DM, r, lane); return; } r -= WC_WOUT;
    if (r < WC_POOL) { const int g = r >> 4; transpose_item_nolds(pool_w + (size_t)(L * 4 + g) * 65536, 256, 256, POOLWT + (size_t)(L * 4 + g) * 65536, r & 15, lane); return; } r -= WC_POOL;
    if (r < WC_WUP) { const int dd = r >> 4; transpose_item_nolds(rw_w_up + (size_t)(L * 2 + dd) * 65536, 64, 1024, WUPT + (size_t)(L * 2 + dd) * 65536, r & 15, lane); return; } r -= WC_WUP;
    if (r < WC_AUP) { const int dd = r >> 4; transpose_item_nolds(rw_a_up + (size_t)(L * 2 + dd) * 65536, 64, 1024, AUPT + (size_t)(L * 2 + dd) * 65536, r & 15, lane); return; } r -= WC_AUP;
    {   const size_t e0 = (size_t)L * 131072 + (size_t)r * 512 + lane * 8; const f32x4 a = *(const f32x4*)(sg_w + e0), b = *(const f32x4*)(sg_w + e0 + 4);
        v4u o; o.x = pk2(a.x, a.y); o.y = pk2(a.z, a.w); o.z = pk2(b.x, b.y); o.w = pk2(b.z, b.w); *(v4u*)(SGW + e0) = o; }
}
__device__ __forceinline__ void p0_mod_item(const float* wmod, const float* cvec, const float* cctx, float* MODP, LAS float* scr, int item, int lane) {
    const int l = item / (64 * 48), r = item % (64 * 48), kc = r / 48, nc = r % 48, k0 = kc * 64, n0 = nc * 256 + lane * 4;
    scr[lane] = silu_f(cvec[k0 + lane]); scr[64 + lane] = silu_f(cvec[4096 + k0 + lane]); scr[128 + lane] = silu_f(cctx[k0 + lane]);
    LDS_WAIT(); asm volatile("" ::: "memory");
    f32x4 a0 = {0.f, 0.f, 0.f, 0.f}, a1 = a0, a2 = a0;
    const float* wp = wmod + ((size_t)l * 4096 + k0) * 12288 + n0;
#pragma unroll 16
    for (int k = 0; k < 64; ++k) { const f32x4 w = *(const f32x4*)(wp + (size_t)k * 12288); a0 += scr[k] * w; a1 += scr[64 + k] * w; a2 += scr[128 + k] * w; }
    float* o = MODP + ((size_t)(l * 64 + kc) * 3) * 12288 + n0;
    *(f32x4*)(o) = a0; *(f32x4*)(o + 12288) = a1; *(f32x4*)(o + 2 * 12288) = a2;
    LDS_WAIT(); asm volatile("" ::: "memory");
}
__device__ __forceinline__ void sincos_acc(float ang, float& c, float& s) {
    const double x = (double)ang; const double n = __builtin_rint(x * 0.63661977236758134308); const double r = x - n * 1.57079632679489661923;
    const double r2 = r * r;
    const double sp = r * (1.0 + r2 * (-1.0 / 6 + r2 * (1.0 / 120 + r2 * (-1.0 / 5040 + r2 * (1.0 / 362880 + r2 * (-1.0 / 39916800 + r2 * (1.0 / 6227020800.0)))))));
    const double cp = 1.0 + r2 * (-0.5 + r2 * (1.0 / 24 + r2 * (-1.0 / 720 + r2 * (1.0 / 40320 + r2 * (-1.0 / 3628800 + r2 * (1.0 / 479001600 + r2 * (-1.0 / 87178291200.0)))))));
    const int q = ((int)n) & 3;
    const double cc = (q == 0) ? cp : (q == 1) ? -sp : (q == 2) ? -cp : sp;
    const double ss = (q == 0) ? sp : (q == 1) ? cp : (q == 2) ? -sp : -cp;
    c = (float)cc; s = (float)ss;
}

__device__ __forceinline__ void phase_xn(const float* hlat, const float* hctx, const float* mod, bf16* XN, int gw, int NGW, int lane) {
    for (int m = gw; m < MROWS; m += NGW) {
        const float* src = m < NLAT ? hlat + (size_t)m * DM : hctx + (size_t)(m - NLAT) * DM;
        const int cond = m < NLAT ? (m >> 13) : 2;
        const f32x4* s4 = (const f32x4*)src + lane;
        f32x4 v[16]; float ss = 0.f;
#pragma unroll
        for (int j = 0; j < 16; ++j) { v[j] = s4[64 * j]; ss += (v[j].x * v[j].x + v[j].y * v[j].y) + (v[j].z * v[j].z + v[j].w * v[j].w); }
        ss = wave_sum(ss);
        const float rstd = rsq_f(ss * (1.f / 4096.f) + 1e-6f);
        const f32x4* sh4 = (const f32x4*)(mod + cond * 12288) + lane; const f32x4* sc4 = (const f32x4*)(mod + cond * 12288 + 4096) + lane;
        v2u* o = (v2u*)(XN + (size_t)m * DM) + lane;
#pragma unroll
        for (int j = 0; j < 16; ++j) { const f32x4 sh = sh4[64 * j], sc = sc4[64 * j]; const f32x4 x = v[j] * rstd * (sc + 1.f) + sh; v2u w; w.x = pk2(x.x, x.y); w.y = pk2(x.z, x.w); o[64 * j] = w; }
    }
}

__device__ __forceinline__ void phase_rowprep(const bf16* P, const float* qgain, const float* kgain, const f32x2* tab, bf16* QN, bf16* KN, f32x2* SGST, int gw, int NGW, int lane) {
    const int sub = lane & 3;
    for (int m = gw; m < MROWS; m += NGW) {
        const bf16* pr = P + (size_t)m * NIN;
        const bool isctx = m >= NLAT; const int t = isctx ? ((m - NLAT) & 255) : (m & 8191);
        {   float x[16]; unpack8(*(const v4u*)(pr + C_SGV + 16 * lane), x); unpack8(*(const v4u*)(pr + C_SGV + 16 * lane + 8), x + 8);
            float s = 0.f;
#pragma unroll
            for (int i = 0; i < 16; ++i) s += x[i];
            const float mean = wave_sum(s) * (1.f / 1024.f); float q = 0.f;
#pragma unroll
            for (int i = 0; i < 16; ++i) { const float dlt = x[i] - mean; q += dlt * dlt; }
            const float var = wave_sum(q) * (1.f / 1024.f);
            if (lane == 0) SGST[m] = (f32x2){mean, rsq_f(var + 1e-5f)}; }
        float q[16], k[16];
        unpack8(*(const v4u*)(pr + C_NAQ + 16 * lane), q); unpack8(*(const v4u*)(pr + C_NAQ + 16 * lane + 8), q + 8);
        unpack8(*(const v4u*)(pr + C_NAK + 16 * lane), k); unpack8(*(const v4u*)(pr + C_NAK + 16 * lane + 8), k + 8);
        float sq = 0.f, sk = 0.f;
#pragma unroll
        for (int i = 0; i < 16; ++i) { sq += q[i] * q[i]; sk += k[i] * k[i]; }
        sq += __shfl_xor(sq, 1); sq += __shfl_xor(sq, 2); sk += __shfl_xor(sk, 1); sk += __shfl_xor(sk, 2);
        const float rq = rsq_f(sq * (1.f / 64.f) + 1e-6f), rk = rsq_f(sk * (1.f / 64.f) + 1e-6f);
#pragma unroll
        for (int i = 0; i < 16; ++i) { q[i] *= rq * qgain[16 * sub + i]; k[i] *= rk * kgain[16 * sub + i]; }
        if (!isctx) {
            const int pos = sub < 2 ? (t >> 6) : (t & 63);
#pragma unroll
            for (int i = 0; i < 16; ++i) { const f32x2 cs = tab[pos * 16 + i]; const float pq = __shfl_xor(q[i], 1), pkk = __shfl_xor(k[i], 1);
                q[i] = (sub & 1) ? (q[i] * cs.x + pq * cs.y) : (q[i] * cs.x - pq * cs.y);
                k[i] = (sub & 1) ? (k[i] * cs.x + pkk * cs.y) : (k[i] * cs.x - pkk * cs.y); }
        }
#pragma unroll
        for (int i = 0; i < 16; ++i) q[i] *= 0.125f;
        *(v4u*)(QN + (size_t)m * GWD + 16 * lane) = pack8(q); *(v4u*)(QN + (size_t)m * GWD + 16 * lane + 8) = pack8(q + 8);
        *(v4u*)(KN + (size_t)m * GWD + 16 * lane) = pack8(k); *(v4u*)(KN + (size_t)m * GWD + 16 * lane + 8) = pack8(k + 8);
    }
}
__device__ __forceinline__ void phase_vt(const bf16* P, bf16* VTL, bf16* VTC, int gw, int NGW, int lane) {
    for (int u = gw; u < (MROWS / 64) * 16; u += NGW) {
        const int tt = u >> 4, h = u & 15, m0 = tt * 64;
        const bf16* src = P + (size_t)m0 * NIN + C_NAV + h * 64 + lane;
        unsigned w[32];
#pragma unroll
        for (int i = 0; i < 32; ++i) { const unsigned lo = src[(size_t)(2 * i) * NIN], hi = src[(size_t)(2 * i + 1) * NIN]; w[i] = lo | (hi << 16); }
        bf16* dst = tt < 256 ? VTL + (((size_t)((tt >> 7) * 16 + h) * 64 + lane) * 8192 + (tt & 127) * 64)
                             : VTC + (((size_t)(((tt - 256) >> 2) * 16 + h) * 64 + lane) * 256 + ((tt - 256) & 3) * 64);
#pragma unroll
        for (int j = 0; j < 8; ++j) { v4u o; o.x = w[4 * j]; o.y = w[4 * j + 1]; o.z = w[4 * j + 2]; o.w = w[4 * j + 3]; ((v4u*)dst)[j] = o; }
    }
}
template <int G>
__device__ __forceinline__ void pool_unit(const bf16* P, const bf16* wbase, const float* pscale, bf16* Y, int m0, int lane) {
    constexpr int WIN = 2 << G;
    const int r = lane & 15, q4 = lane >> 4, m = m0 + r;
    const bool isctx = m0 >= NLAT; const int T = isctx ? CTXL : SEQ; const int t = isctx ? ((m - NLAT) & 255) : (m & 8191);
    const int tlo = t - (WIN >> 1);
    const int lo = tlo < 0 ? 0 : tlo, hi = (tlo + WIN) > T ? T : (tlo + WIN);
    const float inv = rcp_f((float)(hi - lo));
    f32x4 acc[16];
#pragma unroll
    for (int nt = 0; nt < 16; ++nt) acc[nt] = (f32x4){0.f, 0.f, 0.f, 0.f};
#pragma unroll 1
    for (int ks = 0; ks < 8; ++ks) {
        const int ch0 = C_POOLV + G * 256 + 32 * ks + 8 * q4;
        constexpr int WB = WIN < 8 ? WIN : 8;
        bf16x8 bfr[8];
        float sum[8];
#pragma unroll
        for (int j = 0; j < 8; ++j) sum[j] = 0.f;
        const v4u selfw = *(const v4u*)(P + (size_t)m * NIN + ch0);
#pragma unroll
        for (int nt = 0; nt < 8; ++nt) bfr[nt] = ld_frag(wbase + (size_t)(16 * nt + r) * 256 + 32 * ks + 8 * q4);
#pragma unroll
        for (int k0 = 0; k0 < WIN; k0 += WB) {
            v4u wl[WB];
#pragma unroll
            for (int k = 0; k < WB; ++k) { const int tk = tlo + k0 + k; const bool ok = tk >= 0 && tk < T; wl[k] = *(const v4u*)(P + (size_t)(ok ? (m - t + tk) : m) * NIN + ch0); }
            __builtin_amdgcn_sched_barrier(0);
#pragma unroll
            for (int k = 0; k < WB; ++k) { const int tk = tlo + k0 + k; const bool ok = tk >= 0 && tk < T; float x[8]; unpack8(wl[k], x);
#pragma unroll
                for (int j = 0; j < 8; ++j) sum[j] += ok ? x[j] : 0.f; }
            __builtin_amdgcn_sched_barrier(0);
        }
        float self[8]; unpack8(selfw, self);
        float dv[8];
#pragma unroll
        for (int j = 0; j < 8; ++j) dv[j] = sum[j] * inv - self[j];
        const bf16x8 af = __builtin_bit_cast(bf16x8, pack8(dv));
        __builtin_amdgcn_sched_barrier(0);
        bf16x8 bfr2[8];
#pragma unroll
        for (int nt = 0; nt < 8; ++nt) bfr2[nt] = ld_frag(wbase + (size_t)(16 * (nt + 8) + r) * 256 + 32 * ks + 8 * q4);
        __builtin_amdgcn_sched_barrier(0);
#pragma unroll
        for (int nt = 0; nt < 8; ++nt) acc[nt] = mfma16(af, bfr[nt], acc[nt]);
        __builtin_amdgcn_sched_barrier(0);
#pragma unroll
        for (int nt = 0; nt < 8; ++nt) acc[nt + 8] = mfma16(af, bfr2[nt], acc[nt + 8]);
        __builtin_amdgcn_sched_barrier(0);
    }
#pragma unroll
    for (int nh = 0; nh < 4; ++nh) {
        unsigned short zz[4][4]; float ps[4];
#pragma unroll
        for (int nq = 0; nq < 4; ++nq) { const int oc = G * 256 + 16 * (4 * nh + nq) + r; ps[nq] = pscale[oc];
#pragma unroll
            for (int i = 0; i < 4; ++i) zz[nq][i] = P[(size_t)(m0 + 4 * q4 + i) * NIN + C_POOLZ + oc]; }
        __builtin_amdgcn_sched_barrier(0);
#pragma unroll
        for (int nq = 0; nq < 4; ++nq) { const int oc = G * 256 + 16 * (4 * nh + nq) + r;
#pragma unroll
            for (int i = 0; i < 4; ++i) Y[(size_t)(m0 + 4 * q4 + i) * DM + oc] = (bf16)f2bf(acc[4 * nh + nq][i] * ps[nq] * silu_f(bf2f(zz[nq][i]))); }
        __builtin_amdgcn_sched_barrier(0);
    }
}
__device__ __forceinline__ void phase_pool(const bf16* P, const bf16* PWT  , const float* pscale, bf16* Y, int nrows, int gw, int NGW, int lane) {
    for (int u = gw; u < (nrows / 16) * 4; u += NGW) {
        const int tt = u >> 2, g = u & 3, m0 = tt * 16;
        const bf16* wbase = PWT + (size_t)g * 65536;
        if (g == 0) pool_unit<0>(P, wbase, pscale, Y, m0, lane);
        else if (g == 1) pool_unit<1>(P, wbase, pscale, Y, m0, lane);
        else if (g == 2) pool_unit<2>(P, wbase, pscale, Y, m0, lane);
        else pool_unit<3>(P, wbase, pscale, Y, m0, lane);
    }
}
#if defined(PROBE_REC2)
#define REC_ST(p, v) do { __builtin_nontemporal_store((v), (p)); __builtin_nontemporal_store((v), (f32x4*)((char*)(p) + (size_t)792 * 1048576)); } while (0)
#elif defined(REC_NT)
#define REC_ST(p, v) __builtin_nontemporal_store((v), (p))
#else
#define REC_ST(p, v) (*(p) = (v))
#endif
__device__ __forceinline__ void phase_rwprep(const bf16* P, const float* mu_rkv  , const float* mu_lora  , const float* w0  , const bf16* WUPT  ,
                                             const float* a0, const bf16* AUPT, const float* k_k, const float* k_a, const float* r_k, float* REC, float* BON, LAS unsigned char* lds,
                                             unsigned* queue  , int cls, int wave, int lane) {
    const int n = lane & 15, q4 = lane >> 4;
    const int d = cls >> 3, hp = cls & 7;
    unsigned* qh = queue + 64 * cls;
    LAS float* prm = (LAS float*)(lds + wave * 4096);
#pragma unroll
    for (int it = 0; it < 16; ++it) { const int hh = it >> 3, p = it & 7, ch = (hp * 2 + hh) * 64 + lane;
        const float* src = p == 0 ? w0 + d * 1024 : p == 1 ? a0 + d * 1024 : p == 2 ? mu_rkv + (d * 3 + 0) * 1024 : p == 3 ? mu_rkv + (d * 3 + 1) * 1024 : p == 4 ? mu_rkv + (d * 3 + 2) * 1024 : p == 5 ? k_k : p == 6 ? k_a : r_k;
        prm[it * 64 + lane] = src[ch]; }
    LDS_WAIT(); asm volatile("" ::: "memory");
    unsigned pend = 0u;
    if (lane == 0) pend = __hip_atomic_fetch_add(qh, 1u, __ATOMIC_RELAXED, __HIP_MEMORY_SCOPE_AGENT);
    for (;;) {
        const int tt = __builtin_amdgcn_readfirstlane((int)pend);
        if (tt >= MROWS / 16) break;
        if (lane == 0) pend = __hip_atomic_fetch_add(qh, 1u, __ATOMIC_RELAXED, __HIP_MEMORY_SCOPE_AGENT);
        const int m0 = tt * 16;
        const bool isctx = m0 >= NLAT; const int T = isctx ? CTXL : SEQ; const int t0 = isctx ? ((m0 - NLAT) & 255) : (m0 & 8191); const int b = isctx ? ((m0 - NLAT) >> 8) : (m0 >> 13);
        const int m = m0 + n, t = t0 + n; const bool hasnb = d == 0 ? (t > 0) : (t < T - 1); const int nbr = hasnb ? (d == 0 ? m - 1 : m + 1) : m;
        const bf16* prow = P + (size_t)m * NIN; const bf16* nrow = P + (size_t)nbr * NIN;
        bf16x8 Bw[2], Ba[2];
        {   v4u cw[2], nw[2], ca[2], na[2]; f32x4 mw[2][2], ma[2][2];
#pragma unroll
            for (int ks = 0; ks < 2; ++ks) { const int j0 = 32 * ks + 8 * q4;
                cw[ks] = *(const v4u*)(prow + C_RWWD + d * 64 + j0); nw[ks] = *(const v4u*)(nrow + C_RWWD + d * 64 + j0);
                ca[ks] = *(const v4u*)(prow + C_RWAD + d * 64 + j0); na[ks] = *(const v4u*)(nrow + C_RWAD + d * 64 + j0);
                mw[ks][0] = *(const f32x4*)(mu_lora + (d * 2 + 0) * 64 + j0); mw[ks][1] = *(const f32x4*)(mu_lora + (d * 2 + 0) * 64 + j0 + 4);
                ma[ks][0] = *(const f32x4*)(mu_lora + (d * 2 + 1) * 64 + j0); ma[ks][1] = *(const f32x4*)(mu_lora + (d * 2 + 1) * 64 + j0 + 4); }
            __builtin_amdgcn_sched_barrier(0);
#pragma unroll
            for (int ks = 0; ks < 2; ++ks) {
                float cur[8], nb[8], o[8];
                unpack8(cw[ks], cur); unpack8(nw[ks], nb);
#pragma unroll
                for (int j = 0; j < 8; ++j) { const float xx = cur[j] + ((hasnb ? nb[j] : 0.f) - cur[j]) * mw[ks][j >> 2][j & 3]; o[j] = 1.0f - 2.0f * rcp_f(1.0f + __expf(2.0f * xx)); }
                Bw[ks] = __builtin_bit_cast(bf16x8, pack8(o));
                unpack8(ca[ks], cur); unpack8(na[ks], nb);
#pragma unroll
                for (int j = 0; j < 8; ++j) o[j] = cur[j] + ((hasnb ? nb[j] : 0.f) - cur[j]) * ma[ks][j >> 2][j & 3];
                Ba[ks] = __builtin_bit_cast(bf16x8, pack8(o)); }
        }
        const int pos = scan_pos(d, isctx, t);
#pragma unroll 1
        for (int hh = 0; hh < 2; ++hh) {
            const int head = hp * 2 + hh, chain = (b * 2 + d) * 16 + head;
            char* recb = (char*)REC + ((size_t)chain * SCANLEN + pos) * RECB;
            const LAS float* pr = prm + hh * 512;
            float KK[16], AV[16]; float ss = 0.f, bon = 0.f;
#pragma unroll
            for (int hf = 0; hf < 2; ++hf) {
                const int cl = 32 * hf + 8 * q4, cg = head * 64 + cl;
                bf16x8 wf[2][2], af[2][2];
#pragma unroll
                for (int tq = 0; tq < 2; ++tq) { const size_t wrow = (size_t)(d * 1024 + head * 64 + 32 * hf + 8 * (n >> 2) + 4 * tq + (n & 3)) * 64 + 8 * q4;
                    wf[tq][0] = ld_frag(WUPT + wrow); wf[tq][1] = ld_frag(WUPT + wrow + 32); af[tq][0] = ld_frag(AUPT + wrow); af[tq][1] = ld_frag(AUPT + wrow + 32); }
                const v4u rcw = *(const v4u*)(prow + C_RWR + cg), kcw = *(const v4u*)(prow + C_RWK + cg), vcw = *(const v4u*)(prow + C_RWV + cg);
                const v4u rnw = *(const v4u*)(nrow + C_RWR + cg), knw = *(const v4u*)(nrow + C_RWK + cg), vnw = *(const v4u*)(nrow + C_RWV + cg);
                __builtin_amdgcn_sched_barrier(0);
                f32x4 accW[2], accA[2];
#pragma unroll
                for (int tq = 0; tq < 2; ++tq) { f32x4 z = {0.f, 0.f, 0.f, 0.f}; z = mfma16(wf[tq][0], Bw[0], z); accW[tq] = mfma16(wf[tq][1], Bw[1], z);
                                                 f32x4 y = {0.f, 0.f, 0.f, 0.f}; y = mfma16(af[tq][0], Ba[0], y); accA[tq] = mfma16(af[tq][1], Ba[1], y); }
                float rc[8], kc[8], vc[8], rn[8], kn[8], vn[8];
                unpack8(rcw, rc); unpack8(kcw, kc); unpack8(vcw, vc); unpack8(rnw, rn); unpack8(knw, kn); unpack8(vnw, vn);
                float dec[8], kp[8], rr[8], vv[8];
#pragma unroll
                for (int g = 0; g < 2; ++g) {
                    const f32x4 w0v = *(const LAS f32x4*)(pr + 0 * 64 + cl + 4 * g), a0v = *(const LAS f32x4*)(pr + 1 * 64 + cl + 4 * g), mur = *(const LAS f32x4*)(pr + 2 * 64 + cl + 4 * g),
                                muk = *(const LAS f32x4*)(pr + 3 * 64 + cl + 4 * g), muv = *(const LAS f32x4*)(pr + 4 * 64 + cl + 4 * g), kkv = *(const LAS f32x4*)(pr + 5 * 64 + cl + 4 * g),
                                kav = *(const LAS f32x4*)(pr + 6 * 64 + cl + 4 * g), rkv = *(const LAS f32x4*)(pr + 7 * 64 + cl + 4 * g);
#pragma unroll
                    for (int i = 0; i < 4; ++i) { const int j = 4 * g + i;
                        const float rnb = hasnb ? rn[j] : 0.f, knb = hasnb ? kn[j] : 0.f, vnb = hasnb ? vn[j] : 0.f;
                        const float r_ = rc[j] + (rnb - rc[j]) * mur[i], k0 = kc[j] + (knb - kc[j]) * muk[i], v_ = vc[j] + (vnb - vc[j]) * muv[i];
                        const float xw = -(w0v[i] + accW[g][i]);
                        const float sp = fmaxf(xw, 0.f) + __logf(1.0f + __expf(-fabsf(xw)));
                        dec[j] = __expf(-__expf(-sp - 0.5f));
                        const float av = rcp_f(1.0f + __expf(-(a0v[i] + accA[g][i])));
                        const float kx = k0 * kkv[i]; ss += kx * kx;
                        const float kp_ = k0 * (1.f + (av - 1.f) * kav[i]); bon += r_ * kp_ * rkv[i];
                        KK[8 * hf + j] = kx; AV[8 * hf + j] = av; kp[j] = kp_; rr[j] = r_; vv[j] = v_; }
                }
                char* ob = recb + cl * 2;
                REC_ST((f32x4*)(recb + cl * 4), ((f32x4){dec[0], dec[1], dec[2], dec[3]})); REC_ST((f32x4*)(recb + cl * 4 + 16), ((f32x4){dec[4], dec[5], dec[6], dec[7]}));
                REC_ST((h8*)(ob + 512), ((h8){(_Float16)kp[0], (_Float16)kp[1], (_Float16)kp[2], (_Float16)kp[3], (_Float16)kp[4], (_Float16)kp[5], (_Float16)kp[6], (_Float16)kp[7]}));
                REC_ST((h8*)(ob + 640), ((h8){(_Float16)rr[0], (_Float16)rr[1], (_Float16)rr[2], (_Float16)rr[3], (_Float16)rr[4], (_Float16)rr[5], (_Float16)rr[6], (_Float16)rr[7]}));
                REC_ST((h8*)(ob + 768), ((h8){(_Float16)vv[0], (_Float16)vv[1], (_Float16)vv[2], (_Float16)vv[3], (_Float16)vv[4], (_Float16)vv[5], (_Float16)vv[6], (_Float16)vv[7]}));
                __builtin_amdgcn_sched_barrier(0);
            }
            ss = sum16x4(ss); bon = sum16x4(bon);
            const float inv = rsq_f(fmaxf(ss, 1e-12f));
#pragma unroll
            for (int hf = 0; hf < 2; ++hf) { char* ob = recb + (32 * hf + 8 * q4) * 2; float kkn[8], nka[8];
#pragma unroll
                for (int j = 0; j < 8; ++j) { kkn[j] = KK[8 * hf + j] * inv; nka[j] = -(kkn[j] * AV[8 * hf + j]); }
                REC_ST((h8*)(ob + 256), ((h8){(_Float16)kkn[0], (_Float16)kkn[1], (_Float16)kkn[2], (_Float16)kkn[3], (_Float16)kkn[4], (_Float16)kkn[5], (_Float16)kkn[6], (_Float16)kkn[7]}));
                REC_ST((h8*)(ob + 384), ((h8){(_Float16)nka[0], (_Float16)nka[1], (_Float16)nka[2], (_Float16)nka[3], (_Float16)nka[4], (_Float16)nka[5], (_Float16)nka[6], (_Float16)nka[7]})); }
            if (q4 == 0) BON[(size_t)chain * SCANLEN + pos] = bon;
        }
    }
}
template <bool CTXQ>
__device__ __forceinline__ void na_unit(const bf16* QN, const bf16* KN, const bf16* VTL, const bf16* VTC, const bf16* P, const float* rpb  , bf16* Y, int u, int lane) {
    const int n = lane & 15, q4 = lane >> 4;
    int b, h, qrow0, qr = 0, jt = 0;
    if (CTXQ) { b = u >> 8; h = (u >> 4) & 15; qrow0 = NLAT + b * CTXL + 16 * (u & 15); }
    else { jt = u & 3; h = (u >> 2) & 15; qr = (u >> 6) & 127; b = u >> 13; qrow0 = b * SEQ + qr * 64 + 16 * jt; }
    constexpr int NT = CTXQ ? 16 : 32, WT = CTXQ ? 0 : 16;
    f32x4 s[NT];
    const int rs = qr - 4 < 0 ? 0 : (qr - 4 > 120 ? 120 : qr - 4);
    const int span0 = jt == 0 ? 0 : (jt == 1 ? 8 : (jt == 2 ? 24 : 32));
    const int qc = 16 * jt + n; const int cs = qc - 8 < 0 ? 0 : (qc - 8 > 48 ? 48 : qc - 8);
    bf16x8 qf[2];
#pragma unroll
    for (int ks = 0; ks < 2; ++ks) qf[ks] = ld_frag(QN + (size_t)(qrow0 + n) * GWD + h * 64 + 32 * ks + 8 * q4);
    if (!CTXQ) {
        const float* rp = rpb + (size_t)h * 15 * 31;
#pragma unroll
        for (int wt = 0; wt < 16; ++wt) { const int kri = wt >> 1, half = wt & 1, relr = rs + kri - qr + 7;
#pragma unroll
            for (int i = 0; i < 4; ++i) { const int relc = span0 + 8 * q4 + 4 * half + i - qc + 15; const int relcc = relc < 0 ? 0 : (relc > 30 ? 30 : relc); s[wt][i] = rp[relr * 31 + relcc]; } }
        __builtin_amdgcn_sched_barrier(0);
#pragma unroll
        for (int bt = 0; bt < 2; ++bt) {
            bf16x8 kf[16];
#pragma unroll
            for (int t = 0; t < 8; ++t) { const int wt = bt * 8 + t, kri = wt >> 1, half = wt & 1;
                const bf16* kp = KN + (size_t)(b * SEQ + (rs + kri) * 64 + span0 + 8 * (n >> 2) + 4 * half + (n & 3)) * GWD + h * 64 + 8 * q4; kf[2 * t] = ld_frag(kp); kf[2 * t + 1] = ld_frag(kp + 32); }
            __builtin_amdgcn_sched_barrier(0);
#pragma unroll
            for (int t = 0; t < 8; ++t) { const int wt = bt * 8 + t, half = wt & 1;
                f32x4 a = s[wt];
#pragma unroll
                for (int i = 0; i < 4; ++i) { const int kc = span0 + 8 * q4 + 4 * half + i; const bool ok = kc >= cs && kc < cs + 16; a[i] = ok ? a[i] : -INFINITY; }
                a = mfma16(kf[2 * t], qf[0], a); a = mfma16(kf[2 * t + 1], qf[1], a); s[wt] = a; }
            __builtin_amdgcn_sched_barrier(0);
        }
    }
#pragma unroll
    for (int bt = 0; bt < 2; ++bt) {
        bf16x8 kf[16];
#pragma unroll
        for (int t = 0; t < 8; ++t) { const int ctile = bt * 8 + t; const bf16* kp = KN + (size_t)(NLAT + b * CTXL + 32 * (ctile >> 1) + 8 * (n >> 2) + 4 * (ctile & 1) + (n & 3)) * GWD + h * 64 + 8 * q4; kf[2 * t] = ld_frag(kp); kf[2 * t + 1] = ld_frag(kp + 32); }
        __builtin_amdgcn_sched_barrier(0);
#pragma unroll
        for (int t = 0; t < 8; ++t) { f32x4 a = {0.f, 0.f, 0.f, 0.f}; a = mfma16(kf[2 * t], qf[0], a); a = mfma16(kf[2 * t + 1], qf[1], a); s[WT + bt * 8 + t] = a; }
        __builtin_amdgcn_sched_barrier(0);
    }
    float mx = -INFINITY;
#pragma unroll
    for (int t = 0; t < NT; ++t) mx = fmaxf(fmaxf(fmaxf(s[t][0], s[t][1]), fmaxf(s[t][2], s[t][3])), mx);
    mx = max16x4(mx);
    float sum = 0.f;
#pragma unroll
    for (int t = 0; t < NT; ++t) {
#pragma unroll
        for (int i = 0; i < 4; ++i) { const float e = __expf(s[t][i] - mx); s[t][i] = e; sum += e; } }
    sum = sum16x4(sum);
    const float inv = rcp_f(sum);
    f32x4 o[4];
#pragma unroll
    for (int nt = 0; nt < 4; ++nt) o[nt] = (f32x4){0.f, 0.f, 0.f, 0.f};
#pragma unroll
    for (int tb = 0; tb < NT / 8; ++tb) {
        v4u vv[4][4];
#pragma unroll
        for (int tq = 0; tq < 4; ++tq) { const int tp = tb * 4 + tq;
            const bf16* vb; size_t dstride;
            if (!CTXQ && tp < 8) { vb = VTL + ((size_t)(b * 16 + h) * 64 + n) * 8192 + (rs + tp) * 64 + span0 + 8 * q4; dstride = (size_t)16 * 8192; }
            else { const int cp = tp - (CTXQ ? 0 : 8); vb = VTC + ((size_t)(b * 16 + h) * 64 + n) * 256 + 32 * cp + 8 * q4; dstride = (size_t)16 * 256; }
#pragma unroll
            for (int nt = 0; nt < 4; ++nt) vv[tq][nt] = *(const v4u*)(vb + nt * dstride); }
        __builtin_amdgcn_sched_barrier(0);
#pragma unroll
        for (int tq = 0; tq < 4; ++tq) { const int tp = tb * 4 + tq;
            const f32x4 p0 = s[2 * tp] * inv, p1 = s[2 * tp + 1] * inv;
            v4u aw; aw.x = pk2(p0[0], p0[1]); aw.y = pk2(p0[2], p0[3]); aw.z = pk2(p1[0], p1[1]); aw.w = pk2(p1[2], p1[3]);
            const bf16x8 af = __builtin_bit_cast(bf16x8, aw);
#pragma unroll
            for (int nt = 0; nt < 4; ++nt) o[nt] = mfma16(af, __builtin_bit_cast(bf16x8, vv[tq][nt]), o[nt]); }
        __builtin_amdgcn_sched_barrier(0);
    }
    unsigned short zz[4][4];
#pragma unroll
    for (int nt = 0; nt < 4; ++nt)
#pragma unroll
        for (int i = 0; i < 4; ++i) zz[nt][i] = P[(size_t)(qrow0 + 4 * q4 + i) * NIN + C_NAZ + h * 64 + 16 * nt + n];
    __builtin_amdgcn_sched_barrier(0);
#pragma unroll
    for (int nt = 0; nt < 4; ++nt)
#pragma unroll
        for (int i = 0; i < 4; ++i) { const int row = qrow0 + 4 * q4 + i, col = h * 64 + 16 * nt + n;
            Y[(size_t)row * DM + 1024 + col] = (bf16)f2bf(o[nt][i] * silu_f(bf2f(zz[nt][i]))); }
}
__device__ __forceinline__ void phase_sgu(const bf16* P, const f32x2* SGST, const float* lnw, const float* lnb, const bf16* SGW  , const float* sgb  , bf16* Y,
                                          LAS unsigned char* lds, int nchunks, int tid, int wave, int lane) {
    const int n = lane & 15, q4 = lane >> 4;
    LAS bf16* T = (LAS bf16*)lds;
    for (int u = blockIdx.x; u < nchunks * 8; u += 256) {
        const int ck = u >> 3, g = u & 7, m0 = ck * 128;
#pragma unroll
        for (int it = 0; it < 4; ++it) { const int idx = tid + 512 * it, q = idx >> 4, c8 = idx & 15;
            float x[8]; unpack8(*(const v4u*)(P + (size_t)(m0 + q) * NIN + C_SGV + g * 128 + 8 * c8), x);
            const f32x2 st = SGST[m0 + q];
#pragma unroll
            for (int j = 0; j < 8; ++j) { const int c = 8 * c8 + j; const float v = (x[j] - st.x) * st.y * lnw[g * 128 + c] + lnb[g * 128 + c]; T[c * 136 + q] = (bf16)f2bf(v); } }
        __syncthreads();
        bf16x8 af[4];
#pragma unroll
        for (int ks = 0; ks < 4; ++ks) af[ks] = ld_frag(SGW + ((size_t)g * 128 + 16 * wave + n) * 128 + 32 * ks + 8 * q4);
#pragma unroll
        for (int nt = 0; nt < 8; ++nt) {
            f32x4 acc = {0.f, 0.f, 0.f, 0.f};
#pragma unroll
            for (int ks = 0; ks < 4; ++ks) { const bf16x8 bfg = *(const LAS bf16x8*)(T + (16 * nt + n) * 136 + 32 * ks + 8 * q4); acc = mfma16(af[ks], bfg, acc); }
#pragma unroll
            for (int i = 0; i < 4; ++i) { const int p = 16 * wave + 4 * q4 + i, row = m0 + p, col = g * 128 + 16 * nt + n;
                const float mixed = acc[i] + sgb[g * 128 + p]; const bf16* pr = P + (size_t)row * NIN;
                const float uu = bf2f(pr[C_SGU + col]), z = bf2f(pr[C_SGZ + col]);
                Y[(size_t)row * DM + 3072 + col] = (bf16)f2bf(uu * mixed * silu_f(z)); }
        }
        __syncthreads();
    }
}
__device__ __forceinline__ void bar4(LAS unsigned* cnt, unsigned& seq, int lane) {
    asm volatile("s_waitcnt vmcnt(0) lgkmcnt(0)" ::: "memory");
    const unsigned baddr = (unsigned)(size_t)cnt, one = 1u; seq += 4u;
    if (lane == 0) asm volatile("ds_add_u32 %0, %1" :: "v"(baddr), "v"(one) : "memory");
    unsigned sp = 0, got;
    for (;;) { asm volatile("ds_read_b32 %0, %1\n\ts_waitcnt lgkmcnt(0)" : "=v"(got) : "v"(baddr) : "memory");
        if (__builtin_amdgcn_readfirstlane((int)got) >= (int)seq) break; __builtin_amdgcn_s_sleep(1); if (++sp > (1u << 22)) break; }
    asm volatile("" ::: "memory");
}
__device__ __forceinline__ void phase_sgu4(const bf16* P, const f32x2* SGST, const float* lnw, const float* lnb, const bf16* SGW, const float* sgb, bf16* Y,
                                           LAS unsigned char* ldsT, LAS unsigned* cnt, int nchunks, int tid4  , int w4  , int lane) {
    const int n = lane & 15, q4 = lane >> 4;
    LAS bf16* T = (LAS bf16*)ldsT; unsigned seq = 0u;
    for (int u = blockIdx.x; u < nchunks * 8; u += 256) {
        const int ck = u >> 3, g = u & 7, m0 = ck * 128;
#pragma unroll
        for (int it = 0; it < 8; ++it) { const int idx = tid4 + 256 * it, q = idx >> 4, c8 = idx & 15;
            float x[8]; unpack8(*(const v4u*)(P + (size_t)(m0 + q) * NIN + C_SGV + g * 128 + 8 * c8), x);
            const f32x2 st = SGST[m0 + q];
#pragma unroll
            for (int j = 0; j < 8; ++j) { const int c = 8 * c8 + j; const float v = (x[j] - st.x) * st.y * lnw[g * 128 + c] + lnb[g * 128 + c]; T[c * 136 + q] = (bf16)f2bf(v); } }
        bar4(cnt, seq, lane);
#pragma unroll 1
        for (int mt = 0; mt < 2; ++mt) { const int mrow = 32 * w4 + 16 * mt;
            bf16x8 af[4];
#pragma unroll
            for (int ks = 0; ks < 4; ++ks) af[ks] = ld_frag(SGW + ((size_t)g * 128 + mrow + n) * 128 + 32 * ks + 8 * q4);
#pragma unroll
            for (int nt = 0; nt < 8; ++nt) {
                f32x4 acc = {0.f, 0.f, 0.f, 0.f};
#pragma unroll
                for (int ks = 0; ks < 4; ++ks) { const bf16x8 bfg = *(const LAS bf16x8*)(T + (16 * nt + n) * 136 + 32 * ks + 8 * q4); acc = mfma16(af[ks], bfg, acc); }
#pragma unroll
                for (int i = 0; i < 4; ++i) { const int p = mrow + 4 * q4 + i, row = m0 + p, col = g * 128 + 16 * nt + n;
                    const float mixed = acc[i] + sgb[g * 128 + p]; const bf16* pr = P + (size_t)row * NIN;
                    const float uu = bf2f(pr[C_SGU + col]), z = bf2f(pr[C_SGZ + col]);
                    Y[(size_t)row * DM + 3072 + col] = (bf16)f2bf(uu * mixed * silu_f(z)); }
            }
        }
        bar4(cnt, seq, lane);
    }
}
__device__ __forceinline__ void scan_self(const float* REC, float* YR, LAS unsigned char* lds, LAS unsigned* bcnt, int su, int wave, int lane) {
    constexpr int CS = 32, NCH = SCANLEN / CS, SLOT = CS * RECB, NPW = SLOT / 1024 / 4;
    const int chain = (su & 7) * 8 + ((su >> 3) >> 2), part = (su >> 3) & 3;
    const char* recb = (const char*)REC + (size_t)chain * SCANLEN * RECB;
    const int wl = wave;
#define SCAN_ISSUE(cc, sl) do { _Pragma("unroll") for (int p_ = 0; p_ < NPW; ++p_) \
    __builtin_amdgcn_global_load_lds((const unsigned*)(recb + (size_t)(cc) * SLOT + (wl * NPW + p_) * 1024 + lane * 16), (LAS unsigned*)(lds + (sl) * SLOT + (wl * NPW + p_) * 1024), 16, 0, 0); } while (0)
    __builtin_amdgcn_s_setprio(3);
    SCAN_ISSUE(0, 0); SCAN_ISSUE(1, 1);
    const int c16 = lane & 15, rg = lane >> 4, row = 16 * part + 4 * wave + rg;
    float S0 = 0.f, S1 = 0.f, S2 = 0.f, S3 = 0.f;
    float* yout = YR + (size_t)chain * SCANLEN * 64 + row;
    const int lo_w = c16 * 16, lo_h = 256 + c16 * 8, lo_v = 768 + row * 2;
#define SCAN_LD(dst, sl, s_) do { const LAS unsigned char* rec_ = (sl) + (s_) * RECB; dst##w = *(const LAS f32x4*)(rec_ + lo_w); dst##kk = *(const LAS h4*)(rec_ + lo_h); \
    dst##na = *(const LAS h4*)(rec_ + 128 + lo_h); dst##k = *(const LAS h4*)(rec_ + 256 + lo_h); dst##r = *(const LAS h4*)(rec_ + 384 + lo_h); dst##v = *(const LAS _Float16*)(rec_ + lo_v); } while (0)
#define FMX(a, b, c) __builtin_fmaf((a), (float)(b), (c))
    int sl = 0;
    for (int c = 0; c < NCH; ++c) {
        asm volatile("s_waitcnt vmcnt(7)" ::: "memory");
        {   const unsigned baddr = (unsigned)(size_t)bcnt, one = 1u;
            if (lane == 0) asm volatile("ds_add_u32 %0, %1" :: "v"(baddr), "v"(one) : "memory");
            const unsigned want = 4u * (unsigned)(c + 1); unsigned sp = 0, got;
            for (;;) { asm volatile("ds_read_b32 %0, %1\n\ts_waitcnt lgkmcnt(0)" : "=v"(got) : "v"(baddr) : "memory");
                if (__builtin_amdgcn_readfirstlane((int)got) >= (int)want) break; __builtin_amdgcn_s_sleep(1); if (++sp > (1u << 22)) break; } }
        asm volatile("" ::: "memory");
        {   const int cc = c + 2 < NCH ? c + 2 : NCH - 1; const int s2 = sl == 0 ? 2 : sl - 1; SCAN_ISSUE(cc, s2); }
        const LAS unsigned char* slot = lds + sl * SLOT;
        sl = sl == 2 ? 0 : sl + 1;
        float ysv0 = 0.f, ysv1 = 0.f; float yp[16];
        f32x4 Aw; h4 Akk, Ana, Ak, Ar, Pr; _Float16 Av;
        SCAN_LD(A, slot, 0);
#pragma unroll
        for (int s = 0; s < CS; ++s) {
            f32x4 Bw; h4 Bkk, Bna, Bk, Br; _Float16 Bv;
            if (s < CS - 1) SCAN_LD(B, slot, s + 1);
            __builtin_amdgcn_sched_barrier(0);
            if (s > 0) { float q0 = FMX(S0, Pr.x, 0.f), q1 = FMX(S2, Pr.z, 0.f); q0 = FMX(S1, Pr.y, q0); q1 = FMX(S3, Pr.w, q1); yp[(s - 1) & 15] = q0 + q1; }
            float p0 = FMX(S0, Akk.x, 0.f), p1 = FMX(S2, Akk.z, 0.f); p0 = FMX(S1, Akk.y, p0); p1 = FMX(S3, Akk.w, p1);
            const float dt = red16(p0 + p1);
            const float u0 = __builtin_fmaf(S0, Aw.x, FMX((float)Av, Ak.x, 0.f)), u1 = __builtin_fmaf(S1, Aw.y, FMX((float)Av, Ak.y, 0.f)),
                        u2 = __builtin_fmaf(S2, Aw.z, FMX((float)Av, Ak.z, 0.f)), u3 = __builtin_fmaf(S3, Aw.w, FMX((float)Av, Ak.w, 0.f));
            S0 = FMX(dt, Ana.x, u0); S1 = FMX(dt, Ana.y, u1); S2 = FMX(dt, Ana.z, u2); S3 = FMX(dt, Ana.w, u3);
            if (s == 16) ysv0 = red16_transpose(yp, c16);
            Pr = Ar;
            if (s < CS - 1) { Aw = Bw; Akk = Bkk; Ana = Bna; Ak = Bk; Ar = Br; Av = Bv; }
        }
        { float q0 = FMX(S0, Pr.x, 0.f), q1 = FMX(S2, Pr.z, 0.f); q0 = FMX(S1, Pr.y, q0); q1 = FMX(S3, Pr.w, q1); yp[15] = q0 + q1; }
        ysv1 = red16_transpose(yp, c16);
        asm volatile("" ::: "memory");
        yout[(size_t)(c * CS + c16) * 64] = ysv0; yout[(size_t)(c * CS + 16 + c16) * 64] = ysv1;
    }
    asm volatile("s_waitcnt vmcnt(0)" ::: "memory");
    __builtin_amdgcn_s_setprio(0);
#undef FMX
#undef SCAN_LD
#undef SCAN_ISSUE
}
__device__ __forceinline__ void phase_rwfin(const bf16* P, const float* YR, const float* REC, const float* BON, const float* lnw, const float* lnb, bf16* Y, int nrows, int gw, int NGW, int lane) {
    const int head = lane >> 2, sub = lane & 3;
    for (int m = gw; m < nrows; m += NGW) {
        const bool isctx = m >= NLAT; const int t = isctx ? ((m - NLAT) & 255) : (m & 8191); const int b = isctx ? ((m - NLAT) >> 8) : (m >> 13);
        float out[16];
#pragma unroll
        for (int i = 0; i < 16; ++i) out[i] = 0.f;
#pragma unroll
        for (int d = 0; d < 2; ++d) {
            const int chain = (b * 2 + d) * 16 + head; const size_t pp = (size_t)chain * SCANLEN + scan_pos(d, isctx, t);
            float y[16], v[16];
#pragma unroll
            for (int j = 0; j < 4; ++j) { const f32x4 a = *(const f32x4*)(YR + pp * 64 + 16 * sub + 4 * j); const h4 c = *(const h4*)((const char*)REC + pp * RECB + 768 + (16 * sub + 4 * j) * 2);
                y[4 * j] = a.x; y[4 * j + 1] = a.y; y[4 * j + 2] = a.z; y[4 * j + 3] = a.w; v[4 * j] = (float)c.x; v[4 * j + 1] = (float)c.y; v[4 * j + 2] = (float)c.z; v[4 * j + 3] = (float)c.w; }
            const float bo = BON[pp];
            float s = 0.f;
#pragma unroll
            for (int i = 0; i < 16; ++i) s += y[i];
            s += __shfl_xor(s, 1); s += __shfl_xor(s, 2);
            const float mean = s * (1.f / 64.f); float q = 0.f;
#pragma unroll
            for (int i = 0; i < 16; ++i) { const float dl = y[i] - mean; q += dl * dl; }
            q += __shfl_xor(q, 1); q += __shfl_xor(q, 2);
            const float rstd = rsq_f(q * (1.f / 64.f) + 64e-5f);
#pragma unroll
            for (int i = 0; i < 16; ++i) { const int ch = head * 64 + 16 * sub + i; out[i] += (y[i] - mean) * rstd * lnw[ch] + lnb[ch] + bo * v[i]; }
        }
        float z[16]; unpack8(*(const v4u*)(P + (size_t)m * NIN + C_RWZ + 16 * lane), z); unpack8(*(const v4u*)(P + (size_t)m * NIN + C_RWZ + 16 * lane + 8), z + 8);
#pragma unroll
        for (int i = 0; i < 16; ++i) out[i] *= silu_f(z[i]);
        *(v4u*)(Y + (size_t)m * DM + 2048 + 16 * lane) = pack8(out); *(v4u*)(Y + (size_t)m * DM + 2048 + 16 * lane + 8) = pack8(out + 8);
    }
}
#define XB_TMO      128
#define XB_XCNT(j)  (256  + 64 * (j))
#define XB_XSUB(j)  (1280 + 64 * (j))
#define XB_XGEN(j)  (2304 + 64 * (j))
#define XB_TOP      3328
#define XB_TOPGEN   3392
#define XCD_BAR_WORDS 3456
#define XB_SPIN_CAP (1u << 18)

__device__ __forceinline__ unsigned xb_ld(unsigned* p)              { return __hip_atomic_load(p, __ATOMIC_RELAXED, __HIP_MEMORY_SCOPE_AGENT); }
__device__ __forceinline__ unsigned xb_add(unsigned* p, unsigned v) { return __hip_atomic_fetch_add(p, v, __ATOMIC_RELAXED, __HIP_MEMORY_SCOPE_AGENT); }
__device__ __forceinline__ unsigned xb_xcc_id() { return (unsigned)__builtin_amdgcn_s_getreg((3 << 11) | 20) & 0xFu; }
#define XB_SPIN(cond, bar) do { unsigned _sp = 0; while (cond) { __builtin_amdgcn_s_sleep(1); \
    if ((++_sp & 255u) == 0u) { if (xb_ld(&(bar)[XB_TMO])) break; if (_sp > XB_SPIN_CAP) { atomicAdd(&(bar)[XB_TMO], 1u); break; } } } } while (0)

struct XcdBarrier {
    unsigned* bar; unsigned x;
    volatile LAS unsigned* st;
};

__device__ __forceinline__ XcdBarrier xcd_barrier_post(unsigned* bar, volatile LAS unsigned* st) {
    XcdBarrier b; b.bar = bar; b.x = xb_xcc_id(); b.st = st;
    if (threadIdx.x == 0) (void)xb_add(&bar[XB_XCNT(b.x)], 1u);
    return b;
}
__device__ __forceinline__ void xcd_barrier_complete(unsigned* bar, unsigned x, unsigned& nloc, unsigned& nx) {
    const unsigned G = gridDim.x * gridDim.y * gridDim.z;
    unsigned sum, cnt, mine, sp = 0u;
    for (;;) {
        sum = 0u; cnt = 0u; mine = 0u;
#pragma unroll
        for (unsigned j = 0; j < 16; ++j) { const unsigned c = xb_ld(&bar[XB_XCNT(j)]); sum += c; cnt += (c > 0u) ? 1u : 0u; mine = (j == x) ? c : mine; }
        if (sum == G) break;
        __builtin_amdgcn_s_sleep(1);
        if ((++sp & 255u) == 0u) { if (xb_ld(&bar[XB_TMO])) break; if (sp > XB_SPIN_CAP) { atomicAdd(&bar[XB_TMO], 1u); break; } }
    }
    nloc = mine > 0u ? mine : 1u; nx = cnt > 0u ? cnt : 1u;
}

__device__ __forceinline__ void xcd_barrier(const XcdBarrier& b) {
    asm volatile("s_waitcnt vmcnt(0)" ::: "memory");
    __syncthreads();
    if (threadIdx.x == 0) {
        unsigned* bar = b.bar;
        __builtin_amdgcn_s_waitcnt(0);
        unsigned nloc = b.st[0], nx = b.st[1];
        if (nloc == 0u) { xcd_barrier_complete(bar, b.x, nloc, nx); b.st[0] = nloc; b.st[1] = nx; }
        const unsigned old = xb_add(&bar[XB_XSUB(b.x)], 1u);
        const unsigned gen = old / nloc;
        if (old + 1u == (gen + 1u) * nloc) {
            __builtin_amdgcn_fence(__ATOMIC_RELEASE, "agent");
            asm volatile("s_waitcnt vmcnt(0)" ::: "memory");
            const unsigned og = xb_add(&bar[XB_TOP], 1u);
            const unsigned tg = og / nx;
            if (og + 1u == (tg + 1u) * nx) xb_add(&bar[XB_TOPGEN], 1u);
            else XB_SPIN(xb_ld(&bar[XB_TOPGEN]) == tg, bar);
            __builtin_amdgcn_fence(__ATOMIC_ACQUIRE, "agent");
            xb_add(&bar[XB_XGEN(b.x)], 1u);
            asm volatile("s_waitcnt vmcnt(0)" ::: "memory");
        } else {
            XB_SPIN(xb_ld(&bar[XB_XGEN(b.x)]) == gen, bar);
            __builtin_amdgcn_fence(__ATOMIC_ACQUIRE, "agent");
            asm volatile("s_waitcnt vmcnt(0)" ::: "memory");
        }
    }
    __syncthreads();
}

#ifndef MK_SPLIT
#define MK_SPLIT 0
#endif
#ifndef REP_G1
#define REP_G1 1
#endif
#ifndef REP_PREP
#define REP_PREP 1
#endif
#ifndef REP_MIXA
#define REP_MIXA 1
#endif
#ifndef REP_RWP
#define REP_RWP 1
#endif
#ifndef REP_POOL
#define REP_POOL 1
#endif
#ifndef REP_NA
#define REP_NA 1
#endif
#ifndef REP_SGU
#define REP_SGU 1
#endif
#ifndef REP_ROWP
#define REP_ROWP 1
#endif
#ifndef REP_VT
#define REP_VT 1
#endif
#ifndef REP_XN
#define REP_XN 1
#endif
#ifndef REP_FIN
#define REP_FIN 1
#endif
#ifndef REP_SCAN
#define REP_SCAN 1
#endif
constexpr int PPL = 6;
constexpr int NPHASE = 2 + PPL * DEPTH;
constexpr int RWP_BLOCKS = 14;
constexpr int CW_RWQ = 16384;
constexpr int NGRID = 256;
struct Args { const float* in[28]; float* out; unsigned char* ws; int ph_lo, ph_hi, li, pad; };

__global__ void __launch_bounds__(NWAVES * 64, 2) fwd(Args args) {
    extern __shared__ __attribute__((aligned(16))) unsigned char lds_raw[];
    LAS unsigned char* lds = (LAS unsigned char*)lds_raw;
    volatile LAS unsigned* MISC = (volatile LAS unsigned*)(lds + MISC_OFF);
    const int tid = threadIdx.x, lane = tid & 63, wave = __builtin_amdgcn_readfirstlane(tid >> 6);
    constexpr int G = NGRID; const int bx = blockIdx.x;
    const int vcu = (bx % 8) * (G / 8) + bx / 8;
    const int gw = vcu * NWAVES + wave; constexpr int NGW = G * NWAVES;
    unsigned char* ws = args.ws;
    const int lo = args.ph_lo, hi = args.ph_hi;

    for (int u = tid; u < (LDS_BYTES - LDSCTL_OFF) / 4; u += NWAVES * 64) ((LAS unsigned*)(lds + LDSCTL_OFF))[u] = 0u;
    __syncthreads();
    XcdBarrier bar; bar.bar = (unsigned*)(ws + WS_CTL) + CW_BAR; bar.x = 0; bar.st = MISC + 8;
    if (hi - lo > 1) bar = xcd_barrier_post((unsigned*)(ws + WS_CTL) + CW_BAR, MISC + 8);
#define IN(k) (lo <= (k) && (k) < hi)
#define SEAM(k) do { if (lo <= (k) && (k) + 1 < hi) { XcdBarrier b2_; b2_.bar = WSP(unsigned, WS_CTL) + CW_BAR; b2_.x = bar.x; b2_.st = bar.st; xcd_barrier(b2_); } } while (0)

#define OPQ_S(x) ({ int _t = (x); asm volatile("" : "+s"(_t)); _t; })
#define OPQ_V(x) ({ int _t = (x); asm volatile("" : "+v"(_t)); _t; })
#define INP(i) (args.in[OPQ_S(i)])
#define WSP(T, off) ((T*)(args.ws + ({ size_t _o = (off); asm volatile("" : "+s"(_o)); _o; })))
#define x_in INP(0)
#define c_in INP(1)
#define ctx_in INP(2)
#define cctx_in INP(3)
#define w_mod INP(4)
#define b_mod INP(5)
#define w_in INP(6)
#define w_out INP(7)
#define pool_w INP(8)
#define pool_scale INP(9)
#define na_qg INP(10)
#define na_kg INP(11)
#define na_rpb INP(12)
#define rw_mu_rkv INP(13)
#define rw_mu_lora INP(14)
#define rw_w0 INP(15)
#define rw_w_up INP(16)
#define rw_a0 INP(17)
#define rw_a_up INP(18)
#define rw_k_k INP(19)
#define rw_k_a INP(20)
#define rw_r_k INP(21)
#define rw_ln_w INP(22)
#define rw_ln_b INP(23)
#define sg_ln_w INP(24)
#define sg_ln_b INP(25)
#define sg_w INP(26)
#define sg_b INP(27)
#define MOD WSP(float, WS_MOD)
#define MODP WSP(float, WS_MODP)
#define TAB WSP(f32x2, WS_TAB)
#define SGST WSP(f32x2, WS_SGST)
#define BON WSP(float, WS_BON)
#define POOLWT WSP(bf16, WS_POOLWT)
#define WUPT WSP(bf16, WS_WUPT)
#define AUPT WSP(bf16, WS_AUPT)
#define SGW WSP(bf16, WS_SGW)
#define VTC WSP(bf16, WS_VTC)
#define VTL WSP(bf16, WS_VTL)
#define HCTX WSP(float, WS_HCTX)
#define QN WSP(bf16, WS_QN)
#define KN WSP(bf16, WS_KN)
#define WOUTT WSP(bf16, WS_WOUTT)
#define WINT WSP(bf16, WS_WINT)
#define XN WSP(bf16, WS_XN)
#define Y WSP(bf16, WS_Y)
#define P WSP(bf16, WS_P)
#define YR WSP(float, WS_YR)
#define REC WSP(float, WS_REC)
    float* const out = args.out;

    if (IN(0)) {
        LAS float* scr = (LAS float*)(lds + wave * 16384);
        constexpr int I_MOD = 4 * 64 * 48, I_WIN = 64 * (NIN / 32), I_WOUT = 64 * 128, I_POOL = 4 * 32, I_WUP = 2 * 32, I_AUP = 2 * 32, I_SGW = 256;
        constexpr int NITEMS = I_MOD + I_WIN + I_WOUT + I_POOL + I_WUP + I_AUP + I_SGW;
        for (int it = gw; it < NITEMS; it += NGW) {
            int r = it;
            if (r < I_MOD) { p0_mod_item(w_mod, c_in, cctx_in, MODP, scr, r, lane); continue; } r -= I_MOD;
            if (r < I_WIN) { p0_transpose_item<true>(w_in, DM, NIN, WINT, scr, r, lane); continue; } r -= I_WIN;
            if (r < I_WOUT) { p0_transpose_item(w_out, DM, DM, WOUTT, scr, r, lane); continue; } r -= I_WOUT;
            if (r < I_POOL) { const int g = r / 32; p0_transpose_item(pool_w + (size_t)g * 65536, 256, 256, POOLWT + (size_t)g * 65536, scr, r % 32, lane); continue; } r -= I_POOL;
            if (r < I_WUP) { const int dd = r / 32; p0_transpose_item(rw_w_up + (size_t)dd * 65536, 64, 1024, WUPT + (size_t)dd * 65536, scr, r % 32, lane); continue; } r -= I_WUP;
            if (r < I_AUP) { const int dd = r / 32; p0_transpose_item(rw_a_up + (size_t)dd * 65536, 64, 1024, AUPT + (size_t)dd * 65536, scr, r % 32, lane); continue; } r -= I_AUP;
            {   const size_t e0 = (size_t)r * 512 + lane * 8; const f32x4 a = *(const f32x4*)(sg_w + e0), b = *(const f32x4*)(sg_w + e0 + 4);
                v4u o; o.x = pk2(a.x, a.y); o.y = pk2(a.z, a.w); o.z = pk2(b.x, b.y); o.w = pk2(b.z, b.w); *(v4u*)(SGW + e0) = o; }
        }
        SEAM(0);
    }
    if (IN(1)) {
#ifdef PROBE_ISSUE
        if (wave < 4) {
            float a0 = 1.f, a1 = 2.f, a2 = 3.f, a3 = 4.f, a4 = 5.f, a5 = 6.f, a6 = 7.f, a7 = 8.f; const float b = 0.999f, cc = 1e-6f;
            for (int it = 0; it < 100000; ++it) {
#if PROBE_ISSUE == 1
                asm volatile("v_fma_f32 %0, %0, %8, %9\n v_fma_f32 %1, %1, %8, %9\n v_fma_f32 %2, %2, %8, %9\n v_fma_f32 %3, %3, %8, %9\n v_fma_f32 %4, %4, %8, %9\n v_fma_f32 %5, %5, %8, %9\n v_fma_f32 %6, %6, %8, %9\n v_fma_f32 %7, %7, %8, %9"
                    : "+v"(a0), "+v"(a1), "+v"(a2), "+v"(a3), "+v"(a4), "+v"(a5), "+v"(a6), "+v"(a7) : "v"(b), "v"(cc));
#elif PROBE_ISSUE == 2
                asm volatile("v_fma_mix_f32 %0, %0, %8, %9\n v_fma_mix_f32 %1, %1, %8, %9\n v_fma_mix_f32 %2, %2, %8, %9\n v_fma_mix_f32 %3, %3, %8, %9\n v_fma_mix_f32 %4, %4, %8, %9\n v_fma_mix_f32 %5, %5, %8, %9\n v_fma_mix_f32 %6, %6, %8, %9\n v_fma_mix_f32 %7, %7, %8, %9"
                    : "+v"(a0), "+v"(a1), "+v"(a2), "+v"(a3), "+v"(a4), "+v"(a5), "+v"(a6), "+v"(a7) : "v"(b), "v"(cc));
#else
                asm volatile("v_add_f32_dpp %0, %0, %0 quad_perm:[1,0,3,2] row_mask:0xf bank_mask:0xf bound_ctrl:1\n v_add_f32_dpp %1, %1, %1 quad_perm:[1,0,3,2] row_mask:0xf bank_mask:0xf bound_ctrl:1\n v_add_f32_dpp %2, %2, %2 quad_perm:[1,0,3,2] row_mask:0xf bank_mask:0xf bound_ctrl:1\n v_add_f32_dpp %3, %3, %3 quad_perm:[1,0,3,2] row_mask:0xf bank_mask:0xf bound_ctrl:1\n v_add_f32_dpp %4, %4, %4 quad_perm:[1,0,3,2] row_mask:0xf bank_mask:0xf bound_ctrl:1\n v_add_f32_dpp %5, %5, %5 quad_perm:[1,0,3,2] row_mask:0xf bank_mask:0xf bound_ctrl:1\n v_add_f32_dpp %6, %6, %6 quad_perm:[1,0,3,2] row_mask:0xf bank_mask:0xf bound_ctrl:1\n v_add_f32_dpp %7, %7, %7 quad_perm:[1,0,3,2] row_mask:0xf bank_mask:0xf bound_ctrl:1"
                    : "+v"(a0), "+v"(a1), "+v"(a2), "+v"(a3), "+v"(a4), "+v"(a5), "+v"(a6), "+v"(a7) : "v"(b), "v"(cc));
#endif
            }
            asm volatile("" :: "v"(a0), "v"(a1), "v"(a2), "v"(a3), "v"(a4), "v"(a5), "v"(a6), "v"(a7));
        }
#endif

        for (int idx = gw * 64 + lane; idx < 4 * 3 * 12288; idx += NGW * 64) {
            const int l = idx / 36864, c = (idx / 12288) % 3, n = idx % 12288;
            float s = b_mod[l * 12288 + n];
            const float* pp = MODP + ((size_t)(l * 64) * 3 + c) * 12288 + n;
#pragma unroll 8
            for (int kc = 0; kc < 64; ++kc) s += pp[(size_t)kc * 3 * 12288];
            MOD[idx] = s;
        }
        for (int idx = gw * 64 + lane; idx < 2048; idx += NGW * 64) {
            const int pos = idx >> 4, i = idx & 15;
            float inv = (i & 3) == 0 ? 1.0f : ((i & 3) == 1 ? 0.5623413251903491f : ((i & 3) == 2 ? 0.31622776601683794f : 0.17782794100389228f));
            inv *= (i >> 2) == 0 ? 1.0f : ((i >> 2) == 1 ? 0.1f : ((i >> 2) == 2 ? 0.01f : 0.001f));
            float cc, sn; sincos_acc((float)pos * inv, cc, sn);
            TAB[idx] = (f32x2){cc, sn};
        }
        SEAM(1);
    }
    for (int l = 0; l < DEPTH; ++l) {
        const int pb = 2 + PPL * l;
        const bool with_ctx = l < DEPTH - 1;
#define hin_lat (l == 0 ? x_in : (const float*)out)
#define hin_ctx (l == 0 ? ctx_in : (const float*)HCTX)
#define mod (MOD + (size_t)l * 3 * 12288)
        const int nrows = with_ctx ? MROWS : NLAT;
        if (IN(pb + 0)) {
            for (int rep = 0; rep < REP_XN; ++rep)
            phase_xn(hin_lat, hin_ctx, mod, XN, OPQ_S(gw), NGW, OPQ_V(lane));
            SEAM(pb + 0);
#ifdef PROBE_BAR
            SEAM(pb + 0); SEAM(pb + 0); SEAM(pb + 0); SEAM(pb + 0);
#endif
        }
        if (IN(pb + 1)) {
            constexpr int C0 = C_SPLIT, NA_ = NIN - C0;
            pg8::Gemm g{XN, WINT + (size_t)l * NIN * DM + (size_t)C0 * DM, MROWS, NA_, DM}; pg8::StaticOrder S; S.init(MROWS, NA_, G, bx);
            pg8::EpiStoreBf16 E{P + C0, NIN};
            pg8::gemm_phase<pg8::EpiStoreBf16, pg8::StaticOrder, true, true>(lds, g, S, E);
            SEAM(pb + 1);
        }
        if (IN(pb + 2)) {
            if (bx >= RWP_BLOCKS) {
                constexpr int NB_ = C_SPLIT;
                pg8::Gemm g{XN, WINT + (size_t)l * NIN * DM, MROWS, NB_, DM}; pg8::StaticOrder S; S.init(MROWS, NB_, G - RWP_BLOCKS, bx - RWP_BLOCKS);
                pg8::EpiStoreBf16 E{P, NIN};
                pg8::gemm_phase<pg8::EpiStoreBf16, pg8::StaticOrder, true, true>(lds, g, S, E);
            }
            phase_rwprep(P, rw_mu_rkv + (size_t)l * 6144, rw_mu_lora + (size_t)l * 256, rw_w0 + (size_t)l * 2048, WUPT + (size_t)l * 131072, rw_a0 + (size_t)l * 2048, AUPT + (size_t)l * 131072,
                         rw_k_k + (size_t)l * 1024, rw_k_a + (size_t)l * 1024, rw_r_k + (size_t)l * 1024, REC, BON, lds, WSP(unsigned, WS_CTL) + CW_RWQ + l * 1024, (bx * NWAVES + wave) & 15, wave, OPQ_V(lane));
            phase_rowprep(P, na_qg + l * 64, na_kg + l * 64, TAB, QN, KN, SGST, OPQ_S(gw), NGW, OPQ_V(lane));
            phase_vt(P, VTL, VTC, OPQ_S(gw), NGW, OPQ_V(lane));
            SEAM(pb + 2);
        }
        if (IN(pb + 3)) {
#ifdef PROBE_MIX
            for (int rep = 0; rep < 2; ++rep) {
#else
            {
#endif
            LAS unsigned* mixq = (LAS unsigned*)(lds + LDSCTL_OFF + 64); LAS unsigned* mixb = (LAS unsigned*)(lds + LDSCTL_OFF + 128); LAS unsigned* mixs = (LAS unsigned*)(lds + LDSCTL_OFF + 192);
            if (tid == 0) { *mixq = 0u; *mixb = 0u; *mixs = 0u; }
            __syncthreads();
            if (wave < 4) scan_self(REC, YR, lds, mixb, bx, wave, OPQ_V(lane));
            else phase_sgu4(P, SGST, sg_ln_w + (size_t)l * 1024, sg_ln_b + (size_t)l * 1024, SGW + (size_t)l * 131072, sg_b + (size_t)l * 1024, Y, lds + 3 * 28672, mixs, nrows / 128, OPQ_V(tid) - 256, wave - 4, OPQ_V(lane));
#ifdef PROBE_SEQ
            if (wave >= 4) { unsigned sp = 0; while (__hip_atomic_load(mixb, __ATOMIC_RELAXED, __HIP_MEMORY_SCOPE_WORKGROUP) < 4u * (SCANLEN / 32)) { __builtin_amdgcn_s_sleep(8); if (++sp > (1u << 24)) break; } }
#endif
            {   const int nctxu = with_ctx ? 2 : 0, npool = (nrows / 16) * 4, npq = (npool + NGRID - 1) / NGRID, nwc = l + 1 < DEPTH ? (WC_ITEMS + NGRID - 1) / NGRID : 0, nq = 64 + nctxu + npq + nwc;
                for (;;) {
                    unsigned k = 0; if (lane == 0) k = __hip_atomic_fetch_add(mixq, 1u, __ATOMIC_RELAXED, __HIP_MEMORY_SCOPE_WORKGROUP);
                    k = (unsigned)__builtin_amdgcn_readfirstlane((int)k);
                    if ((int)k >= nq) break;
                    const int ln = OPQ_V(lane);
                    if (k < 64u) { na_unit<false>(QN, KN, VTL, VTC, P, na_rpb + (size_t)l * 16 * 15 * 31, Y, bx * 64 + (int)k, ln);
#ifdef PROBE_NA2
                        na_unit<false>(QN, KN, VTL, VTC, P, na_rpb + (size_t)l * 16 * 15 * 31, Y, bx * 64 + (int)k, OPQ_V(ln));
#endif
                    }
                    else if ((int)k < 64 + nctxu) na_unit<true>(QN, KN, VTL, VTC, P, na_rpb, Y, bx * 2 + ((int)k - 64), ln);
                    else if ((int)k >= 64 + nctxu + npq) { const int r = bx + NGRID * ((int)k - 64 - nctxu - npq);
                        if (r < WC_ITEMS) weight_copy_item(l + 1, r, w_in, w_out, pool_w, rw_w_up, rw_a_up, sg_w, WINT, WOUTT, POOLWT, WUPT, AUPT, SGW, ln); }
                    else { const int u = bx + NGRID * ((int)k - 64 - nctxu);
                        if (u < npool) { const int tt = u >> 2, g = u & 3; const bf16* wbase = POOLWT + (size_t)l * 262144 + (size_t)g * 65536; const float* psc = pool_scale + (size_t)l * 1024;
                            if (g == 0) pool_unit<0>(P, wbase, psc, Y, tt * 16, ln); else if (g == 1) pool_unit<1>(P, wbase, psc, Y, tt * 16, ln);
                            else if (g == 2) pool_unit<2>(P, wbase, psc, Y, tt * 16, ln); else pool_unit<3>(P, wbase, psc, Y, tt * 16, ln); } }
                }
            }
#ifdef PROBE_MIX
            __syncthreads();
#endif
            }
            SEAM(pb + 3);
        }
        if (IN(pb + 4)) {
            for (int rep = 0; rep < REP_FIN; ++rep)
            phase_rwfin(P, YR, REC, BON, rw_ln_w + (size_t)l * 1024, rw_ln_b + (size_t)l * 1024, Y, nrows, OPQ_S(gw), NGW, OPQ_V(lane));
            SEAM(pb + 4);
        }
        if (IN(pb + 5)) {
            pg8::Gemm g{Y, WOUTT + (size_t)l * DM * DM, nrows, DM, DM}; pg8::StaticOrder S; S.init(nrows, DM, G, bx);
#ifdef PROBE_G2
            { pg8::EpiResGate E0{hin_lat, hin_ctx, (float*)REC, (float*)REC + (size_t)NLAT * DM, mod}; pg8::gemm_phase<pg8::EpiResGate, pg8::StaticOrder, true, true>(lds, g, S, E0); }
#endif
            pg8::EpiResGate E{hin_lat, hin_ctx, out, HCTX, mod};
            pg8::gemm_phase<pg8::EpiResGate, pg8::StaticOrder, true, true>(lds, g, S, E);
            SEAM(pb + 5);
        }
    }
#undef IN
#undef SEAM
}
#undef hin_lat
#undef hin_ctx
#undef mod
#undef P
#undef Y
#undef XN
#undef out

extern "C" void kernel_launch(void* const* d_in, const int* in_sizes, int n_in, void* d_out, int out_size, void* d_ws, size_t ws_size, hipStream_t stream) {
    static int grid = 0;
    if (grid == 0) {
        if (n_in != 28 || out_size != NLAT * DM || ws_size < WS_END) { fprintf(stderr, "kernel_launch: unexpected shapes (n_in %d, out %d, ws %zu < %zu); nothing launched\n", n_in, out_size, ws_size, (size_t)WS_END); grid = -1; return; }
        int dev = 0, cus = 0, per_cu = 0;
        if (hipGetDevice(&dev) != hipSuccess || hipDeviceGetAttribute(&cus, hipDeviceAttributeMultiprocessorCount, dev) != hipSuccess) { grid = -1; return; }
        if (hipFuncSetAttribute((const void*)fwd, hipFuncAttributeMaxDynamicSharedMemorySize, LDS_BYTES) != hipSuccess) { fprintf(stderr, "kernel_launch: hipFuncSetAttribute failed\n"); grid = -1; return; }
        if (hipOccupancyMaxActiveBlocksPerMultiprocessor(&per_cu, (const void*)fwd, NWAVES * 64, LDS_BYTES) != hipSuccess || per_cu < 1)
            fprintf(stderr, "kernel_launch: note: occupancy query reports %d workgroups per CU\n", per_cu);
        (void)hipGetLastError();
        grid = cus >= NGRID ? NGRID : -2;
    }
    if (grid == -1) return;
    if (hipMemsetAsync((char*)d_ws + WS_CTL, 0, CTL_ZERO_BYTES, stream) != hipSuccess) { fprintf(stderr, "kernel_launch: memset failed\n"); return; }
    Args a{};
    for (int i = 0; i < 28; ++i) a.in[i] = (const float*)d_in[i];
    a.out = (float*)d_out; a.ws = (unsigned char*)d_ws; a.li = 0; a.pad = 0;
    const bool split = MK_SPLIT || grid == -2;
    if (split) { for (int k = 0; k < NPHASE; ++k) { a.ph_lo = k; a.ph_hi = k + 1; hipLaunchKernelGGL(fwd, dim3(NGRID), dim3(NWAVES * 64), LDS_BYTES, stream, a); } }
    else { a.ph_lo = 0; a.ph_hi = NPHASE; hipLaunchKernelGGL(fwd, dim3(NGRID), dim3(NWAVES * 64), LDS_BYTES, stream, a); }
    const hipError_t le = hipPeekAtLastError();
    if (le != hipSuccess) fprintf(stderr, "kernel_launch: launch failed: %s\n", hipGetErrorName(le));
}
```

```cpp
#include <hip/hip_runtime.h>
#include <cstdio>
#include <cstdint>
#define MK_SPLIT 0
namespace pg8 {
#define PG8_LAS __attribute__((address_space(3)))
typedef unsigned short bf16_t;
typedef short bf16x8 __attribute__((ext_vector_type(8)));
typedef float f32x4 __attribute__((ext_vector_type(4)));
typedef unsigned u32x4 __attribute__((ext_vector_type(4)));
constexpr int BM = 256, BK = 64, HALF = 128, HTB = HALF * BK * 2  , STAGE_BYTES = 8 * HTB, NXCD = 8, WGM = 8;

__host__ __device__ __forceinline__ int lds_byte(int r, int c) { const int st = (r >> 4) * 2 + (c >> 5), rr = r & 15, cc = c & 31, ob = rr * 64 + cc * 2; return st * 1024 + (ob ^ (((ob >> 9) & 1) << 5)); }
__host__ __device__ __forceinline__ void stage_rc(int b, int& R, int& C) { const int st = b / 1024, sb = b % 1024, swz = sb ^ (((sb >> 9) & 1) << 5); R = (st >> 1) * 16 + swz / 64; C = (st & 1) * 32 + (swz % 64) / 2; }
__host__ __device__ __forceinline__ int perm32(int rho) { const int n = rho >> 4, i = rho & 15; return 8 * (i >> 2) + 4 * n + (i & 3); }

struct Unit { int pm, pn; };
struct Gemm { const bf16_t* A; const bf16_t* Bt; int M, N, K; };

struct StaticOrder {
    int nM, nN, nwg, G, c;
    __host__ __device__ void init(int M, int N, int G_, int c_) { nM = M / BM; nN = N / BM; nwg = nM * nN; G = G_; c = c_; }
    __host__ __device__ bool next(int i, Unit& u) const {
        const long L = (long)i * G + c; if (L >= nwg) return false;
        int wgid = (int)L; { const int q = nwg / NXCD, r = nwg % NXCD, xcd = wgid % NXCD, off = wgid / NXCD; wgid = (xcd < r ? xcd * (q + 1) : r * (q + 1) + (xcd - r) * q) + off; }
        const int nig = WGM * nN, gid = wgid / nig, fm = gid * WGM, gsz = (nM - fm) < WGM ? (nM - fm) : WGM;
        u.pm = fm + ((wgid % nig) % gsz); u.pn = (wgid % nig) / gsz; return true;
    }
    __device__ __forceinline__ void a_ready(const Unit&) const {}
    __device__ __forceinline__ void done(const Unit&) const {}
};

__device__ __forceinline__ unsigned cvt_pk_bf16(float lo, float hi) { unsigned r; asm volatile("v_cvt_pk_bf16_f32 %0, %1, %2" : "=v"(r) : "v"(lo), "v"(hi)); return r; }
template <class Epi, class Sched, bool ALIGN_EPI = false, bool SP2 = false>
__device__ __forceinline__ void gemm_phase(PG8_LAS unsigned char* lds, const Gemm g, const Sched& S, const Epi& E) {
    int tid_ = threadIdx.x; asm volatile("" : "+v"(tid_));
    const int tid = tid_, wid = __builtin_amdgcn_readfirstlane(tid >> 6), lane = tid & 63, wr = wid >> 2, wc = wid & 3, fr = lane & 15, fq = lane >> 4;
    const int K = g.K, nt = K / BK;
    unsigned voffA[2], voffB[2];
#pragma unroll
    for (int i = 0; i < 2; ++i) { int R, C; stage_rc(tid * 16 + i * 8192, R, C); const int Rb = Epi::PERM ? ((R & ~31) + perm32(R & 31)) : R;
        voffA[i] = (unsigned)(R * K + C) * 2u; voffB[i] = (unsigned)(Rb * K + C) * 2u; }
    const size_t kstep = (size_t)(BK * 2);
    const size_t hstep = (size_t)HALF * K * 2;
    const size_t tstep = 2 * hstep;
    const unsigned ldsw = (unsigned)wid * 1024u;
    const int aoff = lds_byte(wr * 64 + fr, fq * 8), boff = lds_byte(wc * 32 + fr, fq * 8);
#define PG8_SA(b, h) (((b) * 2 + (h)) * HTB)
#define PG8_SB(b, h) ((4 + (b) * 2 + (h)) * HTB)
#define PG8_STAGE(bufoff, gbase, voff) do { _Pragma("unroll") for (int _i = 0; _i < 2; ++_i) \
        __builtin_amdgcn_global_load_lds((const unsigned*)((const char*)(gbase) + (voff)[_i]), (PG8_LAS unsigned*)(lds + (bufoff) + ldsw + _i * 8192), 16, 0, 0); } while (0)
#define PG8_LDA(dst, b, h) do { _Pragma("unroll") for (int m = 0; m < 4; ++m) _Pragma("unroll") for (int k = 0; k < 2; ++k) dst[m][k] = *(const PG8_LAS bf16x8*)(lds + PG8_SA(b, h) + aoff + m * 2048 + k * 1024); } while (0)
#define PG8_LDB(dst, b, h) do { _Pragma("unroll") for (int n = 0; n < 2; ++n) _Pragma("unroll") for (int k = 0; k < 2; ++k) dst[n][k] = *(const PG8_LAS bf16x8*)(lds + PG8_SB(b, h) + boff + n * 2048 + k * 1024); } while (0)
#define PG8_MMA(ai, bj, At, Bt) do { __builtin_amdgcn_s_setprio(1); _Pragma("unroll") for (int m = 0; m < 4; ++m) _Pragma("unroll") for (int n = 0; n < 2; ++n) _Pragma("unroll") for (int k = 0; k < 2; ++k) \
        acc[ai][bj][m][n] = __builtin_amdgcn_mfma_f32_16x16x32_bf16(Bt[n][k], At[m][k], acc[ai][bj][m][n], 0, 0, 0); __builtin_amdgcn_s_setprio(0); } while (0)
#define PG8_WAIT_V(n) asm volatile("s_waitcnt vmcnt(" #n ")" ::: "memory")
#define PG8_WAIT_L(n) asm volatile("s_waitcnt lgkmcnt(" #n ")" ::: "memory")
#define PG8_BAR __builtin_amdgcn_s_barrier()
#define PG8_SCHED __builtin_amdgcn_sched_barrier(0)
    Unit cur, nxt; int ui = 0;
    if (!S.next(0, cur)) return;
    f32x4 acc[2][2][4][2];
#pragma unroll
    for (int a = 0; a < 2; ++a)
#pragma unroll
        for (int b = 0; b < 2; ++b)
#pragma unroll
            for (int m = 0; m < 4; ++m)
#pragma unroll
                for (int n = 0; n < 2; ++n) acc[a][b][m][n] = (f32x4){0.f, 0.f, 0.f, 0.f};
    bf16x8 At[4][2], B0[2][2], B1[2][2];
    const char* cA = (const char*)g.A + (size_t)cur.pm * tstep; const char* cB = (const char*)g.Bt + (size_t)cur.pn * tstep;
    S.a_ready(cur);
    if constexpr (SP2) {
        PG8_STAGE(PG8_SB(0, 0), cB, voffB); PG8_STAGE(PG8_SB(0, 1), cB + hstep, voffB); PG8_STAGE(PG8_SA(0, 0), cA, voffA); PG8_STAGE(PG8_SA(0, 1), cA + hstep, voffA);
        if (wr == 1) PG8_BAR;
        PG8_WAIT_V(2); PG8_BAR;
        PG8_STAGE(PG8_SB(1, 0), cB + kstep, voffB); PG8_STAGE(PG8_SA(1, 0), cA + kstep, voffA); PG8_STAGE(PG8_SB(1, 1), cB + hstep + kstep, voffB);
        PG8_WAIT_V(6); PG8_BAR;
    } else {
        PG8_STAGE(PG8_SB(0, 0), cB, voffB); PG8_STAGE(PG8_SA(0, 0), cA, voffA); PG8_STAGE(PG8_SB(0, 1), cB + hstep, voffB); PG8_STAGE(PG8_SA(0, 1), cA + hstep, voffA);
        if (wr == 1) PG8_BAR;
        PG8_WAIT_V(4); PG8_BAR;
        PG8_STAGE(PG8_SB(1, 0), cB + kstep, voffB); PG8_STAGE(PG8_SA(1, 0), cA + kstep, voffA); PG8_STAGE(PG8_SB(1, 1), cB + hstep + kstep, voffB);
        PG8_WAIT_V(6); PG8_BAR;
    }
    for (;;) {
        const bool has_next = S.next(ui + 1, nxt);
        const char* nA = has_next ? (const char*)g.A + (size_t)nxt.pm * tstep : cA; const char* nB = has_next ? (const char*)g.Bt + (size_t)nxt.pn * tstep : cB;
        for (int t = 0; t < nt; t += 2) {
            const bool last = (t == nt - 2);
            const char* a1 = cA + (size_t)(t + 1) * kstep;
            const char* a2 = last ? nA : cA + (size_t)(t + 2) * kstep; const char* b2 = last ? nB : cB + (size_t)(t + 2) * kstep;
            const char* a3 = a2 + kstep; const char* b3 = b2 + kstep;
            if (last && has_next) S.a_ready(nxt);
            if constexpr (SP2) {
            PG8_LDB(B0, 0, 0); PG8_LDB(B1, 0, 1); PG8_SCHED; PG8_LDA(At, 0, 0); PG8_STAGE(PG8_SA(1, 1), a1 + hstep, voffA);
            PG8_WAIT_V(8); PG8_WAIT_L(0); PG8_BAR; PG8_MMA(0, 0, At, B0); PG8_MMA(0, 1, At, B1); PG8_BAR; PG8_SCHED;
            PG8_LDA(At, 0, 1); PG8_STAGE(PG8_SB(0, 0), b2, voffB); PG8_STAGE(PG8_SB(0, 1), b2 + hstep, voffB); PG8_STAGE(PG8_SA(0, 0), a2, voffA);
            PG8_WAIT_V(8); PG8_WAIT_L(0); PG8_BAR; PG8_MMA(1, 0, At, B0); PG8_MMA(1, 1, At, B1); PG8_BAR; PG8_SCHED;
            PG8_LDB(B0, 1, 0); PG8_LDB(B1, 1, 1); PG8_SCHED; PG8_LDA(At, 1, 0); PG8_STAGE(PG8_SA(0, 1), a2 + hstep, voffA);
            PG8_WAIT_V(8); PG8_WAIT_L(0); PG8_BAR; PG8_MMA(0, 0, At, B0); PG8_MMA(0, 1, At, B1); PG8_BAR; PG8_SCHED;
            PG8_LDA(At, 1, 1); PG8_STAGE(PG8_SB(1, 0), b3, voffB); PG8_STAGE(PG8_SB(1, 1), b3 + hstep, voffB); PG8_STAGE(PG8_SA(1, 0), a3, voffA);
            PG8_WAIT_V(8); PG8_WAIT_L(0); PG8_BAR; PG8_MMA(1, 0, At, B0); PG8_MMA(1, 1, At, B1); PG8_BAR; PG8_SCHED;
            } else {
            PG8_LDB(B0, 0, 0); PG8_SCHED; PG8_LDA(At, 0, 0); PG8_STAGE(PG8_SA(1, 1), a1 + hstep, voffA);
            PG8_WAIT_L(8); PG8_BAR; PG8_WAIT_L(0); PG8_MMA(0, 0, At, B0); PG8_BAR; PG8_SCHED;
            PG8_LDB(B1, 0, 1); PG8_STAGE(PG8_SB(0, 0), b2, voffB);
            PG8_BAR; PG8_WAIT_L(0); PG8_MMA(0, 1, At, B1); PG8_BAR;
            PG8_LDA(At, 0, 1); PG8_STAGE(PG8_SA(0, 0), a2, voffA);
            PG8_BAR; PG8_WAIT_L(0); PG8_MMA(1, 0, At, B0); PG8_BAR; PG8_SCHED;
            PG8_STAGE(PG8_SB(0, 1), b2 + hstep, voffB);
            PG8_WAIT_V(6); PG8_BAR; PG8_MMA(1, 1, At, B1); PG8_BAR;
            PG8_LDB(B0, 1, 0); PG8_SCHED; PG8_LDA(At, 1, 0); PG8_STAGE(PG8_SA(0, 1), a2 + hstep, voffA);
            PG8_WAIT_L(8); PG8_BAR; PG8_WAIT_L(0); PG8_MMA(0, 0, At, B0); PG8_BAR; PG8_SCHED;
            PG8_LDB(B1, 1, 1); PG8_STAGE(PG8_SB(1, 0), b3, voffB);
            PG8_BAR; PG8_WAIT_L(0); PG8_MMA(0, 1, At, B1); PG8_BAR;
            PG8_LDA(At, 1, 1); PG8_STAGE(PG8_SA(1, 0), a3, voffA);
            PG8_BAR; PG8_WAIT_L(0); PG8_MMA(1, 0, At, B0); PG8_BAR; PG8_SCHED;
            PG8_STAGE(PG8_SB(1, 1), b3 + hstep, voffB);
            PG8_WAIT_V(6); PG8_BAR; PG8_MMA(1, 1, At, B1); PG8_BAR;
            }
        }
        if constexpr (ALIGN_EPI) { if (wr == 0) PG8_BAR; }
        if constexpr (!Epi::AFTER_DRAIN) { E(acc, cur, wr, wc, fr, fq); S.done(cur); }
        if (!has_next) break;
#pragma unroll
        for (int a = 0; a < 2; ++a)
#pragma unroll
            for (int b = 0; b < 2; ++b)
#pragma unroll
                for (int m = 0; m < 4; ++m)
#pragma unroll
                    for (int n = 0; n < 2; ++n) acc[a][b][m][n] = (f32x4){0.f, 0.f, 0.f, 0.f};
        cur = nxt; cA = nA; cB = nB; ++ui;
        if constexpr (ALIGN_EPI) { if (wr == 1) PG8_BAR; }
    }
    PG8_WAIT_V(0);
    if constexpr (!ALIGN_EPI) { if (wr == 0) PG8_BAR; }
    PG8_BAR;
    if constexpr (Epi::AFTER_DRAIN) { E.fused(acc, cur, wr, wc, fr, fq, lds, wid, lane); S.done(cur); }
#undef PG8_SA
#undef PG8_SB
#undef PG8_STAGE
#undef PG8_LDA
#undef PG8_LDB
#undef PG8_MMA
#undef PG8_WAIT_V
#undef PG8_WAIT_L
#undef PG8_BAR
#undef PG8_SCHED
}
}

constexpr int DM = 4096, NBATCH = 2, SEQ = 8192, DEPTH = 4, CTXL = 256;
constexpr int NLAT = NBATCH * SEQ, NCTX = NBATCH * CTXL, MROWS = NLAT + NCTX;
constexpr int NIN = 13568, GWD = 1024;
constexpr int C_POOLV = 0, C_POOLZ = 1024, C_NAZ = 2048, C_RWZ = 3072, C_SGU = 4096, C_SGZ = 5120, C_NAQ = 6144, C_NAK = 7168, C_NAV = 8192, C_RWR = 9216, C_RWK = 10240, C_RWV = 11264,
              C_RWWD = 12288, C_RWAD = 12416, C_SGV = 12544;
constexpr int C_SPLIT = 5632;
__host__ __device__ __forceinline__ int phys_tile(int lt) {
    return lt < 8 ? lt : lt < 20 ? lt + 16 : lt < 24 ? lt - 12 : lt < 36 ? lt + 12 : lt < 40 ? lt - 24 : lt == 40 ? 48 : lt < 45 ? lt - 25 : lt < 49 ? lt + 4 : lt - 29;
}
constexpr int SCANLEN = CTXL + SEQ;
constexpr int NCHAIN = 64;
constexpr int RECB = 896;
constexpr int RECF = RECB / 4;
constexpr int NWAVES = 8;

constexpr size_t MiB = 1u << 20;
constexpr size_t WS_CTL = 0, CTL_ZERO_BYTES = 1 * MiB;
constexpr size_t WS_MOD   = 2 * MiB;
constexpr size_t WS_TAB   = 3 * MiB;
constexpr size_t WS_SGST  = 4 * MiB;
constexpr size_t WS_BON   = 5 * MiB;
constexpr size_t WS_POOLWT= 8 * MiB;
constexpr size_t WS_WUPT  = 10 * MiB;
constexpr size_t WS_AUPT  = 11 * MiB;
constexpr size_t WS_SGW   = 12 * MiB;
constexpr size_t WS_VTC   = 13 * MiB;
constexpr size_t WS_HCTX  = 14 * MiB;
constexpr size_t WS_MODP  = 22 * MiB;
constexpr size_t WS_VTL   = 58 * MiB;
constexpr size_t WS_QN    = 90 * MiB;
constexpr size_t WS_KN    = 123 * MiB;
constexpr size_t WS_WOUTT = 156 * MiB;
constexpr size_t WS_WINT  = 284 * MiB;
constexpr size_t WS_XN    = 708 * MiB;
constexpr size_t WS_Y     = 840 * MiB;
constexpr size_t WS_P     = 972 * MiB;
constexpr size_t WS_YR    = 1410 * MiB;
constexpr size_t WS_REC   = 1542 * MiB;
constexpr size_t WS_END   = 2334 * MiB;
static_assert(WS_P + (size_t)MROWS * NIN * 2 <= WS_YR && WS_REC + (size_t)NCHAIN * SCANLEN * RECB <= WS_END && WS_WINT + (size_t)4 * NIN * DM * 2 <= WS_XN, "ws map");
constexpr int CW_TMO = 0, CW_BAR = 4096;

constexpr int RING_BYTES = 131072, LDSCTL_OFF = RING_BYTES, MISC_OFF = LDSCTL_OFF + 320, LDS_BYTES = 147456;

#define GAS __attribute__((address_space(1)))
#define LAS __attribute__((address_space(3)))
typedef unsigned short bf16;
typedef unsigned v4u __attribute__((ext_vector_type(4)));
typedef unsigned v2u __attribute__((ext_vector_type(2)));
typedef float f32x4 __attribute__((ext_vector_type(4)));
typedef float f32x2 __attribute__((ext_vector_type(2)));
typedef short bf16x8 __attribute__((ext_vector_type(8)));
typedef _Float16 h4 __attribute__((ext_vector_type(4)));
typedef _Float16 h8 __attribute__((ext_vector_type(8)));
#define RLX_AGENT __ATOMIC_RELAXED, __HIP_MEMORY_SCOPE_AGENT
#define LDS_WAIT() asm volatile("s_waitcnt lgkmcnt(0)" ::: "memory")

__device__ __forceinline__ float bf2f(unsigned short h) { return __uint_as_float(((unsigned)h) << 16); }
__device__ __forceinline__ float bflo(unsigned w) { return __uint_as_float(w << 16); }
__device__ __forceinline__ float bfhi(unsigned w) { return __uint_as_float(w & 0xffff0000u); }
typedef __bf16 bf16x2_t __attribute__((ext_vector_type(2)));
__device__ __forceinline__ unsigned pk2(float lo, float hi) { const f32x2 v = {lo, hi}; const bf16x2_t b = __builtin_convertvector(v, bf16x2_t); return __builtin_bit_cast(unsigned, b); }
__device__ __forceinline__ unsigned f2bf(float f) { return pk2(f, 0.f) & 0xffffu; }
__device__ __forceinline__ float rcp_f(float x) { return __builtin_amdgcn_rcpf(x); }
__device__ __forceinline__ float rsq_f(float x) { return __builtin_amdgcn_rsqf(x); }
__device__ __forceinline__ void unpack8(const v4u w, float* x) { x[0] = bflo(w.x); x[1] = bfhi(w.x); x[2] = bflo(w.y); x[3] = bfhi(w.y); x[4] = bflo(w.z); x[5] = bfhi(w.z); x[6] = bflo(w.w); x[7] = bfhi(w.w); }
__device__ __forceinline__ v4u pack8(const float* x) { v4u w; w.x = pk2(x[0], x[1]); w.y = pk2(x[2], x[3]); w.z = pk2(x[4], x[5]); w.w = pk2(x[6], x[7]); return w; }
__device__ __forceinline__ float silu_f(float x) { return x * rcp_f(1.f + __expf(-x)); }
__device__ __forceinline__ float wave_sum(float v) {
#pragma unroll
    for (int o = 1; o < 64; o <<= 1) v += __shfl_xor(v, o);
    return v;
}
template <int CTRL> __device__ __forceinline__ float dppf(float v) { return __builtin_bit_cast(float, __builtin_amdgcn_update_dpp(0, __builtin_bit_cast(int, v), CTRL, 0xF, 0xF, true)); }
__device__ __forceinline__ float red16(float v) { v += dppf<0xB1>(v); v += dppf<0x4E>(v); v += dppf<0x141>(v); v += dppf<0x140>(v); return v; }
__device__ __forceinline__ void red16x2(float& a, float& b) {
    a += dppf<0xB1>(a); b += dppf<0xB1>(b); a += dppf<0x4E>(a); b += dppf<0x4E>(b); a += dppf<0x141>(a); b += dppf<0x141>(b); a += dppf<0x140>(a); b += dppf<0x140>(b); }
__device__ __forceinline__ float red16_transpose(const float (&y)[16], int c16) {
    float a[8], b[4], c[2];
    const bool h8 = (c16 & 8) != 0, h4 = (c16 & 4) != 0, h2 = (c16 & 2) != 0, h1 = (c16 & 1) != 0;
#pragma unroll
    for (int j = 0; j < 8; ++j) { const float keep = h8 ? y[j + 8] : y[j], send = h8 ? y[j] : y[j + 8]; a[j] = keep + dppf<0x140>(send); }
#pragma unroll
    for (int j = 0; j < 4; ++j) { const float keep = h4 ? a[j + 4] : a[j], send = h4 ? a[j] : a[j + 4]; b[j] = keep + dppf<0x141>(send); }
#pragma unroll
    for (int j = 0; j < 2; ++j) { const float keep = h2 ? b[j + 2] : b[j], send = h2 ? b[j] : b[j + 2]; c[j] = keep + dppf<0x1B>(send); }
    const float keep = h1 ? c[1] : c[0], send = h1 ? c[0] : c[1];
    return keep + dppf<0xB1>(send);
}
__device__ __forceinline__ float max16x4(float v) { v = fmaxf(v, __shfl_xor(v, 16)); v = fmaxf(v, __shfl_xor(v, 32)); return v; }
__device__ __forceinline__ float sum16x4(float v) { v += __shfl_xor(v, 16); v += __shfl_xor(v, 32); return v; }
__device__ __forceinline__ int scan_pos(int d, bool isctx, int t) { return d == 0 ? (isctx ? t : CTXL + t) : (isctx ? (CTXL - 1 - t) : (CTXL + SEQ - 1 - t)); }
__device__ __forceinline__ f32x4 mfma16(bf16x8 a, bf16x8 b, f32x4 c) { return __builtin_amdgcn_mfma_f32_16x16x32_bf16(a, b, c, 0, 0, 0); }
__device__ __forceinline__ bf16x8 ld_frag(const bf16* p) { return __builtin_bit_cast(bf16x8, *(const v4u*)p); }

namespace pg8 {
struct EpiStoreBf16 {
    static constexpr bool PERM = true, AFTER_DRAIN = false;
    bf16_t* O; int ldc;
    __device__ __forceinline__ void operator()(const f32x4 (&acc)[2][2][4][2], const Unit& u, int wr, int wc, int fr, int fq) const {
        const int row0 = u.pm * BM + wr * 64 + fr, col0 = u.pn * BM + wc * 32 + 8 * fq;
#pragma unroll
        for (int ai = 0; ai < 2; ++ai)
#pragma unroll
            for (int m = 0; m < 4; ++m) { bf16_t* rowp = O + (size_t)(row0 + ai * HALF + m * 16) * ldc + col0;
#pragma unroll
                for (int bj = 0; bj < 2; ++bj) { const f32x4 v0 = acc[ai][bj][m][0], v1 = acc[ai][bj][m][1];
                    u32x4 w; w.x = cvt_pk_bf16(v0[0], v0[1]); w.y = cvt_pk_bf16(v0[2], v0[3]); w.z = cvt_pk_bf16(v1[0], v1[1]); w.w = cvt_pk_bf16(v1[2], v1[3]);
                    *(u32x4*)(rowp + bj * HALF) = w; } }
    }
};
struct EpiResGate {
    static constexpr bool PERM = false, AFTER_DRAIN = false;
    const float* hin_lat; const float* hin_ctx; float* hout_lat; float* hout_ctx; const float* gate;
    __device__ __forceinline__ void operator()(const f32x4 (&acc)[2][2][4][2], const Unit& u, int wr, int wc, int fr, int fq) const {
        const int cond = u.pm < 32 ? 0 : (u.pm < 64 ? 1 : 2);
        const int rloc = (u.pm < 64 ? u.pm * BM : (u.pm - 64) * BM) + wr * 64 + fr, col0 = u.pn * BM + wc * 32 + 4 * fq;
        const float* hin = u.pm < 64 ? hin_lat : hin_ctx; float* hout = u.pm < 64 ? hout_lat : hout_ctx;
        f32x4 gv[2][2];
#pragma unroll
        for (int bj = 0; bj < 2; ++bj)
#pragma unroll
            for (int n = 0; n < 2; ++n) gv[bj][n] = *(const f32x4*)(gate + cond * 12288 + 8192 + col0 + bj * HALF + n * 16);
#pragma unroll
        for (int ai = 0; ai < 2; ++ai)
#pragma unroll
            for (int m = 0; m < 4; ++m) { const size_t off = (size_t)(rloc + ai * HALF + m * 16) * 4096 + col0;
#pragma unroll
                for (int bj = 0; bj < 2; ++bj)
#pragma unroll
                    for (int n = 0; n < 2; ++n) { const f32x4 b = *(const f32x4*)(hin + off + bj * HALF + n * 16);
                        *(f32x4*)(hout + off + bj * HALF + n * 16) = b + gv[bj][n] * acc[ai][bj][m][n]; } }
    }
};
}

template <bool PERMC = false>
__device__ __forceinline__ void p0_transpose_item(const float* W, int K, int N, bf16* WT, LAS float* scr, int item, int lane) {
    const int nblk = N / 32, kb = item / nblk, nb = item % nblk, k0 = 64 * kb, n0 = 32 * nb;
    const int pn0 = PERMC ? phys_tile(n0 >> 8) * 256 + (n0 & 255) : n0;
#pragma unroll 8
    for (int i = 0; i < 32; ++i) { const int kk = 2 * i + (lane >> 5); scr[kk * 33 + (lane & 31)] = W[(size_t)(k0 + kk) * N + n0 + (lane & 31)]; }
    LDS_WAIT(); asm volatile("" ::: "memory");
    const int c = lane & 7;
#pragma unroll
    for (int j = 0; j < 4; ++j) { const int n = (lane >> 3) + 8 * j; const LAS float* s = scr + (8 * c) * 33 + n;
        v4u o; o.x = pk2(s[0 * 33], s[1 * 33]); o.y = pk2(s[2 * 33], s[3 * 33]); o.z = pk2(s[4 * 33], s[5 * 33]); o.w = pk2(s[6 * 33], s[7 * 33]);
        *(v4u*)(WT + (size_t)(pn0 + n) * K + k0 + 8 * c) = o; }
    LDS_WAIT(); asm volatile("" ::: "memory");
}
template <bool PERMC = false>
__device__ __forceinline__ void transpose_item_nolds(const float* W, int K, int N, bf16* WT, int item, int lane) {
    const int nblk = N / 64, kb = item / nblk, nb = item % nblk, k0 = 64 * kb, n0 = 64 * nb;
    const int pn0 = PERMC ? phys_tile(n0 >> 8) * 256 + (n0 & 255) : n0;
    const float* src = W + (size_t)k0 * N + n0 + lane;
    bf16* dst = WT + (size_t)(pn0 + lane) * K + k0;
#pragma unroll
    for (int hb = 0; hb < 2; ++hb) {
        float v[32];
#pragma unroll
        for (int i = 0; i < 32; ++i) v[i] = src[(size_t)(32 * hb + i) * N];
        __builtin_amdgcn_sched_barrier(0);
#pragma unroll
        for (int j = 0; j < 4; ++j) { v4u o; o.x = pk2(v[8 * j], v[8 * j + 1]); o.y = pk2(v[8 * j + 2], v[8 * j + 3]); o.z = pk2(v[8 * j + 4], v[8 * j + 5]); o.w = pk2(v[8 * j + 6], v[8 * j + 7]);
            *(v4u*)(dst + 32 * hb + 8 * j) = o; }
        __builtin_amdgcn_sched_barrier(0);
    }
}
constexpr int WC_WIN = (DM / 64) * (NIN / 64), WC_WOUT = (DM / 64) * (DM / 64), WC_POOL = 4 * 16, WC_WUP = 2 * 16, WC_AUP = 2 * 16, WC_SGW = 256, WC_ITEMS = WC_WIN + WC_WOUT + WC_POOL + WC_WUP + WC_AUP + WC_SGW;
__device__ __forceinline__ void weight_copy_item(int L, int r, const float* w_in, const float* w_out, const float* pool_w, const float* rw_w_up, const float* rw_a_up, const float* sg_w,
                                                 bf16* WINT, bf16* WOUTT, bf16* POOLWT, bf16* WUPT, bf16* AUPT, bf16* SGW, int lane) {
    if (r < WC_WIN) { transpose_item_nolds<true>(w_in + (size_t)L * DM * NIN, DM, NIN, WINT + (size_t)L * NIN * DM, r, lane); return; } r -= WC_WIN;
    if (r < WC_WOUT) { transpose_item_nolds(w_out + (size_t)L * DM * DM, DM, DM, WOUTT + (size_t)L * DM * DM, r, lane); return; } r -= WC_WOUT;
    if (r < WC_POOL) { const int g = r >> 4; transpose_item_nolds(pool_w + (size_t)(L * 4 + g) * 65536, 256, 256, POOLWT + (size_t)(L * 4 + g) * 65536, r & 15, lane); return; } r -= WC_POOL;
    if (r < WC_WUP) { const int dd = r >> 4; transpose_item_nolds(rw_w_up + (size_t)(L * 2 + dd) * 65536, 64, 1024, WUPT + (size_t)(L * 2 + dd) * 65536, r & 15, lane); return; } r -= WC_WUP;
    if (r < WC_AUP) { const int dd = r >> 4; transpose_item_nolds(rw_a_up + (size_t)(L * 2 + dd) * 65536, 64, 1024, AUPT + (size_t)(L * 2 + dd) * 65536, r & 15, lane); return; } r -= WC_AUP;
    {   const size_t e0 = (size_t)L * 131072 + (size_t)r * 512 + lane * 8; const f32x4 a = *(const f32x4*)(sg_w + e0), b = *(const f32x4*)(sg_w + e0 + 4);
        v4u o; o.x = pk2(a.x, a.y); o.y = pk2(a.z, a.w); o.z = pk2(b.x, b.y); o.w = pk2(b.z, b.w); *(v4u*)(SGW + e0) = o; }
}
__device__ __forceinline__ void p0_mod_item(const float* wmod, const float* cvec, const float* cctx, float* MODP, LAS float* scr, int item, int lane) {
    const int l = item / (64 * 48), r = item % (64 * 48), kc = r / 48, nc = r % 48, k0 = kc * 64, n0 = nc * 256 + lane * 4;
    scr[lane] = silu_f(cvec[k0 + lane]); scr[64 + lane] = silu_f(cvec[4096 + k0 + lane]); scr[128 + lane] = silu_f(cctx[k0 + lane]);
    LDS_WAIT(); asm volatile("" ::: "memory");
    f32x4 a0 = {0.f, 0.f, 0.f, 0.f}, a1 = a0, a2 = a0;
    const float* wp = wmod + ((size_t)l * 4096 + k0) * 12288 + n0;
#pragma unroll 16
    for (int k = 0; k < 64; ++k) { const f32x4 w = *(const f32x4*)(wp + (size_t)k * 12288); a0 += scr[k] * w; a1 += scr[64 + k] * w; a2 += scr[128 + k] * w; }
    float* o = MODP + ((size_t)(l * 64 + kc) * 3) * 12288 + n0;
    *(f32x4*)(o) = a0; *(f32x4*)(o + 12288) = a1; *(f32x4*)(o + 2 * 12288) = a2;
    LDS_WAIT(); asm volatile("" ::: "memory");
}
__device__ __forceinline__ void sincos_acc(float ang, float& c, float& s) {
    const double x = (double)ang; const double n = __builtin_rint(x * 0.63661977236758134308); const double r = x - n * 1.57079632679489661923;
    const double r2 = r * r;
    const double sp = r * (1.0 + r2 * (-1.0 / 6 + r2 * (1.0 / 120 + r2 * (-1.0 / 5040 + r2 * (1.0 / 362880 + r2 * (-1.0 / 39916800 + r2 * (1.0 / 6227020800.0)))))));
    const double cp = 1.0 + r2 * (-0.5 + r2 * (1.0 / 24 + r2 * (-1.0 / 720 + r2 * (1.0 / 40320 + r2 * (-1.0 / 3628800 + r2 * (1.0 / 479001600 + r2 * (-1.0 / 87178291200.0)))))));
    const int q = ((int)n) & 3;
    const double cc = (q == 0) ? cp : (q == 1) ? -sp : (q == 2) ? -cp : sp;
    const double ss = (q == 0) ? sp : (q == 1) ? cp : (q == 2) ? -sp : -cp;
    c = (float)cc; s = (float)ss;
}

__device__ __forceinline__ void phase_xn(const float* hlat, const float* hctx, const float* mod, bf16* XN, int gw, int NGW, int lane) {
    for (int m = gw; m < MROWS; m += NGW) {
        const float* src = m < NLAT ? hlat + (size_t)m * DM : hctx + (size_t)(m - NLAT) * DM;
        const int cond = m < NLAT ? (m >> 13) : 2;
        const f32x4* s4 = (const f32x4*)src + lane;
        f32x4 v[16]; float ss = 0.f;
#pragma unroll
        for (int j = 0; j < 16; ++j) { v[j] = s4[64 * j]; ss += (v[j].x * v[j].x + v[j].y * v[j].y) + (v[j].z * v[j].z + v[j].w * v[j].w); }
        ss = wave_sum(ss);
        const float rstd = rsq_f(ss * (1.f / 4096.f) + 1e-6f);
        const f32x4* sh4 = (const f32x4*)(mod + cond * 12288) + lane; const f32x4* sc4 = (const f32x4*)(mod + cond * 12288 + 4096) + lane;
        v2u* o = (v2u*)(XN + (size_t)m * DM) + lane;
#pragma unroll
        for (int j = 0; j < 16; ++j) { const f32x4 sh = sh4[64 * j], sc = sc4[64 * j]; const f32x4 x = v[j] * rstd * (sc + 1.f) + sh; v2u w; w.x = pk2(x.x, x.y); w.y = pk2(x.z, x.w); o[64 * j] = w; }
    }
}

__device__ __forceinline__ void phase_rowprep(const bf16* P, const float* qgain, const float* kgain, const f32x2* tab, bf16* QN, bf16* KN, f32x2* SGST, int gw, int NGW, int lane) {
    const int sub = lane & 3;
    for (int m = gw; m < MROWS; m += NGW) {
        const bf16* pr = P + (size_t)m * NIN;
        const bool isctx = m >= NLAT; const int t = isctx ? ((m - NLAT) & 255) : (m & 8191);
        {   float x[16]; unpack8(*(const v4u*)(pr + C_SGV + 16 * lane), x); unpack8(*(const v4u*)(pr + C_SGV + 16 * lane + 8), x + 8);
            float s = 0.f;
#pragma unroll
            for (int i = 0; i < 16; ++i) s += x[i];
            const float mean = wave_sum(s) * (1.f / 1024.f); float q = 0.f;
#pragma unroll
            for (int i = 0; i < 16; ++i) { const float dlt = x[i] - mean; q += dlt * dlt; }
            const float var = wave_sum(q) * (1.f / 1024.f);
            if (lane == 0) SGST[m] = (f32x2){mean, rsq_f(var + 1e-5f)}; }
        float q[16], k[16];
        unpack8(*(const v4u*)(pr + C_NAQ + 16 * lane), q); unpack8(*(const v4u*)(pr + C_NAQ + 16 * lane + 8), q + 8);
        unpack8(*(const v4u*)(pr + C_NAK + 16 * lane), k); unpack8(*(const v4u*)(pr + C_NAK + 16 * lane + 8), k + 8);
        float sq = 0.f, sk = 0.f;
#pragma unroll
        for (int i = 0; i < 16; ++i) { sq += q[i] * q[i]; sk += k[i] * k[i]; }
        sq += __shfl_xor(sq, 1); sq += __shfl_xor(sq, 2); sk += __shfl_xor(sk, 1); sk += __shfl_xor(sk, 2);
        const float rq = rsq_f(sq * (1.f / 64.f) + 1e-6f), rk = rsq_f(sk * (1.f / 64.f) + 1e-6f);
#pragma unroll
        for (int i = 0; i < 16; ++i) { q[i] *= rq * qgain[16 * sub + i]; k[i] *= rk * kgain[16 * sub + i]; }
        if (!isctx) {
            const int pos = sub < 2 ? (t >> 6) : (t & 63);
#pragma unroll
            for (int i = 0; i < 16; ++i) { const f32x2 cs = tab[pos * 16 + i]; const float pq = __shfl_xor(q[i], 1), pkk = __shfl_xor(k[i], 1);
                q[i] = (sub & 1) ? (q[i] * cs.x + pq * cs.y) : (q[i] * cs.x - pq * cs.y);
                k[i] = (sub & 1) ? (k[i] * cs.x + pkk * cs.y) : (k[i] * cs.x - pkk * cs.y); }
        }
#pragma unroll
        for (int i = 0; i < 16; ++i) q[i] *= 0.125f;
        *(v4u*)(QN + (size_t)m * GWD + 16 * lane) = pack8(q); *(v4u*)(QN + (size_t)m * GWD + 16 * lane + 8) = pack8(q + 8);
        *(v4u*)(KN + (size_t)m * GWD + 16 * lane) = pack8(k); *(v4u*)(KN + (size_t)m * GWD + 16 * lane + 8) = pack8(k + 8);
    }
}
__device__ __forceinline__ void phase_vt(const bf16* P, bf16* VTL, bf16* VTC, int gw, int NGW, int lane) {
    for (int u = gw; u < (MROWS / 64) * 16; u += NGW) {
        const int tt = u >> 4, h = u & 15, m0 = tt * 64;
        const bf16* src = P + (size_t)m0 * NIN + C_NAV + h * 64 + lane;
        unsigned w[32];
#pragma unroll
        for (int i = 0; i < 32; ++i) { const unsigned lo = src[(size_t)(2 * i) * NIN], hi = src[(size_t)(2 * i + 1) * NIN]; w[i] = lo | (hi << 16); }
        bf16* dst = tt < 256 ? VTL + (((size_t)((tt >> 7) * 16 + h) * 64 + lane) * 8192 + (tt & 127) * 64)
                             : VTC + (((size_t)(((tt - 256) >> 2) * 16 + h) * 64 + lane) * 256 + ((tt - 256) & 3) * 64);
#pragma unroll
        for (int j = 0; j < 8; ++j) { v4u o; o.x = w[4 * j]; o.y = w[4 * j + 1]; o.z = w[4 * j + 2]; o.w = w[4 * j + 3]; ((v4u*)dst)[j] = o; }
    }
}
template <int G>
__device__ __forceinline__ void pool_unit(const bf16* P, const bf16* wbase, const float* pscale, bf16* Y, int m0, int lane) {
    constexpr int WIN = 2 << G;
    const int r = lane & 15, q4 = lane >> 4, m = m0 + r;
    const bool isctx = m0 >= NLAT; const int T = isctx ? CTXL : SEQ; const int t = isctx ? ((m - NLAT) & 255) : (m & 8191);
    const int tlo = t - (WIN >> 1);
    const int lo = tlo < 0 ? 0 : tlo, hi = (tlo + WIN) > T ? T : (tlo + WIN);
    const float inv = rcp_f((float)(hi - lo));
    f32x4 acc[16];
#pragma unroll
    for (int nt = 0; nt < 16; ++nt) acc[nt] = (f32x4){0.f, 0.f, 0.f, 0.f};
#pragma unroll 1
    for (int ks = 0; ks < 8; ++ks) {
        const int ch0 = C_POOLV + G * 256 + 32 * ks + 8 * q4;
        constexpr int WB = WIN < 8 ? WIN : 8;
        bf16x8 bfr[8];
        float sum[8];
#pragma unroll
        for (int j = 0; j < 8; ++j) sum[j] = 0.f;
        const v4u selfw = *(const v4u*)(P + (size_t)m * NIN + ch0);
#pragma unroll
        for (int nt = 0; nt < 8; ++nt) bfr[nt] = ld_frag(wbase + (size_t)(16 * nt + r) * 256 + 32 * ks + 8 * q4);
#pragma unroll
        for (int k0 = 0; k0 < WIN; k0 += WB) {
            v4u wl[WB];
#pragma unroll
            for (int k = 0; k < WB; ++k) { const int tk = tlo + k0 + k; const bool ok = tk >= 0 && tk < T; wl[k] = *(const v4u*)(P + (size_t)(ok ? (m - t + tk) : m) * NIN + ch0); }
            __builtin_amdgcn_sched_barrier(0);
#pragma unroll
            for (int k = 0; k < WB; ++k) { const int tk = tlo + k0 + k; const bool ok = tk >= 0 && tk < T; float x[8]; unpack8(wl[k], x);
#pragma unroll
                for (int j = 0; j < 8; ++j) sum[j] += ok ? x[j] : 0.f; }
            __builtin_amdgcn_sched_barrier(0);
        }
        float self[8]; unpack8(selfw, self);
        float dv[8];
#pragma unroll
        for (int j = 0; j < 8; ++j) dv[j] = sum[j] * inv - self[j];
        const bf16x8 af = __builtin_bit_cast(bf16x8, pack8(dv));
        __builtin_amdgcn_sched_barrier(0);
        bf16x8 bfr2[8];
#pragma unroll
        for (int nt = 0; nt < 8; ++nt) bfr2[nt] = ld_frag(wbase + (size_t)(16 * (nt + 8) + r) * 256 + 32 * ks + 8 * q4);
        __builtin_amdgcn_sched_barrier(0);
#pragma unroll
        for (int nt = 0; nt < 8; ++nt) acc[nt] = mfma16(af, bfr[nt], acc[nt]);
        __builtin_amdgcn_sched_barrier(0);
#pragma unroll
        for (int nt = 0; nt < 8; ++nt) acc[nt + 8] = mfma16(af, bfr2[nt], acc[nt + 8]);
        __builtin_amdgcn_sched_barrier(0);
    }
#pragma unroll
    for (int nh = 0; nh < 4; ++nh) {
        unsigned short zz[4][4]; float ps[4];
#pragma unroll
        for (int nq = 0; nq < 4; ++nq) { const int oc = G * 256 + 16 * (4 * nh + nq) + r; ps[nq] = pscale[oc];
#pragma unroll
            for (int i = 0; i < 4; ++i) zz[nq][i] = P[(size_t)(m0 + 4 * q4 + i) * NIN + C_POOLZ + oc]; }
        __builtin_amdgcn_sched_barrier(0);
#pragma unroll
        for (int nq = 0; nq < 4; ++nq) { const int oc = G * 256 + 16 * (4 * nh + nq) + r;
#pragma unroll
            for (int i = 0; i < 4; ++i) Y[(size_t)(m0 + 4 * q4 + i) * DM + oc] = (bf16)f2bf(acc[4 * nh + nq][i] * ps[nq] * silu_f(bf2f(zz[nq][i]))); }
        __builtin_amdgcn_sched_barrier(0);
    }
}
__device__ __forceinline__ void phase_pool(const bf16* P, const bf16* PWT  , const float* pscale, bf16* Y, int nrows, int gw, int NGW, int lane) {
    for (int u = gw; u < (nrows / 16) * 4; u += NGW) {
        const int tt = u >> 2, g = u & 3, m0 = tt * 16;
        const bf16* wbase = PWT + (size_t)g * 65536;
        if (g == 0) pool_unit<0>(P, wbase, pscale, Y, m0, lane);
        else if (g == 1) pool_unit<1>(P, wbase, pscale, Y, m0, lane);
        else if (g == 2) pool_unit<2>(P, wbase, pscale, Y, m0, lane);
        else pool_unit<3>(P, wbase, pscale, Y, m0, lane);
    }
}
#define REC_ST(p, v) __builtin_nontemporal_store((v), (p))
__device__ __forceinline__ void phase_rwprep(const bf16* P, const float* mu_rkv  , const float* mu_lora  , const float* w0  , const bf16* WUPT  ,
                                             const float* a0, const bf16* AUPT, const float* k_k, const float* k_a, const float* r_k, float* REC, float* BON, LAS unsigned char* lds,
                                             unsigned* queue  , int cls, int wave, int lane) {
    const int n = lane & 15, q4 = lane >> 4;
    const int d = cls >> 3, hp = cls & 7;
    unsigned* qh = queue + 64 * cls;
    LAS float* prm = (LAS float*)(lds + wave * 4096);
#pragma unroll
    for (int it = 0; it < 16; ++it) { const int hh = it >> 3, p = it & 7, ch = (hp * 2 + hh) * 64 + lane;
        const float* src = p == 0 ? w0 + d * 1024 : p == 1 ? a0 + d * 1024 : p == 2 ? mu_rkv + (d * 3 + 0) * 1024 : p == 3 ? mu_rkv + (d * 3 + 1) * 1024 : p == 4 ? mu_rkv + (d * 3 + 2) * 1024 : p == 5 ? k_k : p == 6 ? k_a : r_k;
        prm[it * 64 + lane] = src[ch]; }
    LDS_WAIT(); asm volatile("" ::: "memory");
    unsigned pend = 0u;
    if (lane == 0) pend = __hip_atomic_fetch_add(qh, 1u, __ATOMIC_RELAXED, __HIP_MEMORY_SCOPE_AGENT);
    for (;;) {
        const int tt = __builtin_amdgcn_readfirstlane((int)pend);
        if (tt >= MROWS / 16) break;
        if (lane == 0) pend = __hip_atomic_fetch_add(qh, 1u, __ATOMIC_RELAXED, __HIP_MEMORY_SCOPE_AGENT);
        const int m0 = tt * 16;
        const bool isctx = m0 >= NLAT; const int T = isctx ? CTXL : SEQ; const int t0 = isctx ? ((m0 - NLAT) & 255) : (m0 & 8191); const int b = isctx ? ((m0 - NLAT) >> 8) : (m0 >> 13);
        const int m = m0 + n, t = t0 + n; const bool hasnb = d == 0 ? (t > 0) : (t < T - 1); const int nbr = hasnb ? (d == 0 ? m - 1 : m + 1) : m;
        const bf16* prow = P + (size_t)m * NIN; const bf16* nrow = P + (size_t)nbr * NIN;
        bf16x8 Bw[2], Ba[2];
        {   v4u cw[2], nw[2], ca[2], na[2]; f32x4 mw[2][2], ma[2][2];
#pragma unroll
            for (int ks = 0; ks < 2; ++ks) { const int j0 = 32 * ks + 8 * q4;
                cw[ks] = *(const v4u*)(prow + C_RWWD + d * 64 + j0); nw[ks] = *(const v4u*)(nrow + C_RWWD + d * 64 + j0);
                ca[ks] = *(const v4u*)(prow + C_RWAD + d * 64 + j0); na[ks] = *(const v4u*)(nrow + C_RWAD + d * 64 + j0);
                mw[ks][0] = *(const f32x4*)(mu_lora + (d * 2 + 0) * 64 + j0); mw[ks][1] = *(const f32x4*)(mu_lora + (d * 2 + 0) * 64 + j0 + 4);
                ma[ks][0] = *(const f32x4*)(mu_lora + (d * 2 + 1) * 64 + j0); ma[ks][1] = *(const f32x4*)(mu_lora + (d * 2 + 1) * 64 + j0 + 4); }
            __builtin_amdgcn_sched_barrier(0);
#pragma unroll
            for (int ks = 0; ks < 2; ++ks) {
                float cur[8], nb[8], o[8];
                unpack8(cw[ks], cur); unpack8(nw[ks], nb);
#pragma unroll
                for (int j = 0; j < 8; ++j) { const float xx = cur[j] + ((hasnb ? nb[j] : 0.f) - cur[j]) * mw[ks][j >> 2][j & 3]; o[j] = 1.0f - 2.0f * rcp_f(1.0f + __expf(2.0f * xx)); }
                Bw[ks] = __builtin_bit_cast(bf16x8, pack8(o));
                unpack8(ca[ks], cur); unpack8(na[ks], nb);
#pragma unroll
                for (int j = 0; j < 8; ++j) o[j] = cur[j] + ((hasnb ? nb[j] : 0.f) - cur[j]) * ma[ks][j >> 2][j & 3];
                Ba[ks] = __builtin_bit_cast(bf16x8, pack8(o)); }
        }
        const int pos = scan_pos(d, isctx, t);
#pragma unroll 1
        for (int hh = 0; hh < 2; ++hh) {
            const int head = hp * 2 + hh, chain = (b * 2 + d) * 16 + head;
            char* recb = (char*)REC + ((size_t)chain * SCANLEN + pos) * RECB;
            const LAS float* pr = prm + hh * 512;
            float KK[16], AV[16]; float ss = 0.f, bon = 0.f;
#pragma unroll
            for (int hf = 0; hf < 2; ++hf) {
                const int cl = 32 * hf + 8 * q4, cg = head * 64 + cl;
                bf16x8 wf[2][2], af[2][2];
#pragma unroll
                for (int tq = 0; tq < 2; ++tq) { const size_t wrow = (size_t)(d * 1024 + head * 64 + 32 * hf + 8 * (n >> 2) + 4 * tq + (n & 3)) * 64 + 8 * q4;
                    wf[tq][0] = ld_frag(WUPT + wrow); wf[tq][1] = ld_frag(WUPT + wrow + 32); af[tq][0] = ld_frag(AUPT + wrow); af[tq][1] = ld_frag(AUPT + wrow + 32); }
                const v4u rcw = *(const v4u*)(prow + C_RWR + cg), kcw = *(const v4u*)(prow + C_RWK + cg), vcw = *(const v4u*)(prow + C_RWV + cg);
                const v4u rnw = *(const v4u*)(nrow + C_RWR + cg), knw = *(const v4u*)(nrow + C_RWK + cg), vnw = *(const v4u*)(nrow + C_RWV + cg);
                __builtin_amdgcn_sched_barrier(0);
                f32x4 accW[2], accA[2];
#pragma unroll
                for (int tq = 0; tq < 2; ++tq) { f32x4 z = {0.f, 0.f, 0.f, 0.f}; z = mfma16(wf[tq][0], Bw[0], z); accW[tq] = mfma16(wf[tq][1], Bw[1], z);
                                                 f32x4 y = {0.f, 0.f, 0.f, 0.f}; y = mfma16(af[tq][0], Ba[0], y); accA[tq] = mfma16(af[tq][1], Ba[1], y); }
                float rc[8], kc[8], vc[8], rn[8], kn[8], vn[8];
                unpack8(rcw, rc); unpack8(kcw, kc); unpack8(vcw, vc); unpack8(rnw, rn); unpack8(knw, kn); unpack8(vnw, vn);
                float dec[8], kp[8], rr[8], vv[8];
#pragma unroll
                for (int g = 0; g < 2; ++g) {
                    const f32x4 w0v = *(const LAS f32x4*)(pr + 0 * 64 + cl + 4 * g), a0v = *(const LAS f32x4*)(pr + 1 * 64 + cl + 4 * g), mur = *(const LAS f32x4*)(pr + 2 * 64 + cl + 4 * g),
                                muk = *(const LAS f32x4*)(pr + 3 * 64 + cl + 4 * g), muv = *(const LAS f32x4*)(pr + 4 * 64 + cl + 4 * g), kkv = *(const LAS f32x4*)(pr + 5 * 64 + cl + 4 * g),
                                kav = *(const LAS f32x4*)(pr + 6 * 64 + cl + 4 * g), rkv = *(const LAS f32x4*)(pr + 7 * 64 + cl + 4 * g);
#pragma unroll
                    for (int i = 0; i < 4; ++i) { const int j = 4 * g + i;
                        const float rnb = hasnb ? rn[j] : 0.f, knb = hasnb ? kn[j] : 0.f, vnb = hasnb ? vn[j] : 0.f;
                        const float r_ = rc[j] + (rnb - rc[j]) * mur[i], k0 = kc[j] + (knb - kc[j]) * muk[i], v_ = vc[j] + (vnb - vc[j]) * muv[i];
                        const float xw = -(w0v[i] + accW[g][i]);
                        const float sp = fmaxf(xw, 0.f) + __logf(1.0f + __expf(-fabsf(xw)));
                        dec[j] = __expf(-__expf(-sp - 0.5f));
                        const float av = rcp_f(1.0f + __expf(-(a0v[i] + accA[g][i])));
                        const float kx = k0 * kkv[i]; ss += kx * kx;
                        const float kp_ = k0 * (1.f + (av - 1.f) * kav[i]); bon += r_ * kp_ * rkv[i];
                        KK[8 * hf + j] = kx; AV[8 * hf + j] = av; kp[j] = kp_; rr[j] = r_; vv[j] = v_; }
                }
                char* ob = recb + cl * 2;
                REC_ST((f32x4*)(recb + cl * 4), ((f32x4){dec[0], dec[1], dec[2], dec[3]})); REC_ST((f32x4*)(recb + cl * 4 + 16), ((f32x4){dec[4], dec[5], dec[6], dec[7]}));
                REC_ST((h8*)(ob + 512), ((h8){(_Float16)kp[0], (_Float16)kp[1], (_Float16)kp[2], (_Float16)kp[3], (_Float16)kp[4], (_Float16)kp[5], (_Float16)kp[6], (_Float16)kp[7]}));
                REC_ST((h8*)(ob + 640), ((h8){(_Float16)rr[0], (_Float16)rr[1], (_Float16)rr[2], (_Float16)rr[3], (_Float16)rr[4], (_Float16)rr[5], (_Float16)rr[6], (_Float16)rr[7]}));
                REC_ST((h8*)(ob + 768), ((h8){(_Float16)vv[0], (_Float16)vv[1], (_Float16)vv[2], (_Float16)vv[3], (_Float16)vv[4], (_Float16)vv[5], (_Float16)vv[6], (_Float16)vv[7]}));
                __builtin_amdgcn_sched_barrier(0);
            }
            ss = sum16x4(ss); bon = sum16x4(bon);
            const float inv = rsq_f(fmaxf(ss, 1e-12f));
#pragma unroll
            for (int hf = 0; hf < 2; ++hf) { char* ob = recb + (32 * hf + 8 * q4) * 2; float kkn[8], nka[8];
#pragma unroll
                for (int j = 0; j < 8; ++j) { kkn[j] = KK[8 * hf + j] * inv; nka[j] = -(kkn[j] * AV[8 * hf + j]); }
                REC_ST((h8*)(ob + 256), ((h8){(_Float16)kkn[0], (_Float16)kkn[1], (_Float16)kkn[2], (_Float16)kkn[3], (_Float16)kkn[4], (_Float16)kkn[5], (_Float16)kkn[6], (_Float16)kkn[7]}));
                REC_ST((h8*)(ob + 384), ((h8){(_Float16)nka[0], (_Float16)nka[1], (_Float16)nka[2], (_Float16)nka[3], (_Float16)nka[4], (_Float16)nka[5], (_Float16)nka[6], (_Float16)nka[7]})); }
            if (q4 == 0) BON[(size_t)chain * SCANLEN + pos] = bon;
        }
    }
}
template <bool CTXQ>
__device__ __forceinline__ void na_unit(const bf16* QN, const bf16* KN, const bf16* VTL, const bf16* VTC, const bf16* P, const float* rpb  , bf16* Y, int u, int lane) {
    const int n = lane & 15, q4 = lane >> 4;
    int b, h, qrow0, qr = 0, jt = 0;
    if (CTXQ) { b = u >> 8; h = (u >> 4) & 15; qrow0 = NLAT + b * CTXL + 16 * (u & 15); }
    else { jt = u & 3; h = (u >> 2) & 15; qr = (u >> 6) & 127; b = u >> 13; qrow0 = b * SEQ + qr * 64 + 16 * jt; }
    constexpr int NT = CTXQ ? 16 : 32, WT = CTXQ ? 0 : 16;
    f32x4 s[NT];
    const int rs = qr - 4 < 0 ? 0 : (qr - 4 > 120 ? 120 : qr - 4);
    const int span0 = jt == 0 ? 0 : (jt == 1 ? 8 : (jt == 2 ? 24 : 32));
    const int qc = 16 * jt + n; const int cs = qc - 8 < 0 ? 0 : (qc - 8 > 48 ? 48 : qc - 8);
    bf16x8 qf[2];
#pragma unroll
    for (int ks = 0; ks < 2; ++ks) qf[ks] = ld_frag(QN + (size_t)(qrow0 + n) * GWD + h * 64 + 32 * ks + 8 * q4);
    if (!CTXQ) {
        const float* rp = rpb + (size_t)h * 15 * 31;
#pragma unroll
        for (int wt = 0; wt < 16; ++wt) { const int kri = wt >> 1, half = wt & 1, relr = rs + kri - qr + 7;
#pragma unroll
            for (int i = 0; i < 4; ++i) { const int relc = span0 + 8 * q4 + 4 * half + i - qc + 15; const int relcc = relc < 0 ? 0 : (relc > 30 ? 30 : relc); s[wt][i] = rp[relr * 31 + relcc]; } }
        __builtin_amdgcn_sched_barrier(0);
#pragma unroll
        for (int bt = 0; bt < 2; ++bt) {
            bf16x8 kf[16];
#pragma unroll
            for (int t = 0; t < 8; ++t) { const int wt = bt * 8 + t, kri = wt >> 1, half = wt & 1;
                const bf16* kp = KN + (size_t)(b * SEQ + (rs + kri) * 64 + span0 + 8 * (n >> 2) + 4 * half + (n & 3)) * GWD + h * 64 + 8 * q4; kf[2 * t] = ld_frag(kp); kf[2 * t + 1] = ld_frag(kp + 32); }
            __builtin_amdgcn_sched_barrier(0);
#pragma unroll
            for (int t = 0; t < 8; ++t) { const int wt = bt * 8 + t, half = wt & 1;
                f32x4 a = s[wt];
#pragma unroll
                for (int i = 0; i < 4; ++i) { const int kc = span0 + 8 * q4 + 4 * half + i; const bool ok = kc >= cs && kc < cs + 16; a[i] = ok ? a[i] : -INFINITY; }
                a = mfma16(kf[2 * t], qf[0], a); a = mfma16(kf[2 * t + 1], qf[1], a); s[wt] = a; }
            __builtin_amdgcn_sched_barrier(0);
        }
    }
#pragma unroll
    for (int bt = 0; bt < 2; ++bt) {
        bf16x8 kf[16];
#pragma unroll
        for (int t = 0; t < 8; ++t) { const int ctile = bt * 8 + t; const bf16* kp = KN + (size_t)(NLAT + b * CTXL + 32 * (ctile >> 1) + 8 * (n >> 2) + 4 * (ctile & 1) + (n & 3)) * GWD + h * 64 + 8 * q4; kf[2 * t] = ld_frag(kp); kf[2 * t + 1] = ld_frag(kp + 32); }
        __builtin_amdgcn_sched_barrier(0);
#pragma unroll
        for (int t = 0; t < 8; ++t) { f32x4 a = {0.f, 0.f, 0.f, 0.f}; a = mfma16(kf[2 * t], qf[0], a); a = mfma16(kf[2 * t + 1], qf[1], a); s[WT + bt * 8 + t] = a; }
        __builtin_amdgcn_sched_barrier(0);
    }
    float mx = -INFINITY;
#pragma unroll
    for (int t = 0; t < NT; ++t) mx = fmaxf(fmaxf(fmaxf(s[t][0], s[t][1]), fmaxf(s[t][2], s[t][3])), mx);
    mx = max16x4(mx);
    float sum = 0.f;
#pragma unroll
    for (int t = 0; t < NT; ++t) {
#pragma unroll
        for (int i = 0; i < 4; ++i) { const float e = __expf(s[t][i] - mx); s[t][i] = e; sum += e; } }
    sum = sum16x4(sum);
    const float inv = rcp_f(sum);
    f32x4 o[4];
#pragma unroll
    for (int nt = 0; nt < 4; ++nt) o[nt] = (f32x4){0.f, 0.f, 0.f, 0.f};
#pragma unroll
    for (int tb = 0; tb < NT / 8; ++tb) {
        v4u vv[4][4];
#pragma unroll
        for (int tq = 0; tq < 4; ++tq) { const int tp = tb * 4 + tq;
            const bf16* vb; size_t dstride;
            if (!CTXQ && tp < 8) { vb = VTL + ((size_t)(b * 16 + h) * 64 + n) * 8192 + (rs + tp) * 64 + span0 + 8 * q4; dstride = (size_t)16 * 8192; }
            else { const int cp = tp - (CTXQ ? 0 : 8); vb = VTC + ((size_t)(b * 16 + h) * 64 + n) * 256 + 32 * cp + 8 * q4; dstride = (size_t)16 * 256; }
#pragma unroll
            for (int nt = 0; nt < 4; ++nt) vv[tq][nt] = *(const v4u*)(vb + nt * dstride); }
        __builtin_amdgcn_sched_barrier(0);
#pragma unroll
        for (int tq = 0; tq < 4; ++tq) { const int tp = tb * 4 + tq;
            const f32x4 p0 = s[2 * tp] * inv, p1 = s[2 * tp + 1] * inv;
            v4u aw; aw.x = pk2(p0[0], p0[1]); aw.y = pk2(p0[2], p0[3]); aw.z = pk2(p1[0], p1[1]); aw.w = pk2(p1[2], p1[3]);
            const bf16x8 af = __builtin_bit_cast(bf16x8, aw);
#pragma unroll
            for (int nt = 0; nt < 4; ++nt) o[nt] = mfma16(af, __builtin_bit_cast(bf16x8, vv[tq][nt]), o[nt]); }
        __builtin_amdgcn_sched_barrier(0);
    }
    unsigned short zz[4][4];
#pragma unroll
    for (int nt = 0; nt < 4; ++nt)
#pragma unroll
        for (int i = 0; i < 4; ++i) zz[nt][i] = P[(size_t)(qrow0 + 4 * q4 + i) * NIN + C_NAZ + h * 64 + 16 * nt + n];
    __builtin_amdgcn_sched_barrier(0);
#pragma unroll
    for (int nt = 0; nt < 4; ++nt)
#pragma unroll
        for (int i = 0; i < 4; ++i) { const int row = qrow0 + 4 * q4 + i, col = h * 64 + 16 * nt + n;
            Y[(size_t)row * DM + 1024 + col] = (bf16)f2bf(o[nt][i] * silu_f(bf2f(zz[nt][i]))); }
}
__device__ __forceinline__ void bar4(LAS unsigned* cnt, unsigned& seq, int lane) {
    asm volatile("s_waitcnt vmcnt(0) lgkmcnt(0)" ::: "memory");
    const unsigned baddr = (unsigned)(size_t)cnt, one = 1u; seq += 4u;
    if (lane == 0) asm volatile("ds_add_u32 %0, %1" :: "v"(baddr), "v"(one) : "memory");
    unsigned sp = 0, got;
    for (;;) { asm volatile("ds_read_b32 %0, %1\n\ts_waitcnt lgkmcnt(0)" : "=v"(got) : "v"(baddr) : "memory");
        if (__builtin_amdgcn_readfirstlane((int)got) >= (int)seq) break; __builtin_amdgcn_s_sleep(1); if (++sp > (1u << 22)) break; }
    asm volatile("" ::: "memory");
}
__device__ __forceinline__ void phase_sgu4(const bf16* P, const f32x2* SGST, const float* lnw, const float* lnb, const bf16* SGW, const float* sgb, bf16* Y,
                                           LAS unsigned char* ldsT, LAS unsigned* cnt, int nchunks, int tid4  , int w4  , int lane) {
    const int n = lane & 15, q4 = lane >> 4;
    LAS bf16* T = (LAS bf16*)ldsT; unsigned seq = 0u;
    for (int u = blockIdx.x; u < nchunks * 8; u += 256) {
        const int ck = u >> 3, g = u & 7, m0 = ck * 128;
#pragma unroll
        for (int it = 0; it < 8; ++it) { const int idx = tid4 + 256 * it, q = idx >> 4, c8 = idx & 15;
            float x[8]; unpack8(*(const v4u*)(P + (size_t)(m0 + q) * NIN + C_SGV + g * 128 + 8 * c8), x);
            const f32x2 st = SGST[m0 + q];
#pragma unroll
            for (int j = 0; j < 8; ++j) { const int c = 8 * c8 + j; const float v = (x[j] - st.x) * st.y * lnw[g * 128 + c] + lnb[g * 128 + c]; T[c * 136 + q] = (bf16)f2bf(v); } }
        bar4(cnt, seq, lane);
#pragma unroll 1
        for (int mt = 0; mt < 2; ++mt) { const int mrow = 32 * w4 + 16 * mt;
            bf16x8 af[4];
#pragma unroll
            for (int ks = 0; ks < 4; ++ks) af[ks] = ld_frag(SGW + ((size_t)g * 128 + mrow + n) * 128 + 32 * ks + 8 * q4);
#pragma unroll
            for (int nt = 0; nt < 8; ++nt) {
                f32x4 acc = {0.f, 0.f, 0.f, 0.f};
#pragma unroll
                for (int ks = 0; ks < 4; ++ks) { const bf16x8 bfg = *(const LAS bf16x8*)(T + (16 * nt + n) * 136 + 32 * ks + 8 * q4); acc = mfma16(af[ks], bfg, acc); }
#pragma unroll
                for (int i = 0; i < 4; ++i) { const int p = mrow + 4 * q4 + i, row = m0 + p, col = g * 128 + 16 * nt + n;
                    const float mixed = acc[i] + sgb[g * 128 + p]; const bf16* pr = P + (size_t)row * NIN;
                    const float uu = bf2f(pr[C_SGU + col]), z = bf2f(pr[C_SGZ + col]);
                    Y[(size_t)row * DM + 3072 + col] = (bf16)f2bf(uu * mixed * silu_f(z)); }
            }
        }
        bar4(cnt, seq, lane);
    }
}
__device__ __forceinline__ void scan_self(const float* REC, float* YR, LAS unsigned char* lds, LAS unsigned* bcnt, int su, int wave, int lane) {
    constexpr int CS = 32, NCH = SCANLEN / CS, SLOT = CS * RECB, NPW = SLOT / 1024 / 4;
    const int chain = (su & 7) * 8 + ((su >> 3) >> 2), part = (su >> 3) & 3;
    const char* recb = (const char*)REC + (size_t)chain * SCANLEN * RECB;
    const int wl = wave;
#define SCAN_ISSUE(cc, sl) do { _Pragma("unroll") for (int p_ = 0; p_ < NPW; ++p_) \
    __builtin_amdgcn_global_load_lds((const unsigned*)(recb + (size_t)(cc) * SLOT + (wl * NPW + p_) * 1024 + lane * 16), (LAS unsigned*)(lds + (sl) * SLOT + (wl * NPW + p_) * 1024), 16, 0, 0); } while (0)
    __builtin_amdgcn_s_setprio(3);
    SCAN_ISSUE(0, 0); SCAN_ISSUE(1, 1);
    const int c16 = lane & 15, rg = lane >> 4, row = 16 * part + 4 * wave + rg;
    float S0 = 0.f, S1 = 0.f, S2 = 0.f, S3 = 0.f;
    float* yout = YR + (size_t)chain * SCANLEN * 64 + row;
    const int lo_w = c16 * 16, lo_h = 256 + c16 * 8, lo_v = 768 + row * 2;
#define SCAN_LD(dst, sl, s_) do { const LAS unsigned char* rec_ = (sl) + (s_) * RECB; dst##w = *(const LAS f32x4*)(rec_ + lo_w); dst##kk = *(const LAS h4*)(rec_ + lo_h); \
    dst##na = *(const LAS h4*)(rec_ + 128 + lo_h); dst##k = *(const LAS h4*)(rec_ + 256 + lo_h); dst##r = *(const LAS h4*)(rec_ + 384 + lo_h); dst##v = *(const LAS _Float16*)(rec_ + lo_v); } while (0)
#define FMX(a, b, c) __builtin_fmaf((a), (float)(b), (c))
    int sl = 0;
    for (int c = 0; c < NCH; ++c) {
        asm volatile("s_waitcnt vmcnt(7)" ::: "memory");
        {   const unsigned baddr = (unsigned)(size_t)bcnt, one = 1u;
            if (lane == 0) asm volatile("ds_add_u32 %0, %1" :: "v"(baddr), "v"(one) : "memory");
            const unsigned want = 4u * (unsigned)(c + 1); unsigned sp = 0, got;
            for (;;) { asm volatile("ds_read_b32 %0, %1\n\ts_waitcnt lgkmcnt(0)" : "=v"(got) : "v"(baddr) : "memory");
                if (__builtin_amdgcn_readfirstlane((int)got) >= (int)want) break; __builtin_amdgcn_s_sleep(1); if (++sp > (1u << 22)) break; } }
        asm volatile("" ::: "memory");
        {   const int cc = c + 2 < NCH ? c + 2 : NCH - 1; const int s2 = sl == 0 ? 2 : sl - 1; SCAN_ISSUE(cc, s2); }
        const LAS unsigned char* slot = lds + sl * SLOT;
        sl = sl == 2 ? 0 : sl + 1;
        float ysv0 = 0.f, ysv1 = 0.f; float yp[16];
        f32x4 Aw; h4 Akk, Ana, Ak, Ar, Pr; _Float16 Av;
        SCAN_LD(A, slot, 0);
#pragma unroll
        for (int s = 0; s < CS; ++s) {
            f32x4 Bw; h4 Bkk, Bna, Bk, Br; _Float16 Bv;
            if (s < CS - 1) SCAN_LD(B, slot, s + 1);
            __builtin_amdgcn_sched_barrier(0);
            if (s > 0) { float q0 = FMX(S0, Pr.x, 0.f), q1 = FMX(S2, Pr.z, 0.f); q0 = FMX(S1, Pr.y, q0); q1 = FMX(S3, Pr.w, q1); yp[(s - 1) & 15] = q0 + q1; }
            float p0 = FMX(S0, Akk.x, 0.f), p1 = FMX(S2, Akk.z, 0.f); p0 = FMX(S1, Akk.y, p0); p1 = FMX(S3, Akk.w, p1);
            const float dt = red16(p0 + p1);
            const float u0 = __builtin_fmaf(S0, Aw.x, FMX((float)Av, Ak.x, 0.f)), u1 = __builtin_fmaf(S1, Aw.y, FMX((float)Av, Ak.y, 0.f)),
                        u2 = __builtin_fmaf(S2, Aw.z, FMX((float)Av, Ak.z, 0.f)), u3 = __builtin_fmaf(S3, Aw.w, FMX((float)Av, Ak.w, 0.f));
            S0 = FMX(dt, Ana.x, u0); S1 = FMX(dt, Ana.y, u1); S2 = FMX(dt, Ana.z, u2); S3 = FMX(dt, Ana.w, u3);
            if (s == 16) ysv0 = red16_transpose(yp, c16);
            Pr = Ar;
            if (s < CS - 1) { Aw = Bw; Akk = Bkk; Ana = Bna; Ak = Bk; Ar = Br; Av = Bv; }
        }
        { float q0 = FMX(S0, Pr.x, 0.f), q1 = FMX(S2, Pr.z, 0.f); q0 = FMX(S1, Pr.y, q0); q1 = FMX(S3, Pr.w, q1); yp[15] = q0 + q1; }
        ysv1 = red16_transpose(yp, c16);
        asm volatile("" ::: "memory");
        yout[(size_t)(c * CS + c16) * 64] = ysv0; yout[(size_t)(c * CS + 16 + c16) * 64] = ysv1;
    }
    asm volatile("s_waitcnt vmcnt(0)" ::: "memory");
    __builtin_amdgcn_s_setprio(0);
#undef FMX
#undef SCAN_LD
#undef SCAN_ISSUE
}
__device__ __forceinline__ void phase_rwfin(const bf16* P, const float* YR, const float* REC, const float* BON, const float* lnw, const float* lnb, bf16* Y, int nrows, int gw, int NGW, int lane) {
    const int head = lane >> 2, sub = lane & 3;
    for (int m = gw; m < nrows; m += NGW) {
        const bool isctx = m >= NLAT; const int t = isctx ? ((m - NLAT) & 255) : (m & 8191); const int b = isctx ? ((m - NLAT) >> 8) : (m >> 13);
        float out[16];
#pragma unroll
        for (int i = 0; i < 16; ++i) out[i] = 0.f;
#pragma unroll
        for (int d = 0; d < 2; ++d) {
            const int chain = (b * 2 + d) * 16 + head; const size_t pp = (size_t)chain * SCANLEN + scan_pos(d, isctx, t);
            float y[16], v[16];
#pragma unroll
            for (int j = 0; j < 4; ++j) { const f32x4 a = *(const f32x4*)(YR + pp * 64 + 16 * sub + 4 * j); const h4 c = *(const h4*)((const char*)REC + pp * RECB + 768 + (16 * sub + 4 * j) * 2);
                y[4 * j] = a.x; y[4 * j + 1] = a.y; y[4 * j + 2] = a.z; y[4 * j + 3] = a.w; v[4 * j] = (float)c.x; v[4 * j + 1] = (float)c.y; v[4 * j + 2] = (float)c.z; v[4 * j + 3] = (float)c.w; }
            const float bo = BON[pp];
            float s = 0.f;
#pragma unroll
            for (int i = 0; i < 16; ++i) s += y[i];
            s += __shfl_xor(s, 1); s += __shfl_xor(s, 2);
            const float mean = s * (1.f / 64.f); float q = 0.f;
#pragma unroll
            for (int i = 0; i < 16; ++i) { const float dl = y[i] - mean; q += dl * dl; }
            q += __shfl_xor(q, 1); q += __shfl_xor(q, 2);
            const float rstd = rsq_f(q * (1.f / 64.f) + 64e-5f);
#pragma unroll
            for (int i = 0; i < 16; ++i) { const int ch = head * 64 + 16 * sub + i; out[i] += (y[i] - mean) * rstd * lnw[ch] + lnb[ch] + bo * v[i]; }
        }
        float z[16]; unpack8(*(const v4u*)(P + (size_t)m * NIN + C_RWZ + 16 * lane), z); unpack8(*(const v4u*)(P + (size_t)m * NIN + C_RWZ + 16 * lane + 8), z + 8);
#pragma unroll
        for (int i = 0; i < 16; ++i) out[i] *= silu_f(z[i]);
        *(v4u*)(Y + (size_t)m * DM + 2048 + 16 * lane) = pack8(out); *(v4u*)(Y + (size_t)m * DM + 2048 + 16 * lane + 8) = pack8(out + 8);
    }
}
#define XB_TMO      128
#define XB_XCNT(j)  (256  + 64 * (j))
#define XB_XSUB(j)  (1280 + 64 * (j))
#define XB_XGEN(j)  (2304 + 64 * (j))
#define XB_TOP      3328
#define XB_TOPGEN   3392
#define XCD_BAR_WORDS 3456
#define XB_SPIN_CAP (1u << 18)

__device__ __forceinline__ unsigned xb_ld(unsigned* p)              { return __hip_atomic_load(p, __ATOMIC_RELAXED, __HIP_MEMORY_SCOPE_AGENT); }
__device__ __forceinline__ unsigned xb_add(unsigned* p, unsigned v) { return __hip_atomic_fetch_add(p, v, __ATOMIC_RELAXED, __HIP_MEMORY_SCOPE_AGENT); }
__device__ __forceinline__ unsigned xb_xcc_id() { return (unsigned)__builtin_amdgcn_s_getreg((3 << 11) | 20) & 0xFu; }
#define XB_SPIN(cond, bar) do { unsigned _sp = 0; while (cond) { __builtin_amdgcn_s_sleep(1); \
    if ((++_sp & 255u) == 0u) { if (xb_ld(&(bar)[XB_TMO])) break; if (_sp > XB_SPIN_CAP) { atomicAdd(&(bar)[XB_TMO], 1u); break; } } } } while (0)

struct XcdBarrier {
    unsigned* bar; unsigned x;
    volatile LAS unsigned* st;
};

__device__ __forceinline__ XcdBarrier xcd_barrier_post(unsigned* bar, volatile LAS unsigned* st) {
    XcdBarrier b; b.bar = bar; b.x = xb_xcc_id(); b.st = st;
    if (threadIdx.x == 0) (void)xb_add(&bar[XB_XCNT(b.x)], 1u);
    return b;
}
__device__ __forceinline__ void xcd_barrier_complete(unsigned* bar, unsigned x, unsigned& nloc, unsigned& nx) {
    const unsigned G = gridDim.x * gridDim.y * gridDim.z;
    unsigned sum, cnt, mine, sp = 0u;
    for (;;) {
        sum = 0u; cnt = 0u; mine = 0u;
#pragma unroll
        for (unsigned j = 0; j < 16; ++j) { const unsigned c = xb_ld(&bar[XB_XCNT(j)]); sum += c; cnt += (c > 0u) ? 1u : 0u; mine = (j == x) ? c : mine; }
        if (sum == G) break;
        __builtin_amdgcn_s_sleep(1);
        if ((++sp & 255u) == 0u) { if (xb_ld(&bar[XB_TMO])) break; if (sp > XB_SPIN_CAP) { atomicAdd(&bar[XB_TMO], 1u); break; } }
    }
    nloc = mine > 0u ? mine : 1u; nx = cnt > 0u ? cnt : 1u;
}

__device__ __forceinline__ void xcd_barrier(const XcdBarrier& b) {
    asm volatile("s_waitcnt vmcnt(0)" ::: "memory");
    __syncthreads();
    if (threadIdx.x == 0) {
        unsigned* bar = b.bar;
        __builtin_amdgcn_s_waitcnt(0);
        unsigned nloc = b.st[0], nx = b.st[1];
        if (nloc == 0u) { xcd_barrier_complete(bar, b.x, nloc, nx); b.st[0] = nloc; b.st[1] = nx; }
        const unsigned old = xb_add(&bar[XB_XSUB(b.x)], 1u);
        const unsigned gen = old / nloc;
        if (old + 1u == (gen + 1u) * nloc) {
            __builtin_amdgcn_fence(__ATOMIC_RELEASE, "agent");
            asm volatile("s_waitcnt vmcnt(0)" ::: "memory");
            const unsigned og = xb_add(&bar[XB_TOP], 1u);
            const unsigned tg = og / nx;
            if (og + 1u == (tg + 1u) * nx) xb_add(&bar[XB_TOPGEN], 1u);
            else XB_SPIN(xb_ld(&bar[XB_TOPGEN]) == tg, bar);
            __builtin_amdgcn_fence(__ATOMIC_ACQUIRE, "agent");
            xb_add(&bar[XB_XGEN(b.x)], 1u);
            asm volatile("s_waitcnt vmcnt(0)" ::: "memory");
        } else {
            XB_SPIN(xb_ld(&bar[XB_XGEN(b.x)]) == gen, bar);
            __builtin_amdgcn_fence(__ATOMIC_ACQUIRE, "agent");
            asm volatile("s_waitcnt vmcnt(0)" ::: "memory");
        }
    }
    __syncthreads();
}

#ifndef MK_SPLIT
#define MK_SPLIT 0
#endif
constexpr int PPL = 6;
constexpr int NPHASE = 2 + PPL * DEPTH;
constexpr int RWP_BLOCKS = 14;
constexpr int CW_RWQ = 16384;
constexpr int NGRID = 256;
struct Args { const float* in[28]; float* out; unsigned char* ws; int ph_lo, ph_hi, li, pad; };

__global__ void __launch_bounds__(NWAVES * 64, 2) fwd(Args args) {
    extern __shared__ __attribute__((aligned(16))) unsigned char lds_raw[];
    LAS unsigned char* lds = (LAS unsigned char*)lds_raw;
    volatile LAS unsigned* MISC = (volatile LAS unsigned*)(lds + MISC_OFF);
    const int tid = threadIdx.x, lane = tid & 63, wave = __builtin_amdgcn_readfirstlane(tid >> 6);
    constexpr int G = NGRID; const int bx = blockIdx.x;
    const int vcu = (bx % 8) * (G / 8) + bx / 8;
    const int gw = vcu * NWAVES + wave; constexpr int NGW = G * NWAVES;
    unsigned char* ws = args.ws;
    const int lo = args.ph_lo, hi = args.ph_hi;

    for (int u = tid; u < (LDS_BYTES - LDSCTL_OFF) / 4; u += NWAVES * 64) ((LAS unsigned*)(lds + LDSCTL_OFF))[u] = 0u;
    __syncthreads();
    XcdBarrier bar; bar.bar = (unsigned*)(ws + WS_CTL) + CW_BAR; bar.x = 0; bar.st = MISC + 8;
    if (hi - lo > 1) bar = xcd_barrier_post((unsigned*)(ws + WS_CTL) + CW_BAR, MISC + 8);
#define IN(k) (lo <= (k) && (k) < hi)
#define SEAM(k) do { if (lo <= (k) && (k) + 1 < hi) { XcdBarrier b2_; b2_.bar = WSP(unsigned, WS_CTL) + CW_BAR; b2_.x = bar.x; b2_.st = bar.st; xcd_barrier(b2_); } } while (0)

#define OPQ_S(x) ({ int _t = (x); asm volatile("" : "+s"(_t)); _t; })
#define OPQ_V(x) ({ int _t = (x); asm volatile("" : "+v"(_t)); _t; })
#define INP(i) (args.in[OPQ_S(i)])
#define WSP(T, off) ((T*)(args.ws + ({ size_t _o = (off); asm volatile("" : "+s"(_o)); _o; })))
#define x_in INP(0)
#define c_in INP(1)
#define ctx_in INP(2)
#define cctx_in INP(3)
#define w_mod INP(4)
#define b_mod INP(5)
#define w_in INP(6)
#define w_out INP(7)
#define pool_w INP(8)
#define pool_scale INP(9)
#define na_qg INP(10)
#define na_kg INP(11)
#define na_rpb INP(12)
#define rw_mu_rkv INP(13)
#define rw_mu_lora INP(14)
#define rw_w0 INP(15)
#define rw_w_up INP(16)
#define rw_a0 INP(17)
#define rw_a_up INP(18)
#define rw_k_k INP(19)
#define rw_k_a INP(20)
#define rw_r_k INP(21)
#define rw_ln_w INP(22)
#define rw_ln_b INP(23)
#define sg_ln_w INP(24)
#define sg_ln_b INP(25)
#define sg_w INP(26)
#define sg_b INP(27)
#define MOD WSP(float, WS_MOD)
#define MODP WSP(float, WS_MODP)
#define TAB WSP(f32x2, WS_TAB)
#define SGST WSP(f32x2, WS_SGST)
#define BON WSP(float, WS_BON)
#define POOLWT WSP(bf16, WS_POOLWT)
#define WUPT WSP(bf16, WS_WUPT)
#define AUPT WSP(bf16, WS_AUPT)
#define SGW WSP(bf16, WS_SGW)
#define VTC WSP(bf16, WS_VTC)
#define VTL WSP(bf16, WS_VTL)
#define HCTX WSP(float, WS_HCTX)
#define QN WSP(bf16, WS_QN)
#define KN WSP(bf16, WS_KN)
#define WOUTT WSP(bf16, WS_WOUTT)
#define WINT WSP(bf16, WS_WINT)
#define XN WSP(bf16, WS_XN)
#define Y WSP(bf16, WS_Y)
#define P WSP(bf16, WS_P)
#define YR WSP(float, WS_YR)
#define REC WSP(float, WS_REC)
    float* const out = args.out;

    if (IN(0)) {
        LAS float* scr = (LAS float*)(lds + wave * 16384);
        constexpr int I_MOD = 4 * 64 * 48, I_WIN = 64 * (NIN / 32), I_WOUT = 64 * 128, I_POOL = 4 * 32, I_WUP = 2 * 32, I_AUP = 2 * 32, I_SGW = 256;
        constexpr int NITEMS = I_MOD + I_WIN + I_WOUT + I_POOL + I_WUP + I_AUP + I_SGW;
        for (int it = gw; it < NITEMS; it += NGW) {
            int r = it;
            if (r < I_MOD) { p0_mod_item(w_mod, c_in, cctx_in, MODP, scr, r, lane); continue; } r -= I_MOD;
            if (r < I_WIN) { p0_transpose_item<true>(w_in, DM, NIN, WINT, scr, r, lane); continue; } r -= I_WIN;
            if (r < I_WOUT) { p0_transpose_item(w_out, DM, DM, WOUTT, scr, r, lane); continue; } r -= I_WOUT;
            if (r < I_POOL) { const int g = r / 32; p0_transpose_item(pool_w + (size_t)g * 65536, 256, 256, POOLWT + (size_t)g * 65536, scr, r % 32, lane); continue; } r -= I_POOL;
            if (r < I_WUP) { const int dd = r / 32; p0_transpose_item(rw_w_up + (size_t)dd * 65536, 64, 1024, WUPT + (size_t)dd * 65536, scr, r % 32, lane); continue; } r -= I_WUP;
            if (r < I_AUP) { const int dd = r / 32; p0_transpose_item(rw_a_up + (size_t)dd * 65536, 64, 1024, AUPT + (size_t)dd * 65536, scr, r % 32, lane); continue; } r -= I_AUP;
            {   const size_t e0 = (size_t)r * 512 + lane * 8; const f32x4 a = *(const f32x4*)(sg_w + e0), b = *(const f32x4*)(sg_w + e0 + 4);
                v4u o; o.x = pk2(a.x, a.y); o.y = pk2(a.z, a.w); o.z = pk2(b.x, b.y); o.w = pk2(b.z, b.w); *(v4u*)(SGW + e0) = o; }
        }
        SEAM(0);
    }
    if (IN(1)) {

        for (int idx = gw * 64 + lane; idx < 4 * 3 * 12288; idx += NGW * 64) {
            const int l = idx / 36864, c = (idx / 12288) % 3, n = idx % 12288;
            float s = b_mod[l * 12288 + n];
            const float* pp = MODP + ((size_t)(l * 64) * 3 + c) * 12288 + n;
#pragma unroll 8
            for (int kc = 0; kc < 64; ++kc) s += pp[(size_t)kc * 3 * 12288];
            MOD[idx] = s;
        }
        for (int idx = gw * 64 + lane; idx < 2048; idx += NGW * 64) {
            const int pos = idx >> 4, i = idx & 15;
            float inv = (i & 3) == 0 ? 1.0f : ((i & 3) == 1 ? 0.5623413251903491f : ((i & 3) == 2 ? 0.31622776601683794f : 0.17782794100389228f));
            inv *= (i >> 2) == 0 ? 1.0f : ((i >> 2) == 1 ? 0.1f : ((i >> 2) == 2 ? 0.01f : 0.001f));
            float cc, sn; sincos_acc((float)pos * inv, cc, sn);
            TAB[idx] = (f32x2){cc, sn};
        }
        SEAM(1);
    }
    for (int l = 0; l < DEPTH; ++l) {
        const int pb = 2 + PPL * l;
        const bool with_ctx = l < DEPTH - 1;
#define hin_lat (l == 0 ? x_in : (const float*)out)
#define hin_ctx (l == 0 ? ctx_in : (const float*)HCTX)
#define mod (MOD + (size_t)l * 3 * 12288)
        const int nrows = with_ctx ? MROWS : NLAT;
        if (IN(pb + 0)) {
            phase_xn(hin_lat, hin_ctx, mod, XN, OPQ_S(gw), NGW, OPQ_V(lane));
            SEAM(pb + 0);
        }
        if (IN(pb + 1)) {
            constexpr int C0 = C_SPLIT, NA_ = NIN - C0;
            pg8::Gemm g{XN, WINT + (size_t)l * NIN * DM + (size_t)C0 * DM, MROWS, NA_, DM}; pg8::StaticOrder S; S.init(MROWS, NA_, G, bx);
            pg8::EpiStoreBf16 E{P + C0, NIN};
            pg8::gemm_phase<pg8::EpiStoreBf16, pg8::StaticOrder, true, true>(lds, g, S, E);
            SEAM(pb + 1);
        }
        if (IN(pb + 2)) {
            if (bx >= RWP_BLOCKS) {
                constexpr int NB_ = C_SPLIT;
                pg8::Gemm g{XN, WINT + (size_t)l * NIN * DM, MROWS, NB_, DM}; pg8::StaticOrder S; S.init(MROWS, NB_, G - RWP_BLOCKS, bx - RWP_BLOCKS);
                pg8::EpiStoreBf16 E{P, NIN};
                pg8::gemm_phase<pg8::EpiStoreBf16, pg8::StaticOrder, true, true>(lds, g, S, E);
            }
            phase_rwprep(P, rw_mu_rkv + (size_t)l * 6144, rw_mu_lora + (size_t)l * 256, rw_w0 + (size_t)l * 2048, WUPT + (size_t)l * 131072, rw_a0 + (size_t)l * 2048, AUPT + (size_t)l * 131072,
                         rw_k_k + (size_t)l * 1024, rw_k_a + (size_t)l * 1024, rw_r_k + (size_t)l * 1024, REC, BON, lds, WSP(unsigned, WS_CTL) + CW_RWQ + l * 1024, (bx * NWAVES + wave) & 15, wave, OPQ_V(lane));
            phase_rowprep(P, na_qg + l * 64, na_kg + l * 64, TAB, QN, KN, SGST, OPQ_S(gw), NGW, OPQ_V(lane));
            phase_vt(P, VTL, VTC, OPQ_S(gw), NGW, OPQ_V(lane));
            SEAM(pb + 2);
        }
        if (IN(pb + 3)) {
            {
            LAS unsigned* mixq = (LAS unsigned*)(lds + LDSCTL_OFF + 64); LAS unsigned* mixb = (LAS unsigned*)(lds + LDSCTL_OFF + 128); LAS unsigned* mixs = (LAS unsigned*)(lds + LDSCTL_OFF + 192);
            if (tid == 0) { *mixq = 0u; *mixb = 0u; *mixs = 0u; }
            __syncthreads();
            if (wave < 4) scan_self(REC, YR, lds, mixb, bx, wave, OPQ_V(lane));
            else phase_sgu4(P, SGST, sg_ln_w + (size_t)l * 1024, sg_ln_b + (size_t)l * 1024, SGW + (size_t)l * 131072, sg_b + (size_t)l * 1024, Y, lds + 3 * 28672, mixs, nrows / 128, OPQ_V(tid) - 256, wave - 4, OPQ_V(lane));
            {   const int nctxu = with_ctx ? 2 : 0, npool = (nrows / 16) * 4, npq = (npool + NGRID - 1) / NGRID, nwc = l + 1 < DEPTH ? (WC_ITEMS + NGRID - 1) / NGRID : 0, nq = 64 + nctxu + npq + nwc;
                for (;;) {
                    unsigned k = 0; if (lane == 0) k = __hip_atomic_fetch_add(mixq, 1u, __ATOMIC_RELAXED, __HIP_MEMORY_SCOPE_WORKGROUP);
                    k = (unsigned)__builtin_amdgcn_readfirstlane((int)k);
                    if ((int)k >= nq) break;
                    const int ln = OPQ_V(lane);
                    if (k < 64u) { na_unit<false>(QN, KN, VTL, VTC, P, na_rpb + (size_t)l * 16 * 15 * 31, Y, bx * 64 + (int)k, ln);
                    }
                    else if ((int)k < 64 + nctxu) na_unit<true>(QN, KN, VTL, VTC, P, na_rpb, Y, bx * 2 + ((int)k - 64), ln);
                    else if ((int)k >= 64 + nctxu + npq) { const int r = bx + NGRID * ((int)k - 64 - nctxu - npq);
                        if (r < WC_ITEMS) weight_copy_item(l + 1, r, w_in, w_out, pool_w, rw_w_up, rw_a_up, sg_w, WINT, WOUTT, POOLWT, WUPT, AUPT, SGW, ln); }
                    else { const int u = bx + NGRID * ((int)k - 64 - nctxu);
                        if (u < npool) { const int tt = u >> 2, g = u & 3; const bf16* wbase = POOLWT + (size_t)l * 262144 + (size_t)g * 65536; const float* psc = pool_scale + (size_t)l * 1024;
                            if (g == 0) pool_unit<0>(P, wbase, psc, Y, tt * 16, ln); else if (g == 1) pool_unit<1>(P, wbase, psc, Y, tt * 16, ln);
                            else if (g == 2) pool_unit<2>(P, wbase, psc, Y, tt * 16, ln); else pool_unit<3>(P, wbase, psc, Y, tt * 16, ln); } }
                }
            }
            }
            SEAM(pb + 3);
        }
        if (IN(pb + 4)) {
            phase_rwfin(P, YR, REC, BON, rw_ln_w + (size_t)l * 1024, rw_ln_b + (size_t)l * 1024, Y, nrows, OPQ_S(gw), NGW, OPQ_V(lane));
            SEAM(pb + 4);
        }
        if (IN(pb + 5)) {
            pg8::Gemm g{Y, WOUTT + (size_t)l * DM * DM, nrows, DM, DM}; pg8::StaticOrder S; S.init(nrows, DM, G, bx);
            pg8::EpiResGate E{hin_lat, hin_ctx, out, HCTX, mod};
            pg8::gemm_phase<pg8::EpiResGate, pg8::StaticOrder, true, true>(lds, g, S, E);
            SEAM(pb + 5);
        }
    }
#undef IN
#undef SEAM
}
#undef hin_lat
#undef hin_ctx
#undef mod
#undef P
#undef Y
#undef XN
#undef out

extern "C" void kernel_launch(void* const* d_in, const int* in_sizes, int n_in, void* d_out, int out_size, void* d_ws, size_t ws_size, hipStream_t stream) {
    static int grid = 0;
    if (grid == 0) {
        if (n_in != 28 || out_size != NLAT * DM || ws_size < WS_END) { fprintf(stderr, "kernel_launch: unexpected shapes (n_in %d, out %d, ws %zu < %zu); nothing launched\n", n_in, out_size, ws_size, (size_t)WS_END); grid = -1; return; }
        int dev = 0, cus = 0, per_cu = 0;
        if (hipGetDevice(&dev) != hipSuccess || hipDeviceGetAttribute(&cus, hipDeviceAttributeMultiprocessorCount, dev) != hipSuccess) { grid = -1; return; }
        if (hipFuncSetAttribute((const void*)fwd, hipFuncAttributeMaxDynamicSharedMemorySize, LDS_BYTES) != hipSuccess) { fprintf(stderr, "kernel_launch: hipFuncSetAttribute failed\n"); grid = -1; return; }
        if (hipOccupancyMaxActiveBlocksPerMultiprocessor(&per_cu, (const void*)fwd, NWAVES * 64, LDS_BYTES) != hipSuccess || per_cu < 1)
            fprintf(stderr, "kernel_launch: note: occupancy query reports %d workgroups per CU\n", per_cu);
        (void)hipGetLastError();
        grid = cus >= NGRID ? NGRID : -2;
    }
    if (grid == -1) return;
    if (hipMemsetAsync((char*)d_ws + WS_CTL, 0, CTL_ZERO_BYTES, stream) != hipSuccess) { fprintf(stderr, "kernel_launch: memset failed\n"); return; }
    Args a{};
    for (int i = 0; i < 28; ++i) a.in[i] = (const float*)d_in[i];
    a.out = (float*)d_out; a.ws = (unsigned char*)d_ws; a.li = 0; a.pad = 0;
    const bool split = MK_SPLIT || grid == -2;
    if (split) { for (int k = 0; k < NPHASE; ++k) { a.ph_lo = k; a.ph_hi = k + 1; hipLaunchKernelGGL(fwd, dim3(NGRID), dim3(NWAVES * 64), LDS_BYTES, stream, a); } }
    else { a.ph_lo = 0; a.ph_hi = NPHASE; hipLaunchKernelGGL(fwd, dim3(NGRID), dim3(NWAVES * 64), LDS_BYTES, stream, a); }
    const hipError_t le = hipPeekAtLastError();
    if (le != hipSuccess) fprintf(stderr, "kernel_launch: launch failed: %s\n", hipGetErrorName(le));
}
```

```cpp
#include <hip/hip_runtime.h>
#include <cstdio>
#include <cstdint>
#define MK_SPLIT 0
namespace pg8 {
#define PG8_LAS __attribute__((address_space(3)))
typedef unsigned short bf16_t;
typedef short bf16x8 __attribute__((ext_vector_type(8)));
typedef float f32x4 __attribute__((ext_vector_type(4)));
typedef unsigned u32x4 __attribute__((ext_vector_type(4)));
constexpr int BM = 256, BK = 64, HALF = 128, HTB = HALF * BK * 2  , STAGE_BYTES = 8 * HTB, NXCD = 8, WGM = 8;

__host__ __device__ __forceinline__ int lds_byte(int r, int c) { const int st = (r >> 4) * 2 + (c >> 5), rr = r & 15, cc = c & 31, ob = rr * 64 + cc * 2; return st * 1024 + (ob ^ (((ob >> 9) & 1) << 5)); }
__host__ __device__ __forceinline__ void stage_rc(int b, int& R, int& C) { const int st = b / 1024, sb = b % 1024, swz = sb ^ (((sb >> 9) & 1) << 5); R = (st >> 1) * 16 + swz / 64; C = (st & 1) * 32 + (swz % 64) / 2; }
__host__ __device__ __forceinline__ int perm32(int rho) { const int n = rho >> 4, i = rho & 15; return 8 * (i >> 2) + 4 * n + (i & 3); }

struct Unit { int pm, pn; };
struct Gemm { const bf16_t* A; const bf16_t* Bt; int M, N, K; };

struct StaticOrder {
    int nM, nN, nwg, G, c;
    __host__ __device__ void init(int M, int N, int G_, int c_) { nM = M / BM; nN = N / BM; nwg = nM * nN; G = G_; c = c_; }
    __host__ __device__ bool next(int i, Unit& u) const {
        const long L = (long)i * G + c; if (L >= nwg) return false;
        int wgid = (int)L; { const int q = nwg / NXCD, r = nwg % NXCD, xcd = wgid % NXCD, off = wgid / NXCD; wgid = (xcd < r ? xcd * (q + 1) : r * (q + 1) + (xcd - r) * q) + off; }
        const int nig = WGM * nN, gid = wgid / nig, fm = gid * WGM, gsz = (nM - fm) < WGM ? (nM - fm) : WGM;
        u.pm = fm + ((wgid % nig) % gsz); u.pn = (wgid % nig) / gsz; return true;
    }
    __device__ __forceinline__ void a_ready(const Unit&) const {}
    __device__ __forceinline__ void done(const Unit&) const {}
};

__device__ __forceinline__ unsigned cvt_pk_bf16(float lo, float hi) { unsigned r; asm volatile("v_cvt_pk_bf16_f32 %0, %1, %2" : "=v"(r) : "v"(lo), "v"(hi)); return r; }
template <class Epi, class Sched, bool ALIGN_EPI = false, bool SP2 = false>
__device__ __forceinline__ void gemm_phase(PG8_LAS unsigned char* lds, const Gemm g, const Sched& S, const Epi& E) {
    int tid_ = threadIdx.x; asm volatile("" : "+v"(tid_));
    const int tid = tid_, wid = __builtin_amdgcn_readfirstlane(tid >> 6), lane = tid & 63, wr = wid >> 2, wc = wid & 3, fr = lane & 15, fq = lane >> 4;
    const int K = g.K, nt = K / BK;
    unsigned voffA[2], voffB[2];
#pragma unroll
    for (int i = 0; i < 2; ++i) { int R, C; stage_rc(tid * 16 + i * 8192, R, C); const int Rb = Epi::PERM ? ((R & ~31) + perm32(R & 31)) : R;
        voffA[i] = (unsigned)(R * K + C) * 2u; voffB[i] = (unsigned)(Rb * K + C) * 2u; }
    const size_t kstep = (size_t)(BK * 2);
    const size_t hstep = (size_t)HALF * K * 2;
    const size_t tstep = 2 * hstep;
    const unsigned ldsw = (unsigned)wid * 1024u;
    const int aoff = lds_byte(wr * 64 + fr, fq * 8), boff = lds_byte(wc * 32 + fr, fq * 8);
#define PG8_SA(b, h) (((b) * 2 + (h)) * HTB)
#define PG8_SB(b, h) ((4 + (b) * 2 + (h)) * HTB)
#define PG8_STAGE(bufoff, gbase, voff) do { _Pragma("unroll") for (int _i = 0; _i < 2; ++_i) \
        __builtin_amdgcn_global_load_lds((const unsigned*)((const char*)(gbase) + (voff)[_i]), (PG8_LAS unsigned*)(lds + (bufoff) + ldsw + _i * 8192), 16, 0, 0); } while (0)
#define PG8_LDA(dst, b, h) do { _Pragma("unroll") for (int m = 0; m < 4; ++m) _Pragma("unroll") for (int k = 0; k < 2; ++k) dst[m][k] = *(const PG8_LAS bf16x8*)(lds + PG8_SA(b, h) + aoff + m * 2048 + k * 1024); } while (0)
#define PG8_LDB(dst, b, h) do { _Pragma("unroll") for (int n = 0; n < 2; ++n) _Pragma("unroll") for (int k = 0; k < 2; ++k) dst[n][k] = *(const PG8_LAS bf16x8*)(lds + PG8_SB(b, h) + boff + n * 2048 + k * 1024); } while (0)
#define PG8_MMA(ai, bj, At, Bt) do { __builtin_amdgcn_s_setprio(1); _Pragma("unroll") for (int m = 0; m < 4; ++m) _Pragma("unroll") for (int n = 0; n < 2; ++n) _Pragma("unroll") for (int k = 0; k < 2; ++k) \
        acc[ai][bj][m][n] = __builtin_amdgcn_mfma_f32_16x16x32_bf16(Bt[n][k], At[m][k], acc[ai][bj][m][n], 0, 0, 0); __builtin_amdgcn_s_setprio(0); } while (0)
#define PG8_WAIT_V(n) asm volatile("s_waitcnt vmcnt(" #n ")" ::: "memory")
#define PG8_WAIT_L(n) asm volatile("s_waitcnt lgkmcnt(" #n ")" ::: "memory")
#define PG8_BAR __builtin_amdgcn_s_barrier()
#define PG8_SCHED __builtin_amdgcn_sched_barrier(0)
    Unit cur, nxt; int ui = 0;
    if (!S.next(0, cur)) return;
    f32x4 acc[2][2][4][2];
#pragma unroll
    for (int a = 0; a < 2; ++a)
#pragma unroll
        for (int b = 0; b < 2; ++b)
#pragma unroll
            for (int m = 0; m < 4; ++m)
#pragma unroll
                for (int n = 0; n < 2; ++n) acc[a][b][m][n] = (f32x4){0.f, 0.f, 0.f, 0.f};
    bf16x8 At[4][2], B0[2][2], B1[2][2];
    const char* cA = (const char*)g.A + (size_t)cur.pm * tstep; const char* cB = (const char*)g.Bt + (size_t)cur.pn * tstep;
    S.a_ready(cur);
    if constexpr (SP2) {
        PG8_STAGE(PG8_SB(0, 0), cB, voffB); PG8_STAGE(PG8_SB(0, 1), cB + hstep, voffB); PG8_STAGE(PG8_SA(0, 0), cA, voffA); PG8_STAGE(PG8_SA(0, 1), cA + hstep, voffA);
        if (wr == 1) PG8_BAR;
        PG8_WAIT_V(2); PG8_BAR;
        PG8_STAGE(PG8_SB(1, 0), cB + kstep, voffB); PG8_STAGE(PG8_SA(1, 0), cA + kstep, voffA); PG8_STAGE(PG8_SB(1, 1), cB + hstep + kstep, voffB);
        PG8_WAIT_V(6); PG8_BAR;
    } else {
        PG8_STAGE(PG8_SB(0, 0), cB, voffB); PG8_STAGE(PG8_SA(0, 0), cA, voffA); PG8_STAGE(PG8_SB(0, 1), cB + hstep, voffB); PG8_STAGE(PG8_SA(0, 1), cA + hstep, voffA);
        if (wr == 1) PG8_BAR;
        PG8_WAIT_V(4); PG8_BAR;
        PG8_STAGE(PG8_SB(1, 0), cB + kstep, voffB); PG8_STAGE(PG8_SA(1, 0), cA + kstep, voffA); PG8_STAGE(PG8_SB(1, 1), cB + hstep + kstep, voffB);
        PG8_WAIT_V(6); PG8_BAR;
    }
    for (;;) {
        const bool has_next = S.next(ui + 1, nxt);
        const char* nA = has_next ? (const char*)g.A + (size_t)nxt.pm * tstep : cA; const char* nB = has_next ? (const char*)g.Bt + (size_t)nxt.pn * tstep : cB;
        for (int t = 0; t < nt; t += 2) {
            const bool last = (t == nt - 2);
            const char* a1 = cA + (size_t)(t + 1) * kstep;
            const char* a2 = last ? nA : cA + (size_t)(t + 2) * kstep; const char* b2 = last ? nB : cB + (size_t)(t + 2) * kstep;
            const char* a3 = a2 + kstep; const char* b3 = b2 + kstep;
            if (last && has_next) S.a_ready(nxt);
            if constexpr (SP2) {
            PG8_LDB(B0, 0, 0); PG8_LDB(B1, 0, 1); PG8_SCHED; PG8_LDA(At, 0, 0); PG8_STAGE(PG8_SA(1, 1), a1 + hstep, voffA);
            PG8_WAIT_V(8); PG8_WAIT_L(0); PG8_BAR; PG8_MMA(0, 0, At, B0); PG8_MMA(0, 1, At, B1); PG8_BAR; PG8_SCHED;
            PG8_LDA(At, 0, 1); PG8_STAGE(PG8_SB(0, 0), b2, voffB); PG8_STAGE(PG8_SB(0, 1), b2 + hstep, voffB); PG8_STAGE(PG8_SA(0, 0), a2, voffA);
            PG8_WAIT_V(8); PG8_WAIT_L(0); PG8_BAR; PG8_MMA(1, 0, At, B0); PG8_MMA(1, 1, At, B1); PG8_BAR; PG8_SCHED;
            PG8_LDB(B0, 1, 0); PG8_LDB(B1, 1, 1); PG8_SCHED; PG8_LDA(At, 1, 0); PG8_STAGE(PG8_SA(0, 1), a2 + hstep, voffA);
            PG8_WAIT_V(8); PG8_WAIT_L(0); PG8_BAR; PG8_MMA(0, 0, At, B0); PG8_MMA(0, 1, At, B1); PG8_BAR; PG8_SCHED;
            PG8_LDA(At, 1, 1); PG8_STAGE(PG8_SB(1, 0), b3, voffB); PG8_STAGE(PG8_SB(1, 1), b3 + hstep, voffB); PG8_STAGE(PG8_SA(1, 0), a3, voffA);
            PG8_WAIT_V(8); PG8_WAIT_L(0); PG8_BAR; PG8_MMA(1, 0, At, B0); PG8_MMA(1, 1, At, B1); PG8_BAR; PG8_SCHED;
            } else {
            PG8_LDB(B0, 0, 0); PG8_SCHED; PG8_LDA(At, 0, 0); PG8_STAGE(PG8_SA(1, 1), a1 + hstep, voffA);
            PG8_WAIT_L(8); PG8_BAR; PG8_WAIT_L(0); PG8_MMA(0, 0, At, B0); PG8_BAR; PG8_SCHED;
            PG8_LDB(B1, 0, 1); PG8_STAGE(PG8_SB(0, 0), b2, voffB);
            PG8_BAR; PG8_WAIT_L(0); PG8_MMA(0, 1, At, B1); PG8_BAR;
            PG8_LDA(At, 0, 1); PG8_STAGE(PG8_SA(0, 0), a2, voffA);
            PG8_BAR; PG8_WAIT_L(0); PG8_MMA(1, 0, At, B0); PG8_BAR; PG8_SCHED;
            PG8_STAGE(PG8_SB(0, 1), b2 + hstep, voffB);
            PG8_WAIT_V(6); PG8_BAR; PG8_MMA(1, 1, At, B1); PG8_BAR;
            PG8_LDB(B0, 1, 0); PG8_SCHED; PG8_LDA(At, 1, 0); PG8_STAGE(PG8_SA(0, 1), a2 + hstep, voffA);
            PG8_WAIT_L(8); PG8_BAR; PG8_WAIT_L(0); PG8_MMA(0, 0, At, B0); PG8_BAR; PG8_SCHED;
            PG8_LDB(B1, 1, 1); PG8_STAGE(PG8_SB(1, 0), b3, voffB);
            PG8_BAR; PG8_WAIT_L(0); PG8_MMA(0, 1, At, B1); PG8_BAR;
            PG8_LDA(At, 1, 1); PG8_STAGE(PG8_SA(1, 0), a3, voffA);
            PG8_BAR; PG8_WAIT_L(0); PG8_MMA(1, 0, At, B0); PG8_BAR; PG8_SCHED;
            PG8_STAGE(PG8_SB(1, 1), b3 + hstep, voffB);
            PG8_WAIT_V(6); PG8_BAR; PG8_MMA(1, 1, At, B1); PG8_BAR;
            }
        }
        if constexpr (ALIGN_EPI) { if (wr == 0) PG8_BAR; }
        if constexpr (!Epi::AFTER_DRAIN) { E(acc, cur, wr, wc, fr, fq); S.done(cur); }
        if (!has_next) break;
#pragma unroll
        for (int a = 0; a < 2; ++a)
#pragma unroll
            for (int b = 0; b < 2; ++b)
#pragma unroll
                for (int m = 0; m < 4; ++m)
#pragma unroll
                    for (int n = 0; n < 2; ++n) acc[a][b][m][n] = (f32x4){0.f, 0.f, 0.f, 0.f};
        cur = nxt; cA = nA; cB = nB; ++ui;
        if constexpr (ALIGN_EPI) { if (wr == 1) PG8_BAR; }
    }
    PG8_WAIT_V(0);
    if constexpr (!ALIGN_EPI) { if (wr == 0) PG8_BAR; }
    PG8_BAR;
    if constexpr (Epi::AFTER_DRAIN) { E.fused(acc, cur, wr, wc, fr, fq, lds, wid, lane); S.done(cur); }
#undef PG8_SA
#undef PG8_SB
#undef PG8_STAGE
#undef PG8_LDA
#undef PG8_LDB
#undef PG8_MMA
#undef PG8_WAIT_V
#undef PG8_WAIT_L
#undef PG8_BAR
#undef PG8_SCHED
}
}

constexpr int DM = 4096, NBATCH = 2, SEQ = 8192, DEPTH = 4, CTXL = 256;
constexpr int NLAT = NBATCH * SEQ, NCTX = NBATCH * CTXL, MROWS = NLAT + NCTX;
constexpr int NIN = 13568, GWD = 1024;
constexpr int C_POOLV = 0, C_POOLZ = 1024, C_NAZ = 2048, C_RWZ = 3072, C_SGU = 4096, C_SGZ = 5120, C_NAQ = 6144, C_NAK = 7168, C_NAV = 8192, C_RWR = 9216, C_RWK = 10240, C_RWV = 11264,
              C_RWWD = 12288, C_RWAD = 12416, C_SGV = 12544;
constexpr int C_SPLIT = 5632;
__host__ __device__ __forceinline__ int phys_tile(int lt) {
    return lt < 8 ? lt : lt < 20 ? lt + 16 : lt < 24 ? lt - 12 : lt < 36 ? lt + 12 : lt < 40 ? lt - 24 : lt == 40 ? 48 : lt < 45 ? lt - 25 : lt < 49 ? lt + 4 : lt - 29;
}
constexpr int SCANLEN = CTXL + SEQ;
constexpr int NCHAIN = 64;
constexpr int RECB = 896;
constexpr int RECF = RECB / 4;
constexpr int NWAVES = 8;

constexpr size_t MiB = 1u << 20;
constexpr size_t WS_CTL = 0, CTL_ZERO_BYTES = 1 * MiB;
constexpr size_t WS_MOD   = 2 * MiB;
constexpr size_t WS_TAB   = 3 * MiB;
constexpr size_t WS_SILUC = 3 * MiB + 512 * 1024;
constexpr size_t WS_SGST  = 4 * MiB;
constexpr size_t WS_BON   = 5 * MiB;
constexpr size_t WS_POOLWT= 8 * MiB;
constexpr size_t WS_WUPT  = 10 * MiB;
constexpr size_t WS_AUPT  = 11 * MiB;
constexpr size_t WS_SGW   = 12 * MiB;
constexpr size_t WS_VTC   = 13 * MiB;
constexpr size_t WS_HCTX  = 14 * MiB;
constexpr size_t WS_MODP  = 22 * MiB;
constexpr size_t WS_VTL   = 58 * MiB;
constexpr size_t WS_QN    = 90 * MiB;
constexpr size_t WS_KN    = 123 * MiB;
constexpr size_t WS_WOUTT = 156 * MiB;
constexpr size_t WS_WINT  = 284 * MiB;
constexpr size_t WS_XN    = 708 * MiB;
constexpr size_t WS_Y     = 840 * MiB;
constexpr size_t WS_P     = 972 * MiB;
constexpr size_t WS_YR    = 1410 * MiB;
constexpr size_t WS_REC   = 1542 * MiB;
constexpr size_t WS_END   = 2334 * MiB;
static_assert(WS_P + (size_t)MROWS * NIN * 2 <= WS_YR && WS_REC + (size_t)NCHAIN * SCANLEN * RECB <= WS_END && WS_WINT + (size_t)4 * NIN * DM * 2 <= WS_XN, "ws map");
constexpr int CW_TMO = 0, CW_BAR = 4096;

constexpr int RING_BYTES = 131072, LDSCTL_OFF = RING_BYTES, MISC_OFF = LDSCTL_OFF + 320, LDS_BYTES = 147456;

#define GAS __attribute__((address_space(1)))
#define LAS __attribute__((address_space(3)))
typedef unsigned short bf16;
typedef unsigned v4u __attribute__((ext_vector_type(4)));
typedef unsigned v2u __attribute__((ext_vector_type(2)));
typedef float f32x4 __attribute__((ext_vector_type(4)));
typedef float f32x2 __attribute__((ext_vector_type(2)));
typedef short bf16x8 __attribute__((ext_vector_type(8)));
typedef _Float16 h4 __attribute__((ext_vector_type(4)));
typedef _Float16 h8 __attribute__((ext_vector_type(8)));
#define RLX_AGENT __ATOMIC_RELAXED, __HIP_MEMORY_SCOPE_AGENT
#define LDS_WAIT() asm volatile("s_waitcnt lgkmcnt(0)" ::: "memory")

__device__ __forceinline__ float bf2f(unsigned short h) { return __uint_as_float(((unsigned)h) << 16); }
__device__ __forceinline__ float bflo(unsigned w) { return __uint_as_float(w << 16); }
__device__ __forceinline__ float bfhi(unsigned w) { return __uint_as_float(w & 0xffff0000u); }
typedef __bf16 bf16x2_t __attribute__((ext_vector_type(2)));
__device__ __forceinline__ unsigned pk2(float lo, float hi) { const f32x2 v = {lo, hi}; const bf16x2_t b = __builtin_convertvector(v, bf16x2_t); return __builtin_bit_cast(unsigned, b); }
__device__ __forceinline__ unsigned f2bf(float f) { return pk2(f, 0.f) & 0xffffu; }
__device__ __forceinline__ float rcp_f(float x) { return __builtin_amdgcn_rcpf(x); }
__device__ __forceinline__ float rsq_f(float x) { return __builtin_amdgcn_rsqf(x); }
__device__ __forceinline__ void unpack8(const v4u w, float* x) { x[0] = bflo(w.x); x[1] = bfhi(w.x); x[2] = bflo(w.y); x[3] = bfhi(w.y); x[4] = bflo(w.z); x[5] = bfhi(w.z); x[6] = bflo(w.w); x[7] = bfhi(w.w); }
__device__ __forceinline__ v4u pack8(const float* x) { v4u w; w.x = pk2(x[0], x[1]); w.y = pk2(x[2], x[3]); w.z = pk2(x[4], x[5]); w.w = pk2(x[6], x[7]); return w; }
__device__ __forceinline__ float silu_f(float x) { return x * rcp_f(1.f + __expf(-x)); }
__device__ __forceinline__ float wave_sum(float v) {
#pragma unroll
    for (int o = 1; o < 64; o <<= 1) v += __shfl_xor(v, o);
    return v;
}
template <int CTRL> __device__ __forceinline__ float dppf(float v) { return __builtin_bit_cast(float, __builtin_amdgcn_update_dpp(0, __builtin_bit_cast(int, v), CTRL, 0xF, 0xF, true)); }
__device__ __forceinline__ float red16(float v) { v += dppf<0xB1>(v); v += dppf<0x4E>(v); v += dppf<0x141>(v); v += dppf<0x140>(v); return v; }
__device__ __forceinline__ void red16x2(float& a, float& b) {
    a += dppf<0xB1>(a); b += dppf<0xB1>(b); a += dppf<0x4E>(a); b += dppf<0x4E>(b); a += dppf<0x141>(a); b += dppf<0x141>(b); a += dppf<0x140>(a); b += dppf<0x140>(b); }
__device__ __forceinline__ float red16_transpose(const float (&y)[16], int c16) {
    float a[8], b[4], c[2];
    const bool h8 = (c16 & 8) != 0, h4 = (c16 & 4) != 0, h2 = (c16 & 2) != 0, h1 = (c16 & 1) != 0;
#pragma unroll
    for (int j = 0; j < 8; ++j) { const float keep = h8 ? y[j + 8] : y[j], send = h8 ? y[j] : y[j + 8]; a[j] = keep + dppf<0x140>(send); }
#pragma unroll
    for (int j = 0; j < 4; ++j) { const float keep = h4 ? a[j + 4] : a[j], send = h4 ? a[j] : a[j + 4]; b[j] = keep + dppf<0x141>(send); }
#pragma unroll
    for (int j = 0; j < 2; ++j) { const float keep = h2 ? b[j + 2] : b[j], send = h2 ? b[j] : b[j + 2]; c[j] = keep + dppf<0x1B>(send); }
    const float keep = h1 ? c[1] : c[0], send = h1 ? c[0] : c[1];
    return keep + dppf<0xB1>(send);
}
__device__ __forceinline__ float max16x4(float v) { v = fmaxf(v, __shfl_xor(v, 16)); v = fmaxf(v, __shfl_xor(v, 32)); return v; }
__device__ __forceinline__ float sum16x4(float v) { v += __shfl_xor(v, 16); v += __shfl_xor(v, 32); return v; }
__device__ __forceinline__ int scan_pos(int d, bool isctx, int t) { return d == 0 ? (isctx ? t : CTXL + t) : (isctx ? (CTXL - 1 - t) : (CTXL + SEQ - 1 - t)); }
__device__ __forceinline__ f32x4 mfma16(bf16x8 a, bf16x8 b, f32x4 c) { return __builtin_amdgcn_mfma_f32_16x16x32_bf16(a, b, c, 0, 0, 0); }
__device__ __forceinline__ bf16x8 ld_frag(const bf16* p) { return __builtin_bit_cast(bf16x8, *(const v4u*)p); }

namespace pg8 {
struct EpiStoreBf16 {
    static constexpr bool PERM = true, AFTER_DRAIN = false;
    bf16_t* O; int ldc;
    __device__ __forceinline__ void operator()(const f32x4 (&acc)[2][2][4][2], const Unit& u, int wr, int wc, int fr, int fq) const {
        const int row0 = u.pm * BM + wr * 64 + fr, col0 = u.pn * BM + wc * 32 + 8 * fq;
#pragma unroll
        for (int ai = 0; ai < 2; ++ai)
#pragma unroll
            for (int m = 0; m < 4; ++m) { bf16_t* rowp = O + (size_t)(row0 + ai * HALF + m * 16) * ldc + col0;
#pragma unroll
                for (int bj = 0; bj < 2; ++bj) { const f32x4 v0 = acc[ai][bj][m][0], v1 = acc[ai][bj][m][1];
                    u32x4 w; w.x = cvt_pk_bf16(v0[0], v0[1]); w.y = cvt_pk_bf16(v0[2], v0[3]); w.z = cvt_pk_bf16(v1[0], v1[1]); w.w = cvt_pk_bf16(v1[2], v1[3]);
                    *(u32x4*)(rowp + bj * HALF) = w; } }
    }
};
struct EpiResGate {
    static constexpr bool PERM = false, AFTER_DRAIN = false;
    const float* hin_lat; const float* hin_ctx; float* hout_lat; float* hout_ctx; const float* gate;
    __device__ __forceinline__ void operator()(const f32x4 (&acc)[2][2][4][2], const Unit& u, int wr, int wc, int fr, int fq) const {
        const int cond = u.pm < 32 ? 0 : (u.pm < 64 ? 1 : 2);
        const int rloc = (u.pm < 64 ? u.pm * BM : (u.pm - 64) * BM) + wr * 64 + fr, col0 = u.pn * BM + wc * 32 + 4 * fq;
        const float* hin = u.pm < 64 ? hin_lat : hin_ctx; float* hout = u.pm < 64 ? hout_lat : hout_ctx;
        f32x4 gv[2][2];
#pragma unroll
        for (int bj = 0; bj < 2; ++bj)
#pragma unroll
            for (int n = 0; n < 2; ++n) gv[bj][n] = *(const f32x4*)(gate + cond * 12288 + 8192 + col0 + bj * HALF + n * 16);
#pragma unroll
        for (int ai = 0; ai < 2; ++ai)
#pragma unroll
            for (int m = 0; m < 4; ++m) { const size_t off = (size_t)(rloc + ai * HALF + m * 16) * 4096 + col0;
#pragma unroll
                for (int bj = 0; bj < 2; ++bj)
#pragma unroll
                    for (int n = 0; n < 2; ++n) { const f32x4 b = *(const f32x4*)(hin + off + bj * HALF + n * 16);
                        *(f32x4*)(hout + off + bj * HALF + n * 16) = b + gv[bj][n] * acc[ai][bj][m][n]; } }
    }
};
}

template <bool PERMC = false>
__device__ __forceinline__ void p0_transpose_item(const float* W, int K, int N, bf16* WT, LAS float* scr, int item, int lane) {
    const int nblk = N / 32, kb = item / nblk, nb = item % nblk, k0 = 64 * kb, n0 = 32 * nb;
    const int pn0 = PERMC ? phys_tile(n0 >> 8) * 256 + (n0 & 255) : n0;
#pragma unroll 8
    for (int i = 0; i < 32; ++i) { const int kk = 2 * i + (lane >> 5); scr[kk * 33 + (lane & 31)] = W[(size_t)(k0 + kk) * N + n0 + (lane & 31)]; }
    LDS_WAIT(); asm volatile("" ::: "memory");
    const int c = lane & 7;
#pragma unroll
    for (int j = 0; j < 4; ++j) { const int n = (lane >> 3) + 8 * j; const LAS float* s = scr + (8 * c) * 33 + n;
        v4u o; o.x = pk2(s[0 * 33], s[1 * 33]); o.y = pk2(s[2 * 33], s[3 * 33]); o.z = pk2(s[4 * 33], s[5 * 33]); o.w = pk2(s[6 * 33], s[7 * 33]);
        *(v4u*)(WT + (size_t)(pn0 + n) * K + k0 + 8 * c) = o; }
    LDS_WAIT(); asm volatile("" ::: "memory");
}
template <bool PERMC = false>
__device__ __forceinline__ void transpose_item_nolds(const float* W, int K, int N, bf16* WT, int item, int lane) {
    const int nblk = N / 64, kb = item / nblk, nb = item % nblk, k0 = 64 * kb, n0 = 64 * nb;
    const int pn0 = PERMC ? phys_tile(n0 >> 8) * 256 + (n0 & 255) : n0;
    const float* src = W + (size_t)k0 * N + n0 + lane;
    bf16* dst = WT + (size_t)(pn0 + lane) * K + k0;
#pragma unroll
    for (int hb = 0; hb < 2; ++hb) {
        float v[32];
#pragma unroll
        for (int i = 0; i < 32; ++i) v[i] = src[(size_t)(32 * hb + i) * N];
        __builtin_amdgcn_sched_barrier(0);
#pragma unroll
        for (int j = 0; j < 4; ++j) { v4u o; o.x = pk2(v[8 * j], v[8 * j + 1]); o.y = pk2(v[8 * j + 2], v[8 * j + 3]); o.z = pk2(v[8 * j + 4], v[8 * j + 5]); o.w = pk2(v[8 * j + 6], v[8 * j + 7]);
            *(v4u*)(dst + 32 * hb + 8 * j) = o; }
        __builtin_amdgcn_sched_barrier(0);
    }
}
constexpr int WC_WIN = (DM / 64) * (NIN / 64), WC_WOUT = (DM / 64) * (DM / 64), WC_POOL = 4 * 16, WC_WUP = 2 * 16, WC_AUP = 2 * 16, WC_SGW = 256, WC_ITEMS = WC_WIN + WC_WOUT + WC_POOL + WC_WUP + WC_AUP + WC_SGW;
__device__ __forceinline__ void weight_copy_item(int L, int r, const float* w_in, const float* w_out, const float* pool_w, const float* rw_w_up, const float* rw_a_up, const float* sg_w,
                                                 bf16* WINT, bf16* WOUTT, bf16* POOLWT, bf16* WUPT, bf16* AUPT, bf16* SGW, int lane) {
    if (r < WC_WIN) { transpose_item_nolds<true>(w_in + (size_t)L * DM * NIN, DM, NIN, WINT + (size_t)L * NIN * DM, r, lane); return; } r -= WC_WIN;
    if (r < WC_WOUT) { transpose_item_nolds(w_out + (size_t)L * DM * DM, DM, DM, WOUTT + (size_t)L * DM * DM, r, lane); return; } r -= WC_WOUT;
    if (r < WC_POOL) { const int g = r >> 4; transpose_item_nolds(pool_w + (size_t)(L * 4 + g) * 65536, 256, 256, POOLWT + (size_t)(L * 4 + g) * 65536, r & 15, lane); return; } r -= WC_POOL;
    if (r < WC_WUP) { const int dd = r >> 4; transpose_item_nolds(rw_w_up + (size_t)(L * 2 + dd) * 65536, 64, 1024, WUPT + (size_t)(L * 2 + dd) * 65536, r & 15, lane); return; } r -= WC_WUP;
    if (r < WC_AUP) { const int dd = r >> 4; transpose_item_nolds(rw_a_up + (size_t)(L * 2 + dd) * 65536, 64, 1024, AUPT + (size_t)(L * 2 + dd) * 65536, r & 15, lane); return; } r -= WC_AUP;
    {   const size_t e0 = (size_t)L * 131072 + (size_t)r * 512 + lane * 8; const f32x4 a = *(const f32x4*)(sg_w + e0), b = *(const f32x4*)(sg_w + e0 + 4);
        v4u o; o.x = pk2(a.x, a.y); o.y = pk2(a.z, a.w); o.z = pk2(b.x, b.y); o.w = pk2(b.z, b.w); *(v4u*)(SGW + e0) = o; }
}
__device__ __forceinline__ void p0_mod_item(const float* wmod, const float* cvec, const float* cctx, float* MODP, LAS float* scr, int item, int lane) {
    const int l = item / (64 * 48), r = item % (64 * 48), kc = r / 48, nc = r % 48, k0 = kc * 64, n0 = nc * 256 + lane * 4;
    scr[lane] = silu_f(cvec[k0 + lane]); scr[64 + lane] = silu_f(cvec[4096 + k0 + lane]); scr[128 + lane] = silu_f(cctx[k0 + lane]);
    LDS_WAIT(); asm volatile("" ::: "memory");
    f32x4 a0 = {0.f, 0.f, 0.f, 0.f}, a1 = a0, a2 = a0;
    const float* wp = wmod + ((size_t)l * 4096 + k0) * 12288 + n0;
#pragma unroll 16
    for (int k = 0; k < 64; ++k) { const f32x4 w = *(const f32x4*)(wp + (size_t)k * 12288); a0 += scr[k] * w; a1 += scr[64 + k] * w; a2 += scr[128 + k] * w; }
    float* o = MODP + ((size_t)(l * 64 + kc) * 3) * 12288 + n0;
    *(f32x4*)(o) = a0; *(f32x4*)(o + 12288) = a1; *(f32x4*)(o + 2 * 12288) = a2;
    LDS_WAIT(); asm volatile("" ::: "memory");
}
__device__ __forceinline__ void mod_item_nolds(const float* wmod_l  , const float* siluc, float* MODP_l  , int item, int lane) {
    const int kc = item / 48, nc = item % 48, k0 = kc * 64, n0 = nc * 256 + lane * 4;
    f32x4 a0 = {0.f, 0.f, 0.f, 0.f}, a1 = a0, a2 = a0;
    const float* wp = wmod_l + (size_t)k0 * 12288 + n0;
    const int s0v = __builtin_bit_cast(int, siluc[k0 + lane]), s1v = __builtin_bit_cast(int, siluc[4096 + k0 + lane]), s2v = __builtin_bit_cast(int, siluc[8192 + k0 + lane]);
#pragma unroll
    for (int k = 0; k < 64; ++k) { const f32x4 w = *(const f32x4*)(wp + (size_t)k * 12288);
        a0 += __builtin_bit_cast(float, __builtin_amdgcn_readlane(s0v, k)) * w; a1 += __builtin_bit_cast(float, __builtin_amdgcn_readlane(s1v, k)) * w; a2 += __builtin_bit_cast(float, __builtin_amdgcn_readlane(s2v, k)) * w; }
    float* o = MODP_l + ((size_t)kc * 3) * 12288 + n0;
    *(f32x4*)(o) = a0; *(f32x4*)(o + 12288) = a1; *(f32x4*)(o + 2 * 12288) = a2;
}
__device__ __forceinline__ void sincos_acc(float ang, float& c, float& s) {
    const double x = (double)ang; const double n = __builtin_rint(x * 0.63661977236758134308); const double r = x - n * 1.57079632679489661923;
    const double r2 = r * r;
    const double sp = r * (1.0 + r2 * (-1.0 / 6 + r2 * (1.0 / 120 + r2 * (-1.0 / 5040 + r2 * (1.0 / 362880 + r2 * (-1.0 / 39916800 + r2 * (1.0 / 6227020800.0)))))));
    const double cp = 1.0 + r2 * (-0.5 + r2 * (1.0 / 24 + r2 * (-1.0 / 720 + r2 * (1.0 / 40320 + r2 * (-1.0 / 3628800 + r2 * (1.0 / 479001600 + r2 * (-1.0 / 87178291200.0)))))));
    const int q = ((int)n) & 3;
    const double cc = (q == 0) ? cp : (q == 1) ? -sp : (q == 2) ? -cp : sp;
    const double ss = (q == 0) ? sp : (q == 1) ? cp : (q == 2) ? -sp : -cp;
    c = (float)cc; s = (float)ss;
}

__device__ __forceinline__ void phase_xn(const float* hlat, const float* hctx, const float* mod, bf16* XN, int gw, int NGW, int lane) {
    for (int m = gw; m < MROWS; m += NGW) {
        const float* src = m < NLAT ? hlat + (size_t)m * DM : hctx + (size_t)(m - NLAT) * DM;
        const int cond = m < NLAT ? (m >> 13) : 2;
        const f32x4* s4 = (const f32x4*)src + lane;
        f32x4 v[16]; float ss = 0.f;
#pragma unroll
        for (int j = 0; j < 16; ++j) { v[j] = s4[64 * j]; ss += (v[j].x * v[j].x + v[j].y * v[j].y) + (v[j].z * v[j].z + v[j].w * v[j].w); }
        ss = wave_sum(ss);
        const float rstd = rsq_f(ss * (1.f / 4096.f) + 1e-6f);
        const f32x4* sh4 = (const f32x4*)(mod + cond * 12288) + lane; const f32x4* sc4 = (const f32x4*)(mod + cond * 12288 + 4096) + lane;
        v2u* o = (v2u*)(XN + (size_t)m * DM) + lane;
#pragma unroll
        for (int j = 0; j < 16; ++j) { const f32x4 sh = sh4[64 * j], sc = sc4[64 * j]; const f32x4 x = v[j] * rstd * (sc + 1.f) + sh; v2u w; w.x = pk2(x.x, x.y); w.y = pk2(x.z, x.w); o[64 * j] = w; }
    }
}

__device__ __forceinline__ void phase_rowprep(const bf16* P, const float* qgain, const float* kgain, const f32x2* tab, bf16* QN, bf16* KN, f32x2* SGST, int gw, int NGW, int lane) {
    const int sub = lane & 3;
    for (int m = gw; m < MROWS; m += NGW) {
        const bf16* pr = P + (size_t)m * NIN;
        const bool isctx = m >= NLAT; const int t = isctx ? ((m - NLAT) & 255) : (m & 8191);
        {   float x[16]; unpack8(*(const v4u*)(pr + C_SGV + 16 * lane), x); unpack8(*(const v4u*)(pr + C_SGV + 16 * lane + 8), x + 8);
            float s = 0.f;
#pragma unroll
            for (int i = 0; i < 16; ++i) s += x[i];
            const float mean = wave_sum(s) * (1.f / 1024.f); float q = 0.f;
#pragma unroll
            for (int i = 0; i < 16; ++i) { const float dlt = x[i] - mean; q += dlt * dlt; }
            const float var = wave_sum(q) * (1.f / 1024.f);
            if (lane == 0) SGST[m] = (f32x2){mean, rsq_f(var + 1e-5f)}; }
        float q[16], k[16];
        unpack8(*(const v4u*)(pr + C_NAQ + 16 * lane), q); unpack8(*(const v4u*)(pr + C_NAQ + 16 * lane + 8), q + 8);
        unpack8(*(const v4u*)(pr + C_NAK + 16 * lane), k); unpack8(*(const v4u*)(pr + C_NAK + 16 * lane + 8), k + 8);
        float sq = 0.f, sk = 0.f;
#pragma unroll
        for (int i = 0; i < 16; ++i) { sq += q[i] * q[i]; sk += k[i] * k[i]; }
        sq += __shfl_xor(sq, 1); sq += __shfl_xor(sq, 2); sk += __shfl_xor(sk, 1); sk += __shfl_xor(sk, 2);
        const float rq = rsq_f(sq * (1.f / 64.f) + 1e-6f), rk = rsq_f(sk * (1.f / 64.f) + 1e-6f);
#pragma unroll
        for (int i = 0; i < 16; ++i) { q[i] *= rq * qgain[16 * sub + i]; k[i] *= rk * kgain[16 * sub + i]; }
        if (!isctx) {
            const int pos = sub < 2 ? (t >> 6) : (t & 63);
#pragma unroll
            for (int i = 0; i < 16; ++i) { const f32x2 cs = tab[pos * 16 + i]; const float pq = __shfl_xor(q[i], 1), pkk = __shfl_xor(k[i], 1);
                q[i] = (sub & 1) ? (q[i] * cs.x + pq * cs.y) : (q[i] * cs.x - pq * cs.y);
                k[i] = (sub & 1) ? (k[i] * cs.x + pkk * cs.y) : (k[i] * cs.x - pkk * cs.y); }
        }
#pragma unroll
        for (int i = 0; i < 16; ++i) q[i] *= 0.125f;
        *(v4u*)(QN + (size_t)m * GWD + 16 * lane) = pack8(q); *(v4u*)(QN + (size_t)m * GWD + 16 * lane + 8) = pack8(q + 8);
        *(v4u*)(KN + (size_t)m * GWD + 16 * lane) = pack8(k); *(v4u*)(KN + (size_t)m * GWD + 16 * lane + 8) = pack8(k + 8);
    }
}
__device__ __forceinline__ void phase_vt(const bf16* P, bf16* VTL, bf16* VTC, int gw, int NGW, int lane) {
    for (int u = gw; u < (MROWS / 64) * 16; u += NGW) {
        const int tt = u >> 4, h = u & 15, m0 = tt * 64;
        const bf16* src = P + (size_t)m0 * NIN + C_NAV + h * 64 + lane;
        unsigned w[32];
#pragma unroll
        for (int i = 0; i < 32; ++i) { const unsigned lo = src[(size_t)(2 * i) * NIN], hi = src[(size_t)(2 * i + 1) * NIN]; w[i] = lo | (hi << 16); }
        bf16* dst = tt < 256 ? VTL + (((size_t)((tt >> 7) * 16 + h) * 64 + lane) * 8192 + (tt & 127) * 64)
                             : VTC + (((size_t)(((tt - 256) >> 2) * 16 + h) * 64 + lane) * 256 + ((tt - 256) & 3) * 64);
#pragma unroll
        for (int j = 0; j < 8; ++j) { v4u o; o.x = w[4 * j]; o.y = w[4 * j + 1]; o.z = w[4 * j + 2]; o.w = w[4 * j + 3]; ((v4u*)dst)[j] = o; }
    }
}
template <int G>
__device__ __forceinline__ void pool_unit(const bf16* P, const bf16* wbase, const float* pscale, bf16* Y, int m0, int lane) {
    constexpr int WIN = 2 << G;
    const int r = lane & 15, q4 = lane >> 4, m = m0 + r;
    const bool isctx = m0 >= NLAT; const int T = isctx ? CTXL : SEQ; const int t = isctx ? ((m - NLAT) & 255) : (m & 8191);
    const int tlo = t - (WIN >> 1);
    const int lo = tlo < 0 ? 0 : tlo, hi = (tlo + WIN) > T ? T : (tlo + WIN);
    const float inv = rcp_f((float)(hi - lo));
    f32x4 acc[16];
#pragma unroll
    for (int nt = 0; nt < 16; ++nt) acc[nt] = (f32x4){0.f, 0.f, 0.f, 0.f};
#pragma unroll 1
    for (int ks = 0; ks < 8; ++ks) {
        const int ch0 = C_POOLV + G * 256 + 32 * ks + 8 * q4;
        constexpr int WB = WIN < 8 ? WIN : 8;
        bf16x8 bfr[8];
        float sum[8];
#pragma unroll
        for (int j = 0; j < 8; ++j) sum[j] = 0.f;
        const v4u selfw = *(const v4u*)(P + (size_t)m * NIN + ch0);
#pragma unroll
        for (int nt = 0; nt < 8; ++nt) bfr[nt] = ld_frag(wbase + (size_t)(16 * nt + r) * 256 + 32 * ks + 8 * q4);
#pragma unroll
        for (int k0 = 0; k0 < WIN; k0 += WB) {
            v4u wl[WB];
#pragma unroll
            for (int k = 0; k < WB; ++k) { const int tk = tlo + k0 + k; const bool ok = tk >= 0 && tk < T; wl[k] = *(const v4u*)(P + (size_t)(ok ? (m - t + tk) : m) * NIN + ch0); }
            __builtin_amdgcn_sched_barrier(0);
#pragma unroll
            for (int k = 0; k < WB; ++k) { const int tk = tlo + k0 + k; const bool ok = tk >= 0 && tk < T; float x[8]; unpack8(wl[k], x);
#pragma unroll
                for (int j = 0; j < 8; ++j) sum[j] += ok ? x[j] : 0.f; }
            __builtin_amdgcn_sched_barrier(0);
        }
        float self[8]; unpack8(selfw, self);
        float dv[8];
#pragma unroll
        for (int j = 0; j < 8; ++j) dv[j] = sum[j] * inv - self[j];
        const bf16x8 af = __builtin_bit_cast(bf16x8, pack8(dv));
        __builtin_amdgcn_sched_barrier(0);
        bf16x8 bfr2[8];
#pragma unroll
        for (int nt = 0; nt < 8; ++nt) bfr2[nt] = ld_frag(wbase + (size_t)(16 * (nt + 8) + r) * 256 + 32 * ks + 8 * q4);
        __builtin_amdgcn_sched_barrier(0);
#pragma unroll
        for (int nt = 0; nt < 8; ++nt) acc[nt] = mfma16(af, bfr[nt], acc[nt]);
        __builtin_amdgcn_sched_barrier(0);
#pragma unroll
        for (int nt = 0; nt < 8; ++nt) acc[nt + 8] = mfma16(af, bfr2[nt], acc[nt + 8]);
        __builtin_amdgcn_sched_barrier(0);
    }
#pragma unroll
    for (int nh = 0; nh < 4; ++nh) {
        unsigned short zz[4][4]; float ps[4];
#pragma unroll
        for (int nq = 0; nq < 4; ++nq) { const int oc = G * 256 + 16 * (4 * nh + nq) + r; ps[nq] = pscale[oc];
#pragma unroll
            for (int i = 0; i < 4; ++i) zz[nq][i] = P[(size_t)(m0 + 4 * q4 + i) * NIN + C_POOLZ + oc]; }
        __builtin_amdgcn_sched_barrier(0);
#pragma unroll
        for (int nq = 0; nq < 4; ++nq) { const int oc = G * 256 + 16 * (4 * nh + nq) + r;
#pragma unroll
            for (int i = 0; i < 4; ++i) Y[(size_t)(m0 + 4 * q4 + i) * DM + oc] = (bf16)f2bf(acc[4 * nh + nq][i] * ps[nq] * silu_f(bf2f(zz[nq][i]))); }
        __builtin_amdgcn_sched_barrier(0);
    }
}
__device__ __forceinline__ void phase_pool(const bf16* P, const bf16* PWT  , const float* pscale, bf16* Y, int nrows, int gw, int NGW, int lane) {
    for (int u = gw; u < (nrows / 16) * 4; u += NGW) {
        const int tt = u >> 2, g = u & 3, m0 = tt * 16;
        const bf16* wbase = PWT + (size_t)g * 65536;
        if (g == 0) pool_unit<0>(P, wbase, pscale, Y, m0, lane);
        else if (g == 1) pool_unit<1>(P, wbase, pscale, Y, m0, lane);
        else if (g == 2) pool_unit<2>(P, wbase, pscale, Y, m0, lane);
        else pool_unit<3>(P, wbase, pscale, Y, m0, lane);
    }
}
#define REC_ST(p, v) __builtin_nontemporal_store((v), (p))
__device__ __forceinline__ void phase_rwprep(const bf16* P, const float* mu_rkv  , const float* mu_lora  , const float* w0  , const bf16* WUPT  ,
                                             const float* a0, const bf16* AUPT, const float* k_k, const float* k_a, const float* r_k, float* REC, float* BON, LAS unsigned char* lds,
                                             unsigned* queue  , int cls, int wave, int lane) {
    const int n = lane & 15, q4 = lane >> 4;
    const int d = cls >> 3, hp = cls & 7;
    unsigned* qh = queue + 64 * cls;
    LAS float* prm = (LAS float*)(lds + wave * 4096);
#pragma unroll
    for (int it = 0; it < 16; ++it) { const int hh = it >> 3, p = it & 7, ch = (hp * 2 + hh) * 64 + lane;
        const float* src = p == 0 ? w0 + d * 1024 : p == 1 ? a0 + d * 1024 : p == 2 ? mu_rkv + (d * 3 + 0) * 1024 : p == 3 ? mu_rkv + (d * 3 + 1) * 1024 : p == 4 ? mu_rkv + (d * 3 + 2) * 1024 : p == 5 ? k_k : p == 6 ? k_a : r_k;
        prm[it * 64 + lane] = src[ch]; }
    LDS_WAIT(); asm volatile("" ::: "memory");
    unsigned pend = 0u;
    if (lane == 0) pend = __hip_atomic_fetch_add(qh, 1u, __ATOMIC_RELAXED, __HIP_MEMORY_SCOPE_AGENT);
    for (;;) {
        const int tt = __builtin_amdgcn_readfirstlane((int)pend);
        if (tt >= MROWS / 16) break;
        if (lane == 0) pend = __hip_atomic_fetch_add(qh, 1u, __ATOMIC_RELAXED, __HIP_MEMORY_SCOPE_AGENT);
        const int m0 = tt * 16;
        const bool isctx = m0 >= NLAT; const int T = isctx ? CTXL : SEQ; const int t0 = isctx ? ((m0 - NLAT) & 255) : (m0 & 8191); const int b = isctx ? ((m0 - NLAT) >> 8) : (m0 >> 13);
        const int m = m0 + n, t = t0 + n; const bool hasnb = d == 0 ? (t > 0) : (t < T - 1); const int nbr = hasnb ? (d == 0 ? m - 1 : m + 1) : m;
        const bf16* prow = P + (size_t)m * NIN; const bf16* nrow = P + (size_t)nbr * NIN;
        bf16x8 Bw[2], Ba[2];
        {   v4u cw[2], nw[2], ca[2], na[2]; f32x4 mw[2][2], ma[2][2];
#pragma unroll
            for (int ks = 0; ks < 2; ++ks) { const int j0 = 32 * ks + 8 * q4;
                cw[ks] = *(const v4u*)(prow + C_RWWD + d * 64 + j0); nw[ks] = *(const v4u*)(nrow + C_RWWD + d * 64 + j0);
                ca[ks] = *(const v4u*)(prow + C_RWAD + d * 64 + j0); na[ks] = *(const v4u*)(nrow + C_RWAD + d * 64 + j0);
                mw[ks][0] = *(const f32x4*)(mu_lora + (d * 2 + 0) * 64 + j0); mw[ks][1] = *(const f32x4*)(mu_lora + (d * 2 + 0) * 64 + j0 + 4);
                ma[ks][0] = *(const f32x4*)(mu_lora + (d * 2 + 1) * 64 + j0); ma[ks][1] = *(const f32x4*)(mu_lora + (d * 2 + 1) * 64 + j0 + 4); }
            __builtin_amdgcn_sched_barrier(0);
#pragma unroll
            for (int ks = 0; ks < 2; ++ks) {
                float cur[8], nb[8], o[8];
                unpack8(cw[ks], cur); unpack8(nw[ks], nb);
#pragma unroll
                for (int j = 0; j < 8; ++j) { const float xx = cur[j] + ((hasnb ? nb[j] : 0.f) - cur[j]) * mw[ks][j >> 2][j & 3]; o[j] = 1.0f - 2.0f * rcp_f(1.0f + __expf(2.0f * xx)); }
                Bw[ks] = __builtin_bit_cast(bf16x8, pack8(o));
                unpack8(ca[ks], cur); unpack8(na[ks], nb);
#pragma unroll
                for (int j = 0; j < 8; ++j) o[j] = cur[j] + ((hasnb ? nb[j] : 0.f) - cur[j]) * ma[ks][j >> 2][j & 3];
                Ba[ks] = __builtin_bit_cast(bf16x8, pack8(o)); }
        }
        const int pos = scan_pos(d, isctx, t);
#pragma unroll 1
        for (int hh = 0; hh < 2; ++hh) {
            const int head = hp * 2 + hh, chain = (b * 2 + d) * 16 + head;
            char* recb = (char*)REC + ((size_t)chain * SCANLEN + pos) * RECB;
            const LAS float* pr = prm + hh * 512;
            float KK[16], AV[16]; float ss = 0.f, bon = 0.f;
#pragma unroll
            for (int hf = 0; hf < 2; ++hf) {
                const int cl = 32 * hf + 8 * q4, cg = head * 64 + cl;
                bf16x8 wf[2][2], af[2][2];
#pragma unroll
                for (int tq = 0; tq < 2; ++tq) { const size_t wrow = (size_t)(d * 1024 + head * 64 + 32 * hf + 8 * (n >> 2) + 4 * tq + (n & 3)) * 64 + 8 * q4;
                    wf[tq][0] = ld_frag(WUPT + wrow); wf[tq][1] = ld_frag(WUPT + wrow + 32); af[tq][0] = ld_frag(AUPT + wrow); af[tq][1] = ld_frag(AUPT + wrow + 32); }
                const v4u rcw = *(const v4u*)(prow + C_RWR + cg), kcw = *(const v4u*)(prow + C_RWK + cg), vcw = *(const v4u*)(prow + C_RWV + cg);
                const v4u rnw = *(const v4u*)(nrow + C_RWR + cg), knw = *(const v4u*)(nrow + C_RWK + cg), vnw = *(const v4u*)(nrow + C_RWV + cg);
                __builtin_amdgcn_sched_barrier(0);
                f32x4 accW[2], accA[2];
#pragma unroll
                for (int tq = 0; tq < 2; ++tq) { f32x4 z = {0.f, 0.f, 0.f, 0.f}; z = mfma16(wf[tq][0], Bw[0], z); accW[tq] = mfma16(wf[tq][1], Bw[1], z);
                                                 f32x4 y = {0.f, 0.f, 0.f, 0.f}; y = mfma16(af[tq][0], Ba[0], y); accA[tq] = mfma16(af[tq][1], Ba[1], y); }
                float rc[8], kc[8], vc[8], rn[8], kn[8], vn[8];
                unpack8(rcw, rc); unpack8(kcw, kc); unpack8(vcw, vc); unpack8(rnw, rn); unpack8(knw, kn); unpack8(vnw, vn);
                float dec[8], kp[8], rr[8], vv[8];
#pragma unroll
                for (int g = 0; g < 2; ++g) {
                    const f32x4 w0v = *(const LAS f32x4*)(pr + 0 * 64 + cl + 4 * g), a0v = *(const LAS f32x4*)(pr + 1 * 64 + cl + 4 * g), mur = *(const LAS f32x4*)(pr + 2 * 64 + cl + 4 * g),
                                muk = *(const LAS f32x4*)(pr + 3 * 64 + cl + 4 * g), muv = *(const LAS f32x4*)(pr + 4 * 64 + cl + 4 * g), kkv = *(const LAS f32x4*)(pr + 5 * 64 + cl + 4 * g),
                                kav = *(const LAS f32x4*)(pr + 6 * 64 + cl + 4 * g), rkv = *(const LAS f32x4*)(pr + 7 * 64 + cl + 4 * g);
#pragma unroll
                    for (int i = 0; i < 4; ++i) { const int j = 4 * g + i;
                        const float rnb = hasnb ? rn[j] : 0.f, knb = hasnb ? kn[j] : 0.f, vnb = hasnb ? vn[j] : 0.f;
                        const float r_ = rc[j] + (rnb - rc[j]) * mur[i], k0 = kc[j] + (knb - kc[j]) * muk[i], v_ = vc[j] + (vnb - vc[j]) * muv[i];
                        const float xw = -(w0v[i] + accW[g][i]);
                        const float sp = fmaxf(xw, 0.f) + __logf(1.0f + __expf(-fabsf(xw)));
                        dec[j] = __expf(-__expf(-sp - 0.5f));
                        const float av = rcp_f(1.0f + __expf(-(a0v[i] + accA[g][i])));
                        const float kx = k0 * kkv[i]; ss += kx * kx;
                        const float kp_ = k0 * (1.f + (av - 1.f) * kav[i]); bon += r_ * kp_ * rkv[i];
                        KK[8 * hf + j] = kx; AV[8 * hf + j] = av; kp[j] = kp_; rr[j] = r_; vv[j] = v_; }
                }
                char* ob = recb + cl * 2;
                REC_ST((f32x4*)(recb + cl * 4), ((f32x4){dec[0], dec[1], dec[2], dec[3]})); REC_ST((f32x4*)(recb + cl * 4 + 16), ((f32x4){dec[4], dec[5], dec[6], dec[7]}));
                REC_ST((h8*)(ob + 512), ((h8){(_Float16)kp[0], (_Float16)kp[1], (_Float16)kp[2], (_Float16)kp[3], (_Float16)kp[4], (_Float16)kp[5], (_Float16)kp[6], (_Float16)kp[7]}));
                REC_ST((h8*)(ob + 640), ((h8){(_Float16)rr[0], (_Float16)rr[1], (_Float16)rr[2], (_Float16)rr[3], (_Float16)rr[4], (_Float16)rr[5], (_Float16)rr[6], (_Float16)rr[7]}));
                REC_ST((h8*)(ob + 768), ((h8){(_Float16)vv[0], (_Float16)vv[1], (_Float16)vv[2], (_Float16)vv[3], (_Float16)vv[4], (_Float16)vv[5], (_Float16)vv[6], (_Float16)vv[7]}));
                __builtin_amdgcn_sched_barrier(0);
            }
            ss = sum16x4(ss); bon = sum16x4(bon);
            const float inv = rsq_f(fmaxf(ss, 1e-12f));
#pragma unroll
            for (int hf = 0; hf < 2; ++hf) { char* ob = recb + (32 * hf + 8 * q4) * 2; float kkn[8], nka[8];
#pragma unroll
                for (int j = 0; j < 8; ++j) { kkn[j] = KK[8 * hf + j] * inv; nka[j] = -(kkn[j] * AV[8 * hf + j]); }
                REC_ST((h8*)(ob + 256), ((h8){(_Float16)kkn[0], (_Float16)kkn[1], (_Float16)kkn[2], (_Float16)kkn[3], (_Float16)kkn[4], (_Float16)kkn[5], (_Float16)kkn[6], (_Float16)kkn[7]}));
                REC_ST((h8*)(ob + 384), ((h8){(_Float16)nka[0], (_Float16)nka[1], (_Float16)nka[2], (_Float16)nka[3], (_Float16)nka[4], (_Float16)nka[5], (_Float16)nka[6], (_Float16)nka[7]})); }
            if (q4 == 0) BON[(size_t)chain * SCANLEN + pos] = bon;
        }
    }
}
template <bool CTXQ>
__device__ __forceinline__ void na_unit(const bf16* QN, const bf16* KN, const bf16* VTL, const bf16* VTC, const bf16* P, const float* rpb  , bf16* Y, int u, int lane) {
    const int n = lane & 15, q4 = lane >> 4;
    int b, h, qrow0, qr = 0, jt = 0;
    if (CTXQ) { b = u >> 8; h = (u >> 4) & 15; qrow0 = NLAT + b * CTXL + 16 * (u & 15); }
    else { jt = u & 3; h = (u >> 2) & 15; qr = (u >> 6) & 127; b = u >> 13; qrow0 = b * SEQ + qr * 64 + 16 * jt; }
    constexpr int NT = CTXQ ? 16 : 32, WT = CTXQ ? 0 : 16;
    f32x4 s[NT];
    const int rs = qr - 4 < 0 ? 0 : (qr - 4 > 120 ? 120 : qr - 4);
    const int span0 = jt == 0 ? 0 : (jt == 1 ? 8 : (jt == 2 ? 24 : 32));
    const int qc = 16 * jt + n; const int cs = qc - 8 < 0 ? 0 : (qc - 8 > 48 ? 48 : qc - 8);
    bf16x8 qf[2];
#pragma unroll
    for (int ks = 0; ks < 2; ++ks) qf[ks] = ld_frag(QN + (size_t)(qrow0 + n) * GWD + h * 64 + 32 * ks + 8 * q4);
    if (!CTXQ) {
        const float* rp = rpb + (size_t)h * 15 * 31;
#pragma unroll
        for (int wt = 0; wt < 16; ++wt) { const int kri = wt >> 1, half = wt & 1, relr = rs + kri - qr + 7;
#pragma unroll
            for (int i = 0; i < 4; ++i) { const int relc = span0 + 8 * q4 + 4 * half + i - qc + 15; const int relcc = relc < 0 ? 0 : (relc > 30 ? 30 : relc); s[wt][i] = rp[relr * 31 + relcc]; } }
        __builtin_amdgcn_sched_barrier(0);
#pragma unroll
        for (int bt = 0; bt < 2; ++bt) {
            bf16x8 kf[16];
#pragma unroll
            for (int t = 0; t < 8; ++t) { const int wt = bt * 8 + t, kri = wt >> 1, half = wt & 1;
                const bf16* kp = KN + (size_t)(b * SEQ + (rs + kri) * 64 + span0 + 8 * (n >> 2) + 4 * half + (n & 3)) * GWD + h * 64 + 8 * q4; kf[2 * t] = ld_frag(kp); kf[2 * t + 1] = ld_frag(kp + 32); }
            __builtin_amdgcn_sched_barrier(0);
#pragma unroll
            for (int t = 0; t < 8; ++t) { const int wt = bt * 8 + t, half = wt & 1;
                f32x4 a = s[wt];
#pragma unroll
                for (int i = 0; i < 4; ++i) { const int kc = span0 + 8 * q4 + 4 * half + i; const bool ok = kc >= cs && kc < cs + 16; a[i] = ok ? a[i] : -INFINITY; }
                a = mfma16(kf[2 * t], qf[0], a); a = mfma16(kf[2 * t + 1], qf[1], a); s[wt] = a; }
            __builtin_amdgcn_sched_barrier(0);
        }
    }
#pragma unroll
    for (int bt = 0; bt < 2; ++bt) {
        bf16x8 kf[16];
#pragma unroll
        for (int t = 0; t < 8; ++t) { const int ctile = bt * 8 + t; const bf16* kp = KN + (size_t)(NLAT + b * CTXL + 32 * (ctile >> 1) + 8 * (n >> 2) + 4 * (ctile & 1) + (n & 3)) * GWD + h * 64 + 8 * q4; kf[2 * t] = ld_frag(kp); kf[2 * t + 1] = ld_frag(kp + 32); }
        __builtin_amdgcn_sched_barrier(0);
#pragma unroll
        for (int t = 0; t < 8; ++t) { f32x4 a = {0.f, 0.f, 0.f, 0.f}; a = mfma16(kf[2 * t], qf[0], a); a = mfma16(kf[2 * t + 1], qf[1], a); s[WT + bt * 8 + t] = a; }
        __builtin_amdgcn_sched_barrier(0);
    }
    float mx = -INFINITY;
#pragma unroll
    for (int t = 0; t < NT; ++t) mx = fmaxf(fmaxf(fmaxf(s[t][0], s[t][1]), fmaxf(s[t][2], s[t][3])), mx);
    mx = max16x4(mx);
    float sum = 0.f;
#pragma unroll
    for (int t = 0; t < NT; ++t) {
#pragma unroll
        for (int i = 0; i < 4; ++i) { const float e = __expf(s[t][i] - mx); s[t][i] = e; sum += e; } }
    sum = sum16x4(sum);
    const float inv = rcp_f(sum);
    f32x4 o[4];
#pragma unroll
    for (int nt = 0; nt < 4; ++nt) o[nt] = (f32x4){0.f, 0.f, 0.f, 0.f};
#pragma unroll
    for (int tb = 0; tb < NT / 8; ++tb) {
        v4u vv[4][4];
#pragma unroll
        for (int tq = 0; tq < 4; ++tq) { const int tp = tb * 4 + tq;
            const bf16* vb; size_t dstride;
            if (!CTXQ && tp < 8) { vb = VTL + ((size_t)(b * 16 + h) * 64 + n) * 8192 + (rs + tp) * 64 + span0 + 8 * q4; dstride = (size_t)16 * 8192; }
            else { const int cp = tp - (CTXQ ? 0 : 8); vb = VTC + ((size_t)(b * 16 + h) * 64 + n) * 256 + 32 * cp + 8 * q4; dstride = (size_t)16 * 256; }
#pragma unroll
            for (int nt = 0; nt < 4; ++nt) vv[tq][nt] = *(const v4u*)(vb + nt * dstride); }
        __builtin_amdgcn_sched_barrier(0);
#pragma unroll
        for (int tq = 0; tq < 4; ++tq) { const int tp = tb * 4 + tq;
            const f32x4 p0 = s[2 * tp] * inv, p1 = s[2 * tp + 1] * inv;
            v4u aw; aw.x = pk2(p0[0], p0[1]); aw.y = pk2(p0[2], p0[3]); aw.z = pk2(p1[0], p1[1]); aw.w = pk2(p1[2], p1[3]);
            const bf16x8 af = __builtin_bit_cast(bf16x8, aw);
#pragma unroll
            for (int nt = 0; nt < 4; ++nt) o[nt] = mfma16(af, __builtin_bit_cast(bf16x8, vv[tq][nt]), o[nt]); }
        __builtin_amdgcn_sched_barrier(0);
    }
    unsigned short zz[4][4];
#pragma unroll
    for (int nt = 0; nt < 4; ++nt)
#pragma unroll
        for (int i = 0; i < 4; ++i) zz[nt][i] = P[(size_t)(qrow0 + 4 * q4 + i) * NIN + C_NAZ + h * 64 + 16 * nt + n];
    __builtin_amdgcn_sched_barrier(0);
#pragma unroll
    for (int nt = 0; nt < 4; ++nt)
#pragma unroll
        for (int i = 0; i < 4; ++i) { const int row = qrow0 + 4 * q4 + i, col = h * 64 + 16 * nt + n;
            Y[(size_t)row * DM + 1024 + col] = (bf16)f2bf(o[nt][i] * silu_f(bf2f(zz[nt][i]))); }
}
__device__ __forceinline__ void bar4(LAS unsigned* cnt, unsigned& seq, int lane) {
    asm volatile("s_waitcnt vmcnt(0) lgkmcnt(0)" ::: "memory");
    const unsigned baddr = (unsigned)(size_t)cnt, one = 1u; seq += 4u;
    if (lane == 0) asm volatile("ds_add_u32 %0, %1" :: "v"(baddr), "v"(one) : "memory");
    unsigned sp = 0, got;
    for (;;) { asm volatile("ds_read_b32 %0, %1\n\ts_waitcnt lgkmcnt(0)" : "=v"(got) : "v"(baddr) : "memory");
        if (__builtin_amdgcn_readfirstlane((int)got) >= (int)seq) break; __builtin_amdgcn_s_sleep(1); if (++sp > (1u << 22)) break; }
    asm volatile("" ::: "memory");
}
__device__ __forceinline__ void phase_sgu4(const bf16* P, const f32x2* SGST, const float* lnw, const float* lnb, const bf16* SGW, const float* sgb, bf16* Y,
                                           LAS unsigned char* ldsT, LAS unsigned* cnt, int nchunks, int tid4  , int w4  , int lane) {
    const int n = lane & 15, q4 = lane >> 4;
    LAS bf16* T = (LAS bf16*)ldsT; unsigned seq = 0u;
    for (int u = blockIdx.x; u < nchunks * 8; u += 256) {
        const int ck = u >> 3, g = u & 7, m0 = ck * 128;
#pragma unroll
        for (int it = 0; it < 8; ++it) { const int idx = tid4 + 256 * it, q = idx >> 4, c8 = idx & 15;
            float x[8]; unpack8(*(const v4u*)(P + (size_t)(m0 + q) * NIN + C_SGV + g * 128 + 8 * c8), x);
            const f32x2 st = SGST[m0 + q];
#pragma unroll
            for (int j = 0; j < 8; ++j) { const int c = 8 * c8 + j; const float v = (x[j] - st.x) * st.y * lnw[g * 128 + c] + lnb[g * 128 + c]; T[c * 136 + q] = (bf16)f2bf(v); } }
        bar4(cnt, seq, lane);
#pragma unroll 1
        for (int mt = 0; mt < 2; ++mt) { const int mrow = 32 * w4 + 16 * mt;
            bf16x8 af[4];
#pragma unroll
            for (int ks = 0; ks < 4; ++ks) af[ks] = ld_frag(SGW + ((size_t)g * 128 + mrow + n) * 128 + 32 * ks + 8 * q4);
#pragma unroll
            for (int nt = 0; nt < 8; ++nt) {
                f32x4 acc = {0.f, 0.f, 0.f, 0.f};
#pragma unroll
                for (int ks = 0; ks < 4; ++ks) { const bf16x8 bfg = *(const LAS bf16x8*)(T + (16 * nt + n) * 136 + 32 * ks + 8 * q4); acc = mfma16(af[ks], bfg, acc); }
#pragma unroll
                for (int i = 0; i < 4; ++i) { const int p = mrow + 4 * q4 + i, row = m0 + p, col = g * 128 + 16 * nt + n;
                    const float mixed = acc[i] + sgb[g * 128 + p]; const bf16* pr = P + (size_t)row * NIN;
                    const float uu = bf2f(pr[C_SGU + col]), z = bf2f(pr[C_SGZ + col]);
                    Y[(size_t)row * DM + 3072 + col] = (bf16)f2bf(uu * mixed * silu_f(z)); }
            }
        }
        bar4(cnt, seq, lane);
    }
}
__device__ __forceinline__ void scan_self(const float* REC, float* YR, LAS unsigned char* lds, LAS unsigned* bcnt, int su, int wave, int lane) {
    constexpr int CS = 32, NCH = SCANLEN / CS, SLOT = CS * RECB, NPW = SLOT / 1024 / 4;
    const int chain = (su & 7) * 8 + ((su >> 3) >> 2), part = (su >> 3) & 3;
    const char* recb = (const char*)REC + (size_t)chain * SCANLEN * RECB;
    const int wl = wave;
#define SCAN_ISSUE(cc, sl) do { _Pragma("unroll") for (int p_ = 0; p_ < NPW; ++p_) \
    __builtin_amdgcn_global_load_lds((const unsigned*)(recb + (size_t)(cc) * SLOT + (wl * NPW + p_) * 1024 + lane * 16), (LAS unsigned*)(lds + (sl) * SLOT + (wl * NPW + p_) * 1024), 16, 0, 0); } while (0)
    __builtin_amdgcn_s_setprio(3);
    SCAN_ISSUE(0, 0); SCAN_ISSUE(1, 1);
    const int c16 = lane & 15, rg = lane >> 4, row = 16 * part + 4 * wave + rg;
    float S0 = 0.f, S1 = 0.f, S2 = 0.f, S3 = 0.f;
    float* yout = YR + (size_t)chain * SCANLEN * 64 + row;
    const int lo_w = c16 * 16, lo_h = 256 + c16 * 8, lo_v = 768 + row * 2;
#define SCAN_LD(dst, sl, s_) do { const LAS unsigned char* rec_ = (sl) + (s_) * RECB; dst##w = *(const LAS f32x4*)(rec_ + lo_w); dst##kk = *(const LAS h4*)(rec_ + lo_h); \
    dst##na = *(const LAS h4*)(rec_ + 128 + lo_h); dst##k = *(const LAS h4*)(rec_ + 256 + lo_h); dst##r = *(const LAS h4*)(rec_ + 384 + lo_h); dst##v = *(const LAS _Float16*)(rec_ + lo_v); } while (0)
#define FMX(a, b, c) __builtin_fmaf((a), (float)(b), (c))
    int sl = 0;
    for (int c = 0; c < NCH; ++c) {
        asm volatile("s_waitcnt vmcnt(7)" ::: "memory");
        {   const unsigned baddr = (unsigned)(size_t)bcnt, one = 1u;
            if (lane == 0) asm volatile("ds_add_u32 %0, %1" :: "v"(baddr), "v"(one) : "memory");
            const unsigned want = 4u * (unsigned)(c + 1); unsigned sp = 0, got;
            for (;;) { asm volatile("ds_read_b32 %0, %1\n\ts_waitcnt lgkmcnt(0)" : "=v"(got) : "v"(baddr) : "memory");
                if (__builtin_amdgcn_readfirstlane((int)got) >= (int)want) break; __builtin_amdgcn_s_sleep(1); if (++sp > (1u << 22)) break; } }
        asm volatile("" ::: "memory");
        {   const int cc = c + 2 < NCH ? c + 2 : NCH - 1; const int s2 = sl == 0 ? 2 : sl - 1; SCAN_ISSUE(cc, s2); }
        const LAS unsigned char* slot = lds + sl * SLOT;
        sl = sl == 2 ? 0 : sl + 1;
        float ysv0 = 0.f, ysv1 = 0.f; float yp[16];
        f32x4 Aw; h4 Akk, Ana, Ak, Ar, Pr; _Float16 Av;
        SCAN_LD(A, slot, 0);
#pragma unroll
        for (int s = 0; s < CS; ++s) {
            f32x4 Bw; h4 Bkk, Bna, Bk, Br; _Float16 Bv;
            if (s < CS - 1) SCAN_LD(B, slot, s + 1);
            __builtin_amdgcn_sched_barrier(0);
            if (s > 0) { float q0 = FMX(S0, Pr.x, 0.f), q1 = FMX(S2, Pr.z, 0.f); q0 = FMX(S1, Pr.y, q0); q1 = FMX(S3, Pr.w, q1); yp[(s - 1) & 15] = q0 + q1; }
            float p0 = FMX(S0, Akk.x, 0.f), p1 = FMX(S2, Akk.z, 0.f); p0 = FMX(S1, Akk.y, p0); p1 = FMX(S3, Akk.w, p1);
            const float dt = red16(p0 + p1);
            const float u0 = __builtin_fmaf(S0, Aw.x, FMX((float)Av, Ak.x, 0.f)), u1 = __builtin_fmaf(S1, Aw.y, FMX((float)Av, Ak.y, 0.f)),
                        u2 = __builtin_fmaf(S2, Aw.z, FMX((float)Av, Ak.z, 0.f)), u3 = __builtin_fmaf(S3, Aw.w, FMX((float)Av, Ak.w, 0.f));
            S0 = FMX(dt, Ana.x, u0); S1 = FMX(dt, Ana.y, u1); S2 = FMX(dt, Ana.z, u2); S3 = FMX(dt, Ana.w, u3);
            if (s == 16) ysv0 = red16_transpose(yp, c16);
            Pr = Ar;
            if (s < CS - 1) { Aw = Bw; Akk = Bkk; Ana = Bna; Ak = Bk; Ar = Br; Av = Bv; }
        }
        { float q0 = FMX(S0, Pr.x, 0.f), q1 = FMX(S2, Pr.z, 0.f); q0 = FMX(S1, Pr.y, q0); q1 = FMX(S3, Pr.w, q1); yp[15] = q0 + q1; }
        ysv1 = red16_transpose(yp, c16);
        asm volatile("" ::: "memory");
        yout[(size_t)(c * CS + c16) * 64] = ysv0; yout[(size_t)(c * CS + 16 + c16) * 64] = ysv1;
    }
    asm volatile("s_waitcnt vmcnt(0)" ::: "memory");
    __builtin_amdgcn_s_setprio(0);
#undef FMX
#undef SCAN_LD
#undef SCAN_ISSUE
}
__device__ __forceinline__ void phase_rwfin(const bf16* P, const float* YR, const float* REC, const float* BON, const float* lnw, const float* lnb, bf16* Y, int nrows, int gw, int NGW, int lane) {
    const int head = lane >> 2, sub = lane & 3;
    for (int m = gw; m < nrows; m += NGW) {
        const bool isctx = m >= NLAT; const int t = isctx ? ((m - NLAT) & 255) : (m & 8191); const int b = isctx ? ((m - NLAT) >> 8) : (m >> 13);
        float out[16];
#pragma unroll
        for (int i = 0; i < 16; ++i) out[i] = 0.f;
#pragma unroll
        for (int d = 0; d < 2; ++d) {
            const int chain = (b * 2 + d) * 16 + head; const size_t pp = (size_t)chain * SCANLEN + scan_pos(d, isctx, t);
            float y[16], v[16];
#pragma unroll
            for (int j = 0; j < 4; ++j) { const f32x4 a = *(const f32x4*)(YR + pp * 64 + 16 * sub + 4 * j); const h4 c = *(const h4*)((const char*)REC + pp * RECB + 768 + (16 * sub + 4 * j) * 2);
                y[4 * j] = a.x; y[4 * j + 1] = a.y; y[4 * j + 2] = a.z; y[4 * j + 3] = a.w; v[4 * j] = (float)c.x; v[4 * j + 1] = (float)c.y; v[4 * j + 2] = (float)c.z; v[4 * j + 3] = (float)c.w; }
            const float bo = BON[pp];
            float s = 0.f;
#pragma unroll
            for (int i = 0; i < 16; ++i) s += y[i];
            s += __shfl_xor(s, 1); s += __shfl_xor(s, 2);
            const float mean = s * (1.f / 64.f); float q = 0.f;
#pragma unroll
            for (int i = 0; i < 16; ++i) { const float dl = y[i] - mean; q += dl * dl; }
            q += __shfl_xor(q, 1); q += __shfl_xor(q, 2);
            const float rstd = rsq_f(q * (1.f / 64.f) + 64e-5f);
#pragma unroll
            for (int i = 0; i < 16; ++i) { const int ch = head * 64 + 16 * sub + i; out[i] += (y[i] - mean) * rstd * lnw[ch] + lnb[ch] + bo * v[i]; }
        }
        float z[16]; unpack8(*(const v4u*)(P + (size_t)m * NIN + C_RWZ + 16 * lane), z); unpack8(*(const v4u*)(P + (size_t)m * NIN + C_RWZ + 16 * lane + 8), z + 8);
#pragma unroll
        for (int i = 0; i < 16; ++i) out[i] *= silu_f(z[i]);
        *(v4u*)(Y + (size_t)m * DM + 2048 + 16 * lane) = pack8(out); *(v4u*)(Y + (size_t)m * DM + 2048 + 16 * lane + 8) = pack8(out + 8);
    }
}
#define XB_TMO      128
#define XB_XCNT(j)  (256  + 64 * (j))
#define XB_XSUB(j)  (1280 + 64 * (j))
#define XB_XGEN(j)  (2304 + 64 * (j))
#define XB_TOP      3328
#define XB_TOPGEN   3392
#define XCD_BAR_WORDS 3456
#define XB_SPIN_CAP (1u << 18)

__device__ __forceinline__ unsigned xb_ld(unsigned* p)              { return __hip_atomic_load(p, __ATOMIC_RELAXED, __HIP_MEMORY_SCOPE_AGENT); }
__device__ __forceinline__ unsigned xb_add(unsigned* p, unsigned v) { return __hip_atomic_fetch_add(p, v, __ATOMIC_RELAXED, __HIP_MEMORY_SCOPE_AGENT); }
__device__ __forceinline__ unsigned xb_xcc_id() { return (unsigned)__builtin_amdgcn_s_getreg((3 << 11) | 20) & 0xFu; }
#define XB_SPIN(cond, bar) do { unsigned _sp = 0; while (cond) { __builtin_amdgcn_s_sleep(1); \
    if ((++_sp & 255u) == 0u) { if (xb_ld(&(bar)[XB_TMO])) break; if (_sp > XB_SPIN_CAP) { atomicAdd(&(bar)[XB_TMO], 1u); break; } } } } while (0)

struct XcdBarrier {
    unsigned* bar; unsigned x;
    volatile LAS unsigned* st;
};

__device__ __forceinline__ XcdBarrier xcd_barrier_post(unsigned* bar, volatile LAS unsigned* st) {
    XcdBarrier b; b.bar = bar; b.x = xb_xcc_id(); b.st = st;
    if (threadIdx.x == 0) (void)xb_add(&bar[XB_XCNT(b.x)], 1u);
    return b;
}
__device__ __forceinline__ void xcd_barrier_complete(unsigned* bar, unsigned x, unsigned& nloc, unsigned& nx) {
    const unsigned G = gridDim.x * gridDim.y * gridDim.z;
    unsigned sum, cnt, mine, sp = 0u;
    for (;;) {
        sum = 0u; cnt = 0u; mine = 0u;
#pragma unroll
        for (unsigned j = 0; j < 16; ++j) { const unsigned c = xb_ld(&bar[XB_XCNT(j)]); sum += c; cnt += (c > 0u) ? 1u : 0u; mine = (j == x) ? c : mine; }
        if (sum == G) break;
        __builtin_amdgcn_s_sleep(1);
        if ((++sp & 255u) == 0u) { if (xb_ld(&bar[XB_TMO])) break; if (sp > XB_SPIN_CAP) { atomicAdd(&bar[XB_TMO], 1u); break; } }
    }
    nloc = mine > 0u ? mine : 1u; nx = cnt > 0u ? cnt : 1u;
}

__device__ __forceinline__ void xcd_barrier(const XcdBarrier& b) {
    asm volatile("s_waitcnt vmcnt(0)" ::: "memory");
    __syncthreads();
    if (threadIdx.x == 0) {
        unsigned* bar = b.bar;
        __builtin_amdgcn_s_waitcnt(0);
        unsigned nloc = b.st[0], nx = b.st[1];
        if (nloc == 0u) { xcd_barrier_complete(bar, b.x, nloc, nx); b.st[0] = nloc; b.st[1] = nx; }
        const unsigned old = xb_add(&bar[XB_XSUB(b.x)], 1u);
        const unsigned gen = old / nloc;
        if (old + 1u == (gen + 1u) * nloc) {
            __builtin_amdgcn_fence(__ATOMIC_RELEASE, "agent");
            asm volatile("s_waitcnt vmcnt(0)" ::: "memory");
            const unsigned og = xb_add(&bar[XB_TOP], 1u);
            const unsigned tg = og / nx;
            if (og + 1u == (tg + 1u) * nx) xb_add(&bar[XB_TOPGEN], 1u);
            else XB_SPIN(xb_ld(&bar[XB_TOPGEN]) == tg, bar);
            __builtin_amdgcn_fence(__ATOMIC_ACQUIRE, "agent");
            xb_add(&bar[XB_XGEN(b.x)], 1u);
            asm volatile("s_waitcnt vmcnt(0)" ::: "memory");
        } else {
            XB_SPIN(xb_ld(&bar[XB_XGEN(b.x)]) == gen, bar);
            __builtin_amdgcn_fence(__ATOMIC_ACQUIRE, "agent");
            asm volatile("s_waitcnt vmcnt(0)" ::: "memory");
        }
    }
    __syncthreads();
}

#ifndef MK_SPLIT
#define MK_SPLIT 0
#endif
constexpr int PPL = 6;
constexpr int NPHASE = 2 + PPL * DEPTH;
constexpr int RWP_BLOCKS = 14;
constexpr int CW_RWQ = 16384;
constexpr int NGRID = 256;
struct Args { const float* in[28]; float* out; unsigned char* ws; int ph_lo, ph_hi, li, pad; };

__global__ void __launch_bounds__(NWAVES * 64, 2) fwd(Args args) {
    extern __shared__ __attribute__((aligned(16))) unsigned char lds_raw[];
    LAS unsigned char* lds = (LAS unsigned char*)lds_raw;
    volatile LAS unsigned* MISC = (volatile LAS unsigned*)(lds + MISC_OFF);
    const int tid = threadIdx.x, lane = tid & 63, wave = __builtin_amdgcn_readfirstlane(tid >> 6);
    constexpr int G = NGRID; const int bx = blockIdx.x;
    const int vcu = (bx % 8) * (G / 8) + bx / 8;
    const int gw = vcu * NWAVES + wave; constexpr int NGW = G * NWAVES;
    unsigned char* ws = args.ws;
    const int lo = args.ph_lo, hi = args.ph_hi;

    for (int u = tid; u < (LDS_BYTES - LDSCTL_OFF) / 4; u += NWAVES * 64) ((LAS unsigned*)(lds + LDSCTL_OFF))[u] = 0u;
    __syncthreads();
    XcdBarrier bar; bar.bar = (unsigned*)(ws + WS_CTL) + CW_BAR; bar.x = 0; bar.st = MISC + 8;
    if (hi - lo > 1) bar = xcd_barrier_post((unsigned*)(ws + WS_CTL) + CW_BAR, MISC + 8);
#define IN(k) (lo <= (k) && (k) < hi)
#define SEAM(k) do { if (lo <= (k) && (k) + 1 < hi) { XcdBarrier b2_; b2_.bar = WSP(unsigned, WS_CTL) + CW_BAR; b2_.x = bar.x; b2_.st = bar.st; xcd_barrier(b2_); } } while (0)

#define OPQ_S(x) ({ int _t = (x); asm volatile("" : "+s"(_t)); _t; })
#define OPQ_V(x) ({ int _t = (x); asm volatile("" : "+v"(_t)); _t; })
#define INP(i) (args.in[OPQ_S(i)])
#define WSP(T, off) ((T*)(args.ws + ({ size_t _o = (off); asm volatile("" : "+s"(_o)); _o; })))
#define x_in INP(0)
#define c_in INP(1)
#define ctx_in INP(2)
#define cctx_in INP(3)
#define w_mod INP(4)
#define b_mod INP(5)
#define w_in INP(6)
#define w_out INP(7)
#define pool_w INP(8)
#define pool_scale INP(9)
#define na_qg INP(10)
#define na_kg INP(11)
#define na_rpb INP(12)
#define rw_mu_rkv INP(13)
#define rw_mu_lora INP(14)
#define rw_w0 INP(15)
#define rw_w_up INP(16)
#define rw_a0 INP(17)
#define rw_a_up INP(18)
#define rw_k_k INP(19)
#define rw_k_a INP(20)
#define rw_r_k INP(21)
#define rw_ln_w INP(22)
#define rw_ln_b INP(23)
#define sg_ln_w INP(24)
#define sg_ln_b INP(25)
#define sg_w INP(26)
#define sg_b INP(27)
#define MOD WSP(float, WS_MOD)
#define MODP WSP(float, WS_MODP)
#define TAB WSP(f32x2, WS_TAB)
#define SGST WSP(f32x2, WS_SGST)
#define BON WSP(float, WS_BON)
#define POOLWT WSP(bf16, WS_POOLWT)
#define WUPT WSP(bf16, WS_WUPT)
#define AUPT WSP(bf16, WS_AUPT)
#define SGW WSP(bf16, WS_SGW)
#define VTC WSP(bf16, WS_VTC)
#define VTL WSP(bf16, WS_VTL)
#define HCTX WSP(float, WS_HCTX)
#define QN WSP(bf16, WS_QN)
#define KN WSP(bf16, WS_KN)
#define WOUTT WSP(bf16, WS_WOUTT)
#define WINT WSP(bf16, WS_WINT)
#define XN WSP(bf16, WS_XN)
#define Y WSP(bf16, WS_Y)
#define P WSP(bf16, WS_P)
#define YR WSP(float, WS_YR)
#define REC WSP(float, WS_REC)
#define SILUC WSP(float, WS_SILUC)
    float* const out = args.out;

    if (IN(0)) {
        LAS float* scr = (LAS float*)(lds + wave * 16384);
        constexpr int I_MOD = 64 * 48  , I_WIN = 64 * (NIN / 32), I_WOUT = 64 * 128, I_POOL = 4 * 32, I_WUP = 2 * 32, I_AUP = 2 * 32, I_SGW = 256;
        constexpr int NITEMS = I_MOD + I_WIN + I_WOUT + I_POOL + I_WUP + I_AUP + I_SGW;
        for (int it = gw; it < NITEMS; it += NGW) {
            int r = it;
            if (r < I_MOD) { p0_mod_item(w_mod, c_in, cctx_in, MODP, scr, r, lane); continue; } r -= I_MOD;
            if (r < I_WIN) { p0_transpose_item<true>(w_in, DM, NIN, WINT, scr, r, lane); continue; } r -= I_WIN;
            if (r < I_WOUT) { p0_transpose_item(w_out, DM, DM, WOUTT, scr, r, lane); continue; } r -= I_WOUT;
            if (r < I_POOL) { const int g = r / 32; p0_transpose_item(pool_w + (size_t)g * 65536, 256, 256, POOLWT + (size_t)g * 65536, scr, r % 32, lane); continue; } r -= I_POOL;
            if (r < I_WUP) { const int dd = r / 32; p0_transpose_item(rw_w_up + (size_t)dd * 65536, 64, 1024, WUPT + (size_t)dd * 65536, scr, r % 32, lane); continue; } r -= I_WUP;
            if (r < I_AUP) { const int dd = r / 32; p0_transpose_item(rw_a_up + (size_t)dd * 65536, 64, 1024, AUPT + (size_t)dd * 65536, scr, r % 32, lane); continue; } r -= I_AUP;
            {   const size_t e0 = (size_t)r * 512 + lane * 8; const f32x4 a = *(const f32x4*)(sg_w + e0), b = *(const f32x4*)(sg_w + e0 + 4);
                v4u o; o.x = pk2(a.x, a.y); o.y = pk2(a.z, a.w); o.z = pk2(b.x, b.y); o.w = pk2(b.z, b.w); *(v4u*)(SGW + e0) = o; }
        }
        SEAM(0);
    }
    if (IN(1)) {

        for (int idx = gw * 64 + lane; idx < 3 * 4096; idx += NGW * 64) SILUC[idx] = silu_f(idx < 8192 ? c_in[idx] : cctx_in[idx - 8192]);
        for (int idx = gw * 64 + lane; idx < 3 * 12288; idx += NGW * 64) {
            const int l = idx / 36864, c = (idx / 12288) % 3, n = idx % 12288;
            float s = b_mod[l * 12288 + n];
            const float* pp = MODP + ((size_t)(l * 64) * 3 + c) * 12288 + n;
#pragma unroll 8
            for (int kc = 0; kc < 64; ++kc) s += pp[(size_t)kc * 3 * 12288];
            MOD[idx] = s;
        }
        for (int idx = gw * 64 + lane; idx < 2048; idx += NGW * 64) {
            const int pos = idx >> 4, i = idx & 15;
            float inv = (i & 3) == 0 ? 1.0f : ((i & 3) == 1 ? 0.5623413251903491f : ((i & 3) == 2 ? 0.31622776601683794f : 0.17782794100389228f));
            inv *= (i >> 2) == 0 ? 1.0f : ((i >> 2) == 1 ? 0.1f : ((i >> 2) == 2 ? 0.01f : 0.001f));
            float cc, sn; sincos_acc((float)pos * inv, cc, sn);
            TAB[idx] = (f32x2){cc, sn};
        }
        SEAM(1);
    }
    for (int l = 0; l < DEPTH; ++l) {
        const int pb = 2 + PPL * l;
        const bool with_ctx = l < DEPTH - 1;
#define hin_lat (l == 0 ? x_in : (const float*)out)
#define hin_ctx (l == 0 ? ctx_in : (const float*)HCTX)
#define mod (MOD + (size_t)l * 3 * 12288)
        const int nrows = with_ctx ? MROWS : NLAT;
        if (IN(pb + 0)) {
            phase_xn(hin_lat, hin_ctx, mod, XN, OPQ_S(gw), NGW, OPQ_V(lane));
            SEAM(pb + 0);
        }
        if (IN(pb + 1)) {
            constexpr int C0 = C_SPLIT, NA_ = NIN - C0;
            pg8::Gemm g{XN, WINT + (size_t)l * NIN * DM + (size_t)C0 * DM, MROWS, NA_, DM}; pg8::StaticOrder S; S.init(MROWS, NA_, G, bx);
            pg8::EpiStoreBf16 E{P + C0, NIN};
            pg8::gemm_phase<pg8::EpiStoreBf16, pg8::StaticOrder, true, true>(lds, g, S, E);
            SEAM(pb + 1);
        }
        if (IN(pb + 2)) {
            if (bx >= RWP_BLOCKS) {
                constexpr int NB_ = C_SPLIT;
                pg8::Gemm g{XN, WINT + (size_t)l * NIN * DM, MROWS, NB_, DM}; pg8::StaticOrder S; S.init(MROWS, NB_, G - RWP_BLOCKS, bx - RWP_BLOCKS);
                pg8::EpiStoreBf16 E{P, NIN};
                pg8::gemm_phase<pg8::EpiStoreBf16, pg8::StaticOrder, true, true>(lds, g, S, E);
            }
            phase_rwprep(P, rw_mu_rkv + (size_t)l * 6144, rw_mu_lora + (size_t)l * 256, rw_w0 + (size_t)l * 2048, WUPT + (size_t)l * 131072, rw_a0 + (size_t)l * 2048, AUPT + (size_t)l * 131072,
                         rw_k_k + (size_t)l * 1024, rw_k_a + (size_t)l * 1024, rw_r_k + (size_t)l * 1024, REC, BON, lds, WSP(unsigned, WS_CTL) + CW_RWQ + l * 1024, (bx * NWAVES + wave) & 15, wave, OPQ_V(lane));
            phase_rowprep(P, na_qg + l * 64, na_kg + l * 64, TAB, QN, KN, SGST, OPQ_S(gw), NGW, OPQ_V(lane));
            phase_vt(P, VTL, VTC, OPQ_S(gw), NGW, OPQ_V(lane));
            SEAM(pb + 2);
        }
        if (IN(pb + 3)) {
            {
            LAS unsigned* mixq = (LAS unsigned*)(lds + LDSCTL_OFF + 64); LAS unsigned* mixb = (LAS unsigned*)(lds + LDSCTL_OFF + 128); LAS unsigned* mixs = (LAS unsigned*)(lds + LDSCTL_OFF + 192);
            if (tid == 0) { *mixq = 0u; *mixb = 0u; *mixs = 0u; }
            __syncthreads();
            if (wave < 4) scan_self(REC, YR, lds, mixb, bx, wave, OPQ_V(lane));
            else phase_sgu4(P, SGST, sg_ln_w + (size_t)l * 1024, sg_ln_b + (size_t)l * 1024, SGW + (size_t)l * 131072, sg_b + (size_t)l * 1024, Y, lds + 3 * 28672, mixs, nrows / 128, OPQ_V(tid) - 256, wave - 4, OPQ_V(lane));
            {   const int nctxu = with_ctx ? 2 : 0, npool = (nrows / 16) * 4, npq = (npool + NGRID - 1) / NGRID, nwc = l + 1 < DEPTH ? (WC_ITEMS + NGRID - 1) / NGRID : 0, nmd = l + 1 < DEPTH ? (64 * 48) / NGRID : 0, nq = 64 + nctxu + npq + nwc + nmd;
                for (;;) {
                    unsigned k = 0; if (lane == 0) k = __hip_atomic_fetch_add(mixq, 1u, __ATOMIC_RELAXED, __HIP_MEMORY_SCOPE_WORKGROUP);
                    k = (unsigned)__builtin_amdgcn_readfirstlane((int)k);
                    if ((int)k >= nq) break;
                    const int ln = OPQ_V(lane);
                    if (k < 64u) { na_unit<false>(QN, KN, VTL, VTC, P, na_rpb + (size_t)l * 16 * 15 * 31, Y, bx * 64 + (int)k, ln);
                    }
                    else if ((int)k < 64 + nctxu) na_unit<true>(QN, KN, VTL, VTC, P, na_rpb, Y, bx * 2 + ((int)k - 64), ln);
                    else if ((int)k >= 64 + nctxu + npq + nwc) mod_item_nolds(w_mod + (size_t)(l + 1) * 4096 * 12288, SILUC, MODP + (size_t)(l + 1) * 64 * 3 * 12288, bx + NGRID * ((int)k - 64 - nctxu - npq - nwc), ln);
                    else if ((int)k >= 64 + nctxu + npq) { const int r = bx + NGRID * ((int)k - 64 - nctxu - npq);
                        if (r < WC_ITEMS) weight_copy_item(l + 1, r, w_in, w_out, pool_w, rw_w_up, rw_a_up, sg_w, WINT, WOUTT, POOLWT, WUPT, AUPT, SGW, ln); }
                    else { const int u = bx + NGRID * ((int)k - 64 - nctxu);
                        if (u < npool) { const int tt = u >> 2, g = u & 3; const bf16* wbase = POOLWT + (size_t)l * 262144 + (size_t)g * 65536; const float* psc = pool_scale + (size_t)l * 1024;
                            if (g == 0) pool_unit<0>(P, wbase, psc, Y, tt * 16, ln); else if (g == 1) pool_unit<1>(P, wbase, psc, Y, tt * 16, ln);
                            else if (g == 2) pool_unit<2>(P, wbase, psc, Y, tt * 16, ln); else pool_unit<3>(P, wbase, psc, Y, tt * 16, ln); } }
                }
            }
            }
            SEAM(pb + 3);
        }
        if (IN(pb + 4)) {
            if (l + 1 < DEPTH) for (int idx = gw * 64 + lane; idx < 3 * 12288; idx += NGW * 64) {
                const int c = idx / 12288, n = idx % 12288; float s = b_mod[(l + 1) * 12288 + n];
                const float* pp = MODP + ((size_t)((l + 1) * 64) * 3 + c) * 12288 + n;
#pragma unroll 8
                for (int kc = 0; kc < 64; ++kc) s += pp[(size_t)kc * 3 * 12288];
                MOD[(size_t)(l + 1) * 3 * 12288 + idx] = s; }
            phase_rwfin(P, YR, REC, BON, rw_ln_w + (size_t)l * 1024, rw_ln_b + (size_t)l * 1024, Y, nrows, OPQ_S(gw), NGW, OPQ_V(lane));
            SEAM(pb + 4);
        }
        if (IN(pb + 5)) {
            pg8::Gemm g{Y, WOUTT + (size_t)l * DM * DM, nrows, DM, DM}; pg8::StaticOrder S; S.init(nrows, DM, G, bx);
            pg8::EpiResGate E{hin_lat, hin_ctx, out, HCTX, mod};
            pg8::gemm_phase<pg8::EpiResGate, pg8::StaticOrder, true, true>(lds, g, S, E);
            SEAM(pb + 5);
        }
    }
#undef IN
#undef SEAM
}
#undef hin_lat
#undef hin_ctx
#undef mod
#undef P
#undef Y
#undef XN
#undef out

extern "C" void kernel_launch(void* const* d_in, const int* in_sizes, int n_in, void* d_out, int out_size, void* d_ws, size_t ws_size, hipStream_t stream) {
    static int grid = 0;
    if (grid == 0) {
        if (n_in != 28 || out_size != NLAT * DM || ws_size < WS_END) { fprintf(stderr, "kernel_launch: unexpected shapes (n_in %d, out %d, ws %zu < %zu); nothing launched\n", n_in, out_size, ws_size, (size_t)WS_END); grid = -1; return; }
        int dev = 0, cus = 0, per_cu = 0;
        if (hipGetDevice(&dev) != hipSuccess || hipDeviceGetAttribute(&cus, hipDeviceAttributeMultiprocessorCount, dev) != hipSuccess) { grid = -1; return; }
        if (hipFuncSetAttribute((const void*)fwd, hipFuncAttributeMaxDynamicSharedMemorySize, LDS_BYTES) != hipSuccess) { fprintf(stderr, "kernel_launch: hipFuncSetAttribute failed\n"); grid = -1; return; }
        if (hipOccupancyMaxActiveBlocksPerMultiprocessor(&per_cu, (const void*)fwd, NWAVES * 64, LDS_BYTES) != hipSuccess || per_cu < 1)
            fprintf(stderr, "kernel_launch: note: occupancy query reports %d workgroups per CU\n", per_cu);
        (void)hipGetLastError();
        grid = cus >= NGRID ? NGRID : -2;
    }
    if (grid == -1) return;
    if (hipMemsetAsync((char*)d_ws + WS_CTL, 0, CTL_ZERO_BYTES, stream) != hipSuccess) { fprintf(stderr, "kernel_launch: memset failed\n"); return; }
    Args a{};
    for (int i = 0; i < 28; ++i) a.in[i] = (const float*)d_in[i];
    a.out = (float*)d_out; a.ws = (unsigned char*)d_ws; a.li = 0; a.pad = 0;
    const bool split = MK_SPLIT || grid == -2;
    if (split) { for (int k = 0; k < NPHASE; ++k) { a.ph_lo = k; a.ph_hi = k + 1; hipLaunchKernelGGL(fwd, dim3(NGRID), dim3(NWAVES * 64), LDS_BYTES, stream, a); } }
    else { a.ph_lo = 0; a.ph_hi = NPHASE; hipLaunchKernelGGL(fwd, dim3(NGRID), dim3(NWAVES * 64), LDS_BYTES, stream, a); }
    const hipError_t le = hipPeekAtLastError();
    if (le != hipSuccess) fprintf(stderr, "kernel_launch: launch failed: %s\n", hipGetErrorName(le));
}
```

```cpp
#include <hip/hip_runtime.h>
#include <cstdio>
#include <cstdint>
#define MK_SPLIT 0
namespace pg8 {
#define PG8_LAS __attribute__((address_space(3)))
typedef unsigned short bf16_t;
typedef short bf16x8 __attribute__((ext_vector_type(8)));
typedef float f32x4 __attribute__((ext_vector_type(4)));
typedef unsigned u32x4 __attribute__((ext_vector_type(4)));
constexpr int BM = 256, BK = 64, HALF = 128, HTB = HALF * BK * 2  , STAGE_BYTES = 8 * HTB, NXCD = 8, WGM = 8;

__host__ __device__ __forceinline__ int lds_byte(int r, int c) { const int st = (r >> 4) * 2 + (c >> 5), rr = r & 15, cc = c & 31, ob = rr * 64 + cc * 2; return st * 1024 + (ob ^ (((ob >> 9) & 1) << 5)); }
__host__ __device__ __forceinline__ void stage_rc(int b, int& R, int& C) { const int st = b / 1024, sb = b % 1024, swz = sb ^ (((sb >> 9) & 1) << 5); R = (st >> 1) * 16 + swz / 64; C = (st & 1) * 32 + (swz % 64) / 2; }
__host__ __device__ __forceinline__ int perm32(int rho) { const int n = rho >> 4, i = rho & 15; return 8 * (i >> 2) + 4 * n + (i & 3); }

struct Unit { int pm, pn; };
struct Gemm { const bf16_t* A; const bf16_t* Bt; int M, N, K; };

struct StaticOrder {
    int nM, nN, nwg, G, c;
    __host__ __device__ void init(int M, int N, int G_, int c_) { nM = M / BM; nN = N / BM; nwg = nM * nN; G = G_; c = c_; }
    __host__ __device__ bool next(int i, Unit& u) const {
        const long L = (long)i * G + c; if (L >= nwg) return false;
        int wgid = (int)L; { const int q = nwg / NXCD, r = nwg % NXCD, xcd = wgid % NXCD, off = wgid / NXCD; wgid = (xcd < r ? xcd * (q + 1) : r * (q + 1) + (xcd - r) * q) + off; }
        const int nig = WGM * nN, gid = wgid / nig, fm = gid * WGM, gsz = (nM - fm) < WGM ? (nM - fm) : WGM;
        u.pm = fm + ((wgid % nig) % gsz); u.pn = (wgid % nig) / gsz; return true;
    }
    __device__ __forceinline__ void a_ready(const Unit&) const {}
    __device__ __forceinline__ void done(const Unit&) const {}
};

__device__ __forceinline__ unsigned cvt_pk_bf16(float lo, float hi) { unsigned r; asm volatile("v_cvt_pk_bf16_f32 %0, %1, %2" : "=v"(r) : "v"(lo), "v"(hi)); return r; }
template <class Epi, class Sched, bool ALIGN_EPI = false, bool SP2 = false>
__device__ __forceinline__ void gemm_phase(PG8_LAS unsigned char* lds, const Gemm g, const Sched& S, const Epi& E) {
    int tid_ = threadIdx.x; asm volatile("" : "+v"(tid_));
    const int tid = tid_, wid = __builtin_amdgcn_readfirstlane(tid >> 6), lane = tid & 63, wr = wid >> 2, wc = wid & 3, fr = lane & 15, fq = lane >> 4;
    const int K = g.K, nt = K / BK;
    unsigned voffA[2], voffB[2];
#pragma unroll
    for (int i = 0; i < 2; ++i) { int R, C; stage_rc(tid * 16 + i * 8192, R, C); const int Rb = Epi::PERM ? ((R & ~31) + perm32(R & 31)) : R;
        voffA[i] = (unsigned)(R * K + C) * 2u; voffB[i] = (unsigned)(Rb * K + C) * 2u; }
    const size_t kstep = (size_t)(BK * 2);
    const size_t hstep = (size_t)HALF * K * 2;
    const size_t tstep = 2 * hstep;
    const unsigned ldsw = (unsigned)wid * 1024u;
    const int aoff = lds_byte(wr * 64 + fr, fq * 8), boff = lds_byte(wc * 32 + fr, fq * 8);
#define PG8_SA(b, h) (((b) * 2 + (h)) * HTB)
#define PG8_SB(b, h) ((4 + (b) * 2 + (h)) * HTB)
#define PG8_STAGE(bufoff, gbase, voff) do { _Pragma("unroll") for (int _i = 0; _i < 2; ++_i) \
        __builtin_amdgcn_global_load_lds((const unsigned*)((const char*)(gbase) + (voff)[_i]), (PG8_LAS unsigned*)(lds + (bufoff) + ldsw + _i * 8192), 16, 0, 0); } while (0)
#define PG8_LDA(dst, b, h) do { _Pragma("unroll") for (int m = 0; m < 4; ++m) _Pragma("unroll") for (int k = 0; k < 2; ++k) dst[m][k] = *(const PG8_LAS bf16x8*)(lds + PG8_SA(b, h) + aoff + m * 2048 + k * 1024); } while (0)
#define PG8_LDB(dst, b, h) do { _Pragma("unroll") for (int n = 0; n < 2; ++n) _Pragma("unroll") for (int k = 0; k < 2; ++k) dst[n][k] = *(const PG8_LAS bf16x8*)(lds + PG8_SB(b, h) + boff + n * 2048 + k * 1024); } while (0)
#define PG8_MMA(ai, bj, At, Bt) do { __builtin_amdgcn_s_setprio(1); _Pragma("unroll") for (int m = 0; m < 4; ++m) _Pragma("unroll") for (int n = 0; n < 2; ++n) _Pragma("unroll") for (int k = 0; k < 2; ++k) \
        acc[ai][bj][m][n] = __builtin_amdgcn_mfma_f32_16x16x32_bf16(Bt[n][k], At[m][k], acc[ai][bj][m][n], 0, 0, 0); __builtin_amdgcn_s_setprio(0); } while (0)
#define PG8_WAIT_V(n) asm volatile("s_waitcnt vmcnt(" #n ")" ::: "memory")
#define PG8_WAIT_L(n) asm volatile("s_waitcnt lgkmcnt(" #n ")" ::: "memory")
#define PG8_BAR __builtin_amdgcn_s_barrier()
#define PG8_SCHED __builtin_amdgcn_sched_barrier(0)
    Unit cur, nxt; int ui = 0;
    if (!S.next(0, cur)) return;
    f32x4 acc[2][2][4][2];
#pragma unroll
    for (int a = 0; a < 2; ++a)
#pragma unroll
        for (int b = 0; b < 2; ++b)
#pragma unroll
            for (int m = 0; m < 4; ++m)
#pragma unroll
                for (int n = 0; n < 2; ++n) acc[a][b][m][n] = (f32x4){0.f, 0.f, 0.f, 0.f};
    bf16x8 At[4][2], B0[2][2], B1[2][2];
    const char* cA = (const char*)g.A + (size_t)cur.pm * tstep; const char* cB = (const char*)g.Bt + (size_t)cur.pn * tstep;
    S.a_ready(cur);
    if constexpr (SP2) {
        PG8_STAGE(PG8_SB(0, 0), cB, voffB); PG8_STAGE(PG8_SB(0, 1), cB + hstep, voffB); PG8_STAGE(PG8_SA(0, 0), cA, voffA); PG8_STAGE(PG8_SA(0, 1), cA + hstep, voffA);
        if (wr == 1) PG8_BAR;
        PG8_WAIT_V(2); PG8_BAR;
        PG8_STAGE(PG8_SB(1, 0), cB + kstep, voffB); PG8_STAGE(PG8_SA(1, 0), cA + kstep, voffA); PG8_STAGE(PG8_SB(1, 1), cB + hstep + kstep, voffB);
        PG8_WAIT_V(6); PG8_BAR;
    } else {
        PG8_STAGE(PG8_SB(0, 0), cB, voffB); PG8_STAGE(PG8_SA(0, 0), cA, voffA); PG8_STAGE(PG8_SB(0, 1), cB + hstep, voffB); PG8_STAGE(PG8_SA(0, 1), cA + hstep, voffA);
        if (wr == 1) PG8_BAR;
        PG8_WAIT_V(4); PG8_BAR;
        PG8_STAGE(PG8_SB(1, 0), cB + kstep, voffB); PG8_STAGE(PG8_SA(1, 0), cA + kstep, voffA); PG8_STAGE(PG8_SB(1, 1), cB + hstep + kstep, voffB);
        PG8_WAIT_V(6); PG8_BAR;
    }
    for (;;) {
        const bool has_next = S.next(ui + 1, nxt);
        const char* nA = has_next ? (const char*)g.A + (size_t)nxt.pm * tstep : cA; const char* nB = has_next ? (const char*)g.Bt + (size_t)nxt.pn * tstep : cB;
        for (int t = 0; t < nt; t += 2) {
            const bool last = (t == nt - 2);
            const char* a1 = cA + (size_t)(t + 1) * kstep;
            const char* a2 = last ? nA : cA + (size_t)(t + 2) * kstep; const char* b2 = last ? nB : cB + (size_t)(t + 2) * kstep;
            const char* a3 = a2 + kstep; const char* b3 = b2 + kstep;
            if (last && has_next) S.a_ready(nxt);
            if constexpr (SP2) {
            PG8_LDB(B0, 0, 0); PG8_LDB(B1, 0, 1); PG8_SCHED; PG8_LDA(At, 0, 0); PG8_STAGE(PG8_SA(1, 1), a1 + hstep, voffA);
            PG8_WAIT_V(8); PG8_WAIT_L(0); PG8_BAR; PG8_MMA(0, 0, At, B0); PG8_MMA(0, 1, At, B1); PG8_BAR; PG8_SCHED;
            PG8_LDA(At, 0, 1); PG8_STAGE(PG8_SB(0, 0), b2, voffB); PG8_STAGE(PG8_SB(0, 1), b2 + hstep, voffB); PG8_STAGE(PG8_SA(0, 0), a2, voffA);
            PG8_WAIT_V(8); PG8_WAIT_L(0); PG8_BAR; PG8_MMA(1, 0, At, B0); PG8_MMA(1, 1, At, B1); PG8_BAR; PG8_SCHED;
            PG8_LDB(B0, 1, 0); PG8_LDB(B1, 1, 1); PG8_SCHED; PG8_LDA(At, 1, 0); PG8_STAGE(PG8_SA(0, 1), a2 + hstep, voffA);
            PG8_WAIT_V(8); PG8_WAIT_L(0); PG8_BAR; PG8_MMA(0, 0, At, B0); PG8_MMA(0, 1, At, B1); PG8_BAR; PG8_SCHED;
            PG8_LDA(At, 1, 1); PG8_STAGE(PG8_SB(1, 0), b3, voffB); PG8_STAGE(PG8_SB(1, 1), b3 + hstep, voffB); PG8_STAGE(PG8_SA(1, 0), a3, voffA);
            PG8_WAIT_V(8); PG8_WAIT_L(0); PG8_BAR; PG8_MMA(1, 0, At, B0); PG8_MMA(1, 1, At, B1); PG8_BAR; PG8_SCHED;
            } else {
            PG8_LDB(B0, 0, 0); PG8_SCHED; PG8_LDA(At, 0, 0); PG8_STAGE(PG8_SA(1, 1), a1 + hstep, voffA);
            PG8_WAIT_L(8); PG8_BAR; PG8_WAIT_L(0); PG8_MMA(0, 0, At, B0); PG8_BAR; PG8_SCHED;
            PG8_LDB(B1, 0, 1); PG8_STAGE(PG8_SB(0, 0), b2, voffB);
            PG8_BAR; PG8_WAIT_L(0); PG8_MMA(0, 1, At, B1); PG8_BAR;
            PG8_LDA(At, 0, 1); PG8_STAGE(PG8_SA(0, 0), a2, voffA);
            PG8_BAR; PG8_WAIT_L(0); PG8_MMA(1, 0, At, B0); PG8_BAR; PG8_SCHED;
            PG8_STAGE(PG8_SB(0, 1), b2 + hstep, voffB);
            PG8_WAIT_V(6); PG8_BAR; PG8_MMA(1, 1, At, B1); PG8_BAR;
            PG8_LDB(B0, 1, 0); PG8_SCHED; PG8_LDA(At, 1, 0); PG8_STAGE(PG8_SA(0, 1), a2 + hstep, voffA);
            PG8_WAIT_L(8); PG8_BAR; PG8_WAIT_L(0); PG8_MMA(0, 0, At, B0); PG8_BAR; PG8_SCHED;
            PG8_LDB(B1, 1, 1); PG8_STAGE(PG8_SB(1, 0), b3, voffB);
            PG8_BAR; PG8_WAIT_L(0); PG8_MMA(0, 1, At, B1); PG8_BAR;
            PG8_LDA(At, 1, 1); PG8_STAGE(PG8_SA(1, 0), a3, voffA);
            PG8_BAR; PG8_WAIT_L(0); PG8_MMA(1, 0, At, B0); PG8_BAR; PG8_SCHED;
            PG8_STAGE(PG8_SB(1, 1), b3 + hstep, voffB);
            PG8_WAIT_V(6); PG8_BAR; PG8_MMA(1, 1, At, B1); PG8_BAR;
            }
        }
        if constexpr (ALIGN_EPI) { if (wr == 0) PG8_BAR; }
        if constexpr (!Epi::AFTER_DRAIN) { E(acc, cur, wr, wc, fr, fq); S.done(cur); }
        if (!has_next) break;
#pragma unroll
        for (int a = 0; a < 2; ++a)
#pragma unroll
            for (int b = 0; b < 2; ++b)
#pragma unroll
                for (int m = 0; m < 4; ++m)
#pragma unroll
                    for (int n = 0; n < 2; ++n) acc[a][b][m][n] = (f32x4){0.f, 0.f, 0.f, 0.f};
        cur = nxt; cA = nA; cB = nB; ++ui;
        if constexpr (ALIGN_EPI) { if (wr == 1) PG8_BAR; }
    }
    PG8_WAIT_V(0);
    if constexpr (!ALIGN_EPI) { if (wr == 0) PG8_BAR; }
    PG8_BAR;
    if constexpr (Epi::AFTER_DRAIN) { E.fused(acc, cur, wr, wc, fr, fq, lds, wid, lane); S.done(cur); }
#undef PG8_SA
#undef PG8_SB
#undef PG8_STAGE
#undef PG8_LDA
#undef PG8_LDB
#undef PG8_MMA
#undef PG8_WAIT_V
#undef PG8_WAIT_L
#undef PG8_BAR
#undef PG8_SCHED
}
}

constexpr int DM = 4096, NBATCH = 2, SEQ = 8192, DEPTH = 4, CTXL = 256;
constexpr int NLAT = NBATCH * SEQ, NCTX = NBATCH * CTXL, MROWS = NLAT + NCTX;
constexpr int NIN = 13568, GWD = 1024;
constexpr int C_POOLV = 0, C_POOLZ = 1024, C_NAZ = 2048, C_RWZ = 3072, C_SGU = 4096, C_SGZ = 5120, C_NAQ = 6144, C_NAK = 7168, C_NAV = 8192, C_RWR = 9216, C_RWK = 10240, C_RWV = 11264,
              C_RWWD = 12288, C_RWAD = 12416, C_SGV = 12544;
constexpr int C_SPLIT = 5632;
__host__ __device__ __forceinline__ int phys_tile(int lt) {
    return lt < 8 ? lt : lt < 20 ? lt + 16 : lt < 24 ? lt - 12 : lt < 36 ? lt + 12 : lt < 40 ? lt - 24 : lt == 40 ? 48 : lt < 45 ? lt - 25 : lt < 49 ? lt + 4 : lt - 29;
}
constexpr int SCANLEN = CTXL + SEQ;
constexpr int NCHAIN = 64;
constexpr int RECB = 896;
constexpr int RECF = RECB / 4;
constexpr int NWAVES = 8;

constexpr size_t MiB = 1u << 20;
constexpr size_t WS_CTL = 0, CTL_ZERO_BYTES = 1 * MiB;
constexpr size_t WS_MOD   = 2 * MiB;
constexpr size_t WS_TAB   = 3 * MiB;
constexpr size_t WS_SILUC = 3 * MiB + 512 * 1024;
constexpr size_t WS_SGST  = 4 * MiB;
constexpr size_t WS_BON   = 5 * MiB;
constexpr size_t WS_POOLWT= 8 * MiB;
constexpr size_t WS_WUPT  = 10 * MiB;
constexpr size_t WS_AUPT  = 11 * MiB;
constexpr size_t WS_SGW   = 12 * MiB;
constexpr size_t WS_VTC   = 13 * MiB;
constexpr size_t WS_HCTX  = 14 * MiB;
constexpr size_t WS_MODP  = 22 * MiB;
constexpr size_t WS_VTL   = 58 * MiB;
constexpr size_t WS_QN    = 90 * MiB;
constexpr size_t WS_KN    = 123 * MiB;
constexpr size_t WS_WOUTT = 156 * MiB;
constexpr size_t WS_WINT  = 284 * MiB;
constexpr size_t WS_XN    = 708 * MiB;
constexpr size_t WS_Y     = 840 * MiB;
constexpr size_t WS_P     = 972 * MiB;
constexpr size_t WS_YR    = 1410 * MiB;
constexpr size_t WS_REC   = 1542 * MiB;
constexpr size_t WS_END   = 2334 * MiB;
static_assert(WS_P + (size_t)MROWS * NIN * 2 <= WS_YR && WS_REC + (size_t)NCHAIN * SCANLEN * RECB <= WS_END && WS_WINT + (size_t)4 * NIN * DM * 2 <= WS_XN, "ws map");
constexpr int CW_TMO = 0, CW_BAR = 4096;

constexpr int RING_BYTES = 131072, LDSCTL_OFF = RING_BYTES, MISC_OFF = LDSCTL_OFF + 320, LDS_BYTES = 147456;

#define GAS __attribute__((address_space(1)))
#define LAS __attribute__((address_space(3)))
typedef unsigned short bf16;
typedef unsigned v4u __attribute__((ext_vector_type(4)));
typedef unsigned v2u __attribute__((ext_vector_type(2)));
typedef float f32x4 __attribute__((ext_vector_type(4)));
typedef float f32x2 __attribute__((ext_vector_type(2)));
typedef short bf16x8 __attribute__((ext_vector_type(8)));
typedef _Float16 h4 __attribute__((ext_vector_type(4)));
typedef _Float16 h8 __attribute__((ext_vector_type(8)));
#define RLX_AGENT __ATOMIC_RELAXED, __HIP_MEMORY_SCOPE_AGENT
#define LDS_WAIT() asm volatile("s_waitcnt lgkmcnt(0)" ::: "memory")

__device__ __forceinline__ float bf2f(unsigned short h) { return __uint_as_float(((unsigned)h) << 16); }
__device__ __forceinline__ float bflo(unsigned w) { return __uint_as_float(w << 16); }
__device__ __forceinline__ float bfhi(unsigned w) { return __uint_as_float(w & 0xffff0000u); }
typedef __bf16 bf16x2_t __attribute__((ext_vector_type(2)));
__device__ __forceinline__ unsigned pk2(float lo, float hi) { const f32x2 v = {lo, hi}; const bf16x2_t b = __builtin_convertvector(v, bf16x2_t); return __builtin_bit_cast(unsigned, b); }
__device__ __forceinline__ unsigned f2bf(float f) { return pk2(f, 0.f) & 0xffffu; }
__device__ __forceinline__ float rcp_f(float x) { return __builtin_amdgcn_rcpf(x); }
__device__ __forceinline__ float rsq_f(float x) { return __builtin_amdgcn_rsqf(x); }
__device__ __forceinline__ void unpack8(const v4u w, float* x) { x[0] = bflo(w.x); x[1] = bfhi(w.x); x[2] = bflo(w.y); x[3] = bfhi(w.y); x[4] = bflo(w.z); x[5] = bfhi(w.z); x[6] = bflo(w.w); x[7] = bfhi(w.w); }
__device__ __forceinline__ v4u pack8(const float* x) { v4u w; w.x = pk2(x[0], x[1]); w.y = pk2(x[2], x[3]); w.z = pk2(x[4], x[5]); w.w = pk2(x[6], x[7]); return w; }
__device__ __forceinline__ float silu_f(float x) { return x * rcp_f(1.f + __expf(-x)); }
__device__ __forceinline__ float wave_sum(float v) {
#pragma unroll
    for (int o = 1; o < 64; o <<= 1) v += __shfl_xor(v, o);
    return v;
}
template <int CTRL> __device__ __forceinline__ float dppf(float v) { return __builtin_bit_cast(float, __builtin_amdgcn_update_dpp(0, __builtin_bit_cast(int, v), CTRL, 0xF, 0xF, true)); }
__device__ __forceinline__ float red16(float v) { v += dppf<0xB1>(v); v += dppf<0x4E>(v); v += dppf<0x141>(v); v += dppf<0x140>(v); return v; }
__device__ __forceinline__ void red16x2(float& a, float& b) {
    a += dppf<0xB1>(a); b += dppf<0xB1>(b); a += dppf<0x4E>(a); b += dppf<0x4E>(b); a += dppf<0x141>(a); b += dppf<0x141>(b); a += dppf<0x140>(a); b += dppf<0x140>(b); }
__device__ __forceinline__ float red16_transpose(const float (&y)[16], int c16) {
    float a[8], b[4], c[2];
    const bool h8 = (c16 & 8) != 0, h4 = (c16 & 4) != 0, h2 = (c16 & 2) != 0, h1 = (c16 & 1) != 0;
#pragma unroll
    for (int j = 0; j < 8; ++j) { const float keep = h8 ? y[j + 8] : y[j], send = h8 ? y[j] : y[j + 8]; a[j] = keep + dppf<0x140>(send); }
#pragma unroll
    for (int j = 0; j < 4; ++j) { const float keep = h4 ? a[j + 4] : a[j], send = h4 ? a[j] : a[j + 4]; b[j] = keep + dppf<0x141>(send); }
#pragma unroll
    for (int j = 0; j < 2; ++j) { const float keep = h2 ? b[j + 2] : b[j], send = h2 ? b[j] : b[j + 2]; c[j] = keep + dppf<0x1B>(send); }
    const float keep = h1 ? c[1] : c[0], send = h1 ? c[0] : c[1];
    return keep + dppf<0xB1>(send);
}
__device__ __forceinline__ float max16x4(float v) { v = fmaxf(v, __shfl_xor(v, 16)); v = fmaxf(v, __shfl_xor(v, 32)); return v; }
__device__ __forceinline__ float sum16x4(float v) { v += __shfl_xor(v, 16); v += __shfl_xor(v, 32); return v; }
__device__ __forceinline__ int scan_pos(int d, bool isctx, int t) { return d == 0 ? (isctx ? t : CTXL + t) : (isctx ? (CTXL - 1 - t) : (CTXL + SEQ - 1 - t)); }
__device__ __forceinline__ f32x4 mfma16(bf16x8 a, bf16x8 b, f32x4 c) { return __builtin_amdgcn_mfma_f32_16x16x32_bf16(a, b, c, 0, 0, 0); }
__device__ __forceinline__ bf16x8 ld_frag(const bf16* p) { return __builtin_bit_cast(bf16x8, *(const v4u*)p); }

namespace pg8 {
struct EpiStoreBf16 {
    static constexpr bool PERM = true, AFTER_DRAIN = false;
    bf16_t* O; int ldc;
    __device__ __forceinline__ void operator()(const f32x4 (&acc)[2][2][4][2], const Unit& u, int wr, int wc, int fr, int fq) const {
        const int row0 = u.pm * BM + wr * 64 + fr, col0 = u.pn * BM + wc * 32 + 8 * fq;
#pragma unroll
        for (int ai = 0; ai < 2; ++ai)
#pragma unroll
            for (int m = 0; m < 4; ++m) { bf16_t* rowp = O + (size_t)(row0 + ai * HALF + m * 16) * ldc + col0;
#pragma unroll
                for (int bj = 0; bj < 2; ++bj) { const f32x4 v0 = acc[ai][bj][m][0], v1 = acc[ai][bj][m][1];
                    u32x4 w; w.x = cvt_pk_bf16(v0[0], v0[1]); w.y = cvt_pk_bf16(v0[2], v0[3]); w.z = cvt_pk_bf16(v1[0], v1[1]); w.w = cvt_pk_bf16(v1[2], v1[3]);
                    *(u32x4*)(rowp + bj * HALF) = w; } }
    }
};
struct EpiResGate {
    static constexpr bool PERM = false, AFTER_DRAIN = false;
    const float* hin_lat; const float* hin_ctx; float* hout_lat; float* hout_ctx; const float* gate;
    __device__ __forceinline__ void operator()(const f32x4 (&acc)[2][2][4][2], const Unit& u, int wr, int wc, int fr, int fq) const {
        const int cond = u.pm < 32 ? 0 : (u.pm < 64 ? 1 : 2);
        const int rloc = (u.pm < 64 ? u.pm * BM : (u.pm - 64) * BM) + wr * 64 + fr, col0 = u.pn * BM + wc * 32 + 4 * fq;
        const float* hin = u.pm < 64 ? hin_lat : hin_ctx; float* hout = u.pm < 64 ? hout_lat : hout_ctx;
        f32x4 gv[2][2];
#pragma unroll
        for (int bj = 0; bj < 2; ++bj)
#pragma unroll
            for (int n = 0; n < 2; ++n) gv[bj][n] = *(const f32x4*)(gate + cond * 12288 + 8192 + col0 + bj * HALF + n * 16);
#pragma unroll
        for (int ai = 0; ai < 2; ++ai)
#pragma unroll
            for (int m = 0; m < 4; ++m) { const size_t off = (size_t)(rloc + ai * HALF + m * 16) * 4096 + col0;
#pragma unroll
                for (int bj = 0; bj < 2; ++bj)
#pragma unroll
                    for (int n = 0; n < 2; ++n) { const f32x4 b = *(const f32x4*)(hin + off + bj * HALF + n * 16);
                        *(f32x4*)(hout + off + bj * HALF + n * 16) = b + gv[bj][n] * acc[ai][bj][m][n]; } }
    }
};
}

template <bool PERMC = false>
__device__ __forceinline__ void p0_transpose_item(const float* W, int K, int N, bf16* WT, LAS float* scr, int item, int lane) {
    const int nblk = N / 32, kb = item / nblk, nb = item % nblk, k0 = 64 * kb, n0 = 32 * nb;
    const int pn0 = PERMC ? phys_tile(n0 >> 8) * 256 + (n0 & 255) : n0;
#pragma unroll 8
    for (int i = 0; i < 32; ++i) { const int kk = 2 * i + (lane >> 5); scr[kk * 33 + (lane & 31)] = W[(size_t)(k0 + kk) * N + n0 + (lane & 31)]; }
    LDS_WAIT(); asm volatile("" ::: "memory");
    const int c = lane & 7;
#pragma unroll
    for (int j = 0; j < 4; ++j) { const int n = (lane >> 3) + 8 * j; const LAS float* s = scr + (8 * c) * 33 + n;
        v4u o; o.x = pk2(s[0 * 33], s[1 * 33]); o.y = pk2(s[2 * 33], s[3 * 33]); o.z = pk2(s[4 * 33], s[5 * 33]); o.w = pk2(s[6 * 33], s[7 * 33]);
        *(v4u*)(WT + (size_t)(pn0 + n) * K + k0 + 8 * c) = o; }
    LDS_WAIT(); asm volatile("" ::: "memory");
}
template <bool PERMC = false>
__device__ __forceinline__ void transpose_item_nolds(const float* W, int K, int N, bf16* WT, int item, int lane) {
    const int nblk = N / 64, kb = item / nblk, nb = item % nblk, k0 = 64 * kb, n0 = 64 * nb;
    const int pn0 = PERMC ? phys_tile(n0 >> 8) * 256 + (n0 & 255) : n0;
    const float* src = W + (size_t)k0 * N + n0 + lane;
    bf16* dst = WT + (size_t)(pn0 + lane) * K + k0;
#pragma unroll
    for (int hb = 0; hb < 2; ++hb) {
        float v[32];
#pragma unroll
        for (int i = 0; i < 32; ++i) v[i] = __builtin_nontemporal_load(src + (size_t)(32 * hb + i) * N);
        __builtin_amdgcn_sched_barrier(0);
#pragma unroll
        for (int j = 0; j < 4; ++j) { v4u o; o.x = pk2(v[8 * j], v[8 * j + 1]); o.y = pk2(v[8 * j + 2], v[8 * j + 3]); o.z = pk2(v[8 * j + 4], v[8 * j + 5]); o.w = pk2(v[8 * j + 6], v[8 * j + 7]);
            *(v4u*)(dst + 32 * hb + 8 * j) = o; }
        __builtin_amdgcn_sched_barrier(0);
    }
}
constexpr int WC_WIN = (DM / 64) * (NIN / 64), WC_WOUT = (DM / 64) * (DM / 64), WC_POOL = 4 * 16, WC_WUP = 2 * 16, WC_AUP = 2 * 16, WC_SGW = 256, WC_ITEMS = WC_WIN + WC_WOUT + WC_POOL + WC_WUP + WC_AUP + WC_SGW;
__device__ __forceinline__ void weight_copy_item(int L, int r, const float* w_in, const float* w_out, const float* pool_w, const float* rw_w_up, const float* rw_a_up, const float* sg_w,
                                                 bf16* WINT, bf16* WOUTT, bf16* POOLWT, bf16* WUPT, bf16* AUPT, bf16* SGW, int lane) {
    if (r < WC_WIN) { transpose_item_nolds<true>(w_in + (size_t)L * DM * NIN, DM, NIN, WINT + (size_t)L * NIN * DM, r, lane); return; } r -= WC_WIN;
    if (r < WC_WOUT) { transpose_item_nolds(w_out + (size_t)L * DM * DM, DM, DM, WOUTT + (size_t)L * DM * DM, r, lane); return; } r -= WC_WOUT;
    if (r < WC_POOL) { const int g = r >> 4; transpose_item_nolds(pool_w + (size_t)(L * 4 + g) * 65536, 256, 256, POOLWT + (size_t)(L * 4 + g) * 65536, r & 15, lane); return; } r -= WC_POOL;
    if (r < WC_WUP) { const int dd = r >> 4; transpose_item_nolds(rw_w_up + (size_t)(L * 2 + dd) * 65536, 64, 1024, WUPT + (size_t)(L * 2 + dd) * 65536, r & 15, lane); return; } r -= WC_WUP;
    if (r < WC_AUP) { const int dd = r >> 4; transpose_item_nolds(rw_a_up + (size_t)(L * 2 + dd) * 65536, 64, 1024, AUPT + (size_t)(L * 2 + dd) * 65536, r & 15, lane); return; } r -= WC_AUP;
    {   const size_t e0 = (size_t)L * 131072 + (size_t)r * 512 + lane * 8; const f32x4 a = *(const f32x4*)(sg_w + e0), b = *(const f32x4*)(sg_w + e0 + 4);
        v4u o; o.x = pk2(a.x, a.y); o.y = pk2(a.z, a.w); o.z = pk2(b.x, b.y); o.w = pk2(b.z, b.w); *(v4u*)(SGW + e0) = o; }
}
__device__ __forceinline__ void p0_mod_item(const float* wmod, const float* cvec, const float* cctx, float* MODP, LAS float* scr, int item, int lane) {
    const int l = item / (64 * 48), r = item % (64 * 48), kc = r / 48, nc = r % 48, k0 = kc * 64, n0 = nc * 256 + lane * 4;
    scr[lane] = silu_f(cvec[k0 + lane]); scr[64 + lane] = silu_f(cvec[4096 + k0 + lane]); scr[128 + lane] = silu_f(cctx[k0 + lane]);
    LDS_WAIT(); asm volatile("" ::: "memory");
    f32x4 a0 = {0.f, 0.f, 0.f, 0.f}, a1 = a0, a2 = a0;
    const float* wp = wmod + ((size_t)l * 4096 + k0) * 12288 + n0;
#pragma unroll 16
    for (int k = 0; k < 64; ++k) { const f32x4 w = *(const f32x4*)(wp + (size_t)k * 12288); a0 += scr[k] * w; a1 += scr[64 + k] * w; a2 += scr[128 + k] * w; }
    float* o = MODP + ((size_t)(l * 64 + kc) * 3) * 12288 + n0;
    *(f32x4*)(o) = a0; *(f32x4*)(o + 12288) = a1; *(f32x4*)(o + 2 * 12288) = a2;
    LDS_WAIT(); asm volatile("" ::: "memory");
}
__device__ __forceinline__ void mod_item_nolds(const float* wmod_l  , const float* siluc, float* MODP_l  , int item, int lane) {
    const int kc = item / 48, nc = item % 48, k0 = kc * 64, n0 = nc * 256 + lane * 4;
    f32x4 a0 = {0.f, 0.f, 0.f, 0.f}, a1 = a0, a2 = a0;
    const float* wp = wmod_l + (size_t)k0 * 12288 + n0;
    const int s0v = __builtin_bit_cast(int, siluc[k0 + lane]), s1v = __builtin_bit_cast(int, siluc[4096 + k0 + lane]), s2v = __builtin_bit_cast(int, siluc[8192 + k0 + lane]);
#pragma unroll
    for (int k = 0; k < 64; ++k) { const f32x4 w = __builtin_nontemporal_load((const f32x4*)(wp + (size_t)k * 12288));
        a0 += __builtin_bit_cast(float, __builtin_amdgcn_readlane(s0v, k)) * w; a1 += __builtin_bit_cast(float, __builtin_amdgcn_readlane(s1v, k)) * w; a2 += __builtin_bit_cast(float, __builtin_amdgcn_readlane(s2v, k)) * w; }
    float* o = MODP_l + ((size_t)kc * 3) * 12288 + n0;
    *(f32x4*)(o) = a0; *(f32x4*)(o + 12288) = a1; *(f32x4*)(o + 2 * 12288) = a2;
}
__device__ __forceinline__ void sincos_acc(float ang, float& c, float& s) {
    const double x = (double)ang; const double n = __builtin_rint(x * 0.63661977236758134308); const double r = x - n * 1.57079632679489661923;
    const double r2 = r * r;
    const double sp = r * (1.0 + r2 * (-1.0 / 6 + r2 * (1.0 / 120 + r2 * (-1.0 / 5040 + r2 * (1.0 / 362880 + r2 * (-1.0 / 39916800 + r2 * (1.0 / 6227020800.0)))))));
    const double cp = 1.0 + r2 * (-0.5 + r2 * (1.0 / 24 + r2 * (-1.0 / 720 + r2 * (1.0 / 40320 + r2 * (-1.0 / 3628800 + r2 * (1.0 / 479001600 + r2 * (-1.0 / 87178291200.0)))))));
    const int q = ((int)n) & 3;
    const double cc = (q == 0) ? cp : (q == 1) ? -sp : (q == 2) ? -cp : sp;
    const double ss = (q == 0) ? sp : (q == 1) ? cp : (q == 2) ? -sp : -cp;
    c = (float)cc; s = (float)ss;
}

__device__ __forceinline__ void phase_xn(const float* hlat, const float* hctx, const float* mod, bf16* XN, int gw, int NGW, int lane) {
    for (int m = gw; m < MROWS; m += NGW) {
        const float* src = m < NLAT ? hlat + (size_t)m * DM : hctx + (size_t)(m - NLAT) * DM;
        const int cond = m < NLAT ? (m >> 13) : 2;
        const f32x4* s4 = (const f32x4*)src + lane;
        f32x4 v[16]; float ss = 0.f;
#pragma unroll
        for (int j = 0; j < 16; ++j) { v[j] = __builtin_nontemporal_load(s4 + 64 * j); ss += (v[j].x * v[j].x + v[j].y * v[j].y) + (v[j].z * v[j].z + v[j].w * v[j].w); }
        ss = wave_sum(ss);
        const float rstd = rsq_f(ss * (1.f / 4096.f) + 1e-6f);
        const f32x4* sh4 = (const f32x4*)(mod + cond * 12288) + lane; const f32x4* sc4 = (const f32x4*)(mod + cond * 12288 + 4096) + lane;
        v2u* o = (v2u*)(XN + (size_t)m * DM) + lane;
#pragma unroll
        for (int j = 0; j < 16; ++j) { const f32x4 sh = sh4[64 * j], sc = sc4[64 * j]; const f32x4 x = v[j] * rstd * (sc + 1.f) + sh; v2u w; w.x = pk2(x.x, x.y); w.y = pk2(x.z, x.w); o[64 * j] = w; }
    }
}

__device__ __forceinline__ void phase_rowprep(const bf16* P, const float* qgain, const float* kgain, const f32x2* tab, bf16* QN, bf16* KN, f32x2* SGST, int gw, int NGW, int lane) {
    const int sub = lane & 3;
    for (int m = gw; m < MROWS; m += NGW) {
        const bf16* pr = P + (size_t)m * NIN;
        const bool isctx = m >= NLAT; const int t = isctx ? ((m - NLAT) & 255) : (m & 8191);
        {   float x[16]; unpack8(*(const v4u*)(pr + C_SGV + 16 * lane), x); unpack8(*(const v4u*)(pr + C_SGV + 16 * lane + 8), x + 8);
            float s = 0.f;
#pragma unroll
            for (int i = 0; i < 16; ++i) s += x[i];
            const float mean = wave_sum(s) * (1.f / 1024.f); float q = 0.f;
#pragma unroll
            for (int i = 0; i < 16; ++i) { const float dlt = x[i] - mean; q += dlt * dlt; }
            const float var = wave_sum(q) * (1.f / 1024.f);
            if (lane == 0) SGST[m] = (f32x2){mean, rsq_f(var + 1e-5f)}; }
        float q[16], k[16];
        unpack8(*(const v4u*)(pr + C_NAQ + 16 * lane), q); unpack8(*(const v4u*)(pr + C_NAQ + 16 * lane + 8), q + 8);
        unpack8(*(const v4u*)(pr + C_NAK + 16 * lane), k); unpack8(*(const v4u*)(pr + C_NAK + 16 * lane + 8), k + 8);
        float sq = 0.f, sk = 0.f;
#pragma unroll
        for (int i = 0; i < 16; ++i) { sq += q[i] * q[i]; sk += k[i] * k[i]; }
        sq += __shfl_xor(sq, 1); sq += __shfl_xor(sq, 2); sk += __shfl_xor(sk, 1); sk += __shfl_xor(sk, 2);
        const float rq = rsq_f(sq * (1.f / 64.f) + 1e-6f), rk = rsq_f(sk * (1.f / 64.f) + 1e-6f);
#pragma unroll
        for (int i = 0; i < 16; ++i) { q[i] *= rq * qgain[16 * sub + i]; k[i] *= rk * kgain[16 * sub + i]; }
        if (!isctx) {
            const int pos = sub < 2 ? (t >> 6) : (t & 63);
#pragma unroll
            for (int i = 0; i < 16; ++i) { const f32x2 cs = tab[pos * 16 + i]; const float pq = __shfl_xor(q[i], 1), pkk = __shfl_xor(k[i], 1);
                q[i] = (sub & 1) ? (q[i] * cs.x + pq * cs.y) : (q[i] * cs.x - pq * cs.y);
                k[i] = (sub & 1) ? (k[i] * cs.x + pkk * cs.y) : (k[i] * cs.x - pkk * cs.y); }
        }
#pragma unroll
        for (int i = 0; i < 16; ++i) q[i] *= 0.125f;
        *(v4u*)(QN + (size_t)m * GWD + 16 * lane) = pack8(q); *(v4u*)(QN + (size_t)m * GWD + 16 * lane + 8) = pack8(q + 8);
        *(v4u*)(KN + (size_t)m * GWD + 16 * lane) = pack8(k); *(v4u*)(KN + (size_t)m * GWD + 16 * lane + 8) = pack8(k + 8);
    }
}
__device__ __forceinline__ void phase_vt(const bf16* P, bf16* VTL, bf16* VTC, int gw, int NGW, int lane) {
    for (int u = gw; u < (MROWS / 64) * 16; u += NGW) {
        const int tt = u >> 4, h = u & 15, m0 = tt * 64;
        const bf16* src = P + (size_t)m0 * NIN + C_NAV + h * 64 + lane;
        unsigned w[32];
#pragma unroll
        for (int i = 0; i < 32; ++i) { const unsigned lo = src[(size_t)(2 * i) * NIN], hi = src[(size_t)(2 * i + 1) * NIN]; w[i] = lo | (hi << 16); }
        bf16* dst = tt < 256 ? VTL + (((size_t)((tt >> 7) * 16 + h) * 64 + lane) * 8192 + (tt & 127) * 64)
                             : VTC + (((size_t)(((tt - 256) >> 2) * 16 + h) * 64 + lane) * 256 + ((tt - 256) & 3) * 64);
#pragma unroll
        for (int j = 0; j < 8; ++j) { v4u o; o.x = w[4 * j]; o.y = w[4 * j + 1]; o.z = w[4 * j + 2]; o.w = w[4 * j + 3]; ((v4u*)dst)[j] = o; }
    }
}
template <int G>
__device__ __forceinline__ void pool_unit(const bf16* P, const bf16* wbase, const float* pscale, bf16* Y, int m0, int lane) {
    constexpr int WIN = 2 << G;
    const int r = lane & 15, q4 = lane >> 4, m = m0 + r;
    const bool isctx = m0 >= NLAT; const int T = isctx ? CTXL : SEQ; const int t = isctx ? ((m - NLAT) & 255) : (m & 8191);
    const int tlo = t - (WIN >> 1);
    const int lo = tlo < 0 ? 0 : tlo, hi = (tlo + WIN) > T ? T : (tlo + WIN);
    const float inv = rcp_f((float)(hi - lo));
    f32x4 acc[16];
#pragma unroll
    for (int nt = 0; nt < 16; ++nt) acc[nt] = (f32x4){0.f, 0.f, 0.f, 0.f};
#pragma unroll 1
    for (int ks = 0; ks < 8; ++ks) {
        const int ch0 = C_POOLV + G * 256 + 32 * ks + 8 * q4;
        constexpr int WB = WIN < 8 ? WIN : 8;
        bf16x8 bfr[8];
        float sum[8];
#pragma unroll
        for (int j = 0; j < 8; ++j) sum[j] = 0.f;
        const v4u selfw = *(const v4u*)(P + (size_t)m * NIN + ch0);
#pragma unroll
        for (int nt = 0; nt < 8; ++nt) bfr[nt] = ld_frag(wbase + (size_t)(16 * nt + r) * 256 + 32 * ks + 8 * q4);
#pragma unroll
        for (int k0 = 0; k0 < WIN; k0 += WB) {
            v4u wl[WB];
#pragma unroll
            for (int k = 0; k < WB; ++k) { const int tk = tlo + k0 + k; const bool ok = tk >= 0 && tk < T; wl[k] = *(const v4u*)(P + (size_t)(ok ? (m - t + tk) : m) * NIN + ch0); }
            __builtin_amdgcn_sched_barrier(0);
#pragma unroll
            for (int k = 0; k < WB; ++k) { const int tk = tlo + k0 + k; const bool ok = tk >= 0 && tk < T; float x[8]; unpack8(wl[k], x);
#pragma unroll
                for (int j = 0; j < 8; ++j) sum[j] += ok ? x[j] : 0.f; }
            __builtin_amdgcn_sched_barrier(0);
        }
        float self[8]; unpack8(selfw, self);
        float dv[8];
#pragma unroll
        for (int j = 0; j < 8; ++j) dv[j] = sum[j] * inv - self[j];
        const bf16x8 af = __builtin_bit_cast(bf16x8, pack8(dv));
        __builtin_amdgcn_sched_barrier(0);
        bf16x8 bfr2[8];
#pragma unroll
        for (int nt = 0; nt < 8; ++nt) bfr2[nt] = ld_frag(wbase + (size_t)(16 * (nt + 8) + r) * 256 + 32 * ks + 8 * q4);
        __builtin_amdgcn_sched_barrier(0);
#pragma unroll
        for (int nt = 0; nt < 8; ++nt) acc[nt] = mfma16(af, bfr[nt], acc[nt]);
        __builtin_amdgcn_sched_barrier(0);
#pragma unroll
        for (int nt = 0; nt < 8; ++nt) acc[nt + 8] = mfma16(af, bfr2[nt], acc[nt + 8]);
        __builtin_amdgcn_sched_barrier(0);
    }
#pragma unroll
    for (int nh = 0; nh < 4; ++nh) {
        unsigned short zz[4][4]; float ps[4];
#pragma unroll
        for (int nq = 0; nq < 4; ++nq) { const int oc = G * 256 + 16 * (4 * nh + nq) + r; ps[nq] = pscale[oc];
#pragma unroll
            for (int i = 0; i < 4; ++i) zz[nq][i] = P[(size_t)(m0 + 4 * q4 + i) * NIN + C_POOLZ + oc]; }
        __builtin_amdgcn_sched_barrier(0);
#pragma unroll
        for (int nq = 0; nq < 4; ++nq) { const int oc = G * 256 + 16 * (4 * nh + nq) + r;
#pragma unroll
            for (int i = 0; i < 4; ++i) Y[(size_t)(m0 + 4 * q4 + i) * DM + oc] = (bf16)f2bf(acc[4 * nh + nq][i] * ps[nq] * silu_f(bf2f(zz[nq][i]))); }
        __builtin_amdgcn_sched_barrier(0);
    }
}
__device__ __forceinline__ void phase_pool(const bf16* P, const bf16* PWT  , const float* pscale, bf16* Y, int nrows, int gw, int NGW, int lane) {
    for (int u = gw; u < (nrows / 16) * 4; u += NGW) {
        const int tt = u >> 2, g = u & 3, m0 = tt * 16;
        const bf16* wbase = PWT + (size_t)g * 65536;
        if (g == 0) pool_unit<0>(P, wbase, pscale, Y, m0, lane);
        else if (g == 1) pool_unit<1>(P, wbase, pscale, Y, m0, lane);
        else if (g == 2) pool_unit<2>(P, wbase, pscale, Y, m0, lane);
        else pool_unit<3>(P, wbase, pscale, Y, m0, lane);
    }
}
#define REC_ST(p, v) __builtin_nontemporal_store((v), (p))
__device__ __forceinline__ void phase_rwprep(const bf16* P, const float* mu_rkv  , const float* mu_lora  , const float* w0  , const bf16* WUPT  ,
                                             const float* a0, const bf16* AUPT, const float* k_k, const float* k_a, const float* r_k, float* REC, float* BON, LAS unsigned char* lds,
                                             unsigned* queue  , int cls, int wave, int lane) {
    const int n = lane & 15, q4 = lane >> 4;
    const int d = cls >> 3, hp = cls & 7;
    unsigned* qh = queue + 64 * cls;
    LAS float* prm = (LAS float*)(lds + wave * 4096);
#pragma unroll
    for (int it = 0; it < 16; ++it) { const int hh = it >> 3, p = it & 7, ch = (hp * 2 + hh) * 64 + lane;
        const float* src = p == 0 ? w0 + d * 1024 : p == 1 ? a0 + d * 1024 : p == 2 ? mu_rkv + (d * 3 + 0) * 1024 : p == 3 ? mu_rkv + (d * 3 + 1) * 1024 : p == 4 ? mu_rkv + (d * 3 + 2) * 1024 : p == 5 ? k_k : p == 6 ? k_a : r_k;
        prm[it * 64 + lane] = src[ch]; }
    LDS_WAIT(); asm volatile("" ::: "memory");
    unsigned pend = 0u;
    if (lane == 0) pend = __hip_atomic_fetch_add(qh, 1u, __ATOMIC_RELAXED, __HIP_MEMORY_SCOPE_AGENT);
    for (;;) {
        const int tt = __builtin_amdgcn_readfirstlane((int)pend);
        if (tt >= MROWS / 16) break;
        if (lane == 0) pend = __hip_atomic_fetch_add(qh, 1u, __ATOMIC_RELAXED, __HIP_MEMORY_SCOPE_AGENT);
        const int m0 = tt * 16;
        const bool isctx = m0 >= NLAT; const int T = isctx ? CTXL : SEQ; const int t0 = isctx ? ((m0 - NLAT) & 255) : (m0 & 8191); const int b = isctx ? ((m0 - NLAT) >> 8) : (m0 >> 13);
        const int m = m0 + n, t = t0 + n; const bool hasnb = d == 0 ? (t > 0) : (t < T - 1); const int nbr = hasnb ? (d == 0 ? m - 1 : m + 1) : m;
        const bf16* prow = P + (size_t)m * NIN; const bf16* nrow = P + (size_t)nbr * NIN;
        bf16x8 Bw[2], Ba[2];
        {   v4u cw[2], nw[2], ca[2], na[2]; f32x4 mw[2][2], ma[2][2];
#pragma unroll
            for (int ks = 0; ks < 2; ++ks) { const int j0 = 32 * ks + 8 * q4;
                cw[ks] = *(const v4u*)(prow + C_RWWD + d * 64 + j0); nw[ks] = *(const v4u*)(nrow + C_RWWD + d * 64 + j0);
                ca[ks] = *(const v4u*)(prow + C_RWAD + d * 64 + j0); na[ks] = *(const v4u*)(nrow + C_RWAD + d * 64 + j0);
                mw[ks][0] = *(const f32x4*)(mu_lora + (d * 2 + 0) * 64 + j0); mw[ks][1] = *(const f32x4*)(mu_lora + (d * 2 + 0) * 64 + j0 + 4);
                ma[ks][0] = *(const f32x4*)(mu_lora + (d * 2 + 1) * 64 + j0); ma[ks][1] = *(const f32x4*)(mu_lora + (d * 2 + 1) * 64 + j0 + 4); }
            __builtin_amdgcn_sched_barrier(0);
#pragma unroll
            for (int ks = 0; ks < 2; ++ks) {
                float cur[8], nb[8], o[8];
                unpack8(cw[ks], cur); unpack8(nw[ks], nb);
#pragma unroll
                for (int j = 0; j < 8; ++j) { const float xx = cur[j] + ((hasnb ? nb[j] : 0.f) - cur[j]) * mw[ks][j >> 2][j & 3]; o[j] = 1.0f - 2.0f * rcp_f(1.0f + __expf(2.0f * xx)); }
                Bw[ks] = __builtin_bit_cast(bf16x8, pack8(o));
                unpack8(ca[ks], cur); unpack8(na[ks], nb);
#pragma unroll
                for (int j = 0; j < 8; ++j) o[j] = cur[j] + ((hasnb ? nb[j] : 0.f) - cur[j]) * ma[ks][j >> 2][j & 3];
                Ba[ks] = __builtin_bit_cast(bf16x8, pack8(o)); }
        }
        const int pos = scan_pos(d, isctx, t);
#pragma unroll 1
        for (int hh = 0; hh < 2; ++hh) {
            const int head = hp * 2 + hh, chain = (b * 2 + d) * 16 + head;
            char* recb = (char*)REC + ((size_t)chain * SCANLEN + pos) * RECB;
            const LAS float* pr = prm + hh * 512;
            float KK[16], AV[16]; float ss = 0.f, bon = 0.f;
#pragma unroll
            for (int hf = 0; hf < 2; ++hf) {
                const int cl = 32 * hf + 8 * q4, cg = head * 64 + cl;
                bf16x8 wf[2][2], af[2][2];
#pragma unroll
                for (int tq = 0; tq < 2; ++tq) { const size_t wrow = (size_t)(d * 1024 + head * 64 + 32 * hf + 8 * (n >> 2) + 4 * tq + (n & 3)) * 64 + 8 * q4;
                    wf[tq][0] = ld_frag(WUPT + wrow); wf[tq][1] = ld_frag(WUPT + wrow + 32); af[tq][0] = ld_frag(AUPT + wrow); af[tq][1] = ld_frag(AUPT + wrow + 32); }
                const v4u rcw = *(const v4u*)(prow + C_RWR + cg), kcw = *(const v4u*)(prow + C_RWK + cg), vcw = *(const v4u*)(prow + C_RWV + cg);
                const v4u rnw = *(const v4u*)(nrow + C_RWR + cg), knw = *(const v4u*)(nrow + C_RWK + cg), vnw = *(const v4u*)(nrow + C_RWV + cg);
                __builtin_amdgcn_sched_barrier(0);
                f32x4 accW[2], accA[2];
#pragma unroll
                for (int tq = 0; tq < 2; ++tq) { f32x4 z = {0.f, 0.f, 0.f, 0.f}; z = mfma16(wf[tq][0], Bw[0], z); accW[tq] = mfma16(wf[tq][1], Bw[1], z);
                                                 f32x4 y = {0.f, 0.f, 0.f, 0.f}; y = mfma16(af[tq][0], Ba[0], y); accA[tq] = mfma16(af[tq][1], Ba[1], y); }
                float rc[8], kc[8], vc[8], rn[8], kn[8], vn[8];
                unpack8(rcw, rc); unpack8(kcw, kc); unpack8(vcw, vc); unpack8(rnw, rn); unpack8(knw, kn); unpack8(vnw, vn);
                float dec[8], kp[8], rr[8], vv[8];
#pragma unroll
                for (int g = 0; g < 2; ++g) {
                    const f32x4 w0v = *(const LAS f32x4*)(pr + 0 * 64 + cl + 4 * g), a0v = *(const LAS f32x4*)(pr + 1 * 64 + cl + 4 * g), mur = *(const LAS f32x4*)(pr + 2 * 64 + cl + 4 * g),
                                muk = *(const LAS f32x4*)(pr + 3 * 64 + cl + 4 * g), muv = *(const LAS f32x4*)(pr + 4 * 64 + cl + 4 * g), kkv = *(const LAS f32x4*)(pr + 5 * 64 + cl + 4 * g),
                                kav = *(const LAS f32x4*)(pr + 6 * 64 + cl + 4 * g), rkv = *(const LAS f32x4*)(pr + 7 * 64 + cl + 4 * g);
#pragma unroll
                    for (int i = 0; i < 4; ++i) { const int j = 4 * g + i;
                        const float rnb = hasnb ? rn[j] : 0.f, knb = hasnb ? kn[j] : 0.f, vnb = hasnb ? vn[j] : 0.f;
                        const float r_ = rc[j] + (rnb - rc[j]) * mur[i], k0 = kc[j] + (knb - kc[j]) * muk[i], v_ = vc[j] + (vnb - vc[j]) * muv[i];
                        const float xw = -(w0v[i] + accW[g][i]);
                        const float sp = fmaxf(xw, 0.f) + __logf(1.0f + __expf(-fabsf(xw)));
                        dec[j] = __expf(-__expf(-sp - 0.5f));
                        const float av = rcp_f(1.0f + __expf(-(a0v[i] + accA[g][i])));
                        const float kx = k0 * kkv[i]; ss += kx * kx;
                        const float kp_ = k0 * (1.f + (av - 1.f) * kav[i]); bon += r_ * kp_ * rkv[i];
                        KK[8 * hf + j] = kx; AV[8 * hf + j] = av; kp[j] = kp_; rr[j] = r_; vv[j] = v_; }
                }
                char* ob = recb + cl * 2;
                REC_ST((f32x4*)(recb + cl * 4), ((f32x4){dec[0], dec[1], dec[2], dec[3]})); REC_ST((f32x4*)(recb + cl * 4 + 16), ((f32x4){dec[4], dec[5], dec[6], dec[7]}));
                REC_ST((h8*)(ob + 512), ((h8){(_Float16)kp[0], (_Float16)kp[1], (_Float16)kp[2], (_Float16)kp[3], (_Float16)kp[4], (_Float16)kp[5], (_Float16)kp[6], (_Float16)kp[7]}));
                REC_ST((h8*)(ob + 640), ((h8){(_Float16)rr[0], (_Float16)rr[1], (_Float16)rr[2], (_Float16)rr[3], (_Float16)rr[4], (_Float16)rr[5], (_Float16)rr[6], (_Float16)rr[7]}));
                REC_ST((h8*)(ob + 768), ((h8){(_Float16)vv[0], (_Float16)vv[1], (_Float16)vv[2], (_Float16)vv[3], (_Float16)vv[4], (_Float16)vv[5], (_Float16)vv[6], (_Float16)vv[7]}));
                __builtin_amdgcn_sched_barrier(0);
            }
            ss = sum16x4(ss); bon = sum16x4(bon);
            const float inv = rsq_f(fmaxf(ss, 1e-12f));
#pragma unroll
            for (int hf = 0; hf < 2; ++hf) { char* ob = recb + (32 * hf + 8 * q4) * 2; float kkn[8], nka[8];
#pragma unroll
                for (int j = 0; j < 8; ++j) { kkn[j] = KK[8 * hf + j] * inv; nka[j] = -(kkn[j] * AV[8 * hf + j]); }
                REC_ST((h8*)(ob + 256), ((h8){(_Float16)kkn[0], (_Float16)kkn[1], (_Float16)kkn[2], (_Float16)kkn[3], (_Float16)kkn[4], (_Float16)kkn[5], (_Float16)kkn[6], (_Float16)kkn[7]}));
                REC_ST((h8*)(ob + 384), ((h8){(_Float16)nka[0], (_Float16)nka[1], (_Float16)nka[2], (_Float16)nka[3], (_Float16)nka[4], (_Float16)nka[5], (_Float16)nka[6], (_Float16)nka[7]})); }
            if (q4 == 0) BON[(size_t)chain * SCANLEN + pos] = bon;
        }
    }
}
template <bool CTXQ>
__device__ __forceinline__ void na_unit(const bf16* QN, const bf16* KN, const bf16* VTL, const bf16* VTC, const bf16* P, const float* rpb  , bf16* Y, int u, int lane) {
    const int n = lane & 15, q4 = lane >> 4;
    int b, h, qrow0, qr = 0, jt = 0;
    if (CTXQ) { b = u >> 8; h = (u >> 4) & 15; qrow0 = NLAT + b * CTXL + 16 * (u & 15); }
    else { jt = u & 3; h = (u >> 2) & 15; qr = (u >> 6) & 127; b = u >> 13; qrow0 = b * SEQ + qr * 64 + 16 * jt; }
    constexpr int NT = CTXQ ? 16 : 32, WT = CTXQ ? 0 : 16;
    f32x4 s[NT];
    const int rs = qr - 4 < 0 ? 0 : (qr - 4 > 120 ? 120 : qr - 4);
    const int span0 = jt == 0 ? 0 : (jt == 1 ? 8 : (jt == 2 ? 24 : 32));
    const int qc = 16 * jt + n; const int cs = qc - 8 < 0 ? 0 : (qc - 8 > 48 ? 48 : qc - 8);
    bf16x8 qf[2];
#pragma unroll
    for (int ks = 0; ks < 2; ++ks) qf[ks] = ld_frag(QN + (size_t)(qrow0 + n) * GWD + h * 64 + 32 * ks + 8 * q4);
    if (!CTXQ) {
        const float* rp = rpb + (size_t)h * 15 * 31;
#pragma unroll
        for (int wt = 0; wt < 16; ++wt) { const int kri = wt >> 1, half = wt & 1, relr = rs + kri - qr + 7;
#pragma unroll
            for (int i = 0; i < 4; ++i) { const int relc = span0 + 8 * q4 + 4 * half + i - qc + 15; const int relcc = relc < 0 ? 0 : (relc > 30 ? 30 : relc); s[wt][i] = rp[relr * 31 + relcc]; } }
        __builtin_amdgcn_sched_barrier(0);
#pragma unroll
        for (int bt = 0; bt < 2; ++bt) {
            bf16x8 kf[16];
#pragma unroll
            for (int t = 0; t < 8; ++t) { const int wt = bt * 8 + t, kri = wt >> 1, half = wt & 1;
                const bf16* kp = KN + (size_t)(b * SEQ + (rs + kri) * 64 + span0 + 8 * (n >> 2) + 4 * half + (n & 3)) * GWD + h * 64 + 8 * q4; kf[2 * t] = ld_frag(kp); kf[2 * t + 1] = ld_frag(kp + 32); }
            __builtin_amdgcn_sched_barrier(0);
#pragma unroll
            for (int t = 0; t < 8; ++t) { const int wt = bt * 8 + t, half = wt & 1;
                f32x4 a = s[wt];
#pragma unroll
                for (int i = 0; i < 4; ++i) { const int kc = span0 + 8 * q4 + 4 * half + i; const bool ok = kc >= cs && kc < cs + 16; a[i] = ok ? a[i] : -INFINITY; }
                a = mfma16(kf[2 * t], qf[0], a); a = mfma16(kf[2 * t + 1], qf[1], a); s[wt] = a; }
            __builtin_amdgcn_sched_barrier(0);
        }
    }
#pragma unroll
    for (int bt = 0; bt < 2; ++bt) {
        bf16x8 kf[16];
#pragma unroll
        for (int t = 0; t < 8; ++t) { const int ctile = bt * 8 + t; const bf16* kp = KN + (size_t)(NLAT + b * CTXL + 32 * (ctile >> 1) + 8 * (n >> 2) + 4 * (ctile & 1) + (n & 3)) * GWD + h * 64 + 8 * q4; kf[2 * t] = ld_frag(kp); kf[2 * t + 1] = ld_frag(kp + 32); }
        __builtin_amdgcn_sched_barrier(0);
#pragma unroll
        for (int t = 0; t < 8; ++t) { f32x4 a = {0.f, 0.f, 0.f, 0.f}; a = mfma16(kf[2 * t], qf[0], a); a = mfma16(kf[2 * t + 1], qf[1], a); s[WT + bt * 8 + t] = a; }
        __builtin_amdgcn_sched_barrier(0);
    }
    float mx = -INFINITY;
#pragma unroll
    for (int t = 0; t < NT; ++t) mx = fmaxf(fmaxf(fmaxf(s[t][0], s[t][1]), fmaxf(s[t][2], s[t][3])), mx);
    mx = max16x4(mx);
    float sum = 0.f;
#pragma unroll
    for (int t = 0; t < NT; ++t) {
#pragma unroll
        for (int i = 0; i < 4; ++i) { const float e = __expf(s[t][i] - mx); s[t][i] = e; sum += e; } }
    sum = sum16x4(sum);
    const float inv = rcp_f(sum);
    f32x4 o[4];
#pragma unroll
    for (int nt = 0; nt < 4; ++nt) o[nt] = (f32x4){0.f, 0.f, 0.f, 0.f};
#pragma unroll
    for (int tb = 0; tb < NT / 8; ++tb) {
        v4u vv[4][4];
#pragma unroll
        for (int tq = 0; tq < 4; ++tq) { const int tp = tb * 4 + tq;
            const bf16* vb; size_t dstride;
            if (!CTXQ && tp < 8) { vb = VTL + ((size_t)(b * 16 + h) * 64 + n) * 8192 + (rs + tp) * 64 + span0 + 8 * q4; dstride = (size_t)16 * 8192; }
            else { const int cp = tp - (CTXQ ? 0 : 8); vb = VTC + ((size_t)(b * 16 + h) * 64 + n) * 256 + 32 * cp + 8 * q4; dstride = (size_t)16 * 256; }
#pragma unroll
            for (int nt = 0; nt < 4; ++nt) vv[tq][nt] = *(const v4u*)(vb + nt * dstride); }
        __builtin_amdgcn_sched_barrier(0);
#pragma unroll
        for (int tq = 0; tq < 4; ++tq) { const int tp = tb * 4 + tq;
            const f32x4 p0 = s[2 * tp] * inv, p1 = s[2 * tp + 1] * inv;
            v4u aw; aw.x = pk2(p0[0], p0[1]); aw.y = pk2(p0[2], p0[3]); aw.z = pk2(p1[0], p1[1]); aw.w = pk2(p1[2], p1[3]);
            const bf16x8 af = __builtin_bit_cast(bf16x8, aw);
#pragma unroll
            for (int nt = 0; nt < 4; ++nt) o[nt] = mfma16(af, __builtin_bit_cast(bf16x8, vv[tq][nt]), o[nt]); }
        __builtin_amdgcn_sched_barrier(0);
    }
    unsigned short zz[4][4];
#pragma unroll
    for (int nt = 0; nt < 4; ++nt)
#pragma unroll
        for (int i = 0; i < 4; ++i) zz[nt][i] = P[(size_t)(qrow0 + 4 * q4 + i) * NIN + C_NAZ + h * 64 + 16 * nt + n];
    __builtin_amdgcn_sched_barrier(0);
#pragma unroll
    for (int nt = 0; nt < 4; ++nt)
#pragma unroll
        for (int i = 0; i < 4; ++i) { const int row = qrow0 + 4 * q4 + i, col = h * 64 + 16 * nt + n;
            Y[(size_t)row * DM + 1024 + col] = (bf16)f2bf(o[nt][i] * silu_f(bf2f(zz[nt][i]))); }
}
__device__ __forceinline__ void bar4(LAS unsigned* cnt, unsigned& seq, int lane) {
    asm volatile("s_waitcnt vmcnt(0) lgkmcnt(0)" ::: "memory");
    const unsigned baddr = (unsigned)(size_t)cnt, one = 1u; seq += 4u;
    if (lane == 0) asm volatile("ds_add_u32 %0, %1" :: "v"(baddr), "v"(one) : "memory");
    unsigned sp = 0, got;
    for (;;) { asm volatile("ds_read_b32 %0, %1\n\ts_waitcnt lgkmcnt(0)" : "=v"(got) : "v"(baddr) : "memory");
        if (__builtin_amdgcn_readfirstlane((int)got) >= (int)seq) break; __builtin_amdgcn_s_sleep(1); if (++sp > (1u << 22)) break; }
    asm volatile("" ::: "memory");
}
__device__ __forceinline__ void phase_sgu4(const bf16* P, const f32x2* SGST, const float* lnw, const float* lnb, const bf16* SGW, const float* sgb, bf16* Y,
                                           LAS unsigned char* ldsT, LAS unsigned* cnt, int nchunks, int tid4  , int w4  , int lane) {
    const int n = lane & 15, q4 = lane >> 4;
    LAS bf16* T = (LAS bf16*)ldsT; unsigned seq = 0u;
    for (int u = blockIdx.x; u < nchunks * 8; u += 256) {
        const int ck = u >> 3, g = u & 7, m0 = ck * 128;
#pragma unroll
        for (int it = 0; it < 8; ++it) { const int idx = tid4 + 256 * it, q = idx >> 4, c8 = idx & 15;
            float x[8]; unpack8(*(const v4u*)(P + (size_t)(m0 + q) * NIN + C_SGV + g * 128 + 8 * c8), x);
            const f32x2 st = SGST[m0 + q];
#pragma unroll
            for (int j = 0; j < 8; ++j) { const int c = 8 * c8 + j; const float v = (x[j] - st.x) * st.y * lnw[g * 128 + c] + lnb[g * 128 + c]; T[c * 136 + q] = (bf16)f2bf(v); } }
        bar4(cnt, seq, lane);
#pragma unroll 1
        for (int mt = 0; mt < 2; ++mt) { const int mrow = 32 * w4 + 16 * mt;
            bf16x8 af[4];
#pragma unroll
            for (int ks = 0; ks < 4; ++ks) af[ks] = ld_frag(SGW + ((size_t)g * 128 + mrow + n) * 128 + 32 * ks + 8 * q4);
#pragma unroll
            for (int nt = 0; nt < 8; ++nt) {
                f32x4 acc = {0.f, 0.f, 0.f, 0.f};
#pragma unroll
                for (int ks = 0; ks < 4; ++ks) { const bf16x8 bfg = *(const LAS bf16x8*)(T + (16 * nt + n) * 136 + 32 * ks + 8 * q4); acc = mfma16(af[ks], bfg, acc); }
#pragma unroll
                for (int i = 0; i < 4; ++i) { const int p = mrow + 4 * q4 + i, row = m0 + p, col = g * 128 + 16 * nt + n;
                    const float mixed = acc[i] + sgb[g * 128 + p]; const bf16* pr = P + (size_t)row * NIN;
                    const float uu = bf2f(pr[C_SGU + col]), z = bf2f(pr[C_SGZ + col]);
                    Y[(size_t)row * DM + 3072 + col] = (bf16)f2bf(uu * mixed * silu_f(z)); }
            }
        }
        bar4(cnt, seq, lane);
    }
}
__device__ __forceinline__ void scan_self(const float* REC, float* YR, LAS unsigned char* lds, LAS unsigned* bcnt, int su, int wave, int lane) {
    constexpr int CS = 32, NCH = SCANLEN / CS, SLOT = CS * RECB, NPW = SLOT / 1024 / 4;
    const int chain = (su & 7) * 8 + ((su >> 3) >> 2), part = (su >> 3) & 3;
    const char* recb = (const char*)REC + (size_t)chain * SCANLEN * RECB;
    const int wl = wave;
#define SCAN_ISSUE(cc, sl) do { _Pragma("unroll") for (int p_ = 0; p_ < NPW; ++p_) \
    __builtin_amdgcn_global_load_lds((const unsigned*)(recb + (size_t)(cc) * SLOT + (wl * NPW + p_) * 1024 + lane * 16), (LAS unsigned*)(lds + (sl) * SLOT + (wl * NPW + p_) * 1024), 16, 0, 0); } while (0)
    __builtin_amdgcn_s_setprio(3);
    SCAN_ISSUE(0, 0); SCAN_ISSUE(1, 1);
    const int c16 = lane & 15, rg = lane >> 4, row = 16 * part + 4 * wave + rg;
    float S0 = 0.f, S1 = 0.f, S2 = 0.f, S3 = 0.f;
    float* yout = YR + (size_t)chain * SCANLEN * 64 + row;
    const int lo_w = c16 * 16, lo_h = 256 + c16 * 8, lo_v = 768 + row * 2;
#define SCAN_LD(dst, sl, s_) do { const LAS unsigned char* rec_ = (sl) + (s_) * RECB; dst##w = *(const LAS f32x4*)(rec_ + lo_w); dst##kk = *(const LAS h4*)(rec_ + lo_h); \
    dst##na = *(const LAS h4*)(rec_ + 128 + lo_h); dst##k = *(const LAS h4*)(rec_ + 256 + lo_h); dst##r = *(const LAS h4*)(rec_ + 384 + lo_h); dst##v = *(const LAS _Float16*)(rec_ + lo_v); } while (0)
#define FMX(a, b, c) __builtin_fmaf((a), (float)(b), (c))
    int sl = 0;
    for (int c = 0; c < NCH; ++c) {
        asm volatile("s_waitcnt vmcnt(7)" ::: "memory");
        {   const unsigned baddr = (unsigned)(size_t)bcnt, one = 1u;
            if (lane == 0) asm volatile("ds_add_u32 %0, %1" :: "v"(baddr), "v"(one) : "memory");
            const unsigned want = 4u * (unsigned)(c + 1); unsigned sp = 0, got;
            for (;;) { asm volatile("ds_read_b32 %0, %1\n\ts_waitcnt lgkmcnt(0)" : "=v"(got) : "v"(baddr) : "memory");
                if (__builtin_amdgcn_readfirstlane((int)got) >= (int)want) break; __builtin_amdgcn_s_sleep(1); if (++sp > (1u << 22)) break; } }
        asm volatile("" ::: "memory");
        {   const int cc = c + 2 < NCH ? c + 2 : NCH - 1; const int s2 = sl == 0 ? 2 : sl - 1; SCAN_ISSUE(cc, s2); }
        const LAS unsigned char* slot = lds + sl * SLOT;
        sl = sl == 2 ? 0 : sl + 1;
        float ysv0 = 0.f, ysv1 = 0.f; float yp[16];
        f32x4 Aw; h4 Akk, Ana, Ak, Ar, Pr; _Float16 Av;
        SCAN_LD(A, slot, 0);
#pragma unroll
        for (int s = 0; s < CS; ++s) {
            f32x4 Bw; h4 Bkk, Bna, Bk, Br; _Float16 Bv;
            if (s < CS - 1) SCAN_LD(B, slot, s + 1);
            __builtin_amdgcn_sched_barrier(0);
            if (s > 0) { float q0 = FMX(S0, Pr.x, 0.f), q1 = FMX(S2, Pr.z, 0.f); q0 = FMX(S1, Pr.y, q0); q1 = FMX(S3, Pr.w, q1); yp[(s - 1) & 15] = q0 + q1; }
            float p0 = FMX(S0, Akk.x, 0.f), p1 = FMX(S2, Akk.z, 0.f); p0 = FMX(S1, Akk.y, p0); p1 = FMX(S3, Akk.w, p1);
            const float dt = red16(p0 + p1);
            const float u0 = __builtin_fmaf(S0, Aw.x, FMX((float)Av, Ak.x, 0.f)), u1 = __builtin_fmaf(S1, Aw.y, FMX((float)Av, Ak.y, 0.f)),
                        u2 = __builtin_fmaf(S2, Aw.z, FMX((float)Av, Ak.z, 0.f)), u3 = __builtin_fmaf(S3, Aw.w, FMX((float)Av, Ak.w, 0.f));
            S0 = FMX(dt, Ana.x, u0); S1 = FMX(dt, Ana.y, u1); S2 = FMX(dt, Ana.z, u2); S3 = FMX(dt, Ana.w, u3);
            if (s == 16) ysv0 = red16_transpose(yp, c16);
            Pr = Ar;
            if (s < CS - 1) { Aw = Bw; Akk = Bkk; Ana = Bna; Ak = Bk; Ar = Br; Av = Bv; }
        }
        { float q0 = FMX(S0, Pr.x, 0.f), q1 = FMX(S2, Pr.z, 0.f); q0 = FMX(S1, Pr.y, q0); q1 = FMX(S3, Pr.w, q1); yp[15] = q0 + q1; }
        ysv1 = red16_transpose(yp, c16);
        asm volatile("" ::: "memory");
        yout[(size_t)(c * CS + c16) * 64] = ysv0; yout[(size_t)(c * CS + 16 + c16) * 64] = ysv1;
    }
    asm volatile("s_waitcnt vmcnt(0)" ::: "memory");
    __builtin_amdgcn_s_setprio(0);
#undef FMX
#undef SCAN_LD
#undef SCAN_ISSUE
}
__device__ __forceinline__ void phase_rwfin(const bf16* P, const float* YR, const float* REC, const float* BON, const float* lnw, const float* lnb, bf16* Y, int nrows, int gw, int NGW, int lane) {
    const int head = lane >> 2, sub = lane & 3;
    for (int m = gw; m < nrows; m += NGW) {
        const bool isctx = m >= NLAT; const int t = isctx ? ((m - NLAT) & 255) : (m & 8191); const int b = isctx ? ((m - NLAT) >> 8) : (m >> 13);
        float out[16];
#pragma unroll
        for (int i = 0; i < 16; ++i) out[i] = 0.f;
#pragma unroll
        for (int d = 0; d < 2; ++d) {
            const int chain = (b * 2 + d) * 16 + head; const size_t pp = (size_t)chain * SCANLEN + scan_pos(d, isctx, t);
            float y[16], v[16];
#pragma unroll
            for (int j = 0; j < 4; ++j) { const f32x4 a = *(const f32x4*)(YR + pp * 64 + 16 * sub + 4 * j); const h4 c = *(const h4*)((const char*)REC + pp * RECB + 768 + (16 * sub + 4 * j) * 2);
                y[4 * j] = a.x; y[4 * j + 1] = a.y; y[4 * j + 2] = a.z; y[4 * j + 3] = a.w; v[4 * j] = (float)c.x; v[4 * j + 1] = (float)c.y; v[4 * j + 2] = (float)c.z; v[4 * j + 3] = (float)c.w; }
            const float bo = BON[pp];
            float s = 0.f;
#pragma unroll
            for (int i = 0; i < 16; ++i) s += y[i];
            s += __shfl_xor(s, 1); s += __shfl_xor(s, 2);
            const float mean = s * (1.f / 64.f); float q = 0.f;
#pragma unroll
            for (int i = 0; i < 16; ++i) { const float dl = y[i] - mean; q += dl * dl; }
            q += __shfl_xor(q, 1); q += __shfl_xor(q, 2);
            const float rstd = rsq_f(q * (1.f / 64.f) + 64e-5f);
#pragma unroll
            for (int i = 0; i < 16; ++i) { const int ch = head * 64 + 16 * sub + i; out[i] += (y[i] - mean) * rstd * lnw[ch] + lnb[ch] + bo * v[i]; }
        }
        float z[16]; unpack8(*(const v4u*)(P + (size_t)m * NIN + C_RWZ + 16 * lane), z); unpack8(*(const v4u*)(P + (size_t)m * NIN + C_RWZ + 16 * lane + 8), z + 8);
#pragma unroll
        for (int i = 0; i < 16; ++i) out[i] *= silu_f(z[i]);
        *(v4u*)(Y + (size_t)m * DM + 2048 + 16 * lane) = pack8(out); *(v4u*)(Y + (size_t)m * DM + 2048 + 16 * lane + 8) = pack8(out + 8);
    }
}
#define XB_TMO      128
#define XB_XCNT(j)  (256  + 64 * (j))
#define XB_XSUB(j)  (1280 + 64 * (j))
#define XB_XGEN(j)  (2304 + 64 * (j))
#define XB_TOP      3328
#define XB_TOPGEN   3392
#define XCD_BAR_WORDS 3456
#define XB_SPIN_CAP (1u << 18)

__device__ __forceinline__ unsigned xb_ld(unsigned* p)              { return __hip_atomic_load(p, __ATOMIC_RELAXED, __HIP_MEMORY_SCOPE_AGENT); }
__device__ __forceinline__ unsigned xb_add(unsigned* p, unsigned v) { return __hip_atomic_fetch_add(p, v, __ATOMIC_RELAXED, __HIP_MEMORY_SCOPE_AGENT); }
__device__ __forceinline__ unsigned xb_xcc_id() { return (unsigned)__builtin_amdgcn_s_getreg((3 << 11) | 20) & 0xFu; }
#define XB_SPIN(cond, bar) do { unsigned _sp = 0; while (cond) { __builtin_amdgcn_s_sleep(1); \
    if ((++_sp & 255u) == 0u) { if (xb_ld(&(bar)[XB_TMO])) break; if (_sp > XB_SPIN_CAP) { atomicAdd(&(bar)[XB_TMO], 1u); break; } } } } while (0)

struct XcdBarrier {
    unsigned* bar; unsigned x;
    volatile LAS unsigned* st;
};

__device__ __forceinline__ XcdBarrier xcd_barrier_post(unsigned* bar, volatile LAS unsigned* st) {
    XcdBarrier b; b.bar = bar; b.x = xb_xcc_id(); b.st = st;
    if (threadIdx.x == 0) (void)xb_add(&bar[XB_XCNT(b.x)], 1u);
    return b;
}
__device__ __forceinline__ void xcd_barrier_complete(unsigned* bar, unsigned x, unsigned& nloc, unsigned& nx) {
    const unsigned G = gridDim.x * gridDim.y * gridDim.z;
    unsigned sum, cnt, mine, sp = 0u;
    for (;;) {
        sum = 0u; cnt = 0u; mine = 0u;
#pragma unroll
        for (unsigned j = 0; j < 16; ++j) { const unsigned c = xb_ld(&bar[XB_XCNT(j)]); sum += c; cnt += (c > 0u) ? 1u : 0u; mine = (j == x) ? c : mine; }
        if (sum == G) break;
        __builtin_amdgcn_s_sleep(1);
        if ((++sp & 255u) == 0u) { if (xb_ld(&bar[XB_TMO])) break; if (sp > XB_SPIN_CAP) { atomicAdd(&bar[XB_TMO], 1u); break; } }
    }
    nloc = mine > 0u ? mine : 1u; nx = cnt > 0u ? cnt : 1u;
}

__device__ __forceinline__ void xcd_barrier(const XcdBarrier& b) {
    asm volatile("s_waitcnt vmcnt(0)" ::: "memory");
    __syncthreads();
    if (threadIdx.x == 0) {
        unsigned* bar = b.bar;
        __builtin_amdgcn_s_waitcnt(0);
        unsigned nloc = b.st[0], nx = b.st[1];
        if (nloc == 0u) { xcd_barrier_complete(bar, b.x, nloc, nx); b.st[0] = nloc; b.st[1] = nx; }
        const unsigned old = xb_add(&bar[XB_XSUB(b.x)], 1u);
        const unsigned gen = old / nloc;
        if (old + 1u == (gen + 1u) * nloc) {
            __builtin_amdgcn_fence(__ATOMIC_RELEASE, "agent");
            asm volatile("s_waitcnt vmcnt(0)" ::: "memory");
            const unsigned og = xb_add(&bar[XB_TOP], 1u);
            const unsigned tg = og / nx;
            if (og + 1u == (tg + 1u) * nx) xb_add(&bar[XB_TOPGEN], 1u);
            else XB_SPIN(xb_ld(&bar[XB_TOPGEN]) == tg, bar);
            __builtin_amdgcn_fence(__ATOMIC_ACQUIRE, "agent");
            xb_add(&bar[XB_XGEN(b.x)], 1u);
            asm volatile("s_waitcnt vmcnt(0)" ::: "memory");
        } else {
            XB_SPIN(xb_ld(&bar[XB_XGEN(b.x)]) == gen, bar);
            __builtin_amdgcn_fence(__ATOMIC_ACQUIRE, "agent");
            asm volatile("s_waitcnt vmcnt(0)" ::: "memory");
        }
    }
    __syncthreads();
}

#ifndef MK_SPLIT
#define MK_SPLIT 0
#endif
constexpr int PPL = 6;
constexpr int NPHASE = 2 + PPL * DEPTH;
constexpr int RWP_BLOCKS = 14;
constexpr int CW_RWQ = 16384;
constexpr int NGRID = 256;
struct Args { const float* in[28]; float* out; unsigned char* ws; int ph_lo, ph_hi, li, pad; };

__global__ void __launch_bounds__(NWAVES * 64, 2) fwd(Args args) {
    extern __shared__ __attribute__((aligned(16))) unsigned char lds_raw[];
    LAS unsigned char* lds = (LAS unsigned char*)lds_raw;
    volatile LAS unsigned* MISC = (volatile LAS unsigned*)(lds + MISC_OFF);
    const int tid = threadIdx.x, lane = tid & 63, wave = __builtin_amdgcn_readfirstlane(tid >> 6);
    constexpr int G = NGRID; const int bx = blockIdx.x;
    const int vcu = (bx % 8) * (G / 8) + bx / 8;
    const int gw = vcu * NWAVES + wave; constexpr int NGW = G * NWAVES;
    unsigned char* ws = args.ws;
    const int lo = args.ph_lo, hi = args.ph_hi;

    for (int u = tid; u < (LDS_BYTES - LDSCTL_OFF) / 4; u += NWAVES * 64) ((LAS unsigned*)(lds + LDSCTL_OFF))[u] = 0u;
    __syncthreads();
    XcdBarrier bar; bar.bar = (unsigned*)(ws + WS_CTL) + CW_BAR; bar.x = 0; bar.st = MISC + 8;
    if (hi - lo > 1) bar = xcd_barrier_post((unsigned*)(ws + WS_CTL) + CW_BAR, MISC + 8);
#define IN(k) (lo <= (k) && (k) < hi)
#define SEAM(k) do { if (lo <= (k) && (k) + 1 < hi) { XcdBarrier b2_; b2_.bar = WSP(unsigned, WS_CTL) + CW_BAR; b2_.x = bar.x; b2_.st = bar.st; xcd_barrier(b2_); } } while (0)

#define OPQ_S(x) ({ int _t = (x); asm volatile("" : "+s"(_t)); _t; })
#define OPQ_V(x) ({ int _t = (x); asm volatile("" : "+v"(_t)); _t; })
#define INP(i) (args.in[OPQ_S(i)])
#define WSP(T, off) ((T*)(args.ws + ({ size_t _o = (off); asm volatile("" : "+s"(_o)); _o; })))
#define x_in INP(0)
#define c_in INP(1)
#define ctx_in INP(2)
#define cctx_in INP(3)
#define w_mod INP(4)
#define b_mod INP(5)
#define w_in INP(6)
#define w_out INP(7)
#define pool_w INP(8)
#define pool_scale INP(9)
#define na_qg INP(10)
#define na_kg INP(11)
#define na_rpb INP(12)
#define rw_mu_rkv INP(13)
#define rw_mu_lora INP(14)
#define rw_w0 INP(15)
#define rw_w_up INP(16)
#define rw_a0 INP(17)
#define rw_a_up INP(18)
#define rw_k_k INP(19)
#define rw_k_a INP(20)
#define rw_r_k INP(21)
#define rw_ln_w INP(22)
#define rw_ln_b INP(23)
#define sg_ln_w INP(24)
#define sg_ln_b INP(25)
#define sg_w INP(26)
#define sg_b INP(27)
#define MOD WSP(float, WS_MOD)
#define MODP WSP(float, WS_MODP)
#define TAB WSP(f32x2, WS_TAB)
#define SGST WSP(f32x2, WS_SGST)
#define BON WSP(float, WS_BON)
#define POOLWT WSP(bf16, WS_POOLWT)
#define WUPT WSP(bf16, WS_WUPT)
#define AUPT WSP(bf16, WS_AUPT)
#define SGW WSP(bf16, WS_SGW)
#define VTC WSP(bf16, WS_VTC)
#define VTL WSP(bf16, WS_VTL)
#define HCTX WSP(float, WS_HCTX)
#define QN WSP(bf16, WS_QN)
#define KN WSP(bf16, WS_KN)
#define WOUTT WSP(bf16, WS_WOUTT)
#define WINT WSP(bf16, WS_WINT)
#define XN WSP(bf16, WS_XN)
#define Y WSP(bf16, WS_Y)
#define P WSP(bf16, WS_P)
#define YR WSP(float, WS_YR)
#define REC WSP(float, WS_REC)
#define SILUC WSP(float, WS_SILUC)
    float* const out = args.out;

    if (IN(0)) {
        LAS float* scr = (LAS float*)(lds + wave * 16384);
        constexpr int I_MOD = 64 * 48  , I_WIN = 64 * (NIN / 32), I_WOUT = 64 * 128, I_POOL = 4 * 32, I_WUP = 2 * 32, I_AUP = 2 * 32, I_SGW = 256;
        constexpr int NITEMS = I_MOD + I_WIN + I_WOUT + I_POOL + I_WUP + I_AUP + I_SGW;
        for (int it = gw; it < NITEMS; it += NGW) {
            int r = it;
            if (r < I_MOD) { p0_mod_item(w_mod, c_in, cctx_in, MODP, scr, r, lane); continue; } r -= I_MOD;
            if (r < I_WIN) { p0_transpose_item<true>(w_in, DM, NIN, WINT, scr, r, lane); continue; } r -= I_WIN;
            if (r < I_WOUT) { p0_transpose_item(w_out, DM, DM, WOUTT, scr, r, lane); continue; } r -= I_WOUT;
            if (r < I_POOL) { const int g = r / 32; p0_transpose_item(pool_w + (size_t)g * 65536, 256, 256, POOLWT + (size_t)g * 65536, scr, r % 32, lane); continue; } r -= I_POOL;
            if (r < I_WUP) { const int dd = r / 32; p0_transpose_item(rw_w_up + (size_t)dd * 65536, 64, 1024, WUPT + (size_t)dd * 65536, scr, r % 32, lane); continue; } r -= I_WUP;
            if (r < I_AUP) { const int dd = r / 32; p0_transpose_item(rw_a_up + (size_t)dd * 65536, 64, 1024, AUPT + (size_t)dd * 65536, scr, r % 32, lane); continue; } r -= I_AUP;
            {   const size_t e0 = (size_t)r * 512 + lane * 8; const f32x4 a = *(const f32x4*)(sg_w + e0), b = *(const f32x4*)(sg_w + e0 + 4);
                v4u o; o.x = pk2(a.x, a.y); o.y = pk2(a.z, a.w); o.z = pk2(b.x, b.y); o.w = pk2(b.z, b.w); *(v4u*)(SGW + e0) = o; }
        }
        SEAM(0);
    }
    if (IN(1)) {

        for (int idx = gw * 64 + lane; idx < 3 * 4096; idx += NGW * 64) SILUC[idx] = silu_f(idx < 8192 ? c_in[idx] : cctx_in[idx - 8192]);
        for (int idx = gw * 64 + lane; idx < 3 * 12288; idx += NGW * 64) {
            const int l = idx / 36864, c = (idx / 12288) % 3, n = idx % 12288;
            float s = b_mod[l * 12288 + n];
            const float* pp = MODP + ((size_t)(l * 64) * 3 + c) * 12288 + n;
#pragma unroll 8
            for (int kc = 0; kc < 64; ++kc) s += pp[(size_t)kc * 3 * 12288];
            MOD[idx] = s;
        }
        for (int idx = gw * 64 + lane; idx < 2048; idx += NGW * 64) {
            const int pos = idx >> 4, i = idx & 15;
            float inv = (i & 3) == 0 ? 1.0f : ((i & 3) == 1 ? 0.5623413251903491f : ((i & 3) == 2 ? 0.31622776601683794f : 0.17782794100389228f));
            inv *= (i >> 2) == 0 ? 1.0f : ((i >> 2) == 1 ? 0.1f : ((i >> 2) == 2 ? 0.01f : 0.001f));
            float cc, sn; sincos_acc((float)pos * inv, cc, sn);
            TAB[idx] = (f32x2){cc, sn};
        }
        SEAM(1);
    }
    for (int l = 0; l < DEPTH; ++l) {
        const int pb = 2 + PPL * l;
        const bool with_ctx = l < DEPTH - 1;
#define hin_lat (l == 0 ? x_in : (const float*)out)
#define hin_ctx (l == 0 ? ctx_in : (const float*)HCTX)
#define mod (MOD + (size_t)l * 3 * 12288)
        const int nrows = with_ctx ? MROWS : NLAT;
        if (IN(pb + 0)) {
            phase_xn(hin_lat, hin_ctx, mod, XN, OPQ_S(gw), NGW, OPQ_V(lane));
            SEAM(pb + 0);
        }
        if (IN(pb + 1)) {
            constexpr int C0 = C_SPLIT, NA_ = NIN - C0;
            pg8::Gemm g{XN, WINT + (size_t)l * NIN * DM + (size_t)C0 * DM, MROWS, NA_, DM}; pg8::StaticOrder S; S.init(MROWS, NA_, G, bx);
            pg8::EpiStoreBf16 E{P + C0, NIN};
            pg8::gemm_phase<pg8::EpiStoreBf16, pg8::StaticOrder, true, true>(lds, g, S, E);
            SEAM(pb + 1);
        }
        if (IN(pb + 2)) {
            if (bx >= RWP_BLOCKS) {
                constexpr int NB_ = C_SPLIT;
                pg8::Gemm g{XN, WINT + (size_t)l * NIN * DM, MROWS, NB_, DM}; pg8::StaticOrder S; S.init(MROWS, NB_, G - RWP_BLOCKS, bx - RWP_BLOCKS);
                pg8::EpiStoreBf16 E{P, NIN};
                pg8::gemm_phase<pg8::EpiStoreBf16, pg8::StaticOrder, true, true>(lds, g, S, E);
            }
            phase_rwprep(P, rw_mu_rkv + (size_t)l * 6144, rw_mu_lora + (size_t)l * 256, rw_w0 + (size_t)l * 2048, WUPT + (size_t)l * 131072, rw_a0 + (size_t)l * 2048, AUPT + (size_t)l * 131072,
                         rw_k_k + (size_t)l * 1024, rw_k_a + (size_t)l * 1024, rw_r_k + (size_t)l * 1024, REC, BON, lds, WSP(unsigned, WS_CTL) + CW_RWQ + l * 1024, (bx * NWAVES + wave) & 15, wave, OPQ_V(lane));
            phase_rowprep(P, na_qg + l * 64, na_kg + l * 64, TAB, QN, KN, SGST, OPQ_S(gw), NGW, OPQ_V(lane));
            phase_vt(P, VTL, VTC, OPQ_S(gw), NGW, OPQ_V(lane));
            SEAM(pb + 2);
        }
        if (IN(pb + 3)) {
            {
            LAS unsigned* mixq = (LAS unsigned*)(lds + LDSCTL_OFF + 64); LAS unsigned* mixb = (LAS unsigned*)(lds + LDSCTL_OFF + 128); LAS unsigned* mixs = (LAS unsigned*)(lds + LDSCTL_OFF + 192);
            if (tid == 0) { *mixq = 0u; *mixb = 0u; *mixs = 0u; }
            __syncthreads();
            if (wave < 4) scan_self(REC, YR, lds, mixb, bx, wave, OPQ_V(lane));
            else phase_sgu4(P, SGST, sg_ln_w + (size_t)l * 1024, sg_ln_b + (size_t)l * 1024, SGW + (size_t)l * 131072, sg_b + (size_t)l * 1024, Y, lds + 3 * 28672, mixs, nrows / 128, OPQ_V(tid) - 256, wave - 4, OPQ_V(lane));
            {   const int nctxu = with_ctx ? 2 : 0, npool = (nrows / 16) * 4, npq = (npool + NGRID - 1) / NGRID, nwc = l + 1 < DEPTH ? (WC_ITEMS + NGRID - 1) / NGRID : 0, nmd = l + 1 < DEPTH ? (64 * 48) / NGRID : 0, nq = 64 + nctxu + npq + nwc + nmd;
                for (;;) {
                    unsigned k = 0; if (lane == 0) k = __hip_atomic_fetch_add(mixq, 1u, __ATOMIC_RELAXED, __HIP_MEMORY_SCOPE_WORKGROUP);
                    k = (unsigned)__builtin_amdgcn_readfirstlane((int)k);
                    if ((int)k >= nq) break;
                    const int ln = OPQ_V(lane);
                    if (k < 64u) { na_unit<false>(QN, KN, VTL, VTC, P, na_rpb + (size_t)l * 16 * 15 * 31, Y, bx * 64 + (int)k, ln);
                    }
                    else if ((int)k < 64 + nctxu) na_unit<true>(QN, KN, VTL, VTC, P, na_rpb, Y, bx * 2 + ((int)k - 64), ln);
                    else if ((int)k >= 64 + nctxu + npq + nwc) mod_item_nolds(w_mod + (size_t)(l + 1) * 4096 * 12288, SILUC, MODP + (size_t)(l + 1) * 64 * 3 * 12288, bx + NGRID * ((int)k - 64 - nctxu - npq - nwc), ln);
                    else if ((int)k >= 64 + nctxu + npq) { const int r = bx + NGRID * ((int)k - 64 - nctxu - npq);
                        if (r < WC_ITEMS) weight_copy_item(l + 1, r, w_in, w_out, pool_w, rw_w_up, rw_a_up, sg_w, WINT, WOUTT, POOLWT, WUPT, AUPT, SGW, ln); }
                    else { const int u = bx + NGRID * ((int)k - 64 - nctxu);
                        if (u < npool) { const int tt = u >> 2, g = u & 3; const bf16* wbase = POOLWT + (size_t)l * 262144 + (size_t)g * 65536; const float* psc = pool_scale + (size_t)l * 1024;
                            if (g == 0) pool_unit<0>(P, wbase, psc, Y, tt * 16, ln); else if (g == 1) pool_unit<1>(P, wbase, psc, Y, tt * 16, ln);
                            else if (g == 2) pool_unit<2>(P, wbase, psc, Y, tt * 16, ln); else pool_unit<3>(P, wbase, psc, Y, tt * 16, ln); } }
                }
            }
            }
            SEAM(pb + 3);
        }
        if (IN(pb + 4)) {
            if (l + 1 < DEPTH) for (int idx = gw * 64 + lane; idx < 3 * 12288; idx += NGW * 64) {
                const int c = idx / 12288, n = idx % 12288; float s = b_mod[(l + 1) * 12288 + n];
                const float* pp = MODP + ((size_t)((l + 1) * 64) * 3 + c) * 12288 + n;
#pragma unroll 8
                for (int kc = 0; kc < 64; ++kc) s += pp[(size_t)kc * 3 * 12288];
                MOD[(size_t)(l + 1) * 3 * 12288 + idx] = s; }
            phase_rwfin(P, YR, REC, BON, rw_ln_w + (size_t)l * 1024, rw_ln_b + (size_t)l * 1024, Y, nrows, OPQ_S(gw), NGW, OPQ_V(lane));
            SEAM(pb + 4);
        }
        if (IN(pb + 5)) {
            pg8::Gemm g{Y, WOUTT + (size_t)l * DM * DM, nrows, DM, DM}; pg8::StaticOrder S; S.init(nrows, DM, G, bx);
            pg8::EpiResGate E{hin_lat, hin_ctx, out, HCTX, mod};
            pg8::gemm_phase<pg8::EpiResGate, pg8::StaticOrder, true, true>(lds, g, S, E);
            SEAM(pb + 5);
        }
    }
#undef IN
#undef SEAM
}
#undef hin_lat
#undef hin_ctx
#undef mod
#undef P
#undef Y
#undef XN
#undef out

extern "C" void kernel_launch(void* const* d_in, const int* in_sizes, int n_in, void* d_out, int out_size, void* d_ws, size_t ws_size, hipStream_t stream) {
    static int grid = 0;
    if (grid == 0) {
        if (n_in != 28 || out_size != NLAT * DM || ws_size < WS_END) { fprintf(stderr, "kernel_launch: unexpected shapes (n_in %d, out %d, ws %zu < %zu); nothing launched\n", n_in, out_size, ws_size, (size_t)WS_END); grid = -1; return; }
        int dev = 0, cus = 0, per_cu = 0;
        if (hipGetDevice(&dev) != hipSuccess || hipDeviceGetAttribute(&cus, hipDeviceAttributeMultiprocessorCount, dev) != hipSuccess) { grid = -1; return; }
        if (hipFuncSetAttribute((const void*)fwd, hipFuncAttributeMaxDynamicSharedMemorySize, LDS_BYTES) != hipSuccess) { fprintf(stderr, "kernel_launch: hipFuncSetAttribute failed\n"); grid = -1; return; }
        if (hipOccupancyMaxActiveBlocksPerMultiprocessor(&per_cu, (const void*)fwd, NWAVES * 64, LDS_BYTES) != hipSuccess || per_cu < 1)
            fprintf(stderr, "kernel_launch: note: occupancy query reports %d workgroups per CU\n", per_cu);
        (void)hipGetLastError();
        grid = cus >= NGRID ? NGRID : -2;
    }
    if (grid == -1) return;
    if (hipMemsetAsync((char*)d_ws + WS_CTL, 0, CTL_ZERO_BYTES, stream) != hipSuccess) { fprintf(stderr, "kernel_launch: memset failed\n"); return; }
    Args a{};
    for (int i = 0; i < 28; ++i) a.in[i] = (const float*)d_in[i];
    a.out = (float*)d_out; a.ws = (unsigned char*)d_ws; a.li = 0; a.pad = 0;
    const bool split = MK_SPLIT || grid == -2;
    if (split) { for (int k = 0; k < NPHASE; ++k) { a.ph_lo = k; a.ph_hi = k + 1; hipLaunchKernelGGL(fwd, dim3(NGRID), dim3(NWAVES * 64), LDS_BYTES, stream, a); } }
    else { a.ph_lo = 0; a.ph_hi = NPHASE; hipLaunchKernelGGL(fwd, dim3(NGRID), dim3(NWAVES * 64), LDS_BYTES, stream, a); }
    const hipError_t le = hipPeekAtLastError();
    if (le != hipSuccess) fprintf(stderr, "kernel_launch: launch failed: %s\n", hipGetErrorName(le));
}
```

```cpp
#include <hip/hip_runtime.h>
#include <cstdio>
#include <cstdint>
#define MK_SPLIT 0
namespace pg8 {
#define PG8_LAS __attribute__((address_space(3)))
typedef unsigned short bf16_t;
typedef short bf16x8 __attribute__((ext_vector_type(8)));
typedef float f32x4 __attribute__((ext_vector_type(4)));
typedef unsigned u32x4 __attribute__((ext_vector_type(4)));
constexpr int BM = 256, BK = 64, HALF = 128, HTB = HALF * BK * 2  , STAGE_BYTES = 8 * HTB, NXCD = 8, WGM = 8;

__host__ __device__ __forceinline__ int lds_byte(int r, int c) { const int st = (r >> 4) * 2 + (c >> 5), rr = r & 15, cc = c & 31, ob = rr * 64 + cc * 2; return st * 1024 + (ob ^ (((ob >> 9) & 1) << 5)); }
__host__ __device__ __forceinline__ void stage_rc(int b, int& R, int& C) { const int st = b / 1024, sb = b % 1024, swz = sb ^ (((sb >> 9) & 1) << 5); R = (st >> 1) * 16 + swz / 64; C = (st & 1) * 32 + (swz % 64) / 2; }
__host__ __device__ __forceinline__ int perm32(int rho) { const int n = rho >> 4, i = rho & 15; return 8 * (i >> 2) + 4 * n + (i & 3); }

struct Unit { int pm, pn; };
struct Gemm { const bf16_t* A; const bf16_t* Bt; int M, N, K; };

struct StaticOrder {
    int nM, nN, nwg, G, c;
    __host__ __device__ void init(int M, int N, int G_, int c_) { nM = M / BM; nN = N / BM; nwg = nM * nN; G = G_; c = c_; }
    __host__ __device__ bool next(int i, Unit& u) const {
        const long L = (long)i * G + c; if (L >= nwg) return false;
        int wgid = (int)L; { const int q = nwg / NXCD, r = nwg % NXCD, xcd = wgid % NXCD, off = wgid / NXCD; wgid = (xcd < r ? xcd * (q + 1) : r * (q + 1) + (xcd - r) * q) + off; }
        const int nig = WGM * nN, gid = wgid / nig, fm = gid * WGM, gsz = (nM - fm) < WGM ? (nM - fm) : WGM;
        u.pm = fm + ((wgid % nig) % gsz); u.pn = (wgid % nig) / gsz; return true;
    }
    __device__ __forceinline__ void a_ready(const Unit&) const {}
    __device__ __forceinline__ void done(const Unit&) const {}
};

__device__ __forceinline__ unsigned cvt_pk_bf16(float lo, float hi) { unsigned r; asm volatile("v_cvt_pk_bf16_f32 %0, %1, %2" : "=v"(r) : "v"(lo), "v"(hi)); return r; }
template <class Epi, class Sched, bool ALIGN_EPI = false, bool SP2 = false>
__device__ __forceinline__ void gemm_phase(PG8_LAS unsigned char* lds, const Gemm g, const Sched& S, const Epi& E) {
    int tid_ = threadIdx.x; asm volatile("" : "+v"(tid_));
    const int tid = tid_, wid = __builtin_amdgcn_readfirstlane(tid >> 6), lane = tid & 63, wr = wid >> 2, wc = wid & 3, fr = lane & 15, fq = lane >> 4;
    const int K = g.K, nt = K / BK;
    unsigned voffA[2], voffB[2];
#pragma unroll
    for (int i = 0; i < 2; ++i) { int R, C; stage_rc(tid * 16 + i * 8192, R, C); const int Rb = Epi::PERM ? ((R & ~31) + perm32(R & 31)) : R;
        voffA[i] = (unsigned)(R * K + C) * 2u; voffB[i] = (unsigned)(Rb * K + C) * 2u; }
    const size_t kstep = (size_t)(BK * 2);
    const size_t hstep = (size_t)HALF * K * 2;
    const size_t tstep = 2 * hstep;
    const unsigned ldsw = (unsigned)wid * 1024u;
    const int aoff = lds_byte(wr * 64 + fr, fq * 8), boff = lds_byte(wc * 32 + fr, fq * 8);
#define PG8_SA(b, h) (((b) * 2 + (h)) * HTB)
#define PG8_SB(b, h) ((4 + (b) * 2 + (h)) * HTB)
#define PG8_STAGE(bufoff, gbase, voff) do { _Pragma("unroll") for (int _i = 0; _i < 2; ++_i) \
        __builtin_amdgcn_global_load_lds((const unsigned*)((const char*)(gbase) + (voff)[_i]), (PG8_LAS unsigned*)(lds + (bufoff) + ldsw + _i * 8192), 16, 0, 0); } while (0)
#define PG8_LDA(dst, b, h) do { _Pragma("unroll") for (int m = 0; m < 4; ++m) _Pragma("unroll") for (int k = 0; k < 2; ++k) dst[m][k] = *(const PG8_LAS bf16x8*)(lds + PG8_SA(b, h) + aoff + m * 2048 + k * 1024); } while (0)
#define PG8_LDB(dst, b, h) do { _Pragma("unroll") for (int n = 0; n < 2; ++n) _Pragma("unroll") for (int k = 0; k < 2; ++k) dst[n][k] = *(const PG8_LAS bf16x8*)(lds + PG8_SB(b, h) + boff + n * 2048 + k * 1024); } while (0)
#define PG8_MMA(ai, bj, At, Bt) do { __builtin_amdgcn_s_setprio(1); _Pragma("unroll") for (int m = 0; m < 4; ++m) _Pragma("unroll") for (int n = 0; n < 2; ++n) _Pragma("unroll") for (int k = 0; k < 2; ++k) \
        acc[ai][bj][m][n] = __builtin_amdgcn_mfma_f32_16x16x32_bf16(Bt[n][k], At[m][k], acc[ai][bj][m][n], 0, 0, 0); __builtin_amdgcn_s_setprio(0); } while (0)
#define PG8_WAIT_V(n) asm volatile("s_waitcnt vmcnt(" #n ")" ::: "memory")
#define PG8_WAIT_L(n) asm volatile("s_waitcnt lgkmcnt(" #n ")" ::: "memory")
#define PG8_BAR __builtin_amdgcn_s_barrier()
#define PG8_SCHED __builtin_amdgcn_sched_barrier(0)
    Unit cur, nxt; int ui = 0;
    if (!S.next(0, cur)) return;
    f32x4 acc[2][2][4][2];
#pragma unroll
    for (int a = 0; a < 2; ++a)
#pragma unroll
        for (int b = 0; b < 2; ++b)
#pragma unroll
            for (int m = 0; m < 4; ++m)
#pragma unroll
                for (int n = 0; n < 2; ++n) acc[a][b][m][n] = (f32x4){0.f, 0.f, 0.f, 0.f};
    bf16x8 At[4][2], B0[2][2], B1[2][2];
    const char* cA = (const char*)g.A + (size_t)cur.pm * tstep; const char* cB = (const char*)g.Bt + (size_t)cur.pn * tstep;
    S.a_ready(cur);
    if constexpr (SP2) {
        PG8_STAGE(PG8_SB(0, 0), cB, voffB); PG8_STAGE(PG8_SB(0, 1), cB + hstep, voffB); PG8_STAGE(PG8_SA(0, 0), cA, voffA); PG8_STAGE(PG8_SA(0, 1), cA + hstep, voffA);
        if (wr == 1) PG8_BAR;
        PG8_WAIT_V(2); PG8_BAR;
        PG8_STAGE(PG8_SB(1, 0), cB + kstep, voffB); PG8_STAGE(PG8_SA(1, 0), cA + kstep, voffA); PG8_STAGE(PG8_SB(1, 1), cB + hstep + kstep, voffB);
        PG8_WAIT_V(6); PG8_BAR;
    } else {
        PG8_STAGE(PG8_SB(0, 0), cB, voffB); PG8_STAGE(PG8_SA(0, 0), cA, voffA); PG8_STAGE(PG8_SB(0, 1), cB + hstep, voffB); PG8_STAGE(PG8_SA(0, 1), cA + hstep, voffA);
        if (wr == 1) PG8_BAR;
        PG8_WAIT_V(4); PG8_BAR;
        PG8_STAGE(PG8_SB(1, 0), cB + kstep, voffB); PG8_STAGE(PG8_SA(1, 0), cA + kstep, voffA); PG8_STAGE(PG8_SB(1, 1), cB + hstep + kstep, voffB);
        PG8_WAIT_V(6); PG8_BAR;
    }
    for (;;) {
        const bool has_next = S.next(ui + 1, nxt);
        const char* nA = has_next ? (const char*)g.A + (size_t)nxt.pm * tstep : cA; const char* nB = has_next ? (const char*)g.Bt + (size_t)nxt.pn * tstep : cB;
        for (int t = 0; t < nt; t += 2) {
            const bool last = (t == nt - 2);
            const char* a1 = cA + (size_t)(t + 1) * kstep;
            const char* a2 = last ? nA : cA + (size_t)(t + 2) * kstep; const char* b2 = last ? nB : cB + (size_t)(t + 2) * kstep;
            const char* a3 = a2 + kstep; const char* b3 = b2 + kstep;
            if (last && has_next) S.a_ready(nxt);
            if constexpr (SP2) {
            PG8_LDB(B0, 0, 0); PG8_LDB(B1, 0, 1); PG8_SCHED; PG8_LDA(At, 0, 0); PG8_STAGE(PG8_SA(1, 1), a1 + hstep, voffA);
            PG8_WAIT_V(8); PG8_WAIT_L(0); PG8_BAR; PG8_MMA(0, 0, At, B0); PG8_MMA(0, 1, At, B1); PG8_BAR; PG8_SCHED;
            PG8_LDA(At, 0, 1); PG8_STAGE(PG8_SB(0, 0), b2, voffB); PG8_STAGE(PG8_SB(0, 1), b2 + hstep, voffB); PG8_STAGE(PG8_SA(0, 0), a2, voffA);
            PG8_WAIT_V(8); PG8_WAIT_L(0); PG8_BAR; PG8_MMA(1, 0, At, B0); PG8_MMA(1, 1, At, B1); PG8_BAR; PG8_SCHED;
            PG8_LDB(B0, 1, 0); PG8_LDB(B1, 1, 1); PG8_SCHED; PG8_LDA(At, 1, 0); PG8_STAGE(PG8_SA(0, 1), a2 + hstep, voffA);
            PG8_WAIT_V(8); PG8_WAIT_L(0); PG8_BAR; PG8_MMA(0, 0, At, B0); PG8_MMA(0, 1, At, B1); PG8_BAR; PG8_SCHED;
            PG8_LDA(At, 1, 1); PG8_STAGE(PG8_SB(1, 0), b3, voffB); PG8_STAGE(PG8_SB(1, 1), b3 + hstep, voffB); PG8_STAGE(PG8_SA(1, 0), a3, voffA);
            PG8_WAIT_V(8); PG8_WAIT_L(0); PG8_BAR; PG8_MMA(1, 0, At, B0); PG8_MMA(1, 1, At, B1); PG8_BAR; PG8_SCHED;
            } else {
            PG8_LDB(B0, 0, 0); PG8_SCHED; PG8_LDA(At, 0, 0); PG8_STAGE(PG8_SA(1, 1), a1 + hstep, voffA);
            PG8_WAIT_L(8); PG8_BAR; PG8_WAIT_L(0); PG8_MMA(0, 0, At, B0); PG8_BAR; PG8_SCHED;
            PG8_LDB(B1, 0, 1); PG8_STAGE(PG8_SB(0, 0), b2, voffB);
            PG8_BAR; PG8_WAIT_L(0); PG8_MMA(0, 1, At, B1); PG8_BAR;
            PG8_LDA(At, 0, 1); PG8_STAGE(PG8_SA(0, 0), a2, voffA);
            PG8_BAR; PG8_WAIT_L(0); PG8_MMA(1, 0, At, B0); PG8_BAR; PG8_SCHED;
            PG8_STAGE(PG8_SB(0, 1), b2 + hstep, voffB);
            PG8_WAIT_V(6); PG8_BAR; PG8_MMA(1, 1, At, B1); PG8_BAR;
            PG8_LDB(B0, 1, 0); PG8_SCHED; PG8_LDA(At, 1, 0); PG8_STAGE(PG8_SA(0, 1), a2 + hstep, voffA);
            PG8_WAIT_L(8); PG8_BAR; PG8_WAIT_L(0); PG8_MMA(0, 0, At, B0); PG8_BAR; PG8_SCHED;
            PG8_LDB(B1, 1, 1); PG8_STAGE(PG8_SB(1, 0), b3, voffB);
            PG8_BAR; PG8_WAIT_L(0); PG8_MMA(0, 1, At, B1); PG8_BAR;
            PG8_LDA(At, 1, 1); PG8_STAGE(PG8_SA(1, 0), a3, voffA);
            PG8_BAR; PG8_WAIT_L(0); PG8_MMA(1, 0, At, B0); PG8_BAR; PG8_SCHED;
            PG8_STAGE(PG8_SB(1, 1), b3 + hstep, voffB);
            PG8_WAIT_V(6); PG8_BAR; PG8_MMA(1, 1, At, B1); PG8_BAR;
            }
        }
        if constexpr (ALIGN_EPI) { if (wr == 0) PG8_BAR; }
        if constexpr (!Epi::AFTER_DRAIN) { E(acc, cur, wr, wc, fr, fq); S.done(cur); }
        if (!has_next) break;
#pragma unroll
        for (int a = 0; a < 2; ++a)
#pragma unroll
            for (int b = 0; b < 2; ++b)
#pragma unroll
                for (int m = 0; m < 4; ++m)
#pragma unroll
                    for (int n = 0; n < 2; ++n) acc[a][b][m][n] = (f32x4){0.f, 0.f, 0.f, 0.f};
        cur = nxt; cA = nA; cB = nB; ++ui;
        if constexpr (ALIGN_EPI) { if (wr == 1) PG8_BAR; }
    }
    PG8_WAIT_V(0);
    if constexpr (!ALIGN_EPI) { if (wr == 0) PG8_BAR; }
    PG8_BAR;
    if constexpr (Epi::AFTER_DRAIN) { E.fused(acc, cur, wr, wc, fr, fq, lds, wid, lane); S.done(cur); }
#undef PG8_SA
#undef PG8_SB
#undef PG8_STAGE
#undef PG8_LDA
#undef PG8_LDB
#undef PG8_MMA
#undef PG8_WAIT_V
#undef PG8_WAIT_L
#undef PG8_BAR
#undef PG8_SCHED
}
}

constexpr int DM = 4096, NBATCH = 2, SEQ = 8192, DEPTH = 4, CTXL = 256;
constexpr int NLAT = NBATCH * SEQ, NCTX = NBATCH * CTXL, MROWS = NLAT + NCTX;
constexpr int NIN = 13568, GWD = 1024;
constexpr int C_POOLV = 0, C_POOLZ = 1024, C_NAZ = 2048, C_RWZ = 3072, C_SGU = 4096, C_SGZ = 5120, C_NAQ = 6144, C_NAK = 7168, C_NAV = 8192, C_RWR = 9216, C_RWK = 10240, C_RWV = 11264,
              C_RWWD = 12288, C_RWAD = 12416, C_SGV = 12544;
constexpr int C_SPLIT = 5632;
__host__ __device__ __forceinline__ int phys_tile(int lt) {
    return lt < 8 ? lt : lt < 20 ? lt + 16 : lt < 24 ? lt - 12 : lt < 36 ? lt + 12 : lt < 40 ? lt - 24 : lt == 40 ? 48 : lt < 45 ? lt - 25 : lt < 49 ? lt + 4 : lt - 29;
}
constexpr int SCANLEN = CTXL + SEQ;
constexpr int NCHAIN = 64;
constexpr int RECB = 896;
constexpr int RECF = RECB / 4;
constexpr int NWAVES = 8;

constexpr size_t MiB = 1u << 20;
constexpr size_t WS_CTL = 0, CTL_ZERO_BYTES = 1 * MiB;
constexpr size_t WS_MOD   = 2 * MiB;
constexpr size_t WS_TAB   = 3 * MiB;
constexpr size_t WS_SILUC = 3 * MiB + 512 * 1024;
constexpr size_t WS_SGST  = 4 * MiB;
constexpr size_t WS_BON   = 5 * MiB;
constexpr size_t WS_POOLWT= 8 * MiB;
constexpr size_t WS_WUPT  = 10 * MiB;
constexpr size_t WS_AUPT  = 11 * MiB;
constexpr size_t WS_SGW   = 12 * MiB;
constexpr size_t WS_VTC   = 13 * MiB;
constexpr size_t WS_HCTX  = 14 * MiB;
constexpr size_t WS_MODP  = 22 * MiB;
constexpr size_t WS_VTL   = 58 * MiB;
constexpr size_t WS_QN    = 90 * MiB;
constexpr size_t WS_KN    = 123 * MiB;
constexpr size_t WS_WOUTT = 156 * MiB;
constexpr size_t WS_WINT  = 284 * MiB;
constexpr size_t WS_XN    = 708 * MiB;
constexpr size_t WS_Y     = 840 * MiB;
constexpr size_t WS_P     = 972 * MiB;
constexpr size_t WS_YR    = 1410 * MiB;
constexpr size_t WS_REC   = 1542 * MiB;
constexpr size_t WS_END   = 2334 * MiB;
static_assert(WS_P + (size_t)MROWS * NIN * 2 <= WS_YR && WS_REC + (size_t)NCHAIN * SCANLEN * RECB <= WS_END && WS_WINT + (size_t)4 * NIN * DM * 2 <= WS_XN, "ws map");
constexpr int CW_TMO = 0, CW_BAR = 4096;

constexpr int RING_BYTES = 131072, LDSCTL_OFF = RING_BYTES, MISC_OFF = LDSCTL_OFF + 320, LDS_BYTES = 147456;

#define GAS __attribute__((address_space(1)))
#define LAS __attribute__((address_space(3)))
typedef unsigned short bf16;
typedef unsigned v4u __attribute__((ext_vector_type(4)));
typedef unsigned v2u __attribute__((ext_vector_type(2)));
typedef float f32x4 __attribute__((ext_vector_type(4)));
typedef float f32x2 __attribute__((ext_vector_type(2)));
typedef short bf16x8 __attribute__((ext_vector_type(8)));
typedef _Float16 h4 __attribute__((ext_vector_type(4)));
typedef _Float16 h8 __attribute__((ext_vector_type(8)));
#define RLX_AGENT __ATOMIC_RELAXED, __HIP_MEMORY_SCOPE_AGENT
#define LDS_WAIT() asm volatile("s_waitcnt lgkmcnt(0)" ::: "memory")

__device__ __forceinline__ float bf2f(unsigned short h) { return __uint_as_float(((unsigned)h) << 16); }
__device__ __forceinline__ float bflo(unsigned w) { return __uint_as_float(w << 16); }
__device__ __forceinline__ float bfhi(unsigned w) { return __uint_as_float(w & 0xffff0000u); }
typedef __bf16 bf16x2_t __attribute__((ext_vector_type(2)));
__device__ __forceinline__ unsigned pk2(float lo, float hi) { const f32x2 v = {lo, hi}; const bf16x2_t b = __builtin_convertvector(v, bf16x2_t); return __builtin_bit_cast(unsigned, b); }
__device__ __forceinline__ unsigned f2bf(float f) { return pk2(f, 0.f) & 0xffffu; }
__device__ __forceinline__ float rcp_f(float x) { return __builtin_amdgcn_rcpf(x); }
__device__ __forceinline__ float rsq_f(float x) { return __builtin_amdgcn_rsqf(x); }
__device__ __forceinline__ void unpack8(const v4u w, float* x) { x[0] = bflo(w.x); x[1] = bfhi(w.x); x[2] = bflo(w.y); x[3] = bfhi(w.y); x[4] = bflo(w.z); x[5] = bfhi(w.z); x[6] = bflo(w.w); x[7] = bfhi(w.w); }
__device__ __forceinline__ v4u pack8(const float* x) { v4u w; w.x = pk2(x[0], x[1]); w.y = pk2(x[2], x[3]); w.z = pk2(x[4], x[5]); w.w = pk2(x[6], x[7]); return w; }
__device__ __forceinline__ float silu_f(float x) { return x * rcp_f(1.f + __expf(-x)); }
__device__ __forceinline__ float wave_sum(float v) {
#pragma unroll
    for (int o = 1; o < 64; o <<= 1) v += __shfl_xor(v, o);
    return v;
}
template <int CTRL> __device__ __forceinline__ float dppf(float v) { return __builtin_bit_cast(float, __builtin_amdgcn_update_dpp(0, __builtin_bit_cast(int, v), CTRL, 0xF, 0xF, true)); }
__device__ __forceinline__ float red16(float v) { v += dppf<0xB1>(v); v += dppf<0x4E>(v); v += dppf<0x141>(v); v += dppf<0x140>(v); return v; }
__device__ __forceinline__ void red16x2(float& a, float& b) {
    a += dppf<0xB1>(a); b += dppf<0xB1>(b); a += dppf<0x4E>(a); b += dppf<0x4E>(b); a += dppf<0x141>(a); b += dppf<0x141>(b); a += dppf<0x140>(a); b += dppf<0x140>(b); }
__device__ __forceinline__ float red16_transpose(const float (&y)[16], int c16) {
    float a[8], b[4], c[2];
    const bool h8 = (c16 & 8) != 0, h4 = (c16 & 4) != 0, h2 = (c16 & 2) != 0, h1 = (c16 & 1) != 0;
#pragma unroll
    for (int j = 0; j < 8; ++j) { const float keep = h8 ? y[j + 8] : y[j], send = h8 ? y[j] : y[j + 8]; a[j] = keep + dppf<0x140>(send); }
#pragma unroll
    for (int j = 0; j < 4; ++j) { const float keep = h4 ? a[j + 4] : a[j], send = h4 ? a[j] : a[j + 4]; b[j] = keep + dppf<0x141>(send); }
#pragma unroll
    for (int j = 0; j < 2; ++j) { const float keep = h2 ? b[j + 2] : b[j], send = h2 ? b[j] : b[j + 2]; c[j] = keep + dppf<0x1B>(send); }
    const float keep = h1 ? c[1] : c[0], send = h1 ? c[0] : c[1];
    return keep + dppf<0xB1>(send);
}
__device__ __forceinline__ float max16x4(float v) { v = fmaxf(v, __shfl_xor(v, 16)); v = fmaxf(v, __shfl_xor(v, 32)); return v; }
__device__ __forceinline__ float sum16x4(float v) { v += __shfl_xor(v, 16); v += __shfl_xor(v, 32); return v; }
__device__ __forceinline__ int scan_pos(int d, bool isctx, int t) { return d == 0 ? (isctx ? t : CTXL + t) : (isctx ? (CTXL - 1 - t) : (CTXL + SEQ - 1 - t)); }
__device__ __forceinline__ f32x4 mfma16(bf16x8 a, bf16x8 b, f32x4 c) { return __builtin_amdgcn_mfma_f32_16x16x32_bf16(a, b, c, 0, 0, 0); }
__device__ __forceinline__ bf16x8 ld_frag(const bf16* p) { return __builtin_bit_cast(bf16x8, *(const v4u*)p); }

namespace pg8 {
struct EpiStoreBf16 {
    static constexpr bool PERM = true, AFTER_DRAIN = false;
    bf16_t* O; int ldc;
    __device__ __forceinline__ void operator()(const f32x4 (&acc)[2][2][4][2], const Unit& u, int wr, int wc, int fr, int fq) const {
        const int row0 = u.pm * BM + wr * 64 + fr, col0 = u.pn * BM + wc * 32 + 8 * fq;
#pragma unroll
        for (int ai = 0; ai < 2; ++ai)
#pragma unroll
            for (int m = 0; m < 4; ++m) { bf16_t* rowp = O + (size_t)(row0 + ai * HALF + m * 16) * ldc + col0;
#pragma unroll
                for (int bj = 0; bj < 2; ++bj) { const f32x4 v0 = acc[ai][bj][m][0], v1 = acc[ai][bj][m][1];
                    u32x4 w; w.x = cvt_pk_bf16(v0[0], v0[1]); w.y = cvt_pk_bf16(v0[2], v0[3]); w.z = cvt_pk_bf16(v1[0], v1[1]); w.w = cvt_pk_bf16(v1[2], v1[3]);
                    *(u32x4*)(rowp + bj * HALF) = w; } }
    }
};
struct EpiResGate {
    static constexpr bool PERM = false, AFTER_DRAIN = false;
    const float* hin_lat; const float* hin_ctx; float* hout_lat; float* hout_ctx; const float* gate;
    __device__ __forceinline__ void operator()(const f32x4 (&acc)[2][2][4][2], const Unit& u, int wr, int wc, int fr, int fq) const {
        const int cond = u.pm < 32 ? 0 : (u.pm < 64 ? 1 : 2);
        const int rloc = (u.pm < 64 ? u.pm * BM : (u.pm - 64) * BM) + wr * 64 + fr, col0 = u.pn * BM + wc * 32 + 4 * fq;
        const float* hin = u.pm < 64 ? hin_lat : hin_ctx; float* hout = u.pm < 64 ? hout_lat : hout_ctx;
        f32x4 gv[2][2];
#pragma unroll
        for (int bj = 0; bj < 2; ++bj)
#pragma unroll
            for (int n = 0; n < 2; ++n) gv[bj][n] = *(const f32x4*)(gate + cond * 12288 + 8192 + col0 + bj * HALF + n * 16);
#pragma unroll
        for (int ai = 0; ai < 2; ++ai)
#pragma unroll
            for (int m = 0; m < 4; ++m) { const size_t off = (size_t)(rloc + ai * HALF + m * 16) * 4096 + col0;
#pragma unroll
                for (int bj = 0; bj < 2; ++bj)
#pragma unroll
                    for (int n = 0; n < 2; ++n) { const f32x4 b = *(const f32x4*)(hin + off + bj * HALF + n * 16);
                        *(f32x4*)(hout + off + bj * HALF + n * 16) = b + gv[bj][n] * acc[ai][bj][m][n]; } }
    }
};
}

template <bool PERMC = false>
__device__ __forceinline__ void p0_transpose_item(const float* W, int K, int N, bf16* WT, LAS float* scr, int item, int lane) {
    const int nblk = N / 32, kb = item / nblk, nb = item % nblk, k0 = 64 * kb, n0 = 32 * nb;
    const int pn0 = PERMC ? phys_tile(n0 >> 8) * 256 + (n0 & 255) : n0;
#pragma unroll 8
    for (int i = 0; i < 32; ++i) { const int kk = 2 * i + (lane >> 5); scr[kk * 33 + (lane & 31)] = W[(size_t)(k0 + kk) * N + n0 + (lane & 31)]; }
    LDS_WAIT(); asm volatile("" ::: "memory");
    const int c = lane & 7;
#pragma unroll
    for (int j = 0; j < 4; ++j) { const int n = (lane >> 3) + 8 * j; const LAS float* s = scr + (8 * c) * 33 + n;
        v4u o; o.x = pk2(s[0 * 33], s[1 * 33]); o.y = pk2(s[2 * 33], s[3 * 33]); o.z = pk2(s[4 * 33], s[5 * 33]); o.w = pk2(s[6 * 33], s[7 * 33]);
        *(v4u*)(WT + (size_t)(pn0 + n) * K + k0 + 8 * c) = o; }
    LDS_WAIT(); asm volatile("" ::: "memory");
}
template <bool PERMC = false>
__device__ __forceinline__ void transpose_item_nolds(const float* W, int K, int N, bf16* WT, int item, int lane) {
    const int nblk = N / 64, kb = item / nblk, nb = item % nblk, k0 = 64 * kb, n0 = 64 * nb;
    const int pn0 = PERMC ? phys_tile(n0 >> 8) * 256 + (n0 & 255) : n0;
    const float* src = W + (size_t)k0 * N + n0 + lane;
    bf16* dst = WT + (size_t)(pn0 + lane) * K + k0;
#pragma unroll
    for (int hb = 0; hb < 2; ++hb) {
        float v[32];
#pragma unroll
        for (int i = 0; i < 32; ++i) v[i] = __builtin_nontemporal_load(src + (size_t)(32 * hb + i) * N);
        __builtin_amdgcn_sched_barrier(0);
#pragma unroll
        for (int j = 0; j < 4; ++j) { v4u o; o.x = pk2(v[8 * j], v[8 * j + 1]); o.y = pk2(v[8 * j + 2], v[8 * j + 3]); o.z = pk2(v[8 * j + 4], v[8 * j + 5]); o.w = pk2(v[8 * j + 6], v[8 * j + 7]);
            *(v4u*)(dst + 32 * hb + 8 * j) = o; }
        __builtin_amdgcn_sched_barrier(0);
    }
}
constexpr int WC_WIN = (DM / 64) * (NIN / 64), WC_WOUT = (DM / 64) * (DM / 64), WC_POOL = 4 * 16, WC_WUP = 2 * 16, WC_AUP = 2 * 16, WC_SGW = 256, WC_ITEMS = WC_WIN + WC_WOUT + WC_POOL + WC_WUP + WC_AUP + WC_SGW;
__device__ __forceinline__ void weight_copy_item(int L, int r, const float* w_in, const float* w_out, const float* pool_w, const float* rw_w_up, const float* rw_a_up, const float* sg_w,
                                                 bf16* WINT, bf16* WOUTT, bf16* POOLWT, bf16* WUPT, bf16* AUPT, bf16* SGW, int lane) {
    if (r < WC_WIN) { transpose_item_nolds<true>(w_in + (size_t)L * DM * NIN, DM, NIN, WINT + (size_t)L * NIN * DM, r, lane); return; } r -= WC_WIN;
    if (r < WC_WOUT) { transpose_item_nolds(w_out + (size_t)L * DM * DM, DM, DM, WOUTT + (size_t)L * DM * DM, r, lane); return; } r -= WC_WOUT;
    if (r < WC_POOL) { const int g = r >> 4; transpose_item_nolds(pool_w + (size_t)(L * 4 + g) * 65536, 256, 256, POOLWT + (size_t)(L * 4 + g) * 65536, r & 15, lane); return; } r -= WC_POOL;
    if (r < WC_WUP) { const int dd = r >> 4; transpose_item_nolds(rw_w_up + (size_t)(L * 2 + dd) * 65536, 64, 1024, WUPT + (size_t)(L * 2 + dd) * 65536, r & 15, lane); return; } r -= WC_WUP;
    if (r < WC_AUP) { const int dd = r >> 4; transpose_item_nolds(rw_a_up + (size_t)(L * 2 + dd) * 65536, 64, 1024, AUPT + (size_t)(L * 2 + dd) * 65536, r & 15, lane); return; } r -= WC_AUP;
    {   const size_t e0 = (size_t)L * 131072 + (size_t)r * 512 + lane * 8; const f32x4 a = *(const f32x4*)(sg_w + e0), b = *(const f32x4*)(sg_w + e0 + 4);
        v4u o; o.x = pk2(a.x, a.y); o.y = pk2(a.z, a.w); o.z = pk2(b.x, b.y); o.w = pk2(b.z, b.w); *(v4u*)(SGW + e0) = o; }
}
__device__ __forceinline__ void p0_mod_item(const float* wmod, const float* cvec, const float* cctx, float* MODP, LAS float* scr, int item, int lane) {
    const int l = item / (64 * 48), r = item % (64 * 48), kc = r / 48, nc = r % 48, k0 = kc * 64, n0 = nc * 256 + lane * 4;
    scr[lane] = silu_f(cvec[k0 + lane]); scr[64 + lane] = silu_f(cvec[4096 + k0 + lane]); scr[128 + lane] = silu_f(cctx[k0 + lane]);
    LDS_WAIT(); asm volatile("" ::: "memory");
    f32x4 a0 = {0.f, 0.f, 0.f, 0.f}, a1 = a0, a2 = a0;
    const float* wp = wmod + ((size_t)l * 4096 + k0) * 12288 + n0;
#pragma unroll 16
    for (int k = 0; k < 64; ++k) { const f32x4 w = *(const f32x4*)(wp + (size_t)k * 12288); a0 += scr[k] * w; a1 += scr[64 + k] * w; a2 += scr[128 + k] * w; }
    float* o = MODP + ((size_t)(l * 64 + kc) * 3) * 12288 + n0;
    *(f32x4*)(o) = a0; *(f32x4*)(o + 12288) = a1; *(f32x4*)(o + 2 * 12288) = a2;
    LDS_WAIT(); asm volatile("" ::: "memory");
}
__device__ __forceinline__ void mod_item_nolds(const float* wmod_l  , const float* siluc, float* MODP_l  , int item, int lane) {
    const int kc = item / 48, nc = item % 48, k0 = kc * 64, n0 = nc * 256 + lane * 4;
    f32x4 a0 = {0.f, 0.f, 0.f, 0.f}, a1 = a0, a2 = a0;
    const float* wp = wmod_l + (size_t)k0 * 12288 + n0;
    const int s0v = __builtin_bit_cast(int, siluc[k0 + lane]), s1v = __builtin_bit_cast(int, siluc[4096 + k0 + lane]), s2v = __builtin_bit_cast(int, siluc[8192 + k0 + lane]);
#pragma unroll
    for (int k = 0; k < 64; ++k) { const f32x4 w = __builtin_nontemporal_load((const f32x4*)(wp + (size_t)k * 12288));
        a0 += __builtin_bit_cast(float, __builtin_amdgcn_readlane(s0v, k)) * w; a1 += __builtin_bit_cast(float, __builtin_amdgcn_readlane(s1v, k)) * w; a2 += __builtin_bit_cast(float, __builtin_amdgcn_readlane(s2v, k)) * w; }
    float* o = MODP_l + ((size_t)kc * 3) * 12288 + n0;
    *(f32x4*)(o) = a0; *(f32x4*)(o + 12288) = a1; *(f32x4*)(o + 2 * 12288) = a2;
}
__device__ __forceinline__ void sincos_acc(float ang, float& c, float& s) {
    const double x = (double)ang; const double n = __builtin_rint(x * 0.63661977236758134308); const double r = x - n * 1.57079632679489661923;
    const double r2 = r * r;
    const double sp = r * (1.0 + r2 * (-1.0 / 6 + r2 * (1.0 / 120 + r2 * (-1.0 / 5040 + r2 * (1.0 / 362880 + r2 * (-1.0 / 39916800 + r2 * (1.0 / 6227020800.0)))))));
    const double cp = 1.0 + r2 * (-0.5 + r2 * (1.0 / 24 + r2 * (-1.0 / 720 + r2 * (1.0 / 40320 + r2 * (-1.0 / 3628800 + r2 * (1.0 / 479001600 + r2 * (-1.0 / 87178291200.0)))))));
    const int q = ((int)n) & 3;
    const double cc = (q == 0) ? cp : (q == 1) ? -sp : (q == 2) ? -cp : sp;
    const double ss = (q == 0) ? sp : (q == 1) ? cp : (q == 2) ? -sp : -cp;
    c = (float)cc; s = (float)ss;
}

__device__ __forceinline__ void phase_xn(const float* hlat, const float* hctx, const float* mod, bf16* XN, int gw, int NGW, int lane) {
    for (int m = gw; m < MROWS; m += NGW) {
        const float* src = m < NLAT ? hlat + (size_t)m * DM : hctx + (size_t)(m - NLAT) * DM;
        const int cond = m < NLAT ? (m >> 13) : 2;
        const f32x4* s4 = (const f32x4*)src + lane;
        f32x4 v[16]; float ss = 0.f;
#pragma unroll
        for (int j = 0; j < 16; ++j) { v[j] = __builtin_nontemporal_load(s4 + 64 * j); ss += (v[j].x * v[j].x + v[j].y * v[j].y) + (v[j].z * v[j].z + v[j].w * v[j].w); }
        ss = wave_sum(ss);
        const float rstd = rsq_f(ss * (1.f / 4096.f) + 1e-6f);
        const f32x4* sh4 = (const f32x4*)(mod + cond * 12288) + lane; const f32x4* sc4 = (const f32x4*)(mod + cond * 12288 + 4096) + lane;
        v2u* o = (v2u*)(XN + (size_t)m * DM) + lane;
#pragma unroll
        for (int j = 0; j < 16; ++j) { const f32x4 sh = sh4[64 * j], sc = sc4[64 * j]; const f32x4 x = v[j] * rstd * (sc + 1.f) + sh; v2u w; w.x = pk2(x.x, x.y); w.y = pk2(x.z, x.w); o[64 * j] = w; }
    }
}

__device__ __forceinline__ void phase_rowprep(const bf16* P, const float* qgain, const float* kgain, const f32x2* tab, bf16* QN, bf16* KN, f32x2* SGST, int gw, int NGW, int lane) {
    const int sub = lane & 3;
    for (int m = gw; m < MROWS; m += NGW) {
        const bf16* pr = P + (size_t)m * NIN;
        const bool isctx = m >= NLAT; const int t = isctx ? ((m - NLAT) & 255) : (m & 8191);
        {   float x[16]; unpack8(*(const v4u*)(pr + C_SGV + 16 * lane), x); unpack8(*(const v4u*)(pr + C_SGV + 16 * lane + 8), x + 8);
            float s = 0.f;
#pragma unroll
            for (int i = 0; i < 16; ++i) s += x[i];
            const float mean = wave_sum(s) * (1.f / 1024.f); float q = 0.f;
#pragma unroll
            for (int i = 0; i < 16; ++i) { const float dlt = x[i] - mean; q += dlt * dlt; }
            const float var = wave_sum(q) * (1.f / 1024.f);
            if (lane == 0) SGST[m] = (f32x2){mean, rsq_f(var + 1e-5f)}; }
        float q[16], k[16];
        unpack8(*(const v4u*)(pr + C_NAQ + 16 * lane), q); unpack8(*(const v4u*)(pr + C_NAQ + 16 * lane + 8), q + 8);
        unpack8(*(const v4u*)(pr + C_NAK + 16 * lane), k); unpack8(*(const v4u*)(pr + C_NAK + 16 * lane + 8), k + 8);
        float sq = 0.f, sk = 0.f;
#pragma unroll
        for (int i = 0; i < 16; ++i) { sq += q[i] * q[i]; sk += k[i] * k[i]; }
        sq += __shfl_xor(sq, 1); sq += __shfl_xor(sq, 2); sk += __shfl_xor(sk, 1); sk += __shfl_xor(sk, 2);
        const float rq = rsq_f(sq * (1.f / 64.f) + 1e-6f), rk = rsq_f(sk * (1.f / 64.f) + 1e-6f);
#pragma unroll
        for (int i = 0; i < 16; ++i) { q[i] *= rq * qgain[16 * sub + i]; k[i] *= rk * kgain[16 * sub + i]; }
        if (!isctx) {
            const int pos = sub < 2 ? (t >> 6) : (t & 63);
#pragma unroll
            for (int i = 0; i < 16; ++i) { const f32x2 cs = tab[pos * 16 + i]; const float pq = __shfl_xor(q[i], 1), pkk = __shfl_xor(k[i], 1);
                q[i] = (sub & 1) ? (q[i] * cs.x + pq * cs.y) : (q[i] * cs.x - pq * cs.y);
                k[i] = (sub & 1) ? (k[i] * cs.x + pkk * cs.y) : (k[i] * cs.x - pkk * cs.y); }
        }
#pragma unroll
        for (int i = 0; i < 16; ++i) q[i] *= 0.125f;
        *(v4u*)(QN + (size_t)m * GWD + 16 * lane) = pack8(q); *(v4u*)(QN + (size_t)m * GWD + 16 * lane + 8) = pack8(q + 8);
        *(v4u*)(KN + (size_t)m * GWD + 16 * lane) = pack8(k); *(v4u*)(KN + (size_t)m * GWD + 16 * lane + 8) = pack8(k + 8);
    }
}
__device__ __forceinline__ void phase_vt(const bf16* P, bf16* VTL, bf16* VTC, int gw, int NGW, int lane) {
    for (int u = gw; u < (MROWS / 64) * 16; u += NGW) {
        const int tt = u >> 4, h = u & 15, m0 = tt * 64;
        const bf16* src = P + (size_t)m0 * NIN + C_NAV + h * 64 + lane;
        unsigned w[32];
#pragma unroll
        for (int i = 0; i < 32; ++i) { const unsigned lo = src[(size_t)(2 * i) * NIN], hi = src[(size_t)(2 * i + 1) * NIN]; w[i] = lo | (hi << 16); }
        bf16* dst = tt < 256 ? VTL + (((size_t)((tt >> 7) * 16 + h) * 64 + lane) * 8192 + (tt & 127) * 64)
                             : VTC + (((size_t)(((tt - 256) >> 2) * 16 + h) * 64 + lane) * 256 + ((tt - 256) & 3) * 64);
#pragma unroll
        for (int j = 0; j < 8; ++j) { v4u o; o.x = w[4 * j]; o.y = w[4 * j + 1]; o.z = w[4 * j + 2]; o.w = w[4 * j + 3]; ((v4u*)dst)[j] = o; }
    }
}
template <int G>
__device__ __forceinline__ void pool_unit(const bf16* P, const bf16* wbase, const float* pscale, bf16* Y, int m0, int lane) {
    constexpr int WIN = 2 << G;
    const int r = lane & 15, q4 = lane >> 4, m = m0 + r;
    const bool isctx = m0 >= NLAT; const int T = isctx ? CTXL : SEQ; const int t = isctx ? ((m - NLAT) & 255) : (m & 8191);
    const int tlo = t - (WIN >> 1);
    const int lo = tlo < 0 ? 0 : tlo, hi = (tlo + WIN) > T ? T : (tlo + WIN);
    const float inv = rcp_f((float)(hi - lo));
    f32x4 acc[16];
#pragma unroll
    for (int nt = 0; nt < 16; ++nt) acc[nt] = (f32x4){0.f, 0.f, 0.f, 0.f};
#pragma unroll 1
    for (int ks = 0; ks < 8; ++ks) {
        const int ch0 = C_POOLV + G * 256 + 32 * ks + 8 * q4;
        constexpr int WB = WIN < 8 ? WIN : 8;
        bf16x8 bfr[8];
        float sum[8];
#pragma unroll
        for (int j = 0; j < 8; ++j) sum[j] = 0.f;
        const v4u selfw = *(const v4u*)(P + (size_t)m * NIN + ch0);
#pragma unroll
        for (int nt = 0; nt < 8; ++nt) bfr[nt] = ld_frag(wbase + (size_t)(16 * nt + r) * 256 + 32 * ks + 8 * q4);
        bf16x8 bfr2[8];
#pragma unroll
        for (int nt = 0; nt < 8; ++nt) bfr2[nt] = ld_frag(wbase + (size_t)(16 * (nt + 8) + r) * 256 + 32 * ks + 8 * q4);
#pragma unroll
        for (int k0 = 0; k0 < WIN; k0 += WB) {
            v4u wl[WB];
#pragma unroll
            for (int k = 0; k < WB; ++k) { const int tk = tlo + k0 + k; const bool ok = tk >= 0 && tk < T; wl[k] = *(const v4u*)(P + (size_t)(ok ? (m - t + tk) : m) * NIN + ch0); }
            __builtin_amdgcn_sched_barrier(0);
#pragma unroll
            for (int k = 0; k < WB; ++k) { const int tk = tlo + k0 + k; const bool ok = tk >= 0 && tk < T; float x[8]; unpack8(wl[k], x);
#pragma unroll
                for (int j = 0; j < 8; ++j) sum[j] += ok ? x[j] : 0.f; }
            __builtin_amdgcn_sched_barrier(0);
        }
        float self[8]; unpack8(selfw, self);
        float dv[8];
#pragma unroll
        for (int j = 0; j < 8; ++j) dv[j] = sum[j] * inv - self[j];
        const bf16x8 af = __builtin_bit_cast(bf16x8, pack8(dv));
        __builtin_amdgcn_sched_barrier(0);
#pragma unroll
        for (int nt = 0; nt < 8; ++nt) acc[nt] = mfma16(af, bfr[nt], acc[nt]);
        __builtin_amdgcn_sched_barrier(0);
#pragma unroll
        for (int nt = 0; nt < 8; ++nt) acc[nt + 8] = mfma16(af, bfr2[nt], acc[nt + 8]);
        __builtin_amdgcn_sched_barrier(0);
    }
#pragma unroll
    for (int nh = 0; nh < 4; ++nh) {
        unsigned short zz[4][4]; float ps[4];
#pragma unroll
        for (int nq = 0; nq < 4; ++nq) { const int oc = G * 256 + 16 * (4 * nh + nq) + r; ps[nq] = pscale[oc];
#pragma unroll
            for (int i = 0; i < 4; ++i) zz[nq][i] = P[(size_t)(m0 + 4 * q4 + i) * NIN + C_POOLZ + oc]; }
        __builtin_amdgcn_sched_barrier(0);
#pragma unroll
        for (int nq = 0; nq < 4; ++nq) { const int oc = G * 256 + 16 * (4 * nh + nq) + r;
#pragma unroll
            for (int i = 0; i < 4; ++i) Y[(size_t)(m0 + 4 * q4 + i) * DM + oc] = (bf16)f2bf(acc[4 * nh + nq][i] * ps[nq] * silu_f(bf2f(zz[nq][i]))); }
        __builtin_amdgcn_sched_barrier(0);
    }
}
__device__ __forceinline__ void phase_pool(const bf16* P, const bf16* PWT  , const float* pscale, bf16* Y, int nrows, int gw, int NGW, int lane) {
    for (int u = gw; u < (nrows / 16) * 4; u += NGW) {
        const int tt = u >> 2, g = u & 3, m0 = tt * 16;
        const bf16* wbase = PWT + (size_t)g * 65536;
        if (g == 0) pool_unit<0>(P, wbase, pscale, Y, m0, lane);
        else if (g == 1) pool_unit<1>(P, wbase, pscale, Y, m0, lane);
        else if (g == 2) pool_unit<2>(P, wbase, pscale, Y, m0, lane);
        else pool_unit<3>(P, wbase, pscale, Y, m0, lane);
    }
}
#define REC_ST(p, v) __builtin_nontemporal_store((v), (p))
__device__ __forceinline__ void phase_rwprep(const bf16* P, const float* mu_rkv  , const float* mu_lora  , const float* w0  , const bf16* WUPT  ,
                                             const float* a0, const bf16* AUPT, const float* k_k, const float* k_a, const float* r_k, float* REC, float* BON, LAS unsigned char* lds,
                                             unsigned* queue  , int cls, int wave, int lane) {
    const int n = lane & 15, q4 = lane >> 4;
    const int d = cls >> 3, hp = cls & 7;
    unsigned* qh = queue + 64 * cls;
    LAS float* prm = (LAS float*)(lds + wave * 4096);
#pragma unroll
    for (int it = 0; it < 16; ++it) { const int hh = it >> 3, p = it & 7, ch = (hp * 2 + hh) * 64 + lane;
        const float* src = p == 0 ? w0 + d * 1024 : p == 1 ? a0 + d * 1024 : p == 2 ? mu_rkv + (d * 3 + 0) * 1024 : p == 3 ? mu_rkv + (d * 3 + 1) * 1024 : p == 4 ? mu_rkv + (d * 3 + 2) * 1024 : p == 5 ? k_k : p == 6 ? k_a : r_k;
        prm[it * 64 + lane] = src[ch]; }
    LDS_WAIT(); asm volatile("" ::: "memory");
    unsigned pend = 0u;
    if (lane == 0) pend = __hip_atomic_fetch_add(qh, 1u, __ATOMIC_RELAXED, __HIP_MEMORY_SCOPE_AGENT);
    for (;;) {
        const int tt = __builtin_amdgcn_readfirstlane((int)pend);
        if (tt >= MROWS / 16) break;
        if (lane == 0) pend = __hip_atomic_fetch_add(qh, 1u, __ATOMIC_RELAXED, __HIP_MEMORY_SCOPE_AGENT);
        const int m0 = tt * 16;
        const bool isctx = m0 >= NLAT; const int T = isctx ? CTXL : SEQ; const int t0 = isctx ? ((m0 - NLAT) & 255) : (m0 & 8191); const int b = isctx ? ((m0 - NLAT) >> 8) : (m0 >> 13);
        const int m = m0 + n, t = t0 + n; const bool hasnb = d == 0 ? (t > 0) : (t < T - 1); const int nbr = hasnb ? (d == 0 ? m - 1 : m + 1) : m;
        const bf16* prow = P + (size_t)m * NIN; const bf16* nrow = P + (size_t)nbr * NIN;
        bf16x8 Bw[2], Ba[2];
        {   v4u cw[2], nw[2], ca[2], na[2]; f32x4 mw[2][2], ma[2][2];
#pragma unroll
            for (int ks = 0; ks < 2; ++ks) { const int j0 = 32 * ks + 8 * q4;
                cw[ks] = *(const v4u*)(prow + C_RWWD + d * 64 + j0); nw[ks] = *(const v4u*)(nrow + C_RWWD + d * 64 + j0);
                ca[ks] = *(const v4u*)(prow + C_RWAD + d * 64 + j0); na[ks] = *(const v4u*)(nrow + C_RWAD + d * 64 + j0);
                mw[ks][0] = *(const f32x4*)(mu_lora + (d * 2 + 0) * 64 + j0); mw[ks][1] = *(const f32x4*)(mu_lora + (d * 2 + 0) * 64 + j0 + 4);
                ma[ks][0] = *(const f32x4*)(mu_lora + (d * 2 + 1) * 64 + j0); ma[ks][1] = *(const f32x4*)(mu_lora + (d * 2 + 1) * 64 + j0 + 4); }
            __builtin_amdgcn_sched_barrier(0);
#pragma unroll
            for (int ks = 0; ks < 2; ++ks) {
                float cur[8], nb[8], o[8];
                unpack8(cw[ks], cur); unpack8(nw[ks], nb);
#pragma unroll
                for (int j = 0; j < 8; ++j) { const float xx = cur[j] + ((hasnb ? nb[j] : 0.f) - cur[j]) * mw[ks][j >> 2][j & 3]; o[j] = 1.0f - 2.0f * rcp_f(1.0f + __expf(2.0f * xx)); }
                Bw[ks] = __builtin_bit_cast(bf16x8, pack8(o));
                unpack8(ca[ks], cur); unpack8(na[ks], nb);
#pragma unroll
                for (int j = 0; j < 8; ++j) o[j] = cur[j] + ((hasnb ? nb[j] : 0.f) - cur[j]) * ma[ks][j >> 2][j & 3];
                Ba[ks] = __builtin_bit_cast(bf16x8, pack8(o)); }
        }
        const int pos = scan_pos(d, isctx, t);
#pragma unroll 1
        for (int hh = 0; hh < 2; ++hh) {
            const int head = hp * 2 + hh, chain = (b * 2 + d) * 16 + head;
            char* recb = (char*)REC + ((size_t)chain * SCANLEN + pos) * RECB;
            const LAS float* pr = prm + hh * 512;
            float KK[16], AV[16]; float ss = 0.f, bon = 0.f;
#pragma unroll
            for (int hf = 0; hf < 2; ++hf) {
                const int cl = 32 * hf + 8 * q4, cg = head * 64 + cl;
                bf16x8 wf[2][2], af[2][2];
#pragma unroll
                for (int tq = 0; tq < 2; ++tq) { const size_t wrow = (size_t)(d * 1024 + head * 64 + 32 * hf + 8 * (n >> 2) + 4 * tq + (n & 3)) * 64 + 8 * q4;
                    wf[tq][0] = ld_frag(WUPT + wrow); wf[tq][1] = ld_frag(WUPT + wrow + 32); af[tq][0] = ld_frag(AUPT + wrow); af[tq][1] = ld_frag(AUPT + wrow + 32); }
                const v4u rcw = *(const v4u*)(prow + C_RWR + cg), kcw = *(const v4u*)(prow + C_RWK + cg), vcw = *(const v4u*)(prow + C_RWV + cg);
                const v4u rnw = *(const v4u*)(nrow + C_RWR + cg), knw = *(const v4u*)(nrow + C_RWK + cg), vnw = *(const v4u*)(nrow + C_RWV + cg);
                __builtin_amdgcn_sched_barrier(0);
                f32x4 accW[2], accA[2];
#pragma unroll
                for (int tq = 0; tq < 2; ++tq) { f32x4 z = {0.f, 0.f, 0.f, 0.f}; z = mfma16(wf[tq][0], Bw[0], z); accW[tq] = mfma16(wf[tq][1], Bw[1], z);
                                                 f32x4 y = {0.f, 0.f, 0.f, 0.f}; y = mfma16(af[tq][0], Ba[0], y); accA[tq] = mfma16(af[tq][1], Ba[1], y); }
                float rc[8], kc[8], vc[8], rn[8], kn[8], vn[8];
                unpack8(rcw, rc); unpack8(kcw, kc); unpack8(vcw, vc); unpack8(rnw, rn); unpack8(knw, kn); unpack8(vnw, vn);
                float dec[8], kp[8], rr[8], vv[8];
#pragma unroll
                for (int g = 0; g < 2; ++g) {
                    const f32x4 w0v = *(const LAS f32x4*)(pr + 0 * 64 + cl + 4 * g), a0v = *(const LAS f32x4*)(pr + 1 * 64 + cl + 4 * g), mur = *(const LAS f32x4*)(pr + 2 * 64 + cl + 4 * g),
                                muk = *(const LAS f32x4*)(pr + 3 * 64 + cl + 4 * g), muv = *(const LAS f32x4*)(pr + 4 * 64 + cl + 4 * g), kkv = *(const LAS f32x4*)(pr + 5 * 64 + cl + 4 * g),
                                kav = *(const LAS f32x4*)(pr + 6 * 64 + cl + 4 * g), rkv = *(const LAS f32x4*)(pr + 7 * 64 + cl + 4 * g);
#pragma unroll
                    for (int i = 0; i < 4; ++i) { const int j = 4 * g + i;
                        const float rnb = hasnb ? rn[j] : 0.f, knb = hasnb ? kn[j] : 0.f, vnb = hasnb ? vn[j] : 0.f;
                        const float r_ = rc[j] + (rnb - rc[j]) * mur[i], k0 = kc[j] + (knb - kc[j]) * muk[i], v_ = vc[j] + (vnb - vc[j]) * muv[i];
                        const float xw = -(w0v[i] + accW[g][i]);
                        const float sp = fmaxf(xw, 0.f) + __logf(1.0f + __expf(-fabsf(xw)));
                        dec[j] = __expf(-__expf(-sp - 0.5f));
                        const float av = rcp_f(1.0f + __expf(-(a0v[i] + accA[g][i])));
                        const float kx = k0 * kkv[i]; ss += kx * kx;
                        const float kp_ = k0 * (1.f + (av - 1.f) * kav[i]); bon += r_ * kp_ * rkv[i];
                        KK[8 * hf + j] = kx; AV[8 * hf + j] = av; kp[j] = kp_; rr[j] = r_; vv[j] = v_; }
                }
                char* ob = recb + cl * 2;
                REC_ST((f32x4*)(recb + cl * 4), ((f32x4){dec[0], dec[1], dec[2], dec[3]})); REC_ST((f32x4*)(recb + cl * 4 + 16), ((f32x4){dec[4], dec[5], dec[6], dec[7]}));
                REC_ST((h8*)(ob + 512), ((h8){(_Float16)kp[0], (_Float16)kp[1], (_Float16)kp[2], (_Float16)kp[3], (_Float16)kp[4], (_Float16)kp[5], (_Float16)kp[6], (_Float16)kp[7]}));
                REC_ST((h8*)(ob + 640), ((h8){(_Float16)rr[0], (_Float16)rr[1], (_Float16)rr[2], (_Float16)rr[3], (_Float16)rr[4], (_Float16)rr[5], (_Float16)rr[6], (_Float16)rr[7]}));
                REC_ST((h8*)(ob + 768), ((h8){(_Float16)vv[0], (_Float16)vv[1], (_Float16)vv[2], (_Float16)vv[3], (_Float16)vv[4], (_Float16)vv[5], (_Float16)vv[6], (_Float16)vv[7]}));
                __builtin_amdgcn_sched_barrier(0);
            }
            ss = sum16x4(ss); bon = sum16x4(bon);
            const float inv = rsq_f(fmaxf(ss, 1e-12f));
#pragma unroll
            for (int hf = 0; hf < 2; ++hf) { char* ob = recb + (32 * hf + 8 * q4) * 2; float kkn[8], nka[8];
#pragma unroll
                for (int j = 0; j < 8; ++j) { kkn[j] = KK[8 * hf + j] * inv; nka[j] = -(kkn[j] * AV[8 * hf + j]); }
                REC_ST((h8*)(ob + 256), ((h8){(_Float16)kkn[0], (_Float16)kkn[1], (_Float16)kkn[2], (_Float16)kkn[3], (_Float16)kkn[4], (_Float16)kkn[5], (_Float16)kkn[6], (_Float16)kkn[7]}));
                REC_ST((h8*)(ob + 384), ((h8){(_Float16)nka[0], (_Float16)nka[1], (_Float16)nka[2], (_Float16)nka[3], (_Float16)nka[4], (_Float16)nka[5], (_Float16)nka[6], (_Float16)nka[7]})); }
            if (q4 == 0) BON[(size_t)chain * SCANLEN + pos] = bon;
        }
    }
}
template <bool CTXQ>
__device__ __forceinline__ void na_unit(const bf16* QN, const bf16* KN, const bf16* VTL, const bf16* VTC, const bf16* P, const float* rpb  , bf16* Y, int u, int lane) {
    const int n = lane & 15, q4 = lane >> 4;
    int b, h, qrow0, qr = 0, jt = 0;
    if (CTXQ) { b = u >> 8; h = (u >> 4) & 15; qrow0 = NLAT + b * CTXL + 16 * (u & 15); }
    else { jt = u & 3; h = (u >> 2) & 15; qr = (u >> 6) & 127; b = u >> 13; qrow0 = b * SEQ + qr * 64 + 16 * jt; }
    constexpr int NT = CTXQ ? 16 : 32, WT = CTXQ ? 0 : 16;
    f32x4 s[NT];
    const int rs = qr - 4 < 0 ? 0 : (qr - 4 > 120 ? 120 : qr - 4);
    const int span0 = jt == 0 ? 0 : (jt == 1 ? 8 : (jt == 2 ? 24 : 32));
    const int qc = 16 * jt + n; const int cs = qc - 8 < 0 ? 0 : (qc - 8 > 48 ? 48 : qc - 8);
    bf16x8 qf[2];
#pragma unroll
    for (int ks = 0; ks < 2; ++ks) qf[ks] = ld_frag(QN + (size_t)(qrow0 + n) * GWD + h * 64 + 32 * ks + 8 * q4);
    if (!CTXQ) {
        const float* rp = rpb + (size_t)h * 15 * 31;
#pragma unroll
        for (int wt = 0; wt < 16; ++wt) { const int kri = wt >> 1, half = wt & 1, relr = rs + kri - qr + 7;
#pragma unroll
            for (int i = 0; i < 4; ++i) { const int relc = span0 + 8 * q4 + 4 * half + i - qc + 15; const int relcc = relc < 0 ? 0 : (relc > 30 ? 30 : relc); s[wt][i] = rp[relr * 31 + relcc]; } }
        __builtin_amdgcn_sched_barrier(0);
#pragma unroll
        for (int bt = 0; bt < 2; ++bt) {
            bf16x8 kf[16];
#pragma unroll
            for (int t = 0; t < 8; ++t) { const int wt = bt * 8 + t, kri = wt >> 1, half = wt & 1;
                const bf16* kp = KN + (size_t)(b * SEQ + (rs + kri) * 64 + span0 + 8 * (n >> 2) + 4 * half + (n & 3)) * GWD + h * 64 + 8 * q4; kf[2 * t] = ld_frag(kp); kf[2 * t + 1] = ld_frag(kp + 32); }
            __builtin_amdgcn_sched_barrier(0);
#pragma unroll
            for (int t = 0; t < 8; ++t) { const int wt = bt * 8 + t, half = wt & 1;
                f32x4 a = s[wt];
#pragma unroll
                for (int i = 0; i < 4; ++i) { const int kc = span0 + 8 * q4 + 4 * half + i; const bool ok = kc >= cs && kc < cs + 16; a[i] = ok ? a[i] : -INFINITY; }
                a = mfma16(kf[2 * t], qf[0], a); a = mfma16(kf[2 * t + 1], qf[1], a); s[wt] = a; }
            __builtin_amdgcn_sched_barrier(0);
        }
    }
#pragma unroll
    for (int bt = 0; bt < 2; ++bt) {
        bf16x8 kf[16];
#pragma unroll
        for (int t = 0; t < 8; ++t) { const int ctile = bt * 8 + t; const bf16* kp = KN + (size_t)(NLAT + b * CTXL + 32 * (ctile >> 1) + 8 * (n >> 2) + 4 * (ctile & 1) + (n & 3)) * GWD + h * 64 + 8 * q4; kf[2 * t] = ld_frag(kp); kf[2 * t + 1] = ld_frag(kp + 32); }
        __builtin_amdgcn_sched_barrier(0);
#pragma unroll
        for (int t = 0; t < 8; ++t) { f32x4 a = {0.f, 0.f, 0.f, 0.f}; a = mfma16(kf[2 * t], qf[0], a); a = mfma16(kf[2 * t + 1], qf[1], a); s[WT + bt * 8 + t] = a; }
        __builtin_amdgcn_sched_barrier(0);
    }
    float mx = -INFINITY;
#pragma unroll
    for (int t = 0; t < NT; ++t) mx = fmaxf(fmaxf(fmaxf(s[t][0], s[t][1]), fmaxf(s[t][2], s[t][3])), mx);
    mx = max16x4(mx);
    float sum = 0.f;
#pragma unroll
    for (int t = 0; t < NT; ++t) {
#pragma unroll
        for (int i = 0; i < 4; ++i) { const float e = __expf(s[t][i] - mx); s[t][i] = e; sum += e; } }
    sum = sum16x4(sum);
    const float inv = rcp_f(sum);
    f32x4 o[4];
#pragma unroll
    for (int nt = 0; nt < 4; ++nt) o[nt] = (f32x4){0.f, 0.f, 0.f, 0.f};
#pragma unroll
    for (int tb = 0; tb < NT / 8; ++tb) {
        v4u vv[4][4];
#pragma unroll
        for (int tq = 0; tq < 4; ++tq) { const int tp = tb * 4 + tq;
            const bf16* vb; size_t dstride;
            if (!CTXQ && tp < 8) { vb = VTL + ((size_t)(b * 16 + h) * 64 + n) * 8192 + (rs + tp) * 64 + span0 + 8 * q4; dstride = (size_t)16 * 8192; }
            else { const int cp = tp - (CTXQ ? 0 : 8); vb = VTC + ((size_t)(b * 16 + h) * 64 + n) * 256 + 32 * cp + 8 * q4; dstride = (size_t)16 * 256; }
#pragma unroll
            for (int nt = 0; nt < 4; ++nt) vv[tq][nt] = *(const v4u*)(vb + nt * dstride); }
        __builtin_amdgcn_sched_barrier(0);
#pragma unroll
        for (int tq = 0; tq < 4; ++tq) { const int tp = tb * 4 + tq;
            const f32x4 p0 = s[2 * tp] * inv, p1 = s[2 * tp + 1] * inv;
            v4u aw; aw.x = pk2(p0[0], p0[1]); aw.y = pk2(p0[2], p0[3]); aw.z = pk2(p1[0], p1[1]); aw.w = pk2(p1[2], p1[3]);
            const bf16x8 af = __builtin_bit_cast(bf16x8, aw);
#pragma unroll
            for (int nt = 0; nt < 4; ++nt) o[nt] = mfma16(af, __builtin_bit_cast(bf16x8, vv[tq][nt]), o[nt]); }
        __builtin_amdgcn_sched_barrier(0);
    }
    unsigned short zz[4][4];
#pragma unroll
    for (int nt = 0; nt < 4; ++nt)
#pragma unroll
        for (int i = 0; i < 4; ++i) zz[nt][i] = P[(size_t)(qrow0 + 4 * q4 + i) * NIN + C_NAZ + h * 64 + 16 * nt + n];
    __builtin_amdgcn_sched_barrier(0);
#pragma unroll
    for (int nt = 0; nt < 4; ++nt)
#pragma unroll
        for (int i = 0; i < 4; ++i) { const int row = qrow0 + 4 * q4 + i, col = h * 64 + 16 * nt + n;
            Y[(size_t)row * DM + 1024 + col] = (bf16)f2bf(o[nt][i] * silu_f(bf2f(zz[nt][i]))); }
}
__device__ __forceinline__ void bar4(LAS unsigned* cnt, unsigned& seq, int lane) {
    asm volatile("s_waitcnt vmcnt(0) lgkmcnt(0)" ::: "memory");
    const unsigned baddr = (unsigned)(size_t)cnt, one = 1u; seq += 4u;
    if (lane == 0) asm volatile("ds_add_u32 %0, %1" :: "v"(baddr), "v"(one) : "memory");
    unsigned sp = 0, got;
    for (;;) { asm volatile("ds_read_b32 %0, %1\n\ts_waitcnt lgkmcnt(0)" : "=v"(got) : "v"(baddr) : "memory");
        if (__builtin_amdgcn_readfirstlane((int)got) >= (int)seq) break; __builtin_amdgcn_s_sleep(1); if (++sp > (1u << 22)) break; }
    asm volatile("" ::: "memory");
}
__device__ __forceinline__ void phase_sgu4(const bf16* P, const f32x2* SGST, const float* lnw, const float* lnb, const bf16* SGW, const float* sgb, bf16* Y,
                                           LAS unsigned char* ldsT, LAS unsigned* cnt, int nchunks, int tid4  , int w4  , int lane) {
    const int n = lane & 15, q4 = lane >> 4;
    LAS bf16* T = (LAS bf16*)ldsT; unsigned seq = 0u;
    for (int u = blockIdx.x; u < nchunks * 8; u += 256) {
        const int ck = u >> 3, g = u & 7, m0 = ck * 128;
#pragma unroll
        for (int it = 0; it < 8; ++it) { const int idx = tid4 + 256 * it, q = idx >> 4, c8 = idx & 15;
            float x[8]; unpack8(*(const v4u*)(P + (size_t)(m0 + q) * NIN + C_SGV + g * 128 + 8 * c8), x);
            const f32x2 st = SGST[m0 + q];
#pragma unroll
            for (int j = 0; j < 8; ++j) { const int c = 8 * c8 + j; const float v = (x[j] - st.x) * st.y * lnw[g * 128 + c] + lnb[g * 128 + c]; T[c * 136 + q] = (bf16)f2bf(v); } }
        bar4(cnt, seq, lane);
#pragma unroll 1
        for (int mt = 0; mt < 2; ++mt) { const int mrow = 32 * w4 + 16 * mt;
            bf16x8 af[4];
#pragma unroll
            for (int ks = 0; ks < 4; ++ks) af[ks] = ld_frag(SGW + ((size_t)g * 128 + mrow + n) * 128 + 32 * ks + 8 * q4);
            unsigned short uu16[8][4], zz16[8][4]; float sb4[4];
#pragma unroll
            for (int i = 0; i < 4; ++i) { const int p = mrow + 4 * q4 + i; sb4[i] = sgb[g * 128 + p]; const bf16* pr = P + (size_t)(m0 + p) * NIN + g * 128 + n;
#pragma unroll
                for (int nt = 0; nt < 8; ++nt) { uu16[nt][i] = pr[C_SGU + 16 * nt]; zz16[nt][i] = pr[C_SGZ + 16 * nt]; } }
            __builtin_amdgcn_sched_barrier(0);
#pragma unroll
            for (int nt = 0; nt < 8; ++nt) {
                f32x4 acc = {0.f, 0.f, 0.f, 0.f};
#pragma unroll
                for (int ks = 0; ks < 4; ++ks) { const bf16x8 bfg = *(const LAS bf16x8*)(T + (16 * nt + n) * 136 + 32 * ks + 8 * q4); acc = mfma16(af[ks], bfg, acc); }
#pragma unroll
                for (int i = 0; i < 4; ++i) { const int p = mrow + 4 * q4 + i, row = m0 + p, col = g * 128 + 16 * nt + n;
                    Y[(size_t)row * DM + 3072 + col] = (bf16)f2bf(bf2f(uu16[nt][i]) * (acc[i] + sb4[i]) * silu_f(bf2f(zz16[nt][i]))); }
            }
        }
        bar4(cnt, seq, lane);
    }
}
__device__ __forceinline__ void scan_self(const float* REC, float* YR, LAS unsigned char* lds, LAS unsigned* bcnt, int su, int wave, int lane) {
    constexpr int CS = 32, NCH = SCANLEN / CS, SLOT = CS * RECB, NPW = SLOT / 1024 / 4;
    const int chain = (su & 7) * 8 + ((su >> 3) >> 2), part = (su >> 3) & 3;
    const char* recb = (const char*)REC + (size_t)chain * SCANLEN * RECB;
    const int wl = wave;
#define SCAN_ISSUE(cc, sl) do { _Pragma("unroll") for (int p_ = 0; p_ < NPW; ++p_) \
    __builtin_amdgcn_global_load_lds((const unsigned*)(recb + (size_t)(cc) * SLOT + (wl * NPW + p_) * 1024 + lane * 16), (LAS unsigned*)(lds + (sl) * SLOT + (wl * NPW + p_) * 1024), 16, 0, 0); } while (0)
    __builtin_amdgcn_s_setprio(3);
    SCAN_ISSUE(0, 0); SCAN_ISSUE(1, 1);
    const int c16 = lane & 15, rg = lane >> 4, row = 16 * part + 4 * wave + rg;
    float S0 = 0.f, S1 = 0.f, S2 = 0.f, S3 = 0.f;
    float* yout = YR + (size_t)chain * SCANLEN * 64 + row;
    const int lo_w = c16 * 16, lo_h = 256 + c16 * 8, lo_v = 768 + row * 2;
#define SCAN_LD(dst, s_) do { const unsigned ahj_ = ah + ((s_) & ~1) * RECB; \
    asm volatile("ds_read_b128 %0, %1 offset:%2" : "=v"(dst##w) : "v"(aw), "i"((s_) * RECB)); \
    asm volatile("ds_read_u16 %0, %1 offset:%2" : "=v"(dst##v) : "v"(av), "i"((s_) * RECB)); \
    asm volatile("ds_read2_b64 %0, %1 offset0:%2 offset1:%3" : "=v"(dst##kn) : "v"(ahj_), "i"(((s_) & 1) * (RECB / 8)), "i"(((s_) & 1) * (RECB / 8) + 16)); \
    asm volatile("ds_read2_b64 %0, %1 offset0:%2 offset1:%3" : "=v"(dst##kr) : "v"(ahj_), "i"(((s_) & 1) * (RECB / 8) + 32), "i"(((s_) & 1) * (RECB / 8) + 48)); } while (0)
#define H4LO(q_) __builtin_bit_cast(h4, (v2u){(q_).x, (q_).y})
#define H4HI(q_) __builtin_bit_cast(h4, (v2u){(q_).z, (q_).w})
#define FMX(a, b, c) __builtin_fmaf((a), (float)(b), (c))
    int sl = 0;
    for (int c = 0; c < NCH; ++c) {
        asm volatile("s_waitcnt vmcnt(7)" ::: "memory");
        {   const unsigned baddr = (unsigned)(size_t)bcnt, one = 1u;
            if (lane == 0) asm volatile("ds_add_u32 %0, %1" :: "v"(baddr), "v"(one) : "memory");
            const unsigned want = 4u * (unsigned)(c + 1); unsigned sp = 0, got;
            for (;;) { asm volatile("ds_read_b32 %0, %1\n\ts_waitcnt lgkmcnt(0)" : "=v"(got) : "v"(baddr) : "memory");
                if (__builtin_amdgcn_readfirstlane((int)got) >= (int)want) break; __builtin_amdgcn_s_sleep(1); if (++sp > (1u << 22)) break; } }
        asm volatile("" ::: "memory");
        {   const int cc = c + 2 < NCH ? c + 2 : NCH - 1; const int s2 = sl == 0 ? 2 : sl - 1; SCAN_ISSUE(cc, s2); }
        const LAS unsigned char* slot = lds + sl * SLOT;
        sl = sl == 2 ? 0 : sl + 1;
        float ysv0 = 0.f, ysv1 = 0.f; float yp[16];
        const unsigned aw = (unsigned)(size_t)(slot + lo_w), ah = (unsigned)(size_t)(slot + lo_h), av = (unsigned)(size_t)(slot + lo_v);
        f32x4 Aw; v4u Akn, Akr; unsigned Av; h4 Pr;
        SCAN_LD(A, 0);
#pragma unroll
        for (int s = 0; s < CS; ++s) {
            f32x4 Bw; v4u Bkn, Bkr; unsigned Bv;
            if (s < CS - 1) { SCAN_LD(B, s + 1); asm volatile("s_waitcnt lgkmcnt(4)" : "+v"(Aw), "+v"(Akn), "+v"(Akr), "+v"(Av)); }
            else asm volatile("s_waitcnt lgkmcnt(0)" : "+v"(Aw), "+v"(Akn), "+v"(Akr), "+v"(Av));
            __builtin_amdgcn_sched_barrier(0);
            const h4 Akk = H4LO(Akn), Ana = H4HI(Akn), Ak = H4LO(Akr), Ar = H4HI(Akr); const _Float16 Avh = __builtin_bit_cast(_Float16, (unsigned short)Av);
            if (s > 0) { float q0 = FMX(S0, Pr.x, 0.f), q1 = FMX(S2, Pr.z, 0.f); q0 = FMX(S1, Pr.y, q0); q1 = FMX(S3, Pr.w, q1); yp[(s - 1) & 15] = q0 + q1; }
            float p0 = FMX(S0, Akk.x, 0.f), p1 = FMX(S2, Akk.z, 0.f); p0 = FMX(S1, Akk.y, p0); p1 = FMX(S3, Akk.w, p1);
            const float dt = red16(p0 + p1);
            const float u0 = __builtin_fmaf(S0, Aw.x, FMX((float)Avh, Ak.x, 0.f)), u1 = __builtin_fmaf(S1, Aw.y, FMX((float)Avh, Ak.y, 0.f)),
                        u2 = __builtin_fmaf(S2, Aw.z, FMX((float)Avh, Ak.z, 0.f)), u3 = __builtin_fmaf(S3, Aw.w, FMX((float)Avh, Ak.w, 0.f));
            S0 = FMX(dt, Ana.x, u0); S1 = FMX(dt, Ana.y, u1); S2 = FMX(dt, Ana.z, u2); S3 = FMX(dt, Ana.w, u3);
            if (s == 16) ysv0 = red16_transpose(yp, c16);
            Pr = Ar;
            if (s < CS - 1) { Aw = Bw; Akn = Bkn; Akr = Bkr; Av = Bv; }
        }
        { float q0 = FMX(S0, Pr.x, 0.f), q1 = FMX(S2, Pr.z, 0.f); q0 = FMX(S1, Pr.y, q0); q1 = FMX(S3, Pr.w, q1); yp[15] = q0 + q1; }
        ysv1 = red16_transpose(yp, c16);
        asm volatile("" ::: "memory");
        yout[(size_t)(c * CS + c16) * 64] = ysv0; yout[(size_t)(c * CS + 16 + c16) * 64] = ysv1;
    }
    asm volatile("s_waitcnt vmcnt(0)" ::: "memory");
    __builtin_amdgcn_s_setprio(0);
#undef FMX
#undef SCAN_LD
#undef H4LO
#undef H4HI
#undef SCAN_ISSUE
}
__device__ __forceinline__ void phase_rwfin(const bf16* P, const float* YR, const float* REC, const float* BON, const float* lnw, const float* lnb, bf16* Y, int nrows, int gw, int NGW, int lane) {
    const int head = lane >> 2, sub = lane & 3;
    for (int m = gw; m < nrows; m += NGW) {
        const bool isctx = m >= NLAT; const int t = isctx ? ((m - NLAT) & 255) : (m & 8191); const int b = isctx ? ((m - NLAT) >> 8) : (m >> 13);
        float out[16];
#pragma unroll
        for (int i = 0; i < 16; ++i) out[i] = 0.f;
#pragma unroll
        for (int d = 0; d < 2; ++d) {
            const int chain = (b * 2 + d) * 16 + head; const size_t pp = (size_t)chain * SCANLEN + scan_pos(d, isctx, t);
            float y[16], v[16];
#pragma unroll
            for (int j = 0; j < 4; ++j) { const f32x4 a = *(const f32x4*)(YR + pp * 64 + 16 * sub + 4 * j); const h4 c = *(const h4*)((const char*)REC + pp * RECB + 768 + (16 * sub + 4 * j) * 2);
                y[4 * j] = a.x; y[4 * j + 1] = a.y; y[4 * j + 2] = a.z; y[4 * j + 3] = a.w; v[4 * j] = (float)c.x; v[4 * j + 1] = (float)c.y; v[4 * j + 2] = (float)c.z; v[4 * j + 3] = (float)c.w; }
            const float bo = BON[pp];
            float s = 0.f;
#pragma unroll
            for (int i = 0; i < 16; ++i) s += y[i];
            s += __shfl_xor(s, 1); s += __shfl_xor(s, 2);
            const float mean = s * (1.f / 64.f); float q = 0.f;
#pragma unroll
            for (int i = 0; i < 16; ++i) { const float dl = y[i] - mean; q += dl * dl; }
            q += __shfl_xor(q, 1); q += __shfl_xor(q, 2);
            const float rstd = rsq_f(q * (1.f / 64.f) + 64e-5f);
#pragma unroll
            for (int i = 0; i < 16; ++i) { const int ch = head * 64 + 16 * sub + i; out[i] += (y[i] - mean) * rstd * lnw[ch] + lnb[ch] + bo * v[i]; }
        }
        float z[16]; unpack8(*(const v4u*)(P + (size_t)m * NIN + C_RWZ + 16 * lane), z); unpack8(*(const v4u*)(P + (size_t)m * NIN + C_RWZ + 16 * lane + 8), z + 8);
#pragma unroll
        for (int i = 0; i < 16; ++i) out[i] *= silu_f(z[i]);
        *(v4u*)(Y + (size_t)m * DM + 2048 + 16 * lane) = pack8(out); *(v4u*)(Y + (size_t)m * DM + 2048 + 16 * lane + 8) = pack8(out + 8);
    }
}
#define XB_TMO      128
#define XB_XCNT(j)  (256  + 64 * (j))
#define XB_XSUB(j)  (1280 + 64 * (j))
#define XB_XGEN(j)  (2304 + 64 * (j))
#define XB_TOP      3328
#define XB_TOPGEN   3392
#define XCD_BAR_WORDS 3456
#define XB_SPIN_CAP (1u << 18)

__device__ __forceinline__ unsigned xb_ld(unsigned* p)              { return __hip_atomic_load(p, __ATOMIC_RELAXED, __HIP_MEMORY_SCOPE_AGENT); }
__device__ __forceinline__ unsigned xb_add(unsigned* p, unsigned v) { return __hip_atomic_fetch_add(p, v, __ATOMIC_RELAXED, __HIP_MEMORY_SCOPE_AGENT); }
__device__ __forceinline__ unsigned xb_xcc_id() { return (unsigned)__builtin_amdgcn_s_getreg((3 << 11) | 20) & 0xFu; }
#define XB_SPIN(cond, bar) do { unsigned _sp = 0; while (cond) { __builtin_amdgcn_s_sleep(1); \
    if ((++_sp & 255u) == 0u) { if (xb_ld(&(bar)[XB_TMO])) break; if (_sp > XB_SPIN_CAP) { atomicAdd(&(bar)[XB_TMO], 1u); break; } } } } while (0)

struct XcdBarrier {
    unsigned* bar; unsigned x;
    volatile LAS unsigned* st;
};

__device__ __forceinline__ XcdBarrier xcd_barrier_post(unsigned* bar, volatile LAS unsigned* st) {
    XcdBarrier b; b.bar = bar; b.x = xb_xcc_id(); b.st = st;
    if (threadIdx.x == 0) (void)xb_add(&bar[XB_XCNT(b.x)], 1u);
    return b;
}
__device__ __forceinline__ void xcd_barrier_complete(unsigned* bar, unsigned x, unsigned& nloc, unsigned& nx) {
    const unsigned G = gridDim.x * gridDim.y * gridDim.z;
    unsigned sum, cnt, mine, sp = 0u;
    for (;;) {
        sum = 0u; cnt = 0u; mine = 0u;
#pragma unroll
        for (unsigned j = 0; j < 16; ++j) { const unsigned c = xb_ld(&bar[XB_XCNT(j)]); sum += c; cnt += (c > 0u) ? 1u : 0u; mine = (j == x) ? c : mine; }
        if (sum == G) break;
        __builtin_amdgcn_s_sleep(1);
        if ((++sp & 255u) == 0u) { if (xb_ld(&bar[XB_TMO])) break; if (sp > XB_SPIN_CAP) { atomicAdd(&bar[XB_TMO], 1u); break; } }
    }
    nloc = mine > 0u ? mine : 1u; nx = cnt > 0u ? cnt : 1u;
}

__device__ __forceinline__ void xcd_barrier(const XcdBarrier& b) {
    asm volatile("s_waitcnt vmcnt(0)" ::: "memory");
    __syncthreads();
    if (threadIdx.x == 0) {
        unsigned* bar = b.bar;
        __builtin_amdgcn_s_waitcnt(0);
        unsigned nloc = b.st[0], nx = b.st[1];
        if (nloc == 0u) { xcd_barrier_complete(bar, b.x, nloc, nx); b.st[0] = nloc; b.st[1] = nx; }
        const unsigned old = xb_add(&bar[XB_XSUB(b.x)], 1u);
        const unsigned gen = old / nloc;
        if (old + 1u == (gen + 1u) * nloc) {
            __builtin_amdgcn_fence(__ATOMIC_RELEASE, "agent");
            asm volatile("s_waitcnt vmcnt(0)" ::: "memory");
            const unsigned og = xb_add(&bar[XB_TOP], 1u);
            const unsigned tg = og / nx;
            if (og + 1u == (tg + 1u) * nx) xb_add(&bar[XB_TOPGEN], 1u);
            else XB_SPIN(xb_ld(&bar[XB_TOPGEN]) == tg, bar);
            __builtin_amdgcn_fence(__ATOMIC_ACQUIRE, "agent");
            xb_add(&bar[XB_XGEN(b.x)], 1u);
            asm volatile("s_waitcnt vmcnt(0)" ::: "memory");
        } else {
            XB_SPIN(xb_ld(&bar[XB_XGEN(b.x)]) == gen, bar);
            __builtin_amdgcn_fence(__ATOMIC_ACQUIRE, "agent");
            asm volatile("s_waitcnt vmcnt(0)" ::: "memory");
        }
    }
    __syncthreads();
}

#ifndef MK_SPLIT
#define MK_SPLIT 0
#endif
constexpr int PPL = 6;
constexpr int NPHASE = 2 + PPL * DEPTH;
constexpr int RWP_BLOCKS = 14;
constexpr int CW_RWQ = 16384;
constexpr int NGRID = 256;
struct Args { const float* in[28]; float* out; unsigned char* ws; int ph_lo, ph_hi, li, pad; };

__global__ void __launch_bounds__(NWAVES * 64, 2) fwd(Args args) {
    extern __shared__ __attribute__((aligned(16))) unsigned char lds_raw[];
    LAS unsigned char* lds = (LAS unsigned char*)lds_raw;
    volatile LAS unsigned* MISC = (volatile LAS unsigned*)(lds + MISC_OFF);
    const int tid = threadIdx.x, lane = tid & 63, wave = __builtin_amdgcn_readfirstlane(tid >> 6);
    constexpr int G = NGRID; const int bx = blockIdx.x;
    const int vcu = (bx % 8) * (G / 8) + bx / 8;
    const int gw = vcu * NWAVES + wave; constexpr int NGW = G * NWAVES;
    unsigned char* ws = args.ws;
    const int lo = args.ph_lo, hi = args.ph_hi;

    for (int u = tid; u < (LDS_BYTES - LDSCTL_OFF) / 4; u += NWAVES * 64) ((LAS unsigned*)(lds + LDSCTL_OFF))[u] = 0u;
    __syncthreads();
    XcdBarrier bar; bar.bar = (unsigned*)(ws + WS_CTL) + CW_BAR; bar.x = 0; bar.st = MISC + 8;
    if (hi - lo > 1) bar = xcd_barrier_post((unsigned*)(ws + WS_CTL) + CW_BAR, MISC + 8);
#define IN(k) (lo <= (k) && (k) < hi)
#define SEAM(k) do { if (lo <= (k) && (k) + 1 < hi) { XcdBarrier b2_; b2_.bar = WSP(unsigned, WS_CTL) + CW_BAR; b2_.x = bar.x; b2_.st = bar.st; xcd_barrier(b2_); } } while (0)

#define OPQ_S(x) ({ int _t = (x); asm volatile("" : "+s"(_t)); _t; })
#define OPQ_V(x) ({ int _t = (x); asm volatile("" : "+v"(_t)); _t; })
#define INP(i) (args.in[OPQ_S(i)])
#define WSP(T, off) ((T*)(args.ws + ({ size_t _o = (off); asm volatile("" : "+s"(_o)); _o; })))
#define x_in INP(0)
#define c_in INP(1)
#define ctx_in INP(2)
#define cctx_in INP(3)
#define w_mod INP(4)
#define b_mod INP(5)
#define w_in INP(6)
#define w_out INP(7)
#define pool_w INP(8)
#define pool_scale INP(9)
#define na_qg INP(10)
#define na_kg INP(11)
#define na_rpb INP(12)
#define rw_mu_rkv INP(13)
#define rw_mu_lora INP(14)
#define rw_w0 INP(15)
#define rw_w_up INP(16)
#define rw_a0 INP(17)
#define rw_a_up INP(18)
#define rw_k_k INP(19)
#define rw_k_a INP(20)
#define rw_r_k INP(21)
#define rw_ln_w INP(22)
#define rw_ln_b INP(23)
#define sg_ln_w INP(24)
#define sg_ln_b INP(25)
#define sg_w INP(26)
#define sg_b INP(27)
#define MOD WSP(float, WS_MOD)
#define MODP WSP(float, WS_MODP)
#define TAB WSP(f32x2, WS_TAB)
#define SGST WSP(f32x2, WS_SGST)
#define BON WSP(float, WS_BON)
#define POOLWT WSP(bf16, WS_POOLWT)
#define WUPT WSP(bf16, WS_WUPT)
#define AUPT WSP(bf16, WS_AUPT)
#define SGW WSP(bf16, WS_SGW)
#define VTC WSP(bf16, WS_VTC)
#define VTL WSP(bf16, WS_VTL)
#define HCTX WSP(float, WS_HCTX)
#define QN WSP(bf16, WS_QN)
#define KN WSP(bf16, WS_KN)
#define WOUTT WSP(bf16, WS_WOUTT)
#define WINT WSP(bf16, WS_WINT)
#define XN WSP(bf16, WS_XN)
#define Y WSP(bf16, WS_Y)
#define P WSP(bf16, WS_P)
#define YR WSP(float, WS_YR)
#define REC WSP(float, WS_REC)
#define SILUC WSP(float, WS_SILUC)
    float* const out = args.out;

    if (IN(0)) {
        LAS float* scr = (LAS float*)(lds + wave * 16384);
        constexpr int I_MOD = 64 * 48  , I_WIN = 64 * (NIN / 32), I_WOUT = 64 * 128, I_POOL = 4 * 32, I_WUP = 2 * 32, I_AUP = 2 * 32, I_SGW = 256;
        constexpr int NITEMS = I_MOD + I_WIN + I_WOUT + I_POOL + I_WUP + I_AUP + I_SGW;
        for (int it = gw; it < NITEMS; it += NGW) {
            int r = it;
            if (r < I_MOD) { p0_mod_item(w_mod, c_in, cctx_in, MODP, scr, r, lane); continue; } r -= I_MOD;
            if (r < I_WIN) { p0_transpose_item<true>(w_in, DM, NIN, WINT, scr, r, lane); continue; } r -= I_WIN;
            if (r < I_WOUT) { p0_transpose_item(w_out, DM, DM, WOUTT, scr, r, lane); continue; } r -= I_WOUT;
            if (r < I_POOL) { const int g = r / 32; p0_transpose_item(pool_w + (size_t)g * 65536, 256, 256, POOLWT + (size_t)g * 65536, scr, r % 32, lane); continue; } r -= I_POOL;
            if (r < I_WUP) { const int dd = r / 32; p0_transpose_item(rw_w_up + (size_t)dd * 65536, 64, 1024, WUPT + (size_t)dd * 65536, scr, r % 32, lane); continue; } r -= I_WUP;
            if (r < I_AUP) { const int dd = r / 32; p0_transpose_item(rw_a_up + (size_t)dd * 65536, 64, 1024, AUPT + (size_t)dd * 65536, scr, r % 32, lane); continue; } r -= I_AUP;
            {   const size_t e0 = (size_t)r * 512 + lane * 8; const f32x4 a = *(const f32x4*)(sg_w + e0), b = *(const f32x4*)(sg_w + e0 + 4);
                v4u o; o.x = pk2(a.x, a.y); o.y = pk2(a.z, a.w); o.z = pk2(b.x, b.y); o.w = pk2(b.z, b.w); *(v4u*)(SGW + e0) = o; }
        }
        SEAM(0);
    }
    if (IN(1)) {

        for (int idx = gw * 64 + lane; idx < 3 * 4096; idx += NGW * 64) SILUC[idx] = silu_f(idx < 8192 ? c_in[idx] : cctx_in[idx - 8192]);
        for (int idx = gw * 64 + lane; idx < 3 * 12288; idx += NGW * 64) {
            const int l = idx / 36864, c = (idx / 12288) % 3, n = idx % 12288;
            float s = b_mod[l * 12288 + n];
            const float* pp = MODP + ((size_t)(l * 64) * 3 + c) * 12288 + n;
#pragma unroll 8
            for (int kc = 0; kc < 64; ++kc) s += pp[(size_t)kc * 3 * 12288];
            MOD[idx] = s;
        }
        for (int idx = gw * 64 + lane; idx < 2048; idx += NGW * 64) {
            const int pos = idx >> 4, i = idx & 15;
            float inv = (i & 3) == 0 ? 1.0f : ((i & 3) == 1 ? 0.5623413251903491f : ((i & 3) == 2 ? 0.31622776601683794f : 0.17782794100389228f));
            inv *= (i >> 2) == 0 ? 1.0f : ((i >> 2) == 1 ? 0.1f : ((i >> 2) == 2 ? 0.01f : 0.001f));
            float cc, sn; sincos_acc((float)pos * inv, cc, sn);
            TAB[idx] = (f32x2){cc, sn};
        }
        SEAM(1);
    }
    for (int l = 0; l < DEPTH; ++l) {
        const int pb = 2 + PPL * l;
        const bool with_ctx = l < DEPTH - 1;
#define hin_lat (l == 0 ? x_in : (const float*)out)
#define hin_ctx (l == 0 ? ctx_in : (const float*)HCTX)
#define mod (MOD + (size_t)l * 3 * 12288)
        const int nrows = with_ctx ? MROWS : NLAT;
        if (IN(pb + 0)) {
            phase_xn(hin_lat, hin_ctx, mod, XN, OPQ_S(gw), NGW, OPQ_V(lane));
            SEAM(pb + 0);
        }
        if (IN(pb + 1)) {
            constexpr int C0 = C_SPLIT, NA_ = NIN - C0;
            pg8::Gemm g{XN, WINT + (size_t)l * NIN * DM + (size_t)C0 * DM, MROWS, NA_, DM}; pg8::StaticOrder S; S.init(MROWS, NA_, G, bx);
            pg8::EpiStoreBf16 E{P + C0, NIN};
            pg8::gemm_phase<pg8::EpiStoreBf16, pg8::StaticOrder, true, true>(lds, g, S, E);
            SEAM(pb + 1);
        }
        if (IN(pb + 2)) {
            if (bx >= RWP_BLOCKS) {
                constexpr int NB_ = C_SPLIT;
                pg8::Gemm g{XN, WINT + (size_t)l * NIN * DM, MROWS, NB_, DM}; pg8::StaticOrder S; S.init(MROWS, NB_, G - RWP_BLOCKS, bx - RWP_BLOCKS);
                pg8::EpiStoreBf16 E{P, NIN};
                pg8::gemm_phase<pg8::EpiStoreBf16, pg8::StaticOrder, true, true>(lds, g, S, E);
            }
            phase_rwprep(P, rw_mu_rkv + (size_t)l * 6144, rw_mu_lora + (size_t)l * 256, rw_w0 + (size_t)l * 2048, WUPT + (size_t)l * 131072, rw_a0 + (size_t)l * 2048, AUPT + (size_t)l * 131072,
                         rw_k_k + (size_t)l * 1024, rw_k_a + (size_t)l * 1024, rw_r_k + (size_t)l * 1024, REC, BON, lds, WSP(unsigned, WS_CTL) + CW_RWQ + l * 1024, (bx * NWAVES + wave) & 15, wave, OPQ_V(lane));
            phase_rowprep(P, na_qg + l * 64, na_kg + l * 64, TAB, QN, KN, SGST, OPQ_S(gw), NGW, OPQ_V(lane));
            phase_vt(P, VTL, VTC, OPQ_S(gw), NGW, OPQ_V(lane));
            SEAM(pb + 2);
        }
        if (IN(pb + 3)) {
            {
            LAS unsigned* mixq = (LAS unsigned*)(lds + LDSCTL_OFF + 64); LAS unsigned* mixb = (LAS unsigned*)(lds + LDSCTL_OFF + 128); LAS unsigned* mixs = (LAS unsigned*)(lds + LDSCTL_OFF + 192);
            if (tid == 0) { *mixq = 0u; *mixb = 0u; *mixs = 0u; }
            __syncthreads();
            if (wave < 4) scan_self(REC, YR, lds, mixb, bx, wave, OPQ_V(lane));
            else phase_sgu4(P, SGST, sg_ln_w + (size_t)l * 1024, sg_ln_b + (size_t)l * 1024, SGW + (size_t)l * 131072, sg_b + (size_t)l * 1024, Y, lds + 3 * 28672, mixs, nrows / 128, OPQ_V(tid) - 256, wave - 4, OPQ_V(lane));
            {   const int nctxu = with_ctx ? 2 : 0, npool = (nrows / 16) * 4, npq = (npool + NGRID - 1) / NGRID, nwc = l + 1 < DEPTH ? (WC_ITEMS + NGRID - 1) / NGRID : 0, nmd = l + 1 < DEPTH ? (64 * 48) / NGRID : 0, nq = 64 + nctxu + npq + nwc + nmd;
                for (;;) {
                    unsigned k = 0; if (lane == 0) k = __hip_atomic_fetch_add(mixq, 1u, __ATOMIC_RELAXED, __HIP_MEMORY_SCOPE_WORKGROUP);
                    k = (unsigned)__builtin_amdgcn_readfirstlane((int)k);
                    if ((int)k >= nq) break;
                    const int ln = OPQ_V(lane);
                    if (k < 64u) { na_unit<false>(QN, KN, VTL, VTC, P, na_rpb + (size_t)l * 16 * 15 * 31, Y, vcu * 64 + (int)k, ln);
                    }
                    else if ((int)k < 64 + nctxu) na_unit<true>(QN, KN, VTL, VTC, P, na_rpb, Y, bx * 2 + ((int)k - 64), ln);
                    else if ((int)k >= 64 + nctxu + npq + nwc) mod_item_nolds(w_mod + (size_t)(l + 1) * 4096 * 12288, SILUC, MODP + (size_t)(l + 1) * 64 * 3 * 12288, bx + NGRID * ((int)k - 64 - nctxu - npq - nwc), ln);
                    else if ((int)k >= 64 + nctxu + npq) { const int r = bx + NGRID * ((int)k - 64 - nctxu - npq);
                        if (r < WC_ITEMS) weight_copy_item(l + 1, r, w_in, w_out, pool_w, rw_w_up, rw_a_up, sg_w, WINT, WOUTT, POOLWT, WUPT, AUPT, SGW, ln); }
                    else { const int u = bx + NGRID * ((int)k - 64 - nctxu);
                        if (u < npool) { const int tt = u >> 2, g = u & 3; const bf16* wbase = POOLWT + (size_t)l * 262144 + (size_t)g * 65536; const float* psc = pool_scale + (size_t)l * 1024;
                            if (g == 0) pool_unit<0>(P, wbase, psc, Y, tt * 16, ln); else if (g == 1) pool_unit<1>(P, wbase, psc, Y, tt * 16, ln);
                            else if (g == 2) pool_unit<2>(P, wbase, psc, Y, tt * 16, ln); else pool_unit<3>(P, wbase, psc, Y, tt * 16, ln); } }
                }
            }
            }
            SEAM(pb + 3);
        }
        if (IN(pb + 4)) {
            if (l + 1 < DEPTH) for (int idx = gw * 64 + lane; idx < 3 * 12288; idx += NGW * 64) {
                const int c = idx / 12288, n = idx % 12288; float s = b_mod[(l + 1) * 12288 + n];
                const float* pp = MODP + ((size_t)((l + 1) * 64) * 3 + c) * 12288 + n;
#pragma unroll 8
                for (int kc = 0; kc < 64; ++kc) s += pp[(size_t)kc * 3 * 12288];
                MOD[(size_t)(l + 1) * 3 * 12288 + idx] = s; }
            phase_rwfin(P, YR, REC, BON, rw_ln_w + (size_t)l * 1024, rw_ln_b + (size_t)l * 1024, Y, nrows, OPQ_S(gw), NGW, OPQ_V(lane));
            SEAM(pb + 4);
        }
        if (IN(pb + 5)) {
            pg8::Gemm g{Y, WOUTT + (size_t)l * DM * DM, nrows, DM, DM}; pg8::StaticOrder S; S.init(nrows, DM, G, bx);
            pg8::EpiResGate E{hin_lat, hin_ctx, out, HCTX, mod};
            pg8::gemm_phase<pg8::EpiResGate, pg8::StaticOrder, true, true>(lds, g, S, E);
            SEAM(pb + 5);
        }
    }
#undef IN
#undef SEAM
}
#undef hin_lat
#undef hin_ctx
#undef mod
#undef P
#undef Y
#undef XN
#undef out

extern "C" void kernel_launch(void* const* d_in, const int* in_sizes, int n_in, void* d_out, int out_size, void* d_ws, size_t ws_size, hipStream_t stream) {
    static int grid = 0;
    if (grid == 0) {
        if (n_in != 28 || out_size != NLAT * DM || ws_size < WS_END) { fprintf(stderr, "kernel_launch: unexpected shapes (n_in %d, out %d, ws %zu < %zu); nothing launched\n", n_in, out_size, ws_size, (size_t)WS_END); grid = -1; return; }
        int dev = 0, cus = 0, per_cu = 0;
        if (hipGetDevice(&dev) != hipSuccess || hipDeviceGetAttribute(&cus, hipDeviceAttributeMultiprocessorCount, dev) != hipSuccess) { grid = -1; return; }
        if (hipFuncSetAttribute((const void*)fwd, hipFuncAttributeMaxDynamicSharedMemorySize, LDS_BYTES) != hipSuccess) { fprintf(stderr, "kernel_launch: hipFuncSetAttribute failed\n"); grid = -1; return; }
        if (hipOccupancyMaxActiveBlocksPerMultiprocessor(&per_cu, (const void*)fwd, NWAVES * 64, LDS_BYTES) != hipSuccess || per_cu < 1)
            fprintf(stderr, "kernel_launch: note: occupancy query reports %d workgroups per CU\n", per_cu);
        (void)hipGetLastError();
        grid = cus >= NGRID ? NGRID : -2;
    }
    if (grid == -1) return;
    if (hipMemsetAsync((char*)d_ws + WS_CTL, 0, CTL_ZERO_BYTES, stream) != hipSuccess) { fprintf(stderr, "kernel_launch: memset failed\n"); return; }
    Args a{};
    for (int i = 0; i < 28; ++i) a.in[i] = (const float*)d_in[i];
    a.out = (float*)d_out; a.ws = (unsigned char*)d_ws; a.li = 0; a.pad = 0;
    const bool split = MK_SPLIT || grid == -2;
    if (split) { for (int k = 0; k < NPHASE; ++k) { a.ph_lo = k; a.ph_hi = k + 1; hipLaunchKernelGGL(fwd, dim3(NGRID), dim3(NWAVES * 64), LDS_BYTES, stream, a); } }
    else { a.ph_lo = 0; a.ph_hi = NPHASE; hipLaunchKernelGGL(fwd, dim3(NGRID), dim3(NWAVES * 64), LDS_BYTES, stream, a); }
    const hipError_t le = hipPeekAtLastError();
    if (le != hipSuccess) fprintf(stderr, "kernel_launch: launch failed: %s\n", hipGetErrorName(le));
}
```

```cpp
#include <hip/hip_runtime.h>
#include <cstdio>
#include <cstdint>
#define MK_SPLIT 0
namespace pg8 {
#define PG8_LAS __attribute__((address_space(3)))
typedef unsigned short bf16_t;
typedef short bf16x8 __attribute__((ext_vector_type(8)));
typedef float f32x4 __attribute__((ext_vector_type(4)));
typedef unsigned u32x4 __attribute__((ext_vector_type(4)));
constexpr int BM = 256, BK = 64, HALF = 128, HTB = HALF * BK * 2  , STAGE_BYTES = 8 * HTB, NXCD = 8, WGM = 8;

__host__ __device__ __forceinline__ int lds_byte(int r, int c) { const int st = (r >> 4) * 2 + (c >> 5), rr = r & 15, cc = c & 31, ob = rr * 64 + cc * 2; return st * 1024 + (ob ^ (((ob >> 9) & 1) << 5)); }
__host__ __device__ __forceinline__ void stage_rc(int b, int& R, int& C) { const int st = b / 1024, sb = b % 1024, swz = sb ^ (((sb >> 9) & 1) << 5); R = (st >> 1) * 16 + swz / 64; C = (st & 1) * 32 + (swz % 64) / 2; }
__host__ __device__ __forceinline__ int perm32(int rho) { const int n = rho >> 4, i = rho & 15; return 8 * (i >> 2) + 4 * n + (i & 3); }

struct Unit { int pm, pn; };
struct Gemm { const bf16_t* A; const bf16_t* Bt; int M, N, K; };

struct StaticOrder {
    int nM, nN, nwg, G, c;
    __host__ __device__ void init(int M, int N, int G_, int c_) { nM = M / BM; nN = N / BM; nwg = nM * nN; G = G_; c = c_; }
    __host__ __device__ bool next(int i, Unit& u) const {
        const long L = (long)i * G + c; if (L >= nwg) return false;
        int wgid = (int)L; { const int q = nwg / NXCD, r = nwg % NXCD, xcd = wgid % NXCD, off = wgid / NXCD; wgid = (xcd < r ? xcd * (q + 1) : r * (q + 1) + (xcd - r) * q) + off; }
        const int nig = WGM * nN, gid = wgid / nig, fm = gid * WGM, gsz = (nM - fm) < WGM ? (nM - fm) : WGM;
        u.pm = fm + ((wgid % nig) % gsz); u.pn = (wgid % nig) / gsz; return true;
    }
    __device__ __forceinline__ void a_ready(const Unit&) const {}
    __device__ __forceinline__ void done(const Unit&) const {}
};

__device__ __forceinline__ unsigned cvt_pk_bf16(float lo, float hi) { unsigned r; asm volatile("v_cvt_pk_bf16_f32 %0, %1, %2" : "=v"(r) : "v"(lo), "v"(hi)); return r; }
template <class Epi, class Sched, bool ALIGN_EPI = false, bool SP2 = false>
__device__ __forceinline__ void gemm_phase(PG8_LAS unsigned char* lds, const Gemm g, const Sched& S, const Epi& E) {
    int tid_ = threadIdx.x; asm volatile("" : "+v"(tid_));
    const int tid = tid_, wid = __builtin_amdgcn_readfirstlane(tid >> 6), lane = tid & 63, wr = wid >> 2, wc = wid & 3, fr = lane & 15, fq = lane >> 4;
    const int K = g.K, nt = K / BK;
    unsigned voffA[2], voffB[2];
#pragma unroll
    for (int i = 0; i < 2; ++i) { int R, C; stage_rc(tid * 16 + i * 8192, R, C); const int Rb = Epi::PERM ? ((R & ~31) + perm32(R & 31)) : R;
        voffA[i] = (unsigned)(R * K + C) * 2u; voffB[i] = (unsigned)(Rb * K + C) * 2u; }
    const size_t kstep = (size_t)(BK * 2);
    const size_t hstep = (size_t)HALF * K * 2;
    const size_t tstep = 2 * hstep;
    const unsigned ldsw = (unsigned)wid * 1024u;
    const int aoff = lds_byte(wr * 64 + fr, fq * 8), boff = lds_byte(wc * 32 + fr, fq * 8);
#define PG8_SA(b, h) (((b) * 2 + (h)) * HTB)
#define PG8_SB(b, h) ((4 + (b) * 2 + (h)) * HTB)
#define PG8_STAGE(bufoff, gbase, voff) do { _Pragma("unroll") for (int _i = 0; _i < 2; ++_i) \
        __builtin_amdgcn_global_load_lds((const unsigned*)((const char*)(gbase) + (voff)[_i]), (PG8_LAS unsigned*)(lds + (bufoff) + ldsw + _i * 8192), 16, 0, 0); } while (0)
#define PG8_LDA(dst, b, h) do { _Pragma("unroll") for (int m = 0; m < 4; ++m) _Pragma("unroll") for (int k = 0; k < 2; ++k) dst[m][k] = *(const PG8_LAS bf16x8*)(lds + PG8_SA(b, h) + aoff + m * 2048 + k * 1024); } while (0)
#define PG8_LDB(dst, b, h) do { _Pragma("unroll") for (int n = 0; n < 2; ++n) _Pragma("unroll") for (int k = 0; k < 2; ++k) dst[n][k] = *(const PG8_LAS bf16x8*)(lds + PG8_SB(b, h) + boff + n * 2048 + k * 1024); } while (0)
#define PG8_MMA(ai, bj, At, Bt) do { __builtin_amdgcn_s_setprio(1); _Pragma("unroll") for (int m = 0; m < 4; ++m) _Pragma("unroll") for (int n = 0; n < 2; ++n) _Pragma("unroll") for (int k = 0; k < 2; ++k) \
        acc[ai][bj][m][n] = __builtin_amdgcn_mfma_f32_16x16x32_bf16(Bt[n][k], At[m][k], acc[ai][bj][m][n], 0, 0, 0); __builtin_amdgcn_s_setprio(0); } while (0)
#define PG8_WAIT_V(n) asm volatile("s_waitcnt vmcnt(" #n ")" ::: "memory")
#define PG8_WAIT_L(n) asm volatile("s_waitcnt lgkmcnt(" #n ")" ::: "memory")
#define PG8_BAR __builtin_amdgcn_s_barrier()
#define PG8_SCHED __builtin_amdgcn_sched_barrier(0)
    Unit cur, nxt; int ui = 0;
    if (!S.next(0, cur)) return;
    f32x4 acc[2][2][4][2];
#pragma unroll
    for (int a = 0; a < 2; ++a)
#pragma unroll
        for (int b = 0; b < 2; ++b)
#pragma unroll
            for (int m = 0; m < 4; ++m)
#pragma unroll
                for (int n = 0; n < 2; ++n) acc[a][b][m][n] = (f32x4){0.f, 0.f, 0.f, 0.f};
    bf16x8 At[4][2], B0[2][2], B1[2][2];
    const char* cA = (const char*)g.A + (size_t)cur.pm * tstep; const char* cB = (const char*)g.Bt + (size_t)cur.pn * tstep;
    S.a_ready(cur);
    if constexpr (SP2) {
        PG8_STAGE(PG8_SB(0, 0), cB, voffB); PG8_STAGE(PG8_SB(0, 1), cB + hstep, voffB); PG8_STAGE(PG8_SA(0, 0), cA, voffA); PG8_STAGE(PG8_SA(0, 1), cA + hstep, voffA);
        if (wr == 1) PG8_BAR;
        PG8_WAIT_V(2); PG8_BAR;
        PG8_STAGE(PG8_SB(1, 0), cB + kstep, voffB); PG8_STAGE(PG8_SA(1, 0), cA + kstep, voffA); PG8_STAGE(PG8_SB(1, 1), cB + hstep + kstep, voffB);
        PG8_WAIT_V(6); PG8_BAR;
    } else {
        PG8_STAGE(PG8_SB(0, 0), cB, voffB); PG8_STAGE(PG8_SA(0, 0), cA, voffA); PG8_STAGE(PG8_SB(0, 1), cB + hstep, voffB); PG8_STAGE(PG8_SA(0, 1), cA + hstep, voffA);
        if (wr == 1) PG8_BAR;
        PG8_WAIT_V(4); PG8_BAR;
        PG8_STAGE(PG8_SB(1, 0), cB + kstep, voffB); PG8_STAGE(PG8_SA(1, 0), cA + kstep, voffA); PG8_STAGE(PG8_SB(1, 1), cB + hstep + kstep, voffB);
        PG8_WAIT_V(6); PG8_BAR;
    }
    for (;;) {
        const bool has_next = S.next(ui + 1, nxt);
        const char* nA = has_next ? (const char*)g.A + (size_t)nxt.pm * tstep : cA; const char* nB = has_next ? (const char*)g.Bt + (size_t)nxt.pn * tstep : cB;
        for (int t = 0; t < nt; t += 2) {
            const bool last = (t == nt - 2);
            const char* a1 = cA + (size_t)(t + 1) * kstep;
            const char* a2 = last ? nA : cA + (size_t)(t + 2) * kstep; const char* b2 = last ? nB : cB + (size_t)(t + 2) * kstep;
            const char* a3 = a2 + kstep; const char* b3 = b2 + kstep;
            if (last && has_next) S.a_ready(nxt);
            if constexpr (SP2) {
            PG8_LDB(B0, 0, 0); PG8_LDB(B1, 0, 1); PG8_SCHED; PG8_LDA(At, 0, 0); PG8_STAGE(PG8_SA(1, 1), a1 + hstep, voffA);
            PG8_WAIT_V(8); PG8_WAIT_L(0); PG8_BAR; PG8_MMA(0, 0, At, B0); PG8_MMA(0, 1, At, B1); PG8_BAR; PG8_SCHED;
            PG8_LDA(At, 0, 1); PG8_STAGE(PG8_SB(0, 0), b2, voffB); PG8_STAGE(PG8_SB(0, 1), b2 + hstep, voffB); PG8_STAGE(PG8_SA(0, 0), a2, voffA);
            PG8_WAIT_V(8); PG8_WAIT_L(0); PG8_BAR; PG8_MMA(1, 0, At, B0); PG8_MMA(1, 1, At, B1); PG8_BAR; PG8_SCHED;
            PG8_LDB(B0, 1, 0); PG8_LDB(B1, 1, 1); PG8_SCHED; PG8_LDA(At, 1, 0); PG8_STAGE(PG8_SA(0, 1), a2 + hstep, voffA);
            PG8_WAIT_V(8); PG8_WAIT_L(0); PG8_BAR; PG8_MMA(0, 0, At, B0); PG8_MMA(0, 1, At, B1); PG8_BAR; PG8_SCHED;
            PG8_LDA(At, 1, 1); PG8_STAGE(PG8_SB(1, 0), b3, voffB); PG8_STAGE(PG8_SB(1, 1), b3 + hstep, voffB); PG8_STAGE(PG8_SA(1, 0), a3, voffA);
            PG8_WAIT_V(8); PG8_WAIT_L(0); PG8_BAR; PG8_MMA(1, 0, At, B0); PG8_MMA(1, 1, At, B1); PG8_BAR; PG8_SCHED;
            } else {
            PG8_LDB(B0, 0, 0); PG8_SCHED; PG8_LDA(At, 0, 0); PG8_STAGE(PG8_SA(1, 1), a1 + hstep, voffA);
            PG8_WAIT_L(8); PG8_BAR; PG8_WAIT_L(0); PG8_MMA(0, 0, At, B0); PG8_BAR; PG8_SCHED;
            PG8_LDB(B1, 0, 1); PG8_STAGE(PG8_SB(0, 0), b2, voffB);
            PG8_BAR; PG8_WAIT_L(0); PG8_MMA(0, 1, At, B1); PG8_BAR;
            PG8_LDA(At, 0, 1); PG8_STAGE(PG8_SA(0, 0), a2, voffA);
            PG8_BAR; PG8_WAIT_L(0); PG8_MMA(1, 0, At, B0); PG8_BAR; PG8_SCHED;
            PG8_STAGE(PG8_SB(0, 1), b2 + hstep, voffB);
            PG8_WAIT_V(6); PG8_BAR; PG8_MMA(1, 1, At, B1); PG8_BAR;
            PG8_LDB(B0, 1, 0); PG8_SCHED; PG8_LDA(At, 1, 0); PG8_STAGE(PG8_SA(0, 1), a2 + hstep, voffA);
            PG8_WAIT_L(8); PG8_BAR; PG8_WAIT_L(0); PG8_MMA(0, 0, At, B0); PG8_BAR; PG8_SCHED;
            PG8_LDB(B1, 1, 1); PG8_STAGE(PG8_SB(1, 0), b3, voffB);
            PG8_BAR; PG8_WAIT_L(0); PG8_MMA(0, 1, At, B1); PG8_BAR;
            PG8_LDA(At, 1, 1); PG8_STAGE(PG8_SA(1, 0), a3, voffA);
            PG8_BAR; PG8_WAIT_L(0); PG8_MMA(1, 0, At, B0); PG8_BAR; PG8_SCHED;
            PG8_STAGE(PG8_SB(1, 1), b3 + hstep, voffB);
            PG8_WAIT_V(6); PG8_BAR; PG8_MMA(1, 1, At, B1); PG8_BAR;
            }
        }
        if constexpr (ALIGN_EPI) { if (wr == 0) PG8_BAR; }
        if constexpr (!Epi::AFTER_DRAIN) { E(acc, cur, wr, wc, fr, fq); S.done(cur); }
        if (!has_next) break;
#pragma unroll
        for (int a = 0; a < 2; ++a)
#pragma unroll
            for (int b = 0; b < 2; ++b)
#pragma unroll
                for (int m = 0; m < 4; ++m)
#pragma unroll
                    for (int n = 0; n < 2; ++n) acc[a][b][m][n] = (f32x4){0.f, 0.f, 0.f, 0.f};
        cur = nxt; cA = nA; cB = nB; ++ui;
        if constexpr (ALIGN_EPI) { if (wr == 1) PG8_BAR; }
    }
    PG8_WAIT_V(0);
    if constexpr (!ALIGN_EPI) { if (wr == 0) PG8_BAR; }
    PG8_BAR;
    if constexpr (Epi::AFTER_DRAIN) { E.fused(acc, cur, wr, wc, fr, fq, lds, wid, lane); S.done(cur); }
#undef PG8_SA
#undef PG8_SB
#undef PG8_STAGE
#undef PG8_LDA
#undef PG8_LDB
#undef PG8_MMA
#undef PG8_WAIT_V
#undef PG8_WAIT_L
#undef PG8_BAR
#undef PG8_SCHED
}
}

constexpr int DM = 4096, NBATCH = 2, SEQ = 8192, DEPTH = 4, CTXL = 256;
constexpr int NLAT = NBATCH * SEQ, NCTX = NBATCH * CTXL, MROWS = NLAT + NCTX;
constexpr int NIN = 13568, GWD = 1024;
constexpr int C_POOLV = 0, C_POOLZ = 1024, C_NAZ = 2048, C_RWZ = 3072, C_SGU = 4096, C_SGZ = 5120, C_NAQ = 6144, C_NAK = 7168, C_NAV = 8192, C_RWR = 9216, C_RWK = 10240, C_RWV = 11264,
              C_RWWD = 12288, C_RWAD = 12416, C_SGV = 12544;
constexpr int C_SPLIT = 5632;
__host__ __device__ __forceinline__ int phys_tile(int lt) {
    return lt < 8 ? lt : lt < 20 ? lt + 16 : lt < 24 ? lt - 12 : lt < 36 ? lt + 12 : lt < 40 ? lt - 24 : lt == 40 ? 48 : lt < 45 ? lt - 25 : lt < 49 ? lt + 4 : lt - 29;
}
constexpr int SCANLEN = CTXL + SEQ;
constexpr int NCHAIN = 64;
constexpr int RECB = 896;
constexpr int RECF = RECB / 4;
constexpr int NWAVES = 8;

constexpr size_t MiB = 1u << 20;
constexpr size_t WS_CTL = 0, CTL_ZERO_BYTES = 1 * MiB;
constexpr size_t WS_MOD   = 2 * MiB;
constexpr size_t WS_TAB   = 3 * MiB;
constexpr size_t WS_SILUC = 3 * MiB + 512 * 1024;
constexpr size_t WS_SGST  = 4 * MiB;
constexpr size_t WS_BON   = 5 * MiB;
constexpr size_t WS_POOLWT= 8 * MiB;
constexpr size_t WS_WUPT  = 10 * MiB;
constexpr size_t WS_AUPT  = 11 * MiB;
constexpr size_t WS_SGW   = 12 * MiB;
constexpr size_t WS_VTC   = 13 * MiB;
constexpr size_t WS_HCTX  = 14 * MiB;
constexpr size_t WS_MODP  = 22 * MiB;
constexpr size_t WS_VTL   = 58 * MiB;
constexpr size_t WS_QN    = 90 * MiB;
constexpr size_t WS_KN    = 123 * MiB;
constexpr size_t WS_WOUTT = 156 * MiB;
constexpr size_t WS_WINT  = 284 * MiB;
constexpr size_t WS_XN    = 708 * MiB;
constexpr size_t WS_Y     = 840 * MiB;
constexpr size_t WS_P     = 972 * MiB;
constexpr size_t WS_YR    = 1410 * MiB;
constexpr size_t WS_REC   = 1542 * MiB;
constexpr size_t WS_END   = 2334 * MiB;
static_assert(WS_P + (size_t)MROWS * NIN * 2 <= WS_YR && WS_REC + (size_t)NCHAIN * SCANLEN * RECB <= WS_END && WS_WINT + (size_t)4 * NIN * DM * 2 <= WS_XN, "ws map");
constexpr int CW_TMO = 0, CW_BAR = 4096;

constexpr int RING_BYTES = 131072, SCANRING_BYTES = 4 * 32 * 896, SGUT_OFF = SCANRING_BYTES, LDSCTL_OFF = SGUT_OFF + 128 * 136 * 2, MISC_OFF = LDSCTL_OFF + 320, LDS_BYTES = LDSCTL_OFF + 1024;

#define GAS __attribute__((address_space(1)))
#define LAS __attribute__((address_space(3)))
typedef unsigned short bf16;
typedef unsigned v4u __attribute__((ext_vector_type(4)));
typedef unsigned v2u __attribute__((ext_vector_type(2)));
typedef float f32x4 __attribute__((ext_vector_type(4)));
typedef float f32x2 __attribute__((ext_vector_type(2)));
typedef short bf16x8 __attribute__((ext_vector_type(8)));
typedef _Float16 h4 __attribute__((ext_vector_type(4)));
typedef _Float16 h8 __attribute__((ext_vector_type(8)));
#define RLX_AGENT __ATOMIC_RELAXED, __HIP_MEMORY_SCOPE_AGENT
#define LDS_WAIT() asm volatile("s_waitcnt lgkmcnt(0)" ::: "memory")

__device__ __forceinline__ float bf2f(unsigned short h) { return __uint_as_float(((unsigned)h) << 16); }
__device__ __forceinline__ float bflo(unsigned w) { return __uint_as_float(w << 16); }
__device__ __forceinline__ float bfhi(unsigned w) { return __uint_as_float(w & 0xffff0000u); }
typedef __bf16 bf16x2_t __attribute__((ext_vector_type(2)));
__device__ __forceinline__ unsigned pk2(float lo, float hi) { const f32x2 v = {lo, hi}; const bf16x2_t b = __builtin_convertvector(v, bf16x2_t); return __builtin_bit_cast(unsigned, b); }
__device__ __forceinline__ unsigned f2bf(float f) { return pk2(f, 0.f) & 0xffffu; }
__device__ __forceinline__ float rcp_f(float x) { return __builtin_amdgcn_rcpf(x); }
__device__ __forceinline__ float rsq_f(float x) { return __builtin_amdgcn_rsqf(x); }
__device__ __forceinline__ void unpack8(const v4u w, float* x) { x[0] = bflo(w.x); x[1] = bfhi(w.x); x[2] = bflo(w.y); x[3] = bfhi(w.y); x[4] = bflo(w.z); x[5] = bfhi(w.z); x[6] = bflo(w.w); x[7] = bfhi(w.w); }
__device__ __forceinline__ v4u pack8(const float* x) { v4u w; w.x = pk2(x[0], x[1]); w.y = pk2(x[2], x[3]); w.z = pk2(x[4], x[5]); w.w = pk2(x[6], x[7]); return w; }
__device__ __forceinline__ float silu_f(float x) { return x * rcp_f(1.f + __expf(-x)); }
__device__ __forceinline__ float wave_sum(float v) {
#pragma unroll
    for (int o = 1; o < 64; o <<= 1) v += __shfl_xor(v, o);
    return v;
}
template <int CTRL> __device__ __forceinline__ float dppf(float v) { return __builtin_bit_cast(float, __builtin_amdgcn_update_dpp(0, __builtin_bit_cast(int, v), CTRL, 0xF, 0xF, true)); }
__device__ __forceinline__ float red16(float v) { v += dppf<0xB1>(v); v += dppf<0x4E>(v); v += dppf<0x141>(v); v += dppf<0x140>(v); return v; }
__device__ __forceinline__ void red16x2(float& a, float& b) {
    a += dppf<0xB1>(a); b += dppf<0xB1>(b); a += dppf<0x4E>(a); b += dppf<0x4E>(b); a += dppf<0x141>(a); b += dppf<0x141>(b); a += dppf<0x140>(a); b += dppf<0x140>(b); }
__device__ __forceinline__ float red16_transpose(const float (&y)[16], int c16) {
    float a[8], b[4], c[2];
    const bool h8 = (c16 & 8) != 0, h4 = (c16 & 4) != 0, h2 = (c16 & 2) != 0, h1 = (c16 & 1) != 0;
#pragma unroll
    for (int j = 0; j < 8; ++j) { const float keep = h8 ? y[j + 8] : y[j], send = h8 ? y[j] : y[j + 8]; a[j] = keep + dppf<0x140>(send); }
#pragma unroll
    for (int j = 0; j < 4; ++j) { const float keep = h4 ? a[j + 4] : a[j], send = h4 ? a[j] : a[j + 4]; b[j] = keep + dppf<0x141>(send); }
#pragma unroll
    for (int j = 0; j < 2; ++j) { const float keep = h2 ? b[j + 2] : b[j], send = h2 ? b[j] : b[j + 2]; c[j] = keep + dppf<0x1B>(send); }
    const float keep = h1 ? c[1] : c[0], send = h1 ? c[0] : c[1];
    return keep + dppf<0xB1>(send);
}
__device__ __forceinline__ float max16x4(float v) { v = fmaxf(v, __shfl_xor(v, 16)); v = fmaxf(v, __shfl_xor(v, 32)); return v; }
__device__ __forceinline__ float sum16x4(float v) { v += __shfl_xor(v, 16); v += __shfl_xor(v, 32); return v; }
__device__ __forceinline__ int scan_pos(int d, bool isctx, int t) { return d == 0 ? (isctx ? t : CTXL + t) : (isctx ? (CTXL - 1 - t) : (CTXL + SEQ - 1 - t)); }
__device__ __forceinline__ f32x4 mfma16(bf16x8 a, bf16x8 b, f32x4 c) { return __builtin_amdgcn_mfma_f32_16x16x32_bf16(a, b, c, 0, 0, 0); }
__device__ __forceinline__ bf16x8 ld_frag(const bf16* p) { return __builtin_bit_cast(bf16x8, *(const v4u*)p); }

namespace pg8 {
struct EpiStoreBf16 {
    static constexpr bool PERM = true, AFTER_DRAIN = false;
    bf16_t* O; int ldc;
    __device__ __forceinline__ void operator()(const f32x4 (&acc)[2][2][4][2], const Unit& u, int wr, int wc, int fr, int fq) const {
        const int row0 = u.pm * BM + wr * 64 + fr, col0 = u.pn * BM + wc * 32 + 8 * fq;
#pragma unroll
        for (int ai = 0; ai < 2; ++ai)
#pragma unroll
            for (int m = 0; m < 4; ++m) { bf16_t* rowp = O + (size_t)(row0 + ai * HALF + m * 16) * ldc + col0;
#pragma unroll
                for (int bj = 0; bj < 2; ++bj) { const f32x4 v0 = acc[ai][bj][m][0], v1 = acc[ai][bj][m][1];
                    u32x4 w; w.x = cvt_pk_bf16(v0[0], v0[1]); w.y = cvt_pk_bf16(v0[2], v0[3]); w.z = cvt_pk_bf16(v1[0], v1[1]); w.w = cvt_pk_bf16(v1[2], v1[3]);
                    *(u32x4*)(rowp + bj * HALF) = w; } }
    }
};
struct EpiResGate {
    static constexpr bool PERM = false, AFTER_DRAIN = false;
    const float* hin_lat; const float* hin_ctx; float* hout_lat; float* hout_ctx; const float* gate;
    __device__ __forceinline__ void operator()(const f32x4 (&acc)[2][2][4][2], const Unit& u, int wr, int wc, int fr, int fq) const {
        const int cond = u.pm < 32 ? 0 : (u.pm < 64 ? 1 : 2);
        const int rloc = (u.pm < 64 ? u.pm * BM : (u.pm - 64) * BM) + wr * 64 + fr, col0 = u.pn * BM + wc * 32 + 4 * fq;
        const float* hin = u.pm < 64 ? hin_lat : hin_ctx; float* hout = u.pm < 64 ? hout_lat : hout_ctx;
        f32x4 gv[2][2];
#pragma unroll
        for (int bj = 0; bj < 2; ++bj)
#pragma unroll
            for (int n = 0; n < 2; ++n) gv[bj][n] = *(const f32x4*)(gate + cond * 12288 + 8192 + col0 + bj * HALF + n * 16);
#pragma unroll
        for (int ai = 0; ai < 2; ++ai)
#pragma unroll
            for (int m = 0; m < 4; ++m) { const size_t off = (size_t)(rloc + ai * HALF + m * 16) * 4096 + col0;
#pragma unroll
                for (int bj = 0; bj < 2; ++bj)
#pragma unroll
                    for (int n = 0; n < 2; ++n) { const f32x4 b = *(const f32x4*)(hin + off + bj * HALF + n * 16);
                        *(f32x4*)(hout + off + bj * HALF + n * 16) = b + gv[bj][n] * acc[ai][bj][m][n]; } }
    }
};
}

template <bool PERMC = false>
__device__ __forceinline__ void p0_transpose_item(const float* W, int K, int N, bf16* WT, LAS float* scr, int item, int lane) {
    const int nblk = N / 32, kb = item / nblk, nb = item % nblk, k0 = 64 * kb, n0 = 32 * nb;
    const int pn0 = PERMC ? phys_tile(n0 >> 8) * 256 + (n0 & 255) : n0;
#pragma unroll 8
    for (int i = 0; i < 32; ++i) { const int kk = 2 * i + (lane >> 5); scr[kk * 33 + (lane & 31)] = W[(size_t)(k0 + kk) * N + n0 + (lane & 31)]; }
    LDS_WAIT(); asm volatile("" ::: "memory");
    const int c = lane & 7;
#pragma unroll
    for (int j = 0; j < 4; ++j) { const int n = (lane >> 3) + 8 * j; const LAS float* s = scr + (8 * c) * 33 + n;
        v4u o; o.x = pk2(s[0 * 33], s[1 * 33]); o.y = pk2(s[2 * 33], s[3 * 33]); o.z = pk2(s[4 * 33], s[5 * 33]); o.w = pk2(s[6 * 33], s[7 * 33]);
        *(v4u*)(WT + (size_t)(pn0 + n) * K + k0 + 8 * c) = o; }
    LDS_WAIT(); asm volatile("" ::: "memory");
}
template <bool PERMC = false>
__device__ __forceinline__ void transpose_item_nolds(const float* W, int K, int N, bf16* WT, int item, int lane) {
    const int nblk = N / 64, kb = item / nblk, nb = item % nblk, k0 = 64 * kb, n0 = 64 * nb;
    const int pn0 = PERMC ? phys_tile(n0 >> 8) * 256 + (n0 & 255) : n0;
    const float* src = W + (size_t)k0 * N + n0 + lane;
    bf16* dst = WT + (size_t)(pn0 + lane) * K + k0;
#pragma unroll
    for (int hb = 0; hb < 2; ++hb) {
        float v[32];
#pragma unroll
        for (int i = 0; i < 32; ++i) v[i] = __builtin_nontemporal_load(src + (size_t)(32 * hb + i) * N);
        __builtin_amdgcn_sched_barrier(0);
#pragma unroll
        for (int j = 0; j < 4; ++j) { v4u o; o.x = pk2(v[8 * j], v[8 * j + 1]); o.y = pk2(v[8 * j + 2], v[8 * j + 3]); o.z = pk2(v[8 * j + 4], v[8 * j + 5]); o.w = pk2(v[8 * j + 6], v[8 * j + 7]);
            *(v4u*)(dst + 32 * hb + 8 * j) = o; }
        __builtin_amdgcn_sched_barrier(0);
    }
}
constexpr int WC_WIN = (DM / 64) * (NIN / 64), WC_WOUT = (DM / 64) * (DM / 64), WC_POOL = 4 * 16, WC_WUP = 2 * 16, WC_AUP = 2 * 16, WC_SGW = 256, WC_ITEMS = WC_WIN + WC_WOUT + WC_POOL + WC_WUP + WC_AUP + WC_SGW;
__device__ __forceinline__ void weight_copy_item(int L, int r, const float* w_in, const float* w_out, const float* pool_w, const float* rw_w_up, const float* rw_a_up, const float* sg_w,
                                                 bf16* WINT, bf16* WOUTT, bf16* POOLWT, bf16* WUPT, bf16* AUPT, bf16* SGW, int lane) {
    if (r < WC_WIN) { transpose_item_nolds<true>(w_in + (size_t)L * DM * NIN, DM, NIN, WINT + (size_t)L * NIN * DM, r, lane); return; } r -= WC_WIN;
    if (r < WC_WOUT) { transpose_item_nolds(w_out + (size_t)L * DM * DM, DM, DM, WOUTT + (size_t)L * DM * DM, r, lane); return; } r -= WC_WOUT;
    if (r < WC_POOL) { const int g = r >> 4; transpose_item_nolds(pool_w + (size_t)(L * 4 + g) * 65536, 256, 256, POOLWT + (size_t)(L * 4 + g) * 65536, r & 15, lane); return; } r -= WC_POOL;
    if (r < WC_WUP) { const int dd = r >> 4; transpose_item_nolds(rw_w_up + (size_t)(L * 2 + dd) * 65536, 64, 1024, WUPT + (size_t)(L * 2 + dd) * 65536, r & 15, lane); return; } r -= WC_WUP;
    if (r < WC_AUP) { const int dd = r >> 4; transpose_item_nolds(rw_a_up + (size_t)(L * 2 + dd) * 65536, 64, 1024, AUPT + (size_t)(L * 2 + dd) * 65536, r & 15, lane); return; } r -= WC_AUP;
    {   const size_t e0 = (size_t)L * 131072 + (size_t)r * 512 + lane * 8; const f32x4 a = *(const f32x4*)(sg_w + e0), b = *(const f32x4*)(sg_w + e0 + 4);
        v4u o; o.x = pk2(a.x, a.y); o.y = pk2(a.z, a.w); o.z = pk2(b.x, b.y); o.w = pk2(b.z, b.w); *(v4u*)(SGW + e0) = o; }
}
__device__ __forceinline__ void p0_mod_item(const float* wmod, const float* cvec, const float* cctx, float* MODP, LAS float* scr, int item, int lane) {
    const int l = item / (64 * 48), r = item % (64 * 48), kc = r / 48, nc = r % 48, k0 = kc * 64, n0 = nc * 256 + lane * 4;
    scr[lane] = silu_f(cvec[k0 + lane]); scr[64 + lane] = silu_f(cvec[4096 + k0 + lane]); scr[128 + lane] = silu_f(cctx[k0 + lane]);
    LDS_WAIT(); asm volatile("" ::: "memory");
    f32x4 a0 = {0.f, 0.f, 0.f, 0.f}, a1 = a0, a2 = a0;
    const float* wp = wmod + ((size_t)l * 4096 + k0) * 12288 + n0;
#pragma unroll 16
    for (int k = 0; k < 64; ++k) { const f32x4 w = *(const f32x4*)(wp + (size_t)k * 12288); a0 += scr[k] * w; a1 += scr[64 + k] * w; a2 += scr[128 + k] * w; }
    float* o = MODP + ((size_t)(l * 64 + kc) * 3) * 12288 + n0;
    *(f32x4*)(o) = a0; *(f32x4*)(o + 12288) = a1; *(f32x4*)(o + 2 * 12288) = a2;
    LDS_WAIT(); asm volatile("" ::: "memory");
}
__device__ __forceinline__ void mod_item_nolds(const float* wmod_l  , const float* siluc, float* MODP_l  , int item, int lane) {
    const int kc = item / 48, nc = item % 48, k0 = kc * 64, n0 = nc * 256 + lane * 4;
    f32x4 a0 = {0.f, 0.f, 0.f, 0.f}, a1 = a0, a2 = a0;
    const float* wp = wmod_l + (size_t)k0 * 12288 + n0;
    const int s0v = __builtin_bit_cast(int, siluc[k0 + lane]), s1v = __builtin_bit_cast(int, siluc[4096 + k0 + lane]), s2v = __builtin_bit_cast(int, siluc[8192 + k0 + lane]);
#pragma unroll
    for (int k = 0; k < 64; ++k) { const f32x4 w = __builtin_nontemporal_load((const f32x4*)(wp + (size_t)k * 12288));
        a0 += __builtin_bit_cast(float, __builtin_amdgcn_readlane(s0v, k)) * w; a1 += __builtin_bit_cast(float, __builtin_amdgcn_readlane(s1v, k)) * w; a2 += __builtin_bit_cast(float, __builtin_amdgcn_readlane(s2v, k)) * w; }
    float* o = MODP_l + ((size_t)kc * 3) * 12288 + n0;
    *(f32x4*)(o) = a0; *(f32x4*)(o + 12288) = a1; *(f32x4*)(o + 2 * 12288) = a2;
}
__device__ __forceinline__ void sincos_acc(float ang, float& c, float& s) {
    const double x = (double)ang; const double n = __builtin_rint(x * 0.63661977236758134308); const double r = x - n * 1.57079632679489661923;
    const double r2 = r * r;
    const double sp = r * (1.0 + r2 * (-1.0 / 6 + r2 * (1.0 / 120 + r2 * (-1.0 / 5040 + r2 * (1.0 / 362880 + r2 * (-1.0 / 39916800 + r2 * (1.0 / 6227020800.0)))))));
    const double cp = 1.0 + r2 * (-0.5 + r2 * (1.0 / 24 + r2 * (-1.0 / 720 + r2 * (1.0 / 40320 + r2 * (-1.0 / 3628800 + r2 * (1.0 / 479001600 + r2 * (-1.0 / 87178291200.0)))))));
    const int q = ((int)n) & 3;
    const double cc = (q == 0) ? cp : (q == 1) ? -sp : (q == 2) ? -cp : sp;
    const double ss = (q == 0) ? sp : (q == 1) ? cp : (q == 2) ? -sp : -cp;
    c = (float)cc; s = (float)ss;
}

__device__ __forceinline__ void phase_xn(const float* hlat, const float* hctx, const float* mod, bf16* XN, int gw, int NGW, int lane) {
    for (int m = gw; m < MROWS; m += NGW) {
        const float* src = m < NLAT ? hlat + (size_t)m * DM : hctx + (size_t)(m - NLAT) * DM;
        const int cond = m < NLAT ? (m >> 13) : 2;
        const f32x4* s4 = (const f32x4*)src + lane;
        f32x4 v[16]; float ss = 0.f;
#pragma unroll
        for (int j = 0; j < 16; ++j) { v[j] = __builtin_nontemporal_load(s4 + 64 * j); ss += (v[j].x * v[j].x + v[j].y * v[j].y) + (v[j].z * v[j].z + v[j].w * v[j].w); }
        ss = wave_sum(ss);
        const float rstd = rsq_f(ss * (1.f / 4096.f) + 1e-6f);
        const f32x4* sh4 = (const f32x4*)(mod + cond * 12288) + lane; const f32x4* sc4 = (const f32x4*)(mod + cond * 12288 + 4096) + lane;
        v2u* o = (v2u*)(XN + (size_t)m * DM) + lane;
#pragma unroll
        for (int j = 0; j < 16; ++j) { const f32x4 sh = sh4[64 * j], sc = sc4[64 * j]; const f32x4 x = v[j] * rstd * (sc + 1.f) + sh; v2u w; w.x = pk2(x.x, x.y); w.y = pk2(x.z, x.w); o[64 * j] = w; }
    }
}

__device__ __forceinline__ void phase_rowprep(const bf16* P, const float* qgain, const float* kgain, const f32x2* tab, bf16* QN, bf16* KN, f32x2* SGST, int gw, int NGW, int lane) {
    const int sub = lane & 3;
    for (int m = gw; m < MROWS; m += NGW) {
        const bf16* pr = P + (size_t)m * NIN;
        const bool isctx = m >= NLAT; const int t = isctx ? ((m - NLAT) & 255) : (m & 8191);
        {   float x[16]; unpack8(*(const v4u*)(pr + C_SGV + 16 * lane), x); unpack8(*(const v4u*)(pr + C_SGV + 16 * lane + 8), x + 8);
            float s = 0.f;
#pragma unroll
            for (int i = 0; i < 16; ++i) s += x[i];
            const float mean = wave_sum(s) * (1.f / 1024.f); float q = 0.f;
#pragma unroll
            for (int i = 0; i < 16; ++i) { const float dlt = x[i] - mean; q += dlt * dlt; }
            const float var = wave_sum(q) * (1.f / 1024.f);
            if (lane == 0) SGST[m] = (f32x2){mean, rsq_f(var + 1e-5f)}; }
        float q[16], k[16];
        unpack8(*(const v4u*)(pr + C_NAQ + 16 * lane), q); unpack8(*(const v4u*)(pr + C_NAQ + 16 * lane + 8), q + 8);
        unpack8(*(const v4u*)(pr + C_NAK + 16 * lane), k); unpack8(*(const v4u*)(pr + C_NAK + 16 * lane + 8), k + 8);
        float sq = 0.f, sk = 0.f;
#pragma unroll
        for (int i = 0; i < 16; ++i) { sq += q[i] * q[i]; sk += k[i] * k[i]; }
        sq += __shfl_xor(sq, 1); sq += __shfl_xor(sq, 2); sk += __shfl_xor(sk, 1); sk += __shfl_xor(sk, 2);
        const float rq = rsq_f(sq * (1.f / 64.f) + 1e-6f), rk = rsq_f(sk * (1.f / 64.f) + 1e-6f);
#pragma unroll
        for (int i = 0; i < 16; ++i) { q[i] *= rq * qgain[16 * sub + i]; k[i] *= rk * kgain[16 * sub + i]; }
        if (!isctx) {
            const int pos = sub < 2 ? (t >> 6) : (t & 63);
#pragma unroll
            for (int i = 0; i < 16; ++i) { const f32x2 cs = tab[pos * 16 + i]; const float pq = __shfl_xor(q[i], 1), pkk = __shfl_xor(k[i], 1);
                q[i] = (sub & 1) ? (q[i] * cs.x + pq * cs.y) : (q[i] * cs.x - pq * cs.y);
                k[i] = (sub & 1) ? (k[i] * cs.x + pkk * cs.y) : (k[i] * cs.x - pkk * cs.y); }
        }
#pragma unroll
        for (int i = 0; i < 16; ++i) q[i] *= 0.125f;
        *(v4u*)(QN + (size_t)m * GWD + 16 * lane) = pack8(q); *(v4u*)(QN + (size_t)m * GWD + 16 * lane + 8) = pack8(q + 8);
        *(v4u*)(KN + (size_t)m * GWD + 16 * lane) = pack8(k); *(v4u*)(KN + (size_t)m * GWD + 16 * lane + 8) = pack8(k + 8);
    }
}
__device__ __forceinline__ void phase_vt(const bf16* P, bf16* VTL, bf16* VTC, int gw, int NGW, int lane) {
    for (int u = gw; u < (MROWS / 64) * 16; u += NGW) {
        const int tt = u >> 4, h = u & 15, m0 = tt * 64;
        const bf16* src = P + (size_t)m0 * NIN + C_NAV + h * 64 + lane;
        unsigned w[32];
#pragma unroll
        for (int i = 0; i < 32; ++i) { const unsigned lo = src[(size_t)(2 * i) * NIN], hi = src[(size_t)(2 * i + 1) * NIN]; w[i] = lo | (hi << 16); }
        bf16* dst = tt < 256 ? VTL + (((size_t)((tt >> 7) * 16 + h) * 64 + lane) * 8192 + (tt & 127) * 64)
                             : VTC + (((size_t)(((tt - 256) >> 2) * 16 + h) * 64 + lane) * 256 + ((tt - 256) & 3) * 64);
#pragma unroll
        for (int j = 0; j < 8; ++j) { v4u o; o.x = w[4 * j]; o.y = w[4 * j + 1]; o.z = w[4 * j + 2]; o.w = w[4 * j + 3]; ((v4u*)dst)[j] = o; }
    }
}
template <int G>
__device__ __forceinline__ void pool_unit(const bf16* P, const bf16* wbase, const float* pscale, bf16* Y, int m0, int lane) {
    constexpr int WIN = 2 << G;
    const int r = lane & 15, q4 = lane >> 4, m = m0 + r;
    const bool isctx = m0 >= NLAT; const int T = isctx ? CTXL : SEQ; const int t = isctx ? ((m - NLAT) & 255) : (m & 8191);
    const int tlo = t - (WIN >> 1);
    const int lo = tlo < 0 ? 0 : tlo, hi = (tlo + WIN) > T ? T : (tlo + WIN);
    const float inv = rcp_f((float)(hi - lo));
    f32x4 acc[16];
#pragma unroll
    for (int nt = 0; nt < 16; ++nt) acc[nt] = (f32x4){0.f, 0.f, 0.f, 0.f};
#pragma unroll 1
    for (int ks = 0; ks < 8; ++ks) {
        const int ch0 = C_POOLV + G * 256 + 32 * ks + 8 * q4;
        constexpr int WB = WIN < 8 ? WIN : 8;
        bf16x8 bfr[8];
        float sum[8];
#pragma unroll
        for (int j = 0; j < 8; ++j) sum[j] = 0.f;
        const v4u selfw = *(const v4u*)(P + (size_t)m * NIN + ch0);
#pragma unroll
        for (int nt = 0; nt < 8; ++nt) bfr[nt] = ld_frag(wbase + (size_t)(16 * nt + r) * 256 + 32 * ks + 8 * q4);
        bf16x8 bfr2[8];
#pragma unroll
        for (int nt = 0; nt < 8; ++nt) bfr2[nt] = ld_frag(wbase + (size_t)(16 * (nt + 8) + r) * 256 + 32 * ks + 8 * q4);
#pragma unroll
        for (int k0 = 0; k0 < WIN; k0 += WB) {
            v4u wl[WB];
#pragma unroll
            for (int k = 0; k < WB; ++k) { const int tk = tlo + k0 + k; const bool ok = tk >= 0 && tk < T; wl[k] = *(const v4u*)(P + (size_t)(ok ? (m - t + tk) : m) * NIN + ch0); }
            __builtin_amdgcn_sched_barrier(0);
#pragma unroll
            for (int k = 0; k < WB; ++k) { const int tk = tlo + k0 + k; const bool ok = tk >= 0 && tk < T; float x[8]; unpack8(wl[k], x);
#pragma unroll
                for (int j = 0; j < 8; ++j) sum[j] += ok ? x[j] : 0.f; }
            __builtin_amdgcn_sched_barrier(0);
        }
        float self[8]; unpack8(selfw, self);
        float dv[8];
#pragma unroll
        for (int j = 0; j < 8; ++j) dv[j] = sum[j] * inv - self[j];
        const bf16x8 af = __builtin_bit_cast(bf16x8, pack8(dv));
        __builtin_amdgcn_sched_barrier(0);
#pragma unroll
        for (int nt = 0; nt < 8; ++nt) acc[nt] = mfma16(af, bfr[nt], acc[nt]);
        __builtin_amdgcn_sched_barrier(0);
#pragma unroll
        for (int nt = 0; nt < 8; ++nt) acc[nt + 8] = mfma16(af, bfr2[nt], acc[nt + 8]);
        __builtin_amdgcn_sched_barrier(0);
    }
#pragma unroll
    for (int nh = 0; nh < 4; ++nh) {
        unsigned short zz[4][4]; float ps[4];
#pragma unroll
        for (int nq = 0; nq < 4; ++nq) { const int oc = G * 256 + 16 * (4 * nh + nq) + r; ps[nq] = pscale[oc];
#pragma unroll
            for (int i = 0; i < 4; ++i) zz[nq][i] = P[(size_t)(m0 + 4 * q4 + i) * NIN + C_POOLZ + oc]; }
        __builtin_amdgcn_sched_barrier(0);
#pragma unroll
        for (int nq = 0; nq < 4; ++nq) { const int oc = G * 256 + 16 * (4 * nh + nq) + r;
#pragma unroll
            for (int i = 0; i < 4; ++i) Y[(size_t)(m0 + 4 * q4 + i) * DM + oc] = (bf16)f2bf(acc[4 * nh + nq][i] * ps[nq] * silu_f(bf2f(zz[nq][i]))); }
        __builtin_amdgcn_sched_barrier(0);
    }
}
__device__ __forceinline__ void phase_pool(const bf16* P, const bf16* PWT  , const float* pscale, bf16* Y, int nrows, int gw, int NGW, int lane) {
    for (int u = gw; u < (nrows / 16) * 4; u += NGW) {
        const int tt = u >> 2, g = u & 3, m0 = tt * 16;
        const bf16* wbase = PWT + (size_t)g * 65536;
        if (g == 0) pool_unit<0>(P, wbase, pscale, Y, m0, lane);
        else if (g == 1) pool_unit<1>(P, wbase, pscale, Y, m0, lane);
        else if (g == 2) pool_unit<2>(P, wbase, pscale, Y, m0, lane);
        else pool_unit<3>(P, wbase, pscale, Y, m0, lane);
    }
}
#define REC_ST(p, v) __builtin_nontemporal_store((v), (p))
__device__ __forceinline__ void phase_rwprep(const bf16* P, const float* mu_rkv  , const float* mu_lora  , const float* w0  , const bf16* WUPT  ,
                                             const float* a0, const bf16* AUPT, const float* k_k, const float* k_a, const float* r_k, float* REC, float* BON, LAS unsigned char* lds,
                                             unsigned* queue  , int cls, int wave, int lane) {
    const int n = lane & 15, q4 = lane >> 4;
    const int d = cls >> 3, hp = cls & 7;
    unsigned* qh = queue + 64 * cls;
    LAS float* prm = (LAS float*)(lds + wave * 4096);
#pragma unroll
    for (int it = 0; it < 16; ++it) { const int hh = it >> 3, p = it & 7, ch = (hp * 2 + hh) * 64 + lane;
        const float* src = p == 0 ? w0 + d * 1024 : p == 1 ? a0 + d * 1024 : p == 2 ? mu_rkv + (d * 3 + 0) * 1024 : p == 3 ? mu_rkv + (d * 3 + 1) * 1024 : p == 4 ? mu_rkv + (d * 3 + 2) * 1024 : p == 5 ? k_k : p == 6 ? k_a : r_k;
        prm[it * 64 + lane] = src[ch]; }
    LDS_WAIT(); asm volatile("" ::: "memory");
    unsigned pend = 0u;
    if (lane == 0) pend = __hip_atomic_fetch_add(qh, 1u, __ATOMIC_RELAXED, __HIP_MEMORY_SCOPE_AGENT);
    for (;;) {
        const int tt = __builtin_amdgcn_readfirstlane((int)pend);
        if (tt >= MROWS / 16) break;
        if (lane == 0) pend = __hip_atomic_fetch_add(qh, 1u, __ATOMIC_RELAXED, __HIP_MEMORY_SCOPE_AGENT);
        const int m0 = tt * 16;
        const bool isctx = m0 >= NLAT; const int T = isctx ? CTXL : SEQ; const int t0 = isctx ? ((m0 - NLAT) & 255) : (m0 & 8191); const int b = isctx ? ((m0 - NLAT) >> 8) : (m0 >> 13);
        const int m = m0 + n, t = t0 + n; const bool hasnb = d == 0 ? (t > 0) : (t < T - 1); const int nbr = hasnb ? (d == 0 ? m - 1 : m + 1) : m;
        const bf16* prow = P + (size_t)m * NIN; const bf16* nrow = P + (size_t)nbr * NIN;
        bf16x8 Bw[2], Ba[2];
        {   v4u cw[2], nw[2], ca[2], na[2]; f32x4 mw[2][2], ma[2][2];
#pragma unroll
            for (int ks = 0; ks < 2; ++ks) { const int j0 = 32 * ks + 8 * q4;
                cw[ks] = *(const v4u*)(prow + C_RWWD + d * 64 + j0); nw[ks] = *(const v4u*)(nrow + C_RWWD + d * 64 + j0);
                ca[ks] = *(const v4u*)(prow + C_RWAD + d * 64 + j0); na[ks] = *(const v4u*)(nrow + C_RWAD + d * 64 + j0);
                mw[ks][0] = *(const f32x4*)(mu_lora + (d * 2 + 0) * 64 + j0); mw[ks][1] = *(const f32x4*)(mu_lora + (d * 2 + 0) * 64 + j0 + 4);
                ma[ks][0] = *(const f32x4*)(mu_lora + (d * 2 + 1) * 64 + j0); ma[ks][1] = *(const f32x4*)(mu_lora + (d * 2 + 1) * 64 + j0 + 4); }
            __builtin_amdgcn_sched_barrier(0);
#pragma unroll
            for (int ks = 0; ks < 2; ++ks) {
                float cur[8], nb[8], o[8];
                unpack8(cw[ks], cur); unpack8(nw[ks], nb);
#pragma unroll
                for (int j = 0; j < 8; ++j) { const float xx = cur[j] + ((hasnb ? nb[j] : 0.f) - cur[j]) * mw[ks][j >> 2][j & 3]; o[j] = 1.0f - 2.0f * rcp_f(1.0f + __expf(2.0f * xx)); }
                Bw[ks] = __builtin_bit_cast(bf16x8, pack8(o));
                unpack8(ca[ks], cur); unpack8(na[ks], nb);
#pragma unroll
                for (int j = 0; j < 8; ++j) o[j] = cur[j] + ((hasnb ? nb[j] : 0.f) - cur[j]) * ma[ks][j >> 2][j & 3];
                Ba[ks] = __builtin_bit_cast(bf16x8, pack8(o)); }
        }
        const int pos = scan_pos(d, isctx, t);
#pragma unroll 1
        for (int hh = 0; hh < 2; ++hh) {
            const int head = hp * 2 + hh, chain = (b * 2 + d) * 16 + head;
            char* recb = (char*)REC + ((size_t)chain * SCANLEN + pos) * RECB;
            const LAS float* pr = prm + hh * 512;
            float KK[16], AV[16]; float ss = 0.f, bon = 0.f;
#pragma unroll
            for (int hf = 0; hf < 2; ++hf) {
                const int cl = 32 * hf + 8 * q4, cg = head * 64 + cl;
                bf16x8 wf[2][2], af[2][2];
#pragma unroll
                for (int tq = 0; tq < 2; ++tq) { const size_t wrow = (size_t)(d * 1024 + head * 64 + 32 * hf + 8 * (n >> 2) + 4 * tq + (n & 3)) * 64 + 8 * q4;
                    wf[tq][0] = ld_frag(WUPT + wrow); wf[tq][1] = ld_frag(WUPT + wrow + 32); af[tq][0] = ld_frag(AUPT + wrow); af[tq][1] = ld_frag(AUPT + wrow + 32); }
                const v4u rcw = *(const v4u*)(prow + C_RWR + cg), kcw = *(const v4u*)(prow + C_RWK + cg), vcw = *(const v4u*)(prow + C_RWV + cg);
                const v4u rnw = *(const v4u*)(nrow + C_RWR + cg), knw = *(const v4u*)(nrow + C_RWK + cg), vnw = *(const v4u*)(nrow + C_RWV + cg);
                __builtin_amdgcn_sched_barrier(0);
                f32x4 accW[2], accA[2];
#pragma unroll
                for (int tq = 0; tq < 2; ++tq) { f32x4 z = {0.f, 0.f, 0.f, 0.f}; z = mfma16(wf[tq][0], Bw[0], z); accW[tq] = mfma16(wf[tq][1], Bw[1], z);
                                                 f32x4 y = {0.f, 0.f, 0.f, 0.f}; y = mfma16(af[tq][0], Ba[0], y); accA[tq] = mfma16(af[tq][1], Ba[1], y); }
                float rc[8], kc[8], vc[8], rn[8], kn[8], vn[8];
                unpack8(rcw, rc); unpack8(kcw, kc); unpack8(vcw, vc); unpack8(rnw, rn); unpack8(knw, kn); unpack8(vnw, vn);
                float dec[8], kp[8], rr[8], vv[8];
#pragma unroll
                for (int g = 0; g < 2; ++g) {
                    const f32x4 w0v = *(const LAS f32x4*)(pr + 0 * 64 + cl + 4 * g), a0v = *(const LAS f32x4*)(pr + 1 * 64 + cl + 4 * g), mur = *(const LAS f32x4*)(pr + 2 * 64 + cl + 4 * g),
                                muk = *(const LAS f32x4*)(pr + 3 * 64 + cl + 4 * g), muv = *(const LAS f32x4*)(pr + 4 * 64 + cl + 4 * g), kkv = *(const LAS f32x4*)(pr + 5 * 64 + cl + 4 * g),
                                kav = *(const LAS f32x4*)(pr + 6 * 64 + cl + 4 * g), rkv = *(const LAS f32x4*)(pr + 7 * 64 + cl + 4 * g);
#pragma unroll
                    for (int i = 0; i < 4; ++i) { const int j = 4 * g + i;
                        const float rnb = hasnb ? rn[j] : 0.f, knb = hasnb ? kn[j] : 0.f, vnb = hasnb ? vn[j] : 0.f;
                        const float r_ = rc[j] + (rnb - rc[j]) * mur[i], k0 = kc[j] + (knb - kc[j]) * muk[i], v_ = vc[j] + (vnb - vc[j]) * muv[i];
                        const float xw = -(w0v[i] + accW[g][i]);
                        const float sp = fmaxf(xw, 0.f) + __logf(1.0f + __expf(-fabsf(xw)));
                        dec[j] = __expf(-__expf(-sp - 0.5f));
                        const float av = rcp_f(1.0f + __expf(-(a0v[i] + accA[g][i])));
                        const float kx = k0 * kkv[i]; ss += kx * kx;
                        const float kp_ = k0 * (1.f + (av - 1.f) * kav[i]); bon += r_ * kp_ * rkv[i];
                        KK[8 * hf + j] = kx; AV[8 * hf + j] = av; kp[j] = kp_; rr[j] = r_; vv[j] = v_; }
                }
                char* ob = recb + cl * 2;
                REC_ST((f32x4*)(recb + cl * 4), ((f32x4){dec[0], dec[1], dec[2], dec[3]})); REC_ST((f32x4*)(recb + cl * 4 + 16), ((f32x4){dec[4], dec[5], dec[6], dec[7]}));
                REC_ST((h8*)(ob + 512), ((h8){(_Float16)kp[0], (_Float16)kp[1], (_Float16)kp[2], (_Float16)kp[3], (_Float16)kp[4], (_Float16)kp[5], (_Float16)kp[6], (_Float16)kp[7]}));
                REC_ST((h8*)(ob + 640), ((h8){(_Float16)rr[0], (_Float16)rr[1], (_Float16)rr[2], (_Float16)rr[3], (_Float16)rr[4], (_Float16)rr[5], (_Float16)rr[6], (_Float16)rr[7]}));
                REC_ST((h8*)(ob + 768), ((h8){(_Float16)vv[0], (_Float16)vv[1], (_Float16)vv[2], (_Float16)vv[3], (_Float16)vv[4], (_Float16)vv[5], (_Float16)vv[6], (_Float16)vv[7]}));
                __builtin_amdgcn_sched_barrier(0);
            }
            ss = sum16x4(ss); bon = sum16x4(bon);
            const float inv = rsq_f(fmaxf(ss, 1e-12f));
#pragma unroll
            for (int hf = 0; hf < 2; ++hf) { char* ob = recb + (32 * hf + 8 * q4) * 2; float kkn[8], nka[8];
#pragma unroll
                for (int j = 0; j < 8; ++j) { kkn[j] = KK[8 * hf + j] * inv; nka[j] = -(kkn[j] * AV[8 * hf + j]); }
                REC_ST((h8*)(ob + 256), ((h8){(_Float16)kkn[0], (_Float16)kkn[1], (_Float16)kkn[2], (_Float16)kkn[3], (_Float16)kkn[4], (_Float16)kkn[5], (_Float16)kkn[6], (_Float16)kkn[7]}));
                REC_ST((h8*)(ob + 384), ((h8){(_Float16)nka[0], (_Float16)nka[1], (_Float16)nka[2], (_Float16)nka[3], (_Float16)nka[4], (_Float16)nka[5], (_Float16)nka[6], (_Float16)nka[7]})); }
            if (q4 == 0) BON[(size_t)chain * SCANLEN + pos] = bon;
        }
    }
}
template <bool CTXQ>
__device__ __forceinline__ void na_unit(const bf16* QN, const bf16* KN, const bf16* VTL, const bf16* VTC, const bf16* P, const float* rpb  , bf16* Y, int u, int lane) {
    const int n = lane & 15, q4 = lane >> 4;
    int b, h, qrow0, qr = 0, jt = 0;
    if (CTXQ) { b = u >> 8; h = (u >> 4) & 15; qrow0 = NLAT + b * CTXL + 16 * (u & 15); }
    else { jt = u & 3; h = (u >> 2) & 15; qr = (u >> 6) & 127; b = u >> 13; qrow0 = b * SEQ + qr * 64 + 16 * jt; }
    constexpr int NT = CTXQ ? 16 : 32, WT = CTXQ ? 0 : 16;
    f32x4 s[NT];
    const int rs = qr - 4 < 0 ? 0 : (qr - 4 > 120 ? 120 : qr - 4);
    const int span0 = jt == 0 ? 0 : (jt == 1 ? 8 : (jt == 2 ? 24 : 32));
    const int qc = 16 * jt + n; const int cs = qc - 8 < 0 ? 0 : (qc - 8 > 48 ? 48 : qc - 8);
    bf16x8 qf[2];
#pragma unroll
    for (int ks = 0; ks < 2; ++ks) qf[ks] = ld_frag(QN + (size_t)(qrow0 + n) * GWD + h * 64 + 32 * ks + 8 * q4);
    if (!CTXQ) {
        const float* rp = rpb + (size_t)h * 15 * 31;
#pragma unroll
        for (int wt = 0; wt < 16; ++wt) { const int kri = wt >> 1, half = wt & 1, relr = rs + kri - qr + 7;
#pragma unroll
            for (int i = 0; i < 4; ++i) { const int relc = span0 + 8 * q4 + 4 * half + i - qc + 15; const int relcc = relc < 0 ? 0 : (relc > 30 ? 30 : relc); s[wt][i] = rp[relr * 31 + relcc]; } }
        __builtin_amdgcn_sched_barrier(0);
#pragma unroll
        for (int bt = 0; bt < 2; ++bt) {
            bf16x8 kf[16];
#pragma unroll
            for (int t = 0; t < 8; ++t) { const int wt = bt * 8 + t, kri = wt >> 1, half = wt & 1;
                const bf16* kp = KN + (size_t)(b * SEQ + (rs + kri) * 64 + span0 + 8 * (n >> 2) + 4 * half + (n & 3)) * GWD + h * 64 + 8 * q4; kf[2 * t] = ld_frag(kp); kf[2 * t + 1] = ld_frag(kp + 32); }
            __builtin_amdgcn_sched_barrier(0);
#pragma unroll
            for (int t = 0; t < 8; ++t) { const int wt = bt * 8 + t, half = wt & 1;
                f32x4 a = s[wt];
#pragma unroll
                for (int i = 0; i < 4; ++i) { const int kc = span0 + 8 * q4 + 4 * half + i; const bool ok = kc >= cs && kc < cs + 16; a[i] = ok ? a[i] : -INFINITY; }
                a = mfma16(kf[2 * t], qf[0], a); a = mfma16(kf[2 * t + 1], qf[1], a); s[wt] = a; }
            __builtin_amdgcn_sched_barrier(0);
        }
    }
#pragma unroll
    for (int bt = 0; bt < 2; ++bt) {
        bf16x8 kf[16];
#pragma unroll
        for (int t = 0; t < 8; ++t) { const int ctile = bt * 8 + t; const bf16* kp = KN + (size_t)(NLAT + b * CTXL + 32 * (ctile >> 1) + 8 * (n >> 2) + 4 * (ctile & 1) + (n & 3)) * GWD + h * 64 + 8 * q4; kf[2 * t] = ld_frag(kp); kf[2 * t + 1] = ld_frag(kp + 32); }
        __builtin_amdgcn_sched_barrier(0);
#pragma unroll
        for (int t = 0; t < 8; ++t) { f32x4 a = {0.f, 0.f, 0.f, 0.f}; a = mfma16(kf[2 * t], qf[0], a); a = mfma16(kf[2 * t + 1], qf[1], a); s[WT + bt * 8 + t] = a; }
        __builtin_amdgcn_sched_barrier(0);
    }
    float mx = -INFINITY;
#pragma unroll
    for (int t = 0; t < NT; ++t) mx = fmaxf(fmaxf(fmaxf(s[t][0], s[t][1]), fmaxf(s[t][2], s[t][3])), mx);
    mx = max16x4(mx);
    float sum = 0.f;
#pragma unroll
    for (int t = 0; t < NT; ++t) {
#pragma unroll
        for (int i = 0; i < 4; ++i) { const float e = __expf(s[t][i] - mx); s[t][i] = e; sum += e; } }
    sum = sum16x4(sum);
    const float inv = rcp_f(sum);
    f32x4 o[4];
#pragma unroll
    for (int nt = 0; nt < 4; ++nt) o[nt] = (f32x4){0.f, 0.f, 0.f, 0.f};
#pragma unroll
    for (int tb = 0; tb < NT / 8; ++tb) {
        v4u vv[4][4];
#pragma unroll
        for (int tq = 0; tq < 4; ++tq) { const int tp = tb * 4 + tq;
            const bf16* vb; size_t dstride;
            if (!CTXQ && tp < 8) { vb = VTL + ((size_t)(b * 16 + h) * 64 + n) * 8192 + (rs + tp) * 64 + span0 + 8 * q4; dstride = (size_t)16 * 8192; }
            else { const int cp = tp - (CTXQ ? 0 : 8); vb = VTC + ((size_t)(b * 16 + h) * 64 + n) * 256 + 32 * cp + 8 * q4; dstride = (size_t)16 * 256; }
#pragma unroll
            for (int nt = 0; nt < 4; ++nt) vv[tq][nt] = *(const v4u*)(vb + nt * dstride); }
        __builtin_amdgcn_sched_barrier(0);
#pragma unroll
        for (int tq = 0; tq < 4; ++tq) { const int tp = tb * 4 + tq;
            const f32x4 p0 = s[2 * tp] * inv, p1 = s[2 * tp + 1] * inv;
            v4u aw; aw.x = pk2(p0[0], p0[1]); aw.y = pk2(p0[2], p0[3]); aw.z = pk2(p1[0], p1[1]); aw.w = pk2(p1[2], p1[3]);
            const bf16x8 af = __builtin_bit_cast(bf16x8, aw);
#pragma unroll
            for (int nt = 0; nt < 4; ++nt) o[nt] = mfma16(af, __builtin_bit_cast(bf16x8, vv[tq][nt]), o[nt]); }
        __builtin_amdgcn_sched_barrier(0);
    }
    unsigned short zz[4][4];
#pragma unroll
    for (int nt = 0; nt < 4; ++nt)
#pragma unroll
        for (int i = 0; i < 4; ++i) zz[nt][i] = P[(size_t)(qrow0 + 4 * q4 + i) * NIN + C_NAZ + h * 64 + 16 * nt + n];
    __builtin_amdgcn_sched_barrier(0);
#pragma unroll
    for (int nt = 0; nt < 4; ++nt)
#pragma unroll
        for (int i = 0; i < 4; ++i) { const int row = qrow0 + 4 * q4 + i, col = h * 64 + 16 * nt + n;
            Y[(size_t)row * DM + 1024 + col] = (bf16)f2bf(o[nt][i] * silu_f(bf2f(zz[nt][i]))); }
}
__device__ __forceinline__ void bar4(LAS unsigned* cnt, unsigned& seq, int lane) {
    asm volatile("s_waitcnt vmcnt(0) lgkmcnt(0)" ::: "memory");
    const unsigned baddr = (unsigned)(size_t)cnt, one = 1u; seq += 4u;
    if (lane == 0) asm volatile("ds_add_u32 %0, %1" :: "v"(baddr), "v"(one) : "memory");
    unsigned sp = 0, got;
    for (;;) { asm volatile("ds_read_b32 %0, %1\n\ts_waitcnt lgkmcnt(0)" : "=v"(got) : "v"(baddr) : "memory");
        if (__builtin_amdgcn_readfirstlane((int)got) >= (int)seq) break; __builtin_amdgcn_s_sleep(1); if (++sp > (1u << 22)) break; }
    asm volatile("" ::: "memory");
}
__device__ __forceinline__ void phase_sgu4(const bf16* P, const f32x2* SGST, const float* lnw, const float* lnb, const bf16* SGW, const float* sgb, bf16* Y,
                                           LAS unsigned char* ldsT, LAS unsigned* cnt, int nchunks, int tid4  , int w4  , int lane) {
    const int n = lane & 15, q4 = lane >> 4;
    LAS bf16* T = (LAS bf16*)ldsT; unsigned seq = 0u;
    for (int u = blockIdx.x; u < nchunks * 8; u += 256) {
        const int ck = u >> 3, g = u & 7, m0 = ck * 128;
#pragma unroll
        for (int it = 0; it < 8; ++it) { const int idx = tid4 + 256 * it, q = idx >> 4, c8 = idx & 15;
            float x[8]; unpack8(*(const v4u*)(P + (size_t)(m0 + q) * NIN + C_SGV + g * 128 + 8 * c8), x);
            const f32x2 st = SGST[m0 + q];
#pragma unroll
            for (int j = 0; j < 8; ++j) { const int c = 8 * c8 + j; const float v = (x[j] - st.x) * st.y * lnw[g * 128 + c] + lnb[g * 128 + c]; T[c * 136 + q] = (bf16)f2bf(v); } }
        bar4(cnt, seq, lane);
#pragma unroll 1
        for (int mt = 0; mt < 2; ++mt) { const int mrow = 32 * w4 + 16 * mt;
            bf16x8 af[4];
#pragma unroll
            for (int ks = 0; ks < 4; ++ks) af[ks] = ld_frag(SGW + ((size_t)g * 128 + mrow + n) * 128 + 32 * ks + 8 * q4);
            unsigned short uu16[8][4], zz16[8][4]; float sb4[4];
#pragma unroll
            for (int i = 0; i < 4; ++i) { const int p = mrow + 4 * q4 + i; sb4[i] = sgb[g * 128 + p]; const bf16* pr = P + (size_t)(m0 + p) * NIN + g * 128 + n;
#pragma unroll
                for (int nt = 0; nt < 8; ++nt) { uu16[nt][i] = pr[C_SGU + 16 * nt]; zz16[nt][i] = pr[C_SGZ + 16 * nt]; } }
            __builtin_amdgcn_sched_barrier(0);
#pragma unroll
            for (int nt = 0; nt < 8; ++nt) {
                f32x4 acc = {0.f, 0.f, 0.f, 0.f};
#pragma unroll
                for (int ks = 0; ks < 4; ++ks) { const bf16x8 bfg = *(const LAS bf16x8*)(T + (16 * nt + n) * 136 + 32 * ks + 8 * q4); acc = mfma16(af[ks], bfg, acc); }
#pragma unroll
                for (int i = 0; i < 4; ++i) { const int p = mrow + 4 * q4 + i, row = m0 + p, col = g * 128 + 16 * nt + n;
                    Y[(size_t)row * DM + 3072 + col] = (bf16)f2bf(bf2f(uu16[nt][i]) * (acc[i] + sb4[i]) * silu_f(bf2f(zz16[nt][i]))); }
            }
        }
        bar4(cnt, seq, lane);
    }
}
__device__ __forceinline__ void scan_self(const float* REC, float* YR, LAS unsigned char* lds, LAS unsigned* bcnt, int su, int wave, int lane) {
    constexpr int CS = 32, NCH = SCANLEN / CS, SLOT = CS * RECB, NPW = SLOT / 1024 / 4;
    const int chain = (su & 7) * 8 + ((su >> 3) >> 2), part = (su >> 3) & 3;
    const char* recb = (const char*)REC + (size_t)chain * SCANLEN * RECB;
    const int wl = wave;
#define SCAN_ISSUE(cc, sl) do { _Pragma("unroll") for (int p_ = 0; p_ < NPW; ++p_) \
    __builtin_amdgcn_global_load_lds((const unsigned*)(recb + (size_t)(cc) * SLOT + (wl * NPW + p_) * 1024 + lane * 16), (LAS unsigned*)(lds + (sl) * SLOT + (wl * NPW + p_) * 1024), 16, 0, 0); } while (0)
    __builtin_amdgcn_s_setprio(3);
    SCAN_ISSUE(0, 0); SCAN_ISSUE(1, 1);
#define SCAN_ARRIVE() do { unsigned long long ex_; const unsigned baddr_ = (unsigned)(size_t)bcnt, one_ = 1u; \
    asm volatile("s_mov_b64 %0, exec\n\ts_mov_b64 exec, 1\n\tds_add_u32 %1, %2\n\ts_mov_b64 exec, %0" : "=&s"(ex_) : "v"(baddr_), "v"(one_) : "memory"); } while (0)
    asm volatile("s_waitcnt vmcnt(7)" ::: "memory");
    SCAN_ARRIVE();
    const int c16 = lane & 15, rg = lane >> 4, row = 16 * part + 4 * wave + rg;
    float S0 = 0.f, S1 = 0.f, S2 = 0.f, S3 = 0.f;
#if defined(PROBE_DUP)
    float T0 = 0.f, T1 = 0.f, T2 = 0.f, T3 = 0.f, tdum = 0.f; asm volatile("" : "+v"(T0), "+v"(T1), "+v"(T2), "+v"(T3));
#endif
#if defined(PROBE_LDS2)
    f32x4 dw_ = {0.f, 0.f, 0.f, 0.f}; v4u dk_ = {0u, 0u, 0u, 0u};
#endif
    float* yout = YR + (size_t)chain * SCANLEN * 64 + row;
    const int lo_w = c16 * 16, lo_h = 256 + c16 * 8, lo_v = 768 + row * 2;
#define SCAN_LD(dst, s_) do { const unsigned ahj_ = ah + ((s_) & ~1) * RECB; \
    asm volatile("ds_read_b128 %0, %1 offset:%2" : "=v"(dst##w) : "v"(aw), "i"((s_) * RECB)); \
    asm volatile("ds_read_u16 %0, %1 offset:%2" : "=v"(dst##v) : "v"(av), "i"((s_) * RECB)); \
    asm volatile("ds_read2_b64 %0, %1 offset0:%2 offset1:%3" : "=v"(dst##kn) : "v"(ahj_), "i"(((s_) & 1) * (RECB / 8)), "i"(((s_) & 1) * (RECB / 8) + 16)); \
    asm volatile("ds_read2_b64 %0, %1 offset0:%2 offset1:%3" : "=v"(dst##kr) : "v"(ahj_), "i"(((s_) & 1) * (RECB / 8) + 32), "i"(((s_) & 1) * (RECB / 8) + 48)); } while (0)
#define H4LO(q_) __builtin_bit_cast(h4, (v2u){(q_).x, (q_).y})
#define H4HI(q_) __builtin_bit_cast(h4, (v2u){(q_).z, (q_).w})
#define FMX(a, b, c) __builtin_fmaf((a), (float)(b), (c))
    for (int c = 0; c < NCH; ++c) {
#if defined(PROBE_CHUNK)
        const unsigned long long pt0_ = __builtin_amdgcn_s_memrealtime(); unsigned long long pt8_ = pt0_;
#endif
        {   const unsigned baddr = (unsigned)(size_t)bcnt; const unsigned want = 4u * (unsigned)(c + 1); unsigned sp = 0, got;
            for (;;) { asm volatile("ds_read_b32 %0, %1\n\ts_waitcnt lgkmcnt(0)" : "=v"(got) : "v"(baddr) : "memory");
                if (__builtin_amdgcn_readfirstlane((int)got) >= (int)want) break; __builtin_amdgcn_s_sleep(1); if (++sp > (1u << 22)) break; } }
        asm volatile("" ::: "memory");
        const int cc = c + 2 < NCH ? c + 2 : NCH - 1; const int s2 = (c + 2) & 3;
        const LAS unsigned char* slot = lds + (c & 3) * SLOT;
        float ysv0 = 0.f, ysv1 = 0.f; float yp[16];
        const unsigned aw = (unsigned)(size_t)(slot + lo_w), ah = (unsigned)(size_t)(slot + lo_h), av = (unsigned)(size_t)(slot + lo_v);
        f32x4 Aw, Bw; v4u Akn, Akr, Bkn, Bkr; unsigned Av, Bv; h4 Pr;
#if defined(PROBE_CHUNK)
        if (PROBE_CHUNK & 1) { const unsigned long long n_ = __builtin_amdgcn_s_memrealtime(), te_ = n_ + (n_ - pt0_) * 4; while (__builtin_amdgcn_s_memrealtime() < te_) __builtin_amdgcn_s_sleep(1); }
#endif
        SCAN_LD(A, 0); SCAN_LD(B, 1);
#pragma unroll
        for (int s = 0; s < CS; ++s) {
            f32x4 Cw; v4u Ckn, Ckr; unsigned Cv;
#if defined(PROBE_LDS2)
            if (s < CS - 2) { SCAN_LD(C, s + 2);
                { const unsigned ahj_ = ah + ((s + 2) & ~1) * RECB;
                  asm volatile("ds_read_b128 %0, %1 offset:%2" : "+v"(dw_) : "v"(aw), "i"((s + 2) * RECB));
                  asm volatile("ds_read2_b64 %0, %1 offset0:%2 offset1:%3" : "+v"(dk_) : "v"(ahj_), "i"(((s + 2) & 1) * (RECB / 8)), "i"(((s + 2) & 1) * (RECB / 8) + 16)); }
                if (s == 0) asm volatile("s_waitcnt lgkmcnt(10)" : "+v"(Aw), "+v"(Akn), "+v"(Akr), "+v"(Av)); else asm volatile("s_waitcnt lgkmcnt(12)" : "+v"(Aw), "+v"(Akn), "+v"(Akr), "+v"(Av)); }
            else if (s == CS - 2) asm volatile("s_waitcnt lgkmcnt(6)" : "+v"(Aw), "+v"(Akn), "+v"(Akr), "+v"(Av));
#else
            if (s < CS - 2) { SCAN_LD(C, s + 2); asm volatile("s_waitcnt lgkmcnt(8)" : "+v"(Aw), "+v"(Akn), "+v"(Akr), "+v"(Av)); }
            else if (s == CS - 2) asm volatile("s_waitcnt lgkmcnt(4)" : "+v"(Aw), "+v"(Akn), "+v"(Akr), "+v"(Av));
#endif
            else asm volatile("s_waitcnt lgkmcnt(0)" : "+v"(Aw), "+v"(Akn), "+v"(Akr), "+v"(Av));
#if defined(PROBE_CHUNK)
            if (s == 8) pt8_ = __builtin_amdgcn_s_memrealtime();
#endif
            if ((s & 3) == 1 && (s >> 2) < NPW) { const int p_ = s >> 2;
                __builtin_amdgcn_global_load_lds((const unsigned*)(recb + (size_t)cc * SLOT + (wl * NPW + p_) * 1024 + lane * 16), (LAS unsigned*)(lds + s2 * SLOT + (wl * NPW + p_) * 1024), 16, 0, 0); }
            if (s == 16) { if (c == 0) asm volatile("s_waitcnt vmcnt(4)" ::: "memory"); else asm volatile("s_waitcnt vmcnt(6)" ::: "memory"); SCAN_ARRIVE(); }
            __builtin_amdgcn_sched_barrier(0);
            const h4 Akk = H4LO(Akn), Ana = H4HI(Akn), Ak = H4LO(Akr), Ar = H4HI(Akr); const _Float16 Avh = __builtin_bit_cast(_Float16, (unsigned short)Av);
            if (s > 0) { float q0 = FMX(S0, Pr.x, 0.f), q1 = FMX(S2, Pr.z, 0.f); q0 = FMX(S1, Pr.y, q0); q1 = FMX(S3, Pr.w, q1); yp[(s - 1) & 15] = q0 + q1; }
            float p0 = FMX(S0, Akk.x, 0.f), p1 = FMX(S2, Akk.z, 0.f); p0 = FMX(S1, Akk.y, p0); p1 = FMX(S3, Akk.w, p1);
            const float dt = red16(p0 + p1);
            const float u0 = __builtin_fmaf(S0, Aw.x, FMX((float)Avh, Ak.x, 0.f)), u1 = __builtin_fmaf(S1, Aw.y, FMX((float)Avh, Ak.y, 0.f)),
                        u2 = __builtin_fmaf(S2, Aw.z, FMX((float)Avh, Ak.z, 0.f)), u3 = __builtin_fmaf(S3, Aw.w, FMX((float)Avh, Ak.w, 0.f));
            S0 = FMX(dt, Ana.x, u0); S1 = FMX(dt, Ana.y, u1); S2 = FMX(dt, Ana.z, u2); S3 = FMX(dt, Ana.w, u3);
#if defined(PROBE_IND)
            {   float d0, d1, d2, d3;
                asm volatile("v_mul_f32 %0, %4, %4\n\tv_mul_f32 %1, %4, %4\n\tv_mul_f32 %2, %4, %4\n\tv_mul_f32 %3, %4, %4\n\t"
                             "v_mul_f32 %0, %4, %4\n\tv_mul_f32 %1, %4, %4\n\tv_mul_f32 %2, %4, %4\n\tv_mul_f32 %3, %4, %4\n\t"
                             "v_mul_f32 %0, %4, %4\n\tv_mul_f32 %1, %4, %4\n\tv_mul_f32 %2, %4, %4\n\tv_mul_f32 %3, %4, %4\n\t"
                             "v_mul_f32 %0, %4, %4\n\tv_mul_f32 %1, %4, %4\n\tv_mul_f32 %2, %4, %4\n\tv_mul_f32 %3, %4, %4" : "=&v"(d0), "=&v"(d1), "=&v"(d2), "=&v"(d3) : "v"(Aw.x)); }
#endif
#if defined(PROBE_DUP)
            {
                if (s > 0) { float q0 = FMX(T0, Pr.x, 0.f), q1 = FMX(T2, Pr.z, 0.f); q0 = FMX(T1, Pr.y, q0); q1 = FMX(T3, Pr.w, q1); tdum += q0 + q1; }
                float p0 = FMX(T0, Akk.x, 0.f), p1 = FMX(T2, Akk.z, 0.f); p0 = FMX(T1, Akk.y, p0); p1 = FMX(T3, Akk.w, p1);
                const float dt2 = red16(p0 + p1);
                const float u0 = __builtin_fmaf(T0, Aw.x, FMX((float)Avh, Ak.x, 0.f)), u1 = __builtin_fmaf(T1, Aw.y, FMX((float)Avh, Ak.y, 0.f)),
                            u2 = __builtin_fmaf(T2, Aw.z, FMX((float)Avh, Ak.z, 0.f)), u3 = __builtin_fmaf(T3, Aw.w, FMX((float)Avh, Ak.w, 0.f));
                T0 = FMX(dt2, Ana.x, u0); T1 = FMX(dt2, Ana.y, u1); T2 = FMX(dt2, Ana.z, u2); T3 = FMX(dt2, Ana.w, u3); }
#endif
            if (s == 16) ysv0 = red16_transpose(yp, c16);
            Pr = Ar;
            if (s < CS - 1) { Aw = Bw; Akn = Bkn; Akr = Bkr; Av = Bv; }
            if (s < CS - 2) { Bw = Cw; Bkn = Ckn; Bkr = Ckr; Bv = Cv; }
        }
#if defined(PROBE_CHUNK)
        asm volatile("" : "+v"(S0), "+v"(S1), "+v"(S2), "+v"(S3));
        const unsigned long long pt1_ = __builtin_amdgcn_s_memrealtime();
        if (PROBE_CHUNK & 4) { const unsigned long long te_ = pt1_ + (pt1_ - pt8_) * 4; while (__builtin_amdgcn_s_memrealtime() < te_) __builtin_amdgcn_s_sleep(1); }
#endif
        { float q0 = FMX(S0, Pr.x, 0.f), q1 = FMX(S2, Pr.z, 0.f); q0 = FMX(S1, Pr.y, q0); q1 = FMX(S3, Pr.w, q1); yp[15] = q0 + q1; }
        ysv1 = red16_transpose(yp, c16);
        asm volatile("" ::: "memory");
        yout[(size_t)(c * CS + c16) * 64] = ysv0; yout[(size_t)(c * CS + 16 + c16) * 64] = ysv1;
#if defined(PROBE_CHUNK)
        if (PROBE_CHUNK & 2) { const unsigned long long n_ = __builtin_amdgcn_s_memrealtime(), te_ = n_ + (n_ - pt1_) * 4; while (__builtin_amdgcn_s_memrealtime() < te_) __builtin_amdgcn_s_sleep(1); }
#endif
    }
    asm volatile("s_waitcnt vmcnt(0)" ::: "memory");
    __builtin_amdgcn_s_setprio(0);
#if defined(PROBE_DUP)
    asm volatile("" :: "v"(T0), "v"(T1), "v"(T2), "v"(T3), "v"(tdum));
#endif
#if defined(PROBE_LDS2)
    asm volatile("s_waitcnt lgkmcnt(0)" :: "v"(dw_), "v"(dk_));
#endif
#undef FMX
#undef SCAN_LD
#undef SCAN_ARRIVE
#undef H4LO
#undef H4HI
#undef SCAN_ISSUE
}
__device__ __forceinline__ void phase_rwfin(const bf16* P, const float* YR, const float* REC, const float* BON, const float* lnw, const float* lnb, bf16* Y, int nrows, int gw, int NGW, int lane) {
    const int head = lane >> 2, sub = lane & 3;
    for (int m = gw; m < nrows; m += NGW) {
        const bool isctx = m >= NLAT; const int t = isctx ? ((m - NLAT) & 255) : (m & 8191); const int b = isctx ? ((m - NLAT) >> 8) : (m >> 13);
        float out[16];
#pragma unroll
        for (int i = 0; i < 16; ++i) out[i] = 0.f;
#pragma unroll
        for (int d = 0; d < 2; ++d) {
            const int chain = (b * 2 + d) * 16 + head; const size_t pp = (size_t)chain * SCANLEN + scan_pos(d, isctx, t);
            float y[16], v[16];
#pragma unroll
            for (int j = 0; j < 4; ++j) { const f32x4 a = *(const f32x4*)(YR + pp * 64 + 16 * sub + 4 * j); const h4 c = *(const h4*)((const char*)REC + pp * RECB + 768 + (16 * sub + 4 * j) * 2);
                y[4 * j] = a.x; y[4 * j + 1] = a.y; y[4 * j + 2] = a.z; y[4 * j + 3] = a.w; v[4 * j] = (float)c.x; v[4 * j + 1] = (float)c.y; v[4 * j + 2] = (float)c.z; v[4 * j + 3] = (float)c.w; }
            const float bo = BON[pp];
            float s = 0.f;
#pragma unroll
            for (int i = 0; i < 16; ++i) s += y[i];
            s += __shfl_xor(s, 1); s += __shfl_xor(s, 2);
            const float mean = s * (1.f / 64.f); float q = 0.f;
#pragma unroll
            for (int i = 0; i < 16; ++i) { const float dl = y[i] - mean; q += dl * dl; }
            q += __shfl_xor(q, 1); q += __shfl_xor(q, 2);
            const float rstd = rsq_f(q * (1.f / 64.f) + 64e-5f);
#pragma unroll
            for (int i = 0; i < 16; ++i) { const int ch = head * 64 + 16 * sub + i; out[i] += (y[i] - mean) * rstd * lnw[ch] + lnb[ch] + bo * v[i]; }
        }
        float z[16]; unpack8(*(const v4u*)(P + (size_t)m * NIN + C_RWZ + 16 * lane), z); unpack8(*(const v4u*)(P + (size_t)m * NIN + C_RWZ + 16 * lane + 8), z + 8);
#pragma unroll
        for (int i = 0; i < 16; ++i) out[i] *= silu_f(z[i]);
        *(v4u*)(Y + (size_t)m * DM + 2048 + 16 * lane) = pack8(out); *(v4u*)(Y + (size_t)m * DM + 2048 + 16 * lane + 8) = pack8(out + 8);
    }
}
#define XB_TMO      128
#define XB_XCNT(j)  (256  + 64 * (j))
#define XB_XSUB(j)  (1280 + 64 * (j))
#define XB_XGEN(j)  (2304 + 64 * (j))
#define XB_TOP      3328
#define XB_TOPGEN   3392
#define XCD_BAR_WORDS 3456
#define XB_SPIN_CAP (1u << 18)

__device__ __forceinline__ unsigned xb_ld(unsigned* p)              { return __hip_atomic_load(p, __ATOMIC_RELAXED, __HIP_MEMORY_SCOPE_AGENT); }
__device__ __forceinline__ unsigned xb_add(unsigned* p, unsigned v) { return __hip_atomic_fetch_add(p, v, __ATOMIC_RELAXED, __HIP_MEMORY_SCOPE_AGENT); }
__device__ __forceinline__ unsigned xb_xcc_id() { return (unsigned)__builtin_amdgcn_s_getreg((3 << 11) | 20) & 0xFu; }
#define XB_SPIN(cond, bar) do { unsigned _sp = 0; while (cond) { __builtin_amdgcn_s_sleep(1); \
    if ((++_sp & 255u) == 0u) { if (xb_ld(&(bar)[XB_TMO])) break; if (_sp > XB_SPIN_CAP) { atomicAdd(&(bar)[XB_TMO], 1u); break; } } } } while (0)

struct XcdBarrier {
    unsigned* bar; unsigned x;
    volatile LAS unsigned* st;
};

__device__ __forceinline__ XcdBarrier xcd_barrier_post(unsigned* bar, volatile LAS unsigned* st) {
    XcdBarrier b; b.bar = bar; b.x = xb_xcc_id(); b.st = st;
    if (threadIdx.x == 0) (void)xb_add(&bar[XB_XCNT(b.x)], 1u);
    return b;
}
__device__ __forceinline__ void xcd_barrier_complete(unsigned* bar, unsigned x, unsigned& nloc, unsigned& nx) {
    const unsigned G = gridDim.x * gridDim.y * gridDim.z;
    unsigned sum, cnt, mine, sp = 0u;
    for (;;) {
        sum = 0u; cnt = 0u; mine = 0u;
#pragma unroll
        for (unsigned j = 0; j < 16; ++j) { const unsigned c = xb_ld(&bar[XB_XCNT(j)]); sum += c; cnt += (c > 0u) ? 1u : 0u; mine = (j == x) ? c : mine; }
        if (sum == G) break;
        __builtin_amdgcn_s_sleep(1);
        if ((++sp & 255u) == 0u) { if (xb_ld(&bar[XB_TMO])) break; if (sp > XB_SPIN_CAP) { atomicAdd(&bar[XB_TMO], 1u); break; } }
    }
    nloc = mine > 0u ? mine : 1u; nx = cnt > 0u ? cnt : 1u;
}

__device__ __forceinline__ void xcd_barrier(const XcdBarrier& b) {
    asm volatile("s_waitcnt vmcnt(0)" ::: "memory");
    __syncthreads();
    if (threadIdx.x == 0) {
        unsigned* bar = b.bar;
        __builtin_amdgcn_s_waitcnt(0);
        unsigned nloc = b.st[0], nx = b.st[1];
        if (nloc == 0u) { xcd_barrier_complete(bar, b.x, nloc, nx); b.st[0] = nloc; b.st[1] = nx; }
        const unsigned old = xb_add(&bar[XB_XSUB(b.x)], 1u);
        const unsigned gen = old / nloc;
        if (old + 1u == (gen + 1u) * nloc) {
            __builtin_amdgcn_fence(__ATOMIC_RELEASE, "agent");
            asm volatile("s_waitcnt vmcnt(0)" ::: "memory");
            const unsigned og = xb_add(&bar[XB_TOP], 1u);
            const unsigned tg = og / nx;
            if (og + 1u == (tg + 1u) * nx) xb_add(&bar[XB_TOPGEN], 1u);
            else XB_SPIN(xb_ld(&bar[XB_TOPGEN]) == tg, bar);
            __builtin_amdgcn_fence(__ATOMIC_ACQUIRE, "agent");
            xb_add(&bar[XB_XGEN(b.x)], 1u);
            asm volatile("s_waitcnt vmcnt(0)" ::: "memory");
        } else {
            XB_SPIN(xb_ld(&bar[XB_XGEN(b.x)]) == gen, bar);
            __builtin_amdgcn_fence(__ATOMIC_ACQUIRE, "agent");
            asm volatile("s_waitcnt vmcnt(0)" ::: "memory");
        }
    }
    __syncthreads();
}

#ifndef MK_SPLIT
#define MK_SPLIT 0
#endif
constexpr int PPL = 6;
constexpr int NPHASE = 2 + PPL * DEPTH;
constexpr int RWP_BLOCKS = 14;
constexpr int CW_RWQ = 16384;
constexpr int NGRID = 256;
struct Args { const float* in[28]; float* out; unsigned char* ws; int ph_lo, ph_hi, li, pad; };

__global__ void __launch_bounds__(NWAVES * 64, 2) fwd(Args args) {
    extern __shared__ __attribute__((aligned(16))) unsigned char lds_raw[];
    LAS unsigned char* lds = (LAS unsigned char*)lds_raw;
    volatile LAS unsigned* MISC = (volatile LAS unsigned*)(lds + MISC_OFF);
    const int tid = threadIdx.x, lane = tid & 63, wave = __builtin_amdgcn_readfirstlane(tid >> 6);
    constexpr int G = NGRID; const int bx = blockIdx.x;
    const int vcu = (bx % 8) * (G / 8) + bx / 8;
    const int gw = vcu * NWAVES + wave; constexpr int NGW = G * NWAVES;
    unsigned char* ws = args.ws;
    const int lo = args.ph_lo, hi = args.ph_hi;

    for (int u = tid; u < (LDS_BYTES - LDSCTL_OFF) / 4; u += NWAVES * 64) ((LAS unsigned*)(lds + LDSCTL_OFF))[u] = 0u;
    __syncthreads();
    XcdBarrier bar; bar.bar = (unsigned*)(ws + WS_CTL) + CW_BAR; bar.x = 0; bar.st = MISC + 8;
    if (hi - lo > 1) bar = xcd_barrier_post((unsigned*)(ws + WS_CTL) + CW_BAR, MISC + 8);
#define IN(k) (lo <= (k) && (k) < hi)
#define SEAM(k) do { if (lo <= (k) && (k) + 1 < hi) { XcdBarrier b2_; b2_.bar = WSP(unsigned, WS_CTL) + CW_BAR; b2_.x = bar.x; b2_.st = bar.st; xcd_barrier(b2_); } } while (0)

#define OPQ_S(x) ({ int _t = (x); asm volatile("" : "+s"(_t)); _t; })
#define OPQ_V(x) ({ int _t = (x); asm volatile("" : "+v"(_t)); _t; })
#define INP(i) (args.in[OPQ_S(i)])
#define WSP(T, off) ((T*)(args.ws + ({ size_t _o = (off); asm volatile("" : "+s"(_o)); _o; })))
#define x_in INP(0)
#define c_in INP(1)
#define ctx_in INP(2)
#define cctx_in INP(3)
#define w_mod INP(4)
#define b_mod INP(5)
#define w_in INP(6)
#define w_out INP(7)
#define pool_w INP(8)
#define pool_scale INP(9)
#define na_qg INP(10)
#define na_kg INP(11)
#define na_rpb INP(12)
#define rw_mu_rkv INP(13)
#define rw_mu_lora INP(14)
#define rw_w0 INP(15)
#define rw_w_up INP(16)
#define rw_a0 INP(17)
#define rw_a_up INP(18)
#define rw_k_k INP(19)
#define rw_k_a INP(20)
#define rw_r_k INP(21)
#define rw_ln_w INP(22)
#define rw_ln_b INP(23)
#define sg_ln_w INP(24)
#define sg_ln_b INP(25)
#define sg_w INP(26)
#define sg_b INP(27)
#define MOD WSP(float, WS_MOD)
#define MODP WSP(float, WS_MODP)
#define TAB WSP(f32x2, WS_TAB)
#define SGST WSP(f32x2, WS_SGST)
#define BON WSP(float, WS_BON)
#define POOLWT WSP(bf16, WS_POOLWT)
#define WUPT WSP(bf16, WS_WUPT)
#define AUPT WSP(bf16, WS_AUPT)
#define SGW WSP(bf16, WS_SGW)
#define VTC WSP(bf16, WS_VTC)
#define VTL WSP(bf16, WS_VTL)
#define HCTX WSP(float, WS_HCTX)
#define QN WSP(bf16, WS_QN)
#define KN WSP(bf16, WS_KN)
#define WOUTT WSP(bf16, WS_WOUTT)
#define WINT WSP(bf16, WS_WINT)
#define XN WSP(bf16, WS_XN)
#define Y WSP(bf16, WS_Y)
#define P WSP(bf16, WS_P)
#define YR WSP(float, WS_YR)
#define REC WSP(float, WS_REC)
#define SILUC WSP(float, WS_SILUC)
    float* const out = args.out;

    if (IN(0)) {
        LAS float* scr = (LAS float*)(lds + wave * 16384);
        constexpr int I_MOD = 64 * 48  , I_WIN = 64 * (NIN / 32), I_WOUT = 64 * 128, I_POOL = 4 * 32, I_WUP = 2 * 32, I_AUP = 2 * 32, I_SGW = 256;
        constexpr int NITEMS = I_MOD + I_WIN + I_WOUT + I_POOL + I_WUP + I_AUP + I_SGW;
        for (int it = gw; it < NITEMS; it += NGW) {
            int r = it;
            if (r < I_MOD) { p0_mod_item(w_mod, c_in, cctx_in, MODP, scr, r, lane); continue; } r -= I_MOD;
            if (r < I_WIN) { p0_transpose_item<true>(w_in, DM, NIN, WINT, scr, r, lane); continue; } r -= I_WIN;
            if (r < I_WOUT) { p0_transpose_item(w_out, DM, DM, WOUTT, scr, r, lane); continue; } r -= I_WOUT;
            if (r < I_POOL) { const int g = r / 32; p0_transpose_item(pool_w + (size_t)g * 65536, 256, 256, POOLWT + (size_t)g * 65536, scr, r % 32, lane); continue; } r -= I_POOL;
            if (r < I_WUP) { const int dd = r / 32; p0_transpose_item(rw_w_up + (size_t)dd * 65536, 64, 1024, WUPT + (size_t)dd * 65536, scr, r % 32, lane); continue; } r -= I_WUP;
            if (r < I_AUP) { const int dd = r / 32; p0_transpose_item(rw_a_up + (size_t)dd * 65536, 64, 1024, AUPT + (size_t)dd * 65536, scr, r % 32, lane); continue; } r -= I_AUP;
            {   const size_t e0 = (size_t)r * 512 + lane * 8; const f32x4 a = *(const f32x4*)(sg_w + e0), b = *(const f32x4*)(sg_w + e0 + 4);
                v4u o; o.x = pk2(a.x, a.y); o.y = pk2(a.z, a.w); o.z = pk2(b.x, b.y); o.w = pk2(b.z, b.w); *(v4u*)(SGW + e0) = o; }
        }
        SEAM(0);
    }
    if (IN(1)) {

        for (int idx = gw * 64 + lane; idx < 3 * 4096; idx += NGW * 64) SILUC[idx] = silu_f(idx < 8192 ? c_in[idx] : cctx_in[idx - 8192]);
        for (int idx = gw * 64 + lane; idx < 3 * 12288; idx += NGW * 64) {
            const int l = idx / 36864, c = (idx / 12288) % 3, n = idx % 12288;
            float s = b_mod[l * 12288 + n];
            const float* pp = MODP + ((size_t)(l * 64) * 3 + c) * 12288 + n;
#pragma unroll 8
            for (int kc = 0; kc < 64; ++kc) s += pp[(size_t)kc * 3 * 12288];
            MOD[idx] = s;
        }
        for (int idx = gw * 64 + lane; idx < 2048; idx += NGW * 64) {
            const int pos = idx >> 4, i = idx & 15;
            float inv = (i & 3) == 0 ? 1.0f : ((i & 3) == 1 ? 0.5623413251903491f : ((i & 3) == 2 ? 0.31622776601683794f : 0.17782794100389228f));
            inv *= (i >> 2) == 0 ? 1.0f : ((i >> 2) == 1 ? 0.1f : ((i >> 2) == 2 ? 0.01f : 0.001f));
            float cc, sn; sincos_acc((float)pos * inv, cc, sn);
            TAB[idx] = (f32x2){cc, sn};
        }
        SEAM(1);
    }
    for (int l = 0; l < DEPTH; ++l) {
        const int pb = 2 + PPL * l;
        const bool with_ctx = l < DEPTH - 1;
#define hin_lat (l == 0 ? x_in : (const float*)out)
#define hin_ctx (l == 0 ? ctx_in : (const float*)HCTX)
#define mod (MOD + (size_t)l * 3 * 12288)
        const int nrows = with_ctx ? MROWS : NLAT;
        if (IN(pb + 0)) {
            phase_xn(hin_lat, hin_ctx, mod, XN, OPQ_S(gw), NGW, OPQ_V(lane));
            SEAM(pb + 0);
        }
        if (IN(pb + 1)) {
            constexpr int C0 = C_SPLIT, NA_ = NIN - C0;
            pg8::Gemm g{XN, WINT + (size_t)l * NIN * DM + (size_t)C0 * DM, MROWS, NA_, DM}; pg8::StaticOrder S; S.init(MROWS, NA_, G, bx);
            pg8::EpiStoreBf16 E{P + C0, NIN};
            pg8::gemm_phase<pg8::EpiStoreBf16, pg8::StaticOrder, true, true>(lds, g, S, E);
            SEAM(pb + 1);
        }
        if (IN(pb + 2)) {
            if (bx >= RWP_BLOCKS) {
                constexpr int NB_ = C_SPLIT;
                pg8::Gemm g{XN, WINT + (size_t)l * NIN * DM, MROWS, NB_, DM}; pg8::StaticOrder S; S.init(MROWS, NB_, G - RWP_BLOCKS, bx - RWP_BLOCKS);
                pg8::EpiStoreBf16 E{P, NIN};
                pg8::gemm_phase<pg8::EpiStoreBf16, pg8::StaticOrder, true, true>(lds, g, S, E);
            }
            phase_rwprep(P, rw_mu_rkv + (size_t)l * 6144, rw_mu_lora + (size_t)l * 256, rw_w0 + (size_t)l * 2048, WUPT + (size_t)l * 131072, rw_a0 + (size_t)l * 2048, AUPT + (size_t)l * 131072,
                         rw_k_k + (size_t)l * 1024, rw_k_a + (size_t)l * 1024, rw_r_k + (size_t)l * 1024, REC, BON, lds, WSP(unsigned, WS_CTL) + CW_RWQ + l * 1024, (bx * NWAVES + wave) & 15, wave, OPQ_V(lane));
            phase_rowprep(P, na_qg + l * 64, na_kg + l * 64, TAB, QN, KN, SGST, OPQ_S(gw), NGW, OPQ_V(lane));
            phase_vt(P, VTL, VTC, OPQ_S(gw), NGW, OPQ_V(lane));
            SEAM(pb + 2);
        }
        if (IN(pb + 3)) {
            {
            LAS unsigned* mixq = (LAS unsigned*)(lds + LDSCTL_OFF + 64); LAS unsigned* mixb = (LAS unsigned*)(lds + LDSCTL_OFF + 128); LAS unsigned* mixs = (LAS unsigned*)(lds + LDSCTL_OFF + 192);
            if (tid == 0) { *mixq = 0u; *mixb = 0u; *mixs = 0u; }
            __syncthreads();
            if (wave < 4) scan_self(REC, YR, lds, mixb, bx, wave, OPQ_V(lane));
            else phase_sgu4(P, SGST, sg_ln_w + (size_t)l * 1024, sg_ln_b + (size_t)l * 1024, SGW + (size_t)l * 131072, sg_b + (size_t)l * 1024, Y, lds + SGUT_OFF, mixs, nrows / 128, OPQ_V(tid) - 256, wave - 4, OPQ_V(lane));
            {   const int nctxu = with_ctx ? 2 : 0, npool = (nrows / 16) * 4, npq = (npool + NGRID - 1) / NGRID, nwc = l + 1 < DEPTH ? (WC_ITEMS + NGRID - 1) / NGRID : 0, nmd = l + 1 < DEPTH ? (64 * 48) / NGRID : 0, nq = 64 + nctxu + npq + nwc + nmd;
                for (;;) {
                    unsigned k = 0; if (lane == 0) k = __hip_atomic_fetch_add(mixq, 1u, __ATOMIC_RELAXED, __HIP_MEMORY_SCOPE_WORKGROUP);
                    k = (unsigned)__builtin_amdgcn_readfirstlane((int)k);
                    if ((int)k >= nq) break;
                    const int ln = OPQ_V(lane);
                    if (k < 64u) { na_unit<false>(QN, KN, VTL, VTC, P, na_rpb + (size_t)l * 16 * 15 * 31, Y, vcu * 64 + (int)k, ln);
                    }
                    else if ((int)k < 64 + nctxu) na_unit<true>(QN, KN, VTL, VTC, P, na_rpb, Y, bx * 2 + ((int)k - 64), ln);
                    else if ((int)k >= 64 + nctxu + npq + nwc) mod_item_nolds(w_mod + (size_t)(l + 1) * 4096 * 12288, SILUC, MODP + (size_t)(l + 1) * 64 * 3 * 12288, bx + NGRID * ((int)k - 64 - nctxu - npq - nwc), ln);
                    else if ((int)k >= 64 + nctxu + npq) { const int r = bx + NGRID * ((int)k - 64 - nctxu - npq);
                        if (r < WC_ITEMS) weight_copy_item(l + 1, r, w_in, w_out, pool_w, rw_w_up, rw_a_up, sg_w, WINT, WOUTT, POOLWT, WUPT, AUPT, SGW, ln); }
                    else { const int u = bx + NGRID * ((int)k - 64 - nctxu);
                        if (u < npool) { const int tt = u >> 2, g = u & 3; const bf16* wbase = POOLWT + (size_t)l * 262144 + (size_t)g * 65536; const float* psc = pool_scale + (size_t)l * 1024;
                            if (g == 0) pool_unit<0>(P, wbase, psc, Y, tt * 16, ln); else if (g == 1) pool_unit<1>(P, wbase, psc, Y, tt * 16, ln);
                            else if (g == 2) pool_unit<2>(P, wbase, psc, Y, tt * 16, ln); else pool_unit<3>(P, wbase, psc, Y, tt * 16, ln); } }
                }
            }
            }
            SEAM(pb + 3);
        }
        if (IN(pb + 4)) {
            if (l + 1 < DEPTH) for (int idx = gw * 64 + lane; idx < 3 * 12288; idx += NGW * 64) {
                const int c = idx / 12288, n = idx % 12288; float s = b_mod[(l + 1) * 12288 + n];
                const float* pp = MODP + ((size_t)((l + 1) * 64) * 3 + c) * 12288 + n;
#pragma unroll 8
                for (int kc = 0; kc < 64; ++kc) s += pp[(size_t)kc * 3 * 12288];
                MOD[(size_t)(l + 1) * 3 * 12288 + idx] = s; }
            phase_rwfin(P, YR, REC, BON, rw_ln_w + (size_t)l * 1024, rw_ln_b + (size_t)l * 1024, Y, nrows, OPQ_S(gw), NGW, OPQ_V(lane));
            SEAM(pb + 4);
        }
        if (IN(pb + 5)) {
            pg8::Gemm g{Y, WOUTT + (size_t)l * DM * DM, nrows, DM, DM}; pg8::StaticOrder S; S.init(nrows, DM, G, bx);
            pg8::EpiResGate E{hin_lat, hin_ctx, out, HCTX, mod};
            pg8::gemm_phase<pg8::EpiResGate, pg8::StaticOrder, true, true>(lds, g, S, E);
            SEAM(pb + 5);
        }
    }
#undef IN
#undef SEAM
}
#undef hin_lat
#undef hin_ctx
#undef mod
#undef P
#undef Y
#undef XN
#undef out

extern "C" void kernel_launch(void* const* d_in, const int* in_sizes, int n_in, void* d_out, int out_size, void* d_ws, size_t ws_size, hipStream_t stream) {
    static int grid = 0;
    if (grid == 0) {
        if (n_in != 28 || out_size != NLAT * DM || ws_size < WS_END) { fprintf(stderr, "kernel_launch: unexpected shapes (n_in %d, out %d, ws %zu < %zu); nothing launched\n", n_in, out_size, ws_size, (size_t)WS_END); grid = -1; return; }
        int dev = 0, cus = 0, per_cu = 0;
        if (hipGetDevice(&dev) != hipSuccess || hipDeviceGetAttribute(&cus, hipDeviceAttributeMultiprocessorCount, dev) != hipSuccess) { grid = -1; return; }
        if (hipFuncSetAttribute((const void*)fwd, hipFuncAttributeMaxDynamicSharedMemorySize, LDS_BYTES) != hipSuccess) { fprintf(stderr, "kernel_launch: hipFuncSetAttribute failed\n"); grid = -1; return; }
        if (hipOccupancyMaxActiveBlocksPerMultiprocessor(&per_cu, (const void*)fwd, NWAVES * 64, LDS_BYTES) != hipSuccess || per_cu < 1)
            fprintf(stderr, "kernel_launch: note: occupancy query reports %d workgroups per CU\n", per_cu);
        (void)hipGetLastError();
        grid = cus >= NGRID ? NGRID : -2;
    }
    if (grid == -1) return;
    if (hipMemsetAsync((char*)d_ws + WS_CTL, 0, CTL_ZERO_BYTES, stream) != hipSuccess) { fprintf(stderr, "kernel_launch: memset failed\n"); return; }
    Args a{};
    for (int i = 0; i < 28; ++i) a.in[i] = (const float*)d_in[i];
    a.out = (float*)d_out; a.ws = (unsigned char*)d_ws; a.li = 0; a.pad = 0;
    const bool split = MK_SPLIT || grid == -2;
    if (split) { for (int k = 0; k < NPHASE; ++k) { a.ph_lo = k; a.ph_hi = k + 1; hipLaunchKernelGGL(fwd, dim3(NGRID), dim3(NWAVES * 64), LDS_BYTES, stream, a); } }
    else { a.ph_lo = 0; a.ph_hi = NPHASE; hipLaunchKernelGGL(fwd, dim3(NGRID), dim3(NWAVES * 64), LDS_BYTES, stream, a); }
    const hipError_t le = hipPeekAtLastError();
    if (le != hipSuccess) fprintf(stderr, "kernel_launch: launch failed: %s\n", hipGetErrorName(le));
}
```

```cpp
#include <hip/hip_runtime.h>
#include <cstdio>
#include <cstdint>
#define MK_SPLIT 0
namespace pg8 {
#define PG8_LAS __attribute__((address_space(3)))
typedef unsigned short bf16_t;
typedef short bf16x8 __attribute__((ext_vector_type(8)));
typedef float f32x4 __attribute__((ext_vector_type(4)));
typedef unsigned u32x4 __attribute__((ext_vector_type(4)));
constexpr int BM = 256, BK = 64, HALF = 128, HTB = HALF * BK * 2  , STAGE_BYTES = 8 * HTB, NXCD = 8, WGM = 8;

__host__ __device__ __forceinline__ int lds_byte(int r, int c) { const int st = (r >> 4) * 2 + (c >> 5), rr = r & 15, cc = c & 31, ob = rr * 64 + cc * 2; return st * 1024 + (ob ^ (((ob >> 9) & 1) << 5)); }
__host__ __device__ __forceinline__ void stage_rc(int b, int& R, int& C) { const int st = b / 1024, sb = b % 1024, swz = sb ^ (((sb >> 9) & 1) << 5); R = (st >> 1) * 16 + swz / 64; C = (st & 1) * 32 + (swz % 64) / 2; }
__host__ __device__ __forceinline__ int perm32(int rho) { const int n = rho >> 4, i = rho & 15; return 8 * (i >> 2) + 4 * n + (i & 3); }

struct Unit { int pm, pn; };
struct Gemm { const bf16_t* A; const bf16_t* Bt; int M, N, K; };

struct StaticOrder {
    int nM, nN, nwg, G, c;
    __host__ __device__ void init(int M, int N, int G_, int c_) { nM = M / BM; nN = N / BM; nwg = nM * nN; G = G_; c = c_; }
    __host__ __device__ bool next(int i, Unit& u) const {
        const long L = (long)i * G + c; if (L >= nwg) return false;
        int wgid = (int)L; { const int q = nwg / NXCD, r = nwg % NXCD, xcd = wgid % NXCD, off = wgid / NXCD; wgid = (xcd < r ? xcd * (q + 1) : r * (q + 1) + (xcd - r) * q) + off; }
        const int nig = WGM * nN, gid = wgid / nig, fm = gid * WGM, gsz = (nM - fm) < WGM ? (nM - fm) : WGM;
        u.pm = fm + ((wgid % nig) % gsz); u.pn = (wgid % nig) / gsz; return true;
    }
    __device__ __forceinline__ void a_ready(const Unit&) const {}
    __device__ __forceinline__ void done(const Unit&) const {}
};

__device__ __forceinline__ unsigned cvt_pk_bf16(float lo, float hi) { unsigned r; asm volatile("v_cvt_pk_bf16_f32 %0, %1, %2" : "=v"(r) : "v"(lo), "v"(hi)); return r; }
template <class Epi, class Sched, bool ALIGN_EPI = false, bool SP2 = false>
__device__ __forceinline__ void gemm_phase(PG8_LAS unsigned char* lds, const Gemm g, const Sched& S, const Epi& E) {
    int tid_ = threadIdx.x; asm volatile("" : "+v"(tid_));
    const int tid = tid_, wid = __builtin_amdgcn_readfirstlane(tid >> 6), lane = tid & 63, wr = wid >> 2, wc = wid & 3, fr = lane & 15, fq = lane >> 4;
    const int K = g.K, nt = K / BK;
    unsigned voffA[2], voffB[2];
#pragma unroll
    for (int i = 0; i < 2; ++i) { int R, C; stage_rc(tid * 16 + i * 8192, R, C); const int Rb = Epi::PERM ? ((R & ~31) + perm32(R & 31)) : R;
        voffA[i] = (unsigned)(R * K + C) * 2u; voffB[i] = (unsigned)(Rb * K + C) * 2u; }
    const size_t kstep = (size_t)(BK * 2);
    const size_t hstep = (size_t)HALF * K * 2;
    const size_t tstep = 2 * hstep;
    const unsigned ldsw = (unsigned)wid * 1024u;
    const int aoff = lds_byte(wr * 64 + fr, fq * 8), boff = lds_byte(wc * 32 + fr, fq * 8);
#define PG8_SA(b, h) (((b) * 2 + (h)) * HTB)
#define PG8_SB(b, h) ((4 + (b) * 2 + (h)) * HTB)
#define PG8_STAGE(bufoff, gbase, voff) do { _Pragma("unroll") for (int _i = 0; _i < 2; ++_i) \
        __builtin_amdgcn_global_load_lds((const unsigned*)((const char*)(gbase) + (voff)[_i]), (PG8_LAS unsigned*)(lds + (bufoff) + ldsw + _i * 8192), 16, 0, 0); } while (0)
#define PG8_LDA(dst, b, h) do { _Pragma("unroll") for (int m = 0; m < 4; ++m) _Pragma("unroll") for (int k = 0; k < 2; ++k) dst[m][k] = *(const PG8_LAS bf16x8*)(lds + PG8_SA(b, h) + aoff + m * 2048 + k * 1024); } while (0)
#define PG8_LDB(dst, b, h) do { _Pragma("unroll") for (int n = 0; n < 2; ++n) _Pragma("unroll") for (int k = 0; k < 2; ++k) dst[n][k] = *(const PG8_LAS bf16x8*)(lds + PG8_SB(b, h) + boff + n * 2048 + k * 1024); } while (0)
#define PG8_MMA(ai, bj, At, Bt) do { __builtin_amdgcn_s_setprio(1); _Pragma("unroll") for (int m = 0; m < 4; ++m) _Pragma("unroll") for (int n = 0; n < 2; ++n) _Pragma("unroll") for (int k = 0; k < 2; ++k) \
        acc[ai][bj][m][n] = __builtin_amdgcn_mfma_f32_16x16x32_bf16(Bt[n][k], At[m][k], acc[ai][bj][m][n], 0, 0, 0); __builtin_amdgcn_s_setprio(0); } while (0)
#define PG8_WAIT_V(n) asm volatile("s_waitcnt vmcnt(" #n ")" ::: "memory")
#define PG8_WAIT_L(n) asm volatile("s_waitcnt lgkmcnt(" #n ")" ::: "memory")
#define PG8_BAR __builtin_amdgcn_s_barrier()
#define PG8_SCHED __builtin_amdgcn_sched_barrier(0)
    Unit cur, nxt; int ui = 0;
    if (!S.next(0, cur)) return;
    f32x4 acc[2][2][4][2];
#pragma unroll
    for (int a = 0; a < 2; ++a)
#pragma unroll
        for (int b = 0; b < 2; ++b)
#pragma unroll
            for (int m = 0; m < 4; ++m)
#pragma unroll
                for (int n = 0; n < 2; ++n) acc[a][b][m][n] = (f32x4){0.f, 0.f, 0.f, 0.f};
    bf16x8 At[4][2], B0[2][2], B1[2][2];
    const char* cA = (const char*)g.A + (size_t)cur.pm * tstep; const char* cB = (const char*)g.Bt + (size_t)cur.pn * tstep;
    S.a_ready(cur);
    if constexpr (SP2) {
        PG8_STAGE(PG8_SB(0, 0), cB, voffB); PG8_STAGE(PG8_SB(0, 1), cB + hstep, voffB); PG8_STAGE(PG8_SA(0, 0), cA, voffA); PG8_STAGE(PG8_SA(0, 1), cA + hstep, voffA);
        if (wr == 1) PG8_BAR;
        PG8_WAIT_V(2); PG8_BAR;
        PG8_STAGE(PG8_SB(1, 0), cB + kstep, voffB); PG8_STAGE(PG8_SA(1, 0), cA + kstep, voffA); PG8_STAGE(PG8_SB(1, 1), cB + hstep + kstep, voffB);
        PG8_WAIT_V(6); PG8_BAR;
    } else {
        PG8_STAGE(PG8_SB(0, 0), cB, voffB); PG8_STAGE(PG8_SA(0, 0), cA, voffA); PG8_STAGE(PG8_SB(0, 1), cB + hstep, voffB); PG8_STAGE(PG8_SA(0, 1), cA + hstep, voffA);
        if (wr == 1) PG8_BAR;
        PG8_WAIT_V(4); PG8_BAR;
        PG8_STAGE(PG8_SB(1, 0), cB + kstep, voffB); PG8_STAGE(PG8_SA(1, 0), cA + kstep, voffA); PG8_STAGE(PG8_SB(1, 1), cB + hstep + kstep, voffB);
        PG8_WAIT_V(6); PG8_BAR;
    }
    for (;;) {
        const bool has_next = S.next(ui + 1, nxt);
        const char* nA = has_next ? (const char*)g.A + (size_t)nxt.pm * tstep : cA; const char* nB = has_next ? (const char*)g.Bt + (size_t)nxt.pn * tstep : cB;
        for (int t = 0; t < nt; t += 2) {
            const bool last = (t == nt - 2);
            const char* a1 = cA + (size_t)(t + 1) * kstep;
            const char* a2 = last ? nA : cA + (size_t)(t + 2) * kstep; const char* b2 = last ? nB : cB + (size_t)(t + 2) * kstep;
            const char* a3 = a2 + kstep; const char* b3 = b2 + kstep;
            if (last && has_next) S.a_ready(nxt);
            if constexpr (SP2) {
            PG8_LDB(B0, 0, 0); PG8_LDB(B1, 0, 1); PG8_SCHED; PG8_LDA(At, 0, 0); PG8_STAGE(PG8_SA(1, 1), a1 + hstep, voffA);
            PG8_WAIT_V(8); PG8_WAIT_L(0); PG8_BAR; PG8_MMA(0, 0, At, B0); PG8_MMA(0, 1, At, B1); PG8_BAR; PG8_SCHED;
            PG8_LDA(At, 0, 1); PG8_STAGE(PG8_SB(0, 0), b2, voffB); PG8_STAGE(PG8_SB(0, 1), b2 + hstep, voffB); PG8_STAGE(PG8_SA(0, 0), a2, voffA);
            PG8_WAIT_V(8); PG8_WAIT_L(0); PG8_BAR; PG8_MMA(1, 0, At, B0); PG8_MMA(1, 1, At, B1); PG8_BAR; PG8_SCHED;
            PG8_LDB(B0, 1, 0); PG8_LDB(B1, 1, 1); PG8_SCHED; PG8_LDA(At, 1, 0); PG8_STAGE(PG8_SA(0, 1), a2 + hstep, voffA);
            PG8_WAIT_V(8); PG8_WAIT_L(0); PG8_BAR; PG8_MMA(0, 0, At, B0); PG8_MMA(0, 1, At, B1); PG8_BAR; PG8_SCHED;
            PG8_LDA(At, 1, 1); PG8_STAGE(PG8_SB(1, 0), b3, voffB); PG8_STAGE(PG8_SB(1, 1), b3 + hstep, voffB); PG8_STAGE(PG8_SA(1, 0), a3, voffA);
            PG8_WAIT_V(8); PG8_WAIT_L(0); PG8_BAR; PG8_MMA(1, 0, At, B0); PG8_MMA(1, 1, At, B1); PG8_BAR; PG8_SCHED;
            } else {
            PG8_LDB(B0, 0, 0); PG8_SCHED; PG8_LDA(At, 0, 0); PG8_STAGE(PG8_SA(1, 1), a1 + hstep, voffA);
            PG8_WAIT_L(8); PG8_BAR; PG8_WAIT_L(0); PG8_MMA(0, 0, At, B0); PG8_BAR; PG8_SCHED;
            PG8_LDB(B1, 0, 1); PG8_STAGE(PG8_SB(0, 0), b2, voffB);
            PG8_BAR; PG8_WAIT_L(0); PG8_MMA(0, 1, At, B1); PG8_BAR;
            PG8_LDA(At, 0, 1); PG8_STAGE(PG8_SA(0, 0), a2, voffA);
            PG8_BAR; PG8_WAIT_L(0); PG8_MMA(1, 0, At, B0); PG8_BAR; PG8_SCHED;
            PG8_STAGE(PG8_SB(0, 1), b2 + hstep, voffB);
            PG8_WAIT_V(6); PG8_BAR; PG8_MMA(1, 1, At, B1); PG8_BAR;
            PG8_LDB(B0, 1, 0); PG8_SCHED; PG8_LDA(At, 1, 0); PG8_STAGE(PG8_SA(0, 1), a2 + hstep, voffA);
            PG8_WAIT_L(8); PG8_BAR; PG8_WAIT_L(0); PG8_MMA(0, 0, At, B0); PG8_BAR; PG8_SCHED;
            PG8_LDB(B1, 1, 1); PG8_STAGE(PG8_SB(1, 0), b3, voffB);
            PG8_BAR; PG8_WAIT_L(0); PG8_MMA(0, 1, At, B1); PG8_BAR;
            PG8_LDA(At, 1, 1); PG8_STAGE(PG8_SA(1, 0), a3, voffA);
            PG8_BAR; PG8_WAIT_L(0); PG8_MMA(1, 0, At, B0); PG8_BAR; PG8_SCHED;
            PG8_STAGE(PG8_SB(1, 1), b3 + hstep, voffB);
            PG8_WAIT_V(6); PG8_BAR; PG8_MMA(1, 1, At, B1); PG8_BAR;
            }
        }
        if constexpr (ALIGN_EPI) { if (wr == 0) PG8_BAR; }
        if constexpr (!Epi::AFTER_DRAIN) { E(acc, cur, wr, wc, fr, fq); S.done(cur); }
        if (!has_next) break;
#pragma unroll
        for (int a = 0; a < 2; ++a)
#pragma unroll
            for (int b = 0; b < 2; ++b)
#pragma unroll
                for (int m = 0; m < 4; ++m)
#pragma unroll
                    for (int n = 0; n < 2; ++n) acc[a][b][m][n] = (f32x4){0.f, 0.f, 0.f, 0.f};
        cur = nxt; cA = nA; cB = nB; ++ui;
        if constexpr (ALIGN_EPI) { if (wr == 1) PG8_BAR; }
    }
    PG8_WAIT_V(0);
    if constexpr (!ALIGN_EPI) { if (wr == 0) PG8_BAR; }
    PG8_BAR;
    if constexpr (Epi::AFTER_DRAIN) { E.fused(acc, cur, wr, wc, fr, fq, lds, wid, lane); S.done(cur); }
#undef PG8_SA
#undef PG8_SB
#undef PG8_STAGE
#undef PG8_LDA
#undef PG8_LDB
#undef PG8_MMA
#undef PG8_WAIT_V
#undef PG8_WAIT_L
#undef PG8_BAR
#undef PG8_SCHED
}
}

constexpr int DM = 4096, NBATCH = 2, SEQ = 8192, DEPTH = 4, CTXL = 256;
constexpr int NLAT = NBATCH * SEQ, NCTX = NBATCH * CTXL, MROWS = NLAT + NCTX;
constexpr int NIN = 13568, GWD = 1024;
constexpr int C_POOLV = 0, C_POOLZ = 1024, C_NAZ = 2048, C_RWZ = 3072, C_SGU = 4096, C_SGZ = 5120, C_NAQ = 6144, C_NAK = 7168, C_NAV = 8192, C_RWR = 9216, C_RWK = 10240, C_RWV = 11264,
              C_RWWD = 12288, C_RWAD = 12416, C_SGV = 12544;
constexpr int C_SPLIT = 5632;
__host__ __device__ __forceinline__ int phys_tile(int lt) {
    return lt < 8 ? lt : lt < 20 ? lt + 16 : lt < 24 ? lt - 12 : lt < 36 ? lt + 12 : lt < 40 ? lt - 24 : lt == 40 ? 48 : lt < 45 ? lt - 25 : lt < 49 ? lt + 4 : lt - 29;
}
constexpr int SCANLEN = CTXL + SEQ;
constexpr int NCHAIN = 64;
constexpr int RECB = 768;
constexpr int RECF = RECB / 4;
constexpr int NWAVES = 8;

constexpr size_t MiB = 1u << 20;
constexpr size_t WS_CTL = 0, CTL_ZERO_BYTES = 1 * MiB;
constexpr size_t WS_MOD   = 2 * MiB;
constexpr size_t WS_TAB   = 3 * MiB;
constexpr size_t WS_SILUC = 3 * MiB + 512 * 1024;
constexpr size_t WS_SGST  = 4 * MiB;
constexpr size_t WS_BON   = 5 * MiB;
constexpr size_t WS_POOLWT= 8 * MiB;
constexpr size_t WS_WUPT  = 10 * MiB;
constexpr size_t WS_AUPT  = 11 * MiB;
constexpr size_t WS_SGW   = 12 * MiB;
constexpr size_t WS_VTC   = 13 * MiB;
constexpr size_t WS_HCTX  = 14 * MiB;
constexpr size_t WS_MODP  = 22 * MiB;
constexpr size_t WS_VTL   = 58 * MiB;
constexpr size_t WS_QN    = 90 * MiB;
constexpr size_t WS_KN    = 123 * MiB;
constexpr size_t WS_WOUTT = 156 * MiB;
constexpr size_t WS_WINT  = 284 * MiB;
constexpr size_t WS_XN    = 708 * MiB;
constexpr size_t WS_Y     = 840 * MiB;
constexpr size_t WS_P     = 972 * MiB;
constexpr size_t WS_YR    = 1410 * MiB;
constexpr size_t WS_REC   = 1542 * MiB;
constexpr size_t WS_END   = 2334 * MiB;
static_assert(WS_P + (size_t)MROWS * NIN * 2 <= WS_YR && WS_REC + (size_t)NCHAIN * SCANLEN * RECB <= WS_END && WS_WINT + (size_t)4 * NIN * DM * 2 <= WS_XN, "ws map");
constexpr int CW_TMO = 0, CW_BAR = 4096;

constexpr int RING_BYTES = 131072, SCANRING_BYTES = 4 * 32 * RECB, SGUT_OFF = SCANRING_BYTES, LDSCTL_OFF = SGUT_OFF + 128 * 136 * 2, MISC_OFF = LDSCTL_OFF + 320, LDS_BYTES = LDSCTL_OFF + 1024;

#define GAS __attribute__((address_space(1)))
#define LAS __attribute__((address_space(3)))
typedef unsigned short bf16;
typedef unsigned v4u __attribute__((ext_vector_type(4)));
typedef unsigned v2u __attribute__((ext_vector_type(2)));
typedef float f32x4 __attribute__((ext_vector_type(4)));
typedef float f32x2 __attribute__((ext_vector_type(2)));
typedef short bf16x8 __attribute__((ext_vector_type(8)));
typedef _Float16 h4 __attribute__((ext_vector_type(4)));
typedef _Float16 h8 __attribute__((ext_vector_type(8)));
#define RLX_AGENT __ATOMIC_RELAXED, __HIP_MEMORY_SCOPE_AGENT
#define LDS_WAIT() asm volatile("s_waitcnt lgkmcnt(0)" ::: "memory")

__device__ __forceinline__ float bf2f(unsigned short h) { return __uint_as_float(((unsigned)h) << 16); }
__device__ __forceinline__ float bflo(unsigned w) { return __uint_as_float(w << 16); }
__device__ __forceinline__ float bfhi(unsigned w) { return __uint_as_float(w & 0xffff0000u); }
typedef __bf16 bf16x2_t __attribute__((ext_vector_type(2)));
__device__ __forceinline__ unsigned pk2(float lo, float hi) { const f32x2 v = {lo, hi}; const bf16x2_t b = __builtin_convertvector(v, bf16x2_t); return __builtin_bit_cast(unsigned, b); }
__device__ __forceinline__ unsigned f2bf(float f) { return pk2(f, 0.f) & 0xffffu; }
__device__ __forceinline__ float rcp_f(float x) { return __builtin_amdgcn_rcpf(x); }
__device__ __forceinline__ float rsq_f(float x) { return __builtin_amdgcn_rsqf(x); }
__device__ __forceinline__ void unpack8(const v4u w, float* x) { x[0] = bflo(w.x); x[1] = bfhi(w.x); x[2] = bflo(w.y); x[3] = bfhi(w.y); x[4] = bflo(w.z); x[5] = bfhi(w.z); x[6] = bflo(w.w); x[7] = bfhi(w.w); }
__device__ __forceinline__ v4u pack8(const float* x) { v4u w; w.x = pk2(x[0], x[1]); w.y = pk2(x[2], x[3]); w.z = pk2(x[4], x[5]); w.w = pk2(x[6], x[7]); return w; }
__device__ __forceinline__ float silu_f(float x) { return x * rcp_f(1.f + __expf(-x)); }
__device__ __forceinline__ float wave_sum(float v) {
#pragma unroll
    for (int o = 1; o < 64; o <<= 1) v += __shfl_xor(v, o);
    return v;
}
template <int CTRL> __device__ __forceinline__ float dppf(float v) { return __builtin_bit_cast(float, __builtin_amdgcn_update_dpp(0, __builtin_bit_cast(int, v), CTRL, 0xF, 0xF, true)); }
__device__ __forceinline__ float red16(float v) { v += dppf<0xB1>(v); v += dppf<0x4E>(v); v += dppf<0x141>(v); v += dppf<0x140>(v); return v; }
__device__ __forceinline__ void red16x2(float& a, float& b) {
    a += dppf<0xB1>(a); b += dppf<0xB1>(b); a += dppf<0x4E>(a); b += dppf<0x4E>(b); a += dppf<0x141>(a); b += dppf<0x141>(b); a += dppf<0x140>(a); b += dppf<0x140>(b); }
__device__ __forceinline__ float red16_transpose(const float (&y)[16], int c16) {
    float a[8], b[4], c[2];
    const bool h8 = (c16 & 8) != 0, h4 = (c16 & 4) != 0, h2 = (c16 & 2) != 0, h1 = (c16 & 1) != 0;
#pragma unroll
    for (int j = 0; j < 8; ++j) { const float keep = h8 ? y[j + 8] : y[j], send = h8 ? y[j] : y[j + 8]; a[j] = keep + dppf<0x140>(send); }
#pragma unroll
    for (int j = 0; j < 4; ++j) { const float keep = h4 ? a[j + 4] : a[j], send = h4 ? a[j] : a[j + 4]; b[j] = keep + dppf<0x141>(send); }
#pragma unroll
    for (int j = 0; j < 2; ++j) { const float keep = h2 ? b[j + 2] : b[j], send = h2 ? b[j] : b[j + 2]; c[j] = keep + dppf<0x1B>(send); }
    const float keep = h1 ? c[1] : c[0], send = h1 ? c[0] : c[1];
    return keep + dppf<0xB1>(send);
}
__device__ __forceinline__ float max16x4(float v) { v = fmaxf(v, __shfl_xor(v, 16)); v = fmaxf(v, __shfl_xor(v, 32)); return v; }
__device__ __forceinline__ float sum16x4(float v) { v += __shfl_xor(v, 16); v += __shfl_xor(v, 32); return v; }
__device__ __forceinline__ int scan_pos(int d, bool isctx, int t) { return d == 0 ? (isctx ? t : CTXL + t) : (isctx ? (CTXL - 1 - t) : (CTXL + SEQ - 1 - t)); }
__device__ __forceinline__ f32x4 mfma16(bf16x8 a, bf16x8 b, f32x4 c) { return __builtin_amdgcn_mfma_f32_16x16x32_bf16(a, b, c, 0, 0, 0); }
__device__ __forceinline__ bf16x8 ld_frag(const bf16* p) { return __builtin_bit_cast(bf16x8, *(const v4u*)p); }

namespace pg8 {
struct EpiStoreBf16 {
    static constexpr bool PERM = true, AFTER_DRAIN = false;
    bf16_t* O; int ldc;
    __device__ __forceinline__ void operator()(const f32x4 (&acc)[2][2][4][2], const Unit& u, int wr, int wc, int fr, int fq) const {
        const int row0 = u.pm * BM + wr * 64 + fr, col0 = u.pn * BM + wc * 32 + 8 * fq;
#pragma unroll
        for (int ai = 0; ai < 2; ++ai)
#pragma unroll
            for (int m = 0; m < 4; ++m) { bf16_t* rowp = O + (size_t)(row0 + ai * HALF + m * 16) * ldc + col0;
#pragma unroll
                for (int bj = 0; bj < 2; ++bj) { const f32x4 v0 = acc[ai][bj][m][0], v1 = acc[ai][bj][m][1];
                    u32x4 w; w.x = cvt_pk_bf16(v0[0], v0[1]); w.y = cvt_pk_bf16(v0[2], v0[3]); w.z = cvt_pk_bf16(v1[0], v1[1]); w.w = cvt_pk_bf16(v1[2], v1[3]);
                    *(u32x4*)(rowp + bj * HALF) = w; } }
    }
};
struct EpiResGate {
    static constexpr bool PERM = false, AFTER_DRAIN = false;
    const float* hin_lat; const float* hin_ctx; float* hout_lat; float* hout_ctx; const float* gate;
    __device__ __forceinline__ void operator()(const f32x4 (&acc)[2][2][4][2], const Unit& u, int wr, int wc, int fr, int fq) const {
        const int cond = u.pm < 32 ? 0 : (u.pm < 64 ? 1 : 2);
        const int rloc = (u.pm < 64 ? u.pm * BM : (u.pm - 64) * BM) + wr * 64 + fr, col0 = u.pn * BM + wc * 32 + 4 * fq;
        const float* hin = u.pm < 64 ? hin_lat : hin_ctx; float* hout = u.pm < 64 ? hout_lat : hout_ctx;
        f32x4 gv[2][2];
#pragma unroll
        for (int bj = 0; bj < 2; ++bj)
#pragma unroll
            for (int n = 0; n < 2; ++n) gv[bj][n] = *(const f32x4*)(gate + cond * 12288 + 8192 + col0 + bj * HALF + n * 16);
#pragma unroll
        for (int ai = 0; ai < 2; ++ai)
#pragma unroll
            for (int m = 0; m < 4; ++m) { const size_t off = (size_t)(rloc + ai * HALF + m * 16) * 4096 + col0;
#pragma unroll
                for (int bj = 0; bj < 2; ++bj)
#pragma unroll
                    for (int n = 0; n < 2; ++n) { const f32x4 b = *(const f32x4*)(hin + off + bj * HALF + n * 16);
                        *(f32x4*)(hout + off + bj * HALF + n * 16) = b + gv[bj][n] * acc[ai][bj][m][n]; } }
    }
};
}

template <bool PERMC = false>
__device__ __forceinline__ void p0_transpose_item(const float* W, int K, int N, bf16* WT, LAS float* scr, int item, int lane) {
    const int nblk = N / 32, kb = item / nblk, nb = item % nblk, k0 = 64 * kb, n0 = 32 * nb;
    const int pn0 = PERMC ? phys_tile(n0 >> 8) * 256 + (n0 & 255) : n0;
#pragma unroll 8
    for (int i = 0; i < 32; ++i) { const int kk = 2 * i + (lane >> 5); scr[kk * 33 + (lane & 31)] = W[(size_t)(k0 + kk) * N + n0 + (lane & 31)]; }
    LDS_WAIT(); asm volatile("" ::: "memory");
    const int c = lane & 7;
#pragma unroll
    for (int j = 0; j < 4; ++j) { const int n = (lane >> 3) + 8 * j; const LAS float* s = scr + (8 * c) * 33 + n;
        v4u o; o.x = pk2(s[0 * 33], s[1 * 33]); o.y = pk2(s[2 * 33], s[3 * 33]); o.z = pk2(s[4 * 33], s[5 * 33]); o.w = pk2(s[6 * 33], s[7 * 33]);
        *(v4u*)(WT + (size_t)(pn0 + n) * K + k0 + 8 * c) = o; }
    LDS_WAIT(); asm volatile("" ::: "memory");
}
template <bool PERMC = false>
__device__ __forceinline__ void transpose_item_nolds(const float* W, int K, int N, bf16* WT, int item, int lane) {
    const int nblk = N / 64, kb = item / nblk, nb = item % nblk, k0 = 64 * kb, n0 = 64 * nb;
    const int pn0 = PERMC ? phys_tile(n0 >> 8) * 256 + (n0 & 255) : n0;
    const float* src = W + (size_t)k0 * N + n0 + lane;
    bf16* dst = WT + (size_t)(pn0 + lane) * K + k0;
#pragma unroll
    for (int hb = 0; hb < 2; ++hb) {
        float v[32];
#pragma unroll
        for (int i = 0; i < 32; ++i) v[i] = __builtin_nontemporal_load(src + (size_t)(32 * hb + i) * N);
        __builtin_amdgcn_sched_barrier(0);
#pragma unroll
        for (int j = 0; j < 4; ++j) { v4u o; o.x = pk2(v[8 * j], v[8 * j + 1]); o.y = pk2(v[8 * j + 2], v[8 * j + 3]); o.z = pk2(v[8 * j + 4], v[8 * j + 5]); o.w = pk2(v[8 * j + 6], v[8 * j + 7]);
            *(v4u*)(dst + 32 * hb + 8 * j) = o; }
        __builtin_amdgcn_sched_barrier(0);
    }
}
constexpr int WC_WIN = (DM / 64) * (NIN / 64), WC_WOUT = (DM / 64) * (DM / 64), WC_POOL = 4 * 16, WC_WUP = 2 * 16, WC_AUP = 2 * 16, WC_SGW = 256, WC_ITEMS = WC_WIN + WC_WOUT + WC_POOL + WC_WUP + WC_AUP + WC_SGW;
__device__ __forceinline__ void weight_copy_item(int L, int r, const float* w_in, const float* w_out, const float* pool_w, const float* rw_w_up, const float* rw_a_up, const float* sg_w,
                                                 bf16* WINT, bf16* WOUTT, bf16* POOLWT, bf16* WUPT, bf16* AUPT, bf16* SGW, int lane) {
    if (r < WC_WIN) { transpose_item_nolds<true>(w_in + (size_t)L * DM * NIN, DM, NIN, WINT + (size_t)L * NIN * DM, r, lane); return; } r -= WC_WIN;
    if (r < WC_WOUT) { transpose_item_nolds(w_out + (size_t)L * DM * DM, DM, DM, WOUTT + (size_t)L * DM * DM, r, lane); return; } r -= WC_WOUT;
    if (r < WC_POOL) { const int g = r >> 4; transpose_item_nolds(pool_w + (size_t)(L * 4 + g) * 65536, 256, 256, POOLWT + (size_t)(L * 4 + g) * 65536, r & 15, lane); return; } r -= WC_POOL;
    if (r < WC_WUP) { const int dd = r >> 4; transpose_item_nolds(rw_w_up + (size_t)(L * 2 + dd) * 65536, 64, 1024, WUPT + (size_t)(L * 2 + dd) * 65536, r & 15, lane); return; } r -= WC_WUP;
    if (r < WC_AUP) { const int dd = r >> 4; transpose_item_nolds(rw_a_up + (size_t)(L * 2 + dd) * 65536, 64, 1024, AUPT + (size_t)(L * 2 + dd) * 65536, r & 15, lane); return; } r -= WC_AUP;
    {   const size_t e0 = (size_t)L * 131072 + (size_t)r * 512 + lane * 8; const f32x4 a = *(const f32x4*)(sg_w + e0), b = *(const f32x4*)(sg_w + e0 + 4);
        v4u o; o.x = pk2(a.x, a.y); o.y = pk2(a.z, a.w); o.z = pk2(b.x, b.y); o.w = pk2(b.z, b.w); *(v4u*)(SGW + e0) = o; }
}
__device__ __forceinline__ void p0_mod_item(const float* wmod, const float* cvec, const float* cctx, float* MODP, LAS float* scr, int item, int lane) {
    const int l = item / (64 * 48), r = item % (64 * 48), kc = r / 48, nc = r % 48, k0 = kc * 64, n0 = nc * 256 + lane * 4;
    scr[lane] = silu_f(cvec[k0 + lane]); scr[64 + lane] = silu_f(cvec[4096 + k0 + lane]); scr[128 + lane] = silu_f(cctx[k0 + lane]);
    LDS_WAIT(); asm volatile("" ::: "memory");
    f32x4 a0 = {0.f, 0.f, 0.f, 0.f}, a1 = a0, a2 = a0;
    const float* wp = wmod + ((size_t)l * 4096 + k0) * 12288 + n0;
#pragma unroll 16
    for (int k = 0; k < 64; ++k) { const f32x4 w = *(const f32x4*)(wp + (size_t)k * 12288); a0 += scr[k] * w; a1 += scr[64 + k] * w; a2 += scr[128 + k] * w; }
    float* o = MODP + ((size_t)(l * 64 + kc) * 3) * 12288 + n0;
    *(f32x4*)(o) = a0; *(f32x4*)(o + 12288) = a1; *(f32x4*)(o + 2 * 12288) = a2;
    LDS_WAIT(); asm volatile("" ::: "memory");
}
__device__ __forceinline__ void mod_item_nolds(const float* wmod_l  , const float* siluc, float* MODP_l  , int item, int lane) {
    const int kc = item / 48, nc = item % 48, k0 = kc * 64, n0 = nc * 256 + lane * 4;
    f32x4 a0 = {0.f, 0.f, 0.f, 0.f}, a1 = a0, a2 = a0;
    const float* wp = wmod_l + (size_t)k0 * 12288 + n0;
    const int s0v = __builtin_bit_cast(int, siluc[k0 + lane]), s1v = __builtin_bit_cast(int, siluc[4096 + k0 + lane]), s2v = __builtin_bit_cast(int, siluc[8192 + k0 + lane]);
#pragma unroll
    for (int k = 0; k < 64; ++k) { const f32x4 w = __builtin_nontemporal_load((const f32x4*)(wp + (size_t)k * 12288));
        a0 += __builtin_bit_cast(float, __builtin_amdgcn_readlane(s0v, k)) * w; a1 += __builtin_bit_cast(float, __builtin_amdgcn_readlane(s1v, k)) * w; a2 += __builtin_bit_cast(float, __builtin_amdgcn_readlane(s2v, k)) * w; }
    float* o = MODP_l + ((size_t)kc * 3) * 12288 + n0;
    *(f32x4*)(o) = a0; *(f32x4*)(o + 12288) = a1; *(f32x4*)(o + 2 * 12288) = a2;
}
__device__ __forceinline__ void sincos_acc(float ang, float& c, float& s) {
    const double x = (double)ang; const double n = __builtin_rint(x * 0.63661977236758134308); const double r = x - n * 1.57079632679489661923;
    const double r2 = r * r;
    const double sp = r * (1.0 + r2 * (-1.0 / 6 + r2 * (1.0 / 120 + r2 * (-1.0 / 5040 + r2 * (1.0 / 362880 + r2 * (-1.0 / 39916800 + r2 * (1.0 / 6227020800.0)))))));
    const double cp = 1.0 + r2 * (-0.5 + r2 * (1.0 / 24 + r2 * (-1.0 / 720 + r2 * (1.0 / 40320 + r2 * (-1.0 / 3628800 + r2 * (1.0 / 479001600 + r2 * (-1.0 / 87178291200.0)))))));
    const int q = ((int)n) & 3;
    const double cc = (q == 0) ? cp : (q == 1) ? -sp : (q == 2) ? -cp : sp;
    const double ss = (q == 0) ? sp : (q == 1) ? cp : (q == 2) ? -sp : -cp;
    c = (float)cc; s = (float)ss;
}

__device__ __forceinline__ void phase_xn(const float* hlat, const float* hctx, const float* mod, bf16* XN, int gw, int NGW, int lane) {
    for (int m = gw; m < MROWS; m += NGW) {
        const float* src = m < NLAT ? hlat + (size_t)m * DM : hctx + (size_t)(m - NLAT) * DM;
        const int cond = m < NLAT ? (m >> 13) : 2;
        const f32x4* s4 = (const f32x4*)src + lane;
        f32x4 v[16]; float ss = 0.f;
#pragma unroll
        for (int j = 0; j < 16; ++j) { v[j] = __builtin_nontemporal_load(s4 + 64 * j); ss += (v[j].x * v[j].x + v[j].y * v[j].y) + (v[j].z * v[j].z + v[j].w * v[j].w); }
        ss = wave_sum(ss);
        const float rstd = rsq_f(ss * (1.f / 4096.f) + 1e-6f);
        const f32x4* sh4 = (const f32x4*)(mod + cond * 12288) + lane; const f32x4* sc4 = (const f32x4*)(mod + cond * 12288 + 4096) + lane;
        v2u* o = (v2u*)(XN + (size_t)m * DM) + lane;
#pragma unroll
        for (int j = 0; j < 16; ++j) { const f32x4 sh = sh4[64 * j], sc = sc4[64 * j]; const f32x4 x = v[j] * rstd * (sc + 1.f) + sh; v2u w; w.x = pk2(x.x, x.y); w.y = pk2(x.z, x.w); o[64 * j] = w; }
    }
}

__device__ __forceinline__ void phase_rowprep(const bf16* P, const float* qgain, const float* kgain, const f32x2* tab, bf16* QN, bf16* KN, f32x2* SGST, int gw, int NGW, int lane) {
    const int sub = lane & 3;
    for (int m = gw; m < MROWS; m += NGW) {
        const bf16* pr = P + (size_t)m * NIN;
        const bool isctx = m >= NLAT; const int t = isctx ? ((m - NLAT) & 255) : (m & 8191);
        {   float x[16]; unpack8(*(const v4u*)(pr + C_SGV + 16 * lane), x); unpack8(*(const v4u*)(pr + C_SGV + 16 * lane + 8), x + 8);
            float s = 0.f;
#pragma unroll
            for (int i = 0; i < 16; ++i) s += x[i];
            const float mean = wave_sum(s) * (1.f / 1024.f); float q = 0.f;
#pragma unroll
            for (int i = 0; i < 16; ++i) { const float dlt = x[i] - mean; q += dlt * dlt; }
            const float var = wave_sum(q) * (1.f / 1024.f);
            if (lane == 0) SGST[m] = (f32x2){mean, rsq_f(var + 1e-5f)}; }
        float q[16], k[16];
        unpack8(*(const v4u*)(pr + C_NAQ + 16 * lane), q); unpack8(*(const v4u*)(pr + C_NAQ + 16 * lane + 8), q + 8);
        unpack8(*(const v4u*)(pr + C_NAK + 16 * lane), k); unpack8(*(const v4u*)(pr + C_NAK + 16 * lane + 8), k + 8);
        float sq = 0.f, sk = 0.f;
#pragma unroll
        for (int i = 0; i < 16; ++i) { sq += q[i] * q[i]; sk += k[i] * k[i]; }
        sq += __shfl_xor(sq, 1); sq += __shfl_xor(sq, 2); sk += __shfl_xor(sk, 1); sk += __shfl_xor(sk, 2);
        const float rq = rsq_f(sq * (1.f / 64.f) + 1e-6f), rk = rsq_f(sk * (1.f / 64.f) + 1e-6f);
#pragma unroll
        for (int i = 0; i < 16; ++i) { q[i] *= rq * qgain[16 * sub + i]; k[i] *= rk * kgain[16 * sub + i]; }
        if (!isctx) {
            const int pos = sub < 2 ? (t >> 6) : (t & 63);
#pragma unroll
            for (int i = 0; i < 16; ++i) { const f32x2 cs = tab[pos * 16 + i]; const float pq = __shfl_xor(q[i], 1), pkk = __shfl_xor(k[i], 1);
                q[i] = (sub & 1) ? (q[i] * cs.x + pq * cs.y) : (q[i] * cs.x - pq * cs.y);
                k[i] = (sub & 1) ? (k[i] * cs.x + pkk * cs.y) : (k[i] * cs.x - pkk * cs.y); }
        }
#pragma unroll
        for (int i = 0; i < 16; ++i) q[i] *= 0.125f;
        *(v4u*)(QN + (size_t)m * GWD + 16 * lane) = pack8(q); *(v4u*)(QN + (size_t)m * GWD + 16 * lane + 8) = pack8(q + 8);
        *(v4u*)(KN + (size_t)m * GWD + 16 * lane) = pack8(k); *(v4u*)(KN + (size_t)m * GWD + 16 * lane + 8) = pack8(k + 8);
    }
}
__device__ __forceinline__ void phase_vt(const bf16* P, bf16* VTL, bf16* VTC, int gw, int NGW, int lane) {
    for (int u = gw; u < (MROWS / 64) * 16; u += NGW) {
        const int tt = u >> 4, h = u & 15, m0 = tt * 64;
        const bf16* src = P + (size_t)m0 * NIN + C_NAV + h * 64 + lane;
        unsigned w[32];
#pragma unroll
        for (int i = 0; i < 32; ++i) { const unsigned lo = src[(size_t)(2 * i) * NIN], hi = src[(size_t)(2 * i + 1) * NIN]; w[i] = lo | (hi << 16); }
        bf16* dst = tt < 256 ? VTL + (((size_t)((tt >> 7) * 16 + h) * 64 + lane) * 8192 + (tt & 127) * 64)
                             : VTC + (((size_t)(((tt - 256) >> 2) * 16 + h) * 64 + lane) * 256 + ((tt - 256) & 3) * 64);
#pragma unroll
        for (int j = 0; j < 8; ++j) { v4u o; o.x = w[4 * j]; o.y = w[4 * j + 1]; o.z = w[4 * j + 2]; o.w = w[4 * j + 3]; ((v4u*)dst)[j] = o; }
    }
}
template <int G>
__device__ __forceinline__ void pool_unit(const bf16* P, const bf16* wbase, const float* pscale, bf16* Y, int m0, int lane) {
    constexpr int WIN = 2 << G;
    const int r = lane & 15, q4 = lane >> 4, m = m0 + r;
    const bool isctx = m0 >= NLAT; const int T = isctx ? CTXL : SEQ; const int t = isctx ? ((m - NLAT) & 255) : (m & 8191);
    const int tlo = t - (WIN >> 1);
    const int lo = tlo < 0 ? 0 : tlo, hi = (tlo + WIN) > T ? T : (tlo + WIN);
    const float inv = rcp_f((float)(hi - lo));
    f32x4 acc[16];
#pragma unroll
    for (int nt = 0; nt < 16; ++nt) acc[nt] = (f32x4){0.f, 0.f, 0.f, 0.f};
#pragma unroll 1
    for (int ks = 0; ks < 8; ++ks) {
        const int ch0 = C_POOLV + G * 256 + 32 * ks + 8 * q4;
        constexpr int WB = WIN < 8 ? WIN : 8;
        bf16x8 bfr[8];
        float sum[8];
#pragma unroll
        for (int j = 0; j < 8; ++j) sum[j] = 0.f;
        const v4u selfw = *(const v4u*)(P + (size_t)m * NIN + ch0);
#pragma unroll
        for (int nt = 0; nt < 8; ++nt) bfr[nt] = ld_frag(wbase + (size_t)(16 * nt + r) * 256 + 32 * ks + 8 * q4);
        bf16x8 bfr2[8];
#pragma unroll
        for (int nt = 0; nt < 8; ++nt) bfr2[nt] = ld_frag(wbase + (size_t)(16 * (nt + 8) + r) * 256 + 32 * ks + 8 * q4);
#pragma unroll
        for (int k0 = 0; k0 < WIN; k0 += WB) {
            v4u wl[WB];
#pragma unroll
            for (int k = 0; k < WB; ++k) { const int tk = tlo + k0 + k; const bool ok = tk >= 0 && tk < T; wl[k] = *(const v4u*)(P + (size_t)(ok ? (m - t + tk) : m) * NIN + ch0); }
            __builtin_amdgcn_sched_barrier(0);
#pragma unroll
            for (int k = 0; k < WB; ++k) { const int tk = tlo + k0 + k; const bool ok = tk >= 0 && tk < T; float x[8]; unpack8(wl[k], x);
#pragma unroll
                for (int j = 0; j < 8; ++j) sum[j] += ok ? x[j] : 0.f; }
            __builtin_amdgcn_sched_barrier(0);
        }
        float self[8]; unpack8(selfw, self);
        float dv[8];
#pragma unroll
        for (int j = 0; j < 8; ++j) dv[j] = sum[j] * inv - self[j];
        const bf16x8 af = __builtin_bit_cast(bf16x8, pack8(dv));
        __builtin_amdgcn_sched_barrier(0);
#pragma unroll
        for (int nt = 0; nt < 8; ++nt) acc[nt] = mfma16(af, bfr[nt], acc[nt]);
        __builtin_amdgcn_sched_barrier(0);
#pragma unroll
        for (int nt = 0; nt < 8; ++nt) acc[nt + 8] = mfma16(af, bfr2[nt], acc[nt + 8]);
        __builtin_amdgcn_sched_barrier(0);
    }
#pragma unroll
    for (int nh = 0; nh < 4; ++nh) {
        unsigned short zz[4][4]; float ps[4];
#pragma unroll
        for (int nq = 0; nq < 4; ++nq) { const int oc = G * 256 + 16 * (4 * nh + nq) + r; ps[nq] = pscale[oc];
#pragma unroll
            for (int i = 0; i < 4; ++i) zz[nq][i] = P[(size_t)(m0 + 4 * q4 + i) * NIN + C_POOLZ + oc]; }
        __builtin_amdgcn_sched_barrier(0);
#pragma unroll
        for (int nq = 0; nq < 4; ++nq) { const int oc = G * 256 + 16 * (4 * nh + nq) + r;
#pragma unroll
            for (int i = 0; i < 4; ++i) Y[(size_t)(m0 + 4 * q4 + i) * DM + oc] = (bf16)f2bf(acc[4 * nh + nq][i] * ps[nq] * silu_f(bf2f(zz[nq][i]))); }
        __builtin_amdgcn_sched_barrier(0);
    }
}
__device__ __forceinline__ void phase_pool(const bf16* P, const bf16* PWT  , const float* pscale, bf16* Y, int nrows, int gw, int NGW, int lane) {
    for (int u = gw; u < (nrows / 16) * 4; u += NGW) {
        const int tt = u >> 2, g = u & 3, m0 = tt * 16;
        const bf16* wbase = PWT + (size_t)g * 65536;
        if (g == 0) pool_unit<0>(P, wbase, pscale, Y, m0, lane);
        else if (g == 1) pool_unit<1>(P, wbase, pscale, Y, m0, lane);
        else if (g == 2) pool_unit<2>(P, wbase, pscale, Y, m0, lane);
        else pool_unit<3>(P, wbase, pscale, Y, m0, lane);
    }
}
#define REC_ST(p, v) __builtin_nontemporal_store((v), (p))
__device__ __forceinline__ void phase_rwprep(const bf16* P, const float* mu_rkv  , const float* mu_lora  , const float* w0  , const bf16* WUPT  ,
                                             const float* a0, const bf16* AUPT, const float* k_k, const float* k_a, const float* r_k, float* REC, float* BON, LAS unsigned char* lds,
                                             unsigned* queue  , int cls, int wave, int lane) {
    const int n = lane & 15, q4 = lane >> 4;
    const int d = cls >> 3, hp = cls & 7;
    unsigned* qh = queue + 64 * cls;
    LAS float* prm = (LAS float*)(lds + wave * 4096);
#pragma unroll
    for (int it = 0; it < 16; ++it) { const int hh = it >> 3, p = it & 7, ch = (hp * 2 + hh) * 64 + lane;
        const float* src = p == 0 ? w0 + d * 1024 : p == 1 ? a0 + d * 1024 : p == 2 ? mu_rkv + (d * 3 + 0) * 1024 : p == 3 ? mu_rkv + (d * 3 + 1) * 1024 : p == 4 ? mu_rkv + (d * 3 + 2) * 1024 : p == 5 ? k_k : p == 6 ? k_a : r_k;
        prm[it * 64 + lane] = src[ch]; }
    LDS_WAIT(); asm volatile("" ::: "memory");
    unsigned pend = 0u;
    if (lane == 0) pend = __hip_atomic_fetch_add(qh, 1u, __ATOMIC_RELAXED, __HIP_MEMORY_SCOPE_AGENT);
    for (;;) {
        const int tt = __builtin_amdgcn_readfirstlane((int)pend);
        if (tt >= MROWS / 16) break;
        if (lane == 0) pend = __hip_atomic_fetch_add(qh, 1u, __ATOMIC_RELAXED, __HIP_MEMORY_SCOPE_AGENT);
        const int m0 = tt * 16;
        const bool isctx = m0 >= NLAT; const int T = isctx ? CTXL : SEQ; const int t0 = isctx ? ((m0 - NLAT) & 255) : (m0 & 8191); const int b = isctx ? ((m0 - NLAT) >> 8) : (m0 >> 13);
        const int m = m0 + n, t = t0 + n; const bool hasnb = d == 0 ? (t > 0) : (t < T - 1); const int nbr = hasnb ? (d == 0 ? m - 1 : m + 1) : m;
        const bf16* prow = P + (size_t)m * NIN; const bf16* nrow = P + (size_t)nbr * NIN;
        bf16x8 Bw[2], Ba[2];
        {   v4u cw[2], nw[2], ca[2], na[2]; f32x4 mw[2][2], ma[2][2];
#pragma unroll
            for (int ks = 0; ks < 2; ++ks) { const int j0 = 32 * ks + 8 * q4;
                cw[ks] = *(const v4u*)(prow + C_RWWD + d * 64 + j0); nw[ks] = *(const v4u*)(nrow + C_RWWD + d * 64 + j0);
                ca[ks] = *(const v4u*)(prow + C_RWAD + d * 64 + j0); na[ks] = *(const v4u*)(nrow + C_RWAD + d * 64 + j0);
                mw[ks][0] = *(const f32x4*)(mu_lora + (d * 2 + 0) * 64 + j0); mw[ks][1] = *(const f32x4*)(mu_lora + (d * 2 + 0) * 64 + j0 + 4);
                ma[ks][0] = *(const f32x4*)(mu_lora + (d * 2 + 1) * 64 + j0); ma[ks][1] = *(const f32x4*)(mu_lora + (d * 2 + 1) * 64 + j0 + 4); }
            __builtin_amdgcn_sched_barrier(0);
#pragma unroll
            for (int ks = 0; ks < 2; ++ks) {
                float cur[8], nb[8], o[8];
                unpack8(cw[ks], cur); unpack8(nw[ks], nb);
#pragma unroll
                for (int j = 0; j < 8; ++j) { const float xx = cur[j] + ((hasnb ? nb[j] : 0.f) - cur[j]) * mw[ks][j >> 2][j & 3]; o[j] = 1.0f - 2.0f * rcp_f(1.0f + __expf(2.0f * xx)); }
                Bw[ks] = __builtin_bit_cast(bf16x8, pack8(o));
                unpack8(ca[ks], cur); unpack8(na[ks], nb);
#pragma unroll
                for (int j = 0; j < 8; ++j) o[j] = cur[j] + ((hasnb ? nb[j] : 0.f) - cur[j]) * ma[ks][j >> 2][j & 3];
                Ba[ks] = __builtin_bit_cast(bf16x8, pack8(o)); }
        }
        const int pos = scan_pos(d, isctx, t);
#pragma unroll 1
        for (int hh = 0; hh < 2; ++hh) {
            const int head = hp * 2 + hh, chain = (b * 2 + d) * 16 + head;
            char* recb = (char*)REC + ((size_t)chain * SCANLEN + pos) * RECB;
            const LAS float* pr = prm + hh * 512;
            float KK[16], AV[16]; float ss = 0.f, bon = 0.f;
#pragma unroll
            for (int hf = 0; hf < 2; ++hf) {
                const int cl = 32 * hf + 8 * q4, cg = head * 64 + cl;
                bf16x8 wf[2][2], af[2][2];
#pragma unroll
                for (int tq = 0; tq < 2; ++tq) { const size_t wrow = (size_t)(d * 1024 + head * 64 + 32 * hf + 8 * (n >> 2) + 4 * tq + (n & 3)) * 64 + 8 * q4;
                    wf[tq][0] = ld_frag(WUPT + wrow); wf[tq][1] = ld_frag(WUPT + wrow + 32); af[tq][0] = ld_frag(AUPT + wrow); af[tq][1] = ld_frag(AUPT + wrow + 32); }
                const v4u rcw = *(const v4u*)(prow + C_RWR + cg), kcw = *(const v4u*)(prow + C_RWK + cg), vcw = *(const v4u*)(prow + C_RWV + cg);
                const v4u rnw = *(const v4u*)(nrow + C_RWR + cg), knw = *(const v4u*)(nrow + C_RWK + cg), vnw = *(const v4u*)(nrow + C_RWV + cg);
                __builtin_amdgcn_sched_barrier(0);
                f32x4 accW[2], accA[2];
#pragma unroll
                for (int tq = 0; tq < 2; ++tq) { f32x4 z = {0.f, 0.f, 0.f, 0.f}; z = mfma16(wf[tq][0], Bw[0], z); accW[tq] = mfma16(wf[tq][1], Bw[1], z);
                                                 f32x4 y = {0.f, 0.f, 0.f, 0.f}; y = mfma16(af[tq][0], Ba[0], y); accA[tq] = mfma16(af[tq][1], Ba[1], y); }
                float rc[8], kc[8], vc[8], rn[8], kn[8], vn[8];
                unpack8(rcw, rc); unpack8(kcw, kc); unpack8(vcw, vc); unpack8(rnw, rn); unpack8(knw, kn); unpack8(vnw, vn);
                float dec[8], kp[8], rr[8], vv[8];
#pragma unroll
                for (int g = 0; g < 2; ++g) {
                    const f32x4 w0v = *(const LAS f32x4*)(pr + 0 * 64 + cl + 4 * g), a0v = *(const LAS f32x4*)(pr + 1 * 64 + cl + 4 * g), mur = *(const LAS f32x4*)(pr + 2 * 64 + cl + 4 * g),
                                muk = *(const LAS f32x4*)(pr + 3 * 64 + cl + 4 * g), muv = *(const LAS f32x4*)(pr + 4 * 64 + cl + 4 * g), kkv = *(const LAS f32x4*)(pr + 5 * 64 + cl + 4 * g),
                                kav = *(const LAS f32x4*)(pr + 6 * 64 + cl + 4 * g), rkv = *(const LAS f32x4*)(pr + 7 * 64 + cl + 4 * g);
#pragma unroll
                    for (int i = 0; i < 4; ++i) { const int j = 4 * g + i;
                        const float rnb = hasnb ? rn[j] : 0.f, knb = hasnb ? kn[j] : 0.f, vnb = hasnb ? vn[j] : 0.f;
                        const float r_ = rc[j] + (rnb - rc[j]) * mur[i], k0 = kc[j] + (knb - kc[j]) * muk[i], v_ = vc[j] + (vnb - vc[j]) * muv[i];
                        const float xw = -(w0v[i] + accW[g][i]);
                        const float sp = fmaxf(xw, 0.f) + __logf(1.0f + __expf(-fabsf(xw)));
                        dec[j] = __expf(-__expf(-sp - 0.5f));
                        const float av = rcp_f(1.0f + __expf(-(a0v[i] + accA[g][i])));
                        const float kx = k0 * kkv[i]; ss += kx * kx;
                        const float kp_ = k0 * (1.f + (av - 1.f) * kav[i]); bon += r_ * kp_ * rkv[i];
                        KK[8 * hf + j] = kx; AV[8 * hf + j] = av; kp[j] = kp_; rr[j] = r_; vv[j] = v_; }
                }
                char* ob = recb + cl * 2;
                REC_ST((h8*)(ob), ((h8){(_Float16)(1.0f - dec[0]), (_Float16)(1.0f - dec[1]), (_Float16)(1.0f - dec[2]), (_Float16)(1.0f - dec[3]), (_Float16)(1.0f - dec[4]), (_Float16)(1.0f - dec[5]), (_Float16)(1.0f - dec[6]), (_Float16)(1.0f - dec[7])}));
                REC_ST((h8*)(ob + 384), ((h8){(_Float16)kp[0], (_Float16)kp[1], (_Float16)kp[2], (_Float16)kp[3], (_Float16)kp[4], (_Float16)kp[5], (_Float16)kp[6], (_Float16)kp[7]}));
                REC_ST((h8*)(ob + 512), ((h8){(_Float16)rr[0], (_Float16)rr[1], (_Float16)rr[2], (_Float16)rr[3], (_Float16)rr[4], (_Float16)rr[5], (_Float16)rr[6], (_Float16)rr[7]}));
                REC_ST((h8*)(ob + 640), ((h8){(_Float16)vv[0], (_Float16)vv[1], (_Float16)vv[2], (_Float16)vv[3], (_Float16)vv[4], (_Float16)vv[5], (_Float16)vv[6], (_Float16)vv[7]}));
                __builtin_amdgcn_sched_barrier(0);
            }
            ss = sum16x4(ss); bon = sum16x4(bon);
            const float inv = rsq_f(fmaxf(ss, 1e-12f));
#pragma unroll
            for (int hf = 0; hf < 2; ++hf) { char* ob = recb + (32 * hf + 8 * q4) * 2; float kkn[8], nka[8];
#pragma unroll
                for (int j = 0; j < 8; ++j) { kkn[j] = KK[8 * hf + j] * inv; nka[j] = -(kkn[j] * AV[8 * hf + j]); }
                REC_ST((h8*)(ob + 128), ((h8){(_Float16)kkn[0], (_Float16)kkn[1], (_Float16)kkn[2], (_Float16)kkn[3], (_Float16)kkn[4], (_Float16)kkn[5], (_Float16)kkn[6], (_Float16)kkn[7]}));
                REC_ST((h8*)(ob + 256), ((h8){(_Float16)nka[0], (_Float16)nka[1], (_Float16)nka[2], (_Float16)nka[3], (_Float16)nka[4], (_Float16)nka[5], (_Float16)nka[6], (_Float16)nka[7]})); }
            if (q4 == 0) BON[(size_t)chain * SCANLEN + pos] = bon;
        }
    }
}
template <bool CTXQ>
__device__ __forceinline__ void na_unit(const bf16* QN, const bf16* KN, const bf16* VTL, const bf16* VTC, const bf16* P, const float* rpb  , bf16* Y, int u, int lane) {
    const int n = lane & 15, q4 = lane >> 4;
    int b, h, qrow0, qr = 0, jt = 0;
    if (CTXQ) { b = u >> 8; h = (u >> 4) & 15; qrow0 = NLAT + b * CTXL + 16 * (u & 15); }
    else { jt = u & 3; h = (u >> 2) & 15; qr = (u >> 6) & 127; b = u >> 13; qrow0 = b * SEQ + qr * 64 + 16 * jt; }
    constexpr int NT = CTXQ ? 16 : 32, WT = CTXQ ? 0 : 16;
    f32x4 s[NT];
    const int rs = qr - 4 < 0 ? 0 : (qr - 4 > 120 ? 120 : qr - 4);
    const int span0 = jt == 0 ? 0 : (jt == 1 ? 8 : (jt == 2 ? 24 : 32));
    const int qc = 16 * jt + n; const int cs = qc - 8 < 0 ? 0 : (qc - 8 > 48 ? 48 : qc - 8);
    bf16x8 qf[2];
#pragma unroll
    for (int ks = 0; ks < 2; ++ks) qf[ks] = ld_frag(QN + (size_t)(qrow0 + n) * GWD + h * 64 + 32 * ks + 8 * q4);
    if (!CTXQ) {
        const float* rp = rpb + (size_t)h * 15 * 31;
#pragma unroll
        for (int wt = 0; wt < 16; ++wt) { const int kri = wt >> 1, half = wt & 1, relr = rs + kri - qr + 7;
#pragma unroll
            for (int i = 0; i < 4; ++i) { const int relc = span0 + 8 * q4 + 4 * half + i - qc + 15; const int relcc = relc < 0 ? 0 : (relc > 30 ? 30 : relc); s[wt][i] = rp[relr * 31 + relcc]; } }
        __builtin_amdgcn_sched_barrier(0);
#pragma unroll
        for (int bt = 0; bt < 2; ++bt) {
            bf16x8 kf[16];
#pragma unroll
            for (int t = 0; t < 8; ++t) { const int wt = bt * 8 + t, kri = wt >> 1, half = wt & 1;
                const bf16* kp = KN + (size_t)(b * SEQ + (rs + kri) * 64 + span0 + 8 * (n >> 2) + 4 * half + (n & 3)) * GWD + h * 64 + 8 * q4; kf[2 * t] = ld_frag(kp); kf[2 * t + 1] = ld_frag(kp + 32); }
            __builtin_amdgcn_sched_barrier(0);
#pragma unroll
            for (int t = 0; t < 8; ++t) { const int wt = bt * 8 + t, half = wt & 1;
                f32x4 a = s[wt];
#pragma unroll
                for (int i = 0; i < 4; ++i) { const int kc = span0 + 8 * q4 + 4 * half + i; const bool ok = kc >= cs && kc < cs + 16; a[i] = ok ? a[i] : -INFINITY; }
                a = mfma16(kf[2 * t], qf[0], a); a = mfma16(kf[2 * t + 1], qf[1], a); s[wt] = a; }
            __builtin_amdgcn_sched_barrier(0);
        }
    }
#pragma unroll
    for (int bt = 0; bt < 2; ++bt) {
        bf16x8 kf[16];
#pragma unroll
        for (int t = 0; t < 8; ++t) { const int ctile = bt * 8 + t; const bf16* kp = KN + (size_t)(NLAT + b * CTXL + 32 * (ctile >> 1) + 8 * (n >> 2) + 4 * (ctile & 1) + (n & 3)) * GWD + h * 64 + 8 * q4; kf[2 * t] = ld_frag(kp); kf[2 * t + 1] = ld_frag(kp + 32); }
        __builtin_amdgcn_sched_barrier(0);
#pragma unroll
        for (int t = 0; t < 8; ++t) { f32x4 a = {0.f, 0.f, 0.f, 0.f}; a = mfma16(kf[2 * t], qf[0], a); a = mfma16(kf[2 * t + 1], qf[1], a); s[WT + bt * 8 + t] = a; }
        __builtin_amdgcn_sched_barrier(0);
    }
    float mx = -INFINITY;
#pragma unroll
    for (int t = 0; t < NT; ++t) mx = fmaxf(fmaxf(fmaxf(s[t][0], s[t][1]), fmaxf(s[t][2], s[t][3])), mx);
    mx = max16x4(mx);
    float sum = 0.f;
#pragma unroll
    for (int t = 0; t < NT; ++t) {
#pragma unroll
        for (int i = 0; i < 4; ++i) { const float e = __expf(s[t][i] - mx); s[t][i] = e; sum += e; } }
    sum = sum16x4(sum);
    const float inv = rcp_f(sum);
    f32x4 o[4];
#pragma unroll
    for (int nt = 0; nt < 4; ++nt) o[nt] = (f32x4){0.f, 0.f, 0.f, 0.f};
#pragma unroll
    for (int tb = 0; tb < NT / 8; ++tb) {
        v4u vv[4][4];
#pragma unroll
        for (int tq = 0; tq < 4; ++tq) { const int tp = tb * 4 + tq;
            const bf16* vb; size_t dstride;
            if (!CTXQ && tp < 8) { vb = VTL + ((size_t)(b * 16 + h) * 64 + n) * 8192 + (rs + tp) * 64 + span0 + 8 * q4; dstride = (size_t)16 * 8192; }
            else { const int cp = tp - (CTXQ ? 0 : 8); vb = VTC + ((size_t)(b * 16 + h) * 64 + n) * 256 + 32 * cp + 8 * q4; dstride = (size_t)16 * 256; }
#pragma unroll
            for (int nt = 0; nt < 4; ++nt) vv[tq][nt] = *(const v4u*)(vb + nt * dstride); }
        __builtin_amdgcn_sched_barrier(0);
#pragma unroll
        for (int tq = 0; tq < 4; ++tq) { const int tp = tb * 4 + tq;
            const f32x4 p0 = s[2 * tp] * inv, p1 = s[2 * tp + 1] * inv;
            v4u aw; aw.x = pk2(p0[0], p0[1]); aw.y = pk2(p0[2], p0[3]); aw.z = pk2(p1[0], p1[1]); aw.w = pk2(p1[2], p1[3]);
            const bf16x8 af = __builtin_bit_cast(bf16x8, aw);
#pragma unroll
            for (int nt = 0; nt < 4; ++nt) o[nt] = mfma16(af, __builtin_bit_cast(bf16x8, vv[tq][nt]), o[nt]); }
        __builtin_amdgcn_sched_barrier(0);
    }
    unsigned short zz[4][4];
#pragma unroll
    for (int nt = 0; nt < 4; ++nt)
#pragma unroll
        for (int i = 0; i < 4; ++i) zz[nt][i] = P[(size_t)(qrow0 + 4 * q4 + i) * NIN + C_NAZ + h * 64 + 16 * nt + n];
    __builtin_amdgcn_sched_barrier(0);
#pragma unroll
    for (int nt = 0; nt < 4; ++nt)
#pragma unroll
        for (int i = 0; i < 4; ++i) { const int row = qrow0 + 4 * q4 + i, col = h * 64 + 16 * nt + n;
            Y[(size_t)row * DM + 1024 + col] = (bf16)f2bf(o[nt][i] * silu_f(bf2f(zz[nt][i]))); }
}
__device__ __forceinline__ void bar4(LAS unsigned* cnt, unsigned& seq, int lane) {
    asm volatile("s_waitcnt vmcnt(0) lgkmcnt(0)" ::: "memory");
    const unsigned baddr = (unsigned)(size_t)cnt, one = 1u; seq += 4u;
    if (lane == 0) asm volatile("ds_add_u32 %0, %1" :: "v"(baddr), "v"(one) : "memory");
    unsigned sp = 0, got;
    for (;;) { asm volatile("ds_read_b32 %0, %1\n\ts_waitcnt lgkmcnt(0)" : "=v"(got) : "v"(baddr) : "memory");
        if (__builtin_amdgcn_readfirstlane((int)got) >= (int)seq) break; __builtin_amdgcn_s_sleep(1); if (++sp > (1u << 22)) break; }
    asm volatile("" ::: "memory");
}
__device__ __forceinline__ void phase_sgu4(const bf16* P, const f32x2* SGST, const float* lnw, const float* lnb, const bf16* SGW, const float* sgb, bf16* Y,
                                           LAS unsigned char* ldsT, LAS unsigned* cnt, int nchunks, int tid4  , int w4  , int lane) {
    const int n = lane & 15, q4 = lane >> 4;
    LAS bf16* T = (LAS bf16*)ldsT; unsigned seq = 0u;
    for (int u = blockIdx.x; u < nchunks * 8; u += 256) {
        const int ck = u >> 3, g = u & 7, m0 = ck * 128;
#pragma unroll
        for (int it = 0; it < 8; ++it) { const int idx = tid4 + 256 * it, q = idx >> 4, c8 = idx & 15;
            float x[8]; unpack8(*(const v4u*)(P + (size_t)(m0 + q) * NIN + C_SGV + g * 128 + 8 * c8), x);
            const f32x2 st = SGST[m0 + q];
#pragma unroll
            for (int j = 0; j < 8; ++j) { const int c = 8 * c8 + j; const float v = (x[j] - st.x) * st.y * lnw[g * 128 + c] + lnb[g * 128 + c]; T[c * 136 + q] = (bf16)f2bf(v); } }
        bar4(cnt, seq, lane);
#pragma unroll 1
        for (int mt = 0; mt < 2; ++mt) { const int mrow = 32 * w4 + 16 * mt;
            bf16x8 af[4];
#pragma unroll
            for (int ks = 0; ks < 4; ++ks) af[ks] = ld_frag(SGW + ((size_t)g * 128 + mrow + n) * 128 + 32 * ks + 8 * q4);
            unsigned short uu16[8][4], zz16[8][4]; float sb4[4];
#pragma unroll
            for (int i = 0; i < 4; ++i) { const int p = mrow + 4 * q4 + i; sb4[i] = sgb[g * 128 + p]; const bf16* pr = P + (size_t)(m0 + p) * NIN + g * 128 + n;
#pragma unroll
                for (int nt = 0; nt < 8; ++nt) { uu16[nt][i] = pr[C_SGU + 16 * nt]; zz16[nt][i] = pr[C_SGZ + 16 * nt]; } }
            __builtin_amdgcn_sched_barrier(0);
#pragma unroll
            for (int nt = 0; nt < 8; ++nt) {
                f32x4 acc = {0.f, 0.f, 0.f, 0.f};
#pragma unroll
                for (int ks = 0; ks < 4; ++ks) { const bf16x8 bfg = *(const LAS bf16x8*)(T + (16 * nt + n) * 136 + 32 * ks + 8 * q4); acc = mfma16(af[ks], bfg, acc); }
#pragma unroll
                for (int i = 0; i < 4; ++i) { const int p = mrow + 4 * q4 + i, row = m0 + p, col = g * 128 + 16 * nt + n;
                    Y[(size_t)row * DM + 3072 + col] = (bf16)f2bf(bf2f(uu16[nt][i]) * (acc[i] + sb4[i]) * silu_f(bf2f(zz16[nt][i]))); }
            }
        }
        bar4(cnt, seq, lane);
    }
}
__device__ __forceinline__ void scan_self(const float* REC, float* YR, LAS unsigned char* lds, LAS unsigned* bcnt, int su, int wave, int lane) {
    constexpr int CS = 32, NCH = SCANLEN / CS, SLOT = CS * RECB, NPW = SLOT / 1024 / 4;
    const int chain = (su & 7) * 8 + ((su >> 3) >> 2), part = (su >> 3) & 3;
    const char* recb = (const char*)REC + (size_t)chain * SCANLEN * RECB;
    const int wl = wave;
#define SCAN_ISSUE(cc, sl) do { _Pragma("unroll") for (int p_ = 0; p_ < NPW; ++p_) \
    __builtin_amdgcn_global_load_lds((const unsigned*)(recb + (size_t)(cc) * SLOT + (wl * NPW + p_) * 1024 + lane * 16), (LAS unsigned*)(lds + (sl) * SLOT + (wl * NPW + p_) * 1024), 16, 0, 0); } while (0)
    __builtin_amdgcn_s_setprio(3);
    SCAN_ISSUE(0, 0); SCAN_ISSUE(1, 1);
#define SCAN_ARRIVE() do { unsigned long long ex_; const unsigned baddr_ = (unsigned)(size_t)bcnt, one_ = 1u; \
    asm volatile("s_mov_b64 %0, exec\n\ts_mov_b64 exec, 1\n\tds_add_u32 %1, %2\n\ts_mov_b64 exec, %0" : "=&s"(ex_) : "v"(baddr_), "v"(one_) : "memory"); } while (0)
    static_assert(NPW == 6, "vmcnt counts below assume 6 pieces per wave and chunk");
    asm volatile("s_waitcnt vmcnt(6)" ::: "memory");
    SCAN_ARRIVE();
    const int c16 = lane & 15, rg = lane >> 4, row = 16 * part + 4 * wave + rg;
    float S0 = 0.f, S1 = 0.f, S2 = 0.f, S3 = 0.f;
#if defined(PROBE_DUP)
    float T0 = 0.f, T1 = 0.f, T2 = 0.f, T3 = 0.f, tdum = 0.f; asm volatile("" : "+v"(T0), "+v"(T1), "+v"(T2), "+v"(T3));
#endif
#if defined(PROBE_LDS2)
    f32x4 dw_ = {0.f, 0.f, 0.f, 0.f}; v4u dk_ = {0u, 0u, 0u, 0u};
#endif
    float* yout = YR + (size_t)chain * SCANLEN * 64 + row;
    const int lo_h = c16 * 8, lo_v = 640 + row * 2;
#define SCAN_LD(dst, s_) do { const unsigned ahj_ = ah + ((s_) & ~1) * RECB; \
    asm volatile("ds_read2_b64 %0, %1 offset0:%2 offset1:%3" : "=v"(dst##ek) : "v"(ahj_), "i"(((s_) & 1) * (RECB / 8)), "i"(((s_) & 1) * (RECB / 8) + 16)); \
    asm volatile("ds_read_u16 %0, %1 offset:%2" : "=v"(dst##v) : "v"(av), "i"((s_) * RECB)); \
    asm volatile("ds_read2_b64 %0, %1 offset0:%2 offset1:%3" : "=v"(dst##nk) : "v"(ahj_), "i"(((s_) & 1) * (RECB / 8) + 32), "i"(((s_) & 1) * (RECB / 8) + 48)); \
    asm volatile("ds_read_b64 %0, %1 offset:%2" : "=v"(dst##r) : "v"(ah), "i"((s_) * RECB + 512)); } while (0)
#define H2H(q_) __builtin_bit_cast(h4, (q_))
#define H4LO(q_) __builtin_bit_cast(h4, (v2u){(q_).x, (q_).y})
#define H4HI(q_) __builtin_bit_cast(h4, (v2u){(q_).z, (q_).w})
#define FMX(a, b, c) __builtin_fmaf((a), (float)(b), (c))
#if defined(PROBE_CHUNK)
    unsigned long long ptz_ = 0ull;
#endif
    for (int c = 0; c < NCH; ++c) {
#if defined(PROBE_CHUNK)
        const unsigned long long pt0_ = __builtin_amdgcn_s_memrealtime(); unsigned long long pt8_ = pt0_;
#endif
        {   const unsigned baddr = (unsigned)(size_t)bcnt; const unsigned want = 4u * (unsigned)(c + 1); unsigned sp = 0, got;
#if defined(PROBE_CHUNK)
            if (PROBE_CHUNK & 64) { const unsigned long long a_ = __builtin_amdgcn_s_memrealtime(); asm volatile("s_waitcnt lgkmcnt(0)" ::: "memory");
                asm volatile("ds_read_b32 %0, %1\n\ts_waitcnt lgkmcnt(0)" : "=v"(got) : "v"(baddr) : "memory");
                const unsigned long long n_ = __builtin_amdgcn_s_memrealtime(), te_ = n_ + (n_ - a_) * 4; while (__builtin_amdgcn_s_memrealtime() < te_) __builtin_amdgcn_s_sleep(1); }
#endif
            for (;;) { asm volatile("ds_read_b32 %0, %1\n\ts_waitcnt lgkmcnt(0)" : "=v"(got) : "v"(baddr) : "memory");
                if (__builtin_amdgcn_readfirstlane((int)got) >= (int)want) break; __builtin_amdgcn_s_sleep(1); if (++sp > (1u << 22)) break; } }
        asm volatile("" ::: "memory");
#if defined(PROBE_CHUNK)
        if ((PROBE_CHUNK & 128) && c > 0) { const unsigned long long n_ = __builtin_amdgcn_s_memrealtime(), te_ = n_ + (n_ - ptz_) * 4; while (__builtin_amdgcn_s_memrealtime() < te_) __builtin_amdgcn_s_sleep(1); }
        const unsigned long long ptp_ = __builtin_amdgcn_s_memrealtime();
#endif
        const int cc = c + 2 < NCH ? c + 2 : NCH - 1; const int s2 = (c + 2) & 3;
        const LAS unsigned char* slot = lds + (c & 3) * SLOT;
        float ysv0 = 0.f, ysv1 = 0.f; float yp[16];
        const unsigned ah = (unsigned)(size_t)(slot + lo_h), av = (unsigned)(size_t)(slot + lo_v);
        v4u Aek, Ank, Bek, Bnk; v2u Ar, Br; unsigned Av, Bv; h4 Pr;
        SCAN_LD(A, 0); SCAN_LD(B, 1);
#pragma unroll
        for (int s = 0; s < CS; ++s) {
            v4u Cek, Cnk; v2u Cr; unsigned Cv;
#if defined(PROBE_LDS2)
            if (s < CS - 2) { SCAN_LD(C, s + 2);
                { const unsigned ahj_ = ah + ((s + 2) & ~1) * RECB;
                  asm volatile("ds_read_b128 %0, %1 offset:%2" : "+v"(dw_) : "v"(aw), "i"((s + 2) * RECB));
                  asm volatile("ds_read2_b64 %0, %1 offset0:%2 offset1:%3" : "+v"(dk_) : "v"(ahj_), "i"(((s + 2) & 1) * (RECB / 8)), "i"(((s + 2) & 1) * (RECB / 8) + 16)); }
                if (s == 0) asm volatile("s_waitcnt lgkmcnt(10)" : "+v"(Aek), "+v"(Ank), "+v"(Ar), "+v"(Av)); else asm volatile("s_waitcnt lgkmcnt(12)" : "+v"(Aek), "+v"(Ank), "+v"(Ar), "+v"(Av)); }
            else if (s == CS - 2) asm volatile("s_waitcnt lgkmcnt(6)" : "+v"(Aek), "+v"(Ank), "+v"(Ar), "+v"(Av));
#else
            if (s < CS - 2) { SCAN_LD(C, s + 2); asm volatile("s_waitcnt lgkmcnt(8)" : "+v"(Aek), "+v"(Ank), "+v"(Ar), "+v"(Av)); }
            else if (s == CS - 2) asm volatile("s_waitcnt lgkmcnt(4)" : "+v"(Aek), "+v"(Ank), "+v"(Ar), "+v"(Av));
#endif
            else asm volatile("s_waitcnt lgkmcnt(0)" : "+v"(Aek), "+v"(Ank), "+v"(Ar), "+v"(Av));
#if defined(PROBE_CHUNK)
            if (s == 8) pt8_ = __builtin_amdgcn_s_memrealtime();
            if (s == 8 && (PROBE_CHUNK & 8)) { const unsigned long long te_ = pt8_ + (pt8_ - ptp_) * 4; while (__builtin_amdgcn_s_memrealtime() < te_) __builtin_amdgcn_s_sleep(1); }
#endif
            if ((s & 3) == 1 && (s >> 2) < NPW) { const int p_ = s >> 2;
                __builtin_amdgcn_global_load_lds((const unsigned*)(recb + (size_t)cc * SLOT + (wl * NPW + p_) * 1024 + lane * 16), (LAS unsigned*)(lds + s2 * SLOT + (wl * NPW + p_) * 1024), 16, 0, 0); }
#if defined(PROBE_CHUNK)
            unsigned long long ptv_ = 0ull; if (s == 16 && (PROBE_CHUNK & 16)) { ptv_ = __builtin_amdgcn_s_memrealtime(); asm volatile("s_waitcnt lgkmcnt(0)" ::: "memory"); }
#endif
            if (s == 16) { if (c == 0) asm volatile("s_waitcnt vmcnt(4)" ::: "memory"); else asm volatile("s_waitcnt vmcnt(6)" ::: "memory"); SCAN_ARRIVE(); }
#if defined(PROBE_CHUNK)
            if (s == 16 && (PROBE_CHUNK & 16)) { const unsigned long long n_ = __builtin_amdgcn_s_memrealtime(), te_ = n_ + (n_ - ptv_) * 4; while (__builtin_amdgcn_s_memrealtime() < te_) __builtin_amdgcn_s_sleep(1); }
#endif
            __builtin_amdgcn_sched_barrier(0);
            const h4 Ae = H4LO(Aek), Akk = H4HI(Aek), Ana = H4LO(Ank), Ak = H4HI(Ank), Arr = H2H(Ar); const _Float16 Avh = __builtin_bit_cast(_Float16, (unsigned short)Av);
            if (s > 0) { float q0 = FMX(S0, Pr.x, 0.f); q0 = FMX(S1, Pr.y, q0); q0 = FMX(S2, Pr.z, q0); yp[(s - 1) & 15] = FMX(S3, Pr.w, q0); }
            float p0 = FMX(S0, Akk.x, 0.f), p1 = FMX(S2, Akk.z, 0.f); p0 = FMX(S1, Akk.y, p0); p1 = FMX(S3, Akk.w, p1);
            const float dt = red16(p0 + p1);
            const float u0 = FMX(S0, -Ae.x, FMX((float)Avh, Ak.x, S0)), u1 = FMX(S1, -Ae.y, FMX((float)Avh, Ak.y, S1)),
                        u2 = FMX(S2, -Ae.z, FMX((float)Avh, Ak.z, S2)), u3 = FMX(S3, -Ae.w, FMX((float)Avh, Ak.w, S3));
            S0 = FMX(dt, Ana.x, u0); S1 = FMX(dt, Ana.y, u1); S2 = FMX(dt, Ana.z, u2); S3 = FMX(dt, Ana.w, u3);
#if defined(PROBE_IND)
            {   float d0, d1, d2, d3;
                asm volatile("v_mul_f32 %0, %4, %4\n\tv_mul_f32 %1, %4, %4\n\tv_mul_f32 %2, %4, %4\n\tv_mul_f32 %3, %4, %4\n\t"
                             "v_mul_f32 %0, %4, %4\n\tv_mul_f32 %1, %4, %4\n\tv_mul_f32 %2, %4, %4\n\tv_mul_f32 %3, %4, %4\n\t"
                             "v_mul_f32 %0, %4, %4\n\tv_mul_f32 %1, %4, %4\n\tv_mul_f32 %2, %4, %4\n\tv_mul_f32 %3, %4, %4\n\t"
                             "v_mul_f32 %0, %4, %4\n\tv_mul_f32 %1, %4, %4\n\tv_mul_f32 %2, %4, %4\n\tv_mul_f32 %3, %4, %4" : "=&v"(d0), "=&v"(d1), "=&v"(d2), "=&v"(d3) : "v"(Aw.x)); }
#endif
#if defined(PROBE_DUP)
            {
                if (s > 0) { float q0 = FMX(T0, Pr.x, 0.f), q1 = FMX(T2, Pr.z, 0.f); q0 = FMX(T1, Pr.y, q0); q1 = FMX(T3, Pr.w, q1); tdum += q0 + q1; }
                float p0 = FMX(T0, Akk.x, 0.f), p1 = FMX(T2, Akk.z, 0.f); p0 = FMX(T1, Akk.y, p0); p1 = FMX(T3, Akk.w, p1);
                const float dt2 = red16(p0 + p1);
                const float u0 = __builtin_fmaf(T0, Aw.x, FMX((float)Avh, Ak.x, 0.f)), u1 = __builtin_fmaf(T1, Aw.y, FMX((float)Avh, Ak.y, 0.f)),
                            u2 = __builtin_fmaf(T2, Aw.z, FMX((float)Avh, Ak.z, 0.f)), u3 = __builtin_fmaf(T3, Aw.w, FMX((float)Avh, Ak.w, 0.f));
                T0 = FMX(dt2, Ana.x, u0); T1 = FMX(dt2, Ana.y, u1); T2 = FMX(dt2, Ana.z, u2); T3 = FMX(dt2, Ana.w, u3); }
#endif
            if (s == 16) ysv0 = red16_transpose(yp, c16);
            Pr = Arr;
            if (s < CS - 1) { Aek = Bek; Ank = Bnk; Ar = Br; Av = Bv; }
            if (s < CS - 2) { Bek = Cek; Bnk = Cnk; Br = Cr; Bv = Cv; }
        }
#if defined(PROBE_CHUNK)
        asm volatile("" : "+v"(S0), "+v"(S1), "+v"(S2), "+v"(S3));
        const unsigned long long pt1_ = __builtin_amdgcn_s_memrealtime();
        if (PROBE_CHUNK & 4) { const unsigned long long te_ = pt1_ + (pt1_ - pt8_) * 4; while (__builtin_amdgcn_s_memrealtime() < te_) __builtin_amdgcn_s_sleep(1); }
#endif
        { float q0 = FMX(S0, Pr.x, 0.f); q0 = FMX(S1, Pr.y, q0); q0 = FMX(S2, Pr.z, q0); yp[15] = FMX(S3, Pr.w, q0); }
        ysv1 = red16_transpose(yp, c16);
        asm volatile("" ::: "memory");
        yout[(size_t)(c * CS + c16) * 64] = ysv0; yout[(size_t)(c * CS + 16 + c16) * 64] = ysv1;
#if defined(PROBE_CHUNK)
        if (PROBE_CHUNK & 2) { const unsigned long long n_ = __builtin_amdgcn_s_memrealtime(), te_ = n_ + (n_ - pt1_) * 4; while (__builtin_amdgcn_s_memrealtime() < te_) __builtin_amdgcn_s_sleep(1); }
        if (PROBE_CHUNK & 128) ptz_ = __builtin_amdgcn_s_memrealtime();
        if (PROBE_CHUNK & 32) { const unsigned long long n_ = __builtin_amdgcn_s_memrealtime(), te_ = n_ + (n_ - ptp_) * 2; while (__builtin_amdgcn_s_memrealtime() < te_) __builtin_amdgcn_s_sleep(1); }
#endif
    }
    asm volatile("s_waitcnt vmcnt(0)" ::: "memory");
    __builtin_amdgcn_s_setprio(0);
#if defined(PROBE_DUP)
    asm volatile("" :: "v"(T0), "v"(T1), "v"(T2), "v"(T3), "v"(tdum));
#endif
#if defined(PROBE_LDS2)
    asm volatile("s_waitcnt lgkmcnt(0)" :: "v"(dw_), "v"(dk_));
#endif
#undef FMX
#undef SCAN_LD
#undef SCAN_ARRIVE
#undef H4LO
#undef H4HI
#undef H2H
#undef SCAN_ISSUE
}
__device__ __forceinline__ void phase_rwfin(const bf16* P, const float* YR, const float* REC, const float* BON, const float* lnw, const float* lnb, bf16* Y, int nrows, int gw, int NGW, int lane) {
    const int head = lane >> 2, sub = lane & 3;
    for (int m = gw; m < nrows; m += NGW) {
        const bool isctx = m >= NLAT; const int t = isctx ? ((m - NLAT) & 255) : (m & 8191); const int b = isctx ? ((m - NLAT) >> 8) : (m >> 13);
        float out[16];
#pragma unroll
        for (int i = 0; i < 16; ++i) out[i] = 0.f;
#pragma unroll
        for (int d = 0; d < 2; ++d) {
            const int chain = (b * 2 + d) * 16 + head; const size_t pp = (size_t)chain * SCANLEN + scan_pos(d, isctx, t);
            float y[16], v[16];
#pragma unroll
            for (int j = 0; j < 4; ++j) { const f32x4 a = *(const f32x4*)(YR + pp * 64 + 16 * sub + 4 * j); const h4 c = *(const h4*)((const char*)REC + pp * RECB + 640 + (16 * sub + 4 * j) * 2);
                y[4 * j] = a.x; y[4 * j + 1] = a.y; y[4 * j + 2] = a.z; y[4 * j + 3] = a.w; v[4 * j] = (float)c.x; v[4 * j + 1] = (float)c.y; v[4 * j + 2] = (float)c.z; v[4 * j + 3] = (float)c.w; }
            const float bo = BON[pp];
            float s = 0.f;
#pragma unroll
            for (int i = 0; i < 16; ++i) s += y[i];
            s += __shfl_xor(s, 1); s += __shfl_xor(s, 2);
            const float mean = s * (1.f / 64.f); float q = 0.f;
#pragma unroll
            for (int i = 0; i < 16; ++i) { const float dl = y[i] - mean; q += dl * dl; }
            q += __shfl_xor(q, 1); q += __shfl_xor(q, 2);
            const float rstd = rsq_f(q * (1.f / 64.f) + 64e-5f);
#pragma unroll
            for (int i = 0; i < 16; ++i) { const int ch = head * 64 + 16 * sub + i; out[i] += (y[i] - mean) * rstd * lnw[ch] + lnb[ch] + bo * v[i]; }
        }
        float z[16]; unpack8(*(const v4u*)(P + (size_t)m * NIN + C_RWZ + 16 * lane), z); unpack8(*(const v4u*)(P + (size_t)m * NIN + C_RWZ + 16 * lane + 8), z + 8);
#pragma unroll
        for (int i = 0; i < 16; ++i) out[i] *= silu_f(z[i]);
        *(v4u*)(Y + (size_t)m * DM + 2048 + 16 * lane) = pack8(out); *(v4u*)(Y + (size_t)m * DM + 2048 + 16 * lane + 8) = pack8(out + 8);
    }
}
#define XB_TMO      128
#define XB_XCNT(j)  (256  + 64 * (j))
#define XB_XSUB(j)  (1280 + 64 * (j))
#define XB_XGEN(j)  (2304 + 64 * (j))
#define XB_TOP      3328
#define XB_TOPGEN   3392
#define XCD_BAR_WORDS 3456
#define XB_SPIN_CAP (1u << 18)

__device__ __forceinline__ unsigned xb_ld(unsigned* p)              { return __hip_atomic_load(p, __ATOMIC_RELAXED, __HIP_MEMORY_SCOPE_AGENT); }
__device__ __forceinline__ unsigned xb_add(unsigned* p, unsigned v) { return __hip_atomic_fetch_add(p, v, __ATOMIC_RELAXED, __HIP_MEMORY_SCOPE_AGENT); }
__device__ __forceinline__ unsigned xb_xcc_id() { return (unsigned)__builtin_amdgcn_s_getreg((3 << 11) | 20) & 0xFu; }
#define XB_SPIN(cond, bar) do { unsigned _sp = 0; while (cond) { __builtin_amdgcn_s_sleep(1); \
    if ((++_sp & 255u) == 0u) { if (xb_ld(&(bar)[XB_TMO])) break; if (_sp > XB_SPIN_CAP) { atomicAdd(&(bar)[XB_TMO], 1u); break; } } } } while (0)

struct XcdBarrier {
    unsigned* bar; unsigned x;
    volatile LAS unsigned* st;
};

__device__ __forceinline__ XcdBarrier xcd_barrier_post(unsigned* bar, volatile LAS unsigned* st) {
    XcdBarrier b; b.bar = bar; b.x = xb_xcc_id(); b.st = st;
    if (threadIdx.x == 0) (void)xb_add(&bar[XB_XCNT(b.x)], 1u);
    return b;
}
__device__ __forceinline__ void xcd_barrier_complete(unsigned* bar, unsigned x, unsigned& nloc, unsigned& nx) {
    const unsigned G = gridDim.x * gridDim.y * gridDim.z;
    unsigned sum, cnt, mine, sp = 0u;
    for (;;) {
        sum = 0u; cnt = 0u; mine = 0u;
#pragma unroll
        for (unsigned j = 0; j < 16; ++j) { const unsigned c = xb_ld(&bar[XB_XCNT(j)]); sum += c; cnt += (c > 0u) ? 1u : 0u; mine = (j == x) ? c : mine; }
        if (sum == G) break;
        __builtin_amdgcn_s_sleep(1);
        if ((++sp & 255u) == 0u) { if (xb_ld(&bar[XB_TMO])) break; if (sp > XB_SPIN_CAP) { atomicAdd(&bar[XB_TMO], 1u); break; } }
    }
    nloc = mine > 0u ? mine : 1u; nx = cnt > 0u ? cnt : 1u;
}

__device__ __forceinline__ void xcd_barrier(const XcdBarrier& b) {
    asm volatile("s_waitcnt vmcnt(0)" ::: "memory");
    __syncthreads();
    if (threadIdx.x == 0) {
        unsigned* bar = b.bar;
        __builtin_amdgcn_s_waitcnt(0);
        unsigned nloc = b.st[0], nx = b.st[1];
        if (nloc == 0u) { xcd_barrier_complete(bar, b.x, nloc, nx); b.st[0] = nloc; b.st[1] = nx; }
        const unsigned old = xb_add(&bar[XB_XSUB(b.x)], 1u);
        const unsigned gen = old / nloc;
        if (old + 1u == (gen + 1u) * nloc) {
            __builtin_amdgcn_fence(__ATOMIC_RELEASE, "agent");
            asm volatile("s_waitcnt vmcnt(0)" ::: "memory");
            const unsigned og = xb_add(&bar[XB_TOP], 1u);
            const unsigned tg = og / nx;
            if (og + 1u == (tg + 1u) * nx) xb_add(&bar[XB_TOPGEN], 1u);
            else XB_SPIN(xb_ld(&bar[XB_TOPGEN]) == tg, bar);
            __builtin_amdgcn_fence(__ATOMIC_ACQUIRE, "agent");
            xb_add(&bar[XB_XGEN(b.x)], 1u);
            asm volatile("s_waitcnt vmcnt(0)" ::: "memory");
        } else {
            XB_SPIN(xb_ld(&bar[XB_XGEN(b.x)]) == gen, bar);
            __builtin_amdgcn_fence(__ATOMIC_ACQUIRE, "agent");
            asm volatile("s_waitcnt vmcnt(0)" ::: "memory");
        }
    }
    __syncthreads();
}

#ifndef MK_SPLIT
#define MK_SPLIT 0
#endif
constexpr int PPL = 6;
constexpr int NPHASE = 2 + PPL * DEPTH;
constexpr int RWP_BLOCKS = 14;
constexpr int CW_RWQ = 16384;
constexpr int NGRID = 256;
struct Args { const float* in[28]; float* out; unsigned char* ws; int ph_lo, ph_hi, li, pad; };

__global__ void __launch_bounds__(NWAVES * 64, 2) fwd(Args args) {
    extern __shared__ __attribute__((aligned(16))) unsigned char lds_raw[];
    LAS unsigned char* lds = (LAS unsigned char*)lds_raw;
    volatile LAS unsigned* MISC = (volatile LAS unsigned*)(lds + MISC_OFF);
    const int tid = threadIdx.x, lane = tid & 63, wave = __builtin_amdgcn_readfirstlane(tid >> 6);
    constexpr int G = NGRID; const int bx = blockIdx.x;
    const int vcu = (bx % 8) * (G / 8) + bx / 8;
    const int gw = vcu * NWAVES + wave; constexpr int NGW = G * NWAVES;
    unsigned char* ws = args.ws;
    const int lo = args.ph_lo, hi = args.ph_hi;

    for (int u = tid; u < (LDS_BYTES - LDSCTL_OFF) / 4; u += NWAVES * 64) ((LAS unsigned*)(lds + LDSCTL_OFF))[u] = 0u;
    __syncthreads();
    XcdBarrier bar; bar.bar = (unsigned*)(ws + WS_CTL) + CW_BAR; bar.x = 0; bar.st = MISC + 8;
    if (hi - lo > 1) bar = xcd_barrier_post((unsigned*)(ws + WS_CTL) + CW_BAR, MISC + 8);
#define IN(k) (lo <= (k) && (k) < hi)
#define SEAM(k) do { if (lo <= (k) && (k) + 1 < hi) { XcdBarrier b2_; b2_.bar = WSP(unsigned, WS_CTL) + CW_BAR; b2_.x = bar.x; b2_.st = bar.st; xcd_barrier(b2_); } } while (0)

#define OPQ_S(x) ({ int _t = (x); asm volatile("" : "+s"(_t)); _t; })
#define OPQ_V(x) ({ int _t = (x); asm volatile("" : "+v"(_t)); _t; })
#define INP(i) (args.in[OPQ_S(i)])
#define WSP(T, off) ((T*)(args.ws + ({ size_t _o = (off); asm volatile("" : "+s"(_o)); _o; })))
#define x_in INP(0)
#define c_in INP(1)
#define ctx_in INP(2)
#define cctx_in INP(3)
#define w_mod INP(4)
#define b_mod INP(5)
#define w_in INP(6)
#define w_out INP(7)
#define pool_w INP(8)
#define pool_scale INP(9)
#define na_qg INP(10)
#define na_kg INP(11)
#define na_rpb INP(12)
#define rw_mu_rkv INP(13)
#define rw_mu_lora INP(14)
#define rw_w0 INP(15)
#define rw_w_up INP(16)
#define rw_a0 INP(17)
#define rw_a_up INP(18)
#define rw_k_k INP(19)
#define rw_k_a INP(20)
#define rw_r_k INP(21)
#define rw_ln_w INP(22)
#define rw_ln_b INP(23)
#define sg_ln_w INP(24)
#define sg_ln_b INP(25)
#define sg_w INP(26)
#define sg_b INP(27)
#define MOD WSP(float, WS_MOD)
#define MODP WSP(float, WS_MODP)
#define TAB WSP(f32x2, WS_TAB)
#define SGST WSP(f32x2, WS_SGST)
#define BON WSP(float, WS_BON)
#define POOLWT WSP(bf16, WS_POOLWT)
#define WUPT WSP(bf16, WS_WUPT)
#define AUPT WSP(bf16, WS_AUPT)
#define SGW WSP(bf16, WS_SGW)
#define VTC WSP(bf16, WS_VTC)
#define VTL WSP(bf16, WS_VTL)
#define HCTX WSP(float, WS_HCTX)
#define QN WSP(bf16, WS_QN)
#define KN WSP(bf16, WS_KN)
#define WOUTT WSP(bf16, WS_WOUTT)
#define WINT WSP(bf16, WS_WINT)
#define XN WSP(bf16, WS_XN)
#define Y WSP(bf16, WS_Y)
#define P WSP(bf16, WS_P)
#define YR WSP(float, WS_YR)
#define REC WSP(float, WS_REC)
#define SILUC WSP(float, WS_SILUC)
    float* const out = args.out;

    if (IN(0)) {
        LAS float* scr = (LAS float*)(lds + wave * 16384);
        constexpr int I_MOD = 64 * 48  , I_WIN = 64 * (NIN / 32), I_WOUT = 64 * 128, I_POOL = 4 * 32, I_WUP = 2 * 32, I_AUP = 2 * 32, I_SGW = 256;
        constexpr int NITEMS = I_MOD + I_WIN + I_WOUT + I_POOL + I_WUP + I_AUP + I_SGW;
        for (int it = gw; it < NITEMS; it += NGW) {
            int r = it;
            if (r < I_MOD) { p0_mod_item(w_mod, c_in, cctx_in, MODP, scr, r, lane); continue; } r -= I_MOD;
            if (r < I_WIN) { p0_transpose_item<true>(w_in, DM, NIN, WINT, scr, r, lane); continue; } r -= I_WIN;
            if (r < I_WOUT) { p0_transpose_item(w_out, DM, DM, WOUTT, scr, r, lane); continue; } r -= I_WOUT;
            if (r < I_POOL) { const int g = r / 32; p0_transpose_item(pool_w + (size_t)g * 65536, 256, 256, POOLWT + (size_t)g * 65536, scr, r % 32, lane); continue; } r -= I_POOL;
            if (r < I_WUP) { const int dd = r / 32; p0_transpose_item(rw_w_up + (size_t)dd * 65536, 64, 1024, WUPT + (size_t)dd * 65536, scr, r % 32, lane); continue; } r -= I_WUP;
            if (r < I_AUP) { const int dd = r / 32; p0_transpose_item(rw_a_up + (size_t)dd * 65536, 64, 1024, AUPT + (size_t)dd * 65536, scr, r % 32, lane); continue; } r -= I_AUP;
            {   const size_t e0 = (size_t)r * 512 + lane * 8; const f32x4 a = *(const f32x4*)(sg_w + e0), b = *(const f32x4*)(sg_w + e0 + 4);
                v4u o; o.x = pk2(a.x, a.y); o.y = pk2(a.z, a.w); o.z = pk2(b.x, b.y); o.w = pk2(b.z, b.w); *(v4u*)(SGW + e0) = o; }
        }
        SEAM(0);
    }
    if (IN(1)) {

        for (int idx = gw * 64 + lane; idx < 3 * 4096; idx += NGW * 64) SILUC[idx] = silu_f(idx < 8192 ? c_in[idx] : cctx_in[idx - 8192]);
        for (int idx = gw * 64 + lane; idx < 3 * 12288; idx += NGW * 64) {
            const int l = idx / 36864, c = (idx / 12288) % 3, n = idx % 12288;
            float s = b_mod[l * 12288 + n];
            const float* pp = MODP + ((size_t)(l * 64) * 3 + c) * 12288 + n;
#pragma unroll 8
            for (int kc = 0; kc < 64; ++kc) s += pp[(size_t)kc * 3 * 12288];
            MOD[idx] = s;
        }
        for (int idx = gw * 64 + lane; idx < 2048; idx += NGW * 64) {
            const int pos = idx >> 4, i = idx & 15;
            float inv = (i & 3) == 0 ? 1.0f : ((i & 3) == 1 ? 0.5623413251903491f : ((i & 3) == 2 ? 0.31622776601683794f : 0.17782794100389228f));
            inv *= (i >> 2) == 0 ? 1.0f : ((i >> 2) == 1 ? 0.1f : ((i >> 2) == 2 ? 0.01f : 0.001f));
            float cc, sn; sincos_acc((float)pos * inv, cc, sn);
            TAB[idx] = (f32x2){cc, sn};
        }
        SEAM(1);
    }
    for (int l = 0; l < DEPTH; ++l) {
        const int pb = 2 + PPL * l;
        const bool with_ctx = l < DEPTH - 1;
#define hin_lat (l == 0 ? x_in : (const float*)out)
#define hin_ctx (l == 0 ? ctx_in : (const float*)HCTX)
#define mod (MOD + (size_t)l * 3 * 12288)
        const int nrows = with_ctx ? MROWS : NLAT;
        if (IN(pb + 0)) {
            phase_xn(hin_lat, hin_ctx, mod, XN, OPQ_S(gw), NGW, OPQ_V(lane));
            SEAM(pb + 0);
        }
        if (IN(pb + 1)) {
            constexpr int C0 = C_SPLIT, NA_ = NIN - C0;
            pg8::Gemm g{XN, WINT + (size_t)l * NIN * DM + (size_t)C0 * DM, MROWS, NA_, DM}; pg8::StaticOrder S; S.init(MROWS, NA_, G, bx);
            pg8::EpiStoreBf16 E{P + C0, NIN};
            pg8::gemm_phase<pg8::EpiStoreBf16, pg8::StaticOrder, true, true>(lds, g, S, E);
            SEAM(pb + 1);
        }
        if (IN(pb + 2)) {
            if (bx >= RWP_BLOCKS) {
                constexpr int NB_ = C_SPLIT;
                pg8::Gemm g{XN, WINT + (size_t)l * NIN * DM, MROWS, NB_, DM}; pg8::StaticOrder S; S.init(MROWS, NB_, G - RWP_BLOCKS, bx - RWP_BLOCKS);
                pg8::EpiStoreBf16 E{P, NIN};
                pg8::gemm_phase<pg8::EpiStoreBf16, pg8::StaticOrder, true, true>(lds, g, S, E);
            }
            phase_rwprep(P, rw_mu_rkv + (size_t)l * 6144, rw_mu_lora + (size_t)l * 256, rw_w0 + (size_t)l * 2048, WUPT + (size_t)l * 131072, rw_a0 + (size_t)l * 2048, AUPT + (size_t)l * 131072,
                         rw_k_k + (size_t)l * 1024, rw_k_a + (size_t)l * 1024, rw_r_k + (size_t)l * 1024, REC, BON, lds, WSP(unsigned, WS_CTL) + CW_RWQ + l * 1024, (bx * NWAVES + wave) & 15, wave, OPQ_V(lane));
            phase_rowprep(P, na_qg + l * 64, na_kg + l * 64, TAB, QN, KN, SGST, OPQ_S(gw), NGW, OPQ_V(lane));
            phase_vt(P, VTL, VTC, OPQ_S(gw), NGW, OPQ_V(lane));
            SEAM(pb + 2);
        }
        if (IN(pb + 3)) {
            {
            LAS unsigned* mixq = (LAS unsigned*)(lds + LDSCTL_OFF + 64); LAS unsigned* mixb = (LAS unsigned*)(lds + LDSCTL_OFF + 128); LAS unsigned* mixs = (LAS unsigned*)(lds + LDSCTL_OFF + 192);
            if (tid == 0) { *mixq = 0u; *mixb = 0u; *mixs = 0u; }
            __syncthreads();
#if defined(PROBE_CAT6)
            if (wave < 4) { const unsigned long long t0_ = __builtin_amdgcn_s_memrealtime(); scan_self(REC, YR, lds, mixb, bx, wave, OPQ_V(lane));
                const unsigned long long n_ = __builtin_amdgcn_s_memrealtime(), te_ = n_ + (n_ - t0_); while (__builtin_amdgcn_s_memrealtime() < te_) __builtin_amdgcn_s_sleep(16); }
#else
            if (wave < 4) scan_self(REC, YR, lds, mixb, bx, wave, OPQ_V(lane));
#endif
            else phase_sgu4(P, SGST, sg_ln_w + (size_t)l * 1024, sg_ln_b + (size_t)l * 1024, SGW + (size_t)l * 131072, sg_b + (size_t)l * 1024, Y, lds + SGUT_OFF, mixs, nrows / 128, OPQ_V(tid) - 256, wave - 4, OPQ_V(lane));
            {   const int nctxu = with_ctx ? 2 : 0, npool = (nrows / 16) * 4, npq = (npool + NGRID - 1) / NGRID, nwc = l + 1 < DEPTH ? (WC_ITEMS + NGRID - 1) / NGRID : 0, nmd = l + 1 < DEPTH ? (64 * 48) / NGRID : 0, nq = 64 + nctxu + npq + nwc + nmd;
                for (;;) {
                    unsigned k = 0; if (lane == 0) k = __hip_atomic_fetch_add(mixq, 1u, __ATOMIC_RELAXED, __HIP_MEMORY_SCOPE_WORKGROUP);
                    k = (unsigned)__builtin_amdgcn_readfirstlane((int)k);
                    if ((int)k >= nq) break;
                    const int ln = OPQ_V(lane);
                    if (k < 64u) { na_unit<false>(QN, KN, VTL, VTC, P, na_rpb + (size_t)l * 16 * 15 * 31, Y, vcu * 64 + (int)k, ln);
                    }
                    else if ((int)k < 64 + nctxu) na_unit<true>(QN, KN, VTL, VTC, P, na_rpb, Y, bx * 2 + ((int)k - 64), ln);
                    else if ((int)k >= 64 + nctxu + npq + nwc) mod_item_nolds(w_mod + (size_t)(l + 1) * 4096 * 12288, SILUC, MODP + (size_t)(l + 1) * 64 * 3 * 12288, bx + NGRID * ((int)k - 64 - nctxu - npq - nwc), ln);
                    else if ((int)k >= 64 + nctxu + npq) { const int r = bx + NGRID * ((int)k - 64 - nctxu - npq);
                        if (r < WC_ITEMS) weight_copy_item(l + 1, r, w_in, w_out, pool_w, rw_w_up, rw_a_up, sg_w, WINT, WOUTT, POOLWT, WUPT, AUPT, SGW, ln); }
                    else { const int u = bx + NGRID * ((int)k - 64 - nctxu);
                        if (u < npool) { const int tt = u >> 2, g = u & 3; const bf16* wbase = POOLWT + (size_t)l * 262144 + (size_t)g * 65536; const float* psc = pool_scale + (size_t)l * 1024;
                            if (g == 0) pool_unit<0>(P, wbase, psc, Y, tt * 16, ln); else if (g == 1) pool_unit<1>(P, wbase, psc, Y, tt * 16, ln);
                            else if (g == 2) pool_unit<2>(P, wbase, psc, Y, tt * 16, ln); else pool_unit<3>(P, wbase, psc, Y, tt * 16, ln); } }
                }
            }
            }
            SEAM(pb + 3);
        }
        if (IN(pb + 4)) {
            if (l + 1 < DEPTH) for (int idx = gw * 64 + lane; idx < 3 * 12288; idx += NGW * 64) {
                const int c = idx / 12288, n = idx % 12288; float s = b_mod[(l + 1) * 12288 + n];
                const float* pp = MODP + ((size_t)((l + 1) * 64) * 3 + c) * 12288 + n;
#pragma unroll 8
                for (int kc = 0; kc < 64; ++kc) s += pp[(size_t)kc * 3 * 12288];
                MOD[(size_t)(l + 1) * 3 * 12288 + idx] = s; }
            phase_rwfin(P, YR, REC, BON, rw_ln_w + (size_t)l * 1024, rw_ln_b + (size_t)l * 1024, Y, nrows, OPQ_S(gw), NGW, OPQ_V(lane));
            SEAM(pb + 4);
        }
        if (IN(pb + 5)) {
            pg8::Gemm g{Y, WOUTT + (size_t)l * DM * DM, nrows, DM, DM}; pg8::StaticOrder S; S.init(nrows, DM, G, bx);
            pg8::EpiResGate E{hin_lat, hin_ctx, out, HCTX, mod};
            pg8::gemm_phase<pg8::EpiResGate, pg8::StaticOrder, true, true>(lds, g, S, E);
            SEAM(pb + 5);
        }
    }
#undef IN
#undef SEAM
}
#undef hin_lat
#undef hin_ctx
#undef mod
#undef P
#undef Y
#undef XN
#undef out

extern "C" void kernel_launch(void* const* d_in, const int* in_sizes, int n_in, void* d_out, int out_size, void* d_ws, size_t ws_size, hipStream_t stream) {
    static int grid = 0;
    if (grid == 0) {
        if (n_in != 28 || out_size != NLAT * DM || ws_size < WS_END) { fprintf(stderr, "kernel_launch: unexpected shapes (n_in %d, out %d, ws %zu < %zu); nothing launched\n", n_in, out_size, ws_size, (size_t)WS_END); grid = -1; return; }
        int dev = 0, cus = 0, per_cu = 0;
        if (hipGetDevice(&dev) != hipSuccess || hipDeviceGetAttribute(&cus, hipDeviceAttributeMultiprocessorCount, dev) != hipSuccess) { grid = -1; return; }
        if (hipFuncSetAttribute((const void*)fwd, hipFuncAttributeMaxDynamicSharedMemorySize, LDS_BYTES) != hipSuccess) { fprintf(stderr, "kernel_launch: hipFuncSetAttribute failed\n"); grid = -1; return; }
        if (hipOccupancyMaxActiveBlocksPerMultiprocessor(&per_cu, (const void*)fwd, NWAVES * 64, LDS_BYTES) != hipSuccess || per_cu < 1)
            fprintf(stderr, "kernel_launch: note: occupancy query reports %d workgroups per CU\n", per_cu);
        (void)hipGetLastError();
        grid = cus >= NGRID ? NGRID : -2;
    }
    if (grid == -1) return;
    if (hipMemsetAsync((char*)d_ws + WS_CTL, 0, CTL_ZERO_BYTES, stream) != hipSuccess) { fprintf(stderr, "kernel_launch: memset failed\n"); return; }
    Args a{};
    for (int i = 0; i < 28; ++i) a.in[i] = (const float*)d_in[i];
    a.out = (float*)d_out; a.ws = (unsigned char*)d_ws; a.li = 0; a.pad = 0;
    const bool split = MK_SPLIT || grid == -2;
    if (split) { for (int k = 0; k < NPHASE; ++k) { a.ph_lo = k; a.ph_hi = k + 1; hipLaunchKernelGGL(fwd, dim3(NGRID), dim3(NWAVES * 64), LDS_BYTES, stream, a); } }
    else { a.ph_lo = 0; a.ph_hi = NPHASE; hipLaunchKernelGGL(fwd, dim3(NGRID), dim3(NWAVES * 64), LDS_BYTES, stream, a); }
    const hipError_t le = hipPeekAtLastError();
    if (le != hipSuccess) fprintf(stderr, "kernel_launch: launch failed: %s\n", hipGetErrorName(le));
}
```

```cpp
#include <hip/hip_runtime.h>
#include <cstdio>
#include <cstdint>
#define MK_SPLIT 0
namespace pg8 {
#define PG8_LAS __attribute__((address_space(3)))
typedef unsigned short bf16_t;
typedef short bf16x8 __attribute__((ext_vector_type(8)));
typedef float f32x4 __attribute__((ext_vector_type(4)));
typedef unsigned u32x4 __attribute__((ext_vector_type(4)));
constexpr int BM = 256, BK = 64, HALF = 128, HTB = HALF * BK * 2  , STAGE_BYTES = 8 * HTB, NXCD = 8, WGM = 8;

__host__ __device__ __forceinline__ int lds_byte(int r, int c) { const int st = (r >> 4) * 2 + (c >> 5), rr = r & 15, cc = c & 31, ob = rr * 64 + cc * 2; return st * 1024 + (ob ^ (((ob >> 9) & 1) << 5)); }
__host__ __device__ __forceinline__ void stage_rc(int b, int& R, int& C) { const int st = b / 1024, sb = b % 1024, swz = sb ^ (((sb >> 9) & 1) << 5); R = (st >> 1) * 16 + swz / 64; C = (st & 1) * 32 + (swz % 64) / 2; }
__host__ __device__ __forceinline__ int perm32(int rho) { const int n = rho >> 4, i = rho & 15; return 8 * (i >> 2) + 4 * n + (i & 3); }

struct Unit { int pm, pn; };
struct Gemm { const bf16_t* A; const bf16_t* Bt; int M, N, K; };

struct StaticOrder {
    int nM, nN, nwg, G, c;
    __host__ __device__ void init(int M, int N, int G_, int c_) { nM = M / BM; nN = N / BM; nwg = nM * nN; G = G_; c = c_; }
    __host__ __device__ bool next(int i, Unit& u) const {
        const long L = (long)i * G + c; if (L >= nwg) return false;
        int wgid = (int)L; { const int q = nwg / NXCD, r = nwg % NXCD, xcd = wgid % NXCD, off = wgid / NXCD; wgid = (xcd < r ? xcd * (q + 1) : r * (q + 1) + (xcd - r) * q) + off; }
        const int nig = WGM * nN, gid = wgid / nig, fm = gid * WGM, gsz = (nM - fm) < WGM ? (nM - fm) : WGM;
        u.pm = fm + ((wgid % nig) % gsz); u.pn = (wgid % nig) / gsz; return true;
    }
    __device__ __forceinline__ void a_ready(const Unit&) const {}
    __device__ __forceinline__ void done(const Unit&) const {}
};

__device__ __forceinline__ unsigned cvt_pk_bf16(float lo, float hi) { unsigned r; asm volatile("v_cvt_pk_bf16_f32 %0, %1, %2" : "=v"(r) : "v"(lo), "v"(hi)); return r; }
template <class Epi, class Sched, bool ALIGN_EPI = false, bool SP2 = false>
__device__ __forceinline__ void gemm_phase(PG8_LAS unsigned char* lds, const Gemm g, const Sched& S, const Epi& E) {
    int tid_ = threadIdx.x; asm volatile("" : "+v"(tid_));
    const int tid = tid_, wid = __builtin_amdgcn_readfirstlane(tid >> 6), lane = tid & 63, wr = wid >> 2, wc = wid & 3, fr = lane & 15, fq = lane >> 4;
    const int K = g.K, nt = K / BK;
    unsigned voffA[2], voffB[2];
#pragma unroll
    for (int i = 0; i < 2; ++i) { int R, C; stage_rc(tid * 16 + i * 8192, R, C); const int Rb = Epi::PERM ? ((R & ~31) + perm32(R & 31)) : R;
        voffA[i] = (unsigned)(R * K + C) * 2u; voffB[i] = (unsigned)(Rb * K + C) * 2u; }
    const size_t kstep = (size_t)(BK * 2);
    const size_t hstep = (size_t)HALF * K * 2;
    const size_t tstep = 2 * hstep;
    const unsigned ldsw = (unsigned)wid * 1024u;
    const int aoff = lds_byte(wr * 64 + fr, fq * 8), boff = lds_byte(wc * 32 + fr, fq * 8);
#define PG8_SA(b, h) (((b) * 2 + (h)) * HTB)
#define PG8_SB(b, h) ((4 + (b) * 2 + (h)) * HTB)
#define PG8_STAGE(bufoff, gbase, voff) do { _Pragma("unroll") for (int _i = 0; _i < 2; ++_i) \
        __builtin_amdgcn_global_load_lds((const unsigned*)((const char*)(gbase) + (voff)[_i]), (PG8_LAS unsigned*)(lds + (bufoff) + ldsw + _i * 8192), 16, 0, 0); } while (0)
#define PG8_LDA(dst, b, h) do { _Pragma("unroll") for (int m = 0; m < 4; ++m) _Pragma("unroll") for (int k = 0; k < 2; ++k) dst[m][k] = *(const PG8_LAS bf16x8*)(lds + PG8_SA(b, h) + aoff + m * 2048 + k * 1024); } while (0)
#define PG8_LDB(dst, b, h) do { _Pragma("unroll") for (int n = 0; n < 2; ++n) _Pragma("unroll") for (int k = 0; k < 2; ++k) dst[n][k] = *(const PG8_LAS bf16x8*)(lds + PG8_SB(b, h) + boff + n * 2048 + k * 1024); } while (0)
#define PG8_MMA(ai, bj, At, Bt) do { __builtin_amdgcn_s_setprio(1); _Pragma("unroll") for (int m = 0; m < 4; ++m) _Pragma("unroll") for (int n = 0; n < 2; ++n) _Pragma("unroll") for (int k = 0; k < 2; ++k) \
        acc[ai][bj][m][n] = __builtin_amdgcn_mfma_f32_16x16x32_bf16(Bt[n][k], At[m][k], acc[ai][bj][m][n], 0, 0, 0); __builtin_amdgcn_s_setprio(0); } while (0)
#define PG8_WAIT_V(n) asm volatile("s_waitcnt vmcnt(" #n ")" ::: "memory")
#define PG8_WAIT_L(n) asm volatile("s_waitcnt lgkmcnt(" #n ")" ::: "memory")
#define PG8_BAR __builtin_amdgcn_s_barrier()
#define PG8_SCHED __builtin_amdgcn_sched_barrier(0)
    Unit cur, nxt; int ui = 0;
    if (!S.next(0, cur)) return;
    f32x4 acc[2][2][4][2];
#pragma unroll
    for (int a = 0; a < 2; ++a)
#pragma unroll
        for (int b = 0; b < 2; ++b)
#pragma unroll
            for (int m = 0; m < 4; ++m)
#pragma unroll
                for (int n = 0; n < 2; ++n) acc[a][b][m][n] = (f32x4){0.f, 0.f, 0.f, 0.f};
    bf16x8 At[4][2], B0[2][2], B1[2][2];
    const char* cA = (const char*)g.A + (size_t)cur.pm * tstep; const char* cB = (const char*)g.Bt + (size_t)cur.pn * tstep;
    S.a_ready(cur);
    if constexpr (SP2) {
        PG8_STAGE(PG8_SB(0, 0), cB, voffB); PG8_STAGE(PG8_SB(0, 1), cB + hstep, voffB); PG8_STAGE(PG8_SA(0, 0), cA, voffA); PG8_STAGE(PG8_SA(0, 1), cA + hstep, voffA);
        if (wr == 1) PG8_BAR;
        PG8_WAIT_V(2); PG8_BAR;
        PG8_STAGE(PG8_SB(1, 0), cB + kstep, voffB); PG8_STAGE(PG8_SA(1, 0), cA + kstep, voffA); PG8_STAGE(PG8_SB(1, 1), cB + hstep + kstep, voffB);
        PG8_WAIT_V(6); PG8_BAR;
    } else {
        PG8_STAGE(PG8_SB(0, 0), cB, voffB); PG8_STAGE(PG8_SA(0, 0), cA, voffA); PG8_STAGE(PG8_SB(0, 1), cB + hstep, voffB); PG8_STAGE(PG8_SA(0, 1), cA + hstep, voffA);
        if (wr == 1) PG8_BAR;
        PG8_WAIT_V(4); PG8_BAR;
        PG8_STAGE(PG8_SB(1, 0), cB + kstep, voffB); PG8_STAGE(PG8_SA(1, 0), cA + kstep, voffA); PG8_STAGE(PG8_SB(1, 1), cB + hstep + kstep, voffB);
        PG8_WAIT_V(6); PG8_BAR;
    }
    for (;;) {
        const bool has_next = S.next(ui + 1, nxt);
        const char* nA = has_next ? (const char*)g.A + (size_t)nxt.pm * tstep : cA; const char* nB = has_next ? (const char*)g.Bt + (size_t)nxt.pn * tstep : cB;
        for (int t = 0; t < nt; t += 2) {
            const bool last = (t == nt - 2);
            const char* a1 = cA + (size_t)(t + 1) * kstep;
            const char* a2 = last ? nA : cA + (size_t)(t + 2) * kstep; const char* b2 = last ? nB : cB + (size_t)(t + 2) * kstep;
            const char* a3 = a2 + kstep; const char* b3 = b2 + kstep;
            if (last && has_next) S.a_ready(nxt);
            if constexpr (SP2) {
            PG8_LDB(B0, 0, 0); PG8_LDB(B1, 0, 1); PG8_SCHED; PG8_LDA(At, 0, 0); PG8_STAGE(PG8_SA(1, 1), a1 + hstep, voffA);
            PG8_WAIT_V(8); PG8_WAIT_L(0); PG8_BAR; PG8_MMA(0, 0, At, B0); PG8_MMA(0, 1, At, B1); PG8_BAR; PG8_SCHED;
            PG8_LDA(At, 0, 1); PG8_STAGE(PG8_SB(0, 0), b2, voffB); PG8_STAGE(PG8_SB(0, 1), b2 + hstep, voffB); PG8_STAGE(PG8_SA(0, 0), a2, voffA);
            PG8_WAIT_V(8); PG8_WAIT_L(0); PG8_BAR; PG8_MMA(1, 0, At, B0); PG8_MMA(1, 1, At, B1); PG8_BAR; PG8_SCHED;
            PG8_LDB(B0, 1, 0); PG8_LDB(B1, 1, 1); PG8_SCHED; PG8_LDA(At, 1, 0); PG8_STAGE(PG8_SA(0, 1), a2 + hstep, voffA);
            PG8_WAIT_V(8); PG8_WAIT_L(0); PG8_BAR; PG8_MMA(0, 0, At, B0); PG8_MMA(0, 1, At, B1); PG8_BAR; PG8_SCHED;
            PG8_LDA(At, 1, 1); PG8_STAGE(PG8_SB(1, 0), b3, voffB); PG8_STAGE(PG8_SB(1, 1), b3 + hstep, voffB); PG8_STAGE(PG8_SA(1, 0), a3, voffA);
            PG8_WAIT_V(8); PG8_WAIT_L(0); PG8_BAR; PG8_MMA(1, 0, At, B0); PG8_MMA(1, 1, At, B1); PG8_BAR; PG8_SCHED;
            } else {
            PG8_LDB(B0, 0, 0); PG8_SCHED; PG8_LDA(At, 0, 0); PG8_STAGE(PG8_SA(1, 1), a1 + hstep, voffA);
            PG8_WAIT_L(8); PG8_BAR; PG8_WAIT_L(0); PG8_MMA(0, 0, At, B0); PG8_BAR; PG8_SCHED;
            PG8_LDB(B1, 0, 1); PG8_STAGE(PG8_SB(0, 0), b2, voffB);
            PG8_BAR; PG8_WAIT_L(0); PG8_MMA(0, 1, At, B1); PG8_BAR;
            PG8_LDA(At, 0, 1); PG8_STAGE(PG8_SA(0, 0), a2, voffA);
            PG8_BAR; PG8_WAIT_L(0); PG8_MMA(1, 0, At, B0); PG8_BAR; PG8_SCHED;
            PG8_STAGE(PG8_SB(0, 1), b2 + hstep, voffB);
            PG8_WAIT_V(6); PG8_BAR; PG8_MMA(1, 1, At, B1); PG8_BAR;
            PG8_LDB(B0, 1, 0); PG8_SCHED; PG8_LDA(At, 1, 0); PG8_STAGE(PG8_SA(0, 1), a2 + hstep, voffA);
            PG8_WAIT_L(8); PG8_BAR; PG8_WAIT_L(0); PG8_MMA(0, 0, At, B0); PG8_BAR; PG8_SCHED;
            PG8_LDB(B1, 1, 1); PG8_STAGE(PG8_SB(1, 0), b3, voffB);
            PG8_BAR; PG8_WAIT_L(0); PG8_MMA(0, 1, At, B1); PG8_BAR;
            PG8_LDA(At, 1, 1); PG8_STAGE(PG8_SA(1, 0), a3, voffA);
            PG8_BAR; PG8_WAIT_L(0); PG8_MMA(1, 0, At, B0); PG8_BAR; PG8_SCHED;
            PG8_STAGE(PG8_SB(1, 1), b3 + hstep, voffB);
            PG8_WAIT_V(6); PG8_BAR; PG8_MMA(1, 1, At, B1); PG8_BAR;
            }
        }
        if constexpr (ALIGN_EPI) { if (wr == 0) PG8_BAR; }
        if constexpr (!Epi::AFTER_DRAIN) { E(acc, cur, wr, wc, fr, fq); S.done(cur); }
        if (!has_next) break;
#pragma unroll
        for (int a = 0; a < 2; ++a)
#pragma unroll
            for (int b = 0; b < 2; ++b)
#pragma unroll
                for (int m = 0; m < 4; ++m)
#pragma unroll
                    for (int n = 0; n < 2; ++n) acc[a][b][m][n] = (f32x4){0.f, 0.f, 0.f, 0.f};
        cur = nxt; cA = nA; cB = nB; ++ui;
        if constexpr (ALIGN_EPI) { if (wr == 1) PG8_BAR; }
    }
    PG8_WAIT_V(0);
    if constexpr (!ALIGN_EPI) { if (wr == 0) PG8_BAR; }
    PG8_BAR;
    if constexpr (Epi::AFTER_DRAIN) { E.fused(acc, cur, wr, wc, fr, fq, lds, wid, lane); S.done(cur); }
#undef PG8_SA
#undef PG8_SB
#undef PG8_STAGE
#undef PG8_LDA
#undef PG8_LDB
#undef PG8_MMA
#undef PG8_WAIT_V
#undef PG8_WAIT_L
#undef PG8_BAR
#undef PG8_SCHED
}
}

constexpr int DM = 4096, NBATCH = 2, SEQ = 8192, DEPTH = 4, CTXL = 256;
constexpr int NLAT = NBATCH * SEQ, NCTX = NBATCH * CTXL, MROWS = NLAT + NCTX;
constexpr int NIN = 13568, GWD = 1024;
constexpr int C_POOLV = 0, C_POOLZ = 1024, C_NAZ = 2048, C_RWZ = 3072, C_SGU = 4096, C_SGZ = 5120, C_NAQ = 6144, C_NAK = 7168, C_NAV = 8192, C_RWR = 9216, C_RWK = 10240, C_RWV = 11264,
              C_RWWD = 12288, C_RWAD = 12416, C_SGV = 12544;
constexpr int C_SPLIT = 5632;
__host__ __device__ __forceinline__ int phys_tile(int lt) {
    return lt < 8 ? lt : lt < 20 ? lt + 16 : lt < 24 ? lt - 12 : lt < 36 ? lt + 12 : lt < 40 ? lt - 24 : lt == 40 ? 48 : lt < 45 ? lt - 25 : lt < 49 ? lt + 4 : lt - 29;
}
constexpr int SCANLEN = CTXL + SEQ;
constexpr int NCHAIN = 64;
constexpr int RECB = 768;
constexpr int RECF = RECB / 4;
constexpr int NWAVES = 8;

constexpr size_t MiB = 1u << 20;
constexpr size_t WS_CTL = 0, CTL_ZERO_BYTES = 1 * MiB;
constexpr size_t WS_MOD   = 2 * MiB;
constexpr size_t WS_TAB   = 3 * MiB;
constexpr size_t WS_SILUC = 3 * MiB + 512 * 1024;
constexpr size_t WS_SGST  = 4 * MiB;
constexpr size_t WS_BON   = 5 * MiB;
constexpr size_t WS_POOLWT= 8 * MiB;
constexpr size_t WS_WUPT  = 10 * MiB;
constexpr size_t WS_AUPT  = 11 * MiB;
constexpr size_t WS_SGW   = 12 * MiB;
constexpr size_t WS_VTC   = 13 * MiB;
constexpr size_t WS_HCTX  = 14 * MiB;
constexpr size_t WS_MODP  = 22 * MiB;
constexpr size_t WS_VTL   = 58 * MiB;
constexpr size_t WS_QN    = 90 * MiB;
constexpr size_t WS_KN    = 123 * MiB;
constexpr size_t WS_WOUTT = 156 * MiB;
constexpr size_t WS_WINT  = 284 * MiB;
constexpr size_t WS_XN    = 708 * MiB;
constexpr size_t WS_Y     = 840 * MiB;
constexpr size_t WS_P     = 972 * MiB;
constexpr size_t WS_YR    = 1410 * MiB;
constexpr size_t WS_REC   = 1542 * MiB;
constexpr size_t WS_END   = 2334 * MiB;
static_assert(WS_P + (size_t)MROWS * NIN * 2 <= WS_YR && WS_REC + (size_t)NCHAIN * SCANLEN * RECB <= WS_END && WS_WINT + (size_t)4 * NIN * DM * 2 <= WS_XN, "ws map");
constexpr int CW_TMO = 0, CW_BAR = 4096;

constexpr int RING_BYTES = 131072, SCANRING_BYTES = 4 * 32 * RECB, SGUT_OFF = SCANRING_BYTES, LDSCTL_OFF = SGUT_OFF + 128 * 136 * 2, MISC_OFF = LDSCTL_OFF + 320, LDS_BYTES = LDSCTL_OFF + 1024;

#define GAS __attribute__((address_space(1)))
#define LAS __attribute__((address_space(3)))
typedef unsigned short bf16;
typedef unsigned v4u __attribute__((ext_vector_type(4)));
typedef unsigned v2u __attribute__((ext_vector_type(2)));
typedef float f32x4 __attribute__((ext_vector_type(4)));
typedef float f32x2 __attribute__((ext_vector_type(2)));
typedef short bf16x8 __attribute__((ext_vector_type(8)));
typedef _Float16 h4 __attribute__((ext_vector_type(4)));
typedef _Float16 h8 __attribute__((ext_vector_type(8)));
#define RLX_AGENT __ATOMIC_RELAXED, __HIP_MEMORY_SCOPE_AGENT
#define LDS_WAIT() asm volatile("s_waitcnt lgkmcnt(0)" ::: "memory")

__device__ __forceinline__ float bf2f(unsigned short h) { return __uint_as_float(((unsigned)h) << 16); }
__device__ __forceinline__ float bflo(unsigned w) { return __uint_as_float(w << 16); }
__device__ __forceinline__ float bfhi(unsigned w) { return __uint_as_float(w & 0xffff0000u); }
typedef __bf16 bf16x2_t __attribute__((ext_vector_type(2)));
__device__ __forceinline__ unsigned pk2(float lo, float hi) { const f32x2 v = {lo, hi}; const bf16x2_t b = __builtin_convertvector(v, bf16x2_t); return __builtin_bit_cast(unsigned, b); }
__device__ __forceinline__ unsigned f2bf(float f) { return pk2(f, 0.f) & 0xffffu; }
__device__ __forceinline__ float rcp_f(float x) { return __builtin_amdgcn_rcpf(x); }
__device__ __forceinline__ float rsq_f(float x) { return __builtin_amdgcn_rsqf(x); }
__device__ __forceinline__ void unpack8(const v4u w, float* x) { x[0] = bflo(w.x); x[1] = bfhi(w.x); x[2] = bflo(w.y); x[3] = bfhi(w.y); x[4] = bflo(w.z); x[5] = bfhi(w.z); x[6] = bflo(w.w); x[7] = bfhi(w.w); }
__device__ __forceinline__ v4u pack8(const float* x) { v4u w; w.x = pk2(x[0], x[1]); w.y = pk2(x[2], x[3]); w.z = pk2(x[4], x[5]); w.w = pk2(x[6], x[7]); return w; }
__device__ __forceinline__ float silu_f(float x) { return x * rcp_f(1.f + __expf(-x)); }
__device__ __forceinline__ float wave_sum(float v) {
#pragma unroll
    for (int o = 1; o < 64; o <<= 1) v += __shfl_xor(v, o);
    return v;
}
template <int CTRL> __device__ __forceinline__ float dppf(float v) { return __builtin_bit_cast(float, __builtin_amdgcn_update_dpp(0, __builtin_bit_cast(int, v), CTRL, 0xF, 0xF, true)); }
__device__ __forceinline__ float red16(float v) { v += dppf<0xB1>(v); v += dppf<0x4E>(v); v += dppf<0x141>(v); v += dppf<0x140>(v); return v; }
__device__ __forceinline__ void red16x2(float& a, float& b) {
    a += dppf<0xB1>(a); b += dppf<0xB1>(b); a += dppf<0x4E>(a); b += dppf<0x4E>(b); a += dppf<0x141>(a); b += dppf<0x141>(b); a += dppf<0x140>(a); b += dppf<0x140>(b); }
__device__ __forceinline__ float red16_transpose(const float (&y)[16], int c16) {
    float a[8], b[4], c[2];
    const bool h8 = (c16 & 8) != 0, h4 = (c16 & 4) != 0, h2 = (c16 & 2) != 0, h1 = (c16 & 1) != 0;
#pragma unroll
    for (int j = 0; j < 8; ++j) { const float keep = h8 ? y[j + 8] : y[j], send = h8 ? y[j] : y[j + 8]; a[j] = keep + dppf<0x140>(send); }
#pragma unroll
    for (int j = 0; j < 4; ++j) { const float keep = h4 ? a[j + 4] : a[j], send = h4 ? a[j] : a[j + 4]; b[j] = keep + dppf<0x141>(send); }
#pragma unroll
    for (int j = 0; j < 2; ++j) { const float keep = h2 ? b[j + 2] : b[j], send = h2 ? b[j] : b[j + 2]; c[j] = keep + dppf<0x1B>(send); }
    const float keep = h1 ? c[1] : c[0], send = h1 ? c[0] : c[1];
    return keep + dppf<0xB1>(send);
}
__device__ __forceinline__ float max16x4(float v) { v = fmaxf(v, __shfl_xor(v, 16)); v = fmaxf(v, __shfl_xor(v, 32)); return v; }
__device__ __forceinline__ float sum16x4(float v) { v += __shfl_xor(v, 16); v += __shfl_xor(v, 32); return v; }
__device__ __forceinline__ int scan_pos(int d, bool isctx, int t) { return d == 0 ? (isctx ? t : CTXL + t) : (isctx ? (CTXL - 1 - t) : (CTXL + SEQ - 1 - t)); }
__device__ __forceinline__ f32x4 mfma16(bf16x8 a, bf16x8 b, f32x4 c) { return __builtin_amdgcn_mfma_f32_16x16x32_bf16(a, b, c, 0, 0, 0); }
__device__ __forceinline__ bf16x8 ld_frag(const bf16* p) { return __builtin_bit_cast(bf16x8, *(const v4u*)p); }

namespace pg8 {
struct EpiStoreBf16 {
    static constexpr bool PERM = true, AFTER_DRAIN = false;
    bf16_t* O; int ldc;
    __device__ __forceinline__ void operator()(const f32x4 (&acc)[2][2][4][2], const Unit& u, int wr, int wc, int fr, int fq) const {
        const int row0 = u.pm * BM + wr * 64 + fr, col0 = u.pn * BM + wc * 32 + 8 * fq;
#pragma unroll
        for (int ai = 0; ai < 2; ++ai)
#pragma unroll
            for (int m = 0; m < 4; ++m) { bf16_t* rowp = O + (size_t)(row0 + ai * HALF + m * 16) * ldc + col0;
#pragma unroll
                for (int bj = 0; bj < 2; ++bj) { const f32x4 v0 = acc[ai][bj][m][0], v1 = acc[ai][bj][m][1];
                    u32x4 w; w.x = cvt_pk_bf16(v0[0], v0[1]); w.y = cvt_pk_bf16(v0[2], v0[3]); w.z = cvt_pk_bf16(v1[0], v1[1]); w.w = cvt_pk_bf16(v1[2], v1[3]);
                    *(u32x4*)(rowp + bj * HALF) = w; } }
    }
};
struct EpiResGate {
    static constexpr bool PERM = false, AFTER_DRAIN = false;
    const float* hin_lat; const float* hin_ctx; float* hout_lat; float* hout_ctx; const float* gate;
    __device__ __forceinline__ void operator()(const f32x4 (&acc)[2][2][4][2], const Unit& u, int wr, int wc, int fr, int fq) const {
        const int cond = u.pm < 32 ? 0 : (u.pm < 64 ? 1 : 2);
        const int rloc = (u.pm < 64 ? u.pm * BM : (u.pm - 64) * BM) + wr * 64 + fr, col0 = u.pn * BM + wc * 32 + 4 * fq;
        const float* hin = u.pm < 64 ? hin_lat : hin_ctx; float* hout = u.pm < 64 ? hout_lat : hout_ctx;
        f32x4 gv[2][2];
#pragma unroll
        for (int bj = 0; bj < 2; ++bj)
#pragma unroll
            for (int n = 0; n < 2; ++n) gv[bj][n] = *(const f32x4*)(gate + cond * 12288 + 8192 + col0 + bj * HALF + n * 16);
#pragma unroll
        for (int ai = 0; ai < 2; ++ai)
#pragma unroll
            for (int m = 0; m < 4; ++m) { const size_t off = (size_t)(rloc + ai * HALF + m * 16) * 4096 + col0;
#pragma unroll
                for (int bj = 0; bj < 2; ++bj)
#pragma unroll
                    for (int n = 0; n < 2; ++n) { const f32x4 b = *(const f32x4*)(hin + off + bj * HALF + n * 16);
                        *(f32x4*)(hout + off + bj * HALF + n * 16) = b + gv[bj][n] * acc[ai][bj][m][n]; } }
    }
};
}

template <bool PERMC = false>
__device__ __forceinline__ void p0_transpose_item(const float* W, int K, int N, bf16* WT, LAS float* scr, int item, int lane) {
    const int nblk = N / 32, kb = item / nblk, nb = item % nblk, k0 = 64 * kb, n0 = 32 * nb;
    const int pn0 = PERMC ? phys_tile(n0 >> 8) * 256 + (n0 & 255) : n0;
#pragma unroll 8
    for (int i = 0; i < 32; ++i) { const int kk = 2 * i + (lane >> 5); scr[kk * 33 + (lane & 31)] = W[(size_t)(k0 + kk) * N + n0 + (lane & 31)]; }
    LDS_WAIT(); asm volatile("" ::: "memory");
    const int c = lane & 7;
#pragma unroll
    for (int j = 0; j < 4; ++j) { const int n = (lane >> 3) + 8 * j; const LAS float* s = scr + (8 * c) * 33 + n;
        v4u o; o.x = pk2(s[0 * 33], s[1 * 33]); o.y = pk2(s[2 * 33], s[3 * 33]); o.z = pk2(s[4 * 33], s[5 * 33]); o.w = pk2(s[6 * 33], s[7 * 33]);
        *(v4u*)(WT + (size_t)(pn0 + n) * K + k0 + 8 * c) = o; }
    LDS_WAIT(); asm volatile("" ::: "memory");
}
template <bool PERMC = false>
__device__ __forceinline__ void transpose_item_nolds(const float* W, int K, int N, bf16* WT, int item, int lane) {
    const int nblk = N / 64, kb = item / nblk, nb = item % nblk, k0 = 64 * kb, n0 = 64 * nb;
    const int pn0 = PERMC ? phys_tile(n0 >> 8) * 256 + (n0 & 255) : n0;
    const float* src = W + (size_t)k0 * N + n0 + lane;
    bf16* dst = WT + (size_t)(pn0 + lane) * K + k0;
#pragma unroll
    for (int hb = 0; hb < 2; ++hb) {
        float v[32];
#pragma unroll
        for (int i = 0; i < 32; ++i) v[i] = __builtin_nontemporal_load(src + (size_t)(32 * hb + i) * N);
        __builtin_amdgcn_sched_barrier(0);
#pragma unroll
        for (int j = 0; j < 4; ++j) { v4u o; o.x = pk2(v[8 * j], v[8 * j + 1]); o.y = pk2(v[8 * j + 2], v[8 * j + 3]); o.z = pk2(v[8 * j + 4], v[8 * j + 5]); o.w = pk2(v[8 * j + 6], v[8 * j + 7]);
            *(v4u*)(dst + 32 * hb + 8 * j) = o; }
        __builtin_amdgcn_sched_barrier(0);
    }
}
constexpr int WC_WIN = (DM / 64) * (NIN / 64), WC_WOUT = (DM / 64) * (DM / 64), WC_POOL = 4 * 16, WC_WUP = 2 * 16, WC_AUP = 2 * 16, WC_SGW = 256, WC_ITEMS = WC_WIN + WC_WOUT + WC_POOL + WC_WUP + WC_AUP + WC_SGW;
__device__ __forceinline__ void weight_copy_item(int L, int r, const float* w_in, const float* w_out, const float* pool_w, const float* rw_w_up, const float* rw_a_up, const float* sg_w,
                                                 bf16* WINT, bf16* WOUTT, bf16* POOLWT, bf16* WUPT, bf16* AUPT, bf16* SGW, int lane) {
    if (r < WC_WIN) { transpose_item_nolds<true>(w_in + (size_t)L * DM * NIN, DM, NIN, WINT + (size_t)L * NIN * DM, r, lane); return; } r -= WC_WIN;
    if (r < WC_WOUT) { transpose_item_nolds(w_out + (size_t)L * DM * DM, DM, DM, WOUTT + (size_t)L * DM * DM, r, lane); return; } r -= WC_WOUT;
    if (r < WC_POOL) { const int g = r >> 4; transpose_item_nolds(pool_w + (size_t)(L * 4 + g) * 65536, 256, 256, POOLWT + (size_t)(L * 4 + g) * 65536, r & 15, lane); return; } r -= WC_POOL;
    if (r < WC_WUP) { const int dd = r >> 4; transpose_item_nolds(rw_w_up + (size_t)(L * 2 + dd) * 65536, 64, 1024, WUPT + (size_t)(L * 2 + dd) * 65536, r & 15, lane); return; } r -= WC_WUP;
    if (r < WC_AUP) { const int dd = r >> 4; transpose_item_nolds(rw_a_up + (size_t)(L * 2 + dd) * 65536, 64, 1024, AUPT + (size_t)(L * 2 + dd) * 65536, r & 15, lane); return; } r -= WC_AUP;
    {   const size_t e0 = (size_t)L * 131072 + (size_t)r * 512 + lane * 8; const f32x4 a = *(const f32x4*)(sg_w + e0), b = *(const f32x4*)(sg_w + e0 + 4);
        v4u o; o.x = pk2(a.x, a.y); o.y = pk2(a.z, a.w); o.z = pk2(b.x, b.y); o.w = pk2(b.z, b.w); *(v4u*)(SGW + e0) = o; }
}
__device__ __forceinline__ void p0_mod_item(const float* wmod, const float* cvec, const float* cctx, float* MODP, LAS float* scr, int item, int lane) {
    const int l = item / (64 * 48), r = item % (64 * 48), kc = r / 48, nc = r % 48, k0 = kc * 64, n0 = nc * 256 + lane * 4;
    scr[lane] = silu_f(cvec[k0 + lane]); scr[64 + lane] = silu_f(cvec[4096 + k0 + lane]); scr[128 + lane] = silu_f(cctx[k0 + lane]);
    LDS_WAIT(); asm volatile("" ::: "memory");
    f32x4 a0 = {0.f, 0.f, 0.f, 0.f}, a1 = a0, a2 = a0;
    const float* wp = wmod + ((size_t)l * 4096 + k0) * 12288 + n0;
#pragma unroll 16
    for (int k = 0; k < 64; ++k) { const f32x4 w = *(const f32x4*)(wp + (size_t)k * 12288); a0 += scr[k] * w; a1 += scr[64 + k] * w; a2 += scr[128 + k] * w; }
    float* o = MODP + ((size_t)(l * 64 + kc) * 3) * 12288 + n0;
    *(f32x4*)(o) = a0; *(f32x4*)(o + 12288) = a1; *(f32x4*)(o + 2 * 12288) = a2;
    LDS_WAIT(); asm volatile("" ::: "memory");
}
__device__ __forceinline__ void mod_item_nolds(const float* wmod_l  , const float* siluc, float* MODP_l  , int item, int lane) {
    const int kc = item / 48, nc = item % 48, k0 = kc * 64, n0 = nc * 256 + lane * 4;
    f32x4 a0 = {0.f, 0.f, 0.f, 0.f}, a1 = a0, a2 = a0;
    const float* wp = wmod_l + (size_t)k0 * 12288 + n0;
    const int s0v = __builtin_bit_cast(int, siluc[k0 + lane]), s1v = __builtin_bit_cast(int, siluc[4096 + k0 + lane]), s2v = __builtin_bit_cast(int, siluc[8192 + k0 + lane]);
#pragma unroll
    for (int k = 0; k < 64; ++k) { const f32x4 w = __builtin_nontemporal_load((const f32x4*)(wp + (size_t)k * 12288));
        a0 += __builtin_bit_cast(float, __builtin_amdgcn_readlane(s0v, k)) * w; a1 += __builtin_bit_cast(float, __builtin_amdgcn_readlane(s1v, k)) * w; a2 += __builtin_bit_cast(float, __builtin_amdgcn_readlane(s2v, k)) * w; }
    float* o = MODP_l + ((size_t)kc * 3) * 12288 + n0;
    *(f32x4*)(o) = a0; *(f32x4*)(o + 12288) = a1; *(f32x4*)(o + 2 * 12288) = a2;
}
__device__ __forceinline__ void sincos_acc(float ang, float& c, float& s) {
    const double x = (double)ang; const double n = __builtin_rint(x * 0.63661977236758134308); const double r = x - n * 1.57079632679489661923;
    const double r2 = r * r;
    const double sp = r * (1.0 + r2 * (-1.0 / 6 + r2 * (1.0 / 120 + r2 * (-1.0 / 5040 + r2 * (1.0 / 362880 + r2 * (-1.0 / 39916800 + r2 * (1.0 / 6227020800.0)))))));
    const double cp = 1.0 + r2 * (-0.5 + r2 * (1.0 / 24 + r2 * (-1.0 / 720 + r2 * (1.0 / 40320 + r2 * (-1.0 / 3628800 + r2 * (1.0 / 479001600 + r2 * (-1.0 / 87178291200.0)))))));
    const int q = ((int)n) & 3;
    const double cc = (q == 0) ? cp : (q == 1) ? -sp : (q == 2) ? -cp : sp;
    const double ss = (q == 0) ? sp : (q == 1) ? cp : (q == 2) ? -sp : -cp;
    c = (float)cc; s = (float)ss;
}

__device__ __forceinline__ void phase_xn(const float* hlat, const float* hctx, const float* mod, bf16* XN, int gw, int NGW, int lane) {
    for (int m = gw; m < MROWS; m += NGW) {
        const float* src = m < NLAT ? hlat + (size_t)m * DM : hctx + (size_t)(m - NLAT) * DM;
        const int cond = m < NLAT ? (m >> 13) : 2;
        const f32x4* s4 = (const f32x4*)src + lane;
        f32x4 v[16]; float ss = 0.f;
#pragma unroll
        for (int j = 0; j < 16; ++j) { v[j] = __builtin_nontemporal_load(s4 + 64 * j); ss += (v[j].x * v[j].x + v[j].y * v[j].y) + (v[j].z * v[j].z + v[j].w * v[j].w); }
        ss = wave_sum(ss);
        const float rstd = rsq_f(ss * (1.f / 4096.f) + 1e-6f);
        const f32x4* sh4 = (const f32x4*)(mod + cond * 12288) + lane; const f32x4* sc4 = (const f32x4*)(mod + cond * 12288 + 4096) + lane;
        v2u* o = (v2u*)(XN + (size_t)m * DM) + lane;
#pragma unroll
        for (int j = 0; j < 16; ++j) { const f32x4 sh = sh4[64 * j], sc = sc4[64 * j]; const f32x4 x = v[j] * rstd * (sc + 1.f) + sh; v2u w; w.x = pk2(x.x, x.y); w.y = pk2(x.z, x.w); o[64 * j] = w; }
    }
}

__device__ __forceinline__ void phase_rowprep(const bf16* P, const float* qgain, const float* kgain, const f32x2* tab, bf16* QN, bf16* KN, f32x2* SGST, int gw, int NGW, int lane) {
    const int sub = lane & 3;
    for (int m = gw; m < MROWS; m += NGW) {
        const bf16* pr = P + (size_t)m * NIN;
        const bool isctx = m >= NLAT; const int t = isctx ? ((m - NLAT) & 255) : (m & 8191);
        {   float x[16]; unpack8(*(const v4u*)(pr + C_SGV + 16 * lane), x); unpack8(*(const v4u*)(pr + C_SGV + 16 * lane + 8), x + 8);
            float s = 0.f;
#pragma unroll
            for (int i = 0; i < 16; ++i) s += x[i];
            const float mean = wave_sum(s) * (1.f / 1024.f); float q = 0.f;
#pragma unroll
            for (int i = 0; i < 16; ++i) { const float dlt = x[i] - mean; q += dlt * dlt; }
            const float var = wave_sum(q) * (1.f / 1024.f);
            if (lane == 0) SGST[m] = (f32x2){mean, rsq_f(var + 1e-5f)}; }
        float q[16], k[16];
        unpack8(*(const v4u*)(pr + C_NAQ + 16 * lane), q); unpack8(*(const v4u*)(pr + C_NAQ + 16 * lane + 8), q + 8);
        unpack8(*(const v4u*)(pr + C_NAK + 16 * lane), k); unpack8(*(const v4u*)(pr + C_NAK + 16 * lane + 8), k + 8);
        float sq = 0.f, sk = 0.f;
#pragma unroll
        for (int i = 0; i < 16; ++i) { sq += q[i] * q[i]; sk += k[i] * k[i]; }
        sq += __shfl_xor(sq, 1); sq += __shfl_xor(sq, 2); sk += __shfl_xor(sk, 1); sk += __shfl_xor(sk, 2);
        const float rq = rsq_f(sq * (1.f / 64.f) + 1e-6f), rk = rsq_f(sk * (1.f / 64.f) + 1e-6f);
#pragma unroll
        for (int i = 0; i < 16; ++i) { q[i] *= rq * qgain[16 * sub + i]; k[i] *= rk * kgain[16 * sub + i]; }
        if (!isctx) {
            const int pos = sub < 2 ? (t >> 6) : (t & 63);
#pragma unroll
            for (int i = 0; i < 16; ++i) { const f32x2 cs = tab[pos * 16 + i]; const float pq = __shfl_xor(q[i], 1), pkk = __shfl_xor(k[i], 1);
                q[i] = (sub & 1) ? (q[i] * cs.x + pq * cs.y) : (q[i] * cs.x - pq * cs.y);
                k[i] = (sub & 1) ? (k[i] * cs.x + pkk * cs.y) : (k[i] * cs.x - pkk * cs.y); }
        }
#pragma unroll
        for (int i = 0; i < 16; ++i) q[i] *= 0.125f;
        *(v4u*)(QN + (size_t)m * GWD + 16 * lane) = pack8(q); *(v4u*)(QN + (size_t)m * GWD + 16 * lane + 8) = pack8(q + 8);
        *(v4u*)(KN + (size_t)m * GWD + 16 * lane) = pack8(k); *(v4u*)(KN + (size_t)m * GWD + 16 * lane + 8) = pack8(k + 8);
    }
}
__device__ __forceinline__ void phase_vt(const bf16* P, bf16* VTL, bf16* VTC, int gw, int NGW, int lane) {
    for (int u = gw; u < (MROWS / 64) * 16; u += NGW) {
        const int tt = u >> 4, h = u & 15, m0 = tt * 64;
        const bf16* src = P + (size_t)m0 * NIN + C_NAV + h * 64 + lane;
        unsigned w[32];
#pragma unroll
        for (int i = 0; i < 32; ++i) { const unsigned lo = src[(size_t)(2 * i) * NIN], hi = src[(size_t)(2 * i + 1) * NIN]; w[i] = lo | (hi << 16); }
        bf16* dst = tt < 256 ? VTL + (((size_t)((tt >> 7) * 16 + h) * 64 + lane) * 8192 + (tt & 127) * 64)
                             : VTC + (((size_t)(((tt - 256) >> 2) * 16 + h) * 64 + lane) * 256 + ((tt - 256) & 3) * 64);
#pragma unroll
        for (int j = 0; j < 8; ++j) { v4u o; o.x = w[4 * j]; o.y = w[4 * j + 1]; o.z = w[4 * j + 2]; o.w = w[4 * j + 3]; ((v4u*)dst)[j] = o; }
    }
}
template <int G>
__device__ __forceinline__ void pool_unit(const bf16* P, const bf16* wbase, const float* pscale, bf16* Y, int m0, int lane) {
    constexpr int WIN = 2 << G;
    const int r = lane & 15, q4 = lane >> 4, m = m0 + r;
    const bool isctx = m0 >= NLAT; const int T = isctx ? CTXL : SEQ; const int t = isctx ? ((m - NLAT) & 255) : (m & 8191);
    const int tlo = t - (WIN >> 1);
    const int lo = tlo < 0 ? 0 : tlo, hi = (tlo + WIN) > T ? T : (tlo + WIN);
    const float inv = rcp_f((float)(hi - lo));
    f32x4 acc[16];
#pragma unroll
    for (int nt = 0; nt < 16; ++nt) acc[nt] = (f32x4){0.f, 0.f, 0.f, 0.f};
#pragma unroll 1
    for (int ks = 0; ks < 8; ++ks) {
        const int ch0 = C_POOLV + G * 256 + 32 * ks + 8 * q4;
        constexpr int WB = WIN < 8 ? WIN : 8;
        bf16x8 bfr[8];
        float sum[8];
#pragma unroll
        for (int j = 0; j < 8; ++j) sum[j] = 0.f;
        const v4u selfw = *(const v4u*)(P + (size_t)m * NIN + ch0);
#pragma unroll
        for (int nt = 0; nt < 8; ++nt) bfr[nt] = ld_frag(wbase + (size_t)(16 * nt + r) * 256 + 32 * ks + 8 * q4);
        bf16x8 bfr2[8];
#pragma unroll
        for (int nt = 0; nt < 8; ++nt) bfr2[nt] = ld_frag(wbase + (size_t)(16 * (nt + 8) + r) * 256 + 32 * ks + 8 * q4);
#pragma unroll
        for (int k0 = 0; k0 < WIN; k0 += WB) {
            v4u wl[WB];
#pragma unroll
            for (int k = 0; k < WB; ++k) { const int tk = tlo + k0 + k; const bool ok = tk >= 0 && tk < T; wl[k] = *(const v4u*)(P + (size_t)(ok ? (m - t + tk) : m) * NIN + ch0); }
            __builtin_amdgcn_sched_barrier(0);
#pragma unroll
            for (int k = 0; k < WB; ++k) { const int tk = tlo + k0 + k; const bool ok = tk >= 0 && tk < T; float x[8]; unpack8(wl[k], x);
#pragma unroll
                for (int j = 0; j < 8; ++j) sum[j] += ok ? x[j] : 0.f; }
            __builtin_amdgcn_sched_barrier(0);
        }
        float self[8]; unpack8(selfw, self);
        float dv[8];
#pragma unroll
        for (int j = 0; j < 8; ++j) dv[j] = sum[j] * inv - self[j];
        const bf16x8 af = __builtin_bit_cast(bf16x8, pack8(dv));
        __builtin_amdgcn_sched_barrier(0);
#pragma unroll
        for (int nt = 0; nt < 8; ++nt) acc[nt] = mfma16(af, bfr[nt], acc[nt]);
        __builtin_amdgcn_sched_barrier(0);
#pragma unroll
        for (int nt = 0; nt < 8; ++nt) acc[nt + 8] = mfma16(af, bfr2[nt], acc[nt + 8]);
        __builtin_amdgcn_sched_barrier(0);
    }
#pragma unroll
    for (int nh = 0; nh < 4; ++nh) {
        unsigned short zz[4][4]; float ps[4];
#pragma unroll
        for (int nq = 0; nq < 4; ++nq) { const int oc = G * 256 + 16 * (4 * nh + nq) + r; ps[nq] = pscale[oc];
#pragma unroll
            for (int i = 0; i < 4; ++i) zz[nq][i] = P[(size_t)(m0 + 4 * q4 + i) * NIN + C_POOLZ + oc]; }
        __builtin_amdgcn_sched_barrier(0);
#pragma unroll
        for (int nq = 0; nq < 4; ++nq) { const int oc = G * 256 + 16 * (4 * nh + nq) + r;
#pragma unroll
            for (int i = 0; i < 4; ++i) Y[(size_t)(m0 + 4 * q4 + i) * DM + oc] = (bf16)f2bf(acc[4 * nh + nq][i] * ps[nq] * silu_f(bf2f(zz[nq][i]))); }
        __builtin_amdgcn_sched_barrier(0);
    }
}
__device__ __forceinline__ void phase_pool(const bf16* P, const bf16* PWT  , const float* pscale, bf16* Y, int nrows, int gw, int NGW, int lane) {
    for (int u = gw; u < (nrows / 16) * 4; u += NGW) {
        const int tt = u >> 2, g = u & 3, m0 = tt * 16;
        const bf16* wbase = PWT + (size_t)g * 65536;
        if (g == 0) pool_unit<0>(P, wbase, pscale, Y, m0, lane);
        else if (g == 1) pool_unit<1>(P, wbase, pscale, Y, m0, lane);
        else if (g == 2) pool_unit<2>(P, wbase, pscale, Y, m0, lane);
        else pool_unit<3>(P, wbase, pscale, Y, m0, lane);
    }
}
#define REC_ST(p, v) __builtin_nontemporal_store((v), (p))
__device__ __forceinline__ void phase_rwprep(const bf16* P, const float* mu_rkv  , const float* mu_lora  , const float* w0  , const bf16* WUPT  ,
                                             const float* a0, const bf16* AUPT, const float* k_k, const float* k_a, const float* r_k, float* REC, float* BON, LAS unsigned char* lds,
                                             unsigned* queue  , int cls, int wave, int lane) {
    const int n = lane & 15, q4 = lane >> 4;
    const int d = cls >> 3, hp = cls & 7;
    unsigned* qh = queue + 64 * cls;
    LAS float* prm = (LAS float*)(lds + wave * 4096);
#pragma unroll
    for (int it = 0; it < 16; ++it) { const int hh = it >> 3, p = it & 7, ch = (hp * 2 + hh) * 64 + lane;
        const float* src = p == 0 ? w0 + d * 1024 : p == 1 ? a0 + d * 1024 : p == 2 ? mu_rkv + (d * 3 + 0) * 1024 : p == 3 ? mu_rkv + (d * 3 + 1) * 1024 : p == 4 ? mu_rkv + (d * 3 + 2) * 1024 : p == 5 ? k_k : p == 6 ? k_a : r_k;
        prm[it * 64 + lane] = src[ch]; }
    LDS_WAIT(); asm volatile("" ::: "memory");
    unsigned pend = 0u;
    if (lane == 0) pend = __hip_atomic_fetch_add(qh, 1u, __ATOMIC_RELAXED, __HIP_MEMORY_SCOPE_AGENT);
    for (;;) {
        const int tt = __builtin_amdgcn_readfirstlane((int)pend);
        if (tt >= MROWS / 16) break;
        if (lane == 0) pend = __hip_atomic_fetch_add(qh, 1u, __ATOMIC_RELAXED, __HIP_MEMORY_SCOPE_AGENT);
        const int m0 = tt * 16;
        const bool isctx = m0 >= NLAT; const int T = isctx ? CTXL : SEQ; const int t0 = isctx ? ((m0 - NLAT) & 255) : (m0 & 8191); const int b = isctx ? ((m0 - NLAT) >> 8) : (m0 >> 13);
        const int m = m0 + n, t = t0 + n; const bool hasnb = d == 0 ? (t > 0) : (t < T - 1); const int nbr = hasnb ? (d == 0 ? m - 1 : m + 1) : m;
        const bf16* prow = P + (size_t)m * NIN; const bf16* nrow = P + (size_t)nbr * NIN;
        bf16x8 Bw[2], Ba[2];
        {   v4u cw[2], nw[2], ca[2], na[2]; f32x4 mw[2][2], ma[2][2];
#pragma unroll
            for (int ks = 0; ks < 2; ++ks) { const int j0 = 32 * ks + 8 * q4;
                cw[ks] = *(const v4u*)(prow + C_RWWD + d * 64 + j0); nw[ks] = *(const v4u*)(nrow + C_RWWD + d * 64 + j0);
                ca[ks] = *(const v4u*)(prow + C_RWAD + d * 64 + j0); na[ks] = *(const v4u*)(nrow + C_RWAD + d * 64 + j0);
                mw[ks][0] = *(const f32x4*)(mu_lora + (d * 2 + 0) * 64 + j0); mw[ks][1] = *(const f32x4*)(mu_lora + (d * 2 + 0) * 64 + j0 + 4);
                ma[ks][0] = *(const f32x4*)(mu_lora + (d * 2 + 1) * 64 + j0); ma[ks][1] = *(const f32x4*)(mu_lora + (d * 2 + 1) * 64 + j0 + 4); }
            __builtin_amdgcn_sched_barrier(0);
#pragma unroll
            for (int ks = 0; ks < 2; ++ks) {
                float cur[8], nb[8], o[8];
                unpack8(cw[ks], cur); unpack8(nw[ks], nb);
#pragma unroll
                for (int j = 0; j < 8; ++j) { const float xx = cur[j] + ((hasnb ? nb[j] : 0.f) - cur[j]) * mw[ks][j >> 2][j & 3]; o[j] = 1.0f - 2.0f * rcp_f(1.0f + __expf(2.0f * xx)); }
                Bw[ks] = __builtin_bit_cast(bf16x8, pack8(o));
                unpack8(ca[ks], cur); unpack8(na[ks], nb);
#pragma unroll
                for (int j = 0; j < 8; ++j) o[j] = cur[j] + ((hasnb ? nb[j] : 0.f) - cur[j]) * ma[ks][j >> 2][j & 3];
                Ba[ks] = __builtin_bit_cast(bf16x8, pack8(o)); }
        }
        const int pos = scan_pos(d, isctx, t);
#pragma unroll 1
        for (int hh = 0; hh < 2; ++hh) {
            const int head = hp * 2 + hh, chain = (b * 2 + d) * 16 + head;
            char* recb = (char*)REC + ((size_t)chain * SCANLEN + pos) * RECB;
            const LAS float* pr = prm + hh * 512;
            float KK[16], AV[16]; float ss = 0.f, bon = 0.f;
#pragma unroll
            for (int hf = 0; hf < 2; ++hf) {
                const int cl = 32 * hf + 8 * q4, cg = head * 64 + cl;
                bf16x8 wf[2][2], af[2][2];
#pragma unroll
                for (int tq = 0; tq < 2; ++tq) { const size_t wrow = (size_t)(d * 1024 + head * 64 + 32 * hf + 8 * (n >> 2) + 4 * tq + (n & 3)) * 64 + 8 * q4;
                    wf[tq][0] = ld_frag(WUPT + wrow); wf[tq][1] = ld_frag(WUPT + wrow + 32); af[tq][0] = ld_frag(AUPT + wrow); af[tq][1] = ld_frag(AUPT + wrow + 32); }
                const v4u rcw = *(const v4u*)(prow + C_RWR + cg), kcw = *(const v4u*)(prow + C_RWK + cg), vcw = *(const v4u*)(prow + C_RWV + cg);
                const v4u rnw = *(const v4u*)(nrow + C_RWR + cg), knw = *(const v4u*)(nrow + C_RWK + cg), vnw = *(const v4u*)(nrow + C_RWV + cg);
                __builtin_amdgcn_sched_barrier(0);
                f32x4 accW[2], accA[2];
#pragma unroll
                for (int tq = 0; tq < 2; ++tq) { f32x4 z = {0.f, 0.f, 0.f, 0.f}; z = mfma16(wf[tq][0], Bw[0], z); accW[tq] = mfma16(wf[tq][1], Bw[1], z);
                                                 f32x4 y = {0.f, 0.f, 0.f, 0.f}; y = mfma16(af[tq][0], Ba[0], y); accA[tq] = mfma16(af[tq][1], Ba[1], y); }
                float rc[8], kc[8], vc[8], rn[8], kn[8], vn[8];
                unpack8(rcw, rc); unpack8(kcw, kc); unpack8(vcw, vc); unpack8(rnw, rn); unpack8(knw, kn); unpack8(vnw, vn);
                float dec[8], kp[8], rr[8], vv[8];
#pragma unroll
                for (int g = 0; g < 2; ++g) {
                    const f32x4 w0v = *(const LAS f32x4*)(pr + 0 * 64 + cl + 4 * g), a0v = *(const LAS f32x4*)(pr + 1 * 64 + cl + 4 * g), mur = *(const LAS f32x4*)(pr + 2 * 64 + cl + 4 * g),
                                muk = *(const LAS f32x4*)(pr + 3 * 64 + cl + 4 * g), muv = *(const LAS f32x4*)(pr + 4 * 64 + cl + 4 * g), kkv = *(const LAS f32x4*)(pr + 5 * 64 + cl + 4 * g),
                                kav = *(const LAS f32x4*)(pr + 6 * 64 + cl + 4 * g), rkv = *(const LAS f32x4*)(pr + 7 * 64 + cl + 4 * g);
#pragma unroll
                    for (int i = 0; i < 4; ++i) { const int j = 4 * g + i;
                        const float rnb = hasnb ? rn[j] : 0.f, knb = hasnb ? kn[j] : 0.f, vnb = hasnb ? vn[j] : 0.f;
                        const float r_ = rc[j] + (rnb - rc[j]) * mur[i], k0 = kc[j] + (knb - kc[j]) * muk[i], v_ = vc[j] + (vnb - vc[j]) * muv[i];
                        const float xw = -(w0v[i] + accW[g][i]);
                        const float sp = fmaxf(xw, 0.f) + __logf(1.0f + __expf(-fabsf(xw)));
                        dec[j] = __expf(-__expf(-sp - 0.5f));
                        const float av = rcp_f(1.0f + __expf(-(a0v[i] + accA[g][i])));
                        const float kx = k0 * kkv[i]; ss += kx * kx;
                        const float kp_ = k0 * (1.f + (av - 1.f) * kav[i]); bon += r_ * kp_ * rkv[i];
                        KK[8 * hf + j] = kx; AV[8 * hf + j] = av; kp[j] = kp_; rr[j] = r_; vv[j] = v_; }
                }
                char* ob = recb + cl * 2;
                REC_ST((h8*)(ob), ((h8){(_Float16)(1.0f - dec[0]), (_Float16)(1.0f - dec[1]), (_Float16)(1.0f - dec[2]), (_Float16)(1.0f - dec[3]), (_Float16)(1.0f - dec[4]), (_Float16)(1.0f - dec[5]), (_Float16)(1.0f - dec[6]), (_Float16)(1.0f - dec[7])}));
                REC_ST((h8*)(ob + 384), ((h8){(_Float16)kp[0], (_Float16)kp[1], (_Float16)kp[2], (_Float16)kp[3], (_Float16)kp[4], (_Float16)kp[5], (_Float16)kp[6], (_Float16)kp[7]}));
                REC_ST((h8*)(ob + 512), ((h8){(_Float16)rr[0], (_Float16)rr[1], (_Float16)rr[2], (_Float16)rr[3], (_Float16)rr[4], (_Float16)rr[5], (_Float16)rr[6], (_Float16)rr[7]}));
                REC_ST((h8*)(ob + 640), ((h8){(_Float16)vv[0], (_Float16)vv[1], (_Float16)vv[2], (_Float16)vv[3], (_Float16)vv[4], (_Float16)vv[5], (_Float16)vv[6], (_Float16)vv[7]}));
                __builtin_amdgcn_sched_barrier(0);
            }
            ss = sum16x4(ss); bon = sum16x4(bon);
            const float inv = rsq_f(fmaxf(ss, 1e-12f));
#pragma unroll
            for (int hf = 0; hf < 2; ++hf) { char* ob = recb + (32 * hf + 8 * q4) * 2; float kkn[8], nka[8];
#pragma unroll
                for (int j = 0; j < 8; ++j) { kkn[j] = KK[8 * hf + j] * inv; nka[j] = -(kkn[j] * AV[8 * hf + j]); }
                REC_ST((h8*)(ob + 128), ((h8){(_Float16)kkn[0], (_Float16)kkn[1], (_Float16)kkn[2], (_Float16)kkn[3], (_Float16)kkn[4], (_Float16)kkn[5], (_Float16)kkn[6], (_Float16)kkn[7]}));
                REC_ST((h8*)(ob + 256), ((h8){(_Float16)nka[0], (_Float16)nka[1], (_Float16)nka[2], (_Float16)nka[3], (_Float16)nka[4], (_Float16)nka[5], (_Float16)nka[6], (_Float16)nka[7]})); }
            if (q4 == 0) BON[(size_t)chain * SCANLEN + pos] = bon;
        }
    }
}
template <bool CTXQ>
__device__ __forceinline__ void na_unit(const bf16* QN, const bf16* KN, const bf16* VTL, const bf16* VTC, const bf16* P, const float* rpb  , bf16* Y, int u, int lane) {
    const int n = lane & 15, q4 = lane >> 4;
    int b, h, qrow0, qr = 0, jt = 0;
    if (CTXQ) { b = u >> 8; h = (u >> 4) & 15; qrow0 = NLAT + b * CTXL + 16 * (u & 15); }
    else { jt = u & 3; h = (u >> 2) & 15; qr = (u >> 6) & 127; b = u >> 13; qrow0 = b * SEQ + qr * 64 + 16 * jt; }
    constexpr int NT = CTXQ ? 16 : 32, WT = CTXQ ? 0 : 16;
    f32x4 s[NT];
    const int rs = qr - 4 < 0 ? 0 : (qr - 4 > 120 ? 120 : qr - 4);
    const int span0 = jt == 0 ? 0 : (jt == 1 ? 8 : (jt == 2 ? 24 : 32));
    const int qc = 16 * jt + n; const int cs = qc - 8 < 0 ? 0 : (qc - 8 > 48 ? 48 : qc - 8);
    bf16x8 qf[2];
#pragma unroll
    for (int ks = 0; ks < 2; ++ks) qf[ks] = ld_frag(QN + (size_t)(qrow0 + n) * GWD + h * 64 + 32 * ks + 8 * q4);
    if (!CTXQ) {
        const float* rp = rpb + (size_t)h * 15 * 31;
#pragma unroll
        for (int wt = 0; wt < 16; ++wt) { const int kri = wt >> 1, half = wt & 1, relr = rs + kri - qr + 7;
#pragma unroll
            for (int i = 0; i < 4; ++i) { const int relc = span0 + 8 * q4 + 4 * half + i - qc + 15; const int relcc = relc < 0 ? 0 : (relc > 30 ? 30 : relc); s[wt][i] = rp[relr * 31 + relcc]; } }
        __builtin_amdgcn_sched_barrier(0);
#pragma unroll
        for (int bt = 0; bt < 2; ++bt) {
            bf16x8 kf[16];
#pragma unroll
            for (int t = 0; t < 8; ++t) { const int wt = bt * 8 + t, kri = wt >> 1, half = wt & 1;
                const bf16* kp = KN + (size_t)(b * SEQ + (rs + kri) * 64 + span0 + 8 * (n >> 2) + 4 * half + (n & 3)) * GWD + h * 64 + 8 * q4; kf[2 * t] = ld_frag(kp); kf[2 * t + 1] = ld_frag(kp + 32); }
            __builtin_amdgcn_sched_barrier(0);
#pragma unroll
            for (int t = 0; t < 8; ++t) { const int wt = bt * 8 + t, half = wt & 1;
                f32x4 a = s[wt];
#pragma unroll
                for (int i = 0; i < 4; ++i) { const int kc = span0 + 8 * q4 + 4 * half + i; const bool ok = kc >= cs && kc < cs + 16; a[i] = ok ? a[i] : -INFINITY; }
                a = mfma16(kf[2 * t], qf[0], a); a = mfma16(kf[2 * t + 1], qf[1], a); s[wt] = a; }
            __builtin_amdgcn_sched_barrier(0);
        }
    }
#pragma unroll
    for (int bt = 0; bt < 2; ++bt) {
        bf16x8 kf[16];
#pragma unroll
        for (int t = 0; t < 8; ++t) { const int ctile = bt * 8 + t; const bf16* kp = KN + (size_t)(NLAT + b * CTXL + 32 * (ctile >> 1) + 8 * (n >> 2) + 4 * (ctile & 1) + (n & 3)) * GWD + h * 64 + 8 * q4; kf[2 * t] = ld_frag(kp); kf[2 * t + 1] = ld_frag(kp + 32); }
        __builtin_amdgcn_sched_barrier(0);
#pragma unroll
        for (int t = 0; t < 8; ++t) { f32x4 a = {0.f, 0.f, 0.f, 0.f}; a = mfma16(kf[2 * t], qf[0], a); a = mfma16(kf[2 * t + 1], qf[1], a); s[WT + bt * 8 + t] = a; }
        __builtin_amdgcn_sched_barrier(0);
    }
    float mx = -INFINITY;
#pragma unroll
    for (int t = 0; t < NT; ++t) mx = fmaxf(fmaxf(fmaxf(s[t][0], s[t][1]), fmaxf(s[t][2], s[t][3])), mx);
    mx = max16x4(mx);
    float sum = 0.f;
#pragma unroll
    for (int t = 0; t < NT; ++t) {
#pragma unroll
        for (int i = 0; i < 4; ++i) { const float e = __expf(s[t][i] - mx); s[t][i] = e; sum += e; } }
    sum = sum16x4(sum);
    const float inv = rcp_f(sum);
    f32x4 o[4];
#pragma unroll
    for (int nt = 0; nt < 4; ++nt) o[nt] = (f32x4){0.f, 0.f, 0.f, 0.f};
#pragma unroll
    for (int tb = 0; tb < NT / 8; ++tb) {
        v4u vv[4][4];
#pragma unroll
        for (int tq = 0; tq < 4; ++tq) { const int tp = tb * 4 + tq;
            const bf16* vb; size_t dstride;
            if (!CTXQ && tp < 8) { vb = VTL + ((size_t)(b * 16 + h) * 64 + n) * 8192 + (rs + tp) * 64 + span0 + 8 * q4; dstride = (size_t)16 * 8192; }
            else { const int cp = tp - (CTXQ ? 0 : 8); vb = VTC + ((size_t)(b * 16 + h) * 64 + n) * 256 + 32 * cp + 8 * q4; dstride = (size_t)16 * 256; }
#pragma unroll
            for (int nt = 0; nt < 4; ++nt) vv[tq][nt] = *(const v4u*)(vb + nt * dstride); }
        __builtin_amdgcn_sched_barrier(0);
#pragma unroll
        for (int tq = 0; tq < 4; ++tq) { const int tp = tb * 4 + tq;
            const f32x4 p0 = s[2 * tp] * inv, p1 = s[2 * tp + 1] * inv;
            v4u aw; aw.x = pk2(p0[0], p0[1]); aw.y = pk2(p0[2], p0[3]); aw.z = pk2(p1[0], p1[1]); aw.w = pk2(p1[2], p1[3]);
            const bf16x8 af = __builtin_bit_cast(bf16x8, aw);
#pragma unroll
            for (int nt = 0; nt < 4; ++nt) o[nt] = mfma16(af, __builtin_bit_cast(bf16x8, vv[tq][nt]), o[nt]); }
        __builtin_amdgcn_sched_barrier(0);
    }
    unsigned short zz[4][4];
#pragma unroll
    for (int nt = 0; nt < 4; ++nt)
#pragma unroll
        for (int i = 0; i < 4; ++i) zz[nt][i] = P[(size_t)(qrow0 + 4 * q4 + i) * NIN + C_NAZ + h * 64 + 16 * nt + n];
    __builtin_amdgcn_sched_barrier(0);
#pragma unroll
    for (int nt = 0; nt < 4; ++nt)
#pragma unroll
        for (int i = 0; i < 4; ++i) { const int row = qrow0 + 4 * q4 + i, col = h * 64 + 16 * nt + n;
            Y[(size_t)row * DM + 1024 + col] = (bf16)f2bf(o[nt][i] * silu_f(bf2f(zz[nt][i]))); }
}
__device__ __forceinline__ void bar4(LAS unsigned* cnt, unsigned& seq, int lane) {
    asm volatile("s_waitcnt vmcnt(0) lgkmcnt(0)" ::: "memory");
    const unsigned baddr = (unsigned)(size_t)cnt, one = 1u; seq += 4u;
    if (lane == 0) asm volatile("ds_add_u32 %0, %1" :: "v"(baddr), "v"(one) : "memory");
    unsigned sp = 0, got;
    for (;;) { asm volatile("ds_read_b32 %0, %1\n\ts_waitcnt lgkmcnt(0)" : "=v"(got) : "v"(baddr) : "memory");
        if (__builtin_amdgcn_readfirstlane((int)got) >= (int)seq) break; __builtin_amdgcn_s_sleep(1); if (++sp > (1u << 22)) break; }
    asm volatile("" ::: "memory");
}
__device__ __forceinline__ void phase_sgu4(const bf16* P, const f32x2* SGST, const float* lnw, const float* lnb, const bf16* SGW, const float* sgb, bf16* Y,
                                           LAS unsigned char* ldsT, LAS unsigned* cnt, int nchunks, int tid4  , int w4  , int lane) {
    const int n = lane & 15, q4 = lane >> 4;
    LAS bf16* T = (LAS bf16*)ldsT; unsigned seq = 0u;
    for (int u = blockIdx.x; u < nchunks * 8; u += 256) {
        const int ck = u >> 3, g = u & 7, m0 = ck * 128;
#pragma unroll
        for (int it = 0; it < 8; ++it) { const int idx = tid4 + 256 * it, q = idx >> 4, c8 = idx & 15;
            float x[8]; unpack8(*(const v4u*)(P + (size_t)(m0 + q) * NIN + C_SGV + g * 128 + 8 * c8), x);
            const f32x2 st = SGST[m0 + q];
#pragma unroll
            for (int j = 0; j < 8; ++j) { const int c = 8 * c8 + j; const float v = (x[j] - st.x) * st.y * lnw[g * 128 + c] + lnb[g * 128 + c]; T[c * 136 + q] = (bf16)f2bf(v); } }
        bar4(cnt, seq, lane);
#pragma unroll 1
        for (int mt = 0; mt < 2; ++mt) { const int mrow = 32 * w4 + 16 * mt;
            bf16x8 af[4];
#pragma unroll
            for (int ks = 0; ks < 4; ++ks) af[ks] = ld_frag(SGW + ((size_t)g * 128 + mrow + n) * 128 + 32 * ks + 8 * q4);
            unsigned short uu16[8][4], zz16[8][4]; float sb4[4];
#pragma unroll
            for (int i = 0; i < 4; ++i) { const int p = mrow + 4 * q4 + i; sb4[i] = sgb[g * 128 + p]; const bf16* pr = P + (size_t)(m0 + p) * NIN + g * 128 + n;
#pragma unroll
                for (int nt = 0; nt < 8; ++nt) { uu16[nt][i] = pr[C_SGU + 16 * nt]; zz16[nt][i] = pr[C_SGZ + 16 * nt]; } }
            __builtin_amdgcn_sched_barrier(0);
#pragma unroll
            for (int nt = 0; nt < 8; ++nt) {
                f32x4 acc = {0.f, 0.f, 0.f, 0.f};
#pragma unroll
                for (int ks = 0; ks < 4; ++ks) { const bf16x8 bfg = *(const LAS bf16x8*)(T + (16 * nt + n) * 136 + 32 * ks + 8 * q4); acc = mfma16(af[ks], bfg, acc); }
#pragma unroll
                for (int i = 0; i < 4; ++i) { const int p = mrow + 4 * q4 + i, row = m0 + p, col = g * 128 + 16 * nt + n;
                    Y[(size_t)row * DM + 3072 + col] = (bf16)f2bf(bf2f(uu16[nt][i]) * (acc[i] + sb4[i]) * silu_f(bf2f(zz16[nt][i]))); }
            }
        }
        bar4(cnt, seq, lane);
    }
}
__device__ __forceinline__ void scan_self(const float* REC, float* YR, LAS unsigned char* lds, LAS unsigned* bcnt, int su, int wave, int lane) {
    constexpr int CS = 32, NCH = SCANLEN / CS, SLOT = CS * RECB, NPW = SLOT / 1024 / 4;
    const int chain = (su & 7) * 8 + ((su >> 3) >> 2), part = (su >> 3) & 3;
    const char* recb = (const char*)REC + (size_t)chain * SCANLEN * RECB;
    const int wl = wave;
#define SCAN_ISSUE(cc, sl) do { _Pragma("unroll") for (int p_ = 0; p_ < NPW; ++p_) \
    __builtin_amdgcn_global_load_lds((const unsigned*)(recb + (size_t)(cc) * SLOT + (wl * NPW + p_) * 1024 + lane * 16), (LAS unsigned*)(lds + (sl) * SLOT + (wl * NPW + p_) * 1024), 16, 0, 0); } while (0)
    __builtin_amdgcn_s_setprio(3);
    SCAN_ISSUE(0, 0); SCAN_ISSUE(1, 1);
#define SCAN_ARRIVE() do { unsigned long long ex_; const unsigned baddr_ = (unsigned)(size_t)bcnt, one_ = 1u; \
    asm volatile("s_mov_b64 %0, exec\n\ts_mov_b64 exec, 1\n\tds_add_u32 %1, %2\n\ts_mov_b64 exec, %0" : "=&s"(ex_) : "v"(baddr_), "v"(one_) : "memory"); } while (0)
    static_assert(NPW == 6, "vmcnt counts below assume 6 pieces per wave and chunk");
    asm volatile("s_waitcnt vmcnt(6)" ::: "memory");
    SCAN_ARRIVE();
    const int c16 = lane & 15, rg = lane >> 4, row = 16 * part + 4 * wave + rg;
    float S0 = 0.f, S1 = 0.f, S2 = 0.f, S3 = 0.f;
#if defined(PROBE_DUP)
    float T0 = 0.f, T1 = 0.f, T2 = 0.f, T3 = 0.f, tdum = 0.f; asm volatile("" : "+v"(T0), "+v"(T1), "+v"(T2), "+v"(T3));
#endif
#if defined(PROBE_LDS2)
    f32x4 dw_ = {0.f, 0.f, 0.f, 0.f}; v4u dk_ = {0u, 0u, 0u, 0u};
#endif
    float* yout = YR + (size_t)chain * SCANLEN * 64 + row;
    const int lo_h = c16 * 8, lo_v = 640 + row * 2;
#define SCAN_LD(dst, s_) do { const unsigned ahj_ = ah + ((s_) & ~1) * RECB; \
    asm volatile("ds_read2_b64 %0, %1 offset0:%2 offset1:%3" : "=v"(dst##ek) : "v"(ahj_), "i"(((s_) & 1) * (RECB / 8)), "i"(((s_) & 1) * (RECB / 8) + 16)); \
    asm volatile("ds_read_u16 %0, %1 offset:%2" : "=v"(dst##v) : "v"(av), "i"((s_) * RECB)); \
    asm volatile("ds_read2_b64 %0, %1 offset0:%2 offset1:%3" : "=v"(dst##nk) : "v"(ahj_), "i"(((s_) & 1) * (RECB / 8) + 32), "i"(((s_) & 1) * (RECB / 8) + 48)); \
    asm volatile("ds_read_b64 %0, %1 offset:%2" : "=v"(dst##r) : "v"(ah), "i"((s_) * RECB + 512)); } while (0)
#define H2H(q_) __builtin_bit_cast(h4, (q_))
#define H4LO(q_) __builtin_bit_cast(h4, (v2u){(q_).x, (q_).y})
#define H4HI(q_) __builtin_bit_cast(h4, (v2u){(q_).z, (q_).w})
#define FMX(a, b, c) __builtin_fmaf((a), (float)(b), (c))
#if defined(PROBE_CHUNK)
    unsigned long long ptz_ = 0ull;
#endif
    for (int c = 0; c < NCH; ++c) {
#if defined(PROBE_CHUNK)
        const unsigned long long pt0_ = __builtin_amdgcn_s_memrealtime(); unsigned long long pt8_ = pt0_;
#endif
        {   const unsigned baddr = (unsigned)(size_t)bcnt; const unsigned want = 4u * (unsigned)(c + 1); unsigned sp = 0, got;
#if defined(PROBE_CHUNK)
            if (PROBE_CHUNK & 64) { const unsigned long long a_ = __builtin_amdgcn_s_memrealtime(); asm volatile("s_waitcnt lgkmcnt(0)" ::: "memory");
                asm volatile("ds_read_b32 %0, %1\n\ts_waitcnt lgkmcnt(0)" : "=v"(got) : "v"(baddr) : "memory");
                const unsigned long long n_ = __builtin_amdgcn_s_memrealtime(), te_ = n_ + (n_ - a_) * 4; while (__builtin_amdgcn_s_memrealtime() < te_) __builtin_amdgcn_s_sleep(1); }
#endif
            for (;;) { asm volatile("ds_read_b32 %0, %1\n\ts_waitcnt lgkmcnt(0)" : "=v"(got) : "v"(baddr) : "memory");
                if (__builtin_amdgcn_readfirstlane((int)got) >= (int)want) break; __builtin_amdgcn_s_sleep(1); if (++sp > (1u << 22)) break; } }
        asm volatile("" ::: "memory");
#if defined(PROBE_CHUNK)
        if ((PROBE_CHUNK & 128) && c > 0) { const unsigned long long n_ = __builtin_amdgcn_s_memrealtime(), te_ = n_ + (n_ - ptz_) * 4; while (__builtin_amdgcn_s_memrealtime() < te_) __builtin_amdgcn_s_sleep(1); }
        const unsigned long long ptp_ = __builtin_amdgcn_s_memrealtime();
#endif
        const int cc = c + 2 < NCH ? c + 2 : NCH - 1; const int s2 = (c + 2) & 3;
        const LAS unsigned char* slot = lds + (c & 3) * SLOT;
        float ysv0 = 0.f, ysv1 = 0.f; float yp[16];
        const unsigned ah = (unsigned)(size_t)(slot + lo_h), av = (unsigned)(size_t)(slot + lo_v);
        v4u Aek, Ank, Bek, Bnk; v2u Ar, Br; unsigned Av, Bv; h4 Pr;
        SCAN_LD(A, 0); SCAN_LD(B, 1);
#pragma unroll
        for (int s = 0; s < CS; ++s) {
            v4u Cek, Cnk; v2u Cr; unsigned Cv;
#if defined(PROBE_LDS2)
            if (s < CS - 2) { SCAN_LD(C, s + 2);
                { const unsigned ahj_ = ah + ((s + 2) & ~1) * RECB;
                  asm volatile("ds_read_b128 %0, %1 offset:%2" : "+v"(dw_) : "v"(aw), "i"((s + 2) * RECB));
                  asm volatile("ds_read2_b64 %0, %1 offset0:%2 offset1:%3" : "+v"(dk_) : "v"(ahj_), "i"(((s + 2) & 1) * (RECB / 8)), "i"(((s + 2) & 1) * (RECB / 8) + 16)); }
                if (s == 0) asm volatile("s_waitcnt lgkmcnt(10)" : "+v"(Aek), "+v"(Ank), "+v"(Ar), "+v"(Av)); else asm volatile("s_waitcnt lgkmcnt(12)" : "+v"(Aek), "+v"(Ank), "+v"(Ar), "+v"(Av)); }
            else if (s == CS - 2) asm volatile("s_waitcnt lgkmcnt(6)" : "+v"(Aek), "+v"(Ank), "+v"(Ar), "+v"(Av));
#else
            if (s < CS - 2) { SCAN_LD(C, s + 2); asm volatile("s_waitcnt lgkmcnt(8)" : "+v"(Aek), "+v"(Ank), "+v"(Ar), "+v"(Av)); }
            else if (s == CS - 2) asm volatile("s_waitcnt lgkmcnt(4)" : "+v"(Aek), "+v"(Ank), "+v"(Ar), "+v"(Av));
#endif
            else asm volatile("s_waitcnt lgkmcnt(0)" : "+v"(Aek), "+v"(Ank), "+v"(Ar), "+v"(Av));
#if defined(PROBE_CHUNK)
            if (s == 8) pt8_ = __builtin_amdgcn_s_memrealtime();
            if (s == 8 && (PROBE_CHUNK & 8)) { const unsigned long long te_ = pt8_ + (pt8_ - ptp_) * 4; while (__builtin_amdgcn_s_memrealtime() < te_) __builtin_amdgcn_s_sleep(1); }
#endif
            if ((s & 3) == 1 && (s >> 2) < NPW) { const int p_ = s >> 2;
                __builtin_amdgcn_global_load_lds((const unsigned*)(recb + (size_t)cc * SLOT + (wl * NPW + p_) * 1024 + lane * 16), (LAS unsigned*)(lds + s2 * SLOT + (wl * NPW + p_) * 1024), 16, 0, 0); }
#if defined(PROBE_CHUNK)
            unsigned long long ptv_ = 0ull; if (s == 16 && (PROBE_CHUNK & 16)) { ptv_ = __builtin_amdgcn_s_memrealtime(); asm volatile("s_waitcnt lgkmcnt(0)" ::: "memory"); }
#endif
            if (s == 16) { if (c == 0) asm volatile("s_waitcnt vmcnt(4)" ::: "memory"); else asm volatile("s_waitcnt vmcnt(6)" ::: "memory"); SCAN_ARRIVE(); }
#if defined(PROBE_CHUNK)
            if (s == 16 && (PROBE_CHUNK & 16)) { const unsigned long long n_ = __builtin_amdgcn_s_memrealtime(), te_ = n_ + (n_ - ptv_) * 4; while (__builtin_amdgcn_s_memrealtime() < te_) __builtin_amdgcn_s_sleep(1); }
#endif
            __builtin_amdgcn_sched_barrier(0);
            const h4 Ae = H4LO(Aek), Akk = H4HI(Aek), Ana = H4LO(Ank), Ak = H4HI(Ank), Arr = H2H(Ar); const _Float16 Avh = __builtin_bit_cast(_Float16, (unsigned short)Av);
            if (s > 0) { float q0 = FMX(S0, Pr.x, 0.f); q0 = FMX(S1, Pr.y, q0); q0 = FMX(S2, Pr.z, q0); yp[(s - 1) & 15] = FMX(S3, Pr.w, q0); }
            float p0 = FMX(S0, Akk.x, 0.f); p0 = FMX(S1, Akk.y, p0); p0 = FMX(S2, Akk.z, p0); p0 = FMX(S3, Akk.w, p0);
            const float dt = red16(p0);
            const float u0 = FMX(S0, -Ae.x, FMX((float)Avh, Ak.x, S0)), u1 = FMX(S1, -Ae.y, FMX((float)Avh, Ak.y, S1)),
                        u2 = FMX(S2, -Ae.z, FMX((float)Avh, Ak.z, S2)), u3 = FMX(S3, -Ae.w, FMX((float)Avh, Ak.w, S3));
            S0 = FMX(dt, Ana.x, u0); S1 = FMX(dt, Ana.y, u1); S2 = FMX(dt, Ana.z, u2); S3 = FMX(dt, Ana.w, u3);
#if defined(PROBE_IND)
            {   float d0, d1, d2, d3;
                asm volatile("v_mul_f32 %0, %4, %4\n\tv_mul_f32 %1, %4, %4\n\tv_mul_f32 %2, %4, %4\n\tv_mul_f32 %3, %4, %4\n\t"
                             "v_mul_f32 %0, %4, %4\n\tv_mul_f32 %1, %4, %4\n\tv_mul_f32 %2, %4, %4\n\tv_mul_f32 %3, %4, %4\n\t"
                             "v_mul_f32 %0, %4, %4\n\tv_mul_f32 %1, %4, %4\n\tv_mul_f32 %2, %4, %4\n\tv_mul_f32 %3, %4, %4\n\t"
                             "v_mul_f32 %0, %4, %4\n\tv_mul_f32 %1, %4, %4\n\tv_mul_f32 %2, %4, %4\n\tv_mul_f32 %3, %4, %4" : "=&v"(d0), "=&v"(d1), "=&v"(d2), "=&v"(d3) : "v"(Aw.x)); }
#endif
#if defined(PROBE_DUP)
            {
                if (s > 0) { float q0 = FMX(T0, Pr.x, 0.f), q1 = FMX(T2, Pr.z, 0.f); q0 = FMX(T1, Pr.y, q0); q1 = FMX(T3, Pr.w, q1); tdum += q0 + q1; }
                float p0 = FMX(T0, Akk.x, 0.f), p1 = FMX(T2, Akk.z, 0.f); p0 = FMX(T1, Akk.y, p0); p1 = FMX(T3, Akk.w, p1);
                const float dt2 = red16(p0 + p1);
                const float u0 = __builtin_fmaf(T0, Aw.x, FMX((float)Avh, Ak.x, 0.f)), u1 = __builtin_fmaf(T1, Aw.y, FMX((float)Avh, Ak.y, 0.f)),
                            u2 = __builtin_fmaf(T2, Aw.z, FMX((float)Avh, Ak.z, 0.f)), u3 = __builtin_fmaf(T3, Aw.w, FMX((float)Avh, Ak.w, 0.f));
                T0 = FMX(dt2, Ana.x, u0); T1 = FMX(dt2, Ana.y, u1); T2 = FMX(dt2, Ana.z, u2); T3 = FMX(dt2, Ana.w, u3); }
#endif
            if (s == 16) ysv0 = red16_transpose(yp, c16);
            Pr = Arr;
            if (s < CS - 1) { Aek = Bek; Ank = Bnk; Ar = Br; Av = Bv; }
            if (s < CS - 2) { Bek = Cek; Bnk = Cnk; Br = Cr; Bv = Cv; }
        }
#if defined(PROBE_CHUNK)
        asm volatile("" : "+v"(S0), "+v"(S1), "+v"(S2), "+v"(S3));
        const unsigned long long pt1_ = __builtin_amdgcn_s_memrealtime();
        if (PROBE_CHUNK & 4) { const unsigned long long te_ = pt1_ + (pt1_ - pt8_) * 4; while (__builtin_amdgcn_s_memrealtime() < te_) __builtin_amdgcn_s_sleep(1); }
#endif
        { float q0 = FMX(S0, Pr.x, 0.f); q0 = FMX(S1, Pr.y, q0); q0 = FMX(S2, Pr.z, q0); yp[15] = FMX(S3, Pr.w, q0); }
        ysv1 = red16_transpose(yp, c16);
        asm volatile("" ::: "memory");
        yout[(size_t)(c * CS + c16) * 64] = ysv0; yout[(size_t)(c * CS + 16 + c16) * 64] = ysv1;
#if defined(PROBE_CHUNK)
        if (PROBE_CHUNK & 2) { const unsigned long long n_ = __builtin_amdgcn_s_memrealtime(), te_ = n_ + (n_ - pt1_) * 4; while (__builtin_amdgcn_s_memrealtime() < te_) __builtin_amdgcn_s_sleep(1); }
        if (PROBE_CHUNK & 128) ptz_ = __builtin_amdgcn_s_memrealtime();
        if (PROBE_CHUNK & 32) { const unsigned long long n_ = __builtin_amdgcn_s_memrealtime(), te_ = n_ + (n_ - ptp_) * 2; while (__builtin_amdgcn_s_memrealtime() < te_) __builtin_amdgcn_s_sleep(1); }
#endif
    }
    asm volatile("s_waitcnt vmcnt(0)" ::: "memory");
    __builtin_amdgcn_s_setprio(0);
#if defined(PROBE_DUP)
    asm volatile("" :: "v"(T0), "v"(T1), "v"(T2), "v"(T3), "v"(tdum));
#endif
#if defined(PROBE_LDS2)
    asm volatile("s_waitcnt lgkmcnt(0)" :: "v"(dw_), "v"(dk_));
#endif
#undef FMX
#undef SCAN_LD
#undef SCAN_ARRIVE
#undef H4LO
#undef H4HI
#undef H2H
#undef SCAN_ISSUE
}
__device__ __forceinline__ void phase_rwfin(const bf16* P, const float* YR, const float* REC, const float* BON, const float* lnw, const float* lnb, bf16* Y, int nrows, int gw, int NGW, int lane) {
    const int head = lane >> 2, sub = lane & 3;
    for (int m = gw; m < nrows; m += NGW) {
        const bool isctx = m >= NLAT; const int t = isctx ? ((m - NLAT) & 255) : (m & 8191); const int b = isctx ? ((m - NLAT) >> 8) : (m >> 13);
        float out[16];
#pragma unroll
        for (int i = 0; i < 16; ++i) out[i] = 0.f;
#pragma unroll
        for (int d = 0; d < 2; ++d) {
            const int chain = (b * 2 + d) * 16 + head; const size_t pp = (size_t)chain * SCANLEN + scan_pos(d, isctx, t);
            float y[16], v[16];
#pragma unroll
            for (int j = 0; j < 4; ++j) { const f32x4 a = *(const f32x4*)(YR + pp * 64 + 16 * sub + 4 * j); const h4 c = *(const h4*)((const char*)REC + pp * RECB + 640 + (16 * sub + 4 * j) * 2);
                y[4 * j] = a.x; y[4 * j + 1] = a.y; y[4 * j + 2] = a.z; y[4 * j + 3] = a.w; v[4 * j] = (float)c.x; v[4 * j + 1] = (float)c.y; v[4 * j + 2] = (float)c.z; v[4 * j + 3] = (float)c.w; }
            const float bo = BON[pp];
            float s = 0.f;
#pragma unroll
            for (int i = 0; i < 16; ++i) s += y[i];
            s += __shfl_xor(s, 1); s += __shfl_xor(s, 2);
            const float mean = s * (1.f / 64.f); float q = 0.f;
#pragma unroll
            for (int i = 0; i < 16; ++i) { const float dl = y[i] - mean; q += dl * dl; }
            q += __shfl_xor(q, 1); q += __shfl_xor(q, 2);
            const float rstd = rsq_f(q * (1.f / 64.f) + 64e-5f);
#pragma unroll
            for (int i = 0; i < 16; ++i) { const int ch = head * 64 + 16 * sub + i; out[i] += (y[i] - mean) * rstd * lnw[ch] + lnb[ch] + bo * v[i]; }
        }
        float z[16]; unpack8(*(const v4u*)(P + (size_t)m * NIN + C_RWZ + 16 * lane), z); unpack8(*(const v4u*)(P + (size_t)m * NIN + C_RWZ + 16 * lane + 8), z + 8);
#pragma unroll
        for (int i = 0; i < 16; ++i) out[i] *= silu_f(z[i]);
        *(v4u*)(Y + (size_t)m * DM + 2048 + 16 * lane) = pack8(out); *(v4u*)(Y + (size_t)m * DM + 2048 + 16 * lane + 8) = pack8(out + 8);
    }
}
#define XB_TMO      128
#define XB_XCNT(j)  (256  + 64 * (j))
#define XB_XSUB(j)  (1280 + 64 * (j))
#define XB_XGEN(j)  (2304 + 64 * (j))
#define XB_TOP      3328
#define XB_TOPGEN   3392
#define XCD_BAR_WORDS 3456
#define XB_SPIN_CAP (1u << 18)

__device__ __forceinline__ unsigned xb_ld(unsigned* p)              { return __hip_atomic_load(p, __ATOMIC_RELAXED, __HIP_MEMORY_SCOPE_AGENT); }
__device__ __forceinline__ unsigned xb_add(unsigned* p, unsigned v) { return __hip_atomic_fetch_add(p, v, __ATOMIC_RELAXED, __HIP_MEMORY_SCOPE_AGENT); }
__device__ __forceinline__ unsigned xb_xcc_id() { return (unsigned)__builtin_amdgcn_s_getreg((3 << 11) | 20) & 0xFu; }
#define XB_SPIN(cond, bar) do { unsigned _sp = 0; while (cond) { __builtin_amdgcn_s_sleep(1); \
    if ((++_sp & 255u) == 0u) { if (xb_ld(&(bar)[XB_TMO])) break; if (_sp > XB_SPIN_CAP) { atomicAdd(&(bar)[XB_TMO], 1u); break; } } } } while (0)

struct XcdBarrier {
    unsigned* bar; unsigned x;
    volatile LAS unsigned* st;
};

__device__ __forceinline__ XcdBarrier xcd_barrier_post(unsigned* bar, volatile LAS unsigned* st) {
    XcdBarrier b; b.bar = bar; b.x = xb_xcc_id(); b.st = st;
    if (threadIdx.x == 0) (void)xb_add(&bar[XB_XCNT(b.x)], 1u);
    return b;
}
__device__ __forceinline__ void xcd_barrier_complete(unsigned* bar, unsigned x, unsigned& nloc, unsigned& nx) {
    const unsigned G = gridDim.x * gridDim.y * gridDim.z;
    unsigned sum, cnt, mine, sp = 0u;
    for (;;) {
        sum = 0u; cnt = 0u; mine = 0u;
#pragma unroll
        for (unsigned j = 0; j < 16; ++j) { const unsigned c = xb_ld(&bar[XB_XCNT(j)]); sum += c; cnt += (c > 0u) ? 1u : 0u; mine = (j == x) ? c : mine; }
        if (sum == G) break;
        __builtin_amdgcn_s_sleep(1);
        if ((++sp & 255u) == 0u) { if (xb_ld(&bar[XB_TMO])) break; if (sp > XB_SPIN_CAP) { atomicAdd(&bar[XB_TMO], 1u); break; } }
    }
    nloc = mine > 0u ? mine : 1u; nx = cnt > 0u ? cnt : 1u;
}

__device__ __forceinline__ void xcd_barrier(const XcdBarrier& b) {
    asm volatile("s_waitcnt vmcnt(0)" ::: "memory");
    __syncthreads();
    if (threadIdx.x == 0) {
        unsigned* bar = b.bar;
        __builtin_amdgcn_s_waitcnt(0);
        unsigned nloc = b.st[0], nx = b.st[1];
        if (nloc == 0u) { xcd_barrier_complete(bar, b.x, nloc, nx); b.st[0] = nloc; b.st[1] = nx; }
        const unsigned old = xb_add(&bar[XB_XSUB(b.x)], 1u);
        const unsigned gen = old / nloc;
        if (old + 1u == (gen + 1u) * nloc) {
            __builtin_amdgcn_fence(__ATOMIC_RELEASE, "agent");
            asm volatile("s_waitcnt vmcnt(0)" ::: "memory");
            const unsigned og = xb_add(&bar[XB_TOP], 1u);
            const unsigned tg = og / nx;
            if (og + 1u == (tg + 1u) * nx) xb_add(&bar[XB_TOPGEN], 1u);
            else XB_SPIN(xb_ld(&bar[XB_TOPGEN]) == tg, bar);
            __builtin_amdgcn_fence(__ATOMIC_ACQUIRE, "agent");
            xb_add(&bar[XB_XGEN(b.x)], 1u);
            asm volatile("s_waitcnt vmcnt(0)" ::: "memory");
        } else {
            XB_SPIN(xb_ld(&bar[XB_XGEN(b.x)]) == gen, bar);
            __builtin_amdgcn_fence(__ATOMIC_ACQUIRE, "agent");
            asm volatile("s_waitcnt vmcnt(0)" ::: "memory");
        }
    }
    __syncthreads();
}

#ifndef MK_SPLIT
#define MK_SPLIT 0
#endif
constexpr int PPL = 6;
constexpr int NPHASE = 2 + PPL * DEPTH;
constexpr int RWP_BLOCKS = 14;
constexpr int CW_RWQ = 16384;
constexpr int NGRID = 256;
struct Args { const float* in[28]; float* out; unsigned char* ws; int ph_lo, ph_hi, li, pad; };

__global__ void __launch_bounds__(NWAVES * 64, 2) fwd(Args args) {
    extern __shared__ __attribute__((aligned(16))) unsigned char lds_raw[];
    LAS unsigned char* lds = (LAS unsigned char*)lds_raw;
    volatile LAS unsigned* MISC = (volatile LAS unsigned*)(lds + MISC_OFF);
    const int tid = threadIdx.x, lane = tid & 63, wave = __builtin_amdgcn_readfirstlane(tid >> 6);
    constexpr int G = NGRID; const int bx = blockIdx.x;
    const int vcu = (bx % 8) * (G / 8) + bx / 8;
    const int gw = vcu * NWAVES + wave; constexpr int NGW = G * NWAVES;
    unsigned char* ws = args.ws;
    const int lo = args.ph_lo, hi = args.ph_hi;

    for (int u = tid; u < (LDS_BYTES - LDSCTL_OFF) / 4; u += NWAVES * 64) ((LAS unsigned*)(lds + LDSCTL_OFF))[u] = 0u;
    __syncthreads();
    XcdBarrier bar; bar.bar = (unsigned*)(ws + WS_CTL) + CW_BAR; bar.x = 0; bar.st = MISC + 8;
    if (hi - lo > 1) bar = xcd_barrier_post((unsigned*)(ws + WS_CTL) + CW_BAR, MISC + 8);
#define IN(k) (lo <= (k) && (k) < hi)
#define SEAM(k) do { if (lo <= (k) && (k) + 1 < hi) { XcdBarrier b2_; b2_.bar = WSP(unsigned, WS_CTL) + CW_BAR; b2_.x = bar.x; b2_.st = bar.st; xcd_barrier(b2_); } } while (0)

#define OPQ_S(x) ({ int _t = (x); asm volatile("" : "+s"(_t)); _t; })
#define OPQ_V(x) ({ int _t = (x); asm volatile("" : "+v"(_t)); _t; })
#define INP(i) (args.in[OPQ_S(i)])
#define WSP(T, off) ((T*)(args.ws + ({ size_t _o = (off); asm volatile("" : "+s"(_o)); _o; })))
#define x_in INP(0)
#define c_in INP(1)
#define ctx_in INP(2)
#define cctx_in INP(3)
#define w_mod INP(4)
#define b_mod INP(5)
#define w_in INP(6)
#define w_out INP(7)
#define pool_w INP(8)
#define pool_scale INP(9)
#define na_qg INP(10)
#define na_kg INP(11)
#define na_rpb INP(12)
#define rw_mu_rkv INP(13)
#define rw_mu_lora INP(14)
#define rw_w0 INP(15)
#define rw_w_up INP(16)
#define rw_a0 INP(17)
#define rw_a_up INP(18)
#define rw_k_k INP(19)
#define rw_k_a INP(20)
#define rw_r_k INP(21)
#define rw_ln_w INP(22)
#define rw_ln_b INP(23)
#define sg_ln_w INP(24)
#define sg_ln_b INP(25)
#define sg_w INP(26)
#define sg_b INP(27)
#define MOD WSP(float, WS_MOD)
#define MODP WSP(float, WS_MODP)
#define TAB WSP(f32x2, WS_TAB)
#define SGST WSP(f32x2, WS_SGST)
#define BON WSP(float, WS_BON)
#define POOLWT WSP(bf16, WS_POOLWT)
#define WUPT WSP(bf16, WS_WUPT)
#define AUPT WSP(bf16, WS_AUPT)
#define SGW WSP(bf16, WS_SGW)
#define VTC WSP(bf16, WS_VTC)
#define VTL WSP(bf16, WS_VTL)
#define HCTX WSP(float, WS_HCTX)
#define QN WSP(bf16, WS_QN)
#define KN WSP(bf16, WS_KN)
#define WOUTT WSP(bf16, WS_WOUTT)
#define WINT WSP(bf16, WS_WINT)
#define XN WSP(bf16, WS_XN)
#define Y WSP(bf16, WS_Y)
#define P WSP(bf16, WS_P)
#define YR WSP(float, WS_YR)
#define REC WSP(float, WS_REC)
#define SILUC WSP(float, WS_SILUC)
    float* const out = args.out;

    if (IN(0)) {
        LAS float* scr = (LAS float*)(lds + wave * 16384);
        constexpr int I_MOD = 64 * 48  , I_WIN = 64 * (NIN / 32), I_WOUT = 64 * 128, I_POOL = 4 * 32, I_WUP = 2 * 32, I_AUP = 2 * 32, I_SGW = 256;
        constexpr int NITEMS = I_MOD + I_WIN + I_WOUT + I_POOL + I_WUP + I_AUP + I_SGW;
        for (int it = gw; it < NITEMS; it += NGW) {
            int r = it;
            if (r < I_MOD) { p0_mod_item(w_mod, c_in, cctx_in, MODP, scr, r, lane); continue; } r -= I_MOD;
            if (r < I_WIN) { p0_transpose_item<true>(w_in, DM, NIN, WINT, scr, r, lane); continue; } r -= I_WIN;
            if (r < I_WOUT) { p0_transpose_item(w_out, DM, DM, WOUTT, scr, r, lane); continue; } r -= I_WOUT;
            if (r < I_POOL) { const int g = r / 32; p0_transpose_item(pool_w + (size_t)g * 65536, 256, 256, POOLWT + (size_t)g * 65536, scr, r % 32, lane); continue; } r -= I_POOL;
            if (r < I_WUP) { const int dd = r / 32; p0_transpose_item(rw_w_up + (size_t)dd * 65536, 64, 1024, WUPT + (size_t)dd * 65536, scr, r % 32, lane); continue; } r -= I_WUP;
            if (r < I_AUP) { const int dd = r / 32; p0_transpose_item(rw_a_up + (size_t)dd * 65536, 64, 1024, AUPT + (size_t)dd * 65536, scr, r % 32, lane); continue; } r -= I_AUP;
            {   const size_t e0 = (size_t)r * 512 + lane * 8; const f32x4 a = *(const f32x4*)(sg_w + e0), b = *(const f32x4*)(sg_w + e0 + 4);
                v4u o; o.x = pk2(a.x, a.y); o.y = pk2(a.z, a.w); o.z = pk2(b.x, b.y); o.w = pk2(b.z, b.w); *(v4u*)(SGW + e0) = o; }
        }
        SEAM(0);
    }
    if (IN(1)) {

        for (int idx = gw * 64 + lane; idx < 3 * 4096; idx += NGW * 64) SILUC[idx] = silu_f(idx < 8192 ? c_in[idx] : cctx_in[idx - 8192]);
        for (int idx = gw * 64 + lane; idx < 3 * 12288; idx += NGW * 64) {
            const int l = idx / 36864, c = (idx / 12288) % 3, n = idx % 12288;
            float s = b_mod[l * 12288 + n];
            const float* pp = MODP + ((size_t)(l * 64) * 3 + c) * 12288 + n;
#pragma unroll 8
            for (int kc = 0; kc < 64; ++kc) s += pp[(size_t)kc * 3 * 12288];
            MOD[idx] = s;
        }
        for (int idx = gw * 64 + lane; idx < 2048; idx += NGW * 64) {
            const int pos = idx >> 4, i = idx & 15;
            float inv = (i & 3) == 0 ? 1.0f : ((i & 3) == 1 ? 0.5623413251903491f : ((i & 3) == 2 ? 0.31622776601683794f : 0.17782794100389228f));
            inv *= (i >> 2) == 0 ? 1.0f : ((i >> 2) == 1 ? 0.1f : ((i >> 2) == 2 ? 0.01f : 0.001f));
            float cc, sn; sincos_acc((float)pos * inv, cc, sn);
            TAB[idx] = (f32x2){cc, sn};
        }
        SEAM(1);
    }
    for (int l = 0; l < DEPTH; ++l) {
        const int pb = 2 + PPL * l;
        const bool with_ctx = l < DEPTH - 1;
#define hin_lat (l == 0 ? x_in : (const float*)out)
#define hin_ctx (l == 0 ? ctx_in : (const float*)HCTX)
#define mod (MOD + (size_t)l * 3 * 12288)
        const int nrows = with_ctx ? MROWS : NLAT;
        if (IN(pb + 0)) {
            phase_xn(hin_lat, hin_ctx, mod, XN, OPQ_S(gw), NGW, OPQ_V(lane));
            SEAM(pb + 0);
        }
        if (IN(pb + 1)) {
            constexpr int C0 = C_SPLIT, NA_ = NIN - C0;
            pg8::Gemm g{XN, WINT + (size_t)l * NIN * DM + (size_t)C0 * DM, MROWS, NA_, DM}; pg8::StaticOrder S; S.init(MROWS, NA_, G, bx);
            pg8::EpiStoreBf16 E{P + C0, NIN};
            pg8::gemm_phase<pg8::EpiStoreBf16, pg8::StaticOrder, true, true>(lds, g, S, E);
            SEAM(pb + 1);
        }
        if (IN(pb + 2)) {
            if (bx >= RWP_BLOCKS) {
                constexpr int NB_ = C_SPLIT;
                pg8::Gemm g{XN, WINT + (size_t)l * NIN * DM, MROWS, NB_, DM}; pg8::StaticOrder S; S.init(MROWS, NB_, G - RWP_BLOCKS, bx - RWP_BLOCKS);
                pg8::EpiStoreBf16 E{P, NIN};
                pg8::gemm_phase<pg8::EpiStoreBf16, pg8::StaticOrder, true, true>(lds, g, S, E);
            }
            phase_rwprep(P, rw_mu_rkv + (size_t)l * 6144, rw_mu_lora + (size_t)l * 256, rw_w0 + (size_t)l * 2048, WUPT + (size_t)l * 131072, rw_a0 + (size_t)l * 2048, AUPT + (size_t)l * 131072,
                         rw_k_k + (size_t)l * 1024, rw_k_a + (size_t)l * 1024, rw_r_k + (size_t)l * 1024, REC, BON, lds, WSP(unsigned, WS_CTL) + CW_RWQ + l * 1024, (bx * NWAVES + wave) & 15, wave, OPQ_V(lane));
            phase_rowprep(P, na_qg + l * 64, na_kg + l * 64, TAB, QN, KN, SGST, OPQ_S(gw), NGW, OPQ_V(lane));
            phase_vt(P, VTL, VTC, OPQ_S(gw), NGW, OPQ_V(lane));
            SEAM(pb + 2);
        }
        if (IN(pb + 3)) {
            {
            LAS unsigned* mixq = (LAS unsigned*)(lds + LDSCTL_OFF + 64); LAS unsigned* mixb = (LAS unsigned*)(lds + LDSCTL_OFF + 128); LAS unsigned* mixs = (LAS unsigned*)(lds + LDSCTL_OFF + 192);
            if (tid == 0) { *mixq = 0u; *mixb = 0u; *mixs = 0u; }
            __syncthreads();
#if defined(PROBE_CAT6)
            if (wave < 4) { const unsigned long long t0_ = __builtin_amdgcn_s_memrealtime(); scan_self(REC, YR, lds, mixb, bx, wave, OPQ_V(lane));
                const unsigned long long n_ = __builtin_amdgcn_s_memrealtime(), te_ = n_ + (n_ - t0_); while (__builtin_amdgcn_s_memrealtime() < te_) __builtin_amdgcn_s_sleep(16); }
#else
            if (wave < 4) scan_self(REC, YR, lds, mixb, bx, wave, OPQ_V(lane));
#endif
            else phase_sgu4(P, SGST, sg_ln_w + (size_t)l * 1024, sg_ln_b + (size_t)l * 1024, SGW + (size_t)l * 131072, sg_b + (size_t)l * 1024, Y, lds + SGUT_OFF, mixs, nrows / 128, OPQ_V(tid) - 256, wave - 4, OPQ_V(lane));
            {   const int nctxu = with_ctx ? 2 : 0, npool = (nrows / 16) * 4, npq = (npool + NGRID - 1) / NGRID, nwc = l + 1 < DEPTH ? (WC_ITEMS + NGRID - 1) / NGRID : 0, nmd = l + 1 < DEPTH ? (64 * 48) / NGRID : 0, nq = 64 + nctxu + npq + nwc + nmd;
                for (;;) {
                    unsigned k = 0; if (lane == 0) k = __hip_atomic_fetch_add(mixq, 1u, __ATOMIC_RELAXED, __HIP_MEMORY_SCOPE_WORKGROUP);
                    k = (unsigned)__builtin_amdgcn_readfirstlane((int)k);
                    if ((int)k >= nq) break;
                    const int ln = OPQ_V(lane);
                    if (k < 64u) { na_unit<false>(QN, KN, VTL, VTC, P, na_rpb + (size_t)l * 16 * 15 * 31, Y, vcu * 64 + (int)k, ln);
                    }
                    else if ((int)k < 64 + nctxu) na_unit<true>(QN, KN, VTL, VTC, P, na_rpb, Y, bx * 2 + ((int)k - 64), ln);
                    else if ((int)k >= 64 + nctxu + npq + nwc) mod_item_nolds(w_mod + (size_t)(l + 1) * 4096 * 12288, SILUC, MODP + (size_t)(l + 1) * 64 * 3 * 12288, bx + NGRID * ((int)k - 64 - nctxu - npq - nwc), ln);
                    else if ((int)k >= 64 + nctxu + npq) { const int r = bx + NGRID * ((int)k - 64 - nctxu - npq);
                        if (r < WC_ITEMS) weight_copy_item(l + 1, r, w_in, w_out, pool_w, rw_w_up, rw_a_up, sg_w, WINT, WOUTT, POOLWT, WUPT, AUPT, SGW, ln); }
                    else { const int u = bx + NGRID * ((int)k - 64 - nctxu);
                        if (u < npool) { const int tt = u >> 2, g = u & 3; const bf16* wbase = POOLWT + (size_t)l * 262144 + (size_t)g * 65536; const float* psc = pool_scale + (size_t)l * 1024;
                            if (g == 0) pool_unit<0>(P, wbase, psc, Y, tt * 16, ln); else if (g == 1) pool_unit<1>(P, wbase, psc, Y, tt * 16, ln);
                            else if (g == 2) pool_unit<2>(P, wbase, psc, Y, tt * 16, ln); else pool_unit<3>(P, wbase, psc, Y, tt * 16, ln); } }
                }
            }
            }
            SEAM(pb + 3);
        }
        if (IN(pb + 4)) {
            if (l + 1 < DEPTH) for (int idx = gw * 64 + lane; idx < 3 * 12288; idx += NGW * 64) {
                const int c = idx / 12288, n = idx % 12288; float s = b_mod[(l + 1) * 12288 + n];
                const float* pp = MODP + ((size_t)((l + 1) * 64) * 3 + c) * 12288 + n;
#pragma unroll 8
                for (int kc = 0; kc < 64; ++kc) s += pp[(size_t)kc * 3 * 12288];
                MOD[(size_t)(l + 1) * 3 * 12288 + idx] = s; }
            phase_rwfin(P, YR, REC, BON, rw_ln_w + (size_t)l * 1024, rw_ln_b + (size_t)l * 1024, Y, nrows, OPQ_S(gw), NGW, OPQ_V(lane));
            SEAM(pb + 4);
        }
        if (IN(pb + 5)) {
            pg8::Gemm g{Y, WOUTT + (size_t)l * DM * DM, nrows, DM, DM}; pg8::StaticOrder S; S.init(nrows, DM, G, bx);
            pg8::EpiResGate E{hin_lat, hin_ctx, out, HCTX, mod};
            pg8::gemm_phase<pg8::EpiResGate, pg8::StaticOrder, true, true>(lds, g, S, E);
            SEAM(pb + 5);
        }
    }
#undef IN
#undef SEAM
}
#undef hin_lat
#undef hin_ctx
#undef mod
#undef P
#undef Y
#undef XN
#undef out

extern "C" void kernel_launch(void* const* d_in, const int* in_sizes, int n_in, void* d_out, int out_size, void* d_ws, size_t ws_size, hipStream_t stream) {
    static int grid = 0;
    if (grid == 0) {
        if (n_in != 28 || out_size != NLAT * DM || ws_size < WS_END) { fprintf(stderr, "kernel_launch: unexpected shapes (n_in %d, out %d, ws %zu < %zu); nothing launched\n", n_in, out_size, ws_size, (size_t)WS_END); grid = -1; return; }
        int dev = 0, cus = 0, per_cu = 0;
        if (hipGetDevice(&dev) != hipSuccess || hipDeviceGetAttribute(&cus, hipDeviceAttributeMultiprocessorCount, dev) != hipSuccess) { grid = -1; return; }
        if (hipFuncSetAttribute((const void*)fwd, hipFuncAttributeMaxDynamicSharedMemorySize, LDS_BYTES) != hipSuccess) { fprintf(stderr, "kernel_launch: hipFuncSetAttribute failed\n"); grid = -1; return; }
        if (hipOccupancyMaxActiveBlocksPerMultiprocessor(&per_cu, (const void*)fwd, NWAVES * 64, LDS_BYTES) != hipSuccess || per_cu < 1)
            fprintf(stderr, "kernel_launch: note: occupancy query reports %d workgroups per CU\n", per_cu);
        (void)hipGetLastError();
        grid = cus >= NGRID ? NGRID : -2;
    }
    if (grid == -1) return;
    if (hipMemsetAsync((char*)d_ws + WS_CTL, 0, CTL_ZERO_BYTES, stream) != hipSuccess) { fprintf(stderr, "kernel_launch: memset failed\n"); return; }
    Args a{};
    for (int i = 0; i < 28; ++i) a.in[i] = (const float*)d_in[i];
    a.out = (float*)d_out; a.ws = (unsigned char*)d_ws; a.li = 0; a.pad = 0;
    const bool split = MK_SPLIT || grid == -2;
    if (split) { for (int k = 0; k < NPHASE; ++k) { a.ph_lo = k; a.ph_hi = k + 1; hipLaunchKernelGGL(fwd, dim3(NGRID), dim3(NWAVES * 64), LDS_BYTES, stream, a); } }
    else { a.ph_lo = 0; a.ph_hi = NPHASE; hipLaunchKernelGGL(fwd, dim3(NGRID), dim3(NWAVES * 64), LDS_BYTES, stream, a); }
    const hipError_t le = hipPeekAtLastError();
    if (le != hipSuccess) fprintf(stderr, "kernel_launch: launch failed: %s\n", hipGetErrorName(le));
}
```

```cpp
#include <hip/hip_runtime.h>
#include <cstdio>
#include <cstdint>
#define MK_SPLIT 0
namespace pg8 {
#define PG8_LAS __attribute__((address_space(3)))
typedef unsigned short bf16_t;
typedef short bf16x8 __attribute__((ext_vector_type(8)));
typedef float f32x4 __attribute__((ext_vector_type(4)));
typedef unsigned u32x4 __attribute__((ext_vector_type(4)));
constexpr int BM = 256, BK = 64, HALF = 128, HTB = HALF * BK * 2  , STAGE_BYTES = 8 * HTB, NXCD = 8, WGM = 8;

__host__ __device__ __forceinline__ int lds_byte(int r, int c) { const int st = (r >> 4) * 2 + (c >> 5), rr = r & 15, cc = c & 31, ob = rr * 64 + cc * 2; return st * 1024 + (ob ^ (((ob >> 9) & 1) << 5)); }
__host__ __device__ __forceinline__ void stage_rc(int b, int& R, int& C) { const int st = b / 1024, sb = b % 1024, swz = sb ^ (((sb >> 9) & 1) << 5); R = (st >> 1) * 16 + swz / 64; C = (st & 1) * 32 + (swz % 64) / 2; }
__host__ __device__ __forceinline__ int perm32(int rho) { const int n = rho >> 4, i = rho & 15; return 8 * (i >> 2) + 4 * n + (i & 3); }

struct Unit { int pm, pn; };
struct Gemm { const bf16_t* A; const bf16_t* Bt; int M, N, K; };

struct StaticOrder {
    int nM, nN, nwg, G, c;
    __host__ __device__ void init(int M, int N, int G_, int c_) { nM = M / BM; nN = N / BM; nwg = nM * nN; G = G_; c = c_; }
    __host__ __device__ bool next(int i, Unit& u) const {
        const long L = (long)i * G + c; if (L >= nwg) return false;
        int wgid = (int)L; { const int q = nwg / NXCD, r = nwg % NXCD, xcd = wgid % NXCD, off = wgid / NXCD; wgid = (xcd < r ? xcd * (q + 1) : r * (q + 1) + (xcd - r) * q) + off; }
        const int nig = WGM * nN, gid = wgid / nig, fm = gid * WGM, gsz = (nM - fm) < WGM ? (nM - fm) : WGM;
        u.pm = fm + ((wgid % nig) % gsz); u.pn = (wgid % nig) / gsz; return true;
    }
    __device__ __forceinline__ void a_ready(const Unit&) const {}
    __device__ __forceinline__ void done(const Unit&) const {}
};

__device__ __forceinline__ unsigned cvt_pk_bf16(float lo, float hi) { unsigned r; asm volatile("v_cvt_pk_bf16_f32 %0, %1, %2" : "=v"(r) : "v"(lo), "v"(hi)); return r; }
template <class Epi, class Sched, bool ALIGN_EPI = false, bool SP2 = false>
__device__ __forceinline__ void gemm_phase(PG8_LAS unsigned char* lds, const Gemm g, const Sched& S, const Epi& E) {
    int tid_ = threadIdx.x; asm volatile("" : "+v"(tid_));
    const int tid = tid_, wid = __builtin_amdgcn_readfirstlane(tid >> 6), lane = tid & 63, wr = wid >> 2, wc = wid & 3, fr = lane & 15, fq = lane >> 4;
    const int K = g.K, nt = K / BK;
    unsigned voffA[2], voffB[2];
#pragma unroll
    for (int i = 0; i < 2; ++i) { int R, C; stage_rc(tid * 16 + i * 8192, R, C); const int Rb = Epi::PERM ? ((R & ~31) + perm32(R & 31)) : R;
        voffA[i] = (unsigned)(R * K + C) * 2u; voffB[i] = (unsigned)(Rb * K + C) * 2u; }
    const size_t kstep = (size_t)(BK * 2);
    const size_t hstep = (size_t)HALF * K * 2;
    const size_t tstep = 2 * hstep;
    const unsigned ldsw = (unsigned)wid * 1024u;
    const int aoff = lds_byte(wr * 64 + fr, fq * 8), boff = lds_byte(wc * 32 + fr, fq * 8);
#define PG8_SA(b, h) (((b) * 2 + (h)) * HTB)
#define PG8_SB(b, h) ((4 + (b) * 2 + (h)) * HTB)
#define PG8_STAGE(bufoff, gbase, voff) do { _Pragma("unroll") for (int _i = 0; _i < 2; ++_i) \
        __builtin_amdgcn_global_load_lds((const unsigned*)((const char*)(gbase) + (voff)[_i]), (PG8_LAS unsigned*)(lds + (bufoff) + ldsw + _i * 8192), 16, 0, 0); } while (0)
#define PG8_LDA(dst, b, h) do { _Pragma("unroll") for (int m = 0; m < 4; ++m) _Pragma("unroll") for (int k = 0; k < 2; ++k) dst[m][k] = *(const PG8_LAS bf16x8*)(lds + PG8_SA(b, h) + aoff + m * 2048 + k * 1024); } while (0)
#define PG8_LDB(dst, b, h) do { _Pragma("unroll") for (int n = 0; n < 2; ++n) _Pragma("unroll") for (int k = 0; k < 2; ++k) dst[n][k] = *(const PG8_LAS bf16x8*)(lds + PG8_SB(b, h) + boff + n * 2048 + k * 1024); } while (0)
#define PG8_MMA(ai, bj, At, Bt) do { __builtin_amdgcn_s_setprio(1); _Pragma("unroll") for (int m = 0; m < 4; ++m) _Pragma("unroll") for (int n = 0; n < 2; ++n) _Pragma("unroll") for (int k = 0; k < 2; ++k) \
        acc[ai][bj][m][n] = __builtin_amdgcn_mfma_f32_16x16x32_bf16(Bt[n][k], At[m][k], acc[ai][bj][m][n], 0, 0, 0); __builtin_amdgcn_s_setprio(0); } while (0)
#define PG8_WAIT_V(n) asm volatile("s_waitcnt vmcnt(" #n ")" ::: "memory")
#define PG8_WAIT_L(n) asm volatile("s_waitcnt lgkmcnt(" #n ")" ::: "memory")
#define PG8_BAR __builtin_amdgcn_s_barrier()
#define PG8_SCHED __builtin_amdgcn_sched_barrier(0)
    Unit cur, nxt; int ui = 0;
    if (!S.next(0, cur)) return;
    f32x4 acc[2][2][4][2];
#pragma unroll
    for (int a = 0; a < 2; ++a)
#pragma unroll
        for (int b = 0; b < 2; ++b)
#pragma unroll
            for (int m = 0; m < 4; ++m)
#pragma unroll
                for (int n = 0; n < 2; ++n) acc[a][b][m][n] = (f32x4){0.f, 0.f, 0.f, 0.f};
    bf16x8 At[4][2], B0[2][2], B1[2][2];
    const char* cA = (const char*)g.A + (size_t)cur.pm * tstep; const char* cB = (const char*)g.Bt + (size_t)cur.pn * tstep;
    S.a_ready(cur);
    if constexpr (SP2) {
        PG8_STAGE(PG8_SB(0, 0), cB, voffB); PG8_STAGE(PG8_SB(0, 1), cB + hstep, voffB); PG8_STAGE(PG8_SA(0, 0), cA, voffA); PG8_STAGE(PG8_SA(0, 1), cA + hstep, voffA);
        if (wr == 1) PG8_BAR;
        PG8_WAIT_V(2); PG8_BAR;
        PG8_STAGE(PG8_SB(1, 0), cB + kstep, voffB); PG8_STAGE(PG8_SA(1, 0), cA + kstep, voffA); PG8_STAGE(PG8_SB(1, 1), cB + hstep + kstep, voffB);
        PG8_WAIT_V(6); PG8_BAR;
    } else {
        PG8_STAGE(PG8_SB(0, 0), cB, voffB); PG8_STAGE(PG8_SA(0, 0), cA, voffA); PG8_STAGE(PG8_SB(0, 1), cB + hstep, voffB); PG8_STAGE(PG8_SA(0, 1), cA + hstep, voffA);
        if (wr == 1) PG8_BAR;
        PG8_WAIT_V(4); PG8_BAR;
        PG8_STAGE(PG8_SB(1, 0), cB + kstep, voffB); PG8_STAGE(PG8_SA(1, 0), cA + kstep, voffA); PG8_STAGE(PG8_SB(1, 1), cB + hstep + kstep, voffB);
        PG8_WAIT_V(6); PG8_BAR;
    }
    for (;;) {
        const bool has_next = S.next(ui + 1, nxt);
        const char* nA = has_next ? (const char*)g.A + (size_t)nxt.pm * tstep : cA; const char* nB = has_next ? (const char*)g.Bt + (size_t)nxt.pn * tstep : cB;
        for (int t = 0; t < nt; t += 2) {
            const bool last = (t == nt - 2);
            const char* a1 = cA + (size_t)(t + 1) * kstep;
            const char* a2 = last ? nA : cA + (size_t)(t + 2) * kstep; const char* b2 = last ? nB : cB + (size_t)(t + 2) * kstep;
            const char* a3 = a2 + kstep; const char* b3 = b2 + kstep;
            if (last && has_next) S.a_ready(nxt);
            if constexpr (SP2) {
            PG8_LDB(B0, 0, 0); PG8_LDB(B1, 0, 1); PG8_SCHED; PG8_LDA(At, 0, 0); PG8_STAGE(PG8_SA(1, 1), a1 + hstep, voffA);
            PG8_WAIT_V(8); PG8_WAIT_L(0); PG8_BAR; PG8_MMA(0, 0, At, B0); PG8_MMA(0, 1, At, B1); PG8_BAR; PG8_SCHED;
            PG8_LDA(At, 0, 1); PG8_STAGE(PG8_SB(0, 0), b2, voffB); PG8_STAGE(PG8_SB(0, 1), b2 + hstep, voffB); PG8_STAGE(PG8_SA(0, 0), a2, voffA);
            PG8_WAIT_V(8); PG8_WAIT_L(0); PG8_BAR; PG8_MMA(1, 0, At, B0); PG8_MMA(1, 1, At, B1); PG8_BAR; PG8_SCHED;
            PG8_LDB(B0, 1, 0); PG8_LDB(B1, 1, 1); PG8_SCHED; PG8_LDA(At, 1, 0); PG8_STAGE(PG8_SA(0, 1), a2 + hstep, voffA);
            PG8_WAIT_V(8); PG8_WAIT_L(0); PG8_BAR; PG8_MMA(0, 0, At, B0); PG8_MMA(0, 1, At, B1); PG8_BAR; PG8_SCHED;
            PG8_LDA(At, 1, 1); PG8_STAGE(PG8_SB(1, 0), b3, voffB); PG8_STAGE(PG8_SB(1, 1), b3 + hstep, voffB); PG8_STAGE(PG8_SA(1, 0), a3, voffA);
            PG8_WAIT_V(8); PG8_WAIT_L(0); PG8_BAR; PG8_MMA(1, 0, At, B0); PG8_MMA(1, 1, At, B1); PG8_BAR; PG8_SCHED;
            } else {
            PG8_LDB(B0, 0, 0); PG8_SCHED; PG8_LDA(At, 0, 0); PG8_STAGE(PG8_SA(1, 1), a1 + hstep, voffA);
            PG8_WAIT_L(8); PG8_BAR; PG8_WAIT_L(0); PG8_MMA(0, 0, At, B0); PG8_BAR; PG8_SCHED;
            PG8_LDB(B1, 0, 1); PG8_STAGE(PG8_SB(0, 0), b2, voffB);
            PG8_BAR; PG8_WAIT_L(0); PG8_MMA(0, 1, At, B1); PG8_BAR;
            PG8_LDA(At, 0, 1); PG8_STAGE(PG8_SA(0, 0), a2, voffA);
            PG8_BAR; PG8_WAIT_L(0); PG8_MMA(1, 0, At, B0); PG8_BAR; PG8_SCHED;
            PG8_STAGE(PG8_SB(0, 1), b2 + hstep, voffB);
            PG8_WAIT_V(6); PG8_BAR; PG8_MMA(1, 1, At, B1); PG8_BAR;
            PG8_LDB(B0, 1, 0); PG8_SCHED; PG8_LDA(At, 1, 0); PG8_STAGE(PG8_SA(0, 1), a2 + hstep, voffA);
            PG8_WAIT_L(8); PG8_BAR; PG8_WAIT_L(0); PG8_MMA(0, 0, At, B0); PG8_BAR; PG8_SCHED;
            PG8_LDB(B1, 1, 1); PG8_STAGE(PG8_SB(1, 0), b3, voffB);
            PG8_BAR; PG8_WAIT_L(0); PG8_MMA(0, 1, At, B1); PG8_BAR;
            PG8_LDA(At, 1, 1); PG8_STAGE(PG8_SA(1, 0), a3, voffA);
            PG8_BAR; PG8_WAIT_L(0); PG8_MMA(1, 0, At, B0); PG8_BAR; PG8_SCHED;
            PG8_STAGE(PG8_SB(1, 1), b3 + hstep, voffB);
            PG8_WAIT_V(6); PG8_BAR; PG8_MMA(1, 1, At, B1); PG8_BAR;
            }
        }
        if constexpr (ALIGN_EPI) { if (wr == 0) PG8_BAR; }
        if constexpr (!Epi::AFTER_DRAIN) { E(acc, cur, wr, wc, fr, fq); S.done(cur); }
        if (!has_next) break;
#pragma unroll
        for (int a = 0; a < 2; ++a)
#pragma unroll
            for (int b = 0; b < 2; ++b)
#pragma unroll
                for (int m = 0; m < 4; ++m)
#pragma unroll
                    for (int n = 0; n < 2; ++n) acc[a][b][m][n] = (f32x4){0.f, 0.f, 0.f, 0.f};
        cur = nxt; cA = nA; cB = nB; ++ui;
        if constexpr (ALIGN_EPI) { if (wr == 1) PG8_BAR; }
    }
    PG8_WAIT_V(0);
    if constexpr (!ALIGN_EPI) { if (wr == 0) PG8_BAR; }
    PG8_BAR;
    if constexpr (Epi::AFTER_DRAIN) { E.fused(acc, cur, wr, wc, fr, fq, lds, wid, lane); S.done(cur); }
#undef PG8_SA
#undef PG8_SB
#undef PG8_STAGE
#undef PG8_LDA
#undef PG8_LDB
#undef PG8_MMA
#undef PG8_WAIT_V
#undef PG8_WAIT_L
#undef PG8_BAR
#undef PG8_SCHED
}
}

constexpr int DM = 4096, NBATCH = 2, SEQ = 8192, DEPTH = 4, CTXL = 256;
constexpr int NLAT = NBATCH * SEQ, NCTX = NBATCH * CTXL, MROWS = NLAT + NCTX;
constexpr int NIN = 13568, GWD = 1024;
constexpr int C_POOLV = 0, C_POOLZ = 1024, C_NAZ = 2048, C_RWZ = 3072, C_SGU = 4096, C_SGZ = 5120, C_NAQ = 6144, C_NAK = 7168, C_NAV = 8192, C_RWR = 9216, C_RWK = 10240, C_RWV = 11264,
              C_RWWD = 12288, C_RWAD = 12416, C_SGV = 12544;
constexpr int C_SPLIT = 5632;
__host__ __device__ __forceinline__ int phys_tile(int lt) {
    return lt < 8 ? lt : lt < 20 ? lt + 16 : lt < 24 ? lt - 12 : lt < 36 ? lt + 12 : lt < 40 ? lt - 24 : lt == 40 ? 48 : lt < 45 ? lt - 25 : lt < 49 ? lt + 4 : lt - 29;
}
constexpr int SCANLEN = CTXL + SEQ;
constexpr int NCHAIN = 64;
constexpr int RECB = 768;
constexpr int RECF = RECB / 4;
constexpr int NWAVES = 8;

constexpr size_t MiB = 1u << 20;
constexpr size_t WS_CTL = 0, CTL_ZERO_BYTES = 1 * MiB;
constexpr size_t WS_MOD   = 2 * MiB;
constexpr size_t WS_TAB   = 3 * MiB;
constexpr size_t WS_SILUC = 3 * MiB + 512 * 1024;
constexpr size_t WS_SGST  = 4 * MiB;
constexpr size_t WS_BON   = 5 * MiB;
constexpr size_t WS_POOLWT= 8 * MiB;
constexpr size_t WS_WUPT  = 10 * MiB;
constexpr size_t WS_AUPT  = 11 * MiB;
constexpr size_t WS_SGW   = 12 * MiB;
constexpr size_t WS_VTC   = 13 * MiB;
constexpr size_t WS_HCTX  = 14 * MiB;
constexpr size_t WS_MODP  = 22 * MiB;
constexpr size_t WS_VTL   = 58 * MiB;
constexpr size_t WS_QN    = 90 * MiB;
constexpr size_t WS_KN    = 123 * MiB;
constexpr size_t WS_WOUTT = 156 * MiB;
constexpr size_t WS_WINT  = 284 * MiB;
constexpr size_t WS_XN    = 708 * MiB;
constexpr size_t WS_Y     = 840 * MiB;
constexpr size_t WS_P     = 972 * MiB;
constexpr size_t WS_YR    = 1410 * MiB;
constexpr size_t WS_REC   = 1542 * MiB;
constexpr size_t WS_END   = 2334 * MiB;
static_assert(WS_P + (size_t)MROWS * NIN * 2 <= WS_YR && WS_REC + (size_t)NCHAIN * SCANLEN * RECB <= WS_END && WS_WINT + (size_t)4 * NIN * DM * 2 <= WS_XN, "ws map");
constexpr int CW_TMO = 0, CW_BAR = 4096;

constexpr int RING_BYTES = 131072, SCANRING_BYTES = 4 * 32 * RECB, SGUT_OFF = SCANRING_BYTES, LDSCTL_OFF = SGUT_OFF + 128 * 136 * 2, MISC_OFF = LDSCTL_OFF + 320, LDS_BYTES = LDSCTL_OFF + 1024;

#define GAS __attribute__((address_space(1)))
#define LAS __attribute__((address_space(3)))
typedef unsigned short bf16;
typedef unsigned v4u __attribute__((ext_vector_type(4)));
typedef unsigned v2u __attribute__((ext_vector_type(2)));
typedef float f32x4 __attribute__((ext_vector_type(4)));
typedef float f32x2 __attribute__((ext_vector_type(2)));
typedef short bf16x8 __attribute__((ext_vector_type(8)));
typedef _Float16 h4 __attribute__((ext_vector_type(4)));
typedef _Float16 h8 __attribute__((ext_vector_type(8)));
#define RLX_AGENT __ATOMIC_RELAXED, __HIP_MEMORY_SCOPE_AGENT
#define LDS_WAIT() asm volatile("s_waitcnt lgkmcnt(0)" ::: "memory")

__device__ __forceinline__ float bf2f(unsigned short h) { return __uint_as_float(((unsigned)h) << 16); }
__device__ __forceinline__ float bflo(unsigned w) { return __uint_as_float(w << 16); }
__device__ __forceinline__ float bfhi(unsigned w) { return __uint_as_float(w & 0xffff0000u); }
typedef __bf16 bf16x2_t __attribute__((ext_vector_type(2)));
__device__ __forceinline__ unsigned pk2(float lo, float hi) { const f32x2 v = {lo, hi}; const bf16x2_t b = __builtin_convertvector(v, bf16x2_t); return __builtin_bit_cast(unsigned, b); }
__device__ __forceinline__ unsigned f2bf(float f) { return pk2(f, 0.f) & 0xffffu; }
__device__ __forceinline__ float rcp_f(float x) { return __builtin_amdgcn_rcpf(x); }
__device__ __forceinline__ float rsq_f(float x) { return __builtin_amdgcn_rsqf(x); }
__device__ __forceinline__ void unpack8(const v4u w, float* x) { x[0] = bflo(w.x); x[1] = bfhi(w.x); x[2] = bflo(w.y); x[3] = bfhi(w.y); x[4] = bflo(w.z); x[5] = bfhi(w.z); x[6] = bflo(w.w); x[7] = bfhi(w.w); }
__device__ __forceinline__ v4u pack8(const float* x) { v4u w; w.x = pk2(x[0], x[1]); w.y = pk2(x[2], x[3]); w.z = pk2(x[4], x[5]); w.w = pk2(x[6], x[7]); return w; }
__device__ __forceinline__ float silu_f(float x) { return x * rcp_f(1.f + __expf(-x)); }
__device__ __forceinline__ float wave_sum(float v) {
#pragma unroll
    for (int o = 1; o < 64; o <<= 1) v += __shfl_xor(v, o);
    return v;
}
template <int CTRL> __device__ __forceinline__ float dppf(float v) { return __builtin_bit_cast(float, __builtin_amdgcn_update_dpp(0, __builtin_bit_cast(int, v), CTRL, 0xF, 0xF, true)); }
__device__ __forceinline__ float red16(float v) { v += dppf<0xB1>(v); v += dppf<0x4E>(v); v += dppf<0x141>(v); v += dppf<0x140>(v); return v; }
__device__ __forceinline__ void red16x2(float& a, float& b) {
    a += dppf<0xB1>(a); b += dppf<0xB1>(b); a += dppf<0x4E>(a); b += dppf<0x4E>(b); a += dppf<0x141>(a); b += dppf<0x141>(b); a += dppf<0x140>(a); b += dppf<0x140>(b); }
__device__ __forceinline__ float red16_transpose(const float (&y)[16], int c16) {
    float a[8], b[4], c[2];
    const bool h2 = (c16 & 2) != 0, h1 = (c16 & 1) != 0;
    asm volatile("s_nop 1");
#pragma unroll
    for (int j = 0; j < 8; ++j)
        asm volatile("v_add_f32_dpp %0, %1, %1 row_mirror row_mask:0xf bank_mask:0x3\n\tv_add_f32_dpp %0, %2, %2 row_mirror row_mask:0xf bank_mask:0xc" : "=&v"(a[j]) : "v"(y[j]), "v"(y[j + 8]));
#pragma unroll
    for (int j = 0; j < 4; ++j)
        asm volatile("v_add_f32_dpp %0, %1, %1 row_half_mirror row_mask:0xf bank_mask:0x5\n\tv_add_f32_dpp %0, %2, %2 row_half_mirror row_mask:0xf bank_mask:0xa" : "=&v"(b[j]) : "v"(a[j]), "v"(a[j + 4]));
    asm volatile("s_nop 0" : "+v"(b[2]), "+v"(b[3]));
#pragma unroll
    for (int j = 0; j < 2; ++j) { const float keep = h2 ? b[j + 2] : b[j], send = h2 ? b[j] : b[j + 2]; c[j] = keep + dppf<0x1B>(send); }
    const float keep = h1 ? c[1] : c[0], send = h1 ? c[0] : c[1];
    return keep + dppf<0xB1>(send);
}
__device__ __forceinline__ float max16x4(float v) { v = fmaxf(v, __shfl_xor(v, 16)); v = fmaxf(v, __shfl_xor(v, 32)); return v; }
__device__ __forceinline__ float sum16x4(float v) { v += __shfl_xor(v, 16); v += __shfl_xor(v, 32); return v; }
__device__ __forceinline__ int scan_pos(int d, bool isctx, int t) { return d == 0 ? (isctx ? t : CTXL + t) : (isctx ? (CTXL - 1 - t) : (CTXL + SEQ - 1 - t)); }
__device__ __forceinline__ f32x4 mfma16(bf16x8 a, bf16x8 b, f32x4 c) { return __builtin_amdgcn_mfma_f32_16x16x32_bf16(a, b, c, 0, 0, 0); }
__device__ __forceinline__ bf16x8 ld_frag(const bf16* p) { return __builtin_bit_cast(bf16x8, *(const v4u*)p); }

namespace pg8 {
struct EpiStoreBf16 {
    static constexpr bool PERM = true, AFTER_DRAIN = false;
    bf16_t* O; int ldc;
    __device__ __forceinline__ void operator()(const f32x4 (&acc)[2][2][4][2], const Unit& u, int wr, int wc, int fr, int fq) const {
        const int row0 = u.pm * BM + wr * 64 + fr, col0 = u.pn * BM + wc * 32 + 8 * fq;
#pragma unroll
        for (int ai = 0; ai < 2; ++ai)
#pragma unroll
            for (int m = 0; m < 4; ++m) { bf16_t* rowp = O + (size_t)(row0 + ai * HALF + m * 16) * ldc + col0;
#pragma unroll
                for (int bj = 0; bj < 2; ++bj) { const f32x4 v0 = acc[ai][bj][m][0], v1 = acc[ai][bj][m][1];
                    u32x4 w; w.x = cvt_pk_bf16(v0[0], v0[1]); w.y = cvt_pk_bf16(v0[2], v0[3]); w.z = cvt_pk_bf16(v1[0], v1[1]); w.w = cvt_pk_bf16(v1[2], v1[3]);
                    *(u32x4*)(rowp + bj * HALF) = w; } }
    }
};
struct EpiResGate {
    static constexpr bool PERM = false, AFTER_DRAIN = false;
    const float* hin_lat; const float* hin_ctx; float* hout_lat; float* hout_ctx; const float* gate;
    __device__ __forceinline__ void operator()(const f32x4 (&acc)[2][2][4][2], const Unit& u, int wr, int wc, int fr, int fq) const {
        const int cond = u.pm < 32 ? 0 : (u.pm < 64 ? 1 : 2);
        const int rloc = (u.pm < 64 ? u.pm * BM : (u.pm - 64) * BM) + wr * 64 + fr, col0 = u.pn * BM + wc * 32 + 4 * fq;
        const float* hin = u.pm < 64 ? hin_lat : hin_ctx; float* hout = u.pm < 64 ? hout_lat : hout_ctx;
        f32x4 gv[2][2];
#pragma unroll
        for (int bj = 0; bj < 2; ++bj)
#pragma unroll
            for (int n = 0; n < 2; ++n) gv[bj][n] = *(const f32x4*)(gate + cond * 12288 + 8192 + col0 + bj * HALF + n * 16);
#pragma unroll
        for (int ai = 0; ai < 2; ++ai)
#pragma unroll
            for (int m = 0; m < 4; ++m) { const size_t off = (size_t)(rloc + ai * HALF + m * 16) * 4096 + col0;
#pragma unroll
                for (int bj = 0; bj < 2; ++bj)
#pragma unroll
                    for (int n = 0; n < 2; ++n) { const f32x4 b = *(const f32x4*)(hin + off + bj * HALF + n * 16);
                        *(f32x4*)(hout + off + bj * HALF + n * 16) = b + gv[bj][n] * acc[ai][bj][m][n]; } }
    }
};
}

template <bool PERMC = false>
__device__ __forceinline__ void p0_transpose_item(const float* W, int K, int N, bf16* WT, LAS float* scr, int item, int lane) {
    const int nblk = N / 32, kb = item / nblk, nb = item % nblk, k0 = 64 * kb, n0 = 32 * nb;
    const int pn0 = PERMC ? phys_tile(n0 >> 8) * 256 + (n0 & 255) : n0;
#pragma unroll 8
    for (int i = 0; i < 32; ++i) { const int kk = 2 * i + (lane >> 5); scr[kk * 33 + (lane & 31)] = W[(size_t)(k0 + kk) * N + n0 + (lane & 31)]; }
    LDS_WAIT(); asm volatile("" ::: "memory");
    const int c = lane & 7;
#pragma unroll
    for (int j = 0; j < 4; ++j) { const int n = (lane >> 3) + 8 * j; const LAS float* s = scr + (8 * c) * 33 + n;
        v4u o; o.x = pk2(s[0 * 33], s[1 * 33]); o.y = pk2(s[2 * 33], s[3 * 33]); o.z = pk2(s[4 * 33], s[5 * 33]); o.w = pk2(s[6 * 33], s[7 * 33]);
        *(v4u*)(WT + (size_t)(pn0 + n) * K + k0 + 8 * c) = o; }
    LDS_WAIT(); asm volatile("" ::: "memory");
}
template <bool PERMC = false>
__device__ __forceinline__ void transpose_item_nolds(const float* W, int K, int N, bf16* WT, int item, int lane) {
    const int nblk = N / 64, kb = item / nblk, nb = item % nblk, k0 = 64 * kb, n0 = 64 * nb;
    const int pn0 = PERMC ? phys_tile(n0 >> 8) * 256 + (n0 & 255) : n0;
    const float* src = W + (size_t)k0 * N + n0 + lane;
    bf16* dst = WT + (size_t)(pn0 + lane) * K + k0;
#pragma unroll
    for (int hb = 0; hb < 2; ++hb) {
        float v[32];
#pragma unroll
        for (int i = 0; i < 32; ++i) v[i] = __builtin_nontemporal_load(src + (size_t)(32 * hb + i) * N);
        __builtin_amdgcn_sched_barrier(0);
#pragma unroll
        for (int j = 0; j < 4; ++j) { v4u o; o.x = pk2(v[8 * j], v[8 * j + 1]); o.y = pk2(v[8 * j + 2], v[8 * j + 3]); o.z = pk2(v[8 * j + 4], v[8 * j + 5]); o.w = pk2(v[8 * j + 6], v[8 * j + 7]);
            *(v4u*)(dst + 32 * hb + 8 * j) = o; }
        __builtin_amdgcn_sched_barrier(0);
    }
}
constexpr int WC_WIN = (DM / 64) * (NIN / 64), WC_WOUT = (DM / 64) * (DM / 64), WC_POOL = 4 * 16, WC_WUP = 2 * 16, WC_AUP = 2 * 16, WC_SGW = 256, WC_ITEMS = WC_WIN + WC_WOUT + WC_POOL + WC_WUP + WC_AUP + WC_SGW;
__device__ __forceinline__ void weight_copy_item(int L, int r, const float* w_in, const float* w_out, const float* pool_w, const float* rw_w_up, const float* rw_a_up, const float* sg_w,
                                                 bf16* WINT, bf16* WOUTT, bf16* POOLWT, bf16* WUPT, bf16* AUPT, bf16* SGW, int lane) {
    if (r < WC_WIN) { transpose_item_nolds<true>(w_in + (size_t)L * DM * NIN, DM, NIN, WINT + (size_t)L * NIN * DM, r, lane); return; } r -= WC_WIN;
    if (r < WC_WOUT) { transpose_item_nolds(w_out + (size_t)L * DM * DM, DM, DM, WOUTT + (size_t)L * DM * DM, r, lane); return; } r -= WC_WOUT;
    if (r < WC_POOL) { const int g = r >> 4; transpose_item_nolds(pool_w + (size_t)(L * 4 + g) * 65536, 256, 256, POOLWT + (size_t)(L * 4 + g) * 65536, r & 15, lane); return; } r -= WC_POOL;
    if (r < WC_WUP) { const int dd = r >> 4; transpose_item_nolds(rw_w_up + (size_t)(L * 2 + dd) * 65536, 64, 1024, WUPT + (size_t)(L * 2 + dd) * 65536, r & 15, lane); return; } r -= WC_WUP;
    if (r < WC_AUP) { const int dd = r >> 4; transpose_item_nolds(rw_a_up + (size_t)(L * 2 + dd) * 65536, 64, 1024, AUPT + (size_t)(L * 2 + dd) * 65536, r & 15, lane); return; } r -= WC_AUP;
    {   const size_t e0 = (size_t)L * 131072 + (size_t)r * 512 + lane * 8; const f32x4 a = *(const f32x4*)(sg_w + e0), b = *(const f32x4*)(sg_w + e0 + 4);
        v4u o; o.x = pk2(a.x, a.y); o.y = pk2(a.z, a.w); o.z = pk2(b.x, b.y); o.w = pk2(b.z, b.w); *(v4u*)(SGW + e0) = o; }
}
__device__ __forceinline__ void p0_mod_item(const float* wmod, const float* cvec, const float* cctx, float* MODP, LAS float* scr, int item, int lane) {
    const int l = item / (64 * 48), r = item % (64 * 48), kc = r / 48, nc = r % 48, k0 = kc * 64, n0 = nc * 256 + lane * 4;
    scr[lane] = silu_f(cvec[k0 + lane]); scr[64 + lane] = silu_f(cvec[4096 + k0 + lane]); scr[128 + lane] = silu_f(cctx[k0 + lane]);
    LDS_WAIT(); asm volatile("" ::: "memory");
    f32x4 a0 = {0.f, 0.f, 0.f, 0.f}, a1 = a0, a2 = a0;
    const float* wp = wmod + ((size_t)l * 4096 + k0) * 12288 + n0;
#pragma unroll 16
    for (int k = 0; k < 64; ++k) { const f32x4 w = *(const f32x4*)(wp + (size_t)k * 12288); a0 += scr[k] * w; a1 += scr[64 + k] * w; a2 += scr[128 + k] * w; }
    float* o = MODP + ((size_t)(l * 64 + kc) * 3) * 12288 + n0;
    *(f32x4*)(o) = a0; *(f32x4*)(o + 12288) = a1; *(f32x4*)(o + 2 * 12288) = a2;
    LDS_WAIT(); asm volatile("" ::: "memory");
}
__device__ __forceinline__ void mod_item_nolds(const float* wmod_l  , const float* siluc, float* MODP_l  , int item, int lane) {
    const int kc = item / 48, nc = item % 48, k0 = kc * 64, n0 = nc * 256 + lane * 4;
    f32x4 a0 = {0.f, 0.f, 0.f, 0.f}, a1 = a0, a2 = a0;
    const float* wp = wmod_l + (size_t)k0 * 12288 + n0;
    const int s0v = __builtin_bit_cast(int, siluc[k0 + lane]), s1v = __builtin_bit_cast(int, siluc[4096 + k0 + lane]), s2v = __builtin_bit_cast(int, siluc[8192 + k0 + lane]);
#pragma unroll
    for (int k = 0; k < 64; ++k) { const f32x4 w = __builtin_nontemporal_load((const f32x4*)(wp + (size_t)k * 12288));
        a0 += __builtin_bit_cast(float, __builtin_amdgcn_readlane(s0v, k)) * w; a1 += __builtin_bit_cast(float, __builtin_amdgcn_readlane(s1v, k)) * w; a2 += __builtin_bit_cast(float, __builtin_amdgcn_readlane(s2v, k)) * w; }
    float* o = MODP_l + ((size_t)kc * 3) * 12288 + n0;
    *(f32x4*)(o) = a0; *(f32x4*)(o + 12288) = a1; *(f32x4*)(o + 2 * 12288) = a2;
}
__device__ __forceinline__ void sincos_acc(float ang, float& c, float& s) {
    const double x = (double)ang; const double n = __builtin_rint(x * 0.63661977236758134308); const double r = x - n * 1.57079632679489661923;
    const double r2 = r * r;
    const double sp = r * (1.0 + r2 * (-1.0 / 6 + r2 * (1.0 / 120 + r2 * (-1.0 / 5040 + r2 * (1.0 / 362880 + r2 * (-1.0 / 39916800 + r2 * (1.0 / 6227020800.0)))))));
    const double cp = 1.0 + r2 * (-0.5 + r2 * (1.0 / 24 + r2 * (-1.0 / 720 + r2 * (1.0 / 40320 + r2 * (-1.0 / 3628800 + r2 * (1.0 / 479001600 + r2 * (-1.0 / 87178291200.0)))))));
    const int q = ((int)n) & 3;
    const double cc = (q == 0) ? cp : (q == 1) ? -sp : (q == 2) ? -cp : sp;
    const double ss = (q == 0) ? sp : (q == 1) ? cp : (q == 2) ? -sp : -cp;
    c = (float)cc; s = (float)ss;
}

__device__ __forceinline__ void phase_xn(const float* hlat, const float* hctx, const float* mod, bf16* XN, int gw, int NGW, int lane) {
    for (int m = gw; m < MROWS; m += NGW) {
        const float* src = m < NLAT ? hlat + (size_t)m * DM : hctx + (size_t)(m - NLAT) * DM;
        const int cond = m < NLAT ? (m >> 13) : 2;
        const f32x4* s4 = (const f32x4*)src + lane;
        f32x4 v[16]; float ss = 0.f;
#pragma unroll
        for (int j = 0; j < 16; ++j) { v[j] = __builtin_nontemporal_load(s4 + 64 * j); ss += (v[j].x * v[j].x + v[j].y * v[j].y) + (v[j].z * v[j].z + v[j].w * v[j].w); }
        ss = wave_sum(ss);
        const float rstd = rsq_f(ss * (1.f / 4096.f) + 1e-6f);
        const f32x4* sh4 = (const f32x4*)(mod + cond * 12288) + lane; const f32x4* sc4 = (const f32x4*)(mod + cond * 12288 + 4096) + lane;
        v2u* o = (v2u*)(XN + (size_t)m * DM) + lane;
#pragma unroll
        for (int j = 0; j < 16; ++j) { const f32x4 sh = sh4[64 * j], sc = sc4[64 * j]; const f32x4 x = v[j] * rstd * (sc + 1.f) + sh; v2u w; w.x = pk2(x.x, x.y); w.y = pk2(x.z, x.w); o[64 * j] = w; }
    }
}

__device__ __forceinline__ void phase_rowprep(const bf16* P, const float* qgain, const float* kgain, const f32x2* tab, bf16* QN, bf16* KN, f32x2* SGST, int gw, int NGW, int lane) {
    const int sub = lane & 3;
    for (int m = gw; m < MROWS; m += NGW) {
        const bf16* pr = P + (size_t)m * NIN;
        const bool isctx = m >= NLAT; const int t = isctx ? ((m - NLAT) & 255) : (m & 8191);
        {   float x[16]; unpack8(*(const v4u*)(pr + C_SGV + 16 * lane), x); unpack8(*(const v4u*)(pr + C_SGV + 16 * lane + 8), x + 8);
            float s = 0.f;
#pragma unroll
            for (int i = 0; i < 16; ++i) s += x[i];
            const float mean = wave_sum(s) * (1.f / 1024.f); float q = 0.f;
#pragma unroll
            for (int i = 0; i < 16; ++i) { const float dlt = x[i] - mean; q += dlt * dlt; }
            const float var = wave_sum(q) * (1.f / 1024.f);
            if (lane == 0) SGST[m] = (f32x2){mean, rsq_f(var + 1e-5f)}; }
        float q[16], k[16];
        unpack8(*(const v4u*)(pr + C_NAQ + 16 * lane), q); unpack8(*(const v4u*)(pr + C_NAQ + 16 * lane + 8), q + 8);
        unpack8(*(const v4u*)(pr + C_NAK + 16 * lane), k); unpack8(*(const v4u*)(pr + C_NAK + 16 * lane + 8), k + 8);
        float sq = 0.f, sk = 0.f;
#pragma unroll
        for (int i = 0; i < 16; ++i) { sq += q[i] * q[i]; sk += k[i] * k[i]; }
        sq += __shfl_xor(sq, 1); sq += __shfl_xor(sq, 2); sk += __shfl_xor(sk, 1); sk += __shfl_xor(sk, 2);
        const float rq = rsq_f(sq * (1.f / 64.f) + 1e-6f), rk = rsq_f(sk * (1.f / 64.f) + 1e-6f);
#pragma unroll
        for (int i = 0; i < 16; ++i) { q[i] *= rq * qgain[16 * sub + i]; k[i] *= rk * kgain[16 * sub + i]; }
        if (!isctx) {
            const int pos = sub < 2 ? (t >> 6) : (t & 63);
#pragma unroll
            for (int i = 0; i < 16; ++i) { const f32x2 cs = tab[pos * 16 + i]; const float pq = __shfl_xor(q[i], 1), pkk = __shfl_xor(k[i], 1);
                q[i] = (sub & 1) ? (q[i] * cs.x + pq * cs.y) : (q[i] * cs.x - pq * cs.y);
                k[i] = (sub & 1) ? (k[i] * cs.x + pkk * cs.y) : (k[i] * cs.x - pkk * cs.y); }
        }
#pragma unroll
        for (int i = 0; i < 16; ++i) q[i] *= 0.125f;
        *(v4u*)(QN + (size_t)m * GWD + 16 * lane) = pack8(q); *(v4u*)(QN + (size_t)m * GWD + 16 * lane + 8) = pack8(q + 8);
        *(v4u*)(KN + (size_t)m * GWD + 16 * lane) = pack8(k); *(v4u*)(KN + (size_t)m * GWD + 16 * lane + 8) = pack8(k + 8);
    }
}
__device__ __forceinline__ void phase_vt(const bf16* P, bf16* VTL, bf16* VTC, int gw, int NGW, int lane) {
    for (int u = gw; u < (MROWS / 64) * 16; u += NGW) {
        const int tt = u >> 4, h = u & 15, m0 = tt * 64;
        const bf16* src = P + (size_t)m0 * NIN + C_NAV + h * 64 + lane;
        unsigned w[32];
#pragma unroll
        for (int i = 0; i < 32; ++i) { const unsigned lo = src[(size_t)(2 * i) * NIN], hi = src[(size_t)(2 * i + 1) * NIN]; w[i] = lo | (hi << 16); }
        bf16* dst = tt < 256 ? VTL + (((size_t)((tt >> 7) * 16 + h) * 64 + lane) * 8192 + (tt & 127) * 64)
                             : VTC + (((size_t)(((tt - 256) >> 2) * 16 + h) * 64 + lane) * 256 + ((tt - 256) & 3) * 64);
#pragma unroll
        for (int j = 0; j < 8; ++j) { v4u o; o.x = w[4 * j]; o.y = w[4 * j + 1]; o.z = w[4 * j + 2]; o.w = w[4 * j + 3]; ((v4u*)dst)[j] = o; }
    }
}
template <int G>
__device__ __forceinline__ void pool_unit(const bf16* P, const bf16* wbase, const float* pscale, bf16* Y, int m0, int lane) {
    constexpr int WIN = 2 << G;
    const int r = lane & 15, q4 = lane >> 4, m = m0 + r;
    const bool isctx = m0 >= NLAT; const int T = isctx ? CTXL : SEQ; const int t = isctx ? ((m - NLAT) & 255) : (m & 8191);
    const int tlo = t - (WIN >> 1);
    const int lo = tlo < 0 ? 0 : tlo, hi = (tlo + WIN) > T ? T : (tlo + WIN);
    const float inv = rcp_f((float)(hi - lo));
    f32x4 acc[16];
#pragma unroll
    for (int nt = 0; nt < 16; ++nt) acc[nt] = (f32x4){0.f, 0.f, 0.f, 0.f};
#pragma unroll 1
    for (int ks = 0; ks < 8; ++ks) {
        const int ch0 = C_POOLV + G * 256 + 32 * ks + 8 * q4;
        constexpr int WB = WIN < 8 ? WIN : 8;
        bf16x8 bfr[8];
        float sum[8];
#pragma unroll
        for (int j = 0; j < 8; ++j) sum[j] = 0.f;
        const v4u selfw = *(const v4u*)(P + (size_t)m * NIN + ch0);
#pragma unroll
        for (int nt = 0; nt < 8; ++nt) bfr[nt] = ld_frag(wbase + (size_t)(16 * nt + r) * 256 + 32 * ks + 8 * q4);
        bf16x8 bfr2[8];
#pragma unroll
        for (int nt = 0; nt < 8; ++nt) bfr2[nt] = ld_frag(wbase + (size_t)(16 * (nt + 8) + r) * 256 + 32 * ks + 8 * q4);
#pragma unroll
        for (int k0 = 0; k0 < WIN; k0 += WB) {
            v4u wl[WB];
#pragma unroll
            for (int k = 0; k < WB; ++k) { const int tk = tlo + k0 + k; const bool ok = tk >= 0 && tk < T; wl[k] = *(const v4u*)(P + (size_t)(ok ? (m - t + tk) : m) * NIN + ch0); }
            __builtin_amdgcn_sched_barrier(0);
#pragma unroll
            for (int k = 0; k < WB; ++k) { const int tk = tlo + k0 + k; const bool ok = tk >= 0 && tk < T; float x[8]; unpack8(wl[k], x);
#pragma unroll
                for (int j = 0; j < 8; ++j) sum[j] += ok ? x[j] : 0.f; }
            __builtin_amdgcn_sched_barrier(0);
        }
        float self[8]; unpack8(selfw, self);
        float dv[8];
#pragma unroll
        for (int j = 0; j < 8; ++j) dv[j] = sum[j] * inv - self[j];
        const bf16x8 af = __builtin_bit_cast(bf16x8, pack8(dv));
        __builtin_amdgcn_sched_barrier(0);
#pragma unroll
        for (int nt = 0; nt < 8; ++nt) acc[nt] = mfma16(af, bfr[nt], acc[nt]);
        __builtin_amdgcn_sched_barrier(0);
#pragma unroll
        for (int nt = 0; nt < 8; ++nt) acc[nt + 8] = mfma16(af, bfr2[nt], acc[nt + 8]);
        __builtin_amdgcn_sched_barrier(0);
    }
#pragma unroll
    for (int nh = 0; nh < 4; ++nh) {
        unsigned short zz[4][4]; float ps[4];
#pragma unroll
        for (int nq = 0; nq < 4; ++nq) { const int oc = G * 256 + 16 * (4 * nh + nq) + r; ps[nq] = pscale[oc];
#pragma unroll
            for (int i = 0; i < 4; ++i) zz[nq][i] = P[(size_t)(m0 + 4 * q4 + i) * NIN + C_POOLZ + oc]; }
        __builtin_amdgcn_sched_barrier(0);
#pragma unroll
        for (int nq = 0; nq < 4; ++nq) { const int oc = G * 256 + 16 * (4 * nh + nq) + r;
#pragma unroll
            for (int i = 0; i < 4; ++i) Y[(size_t)(m0 + 4 * q4 + i) * DM + oc] = (bf16)f2bf(acc[4 * nh + nq][i] * ps[nq] * silu_f(bf2f(zz[nq][i]))); }
        __builtin_amdgcn_sched_barrier(0);
    }
}
__device__ __forceinline__ void phase_pool(const bf16* P, const bf16* PWT  , const float* pscale, bf16* Y, int nrows, int gw, int NGW, int lane) {
    for (int u = gw; u < (nrows / 16) * 4; u += NGW) {
        const int tt = u >> 2, g = u & 3, m0 = tt * 16;
        const bf16* wbase = PWT + (size_t)g * 65536;
        if (g == 0) pool_unit<0>(P, wbase, pscale, Y, m0, lane);
        else if (g == 1) pool_unit<1>(P, wbase, pscale, Y, m0, lane);
        else if (g == 2) pool_unit<2>(P, wbase, pscale, Y, m0, lane);
        else pool_unit<3>(P, wbase, pscale, Y, m0, lane);
    }
}
#define REC_ST(p, v) __builtin_nontemporal_store((v), (p))
__device__ __forceinline__ void phase_rwprep(const bf16* P, const float* mu_rkv  , const float* mu_lora  , const float* w0  , const bf16* WUPT  ,
                                             const float* a0, const bf16* AUPT, const float* k_k, const float* k_a, const float* r_k, float* REC, float* BON, LAS unsigned char* lds,
                                             unsigned* queue  , int cls, int wave, int lane) {
    const int n = lane & 15, q4 = lane >> 4;
    const int d = cls >> 3, hp = cls & 7;
    unsigned* qh = queue + 64 * cls;
    LAS float* prm = (LAS float*)(lds + wave * 4096);
#pragma unroll
    for (int it = 0; it < 16; ++it) { const int hh = it >> 3, p = it & 7, ch = (hp * 2 + hh) * 64 + lane;
        const float* src = p == 0 ? w0 + d * 1024 : p == 1 ? a0 + d * 1024 : p == 2 ? mu_rkv + (d * 3 + 0) * 1024 : p == 3 ? mu_rkv + (d * 3 + 1) * 1024 : p == 4 ? mu_rkv + (d * 3 + 2) * 1024 : p == 5 ? k_k : p == 6 ? k_a : r_k;
        prm[it * 64 + lane] = src[ch]; }
    LDS_WAIT(); asm volatile("" ::: "memory");
    unsigned pend = 0u;
    if (lane == 0) pend = __hip_atomic_fetch_add(qh, 1u, __ATOMIC_RELAXED, __HIP_MEMORY_SCOPE_AGENT);
    for (;;) {
        const int tt = __builtin_amdgcn_readfirstlane((int)pend);
        if (tt >= MROWS / 16) break;
        if (lane == 0) pend = __hip_atomic_fetch_add(qh, 1u, __ATOMIC_RELAXED, __HIP_MEMORY_SCOPE_AGENT);
        const int m0 = tt * 16;
        const bool isctx = m0 >= NLAT; const int T = isctx ? CTXL : SEQ; const int t0 = isctx ? ((m0 - NLAT) & 255) : (m0 & 8191); const int b = isctx ? ((m0 - NLAT) >> 8) : (m0 >> 13);
        const int m = m0 + n, t = t0 + n; const bool hasnb = d == 0 ? (t > 0) : (t < T - 1); const int nbr = hasnb ? (d == 0 ? m - 1 : m + 1) : m;
        const bf16* prow = P + (size_t)m * NIN; const bf16* nrow = P + (size_t)nbr * NIN;
        bf16x8 Bw[2], Ba[2];
        {   v4u cw[2], nw[2], ca[2], na[2]; f32x4 mw[2][2], ma[2][2];
#pragma unroll
            for (int ks = 0; ks < 2; ++ks) { const int j0 = 32 * ks + 8 * q4;
                cw[ks] = *(const v4u*)(prow + C_RWWD + d * 64 + j0); nw[ks] = *(const v4u*)(nrow + C_RWWD + d * 64 + j0);
                ca[ks] = *(const v4u*)(prow + C_RWAD + d * 64 + j0); na[ks] = *(const v4u*)(nrow + C_RWAD + d * 64 + j0);
                mw[ks][0] = *(const f32x4*)(mu_lora + (d * 2 + 0) * 64 + j0); mw[ks][1] = *(const f32x4*)(mu_lora + (d * 2 + 0) * 64 + j0 + 4);
                ma[ks][0] = *(const f32x4*)(mu_lora + (d * 2 + 1) * 64 + j0); ma[ks][1] = *(const f32x4*)(mu_lora + (d * 2 + 1) * 64 + j0 + 4); }
            __builtin_amdgcn_sched_barrier(0);
#pragma unroll
            for (int ks = 0; ks < 2; ++ks) {
                float cur[8], nb[8], o[8];
                unpack8(cw[ks], cur); unpack8(nw[ks], nb);
#pragma unroll
                for (int j = 0; j < 8; ++j) { const float xx = cur[j] + ((hasnb ? nb[j] : 0.f) - cur[j]) * mw[ks][j >> 2][j & 3]; o[j] = 1.0f - 2.0f * rcp_f(1.0f + __expf(2.0f * xx)); }
                Bw[ks] = __builtin_bit_cast(bf16x8, pack8(o));
                unpack8(ca[ks], cur); unpack8(na[ks], nb);
#pragma unroll
                for (int j = 0; j < 8; ++j) o[j] = cur[j] + ((hasnb ? nb[j] : 0.f) - cur[j]) * ma[ks][j >> 2][j & 3];
                Ba[ks] = __builtin_bit_cast(bf16x8, pack8(o)); }
        }
        const int pos = scan_pos(d, isctx, t);
#pragma unroll 1
        for (int hh = 0; hh < 2; ++hh) {
            const int head = hp * 2 + hh, chain = (b * 2 + d) * 16 + head;
            char* recb = (char*)REC + ((size_t)chain * SCANLEN + pos) * RECB;
            const LAS float* pr = prm + hh * 512;
            float KK[16], AV[16]; float ss = 0.f, bon = 0.f;
#pragma unroll
            for (int hf = 0; hf < 2; ++hf) {
                const int cl = 32 * hf + 8 * q4, cg = head * 64 + cl;
                bf16x8 wf[2][2], af[2][2];
#pragma unroll
                for (int tq = 0; tq < 2; ++tq) { const size_t wrow = (size_t)(d * 1024 + head * 64 + 32 * hf + 8 * (n >> 2) + 4 * tq + (n & 3)) * 64 + 8 * q4;
                    wf[tq][0] = ld_frag(WUPT + wrow); wf[tq][1] = ld_frag(WUPT + wrow + 32); af[tq][0] = ld_frag(AUPT + wrow); af[tq][1] = ld_frag(AUPT + wrow + 32); }
                const v4u rcw = *(const v4u*)(prow + C_RWR + cg), kcw = *(const v4u*)(prow + C_RWK + cg), vcw = *(const v4u*)(prow + C_RWV + cg);
                const v4u rnw = *(const v4u*)(nrow + C_RWR + cg), knw = *(const v4u*)(nrow + C_RWK + cg), vnw = *(const v4u*)(nrow + C_RWV + cg);
                __builtin_amdgcn_sched_barrier(0);
                f32x4 accW[2], accA[2];
#pragma unroll
                for (int tq = 0; tq < 2; ++tq) { f32x4 z = {0.f, 0.f, 0.f, 0.f}; z = mfma16(wf[tq][0], Bw[0], z); accW[tq] = mfma16(wf[tq][1], Bw[1], z);
                                                 f32x4 y = {0.f, 0.f, 0.f, 0.f}; y = mfma16(af[tq][0], Ba[0], y); accA[tq] = mfma16(af[tq][1], Ba[1], y); }
                float rc[8], kc[8], vc[8], rn[8], kn[8], vn[8];
                unpack8(rcw, rc); unpack8(kcw, kc); unpack8(vcw, vc); unpack8(rnw, rn); unpack8(knw, kn); unpack8(vnw, vn);
                float dec[8], kp[8], rr[8], vv[8];
#pragma unroll
                for (int g = 0; g < 2; ++g) {
                    const f32x4 w0v = *(const LAS f32x4*)(pr + 0 * 64 + cl + 4 * g), a0v = *(const LAS f32x4*)(pr + 1 * 64 + cl + 4 * g), mur = *(const LAS f32x4*)(pr + 2 * 64 + cl + 4 * g),
                                muk = *(const LAS f32x4*)(pr + 3 * 64 + cl + 4 * g), muv = *(const LAS f32x4*)(pr + 4 * 64 + cl + 4 * g), kkv = *(const LAS f32x4*)(pr + 5 * 64 + cl + 4 * g),
                                kav = *(const LAS f32x4*)(pr + 6 * 64 + cl + 4 * g), rkv = *(const LAS f32x4*)(pr + 7 * 64 + cl + 4 * g);
#pragma unroll
                    for (int i = 0; i < 4; ++i) { const int j = 4 * g + i;
                        const float rnb = hasnb ? rn[j] : 0.f, knb = hasnb ? kn[j] : 0.f, vnb = hasnb ? vn[j] : 0.f;
                        const float r_ = rc[j] + (rnb - rc[j]) * mur[i], k0 = kc[j] + (knb - kc[j]) * muk[i], v_ = vc[j] + (vnb - vc[j]) * muv[i];
                        const float xw = -(w0v[i] + accW[g][i]);
                        const float sp = fmaxf(xw, 0.f) + __logf(1.0f + __expf(-fabsf(xw)));
                        dec[j] = __expf(-__expf(-sp - 0.5f));
                        const float av = rcp_f(1.0f + __expf(-(a0v[i] + accA[g][i])));
                        const float kx = k0 * kkv[i]; ss += kx * kx;
                        const float kp_ = k0 * (1.f + (av - 1.f) * kav[i]); bon += r_ * kp_ * rkv[i];
                        KK[8 * hf + j] = kx; AV[8 * hf + j] = av; kp[j] = kp_; rr[j] = r_; vv[j] = v_; }
                }
                char* ob = recb + cl * 2;
                REC_ST((h8*)(ob), ((h8){(_Float16)(1.0f - dec[0]), (_Float16)(1.0f - dec[1]), (_Float16)(1.0f - dec[2]), (_Float16)(1.0f - dec[3]), (_Float16)(1.0f - dec[4]), (_Float16)(1.0f - dec[5]), (_Float16)(1.0f - dec[6]), (_Float16)(1.0f - dec[7])}));
                REC_ST((h8*)(ob + 384), ((h8){(_Float16)kp[0], (_Float16)kp[1], (_Float16)kp[2], (_Float16)kp[3], (_Float16)kp[4], (_Float16)kp[5], (_Float16)kp[6], (_Float16)kp[7]}));
                REC_ST((h8*)(ob + 512), ((h8){(_Float16)rr[0], (_Float16)rr[1], (_Float16)rr[2], (_Float16)rr[3], (_Float16)rr[4], (_Float16)rr[5], (_Float16)rr[6], (_Float16)rr[7]}));
                REC_ST((h8*)(ob + 640), ((h8){(_Float16)vv[0], (_Float16)vv[1], (_Float16)vv[2], (_Float16)vv[3], (_Float16)vv[4], (_Float16)vv[5], (_Float16)vv[6], (_Float16)vv[7]}));
                __builtin_amdgcn_sched_barrier(0);
            }
            ss = sum16x4(ss); bon = sum16x4(bon);
            const float inv = rsq_f(fmaxf(ss, 1e-12f));
#pragma unroll
            for (int hf = 0; hf < 2; ++hf) { char* ob = recb + (32 * hf + 8 * q4) * 2; float kkn[8], nka[8];
#pragma unroll
                for (int j = 0; j < 8; ++j) { kkn[j] = KK[8 * hf + j] * inv; nka[j] = -(kkn[j] * AV[8 * hf + j]); }
                REC_ST((h8*)(ob + 128), ((h8){(_Float16)kkn[0], (_Float16)kkn[1], (_Float16)kkn[2], (_Float16)kkn[3], (_Float16)kkn[4], (_Float16)kkn[5], (_Float16)kkn[6], (_Float16)kkn[7]}));
                REC_ST((h8*)(ob + 256), ((h8){(_Float16)nka[0], (_Float16)nka[1], (_Float16)nka[2], (_Float16)nka[3], (_Float16)nka[4], (_Float16)nka[5], (_Float16)nka[6], (_Float16)nka[7]})); }
            if (q4 == 0) BON[(size_t)chain * SCANLEN + pos] = bon;
        }
    }
}
template <bool CTXQ>
__device__ __forceinline__ void na_unit(const bf16* QN, const bf16* KN, const bf16* VTL, const bf16* VTC, const bf16* P, const float* rpb  , bf16* Y, int u, int lane) {
    const int n = lane & 15, q4 = lane >> 4;
    int b, h, qrow0, qr = 0, jt = 0;
    if (CTXQ) { b = u >> 8; h = (u >> 4) & 15; qrow0 = NLAT + b * CTXL + 16 * (u & 15); }
    else { jt = u & 3; h = (u >> 2) & 15; qr = (u >> 6) & 127; b = u >> 13; qrow0 = b * SEQ + qr * 64 + 16 * jt; }
    constexpr int NT = CTXQ ? 16 : 32, WT = CTXQ ? 0 : 16;
    f32x4 s[NT];
    const int rs = qr - 4 < 0 ? 0 : (qr - 4 > 120 ? 120 : qr - 4);
    const int span0 = jt == 0 ? 0 : (jt == 1 ? 8 : (jt == 2 ? 24 : 32));
    const int qc = 16 * jt + n; const int cs = qc - 8 < 0 ? 0 : (qc - 8 > 48 ? 48 : qc - 8);
    bf16x8 qf[2];
#pragma unroll
    for (int ks = 0; ks < 2; ++ks) qf[ks] = ld_frag(QN + (size_t)(qrow0 + n) * GWD + h * 64 + 32 * ks + 8 * q4);
    if (!CTXQ) {
        const float* rp = rpb + (size_t)h * 15 * 31;
#pragma unroll
        for (int wt = 0; wt < 16; ++wt) { const int kri = wt >> 1, half = wt & 1, relr = rs + kri - qr + 7;
#pragma unroll
            for (int i = 0; i < 4; ++i) { const int relc = span0 + 8 * q4 + 4 * half + i - qc + 15; const int relcc = relc < 0 ? 0 : (relc > 30 ? 30 : relc); s[wt][i] = rp[relr * 31 + relcc]; } }
        __builtin_amdgcn_sched_barrier(0);
#pragma unroll
        for (int bt = 0; bt < 2; ++bt) {
            bf16x8 kf[16];
#pragma unroll
            for (int t = 0; t < 8; ++t) { const int wt = bt * 8 + t, kri = wt >> 1, half = wt & 1;
                const bf16* kp = KN + (size_t)(b * SEQ + (rs + kri) * 64 + span0 + 8 * (n >> 2) + 4 * half + (n & 3)) * GWD + h * 64 + 8 * q4; kf[2 * t] = ld_frag(kp); kf[2 * t + 1] = ld_frag(kp + 32); }
            __builtin_amdgcn_sched_barrier(0);
#pragma unroll
            for (int t = 0; t < 8; ++t) { const int wt = bt * 8 + t, half = wt & 1;
                f32x4 a = s[wt];
#pragma unroll
                for (int i = 0; i < 4; ++i) { const int kc = span0 + 8 * q4 + 4 * half + i; const bool ok = kc >= cs && kc < cs + 16; a[i] = ok ? a[i] : -INFINITY; }
                a = mfma16(kf[2 * t], qf[0], a); a = mfma16(kf[2 * t + 1], qf[1], a); s[wt] = a; }
            __builtin_amdgcn_sched_barrier(0);
        }
    }
#pragma unroll
    for (int bt = 0; bt < 2; ++bt) {
        bf16x8 kf[16];
#pragma unroll
        for (int t = 0; t < 8; ++t) { const int ctile = bt * 8 + t; const bf16* kp = KN + (size_t)(NLAT + b * CTXL + 32 * (ctile >> 1) + 8 * (n >> 2) + 4 * (ctile & 1) + (n & 3)) * GWD + h * 64 + 8 * q4; kf[2 * t] = ld_frag(kp); kf[2 * t + 1] = ld_frag(kp + 32); }
        __builtin_amdgcn_sched_barrier(0);
#pragma unroll
        for (int t = 0; t < 8; ++t) { f32x4 a = {0.f, 0.f, 0.f, 0.f}; a = mfma16(kf[2 * t], qf[0], a); a = mfma16(kf[2 * t + 1], qf[1], a); s[WT + bt * 8 + t] = a; }
        __builtin_amdgcn_sched_barrier(0);
    }
    float mx = -INFINITY;
#pragma unroll
    for (int t = 0; t < NT; ++t) mx = fmaxf(fmaxf(fmaxf(s[t][0], s[t][1]), fmaxf(s[t][2], s[t][3])), mx);
    mx = max16x4(mx);
    float sum = 0.f;
#pragma unroll
    for (int t = 0; t < NT; ++t) {
#pragma unroll
        for (int i = 0; i < 4; ++i) { const float e = __expf(s[t][i] - mx); s[t][i] = e; sum += e; } }
    sum = sum16x4(sum);
    const float inv = rcp_f(sum);
    f32x4 o[4];
#pragma unroll
    for (int nt = 0; nt < 4; ++nt) o[nt] = (f32x4){0.f, 0.f, 0.f, 0.f};
#pragma unroll
    for (int tb = 0; tb < NT / 8; ++tb) {
        v4u vv[4][4];
#pragma unroll
        for (int tq = 0; tq < 4; ++tq) { const int tp = tb * 4 + tq;
            const bf16* vb; size_t dstride;
            if (!CTXQ && tp < 8) { vb = VTL + ((size_t)(b * 16 + h) * 64 + n) * 8192 + (rs + tp) * 64 + span0 + 8 * q4; dstride = (size_t)16 * 8192; }
            else { const int cp = tp - (CTXQ ? 0 : 8); vb = VTC + ((size_t)(b * 16 + h) * 64 + n) * 256 + 32 * cp + 8 * q4; dstride = (size_t)16 * 256; }
#pragma unroll
            for (int nt = 0; nt < 4; ++nt) vv[tq][nt] = *(const v4u*)(vb + nt * dstride); }
        __builtin_amdgcn_sched_barrier(0);
#pragma unroll
        for (int tq = 0; tq < 4; ++tq) { const int tp = tb * 4 + tq;
            const f32x4 p0 = s[2 * tp] * inv, p1 = s[2 * tp + 1] * inv;
            v4u aw; aw.x = pk2(p0[0], p0[1]); aw.y = pk2(p0[2], p0[3]); aw.z = pk2(p1[0], p1[1]); aw.w = pk2(p1[2], p1[3]);
            const bf16x8 af = __builtin_bit_cast(bf16x8, aw);
#pragma unroll
            for (int nt = 0; nt < 4; ++nt) o[nt] = mfma16(af, __builtin_bit_cast(bf16x8, vv[tq][nt]), o[nt]); }
        __builtin_amdgcn_sched_barrier(0);
    }
    unsigned short zz[4][4];
#pragma unroll
    for (int nt = 0; nt < 4; ++nt)
#pragma unroll
        for (int i = 0; i < 4; ++i) zz[nt][i] = P[(size_t)(qrow0 + 4 * q4 + i) * NIN + C_NAZ + h * 64 + 16 * nt + n];
    __builtin_amdgcn_sched_barrier(0);
#pragma unroll
    for (int nt = 0; nt < 4; ++nt)
#pragma unroll
        for (int i = 0; i < 4; ++i) { const int row = qrow0 + 4 * q4 + i, col = h * 64 + 16 * nt + n;
            Y[(size_t)row * DM + 1024 + col] = (bf16)f2bf(o[nt][i] * silu_f(bf2f(zz[nt][i]))); }
}
__device__ __forceinline__ void bar4(LAS unsigned* cnt, unsigned& seq, int lane) {
    asm volatile("s_waitcnt vmcnt(0) lgkmcnt(0)" ::: "memory");
    const unsigned baddr = (unsigned)(size_t)cnt, one = 1u; seq += 4u;
    if (lane == 0) asm volatile("ds_add_u32 %0, %1" :: "v"(baddr), "v"(one) : "memory");
    unsigned sp = 0, got;
    for (;;) { asm volatile("ds_read_b32 %0, %1\n\ts_waitcnt lgkmcnt(0)" : "=v"(got) : "v"(baddr) : "memory");
        if (__builtin_amdgcn_readfirstlane((int)got) >= (int)seq) break; __builtin_amdgcn_s_sleep(1); if (++sp > (1u << 22)) break; }
    asm volatile("" ::: "memory");
}
__device__ __forceinline__ void phase_sgu4(const bf16* P, const f32x2* SGST, const float* lnw, const float* lnb, const bf16* SGW, const float* sgb, bf16* Y,
                                           LAS unsigned char* ldsT, LAS unsigned* cnt, int nchunks, int tid4  , int w4  , int lane) {
    const int n = lane & 15, q4 = lane >> 4;
    LAS bf16* T = (LAS bf16*)ldsT; unsigned seq = 0u;
    for (int u = blockIdx.x; u < nchunks * 8; u += 256) {
        const int ck = u >> 3, g = u & 7, m0 = ck * 128;
#pragma unroll
        for (int it = 0; it < 8; ++it) { const int idx = tid4 + 256 * it, q = idx >> 4, c8 = idx & 15;
            float x[8]; unpack8(*(const v4u*)(P + (size_t)(m0 + q) * NIN + C_SGV + g * 128 + 8 * c8), x);
            const f32x2 st = SGST[m0 + q];
#pragma unroll
            for (int j = 0; j < 8; ++j) { const int c = 8 * c8 + j; const float v = (x[j] - st.x) * st.y * lnw[g * 128 + c] + lnb[g * 128 + c]; T[c * 136 + q] = (bf16)f2bf(v); } }
        bar4(cnt, seq, lane);
#pragma unroll 1
        for (int mt = 0; mt < 2; ++mt) { const int mrow = 32 * w4 + 16 * mt;
            bf16x8 af[4];
#pragma unroll
            for (int ks = 0; ks < 4; ++ks) af[ks] = ld_frag(SGW + ((size_t)g * 128 + mrow + n) * 128 + 32 * ks + 8 * q4);
            unsigned short uu16[8][4], zz16[8][4]; float sb4[4];
#pragma unroll
            for (int i = 0; i < 4; ++i) { const int p = mrow + 4 * q4 + i; sb4[i] = sgb[g * 128 + p]; const bf16* pr = P + (size_t)(m0 + p) * NIN + g * 128 + n;
#pragma unroll
                for (int nt = 0; nt < 8; ++nt) { uu16[nt][i] = pr[C_SGU + 16 * nt]; zz16[nt][i] = pr[C_SGZ + 16 * nt]; } }
            __builtin_amdgcn_sched_barrier(0);
#pragma unroll
            for (int nt = 0; nt < 8; ++nt) {
                f32x4 acc = {0.f, 0.f, 0.f, 0.f};
#pragma unroll
                for (int ks = 0; ks < 4; ++ks) { const bf16x8 bfg = *(const LAS bf16x8*)(T + (16 * nt + n) * 136 + 32 * ks + 8 * q4); acc = mfma16(af[ks], bfg, acc); }
#pragma unroll
                for (int i = 0; i < 4; ++i) { const int p = mrow + 4 * q4 + i, row = m0 + p, col = g * 128 + 16 * nt + n;
                    Y[(size_t)row * DM + 3072 + col] = (bf16)f2bf(bf2f(uu16[nt][i]) * (acc[i] + sb4[i]) * silu_f(bf2f(zz16[nt][i]))); }
            }
        }
        bar4(cnt, seq, lane);
    }
}
__device__ __forceinline__ void scan_self(const float* REC, float* YR, LAS unsigned char* lds, LAS unsigned* bcnt, int su, int wave, int lane) {
    constexpr int CS = 32, NCH = SCANLEN / CS, SLOT = CS * RECB, NPW = SLOT / 1024 / 4;
    const int chain = (su & 7) * 8 + ((su >> 3) >> 2), part = (su >> 3) & 3;
    const char* recb = (const char*)REC + (size_t)chain * SCANLEN * RECB;
    const int wl = wave;
#define SCAN_ISSUE(cc, sl) do { _Pragma("unroll") for (int p_ = 0; p_ < NPW; ++p_) \
    __builtin_amdgcn_global_load_lds((const unsigned*)(recb + (size_t)(cc) * SLOT + (wl * NPW + p_) * 1024 + lane * 16), (LAS unsigned*)(lds + (sl) * SLOT + (wl * NPW + p_) * 1024), 16, 0, 0); } while (0)
    __builtin_amdgcn_s_setprio(3);
    SCAN_ISSUE(0, 0); SCAN_ISSUE(1, 1);
#define SCAN_ARRIVE() do { unsigned long long ex_; const unsigned baddr_ = (unsigned)(size_t)bcnt, one_ = 1u; \
    asm volatile("s_mov_b64 %0, exec\n\ts_mov_b64 exec, 1\n\tds_add_u32 %1, %2\n\ts_mov_b64 exec, %0" : "=&s"(ex_) : "v"(baddr_), "v"(one_) : "memory"); } while (0)
    static_assert(NPW == 6, "vmcnt counts below assume 6 pieces per wave and chunk");
    asm volatile("s_waitcnt vmcnt(6)" ::: "memory");
    SCAN_ARRIVE();
    const int c16 = lane & 15, rg = lane >> 4, row = 16 * part + 4 * wave + rg;
    float S0 = 0.f, S1 = 0.f, S2 = 0.f, S3 = 0.f;
#if defined(PROBE_DUP)
    float T0 = 0.f, T1 = 0.f, T2 = 0.f, T3 = 0.f, tdum = 0.f; asm volatile("" : "+v"(T0), "+v"(T1), "+v"(T2), "+v"(T3));
#endif
#if defined(PROBE_LDS2)
    f32x4 dw_ = {0.f, 0.f, 0.f, 0.f}; v4u dk_ = {0u, 0u, 0u, 0u};
#endif
    float* yout = YR + (size_t)chain * SCANLEN * 64 + row;
    const int lo_h = c16 * 8, lo_v = 640 + row * 2;
#define SCAN_LD(dst, s_) do { const unsigned ahj_ = ah + ((s_) & ~1) * RECB; \
    asm volatile("ds_read2_b64 %0, %1 offset0:%2 offset1:%3" : "=v"(dst##ek) : "v"(ahj_), "i"(((s_) & 1) * (RECB / 8)), "i"(((s_) & 1) * (RECB / 8) + 16)); \
    asm volatile("ds_read_u16 %0, %1 offset:%2" : "=v"(dst##v) : "v"(av), "i"((s_) * RECB)); \
    asm volatile("ds_read2_b64 %0, %1 offset0:%2 offset1:%3" : "=v"(dst##nk) : "v"(ahj_), "i"(((s_) & 1) * (RECB / 8) + 32), "i"(((s_) & 1) * (RECB / 8) + 48)); \
    asm volatile("ds_read_b64 %0, %1 offset:%2" : "=v"(dst##r) : "v"(ah), "i"((s_) * RECB + 512)); } while (0)
#define H2H(q_) __builtin_bit_cast(h4, (q_))
#define H4LO(q_) __builtin_bit_cast(h4, (v2u){(q_).x, (q_).y})
#define H4HI(q_) __builtin_bit_cast(h4, (v2u){(q_).z, (q_).w})
#define FMX(a, b, c) __builtin_fmaf((a), (float)(b), (c))
#if defined(PROBE_CHUNK)
    unsigned long long ptz_ = 0ull;
#endif
    for (int c = 0; c < NCH; ++c) {
#if defined(PROBE_CHUNK)
        const unsigned long long pt0_ = __builtin_amdgcn_s_memrealtime(); unsigned long long pt8_ = pt0_;
#endif
        {   const unsigned baddr = (unsigned)(size_t)bcnt; const unsigned want = 4u * (unsigned)(c + 1); unsigned sp = 0, got;
#if defined(PROBE_CHUNK)
            if (PROBE_CHUNK & 64) { const unsigned long long a_ = __builtin_amdgcn_s_memrealtime(); asm volatile("s_waitcnt lgkmcnt(0)" ::: "memory");
                asm volatile("ds_read_b32 %0, %1\n\ts_waitcnt lgkmcnt(0)" : "=v"(got) : "v"(baddr) : "memory");
                const unsigned long long n_ = __builtin_amdgcn_s_memrealtime(), te_ = n_ + (n_ - a_) * 4; while (__builtin_amdgcn_s_memrealtime() < te_) __builtin_amdgcn_s_sleep(1); }
#endif
            for (;;) { asm volatile("ds_read_b32 %0, %1\n\ts_waitcnt lgkmcnt(0)" : "=v"(got) : "v"(baddr) : "memory");
                if (__builtin_amdgcn_readfirstlane((int)got) >= (int)want) break; __builtin_amdgcn_s_sleep(1); if (++sp > (1u << 22)) break; } }
        asm volatile("" ::: "memory");
#if defined(PROBE_CHUNK)
        if ((PROBE_CHUNK & 128) && c > 0) { const unsigned long long n_ = __builtin_amdgcn_s_memrealtime(), te_ = n_ + (n_ - ptz_) * 4; while (__builtin_amdgcn_s_memrealtime() < te_) __builtin_amdgcn_s_sleep(1); }
        const unsigned long long ptp_ = __builtin_amdgcn_s_memrealtime();
#endif
        const int cc = c + 2 < NCH ? c + 2 : NCH - 1; const int s2 = (c + 2) & 3;
        const LAS unsigned char* slot = lds + (c & 3) * SLOT;
        float ysv0 = 0.f, ysv1 = 0.f; float yp[16];
        const unsigned ah = (unsigned)(size_t)(slot + lo_h), av = (unsigned)(size_t)(slot + lo_v);
        v4u Aek, Ank, Bek, Bnk; v2u Ar, Br; unsigned Av, Bv; h4 Pr;
        SCAN_LD(A, 0); SCAN_LD(B, 1);
#pragma unroll
        for (int s = 0; s < CS; ++s) {
            v4u Cek, Cnk; v2u Cr; unsigned Cv;
#if defined(PROBE_LDS2)
            if (s < CS - 2) { SCAN_LD(C, s + 2);
                { const unsigned ahj_ = ah + ((s + 2) & ~1) * RECB;
                  asm volatile("ds_read_b128 %0, %1 offset:%2" : "+v"(dw_) : "v"(aw), "i"((s + 2) * RECB));
                  asm volatile("ds_read2_b64 %0, %1 offset0:%2 offset1:%3" : "+v"(dk_) : "v"(ahj_), "i"(((s + 2) & 1) * (RECB / 8)), "i"(((s + 2) & 1) * (RECB / 8) + 16)); }
                if (s == 0) asm volatile("s_waitcnt lgkmcnt(10)" : "+v"(Aek), "+v"(Ank), "+v"(Ar), "+v"(Av)); else asm volatile("s_waitcnt lgkmcnt(12)" : "+v"(Aek), "+v"(Ank), "+v"(Ar), "+v"(Av)); }
            else if (s == CS - 2) asm volatile("s_waitcnt lgkmcnt(6)" : "+v"(Aek), "+v"(Ank), "+v"(Ar), "+v"(Av));
#else
            if (s < CS - 2) { SCAN_LD(C, s + 2); asm volatile("s_waitcnt lgkmcnt(8)" : "+v"(Aek), "+v"(Ank), "+v"(Ar), "+v"(Av)); }
            else if (s == CS - 2) asm volatile("s_waitcnt lgkmcnt(4)" : "+v"(Aek), "+v"(Ank), "+v"(Ar), "+v"(Av));
#endif
            else asm volatile("s_waitcnt lgkmcnt(0)" : "+v"(Aek), "+v"(Ank), "+v"(Ar), "+v"(Av));
#if defined(PROBE_CHUNK)
            if (s == 8) pt8_ = __builtin_amdgcn_s_memrealtime();
            if (s == 8 && (PROBE_CHUNK & 8)) { const unsigned long long te_ = pt8_ + (pt8_ - ptp_) * 4; while (__builtin_amdgcn_s_memrealtime() < te_) __builtin_amdgcn_s_sleep(1); }
#endif
            if ((s & 3) == 1 && (s >> 2) < NPW) { const int p_ = s >> 2;
                __builtin_amdgcn_global_load_lds((const unsigned*)(recb + (size_t)cc * SLOT + (wl * NPW + p_) * 1024 + lane * 16), (LAS unsigned*)(lds + s2 * SLOT + (wl * NPW + p_) * 1024), 16, 0, 0); }
#if defined(PROBE_CHUNK)
            unsigned long long ptv_ = 0ull; if (s == 16 && (PROBE_CHUNK & 16)) { ptv_ = __builtin_amdgcn_s_memrealtime(); asm volatile("s_waitcnt lgkmcnt(0)" ::: "memory"); }
#endif
            if (s == 16) { if (c == 0) asm volatile("s_waitcnt vmcnt(4)" ::: "memory"); else asm volatile("s_waitcnt vmcnt(6)" ::: "memory"); SCAN_ARRIVE(); }
#if defined(PROBE_CHUNK)
            if (s == 16 && (PROBE_CHUNK & 16)) { const unsigned long long n_ = __builtin_amdgcn_s_memrealtime(), te_ = n_ + (n_ - ptv_) * 4; while (__builtin_amdgcn_s_memrealtime() < te_) __builtin_amdgcn_s_sleep(1); }
#endif
            __builtin_amdgcn_sched_barrier(0);
            const h4 Ae = H4LO(Aek), Akk = H4HI(Aek), Ana = H4LO(Ank), Ak = H4HI(Ank), Arr = H2H(Ar); const _Float16 Avh = __builtin_bit_cast(_Float16, (unsigned short)Av);
            if (s > 0) { float q0 = FMX(S0, Pr.x, 0.f); q0 = FMX(S1, Pr.y, q0); q0 = FMX(S2, Pr.z, q0); yp[(s - 1) & 15] = FMX(S3, Pr.w, q0); }
            float p0 = FMX(S0, Akk.x, 0.f); p0 = FMX(S1, Akk.y, p0); p0 = FMX(S2, Akk.z, p0); p0 = FMX(S3, Akk.w, p0);
            const float dt = red16(p0);
            const float u0 = FMX(S0, -Ae.x, FMX((float)Avh, Ak.x, S0)), u1 = FMX(S1, -Ae.y, FMX((float)Avh, Ak.y, S1)),
                        u2 = FMX(S2, -Ae.z, FMX((float)Avh, Ak.z, S2)), u3 = FMX(S3, -Ae.w, FMX((float)Avh, Ak.w, S3));
            S0 = FMX(dt, Ana.x, u0); S1 = FMX(dt, Ana.y, u1); S2 = FMX(dt, Ana.z, u2); S3 = FMX(dt, Ana.w, u3);
#if defined(PROBE_IND)
            {   float d0, d1, d2, d3;
                asm volatile("v_mul_f32 %0, %4, %4\n\tv_mul_f32 %1, %4, %4\n\tv_mul_f32 %2, %4, %4\n\tv_mul_f32 %3, %4, %4\n\t"
                             "v_mul_f32 %0, %4, %4\n\tv_mul_f32 %1, %4, %4\n\tv_mul_f32 %2, %4, %4\n\tv_mul_f32 %3, %4, %4\n\t"
                             "v_mul_f32 %0, %4, %4\n\tv_mul_f32 %1, %4, %4\n\tv_mul_f32 %2, %4, %4\n\tv_mul_f32 %3, %4, %4\n\t"
                             "v_mul_f32 %0, %4, %4\n\tv_mul_f32 %1, %4, %4\n\tv_mul_f32 %2, %4, %4\n\tv_mul_f32 %3, %4, %4" : "=&v"(d0), "=&v"(d1), "=&v"(d2), "=&v"(d3) : "v"(Aw.x)); }
#endif
#if defined(PROBE_DUP)
            {
                if (s > 0) { float q0 = FMX(T0, Pr.x, 0.f), q1 = FMX(T2, Pr.z, 0.f); q0 = FMX(T1, Pr.y, q0); q1 = FMX(T3, Pr.w, q1); tdum += q0 + q1; }
                float p0 = FMX(T0, Akk.x, 0.f), p1 = FMX(T2, Akk.z, 0.f); p0 = FMX(T1, Akk.y, p0); p1 = FMX(T3, Akk.w, p1);
                const float dt2 = red16(p0 + p1);
                const float u0 = __builtin_fmaf(T0, Aw.x, FMX((float)Avh, Ak.x, 0.f)), u1 = __builtin_fmaf(T1, Aw.y, FMX((float)Avh, Ak.y, 0.f)),
                            u2 = __builtin_fmaf(T2, Aw.z, FMX((float)Avh, Ak.z, 0.f)), u3 = __builtin_fmaf(T3, Aw.w, FMX((float)Avh, Ak.w, 0.f));
                T0 = FMX(dt2, Ana.x, u0); T1 = FMX(dt2, Ana.y, u1); T2 = FMX(dt2, Ana.z, u2); T3 = FMX(dt2, Ana.w, u3); }
#endif
            if (s == 16) ysv0 = red16_transpose(yp, c16);
            Pr = Arr;
            if (s < CS - 1) { Aek = Bek; Ank = Bnk; Ar = Br; Av = Bv; }
            if (s < CS - 2) { Bek = Cek; Bnk = Cnk; Br = Cr; Bv = Cv; }
        }
#if defined(PROBE_CHUNK)
        asm volatile("" : "+v"(S0), "+v"(S1), "+v"(S2), "+v"(S3));
        const unsigned long long pt1_ = __builtin_amdgcn_s_memrealtime();
        if (PROBE_CHUNK & 4) { const unsigned long long te_ = pt1_ + (pt1_ - pt8_) * 4; while (__builtin_amdgcn_s_memrealtime() < te_) __builtin_amdgcn_s_sleep(1); }
#endif
        { float q0 = FMX(S0, Pr.x, 0.f); q0 = FMX(S1, Pr.y, q0); q0 = FMX(S2, Pr.z, q0); yp[15] = FMX(S3, Pr.w, q0); }
        ysv1 = red16_transpose(yp, c16);
        asm volatile("" ::: "memory");
        yout[(size_t)(c * CS + c16) * 64] = ysv0; yout[(size_t)(c * CS + 16 + c16) * 64] = ysv1;
#if defined(PROBE_CHUNK)
        if (PROBE_CHUNK & 2) { const unsigned long long n_ = __builtin_amdgcn_s_memrealtime(), te_ = n_ + (n_ - pt1_) * 4; while (__builtin_amdgcn_s_memrealtime() < te_) __builtin_amdgcn_s_sleep(1); }
        if (PROBE_CHUNK & 128) ptz_ = __builtin_amdgcn_s_memrealtime();
        if (PROBE_CHUNK & 32) { const unsigned long long n_ = __builtin_amdgcn_s_memrealtime(), te_ = n_ + (n_ - ptp_) * 2; while (__builtin_amdgcn_s_memrealtime() < te_) __builtin_amdgcn_s_sleep(1); }
#endif
    }
    asm volatile("s_waitcnt vmcnt(0)" ::: "memory");
    __builtin_amdgcn_s_setprio(0);
#if defined(PROBE_DUP)
    asm volatile("" :: "v"(T0), "v"(T1), "v"(T2), "v"(T3), "v"(tdum));
#endif
#if defined(PROBE_LDS2)
    asm volatile("s_waitcnt lgkmcnt(0)" :: "v"(dw_), "v"(dk_));
#endif
#undef FMX
#undef SCAN_LD
#undef SCAN_ARRIVE
#undef H4LO
#undef H4HI
#undef H2H
#undef SCAN_ISSUE
}
__device__ __forceinline__ void phase_rwfin(const bf16* P, const float* YR, const float* REC, const float* BON, const float* lnw, const float* lnb, bf16* Y, int nrows, int gw, int NGW, int lane) {
    const int head = lane >> 2, sub = lane & 3;
    for (int m = gw; m < nrows; m += NGW) {
        const bool isctx = m >= NLAT; const int t = isctx ? ((m - NLAT) & 255) : (m & 8191); const int b = isctx ? ((m - NLAT) >> 8) : (m >> 13);
        float out[16];
#pragma unroll
        for (int i = 0; i < 16; ++i) out[i] = 0.f;
#pragma unroll
        for (int d = 0; d < 2; ++d) {
            const int chain = (b * 2 + d) * 16 + head; const size_t pp = (size_t)chain * SCANLEN + scan_pos(d, isctx, t);
            float y[16], v[16];
#pragma unroll
            for (int j = 0; j < 4; ++j) { const f32x4 a = *(const f32x4*)(YR + pp * 64 + 16 * sub + 4 * j); const h4 c = *(const h4*)((const char*)REC + pp * RECB + 640 + (16 * sub + 4 * j) * 2);
                y[4 * j] = a.x; y[4 * j + 1] = a.y; y[4 * j + 2] = a.z; y[4 * j + 3] = a.w; v[4 * j] = (float)c.x; v[4 * j + 1] = (float)c.y; v[4 * j + 2] = (float)c.z; v[4 * j + 3] = (float)c.w; }
            const float bo = BON[pp];
            float s = 0.f;
#pragma unroll
            for (int i = 0; i < 16; ++i) s += y[i];
            s += __shfl_xor(s, 1); s += __shfl_xor(s, 2);
            const float mean = s * (1.f / 64.f); float q = 0.f;
#pragma unroll
            for (int i = 0; i < 16; ++i) { const float dl = y[i] - mean; q += dl * dl; }
            q += __shfl_xor(q, 1); q += __shfl_xor(q, 2);
            const float rstd = rsq_f(q * (1.f / 64.f) + 64e-5f);
#pragma unroll
            for (int i = 0; i < 16; ++i) { const int ch = head * 64 + 16 * sub + i; out[i] += (y[i] - mean) * rstd * lnw[ch] + lnb[ch] + bo * v[i]; }
        }
        float z[16]; unpack8(*(const v4u*)(P + (size_t)m * NIN + C_RWZ + 16 * lane), z); unpack8(*(const v4u*)(P + (size_t)m * NIN + C_RWZ + 16 * lane + 8), z + 8);
#pragma unroll
        for (int i = 0; i < 16; ++i) out[i] *= silu_f(z[i]);
        *(v4u*)(Y + (size_t)m * DM + 2048 + 16 * lane) = pack8(out); *(v4u*)(Y + (size_t)m * DM + 2048 + 16 * lane + 8) = pack8(out + 8);
    }
}
#define XB_TMO      128
#define XB_XCNT(j)  (256  + 64 * (j))
#define XB_XSUB(j)  (1280 + 64 * (j))
#define XB_XGEN(j)  (2304 + 64 * (j))
#define XB_TOP      3328
#define XB_TOPGEN   3392
#define XCD_BAR_WORDS 3456
#define XB_SPIN_CAP (1u << 18)

__device__ __forceinline__ unsigned xb_ld(unsigned* p)              { return __hip_atomic_load(p, __ATOMIC_RELAXED, __HIP_MEMORY_SCOPE_AGENT); }
__device__ __forceinline__ unsigned xb_add(unsigned* p, unsigned v) { return __hip_atomic_fetch_add(p, v, __ATOMIC_RELAXED, __HIP_MEMORY_SCOPE_AGENT); }
__device__ __forceinline__ unsigned xb_xcc_id() { return (unsigned)__builtin_amdgcn_s_getreg((3 << 11) | 20) & 0xFu; }
#define XB_SPIN(cond, bar) do { unsigned _sp = 0; while (cond) { __builtin_amdgcn_s_sleep(1); \
    if ((++_sp & 255u) == 0u) { if (xb_ld(&(bar)[XB_TMO])) break; if (_sp > XB_SPIN_CAP) { atomicAdd(&(bar)[XB_TMO], 1u); break; } } } } while (0)

struct XcdBarrier {
    unsigned* bar; unsigned x;
    volatile LAS unsigned* st;
};

__device__ __forceinline__ XcdBarrier xcd_barrier_post(unsigned* bar, volatile LAS unsigned* st) {
    XcdBarrier b; b.bar = bar; b.x = xb_xcc_id(); b.st = st;
    if (threadIdx.x == 0) (void)xb_add(&bar[XB_XCNT(b.x)], 1u);
    return b;
}
__device__ __forceinline__ void xcd_barrier_complete(unsigned* bar, unsigned x, unsigned& nloc, unsigned& nx) {
    const unsigned G = gridDim.x * gridDim.y * gridDim.z;
    unsigned sum, cnt, mine, sp = 0u;
    for (;;) {
        sum = 0u; cnt = 0u; mine = 0u;
#pragma unroll
        for (unsigned j = 0; j < 16; ++j) { const unsigned c = xb_ld(&bar[XB_XCNT(j)]); sum += c; cnt += (c > 0u) ? 1u : 0u; mine = (j == x) ? c : mine; }
        if (sum == G) break;
        __builtin_amdgcn_s_sleep(1);
        if ((++sp & 255u) == 0u) { if (xb_ld(&bar[XB_TMO])) break; if (sp > XB_SPIN_CAP) { atomicAdd(&bar[XB_TMO], 1u); break; } }
    }
    nloc = mine > 0u ? mine : 1u; nx = cnt > 0u ? cnt : 1u;
}

__device__ __forceinline__ void xcd_barrier(const XcdBarrier& b) {
    asm volatile("s_waitcnt vmcnt(0)" ::: "memory");
    __syncthreads();
    if (threadIdx.x == 0) {
        unsigned* bar = b.bar;
        __builtin_amdgcn_s_waitcnt(0);
        unsigned nloc = b.st[0], nx = b.st[1];
        if (nloc == 0u) { xcd_barrier_complete(bar, b.x, nloc, nx); b.st[0] = nloc; b.st[1] = nx; }
        const unsigned old = xb_add(&bar[XB_XSUB(b.x)], 1u);
        const unsigned gen = old / nloc;
        if (old + 1u == (gen + 1u) * nloc) {
            __builtin_amdgcn_fence(__ATOMIC_RELEASE, "agent");
            asm volatile("s_waitcnt vmcnt(0)" ::: "memory");
            const unsigned og = xb_add(&bar[XB_TOP], 1u);
            const unsigned tg = og / nx;
            if (og + 1u == (tg + 1u) * nx) xb_add(&bar[XB_TOPGEN], 1u);
            else XB_SPIN(xb_ld(&bar[XB_TOPGEN]) == tg, bar);
            __builtin_amdgcn_fence(__ATOMIC_ACQUIRE, "agent");
            xb_add(&bar[XB_XGEN(b.x)], 1u);
            asm volatile("s_waitcnt vmcnt(0)" ::: "memory");
        } else {
            XB_SPIN(xb_ld(&bar[XB_XGEN(b.x)]) == gen, bar);
            __builtin_amdgcn_fence(__ATOMIC_ACQUIRE, "agent");
            asm volatile("s_waitcnt vmcnt(0)" ::: "memory");
        }
    }
    __syncthreads();
}

#ifndef MK_SPLIT
#define MK_SPLIT 0
#endif
constexpr int PPL = 6;
constexpr int NPHASE = 2 + PPL * DEPTH;
constexpr int RWP_BLOCKS = 14;
constexpr int CW_RWQ = 16384;
constexpr int NGRID = 256;
struct Args { const float* in[28]; float* out; unsigned char* ws; int ph_lo, ph_hi, li, pad; };

__global__ void __launch_bounds__(NWAVES * 64, 2) fwd(Args args) {
    extern __shared__ __attribute__((aligned(16))) unsigned char lds_raw[];
    LAS unsigned char* lds = (LAS unsigned char*)lds_raw;
    volatile LAS unsigned* MISC = (volatile LAS unsigned*)(lds + MISC_OFF);
    const int tid = threadIdx.x, lane = tid & 63, wave = __builtin_amdgcn_readfirstlane(tid >> 6);
    constexpr int G = NGRID; const int bx = blockIdx.x;
    const int vcu = (bx % 8) * (G / 8) + bx / 8;
    const int gw = vcu * NWAVES + wave; constexpr int NGW = G * NWAVES;
    unsigned char* ws = args.ws;
    const int lo = args.ph_lo, hi = args.ph_hi;

    for (int u = tid; u < (LDS_BYTES - LDSCTL_OFF) / 4; u += NWAVES * 64) ((LAS unsigned*)(lds + LDSCTL_OFF))[u] = 0u;
    __syncthreads();
    XcdBarrier bar; bar.bar = (unsigned*)(ws + WS_CTL) + CW_BAR; bar.x = 0; bar.st = MISC + 8;
    if (hi - lo > 1) bar = xcd_barrier_post((unsigned*)(ws + WS_CTL) + CW_BAR, MISC + 8);
#define IN(k) (lo <= (k) && (k) < hi)
#define SEAM(k) do { if (lo <= (k) && (k) + 1 < hi) { XcdBarrier b2_; b2_.bar = WSP(unsigned, WS_CTL) + CW_BAR; b2_.x = bar.x; b2_.st = bar.st; xcd_barrier(b2_); } } while (0)

#define OPQ_S(x) ({ int _t = (x); asm volatile("" : "+s"(_t)); _t; })
#define OPQ_V(x) ({ int _t = (x); asm volatile("" : "+v"(_t)); _t; })
#define INP(i) (args.in[OPQ_S(i)])
#define WSP(T, off) ((T*)(args.ws + ({ size_t _o = (off); asm volatile("" : "+s"(_o)); _o; })))
#define x_in INP(0)
#define c_in INP(1)
#define ctx_in INP(2)
#define cctx_in INP(3)
#define w_mod INP(4)
#define b_mod INP(5)
#define w_in INP(6)
#define w_out INP(7)
#define pool_w INP(8)
#define pool_scale INP(9)
#define na_qg INP(10)
#define na_kg INP(11)
#define na_rpb INP(12)
#define rw_mu_rkv INP(13)
#define rw_mu_lora INP(14)
#define rw_w0 INP(15)
#define rw_w_up INP(16)
#define rw_a0 INP(17)
#define rw_a_up INP(18)
#define rw_k_k INP(19)
#define rw_k_a INP(20)
#define rw_r_k INP(21)
#define rw_ln_w INP(22)
#define rw_ln_b INP(23)
#define sg_ln_w INP(24)
#define sg_ln_b INP(25)
#define sg_w INP(26)
#define sg_b INP(27)
#define MOD WSP(float, WS_MOD)
#define MODP WSP(float, WS_MODP)
#define TAB WSP(f32x2, WS_TAB)
#define SGST WSP(f32x2, WS_SGST)
#define BON WSP(float, WS_BON)
#define POOLWT WSP(bf16, WS_POOLWT)
#define WUPT WSP(bf16, WS_WUPT)
#define AUPT WSP(bf16, WS_AUPT)
#define SGW WSP(bf16, WS_SGW)
#define VTC WSP(bf16, WS_VTC)
#define VTL WSP(bf16, WS_VTL)
#define HCTX WSP(float, WS_HCTX)
#define QN WSP(bf16, WS_QN)
#define KN WSP(bf16, WS_KN)
#define WOUTT WSP(bf16, WS_WOUTT)
#define WINT WSP(bf16, WS_WINT)
#define XN WSP(bf16, WS_XN)
#define Y WSP(bf16, WS_Y)
#define P WSP(bf16, WS_P)
#define YR WSP(float, WS_YR)
#define REC WSP(float, WS_REC)
#define SILUC WSP(float, WS_SILUC)
    float* const out = args.out;

    if (IN(0)) {
        LAS float* scr = (LAS float*)(lds + wave * 16384);
        constexpr int I_MOD = 64 * 48  , I_WIN = 64 * (NIN / 32), I_WOUT = 64 * 128, I_POOL = 4 * 32, I_WUP = 2 * 32, I_AUP = 2 * 32, I_SGW = 256;
        constexpr int NITEMS = I_MOD + I_WIN + I_WOUT + I_POOL + I_WUP + I_AUP + I_SGW;
        for (int it = gw; it < NITEMS; it += NGW) {
            int r = it;
            if (r < I_MOD) { p0_mod_item(w_mod, c_in, cctx_in, MODP, scr, r, lane); continue; } r -= I_MOD;
            if (r < I_WIN) { p0_transpose_item<true>(w_in, DM, NIN, WINT, scr, r, lane); continue; } r -= I_WIN;
            if (r < I_WOUT) { p0_transpose_item(w_out, DM, DM, WOUTT, scr, r, lane); continue; } r -= I_WOUT;
            if (r < I_POOL) { const int g = r / 32; p0_transpose_item(pool_w + (size_t)g * 65536, 256, 256, POOLWT + (size_t)g * 65536, scr, r % 32, lane); continue; } r -= I_POOL;
            if (r < I_WUP) { const int dd = r / 32; p0_transpose_item(rw_w_up + (size_t)dd * 65536, 64, 1024, WUPT + (size_t)dd * 65536, scr, r % 32, lane); continue; } r -= I_WUP;
            if (r < I_AUP) { const int dd = r / 32; p0_transpose_item(rw_a_up + (size_t)dd * 65536, 64, 1024, AUPT + (size_t)dd * 65536, scr, r % 32, lane); continue; } r -= I_AUP;
            {   const size_t e0 = (size_t)r * 512 + lane * 8; const f32x4 a = *(const f32x4*)(sg_w + e0), b = *(const f32x4*)(sg_w + e0 + 4);
                v4u o; o.x = pk2(a.x, a.y); o.y = pk2(a.z, a.w); o.z = pk2(b.x, b.y); o.w = pk2(b.z, b.w); *(v4u*)(SGW + e0) = o; }
        }
        SEAM(0);
    }
    if (IN(1)) {

        for (int idx = gw * 64 + lane; idx < 3 * 4096; idx += NGW * 64) SILUC[idx] = silu_f(idx < 8192 ? c_in[idx] : cctx_in[idx - 8192]);
        for (int idx = gw * 64 + lane; idx < 3 * 12288; idx += NGW * 64) {
            const int l = idx / 36864, c = (idx / 12288) % 3, n = idx % 12288;
            float s = b_mod[l * 12288 + n];
            const float* pp = MODP + ((size_t)(l * 64) * 3 + c) * 12288 + n;
#pragma unroll 8
            for (int kc = 0; kc < 64; ++kc) s += pp[(size_t)kc * 3 * 12288];
            MOD[idx] = s;
        }
        for (int idx = gw * 64 + lane; idx < 2048; idx += NGW * 64) {
            const int pos = idx >> 4, i = idx & 15;
            float inv = (i & 3) == 0 ? 1.0f : ((i & 3) == 1 ? 0.5623413251903491f : ((i & 3) == 2 ? 0.31622776601683794f : 0.17782794100389228f));
            inv *= (i >> 2) == 0 ? 1.0f : ((i >> 2) == 1 ? 0.1f : ((i >> 2) == 2 ? 0.01f : 0.001f));
            float cc, sn; sincos_acc((float)pos * inv, cc, sn);
            TAB[idx] = (f32x2){cc, sn};
        }
        SEAM(1);
    }
    for (int l = 0; l < DEPTH; ++l) {
        const int pb = 2 + PPL * l;
        const bool with_ctx = l < DEPTH - 1;
#define hin_lat (l == 0 ? x_in : (const float*)out)
#define hin_ctx (l == 0 ? ctx_in : (const float*)HCTX)
#define mod (MOD + (size_t)l * 3 * 12288)
        const int nrows = with_ctx ? MROWS : NLAT;
        if (IN(pb + 0)) {
            phase_xn(hin_lat, hin_ctx, mod, XN, OPQ_S(gw), NGW, OPQ_V(lane));
            SEAM(pb + 0);
        }
        if (IN(pb + 1)) {
            constexpr int C0 = C_SPLIT, NA_ = NIN - C0;
            pg8::Gemm g{XN, WINT + (size_t)l * NIN * DM + (size_t)C0 * DM, MROWS, NA_, DM}; pg8::StaticOrder S; S.init(MROWS, NA_, G, bx);
            pg8::EpiStoreBf16 E{P + C0, NIN};
            pg8::gemm_phase<pg8::EpiStoreBf16, pg8::StaticOrder, true, true>(lds, g, S, E);
            SEAM(pb + 1);
        }
        if (IN(pb + 2)) {
            if (bx >= RWP_BLOCKS) {
                constexpr int NB_ = C_SPLIT;
                pg8::Gemm g{XN, WINT + (size_t)l * NIN * DM, MROWS, NB_, DM}; pg8::StaticOrder S; S.init(MROWS, NB_, G - RWP_BLOCKS, bx - RWP_BLOCKS);
                pg8::EpiStoreBf16 E{P, NIN};
                pg8::gemm_phase<pg8::EpiStoreBf16, pg8::StaticOrder, true, true>(lds, g, S, E);
            }
            phase_rwprep(P, rw_mu_rkv + (size_t)l * 6144, rw_mu_lora + (size_t)l * 256, rw_w0 + (size_t)l * 2048, WUPT + (size_t)l * 131072, rw_a0 + (size_t)l * 2048, AUPT + (size_t)l * 131072,
                         rw_k_k + (size_t)l * 1024, rw_k_a + (size_t)l * 1024, rw_r_k + (size_t)l * 1024, REC, BON, lds, WSP(unsigned, WS_CTL) + CW_RWQ + l * 1024, (bx * NWAVES + wave) & 15, wave, OPQ_V(lane));
            phase_rowprep(P, na_qg + l * 64, na_kg + l * 64, TAB, QN, KN, SGST, OPQ_S(gw), NGW, OPQ_V(lane));
            phase_vt(P, VTL, VTC, OPQ_S(gw), NGW, OPQ_V(lane));
            SEAM(pb + 2);
        }
        if (IN(pb + 3)) {
            {
            LAS unsigned* mixq = (LAS unsigned*)(lds + LDSCTL_OFF + 64); LAS unsigned* mixb = (LAS unsigned*)(lds + LDSCTL_OFF + 128); LAS unsigned* mixs = (LAS unsigned*)(lds + LDSCTL_OFF + 192);
            if (tid == 0) { *mixq = 0u; *mixb = 0u; *mixs = 0u; }
            __syncthreads();
#if defined(PROBE_CAT6)
            if (wave < 4) { const unsigned long long t0_ = __builtin_amdgcn_s_memrealtime(); scan_self(REC, YR, lds, mixb, bx, wave, OPQ_V(lane));
                const unsigned long long n_ = __builtin_amdgcn_s_memrealtime(), te_ = n_ + (n_ - t0_); while (__builtin_amdgcn_s_memrealtime() < te_) __builtin_amdgcn_s_sleep(16); }
#else
            if (wave < 4) scan_self(REC, YR, lds, mixb, bx, wave, OPQ_V(lane));
#endif
            else phase_sgu4(P, SGST, sg_ln_w + (size_t)l * 1024, sg_ln_b + (size_t)l * 1024, SGW + (size_t)l * 131072, sg_b + (size_t)l * 1024, Y, lds + SGUT_OFF, mixs, nrows / 128, OPQ_V(tid) - 256, wave - 4, OPQ_V(lane));
            {   const int nctxu = with_ctx ? 2 : 0, npool = (nrows / 16) * 4, npq = (npool + NGRID - 1) / NGRID, nwc = l + 1 < DEPTH ? (WC_ITEMS + NGRID - 1) / NGRID : 0, nmd = l + 1 < DEPTH ? (64 * 48) / NGRID : 0, nq = 64 + nctxu + npq + nwc + nmd;
                for (;;) {
                    unsigned k = 0; if (lane == 0) k = __hip_atomic_fetch_add(mixq, 1u, __ATOMIC_RELAXED, __HIP_MEMORY_SCOPE_WORKGROUP);
                    k = (unsigned)__builtin_amdgcn_readfirstlane((int)k);
                    if ((int)k >= nq) break;
                    const int ln = OPQ_V(lane);
                    if (k < 64u) { na_unit<false>(QN, KN, VTL, VTC, P, na_rpb + (size_t)l * 16 * 15 * 31, Y, vcu * 64 + (int)k, ln);
                    }
                    else if ((int)k < 64 + nctxu) na_unit<true>(QN, KN, VTL, VTC, P, na_rpb, Y, bx * 2 + ((int)k - 64), ln);
                    else if ((int)k >= 64 + nctxu + npq + nwc) mod_item_nolds(w_mod + (size_t)(l + 1) * 4096 * 12288, SILUC, MODP + (size_t)(l + 1) * 64 * 3 * 12288, bx + NGRID * ((int)k - 64 - nctxu - npq - nwc), ln);
                    else if ((int)k >= 64 + nctxu + npq) { const int r = bx + NGRID * ((int)k - 64 - nctxu - npq);
                        if (r < WC_ITEMS) weight_copy_item(l + 1, r, w_in, w_out, pool_w, rw_w_up, rw_a_up, sg_w, WINT, WOUTT, POOLWT, WUPT, AUPT, SGW, ln); }
                    else { const int u = bx + NGRID * ((int)k - 64 - nctxu);
                        if (u < npool) { const int tt = u >> 2, g = u & 3; const bf16* wbase = POOLWT + (size_t)l * 262144 + (size_t)g * 65536; const float* psc = pool_scale + (size_t)l * 1024;
                            if (g == 0) pool_unit<0>(P, wbase, psc, Y, tt * 16, ln); else if (g == 1) pool_unit<1>(P, wbase, psc, Y, tt * 16, ln);
                            else if (g == 2) pool_unit<2>(P, wbase, psc, Y, tt * 16, ln); else pool_unit<3>(P, wbase, psc, Y, tt * 16, ln); } }
                }
            }
            }
            SEAM(pb + 3);
        }
        if (IN(pb + 4)) {
            if (l + 1 < DEPTH) for (int idx = gw * 64 + lane; idx < 3 * 12288; idx += NGW * 64) {
                const int c = idx / 12288, n = idx % 12288; float s = b_mod[(l + 1) * 12288 + n];
                const float* pp = MODP + ((size_t)((l + 1) * 64) * 3 + c) * 12288 + n;
#pragma unroll 8
                for (int kc = 0; kc < 64; ++kc) s += pp[(size_t)kc * 3 * 12288];
                MOD[(size_t)(l + 1) * 3 * 12288 + idx] = s; }
            phase_rwfin(P, YR, REC, BON, rw_ln_w + (size_t)l * 1024, rw_ln_b + (size_t)l * 1024, Y, nrows, OPQ_S(gw), NGW, OPQ_V(lane));
            SEAM(pb + 4);
        }
        if (IN(pb + 5)) {
            pg8::Gemm g{Y, WOUTT + (size_t)l * DM * DM, nrows, DM, DM}; pg8::StaticOrder S; S.init(nrows, DM, G, bx);
            pg8::EpiResGate E{hin_lat, hin_ctx, out, HCTX, mod};
            pg8::gemm_phase<pg8::EpiResGate, pg8::StaticOrder, true, true>(lds, g, S, E);
            SEAM(pb + 5);
        }
    }
#undef IN
#undef SEAM
}
#undef hin_lat
#undef hin_ctx
#undef mod
#undef P
#undef Y
#undef XN
#undef out

extern "C" void kernel_launch(void* const* d_in, const int* in_sizes, int n_in, void* d_out, int out_size, void* d_ws, size_t ws_size, hipStream_t stream) {
    static int grid = 0;
    if (grid == 0) {
        if (n_in != 28 || out_size != NLAT * DM || ws_size < WS_END) { fprintf(stderr, "kernel_launch: unexpected shapes (n_in %d, out %d, ws %zu < %zu); nothing launched\n", n_in, out_size, ws_size, (size_t)WS_END); grid = -1; return; }
        int dev = 0, cus = 0, per_cu = 0;
        if (hipGetDevice(&dev) != hipSuccess || hipDeviceGetAttribute(&cus, hipDeviceAttributeMultiprocessorCount, dev) != hipSuccess) { grid = -1; return; }
        if (hipFuncSetAttribute((const void*)fwd, hipFuncAttributeMaxDynamicSharedMemorySize, LDS_BYTES) != hipSuccess) { fprintf(stderr, "kernel_launch: hipFuncSetAttribute failed\n"); grid = -1; return; }
        if (hipOccupancyMaxActiveBlocksPerMultiprocessor(&per_cu, (const void*)fwd, NWAVES * 64, LDS_BYTES) != hipSuccess || per_cu < 1)
            fprintf(stderr, "kernel_launch: note: occupancy query reports %d workgroups per CU\n", per_cu);
        (void)hipGetLastError();
        grid = cus >= NGRID ? NGRID : -2;
    }
    if (grid == -1) return;
    if (hipMemsetAsync((char*)d_ws + WS_CTL, 0, CTL_ZERO_BYTES, stream) != hipSuccess) { fprintf(stderr, "kernel_launch: memset failed\n"); return; }
    Args a{};
    for (int i = 0; i < 28; ++i) a.in[i] = (const float*)d_in[i];
    a.out = (float*)d_out; a.ws = (unsigned char*)d_ws; a.li = 0; a.pad = 0;
    const bool split = MK_SPLIT || grid == -2;
    if (split) { for (int k = 0; k < NPHASE; ++k) { a.ph_lo = k; a.ph_hi = k + 1; hipLaunchKernelGGL(fwd, dim3(NGRID), dim3(NWAVES * 64), LDS_BYTES, stream, a); } }
    else { a.ph_lo = 0; a.ph_hi = NPHASE; hipLaunchKernelGGL(fwd, dim3(NGRID), dim3(NWAVES * 64), LDS_BYTES, stream, a); }
    const hipError_t le = hipPeekAtLastError();
    if (le != hipSuccess) fprintf(stderr, "kernel_launch: launch failed: %s\n", hipGetErrorName(le));
}
```
